# Optimizing an MI355X kernel written in HIP

```python
import math
import jax
import jax.numpy as jnp
from jax import lax
import numpy as np

D_MODEL = 1024
BATCH = 8
SEQ = 4096
DEPTH = 2

D_MIX = D_MODEL
SSM_WIDTH = D_MIX // 4
POOL_WIDTH = D_MIX // 4
ATT_WIDTH = D_MIX // 2
N_PROJ = SSM_WIDTH + POOL_WIDTH + 3 * ATT_WIDTH
SSM_GROUP = 16
SSM_GROUPS = SSM_WIDTH // SSM_GROUP
SSM_STATE = 64
SSM_DT_MIN = 1e-3
SSM_DT_MAX = 1e-1
POOL_WINDOWS = (2, 4, 8, 16)
POOL_GROUP = POOL_WIDTH // len(POOL_WINDOWS)
ATT_HEAD_DIM = 64
ATT_HEADS = ATT_WIDTH // ATT_HEAD_DIM
MOBA_BLOCK = 256
MOBA_TOPK = 3
MOBA_Q_CHUNK = 32
REL_BUCKETS = 32
REL_MAX_DIST = 128
MOE_GROUPS = 4
MOE_EXPERTS_PER_GROUP = 4
MOE_EXPERTS = MOE_GROUPS * MOE_EXPERTS_PER_GROUP
MOE_TOPK = 2
D_EXPERT = D_MODEL // 4
RMS_EPS = 1e-6
NEG_INF = -1e30

kernel_name = 'hybrid_s5_pool_moba_hmoe'


def rms_norm(x, g):
    xf = x.astype(jnp.float32)
    y = xf * lax.rsqrt(jnp.mean(xf * xf, axis=-1, keepdims=True) + RMS_EPS)
    return (y * g.astype(jnp.float32)).astype(x.dtype)


def t5_bucket(rel):
    n = jnp.maximum(rel, 0)
    max_exact = REL_BUCKETS // 2
    nf = jnp.maximum(n, 1).astype(jnp.float32)
    large = max_exact + (jnp.log(nf / max_exact) / math.log(REL_MAX_DIST / max_exact)
                         * (REL_BUCKETS - max_exact)).astype(jnp.int32)
    large = jnp.minimum(large, REL_BUCKETS - 1)
    return jnp.where(n < max_exact, n, large)


def ssm_mixer(u, a_re, a_im, log_dt, b_re, b_im, c_re, c_im, d, glu_w, glu_b):
    f32 = jnp.float32
    bsz, seq, _ = u.shape
    lam = lax.complex(a_re.astype(f32), a_im.astype(f32))
    dt = jnp.exp(log_dt.astype(f32))[:, None]
    lam_bar = jnp.exp(lam * dt)
    b = lax.complex(b_re.astype(f32), b_im.astype(f32))
    b_bar = ((lam_bar - 1.0) / lam)[..., None] * b
    c = lax.complex(c_re.astype(f32), c_im.astype(f32))
    uf = u.astype(f32)
    ug = uf.reshape(bsz, seq, SSM_GROUPS, SSM_GROUP).astype(jnp.complex64)
    bu = jnp.einsum('blgh,gph->blgp', ug, b_bar)
    a = jnp.broadcast_to(lam_bar, bu.shape)

    def combine(e1, e2):
        a1, b1 = e1
        a2, b2 = e2
        return a1 * a2, a2 * b1 + b2

    _, states = lax.associative_scan(combine, (a, bu), axis=1)
    y = jnp.einsum('blgp,ghp->blgh', states, c).real.reshape(bsz, seq, SSM_WIDTH)
    y = jax.nn.gelu(y + d.astype(f32) * uf)
    y = y * jax.nn.sigmoid(y @ glu_w.astype(f32) + glu_b.astype(f32))
    return y.astype(u.dtype)


def pool_mixer(p, w, b, scale):
    f32 = jnp.float32
    bsz, seq, _ = p.shape
    pf = p.astype(f32)
    cs = lax.cumsum(pf, axis=1)
    t = jnp.arange(seq)
    outs = []
    for gi, win in enumerate(POOL_WINDOWS):
        sl = slice(gi * POOL_GROUP, (gi + 1) * POOL_GROUP)
        csg = cs[..., sl]
        lag = jnp.pad(csg, ((0, 0), (win, 0), (0, 0)))[:, :seq]
        cnt = jnp.minimum(t + 1, win).astype(f32)[None, :, None]
        outs.append((csg - lag) / cnt - pf[..., sl])
    dlt = jnp.stack(outs, axis=2)
    y = jnp.einsum('blgc,gcd->blgd', dlt, w.astype(f32)).reshape(bsz, seq, POOL_WIDTH)
    y = (y + b.astype(f32)) * scale.astype(f32)
    return y.astype(p.dtype)


def moba_attention(q, k, v, rel_bias):
    f32 = jnp.float32
    bsz, seq, nh, dh = q.shape
    nb = -(-seq // MOBA_BLOCK)
    lp = nb * MOBA_BLOCK
    pad = lp - seq

    def to_bhld(t):
        return jnp.pad(t, ((0, 0), (0, pad), (0, 0), (0, 0))).transpose(0, 2, 1, 3)

    qh = to_bhld(q)
    kb = to_bhld(k).reshape(bsz, nh, nb, MOBA_BLOCK, dh)
    vb = to_bhld(v).reshape(bsz, nh, nb, MOBA_BLOCK, dh)
    kmean = jnp.mean(kb.astype(f32), axis=3)
    n_sel = min(MOBA_TOPK, nb - 1)
    bias_t = rel_bias.astype(f32).T
    b_ix = jnp.arange(bsz)[:, None, None, None]
    h_ix = jnp.arange(nh)[None, :, None, None]
    offs = jnp.arange(MOBA_BLOCK)
    scale = dh ** -0.5

    def chunk(ci):
        q0 = ci * MOBA_Q_CHUNK
        qc = lax.dynamic_slice_in_dim(qh, q0, MOBA_Q_CHUNK, axis=2).astype(f32)
        qpos = q0 + jnp.arange(MOBA_Q_CHUNK)
        qblk = q0 // MOBA_BLOCK
        k_own = lax.dynamic_index_in_dim(kb, qblk, axis=2, keepdims=False).astype(f32)
        v_own = lax.dynamic_index_in_dim(vb, qblk, axis=2, keepdims=False).astype(f32)
        rel_own = qpos[:, None] - (qblk * MOBA_BLOCK + offs)[None, :]
        s_own = jnp.einsum('bhqd,bhkd->bhqk', qc, k_own) * scale + bias_t[:, t5_bucket(rel_own)]
        s_own = jnp.where(rel_own >= 0, s_own, NEG_INF)
        if n_sel == 0:
            return jnp.einsum('bhqk,bhkd->bhqd', jax.nn.softmax(s_own, axis=-1), v_own)
        gate = jnp.einsum('bhqd,bhnd->bhqn', qc, kmean)
        gate = jnp.where(jnp.arange(nb) < qblk, gate, NEG_INF)
        _, sel = lax.top_k(gate, n_sel)
        k_sel = kb[b_ix, h_ix, sel].astype(f32)
        v_sel = vb[b_ix, h_ix, sel].astype(f32)
        rel_sel = qpos[:, None, None] - (sel[..., None] * MOBA_BLOCK + offs)
        s_sel = (jnp.einsum('bhqd,bhqnkd->bhqnk', qc, k_sel) * scale
                 + bias_t[h_ix[..., None], t5_bucket(rel_sel)])
        s_sel = jnp.where((sel < qblk)[..., None], s_sel, NEG_INF)
        logits = jnp.concatenate(
            [s_sel.reshape(bsz, nh, MOBA_Q_CHUNK, n_sel * MOBA_BLOCK), s_own], axis=-1)
        probs = jax.nn.softmax(logits, axis=-1)
        p_sel = probs[..., :n_sel * MOBA_BLOCK].reshape(bsz, nh, MOBA_Q_CHUNK, n_sel, MOBA_BLOCK)
        p_own = probs[..., n_sel * MOBA_BLOCK:]
        return (jnp.einsum('bhqnk,bhqnkd->bhqd', p_sel, v_sel)
                + jnp.einsum('bhqk,bhkd->bhqd', p_own, v_own))

    out = lax.map(chunk, jnp.arange(lp // MOBA_Q_CHUNK))
    out = out.transpose(1, 0, 3, 2, 4).reshape(bsz, lp, nh * dh)[:, :seq]
    return out.astype(q.dtype)


def hier_moe(h, group_w, group_b, router_w, router_b, w_gate, w_up, w_down):
    f32 = jnp.float32
    bsz, seq, dm = h.shape
    t = h.reshape(-1, dm)
    g_logits = (t @ group_w + group_b).astype(f32)
    g_prob = jax.nn.softmax(g_logits, axis=-1)
    g_sel = jnp.argmax(g_logits, axis=-1)
    g_wt = jnp.take_along_axis(g_prob, g_sel[:, None], axis=1)[:, 0]
    e_all = jnp.einsum('td,gde->tge', t, router_w) + router_b
    e_logits = jnp.take_along_axis(e_all, g_sel[:, None, None], axis=1)[:, 0].astype(f32)
    top_v, top_i = lax.top_k(e_logits, MOE_TOPK)
    top_w = jax.nn.softmax(top_v, axis=-1)
    within = jnp.sum(jax.nn.one_hot(top_i, MOE_EXPERTS_PER_GROUP, dtype=f32) * top_w[..., None], axis=1)
    comb = ((jax.nn.one_hot(g_sel, MOE_GROUPS, dtype=f32) * g_wt[:, None])[:, :, None]
            * within[:, None, :]).reshape(-1, MOE_EXPERTS)
    hg = jnp.einsum('td,edf->tef', t, w_gate)
    hu = jnp.einsum('td,edf->tef', t, w_up)
    act = jax.nn.silu(hg) * hu * comb[..., None]
    y = jnp.einsum('tef,efd->td', act, w_down)
    return y.reshape(bsz, seq, dm).astype(h.dtype)


def setup_inputs(seed: int = 0) -> dict:
    key = jax.random.key(seed)
    ks = jax.random.split(key, 32)
    f32 = jnp.float32

    def nrm(k, shape, s):
        return jax.random.normal(k, shape, f32) * s

    L, G, P, H = DEPTH, SSM_GROUPS, SSM_STATE, SSM_GROUP
    x = nrm(ks[0], (BATCH, SEQ, D_MODEL), 1.0)
    rel_bias = nrm(ks[1], (REL_BUCKETS, ATT_HEADS), 0.5)
    norm1_g = 1.0 + nrm(ks[2], (L, D_MODEL), 0.02)
    w_in = nrm(ks[3], (L, D_MODEL, N_PROJ), D_MODEL ** -0.5)
    ssm_a_re = -0.5 + nrm(ks[4], (L, G, P), 0.01)
    ssm_a_im = jnp.pi * jnp.arange(P, dtype=f32)[None, None, :] + nrm(ks[5], (L, G, P), 0.01)
    ssm_log_dt = jax.random.uniform(ks[6], (L, G), f32, math.log(SSM_DT_MIN), math.log(SSM_DT_MAX))
    ssm_b_re = nrm(ks[7], (L, G, P, H), (2.0 * H) ** -0.5)
    ssm_b_im = nrm(ks[8], (L, G, P, H), (2.0 * H) ** -0.5)
    ssm_c_re = nrm(ks[9], (L, G, H, P), (2.0 * P) ** -0.5 * 4.0)
    ssm_c_im = nrm(ks[10], (L, G, H, P), (2.0 * P) ** -0.5 * 4.0)
    ssm_d = nrm(ks[11], (L, SSM_WIDTH), 1.0)
    ssm_glu_w = nrm(ks[12], (L, SSM_WIDTH, SSM_WIDTH), SSM_WIDTH ** -0.5)
    ssm_glu_b = nrm(ks[13], (L, SSM_WIDTH), 0.02)
    pool_w = nrm(ks[14], (L, len(POOL_WINDOWS), POOL_GROUP, POOL_GROUP), POOL_GROUP ** -0.5)
    pool_b = nrm(ks[15], (L, POOL_WIDTH), 0.02)
    pool_scale = 1.0 + nrm(ks[16], (L, POOL_WIDTH), 0.02)
    w_out = nrm(ks[17], (L, D_MIX, D_MODEL), D_MIX ** -0.5)
    norm2_g = 1.0 + nrm(ks[18], (L, D_MODEL), 0.02)
    moe_group_w = nrm(ks[19], (L, D_MODEL, MOE_GROUPS), D_MODEL ** -0.5)
    moe_group_b = nrm(ks[20], (L, MOE_GROUPS), 0.01)
    moe_router_w = nrm(ks[21], (L, MOE_GROUPS, D_MODEL, MOE_EXPERTS_PER_GROUP), D_MODEL ** -0.5)
    moe_router_b = nrm(ks[22], (L, MOE_GROUPS, MOE_EXPERTS_PER_GROUP), 0.01)
    moe_w_gate = nrm(ks[23], (L, MOE_EXPERTS, D_MODEL, D_EXPERT), D_MODEL ** -0.5)
    moe_w_up = nrm(ks[24], (L, MOE_EXPERTS, D_MODEL, D_EXPERT), D_MODEL ** -0.5)
    moe_w_down = nrm(ks[25], (L, MOE_EXPERTS, D_EXPERT, D_MODEL), D_EXPERT ** -0.5)
    final_norm_g = 1.0 + nrm(ks[26], (D_MODEL,), 0.02)
    return {'x': x, 'rel_bias': rel_bias, 'norm1_g': norm1_g, 'w_in': w_in,
            'ssm_a_re': ssm_a_re, 'ssm_a_im': ssm_a_im, 'ssm_log_dt': ssm_log_dt,
            'ssm_b_re': ssm_b_re, 'ssm_b_im': ssm_b_im, 'ssm_c_re': ssm_c_re, 'ssm_c_im': ssm_c_im,
            'ssm_d': ssm_d, 'ssm_glu_w': ssm_glu_w, 'ssm_glu_b': ssm_glu_b,
            'pool_w': pool_w, 'pool_b': pool_b, 'pool_scale': pool_scale, 'w_out': w_out,
            'norm2_g': norm2_g, 'moe_group_w': moe_group_w, 'moe_group_b': moe_group_b,
            'moe_router_w': moe_router_w, 'moe_router_b': moe_router_b,
            'moe_w_gate': moe_w_gate, 'moe_w_up': moe_w_up, 'moe_w_down': moe_w_down,
            'final_norm_g': final_norm_g}


def reference(x, rel_bias, norm1_g, w_in, ssm_a_re, ssm_a_im, ssm_log_dt, ssm_b_re, ssm_b_im,
              ssm_c_re, ssm_c_im, ssm_d, ssm_glu_w, ssm_glu_b, pool_w, pool_b, pool_scale,
              w_out, norm2_g, moe_group_w, moe_group_b, moe_router_w, moe_router_b,
              moe_w_gate, moe_w_up, moe_w_down, final_norm_g):
    bsz, seq, _ = x.shape
    s0 = SSM_WIDTH
    s1 = s0 + POOL_WIDTH
    s2 = s1 + ATT_WIDTH
    s3 = s2 + ATT_WIDTH
    for l in range(DEPTH):
        h = rms_norm(x, norm1_g[l])
        proj = h @ w_in[l]
        y_ssm = ssm_mixer(proj[..., :s0], ssm_a_re[l], ssm_a_im[l], ssm_log_dt[l],
                          ssm_b_re[l], ssm_b_im[l], ssm_c_re[l], ssm_c_im[l],
                          ssm_d[l], ssm_glu_w[l], ssm_glu_b[l])
        y_pool = pool_mixer(proj[..., s0:s1], pool_w[l], pool_b[l], pool_scale[l])
        att_shape = (bsz, seq, ATT_HEADS, ATT_HEAD_DIM)
        y_att = moba_attention(proj[..., s1:s2].reshape(att_shape),
                               proj[..., s2:s3].reshape(att_shape),
                               proj[..., s3:].reshape(att_shape), rel_bias)
        x = x + jnp.concatenate([y_ssm, y_pool, y_att], axis=-1) @ w_out[l]
        h = rms_norm(x, norm2_g[l])
        x = x + hier_moe(h, moe_group_w[l], moe_group_b[l], moe_router_w[l], moe_router_b[l],
                         moe_w_gate[l], moe_w_up[l], moe_w_down[l])
    return rms_norm(x, final_norm_g)
```

```cpp
#include <hip/hip_runtime.h>
#include <cstdio>
#include <cstdint>

#define GAS __attribute__((address_space(1)))
#define LAS __attribute__((address_space(3)))
typedef unsigned short bf16;
typedef float f32x4 __attribute__((ext_vector_type(4)));
typedef unsigned u32x4 __attribute__((ext_vector_type(4)));
typedef unsigned u32x2 __attribute__((ext_vector_type(2)));

constexpr int NB = 8, SEQ = 4096, T = NB * SEQ, D = 1024, NPROJ = 2048, DEPTH = 2;
constexpr int NHEAD = 8, HD = 64, MBLK = 256, NBLK = SEQ / MBLK;
constexpr int SG = 16, SGN = 16, SP = 64, SCH = 64, UGP = 1152;
constexpr float RMS_EPS = 1e-6f;
constexpr float LOG2E = 1.4426950408889634f;
constexpr float C2 = 0.125f * LOG2E;
constexpr int NWAVES = 8, NTHREADS = 512;

constexpr size_t MiB = 1u << 20;
constexpr size_t WS_CTL = 0, CTL_ZERO_BYTES = 1 * MiB;
constexpr size_t WS_XB = 2 * MiB;
constexpr size_t WS_UG = 66 * MiB;
constexpr size_t WS_PB = 84 * MiB;
constexpr size_t WS_QB = 100 * MiB;
constexpr size_t WS_KB = 132 * MiB;
constexpr size_t WS_VB = 164 * MiB;
constexpr size_t WS_YMIX = 196 * MiB;
constexpr size_t WS_YS = 260 * MiB;
constexpr size_t WS_DL = 276 * MiB;
constexpr size_t WS_KMP = 292 * MiB;
constexpr size_t WS_BT = 293 * MiB;
constexpr size_t WS_END = 300 * MiB;

constexpr int CW_BAR = 4096;

__device__ __forceinline__ unsigned f2bf(float f) { unsigned u = __builtin_bit_cast(unsigned, f); return (u + 0x7fffu + ((u >> 16) & 1u)) >> 16; }
__device__ __forceinline__ float bf2f(unsigned h) { return __builtin_bit_cast(float, h << 16); }
__device__ __forceinline__ unsigned pk2(float lo, float hi) { return f2bf(lo) | (f2bf(hi) << 16); }
__device__ __forceinline__ float wave_sum(float v) {
#pragma unroll
    for (int o = 1; o < 64; o <<= 1) v += __shfl_xor(v, o);
    return v;
}
__device__ __forceinline__ float wave_max(float v) {
#pragma unroll
    for (int o = 1; o < 64; o <<= 1) v = fmaxf(v, __shfl_xor(v, o));
    return v;
}
__device__ __forceinline__ float gelu_tanh(float x) {
    const float u = 0.7978845608028654f * (x + 0.044715f * x * x * x);
    const float e = __expf(2.f * u);
    const float th = 1.f - 2.f / (e + 1.f);
    return 0.5f * x * (1.f + th);
}
__device__ __forceinline__ float sigmoidf_(float x) { return 1.f / (1.f + __expf(-x)); }

#define XB_TMO      128
#define XB_XCNT(j)  (256  + 64 * (j))
#define XB_XSUB(j)  (1280 + 64 * (j))
#define XB_XGEN(j)  (2304 + 64 * (j))
#define XB_TOP      3328
#define XB_TOPGEN   3392
#define XCD_BAR_WORDS 3456
#define XB_SPIN_CAP (1u << 22)
__device__ __forceinline__ unsigned xb_ld(unsigned* p)              { return __hip_atomic_load(p, __ATOMIC_RELAXED, __HIP_MEMORY_SCOPE_AGENT); }
__device__ __forceinline__ unsigned xb_add(unsigned* p, unsigned v) { return __hip_atomic_fetch_add(p, v, __ATOMIC_RELAXED, __HIP_MEMORY_SCOPE_AGENT); }
__device__ __forceinline__ unsigned xb_xcc_id() { return (unsigned)__builtin_amdgcn_s_getreg((3 << 11) | 20) & 0xFu; }
#define XB_SPIN(cond, bar) do { unsigned _sp = 0; while (cond) { __builtin_amdgcn_s_sleep(1); \
    if ((++_sp & 255u) == 0u) { if (xb_ld(&(bar)[XB_TMO])) break; if (_sp > XB_SPIN_CAP) { atomicAdd(&(bar)[XB_TMO], 1u); break; } } } } while (0)
struct XcdBarrier { unsigned* bar; unsigned x; volatile LAS unsigned* st; };
__device__ __forceinline__ XcdBarrier xcd_barrier_post(unsigned* bar, volatile LAS unsigned* st) {
    XcdBarrier b; b.bar = bar; b.x = xb_xcc_id(); b.st = st;
    if (threadIdx.x == 0) (void)xb_add(&bar[XB_XCNT(b.x)], 1u);
    return b;
}
__device__ __forceinline__ void xcd_barrier_complete(unsigned* bar, unsigned x, unsigned& nloc, unsigned& nx) {
    const unsigned G = gridDim.x * gridDim.y * gridDim.z;
    unsigned sum, cnt, mine, sp = 0u;
    for (;;) {
        sum = 0u; cnt = 0u; mine = 0u;
#pragma unroll
        for (unsigned j = 0; j < 16; ++j) { const unsigned c = xb_ld(&bar[XB_XCNT(j)]); sum += c; cnt += (c > 0u) ? 1u : 0u; mine = (j == x) ? c : mine; }
        if (sum == G) break;
        __builtin_amdgcn_s_sleep(1);
        if ((++sp & 255u) == 0u) { if (xb_ld(&bar[XB_TMO])) break; if (sp > XB_SPIN_CAP) { atomicAdd(&bar[XB_TMO], 1u); break; } }
    }
    nloc = mine > 0u ? mine : 1u; nx = cnt > 0u ? cnt : 1u;
}
__device__ __forceinline__ void xcd_barrier(const XcdBarrier& b) {
    asm volatile("s_waitcnt vmcnt(0)" ::: "memory");
    __syncthreads();
    if (threadIdx.x == 0) {
        unsigned* bar = b.bar;
        __builtin_amdgcn_s_waitcnt(0);
        unsigned nloc = b.st[0], nx = b.st[1];
        if (nloc == 0u) { xcd_barrier_complete(bar, b.x, nloc, nx); b.st[0] = nloc; b.st[1] = nx; }
        const unsigned old = xb_add(&bar[XB_XSUB(b.x)], 1u);
        const unsigned gen = old / nloc;
        if (old + 1u == (gen + 1u) * nloc) {
            __builtin_amdgcn_fence(__ATOMIC_RELEASE, "agent");
            asm volatile("s_waitcnt vmcnt(0)" ::: "memory");
            const unsigned og = xb_add(&bar[XB_TOP], 1u);
            const unsigned tg = og / nx;
            if (og + 1u == (tg + 1u) * nx) xb_add(&bar[XB_TOPGEN], 1u);
            else XB_SPIN(xb_ld(&bar[XB_TOPGEN]) == tg, bar);
            __builtin_amdgcn_fence(__ATOMIC_ACQUIRE, "agent");
            xb_add(&bar[XB_XGEN(b.x)], 1u);
            asm volatile("s_waitcnt vmcnt(0)" ::: "memory");
        } else {
            XB_SPIN(xb_ld(&bar[XB_XGEN(b.x)]) == gen, bar);
            __builtin_amdgcn_fence(__ATOMIC_ACQUIRE, "agent");
            asm volatile("s_waitcnt vmcnt(0)" ::: "memory");
        }
    }
    __syncthreads();
}

struct Args {
    const float* in[27];
    float* out;
    unsigned char* ws;
    int ph_lo, ph_hi;
};

struct Ctx {
    LAS unsigned char* lds;
    int tid, lane, wave, vcu, G;
    const float* const* in;
    float* R;
    unsigned char* ws;
    bf16 *XB, *UG, *PB, *QB, *KB, *VB, *YMIX, *YS, *DL;
    float *KMP, *BT;
};


__device__ __forceinline__ Ctx launder(const Ctx& F0) {
    Ctx F = F0;
    asm volatile("" : "+v"(F.tid), "+v"(F.lane));
    asm volatile("" : "+s"(F.wave), "+s"(F.vcu), "+s"(F.G));
    return F;
}

__device__ __forceinline__ void store_proj(const Ctx& F, int m, int c, float v) {
    if (c < 256) { const int g = c >> 4, h = c & 15; F.UG[((size_t)(g * 512 + (m >> 6))) * UGP + (m & 63) * 16 + h] = (bf16)f2bf(v); }
    else if (c < 512) F.PB[(size_t)m * 256 + (c - 256)] = (bf16)f2bf(v);
    else if (c < 1024) F.QB[(size_t)m * 512 + (c - 512)] = (bf16)f2bf(v * C2);
    else if (c < 1536) F.KB[(size_t)m * 512 + (c - 1024)] = (bf16)f2bf(v);
    else F.VB[(size_t)m * 512 + (c - 1536)] = (bf16)f2bf(v);
}

template <class Epi>
__device__ __forceinline__ void naive_gemm(const Ctx& F0, const bf16* A, int lda, const float* Bw, int ldb, const float* kscale, int M, int N, int K, const Epi& epi) {
    const Ctx F = launder(F0);
    LAS float* As = (LAS float*)F.lds;
    LAS float* Bs = As + 16 * 132;
    const int tid = F.tid, ty = tid >> 4, tx = tid & 15;
    const int tm = M / 128, tn = N / 128;
    for (int tile = F.vcu; tile < tm * tn; tile += F.G) {
        const int m0 = (tile / tn) * 128, n0 = (tile % tn) * 128;
        float acc[4][8];
#pragma unroll
        for (int i = 0; i < 4; ++i)
#pragma unroll
            for (int j = 0; j < 8; ++j) acc[i][j] = 0.f;
        for (int k0 = 0; k0 < K; k0 += 16) {
            {
                const int row = tid >> 2, kq = (tid & 3) * 4;
                const u32x2 v = *(const u32x2*)(A + (size_t)(m0 + row) * lda + k0 + kq);
                As[(kq + 0) * 132 + row] = bf2f(v.x & 0xffffu); As[(kq + 1) * 132 + row] = bf2f(v.x >> 16);
                As[(kq + 2) * 132 + row] = bf2f(v.y & 0xffffu); As[(kq + 3) * 132 + row] = bf2f(v.y >> 16);
                const int kk = tid >> 5, nq = (tid & 31) * 4;
                f32x4 b = *(const f32x4*)(Bw + (size_t)(k0 + kk) * ldb + n0 + nq);
                const float s = kscale ? kscale[k0 + kk] : 1.f;
                b = b * s;
                *(LAS f32x4*)(Bs + kk * 128 + nq) = b;
            }
            __syncthreads();
#pragma unroll
            for (int kk = 0; kk < 16; ++kk) {
                const f32x4 a = *(const LAS f32x4*)(As + kk * 132 + ty * 4);
                const f32x4 b0 = *(const LAS f32x4*)(Bs + kk * 128 + tx * 8);
                const f32x4 b1 = *(const LAS f32x4*)(Bs + kk * 128 + tx * 8 + 4);
#pragma unroll
                for (int i = 0; i < 4; ++i) {
#pragma unroll
                    for (int j = 0; j < 4; ++j) { acc[i][j] += a[i] * b0[j]; acc[i][4 + j] += a[i] * b1[j]; }
                }
            }
            __syncthreads();
        }
#pragma unroll
        for (int i = 0; i < 4; ++i)
#pragma unroll
            for (int j = 0; j < 8; ++j) epi(m0 + ty * 4 + i, n0 + tx * 8 + j, acc[i][j]);
    }
}

struct EpiProj { Ctx F; __device__ __forceinline__ void operator()(int m, int n, float v) const { store_proj(F, m, n, v); } };
struct EpiGlu { bf16* ys; bf16* ymix; const float* gb;
    __device__ __forceinline__ void operator()(int m, int n, float v) const { const float y = bf2f(ys[(size_t)m * 256 + n]); ymix[(size_t)m * 1024 + n] = (bf16)f2bf(y * sigmoidf_(v + gb[n])); } };
struct EpiOut { const float* xin; float* R;
    __device__ __forceinline__ void operator()(int m, int n, float v) const { const size_t o = (size_t)m * D + n; R[o] = xin[o] + v; } };

__device__ __forceinline__ void ph_norm(const Ctx& F0, const float* xin) {
    const Ctx F = launder(F0);
    const int gw = F.vcu * NWAVES + F.wave, NGW = F.G * NWAVES;
    for (int m = gw; m < T; m += NGW) {
        const f32x4* xr = (const f32x4*)(xin + (size_t)m * D) + F.lane;
        f32x4 v[4]; float s = 0.f;
#pragma unroll
        for (int j = 0; j < 4; ++j) { v[j] = xr[64 * j]; s += (v[j].x * v[j].x + v[j].y * v[j].y) + (v[j].z * v[j].z + v[j].w * v[j].w); }
        const float rstd = 1.f / sqrtf(wave_sum(s) * (1.f / D) + RMS_EPS);
        unsigned long long* o8 = (unsigned long long*)(F.XB + (size_t)m * D) + F.lane;
#pragma unroll
        for (int j = 0; j < 4; ++j) o8[64 * j] = (unsigned long long)pk2(v[j].x * rstd, v[j].y * rstd) | ((unsigned long long)pk2(v[j].z * rstd, v[j].w * rstd) << 32);
    }
}

__device__ __forceinline__ void ph_bias_table(const Ctx& F0) {
    const Ctx F = launder(F0);
    if (F.vcu == 0) {
        const float* rel_bias = F.in[1];
        for (int i = F.tid; i < 8 * 132; i += NTHREADS) {
            const int h = i / 132, r = i % 132;
            int bk;
            if (r < 16) bk = r;
            else { bk = 16 + (int)(logf((float)r / 16.f) / logf(8.f) * 16.f); if (bk > 31) bk = 31; }
            F.BT[i] = rel_bias[bk * 8 + h] * LOG2E;
        }
    }
}

__device__ __forceinline__ void ph_kmean_naive(const Ctx& F0) {
    const Ctx F = launder(F0);
    const int gt = F.vcu * NTHREADS + F.tid, NGT = F.G * NTHREADS;
    for (int i = gt; i < 128 * 512; i += NGT) {
        const int pm = i >> 9, c = i & 511; float s = 0.f;
        for (int r = 0; r < 256; ++r) s += bf2f(F.KB[(size_t)(pm * 256 + r) * 512 + c]);
        F.KMP[i] = s; F.KMP[128 * 512 + i] = 0.f;
    }
}

__device__ __forceinline__ void ph_ssm_naive(const Ctx& F0, int l) {
    const Ctx F = launder(F0);
    const int gw = F.vcu * NWAVES + F.wave, NGW = F.G * NWAVES;
    for (int it = gw; it < NB * SGN; it += NGW) {
        const int b = it / SGN, g = it % SGN, p = F.lane;
        const float are = F.in[4][(l * SGN + g) * SP + p], aim = F.in[5][(l * SGN + g) * SP + p];
        const float dt = __expf(F.in[6][l * SGN + g]);
        const float mag = expf(are * dt); float sn, cs; sincosf(aim * dt, &sn, &cs);
        const float lbr = mag * cs, lbi = mag * sn;
        const float nr = lbr - 1.f, ni = lbi, den = are * are + aim * aim;
        const float cr = (nr * are + ni * aim) / den, ci = (ni * are - nr * aim) / den;
        float bbr[16], bbi[16], ccr[16], cci[16];
#pragma unroll
        for (int h = 0; h < 16; ++h) {
            const float br = F.in[7][((size_t)(l * SGN + g) * SP + p) * SG + h], bi = F.in[8][((size_t)(l * SGN + g) * SP + p) * SG + h];
            bbr[h] = cr * br - ci * bi; bbi[h] = cr * bi + ci * br;
            ccr[h] = F.in[9][((size_t)(l * SGN + g) * SG + h) * SP + p]; cci[h] = F.in[10][((size_t)(l * SGN + g) * SG + h) * SP + p];
        }
        const float dh = (F.lane < 16) ? F.in[11][l * 256 + g * 16 + F.lane] : 0.f;
        float sr = 0.f, si = 0.f;
        for (int t = 0; t < SEQ; ++t) {
            const int m = b * SEQ + t;
            const bf16* up = F.UG + ((size_t)(g * 512 + (m >> 6))) * UGP + (m & 63) * 16;
            const u32x4 u0 = *(const u32x4*)up, u1 = *(const u32x4*)(up + 8);
            float u[16];
            u[0] = bf2f(u0.x & 0xffffu); u[1] = bf2f(u0.x >> 16); u[2] = bf2f(u0.y & 0xffffu); u[3] = bf2f(u0.y >> 16);
            u[4] = bf2f(u0.z & 0xffffu); u[5] = bf2f(u0.z >> 16); u[6] = bf2f(u0.w & 0xffffu); u[7] = bf2f(u0.w >> 16);
            u[8] = bf2f(u1.x & 0xffffu); u[9] = bf2f(u1.x >> 16); u[10] = bf2f(u1.y & 0xffffu); u[11] = bf2f(u1.y >> 16);
            u[12] = bf2f(u1.z & 0xffffu); u[13] = bf2f(u1.z >> 16); u[14] = bf2f(u1.w & 0xffffu); u[15] = bf2f(u1.w >> 16);
            float bur = 0.f, bui = 0.f;
#pragma unroll
            for (int h = 0; h < 16; ++h) { bur += bbr[h] * u[h]; bui += bbi[h] * u[h]; }
            const float nsr = lbr * sr - lbi * si + bur, nsi = lbr * si + lbi * sr + bui;
            sr = nsr; si = nsi;
            float yo = 0.f, uo = 0.f;
#pragma unroll
            for (int h = 0; h < 16; ++h) {
                const float y = wave_sum(ccr[h] * sr - cci[h] * si);
                if (F.lane == h) { yo = y; uo = u[h]; }
            }
            if (F.lane < 16) F.YS[(size_t)m * 256 + g * 16 + F.lane] = (bf16)f2bf(gelu_tanh(yo + dh * uo));
        }
    }
}

__device__ __forceinline__ void ph_pool_dl(const Ctx& F0) {
    const Ctx F = launder(F0);
    const int gt = F.vcu * NTHREADS + F.tid, NGT = F.G * NTHREADS;
    for (int i = gt; i < T * 256; i += NGT) {
        const int m = i >> 8, c = i & 255, t = m & (SEQ - 1), gi = c >> 6, win = 2 << gi;
        const int cnt = (t + 1 < win) ? t + 1 : win;
        float s = 0.f;
        for (int j = 0; j < cnt; ++j) s += bf2f(F.PB[(size_t)(m - j) * 256 + c]);
        F.DL[i] = (bf16)f2bf(s / (float)cnt - bf2f(F.PB[i]));
    }
}
__device__ __forceinline__ void ph_pool_mm_naive(const Ctx& F0, int l) {
    const Ctx F = launder(F0);
    const int gt = F.vcu * NTHREADS + F.tid, NGT = F.G * NTHREADS;
    const float* w = F.in[14] + (size_t)l * 4 * 64 * 64;
    for (int i = gt; i < T * 256; i += NGT) {
        const int m = i >> 8, n = i & 255, gi = n >> 6, d = n & 63; float s = 0.f;
        for (int c = 0; c < 64; ++c) s += bf2f(F.DL[(size_t)m * 256 + gi * 64 + c]) * w[(gi * 64 + c) * 64 + d];
        F.YMIX[(size_t)m * 1024 + 256 + n] = (bf16)f2bf((s + F.in[15][l * 256 + n]) * F.in[16][l * 256 + n]);
    }
}

__device__ __forceinline__ void ph_attn_naive(const Ctx& F0) {
    const Ctx F = launder(F0);
    const int gw = F.vcu * NWAVES + F.wave, NGW = F.G * NWAVES, lane = F.lane;
    for (int it = gw; it < T * NHEAD; it += NGW) {
        const int h = it & 7, m = it >> 3, b = m >> 12, q = m & (SEQ - 1), qblk = q >> 8;
        const float qv = bf2f(F.QB[(size_t)m * 512 + h * 64 + lane]);
        float mygate = -3.0e38f;
        for (int j = 0; j < qblk; ++j) {
            const int pm = b * NBLK + j;
            const float km = F.KMP[pm * 512 + h * 64 + lane] + F.KMP[128 * 512 + pm * 512 + h * 64 + lane];
            const float g = wave_sum(qv * km);
            if (lane == j) mygate = g;
        }
        int bsel0 = -1, bsel1 = -1, bsel2 = -1;
        const int nsel = qblk < 3 ? qblk : 3;
        for (int s = 0; s < nsel; ++s) {
            const float bv = wave_max(mygate);
            const unsigned long long bal = __ballot(mygate == bv);
            const int best = __builtin_ctzll(bal);
            if (s == 0) bsel0 = best; else if (s == 1) bsel1 = best; else bsel2 = best;
            if (lane == best) mygate = -3.0e38f;
        }
        float sc[16];
        float mx = -3.0e38f;
#pragma unroll
        for (int s = 0; s < 4; ++s) {
            const int blk = (s == 0) ? bsel0 : (s == 1) ? bsel1 : (s == 2) ? bsel2 : qblk;
#pragma unroll
            for (int c = 0; c < 4; ++c) {
                float v = -3.0e38f;
                if (blk >= 0) {
                    const int kpos = blk * 256 + c * 64 + lane, rel = q - kpos;
                    const bf16* kr = F.KB + (size_t)(b * SEQ + kpos) * 512 + h * 64;
                    float dot = 0.f;
#pragma unroll
                    for (int d8 = 0; d8 < 8; ++d8) {
                        const u32x4 kk = *(const u32x4*)(kr + d8 * 8);
                        dot += __shfl(qv, d8 * 8 + 0) * bf2f(kk.x & 0xffffu) + __shfl(qv, d8 * 8 + 1) * bf2f(kk.x >> 16);
                        dot += __shfl(qv, d8 * 8 + 2) * bf2f(kk.y & 0xffffu) + __shfl(qv, d8 * 8 + 3) * bf2f(kk.y >> 16);
                        dot += __shfl(qv, d8 * 8 + 4) * bf2f(kk.z & 0xffffu) + __shfl(qv, d8 * 8 + 5) * bf2f(kk.z >> 16);
                        dot += __shfl(qv, d8 * 8 + 6) * bf2f(kk.w & 0xffffu) + __shfl(qv, d8 * 8 + 7) * bf2f(kk.w >> 16);
                    }
                    if (rel >= 0) v = dot + F.BT[h * 132 + (rel < 128 ? rel : 128)];
                }
                sc[s * 4 + c] = v; mx = fmaxf(mx, v);
            }
        }
        mx = wave_max(mx);
        float sum = 0.f;
#pragma unroll
        for (int i = 0; i < 16; ++i) { sc[i] = (sc[i] > -1.0e38f) ? exp2f(sc[i] - mx) : 0.f; sum += sc[i]; }
        sum = wave_sum(sum);
        float o = 0.f;
#pragma unroll
        for (int s = 0; s < 4; ++s) {
            const int blk = (s == 0) ? bsel0 : (s == 1) ? bsel1 : (s == 2) ? bsel2 : qblk;
            if (blk >= 0) {
#pragma unroll
                for (int c = 0; c < 4; ++c) {
                    const bf16* vr = F.VB + (size_t)(b * SEQ + blk * 256 + c * 64) * 512 + h * 64 + lane;
                    const float pc = sc[s * 4 + c];
                    for (int kk = 0; kk < 64; ++kk) {
                        const float p = __builtin_bit_cast(float, __builtin_amdgcn_readlane(__builtin_bit_cast(int, pc), kk));
                        o += p * bf2f(vr[(size_t)kk * 512]);
                    }
                }
            }
        }
        F.YMIX[(size_t)m * 1024 + 512 + h * 64 + lane] = (bf16)f2bf(o / sum);
    }
}

__device__ __forceinline__ void ph_moe_naive(const Ctx& F0, int l) {
    const Ctx F = launder(F0);
    LAS float* h2 = (LAS float*)F.lds;
    LAS float* act = h2 + 1024;
    LAS float* red = act + 512;
    LAS float* lg = red + 32;
    LAS float* selw = lg + 24;
    const float* g2 = F.in[18] + l * D;
    const float* gw_ = F.in[19] + (size_t)l * D * 4; const float* gb_ = F.in[20] + l * 4;
    const float* rw_ = F.in[21] + (size_t)l * 4 * D * 4; const float* rb_ = F.in[22] + l * 16;
    const float* wg = F.in[23] + (size_t)l * 16 * D * 256; const float* wu = F.in[24] + (size_t)l * 16 * D * 256; const float* wd = F.in[25] + (size_t)l * 16 * 256 * D;
    const int tid = F.tid, lane = F.lane, wave = F.wave;
    for (int m = F.vcu; m < T; m += F.G) {
        float* xr = F.R + (size_t)m * D;
        const float x0 = xr[tid], x1 = xr[tid + 512];
        float s = wave_sum(x0 * x0 + x1 * x1);
        if (lane == 0) red[wave] = s;
        __syncthreads();
        float tot = 0.f;
#pragma unroll
        for (int w = 0; w < 8; ++w) tot += red[w];
        const float rstd = 1.f / sqrtf(tot * (1.f / D) + RMS_EPS);
        h2[tid] = x0 * rstd * g2[tid]; h2[tid + 512] = x1 * rstd * g2[tid + 512];
        __syncthreads();
        for (int j = wave; j < 20; j += NWAVES) {
            float a = 0.f;
            if (j < 4) { for (int k = lane; k < D; k += 64) a += h2[k] * gw_[k * 4 + j]; }
            else { const int g = (j - 4) >> 2, e = (j - 4) & 3; for (int k = lane; k < D; k += 64) a += h2[k] * rw_[((size_t)g * D + k) * 4 + e]; }
            a = wave_sum(a);
            if (lane == 0) lg[j] = a + (j < 4 ? gb_[j] : rb_[j - 4]);
        }
        __syncthreads();
        if (tid == 0) {
            int gs = 0; float gm = lg[0];
            for (int j = 1; j < 4; ++j) if (lg[j] > gm) { gm = lg[j]; gs = j; }
            float se = 0.f; for (int j = 0; j < 4; ++j) se += __expf(lg[j] - gm);
            const float gwt = 1.f / se;
            int e1 = 0; float v1 = lg[4 + gs * 4];
            for (int e = 1; e < 4; ++e) if (lg[4 + gs * 4 + e] > v1) { v1 = lg[4 + gs * 4 + e]; e1 = e; }
            int e2 = -1; float v2 = -3.0e38f;
            for (int e = 0; e < 4; ++e) if (e != e1 && lg[4 + gs * 4 + e] > v2) { v2 = lg[4 + gs * 4 + e]; e2 = e; }
            const float p2 = __expf(v2 - v1), w1 = 1.f / (1.f + p2), w2 = p2 / (1.f + p2);
            selw[0] = __builtin_bit_cast(float, gs * 4 + e1); selw[1] = __builtin_bit_cast(float, gs * 4 + e2);
            selw[2] = gwt * w1; selw[3] = gwt * w2;
        }
        __syncthreads();
        {
            const int slot = tid >> 8, f = tid & 255;
            const int e = __builtin_bit_cast(int, selw[slot]); const float cw = selw[2 + slot];
            const float* pg = wg + (size_t)e * D * 256 + f; const float* pu = wu + (size_t)e * D * 256 + f;
            float ag = 0.f, au = 0.f;
            for (int k = 0; k < D; ++k) { const float hv = h2[k]; ag += hv * pg[(size_t)k * 256]; au += hv * pu[(size_t)k * 256]; }
            act[slot * 256 + f] = ag * sigmoidf_(ag) * au * cw;
        }
        __syncthreads();
        {
            const int ea = __builtin_bit_cast(int, selw[0]), eb = __builtin_bit_cast(int, selw[1]);
            const float* pa = wd + (size_t)ea * 256 * D; const float* pb = wd + (size_t)eb * 256 * D;
            float y0 = 0.f, y1 = 0.f;
            for (int f = 0; f < 256; ++f) {
                const float a = act[f], b = act[256 + f];
                y0 += a * pa[(size_t)f * D + tid] + b * pb[(size_t)f * D + tid];
                y1 += a * pa[(size_t)f * D + tid + 512] + b * pb[(size_t)f * D + tid + 512];
            }
            xr[tid] = x0 + y0; xr[tid + 512] = x1 + y1;
        }
        __syncthreads();
    }
}

__device__ __forceinline__ void ph_final(const Ctx& F0) {
    const Ctx F = launder(F0);
    const int gw = F.vcu * NWAVES + F.wave, NGW = F.G * NWAVES;
    const f32x4* gf = (const f32x4*)F.in[26] + F.lane;
    for (int m = gw; m < T; m += NGW) {
        f32x4* xr = (f32x4*)(F.R + (size_t)m * D) + F.lane;
        f32x4 v[4]; float s = 0.f;
#pragma unroll
        for (int j = 0; j < 4; ++j) { v[j] = xr[64 * j]; s += (v[j].x * v[j].x + v[j].y * v[j].y) + (v[j].z * v[j].z + v[j].w * v[j].w); }
        const float rstd = 1.f / sqrtf(wave_sum(s) * (1.f / D) + RMS_EPS);
#pragma unroll
        for (int j = 0; j < 4; ++j) xr[64 * j] = v[j] * rstd * gf[64 * j];
    }
}

constexpr int LDS_BYTES = 147456;
constexpr int MISC_OFF = 131072 + 320;

__global__ void __launch_bounds__(NTHREADS, 2) mk_fwd(Args args) {
    extern __shared__ __attribute__((aligned(16))) unsigned char lds[];
    Ctx F;
    F.lds = (LAS unsigned char*)lds;
    F.tid = threadIdx.x; F.lane = F.tid & 63; F.wave = __builtin_amdgcn_readfirstlane(F.tid >> 6);
    F.G = gridDim.x; { const int bx = blockIdx.x; F.vcu = (F.G % 8 == 0) ? (bx % 8) * (F.G / 8) + bx / 8 : bx; }
    F.in = args.in; F.R = args.out; F.ws = args.ws;
    unsigned char* ws = args.ws;
    F.XB = (bf16*)(ws + WS_XB); F.UG = (bf16*)(ws + WS_UG); F.PB = (bf16*)(ws + WS_PB); F.QB = (bf16*)(ws + WS_QB); F.KB = (bf16*)(ws + WS_KB); F.VB = (bf16*)(ws + WS_VB);
    F.YMIX = (bf16*)(ws + WS_YMIX); F.YS = (bf16*)(ws + WS_YS); F.DL = (bf16*)(ws + WS_DL); F.KMP = (float*)(ws + WS_KMP); F.BT = (float*)(ws + WS_BT);
    volatile LAS unsigned* MISC = (volatile LAS unsigned*)(F.lds + MISC_OFF);
    for (int u = F.tid; u < 64; u += NTHREADS) MISC[u] = 0u;
    __syncthreads();
    XcdBarrier bar = xcd_barrier_post((unsigned*)(ws + WS_CTL) + CW_BAR, MISC + 8);
#define GRID_BAR() xcd_barrier(bar)

    ph_bias_table(F);
#pragma unroll 1
    for (int l = 0; l < DEPTH; ++l) {
        const float* xin = (l == 0) ? F.in[0] : F.R;
        ph_norm(F, xin);
        GRID_BAR();
        { EpiProj E{F}; naive_gemm(F, F.XB, D, F.in[3] + (size_t)l * D * NPROJ, NPROJ, F.in[2] + l * D, T, NPROJ, D, E); }
        GRID_BAR();
        ph_ssm_naive(F, l);
        ph_kmean_naive(F);
        ph_pool_dl(F);
        GRID_BAR();
        { EpiGlu E{F.YS, F.YMIX, F.in[13] + l * 256}; naive_gemm(F, F.YS, 256, F.in[12] + (size_t)l * 256 * 256, 256, nullptr, T, 256, 256, E); }
        ph_pool_mm_naive(F, l);
        ph_attn_naive(F);
        GRID_BAR();
        { EpiOut E{xin, F.R}; naive_gemm(F, F.YMIX, D, F.in[17] + (size_t)l * D * D, D, nullptr, T, D, D, E); }
        GRID_BAR();
        ph_moe_naive(F, l);
        GRID_BAR();
    }
    ph_final(F);
}

extern "C" void kernel_launch(void* const* d_in, const int* in_sizes, int n_in, void* d_out, int out_size, void* d_ws, size_t ws_size, hipStream_t stream) {
    static int grid = 0;
    if (grid == 0) {
        if (n_in != 27 || out_size != T * D || ws_size < WS_END) { fprintf(stderr, "kernel_launch: unexpected shapes (n_in %d out %d ws %zu)\n", n_in, out_size, ws_size); grid = -1; return; }
        int dev = 0, cus = 0, per_cu = 0;
        if (hipGetDevice(&dev) != hipSuccess || hipDeviceGetAttribute(&cus, hipDeviceAttributeMultiprocessorCount, dev) != hipSuccess) { grid = -1; return; }
        if (hipFuncSetAttribute((const void*)mk_fwd, hipFuncAttributeMaxDynamicSharedMemorySize, LDS_BYTES) != hipSuccess) { fprintf(stderr, "kernel_launch: hipFuncSetAttribute failed\n"); grid = -1; return; }
        if (hipOccupancyMaxActiveBlocksPerMultiprocessor(&per_cu, (const void*)mk_fwd, NTHREADS, LDS_BYTES) != hipSuccess || per_cu < 1) { fprintf(stderr, "kernel_launch: occupancy query says %d\n", per_cu); per_cu = 1; }
        (void)hipGetLastError();
        grid = cus;
    }
    if (grid < 0) return;
    (void)hipMemsetAsync((char*)d_ws + WS_CTL, 0, CTL_ZERO_BYTES, stream);
    Args a{};
    for (int i = 0; i < 27; ++i) a.in[i] = (const float*)d_in[i];
    a.out = (float*)d_out; a.ws = (unsigned char*)d_ws; a.ph_lo = 0; a.ph_hi = 0;
    hipLaunchKernelGGL(mk_fwd, dim3(grid), dim3(NTHREADS), LDS_BYTES, stream, a);
}
```

```cpp
#include <hip/hip_runtime.h>
#include <cstdio>
#include <cstdint>

#define GAS __attribute__((address_space(1)))
#define LAS __attribute__((address_space(3)))
typedef unsigned short bf16;
typedef float f32x4 __attribute__((ext_vector_type(4)));
typedef unsigned u32x4 __attribute__((ext_vector_type(4)));
typedef unsigned u32x2 __attribute__((ext_vector_type(2)));

constexpr int NB = 8, SEQ = 4096, T = NB * SEQ, D = 1024, NPROJ = 2048, DEPTH = 2;
constexpr int NHEAD = 8, HD = 64, MBLK = 256, NBLK = SEQ / MBLK;
constexpr int SG = 16, SGN = 16, SP = 64, SCH = 64, UGP = 1152;
constexpr float RMS_EPS = 1e-6f;
constexpr float LOG2E = 1.4426950408889634f;
constexpr float C2 = 0.125f * LOG2E;
constexpr int NWAVES = 8, NTHREADS = 512;
#ifndef USE_ENG_PROJ
#define USE_ENG_PROJ 1
#endif

constexpr size_t MiB = 1u << 20;
constexpr size_t WS_CTL = 0, CTL_ZERO_BYTES = 1 * MiB;
constexpr size_t WS_XB = 2 * MiB;
constexpr size_t WS_UG = 66 * MiB;
constexpr size_t WS_PB = 84 * MiB;
constexpr size_t WS_QB = 100 * MiB;
constexpr size_t WS_KB = 132 * MiB;
constexpr size_t WS_VB = 164 * MiB;
constexpr size_t WS_YMIX = 196 * MiB;
constexpr size_t WS_YS = 260 * MiB;
constexpr size_t WS_DL = 276 * MiB;
constexpr size_t WS_KMP = 292 * MiB;
constexpr size_t WS_BT = 293 * MiB;
constexpr size_t WS_WIN = 300 * MiB;
constexpr size_t WS_WOUT = 308 * MiB;
constexpr size_t WS_END = 312 * MiB;

constexpr int CW_BAR = 4096;

__device__ __forceinline__ unsigned f2bf(float f) { unsigned u = __builtin_bit_cast(unsigned, f); return (u + 0x7fffu + ((u >> 16) & 1u)) >> 16; }
__device__ __forceinline__ float bf2f(unsigned h) { return __builtin_bit_cast(float, h << 16); }
__device__ __forceinline__ unsigned pk2(float lo, float hi) { return f2bf(lo) | (f2bf(hi) << 16); }
__device__ __forceinline__ float wave_sum(float v) {
#pragma unroll
    for (int o = 1; o < 64; o <<= 1) v += __shfl_xor(v, o);
    return v;
}
__device__ __forceinline__ float wave_max(float v) {
#pragma unroll
    for (int o = 1; o < 64; o <<= 1) v = fmaxf(v, __shfl_xor(v, o));
    return v;
}
__device__ __forceinline__ float gelu_tanh(float x) {
    const float u = 0.7978845608028654f * (x + 0.044715f * x * x * x);
    const float e = __expf(2.f * u);
    const float th = 1.f - 2.f / (e + 1.f);
    return 0.5f * x * (1.f + th);
}
__device__ __forceinline__ float sigmoidf_(float x) { return 1.f / (1.f + __expf(-x)); }

#define XB_TMO      128
#define XB_XCNT(j)  (256  + 64 * (j))
#define XB_XSUB(j)  (1280 + 64 * (j))
#define XB_XGEN(j)  (2304 + 64 * (j))
#define XB_TOP      3328
#define XB_TOPGEN   3392
#define XCD_BAR_WORDS 3456
#define XB_SPIN_CAP (1u << 22)
__device__ __forceinline__ unsigned xb_ld(unsigned* p)              { return __hip_atomic_load(p, __ATOMIC_RELAXED, __HIP_MEMORY_SCOPE_AGENT); }
__device__ __forceinline__ unsigned xb_add(unsigned* p, unsigned v) { return __hip_atomic_fetch_add(p, v, __ATOMIC_RELAXED, __HIP_MEMORY_SCOPE_AGENT); }
__device__ __forceinline__ unsigned xb_xcc_id() { return (unsigned)__builtin_amdgcn_s_getreg((3 << 11) | 20) & 0xFu; }
#define XB_SPIN(cond, bar) do { unsigned _sp = 0; while (cond) { __builtin_amdgcn_s_sleep(1); \
    if ((++_sp & 255u) == 0u) { if (xb_ld(&(bar)[XB_TMO])) break; if (_sp > XB_SPIN_CAP) { atomicAdd(&(bar)[XB_TMO], 1u); break; } } } } while (0)
struct XcdBarrier { unsigned* bar; unsigned x; volatile LAS unsigned* st; };
__device__ __forceinline__ XcdBarrier xcd_barrier_post(unsigned* bar, volatile LAS unsigned* st) {
    XcdBarrier b; b.bar = bar; b.x = xb_xcc_id(); b.st = st;
    if (threadIdx.x == 0) (void)xb_add(&bar[XB_XCNT(b.x)], 1u);
    return b;
}
__device__ __forceinline__ void xcd_barrier_complete(unsigned* bar, unsigned x, unsigned& nloc, unsigned& nx) {
    const unsigned G = gridDim.x * gridDim.y * gridDim.z;
    unsigned sum, cnt, mine, sp = 0u;
    for (;;) {
        sum = 0u; cnt = 0u; mine = 0u;
#pragma unroll
        for (unsigned j = 0; j < 16; ++j) { const unsigned c = xb_ld(&bar[XB_XCNT(j)]); sum += c; cnt += (c > 0u) ? 1u : 0u; mine = (j == x) ? c : mine; }
        if (sum == G) break;
        __builtin_amdgcn_s_sleep(1);
        if ((++sp & 255u) == 0u) { if (xb_ld(&bar[XB_TMO])) break; if (sp > XB_SPIN_CAP) { atomicAdd(&bar[XB_TMO], 1u); break; } }
    }
    nloc = mine > 0u ? mine : 1u; nx = cnt > 0u ? cnt : 1u;
}
__device__ __forceinline__ void xcd_barrier(const XcdBarrier& b) {
    asm volatile("s_waitcnt vmcnt(0)" ::: "memory");
    __syncthreads();
    if (threadIdx.x == 0) {
        unsigned* bar = b.bar;
        __builtin_amdgcn_s_waitcnt(0);
        unsigned nloc = b.st[0], nx = b.st[1];
        if (nloc == 0u) { xcd_barrier_complete(bar, b.x, nloc, nx); b.st[0] = nloc; b.st[1] = nx; }
        const unsigned old = xb_add(&bar[XB_XSUB(b.x)], 1u);
        const unsigned gen = old / nloc;
        if (old + 1u == (gen + 1u) * nloc) {
            __builtin_amdgcn_fence(__ATOMIC_RELEASE, "agent");
            asm volatile("s_waitcnt vmcnt(0)" ::: "memory");
            const unsigned og = xb_add(&bar[XB_TOP], 1u);
            const unsigned tg = og / nx;
            if (og + 1u == (tg + 1u) * nx) xb_add(&bar[XB_TOPGEN], 1u);
            else XB_SPIN(xb_ld(&bar[XB_TOPGEN]) == tg, bar);
            __builtin_amdgcn_fence(__ATOMIC_ACQUIRE, "agent");
            xb_add(&bar[XB_XGEN(b.x)], 1u);
            asm volatile("s_waitcnt vmcnt(0)" ::: "memory");
        } else {
            XB_SPIN(xb_ld(&bar[XB_XGEN(b.x)]) == gen, bar);
            __builtin_amdgcn_fence(__ATOMIC_ACQUIRE, "agent");
            asm volatile("s_waitcnt vmcnt(0)" ::: "memory");
        }
    }
    __syncthreads();
}

struct Args {
    const float* in[27];
    float* out;
    unsigned char* ws;
    int ph_lo, ph_hi;
};

struct Ctx {
    LAS unsigned char* lds;
    int tid, lane, wave, vcu, G;
    const float* const* in;
    float* R;
    unsigned char* ws;
    bf16 *XB, *UG, *PB, *QB, *KB, *VB, *YMIX, *YS, *DL;
    float *KMP, *BT;
};


__device__ __forceinline__ Ctx launder(const Ctx& F0) {
    Ctx F = F0;
    asm volatile("" : "+v"(F.tid), "+v"(F.lane));
    asm volatile("" : "+s"(F.wave), "+s"(F.vcu), "+s"(F.G));
    return F;
}

__device__ __forceinline__ void store_proj(const Ctx& F, int m, int c, float v) {
    if (c < 256) { const int g = c >> 4, h = c & 15; F.UG[((size_t)(g * 512 + (m >> 6))) * UGP + (m & 63) * 16 + h] = (bf16)f2bf(v); }
    else if (c < 512) F.PB[(size_t)m * 256 + (c - 256)] = (bf16)f2bf(v);
    else if (c < 1024) F.QB[(size_t)m * 512 + (c - 512)] = (bf16)f2bf(v * C2);
    else if (c < 1536) F.KB[(size_t)m * 512 + (c - 1024)] = (bf16)f2bf(v);
    else F.VB[(size_t)m * 512 + (c - 1536)] = (bf16)f2bf(v);
}


namespace pg8 {
typedef short bf16x8 __attribute__((ext_vector_type(8)));
constexpr int BM = 256, BK = 64, HALF = 128, HTB = HALF * BK * 2, STAGE_BYTES = 8 * HTB, NXCD = 8, WGM = 8;
__device__ __forceinline__ int lds_byte(int r, int c) { const int st = (r >> 4) * 2 + (c >> 5), rr = r & 15, cc = c & 31, ob = rr * 64 + cc * 2; return st * 1024 + (ob ^ (((ob >> 9) & 1) << 5)); }
__device__ __forceinline__ void stage_rc(int b, int& R, int& C) { const int st = b / 1024, sb = b % 1024, swz = sb ^ (((sb >> 9) & 1) << 5); R = (st >> 1) * 16 + swz / 64; C = (st & 1) * 32 + (swz % 64) / 2; }
__device__ __forceinline__ int perm32(int rho) { const int n = rho >> 4, i = rho & 15; return 8 * (i >> 2) + 4 * n + (i & 3); }

struct Unit { int pm, pn, aux; };
struct Gemm { const bf16* A; const bf16* Bt; int lda, ldb, K; };

struct StaticOrder {
    int nM, nN, nwg, G, c;
    __device__ void init(int M, int N, int G_, int c_) { nM = M / BM; nN = N / BM; nwg = nM * nN; G = G_; c = c_; }
    __device__ bool next(int i, Unit& u) const {
        const long L = (long)i * G + c; if (L >= nwg) return false;
        int wgid = (int)L; { const int q = nwg / NXCD, r = nwg % NXCD, xcd = wgid % NXCD, off = wgid / NXCD; wgid = (xcd < r ? xcd * (q + 1) : r * (q + 1) + (xcd - r) * q) + off; }
        const int nig = WGM * nN, gid = wgid / nig, fm = gid * WGM, gsz = (nM - fm) < WGM ? (nM - fm) : WGM;
        u.pm = fm + ((wgid % nig) % gsz); u.pn = (wgid % nig) / gsz; u.aux = 0; return true;
    }
};

__device__ __forceinline__ unsigned cvt_pk_bf16(float lo, float hi) { unsigned r; asm volatile("v_cvt_pk_bf16_f32 %0, %1, %2" : "=v"(r) : "v"(lo), "v"(hi)); return r; }

template <class Epi, class Sched>
__device__ __forceinline__ void gemm_phase(LAS unsigned char* lds, const Gemm g, const Sched& S, const Epi& E) {
    int tid_ = threadIdx.x; asm volatile("" : "+v"(tid_));
    const int tid = tid_, wid = __builtin_amdgcn_readfirstlane(tid >> 6), lane = tid & 63, wr = wid >> 2, wc = wid & 3, fr = lane & 15, fq = lane >> 4;
    const int K = g.K, nt = K / BK;
    unsigned voffA[2], voffB[2];
#pragma unroll
    for (int i = 0; i < 2; ++i) { int R, C; stage_rc(tid * 16 + i * 8192, R, C); const int Rb = Epi::PERM ? ((R & ~31) + perm32(R & 31)) : R;
        voffA[i] = (unsigned)(R * g.lda + C) * 2u; voffB[i] = (unsigned)(Rb * g.ldb + C) * 2u; }
    const size_t kstep = (size_t)(BK * 2);
    const size_t hstepA = (size_t)HALF * g.lda * 2, hstepB = (size_t)HALF * g.ldb * 2;
    const size_t tstepA = 2 * hstepA, tstepB = 2 * hstepB;
    const unsigned ldsw = (unsigned)wid * 1024u;
    const int aoff = lds_byte(wr * 64 + fr, fq * 8), boff = lds_byte(wc * 32 + fr, fq * 8);
#define PG8_SA(b, h) (((b) * 2 + (h)) * HTB)
#define PG8_SB(b, h) ((4 + (b) * 2 + (h)) * HTB)
#define PG8_STAGE(bufoff, gbase, voff) do { _Pragma("unroll") for (int _i = 0; _i < 2; ++_i) \
        __builtin_amdgcn_global_load_lds((const unsigned*)((const char*)(gbase) + (voff)[_i]), (LAS unsigned*)(lds + (bufoff) + ldsw + _i * 8192), 16, 0, 0); } while (0)
#define PG8_LDA(dst, b, h) do { _Pragma("unroll") for (int m = 0; m < 4; ++m) _Pragma("unroll") for (int k = 0; k < 2; ++k) dst[m][k] = *(const LAS bf16x8*)(lds + PG8_SA(b, h) + aoff + m * 2048 + k * 1024); } while (0)
#define PG8_LDB(dst, b, h) do { _Pragma("unroll") for (int n = 0; n < 2; ++n) _Pragma("unroll") for (int k = 0; k < 2; ++k) dst[n][k] = *(const LAS bf16x8*)(lds + PG8_SB(b, h) + boff + n * 2048 + k * 1024); } while (0)
#define PG8_MMA(ai, bj, At, Bt) do { __builtin_amdgcn_s_setprio(1); _Pragma("unroll") for (int m = 0; m < 4; ++m) _Pragma("unroll") for (int n = 0; n < 2; ++n) _Pragma("unroll") for (int k = 0; k < 2; ++k) \
        acc[ai][bj][m][n] = __builtin_amdgcn_mfma_f32_16x16x32_bf16(Bt[n][k], At[m][k], acc[ai][bj][m][n], 0, 0, 0); __builtin_amdgcn_s_setprio(0); } while (0)
#define PG8_WAIT_V(n) asm volatile("s_waitcnt vmcnt(" #n ")" ::: "memory")
#define PG8_WAIT_L(n) asm volatile("s_waitcnt lgkmcnt(" #n ")" ::: "memory")
#define PG8_BAR __builtin_amdgcn_s_barrier()
#define PG8_SCHED __builtin_amdgcn_sched_barrier(0)
    Unit cur, nxt; int ui = 0;
    if (!S.next(0, cur)) return;
    f32x4 acc[2][2][4][2];
#pragma unroll
    for (int a = 0; a < 2; ++a)
#pragma unroll
        for (int b = 0; b < 2; ++b)
#pragma unroll
            for (int m = 0; m < 4; ++m)
#pragma unroll
                for (int n = 0; n < 2; ++n) acc[a][b][m][n] = (f32x4){0.f, 0.f, 0.f, 0.f};
    bf16x8 At[4][2], B0[2][2], B1[2][2];
    const char* cA = (const char*)g.A + (size_t)cur.pm * tstepA; const char* cB = (const char*)g.Bt + (size_t)cur.pn * tstepB;
    PG8_STAGE(PG8_SB(0, 0), cB, voffB); PG8_STAGE(PG8_SB(0, 1), cB + hstepB, voffB); PG8_STAGE(PG8_SA(0, 0), cA, voffA); PG8_STAGE(PG8_SA(0, 1), cA + hstepA, voffA);
    if (wr == 1) PG8_BAR;
    PG8_WAIT_V(2); PG8_BAR;
    PG8_STAGE(PG8_SB(1, 0), cB + kstep, voffB); PG8_STAGE(PG8_SA(1, 0), cA + kstep, voffA); PG8_STAGE(PG8_SB(1, 1), cB + hstepB + kstep, voffB);
    PG8_WAIT_V(6); PG8_BAR;
    for (;;) {
        const bool has_next = S.next(ui + 1, nxt);
        const char* nA = has_next ? (const char*)g.A + (size_t)nxt.pm * tstepA : cA; const char* nB = has_next ? (const char*)g.Bt + (size_t)nxt.pn * tstepB : cB;
        for (int t = 0; t < nt; t += 2) {
            const bool last = (t == nt - 2);
            const char* a1 = cA + (size_t)(t + 1) * kstep;
            const char* a2 = last ? nA : cA + (size_t)(t + 2) * kstep; const char* b2 = last ? nB : cB + (size_t)(t + 2) * kstep;
            const char* a3 = a2 + kstep; const char* b3 = b2 + kstep;
            PG8_LDB(B0, 0, 0); PG8_LDB(B1, 0, 1); PG8_SCHED; PG8_LDA(At, 0, 0); PG8_STAGE(PG8_SA(1, 1), a1 + hstepA, voffA);
            PG8_WAIT_V(8); PG8_WAIT_L(0); PG8_BAR; PG8_MMA(0, 0, At, B0); PG8_MMA(0, 1, At, B1); PG8_BAR; PG8_SCHED;
            PG8_LDA(At, 0, 1); PG8_STAGE(PG8_SB(0, 0), b2, voffB); PG8_STAGE(PG8_SB(0, 1), b2 + hstepB, voffB); PG8_STAGE(PG8_SA(0, 0), a2, voffA);
            PG8_WAIT_V(8); PG8_WAIT_L(0); PG8_BAR; PG8_MMA(1, 0, At, B0); PG8_MMA(1, 1, At, B1); PG8_BAR; PG8_SCHED;
            PG8_LDB(B0, 1, 0); PG8_LDB(B1, 1, 1); PG8_SCHED; PG8_LDA(At, 1, 0); PG8_STAGE(PG8_SA(0, 1), a2 + hstepA, voffA);
            PG8_WAIT_V(8); PG8_WAIT_L(0); PG8_BAR; PG8_MMA(0, 0, At, B0); PG8_MMA(0, 1, At, B1); PG8_BAR; PG8_SCHED;
            PG8_LDA(At, 1, 1); PG8_STAGE(PG8_SB(1, 0), b3, voffB); PG8_STAGE(PG8_SB(1, 1), b3 + hstepB, voffB); PG8_STAGE(PG8_SA(1, 0), a3, voffA);
            PG8_WAIT_V(8); PG8_WAIT_L(0); PG8_BAR; PG8_MMA(1, 0, At, B0); PG8_MMA(1, 1, At, B1); PG8_BAR; PG8_SCHED;
        }
        if (wr == 0) PG8_BAR;
        E(acc, cur, wr, wc, fr, fq);
        if (!has_next) break;
#pragma unroll
        for (int a = 0; a < 2; ++a)
#pragma unroll
            for (int b = 0; b < 2; ++b)
#pragma unroll
                for (int m = 0; m < 4; ++m)
#pragma unroll
                    for (int n = 0; n < 2; ++n) acc[a][b][m][n] = (f32x4){0.f, 0.f, 0.f, 0.f};
        cur = nxt; cA = nA; cB = nB; ++ui;
        if (wr == 1) PG8_BAR;
    }
    PG8_WAIT_V(0);
    PG8_BAR;
#undef PG8_SA
#undef PG8_SB
#undef PG8_STAGE
#undef PG8_LDA
#undef PG8_LDB
#undef PG8_MMA
#undef PG8_WAIT_V
#undef PG8_WAIT_L
#undef PG8_BAR
#undef PG8_SCHED
}
}


struct EpiProjE {
    static constexpr bool PERM = true;
    bf16 *UG, *PB, *QB, *KB, *VB; float* KMP;
    __device__ __forceinline__ void operator()(const f32x4 (&acc)[2][2][4][2], const pg8::Unit& u, int wr, int wc, int fr, int fq) const {
        const int pn = u.pn, row0 = u.pm * 256 + wr * 64 + fr, cl = wc * 32 + 8 * fq;
        if (pn == 0) {
#pragma unroll
            for (int ai = 0; ai < 2; ++ai)
#pragma unroll
                for (int m = 0; m < 4; ++m) { const int r = row0 + ai * 128 + m * 16;
#pragma unroll
                    for (int bj = 0; bj < 2; ++bj) { const int ch = bj * 128 + cl, g = ch >> 4, h0 = ch & 15;
                        const f32x4 v0 = acc[ai][bj][m][0], v1 = acc[ai][bj][m][1]; u32x4 w;
                        w.x = pg8::cvt_pk_bf16(v0[0], v0[1]); w.y = pg8::cvt_pk_bf16(v0[2], v0[3]); w.z = pg8::cvt_pk_bf16(v1[0], v1[1]); w.w = pg8::cvt_pk_bf16(v1[2], v1[3]);
                        *(u32x4*)(UG + ((size_t)(g * 512 + (r >> 6))) * UGP + (r & 63) * 16 + h0) = w; } }
        } else {
            bf16* base; int ldc, colt; float sc = 1.f;
            if (pn == 1) { base = PB; ldc = 256; colt = 0; }
            else if (pn < 4) { base = QB; ldc = 512; colt = (pn - 2) * 256; sc = C2; }
            else if (pn < 6) { base = KB; ldc = 512; colt = (pn - 4) * 256; }
            else { base = VB; ldc = 512; colt = (pn - 6) * 256; }
#pragma unroll
            for (int ai = 0; ai < 2; ++ai)
#pragma unroll
                for (int m = 0; m < 4; ++m) { bf16* rowp = base + (size_t)(row0 + ai * 128 + m * 16) * ldc + colt + cl;
#pragma unroll
                    for (int bj = 0; bj < 2; ++bj) { const f32x4 v0 = acc[ai][bj][m][0] * sc, v1 = acc[ai][bj][m][1] * sc; u32x4 w;
                        w.x = pg8::cvt_pk_bf16(v0[0], v0[1]); w.y = pg8::cvt_pk_bf16(v0[2], v0[3]); w.z = pg8::cvt_pk_bf16(v1[0], v1[1]); w.w = pg8::cvt_pk_bf16(v1[2], v1[3]);
                        *(u32x4*)(rowp + bj * 128) = w; } }
            if (pn >= 4 && pn < 6) {
#pragma unroll
                for (int bj = 0; bj < 2; ++bj)
#pragma unroll
                    for (int n = 0; n < 2; ++n) { f32x4 s = (f32x4){0.f, 0.f, 0.f, 0.f};
#pragma unroll
                        for (int ai = 0; ai < 2; ++ai)
#pragma unroll
                            for (int m = 0; m < 4; ++m) s += acc[ai][bj][m][n];
#pragma unroll
                        for (int o = 1; o < 16; o <<= 1) { s[0] += __shfl_xor(s[0], o); s[1] += __shfl_xor(s[1], o); s[2] += __shfl_xor(s[2], o); s[3] += __shfl_xor(s[3], o); }
                        if (fr == 0) *(f32x4*)(KMP + (size_t)wr * 128 * 512 + (size_t)u.pm * 512 + colt + bj * 128 + cl + 4 * n) = s; }
            }
        }
    }
};
struct EpiOutE {
    static constexpr bool PERM = false;
    const float* xin; float* R;
    __device__ __forceinline__ void operator()(const f32x4 (&acc)[2][2][4][2], const pg8::Unit& u, int wr, int wc, int fr, int fq) const {
        const int row0 = u.pm * 256 + wr * 64 + fr, col0 = u.pn * 256 + wc * 32 + 4 * fq;
#pragma unroll
        for (int ai = 0; ai < 2; ++ai)
#pragma unroll
            for (int m = 0; m < 4; ++m) { const size_t off = (size_t)(row0 + ai * 128 + m * 16) * D + col0;
#pragma unroll
                for (int bj = 0; bj < 2; ++bj)
#pragma unroll
                    for (int n = 0; n < 2; ++n) { const size_t o = off + bj * 128 + n * 16; *(f32x4*)(R + o) = *(const f32x4*)(xin + o) + acc[ai][bj][m][n]; }
                if (m & 1) asm volatile("" ::: "memory"); }
    }
};

__device__ __forceinline__ void transpose_item(const float* W, int K, int N, const float* kscale, bf16* WT, LAS float* scr, int item, int lane) {
    const int nblk = N / 32, kb = item / nblk, nb = item % nblk, k0 = 64 * kb, n0 = 32 * nb;
#pragma unroll 8
    for (int i = 0; i < 32; ++i) { const int kk = 2 * i + (lane >> 5); const float s = kscale ? kscale[k0 + kk] : 1.f; scr[kk * 33 + (lane & 31)] = W[(size_t)(k0 + kk) * N + n0 + (lane & 31)] * s; }
    asm volatile("s_waitcnt lgkmcnt(0)" ::: "memory");
    const int c = lane & 7;
#pragma unroll
    for (int j = 0; j < 4; ++j) { const int n = (lane >> 3) + 8 * j; const LAS float* s = scr + (8 * c) * 33 + n;
        u32x4 o; o.x = pk2(s[0 * 33], s[1 * 33]); o.y = pk2(s[2 * 33], s[3 * 33]); o.z = pk2(s[4 * 33], s[5 * 33]); o.w = pk2(s[6 * 33], s[7 * 33]);
        *(u32x4*)(WT + (size_t)(n0 + n) * K + k0 + 8 * c) = o; }
    asm volatile("s_waitcnt lgkmcnt(0)" ::: "memory");
}
__device__ __forceinline__ void ph_prologue(const Ctx& F0) {
    const Ctx F = launder(F0);
    LAS float* scr = (LAS float*)(F.lds + F.wave * 16384);
    const int gw = F.vcu * NWAVES + F.wave, NGW = F.G * NWAVES;
    constexpr int I_IN = (D / 64) * (NPROJ / 32), I_OUT = (D / 64) * (D / 32), I_L = I_IN + I_OUT;
    for (int it = gw; it < DEPTH * I_L; it += NGW) {
        const int l = it / I_L; int r = it % I_L;
        if (r < I_IN) { transpose_item(F.in[3] + (size_t)l * D * NPROJ, D, NPROJ, F.in[2] + l * D, (bf16*)(F.ws + WS_WIN) + (size_t)l * NPROJ * D, scr, r, F.lane); continue; } r -= I_IN;
        transpose_item(F.in[17] + (size_t)l * D * D, D, D, nullptr, (bf16*)(F.ws + WS_WOUT) + (size_t)l * D * D, scr, r, F.lane);
    }
}

template <class Epi>
__device__ __forceinline__ void naive_gemm(const Ctx& F0, const bf16* A, int lda, const float* Bw, int ldb, const float* kscale, int M, int N, int K, const Epi& epi) {
    const Ctx F = launder(F0);
    LAS float* As = (LAS float*)F.lds;
    LAS float* Bs = As + 16 * 132;
    const int tid = F.tid, ty = tid >> 4, tx = tid & 15;
    const int tm = M / 128, tn = N / 128;
    for (int tile = F.vcu; tile < tm * tn; tile += F.G) {
        const int m0 = (tile / tn) * 128, n0 = (tile % tn) * 128;
        float acc[4][8];
#pragma unroll
        for (int i = 0; i < 4; ++i)
#pragma unroll
            for (int j = 0; j < 8; ++j) acc[i][j] = 0.f;
        for (int k0 = 0; k0 < K; k0 += 16) {
            {
                const int row = tid >> 2, kq = (tid & 3) * 4;
                const u32x2 v = *(const u32x2*)(A + (size_t)(m0 + row) * lda + k0 + kq);
                As[(kq + 0) * 132 + row] = bf2f(v.x & 0xffffu); As[(kq + 1) * 132 + row] = bf2f(v.x >> 16);
                As[(kq + 2) * 132 + row] = bf2f(v.y & 0xffffu); As[(kq + 3) * 132 + row] = bf2f(v.y >> 16);
                const int kk = tid >> 5, nq = (tid & 31) * 4;
                f32x4 b = *(const f32x4*)(Bw + (size_t)(k0 + kk) * ldb + n0 + nq);
                const float s = kscale ? kscale[k0 + kk] : 1.f;
                b = b * s;
                *(LAS f32x4*)(Bs + kk * 128 + nq) = b;
            }
            __syncthreads();
#pragma unroll
            for (int kk = 0; kk < 16; ++kk) {
                const f32x4 a = *(const LAS f32x4*)(As + kk * 132 + ty * 4);
                const f32x4 b0 = *(const LAS f32x4*)(Bs + kk * 128 + tx * 8);
                const f32x4 b1 = *(const LAS f32x4*)(Bs + kk * 128 + tx * 8 + 4);
#pragma unroll
                for (int i = 0; i < 4; ++i) {
#pragma unroll
                    for (int j = 0; j < 4; ++j) { acc[i][j] += a[i] * b0[j]; acc[i][4 + j] += a[i] * b1[j]; }
                }
            }
            __syncthreads();
        }
#pragma unroll
        for (int i = 0; i < 4; ++i)
#pragma unroll
            for (int j = 0; j < 8; ++j) epi(m0 + ty * 4 + i, n0 + tx * 8 + j, acc[i][j]);
    }
}

struct EpiProj { Ctx F; __device__ __forceinline__ void operator()(int m, int n, float v) const { store_proj(F, m, n, v); } };
struct EpiGlu { bf16* ys; bf16* ymix; const float* gb;
    __device__ __forceinline__ void operator()(int m, int n, float v) const { const float y = bf2f(ys[(size_t)m * 256 + n]); ymix[(size_t)m * 1024 + n] = (bf16)f2bf(y * sigmoidf_(v + gb[n])); } };
struct EpiOut { const float* xin; float* R;
    __device__ __forceinline__ void operator()(int m, int n, float v) const { const size_t o = (size_t)m * D + n; R[o] = xin[o] + v; } };

__device__ __forceinline__ void ph_norm(const Ctx& F0, const float* xin) {
    const Ctx F = launder(F0);
    const int gw = F.vcu * NWAVES + F.wave, NGW = F.G * NWAVES;
    for (int m = gw; m < T; m += NGW) {
        const f32x4* xr = (const f32x4*)(xin + (size_t)m * D) + F.lane;
        f32x4 v[4]; float s = 0.f;
#pragma unroll
        for (int j = 0; j < 4; ++j) { v[j] = xr[64 * j]; s += (v[j].x * v[j].x + v[j].y * v[j].y) + (v[j].z * v[j].z + v[j].w * v[j].w); }
        const float rstd = 1.f / sqrtf(wave_sum(s) * (1.f / D) + RMS_EPS);
        unsigned long long* o8 = (unsigned long long*)(F.XB + (size_t)m * D) + F.lane;
#pragma unroll
        for (int j = 0; j < 4; ++j) o8[64 * j] = (unsigned long long)pk2(v[j].x * rstd, v[j].y * rstd) | ((unsigned long long)pk2(v[j].z * rstd, v[j].w * rstd) << 32);
    }
}

__device__ __forceinline__ void ph_bias_table(const Ctx& F0) {
    const Ctx F = launder(F0);
    if (F.vcu == 0) {
        const float* rel_bias = F.in[1];
        for (int i = F.tid; i < 8 * 132; i += NTHREADS) {
            const int h = i / 132, r = i % 132;
            int bk;
            if (r < 16) bk = r;
            else { bk = 16 + (int)(logf((float)r / 16.f) / logf(8.f) * 16.f); if (bk > 31) bk = 31; }
            F.BT[i] = rel_bias[bk * 8 + h] * LOG2E;
        }
    }
}

__device__ __forceinline__ void ph_kmean_naive(const Ctx& F0) {
    const Ctx F = launder(F0);
    const int gt = F.vcu * NTHREADS + F.tid, NGT = F.G * NTHREADS;
    for (int i = gt; i < 128 * 512; i += NGT) {
        const int pm = i >> 9, c = i & 511; float s = 0.f;
        for (int r = 0; r < 256; ++r) s += bf2f(F.KB[(size_t)(pm * 256 + r) * 512 + c]);
        F.KMP[i] = s; F.KMP[128 * 512 + i] = 0.f;
    }
}

__device__ __forceinline__ void ph_ssm_naive(const Ctx& F0, int l) {
    const Ctx F = launder(F0);
    const int gw = F.vcu * NWAVES + F.wave, NGW = F.G * NWAVES;
    for (int it = gw; it < NB * SGN; it += NGW) {
        const int b = it / SGN, g = it % SGN, p = F.lane;
        const float are = F.in[4][(l * SGN + g) * SP + p], aim = F.in[5][(l * SGN + g) * SP + p];
        const float dt = __expf(F.in[6][l * SGN + g]);
        const float mag = expf(are * dt); float sn, cs; sincosf(aim * dt, &sn, &cs);
        const float lbr = mag * cs, lbi = mag * sn;
        const float nr = lbr - 1.f, ni = lbi, den = are * are + aim * aim;
        const float cr = (nr * are + ni * aim) / den, ci = (ni * are - nr * aim) / den;
        float bbr[16], bbi[16], ccr[16], cci[16];
#pragma unroll
        for (int h = 0; h < 16; ++h) {
            const float br = F.in[7][((size_t)(l * SGN + g) * SP + p) * SG + h], bi = F.in[8][((size_t)(l * SGN + g) * SP + p) * SG + h];
            bbr[h] = cr * br - ci * bi; bbi[h] = cr * bi + ci * br;
            ccr[h] = F.in[9][((size_t)(l * SGN + g) * SG + h) * SP + p]; cci[h] = F.in[10][((size_t)(l * SGN + g) * SG + h) * SP + p];
        }
        const float dh = (F.lane < 16) ? F.in[11][l * 256 + g * 16 + F.lane] : 0.f;
        float sr = 0.f, si = 0.f;
        for (int t = 0; t < SEQ; ++t) {
            const int m = b * SEQ + t;
            const bf16* up = F.UG + ((size_t)(g * 512 + (m >> 6))) * UGP + (m & 63) * 16;
            const u32x4 u0 = *(const u32x4*)up, u1 = *(const u32x4*)(up + 8);
            float u[16];
            u[0] = bf2f(u0.x & 0xffffu); u[1] = bf2f(u0.x >> 16); u[2] = bf2f(u0.y & 0xffffu); u[3] = bf2f(u0.y >> 16);
            u[4] = bf2f(u0.z & 0xffffu); u[5] = bf2f(u0.z >> 16); u[6] = bf2f(u0.w & 0xffffu); u[7] = bf2f(u0.w >> 16);
            u[8] = bf2f(u1.x & 0xffffu); u[9] = bf2f(u1.x >> 16); u[10] = bf2f(u1.y & 0xffffu); u[11] = bf2f(u1.y >> 16);
            u[12] = bf2f(u1.z & 0xffffu); u[13] = bf2f(u1.z >> 16); u[14] = bf2f(u1.w & 0xffffu); u[15] = bf2f(u1.w >> 16);
            float bur = 0.f, bui = 0.f;
#pragma unroll
            for (int h = 0; h < 16; ++h) { bur += bbr[h] * u[h]; bui += bbi[h] * u[h]; }
            const float nsr = lbr * sr - lbi * si + bur, nsi = lbr * si + lbi * sr + bui;
            sr = nsr; si = nsi;
            float yo = 0.f, uo = 0.f;
#pragma unroll
            for (int h = 0; h < 16; ++h) {
                const float y = wave_sum(ccr[h] * sr - cci[h] * si);
                if (F.lane == h) { yo = y; uo = u[h]; }
            }
            if (F.lane < 16) F.YS[(size_t)m * 256 + g * 16 + F.lane] = (bf16)f2bf(gelu_tanh(yo + dh * uo));
        }
    }
}

__device__ __forceinline__ void ph_pool_dl(const Ctx& F0) {
    const Ctx F = launder(F0);
    const int gt = F.vcu * NTHREADS + F.tid, NGT = F.G * NTHREADS;
    for (int i = gt; i < T * 256; i += NGT) {
        const int m = i >> 8, c = i & 255, t = m & (SEQ - 1), gi = c >> 6, win = 2 << gi;
        const int cnt = (t + 1 < win) ? t + 1 : win;
        float s = 0.f;
        for (int j = 0; j < cnt; ++j) s += bf2f(F.PB[(size_t)(m - j) * 256 + c]);
        F.DL[i] = (bf16)f2bf(s / (float)cnt - bf2f(F.PB[i]));
    }
}
__device__ __forceinline__ void ph_pool_mm_naive(const Ctx& F0, int l) {
    const Ctx F = launder(F0);
    const int gt = F.vcu * NTHREADS + F.tid, NGT = F.G * NTHREADS;
    const float* w = F.in[14] + (size_t)l * 4 * 64 * 64;
    for (int i = gt; i < T * 256; i += NGT) {
        const int m = i >> 8, n = i & 255, gi = n >> 6, d = n & 63; float s = 0.f;
        for (int c = 0; c < 64; ++c) s += bf2f(F.DL[(size_t)m * 256 + gi * 64 + c]) * w[(gi * 64 + c) * 64 + d];
        F.YMIX[(size_t)m * 1024 + 256 + n] = (bf16)f2bf((s + F.in[15][l * 256 + n]) * F.in[16][l * 256 + n]);
    }
}

__device__ __forceinline__ void ph_attn_naive(const Ctx& F0) {
    const Ctx F = launder(F0);
    const int gw = F.vcu * NWAVES + F.wave, NGW = F.G * NWAVES, lane = F.lane;
    for (int it = gw; it < T * NHEAD; it += NGW) {
        const int h = it & 7, m = it >> 3, b = m >> 12, q = m & (SEQ - 1), qblk = q >> 8;
        const float qv = bf2f(F.QB[(size_t)m * 512 + h * 64 + lane]);
        float mygate = -3.0e38f;
        for (int j = 0; j < qblk; ++j) {
            const int pm = b * NBLK + j;
            const float km = F.KMP[pm * 512 + h * 64 + lane] + F.KMP[128 * 512 + pm * 512 + h * 64 + lane];
            const float g = wave_sum(qv * km);
            if (lane == j) mygate = g;
        }
        int bsel0 = -1, bsel1 = -1, bsel2 = -1;
        const int nsel = qblk < 3 ? qblk : 3;
        for (int s = 0; s < nsel; ++s) {
            const float bv = wave_max(mygate);
            const unsigned long long bal = __ballot(mygate == bv);
            const int best = __builtin_ctzll(bal);
            if (s == 0) bsel0 = best; else if (s == 1) bsel1 = best; else bsel2 = best;
            if (lane == best) mygate = -3.0e38f;
        }
        float sc[16];
        float mx = -3.0e38f;
#pragma unroll
        for (int s = 0; s < 4; ++s) {
            const int blk = (s == 0) ? bsel0 : (s == 1) ? bsel1 : (s == 2) ? bsel2 : qblk;
#pragma unroll
            for (int c = 0; c < 4; ++c) {
                float v = -3.0e38f;
                if (blk >= 0) {
                    const int kpos = blk * 256 + c * 64 + lane, rel = q - kpos;
                    const bf16* kr = F.KB + (size_t)(b * SEQ + kpos) * 512 + h * 64;
                    float dot = 0.f;
#pragma unroll
                    for (int d8 = 0; d8 < 8; ++d8) {
                        const u32x4 kk = *(const u32x4*)(kr + d8 * 8);
                        dot += __shfl(qv, d8 * 8 + 0) * bf2f(kk.x & 0xffffu) + __shfl(qv, d8 * 8 + 1) * bf2f(kk.x >> 16);
                        dot += __shfl(qv, d8 * 8 + 2) * bf2f(kk.y & 0xffffu) + __shfl(qv, d8 * 8 + 3) * bf2f(kk.y >> 16);
                        dot += __shfl(qv, d8 * 8 + 4) * bf2f(kk.z & 0xffffu) + __shfl(qv, d8 * 8 + 5) * bf2f(kk.z >> 16);
                        dot += __shfl(qv, d8 * 8 + 6) * bf2f(kk.w & 0xffffu) + __shfl(qv, d8 * 8 + 7) * bf2f(kk.w >> 16);
                    }
                    if (rel >= 0) v = dot + F.BT[h * 132 + (rel < 128 ? rel : 128)];
                }
                sc[s * 4 + c] = v; mx = fmaxf(mx, v);
            }
        }
        mx = wave_max(mx);
        float sum = 0.f;
#pragma unroll
        for (int i = 0; i < 16; ++i) { sc[i] = (sc[i] > -1.0e38f) ? exp2f(sc[i] - mx) : 0.f; sum += sc[i]; }
        sum = wave_sum(sum);
        float o = 0.f;
#pragma unroll
        for (int s = 0; s < 4; ++s) {
            const int blk = (s == 0) ? bsel0 : (s == 1) ? bsel1 : (s == 2) ? bsel2 : qblk;
            if (blk >= 0) {
#pragma unroll
                for (int c = 0; c < 4; ++c) {
                    const bf16* vr = F.VB + (size_t)(b * SEQ + blk * 256 + c * 64) * 512 + h * 64 + lane;
                    const float pc = sc[s * 4 + c];
                    for (int kk = 0; kk < 64; ++kk) {
                        const float p = __builtin_bit_cast(float, __builtin_amdgcn_readlane(__builtin_bit_cast(int, pc), kk));
                        o += p * bf2f(vr[(size_t)kk * 512]);
                    }
                }
            }
        }
        F.YMIX[(size_t)m * 1024 + 512 + h * 64 + lane] = (bf16)f2bf(o / sum);
    }
}

__device__ __forceinline__ void ph_moe_naive(const Ctx& F0, int l) {
    const Ctx F = launder(F0);
    LAS float* h2 = (LAS float*)F.lds;
    LAS float* act = h2 + 1024;
    LAS float* red = act + 512;
    LAS float* lg = red + 32;
    LAS float* selw = lg + 24;
    const float* g2 = F.in[18] + l * D;
    const float* gw_ = F.in[19] + (size_t)l * D * 4; const float* gb_ = F.in[20] + l * 4;
    const float* rw_ = F.in[21] + (size_t)l * 4 * D * 4; const float* rb_ = F.in[22] + l * 16;
    const float* wg = F.in[23] + (size_t)l * 16 * D * 256; const float* wu = F.in[24] + (size_t)l * 16 * D * 256; const float* wd = F.in[25] + (size_t)l * 16 * 256 * D;
    const int tid = F.tid, lane = F.lane, wave = F.wave;
    for (int m = F.vcu; m < T; m += F.G) {
        float* xr = F.R + (size_t)m * D;
        const float x0 = xr[tid], x1 = xr[tid + 512];
        float s = wave_sum(x0 * x0 + x1 * x1);
        if (lane == 0) red[wave] = s;
        __syncthreads();
        float tot = 0.f;
#pragma unroll
        for (int w = 0; w < 8; ++w) tot += red[w];
        const float rstd = 1.f / sqrtf(tot * (1.f / D) + RMS_EPS);
        h2[tid] = x0 * rstd * g2[tid]; h2[tid + 512] = x1 * rstd * g2[tid + 512];
        __syncthreads();
        for (int j = wave; j < 20; j += NWAVES) {
            float a = 0.f;
            if (j < 4) { for (int k = lane; k < D; k += 64) a += h2[k] * gw_[k * 4 + j]; }
            else { const int g = (j - 4) >> 2, e = (j - 4) & 3; for (int k = lane; k < D; k += 64) a += h2[k] * rw_[((size_t)g * D + k) * 4 + e]; }
            a = wave_sum(a);
            if (lane == 0) lg[j] = a + (j < 4 ? gb_[j] : rb_[j - 4]);
        }
        __syncthreads();
        if (tid == 0) {
            int gs = 0; float gm = lg[0];
            for (int j = 1; j < 4; ++j) if (lg[j] > gm) { gm = lg[j]; gs = j; }
            float se = 0.f; for (int j = 0; j < 4; ++j) se += __expf(lg[j] - gm);
            const float gwt = 1.f / se;
            int e1 = 0; float v1 = lg[4 + gs * 4];
            for (int e = 1; e < 4; ++e) if (lg[4 + gs * 4 + e] > v1) { v1 = lg[4 + gs * 4 + e]; e1 = e; }
            int e2 = -1; float v2 = -3.0e38f;
            for (int e = 0; e < 4; ++e) if (e != e1 && lg[4 + gs * 4 + e] > v2) { v2 = lg[4 + gs * 4 + e]; e2 = e; }
            const float p2 = __expf(v2 - v1), w1 = 1.f / (1.f + p2), w2 = p2 / (1.f + p2);
            selw[0] = __builtin_bit_cast(float, gs * 4 + e1); selw[1] = __builtin_bit_cast(float, gs * 4 + e2);
            selw[2] = gwt * w1; selw[3] = gwt * w2;
        }
        __syncthreads();
        {
            const int slot = tid >> 8, f = tid & 255;
            const int e = __builtin_bit_cast(int, selw[slot]); const float cw = selw[2 + slot];
            const float* pg = wg + (size_t)e * D * 256 + f; const float* pu = wu + (size_t)e * D * 256 + f;
            float ag = 0.f, au = 0.f;
            for (int k = 0; k < D; ++k) { const float hv = h2[k]; ag += hv * pg[(size_t)k * 256]; au += hv * pu[(size_t)k * 256]; }
            act[slot * 256 + f] = ag * sigmoidf_(ag) * au * cw;
        }
        __syncthreads();
        {
            const int ea = __builtin_bit_cast(int, selw[0]), eb = __builtin_bit_cast(int, selw[1]);
            const float* pa = wd + (size_t)ea * 256 * D; const float* pb = wd + (size_t)eb * 256 * D;
            float y0 = 0.f, y1 = 0.f;
            for (int f = 0; f < 256; ++f) {
                const float a = act[f], b = act[256 + f];
                y0 += a * pa[(size_t)f * D + tid] + b * pb[(size_t)f * D + tid];
                y1 += a * pa[(size_t)f * D + tid + 512] + b * pb[(size_t)f * D + tid + 512];
            }
            xr[tid] = x0 + y0; xr[tid + 512] = x1 + y1;
        }
        __syncthreads();
    }
}

__device__ __forceinline__ void ph_final(const Ctx& F0) {
    const Ctx F = launder(F0);
    const int gw = F.vcu * NWAVES + F.wave, NGW = F.G * NWAVES;
    const f32x4* gf = (const f32x4*)F.in[26] + F.lane;
    for (int m = gw; m < T; m += NGW) {
        f32x4* xr = (f32x4*)(F.R + (size_t)m * D) + F.lane;
        f32x4 v[4]; float s = 0.f;
#pragma unroll
        for (int j = 0; j < 4; ++j) { v[j] = xr[64 * j]; s += (v[j].x * v[j].x + v[j].y * v[j].y) + (v[j].z * v[j].z + v[j].w * v[j].w); }
        const float rstd = 1.f / sqrtf(wave_sum(s) * (1.f / D) + RMS_EPS);
#pragma unroll
        for (int j = 0; j < 4; ++j) xr[64 * j] = v[j] * rstd * gf[64 * j];
    }
}

constexpr int LDS_BYTES = 147456;
constexpr int MISC_OFF = 131072 + 320;

__global__ void __launch_bounds__(NTHREADS, 2) mk_fwd(Args args) {
    extern __shared__ __attribute__((aligned(16))) unsigned char lds[];
    Ctx F;
    F.lds = (LAS unsigned char*)lds;
    F.tid = threadIdx.x; F.lane = F.tid & 63; F.wave = __builtin_amdgcn_readfirstlane(F.tid >> 6);
    F.G = gridDim.x; { const int bx = blockIdx.x; F.vcu = (F.G % 8 == 0) ? (bx % 8) * (F.G / 8) + bx / 8 : bx; }
    F.in = args.in; F.R = args.out; F.ws = args.ws;
    unsigned char* ws = args.ws;
    F.XB = (bf16*)(ws + WS_XB); F.UG = (bf16*)(ws + WS_UG); F.PB = (bf16*)(ws + WS_PB); F.QB = (bf16*)(ws + WS_QB); F.KB = (bf16*)(ws + WS_KB); F.VB = (bf16*)(ws + WS_VB);
    F.YMIX = (bf16*)(ws + WS_YMIX); F.YS = (bf16*)(ws + WS_YS); F.DL = (bf16*)(ws + WS_DL); F.KMP = (float*)(ws + WS_KMP); F.BT = (float*)(ws + WS_BT);
    volatile LAS unsigned* MISC = (volatile LAS unsigned*)(F.lds + MISC_OFF);
    for (int u = F.tid; u < 64; u += NTHREADS) MISC[u] = 0u;
    __syncthreads();
    XcdBarrier bar = xcd_barrier_post((unsigned*)(ws + WS_CTL) + CW_BAR, MISC + 8);
#define GRID_BAR() xcd_barrier(bar)

    ph_bias_table(F);
#if USE_ENG_PROJ
    ph_prologue(F);
#endif
#pragma unroll 1
    for (int l = 0; l < DEPTH; ++l) {
        const float* xin = (l == 0) ? F.in[0] : F.R;
        ph_norm(F, xin);
        GRID_BAR();
#if USE_ENG_PROJ
        { pg8::Gemm g{F.XB, (const bf16*)(ws + WS_WIN) + (size_t)l * NPROJ * D, D, D, D}; pg8::StaticOrder S; S.init(T, NPROJ, F.G, (int)blockIdx.x);
          EpiProjE E{F.UG, F.PB, F.QB, F.KB, F.VB, F.KMP}; pg8::gemm_phase(F.lds, g, S, E); }
#else
        { EpiProj E{F}; naive_gemm(F, F.XB, D, F.in[3] + (size_t)l * D * NPROJ, NPROJ, F.in[2] + l * D, T, NPROJ, D, E); }
#endif
        GRID_BAR();
        ph_ssm_naive(F, l);
#if !USE_ENG_PROJ
        ph_kmean_naive(F);
#endif
        ph_pool_dl(F);
        GRID_BAR();
        { EpiGlu E{F.YS, F.YMIX, F.in[13] + l * 256}; naive_gemm(F, F.YS, 256, F.in[12] + (size_t)l * 256 * 256, 256, nullptr, T, 256, 256, E); }
        ph_pool_mm_naive(F, l);
        ph_attn_naive(F);
        GRID_BAR();
#if USE_ENG_PROJ
        { pg8::Gemm g{F.YMIX, (const bf16*)(ws + WS_WOUT) + (size_t)l * D * D, D, D, D}; pg8::StaticOrder S; S.init(T, D, F.G, (int)blockIdx.x);
          EpiOutE E{xin, F.R}; pg8::gemm_phase(F.lds, g, S, E); }
#else
        { EpiOut E{xin, F.R}; naive_gemm(F, F.YMIX, D, F.in[17] + (size_t)l * D * D, D, nullptr, T, D, D, E); }
#endif
        GRID_BAR();
        ph_moe_naive(F, l);
        GRID_BAR();
    }
    ph_final(F);
}

extern "C" void kernel_launch(void* const* d_in, const int* in_sizes, int n_in, void* d_out, int out_size, void* d_ws, size_t ws_size, hipStream_t stream) {
    static int grid = 0;
    if (grid == 0) {
        if (n_in != 27 || out_size != T * D || ws_size < WS_END) { fprintf(stderr, "kernel_launch: unexpected shapes (n_in %d out %d ws %zu)\n", n_in, out_size, ws_size); grid = -1; return; }
        int dev = 0, cus = 0, per_cu = 0;
        if (hipGetDevice(&dev) != hipSuccess || hipDeviceGetAttribute(&cus, hipDeviceAttributeMultiprocessorCount, dev) != hipSuccess) { grid = -1; return; }
        if (hipFuncSetAttribute((const void*)mk_fwd, hipFuncAttributeMaxDynamicSharedMemorySize, LDS_BYTES) != hipSuccess) { fprintf(stderr, "kernel_launch: hipFuncSetAttribute failed\n"); grid = -1; return; }
        if (hipOccupancyMaxActiveBlocksPerMultiprocessor(&per_cu, (const void*)mk_fwd, NTHREADS, LDS_BYTES) != hipSuccess || per_cu < 1) { fprintf(stderr, "kernel_launch: occupancy query says %d\n", per_cu); per_cu = 1; }
        (void)hipGetLastError();
        grid = cus;
    }
    if (grid < 0) return;
    (void)hipMemsetAsync((char*)d_ws + WS_CTL, 0, CTL_ZERO_BYTES, stream);
    Args a{};
    for (int i = 0; i < 27; ++i) a.in[i] = (const float*)d_in[i];
    a.out = (float*)d_out; a.ws = (unsigned char*)d_ws; a.ph_lo = 0; a.ph_hi = 0;
    hipLaunchKernelGGL(mk_fwd, dim3(grid), dim3(NTHREADS), LDS_BYTES, stream, a);
}
```

```cpp
#include <hip/hip_runtime.h>
#include <cstdio>
#include <cstdint>

#define GAS __attribute__((address_space(1)))
#define LAS __attribute__((address_space(3)))
typedef unsigned short bf16;
typedef float f32x4 __attribute__((ext_vector_type(4)));
typedef unsigned u32x4 __attribute__((ext_vector_type(4)));
typedef unsigned u32x2 __attribute__((ext_vector_type(2)));

constexpr int NB = 8, SEQ = 4096, T = NB * SEQ, D = 1024, NPROJ = 2048, DEPTH = 2;
constexpr int NHEAD = 8, HD = 64, MBLK = 256, NBLK = SEQ / MBLK;
constexpr int SG = 16, SGN = 16, SP = 64, SCH = 64, UGP = 1152;
constexpr float RMS_EPS = 1e-6f;
constexpr float LOG2E = 1.4426950408889634f;
constexpr float C2 = 0.125f * LOG2E;
constexpr int NWAVES = 8, NTHREADS = 512;
#ifndef USE_ENG_PROJ
#define USE_ENG_PROJ 1
#endif
#ifndef USE_ENG_MOE
#define USE_ENG_MOE 1
#endif

constexpr size_t MiB = 1u << 20;
constexpr size_t WS_CTL = 0, CTL_ZERO_BYTES = 1 * MiB;
constexpr size_t WS_XB = 2 * MiB;
constexpr size_t WS_UG = 66 * MiB;
constexpr size_t WS_PB = 84 * MiB;
constexpr size_t WS_QB = 100 * MiB;
constexpr size_t WS_KB = 132 * MiB;
constexpr size_t WS_VB = 164 * MiB;
constexpr size_t WS_YMIX = 196 * MiB;
constexpr size_t WS_YS = 260 * MiB;
constexpr size_t WS_DL = 276 * MiB;
constexpr size_t WS_KMP = 292 * MiB;
constexpr size_t WS_BT = 293 * MiB;
constexpr size_t WS_WIN = 300 * MiB;
constexpr size_t WS_WOUT = 308 * MiB;
constexpr size_t WS_GU = 312 * MiB;
constexpr size_t WS_WD = 344 * MiB;
constexpr size_t WS_END = 392 * MiB;
constexpr int MOE_MAXT = 152;
constexpr size_t WS_XS = 66 * MiB;
constexpr size_t WS_HACT = 142 * MiB;
constexpr size_t WS_TOKB = 294 * MiB;
constexpr size_t WS_TOKR = WS_TOKB + 128 * 1024;
constexpr size_t WS_TOKW = WS_TOKB + 256 * 1024;
constexpr size_t WS_ROWTOK = 295 * MiB;
constexpr size_t WS_ROWW = WS_ROWTOK + 256 * 1024;
constexpr size_t WS_WGCNT = 296 * MiB;
constexpr size_t WS_TILEB = WS_WGCNT + 64 * 1024;

constexpr int CW_BAR = 4096;

__device__ __forceinline__ unsigned f2bf(float f) { unsigned u = __builtin_bit_cast(unsigned, f); return (u + 0x7fffu + ((u >> 16) & 1u)) >> 16; }
__device__ __forceinline__ float bf2f(unsigned h) { return __builtin_bit_cast(float, h << 16); }
__device__ __forceinline__ unsigned pk2(float lo, float hi) { return f2bf(lo) | (f2bf(hi) << 16); }
template <int O> __device__ __forceinline__ float xshfl(float v) {
    if constexpr (O < 32) return __builtin_bit_cast(float, __builtin_amdgcn_ds_swizzle(__builtin_bit_cast(int, v), (O << 10) | 0x1f));
    else { const unsigned u = __builtin_bit_cast(unsigned, v); auto r = __builtin_amdgcn_permlane32_swap(u, u, false, false);
           const float a = __builtin_bit_cast(float, (unsigned)r[0]), b = __builtin_bit_cast(float, (unsigned)r[1]); return (a == v && __builtin_bit_cast(unsigned, a) == u) ? b : a; }
}
__device__ __forceinline__ float wave_sum(float v) {
    v += xshfl<1>(v); v += xshfl<2>(v); v += xshfl<4>(v); v += xshfl<8>(v); v += xshfl<16>(v);
    const unsigned u = __builtin_bit_cast(unsigned, v); auto r = __builtin_amdgcn_permlane32_swap(u, u, false, false);
    return __builtin_bit_cast(float, (unsigned)r[0]) + __builtin_bit_cast(float, (unsigned)r[1]);
}
__device__ __forceinline__ float wave_max(float v) {
    v = fmaxf(v, xshfl<1>(v)); v = fmaxf(v, xshfl<2>(v)); v = fmaxf(v, xshfl<4>(v)); v = fmaxf(v, xshfl<8>(v)); v = fmaxf(v, xshfl<16>(v));
    const unsigned u = __builtin_bit_cast(unsigned, v); auto r = __builtin_amdgcn_permlane32_swap(u, u, false, false);
    return fmaxf(__builtin_bit_cast(float, (unsigned)r[0]), __builtin_bit_cast(float, (unsigned)r[1]));
}
__device__ __forceinline__ float gelu_tanh(float x) {
    const float u = 0.7978845608028654f * (x + 0.044715f * x * x * x);
    const float e = __expf(2.f * u);
    const float th = 1.f - 2.f / (e + 1.f);
    return 0.5f * x * (1.f + th);
}
__device__ __forceinline__ float sigmoidf_(float x) { return 1.f / (1.f + __expf(-x)); }

#define XB_TMO      128
#define XB_XCNT(j)  (256  + 64 * (j))
#define XB_XSUB(j)  (1280 + 64 * (j))
#define XB_XGEN(j)  (2304 + 64 * (j))
#define XB_TOP      3328
#define XB_TOPGEN   3392
#define XCD_BAR_WORDS 3456
#define XB_SPIN_CAP (1u << 22)
__device__ __forceinline__ unsigned xb_ld(unsigned* p)              { return __hip_atomic_load(p, __ATOMIC_RELAXED, __HIP_MEMORY_SCOPE_AGENT); }
__device__ __forceinline__ unsigned xb_add(unsigned* p, unsigned v) { return __hip_atomic_fetch_add(p, v, __ATOMIC_RELAXED, __HIP_MEMORY_SCOPE_AGENT); }
__device__ __forceinline__ unsigned xb_xcc_id() { return (unsigned)__builtin_amdgcn_s_getreg((3 << 11) | 20) & 0xFu; }
#define XB_SPIN(cond, bar) do { unsigned _sp = 0; while (cond) { __builtin_amdgcn_s_sleep(1); \
    if ((++_sp & 255u) == 0u) { if (xb_ld(&(bar)[XB_TMO])) break; if (_sp > XB_SPIN_CAP) { atomicAdd(&(bar)[XB_TMO], 1u); break; } } } } while (0)
struct XcdBarrier { unsigned* bar; unsigned x; volatile LAS unsigned* st; };
__device__ __forceinline__ XcdBarrier xcd_barrier_post(unsigned* bar, volatile LAS unsigned* st) {
    XcdBarrier b; b.bar = bar; b.x = xb_xcc_id(); b.st = st;
    if (threadIdx.x == 0) (void)xb_add(&bar[XB_XCNT(b.x)], 1u);
    return b;
}
__device__ __forceinline__ void xcd_barrier_complete(unsigned* bar, unsigned x, unsigned& nloc, unsigned& nx) {
    const unsigned G = gridDim.x * gridDim.y * gridDim.z;
    unsigned sum, cnt, mine, sp = 0u;
    for (;;) {
        sum = 0u; cnt = 0u; mine = 0u;
#pragma unroll
        for (unsigned j = 0; j < 16; ++j) { const unsigned c = xb_ld(&bar[XB_XCNT(j)]); sum += c; cnt += (c > 0u) ? 1u : 0u; mine = (j == x) ? c : mine; }
        if (sum == G) break;
        __builtin_amdgcn_s_sleep(1);
        if ((++sp & 255u) == 0u) { if (xb_ld(&bar[XB_TMO])) break; if (sp > XB_SPIN_CAP) { atomicAdd(&bar[XB_TMO], 1u); break; } }
    }
    nloc = mine > 0u ? mine : 1u; nx = cnt > 0u ? cnt : 1u;
}
__device__ __forceinline__ void xcd_barrier(const XcdBarrier& b) {
    asm volatile("s_waitcnt vmcnt(0)" ::: "memory");
    __syncthreads();
    if (threadIdx.x == 0) {
        unsigned* bar = b.bar;
        __builtin_amdgcn_s_waitcnt(0);
        unsigned nloc = b.st[0], nx = b.st[1];
        if (nloc == 0u) { xcd_barrier_complete(bar, b.x, nloc, nx); b.st[0] = nloc; b.st[1] = nx; }
        const unsigned old = xb_add(&bar[XB_XSUB(b.x)], 1u);
        const unsigned gen = old / nloc;
        if (old + 1u == (gen + 1u) * nloc) {
            __builtin_amdgcn_fence(__ATOMIC_RELEASE, "agent");
            asm volatile("s_waitcnt vmcnt(0)" ::: "memory");
            const unsigned og = xb_add(&bar[XB_TOP], 1u);
            const unsigned tg = og / nx;
            if (og + 1u == (tg + 1u) * nx) xb_add(&bar[XB_TOPGEN], 1u);
            else XB_SPIN(xb_ld(&bar[XB_TOPGEN]) == tg, bar);
            __builtin_amdgcn_fence(__ATOMIC_ACQUIRE, "agent");
            xb_add(&bar[XB_XGEN(b.x)], 1u);
            asm volatile("s_waitcnt vmcnt(0)" ::: "memory");
        } else {
            XB_SPIN(xb_ld(&bar[XB_XGEN(b.x)]) == gen, bar);
            __builtin_amdgcn_fence(__ATOMIC_ACQUIRE, "agent");
            asm volatile("s_waitcnt vmcnt(0)" ::: "memory");
        }
    }
    __syncthreads();
}

struct Args {
    const float* in[27];
    float* out;
    unsigned char* ws;
    int ph_lo, ph_hi;
};

struct Ctx {
    LAS unsigned char* lds;
    int tid, lane, wave, vcu, G;
    const float* const* in;
    float* R;
    unsigned char* ws;
};
#define P_XB(F) ((bf16*)((F).ws + WS_XB))
#define P_UG(F) ((bf16*)((F).ws + WS_UG))
#define P_PB(F) ((bf16*)((F).ws + WS_PB))
#define P_QB(F) ((bf16*)((F).ws + WS_QB))
#define P_KB(F) ((bf16*)((F).ws + WS_KB))
#define P_VB(F) ((bf16*)((F).ws + WS_VB))
#define P_YMIX(F) ((bf16*)((F).ws + WS_YMIX))
#define P_YS(F) ((bf16*)((F).ws + WS_YS))
#define P_DL(F) ((bf16*)((F).ws + WS_DL))
#define P_KMP(F) ((float*)((F).ws + WS_KMP))
#define P_BT(F) ((float*)((F).ws + WS_BT))


__device__ __forceinline__ Ctx launder(const Ctx& F0) {
    Ctx F = F0;
    int t = threadIdx.x; asm volatile("" : "+v"(t));
    F.tid = t; F.lane = t & 63; F.wave = __builtin_amdgcn_readfirstlane(t >> 6);
    asm volatile("" : "+s"(F.vcu), "+s"(F.G), "+s"(F.ws), "+s"(F.R));
    return F;
}

__device__ __forceinline__ void store_proj(const Ctx& F, int m, int c, float v) {
    if (c < 256) { const int g = c >> 4, h = c & 15; P_UG(F)[((size_t)(g * 512 + (m >> 6))) * UGP + (m & 63) * 16 + h] = (bf16)f2bf(v); }
    else if (c < 512) P_PB(F)[(size_t)m * 256 + (c - 256)] = (bf16)f2bf(v);
    else if (c < 1024) P_QB(F)[(size_t)m * 512 + (c - 512)] = (bf16)f2bf(v * C2);
    else if (c < 1536) P_KB(F)[(size_t)m * 512 + (c - 1024)] = (bf16)f2bf(v);
    else P_VB(F)[(size_t)m * 512 + (c - 1536)] = (bf16)f2bf(v);
}


namespace pg8 {
typedef short bf16x8 __attribute__((ext_vector_type(8)));
constexpr int BM = 256, BK = 64, HALF = 128, HTB = HALF * BK * 2, STAGE_BYTES = 8 * HTB, NXCD = 8, WGM = 8;
__device__ __forceinline__ int lds_byte(int r, int c) { const int st = (r >> 4) * 2 + (c >> 5), rr = r & 15, cc = c & 31, ob = rr * 64 + cc * 2; return st * 1024 + (ob ^ (((ob >> 9) & 1) << 5)); }
__device__ __forceinline__ void stage_rc(int b, int& R, int& C) { const int st = b / 1024, sb = b % 1024, swz = sb ^ (((sb >> 9) & 1) << 5); R = (st >> 1) * 16 + swz / 64; C = (st & 1) * 32 + (swz % 64) / 2; }
__device__ __forceinline__ int perm32(int rho) { const int n = rho >> 4, i = rho & 15; return 8 * (i >> 2) + 4 * n + (i & 3); }

struct Unit { int pm, pn, aux; };
struct Gemm { const bf16* A; const bf16* Bt; int lda, ldb, K; };

struct StaticOrder {
    int nM, nN, nwg, G, c;
    __device__ void init(int M, int N, int G_, int c_) { nM = M / BM; nN = N / BM; nwg = nM * nN; G = G_; c = c_; }
    __device__ bool next(int i, Unit& u) const {
        const long L = (long)i * G + c; if (L >= nwg) return false;
        int wgid = (int)L; { const int q = nwg / NXCD, r = nwg % NXCD, xcd = wgid % NXCD, off = wgid / NXCD; wgid = (xcd < r ? xcd * (q + 1) : r * (q + 1) + (xcd - r) * q) + off; }
        const int nig = WGM * nN, gid = wgid / nig, fm = gid * WGM, gsz = (nM - fm) < WGM ? (nM - fm) : WGM;
        u.pm = fm + ((wgid % nig) % gsz); u.pn = (wgid % nig) / gsz; u.aux = 0; return true;
    }
};

__device__ __forceinline__ unsigned cvt_pk_bf16(float lo, float hi) { unsigned r; asm volatile("v_cvt_pk_bf16_f32 %0, %1, %2" : "=v"(r) : "v"(lo), "v"(hi)); return r; }

template <class Epi, class Sched>
__device__ __forceinline__ void gemm_phase(LAS unsigned char* lds, const Gemm g, const Sched& S, const Epi& E) {
    int tid_ = threadIdx.x; asm volatile("" : "+v"(tid_));
    const int tid = tid_, wid = __builtin_amdgcn_readfirstlane(tid >> 6), lane = tid & 63, wr = wid >> 2, wc = wid & 3, fr = lane & 15, fq = lane >> 4;
    const int K = g.K, nt = K / BK;
    unsigned voffA[2], voffB[2];
#pragma unroll
    for (int i = 0; i < 2; ++i) { int R, C; stage_rc(tid * 16 + i * 8192, R, C); const int Rb = Epi::PERM ? ((R & ~31) + perm32(R & 31)) : R;
        voffA[i] = (unsigned)(R * g.lda + C) * 2u; voffB[i] = (unsigned)(Rb * g.ldb + C) * 2u; }
    const size_t kstep = (size_t)(BK * 2);
    const size_t hstepA = (size_t)HALF * g.lda * 2, hstepB = (size_t)HALF * g.ldb * 2;
    const size_t tstepA = 2 * hstepA, tstepB = 2 * hstepB;
    const unsigned ldsw = (unsigned)wid * 1024u;
    const int aoff = lds_byte(wr * 64 + fr, fq * 8), boff = lds_byte(wc * 32 + fr, fq * 8);
#define PG8_SA(b, h) (((b) * 2 + (h)) * HTB)
#define PG8_SB(b, h) ((4 + (b) * 2 + (h)) * HTB)
#define PG8_STAGE(bufoff, gbase, voff) do { _Pragma("unroll") for (int _i = 0; _i < 2; ++_i) \
        __builtin_amdgcn_global_load_lds((const unsigned*)((const char*)(gbase) + (voff)[_i]), (LAS unsigned*)(lds + (bufoff) + ldsw + _i * 8192), 16, 0, 0); } while (0)
#define PG8_LDA(dst, b, h) do { _Pragma("unroll") for (int m = 0; m < 4; ++m) _Pragma("unroll") for (int k = 0; k < 2; ++k) dst[m][k] = *(const LAS bf16x8*)(lds + PG8_SA(b, h) + aoff + m * 2048 + k * 1024); } while (0)
#define PG8_LDB(dst, b, h) do { _Pragma("unroll") for (int n = 0; n < 2; ++n) _Pragma("unroll") for (int k = 0; k < 2; ++k) dst[n][k] = *(const LAS bf16x8*)(lds + PG8_SB(b, h) + boff + n * 2048 + k * 1024); } while (0)
#define PG8_MMA(ai, bj, At, Bt) do { __builtin_amdgcn_s_setprio(1); _Pragma("unroll") for (int m = 0; m < 4; ++m) _Pragma("unroll") for (int n = 0; n < 2; ++n) _Pragma("unroll") for (int k = 0; k < 2; ++k) \
        acc[ai][bj][m][n] = __builtin_amdgcn_mfma_f32_16x16x32_bf16(Bt[n][k], At[m][k], acc[ai][bj][m][n], 0, 0, 0); __builtin_amdgcn_s_setprio(0); } while (0)
#define PG8_WAIT_V(n) asm volatile("s_waitcnt vmcnt(" #n ")" ::: "memory")
#define PG8_WAIT_L(n) asm volatile("s_waitcnt lgkmcnt(" #n ")" ::: "memory")
#define PG8_BAR __builtin_amdgcn_s_barrier()
#define PG8_SCHED __builtin_amdgcn_sched_barrier(0)
    Unit cur, nxt; int ui = 0;
    if (!S.next(0, cur)) return;
    f32x4 acc[2][2][4][2];
#pragma unroll
    for (int a = 0; a < 2; ++a)
#pragma unroll
        for (int b = 0; b < 2; ++b)
#pragma unroll
            for (int m = 0; m < 4; ++m)
#pragma unroll
                for (int n = 0; n < 2; ++n) acc[a][b][m][n] = (f32x4){0.f, 0.f, 0.f, 0.f};
    bf16x8 At[4][2], B0[2][2], B1[2][2];
    const char* cA = (const char*)g.A + (size_t)cur.pm * tstepA; const char* cB = (const char*)g.Bt + (size_t)cur.pn * tstepB;
    PG8_STAGE(PG8_SB(0, 0), cB, voffB); PG8_STAGE(PG8_SB(0, 1), cB + hstepB, voffB); PG8_STAGE(PG8_SA(0, 0), cA, voffA); PG8_STAGE(PG8_SA(0, 1), cA + hstepA, voffA);
    if (wr == 1) PG8_BAR;
    PG8_WAIT_V(2); PG8_BAR;
    PG8_STAGE(PG8_SB(1, 0), cB + kstep, voffB); PG8_STAGE(PG8_SA(1, 0), cA + kstep, voffA); PG8_STAGE(PG8_SB(1, 1), cB + hstepB + kstep, voffB);
    PG8_WAIT_V(6); PG8_BAR;
    for (;;) {
        const bool has_next = S.next(ui + 1, nxt);
        const char* nA = has_next ? (const char*)g.A + (size_t)nxt.pm * tstepA : cA; const char* nB = has_next ? (const char*)g.Bt + (size_t)nxt.pn * tstepB : cB;
        for (int t = 0; t < nt; t += 2) {
            const bool last = (t == nt - 2);
            const char* a1 = cA + (size_t)(t + 1) * kstep;
            const char* a2 = last ? nA : cA + (size_t)(t + 2) * kstep; const char* b2 = last ? nB : cB + (size_t)(t + 2) * kstep;
            const char* a3 = a2 + kstep; const char* b3 = b2 + kstep;
            PG8_LDB(B0, 0, 0); PG8_LDB(B1, 0, 1); PG8_SCHED; PG8_LDA(At, 0, 0); PG8_STAGE(PG8_SA(1, 1), a1 + hstepA, voffA);
            PG8_WAIT_V(8); PG8_WAIT_L(0); PG8_BAR; PG8_MMA(0, 0, At, B0); PG8_MMA(0, 1, At, B1); PG8_BAR; PG8_SCHED;
            PG8_LDA(At, 0, 1); PG8_STAGE(PG8_SB(0, 0), b2, voffB); PG8_STAGE(PG8_SB(0, 1), b2 + hstepB, voffB); PG8_STAGE(PG8_SA(0, 0), a2, voffA);
            PG8_WAIT_V(8); PG8_WAIT_L(0); PG8_BAR; PG8_MMA(1, 0, At, B0); PG8_MMA(1, 1, At, B1); PG8_BAR; PG8_SCHED;
            PG8_LDB(B0, 1, 0); PG8_LDB(B1, 1, 1); PG8_SCHED; PG8_LDA(At, 1, 0); PG8_STAGE(PG8_SA(0, 1), a2 + hstepA, voffA);
            PG8_WAIT_V(8); PG8_WAIT_L(0); PG8_BAR; PG8_MMA(0, 0, At, B0); PG8_MMA(0, 1, At, B1); PG8_BAR; PG8_SCHED;
            PG8_LDA(At, 1, 1); PG8_STAGE(PG8_SB(1, 0), b3, voffB); PG8_STAGE(PG8_SB(1, 1), b3 + hstepB, voffB); PG8_STAGE(PG8_SA(1, 0), a3, voffA);
            PG8_WAIT_V(8); PG8_WAIT_L(0); PG8_BAR; PG8_MMA(1, 0, At, B0); PG8_MMA(1, 1, At, B1); PG8_BAR; PG8_SCHED;
        }
        if (wr == 0) PG8_BAR;
        E(acc, cur, wr, wc, fr, fq);
        if (!has_next) break;
#pragma unroll
        for (int a = 0; a < 2; ++a)
#pragma unroll
            for (int b = 0; b < 2; ++b)
#pragma unroll
                for (int m = 0; m < 4; ++m)
#pragma unroll
                    for (int n = 0; n < 2; ++n) acc[a][b][m][n] = (f32x4){0.f, 0.f, 0.f, 0.f};
        cur = nxt; cA = nA; cB = nB; ++ui;
        if (wr == 1) PG8_BAR;
    }
    PG8_WAIT_V(0);
    PG8_BAR;
#undef PG8_SA
#undef PG8_SB
#undef PG8_STAGE
#undef PG8_LDA
#undef PG8_LDB
#undef PG8_MMA
#undef PG8_WAIT_V
#undef PG8_WAIT_L
#undef PG8_BAR
#undef PG8_SCHED
}
}


struct EpiProjE {
    static constexpr bool PERM = true;
    bf16 *UG, *PB, *QB, *KB, *VB; float* KMP;
    __device__ __forceinline__ void operator()(const f32x4 (&acc)[2][2][4][2], const pg8::Unit& u, int wr, int wc, int fr, int fq) const {
        const int pn = u.pn, row0 = u.pm * 256 + wr * 64 + fr, cl = wc * 32 + 8 * fq;
        if (pn == 0) {
#pragma unroll
            for (int ai = 0; ai < 2; ++ai)
#pragma unroll
                for (int m = 0; m < 4; ++m) { const int r = row0 + ai * 128 + m * 16;
#pragma unroll
                    for (int bj = 0; bj < 2; ++bj) { const int ch = bj * 128 + cl, g = ch >> 4, h0 = ch & 15;
                        const f32x4 v0 = acc[ai][bj][m][0], v1 = acc[ai][bj][m][1]; u32x4 w;
                        w.x = pg8::cvt_pk_bf16(v0[0], v0[1]); w.y = pg8::cvt_pk_bf16(v0[2], v0[3]); w.z = pg8::cvt_pk_bf16(v1[0], v1[1]); w.w = pg8::cvt_pk_bf16(v1[2], v1[3]);
                        *(u32x4*)(UG + ((size_t)(g * 512 + (r >> 6))) * UGP + (r & 63) * 16 + h0) = w; } }
        } else {
            bf16* base; int ldc, colt; float sc = 1.f;
            if (pn == 1) { base = PB; ldc = 256; colt = 0; }
            else if (pn < 4) { base = QB; ldc = 512; colt = (pn - 2) * 256; sc = C2; }
            else if (pn < 6) { base = KB; ldc = 512; colt = (pn - 4) * 256; }
            else { base = VB; ldc = 512; colt = (pn - 6) * 256; }
#pragma unroll
            for (int ai = 0; ai < 2; ++ai)
#pragma unroll
                for (int m = 0; m < 4; ++m) { bf16* rowp = base + (size_t)(row0 + ai * 128 + m * 16) * ldc + colt + cl;
#pragma unroll
                    for (int bj = 0; bj < 2; ++bj) { const f32x4 v0 = acc[ai][bj][m][0] * sc, v1 = acc[ai][bj][m][1] * sc; u32x4 w;
                        w.x = pg8::cvt_pk_bf16(v0[0], v0[1]); w.y = pg8::cvt_pk_bf16(v0[2], v0[3]); w.z = pg8::cvt_pk_bf16(v1[0], v1[1]); w.w = pg8::cvt_pk_bf16(v1[2], v1[3]);
                        *(u32x4*)(rowp + bj * 128) = w; } }
            if (pn >= 4 && pn < 6) {
#pragma unroll
                for (int bj = 0; bj < 2; ++bj)
#pragma unroll
                    for (int n = 0; n < 2; ++n) { f32x4 s = (f32x4){0.f, 0.f, 0.f, 0.f};
#pragma unroll
                        for (int ai = 0; ai < 2; ++ai)
#pragma unroll
                            for (int m = 0; m < 4; ++m) s += acc[ai][bj][m][n];
#pragma unroll
                        for (int i = 0; i < 4; ++i) { float t = s[i]; t += xshfl<1>(t); t += xshfl<2>(t); t += xshfl<4>(t); t += xshfl<8>(t); s[i] = t; }
                        if (fr == 0) *(f32x4*)(KMP + (size_t)wr * 128 * 512 + (size_t)u.pm * 512 + colt + bj * 128 + cl + 4 * n) = s; }
            }
        }
    }
};
struct EpiOutE {
    static constexpr bool PERM = false;
    const float* xin; float* R;
    __device__ __forceinline__ void operator()(const f32x4 (&acc)[2][2][4][2], const pg8::Unit& u, int wr, int wc, int fr, int fq) const {
        const int row0 = u.pm * 256 + wr * 64 + fr, col0 = u.pn * 256 + wc * 32 + 4 * fq;
#pragma unroll
        for (int ai = 0; ai < 2; ++ai)
#pragma unroll
            for (int m = 0; m < 4; ++m) { const size_t off = (size_t)(row0 + ai * 128 + m * 16) * D + col0;
#pragma unroll
                for (int bj = 0; bj < 2; ++bj)
#pragma unroll
                    for (int n = 0; n < 2; ++n) { const size_t o = off + bj * 128 + n * 16; *(f32x4*)(R + o) = *(const f32x4*)(xin + o) + acc[ai][bj][m][n]; }
                if (m & 1) asm volatile("" ::: "memory"); }
    }
};

__device__ __forceinline__ void transpose_item(const float* W, int K, int N, const float* kscale, bf16* WT, int ldo, int koff, int rowmode, LAS float* scr, int item, int lane) {
    const int nblk = N / 32, kb = item / nblk, nb = item % nblk, k0 = 64 * kb, n0 = 32 * nb;
#pragma unroll 8
    for (int i = 0; i < 32; ++i) { const int kk = 2 * i + (lane >> 5); const float s = kscale ? kscale[k0 + kk] : 1.f; scr[kk * 33 + (lane & 31)] = W[(size_t)(k0 + kk) * N + n0 + (lane & 31)] * s; }
    asm volatile("s_waitcnt lgkmcnt(0)" ::: "memory");
    const int c = lane & 7;
#pragma unroll
    for (int j = 0; j < 4; ++j) { const int n = (lane >> 3) + 8 * j; const LAS float* s = scr + (8 * c) * 33 + n;
        u32x4 o; o.x = pk2(s[0 * 33], s[1 * 33]); o.y = pk2(s[2 * 33], s[3 * 33]); o.z = pk2(s[4 * 33], s[5 * 33]); o.w = pk2(s[6 * 33], s[7 * 33]);
        const int nn = n0 + n, row = rowmode == 0 ? nn : (8 * (nn >> 2) + (nn & 3) + (rowmode == 2 ? 4 : 0));
        *(u32x4*)(WT + (size_t)row * ldo + koff + k0 + 8 * c) = o; }
    asm volatile("s_waitcnt lgkmcnt(0)" ::: "memory");
}
__device__ __forceinline__ void pair_decode(int pi, int& ea, int& eb) { ea = pi < 3 ? 0 : (pi < 5 ? 1 : 2); eb = pi < 3 ? pi + 1 : (pi < 5 ? pi - 1 : 3); }
__device__ __forceinline__ void ph_prologue(const Ctx& F0) {
    const Ctx F = launder(F0);
    LAS float* scr = (LAS float*)(F.lds + F.wave * 16384);
    const int gw = F.vcu * NWAVES + F.wave, NGW = F.G * NWAVES;
    constexpr int I_IN = (D / 64) * (NPROJ / 32), I_OUT = (D / 64) * (D / 32), I_GU1 = (D / 64) * (256 / 32), I_GU = 16 * 2 * I_GU1, I_WD1 = (256 / 64) * (D / 32), I_WD = 24 * 2 * I_WD1;
    constexpr int I_L = I_IN + I_OUT + I_GU + I_WD;
    for (int it = gw; it < DEPTH * I_L; it += NGW) {
        const int l = it / I_L; int r = it % I_L;
        if (r < I_IN) { transpose_item(F.in[3] + (size_t)l * D * NPROJ, D, NPROJ, F.in[2] + l * D, (bf16*)(F.ws + WS_WIN) + (size_t)l * NPROJ * D, D, 0, 0, scr, r, F.lane); continue; } r -= I_IN;
        if (r < I_OUT) { transpose_item(F.in[17] + (size_t)l * D * D, D, D, nullptr, (bf16*)(F.ws + WS_WOUT) + (size_t)l * D * D, D, 0, 0, scr, r, F.lane); continue; } r -= I_OUT;
        if (r < I_GU) { const int e = r / (2 * I_GU1), up = (r / I_GU1) & 1, item = r % I_GU1;
            transpose_item(F.in[up ? 24 : 23] + ((size_t)l * 16 + e) * D * 256, D, 256, F.in[18] + l * D, (bf16*)(F.ws + WS_GU) + ((size_t)l * 16 + e) * 512 * D, D, 0, 1 + up, scr, item, F.lane); continue; } r -= I_GU;
        { const int bk = r / (2 * I_WD1), half = (r / I_WD1) & 1, item = r % I_WD1, g = bk / 6; int ea, eb; pair_decode(bk % 6, ea, eb); const int e = g * 4 + (half ? eb : ea);
            transpose_item(F.in[25] + ((size_t)l * 16 + e) * 256 * D, 256, D, nullptr, (bf16*)(F.ws + WS_WD) + ((size_t)l * 24 + bk) * D * 512, 512, half * 256, 0, scr, item, F.lane); }
    }
}

__device__ __forceinline__ void ph_route(const Ctx& F0, int l) {
    const Ctx F = launder(F0);
    LAS float* Wl = (LAS float*)F.lds;
    LAS int* hist = (LAS int*)(F.lds + 1024 * 20 * 4);
    const float* g2 = F.in[18] + l * D;
    const f32x4* gw4 = (const f32x4*)(F.in[19] + (size_t)l * D * 4); const f32x4* rw4 = (const f32x4*)(F.in[21] + (size_t)l * 4 * D * 4);
    const float* gb_ = F.in[20] + l * 4; const float* rb_ = F.in[22] + l * 16;
    for (int idx = F.tid; idx < D * 5; idx += NTHREADS) { const int k = idx / 5, q = idx % 5;
        f32x4 v = (q == 0) ? gw4[k] : rw4[(q - 1) * D + k]; v = v * g2[k]; *(LAS f32x4*)(Wl + k * 20 + q * 4) = v; }
    if (F.tid < 32) hist[F.tid] = 0;
    __syncthreads();
    int* tokb = (int*)(F.ws + WS_TOKB); float* tokr = (float*)(F.ws + WS_TOKR); float* tokw = (float*)(F.ws + WS_TOKW);
    for (int i = 0; i < 16; ++i) {
        const int m = F.vcu * 128 + F.wave * 16 + i;
        const float* xr = F.R + (size_t)m * D + F.lane;
        float a[20]; float ss = 0.f;
#pragma unroll
        for (int j = 0; j < 20; ++j) a[j] = 0.f;
#pragma unroll 4
        for (int jj = 0; jj < 16; ++jj) { const float x = xr[64 * jj]; ss += x * x; const LAS f32x4* wp = (const LAS f32x4*)(Wl + (F.lane + 64 * jj) * 20);
#pragma unroll
            for (int q = 0; q < 5; ++q) { const f32x4 w = wp[q]; a[q * 4 + 0] += x * w[0]; a[q * 4 + 1] += x * w[1]; a[q * 4 + 2] += x * w[2]; a[q * 4 + 3] += x * w[3]; } }
        ss = wave_sum(ss);
#pragma unroll
        for (int j = 0; j < 20; ++j) a[j] = wave_sum(a[j]);
        const float rstd = 1.f / sqrtf(ss * (1.f / D) + RMS_EPS);
        float lg0 = a[0] * rstd + gb_[0], lg1 = a[1] * rstd + gb_[1], lg2 = a[2] * rstd + gb_[2], lg3 = a[3] * rstd + gb_[3];
        int gs = 0; float gm = lg0;
        if (lg1 > gm) { gm = lg1; gs = 1; } if (lg2 > gm) { gm = lg2; gs = 2; } if (lg3 > gm) { gm = lg3; gs = 3; }
        const float gwt = 1.f / (__expf(lg0 - gm) + __expf(lg1 - gm) + __expf(lg2 - gm) + __expf(lg3 - gm));
        float e0 = gs == 0 ? a[4] : gs == 1 ? a[8] : gs == 2 ? a[12] : a[16];
        float e1 = gs == 0 ? a[5] : gs == 1 ? a[9] : gs == 2 ? a[13] : a[17];
        float e2 = gs == 0 ? a[6] : gs == 1 ? a[10] : gs == 2 ? a[14] : a[18];
        float e3 = gs == 0 ? a[7] : gs == 1 ? a[11] : gs == 2 ? a[15] : a[19];
        e0 = e0 * rstd + rb_[gs * 4 + 0]; e1 = e1 * rstd + rb_[gs * 4 + 1]; e2 = e2 * rstd + rb_[gs * 4 + 2]; e3 = e3 * rstd + rb_[gs * 4 + 3];
        int t1 = 0; float v1 = e0;
        if (e1 > v1) { v1 = e1; t1 = 1; } if (e2 > v1) { v1 = e2; t1 = 2; } if (e3 > v1) { v1 = e3; t1 = 3; }
        int t2 = -1; float v2 = -3.0e38f;
        if (t1 != 0 && e0 > v2) { v2 = e0; t2 = 0; } if (t1 != 1 && e1 > v2) { v2 = e1; t2 = 1; } if (t1 != 2 && e2 > v2) { v2 = e2; t2 = 2; } if (t1 != 3 && e3 > v2) { v2 = e3; t2 = 3; }
        const float p2 = __expf(v2 - v1), w1 = gwt / (1.f + p2), w2 = gwt * p2 / (1.f + p2);
        const int lo = t1 < t2 ? t1 : t2, hi = t1 < t2 ? t2 : t1; const float wlo = t1 < t2 ? w1 : w2, whi = t1 < t2 ? w2 : w1;
        const int pi = lo == 0 ? hi - 1 : (lo == 1 ? hi + 1 : 5), bk = gs * 6 + pi;
        if (F.lane == 0) { tokb[m] = bk; tokr[m] = rstd; tokw[2 * m] = wlo; tokw[2 * m + 1] = whi; __hip_atomic_fetch_add(hist + bk, 1, __ATOMIC_RELAXED, __HIP_MEMORY_SCOPE_WORKGROUP); }
    }
    __syncthreads();
    if (F.tid < 24) ((int*)(F.ws + WS_WGCNT))[F.vcu * 24 + F.tid] = hist[F.tid];
}
__device__ __forceinline__ void ph_place(const Ctx& F0) {
    const Ctx F = launder(F0);
    LAS int* ptot = (LAS int*)F.lds;
    LAS int* pbef = ptot + 512;
    LAS int* bstart = pbef + 512;
    LAS int* btot = bstart + 32;
    LAS int* carry = btot + 32;
    LAS int* rowidx = carry + 32;
    const int* wgcnt = (const int*)(F.ws + WS_WGCNT);
    int* rowtok = (int*)(F.ws + WS_ROWTOK); float* roww = (float*)(F.ws + WS_ROWW); int* tileb = (int*)(F.ws + WS_TILEB);
    const int* tokb = (const int*)(F.ws + WS_TOKB); const float* tokr = (const float*)(F.ws + WS_TOKR); const float* tokw = (const float*)(F.ws + WS_TOKW);
    { const int p = F.tid >> 5, b = F.tid & 31; int tot = 0, bef = 0;
      if (b < 24) for (int v = p * 16; v < p * 16 + 16; ++v) { const int c = wgcnt[v * 24 + b]; tot += c; if (v < F.vcu) bef += c; }
      ptot[p * 32 + b] = tot; pbef[p * 32 + b] = bef; }
    __syncthreads();
    if (F.tid < 32) { int tot = 0, bef = 0; for (int p = 0; p < 16; ++p) { tot += ptot[p * 32 + F.tid]; bef += pbef[p * 32 + F.tid]; } btot[F.tid] = tot; carry[F.tid] = bef; }
    __syncthreads();
    if (F.tid == 0) { int s = 0; for (int b = 0; b < 24; ++b) { bstart[b] = s; s += (btot[b] + 255) & ~255; } bstart[24] = s; }
    __syncthreads();
    if (F.tid < 24) carry[F.tid] += bstart[F.tid];
    if (F.vcu == 0) {
        if (F.tid == 0) tileb[0] = bstart[24] >> 8;
        for (int b = 0; b < 24; ++b) { const int s = bstart[b], e = bstart[b + 1];
            for (int t = (s >> 8) + F.tid; t < (e >> 8); t += NTHREADS) tileb[1 + t] = b;
            for (int r = s + btot[b] + F.tid; r < e; r += NTHREADS) rowtok[r] = -1; }
    }
    __syncthreads();
    if (F.wave == 0) {
        for (int pass = 0; pass < 2; ++pass) { const int i = pass * 64 + F.lane, bi = tokb[F.vcu * 128 + i]; int row = 0;
            for (int b = 0; b < 24; ++b) { const unsigned long long mask = __ballot(bi == b); const int c = carry[b];
                if (bi == b) row = c + __builtin_popcountll(mask & ((1ull << F.lane) - 1ull));
                asm volatile("s_waitcnt lgkmcnt(0)" ::: "memory");
                if (F.lane == 0) carry[b] = c + __builtin_popcountll(mask);
                asm volatile("s_waitcnt lgkmcnt(0)" ::: "memory"); }
            rowidx[i] = row; }
    }
    __syncthreads();
    bf16* XS = (bf16*)(F.ws + WS_XS);
    for (int i = 0; i < 16; ++i) {
        const int li = F.wave * 16 + i, m = F.vcu * 128 + li, row = rowidx[li]; const float rstd = tokr[m];
        if (F.lane == 0) { rowtok[row] = m; roww[2 * row] = tokw[2 * m]; roww[2 * row + 1] = tokw[2 * m + 1]; }
        const f32x4* xr = (const f32x4*)(F.R + (size_t)m * D) + F.lane;
        unsigned long long* o8 = (unsigned long long*)(XS + (size_t)row * D) + F.lane;
#pragma unroll
        for (int j = 0; j < 4; ++j) { const f32x4 v = xr[64 * j] * rstd; o8[64 * j] = (unsigned long long)pk2(v.x, v.y) | ((unsigned long long)pk2(v.z, v.w) << 32); }
    }
}
struct MoeOrder {
    const int* tileb; int G, c; bool down;
    __device__ __forceinline__ bool next(int i, pg8::Unit& u) const {
        const int NT = tileb[0], L = i * G + c; if (L >= NT * 4) return false;
        const int rt = L >> 2, pn = L & 3, b = tileb[1 + rt];
        if (down) { u.pm = rt; u.pn = b * 4 + pn; u.aux = pn; }
        else { int ea, eb; pair_decode(b % 6, ea, eb); const int e = (b / 6) * 4 + (pn < 2 ? ea : eb); u.pm = rt; u.pn = e * 2 + (pn & 1); u.aux = pn; }
        return true;
    }
};
struct EpiGU {
    static constexpr bool PERM = true;
    bf16* H; const float* roww;
    __device__ __forceinline__ void operator()(const f32x4 (&acc)[2][2][4][2], const pg8::Unit& u, int wr, int wc, int fr, int fq) const {
        const int row0 = u.pm * 256 + wr * 64 + fr, cl = u.aux * 128 + 16 * wc + 4 * fq, ws = u.aux >> 1;
#pragma unroll
        for (int ai = 0; ai < 2; ++ai)
#pragma unroll
            for (int m = 0; m < 4; ++m) { const int r = row0 + ai * 128 + m * 16; const float w = roww[2 * r + ws];
#pragma unroll
                for (int bj = 0; bj < 2; ++bj) { const f32x4 g = acc[ai][bj][m][0], up = acc[ai][bj][m][1]; f32x4 a;
#pragma unroll
                    for (int i = 0; i < 4; ++i) a[i] = g[i] * sigmoidf_(g[i]) * up[i] * w;
                    u32x2 o; o.x = pg8::cvt_pk_bf16(a[0], a[1]); o.y = pg8::cvt_pk_bf16(a[2], a[3]);
                    *(u32x2*)(H + (size_t)r * 512 + cl + bj * 64) = o; } }
    }
};
struct EpiDown {
    static constexpr bool PERM = false;
    float* R; const int* rowtok;
    __device__ __forceinline__ void operator()(const f32x4 (&acc)[2][2][4][2], const pg8::Unit& u, int wr, int wc, int fr, int fq) const {
        const int row0 = u.pm * 256 + wr * 64 + fr, col0 = u.aux * 256 + wc * 32 + 4 * fq;
#pragma unroll
        for (int ai = 0; ai < 2; ++ai)
#pragma unroll
            for (int m = 0; m < 4; ++m) { const int tok = rowtok[row0 + ai * 128 + m * 16];
                if (tok >= 0) { float* rp = R + (size_t)tok * D + col0;
#pragma unroll
                    for (int bj = 0; bj < 2; ++bj)
#pragma unroll
                        for (int n = 0; n < 2; ++n) { float* p = rp + bj * 128 + n * 16; *(f32x4*)p = *(const f32x4*)p + acc[ai][bj][m][n]; } }
                if (m & 1) asm volatile("" ::: "memory"); }
    }
};

template <class Epi>
__device__ __forceinline__ void naive_gemm(const Ctx& F0, const bf16* A, int lda, const float* Bw, int ldb, const float* kscale, int M, int N, int K, const Epi& epi) {
    const Ctx F = launder(F0);
    LAS float* As = (LAS float*)F.lds;
    LAS float* Bs = As + 16 * 132;
    const int tid = F.tid, ty = tid >> 4, tx = tid & 15;
    const int tm = M / 128, tn = N / 128;
    for (int tile = F.vcu; tile < tm * tn; tile += F.G) {
        const int m0 = (tile / tn) * 128, n0 = (tile % tn) * 128;
        float acc[4][8];
#pragma unroll
        for (int i = 0; i < 4; ++i)
#pragma unroll
            for (int j = 0; j < 8; ++j) acc[i][j] = 0.f;
        for (int k0 = 0; k0 < K; k0 += 16) {
            {
                const int row = tid >> 2, kq = (tid & 3) * 4;
                const u32x2 v = *(const u32x2*)(A + (size_t)(m0 + row) * lda + k0 + kq);
                As[(kq + 0) * 132 + row] = bf2f(v.x & 0xffffu); As[(kq + 1) * 132 + row] = bf2f(v.x >> 16);
                As[(kq + 2) * 132 + row] = bf2f(v.y & 0xffffu); As[(kq + 3) * 132 + row] = bf2f(v.y >> 16);
                const int kk = tid >> 5, nq = (tid & 31) * 4;
                f32x4 b = *(const f32x4*)(Bw + (size_t)(k0 + kk) * ldb + n0 + nq);
                const float s = kscale ? kscale[k0 + kk] : 1.f;
                b = b * s;
                *(LAS f32x4*)(Bs + kk * 128 + nq) = b;
            }
            __syncthreads();
#pragma unroll
            for (int kk = 0; kk < 16; ++kk) {
                const f32x4 a = *(const LAS f32x4*)(As + kk * 132 + ty * 4);
                const f32x4 b0 = *(const LAS f32x4*)(Bs + kk * 128 + tx * 8);
                const f32x4 b1 = *(const LAS f32x4*)(Bs + kk * 128 + tx * 8 + 4);
#pragma unroll
                for (int i = 0; i < 4; ++i) {
#pragma unroll
                    for (int j = 0; j < 4; ++j) { acc[i][j] += a[i] * b0[j]; acc[i][4 + j] += a[i] * b1[j]; }
                }
            }
            __syncthreads();
        }
#pragma unroll
        for (int i = 0; i < 4; ++i)
#pragma unroll
            for (int j = 0; j < 8; ++j) epi(m0 + ty * 4 + i, n0 + tx * 8 + j, acc[i][j]);
    }
}

struct EpiProj { Ctx F; __device__ __forceinline__ void operator()(int m, int n, float v) const { store_proj(F, m, n, v); } };
struct EpiGlu { bf16* ys; bf16* ymix; const float* gb;
    __device__ __forceinline__ void operator()(int m, int n, float v) const { const float y = bf2f(ys[(size_t)m * 256 + n]); ymix[(size_t)m * 1024 + n] = (bf16)f2bf(y * sigmoidf_(v + gb[n])); } };
struct EpiOut { const float* xin; float* R;
    __device__ __forceinline__ void operator()(int m, int n, float v) const { const size_t o = (size_t)m * D + n; R[o] = xin[o] + v; } };

__device__ __forceinline__ void ph_norm(const Ctx& F0, const float* xin) {
    const Ctx F = launder(F0);
    const int gw = F.vcu * NWAVES + F.wave, NGW = F.G * NWAVES;
    for (int m = gw; m < T; m += NGW) {
        const f32x4* xr = (const f32x4*)(xin + (size_t)m * D) + F.lane;
        f32x4 v[4]; float s = 0.f;
#pragma unroll
        for (int j = 0; j < 4; ++j) { v[j] = xr[64 * j]; s += (v[j].x * v[j].x + v[j].y * v[j].y) + (v[j].z * v[j].z + v[j].w * v[j].w); }
        const float rstd = 1.f / sqrtf(wave_sum(s) * (1.f / D) + RMS_EPS);
        unsigned long long* o8 = (unsigned long long*)(P_XB(F) + (size_t)m * D) + F.lane;
#pragma unroll
        for (int j = 0; j < 4; ++j) o8[64 * j] = (unsigned long long)pk2(v[j].x * rstd, v[j].y * rstd) | ((unsigned long long)pk2(v[j].z * rstd, v[j].w * rstd) << 32);
    }
}

__device__ __forceinline__ void ph_bias_table(const Ctx& F0) {
    const Ctx F = launder(F0);
    if (F.vcu == 0) {
        const float* rel_bias = F.in[1];
        for (int i = F.tid; i < 8 * 132; i += NTHREADS) {
            const int h = i / 132, r = i % 132;
            int bk;
            if (r < 16) bk = r;
            else { bk = 16 + (int)(logf((float)r / 16.f) / logf(8.f) * 16.f); if (bk > 31) bk = 31; }
            P_BT(F)[i] = rel_bias[bk * 8 + h] * LOG2E;
        }
    }
}

__device__ __forceinline__ void ph_kmean_naive(const Ctx& F0) {
    const Ctx F = launder(F0);
    const int gt = F.vcu * NTHREADS + F.tid, NGT = F.G * NTHREADS;
    for (int i = gt; i < 128 * 512; i += NGT) {
        const int pm = i >> 9, c = i & 511; float s = 0.f;
        for (int r = 0; r < 256; ++r) s += bf2f(P_KB(F)[(size_t)(pm * 256 + r) * 512 + c]);
        P_KMP(F)[i] = s; P_KMP(F)[128 * 512 + i] = 0.f;
    }
}

__device__ __forceinline__ void ph_ssm_naive(const Ctx& F0, int l) {
    const Ctx F = launder(F0);
    const int gw = F.vcu * NWAVES + F.wave, NGW = F.G * NWAVES;
    for (int it = gw; it < NB * SGN; it += NGW) {
        const int b = it / SGN, g = it % SGN, p = F.lane;
        const float are = F.in[4][(l * SGN + g) * SP + p], aim = F.in[5][(l * SGN + g) * SP + p];
        const float dt = __expf(F.in[6][l * SGN + g]);
        const float mag = expf(are * dt); float sn, cs; sincosf(aim * dt, &sn, &cs);
        const float lbr = mag * cs, lbi = mag * sn;
        const float nr = lbr - 1.f, ni = lbi, den = are * are + aim * aim;
        const float cr = (nr * are + ni * aim) / den, ci = (ni * are - nr * aim) / den;
        float bbr[16], bbi[16], ccr[16], cci[16];
#pragma unroll
        for (int h = 0; h < 16; ++h) {
            const float br = F.in[7][((size_t)(l * SGN + g) * SP + p) * SG + h], bi = F.in[8][((size_t)(l * SGN + g) * SP + p) * SG + h];
            bbr[h] = cr * br - ci * bi; bbi[h] = cr * bi + ci * br;
            ccr[h] = F.in[9][((size_t)(l * SGN + g) * SG + h) * SP + p]; cci[h] = F.in[10][((size_t)(l * SGN + g) * SG + h) * SP + p];
        }
        const float dh = (F.lane < 16) ? F.in[11][l * 256 + g * 16 + F.lane] : 0.f;
        float sr = 0.f, si = 0.f;
        for (int t = 0; t < SEQ; ++t) {
            const int m = b * SEQ + t;
            const bf16* up = P_UG(F) + ((size_t)(g * 512 + (m >> 6))) * UGP + (m & 63) * 16;
            const u32x4 u0 = *(const u32x4*)up, u1 = *(const u32x4*)(up + 8);
            float u[16];
            u[0] = bf2f(u0.x & 0xffffu); u[1] = bf2f(u0.x >> 16); u[2] = bf2f(u0.y & 0xffffu); u[3] = bf2f(u0.y >> 16);
            u[4] = bf2f(u0.z & 0xffffu); u[5] = bf2f(u0.z >> 16); u[6] = bf2f(u0.w & 0xffffu); u[7] = bf2f(u0.w >> 16);
            u[8] = bf2f(u1.x & 0xffffu); u[9] = bf2f(u1.x >> 16); u[10] = bf2f(u1.y & 0xffffu); u[11] = bf2f(u1.y >> 16);
            u[12] = bf2f(u1.z & 0xffffu); u[13] = bf2f(u1.z >> 16); u[14] = bf2f(u1.w & 0xffffu); u[15] = bf2f(u1.w >> 16);
            float bur = 0.f, bui = 0.f;
#pragma unroll
            for (int h = 0; h < 16; ++h) { bur += bbr[h] * u[h]; bui += bbi[h] * u[h]; }
            const float nsr = lbr * sr - lbi * si + bur, nsi = lbr * si + lbi * sr + bui;
            sr = nsr; si = nsi;
            float yo = 0.f, uo = 0.f;
#pragma unroll
            for (int h = 0; h < 16; ++h) {
                const float y = wave_sum(ccr[h] * sr - cci[h] * si);
                if (F.lane == h) { yo = y; uo = u[h]; }
            }
            if (F.lane < 16) P_YS(F)[(size_t)m * 256 + g * 16 + F.lane] = (bf16)f2bf(gelu_tanh(yo + dh * uo));
        }
    }
}

__device__ __forceinline__ void ph_pool_dl(const Ctx& F0) {
    const Ctx F = launder(F0);
    const int gt = F.vcu * NTHREADS + F.tid, NGT = F.G * NTHREADS;
    for (int i = gt; i < T * 256; i += NGT) {
        const int m = i >> 8, c = i & 255, t = m & (SEQ - 1), gi = c >> 6, win = 2 << gi;
        const int cnt = (t + 1 < win) ? t + 1 : win;
        float s = 0.f;
        for (int j = 0; j < cnt; ++j) s += bf2f(P_PB(F)[(size_t)(m - j) * 256 + c]);
        P_DL(F)[i] = (bf16)f2bf(s / (float)cnt - bf2f(P_PB(F)[i]));
    }
}
__device__ __forceinline__ void ph_pool_mm_naive(const Ctx& F0, int l) {
    const Ctx F = launder(F0);
    const int gt = F.vcu * NTHREADS + F.tid, NGT = F.G * NTHREADS;
    const float* w = F.in[14] + (size_t)l * 4 * 64 * 64;
    for (int i = gt; i < T * 256; i += NGT) {
        const int m = i >> 8, n = i & 255, gi = n >> 6, d = n & 63; float s = 0.f;
        for (int c = 0; c < 64; ++c) s += bf2f(P_DL(F)[(size_t)m * 256 + gi * 64 + c]) * w[(gi * 64 + c) * 64 + d];
        P_YMIX(F)[(size_t)m * 1024 + 256 + n] = (bf16)f2bf((s + F.in[15][l * 256 + n]) * F.in[16][l * 256 + n]);
    }
}

__device__ __forceinline__ void ph_attn_naive(const Ctx& F0) {
    const Ctx F = launder(F0);
    const int gw = F.vcu * NWAVES + F.wave, NGW = F.G * NWAVES, lane = F.lane;
    for (int it = gw; it < T * NHEAD; it += NGW) {
        const int h = it & 7, m = it >> 3, b = m >> 12, q = m & (SEQ - 1), qblk = q >> 8;
        const float qv = bf2f(P_QB(F)[(size_t)m * 512 + h * 64 + lane]);
        float mygate = -3.0e38f;
        for (int j = 0; j < qblk; ++j) {
            const int pm = b * NBLK + j;
            const float km = P_KMP(F)[pm * 512 + h * 64 + lane] + P_KMP(F)[128 * 512 + pm * 512 + h * 64 + lane];
            const float g = wave_sum(qv * km);
            if (lane == j) mygate = g;
        }
        int bsel0 = -1, bsel1 = -1, bsel2 = -1;
        const int nsel = qblk < 3 ? qblk : 3;
        for (int s = 0; s < nsel; ++s) {
            const float bv = wave_max(mygate);
            const unsigned long long bal = __ballot(mygate == bv);
            const int best = __builtin_ctzll(bal);
            if (s == 0) bsel0 = best; else if (s == 1) bsel1 = best; else bsel2 = best;
            if (lane == best) mygate = -3.0e38f;
        }
        float sc[16];
        float mx = -3.0e38f;
#pragma unroll
        for (int s = 0; s < 4; ++s) {
            const int blk = (s == 0) ? bsel0 : (s == 1) ? bsel1 : (s == 2) ? bsel2 : qblk;
#pragma unroll
            for (int c = 0; c < 4; ++c) {
                float v = -3.0e38f;
                if (blk >= 0) {
                    const int kpos = blk * 256 + c * 64 + lane, rel = q - kpos;
                    const bf16* kr = P_KB(F) + (size_t)(b * SEQ + kpos) * 512 + h * 64;
                    float dot = 0.f;
#pragma unroll
                    for (int d8 = 0; d8 < 8; ++d8) {
                        const u32x4 kk = *(const u32x4*)(kr + d8 * 8);
                        dot += __builtin_bit_cast(float, __builtin_amdgcn_readlane(__builtin_bit_cast(int, qv), d8 * 8 + 0)) * bf2f(kk.x & 0xffffu) + __builtin_bit_cast(float, __builtin_amdgcn_readlane(__builtin_bit_cast(int, qv), d8 * 8 + 1)) * bf2f(kk.x >> 16);
                        dot += __builtin_bit_cast(float, __builtin_amdgcn_readlane(__builtin_bit_cast(int, qv), d8 * 8 + 2)) * bf2f(kk.y & 0xffffu) + __builtin_bit_cast(float, __builtin_amdgcn_readlane(__builtin_bit_cast(int, qv), d8 * 8 + 3)) * bf2f(kk.y >> 16);
                        dot += __builtin_bit_cast(float, __builtin_amdgcn_readlane(__builtin_bit_cast(int, qv), d8 * 8 + 4)) * bf2f(kk.z & 0xffffu) + __builtin_bit_cast(float, __builtin_amdgcn_readlane(__builtin_bit_cast(int, qv), d8 * 8 + 5)) * bf2f(kk.z >> 16);
                        dot += __builtin_bit_cast(float, __builtin_amdgcn_readlane(__builtin_bit_cast(int, qv), d8 * 8 + 6)) * bf2f(kk.w & 0xffffu) + __builtin_bit_cast(float, __builtin_amdgcn_readlane(__builtin_bit_cast(int, qv), d8 * 8 + 7)) * bf2f(kk.w >> 16);
                    }
                    if (rel >= 0) v = dot + P_BT(F)[h * 132 + (rel < 128 ? rel : 128)];
                }
                sc[s * 4 + c] = v; mx = fmaxf(mx, v);
            }
        }
        mx = wave_max(mx);
        float sum = 0.f;
#pragma unroll
        for (int i = 0; i < 16; ++i) { sc[i] = (sc[i] > -1.0e38f) ? exp2f(sc[i] - mx) : 0.f; sum += sc[i]; }
        sum = wave_sum(sum);
        float o = 0.f;
#pragma unroll
        for (int s = 0; s < 4; ++s) {
            const int blk = (s == 0) ? bsel0 : (s == 1) ? bsel1 : (s == 2) ? bsel2 : qblk;
            if (blk >= 0) {
#pragma unroll
                for (int c = 0; c < 4; ++c) {
                    const bf16* vr = P_VB(F) + (size_t)(b * SEQ + blk * 256 + c * 64) * 512 + h * 64 + lane;
                    const float pc = sc[s * 4 + c];
                    for (int kk = 0; kk < 64; ++kk) {
                        const float p = __builtin_bit_cast(float, __builtin_amdgcn_readlane(__builtin_bit_cast(int, pc), kk));
                        o += p * bf2f(vr[(size_t)kk * 512]);
                    }
                }
            }
        }
        P_YMIX(F)[(size_t)m * 1024 + 512 + h * 64 + lane] = (bf16)f2bf(o / sum);
    }
}

__device__ __forceinline__ void ph_moe_naive(const Ctx& F0, int l) {
    const Ctx F = launder(F0);
    LAS float* h2 = (LAS float*)F.lds;
    LAS float* act = h2 + 1024;
    LAS float* red = act + 512;
    LAS float* lg = red + 32;
    LAS float* selw = lg + 24;
    const float* g2 = F.in[18] + l * D;
    const float* gw_ = F.in[19] + (size_t)l * D * 4; const float* gb_ = F.in[20] + l * 4;
    const float* rw_ = F.in[21] + (size_t)l * 4 * D * 4; const float* rb_ = F.in[22] + l * 16;
    const float* wg = F.in[23] + (size_t)l * 16 * D * 256; const float* wu = F.in[24] + (size_t)l * 16 * D * 256; const float* wd = F.in[25] + (size_t)l * 16 * 256 * D;
    const int tid = F.tid, lane = F.lane, wave = F.wave;
    for (int m = F.vcu; m < T; m += F.G) {
        float* xr = F.R + (size_t)m * D;
        const float x0 = xr[tid], x1 = xr[tid + 512];
        float s = wave_sum(x0 * x0 + x1 * x1);
        if (lane == 0) red[wave] = s;
        __syncthreads();
        float tot = 0.f;
#pragma unroll
        for (int w = 0; w < 8; ++w) tot += red[w];
        const float rstd = 1.f / sqrtf(tot * (1.f / D) + RMS_EPS);
        h2[tid] = x0 * rstd * g2[tid]; h2[tid + 512] = x1 * rstd * g2[tid + 512];
        __syncthreads();
        for (int j = wave; j < 20; j += NWAVES) {
            float a = 0.f;
            if (j < 4) { for (int k = lane; k < D; k += 64) a += h2[k] * gw_[k * 4 + j]; }
            else { const int g = (j - 4) >> 2, e = (j - 4) & 3; for (int k = lane; k < D; k += 64) a += h2[k] * rw_[((size_t)g * D + k) * 4 + e]; }
            a = wave_sum(a);
            if (lane == 0) lg[j] = a + (j < 4 ? gb_[j] : rb_[j - 4]);
        }
        __syncthreads();
        if (tid == 0) {
            int gs = 0; float gm = lg[0];
            for (int j = 1; j < 4; ++j) if (lg[j] > gm) { gm = lg[j]; gs = j; }
            float se = 0.f; for (int j = 0; j < 4; ++j) se += __expf(lg[j] - gm);
            const float gwt = 1.f / se;
            int e1 = 0; float v1 = lg[4 + gs * 4];
            for (int e = 1; e < 4; ++e) if (lg[4 + gs * 4 + e] > v1) { v1 = lg[4 + gs * 4 + e]; e1 = e; }
            int e2 = -1; float v2 = -3.0e38f;
            for (int e = 0; e < 4; ++e) if (e != e1 && lg[4 + gs * 4 + e] > v2) { v2 = lg[4 + gs * 4 + e]; e2 = e; }
            const float p2 = __expf(v2 - v1), w1 = 1.f / (1.f + p2), w2 = p2 / (1.f + p2);
            selw[0] = __builtin_bit_cast(float, gs * 4 + e1); selw[1] = __builtin_bit_cast(float, gs * 4 + e2);
            selw[2] = gwt * w1; selw[3] = gwt * w2;
        }
        __syncthreads();
        {
            const int slot = tid >> 8, f = tid & 255;
            const int e = __builtin_bit_cast(int, selw[slot]); const float cw = selw[2 + slot];
            const float* pg = wg + (size_t)e * D * 256 + f; const float* pu = wu + (size_t)e * D * 256 + f;
            float ag = 0.f, au = 0.f;
            for (int k = 0; k < D; ++k) { const float hv = h2[k]; ag += hv * pg[(size_t)k * 256]; au += hv * pu[(size_t)k * 256]; }
            act[slot * 256 + f] = ag * sigmoidf_(ag) * au * cw;
        }
        __syncthreads();
        {
            const int ea = __builtin_bit_cast(int, selw[0]), eb = __builtin_bit_cast(int, selw[1]);
            const float* pa = wd + (size_t)ea * 256 * D; const float* pb = wd + (size_t)eb * 256 * D;
            float y0 = 0.f, y1 = 0.f;
            for (int f = 0; f < 256; ++f) {
                const float a = act[f], b = act[256 + f];
                y0 += a * pa[(size_t)f * D + tid] + b * pb[(size_t)f * D + tid];
                y1 += a * pa[(size_t)f * D + tid + 512] + b * pb[(size_t)f * D + tid + 512];
            }
            xr[tid] = x0 + y0; xr[tid + 512] = x1 + y1;
        }
        __syncthreads();
    }
}

__device__ __forceinline__ void ph_final(const Ctx& F0) {
    const Ctx F = launder(F0);
    const int gw = F.vcu * NWAVES + F.wave, NGW = F.G * NWAVES;
    const f32x4* gf = (const f32x4*)F.in[26] + F.lane;
    for (int m = gw; m < T; m += NGW) {
        f32x4* xr = (f32x4*)(F.R + (size_t)m * D) + F.lane;
        f32x4 v[4]; float s = 0.f;
#pragma unroll
        for (int j = 0; j < 4; ++j) { v[j] = xr[64 * j]; s += (v[j].x * v[j].x + v[j].y * v[j].y) + (v[j].z * v[j].z + v[j].w * v[j].w); }
        const float rstd = 1.f / sqrtf(wave_sum(s) * (1.f / D) + RMS_EPS);
#pragma unroll
        for (int j = 0; j < 4; ++j) xr[64 * j] = v[j] * rstd * gf[64 * j];
    }
}

constexpr int LDS_BYTES = 147456;
constexpr int MISC_OFF = 131072 + 320;

__global__ void __launch_bounds__(NTHREADS, 2) mk_fwd(Args args) {
    extern __shared__ __attribute__((aligned(16))) unsigned char lds[];
    Ctx F;
    F.lds = (LAS unsigned char*)lds;
    F.tid = threadIdx.x; F.lane = F.tid & 63; F.wave = __builtin_amdgcn_readfirstlane(F.tid >> 6);
    F.G = gridDim.x; { const int bx = blockIdx.x; F.vcu = (F.G % 8 == 0) ? (bx % 8) * (F.G / 8) + bx / 8 : bx; }
    F.in = args.in; F.R = args.out; F.ws = args.ws;
    unsigned char* ws = args.ws;
    volatile LAS unsigned* MISC = (volatile LAS unsigned*)(F.lds + MISC_OFF);
    for (int u = F.tid; u < 64; u += NTHREADS) MISC[u] = 0u;
    __syncthreads();
    XcdBarrier bar = xcd_barrier_post((unsigned*)(ws + WS_CTL) + CW_BAR, MISC + 8);
#define GRID_BAR() xcd_barrier(bar)

    ph_bias_table(F);
#if USE_ENG_PROJ
    ph_prologue(F);
#endif
#pragma unroll 1
    for (int l = 0; l < DEPTH; ++l) {
        const float* xin = (l == 0) ? F.in[0] : F.R;
        ph_norm(F, xin);
        GRID_BAR();
#if USE_ENG_PROJ
        { pg8::Gemm g{P_XB(F), (const bf16*)(ws + WS_WIN) + (size_t)l * NPROJ * D, D, D, D}; pg8::StaticOrder S; S.init(T, NPROJ, F.G, (int)blockIdx.x);
          EpiProjE E{P_UG(F), P_PB(F), P_QB(F), P_KB(F), P_VB(F), P_KMP(F)}; pg8::gemm_phase(F.lds, g, S, E); }
#else
        { EpiProj E{F}; naive_gemm(F, P_XB(F), D, F.in[3] + (size_t)l * D * NPROJ, NPROJ, F.in[2] + l * D, T, NPROJ, D, E); }
#endif
        GRID_BAR();
        ph_ssm_naive(F, l);
#if !USE_ENG_PROJ
        ph_kmean_naive(F);
#endif
        ph_pool_dl(F);
        GRID_BAR();
        { EpiGlu E{P_YS(F), P_YMIX(F), F.in[13] + l * 256}; naive_gemm(F, P_YS(F), 256, F.in[12] + (size_t)l * 256 * 256, 256, nullptr, T, 256, 256, E); }
        ph_pool_mm_naive(F, l);
        ph_attn_naive(F);
        GRID_BAR();
#if USE_ENG_PROJ
        { pg8::Gemm g{P_YMIX(F), (const bf16*)(ws + WS_WOUT) + (size_t)l * D * D, D, D, D}; pg8::StaticOrder S; S.init(T, D, F.G, (int)blockIdx.x);
          EpiOutE E{xin, F.R}; pg8::gemm_phase(F.lds, g, S, E); }
#else
        { EpiOut E{xin, F.R}; naive_gemm(F, P_YMIX(F), D, F.in[17] + (size_t)l * D * D, D, nullptr, T, D, D, E); }
#endif
        GRID_BAR();
#if USE_ENG_MOE
        ph_route(F, l);
        GRID_BAR();
        ph_place(F);
        GRID_BAR();
        { pg8::Gemm g{(const bf16*)(ws + WS_XS), (const bf16*)(ws + WS_GU) + (size_t)l * 16 * 512 * D, D, D, D}; MoeOrder S{(const int*)(ws + WS_TILEB), F.G, (int)blockIdx.x, false};
          EpiGU E{(bf16*)(ws + WS_HACT), (const float*)(ws + WS_ROWW)}; pg8::gemm_phase(F.lds, g, S, E); }
        GRID_BAR();
        { pg8::Gemm g{(const bf16*)(ws + WS_HACT), (const bf16*)(ws + WS_WD) + (size_t)l * 24 * D * 512, 512, 512, 512}; MoeOrder S{(const int*)(ws + WS_TILEB), F.G, (int)blockIdx.x, true};
          EpiDown E{F.R, (const int*)(ws + WS_ROWTOK)}; pg8::gemm_phase(F.lds, g, S, E); }
        GRID_BAR();
#else
        ph_moe_naive(F, l);
        GRID_BAR();
#endif
    }
    ph_final(F);
}

extern "C" void kernel_launch(void* const* d_in, const int* in_sizes, int n_in, void* d_out, int out_size, void* d_ws, size_t ws_size, hipStream_t stream) {
    static int grid = 0;
    if (grid == 0) {
        if (n_in != 27 || out_size != T * D || ws_size < WS_END) { fprintf(stderr, "kernel_launch: unexpected shapes (n_in %d out %d ws %zu)\n", n_in, out_size, ws_size); grid = -1; return; }
        int dev = 0, cus = 0, per_cu = 0;
        if (hipGetDevice(&dev) != hipSuccess || hipDeviceGetAttribute(&cus, hipDeviceAttributeMultiprocessorCount, dev) != hipSuccess) { grid = -1; return; }
        if (hipFuncSetAttribute((const void*)mk_fwd, hipFuncAttributeMaxDynamicSharedMemorySize, LDS_BYTES) != hipSuccess) { fprintf(stderr, "kernel_launch: hipFuncSetAttribute failed\n"); grid = -1; return; }
        if (hipOccupancyMaxActiveBlocksPerMultiprocessor(&per_cu, (const void*)mk_fwd, NTHREADS, LDS_BYTES) != hipSuccess || per_cu < 1) { fprintf(stderr, "kernel_launch: occupancy query says %d\n", per_cu); per_cu = 1; }
        (void)hipGetLastError();
        grid = cus;
    }
    if (grid < 0) return;
    (void)hipMemsetAsync((char*)d_ws + WS_CTL, 0, CTL_ZERO_BYTES, stream);
    Args a{};
    for (int i = 0; i < 27; ++i) a.in[i] = (const float*)d_in[i];
    a.out = (float*)d_out; a.ws = (unsigned char*)d_ws; a.ph_lo = 0; a.ph_hi = 0;
    hipLaunchKernelGGL(mk_fwd, dim3(grid), dim3(NTHREADS), LDS_BYTES, stream, a);
}
```

```cpp
#include <hip/hip_runtime.h>
#include <hip/hip_bf16.h>
#include <cstdio>
#include <cstdint>

#define GAS __attribute__((address_space(1)))
#define LAS __attribute__((address_space(3)))
typedef unsigned short bf16;
typedef float f32x4 __attribute__((ext_vector_type(4)));
typedef unsigned u32x4 __attribute__((ext_vector_type(4)));
typedef unsigned u32x2 __attribute__((ext_vector_type(2)));

constexpr int NB = 8, SEQ = 4096, T = NB * SEQ, D = 1024, NPROJ = 2048, DEPTH = 2;
constexpr int NHEAD = 8, HD = 64, MBLK = 256, NBLK = SEQ / MBLK;
constexpr int SG = 16, SGN = 16, SP = 64, SCH = 64, UGP = 1152;
constexpr float RMS_EPS = 1e-6f;
constexpr float LOG2E = 1.4426950408889634f;
constexpr float C2 = 0.125f * LOG2E;
constexpr int NWAVES = 8, NTHREADS = 512;
#ifndef USE_ENG_PROJ
#define USE_ENG_PROJ 1
#endif
#ifndef USE_ENG_SSM
#define USE_ENG_SSM 0
#endif
#ifndef USE_FAST_ATTN
#define USE_FAST_ATTN 2
#endif
#ifndef USE_ENG_MOE
#define USE_ENG_MOE 1
#endif

constexpr size_t MiB = 1u << 20;
constexpr size_t WS_CTL = 0, CTL_ZERO_BYTES = 1 * MiB;
constexpr size_t WS_XB = 2 * MiB;
constexpr size_t WS_UG = 66 * MiB;
constexpr size_t WS_PB = 84 * MiB;
constexpr size_t WS_QB = 100 * MiB;
constexpr size_t WS_KB = 132 * MiB;
constexpr size_t WS_VB = 164 * MiB;
constexpr size_t WS_YMIX = 196 * MiB;
constexpr size_t WS_YS = 260 * MiB;
constexpr size_t WS_DL = 276 * MiB;
constexpr size_t WS_KMP = 292 * MiB;
constexpr size_t WS_BT = 293 * MiB;
constexpr size_t WS_WIN = 300 * MiB;
constexpr size_t WS_WOUT = 308 * MiB;
constexpr size_t WS_GU = 312 * MiB;
constexpr size_t WS_WD = 344 * MiB;
constexpr size_t WS_TG = 392 * MiB;
constexpr size_t WS_BZ = 464 * MiB;
constexpr size_t WS_GLUT = 480 * MiB;
constexpr size_t WS_POOLT = WS_GLUT + 512 * 1024;
constexpr size_t WS_ZB = 482 * MiB;
constexpr size_t WS_END = 486 * MiB;
constexpr int MOE_MAXT = 152;
constexpr size_t WS_XS = 66 * MiB;
constexpr size_t WS_HACT = 142 * MiB;
constexpr size_t WS_TOKB = 294 * MiB;
constexpr size_t WS_TOKR = WS_TOKB + 128 * 1024;
constexpr size_t WS_TOKW = WS_TOKB + 256 * 1024;
constexpr size_t WS_ROWTOK = 295 * MiB;
constexpr size_t WS_ROWW = WS_ROWTOK + 256 * 1024;
constexpr size_t WS_WGCNT = 296 * MiB;
constexpr size_t WS_TILEB = WS_WGCNT + 64 * 1024;

constexpr int CW_BAR = 4096;

__device__ __forceinline__ unsigned f2bf(float f) { unsigned u = __builtin_bit_cast(unsigned, f); return (u + 0x7fffu + ((u >> 16) & 1u)) >> 16; }
__device__ __forceinline__ float bf2f(unsigned h) { return __builtin_bit_cast(float, h << 16); }
__device__ __forceinline__ unsigned pk2(float lo, float hi) { return f2bf(lo) | (f2bf(hi) << 16); }
template <int O> __device__ __forceinline__ float xshfl(float v) {
    if constexpr (O < 32) return __builtin_bit_cast(float, __builtin_amdgcn_ds_swizzle(__builtin_bit_cast(int, v), (O << 10) | 0x1f));
    else { const unsigned u = __builtin_bit_cast(unsigned, v); auto r = __builtin_amdgcn_permlane32_swap(u, u, false, false);
           const float a = __builtin_bit_cast(float, (unsigned)r[0]), b = __builtin_bit_cast(float, (unsigned)r[1]); return (a == v && __builtin_bit_cast(unsigned, a) == u) ? b : a; }
}
__device__ __forceinline__ float wave_sum(float v) {
    v += xshfl<1>(v); v += xshfl<2>(v); v += xshfl<4>(v); v += xshfl<8>(v); v += xshfl<16>(v);
    const unsigned u = __builtin_bit_cast(unsigned, v); auto r = __builtin_amdgcn_permlane32_swap(u, u, false, false);
    return __builtin_bit_cast(float, (unsigned)r[0]) + __builtin_bit_cast(float, (unsigned)r[1]);
}
__device__ __forceinline__ float wave_max(float v) {
    v = fmaxf(v, xshfl<1>(v)); v = fmaxf(v, xshfl<2>(v)); v = fmaxf(v, xshfl<4>(v)); v = fmaxf(v, xshfl<8>(v)); v = fmaxf(v, xshfl<16>(v));
    const unsigned u = __builtin_bit_cast(unsigned, v); auto r = __builtin_amdgcn_permlane32_swap(u, u, false, false);
    return fmaxf(__builtin_bit_cast(float, (unsigned)r[0]), __builtin_bit_cast(float, (unsigned)r[1]));
}
__device__ __forceinline__ float gelu_tanh(float x) {
    const float u = 0.7978845608028654f * (x + 0.044715f * x * x * x);
    const float e = __expf(2.f * u);
    const float th = 1.f - 2.f / (e + 1.f);
    return 0.5f * x * (1.f + th);
}
__device__ __forceinline__ float sigmoidf_(float x) { return 1.f / (1.f + __expf(-x)); }

__device__ __forceinline__ int lane_id() { unsigned m; asm volatile("s_mov_b32 %0, -1" : "=s"(m)); return (int)__builtin_amdgcn_mbcnt_hi(m, __builtin_amdgcn_mbcnt_lo(m, 0u)); }

#define XB_TMO      128
#define XB_XCNT(j)  (256  + 64 * (j))
#define XB_XSUB(j)  (1280 + 64 * (j))
#define XB_XGEN(j)  (2304 + 64 * (j))
#define XB_TOP      3328
#define XB_TOPGEN   3392
#define XCD_BAR_WORDS 3456
#define XB_SPIN_CAP (1u << 22)
__device__ __forceinline__ unsigned xb_ld(unsigned* p)              { return __hip_atomic_load(p, __ATOMIC_RELAXED, __HIP_MEMORY_SCOPE_AGENT); }
__device__ __forceinline__ unsigned xb_add(unsigned* p, unsigned v) { return __hip_atomic_fetch_add(p, v, __ATOMIC_RELAXED, __HIP_MEMORY_SCOPE_AGENT); }
__device__ __forceinline__ unsigned xb_xcc_id() { return (unsigned)__builtin_amdgcn_s_getreg((3 << 11) | 20) & 0xFu; }
#define XB_SPIN(cond, bar) do { unsigned _sp = 0; while (cond) { __builtin_amdgcn_s_sleep(1); \
    if ((++_sp & 255u) == 0u) { if (xb_ld(&(bar)[XB_TMO])) break; if (_sp > XB_SPIN_CAP) { atomicAdd(&(bar)[XB_TMO], 1u); break; } } } } while (0)
struct XcdBarrier { unsigned* bar; unsigned x; volatile LAS unsigned* st; };
__device__ __forceinline__ XcdBarrier xcd_barrier_post(unsigned* bar, volatile LAS unsigned* st, bool t0) {
    XcdBarrier b; b.bar = bar; b.x = xb_xcc_id(); b.st = st;
    if (t0) (void)xb_add(&bar[XB_XCNT(b.x)], 1u);
    return b;
}
__device__ __forceinline__ void xcd_barrier_complete(unsigned* bar, unsigned x, unsigned& nloc, unsigned& nx) {
    const unsigned G = gridDim.x * gridDim.y * gridDim.z;
    unsigned sum, cnt, mine, sp = 0u;
    for (;;) {
        sum = 0u; cnt = 0u; mine = 0u;
#pragma unroll
        for (unsigned j = 0; j < 16; ++j) { const unsigned c = xb_ld(&bar[XB_XCNT(j)]); sum += c; cnt += (c > 0u) ? 1u : 0u; mine = (j == x) ? c : mine; }
        if (sum == G) break;
        __builtin_amdgcn_s_sleep(1);
        if ((++sp & 255u) == 0u) { if (xb_ld(&bar[XB_TMO])) break; if (sp > XB_SPIN_CAP) { atomicAdd(&bar[XB_TMO], 1u); break; } }
    }
    nloc = mine > 0u ? mine : 1u; nx = cnt > 0u ? cnt : 1u;
}
__device__ __forceinline__ void xcd_barrier(const XcdBarrier& b, int wave) {
    asm volatile("s_waitcnt vmcnt(0)" ::: "memory");
    __syncthreads();
    if (wave == 0 && lane_id() == 0) {
        unsigned* bar = b.bar;
        __builtin_amdgcn_s_waitcnt(0);
        unsigned nloc = b.st[0], nx = b.st[1];
        if (nloc == 0u) { xcd_barrier_complete(bar, b.x, nloc, nx); b.st[0] = nloc; b.st[1] = nx; }
        const unsigned old = xb_add(&bar[XB_XSUB(b.x)], 1u);
        const unsigned gen = old / nloc;
        if (old + 1u == (gen + 1u) * nloc) {
            __builtin_amdgcn_fence(__ATOMIC_RELEASE, "agent");
            asm volatile("s_waitcnt vmcnt(0)" ::: "memory");
            const unsigned og = xb_add(&bar[XB_TOP], 1u);
            const unsigned tg = og / nx;
            if (og + 1u == (tg + 1u) * nx) xb_add(&bar[XB_TOPGEN], 1u);
            else XB_SPIN(xb_ld(&bar[XB_TOPGEN]) == tg, bar);
            __builtin_amdgcn_fence(__ATOMIC_ACQUIRE, "agent");
            xb_add(&bar[XB_XGEN(b.x)], 1u);
            asm volatile("s_waitcnt vmcnt(0)" ::: "memory");
        } else {
            XB_SPIN(xb_ld(&bar[XB_XGEN(b.x)]) == gen, bar);
            __builtin_amdgcn_fence(__ATOMIC_ACQUIRE, "agent");
            asm volatile("s_waitcnt vmcnt(0)" ::: "memory");
        }
    }
    __syncthreads();
}

__device__ __forceinline__ void simple_barrier(unsigned* cnt, volatile LAS unsigned* ep, int wave) {
    asm volatile("s_waitcnt vmcnt(0)" ::: "memory");
    __syncthreads();
    if (wave == 0 && lane_id() == 0) {
        __threadfence();
        asm volatile("s_waitcnt vmcnt(0)" ::: "memory");
        const unsigned e = ep[0] + 1u; ep[0] = e; const unsigned target = e * gridDim.x;
        (void)xb_add(cnt, 1u);
        unsigned sp = 0;
        while (xb_ld(cnt) < target) { __builtin_amdgcn_s_sleep(2); if (++sp > (1u << 24)) break; }
        __threadfence();
        asm volatile("s_waitcnt vmcnt(0)" ::: "memory");
    }
    __syncthreads();
}

struct Args {
    const float* in[27];
    float* out;
    unsigned char* ws;
    int ph_lo, ph_hi;
};

typedef const float* fptr_t;
typedef __attribute__((address_space(4))) const fptr_t* KargP;
struct Ctx {
    LAS unsigned char* lds;
    int tid, lane, wave, vcu, G;
    KargP in;
    float* R;
    unsigned char* ws;
};
#define P_XB(F) ((bf16*)((F).ws + WS_XB))
#define P_UG(F) ((bf16*)((F).ws + WS_UG))
#define P_PB(F) ((bf16*)((F).ws + WS_PB))
#define P_QB(F) ((bf16*)((F).ws + WS_QB))
#define P_KB(F) ((bf16*)((F).ws + WS_KB))
#define P_VB(F) ((bf16*)((F).ws + WS_VB))
#define P_YMIX(F) ((bf16*)((F).ws + WS_YMIX))
#define P_YS(F) ((bf16*)((F).ws + WS_YS))
#define P_DL(F) ((bf16*)((F).ws + WS_DL))
#define P_KMP(F) ((float*)((F).ws + WS_KMP))
#define P_BT(F) ((float*)((F).ws + WS_BT))


__device__ __forceinline__ Ctx launder(const Ctx& F0) {
    Ctx F = F0;
    int ln = lane_id(); asm volatile("" : "+v"(ln));
    asm volatile("" : "+s"(F.wave), "+s"(F.vcu), "+s"(F.G));
    F.lane = ln; F.tid = F.wave * 64 + ln;
    KargP kp = (KargP)__builtin_amdgcn_kernarg_segment_ptr(); asm volatile("" : "+s"(kp));
    F.in = kp; F.R = (float*)kp[27]; F.ws = (unsigned char*)kp[28];
    return F;
}

__device__ __forceinline__ unsigned char* wsl(unsigned char* p) { asm volatile("" : "+s"(p)); return p; }
__device__ __forceinline__ int sl(int x) { asm volatile("" : "+s"(x)); return x; }

__device__ __forceinline__ void store_proj(const Ctx& F, int m, int c, float v) {
    if (c < 256) { const int g = c >> 4, h = c & 15; P_UG(F)[((size_t)(g * 512 + (m >> 6))) * UGP + (m & 63) * 16 + h] = (bf16)f2bf(v); }
    else if (c < 512) P_PB(F)[(size_t)m * 256 + (c - 256)] = (bf16)f2bf(v);
    else if (c < 1024) P_QB(F)[(size_t)m * 512 + (c - 512)] = (bf16)f2bf(v * C2);
    else if (c < 1536) P_KB(F)[(size_t)m * 512 + (c - 1024)] = (bf16)f2bf(v);
    else P_VB(F)[(size_t)m * 512 + (c - 1536)] = (bf16)f2bf(v);
}


namespace pg8 {
typedef short bf16x8 __attribute__((ext_vector_type(8)));
constexpr int BM = 256, BK = 64, HALF = 128, HTB = HALF * BK * 2, STAGE_BYTES = 8 * HTB, NXCD = 8, WGM = 8;
__device__ __forceinline__ int lds_byte(int r, int c) { const int st = (r >> 4) * 2 + (c >> 5), rr = r & 15, cc = c & 31, ob = rr * 64 + cc * 2; return st * 1024 + (ob ^ (((ob >> 9) & 1) << 5)); }
__device__ __forceinline__ void stage_rc(int b, int& R, int& C) { const int st = b / 1024, sb = b % 1024, swz = sb ^ (((sb >> 9) & 1) << 5); R = (st >> 1) * 16 + swz / 64; C = (st & 1) * 32 + (swz % 64) / 2; }
__device__ __forceinline__ int perm32(int rho) { const int n = rho >> 4, i = rho & 15; return 8 * (i >> 2) + 4 * n + (i & 3); }

struct Unit { int pm, pn, aux; };
struct Gemm { const bf16* A; const bf16* Bt; int lda, ldb, K; };

struct StaticOrder {
    int nM, nN, nwg, G, c;
    __device__ void init(int M, int N, int G_, int c_) { nM = M / BM; nN = N / BM; nwg = nM * nN; G = G_; c = c_; }
    __device__ bool next(int i, Unit& u) const {
        const long L = (long)i * G + c; if (L >= nwg) return false;
        int wgid = (int)L; { const int q = nwg / NXCD, r = nwg % NXCD, xcd = wgid % NXCD, off = wgid / NXCD; wgid = (xcd < r ? xcd * (q + 1) : r * (q + 1) + (xcd - r) * q) + off; }
        const int nig = WGM * nN, gid = wgid / nig, fm = gid * WGM, gsz = (nM - fm) < WGM ? (nM - fm) : WGM;
        u.pm = fm + ((wgid % nig) % gsz); u.pn = (wgid % nig) / gsz; u.aux = 0; return true;
    }
};

__device__ __forceinline__ unsigned cvt_pk_bf16(float lo, float hi) { unsigned r; asm volatile("v_cvt_pk_bf16_f32 %0, %1, %2" : "=v"(r) : "v"(lo), "v"(hi)); return r; }

template <class Epi, class Sched>
__device__ __forceinline__ void gemm_phase(LAS unsigned char* lds, const Gemm g, const Sched& S, const Epi& E, int wave_) {
    int lane_ = lane_id(); asm volatile("" : "+v"(lane_)); asm volatile("" : "+s"(wave_));
    const int wid = wave_, lane = lane_, tid = wid * 64 + lane, wr = wid >> 2, wc = wid & 3, fr = lane & 15, fq = lane >> 4;
    const int K = g.K, nt = K / BK;
    unsigned voffA[2], voffB[2];
#pragma unroll
    for (int i = 0; i < 2; ++i) { int R, C; stage_rc(tid * 16 + i * 8192, R, C); const int Rb = Epi::PERM ? ((R & ~31) + perm32(R & 31)) : R;
        voffA[i] = (unsigned)(R * g.lda + C) * 2u; voffB[i] = (unsigned)(Rb * g.ldb + C) * 2u; }
    const size_t kstep = (size_t)(BK * 2);
    const size_t hstepA = (size_t)HALF * g.lda * 2, hstepB = (size_t)HALF * g.ldb * 2;
    const size_t tstepA = 2 * hstepA, tstepB = 2 * hstepB;
    const unsigned ldsw = (unsigned)wid * 1024u;
    const int aoff = lds_byte(wr * 64 + fr, fq * 8), boff = lds_byte(wc * 32 + fr, fq * 8);
#define PG8_SA(b, h) (((b) * 2 + (h)) * HTB)
#define PG8_SB(b, h) ((4 + (b) * 2 + (h)) * HTB)
#define PG8_STAGE(bufoff, gbase, voff) do { _Pragma("unroll") for (int _i = 0; _i < 2; ++_i) \
        __builtin_amdgcn_global_load_lds((const unsigned*)((const char*)(gbase) + (voff)[_i]), (LAS unsigned*)(lds + (bufoff) + ldsw + _i * 8192), 16, 0, 0); } while (0)
#define PG8_LDA(dst, b, h) do { _Pragma("unroll") for (int m = 0; m < 4; ++m) _Pragma("unroll") for (int k = 0; k < 2; ++k) dst[m][k] = *(const LAS bf16x8*)(lds + PG8_SA(b, h) + aoff + m * 2048 + k * 1024); } while (0)
#define PG8_LDB(dst, b, h) do { _Pragma("unroll") for (int n = 0; n < 2; ++n) _Pragma("unroll") for (int k = 0; k < 2; ++k) dst[n][k] = *(const LAS bf16x8*)(lds + PG8_SB(b, h) + boff + n * 2048 + k * 1024); } while (0)
#define PG8_MMA(ai, bj, At, Bt) do { __builtin_amdgcn_s_setprio(1); _Pragma("unroll") for (int m = 0; m < 4; ++m) _Pragma("unroll") for (int n = 0; n < 2; ++n) _Pragma("unroll") for (int k = 0; k < 2; ++k) \
        acc[ai][bj][m][n] = __builtin_amdgcn_mfma_f32_16x16x32_bf16(Bt[n][k], At[m][k], acc[ai][bj][m][n], 0, 0, 0); __builtin_amdgcn_s_setprio(0); } while (0)
#define PG8_WAIT_V(n) asm volatile("s_waitcnt vmcnt(0)" ::: "memory")
#define PG8_WAIT_L(n) asm volatile("s_waitcnt lgkmcnt(" #n ")" ::: "memory")
#define PG8_BAR __builtin_amdgcn_s_barrier()
#define PG8_SCHED __builtin_amdgcn_sched_barrier(0)
    Unit cur, nxt; int ui = 0;
    if (!S.next(0, cur)) return;
    f32x4 acc[2][2][4][2];
#pragma unroll
    for (int a = 0; a < 2; ++a)
#pragma unroll
        for (int b = 0; b < 2; ++b)
#pragma unroll
            for (int m = 0; m < 4; ++m)
#pragma unroll
                for (int n = 0; n < 2; ++n) acc[a][b][m][n] = (f32x4){0.f, 0.f, 0.f, 0.f};
    bf16x8 At[4][2], B0[2][2], B1[2][2];
    const char* cA = (const char*)g.A + (size_t)cur.pm * tstepA; const char* cB = (const char*)g.Bt + (size_t)cur.pn * tstepB;
    PG8_STAGE(PG8_SB(0, 0), cB, voffB); PG8_STAGE(PG8_SB(0, 1), cB + hstepB, voffB); PG8_STAGE(PG8_SA(0, 0), cA, voffA); PG8_STAGE(PG8_SA(0, 1), cA + hstepA, voffA);
    if (wr == 1) PG8_BAR;
    PG8_WAIT_V(2); PG8_BAR;
    PG8_STAGE(PG8_SB(1, 0), cB + kstep, voffB); PG8_STAGE(PG8_SA(1, 0), cA + kstep, voffA); PG8_STAGE(PG8_SB(1, 1), cB + hstepB + kstep, voffB);
    PG8_WAIT_V(6); PG8_BAR;
    for (;;) {
        const bool has_next = S.next(ui + 1, nxt);
        const char* nA = has_next ? (const char*)g.A + (size_t)nxt.pm * tstepA : cA; const char* nB = has_next ? (const char*)g.Bt + (size_t)nxt.pn * tstepB : cB;
        for (int t = 0; t < nt; t += 2) {
            const bool last = (t == nt - 2);
            const char* a1 = cA + (size_t)(t + 1) * kstep;
            const char* a2 = last ? nA : cA + (size_t)(t + 2) * kstep; const char* b2 = last ? nB : cB + (size_t)(t + 2) * kstep;
            const char* a3 = a2 + kstep; const char* b3 = b2 + kstep;
            PG8_LDB(B0, 0, 0); PG8_LDB(B1, 0, 1); PG8_SCHED; PG8_LDA(At, 0, 0); PG8_STAGE(PG8_SA(1, 1), a1 + hstepA, voffA);
            PG8_WAIT_V(8); PG8_WAIT_L(0); PG8_BAR; PG8_MMA(0, 0, At, B0); PG8_MMA(0, 1, At, B1); PG8_BAR; PG8_SCHED;
            PG8_LDA(At, 0, 1); PG8_STAGE(PG8_SB(0, 0), b2, voffB); PG8_STAGE(PG8_SB(0, 1), b2 + hstepB, voffB); PG8_STAGE(PG8_SA(0, 0), a2, voffA);
            PG8_WAIT_V(8); PG8_WAIT_L(0); PG8_BAR; PG8_MMA(1, 0, At, B0); PG8_MMA(1, 1, At, B1); PG8_BAR; PG8_SCHED;
            PG8_LDB(B0, 1, 0); PG8_LDB(B1, 1, 1); PG8_SCHED; PG8_LDA(At, 1, 0); PG8_STAGE(PG8_SA(0, 1), a2 + hstepA, voffA);
            PG8_WAIT_V(8); PG8_WAIT_L(0); PG8_BAR; PG8_MMA(0, 0, At, B0); PG8_MMA(0, 1, At, B1); PG8_BAR; PG8_SCHED;
            PG8_LDA(At, 1, 1); PG8_STAGE(PG8_SB(1, 0), b3, voffB); PG8_STAGE(PG8_SB(1, 1), b3 + hstepB, voffB); PG8_STAGE(PG8_SA(1, 0), a3, voffA);
            PG8_WAIT_V(8); PG8_WAIT_L(0); PG8_BAR; PG8_MMA(1, 0, At, B0); PG8_MMA(1, 1, At, B1); PG8_BAR; PG8_SCHED;
        }
        if (wr == 0) PG8_BAR;
        E(acc, cur, wr, wc, fr, fq);
        if (!has_next) break;
#pragma unroll
        for (int a = 0; a < 2; ++a)
#pragma unroll
            for (int b = 0; b < 2; ++b)
#pragma unroll
                for (int m = 0; m < 4; ++m)
#pragma unroll
                    for (int n = 0; n < 2; ++n) acc[a][b][m][n] = (f32x4){0.f, 0.f, 0.f, 0.f};
        cur = nxt; cA = nA; cB = nB; ++ui;
        if (wr == 1) PG8_BAR;
    }
    PG8_WAIT_V(0);
    PG8_BAR;
#undef PG8_SA
#undef PG8_SB
#undef PG8_STAGE
#undef PG8_LDA
#undef PG8_LDB
#undef PG8_MMA
#undef PG8_WAIT_V
#undef PG8_WAIT_L
#undef PG8_BAR
#undef PG8_SCHED
}
}


struct EpiProjE {
    static constexpr bool PERM = true;
    bf16 *UG, *PB, *QB, *KB, *VB; float* KMP;
    __device__ __forceinline__ void operator()(const f32x4 (&acc)[2][2][4][2], const pg8::Unit& u, int wr, int wc, int fr_, int fq_) const {
        const int ln_ = lane_id(), fr = ln_ & 15, fq = ln_ >> 4; (void)fr_; (void)fq_;
        const int pn = u.pn, row0 = u.pm * 256 + wr * 64 + fr, cl = wc * 32 + 8 * fq;
        if (pn == 0) {
#pragma unroll
            for (int ai = 0; ai < 2; ++ai)
#pragma unroll
                for (int m = 0; m < 4; ++m) { const int r = row0 + ai * 128 + m * 16;
#pragma unroll
                    for (int bj = 0; bj < 2; ++bj) { const int ch = bj * 128 + cl, g = ch >> 4, h0 = ch & 15;
                        const f32x4 v0 = acc[ai][bj][m][0], v1 = acc[ai][bj][m][1]; u32x4 w;
                        w.x = pg8::cvt_pk_bf16(v0[0], v0[1]); w.y = pg8::cvt_pk_bf16(v0[2], v0[3]); w.z = pg8::cvt_pk_bf16(v1[0], v1[1]); w.w = pg8::cvt_pk_bf16(v1[2], v1[3]);
                        *(u32x4*)(UG + ((size_t)(g * 512 + (r >> 6))) * UGP + (r & 63) * 16 + h0) = w; } }
        } else {
            bf16* base; int ldc, colt; float sc = 1.f;
            if (pn == 1) { base = PB; ldc = 256; colt = 0; }
            else if (pn < 4) { base = QB; ldc = 512; colt = (pn - 2) * 256; sc = C2; }
            else if (pn < 6) { base = KB; ldc = 512; colt = (pn - 4) * 256; }
            else { base = VB; ldc = 512; colt = (pn - 6) * 256; }
#pragma unroll
            for (int ai = 0; ai < 2; ++ai)
#pragma unroll
                for (int m = 0; m < 4; ++m) { bf16* rowp = base + (size_t)(row0 + ai * 128 + m * 16) * ldc + colt + cl;
#pragma unroll
                    for (int bj = 0; bj < 2; ++bj) { const f32x4 v0 = acc[ai][bj][m][0] * sc, v1 = acc[ai][bj][m][1] * sc; u32x4 w;
                        w.x = pg8::cvt_pk_bf16(v0[0], v0[1]); w.y = pg8::cvt_pk_bf16(v0[2], v0[3]); w.z = pg8::cvt_pk_bf16(v1[0], v1[1]); w.w = pg8::cvt_pk_bf16(v1[2], v1[3]);
                        *(u32x4*)(rowp + bj * 128) = w; } }
            if (pn >= 4 && pn < 6) {
#pragma unroll
                for (int bj = 0; bj < 2; ++bj)
#pragma unroll
                    for (int n = 0; n < 2; ++n) { f32x4 s = (f32x4){0.f, 0.f, 0.f, 0.f};
#pragma unroll
                        for (int ai = 0; ai < 2; ++ai)
#pragma unroll
                            for (int m = 0; m < 4; ++m) s += acc[ai][bj][m][n];
#pragma unroll
                        for (int i = 0; i < 4; ++i) { float t = s[i]; t += xshfl<1>(t); t += xshfl<2>(t); t += xshfl<4>(t); t += xshfl<8>(t); s[i] = t; }
                        if (fr == 0) *(f32x4*)(KMP + (size_t)wr * 128 * 512 + (size_t)u.pm * 512 + colt + bj * 128 + cl + 4 * n) = s; }
            }
        }
    }
};
struct EpiOutE {
    static constexpr bool PERM = false;
    const float* xin; float* R;
    __device__ __forceinline__ void operator()(const f32x4 (&acc)[2][2][4][2], const pg8::Unit& u, int wr, int wc, int fr_, int fq_) const {
        const int ln_ = lane_id(), fr = ln_ & 15, fq = ln_ >> 4; (void)fr_; (void)fq_;
        const int row0 = u.pm * 256 + wr * 64 + fr, col0 = u.pn * 256 + wc * 32 + 4 * fq;
#pragma unroll
        for (int ai = 0; ai < 2; ++ai)
#pragma unroll
            for (int m = 0; m < 4; ++m) { const size_t off = (size_t)(row0 + ai * 128 + m * 16) * D + col0;
#pragma unroll
                for (int bj = 0; bj < 2; ++bj)
#pragma unroll
                    for (int n = 0; n < 2; ++n) { const size_t o = off + bj * 128 + n * 16; *(f32x4*)(R + o) = *(const f32x4*)(xin + o) + acc[ai][bj][m][n]; }
                if (m & 1) asm volatile("" ::: "memory"); }
    }
};

__device__ __forceinline__ void transpose_item(const float* W, int K, int N, const float* kscale, bf16* WT, int ldo, int koff, int rowmode, LAS float* scr, int item, int lane) {
    const int nblk = N / 32, kb = item / nblk, nb = item % nblk, k0 = 64 * kb, n0 = 32 * nb;
#pragma unroll 8
    for (int i = 0; i < 32; ++i) { const int kk = 2 * i + (lane >> 5); const float s = kscale ? kscale[k0 + kk] : 1.f; scr[kk * 33 + (lane & 31)] = W[(size_t)(k0 + kk) * N + n0 + (lane & 31)] * s; }
    asm volatile("s_waitcnt lgkmcnt(0)" ::: "memory");
    const int c = lane & 7;
#pragma unroll
    for (int j = 0; j < 4; ++j) { const int n = (lane >> 3) + 8 * j; const LAS float* s = scr + (8 * c) * 33 + n;
        u32x4 o; o.x = pk2(s[0 * 33], s[1 * 33]); o.y = pk2(s[2 * 33], s[3 * 33]); o.z = pk2(s[4 * 33], s[5 * 33]); o.w = pk2(s[6 * 33], s[7 * 33]);
        const int nn = n0 + n, row = rowmode == 0 ? nn : (8 * (nn >> 2) + (nn & 3) + (rowmode == 2 ? 4 : 0));
        *(u32x4*)(WT + (size_t)row * ldo + koff + k0 + 8 * c) = o; }
    asm volatile("s_waitcnt lgkmcnt(0)" ::: "memory");
}
__device__ __forceinline__ void pair_decode(int pi, int& ea, int& eb) { ea = pi < 3 ? 0 : (pi < 5 ? 1 : 2); eb = pi < 3 ? pi + 1 : (pi < 5 ? pi - 1 : 3); }
__device__ __forceinline__ void ph_prologue(const Ctx& F0) {
    const Ctx F = launder(F0);
    LAS float* scr = (LAS float*)(F.lds + F.wave * 16384);
    const int gw = F.vcu * NWAVES + F.wave, NGW = F.G * NWAVES;
    constexpr int I_IN = (D / 64) * (NPROJ / 32), I_OUT = (D / 64) * (D / 32), I_GU1 = (D / 64) * (256 / 32), I_GU = 16 * 2 * I_GU1, I_WD1 = (256 / 64) * (D / 32), I_WD = 24 * 2 * I_WD1;
    constexpr int I_L = I_IN + I_OUT + I_GU + I_WD;
    for (int it = gw; it < DEPTH * I_L; it += NGW) {
        const int l = it / I_L; int r = it % I_L;
        if (r < I_IN) { transpose_item(F.in[3] + (size_t)l * D * NPROJ, D, NPROJ, F.in[2] + l * D, (bf16*)(F.ws + WS_WIN) + (size_t)l * NPROJ * D, D, 0, 0, scr, r, F.lane); continue; } r -= I_IN;
        if (r < I_OUT) { transpose_item(F.in[17] + (size_t)l * D * D, D, D, nullptr, (bf16*)(F.ws + WS_WOUT) + (size_t)l * D * D, D, 0, 0, scr, r, F.lane); continue; } r -= I_OUT;
        if (r < I_GU) { const int e = r / (2 * I_GU1), up = (r / I_GU1) & 1, item = r % I_GU1;
            transpose_item(F.in[up ? 24 : 23] + ((size_t)l * 16 + e) * D * 256, D, 256, F.in[18] + l * D, (bf16*)(F.ws + WS_GU) + ((size_t)l * 16 + e) * 512 * D, D, 0, 1 + up, scr, item, F.lane); continue; } r -= I_GU;
        { const int bk = r / (2 * I_WD1), half = (r / I_WD1) & 1, item = r % I_WD1, g = bk / 6; int ea, eb; pair_decode(bk % 6, ea, eb); const int e = g * 4 + (half ? eb : ea);
            transpose_item(F.in[25] + ((size_t)l * 16 + e) * 256 * D, 256, D, nullptr, (bf16*)(F.ws + WS_WD) + ((size_t)l * 24 + bk) * D * 512, 512, half * 256, 0, scr, item, F.lane); }
    }
#if USE_ENG_SSM
    for (int it = gw; it < DEPTH * 32; it += NGW) { const int l = it >> 5;
        transpose_item(F.in[12] + (size_t)l * 256 * 256, 256, 256, nullptr, (bf16*)(F.ws + WS_GLUT) + (size_t)l * 65536, 256, 0, 0, scr, it & 31, F.lane); }
    { const int gt = F.vcu * NTHREADS + F.tid, NGT = F.G * NTHREADS;
      for (int i = gt; i < DEPTH * 65536; i += NGT) { const int l = i >> 16, n = (i >> 8) & 255, k = i & 255;
          const float v = ((n >> 6) == (k >> 6)) ? F.in[14][(((size_t)l * 4 + (n >> 6)) * 64 + (k & 63)) * 64 + (n & 63)] : 0.f;
          ((bf16*)(F.ws + WS_POOLT))[i] = (bf16)f2bf(v); } }
    for (int it = gw; it < DEPTH * SGN * 65; it += NGW) {
        const int l = it / (SGN * 65), g = (it / 65) % SGN, tau = it % 65, p = F.lane;
        const float are = F.in[4][(l * SGN + g) * SP + p], aim = F.in[5][(l * SGN + g) * SP + p], dt = expf(F.in[6][l * SGN + g]);
        float sn, cs; sincosf(aim * dt, &sn, &cs); const float mg = expf(are * dt), lbr = mg * cs, lbi = mg * sn;
        const float nr = lbr - 1.f, ni = lbi, den = are * are + aim * aim, cr = (nr * are + ni * aim) / den, ci = (ni * are - nr * aim) / den;
        float sn2, cs2; sincosf(aim * dt * (float)tau, &sn2, &cs2); const float mg2 = expf(are * dt * (float)tau), lr = mg2 * cs2, li = mg2 * sn2;
        float wr[16], wi[16];
#pragma unroll
        for (int h = 0; h < 16; ++h) { const float br = F.in[7][((size_t)(l * SGN + g) * SP + p) * SG + h], bi = F.in[8][((size_t)(l * SGN + g) * SP + p) * SG + h];
            const float bbr = cr * br - ci * bi, bbi = cr * bi + ci * br; wr[h] = lr * bbr - li * bbi; wi[h] = lr * bbi + li * bbr; }
        bf16* TG = (bf16*)(F.ws + WS_TG) + ((size_t)l * SGN + g) * 1024 * UGP;
        if (tau <= 63) {
            bf16* BZ = (bf16*)(F.ws + WS_BZ) + ((size_t)l * SGN + g) * 256 * 1024; const int s = 63 - tau;
            u32x4 o0, o1, o2, o3;
            o0.x = pk2(wr[0], wr[1]); o0.y = pk2(wr[2], wr[3]); o0.z = pk2(wr[4], wr[5]); o0.w = pk2(wr[6], wr[7]); o1.x = pk2(wr[8], wr[9]); o1.y = pk2(wr[10], wr[11]); o1.z = pk2(wr[12], wr[13]); o1.w = pk2(wr[14], wr[15]);
            o2.x = pk2(wi[0], wi[1]); o2.y = pk2(wi[2], wi[3]); o2.z = pk2(wi[4], wi[5]); o2.w = pk2(wi[6], wi[7]); o3.x = pk2(wi[8], wi[9]); o3.y = pk2(wi[10], wi[11]); o3.z = pk2(wi[12], wi[13]); o3.w = pk2(wi[14], wi[15]);
            *(u32x4*)(BZ + (size_t)p * 1024 + s * 16) = o0; *(u32x4*)(BZ + (size_t)p * 1024 + s * 16 + 8) = o1;
            *(u32x4*)(BZ + (size_t)(64 + p) * 1024 + s * 16) = o2; *(u32x4*)(BZ + (size_t)(64 + p) * 1024 + s * 16 + 8) = o3;
        }
#pragma unroll 1
        for (int ho = 0; ho < 16; ++ho) {
            const float ccr = F.in[9][((size_t)(l * SGN + g) * SG + ho) * SP + p], cci = F.in[10][((size_t)(l * SGN + g) * SG + ho) * SP + p];
            if (tau >= 1) { const int n = (tau - 1) * 16 + ho;
                TG[(size_t)n * UGP + 1024 + p] = (bf16)f2bf(ccr * lr - cci * li); TG[(size_t)n * UGP + 1088 + p] = (bf16)f2bf(-(ccr * li + cci * lr)); }
            if (tau <= 63) {
                float kv[16];
#pragma unroll
                for (int h = 0; h < 16; ++h) kv[h] = wave_sum(ccr * wr[h] - cci * wi[h]);
                u32x4 o0, o1; o0.x = pk2(kv[0], kv[1]); o0.y = pk2(kv[2], kv[3]); o0.z = pk2(kv[4], kv[5]); o0.w = pk2(kv[6], kv[7]); o1.x = pk2(kv[8], kv[9]); o1.y = pk2(kv[10], kv[11]); o1.z = pk2(kv[12], kv[13]); o1.w = pk2(kv[14], kv[15]);
                const int to = p;
                if (to >= tau) { bf16* d = TG + (size_t)(to * 16 + ho) * UGP + (to - tau) * 16; *(u32x4*)d = o0; *(u32x4*)(d + 8) = o1; }
                if (tau >= 1 && to + tau <= 63) { bf16* d = TG + (size_t)(to * 16 + ho) * UGP + (to + tau) * 16; const u32x4 z = (u32x4){0u, 0u, 0u, 0u}; *(u32x4*)d = z; *(u32x4*)(d + 8) = z; }
            }
        }
    }
#endif
}

__device__ __forceinline__ void ph_route(const Ctx& F0, int l) {
    const Ctx F = launder(F0);
    LAS float* Wl = (LAS float*)F.lds;
    LAS int* hist = (LAS int*)(F.lds + 1024 * 20 * 4);
    const float* g2 = F.in[18] + l * D;
    const f32x4* gw4 = (const f32x4*)(F.in[19] + (size_t)l * D * 4); const f32x4* rw4 = (const f32x4*)(F.in[21] + (size_t)l * 4 * D * 4);
    const float* gb_ = F.in[20] + l * 4; const float* rb_ = F.in[22] + l * 16;
    for (int idx = F.tid; idx < D * 5; idx += NTHREADS) { const int k = idx / 5, q = idx % 5;
        f32x4 v = (q == 0) ? gw4[k] : rw4[(q - 1) * D + k]; v = v * g2[k]; *(LAS f32x4*)(Wl + k * 20 + q * 4) = v; }
    if (F.tid < 32) hist[F.tid] = 0;
    __syncthreads();
    int* tokb = (int*)(F.ws + WS_TOKB); float* tokr = (float*)(F.ws + WS_TOKR); float* tokw = (float*)(F.ws + WS_TOKW);
    for (int i = 0; i < 16; ++i) {
        const int m = F.vcu * 128 + F.wave * 16 + i;
        const float* xr = F.R + (size_t)m * D + F.lane;
        float a[20]; float ss = 0.f;
#pragma unroll
        for (int j = 0; j < 20; ++j) a[j] = 0.f;
#pragma unroll 2
        for (int jj = 0; jj < 16; ++jj) { const float x = xr[64 * jj]; ss += x * x; const LAS f32x4* wp = (const LAS f32x4*)(Wl + (F.lane + 64 * jj) * 20);
#pragma unroll
            for (int q = 0; q < 5; ++q) { const f32x4 w = wp[q]; a[q * 4 + 0] += x * w[0]; a[q * 4 + 1] += x * w[1]; a[q * 4 + 2] += x * w[2]; a[q * 4 + 3] += x * w[3]; } }
        ss = wave_sum(ss);
#pragma unroll
        for (int j = 0; j < 20; ++j) a[j] = wave_sum(a[j]);
        const float rstd = 1.f / sqrtf(ss * (1.f / D) + RMS_EPS);
        float lg0 = a[0] * rstd + gb_[0], lg1 = a[1] * rstd + gb_[1], lg2 = a[2] * rstd + gb_[2], lg3 = a[3] * rstd + gb_[3];
        int gs = 0; float gm = lg0;
        if (lg1 > gm) { gm = lg1; gs = 1; } if (lg2 > gm) { gm = lg2; gs = 2; } if (lg3 > gm) { gm = lg3; gs = 3; }
        const float gwt = 1.f / (__expf(lg0 - gm) + __expf(lg1 - gm) + __expf(lg2 - gm) + __expf(lg3 - gm));
        float e0 = gs == 0 ? a[4] : gs == 1 ? a[8] : gs == 2 ? a[12] : a[16];
        float e1 = gs == 0 ? a[5] : gs == 1 ? a[9] : gs == 2 ? a[13] : a[17];
        float e2 = gs == 0 ? a[6] : gs == 1 ? a[10] : gs == 2 ? a[14] : a[18];
        float e3 = gs == 0 ? a[7] : gs == 1 ? a[11] : gs == 2 ? a[15] : a[19];
        e0 = e0 * rstd + rb_[gs * 4 + 0]; e1 = e1 * rstd + rb_[gs * 4 + 1]; e2 = e2 * rstd + rb_[gs * 4 + 2]; e3 = e3 * rstd + rb_[gs * 4 + 3];
        int t1 = 0; float v1 = e0;
        if (e1 > v1) { v1 = e1; t1 = 1; } if (e2 > v1) { v1 = e2; t1 = 2; } if (e3 > v1) { v1 = e3; t1 = 3; }
        int t2 = -1; float v2 = -3.0e38f;
        if (t1 != 0 && e0 > v2) { v2 = e0; t2 = 0; } if (t1 != 1 && e1 > v2) { v2 = e1; t2 = 1; } if (t1 != 2 && e2 > v2) { v2 = e2; t2 = 2; } if (t1 != 3 && e3 > v2) { v2 = e3; t2 = 3; }
        const float p2 = __expf(v2 - v1), w1 = gwt / (1.f + p2), w2 = gwt * p2 / (1.f + p2);
        const int lo = t1 < t2 ? t1 : t2, hi = t1 < t2 ? t2 : t1; const float wlo = t1 < t2 ? w1 : w2, whi = t1 < t2 ? w2 : w1;
        const int pi = lo == 0 ? hi - 1 : (lo == 1 ? hi + 1 : 5), bk = gs * 6 + pi;
        if (F.lane == 0) { tokb[m] = bk; tokr[m] = rstd; tokw[2 * m] = wlo; tokw[2 * m + 1] = whi; __hip_atomic_fetch_add(hist + bk, 1, __ATOMIC_RELAXED, __HIP_MEMORY_SCOPE_WORKGROUP); }
    }
    __syncthreads();
    if (F.tid < 24) __hip_atomic_store((int*)(F.ws + WS_WGCNT) + F.vcu * 24 + F.tid, hist[F.tid], __ATOMIC_RELAXED, __HIP_MEMORY_SCOPE_AGENT);
}
__device__ __forceinline__ void ph_place(const Ctx& F0) {
    const Ctx F = launder(F0);
    LAS int* ptot = (LAS int*)F.lds;
    LAS int* pbef = ptot + 512;
    LAS int* bstart = pbef + 512;
    LAS int* btot = bstart + 32;
    LAS int* carry = btot + 32;
    LAS int* rowidx = carry + 32;
    const int* wgcnt = (const int*)(F.ws + WS_WGCNT);
    int* rowtok = (int*)(F.ws + WS_ROWTOK); float* roww = (float*)(F.ws + WS_ROWW); int* tileb = (int*)(F.ws + WS_TILEB);
    const int* tokb = (const int*)(F.ws + WS_TOKB); const float* tokr = (const float*)(F.ws + WS_TOKR); const float* tokw = (const float*)(F.ws + WS_TOKW);
    { const int p = F.tid >> 5, b = F.tid & 31; int tot = 0, bef = 0;
      if (b < 24) for (int v = p * 16; v < p * 16 + 16; ++v) { const int c = wgcnt[v * 24 + b]; tot += c; if (v < F.vcu) bef += c; }
      ptot[p * 32 + b] = tot; pbef[p * 32 + b] = bef; }
    __syncthreads();
    if (F.tid < 32) { int tot = 0, bef = 0; for (int p = 0; p < 16; ++p) { tot += ptot[p * 32 + F.tid]; bef += pbef[p * 32 + F.tid]; } btot[F.tid] = tot; carry[F.tid] = bef; }
    __syncthreads();
    if (F.tid == 0) { int s = 0; for (int b = 0; b < 24; ++b) { bstart[b] = s; s += (btot[b] + 255) & ~255; } bstart[24] = s; }
    __syncthreads();
    if (F.tid < 24) carry[F.tid] += bstart[F.tid];
    if (F.vcu == 0) {
        if (F.tid == 0) tileb[0] = bstart[24] >> 8;
        for (int b = 0; b < 24; ++b) { const int s = bstart[b], e = bstart[b + 1];
            for (int t = (s >> 8) + F.tid; t < (e >> 8); t += NTHREADS) tileb[1 + t] = b;
            for (int r = s + btot[b] + F.tid; r < e; r += NTHREADS) __hip_atomic_store(rowtok + r, -1, __ATOMIC_RELAXED, __HIP_MEMORY_SCOPE_AGENT); }
    }
    __syncthreads();
    if (F.wave == 0) {
        for (int pass = 0; pass < 2; ++pass) { const int i = pass * 64 + F.lane, bi = tokb[F.vcu * 128 + i]; int row = 0;
#pragma unroll 1
            for (int b = 0; b < 24; ++b) { const unsigned long long mask = __ballot(bi == b); const int c = carry[b];
                if (bi == b) row = c + __builtin_popcountll(mask & ((1ull << F.lane) - 1ull));
                asm volatile("s_waitcnt lgkmcnt(0)" ::: "memory");
                if (F.lane == 0) carry[b] = c + __builtin_popcountll(mask);
                asm volatile("s_waitcnt lgkmcnt(0)" ::: "memory"); }
            rowidx[i] = row; }
    }
    __syncthreads();
    bf16* XS = (bf16*)(F.ws + WS_XS);
    for (int i = 0; i < 16; ++i) {
        const int li = F.wave * 16 + i, m = F.vcu * 128 + li, row = rowidx[li]; const float rstd = tokr[m];
        if (F.lane == 0) {
            __hip_atomic_store(rowtok + row, m, __ATOMIC_RELAXED, __HIP_MEMORY_SCOPE_AGENT);
            const unsigned long long w2 = (unsigned long long)__builtin_bit_cast(unsigned, tokw[2 * m]) | ((unsigned long long)__builtin_bit_cast(unsigned, tokw[2 * m + 1]) << 32);
            __hip_atomic_store((unsigned long long*)(roww + 2 * row), w2, __ATOMIC_RELAXED, __HIP_MEMORY_SCOPE_AGENT); }
        const f32x4* xr = (const f32x4*)(F.R + (size_t)m * D) + F.lane;
        unsigned long long* o8 = (unsigned long long*)(XS + (size_t)row * D) + F.lane;
#pragma unroll
        for (int j = 0; j < 4; ++j) { const f32x4 v = xr[64 * j] * rstd; o8[64 * j] = (unsigned long long)pk2(v.x, v.y) | ((unsigned long long)pk2(v.z, v.w) << 32); }
    }
}
struct MoeOrder {
    const int* tileb; int G, c; bool down;
    __device__ __forceinline__ bool next(int i, pg8::Unit& u) const {
        const GAS int* tb_ = (const GAS int*)tileb;
        const int NT = __builtin_amdgcn_readfirstlane(tb_[0]), L = i * G + c; if (L >= NT * 4) return false;
        const int rt = L >> 2, pn = L & 3, b = __builtin_amdgcn_readfirstlane(tb_[1 + rt]);
        if (down) { u.pm = rt; u.pn = b * 4 + pn; u.aux = pn; }
        else { int ea, eb; pair_decode(b % 6, ea, eb); const int e = (b / 6) * 4 + (pn < 2 ? ea : eb); u.pm = rt; u.pn = e * 2 + (pn & 1); u.aux = pn; }
        return true;
    }
};
struct EpiGU {
    static constexpr bool PERM = true;
    bf16* H; const float* roww;
    __device__ __forceinline__ void operator()(const f32x4 (&acc)[2][2][4][2], const pg8::Unit& u, int wr, int wc, int fr_, int fq_) const {
        const int ln_ = lane_id(), fr = ln_ & 15, fq = ln_ >> 4; (void)fr_; (void)fq_;
        const int row0 = u.pm * 256 + wr * 64 + fr, cl = u.aux * 128 + 16 * wc + 4 * fq, ws = u.aux >> 1;
#pragma unroll
        for (int ai = 0; ai < 2; ++ai)
#pragma unroll
            for (int m = 0; m < 4; ++m) { const int r = row0 + ai * 128 + m * 16; const float w = roww[2 * r + ws];
#pragma unroll
                for (int bj = 0; bj < 2; ++bj) { const f32x4 g = acc[ai][bj][m][0], up = acc[ai][bj][m][1]; f32x4 a;
#pragma unroll
                    for (int i = 0; i < 4; ++i) a[i] = g[i] * sigmoidf_(g[i]) * up[i] * w;
                    u32x2 o; o.x = pg8::cvt_pk_bf16(a[0], a[1]); o.y = pg8::cvt_pk_bf16(a[2], a[3]);
                    *(u32x2*)(H + (size_t)r * 512 + cl + bj * 64) = o; } }
    }
};
struct EpiDown {
    static constexpr bool PERM = false;
    float* R; const int* rowtok;
    __device__ __forceinline__ void operator()(const f32x4 (&acc)[2][2][4][2], const pg8::Unit& u, int wr, int wc, int fr_, int fq_) const {
        const int ln_ = lane_id(), fr = ln_ & 15, fq = ln_ >> 4; (void)fr_; (void)fq_;
        const int row0 = u.pm * 256 + wr * 64 + fr, col0 = u.aux * 256 + wc * 32 + 4 * fq;
#pragma unroll
        for (int ai = 0; ai < 2; ++ai)
#pragma unroll
            for (int m = 0; m < 4; ++m) { const int tok = rowtok[row0 + ai * 128 + m * 16];
                if (tok >= 0) { float* rp = R + (size_t)tok * D + col0;
#pragma unroll
                    for (int bj = 0; bj < 2; ++bj)
#pragma unroll
                        for (int n = 0; n < 2; ++n) { float* p = rp + bj * 128 + n * 16; *(f32x4*)p = *(const f32x4*)p + acc[ai][bj][m][n]; } }
                if (m & 1) asm volatile("" ::: "memory"); }
    }
};

namespace attn_body {
using abf16=__hip_bfloat16;
using bf16x8=__attribute__((ext_vector_type(8)))short;
using s16x4=__attribute__((ext_vector_type(4)))short;
using f32x16=__attribute__((ext_vector_type(16)))float;
using u32x4=__attribute__((ext_vector_type(4)))unsigned;
constexpr int BATCH=8,NHEAD=8,SEQ=4096,D=64,DM=NHEAD*D,DMO=1024,OCOL=512;
constexpr int NW=8,QBLK=32,QB=QBLK*NW,KVBLK=64,NQB=SEQ/QB;
constexpr int ATTN_PITCH=DM, ATTN_UNIT_ROWS=QB;
__device__ __forceinline__ int crow(int r,int hi){return (r&3)+8*(r>>2)+4*hi;}
#define SBAR() __builtin_amdgcn_sched_barrier(0)
__device__ __forceinline__ void nearm(f32x16&p0,f32x16&p1,int jn,int qrel,int hi,const __attribute__((address_space(3))) float*tb){
  const __attribute__((address_space(3))) float*t0=tb+(qrel-64*(jn-4)-4*hi+256);
  #pragma unroll
  for(int r=0;r<16;++r){const int k=(r&3)+8*(r>>2); p0[r]+=t0[-k]; p1[r]+=t0[-k-32];}
}

constexpr int NSLOT=3, SLOTB=8192;
constexpr int LDS_K=0, LDS_V=NSLOT*SLOTB, LDS_WS=2*NSLOT*SLOTB, LDS_OST=LDS_WS+NW*64*4, LDS_TB=LDS_OST+NW*4096, LDS_KM=LDS_TB+768*4, LDS_BYTES=LDS_KM+16*64*4;
constexpr float C2=0.125f*1.4426950408889634f;
__device__ __forceinline__ void glds16(const void*gsrc,unsigned lds_dst){unsigned keep;
  asm volatile("s_mov_b32 %0, m0\n\ts_mov_b32 m0, %2\n\ts_nop 0\n\tglobal_load_lds_dwordx4 %1, off\n\ts_mov_b32 m0, %0":"=&s"(keep):"v"(gsrc),"s"(lds_dst):"memory");}
__device__ __forceinline__ float max3f(float a,float b,float c){float r;asm("v_max3_f32 %0, %1, %2, %3":"=v"(r):"v"(a),"v"(b),"v"(c));return r;}
__device__ __forceinline__ float max2f(float a,float b){float r;asm("v_max_f32_e32 %0, %1, %2":"=v"(r):"v"(a),"v"(b));return r;}
__device__ __forceinline__ float fadd_s(float a,float b){float r;asm("v_add_f32_e32 %0, %1, %2":"=v"(r):"v"(a),"v"(b));return r;}
__device__ __forceinline__ float fsub_s(float a,float b){float r;asm("v_sub_f32_e32 %0, %1, %2":"=v"(r):"v"(a),"v"(b));return r;}
typedef float f32x2_t __attribute__((ext_vector_type(2))); typedef __bf16 bf16x2_t __attribute__((ext_vector_type(2)));
__device__ __forceinline__ unsigned cvtpk_s(float lo,float hi){f32x2_t v={lo,hi};bf16x2_t b=__builtin_convertvector(v,bf16x2_t);return __builtin_bit_cast(unsigned,b);}
#define WAIT_BAR(N) asm volatile("s_waitcnt vmcnt(0) lgkmcnt(0)\n\ts_barrier":::"memory")

__device__ __forceinline__ void qkt(f32x16&p0,f32x16&p1,const char*Kslot,const bf16x8*qr,const f32x16&negm,int r32,int hi){
  const char*kb=Kslot+hi*1024+r32*16;
  #pragma unroll
  for(int d0=0;d0<4;++d0){
    const bf16x8 b0=*reinterpret_cast<const bf16x8*>(kb+d0*2048);
    const bf16x8 b1=*reinterpret_cast<const bf16x8*>(kb+d0*2048+512);
    if(d0==0){p0=__builtin_amdgcn_mfma_f32_32x32x16_bf16(b0,qr[0],negm,0,0,0);p1=__builtin_amdgcn_mfma_f32_32x32x16_bf16(b1,qr[0],negm,0,0,0);}
    else{p0=__builtin_amdgcn_mfma_f32_32x32x16_bf16(b0,qr[d0],p0,0,0,0);p1=__builtin_amdgcn_mfma_f32_32x32x16_bf16(b1,qr[d0],p1,0,0,0);}}
}
typedef __attribute__((address_space(3))) const char* lds_cptr;
typedef short v4i16_t __attribute__((ext_vector_type(4)));
__device__ __forceinline__ void kload8(bf16x8*kf,lds_cptr kp){
  kf[0]=*(const __attribute__((address_space(3))) bf16x8*)(kp);      kf[1]=*(const __attribute__((address_space(3))) bf16x8*)(kp+512);
  kf[2]=*(const __attribute__((address_space(3))) bf16x8*)(kp+2048); kf[3]=*(const __attribute__((address_space(3))) bf16x8*)(kp+2560);
  kf[4]=*(const __attribute__((address_space(3))) bf16x8*)(kp+4096); kf[5]=*(const __attribute__((address_space(3))) bf16x8*)(kp+4608);
  kf[6]=*(const __attribute__((address_space(3))) bf16x8*)(kp+6144); kf[7]=*(const __attribute__((address_space(3))) bf16x8*)(kp+6656);
}
__device__ __forceinline__ void kload2(bf16x8*kf,lds_cptr kp,int j){ kf[2*j]=*(const __attribute__((address_space(3))) bf16x8*)(kp+j*2048); kf[2*j+1]=*(const __attribute__((address_space(3))) bf16x8*)(kp+j*2048+512); }
__device__ __forceinline__ s16x4 vtr(lds_cptr p){ return __builtin_bit_cast(s16x4,__builtin_amdgcn_ds_read_tr16_b64_v4i16((__attribute__((address_space(3))) v4i16_t*)p)); }
__device__ __forceinline__ float rowmax(const f32x16&p0,const f32x16&p1){
  float a=max3f(p0[0],p0[1],p1[0]),b=max3f(p0[2],p0[3],p1[1]);a=max3f(a,p1[2],p1[3]);
  #pragma unroll
  for(int r=4;r<16;r+=4){a=max3f(a,p0[r],p0[r+1]);b=max3f(b,p0[r+2],p0[r+3]);a=max3f(a,p1[r],p1[r+1]);b=max3f(b,p1[r+2],p1[r+3]);}
  const float m=max2f(a,b);
  auto rr=__builtin_amdgcn_permlane32_swap(__float_as_uint(m),__float_as_uint(m),false,false);
  return max2f(__uint_as_float(rr[0]),__uint_as_float(rr[1]));
}
__device__ __forceinline__ void pv(f32x16*o,int vb,bf16x8 pa0,bf16x8 pa1,bf16x8 pa2,bf16x8 pa3){
  #pragma unroll
  for(int d0=0;d0<2;++d0){s16x4 lo[4],hi[4];
    #pragma unroll
    for(int ks=0;ks<4;++ks){
      asm volatile("ds_read_b64_tr_b16 %0,%1 offset:%c2":"=&v"(lo[ks]):"v"(vb),"i"(d0*4096+ks*1024):"memory");
      asm volatile("ds_read_b64_tr_b16 %0,%1 offset:%c2":"=&v"(hi[ks]):"v"(vb),"i"(d0*4096+ks*1024+512):"memory");}
    asm volatile("s_waitcnt lgkmcnt(0)":::"memory");SBAR();
    #define PK(k) (bf16x8){lo[k][0],lo[k][1],lo[k][2],lo[k][3],hi[k][0],hi[k][1],hi[k][2],hi[k][3]}
    o[d0]=__builtin_amdgcn_mfma_f32_32x32x16_bf16(pa0,PK(0),o[d0],0,0,0);
    o[d0]=__builtin_amdgcn_mfma_f32_32x32x16_bf16(pa1,PK(1),o[d0],0,0,0);
    o[d0]=__builtin_amdgcn_mfma_f32_32x32x16_bf16(pa2,PK(2),o[d0],0,0,0);
    o[d0]=__builtin_amdgcn_mfma_f32_32x32x16_bf16(pa3,PK(3),o[d0],0,0,0);
    #undef PK
  }
}

#ifndef ATTN_STORE16
#define ATTN_STORE16(p,v) (*(u32x4*)(p)=(v))
#endif
template<int THRL> __device__ __forceinline__ void attn_unit(int wave_,int b,int h,int qb,const abf16*Q,const abf16*__restrict__ K,const abf16*__restrict__ V,abf16*O,const float*KMP,const float*BT,char*shm){
  int lane_=lane_id(); asm volatile("":"+v"(lane_)); asm volatile("":"+s"(b),"+s"(h),"+s"(qb),"+s"(wave_));
  const int wid=wave_,lane=lane_,tid=wid*64+lane,r32=lane&31,hi=lane>>5;
  const long rowbase=(long)b*SEQ; const int q0=qb*QB;
  const abf16*Qw=Q+(rowbase+q0+wid*QBLK)*DM+h*D;
  const abf16*Kh=K+rowbase*DM+h*D,*Vh=V+rowbase*DM+h*D;
  const unsigned lds0=(unsigned)(uintptr_t)shm;
  float*wsf=(float*)(shm+LDS_WS)+wid*64;
  const abf16*ksrc=Kh+(long)lane*DM+wid*8;
  const abf16*vsrc=Vh+(long)(16*(wid&3)+(lane>>2))*DM+(wid>>2)*32+(lane&3)*8;
  const unsigned kdst=lds0+LDS_K+wid*1024, vdst=lds0+LDS_V+wid*1024;
  #define DMA_K(t,slot) glds16(ksrc+(long)(t)*KVBLK*DM,(unsigned)__builtin_amdgcn_readfirstlane(kdst+(slot)))
  #define DMA_V(t,slot) glds16(vsrc+(long)(t)*KVBLK*DM,(unsigned)__builtin_amdgcn_readfirstlane(vdst+(slot)))
  const int vb0=(int)(lds0+LDS_V)+((lane>>4)&1)*32+(lane&3)*8+(4*hi+((lane&15)>>2))*64;
  const char*Kbase=shm+LDS_K; bf16x8 kf[8];
  const lds_cptr shm3=(lds_cptr)shm; const lds_cptr kp0=shm3+LDS_K+hi*1024+r32*16; const lds_cptr vp0=shm3+LDS_V+((lane>>4)&1)*32+(lane&3)*8+(4*hi+((lane&15)>>2))*64;
  const int NT=(q0+QB)/KVBLK;
  typedef __attribute__((address_space(3))) float lfloat;
  lfloat*tb=(lfloat*)((__attribute__((address_space(3))) char*)shm+LDS_TB); lfloat*km=(lfloat*)((__attribute__((address_space(3))) char*)shm+LDS_KM);
  const float bfar=BT[h*132+128];
  for(int i=tid;i<768;i+=NW*64){const int rel=i-256; tb[i]=rel<0?-1.0e30f:(rel<128?BT[h*132+rel]-bfar:0.f);}
  for(int i=tid;i<16*64;i+=NW*64){const int j=i>>6,d=i&63; const int pm=b*16+j; km[i]=KMP[pm*512+h*64+d]+KMP[128*512+pm*512+h*64+d];}
  asm volatile("s_waitcnt vmcnt(0) lgkmcnt(0)\n\ts_barrier":::"memory");
  DMA_K(0,0);DMA_V(0,0);DMA_K(1,SLOTB);
  bf16x8 qr[4];
  #pragma unroll
  for(int d0=0;d0<4;++d0)qr[d0]=*reinterpret_cast<const bf16x8*>(&Qw[(long)r32*DM+d0*16+hi*8]);
  unsigned selmask=1u<<qb;
  { float g[16];
    #pragma unroll
    for(int j=0;j<16;++j)g[j]=0.f;
    #pragma unroll
    for(int d0=0;d0<4;++d0){
      #pragma unroll
      for(int e=0;e<8;++e){ const float qf=__builtin_bit_cast(float,((unsigned)(unsigned short)qr[d0][e])<<16);
        #pragma unroll
        for(int j=0;j<16;++j)g[j]+=qf*km[j*64+d0*16+hi*8+e]; } }
    #pragma unroll
    for(int j=0;j<16;++j){ const unsigned u_=__builtin_bit_cast(unsigned,g[j]); auto rr=__builtin_amdgcn_permlane32_swap(u_,u_,false,false); g[j]=__builtin_bit_cast(float,(unsigned)rr[0])+__builtin_bit_cast(float,(unsigned)rr[1]); }
    #pragma unroll
    for(int s=0;s<3;++s){ float bv=-3.0e38f; int bi=-1;
      #pragma unroll
      for(int j=0;j<16;++j){ const bool ok=(j<qb)&&!((selmask>>j)&1u)&&(g[j]>bv); bv=ok?g[j]:bv; bi=ok?j:bi; }
      if(bi>=0)selmask|=1u<<bi; } }
  float mhat=0.f;
  #define NV(tn) (((selmask>>((tn)>>2))&1u)?(bfar-mhat):-1.0e30f)
  float l_reg=0.f;f32x16 o[2];o[0]=f32x16{};o[1]=f32x16{};f32x16 negm;
  { const float x_=NV(0);
    #pragma unroll
    for(int r=0;r<16;++r)negm[r]=x_; } asm volatile("":"+v"(negm));
  const int qrel=wid*QBLK+r32;
  #define CMASK(P0,P1,t) do{int jn_=(t)-(NT-8); if(jn_>=0)nearm(P0,P1,jn_,qrel,hi,tb);}while(0)
  bool resc=false;
  #define START(P0,P1) do{ const float rm=rowmax(P0,P1); resc=false; \
    { const float dl=(rm<-1.0e29f)?0.f:rm; mhat=fadd_s(mhat,dl); \
      _Pragma("unroll") for(int r=0;r<16;++r){P0[r]=fsub_s(P0[r],dl);P1[r]=fsub_s(P1[r],dl);} \
      { const float x_=NV(1); _Pragma("unroll") for(int r=0;r<16;++r)negm[r]=x_; } asm volatile("":"+v"(negm)); } \
    _Pragma("unroll") for(int r=0;r<16;++r)P0[r]=__builtin_amdgcn_exp2f(P0[r]); }while(0)
  #define RESC() do{ if(resc){ asm volatile("s_waitcnt lgkmcnt(0)":::"memory"); \
      _Pragma("unroll") for(int d_=0;d_<2;++d_) _Pragma("unroll") for(int r=0;r<16;++r)o[d_][r]*=wsf[crow(r,hi)]; } }while(0)
  f32x16 pA0,pA1,pB0,pB1;
  int sl_prev=0,sl_cur=0,sl_next=SLOTB;
  #define ROT() do{sl_prev=sl_cur;sl_cur=sl_next;sl_next=(sl_next==(NSLOT-1)*SLOTB)?0:sl_next+SLOTB;}while(0)
  DMA_K(2,2*SLOTB);
  WAIT_BAR(3);
  qkt(pA0,pA1,Kbase,qr,negm,r32,hi);asm volatile("s_nop 15\n\ts_nop 7":"+v"(pA0),"+v"(pA1));CMASK(pA0,pA1,0);
  START(pA0,pA1);
  _Pragma("unroll") for(int r=0;r<16;++r)pA1[r]=__builtin_amdgcn_exp2f(pA1[r]);
  WAIT_BAR(0);
  DMA_K(3,0);DMA_V(1,SLOTB);
  ROT();
  kload8(kf,kp0+sl_cur);
  WAIT_BAR(2);
  s16x4 vlo[8],vhi[8]; u32x4 pw0,pw1,pw2,pw3;
  #define PKW(P,B) cvtpk_s(P[B],P[B+1])
  #define PAF(k) __builtin_bit_cast(bf16x8,pw##k)
  #define VFR(i) (bf16x8){vlo[i][0],vlo[i][1],vlo[i][2],vlo[i][3],vhi[i][0],vhi[i][1],vhi[i][2],vhi[i][3]}
  #define PIN(x) asm volatile("":"+v"(x))
  #define MX3(a,b,c) __builtin_fmaxf(__builtin_fmaxf((a),(b)),(c))
  #define GAPA(MF,A0,A1,A2,A3,W0,W1,PW) do{ MF; sacc+=A0; sacc+=A1; sacc+=A2; sacc+=A3; PIN(sacc); W0; W1; PIN(PW); SBAR(); }while(0)
  #define EX(v) __builtin_amdgcn_exp2f(v)
  #define GAPB(MF,X,B) do{ MF; X[B]=EX(X[B]); X[B+1]=EX(X[B+1]); X[B+2]=EX(X[B+2]); X[B+3]=EX(X[B+3]); PIN(X); SBAR(); }while(0)
  #define VRD(i) do{ vlo[i]=vtr(vp_+(((i)>>2)*4096+((i)&3)*1024)); vhi[i]=vtr(vp_+(((i)>>2)*4096+((i)&3)*1024+512)); }while(0)
  #define KRD(G,j) do{ if(G){ kload2(kf,kp0+sl_next,j); SBAR(); } }while(0)
  #define STEP(C0,C1,P0,P1,t,GK,GV,GL) do{ SBAR(); \
    const lds_cptr vp_=vp0+sl_prev; \
    VRD(0); SBAR(); float sacc=(P0[0]+P0[1]); \
    GAPA(C0=__builtin_amdgcn_mfma_f32_32x32x16_bf16(kf[0],qr[0],negm,0,0,0), P0[2],P0[3],P0[4],P0[5],     pw0[0]=PKW(P0,0), pw0[1]=PKW(P0,2), pw0); \
    VRD(4); SBAR(); GAPA(C1=__builtin_amdgcn_mfma_f32_32x32x16_bf16(kf[1],qr[0],negm,0,0,0), P0[6],P0[7],P0[8],P0[9],     pw0[2]=PKW(P0,4), pw0[3]=PKW(P0,6), pw0); \
    VRD(1); SBAR(); GAPA(C0=__builtin_amdgcn_mfma_f32_32x32x16_bf16(kf[2],qr[1],C0,0,0,0),   P0[10],P0[11],P0[12],P0[13], pw1[0]=PKW(P0,8), pw1[1]=PKW(P0,10), pw1); \
    VRD(5); SBAR(); GAPA(C1=__builtin_amdgcn_mfma_f32_32x32x16_bf16(kf[3],qr[1],C1,0,0,0),   P0[14],P0[15],P1[0],P1[1],   pw1[2]=PKW(P0,12),pw1[3]=PKW(P0,14), pw1); \
    VRD(2); SBAR(); GAPA(C0=__builtin_amdgcn_mfma_f32_32x32x16_bf16(kf[4],qr[2],C0,0,0,0),   P1[2],P1[3],P1[4],P1[5],     pw2[0]=PKW(P1,0), pw2[1]=PKW(P1,2), pw2); \
    VRD(6); SBAR(); GAPA(C1=__builtin_amdgcn_mfma_f32_32x32x16_bf16(kf[5],qr[2],C1,0,0,0),   P1[6],P1[7],P1[8],P1[9],     pw2[2]=PKW(P1,4), pw2[3]=PKW(P1,6), pw2); \
    VRD(3); SBAR(); GAPA(C0=__builtin_amdgcn_mfma_f32_32x32x16_bf16(kf[6],qr[3],C0,0,0,0),   P1[10],P1[11],P1[12],P1[13], pw3[0]=PKW(P1,8), pw3[1]=PKW(P1,10), pw3); \
    VRD(7); SBAR(); GAPA(C1=__builtin_amdgcn_mfma_f32_32x32x16_bf16(kf[7],qr[3],C1,0,0,0),   P1[14],P1[15],0.f,0.f,       pw3[2]=PKW(P1,12),pw3[3]=PKW(P1,14), pw3); \
    l_reg+=sacc; \
    if(GK){DMA_K((t)+3,sl_cur);} if(GV){DMA_V((t)+1,sl_next);} \
    CMASK(C0,C1,t); \
    { float a=MX3(C0[0],C0[1],C1[0]),b=MX3(C0[2],C0[3],C1[1]); a=MX3(a,C1[2],C1[3]); \
      _Pragma("unroll") for(int r=4;r<16;r+=4){a=MX3(a,C0[r],C0[r+1]);b=MX3(b,C0[r+2],C0[r+3]);a=MX3(a,C1[r],C1[r+1]);b=MX3(b,C1[r+2],C1[r+3]);} \
      float rm=__builtin_fmaxf(a,b); { auto rr=__builtin_amdgcn_permlane32_swap(__float_as_uint(rm),__float_as_uint(rm),false,false); rm=__builtin_fmaxf(__uint_as_float(rr[0]),__uint_as_float(rr[1])); } \
      resc=false; \
      if(__builtin_expect(__any(rm>(float)THRL),0)){ const float dl=__builtin_fmaxf(rm,0.f); mhat+=dl; \
        _Pragma("unroll") for(int r=0;r<16;++r){C0[r]-=dl;C1[r]-=dl;} \
        { const float x_=NV((t)+1); _Pragma("unroll") for(int r=0;r<16;++r)negm[r]=x_; } asm volatile("":"+v"(negm)); \
        const float f=__builtin_amdgcn_exp2f(-dl); l_reg*=f; if(hi==0)wsf[r32]=f; resc=true; } } \
    SBAR(); \
    GAPB(o[0]=__builtin_amdgcn_mfma_f32_32x32x16_bf16(PAF(0),VFR(0),o[0],0,0,0), C0,0); \
    GAPB(o[1]=__builtin_amdgcn_mfma_f32_32x32x16_bf16(PAF(0),VFR(4),o[1],0,0,0), C0,4); \
    KRD(GL,0); GAPB(o[0]=__builtin_amdgcn_mfma_f32_32x32x16_bf16(PAF(1),VFR(1),o[0],0,0,0), C0,8); \
    KRD(GL,1); GAPB(o[1]=__builtin_amdgcn_mfma_f32_32x32x16_bf16(PAF(1),VFR(5),o[1],0,0,0), C0,12); \
    KRD(GL,2); GAPB(o[0]=__builtin_amdgcn_mfma_f32_32x32x16_bf16(PAF(2),VFR(2),o[0],0,0,0), C1,0); \
    KRD(GL,3); GAPB(o[1]=__builtin_amdgcn_mfma_f32_32x32x16_bf16(PAF(2),VFR(6),o[1],0,0,0), C1,4); \
    GAPB(o[0]=__builtin_amdgcn_mfma_f32_32x32x16_bf16(PAF(3),VFR(3),o[0],0,0,0), C1,8); \
    GAPB(o[1]=__builtin_amdgcn_mfma_f32_32x32x16_bf16(PAF(3),VFR(7),o[1],0,0,0), C1,12); \
    }while(0)
  int t=1;
  #undef CMASK
  #define CMASK(P0,P1,t) do{}while(0)
  #define BLKUPD(tn) do{ if((((tn)&3)==0)){ const float x_=NV(tn); _Pragma("unroll") for(int r=0;r<16;++r)negm[r]=x_; asm volatile("":"+v"(negm)); } }while(0)
  for(;t+9<NT;t+=2){
    STEP(pB0,pB1,pA0,pA1,t,true,true,true);     WAIT_BAR(2); RESC(); ROT(); BLKUPD(t+1);
    STEP(pA0,pA1,pB0,pB1,t+1,true,true,true);   WAIT_BAR(2); RESC(); ROT(); BLKUPD(t+2);
  }
  #undef CMASK
  #define CMASK(P0,P1,t) do{int jn_=(t)-(NT-8); if(jn_>=0)nearm(P0,P1,jn_,qrel,hi,tb);}while(0)
  #define ENDW(tt) do{ if((tt)+3<NT){WAIT_BAR(2);} else if((tt)+2<NT){WAIT_BAR(1);} else {WAIT_BAR(0);} }while(0)
  for(;t+1<NT;t+=2){
    STEP(pB0,pB1,pA0,pA1,t,(t+3<NT),(t+1<NT),(t+1<NT));       ENDW(t);   RESC(); ROT(); BLKUPD(t+1);
    STEP(pA0,pA1,pB0,pB1,t+1,(t+4<NT),(t+2<NT),(t+2<NT));     ENDW(t+1); RESC(); ROT(); BLKUPD(t+2);
  }
  STEP(pB0,pB1,pA0,pA1,NT-1,false,false,false); RESC();
  { float sacc=pB0[0]+pB0[1]; _Pragma("unroll") for(int r=2;r<16;++r)sacc+=pB0[r]; _Pragma("unroll") for(int r=0;r<16;++r)sacc+=pB1[r]; l_reg+=sacc;
    pw0=(u32x4){PKW(pB0,0),PKW(pB0,2),PKW(pB0,4),PKW(pB0,6)};pw1=(u32x4){PKW(pB0,8),PKW(pB0,10),PKW(pB0,12),PKW(pB0,14)};pw2=(u32x4){PKW(pB1,0),PKW(pB1,2),PKW(pB1,4),PKW(pB1,6)};pw3=(u32x4){PKW(pB1,8),PKW(pB1,10),PKW(pB1,12),PKW(pB1,14)};
    SBAR(); pv(o,vb0+sl_cur,PAF(0),PAF(1),PAF(2),PAF(3)); }
  #undef PKW
  #undef PAF
  #undef VFR
  #undef PIN
  #undef MX3
  #undef GAPA
  #undef GAPB
  #undef EX
  #undef VRD
  #undef KRD
  #undef STEP
  #undef ENDW
  {auto rr=__builtin_amdgcn_permlane32_swap(__float_as_uint(l_reg),__float_as_uint(l_reg),false,false);l_reg=__uint_as_float(rr[0])+__uint_as_float(rr[1]);}
  if(hi==0)wsf[32+r32]=l_reg;asm volatile("s_waitcnt lgkmcnt(0)":::"memory");
  float rli[16];
  #pragma unroll
  for(int r=0;r<16;++r)rli[r]=__builtin_amdgcn_rcpf(wsf[32+crow(r,hi)]);
  abf16*Ow=O+(rowbase+q0+wid*QBLK)*DMO+OCOL+h*D;
  { abf16*stg=(abf16*)(shm+LDS_OST)+wid*2048;
    #pragma unroll
    for(int r=0;r<16;++r){const int orow=crow(r,hi);
      #pragma unroll
      for(int d0=0;d0<2;++d0)stg[orow*64+d0*32+r32]=__float2bfloat16(o[d0][r]*rli[r]);}
    asm volatile("s_waitcnt lgkmcnt(0)":::"memory");
    #pragma unroll
    for(int i=0;i<4;++i){const int row=i*8+(lane>>3),ch=lane&7; const u32x4 v=*(const u32x4*)(stg+row*64+ch*8); ATTN_STORE16(Ow+(long)row*DMO+ch*8,v);} }
  asm volatile("s_waitcnt lgkmcnt(0)\n\ts_barrier":::"memory");
  #undef DMA_K
  #undef DMA_V
  #undef CMASK
  #undef START
  #undef RESC
  #undef ROT
  #undef NV
  #undef BLKUPD
}
constexpr int ATTN_LDS_BYTES=LDS_BYTES;
struct AttnTensors { const abf16* Q; const abf16* K; const abf16* V; abf16* O; const float* KMP; const float* BT; };
struct AttnUnit { int bh; int qb; };
struct StaticOrder {
  int vcu;
  __device__ __forceinline__ explicit StaticOrder(int vcu_):vcu(vcu_){}
  __device__ __forceinline__ bool next(int i,AttnUnit&u)const{ if(i>=4||vcu>=256)return false; const int s=vcu&3; u.bh=vcu>>2; u.qb=(i==0)?s:(i==1)?7-s:(i==2)?8+s:15-s; return true; }
};
template<class Sched,int THRL=8> __device__ __forceinline__ void attn_phase(int wave_,char*lds,const AttnTensors&T,const Sched&S){
  AttnUnit u;
  for(int i=0;S.next(i,u);++i){ attn_unit<THRL>(wave_,u.bh/NHEAD,u.bh%NHEAD,u.qb,T.Q,T.K,T.V,T.O,T.KMP,T.BT,lds); }
}
#undef SBAR
#undef WAIT_BAR
}


struct SsmOrder { int G, c, mode;
    __device__ __forceinline__ bool next(int i, pg8::Unit& u) const { const int L = i * G + c;
        if (mode == 1) { if (L >= 32) return false; u.pm = L; u.pn = L >> 1; u.aux = 0; return true; }
        if (L >= 128) return false; const int g = L >> 3; u.pm = g * 2 + ((L >> 2) & 1); u.pn = g * 4 + (L & 3); u.aux = L & 3; return true; } };
struct HalfOrder { int L;
    __device__ __forceinline__ bool next(int i, pg8::Unit& u) const { if (i > 0 || L < 0 || L >= 128) return false; u.pm = L; u.pn = 0; u.aux = 0; return true; } };
struct EpiZ { static constexpr bool PERM = false; float* ZB;
    __device__ __forceinline__ void operator()(const f32x4 (&acc)[2][2][4][2], const pg8::Unit& u, int wr, int wc, int fr_, int fq_) const {
        const int ln_ = lane_id(), fr = ln_ & 15, fq = ln_ >> 4; (void)fr_; (void)fq_;
        const int row0 = u.pm * 256 + wr * 64 + fr, col0 = wc * 32 + 4 * fq;
#pragma unroll
        for (int ai = 0; ai < 2; ++ai)
#pragma unroll
            for (int m = 0; m < 4; ++m)
#pragma unroll
                for (int n = 0; n < 2; ++n) *(f32x4*)(ZB + (size_t)(row0 + ai * 128 + m * 16) * 128 + col0 + n * 16) = acc[ai][0][m][n];
    } };
struct EpiSsm2 { static constexpr bool PERM = true; const bf16* UG; bf16* YS; const float* dvec;
    __device__ __forceinline__ void operator()(const f32x4 (&acc)[2][2][4][2], const pg8::Unit& u, int wr, int wc, int fr_, int fq_) const {
        const int ln_ = lane_id(), fr = ln_ & 15, fq = ln_ >> 4; (void)fr_; (void)fq_;
        const int g = u.pm >> 1, cr0 = (u.pm & 1) * 256 + wr * 64 + fr;
#pragma unroll
        for (int bj = 0; bj < 2; ++bj) { const int n0 = u.aux * 256 + bj * 128 + wc * 32 + 8 * fq, to = n0 >> 4, ho0 = n0 & 15;
            const f32x4 d0 = *(const f32x4*)(dvec + g * 16 + ho0), d1 = *(const f32x4*)(dvec + g * 16 + ho0 + 4);
#pragma unroll
            for (int ai = 0; ai < 2; ++ai)
#pragma unroll
                for (int m = 0; m < 4; ++m) { const int cr = cr0 + ai * 128 + m * 16;
                    const u32x4 uu = *(const u32x4*)(UG + ((size_t)(g * 512 + cr)) * UGP + n0);
                    const f32x4 a0 = acc[ai][bj][m][0], a1 = acc[ai][bj][m][1]; float y[8];
                    y[0] = gelu_tanh(a0[0] + d0[0] * bf2f(uu.x & 0xffffu)); y[1] = gelu_tanh(a0[1] + d0[1] * bf2f(uu.x >> 16));
                    y[2] = gelu_tanh(a0[2] + d0[2] * bf2f(uu.y & 0xffffu)); y[3] = gelu_tanh(a0[3] + d0[3] * bf2f(uu.y >> 16));
                    y[4] = gelu_tanh(a1[0] + d1[0] * bf2f(uu.z & 0xffffu)); y[5] = gelu_tanh(a1[1] + d1[1] * bf2f(uu.z >> 16));
                    y[6] = gelu_tanh(a1[2] + d1[2] * bf2f(uu.w & 0xffffu)); y[7] = gelu_tanh(a1[3] + d1[3] * bf2f(uu.w >> 16));
                    u32x4 w; w.x = pg8::cvt_pk_bf16(y[0], y[1]); w.y = pg8::cvt_pk_bf16(y[2], y[3]); w.z = pg8::cvt_pk_bf16(y[4], y[5]); w.w = pg8::cvt_pk_bf16(y[6], y[7]);
                    *(u32x4*)(YS + ((size_t)cr * 64 + to) * 256 + g * 16 + ho0) = w; } }
    } };
struct EpiGluE { static constexpr bool PERM = true; const bf16* YS; bf16* YMIX; const float* gb;
    __device__ __forceinline__ void operator()(const f32x4 (&acc)[2][2][4][2], const pg8::Unit& u, int wr, int wc, int fr_, int fq_) const {
        const int ln_ = lane_id(), fr = ln_ & 15, fq = ln_ >> 4; (void)fr_; (void)fq_;
        const int row0 = u.pm * 256 + wr * 64 + fr;
#pragma unroll
        for (int bj = 0; bj < 2; ++bj) { const int n0 = bj * 128 + wc * 32 + 8 * fq; const f32x4 b0 = *(const f32x4*)(gb + n0), b1 = *(const f32x4*)(gb + n0 + 4);
#pragma unroll
            for (int ai = 0; ai < 2; ++ai)
#pragma unroll
                for (int m = 0; m < 4; ++m) { const size_t r = (size_t)(row0 + ai * 128 + m * 16); const u32x4 yy = *(const u32x4*)(YS + r * 256 + n0);
                    const f32x4 a0 = acc[ai][bj][m][0] + b0, a1 = acc[ai][bj][m][1] + b1; float o[8];
                    o[0] = bf2f(yy.x & 0xffffu) * sigmoidf_(a0[0]); o[1] = bf2f(yy.x >> 16) * sigmoidf_(a0[1]); o[2] = bf2f(yy.y & 0xffffu) * sigmoidf_(a0[2]); o[3] = bf2f(yy.y >> 16) * sigmoidf_(a0[3]);
                    o[4] = bf2f(yy.z & 0xffffu) * sigmoidf_(a1[0]); o[5] = bf2f(yy.z >> 16) * sigmoidf_(a1[1]); o[6] = bf2f(yy.w & 0xffffu) * sigmoidf_(a1[2]); o[7] = bf2f(yy.w >> 16) * sigmoidf_(a1[3]);
                    u32x4 w; w.x = pg8::cvt_pk_bf16(o[0], o[1]); w.y = pg8::cvt_pk_bf16(o[2], o[3]); w.z = pg8::cvt_pk_bf16(o[4], o[5]); w.w = pg8::cvt_pk_bf16(o[6], o[7]);
                    *(u32x4*)(YMIX + r * 1024 + n0) = w; } }
    } };
struct EpiPoolE { static constexpr bool PERM = true; bf16* YMIX; const float* pb; const float* ps;
    __device__ __forceinline__ void operator()(const f32x4 (&acc)[2][2][4][2], const pg8::Unit& u, int wr, int wc, int fr_, int fq_) const {
        const int ln_ = lane_id(), fr = ln_ & 15, fq = ln_ >> 4; (void)fr_; (void)fq_;
        const int row0 = u.pm * 256 + wr * 64 + fr;
#pragma unroll
        for (int bj = 0; bj < 2; ++bj) { const int n0 = bj * 128 + wc * 32 + 8 * fq; const f32x4 b0 = *(const f32x4*)(pb + n0), b1 = *(const f32x4*)(pb + n0 + 4), s0 = *(const f32x4*)(ps + n0), s1 = *(const f32x4*)(ps + n0 + 4);
#pragma unroll
            for (int ai = 0; ai < 2; ++ai)
#pragma unroll
                for (int m = 0; m < 4; ++m) { const size_t r = (size_t)(row0 + ai * 128 + m * 16);
                    const f32x4 a0 = (acc[ai][bj][m][0] + b0) * s0, a1 = (acc[ai][bj][m][1] + b1) * s1;
                    u32x4 w; w.x = pg8::cvt_pk_bf16(a0[0], a0[1]); w.y = pg8::cvt_pk_bf16(a0[2], a0[3]); w.z = pg8::cvt_pk_bf16(a1[0], a1[1]); w.w = pg8::cvt_pk_bf16(a1[2], a1[3]);
                    *(u32x4*)(YMIX + r * 1024 + 256 + n0) = w; } }
    } };
__device__ __forceinline__ void ph_ssm_scan(const Ctx& F0, int l) {
    const Ctx F = launder(F0);
    const int gw = F.vcu * NWAVES + F.wave, NGW = F.G * NWAVES;
    for (int it = gw; it < SGN * NB; it += NGW) {
        const int g = it >> 3, b = it & 7, p = F.lane;
        const float are = F.in[4][(l * SGN + g) * SP + p], aim = F.in[5][(l * SGN + g) * SP + p], dt = expf(F.in[6][l * SGN + g]);
        float sn, cs; sincosf(aim * dt * 64.f, &sn, &cs); const float mg = expf(are * dt * 64.f), lr = mg * cs, li = mg * sn;
        const float* Z = (const float*)(F.ws + WS_ZB) + ((size_t)g * 512 + b * 64) * 128;
        bf16* U = P_UG(F) + ((size_t)g * 512 + b * 64) * UGP + 1024;
        float sr = 0.f, si = 0.f;
#pragma unroll 4
        for (int c = 0; c < 64; ++c) {
            U[(size_t)c * UGP + p] = (bf16)f2bf(sr); U[(size_t)c * UGP + 64 + p] = (bf16)f2bf(si);
            const float zr = Z[c * 128 + p], zi = Z[c * 128 + 64 + p];
            const float nr = lr * sr - li * si + zr, ni = lr * si + li * sr + zi; sr = nr; si = ni;
        }
    }
}


namespace moba {
using bf16x8 = __attribute__((ext_vector_type(8))) short;
using s16x4 = __attribute__((ext_vector_type(4))) short;
using f32x16 = __attribute__((ext_vector_type(16))) float;
typedef short v4i16_t __attribute__((ext_vector_type(4)));
typedef float f32x2_t __attribute__((ext_vector_type(2))); typedef __bf16 bf16x2_t __attribute__((ext_vector_type(2)));
constexpr int L_K = 0, L_V = 16384, L_TB = 32768, L_KM = L_TB + 768 * 4, L_END = L_KM + 16 * 64 * 4;
__device__ __forceinline__ unsigned cvtpk(float lo, float hi) { f32x2_t v = {lo, hi}; bf16x2_t b = __builtin_convertvector(v, bf16x2_t); return __builtin_bit_cast(unsigned, b); }
__device__ __forceinline__ s16x4 vtr(const LAS char* p) { return __builtin_bit_cast(s16x4, __builtin_amdgcn_ds_read_tr16_b64_v4i16((LAS v4i16_t*)p)); }
__device__ __forceinline__ float hmax(float v) { const unsigned u = __builtin_bit_cast(unsigned, v); auto r = __builtin_amdgcn_permlane32_swap(u, u, false, false); return fmaxf(__builtin_bit_cast(float, (unsigned)r[0]), __builtin_bit_cast(float, (unsigned)r[1])); }
__device__ __forceinline__ float hsum(float v) { const unsigned u = __builtin_bit_cast(unsigned, v); auto r = __builtin_amdgcn_permlane32_swap(u, u, false, false); return __builtin_bit_cast(float, (unsigned)r[0]) + __builtin_bit_cast(float, (unsigned)r[1]); }

__device__ __forceinline__ void unit(int wave_, int b, int h, int qb, const bf16* Q, const bf16* K, const bf16* V, bf16* O, const float* KMP, const float* BT, LAS char* lds) {
    int lane_ = lane_id(); asm volatile("" : "+v"(lane_)); asm volatile("" : "+s"(b), "+s"(h), "+s"(qb), "+s"(wave_));
    const int wid = wave_, lane = lane_, tid = wid * 64 + lane, r32 = lane & 31, hi = lane >> 5;
    const int NT = 4 * qb + 4, q0 = qb * 256; const size_t rowbase = (size_t)b * SEQ;
    LAS float* tb = (LAS float*)(lds + L_TB); LAS float* km = (LAS float*)(lds + L_KM);
    const float bfar = BT[h * 132 + 128];
    for (int i = tid; i < 768; i += NTHREADS) { const int rel = i - 256; tb[i] = rel < 0 ? -1.0e30f : (rel < 128 ? BT[h * 132 + rel] - bfar : 0.f); }
    for (int i = tid; i < 16 * 64; i += NTHREADS) { const int j = i >> 6, d = i & 63, pm = b * 16 + j; km[i] = KMP[pm * 512 + h * 64 + d] + KMP[128 * 512 + pm * 512 + h * 64 + d]; }
    const bf16* ksrc = K + (rowbase + lane) * 512 + h * 64 + wid * 8;
    const bf16* vsrc = V + (rowbase + 16 * (wid & 3) + (lane >> 2)) * 512 + h * 64 + (wid >> 2) * 32 + (lane & 3) * 8;
    u32x4 kreg = *(const u32x4*)ksrc, vreg = *(const u32x4*)vsrc;
    bf16x8 qr[4];
    { const bf16* qw = Q + (rowbase + q0 + wid * 32 + r32) * 512 + h * 64 + hi * 8;
#pragma unroll
      for (int d0 = 0; d0 < 4; ++d0) qr[d0] = *(const bf16x8*)(qw + d0 * 16); }
    __syncthreads();
    unsigned selmask = 1u << qb;
    { float g[16];
#pragma unroll
      for (int j = 0; j < 16; ++j) g[j] = 0.f;
#pragma unroll
      for (int d0 = 0; d0 < 4; ++d0)
#pragma unroll
          for (int e = 0; e < 8; ++e) { const float qf = bf2f((unsigned)(unsigned short)qr[d0][e]);
#pragma unroll
              for (int j = 0; j < 16; ++j) g[j] += qf * km[j * 64 + d0 * 16 + hi * 8 + e]; }
#pragma unroll
      for (int j = 0; j < 16; ++j) g[j] = hsum(g[j]);
#pragma unroll
      for (int s = 0; s < 3; ++s) { float bv = -3.0e38f; int bi = -1;
#pragma unroll
          for (int j = 0; j < 16; ++j) { const bool ok = (j < qb) && !((selmask >> j) & 1u) && (g[j] > bv); bv = ok ? g[j] : bv; bi = ok ? j : bi; }
          if (bi >= 0) selmask |= 1u << bi; } }
    *(LAS u32x4*)(lds + L_K + wid * 1024 + lane * 16) = kreg; *(LAS u32x4*)(lds + L_V + wid * 1024 + lane * 16) = vreg;
    __syncthreads();
    const int qrel = wid * 32 + r32;
    const LAS char* kp0 = lds + L_K + hi * 1024 + r32 * 16;
    const LAS char* vp0 = lds + L_V + ((lane >> 4) & 1) * 32 + (lane & 3) * 8 + (4 * hi + ((lane & 15) >> 2)) * 64;
    float m = -1.0e20f, l = 0.f; f32x16 o0 = f32x16{}, o1 = f32x16{};
#pragma unroll 1
    for (int t = 0; t < NT; ++t) {
        const int buf = (t & 1) * 8192;
        if (t + 1 < NT) { kreg = *(const u32x4*)(ksrc + (size_t)(t + 1) * 64 * 512); vreg = *(const u32x4*)(vsrc + (size_t)(t + 1) * 64 * 512); }
        const float ci = ((selmask >> (t >> 2)) & 1u) ? bfar : -1.0e30f;
        f32x16 p0, p1;
#pragma unroll
        for (int r = 0; r < 16; ++r) { p0[r] = ci; p1[r] = ci; }
#pragma unroll
        for (int d0 = 0; d0 < 4; ++d0) { const bf16x8 a0 = *(const LAS bf16x8*)(kp0 + buf + d0 * 2048), a1 = *(const LAS bf16x8*)(kp0 + buf + d0 * 2048 + 512);
            p0 = __builtin_amdgcn_mfma_f32_32x32x16_bf16(a0, qr[d0], p0, 0, 0, 0); p1 = __builtin_amdgcn_mfma_f32_32x32x16_bf16(a1, qr[d0], p1, 0, 0, 0); }
        const int jn = t - (NT - 8);
        if (jn >= 0) { const LAS float* t0 = tb + (qrel - 64 * (jn - 4) - 4 * hi + 256);
#pragma unroll
            for (int r = 0; r < 16; ++r) { const int k = (r & 3) + 8 * (r >> 2); p0[r] += t0[-k]; p1[r] += t0[-k - 32]; } }
        float rm = fmaxf(p0[0], p1[0]);
#pragma unroll
        for (int r = 1; r < 16; ++r) rm = fmaxf(rm, fmaxf(p0[r], p1[r]));
        rm = hmax(rm);
        const float mn = fmaxf(fmaxf(m, rm), -1.0e20f), alpha = __builtin_amdgcn_exp2f(m - mn); m = mn;
        float s = 0.f;
#pragma unroll
        for (int r = 0; r < 16; ++r) { p0[r] = __builtin_amdgcn_exp2f(p0[r] - mn); p1[r] = __builtin_amdgcn_exp2f(p1[r] - mn); s += p0[r] + p1[r]; }
        l = l * alpha + s;
#pragma unroll
        for (int r = 0; r < 16; ++r) { o0[r] *= alpha; o1[r] *= alpha; }
        u32x4 pw[4];
#pragma unroll
        for (int q = 0; q < 4; ++q) { pw[0][q] = cvtpk(p0[2 * q], p0[2 * q + 1]); pw[1][q] = cvtpk(p0[8 + 2 * q], p0[9 + 2 * q]); pw[2][q] = cvtpk(p1[2 * q], p1[2 * q + 1]); pw[3][q] = cvtpk(p1[8 + 2 * q], p1[9 + 2 * q]); }
        const LAS char* vp = vp0 + buf;
#pragma unroll
        for (int k = 0; k < 4; ++k) {
            const s16x4 lo0 = vtr(vp + k * 1024), hi0 = vtr(vp + k * 1024 + 512), lo1 = vtr(vp + 4096 + k * 1024), hi1 = vtr(vp + 4096 + k * 1024 + 512);
            const bf16x8 v0 = (bf16x8){lo0[0], lo0[1], lo0[2], lo0[3], hi0[0], hi0[1], hi0[2], hi0[3]}, v1 = (bf16x8){lo1[0], lo1[1], lo1[2], lo1[3], hi1[0], hi1[1], hi1[2], hi1[3]};
            const bf16x8 pa = __builtin_bit_cast(bf16x8, pw[k]);
            o0 = __builtin_amdgcn_mfma_f32_32x32x16_bf16(v0, pa, o0, 0, 0, 0);
            o1 = __builtin_amdgcn_mfma_f32_32x32x16_bf16(v1, pa, o1, 0, 0, 0); }
        if (t + 1 < NT) { const int nb = ((t + 1) & 1) * 8192; *(LAS u32x4*)(lds + L_K + nb + wid * 1024 + lane * 16) = kreg; *(LAS u32x4*)(lds + L_V + nb + wid * 1024 + lane * 16) = vreg; }
        __syncthreads();
    }
    const float inv = 1.f / hsum(l);
    bf16* orow = O + (rowbase + q0 + wid * 32 + r32) * 1024 + 512 + h * 64 + 4 * hi;
#pragma unroll
    for (int g = 0; g < 4; ++g) { u32x2 w0, w1;
        w0.x = cvtpk(o0[4 * g] * inv, o0[4 * g + 1] * inv); w0.y = cvtpk(o0[4 * g + 2] * inv, o0[4 * g + 3] * inv);
        w1.x = cvtpk(o1[4 * g] * inv, o1[4 * g + 1] * inv); w1.y = cvtpk(o1[4 * g + 2] * inv, o1[4 * g + 3] * inv);
        *(u32x2*)(orow + 8 * g) = w0; *(u32x2*)(orow + 32 + 8 * g) = w1; }
}
__device__ __forceinline__ void phase(int wave, int vcu, const bf16* Q, const bf16* K, const bf16* V, bf16* O, const float* KMP, const float* BT, LAS char* lds) {
    if (vcu >= 256) return;
    const int s = vcu & 3, bh = vcu >> 2;
#pragma unroll 1
    for (int i = 0; i < 4; ++i) { const int qb = (i == 0) ? s : (i == 1) ? 7 - s : (i == 2) ? 8 + s : 15 - s; unit(wave, bh >> 3, bh & 7, qb, Q, K, V, O, KMP, BT, lds); }
}
}

template <class Epi>
__device__ __forceinline__ void naive_gemm(const Ctx& F0, const bf16* A, int lda, const float* Bw, int ldb, const float* kscale, int M, int N, int K, const Epi& epi) {
    const Ctx F = launder(F0);
    LAS float* As = (LAS float*)F.lds;
    LAS float* Bs = As + 16 * 132;
    const int tid = F.tid, ty = tid >> 4, tx = tid & 15;
    const int tm = M / 128, tn = N / 128;
    for (int tile = F.vcu; tile < tm * tn; tile += F.G) {
        const int m0 = (tile / tn) * 128, n0 = (tile % tn) * 128;
        float acc[4][8];
#pragma unroll
        for (int i = 0; i < 4; ++i)
#pragma unroll
            for (int j = 0; j < 8; ++j) acc[i][j] = 0.f;
        for (int k0 = 0; k0 < K; k0 += 16) {
            {
                const int row = tid >> 2, kq = (tid & 3) * 4;
                const u32x2 v = *(const u32x2*)(A + (size_t)(m0 + row) * lda + k0 + kq);
                As[(kq + 0) * 132 + row] = bf2f(v.x & 0xffffu); As[(kq + 1) * 132 + row] = bf2f(v.x >> 16);
                As[(kq + 2) * 132 + row] = bf2f(v.y & 0xffffu); As[(kq + 3) * 132 + row] = bf2f(v.y >> 16);
                const int kk = tid >> 5, nq = (tid & 31) * 4;
                f32x4 b = *(const f32x4*)(Bw + (size_t)(k0 + kk) * ldb + n0 + nq);
                const float s = kscale ? kscale[k0 + kk] : 1.f;
                b = b * s;
                *(LAS f32x4*)(Bs + kk * 128 + nq) = b;
            }
            __syncthreads();
#pragma unroll
            for (int kk = 0; kk < 16; ++kk) {
                const f32x4 a = *(const LAS f32x4*)(As + kk * 132 + ty * 4);
                const f32x4 b0 = *(const LAS f32x4*)(Bs + kk * 128 + tx * 8);
                const f32x4 b1 = *(const LAS f32x4*)(Bs + kk * 128 + tx * 8 + 4);
#pragma unroll
                for (int i = 0; i < 4; ++i) {
#pragma unroll
                    for (int j = 0; j < 4; ++j) { acc[i][j] += a[i] * b0[j]; acc[i][4 + j] += a[i] * b1[j]; }
                }
            }
            __syncthreads();
        }
#pragma unroll
        for (int i = 0; i < 4; ++i)
#pragma unroll
            for (int j = 0; j < 8; ++j) epi(m0 + ty * 4 + i, n0 + tx * 8 + j, acc[i][j]);
    }
}

struct EpiProj { Ctx F; __device__ __forceinline__ void operator()(int m, int n, float v) const { store_proj(F, m, n, v); } };
struct EpiGlu { bf16* ys; bf16* ymix; const float* gb;
    __device__ __forceinline__ void operator()(int m, int n, float v) const { const float y = bf2f(ys[(size_t)m * 256 + n]); ymix[(size_t)m * 1024 + n] = (bf16)f2bf(y * sigmoidf_(v + gb[n])); } };
struct EpiOut { const float* xin; float* R;
    __device__ __forceinline__ void operator()(int m, int n, float v) const { const size_t o = (size_t)m * D + n; R[o] = xin[o] + v; } };

__device__ __forceinline__ void ph_norm(const Ctx& F0, const float* xin) {
    const Ctx F = launder(F0);
    const int gw = F.vcu * NWAVES + F.wave, NGW = F.G * NWAVES;
    for (int m = gw; m < T; m += NGW) {
        const f32x4* xr = (const f32x4*)(xin + (size_t)m * D) + F.lane;
        f32x4 v[4]; float s = 0.f;
#pragma unroll
        for (int j = 0; j < 4; ++j) { v[j] = xr[64 * j]; s += (v[j].x * v[j].x + v[j].y * v[j].y) + (v[j].z * v[j].z + v[j].w * v[j].w); }
        const float rstd = 1.f / sqrtf(wave_sum(s) * (1.f / D) + RMS_EPS);
        unsigned long long* o8 = (unsigned long long*)(P_XB(F) + (size_t)m * D) + F.lane;
#pragma unroll
        for (int j = 0; j < 4; ++j) o8[64 * j] = (unsigned long long)pk2(v[j].x * rstd, v[j].y * rstd) | ((unsigned long long)pk2(v[j].z * rstd, v[j].w * rstd) << 32);
    }
}

__device__ __forceinline__ void ph_bias_table(const Ctx& F0) {
    const Ctx F = launder(F0);
    if (F.vcu == 0) {
        const float* rel_bias = F.in[1];
        for (int i = F.tid; i < 8 * 132; i += NTHREADS) {
            const int h = i / 132, r = i % 132;
            int bk;
            if (r < 16) bk = r;
            else { bk = 16 + (int)(logf((float)r / 16.f) / logf(8.f) * 16.f); if (bk > 31) bk = 31; }
            P_BT(F)[i] = rel_bias[bk * 8 + h] * LOG2E;
        }
    }
}

__device__ __forceinline__ void ph_kmean_naive(const Ctx& F0) {
    const Ctx F = launder(F0);
    const int gt = F.vcu * NTHREADS + F.tid, NGT = F.G * NTHREADS;
    for (int i = gt; i < 128 * 512; i += NGT) {
        const int pm = i >> 9, c = i & 511; float s = 0.f;
        for (int r = 0; r < 256; ++r) s += bf2f(P_KB(F)[(size_t)(pm * 256 + r) * 512 + c]);
        P_KMP(F)[i] = s; P_KMP(F)[128 * 512 + i] = 0.f;
    }
}

__device__ __forceinline__ void ph_ssm_naive(const Ctx& F0, int l) {
    const Ctx F = launder(F0);
    const int gw = F.vcu * NWAVES + F.wave, NGW = F.G * NWAVES;
    for (int it = gw; it < NB * SGN; it += NGW) {
        const int b = it / SGN, g = it % SGN, p = F.lane;
        const float are = F.in[4][(l * SGN + g) * SP + p], aim = F.in[5][(l * SGN + g) * SP + p];
        const float dt = __expf(F.in[6][l * SGN + g]);
        const float mag = expf(are * dt); float sn, cs; sincosf(aim * dt, &sn, &cs);
        const float lbr = mag * cs, lbi = mag * sn;
        const float nr = lbr - 1.f, ni = lbi, den = are * are + aim * aim;
        const float cr = (nr * are + ni * aim) / den, ci = (ni * are - nr * aim) / den;
        float bbr[16], bbi[16], ccr[16], cci[16];
#pragma unroll
        for (int h = 0; h < 16; ++h) {
            const float br = F.in[7][((size_t)(l * SGN + g) * SP + p) * SG + h], bi = F.in[8][((size_t)(l * SGN + g) * SP + p) * SG + h];
            bbr[h] = cr * br - ci * bi; bbi[h] = cr * bi + ci * br;
            ccr[h] = F.in[9][((size_t)(l * SGN + g) * SG + h) * SP + p]; cci[h] = F.in[10][((size_t)(l * SGN + g) * SG + h) * SP + p];
        }
        const float dh = (F.lane < 16) ? F.in[11][l * 256 + g * 16 + F.lane] : 0.f;
        float sr = 0.f, si = 0.f;
        for (int t = 0; t < SEQ; ++t) {
            const int m = b * SEQ + t;
            const bf16* up = P_UG(F) + ((size_t)(g * 512 + (m >> 6))) * UGP + (m & 63) * 16;
            const u32x4 u0 = *(const u32x4*)up, u1 = *(const u32x4*)(up + 8);
            float u[16];
            u[0] = bf2f(u0.x & 0xffffu); u[1] = bf2f(u0.x >> 16); u[2] = bf2f(u0.y & 0xffffu); u[3] = bf2f(u0.y >> 16);
            u[4] = bf2f(u0.z & 0xffffu); u[5] = bf2f(u0.z >> 16); u[6] = bf2f(u0.w & 0xffffu); u[7] = bf2f(u0.w >> 16);
            u[8] = bf2f(u1.x & 0xffffu); u[9] = bf2f(u1.x >> 16); u[10] = bf2f(u1.y & 0xffffu); u[11] = bf2f(u1.y >> 16);
            u[12] = bf2f(u1.z & 0xffffu); u[13] = bf2f(u1.z >> 16); u[14] = bf2f(u1.w & 0xffffu); u[15] = bf2f(u1.w >> 16);
            float bur = 0.f, bui = 0.f;
#pragma unroll
            for (int h = 0; h < 16; ++h) { bur += bbr[h] * u[h]; bui += bbi[h] * u[h]; }
            const float nsr = lbr * sr - lbi * si + bur, nsi = lbr * si + lbi * sr + bui;
            sr = nsr; si = nsi;
            float yo = 0.f, uo = 0.f;
#pragma unroll
            for (int h = 0; h < 16; ++h) {
                const float y = wave_sum(ccr[h] * sr - cci[h] * si);
                if (F.lane == h) { yo = y; uo = u[h]; }
            }
            if (F.lane < 16) P_YS(F)[(size_t)m * 256 + g * 16 + F.lane] = (bf16)f2bf(gelu_tanh(yo + dh * uo));
        }
    }
}

__device__ __forceinline__ void ph_pool_dl(const Ctx& F0) {
    const Ctx F = launder(F0);
    const int gt = F.vcu * NTHREADS + F.tid, NGT = F.G * NTHREADS;
    for (int i = gt; i < T * 256; i += NGT) {
        const int m = i >> 8, c = i & 255, t = m & (SEQ - 1), gi = c >> 6, win = 2 << gi;
        const int cnt = (t + 1 < win) ? t + 1 : win;
        float s = 0.f;
        for (int j = 0; j < cnt; ++j) s += bf2f(P_PB(F)[(size_t)(m - j) * 256 + c]);
        P_DL(F)[i] = (bf16)f2bf(s / (float)cnt - bf2f(P_PB(F)[i]));
    }
}
__device__ __forceinline__ void ph_pool_mm_naive(const Ctx& F0, int l) {
    const Ctx F = launder(F0);
    const int gt = F.vcu * NTHREADS + F.tid, NGT = F.G * NTHREADS;
    const float* w = F.in[14] + (size_t)l * 4 * 64 * 64;
    for (int i = gt; i < T * 256; i += NGT) {
        const int m = i >> 8, n = i & 255, gi = n >> 6, d = n & 63; float s = 0.f;
        for (int c = 0; c < 64; ++c) s += bf2f(P_DL(F)[(size_t)m * 256 + gi * 64 + c]) * w[(gi * 64 + c) * 64 + d];
        P_YMIX(F)[(size_t)m * 1024 + 256 + n] = (bf16)f2bf((s + F.in[15][l * 256 + n]) * F.in[16][l * 256 + n]);
    }
}

__device__ __forceinline__ void ph_attn_naive(const Ctx& F0) {
    const Ctx F = launder(F0);
    const int gw = F.vcu * NWAVES + F.wave, NGW = F.G * NWAVES, lane = F.lane;
    for (int it = gw; it < T * NHEAD; it += NGW) {
        const int h = it & 7, m = it >> 3, b = m >> 12, q = m & (SEQ - 1), qblk = q >> 8;
        const float qv = bf2f(P_QB(F)[(size_t)m * 512 + h * 64 + lane]);
        float mygate = -3.0e38f;
        for (int j = 0; j < qblk; ++j) {
            const int pm = b * NBLK + j;
            const float km = P_KMP(F)[pm * 512 + h * 64 + lane] + P_KMP(F)[128 * 512 + pm * 512 + h * 64 + lane];
            const float g = wave_sum(qv * km);
            if (lane == j) mygate = g;
        }
        int bsel0 = -1, bsel1 = -1, bsel2 = -1;
        const int nsel = qblk < 3 ? qblk : 3;
        for (int s = 0; s < nsel; ++s) {
            const float bv = wave_max(mygate);
            const unsigned long long bal = __ballot(mygate == bv);
            const int best = __builtin_ctzll(bal);
            if (s == 0) bsel0 = best; else if (s == 1) bsel1 = best; else bsel2 = best;
            if (lane == best) mygate = -3.0e38f;
        }
        float sc[16];
        float mx = -3.0e38f;
#pragma unroll
        for (int s = 0; s < 4; ++s) {
            const int blk = (s == 0) ? bsel0 : (s == 1) ? bsel1 : (s == 2) ? bsel2 : qblk;
#pragma unroll
            for (int c = 0; c < 4; ++c) {
                float v = -3.0e38f;
                if (blk >= 0) {
                    const int kpos = blk * 256 + c * 64 + lane, rel = q - kpos;
                    const bf16* kr = P_KB(F) + (size_t)(b * SEQ + kpos) * 512 + h * 64;
                    float dot = 0.f;
#pragma unroll
                    for (int d8 = 0; d8 < 8; ++d8) {
                        const u32x4 kk = *(const u32x4*)(kr + d8 * 8);
                        dot += __builtin_bit_cast(float, __builtin_amdgcn_readlane(__builtin_bit_cast(int, qv), d8 * 8 + 0)) * bf2f(kk.x & 0xffffu) + __builtin_bit_cast(float, __builtin_amdgcn_readlane(__builtin_bit_cast(int, qv), d8 * 8 + 1)) * bf2f(kk.x >> 16);
                        dot += __builtin_bit_cast(float, __builtin_amdgcn_readlane(__builtin_bit_cast(int, qv), d8 * 8 + 2)) * bf2f(kk.y & 0xffffu) + __builtin_bit_cast(float, __builtin_amdgcn_readlane(__builtin_bit_cast(int, qv), d8 * 8 + 3)) * bf2f(kk.y >> 16);
                        dot += __builtin_bit_cast(float, __builtin_amdgcn_readlane(__builtin_bit_cast(int, qv), d8 * 8 + 4)) * bf2f(kk.z & 0xffffu) + __builtin_bit_cast(float, __builtin_amdgcn_readlane(__builtin_bit_cast(int, qv), d8 * 8 + 5)) * bf2f(kk.z >> 16);
                        dot += __builtin_bit_cast(float, __builtin_amdgcn_readlane(__builtin_bit_cast(int, qv), d8 * 8 + 6)) * bf2f(kk.w & 0xffffu) + __builtin_bit_cast(float, __builtin_amdgcn_readlane(__builtin_bit_cast(int, qv), d8 * 8 + 7)) * bf2f(kk.w >> 16);
                    }
                    if (rel >= 0) v = dot + P_BT(F)[h * 132 + (rel < 128 ? rel : 128)];
                }
                sc[s * 4 + c] = v; mx = fmaxf(mx, v);
            }
        }
        mx = wave_max(mx);
        float sum = 0.f;
#pragma unroll
        for (int i = 0; i < 16; ++i) { sc[i] = (sc[i] > -1.0e38f) ? exp2f(sc[i] - mx) : 0.f; sum += sc[i]; }
        sum = wave_sum(sum);
        float o = 0.f;
#pragma unroll
        for (int s = 0; s < 4; ++s) {
            const int blk = (s == 0) ? bsel0 : (s == 1) ? bsel1 : (s == 2) ? bsel2 : qblk;
            if (blk >= 0) {
#pragma unroll
                for (int c = 0; c < 4; ++c) {
                    const bf16* vr = P_VB(F) + (size_t)(b * SEQ + blk * 256 + c * 64) * 512 + h * 64 + lane;
                    const float pc = sc[s * 4 + c];
                    for (int kk = 0; kk < 64; ++kk) {
                        const float p = __builtin_bit_cast(float, __builtin_amdgcn_readlane(__builtin_bit_cast(int, pc), kk));
                        o += p * bf2f(vr[(size_t)kk * 512]);
                    }
                }
            }
        }
        P_YMIX(F)[(size_t)m * 1024 + 512 + h * 64 + lane] = (bf16)f2bf(o / sum);
    }
}

__device__ __forceinline__ void ph_moe_naive(const Ctx& F0, int l) {
    const Ctx F = launder(F0);
    LAS float* h2 = (LAS float*)F.lds;
    LAS float* act = h2 + 1024;
    LAS float* red = act + 512;
    LAS float* lg = red + 32;
    LAS float* selw = lg + 24;
    const float* g2 = F.in[18] + l * D;
    const float* gw_ = F.in[19] + (size_t)l * D * 4; const float* gb_ = F.in[20] + l * 4;
    const float* rw_ = F.in[21] + (size_t)l * 4 * D * 4; const float* rb_ = F.in[22] + l * 16;
    const float* wg = F.in[23] + (size_t)l * 16 * D * 256; const float* wu = F.in[24] + (size_t)l * 16 * D * 256; const float* wd = F.in[25] + (size_t)l * 16 * 256 * D;
    const int tid = F.tid, lane = F.lane, wave = F.wave;
    for (int m = F.vcu; m < T; m += F.G) {
        float* xr = F.R + (size_t)m * D;
        const float x0 = xr[tid], x1 = xr[tid + 512];
        float s = wave_sum(x0 * x0 + x1 * x1);
        if (lane == 0) red[wave] = s;
        __syncthreads();
        float tot = 0.f;
#pragma unroll
        for (int w = 0; w < 8; ++w) tot += red[w];
        const float rstd = 1.f / sqrtf(tot * (1.f / D) + RMS_EPS);
        h2[tid] = x0 * rstd * g2[tid]; h2[tid + 512] = x1 * rstd * g2[tid + 512];
        __syncthreads();
        for (int j = wave; j < 20; j += NWAVES) {
            float a = 0.f;
            if (j < 4) { for (int k = lane; k < D; k += 64) a += h2[k] * gw_[k * 4 + j]; }
            else { const int g = (j - 4) >> 2, e = (j - 4) & 3; for (int k = lane; k < D; k += 64) a += h2[k] * rw_[((size_t)g * D + k) * 4 + e]; }
            a = wave_sum(a);
            if (lane == 0) lg[j] = a + (j < 4 ? gb_[j] : rb_[j - 4]);
        }
        __syncthreads();
        if (tid == 0) {
            int gs = 0; float gm = lg[0];
            for (int j = 1; j < 4; ++j) if (lg[j] > gm) { gm = lg[j]; gs = j; }
            float se = 0.f; for (int j = 0; j < 4; ++j) se += __expf(lg[j] - gm);
            const float gwt = 1.f / se;
            int e1 = 0; float v1 = lg[4 + gs * 4];
            for (int e = 1; e < 4; ++e) if (lg[4 + gs * 4 + e] > v1) { v1 = lg[4 + gs * 4 + e]; e1 = e; }
            int e2 = -1; float v2 = -3.0e38f;
            for (int e = 0; e < 4; ++e) if (e != e1 && lg[4 + gs * 4 + e] > v2) { v2 = lg[4 + gs * 4 + e]; e2 = e; }
            const float p2 = __expf(v2 - v1), w1 = 1.f / (1.f + p2), w2 = p2 / (1.f + p2);
            selw[0] = __builtin_bit_cast(float, gs * 4 + e1); selw[1] = __builtin_bit_cast(float, gs * 4 + e2);
            selw[2] = gwt * w1; selw[3] = gwt * w2;
        }
        __syncthreads();
        {
            const int slot = tid >> 8, f = tid & 255;
            const int e = __builtin_bit_cast(int, selw[slot]); const float cw = selw[2 + slot];
            const float* pg = wg + (size_t)e * D * 256 + f; const float* pu = wu + (size_t)e * D * 256 + f;
            float ag = 0.f, au = 0.f;
            for (int k = 0; k < D; ++k) { const float hv = h2[k]; ag += hv * pg[(size_t)k * 256]; au += hv * pu[(size_t)k * 256]; }
            act[slot * 256 + f] = ag * sigmoidf_(ag) * au * cw;
        }
        __syncthreads();
        {
            const int ea = __builtin_bit_cast(int, selw[0]), eb = __builtin_bit_cast(int, selw[1]);
            const float* pa = wd + (size_t)ea * 256 * D; const float* pb = wd + (size_t)eb * 256 * D;
            float y0 = 0.f, y1 = 0.f;
            for (int f = 0; f < 256; ++f) {
                const float a = act[f], b = act[256 + f];
                y0 += a * pa[(size_t)f * D + tid] + b * pb[(size_t)f * D + tid];
                y1 += a * pa[(size_t)f * D + tid + 512] + b * pb[(size_t)f * D + tid + 512];
            }
            xr[tid] = x0 + y0; xr[tid + 512] = x1 + y1;
        }
        __syncthreads();
    }
}

__device__ __forceinline__ void ph_final(const Ctx& F0) {
    const Ctx F = launder(F0);
    const int gw = F.vcu * NWAVES + F.wave, NGW = F.G * NWAVES;
    const f32x4* gf = (const f32x4*)F.in[26] + F.lane;
    for (int m = gw; m < T; m += NGW) {
        f32x4* xr = (f32x4*)(F.R + (size_t)m * D) + F.lane;
        f32x4 v[4]; float s = 0.f;
#pragma unroll
        for (int j = 0; j < 4; ++j) { v[j] = xr[64 * j]; s += (v[j].x * v[j].x + v[j].y * v[j].y) + (v[j].z * v[j].z + v[j].w * v[j].w); }
        const float rstd = 1.f / sqrtf(wave_sum(s) * (1.f / D) + RMS_EPS);
#pragma unroll
        for (int j = 0; j < 4; ++j) xr[64 * j] = v[j] * rstd * gf[64 * j];
    }
}

constexpr int LDS_BYTES = 147456;
constexpr int MISC_OFF = 131072 + 320;

__global__ void __launch_bounds__(NTHREADS, 2) mk_fwd(Args args) {
    extern __shared__ __attribute__((aligned(16))) unsigned char lds[];
    Ctx F;
    F.lds = (LAS unsigned char*)lds;
    F.wave = __builtin_amdgcn_readfirstlane((int)threadIdx.x >> 6);
    F.lane = lane_id(); F.tid = F.wave * 64 + F.lane;
    F.G = gridDim.x; { const int bx = blockIdx.x; F.vcu = (F.G % 8 == 0) ? (bx % 8) * (F.G / 8) + bx / 8 : bx; }
    F.in = (KargP)__builtin_amdgcn_kernarg_segment_ptr(); F.R = args.out; F.ws = args.ws;
    unsigned char* ws = args.ws;
    volatile LAS unsigned* MISC = (volatile LAS unsigned*)(F.lds + MISC_OFF);
    if (F.tid < 64) MISC[F.tid] = 0u;
    __syncthreads();
    XcdBarrier bar = xcd_barrier_post((unsigned*)(ws + WS_CTL) + CW_BAR, MISC + 8, F.tid == 0);
#define GRID_BAR() do { bar.bar = (unsigned*)(wsl(ws) + WS_CTL) + CW_BAR; xcd_barrier(bar, F.wave); } while (0)
#define FL launder(F)

    ph_bias_table(F);
#if USE_ENG_PROJ
    ph_prologue(F);
#endif
#pragma unroll 1
    for (int l = 0; l < DEPTH; ++l) {
        const float* xin = (l == 0) ? F.in[0] : F.R;
        ph_norm(F, xin);
        GRID_BAR();
#if USE_ENG_PROJ
        { pg8::Gemm g{P_XB(FL), (const bf16*)(wsl(ws) + WS_WIN) + (size_t)l * NPROJ * D, D, D, D}; pg8::StaticOrder S; S.init(T, NPROJ, sl(F.G), sl((int)blockIdx.x));
          EpiProjE E{P_UG(FL), P_PB(FL), P_QB(FL), P_KB(FL), P_VB(FL), P_KMP(FL)}; pg8::gemm_phase(F.lds, g, S, E, sl(F.wave)); }
#else
        { EpiProj E{F}; naive_gemm(F, P_XB(FL), D, F.in[3] + (size_t)l * D * NPROJ, NPROJ, F.in[2] + l * D, T, NPROJ, D, E); }
#endif
        GRID_BAR();
#if USE_ENG_SSM
        { pg8::Gemm g{P_UG(FL), (const bf16*)(wsl(ws) + WS_BZ) + (size_t)l * SGN * 256 * 1024, UGP, 1024, 1024}; SsmOrder S{sl(F.G), sl((int)blockIdx.x), 1};
          EpiZ E{(float*)(wsl(ws) + WS_ZB)}; pg8::gemm_phase(F.lds, g, S, E, sl(F.wave)); }
        ph_pool_dl(F);
        GRID_BAR();
        ph_ssm_scan(F, l);
        GRID_BAR();
        { pg8::Gemm g{P_UG(FL), (const bf16*)(wsl(ws) + WS_TG) + (size_t)l * SGN * 1024 * UGP, UGP, UGP, UGP}; SsmOrder S{sl(F.G), sl((int)blockIdx.x), 2};
          EpiSsm2 E{P_UG(FL), P_YS(FL), F.in[11] + l * 256}; pg8::gemm_phase(F.lds, g, S, E, sl(F.wave)); }
        GRID_BAR();
        { pg8::Gemm g{P_YS(FL), (const bf16*)(wsl(ws) + WS_GLUT) + (size_t)l * 65536, 256, 256, 256}; HalfOrder S{sl(F.vcu)};
          EpiGluE E{P_YS(FL), P_YMIX(FL), F.in[13] + l * 256}; pg8::gemm_phase(F.lds, g, S, E, sl(F.wave)); }
        { pg8::Gemm g{P_DL(FL), (const bf16*)(wsl(ws) + WS_POOLT) + (size_t)l * 65536, 256, 256, 256}; HalfOrder S{sl(F.vcu) - 128};
          EpiPoolE E{P_YMIX(FL), F.in[15] + l * 256, F.in[16] + l * 256}; pg8::gemm_phase(F.lds, g, S, E, sl(F.wave)); }
#else
        ph_ssm_naive(F, l);
#if !USE_ENG_PROJ
        ph_kmean_naive(F);
#endif
        ph_pool_dl(F);
        GRID_BAR();
        { EpiGlu E{P_YS(FL), P_YMIX(FL), F.in[13] + l * 256}; naive_gemm(F, P_YS(FL), 256, F.in[12] + (size_t)l * 256 * 256, 256, nullptr, T, 256, 256, E); }
        ph_pool_mm_naive(F, l);
#endif
#if USE_FAST_ATTN == 2
        moba::phase(sl(F.wave), sl(F.vcu), P_QB(FL), P_KB(FL), P_VB(FL), P_YMIX(FL), P_KMP(FL), P_BT(FL), (LAS char*)F.lds);
#elif USE_FAST_ATTN
        { const attn_body::AttnTensors AT{(const attn_body::abf16*)P_QB(FL), (const attn_body::abf16*)P_KB(FL), (const attn_body::abf16*)P_VB(FL), (attn_body::abf16*)P_YMIX(FL), P_KMP(FL), P_BT(FL)};
          const attn_body::StaticOrder S(sl(F.vcu)); attn_body::attn_phase<attn_body::StaticOrder>(sl(F.wave), (char*)lds, AT, S); }
#else
        ph_attn_naive(F);
#endif
        GRID_BAR();
#if USE_ENG_PROJ
        { pg8::Gemm g{P_YMIX(FL), (const bf16*)(wsl(ws) + WS_WOUT) + (size_t)l * D * D, D, D, D}; pg8::StaticOrder S; S.init(T, D, sl(F.G), sl((int)blockIdx.x));
          EpiOutE E{xin, F.R}; pg8::gemm_phase(F.lds, g, S, E, sl(F.wave)); }
#else
        { EpiOut E{xin, F.R}; naive_gemm(F, P_YMIX(FL), D, F.in[17] + (size_t)l * D * D, D, nullptr, T, D, D, E); }
#endif
        GRID_BAR();
#if USE_ENG_MOE
        ph_route(F, l);
        GRID_BAR();
        ph_place(F);
        GRID_BAR();
        { pg8::Gemm g{(const bf16*)(wsl(ws) + WS_XS), (const bf16*)(wsl(ws) + WS_GU) + (size_t)l * 16 * 512 * D, D, D, D}; MoeOrder S{(const int*)(wsl(ws) + WS_TILEB), sl(F.G), sl((int)blockIdx.x), false};
          EpiGU E{(bf16*)(wsl(ws) + WS_HACT), (const float*)(wsl(ws) + WS_ROWW)}; pg8::gemm_phase(F.lds, g, S, E, sl(F.wave)); }
        GRID_BAR();
        { pg8::Gemm g{(const bf16*)(wsl(ws) + WS_HACT), (const bf16*)(wsl(ws) + WS_WD) + (size_t)l * 24 * D * 512, 512, 512, 512}; MoeOrder S{(const int*)(wsl(ws) + WS_TILEB), sl(F.G), sl((int)blockIdx.x), true};
          EpiDown E{F.R, (const int*)(wsl(ws) + WS_ROWTOK)}; pg8::gemm_phase(F.lds, g, S, E, sl(F.wave)); }
        GRID_BAR();
#else
        ph_moe_naive(F, l);
        GRID_BAR();
#endif
    }
    ph_final(F);
}

extern "C" void kernel_launch(void* const* d_in, const int* in_sizes, int n_in, void* d_out, int out_size, void* d_ws, size_t ws_size, hipStream_t stream) {
    static int grid = 0;
    if (grid == 0) {
        if (n_in != 27 || out_size != T * D || ws_size < WS_END) { fprintf(stderr, "kernel_launch: unexpected shapes (n_in %d out %d ws %zu)\n", n_in, out_size, ws_size); grid = -1; return; }
        int dev = 0, cus = 0, per_cu = 0;
        if (hipGetDevice(&dev) != hipSuccess || hipDeviceGetAttribute(&cus, hipDeviceAttributeMultiprocessorCount, dev) != hipSuccess) { grid = -1; return; }
        if (hipFuncSetAttribute((const void*)mk_fwd, hipFuncAttributeMaxDynamicSharedMemorySize, LDS_BYTES) != hipSuccess) { fprintf(stderr, "kernel_launch: hipFuncSetAttribute failed\n"); grid = -1; return; }
        if (hipOccupancyMaxActiveBlocksPerMultiprocessor(&per_cu, (const void*)mk_fwd, NTHREADS, LDS_BYTES) != hipSuccess || per_cu < 1) { fprintf(stderr, "kernel_launch: occupancy query says %d\n", per_cu); per_cu = 1; }
        (void)hipGetLastError();
        grid = cus;
    }
    if (grid < 0) return;
    (void)hipMemsetAsync((char*)d_ws + WS_CTL, 0, CTL_ZERO_BYTES, stream);
    Args a{};
    for (int i = 0; i < 27; ++i) a.in[i] = (const float*)d_in[i];
    a.out = (float*)d_out; a.ws = (unsigned char*)d_ws; a.ph_lo = 0; a.ph_hi = 0;
    hipLaunchKernelGGL(mk_fwd, dim3(grid), dim3(NTHREADS), LDS_BYTES, stream, a);
}
```

```cpp
#include <hip/hip_runtime.h>
#include <hip/hip_bf16.h>
#include <cstdio>
#include <cstdint>

#define GAS __attribute__((address_space(1)))
#define LAS __attribute__((address_space(3)))
typedef unsigned short bf16;
typedef float f32x4 __attribute__((ext_vector_type(4)));
typedef unsigned u32x4 __attribute__((ext_vector_type(4)));
typedef unsigned u32x2 __attribute__((ext_vector_type(2)));

constexpr int NB = 8, SEQ = 4096, T = NB * SEQ, D = 1024, NPROJ = 2048, DEPTH = 2;
constexpr int NHEAD = 8, HD = 64, MBLK = 256, NBLK = SEQ / MBLK;
constexpr int SG = 16, SGN = 16, SP = 64, SCH = 64, UGP = 1152;
constexpr float RMS_EPS = 1e-6f;
constexpr float LOG2E = 1.4426950408889634f;
constexpr float C2 = 0.125f * LOG2E;
constexpr int NWAVES = 8, NTHREADS = 512;
#ifndef USE_ENG_PROJ
#define USE_ENG_PROJ 1
#endif
#ifndef USE_ENG_SSM
#define USE_ENG_SSM 1
#endif
#ifndef USE_FAST_ATTN
#define USE_FAST_ATTN 2
#endif
#ifndef USE_ENG_MOE
#define USE_ENG_MOE 1
#endif

constexpr size_t MiB = 1u << 20;
constexpr size_t WS_CTL = 0, CTL_ZERO_BYTES = 1 * MiB;
constexpr size_t WS_XB = 2 * MiB;
constexpr size_t WS_UG = 66 * MiB;
constexpr size_t WS_PB = 84 * MiB;
constexpr size_t WS_QB = 100 * MiB;
constexpr size_t WS_KB = 132 * MiB;
constexpr size_t WS_VB = 164 * MiB;
constexpr size_t WS_YMIX = 196 * MiB;
constexpr size_t WS_YS = 260 * MiB;
constexpr size_t WS_DL = 276 * MiB;
constexpr size_t WS_KMP = 292 * MiB;
constexpr size_t WS_BT = 293 * MiB;
constexpr size_t WS_WIN = 300 * MiB;
constexpr size_t WS_WOUT = 308 * MiB;
constexpr size_t WS_GU = 312 * MiB;
constexpr size_t WS_WD = 344 * MiB;
constexpr size_t WS_TG = 392 * MiB;
constexpr size_t WS_BZ = 464 * MiB;
constexpr size_t WS_GLUT = 480 * MiB;
constexpr size_t WS_POOLT = WS_GLUT + 512 * 1024;
constexpr size_t WS_ZB = 482 * MiB;
constexpr size_t WS_END = 486 * MiB;
constexpr int MOE_MAXT = 152;
constexpr size_t WS_XS = 66 * MiB;
constexpr size_t WS_HACT = 142 * MiB;
constexpr size_t WS_TOKB = 294 * MiB;
constexpr size_t WS_TOKR = WS_TOKB + 128 * 1024;
constexpr size_t WS_TOKW = WS_TOKB + 256 * 1024;
constexpr size_t WS_ROWTOK = 295 * MiB;
constexpr size_t WS_ROWW = WS_ROWTOK + 256 * 1024;
constexpr size_t WS_WGCNT = 296 * MiB;
constexpr size_t WS_TILEB = WS_WGCNT + 64 * 1024;

constexpr int CW_BAR = 4096;

__device__ __forceinline__ unsigned f2bf(float f) { unsigned u = __builtin_bit_cast(unsigned, f); return (u + 0x7fffu + ((u >> 16) & 1u)) >> 16; }
__device__ __forceinline__ float bf2f(unsigned h) { return __builtin_bit_cast(float, h << 16); }
__device__ __forceinline__ unsigned pk2(float lo, float hi) { return f2bf(lo) | (f2bf(hi) << 16); }
template <int O> __device__ __forceinline__ float xshfl(float v) {
    if constexpr (O < 32) return __builtin_bit_cast(float, __builtin_amdgcn_ds_swizzle(__builtin_bit_cast(int, v), (O << 10) | 0x1f));
    else { const unsigned u = __builtin_bit_cast(unsigned, v); auto r = __builtin_amdgcn_permlane32_swap(u, u, false, false);
           const float a = __builtin_bit_cast(float, (unsigned)r[0]), b = __builtin_bit_cast(float, (unsigned)r[1]); return (a == v && __builtin_bit_cast(unsigned, a) == u) ? b : a; }
}
__device__ __forceinline__ float wave_sum(float v) {
    v += xshfl<1>(v); v += xshfl<2>(v); v += xshfl<4>(v); v += xshfl<8>(v); v += xshfl<16>(v);
    const unsigned u = __builtin_bit_cast(unsigned, v); auto r = __builtin_amdgcn_permlane32_swap(u, u, false, false);
    return __builtin_bit_cast(float, (unsigned)r[0]) + __builtin_bit_cast(float, (unsigned)r[1]);
}
__device__ __forceinline__ float wave_max(float v) {
    v = fmaxf(v, xshfl<1>(v)); v = fmaxf(v, xshfl<2>(v)); v = fmaxf(v, xshfl<4>(v)); v = fmaxf(v, xshfl<8>(v)); v = fmaxf(v, xshfl<16>(v));
    const unsigned u = __builtin_bit_cast(unsigned, v); auto r = __builtin_amdgcn_permlane32_swap(u, u, false, false);
    return fmaxf(__builtin_bit_cast(float, (unsigned)r[0]), __builtin_bit_cast(float, (unsigned)r[1]));
}
__device__ __forceinline__ float gelu_tanh(float x) {
    const float u = 0.7978845608028654f * (x + 0.044715f * x * x * x);
    const float e = __expf(2.f * u);
    const float th = 1.f - 2.f / (e + 1.f);
    return 0.5f * x * (1.f + th);
}
__device__ __forceinline__ float sigmoidf_(float x) { return 1.f / (1.f + __expf(-x)); }

__device__ __forceinline__ int lane_id() { unsigned m; asm volatile("s_mov_b32 %0, -1" : "=s"(m)); return (int)__builtin_amdgcn_mbcnt_hi(m, __builtin_amdgcn_mbcnt_lo(m, 0u)); }

#define XB_TMO      128
#define XB_XCNT(j)  (256  + 64 * (j))
#define XB_XSUB(j)  (1280 + 64 * (j))
#define XB_XGEN(j)  (2304 + 64 * (j))
#define XB_TOP      3328
#define XB_TOPGEN   3392
#define XCD_BAR_WORDS 3456
#define XB_SPIN_CAP (1u << 22)
__device__ __forceinline__ unsigned xb_ld(unsigned* p)              { return __hip_atomic_load(p, __ATOMIC_RELAXED, __HIP_MEMORY_SCOPE_AGENT); }
__device__ __forceinline__ unsigned xb_add(unsigned* p, unsigned v) { return __hip_atomic_fetch_add(p, v, __ATOMIC_RELAXED, __HIP_MEMORY_SCOPE_AGENT); }
__device__ __forceinline__ unsigned xb_xcc_id() { return (unsigned)__builtin_amdgcn_s_getreg((3 << 11) | 20) & 0xFu; }
#define XB_SPIN(cond, bar) do { unsigned _sp = 0; while (cond) { __builtin_amdgcn_s_sleep(1); \
    if ((++_sp & 255u) == 0u) { if (xb_ld(&(bar)[XB_TMO])) break; if (_sp > XB_SPIN_CAP) { atomicAdd(&(bar)[XB_TMO], 1u); break; } } } } while (0)
struct XcdBarrier { unsigned* bar; unsigned x; volatile LAS unsigned* st; };
__device__ __forceinline__ XcdBarrier xcd_barrier_post(unsigned* bar, volatile LAS unsigned* st, bool t0) {
    XcdBarrier b; b.bar = bar; b.x = xb_xcc_id(); b.st = st;
    if (t0) (void)xb_add(&bar[XB_XCNT(b.x)], 1u);
    return b;
}
__device__ __forceinline__ void xcd_barrier_complete(unsigned* bar, unsigned x, unsigned& nloc, unsigned& nx) {
    const unsigned G = gridDim.x * gridDim.y * gridDim.z;
    unsigned sum, cnt, mine, sp = 0u;
    for (;;) {
        sum = 0u; cnt = 0u; mine = 0u;
#pragma unroll
        for (unsigned j = 0; j < 16; ++j) { const unsigned c = xb_ld(&bar[XB_XCNT(j)]); sum += c; cnt += (c > 0u) ? 1u : 0u; mine = (j == x) ? c : mine; }
        if (sum == G) break;
        __builtin_amdgcn_s_sleep(1);
        if ((++sp & 255u) == 0u) { if (xb_ld(&bar[XB_TMO])) break; if (sp > XB_SPIN_CAP) { atomicAdd(&bar[XB_TMO], 1u); break; } }
    }
    nloc = mine > 0u ? mine : 1u; nx = cnt > 0u ? cnt : 1u;
}
__device__ __forceinline__ void xcd_barrier(const XcdBarrier& b, int wave) {
    asm volatile("s_waitcnt vmcnt(0)" ::: "memory");
    __syncthreads();
    if (wave == 0 && lane_id() == 0) {
        unsigned* bar = b.bar;
        __builtin_amdgcn_s_waitcnt(0);
        unsigned nloc = b.st[0], nx = b.st[1];
        if (nloc == 0u) { xcd_barrier_complete(bar, b.x, nloc, nx); b.st[0] = nloc; b.st[1] = nx; }
        const unsigned old = xb_add(&bar[XB_XSUB(b.x)], 1u);
        const unsigned gen = old / nloc;
        if (old + 1u == (gen + 1u) * nloc) {
            __builtin_amdgcn_fence(__ATOMIC_RELEASE, "agent");
            asm volatile("s_waitcnt vmcnt(0)" ::: "memory");
            const unsigned og = xb_add(&bar[XB_TOP], 1u);
            const unsigned tg = og / nx;
            if (og + 1u == (tg + 1u) * nx) xb_add(&bar[XB_TOPGEN], 1u);
            else XB_SPIN(xb_ld(&bar[XB_TOPGEN]) == tg, bar);
            __builtin_amdgcn_fence(__ATOMIC_ACQUIRE, "agent");
            xb_add(&bar[XB_XGEN(b.x)], 1u);
            asm volatile("s_waitcnt vmcnt(0)" ::: "memory");
        } else {
            XB_SPIN(xb_ld(&bar[XB_XGEN(b.x)]) == gen, bar);
            __builtin_amdgcn_fence(__ATOMIC_ACQUIRE, "agent");
            asm volatile("s_waitcnt vmcnt(0)" ::: "memory");
        }
    }
    __syncthreads();
}

__device__ __forceinline__ void simple_barrier(unsigned* cnt, volatile LAS unsigned* ep, int wave) {
    asm volatile("s_waitcnt vmcnt(0)" ::: "memory");
    __syncthreads();
    if (wave == 0 && lane_id() == 0) {
        __threadfence();
        asm volatile("s_waitcnt vmcnt(0)" ::: "memory");
        const unsigned e = ep[0] + 1u; ep[0] = e; const unsigned target = e * gridDim.x;
        (void)xb_add(cnt, 1u);
        unsigned sp = 0;
        while (xb_ld(cnt) < target) { __builtin_amdgcn_s_sleep(2); if (++sp > (1u << 24)) break; }
        __threadfence();
        asm volatile("s_waitcnt vmcnt(0)" ::: "memory");
    }
    __syncthreads();
}

struct Args {
    const float* in[27];
    float* out;
    unsigned char* ws;
    int ph_lo, ph_hi;
};

typedef const float* fptr_t;
typedef __attribute__((address_space(4))) const fptr_t* KargP;
struct Ctx {
    LAS unsigned char* lds;
    int tid, lane, wave, vcu, G;
    KargP in;
    float* R;
    unsigned char* ws;
};
#define P_XB(F) ((bf16*)((F).ws + WS_XB))
#define P_UG(F) ((bf16*)((F).ws + WS_UG))
#define P_PB(F) ((bf16*)((F).ws + WS_PB))
#define P_QB(F) ((bf16*)((F).ws + WS_QB))
#define P_KB(F) ((bf16*)((F).ws + WS_KB))
#define P_VB(F) ((bf16*)((F).ws + WS_VB))
#define P_YMIX(F) ((bf16*)((F).ws + WS_YMIX))
#define P_YS(F) ((bf16*)((F).ws + WS_YS))
#define P_DL(F) ((bf16*)((F).ws + WS_DL))
#define P_KMP(F) ((float*)((F).ws + WS_KMP))
#define P_BT(F) ((float*)((F).ws + WS_BT))


__device__ __forceinline__ Ctx launder(const Ctx& F0) {
    Ctx F = F0;
    int ln = lane_id(); asm volatile("" : "+v"(ln));
    asm volatile("" : "+s"(F.wave), "+s"(F.vcu), "+s"(F.G));
    F.lane = ln; F.tid = F.wave * 64 + ln;
    KargP kp = (KargP)__builtin_amdgcn_kernarg_segment_ptr(); asm volatile("" : "+s"(kp));
    F.in = kp; F.R = (float*)kp[27]; F.ws = (unsigned char*)kp[28];
    return F;
}

__device__ __forceinline__ unsigned char* wsl(unsigned char* p) { asm volatile("" : "+s"(p)); return p; }
__device__ __forceinline__ int sl(int x) { asm volatile("" : "+s"(x)); return x; }

__device__ __forceinline__ void store_proj(const Ctx& F, int m, int c, float v) {
    if (c < 256) { const int g = c >> 4, h = c & 15; P_UG(F)[((size_t)(g * 512 + (m >> 6))) * UGP + (m & 63) * 16 + h] = (bf16)f2bf(v); }
    else if (c < 512) P_PB(F)[(size_t)m * 256 + (c - 256)] = (bf16)f2bf(v);
    else if (c < 1024) P_QB(F)[(size_t)m * 512 + (c - 512)] = (bf16)f2bf(v * C2);
    else if (c < 1536) P_KB(F)[(size_t)m * 512 + (c - 1024)] = (bf16)f2bf(v);
    else P_VB(F)[(size_t)m * 512 + (c - 1536)] = (bf16)f2bf(v);
}


namespace pg8 {
typedef short bf16x8 __attribute__((ext_vector_type(8)));
constexpr int BM = 256, BK = 64, HALF = 128, HTB = HALF * BK * 2, STAGE_BYTES = 8 * HTB, NXCD = 8, WGM = 8;
__device__ __forceinline__ int lds_byte(int r, int c) { const int st = (r >> 4) * 2 + (c >> 5), rr = r & 15, cc = c & 31, ob = rr * 64 + cc * 2; return st * 1024 + (ob ^ (((ob >> 9) & 1) << 5)); }
__device__ __forceinline__ void stage_rc(int b, int& R, int& C) { const int st = b / 1024, sb = b % 1024, swz = sb ^ (((sb >> 9) & 1) << 5); R = (st >> 1) * 16 + swz / 64; C = (st & 1) * 32 + (swz % 64) / 2; }
__device__ __forceinline__ int perm32(int rho) { const int n = rho >> 4, i = rho & 15; return 8 * (i >> 2) + 4 * n + (i & 3); }

struct Unit { int pm, pn, aux; };
struct Gemm { const bf16* A; const bf16* Bt; int lda, ldb, K; };

struct StaticOrder {
    int nM, nN, nwg, G, c;
    __device__ void init(int M, int N, int G_, int c_) { nM = M / BM; nN = N / BM; nwg = nM * nN; G = G_; c = c_; }
    __device__ bool next(int i, Unit& u) const {
        const long L = (long)i * G + c; if (L >= nwg) return false;
        int wgid = (int)L; { const int q = nwg / NXCD, r = nwg % NXCD, xcd = wgid % NXCD, off = wgid / NXCD; wgid = (xcd < r ? xcd * (q + 1) : r * (q + 1) + (xcd - r) * q) + off; }
        const int nig = WGM * nN, gid = wgid / nig, fm = gid * WGM, gsz = (nM - fm) < WGM ? (nM - fm) : WGM;
        u.pm = fm + ((wgid % nig) % gsz); u.pn = (wgid % nig) / gsz; u.aux = 0; return true;
    }
};

__device__ __forceinline__ unsigned cvt_pk_bf16(float lo, float hi) { unsigned r; asm volatile("v_cvt_pk_bf16_f32 %0, %1, %2" : "=v"(r) : "v"(lo), "v"(hi)); return r; }

template <class Epi, class Sched>
__device__ __forceinline__ void gemm_phase(LAS unsigned char* lds, const Gemm g, const Sched& S, const Epi& E, int wave_) {
    int lane_ = lane_id(); asm volatile("" : "+v"(lane_)); asm volatile("" : "+s"(wave_));
    const int wid = wave_, lane = lane_, tid = wid * 64 + lane, wr = wid >> 2, wc = wid & 3, fr = lane & 15, fq = lane >> 4;
    const int K = g.K, nt = K / BK;
    unsigned voffA[2], voffB[2];
#pragma unroll
    for (int i = 0; i < 2; ++i) { int R, C; stage_rc(tid * 16 + i * 8192, R, C); const int Rb = Epi::PERM ? ((R & ~31) + perm32(R & 31)) : R;
        voffA[i] = (unsigned)(R * g.lda + C) * 2u; voffB[i] = (unsigned)(Rb * g.ldb + C) * 2u; }
    const size_t kstep = (size_t)(BK * 2);
    const size_t hstepA = (size_t)HALF * g.lda * 2, hstepB = (size_t)HALF * g.ldb * 2;
    const size_t tstepA = 2 * hstepA, tstepB = 2 * hstepB;
    const unsigned ldsw = (unsigned)wid * 1024u;
    const int aoff = lds_byte(wr * 64 + fr, fq * 8), boff = lds_byte(wc * 32 + fr, fq * 8);
#define PG8_SA(b, h) (((b) * 2 + (h)) * HTB)
#define PG8_SB(b, h) ((4 + (b) * 2 + (h)) * HTB)
#define PG8_STAGE(bufoff, gbase, voff) do { _Pragma("unroll") for (int _i = 0; _i < 2; ++_i) \
        __builtin_amdgcn_global_load_lds((const unsigned*)((const char*)(gbase) + (voff)[_i]), (LAS unsigned*)(lds + (bufoff) + ldsw + _i * 8192), 16, 0, 0); } while (0)
#define PG8_LDA(dst, b, h) do { _Pragma("unroll") for (int m = 0; m < 4; ++m) _Pragma("unroll") for (int k = 0; k < 2; ++k) dst[m][k] = *(const LAS bf16x8*)(lds + PG8_SA(b, h) + aoff + m * 2048 + k * 1024); } while (0)
#define PG8_LDB(dst, b, h) do { _Pragma("unroll") for (int n = 0; n < 2; ++n) _Pragma("unroll") for (int k = 0; k < 2; ++k) dst[n][k] = *(const LAS bf16x8*)(lds + PG8_SB(b, h) + boff + n * 2048 + k * 1024); } while (0)
#define PG8_MMA(ai, bj, At, Bt) do { __builtin_amdgcn_s_setprio(1); _Pragma("unroll") for (int m = 0; m < 4; ++m) _Pragma("unroll") for (int n = 0; n < 2; ++n) _Pragma("unroll") for (int k = 0; k < 2; ++k) \
        acc[ai][bj][m][n] = __builtin_amdgcn_mfma_f32_16x16x32_bf16(Bt[n][k], At[m][k], acc[ai][bj][m][n], 0, 0, 0); __builtin_amdgcn_s_setprio(0); } while (0)
#define PG8_WAIT_V(n) asm volatile("s_waitcnt vmcnt(" #n ")" ::: "memory")
#define PG8_WAIT_L(n) asm volatile("s_waitcnt lgkmcnt(" #n ")" ::: "memory")
#define PG8_BAR __builtin_amdgcn_s_barrier()
#define PG8_SCHED __builtin_amdgcn_sched_barrier(0)
    Unit cur, nxt; int ui = 0;
    if (!S.next(0, cur)) return;
    f32x4 acc[2][2][4][2];
#pragma unroll
    for (int a = 0; a < 2; ++a)
#pragma unroll
        for (int b = 0; b < 2; ++b)
#pragma unroll
            for (int m = 0; m < 4; ++m)
#pragma unroll
                for (int n = 0; n < 2; ++n) acc[a][b][m][n] = (f32x4){0.f, 0.f, 0.f, 0.f};
    bf16x8 At[4][2], B0[2][2], B1[2][2];
    const char* cA = (const char*)g.A + (size_t)cur.pm * tstepA; const char* cB = (const char*)g.Bt + (size_t)cur.pn * tstepB;
    PG8_STAGE(PG8_SB(0, 0), cB, voffB); PG8_STAGE(PG8_SB(0, 1), cB + hstepB, voffB); PG8_STAGE(PG8_SA(0, 0), cA, voffA); PG8_STAGE(PG8_SA(0, 1), cA + hstepA, voffA);
    if (wr == 1) PG8_BAR;
    PG8_WAIT_V(2); PG8_BAR;
    PG8_STAGE(PG8_SB(1, 0), cB + kstep, voffB); PG8_STAGE(PG8_SA(1, 0), cA + kstep, voffA); PG8_STAGE(PG8_SB(1, 1), cB + hstepB + kstep, voffB);
    PG8_WAIT_V(6); PG8_BAR;
    for (;;) {
        const bool has_next = S.next(ui + 1, nxt);
        const char* nA = has_next ? (const char*)g.A + (size_t)nxt.pm * tstepA : cA; const char* nB = has_next ? (const char*)g.Bt + (size_t)nxt.pn * tstepB : cB;
        for (int t = 0; t < nt; t += 2) {
            const bool last = (t == nt - 2);
            const char* a1 = cA + (size_t)(t + 1) * kstep;
            const char* a2 = last ? nA : cA + (size_t)(t + 2) * kstep; const char* b2 = last ? nB : cB + (size_t)(t + 2) * kstep;
            const char* a3 = a2 + kstep; const char* b3 = b2 + kstep;
            PG8_LDB(B0, 0, 0); PG8_LDB(B1, 0, 1); PG8_SCHED; PG8_LDA(At, 0, 0); PG8_STAGE(PG8_SA(1, 1), a1 + hstepA, voffA);
            PG8_WAIT_V(8); PG8_WAIT_L(0); PG8_BAR; PG8_MMA(0, 0, At, B0); PG8_MMA(0, 1, At, B1); PG8_BAR; PG8_SCHED;
            PG8_LDA(At, 0, 1); PG8_STAGE(PG8_SB(0, 0), b2, voffB); PG8_STAGE(PG8_SB(0, 1), b2 + hstepB, voffB); PG8_STAGE(PG8_SA(0, 0), a2, voffA);
            PG8_WAIT_V(8); PG8_WAIT_L(0); PG8_BAR; PG8_MMA(1, 0, At, B0); PG8_MMA(1, 1, At, B1); PG8_BAR; PG8_SCHED;
            PG8_LDB(B0, 1, 0); PG8_LDB(B1, 1, 1); PG8_SCHED; PG8_LDA(At, 1, 0); PG8_STAGE(PG8_SA(0, 1), a2 + hstepA, voffA);
            PG8_WAIT_V(8); PG8_WAIT_L(0); PG8_BAR; PG8_MMA(0, 0, At, B0); PG8_MMA(0, 1, At, B1); PG8_BAR; PG8_SCHED;
            PG8_LDA(At, 1, 1); PG8_STAGE(PG8_SB(1, 0), b3, voffB); PG8_STAGE(PG8_SB(1, 1), b3 + hstepB, voffB); PG8_STAGE(PG8_SA(1, 0), a3, voffA);
            PG8_WAIT_V(8); PG8_WAIT_L(0); PG8_BAR; PG8_MMA(1, 0, At, B0); PG8_MMA(1, 1, At, B1); PG8_BAR; PG8_SCHED;
        }
        if (wr == 0) PG8_BAR;
        E(acc, cur, wr, wc, fr, fq);
        if (!has_next) break;
#pragma unroll
        for (int a = 0; a < 2; ++a)
#pragma unroll
            for (int b = 0; b < 2; ++b)
#pragma unroll
                for (int m = 0; m < 4; ++m)
#pragma unroll
                    for (int n = 0; n < 2; ++n) acc[a][b][m][n] = (f32x4){0.f, 0.f, 0.f, 0.f};
        cur = nxt; cA = nA; cB = nB; ++ui;
        if (wr == 1) PG8_BAR;
    }
    PG8_WAIT_V(0);
    PG8_BAR;
#undef PG8_SA
#undef PG8_SB
#undef PG8_STAGE
#undef PG8_LDA
#undef PG8_LDB
#undef PG8_MMA
#undef PG8_WAIT_V
#undef PG8_WAIT_L
#undef PG8_BAR
#undef PG8_SCHED
}
}


struct EpiProjE {
    static constexpr bool PERM = true;
    bf16 *UG, *PB, *QB, *KB, *VB; float* KMP;
    __device__ __forceinline__ void operator()(const f32x4 (&acc)[2][2][4][2], const pg8::Unit& u, int wr, int wc, int fr_, int fq_) const {
        const int ln_ = lane_id(), fr = ln_ & 15, fq = ln_ >> 4; (void)fr_; (void)fq_;
        const int pn = u.pn, row0 = u.pm * 256 + wr * 64 + fr, cl = wc * 32 + 8 * fq;
        if (pn == 0) {
#pragma unroll
            for (int ai = 0; ai < 2; ++ai)
#pragma unroll
                for (int m = 0; m < 4; ++m) { const int r = row0 + ai * 128 + m * 16;
#pragma unroll
                    for (int bj = 0; bj < 2; ++bj) { const int ch = bj * 128 + cl, g = ch >> 4, h0 = ch & 15;
                        const f32x4 v0 = acc[ai][bj][m][0], v1 = acc[ai][bj][m][1]; u32x4 w;
                        w.x = pg8::cvt_pk_bf16(v0[0], v0[1]); w.y = pg8::cvt_pk_bf16(v0[2], v0[3]); w.z = pg8::cvt_pk_bf16(v1[0], v1[1]); w.w = pg8::cvt_pk_bf16(v1[2], v1[3]);
                        *(u32x4*)(UG + ((size_t)(g * 512 + (r >> 6))) * UGP + (r & 63) * 16 + h0) = w; } }
        } else {
            bf16* base; int ldc, colt; float sc = 1.f;
            if (pn == 1) { base = PB; ldc = 256; colt = 0; }
            else if (pn < 4) { base = QB; ldc = 512; colt = (pn - 2) * 256; sc = C2; }
            else if (pn < 6) { base = KB; ldc = 512; colt = (pn - 4) * 256; }
            else { base = VB; ldc = 512; colt = (pn - 6) * 256; }
#pragma unroll
            for (int ai = 0; ai < 2; ++ai)
#pragma unroll
                for (int m = 0; m < 4; ++m) { bf16* rowp = base + (size_t)(row0 + ai * 128 + m * 16) * ldc + colt + cl;
#pragma unroll
                    for (int bj = 0; bj < 2; ++bj) { const f32x4 v0 = acc[ai][bj][m][0] * sc, v1 = acc[ai][bj][m][1] * sc; u32x4 w;
                        w.x = pg8::cvt_pk_bf16(v0[0], v0[1]); w.y = pg8::cvt_pk_bf16(v0[2], v0[3]); w.z = pg8::cvt_pk_bf16(v1[0], v1[1]); w.w = pg8::cvt_pk_bf16(v1[2], v1[3]);
                        *(u32x4*)(rowp + bj * 128) = w; } }
            if (pn >= 4 && pn < 6) {
#pragma unroll
                for (int bj = 0; bj < 2; ++bj)
#pragma unroll
                    for (int n = 0; n < 2; ++n) { f32x4 s = (f32x4){0.f, 0.f, 0.f, 0.f};
#pragma unroll
                        for (int ai = 0; ai < 2; ++ai)
#pragma unroll
                            for (int m = 0; m < 4; ++m) s += acc[ai][bj][m][n];
#pragma unroll
                        for (int i = 0; i < 4; ++i) { float t = s[i]; t += xshfl<1>(t); t += xshfl<2>(t); t += xshfl<4>(t); t += xshfl<8>(t); s[i] = t; }
                        if (fr == 0) *(f32x4*)(KMP + (size_t)wr * 128 * 512 + (size_t)u.pm * 512 + colt + bj * 128 + cl + 4 * n) = s; }
            }
        }
    }
};
struct EpiOutE {
    static constexpr bool PERM = false;
    const float* xin; float* R;
    __device__ __forceinline__ void operator()(const f32x4 (&acc)[2][2][4][2], const pg8::Unit& u, int wr, int wc, int fr_, int fq_) const {
        const int ln_ = lane_id(), fr = ln_ & 15, fq = ln_ >> 4; (void)fr_; (void)fq_;
        const int row0 = u.pm * 256 + wr * 64 + fr, col0 = u.pn * 256 + wc * 32 + 4 * fq;
#pragma unroll
        for (int ai = 0; ai < 2; ++ai)
#pragma unroll
            for (int m = 0; m < 4; ++m) { const size_t off = (size_t)(row0 + ai * 128 + m * 16) * D + col0;
#pragma unroll
                for (int bj = 0; bj < 2; ++bj)
#pragma unroll
                    for (int n = 0; n < 2; ++n) { const size_t o = off + bj * 128 + n * 16; *(f32x4*)(R + o) = *(const f32x4*)(xin + o) + acc[ai][bj][m][n]; }
                if (m & 1) asm volatile("" ::: "memory"); }
    }
};

__device__ __forceinline__ void transpose_item(const float* W, int K, int N, const float* kscale, bf16* WT, int ldo, int koff, int rowmode, LAS float* scr, int item, int lane) {
    const int nblk = N / 32, kb = item / nblk, nb = item % nblk, k0 = 64 * kb, n0 = 32 * nb;
#pragma unroll 8
    for (int i = 0; i < 32; ++i) { const int kk = 2 * i + (lane >> 5); const float s = kscale ? kscale[k0 + kk] : 1.f; scr[kk * 33 + (lane & 31)] = W[(size_t)(k0 + kk) * N + n0 + (lane & 31)] * s; }
    asm volatile("s_waitcnt lgkmcnt(0)" ::: "memory");
    const int c = lane & 7;
#pragma unroll
    for (int j = 0; j < 4; ++j) { const int n = (lane >> 3) + 8 * j; const LAS float* s = scr + (8 * c) * 33 + n;
        u32x4 o; o.x = pk2(s[0 * 33], s[1 * 33]); o.y = pk2(s[2 * 33], s[3 * 33]); o.z = pk2(s[4 * 33], s[5 * 33]); o.w = pk2(s[6 * 33], s[7 * 33]);
        const int nn = n0 + n, row = rowmode == 0 ? nn : (8 * (nn >> 2) + (nn & 3) + (rowmode == 2 ? 4 : 0));
        *(u32x4*)(WT + (size_t)row * ldo + koff + k0 + 8 * c) = o; }
    asm volatile("s_waitcnt lgkmcnt(0)" ::: "memory");
}
__device__ __forceinline__ void pair_decode(int pi, int& ea, int& eb) { ea = pi < 3 ? 0 : (pi < 5 ? 1 : 2); eb = pi < 3 ? pi + 1 : (pi < 5 ? pi - 1 : 3); }
__device__ __forceinline__ void ph_prologue(const Ctx& F0) {
    const Ctx F = launder(F0);
    LAS float* scr = (LAS float*)(F.lds + F.wave * 16384);
    const int gw = F.vcu * NWAVES + F.wave, NGW = F.G * NWAVES;
    constexpr int I_IN = (D / 64) * (NPROJ / 32), I_OUT = (D / 64) * (D / 32), I_GU1 = (D / 64) * (256 / 32), I_GU = 16 * 2 * I_GU1, I_WD1 = (256 / 64) * (D / 32), I_WD = 24 * 2 * I_WD1;
    constexpr int I_L = I_IN + I_OUT + I_GU + I_WD;
    for (int it = gw; it < DEPTH * I_L; it += NGW) {
        const int l = it / I_L; int r = it % I_L;
        if (r < I_IN) { transpose_item(F.in[3] + (size_t)l * D * NPROJ, D, NPROJ, F.in[2] + l * D, (bf16*)(F.ws + WS_WIN) + (size_t)l * NPROJ * D, D, 0, 0, scr, r, F.lane); continue; } r -= I_IN;
        if (r < I_OUT) { transpose_item(F.in[17] + (size_t)l * D * D, D, D, nullptr, (bf16*)(F.ws + WS_WOUT) + (size_t)l * D * D, D, 0, 0, scr, r, F.lane); continue; } r -= I_OUT;
        if (r < I_GU) { const int e = r / (2 * I_GU1), up = (r / I_GU1) & 1, item = r % I_GU1;
            transpose_item(F.in[up ? 24 : 23] + ((size_t)l * 16 + e) * D * 256, D, 256, F.in[18] + l * D, (bf16*)(F.ws + WS_GU) + ((size_t)l * 16 + e) * 512 * D, D, 0, 1 + up, scr, item, F.lane); continue; } r -= I_GU;
        { const int bk = r / (2 * I_WD1), half = (r / I_WD1) & 1, item = r % I_WD1, g = bk / 6; int ea, eb; pair_decode(bk % 6, ea, eb); const int e = g * 4 + (half ? eb : ea);
            transpose_item(F.in[25] + ((size_t)l * 16 + e) * 256 * D, 256, D, nullptr, (bf16*)(F.ws + WS_WD) + ((size_t)l * 24 + bk) * D * 512, 512, half * 256, 0, scr, item, F.lane); }
    }
#if USE_ENG_SSM
    for (int it = gw; it < DEPTH * 32; it += NGW) { const int l = it >> 5;
        transpose_item(F.in[12] + (size_t)l * 256 * 256, 256, 256, nullptr, (bf16*)(F.ws + WS_GLUT) + (size_t)l * 65536, 256, 0, 0, scr, it & 31, F.lane); }
    { const int gt = F.vcu * NTHREADS + F.tid, NGT = F.G * NTHREADS;
      for (int i = gt; i < DEPTH * 65536; i += NGT) { const int l = i >> 16, n = (i >> 8) & 255, k = i & 255;
          const float v = ((n >> 6) == (k >> 6)) ? F.in[14][(((size_t)l * 4 + (n >> 6)) * 64 + (k & 63)) * 64 + (n & 63)] : 0.f;
          ((bf16*)(F.ws + WS_POOLT))[i] = (bf16)f2bf(v); } }
    for (int it = gw; it < DEPTH * SGN * 65; it += NGW) {
        const int l = it / (SGN * 65), g = (it / 65) % SGN, tau = it % 65, p = F.lane;
        const float are = F.in[4][(l * SGN + g) * SP + p], aim = F.in[5][(l * SGN + g) * SP + p], dt = expf(F.in[6][l * SGN + g]);
        float sn, cs; sincosf(aim * dt, &sn, &cs); const float mg = expf(are * dt), lbr = mg * cs, lbi = mg * sn;
        const float nr = lbr - 1.f, ni = lbi, den = are * are + aim * aim, cr = (nr * are + ni * aim) / den, ci = (ni * are - nr * aim) / den;
        float sn2, cs2; sincosf(aim * dt * (float)tau, &sn2, &cs2); const float mg2 = expf(are * dt * (float)tau), lr = mg2 * cs2, li = mg2 * sn2;
        float wr[16], wi[16];
#pragma unroll
        for (int h = 0; h < 16; ++h) { const float br = F.in[7][((size_t)(l * SGN + g) * SP + p) * SG + h], bi = F.in[8][((size_t)(l * SGN + g) * SP + p) * SG + h];
            const float bbr = cr * br - ci * bi, bbi = cr * bi + ci * br; wr[h] = lr * bbr - li * bbi; wi[h] = lr * bbi + li * bbr; }
        bf16* TG = (bf16*)(F.ws + WS_TG) + ((size_t)l * SGN + g) * 1024 * UGP;
        if (tau <= 63) {
            bf16* BZ = (bf16*)(F.ws + WS_BZ) + ((size_t)l * SGN + g) * 256 * 1024; const int s = 63 - tau;
            u32x4 o0, o1, o2, o3;
            o0.x = pk2(wr[0], wr[1]); o0.y = pk2(wr[2], wr[3]); o0.z = pk2(wr[4], wr[5]); o0.w = pk2(wr[6], wr[7]); o1.x = pk2(wr[8], wr[9]); o1.y = pk2(wr[10], wr[11]); o1.z = pk2(wr[12], wr[13]); o1.w = pk2(wr[14], wr[15]);
            o2.x = pk2(wi[0], wi[1]); o2.y = pk2(wi[2], wi[3]); o2.z = pk2(wi[4], wi[5]); o2.w = pk2(wi[6], wi[7]); o3.x = pk2(wi[8], wi[9]); o3.y = pk2(wi[10], wi[11]); o3.z = pk2(wi[12], wi[13]); o3.w = pk2(wi[14], wi[15]);
            *(u32x4*)(BZ + (size_t)p * 1024 + s * 16) = o0; *(u32x4*)(BZ + (size_t)p * 1024 + s * 16 + 8) = o1;
            *(u32x4*)(BZ + (size_t)(64 + p) * 1024 + s * 16) = o2; *(u32x4*)(BZ + (size_t)(64 + p) * 1024 + s * 16 + 8) = o3;
        }
#pragma unroll 1
        for (int ho = 0; ho < 16; ++ho) {
            const float ccr = F.in[9][((size_t)(l * SGN + g) * SG + ho) * SP + p], cci = F.in[10][((size_t)(l * SGN + g) * SG + ho) * SP + p];
            if (tau >= 1) { const int n = (tau - 1) * 16 + ho;
                TG[(size_t)n * UGP + 1024 + p] = (bf16)f2bf(ccr * lr - cci * li); TG[(size_t)n * UGP + 1088 + p] = (bf16)f2bf(-(ccr * li + cci * lr)); }
            if (tau <= 63) {
                float kv[16];
#pragma unroll
                for (int h = 0; h < 16; ++h) kv[h] = wave_sum(ccr * wr[h] - cci * wi[h]);
                u32x4 o0, o1; o0.x = pk2(kv[0], kv[1]); o0.y = pk2(kv[2], kv[3]); o0.z = pk2(kv[4], kv[5]); o0.w = pk2(kv[6], kv[7]); o1.x = pk2(kv[8], kv[9]); o1.y = pk2(kv[10], kv[11]); o1.z = pk2(kv[12], kv[13]); o1.w = pk2(kv[14], kv[15]);
                const int to = p;
                if (to >= tau) { bf16* d = TG + (size_t)(to * 16 + ho) * UGP + (to - tau) * 16; *(u32x4*)d = o0; *(u32x4*)(d + 8) = o1; }
                if (tau >= 1 && to + tau <= 63) { bf16* d = TG + (size_t)(to * 16 + ho) * UGP + (to + tau) * 16; const u32x4 z = (u32x4){0u, 0u, 0u, 0u}; *(u32x4*)d = z; *(u32x4*)(d + 8) = z; }
            }
        }
    }
#endif
}

__device__ __forceinline__ void ph_route(const Ctx& F0, int l) {
    const Ctx F = launder(F0);
    LAS float* Wl = (LAS float*)F.lds;
    LAS int* hist = (LAS int*)(F.lds + 1024 * 20 * 4);
    const float* g2 = F.in[18] + l * D;
    const f32x4* gw4 = (const f32x4*)(F.in[19] + (size_t)l * D * 4); const f32x4* rw4 = (const f32x4*)(F.in[21] + (size_t)l * 4 * D * 4);
    const float* gb_ = F.in[20] + l * 4; const float* rb_ = F.in[22] + l * 16;
    for (int idx = F.tid; idx < D * 5; idx += NTHREADS) { const int k = idx / 5, q = idx % 5;
        f32x4 v = (q == 0) ? gw4[k] : rw4[(q - 1) * D + k]; v = v * g2[k]; *(LAS f32x4*)(Wl + k * 20 + q * 4) = v; }
    if (F.tid < 32) hist[F.tid] = 0;
    __syncthreads();
    int* tokb = (int*)(F.ws + WS_TOKB); float* tokr = (float*)(F.ws + WS_TOKR); float* tokw = (float*)(F.ws + WS_TOKW);
    for (int i = 0; i < 16; ++i) {
        const int m = F.vcu * 128 + F.wave * 16 + i;
        const float* xr = F.R + (size_t)m * D + F.lane;
        float a[20]; float ss = 0.f;
#pragma unroll
        for (int j = 0; j < 20; ++j) a[j] = 0.f;
#pragma unroll 2
        for (int jj = 0; jj < 16; ++jj) { const float x = xr[64 * jj]; ss += x * x; const LAS f32x4* wp = (const LAS f32x4*)(Wl + (F.lane + 64 * jj) * 20);
#pragma unroll
            for (int q = 0; q < 5; ++q) { const f32x4 w = wp[q]; a[q * 4 + 0] += x * w[0]; a[q * 4 + 1] += x * w[1]; a[q * 4 + 2] += x * w[2]; a[q * 4 + 3] += x * w[3]; } }
        ss = wave_sum(ss);
#pragma unroll
        for (int j = 0; j < 20; ++j) a[j] = wave_sum(a[j]);
        const float rstd = 1.f / sqrtf(ss * (1.f / D) + RMS_EPS);
        float lg0 = a[0] * rstd + gb_[0], lg1 = a[1] * rstd + gb_[1], lg2 = a[2] * rstd + gb_[2], lg3 = a[3] * rstd + gb_[3];
        int gs = 0; float gm = lg0;
        if (lg1 > gm) { gm = lg1; gs = 1; } if (lg2 > gm) { gm = lg2; gs = 2; } if (lg3 > gm) { gm = lg3; gs = 3; }
        const float gwt = 1.f / (__expf(lg0 - gm) + __expf(lg1 - gm) + __expf(lg2 - gm) + __expf(lg3 - gm));
        float e0 = gs == 0 ? a[4] : gs == 1 ? a[8] : gs == 2 ? a[12] : a[16];
        float e1 = gs == 0 ? a[5] : gs == 1 ? a[9] : gs == 2 ? a[13] : a[17];
        float e2 = gs == 0 ? a[6] : gs == 1 ? a[10] : gs == 2 ? a[14] : a[18];
        float e3 = gs == 0 ? a[7] : gs == 1 ? a[11] : gs == 2 ? a[15] : a[19];
        e0 = e0 * rstd + rb_[gs * 4 + 0]; e1 = e1 * rstd + rb_[gs * 4 + 1]; e2 = e2 * rstd + rb_[gs * 4 + 2]; e3 = e3 * rstd + rb_[gs * 4 + 3];
        int t1 = 0; float v1 = e0;
        if (e1 > v1) { v1 = e1; t1 = 1; } if (e2 > v1) { v1 = e2; t1 = 2; } if (e3 > v1) { v1 = e3; t1 = 3; }
        int t2 = -1; float v2 = -3.0e38f;
        if (t1 != 0 && e0 > v2) { v2 = e0; t2 = 0; } if (t1 != 1 && e1 > v2) { v2 = e1; t2 = 1; } if (t1 != 2 && e2 > v2) { v2 = e2; t2 = 2; } if (t1 != 3 && e3 > v2) { v2 = e3; t2 = 3; }
        const float p2 = __expf(v2 - v1), w1 = gwt / (1.f + p2), w2 = gwt * p2 / (1.f + p2);
        const int lo = t1 < t2 ? t1 : t2, hi = t1 < t2 ? t2 : t1; const float wlo = t1 < t2 ? w1 : w2, whi = t1 < t2 ? w2 : w1;
        const int pi = lo == 0 ? hi - 1 : (lo == 1 ? hi + 1 : 5), bk = gs * 6 + pi;
        if (F.lane == 0) { tokb[m] = bk; tokr[m] = rstd; tokw[2 * m] = wlo; tokw[2 * m + 1] = whi; __hip_atomic_fetch_add(hist + bk, 1, __ATOMIC_RELAXED, __HIP_MEMORY_SCOPE_WORKGROUP); }
    }
    __syncthreads();
    if (F.tid < 24) __hip_atomic_store((int*)(F.ws + WS_WGCNT) + F.vcu * 24 + F.tid, hist[F.tid], __ATOMIC_RELAXED, __HIP_MEMORY_SCOPE_AGENT);
}
__device__ __forceinline__ void ph_place(const Ctx& F0) {
    const Ctx F = launder(F0);
    LAS int* ptot = (LAS int*)F.lds;
    LAS int* pbef = ptot + 512;
    LAS int* bstart = pbef + 512;
    LAS int* btot = bstart + 32;
    LAS int* carry = btot + 32;
    LAS int* rowidx = carry + 32;
    const int* wgcnt = (const int*)(F.ws + WS_WGCNT);
    int* rowtok = (int*)(F.ws + WS_ROWTOK); float* roww = (float*)(F.ws + WS_ROWW); int* tileb = (int*)(F.ws + WS_TILEB);
    const int* tokb = (const int*)(F.ws + WS_TOKB); const float* tokr = (const float*)(F.ws + WS_TOKR); const float* tokw = (const float*)(F.ws + WS_TOKW);
    { const int p = F.tid >> 5, b = F.tid & 31; int tot = 0, bef = 0;
      if (b < 24) for (int v = p * 16; v < p * 16 + 16; ++v) { const int c = wgcnt[v * 24 + b]; tot += c; if (v < F.vcu) bef += c; }
      ptot[p * 32 + b] = tot; pbef[p * 32 + b] = bef; }
    __syncthreads();
    if (F.tid < 32) { int tot = 0, bef = 0; for (int p = 0; p < 16; ++p) { tot += ptot[p * 32 + F.tid]; bef += pbef[p * 32 + F.tid]; } btot[F.tid] = tot; carry[F.tid] = bef; }
    __syncthreads();
    if (F.tid == 0) { int s = 0; for (int b = 0; b < 24; ++b) { bstart[b] = s; s += (btot[b] + 255) & ~255; } bstart[24] = s; }
    __syncthreads();
    if (F.tid < 24) carry[F.tid] += bstart[F.tid];
    if (F.vcu == 0) {
        if (F.tid == 0) tileb[0] = bstart[24] >> 8;
        for (int b = 0; b < 24; ++b) { const int s = bstart[b], e = bstart[b + 1];
            for (int t = (s >> 8) + F.tid; t < (e >> 8); t += NTHREADS) tileb[1 + t] = b;
            for (int r = s + btot[b] + F.tid; r < e; r += NTHREADS) __hip_atomic_store(rowtok + r, -1, __ATOMIC_RELAXED, __HIP_MEMORY_SCOPE_AGENT); }
    }
    __syncthreads();
    if (F.wave == 0) {
        for (int pass = 0; pass < 2; ++pass) { const int i = pass * 64 + F.lane, bi = tokb[F.vcu * 128 + i]; int row = 0;
#pragma unroll 1
            for (int b = 0; b < 24; ++b) { const unsigned long long mask = __ballot(bi == b); const int c = carry[b];
                if (bi == b) row = c + __builtin_popcountll(mask & ((1ull << F.lane) - 1ull));
                asm volatile("s_waitcnt lgkmcnt(0)" ::: "memory");
                if (F.lane == 0) carry[b] = c + __builtin_popcountll(mask);
                asm volatile("s_waitcnt lgkmcnt(0)" ::: "memory"); }
            rowidx[i] = row; }
    }
    __syncthreads();
    bf16* XS = (bf16*)(F.ws + WS_XS);
    for (int i = 0; i < 16; ++i) {
        const int li = F.wave * 16 + i, m = F.vcu * 128 + li, row = rowidx[li]; const float rstd = tokr[m];
        if (F.lane == 0) {
            __hip_atomic_store(rowtok + row, m, __ATOMIC_RELAXED, __HIP_MEMORY_SCOPE_AGENT);
            const unsigned long long w2 = (unsigned long long)__builtin_bit_cast(unsigned, tokw[2 * m]) | ((unsigned long long)__builtin_bit_cast(unsigned, tokw[2 * m + 1]) << 32);
            __hip_atomic_store((unsigned long long*)(roww + 2 * row), w2, __ATOMIC_RELAXED, __HIP_MEMORY_SCOPE_AGENT); }
        const f32x4* xr = (const f32x4*)(F.R + (size_t)m * D) + F.lane;
        unsigned long long* o8 = (unsigned long long*)(XS + (size_t)row * D) + F.lane;
#pragma unroll
        for (int j = 0; j < 4; ++j) { const f32x4 v = xr[64 * j] * rstd; o8[64 * j] = (unsigned long long)pk2(v.x, v.y) | ((unsigned long long)pk2(v.z, v.w) << 32); }
    }
}
struct MoeOrder {
    const int* tileb; int G, c; bool down;
    __device__ __forceinline__ bool next(int i, pg8::Unit& u) const {
        const GAS int* tb_ = (const GAS int*)tileb;
        const int NT = __builtin_amdgcn_readfirstlane(tb_[0]), L = i * G + c; if (L >= NT * 4) return false;
        const int rt = L >> 2, pn = L & 3, b = __builtin_amdgcn_readfirstlane(tb_[1 + rt]);
        if (down) { u.pm = rt; u.pn = b * 4 + pn; u.aux = pn; }
        else { int ea, eb; pair_decode(b % 6, ea, eb); const int e = (b / 6) * 4 + (pn < 2 ? ea : eb); u.pm = rt; u.pn = e * 2 + (pn & 1); u.aux = pn; }
        return true;
    }
};
struct EpiGU {
    static constexpr bool PERM = true;
    bf16* H; const float* roww;
    __device__ __forceinline__ void operator()(const f32x4 (&acc)[2][2][4][2], const pg8::Unit& u, int wr, int wc, int fr_, int fq_) const {
        const int ln_ = lane_id(), fr = ln_ & 15, fq = ln_ >> 4; (void)fr_; (void)fq_;
        const int row0 = u.pm * 256 + wr * 64 + fr, cl = u.aux * 128 + 16 * wc + 4 * fq, ws = u.aux >> 1;
#pragma unroll
        for (int ai = 0; ai < 2; ++ai)
#pragma unroll
            for (int m = 0; m < 4; ++m) { const int r = row0 + ai * 128 + m * 16; const float w = roww[2 * r + ws];
#pragma unroll
                for (int bj = 0; bj < 2; ++bj) { const f32x4 g = acc[ai][bj][m][0], up = acc[ai][bj][m][1]; f32x4 a;
#pragma unroll
                    for (int i = 0; i < 4; ++i) a[i] = g[i] * sigmoidf_(g[i]) * up[i] * w;
                    u32x2 o; o.x = pg8::cvt_pk_bf16(a[0], a[1]); o.y = pg8::cvt_pk_bf16(a[2], a[3]);
                    *(u32x2*)(H + (size_t)r * 512 + cl + bj * 64) = o; } }
    }
};
struct EpiDown {
    static constexpr bool PERM = false;
    float* R; const int* rowtok;
    __device__ __forceinline__ void operator()(const f32x4 (&acc)[2][2][4][2], const pg8::Unit& u, int wr, int wc, int fr_, int fq_) const {
        const int ln_ = lane_id(), fr = ln_ & 15, fq = ln_ >> 4; (void)fr_; (void)fq_;
        const int row0 = u.pm * 256 + wr * 64 + fr, col0 = u.aux * 256 + wc * 32 + 4 * fq;
#pragma unroll
        for (int ai = 0; ai < 2; ++ai)
#pragma unroll
            for (int m = 0; m < 4; ++m) { const int tok = rowtok[row0 + ai * 128 + m * 16];
                if (tok >= 0) { float* rp = R + (size_t)tok * D + col0;
#pragma unroll
                    for (int bj = 0; bj < 2; ++bj)
#pragma unroll
                        for (int n = 0; n < 2; ++n) { float* p = rp + bj * 128 + n * 16; *(f32x4*)p = *(const f32x4*)p + acc[ai][bj][m][n]; } }
                if (m & 1) asm volatile("" ::: "memory"); }
    }
};

namespace attn_body {
using abf16=__hip_bfloat16;
using bf16x8=__attribute__((ext_vector_type(8)))short;
using s16x4=__attribute__((ext_vector_type(4)))short;
using f32x16=__attribute__((ext_vector_type(16)))float;
using u32x4=__attribute__((ext_vector_type(4)))unsigned;
constexpr int BATCH=8,NHEAD=8,SEQ=4096,D=64,DM=NHEAD*D,DMO=1024,OCOL=512;
constexpr int NW=8,QBLK=32,QB=QBLK*NW,KVBLK=64,NQB=SEQ/QB;
constexpr int ATTN_PITCH=DM, ATTN_UNIT_ROWS=QB;
__device__ __forceinline__ int crow(int r,int hi){return (r&3)+8*(r>>2)+4*hi;}
#define SBAR() __builtin_amdgcn_sched_barrier(0)
__device__ __forceinline__ void nearm(f32x16&p0,f32x16&p1,int jn,int qrel,int hi,const __attribute__((address_space(3))) float*tb){
  const __attribute__((address_space(3))) float*t0=tb+(qrel-64*(jn-4)-4*hi+256);
  #pragma unroll
  for(int r=0;r<16;++r){const int k=(r&3)+8*(r>>2); p0[r]+=t0[-k]; p1[r]+=t0[-k-32];}
}

constexpr int NSLOT=3, SLOTB=8192;
constexpr int LDS_K=0, LDS_V=NSLOT*SLOTB, LDS_WS=2*NSLOT*SLOTB, LDS_OST=LDS_WS+NW*64*4, LDS_TB=LDS_OST+NW*4096, LDS_KM=LDS_TB+768*4, LDS_BYTES=LDS_KM+16*64*4;
constexpr float C2=0.125f*1.4426950408889634f;
__device__ __forceinline__ void glds16(const void*gsrc,unsigned lds_dst){unsigned keep;
  asm volatile("s_mov_b32 %0, m0\n\ts_mov_b32 m0, %2\n\ts_nop 0\n\tglobal_load_lds_dwordx4 %1, off\n\ts_mov_b32 m0, %0":"=&s"(keep):"v"(gsrc),"s"(lds_dst):"memory");}
__device__ __forceinline__ float max3f(float a,float b,float c){float r;asm("v_max3_f32 %0, %1, %2, %3":"=v"(r):"v"(a),"v"(b),"v"(c));return r;}
__device__ __forceinline__ float max2f(float a,float b){float r;asm("v_max_f32_e32 %0, %1, %2":"=v"(r):"v"(a),"v"(b));return r;}
__device__ __forceinline__ float fadd_s(float a,float b){float r;asm("v_add_f32_e32 %0, %1, %2":"=v"(r):"v"(a),"v"(b));return r;}
__device__ __forceinline__ float fsub_s(float a,float b){float r;asm("v_sub_f32_e32 %0, %1, %2":"=v"(r):"v"(a),"v"(b));return r;}
typedef float f32x2_t __attribute__((ext_vector_type(2))); typedef __bf16 bf16x2_t __attribute__((ext_vector_type(2)));
__device__ __forceinline__ unsigned cvtpk_s(float lo,float hi){f32x2_t v={lo,hi};bf16x2_t b=__builtin_convertvector(v,bf16x2_t);return __builtin_bit_cast(unsigned,b);}
#define WAIT_BAR(N) asm volatile("s_waitcnt vmcnt(0) lgkmcnt(0)\n\ts_barrier":::"memory")

__device__ __forceinline__ void qkt(f32x16&p0,f32x16&p1,const char*Kslot,const bf16x8*qr,const f32x16&negm,int r32,int hi){
  const char*kb=Kslot+hi*1024+r32*16;
  #pragma unroll
  for(int d0=0;d0<4;++d0){
    const bf16x8 b0=*reinterpret_cast<const bf16x8*>(kb+d0*2048);
    const bf16x8 b1=*reinterpret_cast<const bf16x8*>(kb+d0*2048+512);
    if(d0==0){p0=__builtin_amdgcn_mfma_f32_32x32x16_bf16(b0,qr[0],negm,0,0,0);p1=__builtin_amdgcn_mfma_f32_32x32x16_bf16(b1,qr[0],negm,0,0,0);}
    else{p0=__builtin_amdgcn_mfma_f32_32x32x16_bf16(b0,qr[d0],p0,0,0,0);p1=__builtin_amdgcn_mfma_f32_32x32x16_bf16(b1,qr[d0],p1,0,0,0);}}
}
typedef __attribute__((address_space(3))) const char* lds_cptr;
typedef short v4i16_t __attribute__((ext_vector_type(4)));
__device__ __forceinline__ void kload8(bf16x8*kf,lds_cptr kp){
  kf[0]=*(const __attribute__((address_space(3))) bf16x8*)(kp);      kf[1]=*(const __attribute__((address_space(3))) bf16x8*)(kp+512);
  kf[2]=*(const __attribute__((address_space(3))) bf16x8*)(kp+2048); kf[3]=*(const __attribute__((address_space(3))) bf16x8*)(kp+2560);
  kf[4]=*(const __attribute__((address_space(3))) bf16x8*)(kp+4096); kf[5]=*(const __attribute__((address_space(3))) bf16x8*)(kp+4608);
  kf[6]=*(const __attribute__((address_space(3))) bf16x8*)(kp+6144); kf[7]=*(const __attribute__((address_space(3))) bf16x8*)(kp+6656);
}
__device__ __forceinline__ void kload2(bf16x8*kf,lds_cptr kp,int j){ kf[2*j]=*(const __attribute__((address_space(3))) bf16x8*)(kp+j*2048); kf[2*j+1]=*(const __attribute__((address_space(3))) bf16x8*)(kp+j*2048+512); }
__device__ __forceinline__ s16x4 vtr(lds_cptr p){ return __builtin_bit_cast(s16x4,__builtin_amdgcn_ds_read_tr16_b64_v4i16((__attribute__((address_space(3))) v4i16_t*)p)); }
__device__ __forceinline__ float rowmax(const f32x16&p0,const f32x16&p1){
  float a=max3f(p0[0],p0[1],p1[0]),b=max3f(p0[2],p0[3],p1[1]);a=max3f(a,p1[2],p1[3]);
  #pragma unroll
  for(int r=4;r<16;r+=4){a=max3f(a,p0[r],p0[r+1]);b=max3f(b,p0[r+2],p0[r+3]);a=max3f(a,p1[r],p1[r+1]);b=max3f(b,p1[r+2],p1[r+3]);}
  const float m=max2f(a,b);
  auto rr=__builtin_amdgcn_permlane32_swap(__float_as_uint(m),__float_as_uint(m),false,false);
  return max2f(__uint_as_float(rr[0]),__uint_as_float(rr[1]));
}
__device__ __forceinline__ void pv(f32x16*o,int vb,bf16x8 pa0,bf16x8 pa1,bf16x8 pa2,bf16x8 pa3){
  #pragma unroll
  for(int d0=0;d0<2;++d0){s16x4 lo[4],hi[4];
    #pragma unroll
    for(int ks=0;ks<4;++ks){
      asm volatile("ds_read_b64_tr_b16 %0,%1 offset:%c2":"=&v"(lo[ks]):"v"(vb),"i"(d0*4096+ks*1024):"memory");
      asm volatile("ds_read_b64_tr_b16 %0,%1 offset:%c2":"=&v"(hi[ks]):"v"(vb),"i"(d0*4096+ks*1024+512):"memory");}
    asm volatile("s_waitcnt lgkmcnt(0)":::"memory");SBAR();
    #define PK(k) (bf16x8){lo[k][0],lo[k][1],lo[k][2],lo[k][3],hi[k][0],hi[k][1],hi[k][2],hi[k][3]}
    o[d0]=__builtin_amdgcn_mfma_f32_32x32x16_bf16(pa0,PK(0),o[d0],0,0,0);
    o[d0]=__builtin_amdgcn_mfma_f32_32x32x16_bf16(pa1,PK(1),o[d0],0,0,0);
    o[d0]=__builtin_amdgcn_mfma_f32_32x32x16_bf16(pa2,PK(2),o[d0],0,0,0);
    o[d0]=__builtin_amdgcn_mfma_f32_32x32x16_bf16(pa3,PK(3),o[d0],0,0,0);
    #undef PK
  }
}

#ifndef ATTN_STORE16
#define ATTN_STORE16(p,v) (*(u32x4*)(p)=(v))
#endif
template<int THRL> __device__ __forceinline__ void attn_unit(int wave_,int b,int h,int qb,const abf16*Q,const abf16*__restrict__ K,const abf16*__restrict__ V,abf16*O,const float*KMP,const float*BT,char*shm){
  int lane_=lane_id(); asm volatile("":"+v"(lane_)); asm volatile("":"+s"(b),"+s"(h),"+s"(qb),"+s"(wave_));
  const int wid=wave_,lane=lane_,tid=wid*64+lane,r32=lane&31,hi=lane>>5;
  const long rowbase=(long)b*SEQ; const int q0=qb*QB;
  const abf16*Qw=Q+(rowbase+q0+wid*QBLK)*DM+h*D;
  const abf16*Kh=K+rowbase*DM+h*D,*Vh=V+rowbase*DM+h*D;
  const unsigned lds0=(unsigned)(uintptr_t)shm;
  float*wsf=(float*)(shm+LDS_WS)+wid*64;
  const abf16*ksrc=Kh+(long)lane*DM+wid*8;
  const abf16*vsrc=Vh+(long)(16*(wid&3)+(lane>>2))*DM+(wid>>2)*32+(lane&3)*8;
  const unsigned kdst=lds0+LDS_K+wid*1024, vdst=lds0+LDS_V+wid*1024;
  #define DMA_K(t,slot) glds16(ksrc+(long)(t)*KVBLK*DM,(unsigned)__builtin_amdgcn_readfirstlane(kdst+(slot)))
  #define DMA_V(t,slot) glds16(vsrc+(long)(t)*KVBLK*DM,(unsigned)__builtin_amdgcn_readfirstlane(vdst+(slot)))
  const int vb0=(int)(lds0+LDS_V)+((lane>>4)&1)*32+(lane&3)*8+(4*hi+((lane&15)>>2))*64;
  const char*Kbase=shm+LDS_K; bf16x8 kf[8];
  const lds_cptr shm3=(lds_cptr)shm; const lds_cptr kp0=shm3+LDS_K+hi*1024+r32*16; const lds_cptr vp0=shm3+LDS_V+((lane>>4)&1)*32+(lane&3)*8+(4*hi+((lane&15)>>2))*64;
  const int NT=(q0+QB)/KVBLK;
  typedef __attribute__((address_space(3))) float lfloat;
  lfloat*tb=(lfloat*)((__attribute__((address_space(3))) char*)shm+LDS_TB); lfloat*km=(lfloat*)((__attribute__((address_space(3))) char*)shm+LDS_KM);
  const float bfar=BT[h*132+128];
  for(int i=tid;i<768;i+=NW*64){const int rel=i-256; tb[i]=rel<0?-1.0e30f:(rel<128?BT[h*132+rel]-bfar:0.f);}
  for(int i=tid;i<16*64;i+=NW*64){const int j=i>>6,d=i&63; const int pm=b*16+j; km[i]=KMP[pm*512+h*64+d]+KMP[128*512+pm*512+h*64+d];}
  asm volatile("s_waitcnt vmcnt(0) lgkmcnt(0)\n\ts_barrier":::"memory");
  DMA_K(0,0);DMA_V(0,0);DMA_K(1,SLOTB);
  bf16x8 qr[4];
  #pragma unroll
  for(int d0=0;d0<4;++d0)qr[d0]=*reinterpret_cast<const bf16x8*>(&Qw[(long)r32*DM+d0*16+hi*8]);
  unsigned selmask=1u<<qb;
  { float g[16];
    #pragma unroll
    for(int j=0;j<16;++j)g[j]=0.f;
    #pragma unroll
    for(int d0=0;d0<4;++d0){
      #pragma unroll
      for(int e=0;e<8;++e){ const float qf=__builtin_bit_cast(float,((unsigned)(unsigned short)qr[d0][e])<<16);
        #pragma unroll
        for(int j=0;j<16;++j)g[j]+=qf*km[j*64+d0*16+hi*8+e]; } }
    #pragma unroll
    for(int j=0;j<16;++j){ const unsigned u_=__builtin_bit_cast(unsigned,g[j]); auto rr=__builtin_amdgcn_permlane32_swap(u_,u_,false,false); g[j]=__builtin_bit_cast(float,(unsigned)rr[0])+__builtin_bit_cast(float,(unsigned)rr[1]); }
    #pragma unroll
    for(int s=0;s<3;++s){ float bv=-3.0e38f; int bi=-1;
      #pragma unroll
      for(int j=0;j<16;++j){ const bool ok=(j<qb)&&!((selmask>>j)&1u)&&(g[j]>bv); bv=ok?g[j]:bv; bi=ok?j:bi; }
      if(bi>=0)selmask|=1u<<bi; } }
  float mhat=0.f;
  #define NV(tn) (((selmask>>((tn)>>2))&1u)?(bfar-mhat):-1.0e30f)
  float l_reg=0.f;f32x16 o[2];o[0]=f32x16{};o[1]=f32x16{};f32x16 negm;
  { const float x_=NV(0);
    #pragma unroll
    for(int r=0;r<16;++r)negm[r]=x_; } asm volatile("":"+v"(negm));
  const int qrel=wid*QBLK+r32;
  #define CMASK(P0,P1,t) do{int jn_=(t)-(NT-8); if(jn_>=0)nearm(P0,P1,jn_,qrel,hi,tb);}while(0)
  bool resc=false;
  #define START(P0,P1) do{ const float rm=rowmax(P0,P1); resc=false; \
    { const float dl=(rm<-1.0e29f)?0.f:rm; mhat=fadd_s(mhat,dl); \
      _Pragma("unroll") for(int r=0;r<16;++r){P0[r]=fsub_s(P0[r],dl);P1[r]=fsub_s(P1[r],dl);} \
      { const float x_=NV(1); _Pragma("unroll") for(int r=0;r<16;++r)negm[r]=x_; } asm volatile("":"+v"(negm)); } \
    _Pragma("unroll") for(int r=0;r<16;++r)P0[r]=__builtin_amdgcn_exp2f(P0[r]); }while(0)
  #define RESC() do{ if(resc){ asm volatile("s_waitcnt lgkmcnt(0)":::"memory"); \
      _Pragma("unroll") for(int d_=0;d_<2;++d_) _Pragma("unroll") for(int r=0;r<16;++r)o[d_][r]*=wsf[crow(r,hi)]; } }while(0)
  f32x16 pA0,pA1,pB0,pB1;
  int sl_prev=0,sl_cur=0,sl_next=SLOTB;
  #define ROT() do{sl_prev=sl_cur;sl_cur=sl_next;sl_next=(sl_next==(NSLOT-1)*SLOTB)?0:sl_next+SLOTB;}while(0)
  DMA_K(2,2*SLOTB);
  WAIT_BAR(3);
  qkt(pA0,pA1,Kbase,qr,negm,r32,hi);asm volatile("s_nop 15\n\ts_nop 7":"+v"(pA0),"+v"(pA1));CMASK(pA0,pA1,0);
  START(pA0,pA1);
  _Pragma("unroll") for(int r=0;r<16;++r)pA1[r]=__builtin_amdgcn_exp2f(pA1[r]);
  WAIT_BAR(0);
  DMA_K(3,0);DMA_V(1,SLOTB);
  ROT();
  kload8(kf,kp0+sl_cur);
  WAIT_BAR(2);
  s16x4 vlo[8],vhi[8]; u32x4 pw0,pw1,pw2,pw3;
  #define PKW(P,B) cvtpk_s(P[B],P[B+1])
  #define PAF(k) __builtin_bit_cast(bf16x8,pw##k)
  #define VFR(i) (bf16x8){vlo[i][0],vlo[i][1],vlo[i][2],vlo[i][3],vhi[i][0],vhi[i][1],vhi[i][2],vhi[i][3]}
  #define PIN(x) asm volatile("":"+v"(x))
  #define MX3(a,b,c) __builtin_fmaxf(__builtin_fmaxf((a),(b)),(c))
  #define GAPA(MF,A0,A1,A2,A3,W0,W1,PW) do{ MF; sacc+=A0; sacc+=A1; sacc+=A2; sacc+=A3; PIN(sacc); W0; W1; PIN(PW); SBAR(); }while(0)
  #define EX(v) __builtin_amdgcn_exp2f(v)
  #define GAPB(MF,X,B) do{ MF; X[B]=EX(X[B]); X[B+1]=EX(X[B+1]); X[B+2]=EX(X[B+2]); X[B+3]=EX(X[B+3]); PIN(X); SBAR(); }while(0)
  #define VRD(i) do{ vlo[i]=vtr(vp_+(((i)>>2)*4096+((i)&3)*1024)); vhi[i]=vtr(vp_+(((i)>>2)*4096+((i)&3)*1024+512)); }while(0)
  #define KRD(G,j) do{ if(G){ kload2(kf,kp0+sl_next,j); SBAR(); } }while(0)
  #define STEP(C0,C1,P0,P1,t,GK,GV,GL) do{ SBAR(); \
    const lds_cptr vp_=vp0+sl_prev; \
    VRD(0); SBAR(); float sacc=(P0[0]+P0[1]); \
    GAPA(C0=__builtin_amdgcn_mfma_f32_32x32x16_bf16(kf[0],qr[0],negm,0,0,0), P0[2],P0[3],P0[4],P0[5],     pw0[0]=PKW(P0,0), pw0[1]=PKW(P0,2), pw0); \
    VRD(4); SBAR(); GAPA(C1=__builtin_amdgcn_mfma_f32_32x32x16_bf16(kf[1],qr[0],negm,0,0,0), P0[6],P0[7],P0[8],P0[9],     pw0[2]=PKW(P0,4), pw0[3]=PKW(P0,6), pw0); \
    VRD(1); SBAR(); GAPA(C0=__builtin_amdgcn_mfma_f32_32x32x16_bf16(kf[2],qr[1],C0,0,0,0),   P0[10],P0[11],P0[12],P0[13], pw1[0]=PKW(P0,8), pw1[1]=PKW(P0,10), pw1); \
    VRD(5); SBAR(); GAPA(C1=__builtin_amdgcn_mfma_f32_32x32x16_bf16(kf[3],qr[1],C1,0,0,0),   P0[14],P0[15],P1[0],P1[1],   pw1[2]=PKW(P0,12),pw1[3]=PKW(P0,14), pw1); \
    VRD(2); SBAR(); GAPA(C0=__builtin_amdgcn_mfma_f32_32x32x16_bf16(kf[4],qr[2],C0,0,0,0),   P1[2],P1[3],P1[4],P1[5],     pw2[0]=PKW(P1,0), pw2[1]=PKW(P1,2), pw2); \
    VRD(6); SBAR(); GAPA(C1=__builtin_amdgcn_mfma_f32_32x32x16_bf16(kf[5],qr[2],C1,0,0,0),   P1[6],P1[7],P1[8],P1[9],     pw2[2]=PKW(P1,4), pw2[3]=PKW(P1,6), pw2); \
    VRD(3); SBAR(); GAPA(C0=__builtin_amdgcn_mfma_f32_32x32x16_bf16(kf[6],qr[3],C0,0,0,0),   P1[10],P1[11],P1[12],P1[13], pw3[0]=PKW(P1,8), pw3[1]=PKW(P1,10), pw3); \
    VRD(7); SBAR(); GAPA(C1=__builtin_amdgcn_mfma_f32_32x32x16_bf16(kf[7],qr[3],C1,0,0,0),   P1[14],P1[15],0.f,0.f,       pw3[2]=PKW(P1,12),pw3[3]=PKW(P1,14), pw3); \
    l_reg+=sacc; \
    if(GK){DMA_K((t)+3,sl_cur);} if(GV){DMA_V((t)+1,sl_next);} \
    CMASK(C0,C1,t); \
    { float a=MX3(C0[0],C0[1],C1[0]),b=MX3(C0[2],C0[3],C1[1]); a=MX3(a,C1[2],C1[3]); \
      _Pragma("unroll") for(int r=4;r<16;r+=4){a=MX3(a,C0[r],C0[r+1]);b=MX3(b,C0[r+2],C0[r+3]);a=MX3(a,C1[r],C1[r+1]);b=MX3(b,C1[r+2],C1[r+3]);} \
      float rm=__builtin_fmaxf(a,b); { auto rr=__builtin_amdgcn_permlane32_swap(__float_as_uint(rm),__float_as_uint(rm),false,false); rm=__builtin_fmaxf(__uint_as_float(rr[0]),__uint_as_float(rr[1])); } \
      resc=false; \
      if(__builtin_expect(__any(rm>(float)THRL),0)){ const float dl=__builtin_fmaxf(rm,0.f); mhat+=dl; \
        _Pragma("unroll") for(int r=0;r<16;++r){C0[r]-=dl;C1[r]-=dl;} \
        { const float x_=NV((t)+1); _Pragma("unroll") for(int r=0;r<16;++r)negm[r]=x_; } asm volatile("":"+v"(negm)); \
        const float f=__builtin_amdgcn_exp2f(-dl); l_reg*=f; if(hi==0)wsf[r32]=f; resc=true; } } \
    SBAR(); \
    GAPB(o[0]=__builtin_amdgcn_mfma_f32_32x32x16_bf16(PAF(0),VFR(0),o[0],0,0,0), C0,0); \
    GAPB(o[1]=__builtin_amdgcn_mfma_f32_32x32x16_bf16(PAF(0),VFR(4),o[1],0,0,0), C0,4); \
    KRD(GL,0); GAPB(o[0]=__builtin_amdgcn_mfma_f32_32x32x16_bf16(PAF(1),VFR(1),o[0],0,0,0), C0,8); \
    KRD(GL,1); GAPB(o[1]=__builtin_amdgcn_mfma_f32_32x32x16_bf16(PAF(1),VFR(5),o[1],0,0,0), C0,12); \
    KRD(GL,2); GAPB(o[0]=__builtin_amdgcn_mfma_f32_32x32x16_bf16(PAF(2),VFR(2),o[0],0,0,0), C1,0); \
    KRD(GL,3); GAPB(o[1]=__builtin_amdgcn_mfma_f32_32x32x16_bf16(PAF(2),VFR(6),o[1],0,0,0), C1,4); \
    GAPB(o[0]=__builtin_amdgcn_mfma_f32_32x32x16_bf16(PAF(3),VFR(3),o[0],0,0,0), C1,8); \
    GAPB(o[1]=__builtin_amdgcn_mfma_f32_32x32x16_bf16(PAF(3),VFR(7),o[1],0,0,0), C1,12); \
    }while(0)
  int t=1;
  #undef CMASK
  #define CMASK(P0,P1,t) do{}while(0)
  #define BLKUPD(tn) do{ if((((tn)&3)==0)){ const float x_=NV(tn); _Pragma("unroll") for(int r=0;r<16;++r)negm[r]=x_; asm volatile("":"+v"(negm)); } }while(0)
  for(;t+9<NT;t+=2){
    STEP(pB0,pB1,pA0,pA1,t,true,true,true);     WAIT_BAR(2); RESC(); ROT(); BLKUPD(t+1);
    STEP(pA0,pA1,pB0,pB1,t+1,true,true,true);   WAIT_BAR(2); RESC(); ROT(); BLKUPD(t+2);
  }
  #undef CMASK
  #define CMASK(P0,P1,t) do{int jn_=(t)-(NT-8); if(jn_>=0)nearm(P0,P1,jn_,qrel,hi,tb);}while(0)
  #define ENDW(tt) do{ if((tt)+3<NT){WAIT_BAR(2);} else if((tt)+2<NT){WAIT_BAR(1);} else {WAIT_BAR(0);} }while(0)
  for(;t+1<NT;t+=2){
    STEP(pB0,pB1,pA0,pA1,t,(t+3<NT),(t+1<NT),(t+1<NT));       ENDW(t);   RESC(); ROT(); BLKUPD(t+1);
    STEP(pA0,pA1,pB0,pB1,t+1,(t+4<NT),(t+2<NT),(t+2<NT));     ENDW(t+1); RESC(); ROT(); BLKUPD(t+2);
  }
  STEP(pB0,pB1,pA0,pA1,NT-1,false,false,false); RESC();
  { float sacc=pB0[0]+pB0[1]; _Pragma("unroll") for(int r=2;r<16;++r)sacc+=pB0[r]; _Pragma("unroll") for(int r=0;r<16;++r)sacc+=pB1[r]; l_reg+=sacc;
    pw0=(u32x4){PKW(pB0,0),PKW(pB0,2),PKW(pB0,4),PKW(pB0,6)};pw1=(u32x4){PKW(pB0,8),PKW(pB0,10),PKW(pB0,12),PKW(pB0,14)};pw2=(u32x4){PKW(pB1,0),PKW(pB1,2),PKW(pB1,4),PKW(pB1,6)};pw3=(u32x4){PKW(pB1,8),PKW(pB1,10),PKW(pB1,12),PKW(pB1,14)};
    SBAR(); pv(o,vb0+sl_cur,PAF(0),PAF(1),PAF(2),PAF(3)); }
  #undef PKW
  #undef PAF
  #undef VFR
  #undef PIN
  #undef MX3
  #undef GAPA
  #undef GAPB
  #undef EX
  #undef VRD
  #undef KRD
  #undef STEP
  #undef ENDW
  {auto rr=__builtin_amdgcn_permlane32_swap(__float_as_uint(l_reg),__float_as_uint(l_reg),false,false);l_reg=__uint_as_float(rr[0])+__uint_as_float(rr[1]);}
  if(hi==0)wsf[32+r32]=l_reg;asm volatile("s_waitcnt lgkmcnt(0)":::"memory");
  float rli[16];
  #pragma unroll
  for(int r=0;r<16;++r)rli[r]=__builtin_amdgcn_rcpf(wsf[32+crow(r,hi)]);
  abf16*Ow=O+(rowbase+q0+wid*QBLK)*DMO+OCOL+h*D;
  { abf16*stg=(abf16*)(shm+LDS_OST)+wid*2048;
    #pragma unroll
    for(int r=0;r<16;++r){const int orow=crow(r,hi);
      #pragma unroll
      for(int d0=0;d0<2;++d0)stg[orow*64+d0*32+r32]=__float2bfloat16(o[d0][r]*rli[r]);}
    asm volatile("s_waitcnt lgkmcnt(0)":::"memory");
    #pragma unroll
    for(int i=0;i<4;++i){const int row=i*8+(lane>>3),ch=lane&7; const u32x4 v=*(const u32x4*)(stg+row*64+ch*8); ATTN_STORE16(Ow+(long)row*DMO+ch*8,v);} }
  asm volatile("s_waitcnt lgkmcnt(0)\n\ts_barrier":::"memory");
  #undef DMA_K
  #undef DMA_V
  #undef CMASK
  #undef START
  #undef RESC
  #undef ROT
  #undef NV
  #undef BLKUPD
}
constexpr int ATTN_LDS_BYTES=LDS_BYTES;
struct AttnTensors { const abf16* Q; const abf16* K; const abf16* V; abf16* O; const float* KMP; const float* BT; };
struct AttnUnit { int bh; int qb; };
struct StaticOrder {
  int vcu;
  __device__ __forceinline__ explicit StaticOrder(int vcu_):vcu(vcu_){}
  __device__ __forceinline__ bool next(int i,AttnUnit&u)const{ if(i>=4||vcu>=256)return false; const int s=vcu&3; u.bh=vcu>>2; u.qb=(i==0)?s:(i==1)?7-s:(i==2)?8+s:15-s; return true; }
};
template<class Sched,int THRL=8> __device__ __forceinline__ void attn_phase(int wave_,char*lds,const AttnTensors&T,const Sched&S){
  AttnUnit u;
  for(int i=0;S.next(i,u);++i){ attn_unit<THRL>(wave_,u.bh/NHEAD,u.bh%NHEAD,u.qb,T.Q,T.K,T.V,T.O,T.KMP,T.BT,lds); }
}
#undef SBAR
#undef WAIT_BAR
}


struct SsmOrder { int G, c, mode;
    __device__ __forceinline__ bool next(int i, pg8::Unit& u) const { const int L = i * G + c;
        if (mode == 1) { if (L >= 32) return false; u.pm = L; u.pn = L >> 1; u.aux = 0; return true; }
        if (L >= 128) return false; const int g = L >> 3; u.pm = g * 2 + ((L >> 2) & 1); u.pn = g * 4 + (L & 3); u.aux = L & 3; return true; } };
struct HalfOrder { int L;
    __device__ __forceinline__ bool next(int i, pg8::Unit& u) const { if (i > 0 || L < 0 || L >= 128) return false; u.pm = L; u.pn = 0; u.aux = 0; return true; } };
struct EpiZ { static constexpr bool PERM = false; float* ZB;
    __device__ __forceinline__ void operator()(const f32x4 (&acc)[2][2][4][2], const pg8::Unit& u, int wr, int wc, int fr_, int fq_) const {
        const int ln_ = lane_id(), fr = ln_ & 15, fq = ln_ >> 4; (void)fr_; (void)fq_;
        const int row0 = u.pm * 256 + wr * 64 + fr, col0 = wc * 32 + 4 * fq;
#pragma unroll
        for (int ai = 0; ai < 2; ++ai)
#pragma unroll
            for (int m = 0; m < 4; ++m)
#pragma unroll
                for (int n = 0; n < 2; ++n) *(f32x4*)(ZB + (size_t)(row0 + ai * 128 + m * 16) * 128 + col0 + n * 16) = acc[ai][0][m][n];
    } };
struct EpiSsm2 { static constexpr bool PERM = true; const bf16* UG; bf16* YS; const float* dvec;
    __device__ __forceinline__ void operator()(const f32x4 (&acc)[2][2][4][2], const pg8::Unit& u, int wr, int wc, int fr_, int fq_) const {
        const int ln_ = lane_id(), fr = ln_ & 15, fq = ln_ >> 4; (void)fr_; (void)fq_;
        const int g = u.pm >> 1, cr0 = (u.pm & 1) * 256 + wr * 64 + fr;
#pragma unroll
        for (int bj = 0; bj < 2; ++bj) { const int n0 = u.aux * 256 + bj * 128 + wc * 32 + 8 * fq, to = n0 >> 4, ho0 = n0 & 15;
            const f32x4 d0 = *(const f32x4*)(dvec + g * 16 + ho0), d1 = *(const f32x4*)(dvec + g * 16 + ho0 + 4);
#pragma unroll
            for (int ai = 0; ai < 2; ++ai)
#pragma unroll
                for (int m = 0; m < 4; ++m) { const int cr = cr0 + ai * 128 + m * 16;
                    const u32x4 uu = *(const u32x4*)(UG + ((size_t)(g * 512 + cr)) * UGP + n0);
                    const f32x4 a0 = acc[ai][bj][m][0], a1 = acc[ai][bj][m][1]; float y[8];
                    y[0] = gelu_tanh(a0[0] + d0[0] * bf2f(uu.x & 0xffffu)); y[1] = gelu_tanh(a0[1] + d0[1] * bf2f(uu.x >> 16));
                    y[2] = gelu_tanh(a0[2] + d0[2] * bf2f(uu.y & 0xffffu)); y[3] = gelu_tanh(a0[3] + d0[3] * bf2f(uu.y >> 16));
                    y[4] = gelu_tanh(a1[0] + d1[0] * bf2f(uu.z & 0xffffu)); y[5] = gelu_tanh(a1[1] + d1[1] * bf2f(uu.z >> 16));
                    y[6] = gelu_tanh(a1[2] + d1[2] * bf2f(uu.w & 0xffffu)); y[7] = gelu_tanh(a1[3] + d1[3] * bf2f(uu.w >> 16));
                    u32x4 w; w.x = pg8::cvt_pk_bf16(y[0], y[1]); w.y = pg8::cvt_pk_bf16(y[2], y[3]); w.z = pg8::cvt_pk_bf16(y[4], y[5]); w.w = pg8::cvt_pk_bf16(y[6], y[7]);
                    *(u32x4*)(YS + ((size_t)cr * 64 + to) * 256 + g * 16 + ho0) = w; } }
    } };
struct EpiGluE { static constexpr bool PERM = true; const bf16* YS; bf16* YMIX; const float* gb;
    __device__ __forceinline__ void operator()(const f32x4 (&acc)[2][2][4][2], const pg8::Unit& u, int wr, int wc, int fr_, int fq_) const {
        const int ln_ = lane_id(), fr = ln_ & 15, fq = ln_ >> 4; (void)fr_; (void)fq_;
        const int row0 = u.pm * 256 + wr * 64 + fr;
#pragma unroll
        for (int bj = 0; bj < 2; ++bj) { const int n0 = bj * 128 + wc * 32 + 8 * fq; const f32x4 b0 = *(const f32x4*)(gb + n0), b1 = *(const f32x4*)(gb + n0 + 4);
#pragma unroll
            for (int ai = 0; ai < 2; ++ai)
#pragma unroll
                for (int m = 0; m < 4; ++m) { const size_t r = (size_t)(row0 + ai * 128 + m * 16); const u32x4 yy = *(const u32x4*)(YS + r * 256 + n0);
                    const f32x4 a0 = acc[ai][bj][m][0] + b0, a1 = acc[ai][bj][m][1] + b1; float o[8];
                    o[0] = bf2f(yy.x & 0xffffu) * sigmoidf_(a0[0]); o[1] = bf2f(yy.x >> 16) * sigmoidf_(a0[1]); o[2] = bf2f(yy.y & 0xffffu) * sigmoidf_(a0[2]); o[3] = bf2f(yy.y >> 16) * sigmoidf_(a0[3]);
                    o[4] = bf2f(yy.z & 0xffffu) * sigmoidf_(a1[0]); o[5] = bf2f(yy.z >> 16) * sigmoidf_(a1[1]); o[6] = bf2f(yy.w & 0xffffu) * sigmoidf_(a1[2]); o[7] = bf2f(yy.w >> 16) * sigmoidf_(a1[3]);
                    u32x4 w; w.x = pg8::cvt_pk_bf16(o[0], o[1]); w.y = pg8::cvt_pk_bf16(o[2], o[3]); w.z = pg8::cvt_pk_bf16(o[4], o[5]); w.w = pg8::cvt_pk_bf16(o[6], o[7]);
                    *(u32x4*)(YMIX + r * 1024 + n0) = w; } }
    } };
struct EpiPoolE { static constexpr bool PERM = true; bf16* YMIX; const float* pb; const float* ps;
    __device__ __forceinline__ void operator()(const f32x4 (&acc)[2][2][4][2], const pg8::Unit& u, int wr, int wc, int fr_, int fq_) const {
        const int ln_ = lane_id(), fr = ln_ & 15, fq = ln_ >> 4; (void)fr_; (void)fq_;
        const int row0 = u.pm * 256 + wr * 64 + fr;
#pragma unroll
        for (int bj = 0; bj < 2; ++bj) { const int n0 = bj * 128 + wc * 32 + 8 * fq; const f32x4 b0 = *(const f32x4*)(pb + n0), b1 = *(const f32x4*)(pb + n0 + 4), s0 = *(const f32x4*)(ps + n0), s1 = *(const f32x4*)(ps + n0 + 4);
#pragma unroll
            for (int ai = 0; ai < 2; ++ai)
#pragma unroll
                for (int m = 0; m < 4; ++m) { const size_t r = (size_t)(row0 + ai * 128 + m * 16);
                    const f32x4 a0 = (acc[ai][bj][m][0] + b0) * s0, a1 = (acc[ai][bj][m][1] + b1) * s1;
                    u32x4 w; w.x = pg8::cvt_pk_bf16(a0[0], a0[1]); w.y = pg8::cvt_pk_bf16(a0[2], a0[3]); w.z = pg8::cvt_pk_bf16(a1[0], a1[1]); w.w = pg8::cvt_pk_bf16(a1[2], a1[3]);
                    *(u32x4*)(YMIX + r * 1024 + 256 + n0) = w; } }
    } };
__device__ __forceinline__ void ph_ssm_scan(const Ctx& F0, int l) {
    const Ctx F = launder(F0);
    const int gw = F.vcu * NWAVES + F.wave, NGW = F.G * NWAVES;
    for (int it = gw; it < SGN * NB; it += NGW) {
        const int g = it >> 3, b = it & 7, p = F.lane;
        const float are = F.in[4][(l * SGN + g) * SP + p], aim = F.in[5][(l * SGN + g) * SP + p], dt = expf(F.in[6][l * SGN + g]);
        float sn, cs; sincosf(aim * dt * 64.f, &sn, &cs); const float mg = expf(are * dt * 64.f), lr = mg * cs, li = mg * sn;
        const float* Z = (const float*)(F.ws + WS_ZB) + ((size_t)g * 512 + b * 64) * 128;
        bf16* U = P_UG(F) + ((size_t)g * 512 + b * 64) * UGP + 1024;
        float sr = 0.f, si = 0.f;
#pragma unroll 4
        for (int c = 0; c < 64; ++c) {
            U[(size_t)c * UGP + p] = (bf16)f2bf(sr); U[(size_t)c * UGP + 64 + p] = (bf16)f2bf(si);
            const float zr = Z[c * 128 + p], zi = Z[c * 128 + 64 + p];
            const float nr = lr * sr - li * si + zr, ni = lr * si + li * sr + zi; sr = nr; si = ni;
        }
    }
}


namespace moba {
using bf16x8 = __attribute__((ext_vector_type(8))) short;
using s16x4 = __attribute__((ext_vector_type(4))) short;
using f32x16 = __attribute__((ext_vector_type(16))) float;
typedef short v4i16_t __attribute__((ext_vector_type(4)));
typedef float f32x2_t __attribute__((ext_vector_type(2))); typedef __bf16 bf16x2_t __attribute__((ext_vector_type(2)));
constexpr int L_K = 0, L_V = 16384, L_TB = 32768, L_KM = L_TB + 768 * 4, L_END = L_KM + 16 * 64 * 4;
__device__ __forceinline__ unsigned cvtpk(float lo, float hi) { f32x2_t v = {lo, hi}; bf16x2_t b = __builtin_convertvector(v, bf16x2_t); return __builtin_bit_cast(unsigned, b); }
__device__ __forceinline__ s16x4 vtr(const LAS char* p) { return __builtin_bit_cast(s16x4, __builtin_amdgcn_ds_read_tr16_b64_v4i16((LAS v4i16_t*)p)); }
__device__ __forceinline__ float hmax(float v) { const unsigned u = __builtin_bit_cast(unsigned, v); auto r = __builtin_amdgcn_permlane32_swap(u, u, false, false); return fmaxf(__builtin_bit_cast(float, (unsigned)r[0]), __builtin_bit_cast(float, (unsigned)r[1])); }
__device__ __forceinline__ float hsum(float v) { const unsigned u = __builtin_bit_cast(unsigned, v); auto r = __builtin_amdgcn_permlane32_swap(u, u, false, false); return __builtin_bit_cast(float, (unsigned)r[0]) + __builtin_bit_cast(float, (unsigned)r[1]); }

__device__ __forceinline__ void unit(int wave_, int b, int h, int qb, const bf16* Q, const bf16* K, const bf16* V, bf16* O, const float* KMP, const float* BT, LAS char* lds) {
    int lane_ = lane_id(); asm volatile("" : "+v"(lane_)); asm volatile("" : "+s"(b), "+s"(h), "+s"(qb), "+s"(wave_));
    const int wid = wave_, lane = lane_, tid = wid * 64 + lane, r32 = lane & 31, hi = lane >> 5;
    const int NT = 4 * qb + 4, q0 = qb * 256; const size_t rowbase = (size_t)b * SEQ;
    LAS float* tb = (LAS float*)(lds + L_TB); LAS float* km = (LAS float*)(lds + L_KM);
    const float bfar = BT[h * 132 + 128];
    for (int i = tid; i < 768; i += NTHREADS) { const int rel = i - 256; tb[i] = rel < 0 ? -1.0e30f : (rel < 128 ? BT[h * 132 + rel] - bfar : 0.f); }
    for (int i = tid; i < 16 * 64; i += NTHREADS) { const int j = i >> 6, d = i & 63, pm = b * 16 + j; km[i] = KMP[pm * 512 + h * 64 + d] + KMP[128 * 512 + pm * 512 + h * 64 + d]; }
    const bf16* ksrc = K + (rowbase + lane) * 512 + h * 64 + wid * 8;
    const bf16* vsrc = V + (rowbase + 16 * (wid & 3) + (lane >> 2)) * 512 + h * 64 + (wid >> 2) * 32 + (lane & 3) * 8;
    u32x4 kreg = *(const u32x4*)ksrc, vreg = *(const u32x4*)vsrc;
    bf16x8 qr[4];
    { const bf16* qw = Q + (rowbase + q0 + wid * 32 + r32) * 512 + h * 64 + hi * 8;
#pragma unroll
      for (int d0 = 0; d0 < 4; ++d0) qr[d0] = *(const bf16x8*)(qw + d0 * 16); }
    __syncthreads();
    unsigned selmask = 1u << qb;
    { float g[16];
#pragma unroll
      for (int j = 0; j < 16; ++j) g[j] = 0.f;
#pragma unroll
      for (int d0 = 0; d0 < 4; ++d0)
#pragma unroll
          for (int e = 0; e < 8; ++e) { const float qf = bf2f((unsigned)(unsigned short)qr[d0][e]);
#pragma unroll
              for (int j = 0; j < 16; ++j) g[j] += qf * km[j * 64 + d0 * 16 + hi * 8 + e]; }
#pragma unroll
      for (int j = 0; j < 16; ++j) g[j] = hsum(g[j]);
#pragma unroll
      for (int s = 0; s < 3; ++s) { float bv = -3.0e38f; int bi = -1;
#pragma unroll
          for (int j = 0; j < 16; ++j) { const bool ok = (j < qb) && !((selmask >> j) & 1u) && (g[j] > bv); bv = ok ? g[j] : bv; bi = ok ? j : bi; }
          if (bi >= 0) selmask |= 1u << bi; } }
    *(LAS u32x4*)(lds + L_K + wid * 1024 + lane * 16) = kreg; *(LAS u32x4*)(lds + L_V + wid * 1024 + lane * 16) = vreg;
    __syncthreads();
    const int qrel = wid * 32 + r32;
    const LAS char* kp0 = lds + L_K + hi * 1024 + r32 * 16;
    const LAS char* vp0 = lds + L_V + ((lane >> 4) & 1) * 32 + (lane & 3) * 8 + (4 * hi + ((lane & 15) >> 2)) * 64;
    float m = -1.0e20f, l = 0.f; f32x16 o0 = f32x16{}, o1 = f32x16{};
#pragma unroll 1
    for (int t = 0; t < NT; ++t) {
        const int buf = (t & 1) * 8192;
        if (t + 1 < NT) { kreg = *(const u32x4*)(ksrc + (size_t)(t + 1) * 64 * 512); vreg = *(const u32x4*)(vsrc + (size_t)(t + 1) * 64 * 512); }
        const float ci = ((selmask >> (t >> 2)) & 1u) ? bfar : -1.0e30f;
        f32x16 p0, p1;
#pragma unroll
        for (int r = 0; r < 16; ++r) { p0[r] = ci; p1[r] = ci; }
#pragma unroll
        for (int d0 = 0; d0 < 4; ++d0) { const bf16x8 a0 = *(const LAS bf16x8*)(kp0 + buf + d0 * 2048), a1 = *(const LAS bf16x8*)(kp0 + buf + d0 * 2048 + 512);
            p0 = __builtin_amdgcn_mfma_f32_32x32x16_bf16(a0, qr[d0], p0, 0, 0, 0); p1 = __builtin_amdgcn_mfma_f32_32x32x16_bf16(a1, qr[d0], p1, 0, 0, 0); }
        const int jn = t - (NT - 8);
        if (jn >= 0) { const LAS float* t0 = tb + (qrel - 64 * (jn - 4) - 4 * hi + 256);
#pragma unroll
            for (int r = 0; r < 16; ++r) { const int k = (r & 3) + 8 * (r >> 2); p0[r] += t0[-k]; p1[r] += t0[-k - 32]; } }
        float rm = fmaxf(p0[0], p1[0]);
#pragma unroll
        for (int r = 1; r < 16; ++r) rm = fmaxf(rm, fmaxf(p0[r], p1[r]));
        rm = hmax(rm);
        const float mn = fmaxf(fmaxf(m, rm), -1.0e20f), alpha = __builtin_amdgcn_exp2f(m - mn); m = mn;
        float s = 0.f;
#pragma unroll
        for (int r = 0; r < 16; ++r) { p0[r] = __builtin_amdgcn_exp2f(p0[r] - mn); p1[r] = __builtin_amdgcn_exp2f(p1[r] - mn); s += p0[r] + p1[r]; }
        l = l * alpha + s;
#pragma unroll
        for (int r = 0; r < 16; ++r) { o0[r] *= alpha; o1[r] *= alpha; }
        u32x4 pw[4];
#pragma unroll
        for (int q = 0; q < 4; ++q) { pw[0][q] = cvtpk(p0[2 * q], p0[2 * q + 1]); pw[1][q] = cvtpk(p0[8 + 2 * q], p0[9 + 2 * q]); pw[2][q] = cvtpk(p1[2 * q], p1[2 * q + 1]); pw[3][q] = cvtpk(p1[8 + 2 * q], p1[9 + 2 * q]); }
        const LAS char* vp = vp0 + buf;
#pragma unroll
        for (int k = 0; k < 4; ++k) {
            const s16x4 lo0 = vtr(vp + k * 1024), hi0 = vtr(vp + k * 1024 + 512), lo1 = vtr(vp + 4096 + k * 1024), hi1 = vtr(vp + 4096 + k * 1024 + 512);
            const bf16x8 v0 = (bf16x8){lo0[0], lo0[1], lo0[2], lo0[3], hi0[0], hi0[1], hi0[2], hi0[3]}, v1 = (bf16x8){lo1[0], lo1[1], lo1[2], lo1[3], hi1[0], hi1[1], hi1[2], hi1[3]};
            const bf16x8 pa = __builtin_bit_cast(bf16x8, pw[k]);
            o0 = __builtin_amdgcn_mfma_f32_32x32x16_bf16(v0, pa, o0, 0, 0, 0);
            o1 = __builtin_amdgcn_mfma_f32_32x32x16_bf16(v1, pa, o1, 0, 0, 0); }
        if (t + 1 < NT) { const int nb = ((t + 1) & 1) * 8192; *(LAS u32x4*)(lds + L_K + nb + wid * 1024 + lane * 16) = kreg; *(LAS u32x4*)(lds + L_V + nb + wid * 1024 + lane * 16) = vreg; }
        __syncthreads();
    }
    const float inv = 1.f / hsum(l);
    bf16* orow = O + (rowbase + q0 + wid * 32 + r32) * 1024 + 512 + h * 64 + 4 * hi;
#pragma unroll
    for (int g = 0; g < 4; ++g) { u32x2 w0, w1;
        w0.x = cvtpk(o0[4 * g] * inv, o0[4 * g + 1] * inv); w0.y = cvtpk(o0[4 * g + 2] * inv, o0[4 * g + 3] * inv);
        w1.x = cvtpk(o1[4 * g] * inv, o1[4 * g + 1] * inv); w1.y = cvtpk(o1[4 * g + 2] * inv, o1[4 * g + 3] * inv);
        *(u32x2*)(orow + 8 * g) = w0; *(u32x2*)(orow + 32 + 8 * g) = w1; }
}
__device__ __forceinline__ void phase(int wave, int vcu, const bf16* Q, const bf16* K, const bf16* V, bf16* O, const float* KMP, const float* BT, LAS char* lds) {
    if (vcu >= 256) return;
    const int s = vcu & 3, bh = vcu >> 2;
#pragma unroll 1
    for (int i = 0; i < 4; ++i) { const int qb = (i == 0) ? s : (i == 1) ? 7 - s : (i == 2) ? 8 + s : 15 - s; unit(wave, bh >> 3, bh & 7, qb, Q, K, V, O, KMP, BT, lds); }
}
}

template <class Epi>
__device__ __forceinline__ void naive_gemm(const Ctx& F0, const bf16* A, int lda, const float* Bw, int ldb, const float* kscale, int M, int N, int K, const Epi& epi) {
    const Ctx F = launder(F0);
    LAS float* As = (LAS float*)F.lds;
    LAS float* Bs = As + 16 * 132;
    const int tid = F.tid, ty = tid >> 4, tx = tid & 15;
    const int tm = M / 128, tn = N / 128;
    for (int tile = F.vcu; tile < tm * tn; tile += F.G) {
        const int m0 = (tile / tn) * 128, n0 = (tile % tn) * 128;
        float acc[4][8];
#pragma unroll
        for (int i = 0; i < 4; ++i)
#pragma unroll
            for (int j = 0; j < 8; ++j) acc[i][j] = 0.f;
        for (int k0 = 0; k0 < K; k0 += 16) {
            {
                const int row = tid >> 2, kq = (tid & 3) * 4;
                const u32x2 v = *(const u32x2*)(A + (size_t)(m0 + row) * lda + k0 + kq);
                As[(kq + 0) * 132 + row] = bf2f(v.x & 0xffffu); As[(kq + 1) * 132 + row] = bf2f(v.x >> 16);
                As[(kq + 2) * 132 + row] = bf2f(v.y & 0xffffu); As[(kq + 3) * 132 + row] = bf2f(v.y >> 16);
                const int kk = tid >> 5, nq = (tid & 31) * 4;
                f32x4 b = *(const f32x4*)(Bw + (size_t)(k0 + kk) * ldb + n0 + nq);
                const float s = kscale ? kscale[k0 + kk] : 1.f;
                b = b * s;
                *(LAS f32x4*)(Bs + kk * 128 + nq) = b;
            }
            __syncthreads();
#pragma unroll
            for (int kk = 0; kk < 16; ++kk) {
                const f32x4 a = *(const LAS f32x4*)(As + kk * 132 + ty * 4);
                const f32x4 b0 = *(const LAS f32x4*)(Bs + kk * 128 + tx * 8);
                const f32x4 b1 = *(const LAS f32x4*)(Bs + kk * 128 + tx * 8 + 4);
#pragma unroll
                for (int i = 0; i < 4; ++i) {
#pragma unroll
                    for (int j = 0; j < 4; ++j) { acc[i][j] += a[i] * b0[j]; acc[i][4 + j] += a[i] * b1[j]; }
                }
            }
            __syncthreads();
        }
#pragma unroll
        for (int i = 0; i < 4; ++i)
#pragma unroll
            for (int j = 0; j < 8; ++j) epi(m0 + ty * 4 + i, n0 + tx * 8 + j, acc[i][j]);
    }
}

struct EpiProj { Ctx F; __device__ __forceinline__ void operator()(int m, int n, float v) const { store_proj(F, m, n, v); } };
struct EpiGlu { bf16* ys; bf16* ymix; const float* gb;
    __device__ __forceinline__ void operator()(int m, int n, float v) const { const float y = bf2f(ys[(size_t)m * 256 + n]); ymix[(size_t)m * 1024 + n] = (bf16)f2bf(y * sigmoidf_(v + gb[n])); } };
struct EpiOut { const float* xin; float* R;
    __device__ __forceinline__ void operator()(int m, int n, float v) const { const size_t o = (size_t)m * D + n; R[o] = xin[o] + v; } };

__device__ __forceinline__ void ph_norm(const Ctx& F0, const float* xin) {
    const Ctx F = launder(F0);
    const int gw = F.vcu * NWAVES + F.wave, NGW = F.G * NWAVES;
    for (int m = gw; m < T; m += NGW) {
        const f32x4* xr = (const f32x4*)(xin + (size_t)m * D) + F.lane;
        f32x4 v[4]; float s = 0.f;
#pragma unroll
        for (int j = 0; j < 4; ++j) { v[j] = xr[64 * j]; s += (v[j].x * v[j].x + v[j].y * v[j].y) + (v[j].z * v[j].z + v[j].w * v[j].w); }
        const float rstd = 1.f / sqrtf(wave_sum(s) * (1.f / D) + RMS_EPS);
        unsigned long long* o8 = (unsigned long long*)(P_XB(F) + (size_t)m * D) + F.lane;
#pragma unroll
        for (int j = 0; j < 4; ++j) o8[64 * j] = (unsigned long long)pk2(v[j].x * rstd, v[j].y * rstd) | ((unsigned long long)pk2(v[j].z * rstd, v[j].w * rstd) << 32);
    }
}

__device__ __forceinline__ void ph_bias_table(const Ctx& F0) {
    const Ctx F = launder(F0);
    if (F.vcu == 0) {
        const float* rel_bias = F.in[1];
        for (int i = F.tid; i < 8 * 132; i += NTHREADS) {
            const int h = i / 132, r = i % 132;
            int bk;
            if (r < 16) bk = r;
            else { bk = 16 + (int)(logf((float)r / 16.f) / logf(8.f) * 16.f); if (bk > 31) bk = 31; }
            P_BT(F)[i] = rel_bias[bk * 8 + h] * LOG2E;
        }
    }
}

__device__ __forceinline__ void ph_kmean_naive(const Ctx& F0) {
    const Ctx F = launder(F0);
    const int gt = F.vcu * NTHREADS + F.tid, NGT = F.G * NTHREADS;
    for (int i = gt; i < 128 * 512; i += NGT) {
        const int pm = i >> 9, c = i & 511; float s = 0.f;
        for (int r = 0; r < 256; ++r) s += bf2f(P_KB(F)[(size_t)(pm * 256 + r) * 512 + c]);
        P_KMP(F)[i] = s; P_KMP(F)[128 * 512 + i] = 0.f;
    }
}

__device__ __forceinline__ void ph_ssm_naive(const Ctx& F0, int l) {
    const Ctx F = launder(F0);
    const int gw = F.vcu * NWAVES + F.wave, NGW = F.G * NWAVES;
    for (int it = gw; it < NB * SGN; it += NGW) {
        const int b = it / SGN, g = it % SGN, p = F.lane;
        const float are = F.in[4][(l * SGN + g) * SP + p], aim = F.in[5][(l * SGN + g) * SP + p];
        const float dt = __expf(F.in[6][l * SGN + g]);
        const float mag = expf(are * dt); float sn, cs; sincosf(aim * dt, &sn, &cs);
        const float lbr = mag * cs, lbi = mag * sn;
        const float nr = lbr - 1.f, ni = lbi, den = are * are + aim * aim;
        const float cr = (nr * are + ni * aim) / den, ci = (ni * are - nr * aim) / den;
        float bbr[16], bbi[16], ccr[16], cci[16];
#pragma unroll
        for (int h = 0; h < 16; ++h) {
            const float br = F.in[7][((size_t)(l * SGN + g) * SP + p) * SG + h], bi = F.in[8][((size_t)(l * SGN + g) * SP + p) * SG + h];
            bbr[h] = cr * br - ci * bi; bbi[h] = cr * bi + ci * br;
            ccr[h] = F.in[9][((size_t)(l * SGN + g) * SG + h) * SP + p]; cci[h] = F.in[10][((size_t)(l * SGN + g) * SG + h) * SP + p];
        }
        const float dh = (F.lane < 16) ? F.in[11][l * 256 + g * 16 + F.lane] : 0.f;
        float sr = 0.f, si = 0.f;
        for (int t = 0; t < SEQ; ++t) {
            const int m = b * SEQ + t;
            const bf16* up = P_UG(F) + ((size_t)(g * 512 + (m >> 6))) * UGP + (m & 63) * 16;
            const u32x4 u0 = *(const u32x4*)up, u1 = *(const u32x4*)(up + 8);
            float u[16];
            u[0] = bf2f(u0.x & 0xffffu); u[1] = bf2f(u0.x >> 16); u[2] = bf2f(u0.y & 0xffffu); u[3] = bf2f(u0.y >> 16);
            u[4] = bf2f(u0.z & 0xffffu); u[5] = bf2f(u0.z >> 16); u[6] = bf2f(u0.w & 0xffffu); u[7] = bf2f(u0.w >> 16);
            u[8] = bf2f(u1.x & 0xffffu); u[9] = bf2f(u1.x >> 16); u[10] = bf2f(u1.y & 0xffffu); u[11] = bf2f(u1.y >> 16);
            u[12] = bf2f(u1.z & 0xffffu); u[13] = bf2f(u1.z >> 16); u[14] = bf2f(u1.w & 0xffffu); u[15] = bf2f(u1.w >> 16);
            float bur = 0.f, bui = 0.f;
#pragma unroll
            for (int h = 0; h < 16; ++h) { bur += bbr[h] * u[h]; bui += bbi[h] * u[h]; }
            const float nsr = lbr * sr - lbi * si + bur, nsi = lbr * si + lbi * sr + bui;
            sr = nsr; si = nsi;
            float yo = 0.f, uo = 0.f;
#pragma unroll
            for (int h = 0; h < 16; ++h) {
                const float y = wave_sum(ccr[h] * sr - cci[h] * si);
                if (F.lane == h) { yo = y; uo = u[h]; }
            }
            if (F.lane < 16) P_YS(F)[(size_t)m * 256 + g * 16 + F.lane] = (bf16)f2bf(gelu_tanh(yo + dh * uo));
        }
    }
}

__device__ __forceinline__ void ph_pool_dl(const Ctx& F0) {
    const Ctx F = launder(F0);
    const int gt = F.vcu * NTHREADS + F.tid, NGT = F.G * NTHREADS;
    for (int i = gt; i < T * 256; i += NGT) {
        const int m = i >> 8, c = i & 255, t = m & (SEQ - 1), gi = c >> 6, win = 2 << gi;
        const int cnt = (t + 1 < win) ? t + 1 : win;
        float s = 0.f;
        for (int j = 0; j < cnt; ++j) s += bf2f(P_PB(F)[(size_t)(m - j) * 256 + c]);
        P_DL(F)[i] = (bf16)f2bf(s / (float)cnt - bf2f(P_PB(F)[i]));
    }
}
__device__ __forceinline__ void ph_pool_mm_naive(const Ctx& F0, int l) {
    const Ctx F = launder(F0);
    const int gt = F.vcu * NTHREADS + F.tid, NGT = F.G * NTHREADS;
    const float* w = F.in[14] + (size_t)l * 4 * 64 * 64;
    for (int i = gt; i < T * 256; i += NGT) {
        const int m = i >> 8, n = i & 255, gi = n >> 6, d = n & 63; float s = 0.f;
        for (int c = 0; c < 64; ++c) s += bf2f(P_DL(F)[(size_t)m * 256 + gi * 64 + c]) * w[(gi * 64 + c) * 64 + d];
        P_YMIX(F)[(size_t)m * 1024 + 256 + n] = (bf16)f2bf((s + F.in[15][l * 256 + n]) * F.in[16][l * 256 + n]);
    }
}

__device__ __forceinline__ void ph_attn_naive(const Ctx& F0) {
    const Ctx F = launder(F0);
    const int gw = F.vcu * NWAVES + F.wave, NGW = F.G * NWAVES, lane = F.lane;
    for (int it = gw; it < T * NHEAD; it += NGW) {
        const int h = it & 7, m = it >> 3, b = m >> 12, q = m & (SEQ - 1), qblk = q >> 8;
        const float qv = bf2f(P_QB(F)[(size_t)m * 512 + h * 64 + lane]);
        float mygate = -3.0e38f;
        for (int j = 0; j < qblk; ++j) {
            const int pm = b * NBLK + j;
            const float km = P_KMP(F)[pm * 512 + h * 64 + lane] + P_KMP(F)[128 * 512 + pm * 512 + h * 64 + lane];
            const float g = wave_sum(qv * km);
            if (lane == j) mygate = g;
        }
        int bsel0 = -1, bsel1 = -1, bsel2 = -1;
        const int nsel = qblk < 3 ? qblk : 3;
        for (int s = 0; s < nsel; ++s) {
            const float bv = wave_max(mygate);
            const unsigned long long bal = __ballot(mygate == bv);
            const int best = __builtin_ctzll(bal);
            if (s == 0) bsel0 = best; else if (s == 1) bsel1 = best; else bsel2 = best;
            if (lane == best) mygate = -3.0e38f;
        }
        float sc[16];
        float mx = -3.0e38f;
#pragma unroll
        for (int s = 0; s < 4; ++s) {
            const int blk = (s == 0) ? bsel0 : (s == 1) ? bsel1 : (s == 2) ? bsel2 : qblk;
#pragma unroll
            for (int c = 0; c < 4; ++c) {
                float v = -3.0e38f;
                if (blk >= 0) {
                    const int kpos = blk * 256 + c * 64 + lane, rel = q - kpos;
                    const bf16* kr = P_KB(F) + (size_t)(b * SEQ + kpos) * 512 + h * 64;
                    float dot = 0.f;
#pragma unroll
                    for (int d8 = 0; d8 < 8; ++d8) {
                        const u32x4 kk = *(const u32x4*)(kr + d8 * 8);
                        dot += __builtin_bit_cast(float, __builtin_amdgcn_readlane(__builtin_bit_cast(int, qv), d8 * 8 + 0)) * bf2f(kk.x & 0xffffu) + __builtin_bit_cast(float, __builtin_amdgcn_readlane(__builtin_bit_cast(int, qv), d8 * 8 + 1)) * bf2f(kk.x >> 16);
                        dot += __builtin_bit_cast(float, __builtin_amdgcn_readlane(__builtin_bit_cast(int, qv), d8 * 8 + 2)) * bf2f(kk.y & 0xffffu) + __builtin_bit_cast(float, __builtin_amdgcn_readlane(__builtin_bit_cast(int, qv), d8 * 8 + 3)) * bf2f(kk.y >> 16);
                        dot += __builtin_bit_cast(float, __builtin_amdgcn_readlane(__builtin_bit_cast(int, qv), d8 * 8 + 4)) * bf2f(kk.z & 0xffffu) + __builtin_bit_cast(float, __builtin_amdgcn_readlane(__builtin_bit_cast(int, qv), d8 * 8 + 5)) * bf2f(kk.z >> 16);
                        dot += __builtin_bit_cast(float, __builtin_amdgcn_readlane(__builtin_bit_cast(int, qv), d8 * 8 + 6)) * bf2f(kk.w & 0xffffu) + __builtin_bit_cast(float, __builtin_amdgcn_readlane(__builtin_bit_cast(int, qv), d8 * 8 + 7)) * bf2f(kk.w >> 16);
                    }
                    if (rel >= 0) v = dot + P_BT(F)[h * 132 + (rel < 128 ? rel : 128)];
                }
                sc[s * 4 + c] = v; mx = fmaxf(mx, v);
            }
        }
        mx = wave_max(mx);
        float sum = 0.f;
#pragma unroll
        for (int i = 0; i < 16; ++i) { sc[i] = (sc[i] > -1.0e38f) ? exp2f(sc[i] - mx) : 0.f; sum += sc[i]; }
        sum = wave_sum(sum);
        float o = 0.f;
#pragma unroll
        for (int s = 0; s < 4; ++s) {
            const int blk = (s == 0) ? bsel0 : (s == 1) ? bsel1 : (s == 2) ? bsel2 : qblk;
            if (blk >= 0) {
#pragma unroll
                for (int c = 0; c < 4; ++c) {
                    const bf16* vr = P_VB(F) + (size_t)(b * SEQ + blk * 256 + c * 64) * 512 + h * 64 + lane;
                    const float pc = sc[s * 4 + c];
                    for (int kk = 0; kk < 64; ++kk) {
                        const float p = __builtin_bit_cast(float, __builtin_amdgcn_readlane(__builtin_bit_cast(int, pc), kk));
                        o += p * bf2f(vr[(size_t)kk * 512]);
                    }
                }
            }
        }
        P_YMIX(F)[(size_t)m * 1024 + 512 + h * 64 + lane] = (bf16)f2bf(o / sum);
    }
}

__device__ __forceinline__ void ph_moe_naive(const Ctx& F0, int l) {
    const Ctx F = launder(F0);
    LAS float* h2 = (LAS float*)F.lds;
    LAS float* act = h2 + 1024;
    LAS float* red = act + 512;
    LAS float* lg = red + 32;
    LAS float* selw = lg + 24;
    const float* g2 = F.in[18] + l * D;
    const float* gw_ = F.in[19] + (size_t)l * D * 4; const float* gb_ = F.in[20] + l * 4;
    const float* rw_ = F.in[21] + (size_t)l * 4 * D * 4; const float* rb_ = F.in[22] + l * 16;
    const float* wg = F.in[23] + (size_t)l * 16 * D * 256; const float* wu = F.in[24] + (size_t)l * 16 * D * 256; const float* wd = F.in[25] + (size_t)l * 16 * 256 * D;
    const int tid = F.tid, lane = F.lane, wave = F.wave;
    for (int m = F.vcu; m < T; m += F.G) {
        float* xr = F.R + (size_t)m * D;
        const float x0 = xr[tid], x1 = xr[tid + 512];
        float s = wave_sum(x0 * x0 + x1 * x1);
        if (lane == 0) red[wave] = s;
        __syncthreads();
        float tot = 0.f;
#pragma unroll
        for (int w = 0; w < 8; ++w) tot += red[w];
        const float rstd = 1.f / sqrtf(tot * (1.f / D) + RMS_EPS);
        h2[tid] = x0 * rstd * g2[tid]; h2[tid + 512] = x1 * rstd * g2[tid + 512];
        __syncthreads();
        for (int j = wave; j < 20; j += NWAVES) {
            float a = 0.f;
            if (j < 4) { for (int k = lane; k < D; k += 64) a += h2[k] * gw_[k * 4 + j]; }
            else { const int g = (j - 4) >> 2, e = (j - 4) & 3; for (int k = lane; k < D; k += 64) a += h2[k] * rw_[((size_t)g * D + k) * 4 + e]; }
            a = wave_sum(a);
            if (lane == 0) lg[j] = a + (j < 4 ? gb_[j] : rb_[j - 4]);
        }
        __syncthreads();
        if (tid == 0) {
            int gs = 0; float gm = lg[0];
            for (int j = 1; j < 4; ++j) if (lg[j] > gm) { gm = lg[j]; gs = j; }
            float se = 0.f; for (int j = 0; j < 4; ++j) se += __expf(lg[j] - gm);
            const float gwt = 1.f / se;
            int e1 = 0; float v1 = lg[4 + gs * 4];
            for (int e = 1; e < 4; ++e) if (lg[4 + gs * 4 + e] > v1) { v1 = lg[4 + gs * 4 + e]; e1 = e; }
            int e2 = -1; float v2 = -3.0e38f;
            for (int e = 0; e < 4; ++e) if (e != e1 && lg[4 + gs * 4 + e] > v2) { v2 = lg[4 + gs * 4 + e]; e2 = e; }
            const float p2 = __expf(v2 - v1), w1 = 1.f / (1.f + p2), w2 = p2 / (1.f + p2);
            selw[0] = __builtin_bit_cast(float, gs * 4 + e1); selw[1] = __builtin_bit_cast(float, gs * 4 + e2);
            selw[2] = gwt * w1; selw[3] = gwt * w2;
        }
        __syncthreads();
        {
            const int slot = tid >> 8, f = tid & 255;
            const int e = __builtin_bit_cast(int, selw[slot]); const float cw = selw[2 + slot];
            const float* pg = wg + (size_t)e * D * 256 + f; const float* pu = wu + (size_t)e * D * 256 + f;
            float ag = 0.f, au = 0.f;
            for (int k = 0; k < D; ++k) { const float hv = h2[k]; ag += hv * pg[(size_t)k * 256]; au += hv * pu[(size_t)k * 256]; }
            act[slot * 256 + f] = ag * sigmoidf_(ag) * au * cw;
        }
        __syncthreads();
        {
            const int ea = __builtin_bit_cast(int, selw[0]), eb = __builtin_bit_cast(int, selw[1]);
            const float* pa = wd + (size_t)ea * 256 * D; const float* pb = wd + (size_t)eb * 256 * D;
            float y0 = 0.f, y1 = 0.f;
            for (int f = 0; f < 256; ++f) {
                const float a = act[f], b = act[256 + f];
                y0 += a * pa[(size_t)f * D + tid] + b * pb[(size_t)f * D + tid];
                y1 += a * pa[(size_t)f * D + tid + 512] + b * pb[(size_t)f * D + tid + 512];
            }
            xr[tid] = x0 + y0; xr[tid + 512] = x1 + y1;
        }
        __syncthreads();
    }
}

__device__ __forceinline__ void ph_final(const Ctx& F0) {
    const Ctx F = launder(F0);
    const int gw = F.vcu * NWAVES + F.wave, NGW = F.G * NWAVES;
    const f32x4* gf = (const f32x4*)F.in[26] + F.lane;
    for (int m = gw; m < T; m += NGW) {
        f32x4* xr = (f32x4*)(F.R + (size_t)m * D) + F.lane;
        f32x4 v[4]; float s = 0.f;
#pragma unroll
        for (int j = 0; j < 4; ++j) { v[j] = xr[64 * j]; s += (v[j].x * v[j].x + v[j].y * v[j].y) + (v[j].z * v[j].z + v[j].w * v[j].w); }
        const float rstd = 1.f / sqrtf(wave_sum(s) * (1.f / D) + RMS_EPS);
#pragma unroll
        for (int j = 0; j < 4; ++j) xr[64 * j] = v[j] * rstd * gf[64 * j];
    }
}

constexpr int LDS_BYTES = 147456;
constexpr int MISC_OFF = 131072 + 320;

__global__ void __launch_bounds__(NTHREADS, 2) mk_fwd(Args args) {
    extern __shared__ __attribute__((aligned(16))) unsigned char lds[];
    Ctx F;
    F.lds = (LAS unsigned char*)lds;
    F.wave = __builtin_amdgcn_readfirstlane((int)threadIdx.x >> 6);
    F.lane = lane_id(); F.tid = F.wave * 64 + F.lane;
    F.G = gridDim.x; { const int bx = blockIdx.x; F.vcu = (F.G % 8 == 0) ? (bx % 8) * (F.G / 8) + bx / 8 : bx; }
    F.in = (KargP)__builtin_amdgcn_kernarg_segment_ptr(); F.R = args.out; F.ws = args.ws;
    unsigned char* ws = args.ws;
    volatile LAS unsigned* MISC = (volatile LAS unsigned*)(F.lds + MISC_OFF);
    if (F.tid < 64) MISC[F.tid] = 0u;
    __syncthreads();
    XcdBarrier bar = xcd_barrier_post((unsigned*)(ws + WS_CTL) + CW_BAR, MISC + 8, F.tid == 0);
#define GRID_BAR() do { bar.bar = (unsigned*)(wsl(ws) + WS_CTL) + CW_BAR; xcd_barrier(bar, F.wave); } while (0)
#define FL launder(F)

    ph_bias_table(F);
#if USE_ENG_PROJ
    ph_prologue(F);
#endif
#pragma unroll 1
    for (int l = 0; l < DEPTH; ++l) {
        const float* xin = (l == 0) ? F.in[0] : F.R;
        ph_norm(F, xin);
        GRID_BAR();
#if USE_ENG_PROJ
        { pg8::Gemm g{P_XB(FL), (const bf16*)(wsl(ws) + WS_WIN) + (size_t)l * NPROJ * D, D, D, D}; pg8::StaticOrder S; S.init(T, NPROJ, sl(F.G), sl((int)blockIdx.x));
          EpiProjE E{P_UG(FL), P_PB(FL), P_QB(FL), P_KB(FL), P_VB(FL), P_KMP(FL)}; pg8::gemm_phase(F.lds, g, S, E, sl(F.wave)); }
#else
        { EpiProj E{F}; naive_gemm(F, P_XB(FL), D, F.in[3] + (size_t)l * D * NPROJ, NPROJ, F.in[2] + l * D, T, NPROJ, D, E); }
#endif
        GRID_BAR();
#if USE_ENG_SSM
        { pg8::Gemm g{P_UG(FL), (const bf16*)(wsl(ws) + WS_BZ) + (size_t)l * SGN * 256 * 1024, UGP, 1024, 1024}; SsmOrder S{sl(F.G), sl((int)blockIdx.x), 1};
          EpiZ E{(float*)(wsl(ws) + WS_ZB)}; pg8::gemm_phase(F.lds, g, S, E, sl(F.wave)); }
        ph_pool_dl(F);
        GRID_BAR();
        ph_ssm_scan(F, l);
        GRID_BAR();
        { pg8::Gemm g{P_UG(FL), (const bf16*)(wsl(ws) + WS_TG) + (size_t)l * SGN * 1024 * UGP, UGP, UGP, UGP}; SsmOrder S{sl(F.G), sl((int)blockIdx.x), 2};
          EpiSsm2 E{P_UG(FL), P_YS(FL), F.in[11] + l * 256}; pg8::gemm_phase(F.lds, g, S, E, sl(F.wave)); }
        GRID_BAR();
        { pg8::Gemm g{P_YS(FL), (const bf16*)(wsl(ws) + WS_GLUT) + (size_t)l * 65536, 256, 256, 256}; HalfOrder S{sl(F.vcu)};
          EpiGluE E{P_YS(FL), P_YMIX(FL), F.in[13] + l * 256}; pg8::gemm_phase(F.lds, g, S, E, sl(F.wave)); }
        { pg8::Gemm g{P_DL(FL), (const bf16*)(wsl(ws) + WS_POOLT) + (size_t)l * 65536, 256, 256, 256}; HalfOrder S{sl(F.vcu) - 128};
          EpiPoolE E{P_YMIX(FL), F.in[15] + l * 256, F.in[16] + l * 256}; pg8::gemm_phase(F.lds, g, S, E, sl(F.wave)); }
#else
        ph_ssm_naive(F, l);
#if !USE_ENG_PROJ
        ph_kmean_naive(F);
#endif
        ph_pool_dl(F);
        GRID_BAR();
        { EpiGlu E{P_YS(FL), P_YMIX(FL), F.in[13] + l * 256}; naive_gemm(F, P_YS(FL), 256, F.in[12] + (size_t)l * 256 * 256, 256, nullptr, T, 256, 256, E); }
        ph_pool_mm_naive(F, l);
#endif
#if USE_FAST_ATTN == 2
        moba::phase(sl(F.wave), sl(F.vcu), P_QB(FL), P_KB(FL), P_VB(FL), P_YMIX(FL), P_KMP(FL), P_BT(FL), (LAS char*)F.lds);
#elif USE_FAST_ATTN
        { const attn_body::AttnTensors AT{(const attn_body::abf16*)P_QB(FL), (const attn_body::abf16*)P_KB(FL), (const attn_body::abf16*)P_VB(FL), (attn_body::abf16*)P_YMIX(FL), P_KMP(FL), P_BT(FL)};
          const attn_body::StaticOrder S(sl(F.vcu)); attn_body::attn_phase<attn_body::StaticOrder>(sl(F.wave), (char*)lds, AT, S); }
#else
        ph_attn_naive(F);
#endif
        GRID_BAR();
#if USE_ENG_PROJ
        { pg8::Gemm g{P_YMIX(FL), (const bf16*)(wsl(ws) + WS_WOUT) + (size_t)l * D * D, D, D, D}; pg8::StaticOrder S; S.init(T, D, sl(F.G), sl((int)blockIdx.x));
          EpiOutE E{xin, F.R}; pg8::gemm_phase(F.lds, g, S, E, sl(F.wave)); }
#else
        { EpiOut E{xin, F.R}; naive_gemm(F, P_YMIX(FL), D, F.in[17] + (size_t)l * D * D, D, nullptr, T, D, D, E); }
#endif
        GRID_BAR();
#if USE_ENG_MOE
        ph_route(F, l);
        GRID_BAR();
        ph_place(F);
        GRID_BAR();
        { pg8::Gemm g{(const bf16*)(wsl(ws) + WS_XS), (const bf16*)(wsl(ws) + WS_GU) + (size_t)l * 16 * 512 * D, D, D, D}; MoeOrder S{(const int*)(wsl(ws) + WS_TILEB), sl(F.G), sl((int)blockIdx.x), false};
          EpiGU E{(bf16*)(wsl(ws) + WS_HACT), (const float*)(wsl(ws) + WS_ROWW)}; pg8::gemm_phase(F.lds, g, S, E, sl(F.wave)); }
        GRID_BAR();
        { pg8::Gemm g{(const bf16*)(wsl(ws) + WS_HACT), (const bf16*)(wsl(ws) + WS_WD) + (size_t)l * 24 * D * 512, 512, 512, 512}; MoeOrder S{(const int*)(wsl(ws) + WS_TILEB), sl(F.G), sl((int)blockIdx.x), true};
          EpiDown E{F.R, (const int*)(wsl(ws) + WS_ROWTOK)}; pg8::gemm_phase(F.lds, g, S, E, sl(F.wave)); }
        GRID_BAR();
#else
        ph_moe_naive(F, l);
        GRID_BAR();
#endif
    }
    ph_final(F);
}

extern "C" void kernel_launch(void* const* d_in, const int* in_sizes, int n_in, void* d_out, int out_size, void* d_ws, size_t ws_size, hipStream_t stream) {
    static int grid = 0;
    if (grid == 0) {
        if (n_in != 27 || out_size != T * D || ws_size < WS_END) { fprintf(stderr, "kernel_launch: unexpected shapes (n_in %d out %d ws %zu)\n", n_in, out_size, ws_size); grid = -1; return; }
        int dev = 0, cus = 0, per_cu = 0;
        if (hipGetDevice(&dev) != hipSuccess || hipDeviceGetAttribute(&cus, hipDeviceAttributeMultiprocessorCount, dev) != hipSuccess) { grid = -1; return; }
        if (hipFuncSetAttribute((const void*)mk_fwd, hipFuncAttributeMaxDynamicSharedMemorySize, LDS_BYTES) != hipSuccess) { fprintf(stderr, "kernel_launch: hipFuncSetAttribute failed\n"); grid = -1; return; }
        if (hipOccupancyMaxActiveBlocksPerMultiprocessor(&per_cu, (const void*)mk_fwd, NTHREADS, LDS_BYTES) != hipSuccess || per_cu < 1) { fprintf(stderr, "kernel_launch: occupancy query says %d\n", per_cu); per_cu = 1; }
        (void)hipGetLastError();
        grid = cus;
    }
    if (grid < 0) return;
    (void)hipMemsetAsync((char*)d_ws + WS_CTL, 0, CTL_ZERO_BYTES, stream);
    Args a{};
    for (int i = 0; i < 27; ++i) a.in[i] = (const float*)d_in[i];
    a.out = (float*)d_out; a.ws = (unsigned char*)d_ws; a.ph_lo = 0; a.ph_hi = 0;
    hipLaunchKernelGGL(mk_fwd, dim3(grid), dim3(NTHREADS), LDS_BYTES, stream, a);
}
```

```cpp
#include <hip/hip_runtime.h>
#include <hip/hip_bf16.h>
#include <cstdio>
#include <cstdint>

#define GAS __attribute__((address_space(1)))
#define LAS __attribute__((address_space(3)))
typedef unsigned short bf16;
typedef float f32x4 __attribute__((ext_vector_type(4)));
typedef unsigned u32x4 __attribute__((ext_vector_type(4)));
typedef unsigned u32x2 __attribute__((ext_vector_type(2)));

constexpr int NB = 8, SEQ = 4096, T = NB * SEQ, D = 1024, NPROJ = 2048, DEPTH = 2;
constexpr int NHEAD = 8, HD = 64, MBLK = 256, NBLK = SEQ / MBLK;
constexpr int SG = 16, SGN = 16, SP = 64, SCH = 64, UGP = 1152;
constexpr float RMS_EPS = 1e-6f;
constexpr float LOG2E = 1.4426950408889634f;
constexpr float C2 = 0.125f * LOG2E;
constexpr int NWAVES = 8, NTHREADS = 512;
#ifndef USE_ENG_PROJ
#define USE_ENG_PROJ 1
#endif
#ifndef USE_ENG_SSM
#define USE_ENG_SSM 1
#endif
#ifndef USE_FAST_ATTN
#define USE_FAST_ATTN 2
#endif
#ifndef USE_ENG_MOE
#define USE_ENG_MOE 1
#endif

constexpr size_t MiB = 1u << 20;
constexpr size_t WS_CTL = 0, CTL_ZERO_BYTES = 1 * MiB;
constexpr size_t WS_XB = 2 * MiB;
constexpr size_t WS_UG = 66 * MiB;
constexpr size_t WS_PB = 84 * MiB;
constexpr size_t WS_QB = 100 * MiB;
constexpr size_t WS_KB = 132 * MiB;
constexpr size_t WS_VB = 164 * MiB;
constexpr size_t WS_YMIX = 196 * MiB;
constexpr size_t WS_YS = 260 * MiB;
constexpr size_t WS_DL = 276 * MiB;
constexpr size_t WS_KMP = 292 * MiB;
constexpr size_t WS_BT = 293 * MiB;
constexpr size_t WS_WIN = 300 * MiB;
constexpr size_t WS_WOUT = 308 * MiB;
constexpr size_t WS_GU = 312 * MiB;
constexpr size_t WS_WD = 344 * MiB;
constexpr size_t WS_TG = 392 * MiB;
constexpr size_t WS_BZ = 464 * MiB;
constexpr size_t WS_GLUT = 480 * MiB;
constexpr size_t WS_POOLT = WS_GLUT + 512 * 1024;
constexpr size_t WS_ZB = 482 * MiB;
constexpr size_t WS_END = 486 * MiB;
constexpr int MOE_MAXT = 152;
constexpr size_t WS_XS = 66 * MiB;
constexpr size_t WS_HACT = 142 * MiB;
constexpr size_t WS_TOKB = 294 * MiB;
constexpr size_t WS_TOKR = WS_TOKB + 128 * 1024;
constexpr size_t WS_TOKW = WS_TOKB + 256 * 1024;
constexpr size_t WS_ROWTOK = 295 * MiB;
constexpr size_t WS_ROWW = WS_ROWTOK + 256 * 1024;
constexpr size_t WS_WGCNT = 296 * MiB;
constexpr size_t WS_TILEB = WS_WGCNT + 64 * 1024;

constexpr int CW_BAR = 4096;

__device__ __forceinline__ unsigned f2bf(float f) { unsigned u = __builtin_bit_cast(unsigned, f); return (u + 0x7fffu + ((u >> 16) & 1u)) >> 16; }
__device__ __forceinline__ float bf2f(unsigned h) { return __builtin_bit_cast(float, h << 16); }
__device__ __forceinline__ unsigned pk2(float lo, float hi) { return f2bf(lo) | (f2bf(hi) << 16); }
template <int O> __device__ __forceinline__ float xshfl(float v) {
    if constexpr (O < 32) return __builtin_bit_cast(float, __builtin_amdgcn_ds_swizzle(__builtin_bit_cast(int, v), (O << 10) | 0x1f));
    else { const unsigned u = __builtin_bit_cast(unsigned, v); auto r = __builtin_amdgcn_permlane32_swap(u, u, false, false);
           const float a = __builtin_bit_cast(float, (unsigned)r[0]), b = __builtin_bit_cast(float, (unsigned)r[1]); return (a == v && __builtin_bit_cast(unsigned, a) == u) ? b : a; }
}
__device__ __forceinline__ float wave_sum(float v) {
    v += xshfl<1>(v); v += xshfl<2>(v); v += xshfl<4>(v); v += xshfl<8>(v); v += xshfl<16>(v);
    const unsigned u = __builtin_bit_cast(unsigned, v); auto r = __builtin_amdgcn_permlane32_swap(u, u, false, false);
    return __builtin_bit_cast(float, (unsigned)r[0]) + __builtin_bit_cast(float, (unsigned)r[1]);
}
__device__ __forceinline__ float wave_max(float v) {
    v = fmaxf(v, xshfl<1>(v)); v = fmaxf(v, xshfl<2>(v)); v = fmaxf(v, xshfl<4>(v)); v = fmaxf(v, xshfl<8>(v)); v = fmaxf(v, xshfl<16>(v));
    const unsigned u = __builtin_bit_cast(unsigned, v); auto r = __builtin_amdgcn_permlane32_swap(u, u, false, false);
    return fmaxf(__builtin_bit_cast(float, (unsigned)r[0]), __builtin_bit_cast(float, (unsigned)r[1]));
}
__device__ __forceinline__ float gelu_tanh(float x) {
    const float u = 0.7978845608028654f * (x + 0.044715f * x * x * x);
    const float e = __expf(2.f * u);
    const float th = 1.f - 2.f / (e + 1.f);
    return 0.5f * x * (1.f + th);
}
__device__ __forceinline__ float sigmoidf_(float x) { return 1.f / (1.f + __expf(-x)); }

__device__ __forceinline__ int lane_id() { unsigned m; asm volatile("s_mov_b32 %0, -1" : "=s"(m)); return (int)__builtin_amdgcn_mbcnt_hi(m, __builtin_amdgcn_mbcnt_lo(m, 0u)); }

#define XB_TMO      128
#define XB_XCNT(j)  (256  + 64 * (j))
#define XB_XSUB(j)  (1280 + 64 * (j))
#define XB_XGEN(j)  (2304 + 64 * (j))
#define XB_TOP      3328
#define XB_TOPGEN   3392
#define XCD_BAR_WORDS 3456
#define XB_SPIN_CAP (1u << 22)
__device__ __forceinline__ unsigned xb_ld(unsigned* p)              { return __hip_atomic_load(p, __ATOMIC_RELAXED, __HIP_MEMORY_SCOPE_AGENT); }
__device__ __forceinline__ unsigned xb_add(unsigned* p, unsigned v) { return __hip_atomic_fetch_add(p, v, __ATOMIC_RELAXED, __HIP_MEMORY_SCOPE_AGENT); }
__device__ __forceinline__ unsigned xb_xcc_id() { return (unsigned)__builtin_amdgcn_s_getreg((3 << 11) | 20) & 0xFu; }
#define XB_SPIN(cond, bar) do { unsigned _sp = 0; while (cond) { __builtin_amdgcn_s_sleep(1); \
    if ((++_sp & 255u) == 0u) { if (xb_ld(&(bar)[XB_TMO])) break; if (_sp > XB_SPIN_CAP) { atomicAdd(&(bar)[XB_TMO], 1u); break; } } } } while (0)
struct XcdBarrier { unsigned* bar; unsigned x; volatile LAS unsigned* st; };
__device__ __forceinline__ XcdBarrier xcd_barrier_post(unsigned* bar, volatile LAS unsigned* st, bool t0) {
    XcdBarrier b; b.bar = bar; b.x = xb_xcc_id(); b.st = st;
    if (t0) (void)xb_add(&bar[XB_XCNT(b.x)], 1u);
    return b;
}
__device__ __forceinline__ void xcd_barrier_complete(unsigned* bar, unsigned x, unsigned& nloc, unsigned& nx) {
    const unsigned G = gridDim.x * gridDim.y * gridDim.z;
    unsigned sum, cnt, mine, sp = 0u;
    for (;;) {
        sum = 0u; cnt = 0u; mine = 0u;
#pragma unroll
        for (unsigned j = 0; j < 16; ++j) { const unsigned c = xb_ld(&bar[XB_XCNT(j)]); sum += c; cnt += (c > 0u) ? 1u : 0u; mine = (j == x) ? c : mine; }
        if (sum == G) break;
        __builtin_amdgcn_s_sleep(1);
        if ((++sp & 255u) == 0u) { if (xb_ld(&bar[XB_TMO])) break; if (sp > XB_SPIN_CAP) { atomicAdd(&bar[XB_TMO], 1u); break; } }
    }
    nloc = mine > 0u ? mine : 1u; nx = cnt > 0u ? cnt : 1u;
}
__device__ __forceinline__ void xcd_barrier(const XcdBarrier& b, int wave) {
    asm volatile("s_waitcnt vmcnt(0)" ::: "memory");
    __syncthreads();
    if (wave == 0 && lane_id() == 0) {
        unsigned* bar = b.bar;
        __builtin_amdgcn_s_waitcnt(0);
        unsigned nloc = b.st[0], nx = b.st[1];
        if (nloc == 0u) { xcd_barrier_complete(bar, b.x, nloc, nx); b.st[0] = nloc; b.st[1] = nx; }
        const unsigned old = xb_add(&bar[XB_XSUB(b.x)], 1u);
        const unsigned gen = old / nloc;
        if (old + 1u == (gen + 1u) * nloc) {
            __builtin_amdgcn_fence(__ATOMIC_RELEASE, "agent");
            asm volatile("s_waitcnt vmcnt(0)" ::: "memory");
            const unsigned og = xb_add(&bar[XB_TOP], 1u);
            const unsigned tg = og / nx;
            if (og + 1u == (tg + 1u) * nx) xb_add(&bar[XB_TOPGEN], 1u);
            else XB_SPIN(xb_ld(&bar[XB_TOPGEN]) == tg, bar);
            __builtin_amdgcn_fence(__ATOMIC_ACQUIRE, "agent");
            xb_add(&bar[XB_XGEN(b.x)], 1u);
            asm volatile("s_waitcnt vmcnt(0)" ::: "memory");
        } else {
            XB_SPIN(xb_ld(&bar[XB_XGEN(b.x)]) == gen, bar);
            __builtin_amdgcn_fence(__ATOMIC_ACQUIRE, "agent");
            asm volatile("s_waitcnt vmcnt(0)" ::: "memory");
        }
    }
    __syncthreads();
}

__device__ __forceinline__ void simple_barrier(unsigned* cnt, volatile LAS unsigned* ep, int wave) {
    asm volatile("s_waitcnt vmcnt(0)" ::: "memory");
    __syncthreads();
    if (wave == 0 && lane_id() == 0) {
        __threadfence();
        asm volatile("s_waitcnt vmcnt(0)" ::: "memory");
        const unsigned e = ep[0] + 1u; ep[0] = e; const unsigned target = e * gridDim.x;
        (void)xb_add(cnt, 1u);
        unsigned sp = 0;
        while (xb_ld(cnt) < target) { __builtin_amdgcn_s_sleep(2); if (++sp > (1u << 24)) break; }
        __threadfence();
        asm volatile("s_waitcnt vmcnt(0)" ::: "memory");
    }
    __syncthreads();
}

struct Args {
    const float* in[27];
    float* out;
    unsigned char* ws;
    int ph_lo, ph_hi;
};

typedef const float* fptr_t;
typedef __attribute__((address_space(4))) const fptr_t* KargP;
struct Ctx {
    LAS unsigned char* lds;
    int tid, lane, wave, vcu, G;
    KargP in;
    float* R;
    unsigned char* ws;
};
#define P_XB(F) ((bf16*)((F).ws + WS_XB))
#define P_UG(F) ((bf16*)((F).ws + WS_UG))
#define P_PB(F) ((bf16*)((F).ws + WS_PB))
#define P_QB(F) ((bf16*)((F).ws + WS_QB))
#define P_KB(F) ((bf16*)((F).ws + WS_KB))
#define P_VB(F) ((bf16*)((F).ws + WS_VB))
#define P_YMIX(F) ((bf16*)((F).ws + WS_YMIX))
#define P_YS(F) ((bf16*)((F).ws + WS_YS))
#define P_DL(F) ((bf16*)((F).ws + WS_DL))
#define P_KMP(F) ((float*)((F).ws + WS_KMP))
#define P_BT(F) ((float*)((F).ws + WS_BT))


__device__ __forceinline__ Ctx launder(const Ctx& F0) {
    Ctx F = F0;
    int ln = lane_id(); asm volatile("" : "+v"(ln));
    asm volatile("" : "+s"(F.wave), "+s"(F.vcu), "+s"(F.G));
    F.lane = ln; F.tid = F.wave * 64 + ln;
    KargP kp = (KargP)__builtin_amdgcn_kernarg_segment_ptr(); asm volatile("" : "+s"(kp));
    F.in = kp; F.R = (float*)kp[27]; F.ws = (unsigned char*)kp[28];
    return F;
}

__device__ __forceinline__ unsigned char* wsl(unsigned char* p) { asm volatile("" : "+s"(p)); return p; }
__device__ __forceinline__ int sl(int x) { asm volatile("" : "+s"(x)); return x; }

__device__ __forceinline__ void store_proj(const Ctx& F, int m, int c, float v) {
    if (c < 256) { const int g = c >> 4, h = c & 15; P_UG(F)[((size_t)(g * 512 + (m >> 6))) * UGP + (m & 63) * 16 + h] = (bf16)f2bf(v); }
    else if (c < 512) P_PB(F)[(size_t)m * 256 + (c - 256)] = (bf16)f2bf(v);
    else if (c < 1024) P_QB(F)[(size_t)m * 512 + (c - 512)] = (bf16)f2bf(v * C2);
    else if (c < 1536) P_KB(F)[(size_t)m * 512 + (c - 1024)] = (bf16)f2bf(v);
    else P_VB(F)[(size_t)m * 512 + (c - 1536)] = (bf16)f2bf(v);
}


namespace pg8 {
typedef short bf16x8 __attribute__((ext_vector_type(8)));
constexpr int BM = 256, BK = 64, HALF = 128, HTB = HALF * BK * 2, STAGE_BYTES = 8 * HTB, NXCD = 8, WGM = 8;
__device__ __forceinline__ int lds_byte(int r, int c) { const int st = (r >> 4) * 2 + (c >> 5), rr = r & 15, cc = c & 31, ob = rr * 64 + cc * 2; return st * 1024 + (ob ^ (((ob >> 9) & 1) << 5)); }
__device__ __forceinline__ void stage_rc(int b, int& R, int& C) { const int st = b / 1024, sb = b % 1024, swz = sb ^ (((sb >> 9) & 1) << 5); R = (st >> 1) * 16 + swz / 64; C = (st & 1) * 32 + (swz % 64) / 2; }
__device__ __forceinline__ int perm32(int rho) { const int n = rho >> 4, i = rho & 15; return 8 * (i >> 2) + 4 * n + (i & 3); }

struct Unit { int pm, pn, aux; };
struct Gemm { const bf16* A; const bf16* Bt; int lda, ldb, K; };

struct StaticOrder {
    int nM, nN, nwg, G, c;
    __device__ void init(int M, int N, int G_, int c_) { nM = M / BM; nN = N / BM; nwg = nM * nN; G = G_; c = c_; }
    __device__ bool next(int i, Unit& u) const {
        const long L = (long)i * G + c; if (L >= nwg) return false;
        int wgid = (int)L; { const int q = nwg / NXCD, r = nwg % NXCD, xcd = wgid % NXCD, off = wgid / NXCD; wgid = (xcd < r ? xcd * (q + 1) : r * (q + 1) + (xcd - r) * q) + off; }
        const int nig = WGM * nN, gid = wgid / nig, fm = gid * WGM, gsz = (nM - fm) < WGM ? (nM - fm) : WGM;
        u.pm = fm + ((wgid % nig) % gsz); u.pn = (wgid % nig) / gsz; u.aux = 0; return true;
    }
};

__device__ __forceinline__ unsigned cvt_pk_bf16(float lo, float hi) { unsigned r; asm volatile("v_cvt_pk_bf16_f32 %0, %1, %2" : "=v"(r) : "v"(lo), "v"(hi)); return r; }

template <class Epi, class Sched>
__device__ __forceinline__ void gemm_phase(LAS unsigned char* lds, const Gemm g, const Sched& S, const Epi& E, int wave_) {
    int lane_ = lane_id(); asm volatile("" : "+v"(lane_)); asm volatile("" : "+s"(wave_));
    const int wid = wave_, lane = lane_, tid = wid * 64 + lane, wr = wid >> 2, wc = wid & 3, fr = lane & 15, fq = lane >> 4;
    const int K = g.K, nt = K / BK;
    unsigned voffA[2], voffB[2];
#pragma unroll
    for (int i = 0; i < 2; ++i) { int R, C; stage_rc(tid * 16 + i * 8192, R, C); const int Rb = Epi::PERM ? ((R & ~31) + perm32(R & 31)) : R;
        voffA[i] = (unsigned)(R * g.lda + C) * 2u; voffB[i] = (unsigned)(Rb * g.ldb + C) * 2u; }
    const size_t kstep = (size_t)(BK * 2);
    const size_t hstepA = (size_t)HALF * g.lda * 2, hstepB = (size_t)HALF * g.ldb * 2;
    const size_t tstepA = 2 * hstepA, tstepB = 2 * hstepB;
    const unsigned ldsw = (unsigned)wid * 1024u;
    const int aoff = lds_byte(wr * 64 + fr, fq * 8), boff = lds_byte(wc * 32 + fr, fq * 8);
#define PG8_SA(b, h) (((b) * 2 + (h)) * HTB)
#define PG8_SB(b, h) ((4 + (b) * 2 + (h)) * HTB)
#define PG8_STAGE(bufoff, gbase, voff) do { _Pragma("unroll") for (int _i = 0; _i < 2; ++_i) \
        __builtin_amdgcn_global_load_lds((const unsigned*)((const char*)(gbase) + (voff)[_i]), (LAS unsigned*)(lds + (bufoff) + ldsw + _i * 8192), 16, 0, 0); } while (0)
#define PG8_LDA(dst, b, h) do { _Pragma("unroll") for (int m = 0; m < 4; ++m) _Pragma("unroll") for (int k = 0; k < 2; ++k) dst[m][k] = *(const LAS bf16x8*)(lds + PG8_SA(b, h) + aoff + m * 2048 + k * 1024); } while (0)
#define PG8_LDB(dst, b, h) do { _Pragma("unroll") for (int n = 0; n < 2; ++n) _Pragma("unroll") for (int k = 0; k < 2; ++k) dst[n][k] = *(const LAS bf16x8*)(lds + PG8_SB(b, h) + boff + n * 2048 + k * 1024); } while (0)
#define PG8_MMA(ai, bj, At, Bt) do { __builtin_amdgcn_s_setprio(1); _Pragma("unroll") for (int m = 0; m < 4; ++m) _Pragma("unroll") for (int n = 0; n < 2; ++n) _Pragma("unroll") for (int k = 0; k < 2; ++k) \
        acc[ai][bj][m][n] = __builtin_amdgcn_mfma_f32_16x16x32_bf16(Bt[n][k], At[m][k], acc[ai][bj][m][n], 0, 0, 0); __builtin_amdgcn_s_setprio(0); } while (0)
#define PG8_WAIT_V(n) asm volatile("s_waitcnt vmcnt(" #n ")" ::: "memory")
#define PG8_WAIT_L(n) asm volatile("s_waitcnt lgkmcnt(" #n ")" ::: "memory")
#define PG8_BAR __builtin_amdgcn_s_barrier()
#define PG8_SCHED __builtin_amdgcn_sched_barrier(0)
    Unit cur, nxt; int ui = 0;
    if (!S.next(0, cur)) return;
    f32x4 acc[2][2][4][2];
#pragma unroll
    for (int a = 0; a < 2; ++a)
#pragma unroll
        for (int b = 0; b < 2; ++b)
#pragma unroll
            for (int m = 0; m < 4; ++m)
#pragma unroll
                for (int n = 0; n < 2; ++n) acc[a][b][m][n] = (f32x4){0.f, 0.f, 0.f, 0.f};
    bf16x8 At[4][2], B0[2][2], B1[2][2];
    const char* cA = (const char*)g.A + (size_t)cur.pm * tstepA; const char* cB = (const char*)g.Bt + (size_t)cur.pn * tstepB;
    PG8_STAGE(PG8_SB(0, 0), cB, voffB); PG8_STAGE(PG8_SB(0, 1), cB + hstepB, voffB); PG8_STAGE(PG8_SA(0, 0), cA, voffA); PG8_STAGE(PG8_SA(0, 1), cA + hstepA, voffA);
    if (wr == 1) PG8_BAR;
    PG8_WAIT_V(2); PG8_BAR;
    PG8_STAGE(PG8_SB(1, 0), cB + kstep, voffB); PG8_STAGE(PG8_SA(1, 0), cA + kstep, voffA); PG8_STAGE(PG8_SB(1, 1), cB + hstepB + kstep, voffB);
    PG8_WAIT_V(6); PG8_BAR;
    for (;;) {
        const bool has_next = S.next(ui + 1, nxt);
        const char* nA = has_next ? (const char*)g.A + (size_t)nxt.pm * tstepA : cA; const char* nB = has_next ? (const char*)g.Bt + (size_t)nxt.pn * tstepB : cB;
        for (int t = 0; t < nt; t += 2) {
            const bool last = (t == nt - 2);
            const char* a1 = cA + (size_t)(t + 1) * kstep;
            const char* a2 = last ? nA : cA + (size_t)(t + 2) * kstep; const char* b2 = last ? nB : cB + (size_t)(t + 2) * kstep;
            const char* a3 = a2 + kstep; const char* b3 = b2 + kstep;
            PG8_LDB(B0, 0, 0); PG8_LDB(B1, 0, 1); PG8_SCHED; PG8_LDA(At, 0, 0); PG8_STAGE(PG8_SA(1, 1), a1 + hstepA, voffA);
            PG8_WAIT_V(8); PG8_WAIT_L(0); PG8_BAR; PG8_MMA(0, 0, At, B0); PG8_MMA(0, 1, At, B1); PG8_BAR; PG8_SCHED;
            PG8_LDA(At, 0, 1); PG8_STAGE(PG8_SB(0, 0), b2, voffB); PG8_STAGE(PG8_SB(0, 1), b2 + hstepB, voffB); PG8_STAGE(PG8_SA(0, 0), a2, voffA);
            PG8_WAIT_V(8); PG8_WAIT_L(0); PG8_BAR; PG8_MMA(1, 0, At, B0); PG8_MMA(1, 1, At, B1); PG8_BAR; PG8_SCHED;
            PG8_LDB(B0, 1, 0); PG8_LDB(B1, 1, 1); PG8_SCHED; PG8_LDA(At, 1, 0); PG8_STAGE(PG8_SA(0, 1), a2 + hstepA, voffA);
            PG8_WAIT_V(8); PG8_WAIT_L(0); PG8_BAR; PG8_MMA(0, 0, At, B0); PG8_MMA(0, 1, At, B1); PG8_BAR; PG8_SCHED;
            PG8_LDA(At, 1, 1); PG8_STAGE(PG8_SB(1, 0), b3, voffB); PG8_STAGE(PG8_SB(1, 1), b3 + hstepB, voffB); PG8_STAGE(PG8_SA(1, 0), a3, voffA);
            PG8_WAIT_V(8); PG8_WAIT_L(0); PG8_BAR; PG8_MMA(1, 0, At, B0); PG8_MMA(1, 1, At, B1); PG8_BAR; PG8_SCHED;
        }
        if (wr == 0) PG8_BAR;
        E(acc, cur, wr, wc, fr, fq);
        if (!has_next) break;
#pragma unroll
        for (int a = 0; a < 2; ++a)
#pragma unroll
            for (int b = 0; b < 2; ++b)
#pragma unroll
                for (int m = 0; m < 4; ++m)
#pragma unroll
                    for (int n = 0; n < 2; ++n) acc[a][b][m][n] = (f32x4){0.f, 0.f, 0.f, 0.f};
        cur = nxt; cA = nA; cB = nB; ++ui;
        if (wr == 1) PG8_BAR;
    }
    PG8_WAIT_V(0);
    PG8_BAR;
#undef PG8_SA
#undef PG8_SB
#undef PG8_STAGE
#undef PG8_LDA
#undef PG8_LDB
#undef PG8_MMA
#undef PG8_WAIT_V
#undef PG8_WAIT_L
#undef PG8_BAR
#undef PG8_SCHED
}
}


struct EpiProjE {
    static constexpr bool PERM = true;
    bf16 *UG, *PB, *QB, *KB, *VB; float* KMP;
    __device__ __forceinline__ void operator()(const f32x4 (&acc)[2][2][4][2], const pg8::Unit& u, int wr, int wc, int fr_, int fq_) const {
        const int ln_ = lane_id(), fr = ln_ & 15, fq = ln_ >> 4; (void)fr_; (void)fq_;
        const int pn = u.pn, row0 = u.pm * 256 + wr * 64 + fr, cl = wc * 32 + 8 * fq;
        if (pn == 0) {
#pragma unroll
            for (int ai = 0; ai < 2; ++ai)
#pragma unroll
                for (int m = 0; m < 4; ++m) { const int r = row0 + ai * 128 + m * 16;
#pragma unroll
                    for (int bj = 0; bj < 2; ++bj) { const int ch = bj * 128 + cl, g = ch >> 4, h0 = ch & 15;
                        const f32x4 v0 = acc[ai][bj][m][0], v1 = acc[ai][bj][m][1]; u32x4 w;
                        w.x = pg8::cvt_pk_bf16(v0[0], v0[1]); w.y = pg8::cvt_pk_bf16(v0[2], v0[3]); w.z = pg8::cvt_pk_bf16(v1[0], v1[1]); w.w = pg8::cvt_pk_bf16(v1[2], v1[3]);
                        *(u32x4*)(UG + ((size_t)(g * 512 + (r >> 6))) * UGP + (r & 63) * 16 + h0) = w; } }
        } else {
            bf16* base; int ldc, colt; float sc = 1.f;
            if (pn == 1) { base = PB; ldc = 256; colt = 0; }
            else if (pn < 4) { base = QB; ldc = 512; colt = (pn - 2) * 256; sc = C2; }
            else if (pn < 6) { base = KB; ldc = 512; colt = (pn - 4) * 256; }
            else { base = VB; ldc = 512; colt = (pn - 6) * 256; }
#pragma unroll
            for (int ai = 0; ai < 2; ++ai)
#pragma unroll
                for (int m = 0; m < 4; ++m) { bf16* rowp = base + (size_t)(row0 + ai * 128 + m * 16) * ldc + colt + cl;
#pragma unroll
                    for (int bj = 0; bj < 2; ++bj) { const f32x4 v0 = acc[ai][bj][m][0] * sc, v1 = acc[ai][bj][m][1] * sc; u32x4 w;
                        w.x = pg8::cvt_pk_bf16(v0[0], v0[1]); w.y = pg8::cvt_pk_bf16(v0[2], v0[3]); w.z = pg8::cvt_pk_bf16(v1[0], v1[1]); w.w = pg8::cvt_pk_bf16(v1[2], v1[3]);
                        *(u32x4*)(rowp + bj * 128) = w; } }
            if (pn >= 4 && pn < 6) {
#pragma unroll
                for (int bj = 0; bj < 2; ++bj)
#pragma unroll
                    for (int n = 0; n < 2; ++n) { f32x4 s = (f32x4){0.f, 0.f, 0.f, 0.f};
#pragma unroll
                        for (int ai = 0; ai < 2; ++ai)
#pragma unroll
                            for (int m = 0; m < 4; ++m) s += acc[ai][bj][m][n];
#pragma unroll
                        for (int i = 0; i < 4; ++i) { float t = s[i]; t += xshfl<1>(t); t += xshfl<2>(t); t += xshfl<4>(t); t += xshfl<8>(t); s[i] = t; }
                        if (fr == 0) *(f32x4*)(KMP + (size_t)wr * 128 * 512 + (size_t)u.pm * 512 + colt + bj * 128 + cl + 4 * n) = s; }
            }
        }
    }
};
struct EpiOutE {
    static constexpr bool PERM = false;
    const float* xin; float* R;
    __device__ __forceinline__ void operator()(const f32x4 (&acc)[2][2][4][2], const pg8::Unit& u, int wr, int wc, int fr_, int fq_) const {
        const int ln_ = lane_id(), fr = ln_ & 15, fq = ln_ >> 4; (void)fr_; (void)fq_;
        const int row0 = u.pm * 256 + wr * 64 + fr, col0 = u.pn * 256 + wc * 32 + 4 * fq;
#pragma unroll
        for (int ai = 0; ai < 2; ++ai)
#pragma unroll
            for (int m = 0; m < 4; ++m) { const size_t off = (size_t)(row0 + ai * 128 + m * 16) * D + col0;
#pragma unroll
                for (int bj = 0; bj < 2; ++bj)
#pragma unroll
                    for (int n = 0; n < 2; ++n) { const size_t o = off + bj * 128 + n * 16; *(f32x4*)(R + o) = *(const f32x4*)(xin + o) + acc[ai][bj][m][n]; }
                if (m & 1) asm volatile("" ::: "memory"); }
    }
};

__device__ __forceinline__ void transpose_item(const float* W, int K, int N, const float* kscale, bf16* WT, int ldo, int koff, int rowmode, LAS float* scr, int item, int lane) {
    const int nblk = N / 32, kb = item / nblk, nb = item % nblk, k0 = 64 * kb, n0 = 32 * nb;
#pragma unroll 8
    for (int i = 0; i < 32; ++i) { const int kk = 2 * i + (lane >> 5); const float s = kscale ? kscale[k0 + kk] : 1.f; scr[kk * 33 + (lane & 31)] = W[(size_t)(k0 + kk) * N + n0 + (lane & 31)] * s; }
    asm volatile("s_waitcnt lgkmcnt(0)" ::: "memory");
    const int c = lane & 7;
#pragma unroll
    for (int j = 0; j < 4; ++j) { const int n = (lane >> 3) + 8 * j; const LAS float* s = scr + (8 * c) * 33 + n;
        u32x4 o; o.x = pk2(s[0 * 33], s[1 * 33]); o.y = pk2(s[2 * 33], s[3 * 33]); o.z = pk2(s[4 * 33], s[5 * 33]); o.w = pk2(s[6 * 33], s[7 * 33]);
        const int nn = n0 + n, row = rowmode == 0 ? nn : (8 * (nn >> 2) + (nn & 3) + (rowmode == 2 ? 4 : 0));
        *(u32x4*)(WT + (size_t)row * ldo + koff + k0 + 8 * c) = o; }
    asm volatile("s_waitcnt lgkmcnt(0)" ::: "memory");
}
__device__ __forceinline__ void pair_decode(int pi, int& ea, int& eb) { ea = pi < 3 ? 0 : (pi < 5 ? 1 : 2); eb = pi < 3 ? pi + 1 : (pi < 5 ? pi - 1 : 3); }
__device__ __forceinline__ void ph_prologue(const Ctx& F0) {
    const Ctx F = launder(F0);
    LAS float* scr = (LAS float*)(F.lds + F.wave * 16384);
    const int gw = F.vcu * NWAVES + F.wave, NGW = F.G * NWAVES;
    constexpr int I_IN = (D / 64) * (NPROJ / 32), I_OUT = (D / 64) * (D / 32), I_GU1 = (D / 64) * (256 / 32), I_GU = 16 * 2 * I_GU1, I_WD1 = (256 / 64) * (D / 32), I_WD = 24 * 2 * I_WD1;
    constexpr int I_L = I_IN + I_OUT + I_GU + I_WD;
    for (int it = gw; it < DEPTH * I_L; it += NGW) {
        const int l = it / I_L; int r = it % I_L;
        if (r < I_IN) { transpose_item(F.in[3] + (size_t)l * D * NPROJ, D, NPROJ, F.in[2] + l * D, (bf16*)(F.ws + WS_WIN) + (size_t)l * NPROJ * D, D, 0, 0, scr, r, F.lane); continue; } r -= I_IN;
        if (r < I_OUT) { transpose_item(F.in[17] + (size_t)l * D * D, D, D, nullptr, (bf16*)(F.ws + WS_WOUT) + (size_t)l * D * D, D, 0, 0, scr, r, F.lane); continue; } r -= I_OUT;
        if (r < I_GU) { const int e = r / (2 * I_GU1), up = (r / I_GU1) & 1, item = r % I_GU1;
            transpose_item(F.in[up ? 24 : 23] + ((size_t)l * 16 + e) * D * 256, D, 256, F.in[18] + l * D, (bf16*)(F.ws + WS_GU) + ((size_t)l * 16 + e) * 512 * D, D, 0, 1 + up, scr, item, F.lane); continue; } r -= I_GU;
        { const int bk = r / (2 * I_WD1), half = (r / I_WD1) & 1, item = r % I_WD1, g = bk / 6; int ea, eb; pair_decode(bk % 6, ea, eb); const int e = g * 4 + (half ? eb : ea);
            transpose_item(F.in[25] + ((size_t)l * 16 + e) * 256 * D, 256, D, nullptr, (bf16*)(F.ws + WS_WD) + ((size_t)l * 24 + bk) * D * 512, 512, half * 256, 0, scr, item, F.lane); }
    }
#if USE_ENG_SSM
    for (int it = gw; it < DEPTH * 32; it += NGW) { const int l = it >> 5;
        transpose_item(F.in[12] + (size_t)l * 256 * 256, 256, 256, nullptr, (bf16*)(F.ws + WS_GLUT) + (size_t)l * 65536, 256, 0, 0, scr, it & 31, F.lane); }
    { const int gt = F.vcu * NTHREADS + F.tid, NGT = F.G * NTHREADS;
      for (int i = gt; i < DEPTH * 65536; i += NGT) { const int l = i >> 16, n = (i >> 8) & 255, k = i & 255;
          const float v = ((n >> 6) == (k >> 6)) ? F.in[14][(((size_t)l * 4 + (n >> 6)) * 64 + (k & 63)) * 64 + (n & 63)] : 0.f;
          ((bf16*)(F.ws + WS_POOLT))[i] = (bf16)f2bf(v); } }
    for (int it = gw; it < DEPTH * SGN * 65; it += NGW) {
        const int l = it / (SGN * 65), g = (it / 65) % SGN, tau = it % 65, p = F.lane;
        const float are = F.in[4][(l * SGN + g) * SP + p], aim = F.in[5][(l * SGN + g) * SP + p], dt = expf(F.in[6][l * SGN + g]);
        float sn, cs; sincosf(aim * dt, &sn, &cs); const float mg = expf(are * dt), lbr = mg * cs, lbi = mg * sn;
        const float nr = lbr - 1.f, ni = lbi, den = are * are + aim * aim, cr = (nr * are + ni * aim) / den, ci = (ni * are - nr * aim) / den;
        float sn2, cs2; sincosf(aim * dt * (float)tau, &sn2, &cs2); const float mg2 = expf(are * dt * (float)tau), lr = mg2 * cs2, li = mg2 * sn2;
        float wr[16], wi[16];
#pragma unroll
        for (int h = 0; h < 16; ++h) { const float br = F.in[7][((size_t)(l * SGN + g) * SP + p) * SG + h], bi = F.in[8][((size_t)(l * SGN + g) * SP + p) * SG + h];
            const float bbr = cr * br - ci * bi, bbi = cr * bi + ci * br; wr[h] = lr * bbr - li * bbi; wi[h] = lr * bbi + li * bbr; }
        bf16* TG = (bf16*)(F.ws + WS_TG) + ((size_t)l * SGN + g) * 1024 * UGP;
        if (tau <= 63) {
            bf16* BZ = (bf16*)(F.ws + WS_BZ) + ((size_t)l * SGN + g) * 256 * 1024; const int s = 63 - tau;
            u32x4 o0, o1, o2, o3;
            o0.x = pk2(wr[0], wr[1]); o0.y = pk2(wr[2], wr[3]); o0.z = pk2(wr[4], wr[5]); o0.w = pk2(wr[6], wr[7]); o1.x = pk2(wr[8], wr[9]); o1.y = pk2(wr[10], wr[11]); o1.z = pk2(wr[12], wr[13]); o1.w = pk2(wr[14], wr[15]);
            o2.x = pk2(wi[0], wi[1]); o2.y = pk2(wi[2], wi[3]); o2.z = pk2(wi[4], wi[5]); o2.w = pk2(wi[6], wi[7]); o3.x = pk2(wi[8], wi[9]); o3.y = pk2(wi[10], wi[11]); o3.z = pk2(wi[12], wi[13]); o3.w = pk2(wi[14], wi[15]);
            *(u32x4*)(BZ + (size_t)p * 1024 + s * 16) = o0; *(u32x4*)(BZ + (size_t)p * 1024 + s * 16 + 8) = o1;
            *(u32x4*)(BZ + (size_t)(64 + p) * 1024 + s * 16) = o2; *(u32x4*)(BZ + (size_t)(64 + p) * 1024 + s * 16 + 8) = o3;
        }
#pragma unroll 1
        for (int ho = 0; ho < 16; ++ho) {
            const float ccr = F.in[9][((size_t)(l * SGN + g) * SG + ho) * SP + p], cci = F.in[10][((size_t)(l * SGN + g) * SG + ho) * SP + p];
            if (tau >= 1) { const int n = (tau - 1) * 16 + ho;
                TG[(size_t)n * UGP + 1024 + p] = (bf16)f2bf(ccr * lr - cci * li); TG[(size_t)n * UGP + 1088 + p] = (bf16)f2bf(-(ccr * li + cci * lr)); }
            if (tau <= 63) {
                float kv[16];
#pragma unroll
                for (int h = 0; h < 16; ++h) kv[h] = wave_sum(ccr * wr[h] - cci * wi[h]);
                u32x4 o0, o1; o0.x = pk2(kv[0], kv[1]); o0.y = pk2(kv[2], kv[3]); o0.z = pk2(kv[4], kv[5]); o0.w = pk2(kv[6], kv[7]); o1.x = pk2(kv[8], kv[9]); o1.y = pk2(kv[10], kv[11]); o1.z = pk2(kv[12], kv[13]); o1.w = pk2(kv[14], kv[15]);
                const int to = p;
                if (to >= tau) { bf16* d = TG + (size_t)(to * 16 + ho) * UGP + (to - tau) * 16; *(u32x4*)d = o0; *(u32x4*)(d + 8) = o1; }
                if (tau >= 1 && to + tau <= 63) { bf16* d = TG + (size_t)(to * 16 + ho) * UGP + (to + tau) * 16; const u32x4 z = (u32x4){0u, 0u, 0u, 0u}; *(u32x4*)d = z; *(u32x4*)(d + 8) = z; }
            }
        }
    }
#endif
}

__device__ __forceinline__ void route_token(float (&a)[20], float ssv, int m, int lane, const float* gb_, const float* rb_, int* tokb, float* tokr, float* tokw, LAS int* hist) {
        const float ssum = wave_sum(ssv);
#pragma unroll
        for (int j = 0; j < 20; ++j) a[j] = wave_sum(a[j]);
        const float rstd = 1.f / sqrtf(ssum * (1.f / D) + RMS_EPS);
        float lg0 = a[0] * rstd + gb_[0], lg1 = a[1] * rstd + gb_[1], lg2 = a[2] * rstd + gb_[2], lg3 = a[3] * rstd + gb_[3];
        int gs = 0; float gm = lg0;
        if (lg1 > gm) { gm = lg1; gs = 1; } if (lg2 > gm) { gm = lg2; gs = 2; } if (lg3 > gm) { gm = lg3; gs = 3; }
        const float gwt = 1.f / (__expf(lg0 - gm) + __expf(lg1 - gm) + __expf(lg2 - gm) + __expf(lg3 - gm));
        float q0 = a[4], q1 = a[5], q2 = a[6], q3 = a[7], q4 = a[8], q5 = a[9], q6 = a[10], q7 = a[11], q8 = a[12], q9 = a[13], q10 = a[14], q11 = a[15], q12 = a[16], q13 = a[17], q14 = a[18], q15 = a[19];
        asm volatile("" : "+v"(q0), "+v"(q1), "+v"(q2), "+v"(q3), "+v"(q4), "+v"(q5), "+v"(q6), "+v"(q7));
        asm volatile("" : "+v"(q8), "+v"(q9), "+v"(q10), "+v"(q11), "+v"(q12), "+v"(q13), "+v"(q14), "+v"(q15));
        float e0 = gs == 0 ? q0 : gs == 1 ? q4 : gs == 2 ? q8 : q12;
        float e1 = gs == 0 ? q1 : gs == 1 ? q5 : gs == 2 ? q9 : q13;
        float e2 = gs == 0 ? q2 : gs == 1 ? q6 : gs == 2 ? q10 : q14;
        float e3 = gs == 0 ? q3 : gs == 1 ? q7 : gs == 2 ? q11 : q15;
        e0 = e0 * rstd + rb_[gs * 4 + 0]; e1 = e1 * rstd + rb_[gs * 4 + 1]; e2 = e2 * rstd + rb_[gs * 4 + 2]; e3 = e3 * rstd + rb_[gs * 4 + 3];
        int t1 = 0; float v1 = e0;
        if (e1 > v1) { v1 = e1; t1 = 1; } if (e2 > v1) { v1 = e2; t1 = 2; } if (e3 > v1) { v1 = e3; t1 = 3; }
        int t2 = -1; float v2 = -3.0e38f;
        if (t1 != 0 && e0 > v2) { v2 = e0; t2 = 0; } if (t1 != 1 && e1 > v2) { v2 = e1; t2 = 1; } if (t1 != 2 && e2 > v2) { v2 = e2; t2 = 2; } if (t1 != 3 && e3 > v2) { v2 = e3; t2 = 3; }
        const float p2 = __expf(v2 - v1), w1 = gwt / (1.f + p2), w2 = gwt * p2 / (1.f + p2);
        const int lo = t1 < t2 ? t1 : t2, hi = t1 < t2 ? t2 : t1; const float wlo = t1 < t2 ? w1 : w2, whi = t1 < t2 ? w2 : w1;
        const int pi = lo == 0 ? hi - 1 : (lo == 1 ? hi + 1 : 5), bk = gs * 6 + pi;
        if (lane == 0) { tokb[m] = bk; tokr[m] = rstd; tokw[2 * m] = wlo; tokw[2 * m + 1] = whi; __hip_atomic_fetch_add(hist + bk, 1, __ATOMIC_RELAXED, __HIP_MEMORY_SCOPE_WORKGROUP); }
}
__device__ __forceinline__ void ph_route(const Ctx& F0, int l) {
    const Ctx F = launder(F0);
    LAS float* Wl = (LAS float*)F.lds;
    LAS int* hist = (LAS int*)(F.lds + 1024 * 20 * 4);
    const float* g2 = F.in[18] + l * D;
    const f32x4* gw4 = (const f32x4*)(F.in[19] + (size_t)l * D * 4); const f32x4* rw4 = (const f32x4*)(F.in[21] + (size_t)l * 4 * D * 4);
    const float* gb_ = F.in[20] + l * 4; const float* rb_ = F.in[22] + l * 16;
    for (int idx = F.tid; idx < D * 5; idx += NTHREADS) { const int k = idx % D, q = idx / D;
        f32x4 v = (q == 0) ? gw4[k] : rw4[(q - 1) * D + k]; v = v * g2[k];
        Wl[(q * 4 + 0) * D + k] = v[0]; Wl[(q * 4 + 1) * D + k] = v[1]; Wl[(q * 4 + 2) * D + k] = v[2]; Wl[(q * 4 + 3) * D + k] = v[3]; }
    if (F.tid < 32) hist[F.tid] = 0;
    __syncthreads();
    int* tokb = (int*)(F.ws + WS_TOKB); float* tokr = (float*)(F.ws + WS_TOKR); float* tokw = (float*)(F.ws + WS_TOKW);
#pragma unroll 1
    for (int i2 = 0; i2 < 16; i2 += 2) {
        const int m0 = F.vcu * 128 + F.wave * 16 + i2;
        const f32x4* xr = (const f32x4*)(F.R + (size_t)m0 * D) + F.lane;
        float a[2][20], ss[2];
#pragma unroll
        for (int t = 0; t < 2; ++t) { ss[t] = 0.f;
#pragma unroll
            for (int j = 0; j < 20; ++j) a[t][j] = 0.f; }
#pragma unroll 1
        for (int jj = 0; jj < 4; ++jj) { const f32x4 x0 = xr[64 * jj], x1 = xr[D / 4 + 64 * jj];
            ss[0] += (x0[0] * x0[0] + x0[1] * x0[1]) + (x0[2] * x0[2] + x0[3] * x0[3]); ss[1] += (x1[0] * x1[0] + x1[1] * x1[1]) + (x1[2] * x1[2] + x1[3] * x1[3]);
#pragma unroll
            for (int j = 0; j < 20; ++j) { const f32x4 w = *(const LAS f32x4*)(Wl + j * D + 256 * jj + 4 * F.lane);
                a[0][j] += (x0[0] * w[0] + x0[1] * w[1]) + (x0[2] * w[2] + x0[3] * w[3]); a[1][j] += (x1[0] * w[0] + x1[1] * w[1]) + (x1[2] * w[2] + x1[3] * w[3]); } }
        route_token(a[0], ss[0], m0, F.lane, gb_, rb_, tokb, tokr, tokw, hist);
        route_token(a[1], ss[1], m0 + 1, F.lane, gb_, rb_, tokb, tokr, tokw, hist);
    }
    __syncthreads();
    if (F.tid < 24) __hip_atomic_store((int*)(F.ws + WS_WGCNT) + F.vcu * 24 + F.tid, hist[F.tid], __ATOMIC_RELAXED, __HIP_MEMORY_SCOPE_AGENT);
}
__device__ __forceinline__ void ph_place(const Ctx& F0) {
    const Ctx F = launder(F0);
    LAS int* ptot = (LAS int*)F.lds;
    LAS int* pbef = ptot + 512;
    LAS int* bstart = pbef + 512;
    LAS int* btot = bstart + 32;
    LAS int* carry = btot + 32;
    LAS int* rowidx = carry + 32;
    const int* wgcnt = (const int*)(F.ws + WS_WGCNT);
    int* rowtok = (int*)(F.ws + WS_ROWTOK); float* roww = (float*)(F.ws + WS_ROWW); int* tileb = (int*)(F.ws + WS_TILEB);
    const int* tokb = (const int*)(F.ws + WS_TOKB); const float* tokr = (const float*)(F.ws + WS_TOKR); const float* tokw = (const float*)(F.ws + WS_TOKW);
    { const int p = F.tid >> 5, b = F.tid & 31; int tot = 0, bef = 0;
      if (b < 24) for (int v = p * 16; v < p * 16 + 16; ++v) { const int c = wgcnt[v * 24 + b]; tot += c; if (v < F.vcu) bef += c; }
      ptot[p * 32 + b] = tot; pbef[p * 32 + b] = bef; }
    __syncthreads();
    if (F.tid < 32) { int tot = 0, bef = 0; for (int p = 0; p < 16; ++p) { tot += ptot[p * 32 + F.tid]; bef += pbef[p * 32 + F.tid]; } btot[F.tid] = tot; carry[F.tid] = bef; }
    __syncthreads();
    if (F.tid == 0) { int s = 0; for (int b = 0; b < 24; ++b) { bstart[b] = s; s += (btot[b] + 255) & ~255; } bstart[24] = s; }
    __syncthreads();
    if (F.tid < 24) carry[F.tid] += bstart[F.tid];
    if (F.vcu == 0) {
        if (F.tid == 0) tileb[0] = bstart[24] >> 8;
        for (int b = 0; b < 24; ++b) { const int s = bstart[b], e = bstart[b + 1];
            for (int t = (s >> 8) + F.tid; t < (e >> 8); t += NTHREADS) tileb[1 + t] = b;
            for (int r = s + btot[b] + F.tid; r < e; r += NTHREADS) __hip_atomic_store(rowtok + r, -1, __ATOMIC_RELAXED, __HIP_MEMORY_SCOPE_AGENT); }
    }
    __syncthreads();
    if (F.wave == 0) {
        for (int pass = 0; pass < 2; ++pass) { const int i = pass * 64 + F.lane, bi = tokb[F.vcu * 128 + i]; int row = 0;
#pragma unroll 1
            for (int b = 0; b < 24; ++b) { const unsigned long long mask = __ballot(bi == b); const int c = carry[b];
                if (bi == b) row = c + __builtin_popcountll(mask & ((1ull << F.lane) - 1ull));
                asm volatile("s_waitcnt lgkmcnt(0)" ::: "memory");
                if (F.lane == 0) carry[b] = c + __builtin_popcountll(mask);
                asm volatile("s_waitcnt lgkmcnt(0)" ::: "memory"); }
            rowidx[i] = row; }
    }
    __syncthreads();
    bf16* XS = (bf16*)(F.ws + WS_XS);
    for (int i = 0; i < 16; ++i) {
        const int li = F.wave * 16 + i, m = F.vcu * 128 + li, row = rowidx[li]; const float rstd = tokr[m];
        if (F.lane == 0) {
            __hip_atomic_store(rowtok + row, m, __ATOMIC_RELAXED, __HIP_MEMORY_SCOPE_AGENT);
            const unsigned long long w2 = (unsigned long long)__builtin_bit_cast(unsigned, tokw[2 * m]) | ((unsigned long long)__builtin_bit_cast(unsigned, tokw[2 * m + 1]) << 32);
            __hip_atomic_store((unsigned long long*)(roww + 2 * row), w2, __ATOMIC_RELAXED, __HIP_MEMORY_SCOPE_AGENT); }
        const f32x4* xr = (const f32x4*)(F.R + (size_t)m * D) + F.lane;
        unsigned long long* o8 = (unsigned long long*)(XS + (size_t)row * D) + F.lane;
#pragma unroll
        for (int j = 0; j < 4; ++j) { const f32x4 v = xr[64 * j] * rstd; o8[64 * j] = (unsigned long long)pk2(v.x, v.y) | ((unsigned long long)pk2(v.z, v.w) << 32); }
    }
}
struct MoeOrder {
    const int* tileb; int G, c; bool down;
    __device__ __forceinline__ bool next(int i, pg8::Unit& u) const {
        const GAS int* tb_ = (const GAS int*)tileb;
        const int NT = __builtin_amdgcn_readfirstlane(tb_[0]), L = i * G + c; if (L >= NT * 4) return false;
        const int rt = L >> 2, pn = L & 3, b = __builtin_amdgcn_readfirstlane(tb_[1 + rt]);
        if (down) { u.pm = rt; u.pn = b * 4 + pn; u.aux = pn; }
        else { int ea, eb; pair_decode(b % 6, ea, eb); const int e = (b / 6) * 4 + (pn < 2 ? ea : eb); u.pm = rt; u.pn = e * 2 + (pn & 1); u.aux = pn; }
        return true;
    }
};
struct EpiGU {
    static constexpr bool PERM = true;
    bf16* H; const float* roww;
    __device__ __forceinline__ void operator()(const f32x4 (&acc)[2][2][4][2], const pg8::Unit& u, int wr, int wc, int fr_, int fq_) const {
        const int ln_ = lane_id(), fr = ln_ & 15, fq = ln_ >> 4; (void)fr_; (void)fq_;
        const int row0 = u.pm * 256 + wr * 64 + fr, cl = u.aux * 128 + 16 * wc + 4 * fq, ws = u.aux >> 1;
#pragma unroll
        for (int ai = 0; ai < 2; ++ai)
#pragma unroll
            for (int m = 0; m < 4; ++m) { const int r = row0 + ai * 128 + m * 16; const float w = roww[2 * r + ws];
#pragma unroll
                for (int bj = 0; bj < 2; ++bj) { const f32x4 g = acc[ai][bj][m][0], up = acc[ai][bj][m][1]; f32x4 a;
#pragma unroll
                    for (int i = 0; i < 4; ++i) a[i] = g[i] * sigmoidf_(g[i]) * up[i] * w;
                    u32x2 o; o.x = pg8::cvt_pk_bf16(a[0], a[1]); o.y = pg8::cvt_pk_bf16(a[2], a[3]);
                    *(u32x2*)(H + (size_t)r * 512 + cl + bj * 64) = o; } }
    }
};
struct EpiDown {
    static constexpr bool PERM = false;
    float* R; const int* rowtok;
    __device__ __forceinline__ void operator()(const f32x4 (&acc)[2][2][4][2], const pg8::Unit& u, int wr, int wc, int fr_, int fq_) const {
        const int ln_ = lane_id(), fr = ln_ & 15, fq = ln_ >> 4; (void)fr_; (void)fq_;
        const int row0 = u.pm * 256 + wr * 64 + fr, col0 = u.aux * 256 + wc * 32 + 4 * fq;
#pragma unroll
        for (int ai = 0; ai < 2; ++ai)
#pragma unroll
            for (int m = 0; m < 4; ++m) { const int tok = rowtok[row0 + ai * 128 + m * 16];
                if (tok >= 0) { float* rp = R + (size_t)tok * D + col0;
#pragma unroll
                    for (int bj = 0; bj < 2; ++bj)
#pragma unroll
                        for (int n = 0; n < 2; ++n) { float* p = rp + bj * 128 + n * 16; *(f32x4*)p = *(const f32x4*)p + acc[ai][bj][m][n]; } }
                if (m & 1) asm volatile("" ::: "memory"); }
    }
};

namespace attn_body {
using abf16=__hip_bfloat16;
using bf16x8=__attribute__((ext_vector_type(8)))short;
using s16x4=__attribute__((ext_vector_type(4)))short;
using f32x16=__attribute__((ext_vector_type(16)))float;
using u32x4=__attribute__((ext_vector_type(4)))unsigned;
constexpr int BATCH=8,NHEAD=8,SEQ=4096,D=64,DM=NHEAD*D,DMO=1024,OCOL=512;
constexpr int NW=8,QBLK=32,QB=QBLK*NW,KVBLK=64,NQB=SEQ/QB;
constexpr int ATTN_PITCH=DM, ATTN_UNIT_ROWS=QB;
__device__ __forceinline__ int crow(int r,int hi){return (r&3)+8*(r>>2)+4*hi;}
#define SBAR() __builtin_amdgcn_sched_barrier(0)
__device__ __forceinline__ void nearm(f32x16&p0,f32x16&p1,int jn,int qrel,int hi,const __attribute__((address_space(3))) float*tb){
  const __attribute__((address_space(3))) float*t0=tb+(qrel-64*(jn-4)-4*hi+256);
  #pragma unroll
  for(int r=0;r<16;++r){const int k=(r&3)+8*(r>>2); p0[r]+=t0[-k]; p1[r]+=t0[-k-32];}
}

constexpr int NSLOT=3, SLOTB=8192;
constexpr int LDS_K=0, LDS_V=NSLOT*SLOTB, LDS_WS=2*NSLOT*SLOTB, LDS_OST=LDS_WS+NW*64*4, LDS_TB=LDS_OST+NW*4096, LDS_KM=LDS_TB+768*4, LDS_BYTES=LDS_KM+16*64*4;
constexpr float C2=0.125f*1.4426950408889634f;
__device__ __forceinline__ void glds16(const void*gsrc,unsigned lds_dst){unsigned keep;
  asm volatile("s_mov_b32 %0, m0\n\ts_mov_b32 m0, %2\n\ts_nop 0\n\tglobal_load_lds_dwordx4 %1, off\n\ts_mov_b32 m0, %0":"=&s"(keep):"v"(gsrc),"s"(lds_dst):"memory");}
__device__ __forceinline__ float max3f(float a,float b,float c){float r;asm("v_max3_f32 %0, %1, %2, %3":"=v"(r):"v"(a),"v"(b),"v"(c));return r;}
__device__ __forceinline__ float max2f(float a,float b){float r;asm("v_max_f32_e32 %0, %1, %2":"=v"(r):"v"(a),"v"(b));return r;}
__device__ __forceinline__ float fadd_s(float a,float b){float r;asm("v_add_f32_e32 %0, %1, %2":"=v"(r):"v"(a),"v"(b));return r;}
__device__ __forceinline__ float fsub_s(float a,float b){float r;asm("v_sub_f32_e32 %0, %1, %2":"=v"(r):"v"(a),"v"(b));return r;}
typedef float f32x2_t __attribute__((ext_vector_type(2))); typedef __bf16 bf16x2_t __attribute__((ext_vector_type(2)));
__device__ __forceinline__ unsigned cvtpk_s(float lo,float hi){f32x2_t v={lo,hi};bf16x2_t b=__builtin_convertvector(v,bf16x2_t);return __builtin_bit_cast(unsigned,b);}
#define WAIT_BAR(N) asm volatile("s_waitcnt vmcnt(0) lgkmcnt(0)\n\ts_barrier":::"memory")

__device__ __forceinline__ void qkt(f32x16&p0,f32x16&p1,const char*Kslot,const bf16x8*qr,const f32x16&negm,int r32,int hi){
  const char*kb=Kslot+hi*1024+r32*16;
  #pragma unroll
  for(int d0=0;d0<4;++d0){
    const bf16x8 b0=*reinterpret_cast<const bf16x8*>(kb+d0*2048);
    const bf16x8 b1=*reinterpret_cast<const bf16x8*>(kb+d0*2048+512);
    if(d0==0){p0=__builtin_amdgcn_mfma_f32_32x32x16_bf16(b0,qr[0],negm,0,0,0);p1=__builtin_amdgcn_mfma_f32_32x32x16_bf16(b1,qr[0],negm,0,0,0);}
    else{p0=__builtin_amdgcn_mfma_f32_32x32x16_bf16(b0,qr[d0],p0,0,0,0);p1=__builtin_amdgcn_mfma_f32_32x32x16_bf16(b1,qr[d0],p1,0,0,0);}}
}
typedef __attribute__((address_space(3))) const char* lds_cptr;
typedef short v4i16_t __attribute__((ext_vector_type(4)));
__device__ __forceinline__ void kload8(bf16x8*kf,lds_cptr kp){
  kf[0]=*(const __attribute__((address_space(3))) bf16x8*)(kp);      kf[1]=*(const __attribute__((address_space(3))) bf16x8*)(kp+512);
  kf[2]=*(const __attribute__((address_space(3))) bf16x8*)(kp+2048); kf[3]=*(const __attribute__((address_space(3))) bf16x8*)(kp+2560);
  kf[4]=*(const __attribute__((address_space(3))) bf16x8*)(kp+4096); kf[5]=*(const __attribute__((address_space(3))) bf16x8*)(kp+4608);
  kf[6]=*(const __attribute__((address_space(3))) bf16x8*)(kp+6144); kf[7]=*(const __attribute__((address_space(3))) bf16x8*)(kp+6656);
}
__device__ __forceinline__ void kload2(bf16x8*kf,lds_cptr kp,int j){ kf[2*j]=*(const __attribute__((address_space(3))) bf16x8*)(kp+j*2048); kf[2*j+1]=*(const __attribute__((address_space(3))) bf16x8*)(kp+j*2048+512); }
__device__ __forceinline__ s16x4 vtr(lds_cptr p){ return __builtin_bit_cast(s16x4,__builtin_amdgcn_ds_read_tr16_b64_v4i16((__attribute__((address_space(3))) v4i16_t*)p)); }
__device__ __forceinline__ float rowmax(const f32x16&p0,const f32x16&p1){
  float a=max3f(p0[0],p0[1],p1[0]),b=max3f(p0[2],p0[3],p1[1]);a=max3f(a,p1[2],p1[3]);
  #pragma unroll
  for(int r=4;r<16;r+=4){a=max3f(a,p0[r],p0[r+1]);b=max3f(b,p0[r+2],p0[r+3]);a=max3f(a,p1[r],p1[r+1]);b=max3f(b,p1[r+2],p1[r+3]);}
  const float m=max2f(a,b);
  auto rr=__builtin_amdgcn_permlane32_swap(__float_as_uint(m),__float_as_uint(m),false,false);
  return max2f(__uint_as_float(rr[0]),__uint_as_float(rr[1]));
}
__device__ __forceinline__ void pv(f32x16*o,int vb,bf16x8 pa0,bf16x8 pa1,bf16x8 pa2,bf16x8 pa3){
  #pragma unroll
  for(int d0=0;d0<2;++d0){s16x4 lo[4],hi[4];
    #pragma unroll
    for(int ks=0;ks<4;++ks){
      asm volatile("ds_read_b64_tr_b16 %0,%1 offset:%c2":"=&v"(lo[ks]):"v"(vb),"i"(d0*4096+ks*1024):"memory");
      asm volatile("ds_read_b64_tr_b16 %0,%1 offset:%c2":"=&v"(hi[ks]):"v"(vb),"i"(d0*4096+ks*1024+512):"memory");}
    asm volatile("s_waitcnt lgkmcnt(0)":::"memory");SBAR();
    #define PK(k) (bf16x8){lo[k][0],lo[k][1],lo[k][2],lo[k][3],hi[k][0],hi[k][1],hi[k][2],hi[k][3]}
    o[d0]=__builtin_amdgcn_mfma_f32_32x32x16_bf16(pa0,PK(0),o[d0],0,0,0);
    o[d0]=__builtin_amdgcn_mfma_f32_32x32x16_bf16(pa1,PK(1),o[d0],0,0,0);
    o[d0]=__builtin_amdgcn_mfma_f32_32x32x16_bf16(pa2,PK(2),o[d0],0,0,0);
    o[d0]=__builtin_amdgcn_mfma_f32_32x32x16_bf16(pa3,PK(3),o[d0],0,0,0);
    #undef PK
  }
}

#ifndef ATTN_STORE16
#define ATTN_STORE16(p,v) (*(u32x4*)(p)=(v))
#endif
template<int THRL> __device__ __forceinline__ void attn_unit(int wave_,int b,int h,int qb,const abf16*Q,const abf16*__restrict__ K,const abf16*__restrict__ V,abf16*O,const float*KMP,const float*BT,char*shm){
  int lane_=lane_id(); asm volatile("":"+v"(lane_)); asm volatile("":"+s"(b),"+s"(h),"+s"(qb),"+s"(wave_));
  const int wid=wave_,lane=lane_,tid=wid*64+lane,r32=lane&31,hi=lane>>5;
  const long rowbase=(long)b*SEQ; const int q0=qb*QB;
  const abf16*Qw=Q+(rowbase+q0+wid*QBLK)*DM+h*D;
  const abf16*Kh=K+rowbase*DM+h*D,*Vh=V+rowbase*DM+h*D;
  const unsigned lds0=(unsigned)(uintptr_t)shm;
  float*wsf=(float*)(shm+LDS_WS)+wid*64;
  const abf16*ksrc=Kh+(long)lane*DM+wid*8;
  const abf16*vsrc=Vh+(long)(16*(wid&3)+(lane>>2))*DM+(wid>>2)*32+(lane&3)*8;
  const unsigned kdst=lds0+LDS_K+wid*1024, vdst=lds0+LDS_V+wid*1024;
  #define DMA_K(t,slot) glds16(ksrc+(long)(t)*KVBLK*DM,(unsigned)__builtin_amdgcn_readfirstlane(kdst+(slot)))
  #define DMA_V(t,slot) glds16(vsrc+(long)(t)*KVBLK*DM,(unsigned)__builtin_amdgcn_readfirstlane(vdst+(slot)))
  const int vb0=(int)(lds0+LDS_V)+((lane>>4)&1)*32+(lane&3)*8+(4*hi+((lane&15)>>2))*64;
  const char*Kbase=shm+LDS_K; bf16x8 kf[8];
  const lds_cptr shm3=(lds_cptr)shm; const lds_cptr kp0=shm3+LDS_K+hi*1024+r32*16; const lds_cptr vp0=shm3+LDS_V+((lane>>4)&1)*32+(lane&3)*8+(4*hi+((lane&15)>>2))*64;
  const int NT=(q0+QB)/KVBLK;
  typedef __attribute__((address_space(3))) float lfloat;
  lfloat*tb=(lfloat*)((__attribute__((address_space(3))) char*)shm+LDS_TB); lfloat*km=(lfloat*)((__attribute__((address_space(3))) char*)shm+LDS_KM);
  const float bfar=BT[h*132+128];
  for(int i=tid;i<768;i+=NW*64){const int rel=i-256; tb[i]=rel<0?-1.0e30f:(rel<128?BT[h*132+rel]-bfar:0.f);}
  for(int i=tid;i<16*64;i+=NW*64){const int j=i>>6,d=i&63; const int pm=b*16+j; km[i]=KMP[pm*512+h*64+d]+KMP[128*512+pm*512+h*64+d];}
  asm volatile("s_waitcnt vmcnt(0) lgkmcnt(0)\n\ts_barrier":::"memory");
  DMA_K(0,0);DMA_V(0,0);DMA_K(1,SLOTB);
  bf16x8 qr[4];
  #pragma unroll
  for(int d0=0;d0<4;++d0)qr[d0]=*reinterpret_cast<const bf16x8*>(&Qw[(long)r32*DM+d0*16+hi*8]);
  unsigned selmask=1u<<qb;
  { float g[16];
    #pragma unroll
    for(int j=0;j<16;++j)g[j]=0.f;
    #pragma unroll
    for(int d0=0;d0<4;++d0){
      #pragma unroll
      for(int e=0;e<8;++e){ const float qf=__builtin_bit_cast(float,((unsigned)(unsigned short)qr[d0][e])<<16);
        #pragma unroll
        for(int j=0;j<16;++j)g[j]+=qf*km[j*64+d0*16+hi*8+e]; } }
    #pragma unroll
    for(int j=0;j<16;++j){ const unsigned u_=__builtin_bit_cast(unsigned,g[j]); auto rr=__builtin_amdgcn_permlane32_swap(u_,u_,false,false); g[j]=__builtin_bit_cast(float,(unsigned)rr[0])+__builtin_bit_cast(float,(unsigned)rr[1]); }
    #pragma unroll
    for(int s=0;s<3;++s){ float bv=-3.0e38f; int bi=-1;
      #pragma unroll
      for(int j=0;j<16;++j){ const bool ok=(j<qb)&&!((selmask>>j)&1u)&&(g[j]>bv); bv=ok?g[j]:bv; bi=ok?j:bi; }
      if(bi>=0)selmask|=1u<<bi; } }
  float mhat=0.f;
  #define NV(tn) (((selmask>>((tn)>>2))&1u)?(bfar-mhat):-1.0e30f)
  float l_reg=0.f;f32x16 o[2];o[0]=f32x16{};o[1]=f32x16{};f32x16 negm;
  { const float x_=NV(0);
    #pragma unroll
    for(int r=0;r<16;++r)negm[r]=x_; } asm volatile("":"+v"(negm));
  const int qrel=wid*QBLK+r32;
  #define CMASK(P0,P1,t) do{int jn_=(t)-(NT-8); if(jn_>=0)nearm(P0,P1,jn_,qrel,hi,tb);}while(0)
  bool resc=false;
  #define START(P0,P1) do{ const float rm=rowmax(P0,P1); resc=false; \
    { const float dl=(rm<-1.0e29f)?0.f:rm; mhat=fadd_s(mhat,dl); \
      _Pragma("unroll") for(int r=0;r<16;++r){P0[r]=fsub_s(P0[r],dl);P1[r]=fsub_s(P1[r],dl);} \
      { const float x_=NV(1); _Pragma("unroll") for(int r=0;r<16;++r)negm[r]=x_; } asm volatile("":"+v"(negm)); } \
    _Pragma("unroll") for(int r=0;r<16;++r)P0[r]=__builtin_amdgcn_exp2f(P0[r]); }while(0)
  #define RESC() do{ if(resc){ asm volatile("s_waitcnt lgkmcnt(0)":::"memory"); \
      _Pragma("unroll") for(int d_=0;d_<2;++d_) _Pragma("unroll") for(int r=0;r<16;++r)o[d_][r]*=wsf[crow(r,hi)]; } }while(0)
  f32x16 pA0,pA1,pB0,pB1;
  int sl_prev=0,sl_cur=0,sl_next=SLOTB;
  #define ROT() do{sl_prev=sl_cur;sl_cur=sl_next;sl_next=(sl_next==(NSLOT-1)*SLOTB)?0:sl_next+SLOTB;}while(0)
  DMA_K(2,2*SLOTB);
  WAIT_BAR(3);
  qkt(pA0,pA1,Kbase,qr,negm,r32,hi);asm volatile("s_nop 15\n\ts_nop 7":"+v"(pA0),"+v"(pA1));CMASK(pA0,pA1,0);
  START(pA0,pA1);
  _Pragma("unroll") for(int r=0;r<16;++r)pA1[r]=__builtin_amdgcn_exp2f(pA1[r]);
  WAIT_BAR(0);
  DMA_K(3,0);DMA_V(1,SLOTB);
  ROT();
  kload8(kf,kp0+sl_cur);
  WAIT_BAR(2);
  s16x4 vlo[8],vhi[8]; u32x4 pw0,pw1,pw2,pw3;
  #define PKW(P,B) cvtpk_s(P[B],P[B+1])
  #define PAF(k) __builtin_bit_cast(bf16x8,pw##k)
  #define VFR(i) (bf16x8){vlo[i][0],vlo[i][1],vlo[i][2],vlo[i][3],vhi[i][0],vhi[i][1],vhi[i][2],vhi[i][3]}
  #define PIN(x) asm volatile("":"+v"(x))
  #define MX3(a,b,c) __builtin_fmaxf(__builtin_fmaxf((a),(b)),(c))
  #define GAPA(MF,A0,A1,A2,A3,W0,W1,PW) do{ MF; sacc+=A0; sacc+=A1; sacc+=A2; sacc+=A3; PIN(sacc); W0; W1; PIN(PW); SBAR(); }while(0)
  #define EX(v) __builtin_amdgcn_exp2f(v)
  #define GAPB(MF,X,B) do{ MF; X[B]=EX(X[B]); X[B+1]=EX(X[B+1]); X[B+2]=EX(X[B+2]); X[B+3]=EX(X[B+3]); PIN(X); SBAR(); }while(0)
  #define VRD(i) do{ vlo[i]=vtr(vp_+(((i)>>2)*4096+((i)&3)*1024)); vhi[i]=vtr(vp_+(((i)>>2)*4096+((i)&3)*1024+512)); }while(0)
  #define KRD(G,j) do{ if(G){ kload2(kf,kp0+sl_next,j); SBAR(); } }while(0)
  #define STEP(C0,C1,P0,P1,t,GK,GV,GL) do{ SBAR(); \
    const lds_cptr vp_=vp0+sl_prev; \
    VRD(0); SBAR(); float sacc=(P0[0]+P0[1]); \
    GAPA(C0=__builtin_amdgcn_mfma_f32_32x32x16_bf16(kf[0],qr[0],negm,0,0,0), P0[2],P0[3],P0[4],P0[5],     pw0[0]=PKW(P0,0), pw0[1]=PKW(P0,2), pw0); \
    VRD(4); SBAR(); GAPA(C1=__builtin_amdgcn_mfma_f32_32x32x16_bf16(kf[1],qr[0],negm,0,0,0), P0[6],P0[7],P0[8],P0[9],     pw0[2]=PKW(P0,4), pw0[3]=PKW(P0,6), pw0); \
    VRD(1); SBAR(); GAPA(C0=__builtin_amdgcn_mfma_f32_32x32x16_bf16(kf[2],qr[1],C0,0,0,0),   P0[10],P0[11],P0[12],P0[13], pw1[0]=PKW(P0,8), pw1[1]=PKW(P0,10), pw1); \
    VRD(5); SBAR(); GAPA(C1=__builtin_amdgcn_mfma_f32_32x32x16_bf16(kf[3],qr[1],C1,0,0,0),   P0[14],P0[15],P1[0],P1[1],   pw1[2]=PKW(P0,12),pw1[3]=PKW(P0,14), pw1); \
    VRD(2); SBAR(); GAPA(C0=__builtin_amdgcn_mfma_f32_32x32x16_bf16(kf[4],qr[2],C0,0,0,0),   P1[2],P1[3],P1[4],P1[5],     pw2[0]=PKW(P1,0), pw2[1]=PKW(P1,2), pw2); \
    VRD(6); SBAR(); GAPA(C1=__builtin_amdgcn_mfma_f32_32x32x16_bf16(kf[5],qr[2],C1,0,0,0),   P1[6],P1[7],P1[8],P1[9],     pw2[2]=PKW(P1,4), pw2[3]=PKW(P1,6), pw2); \
    VRD(3); SBAR(); GAPA(C0=__builtin_amdgcn_mfma_f32_32x32x16_bf16(kf[6],qr[3],C0,0,0,0),   P1[10],P1[11],P1[12],P1[13], pw3[0]=PKW(P1,8), pw3[1]=PKW(P1,10), pw3); \
    VRD(7); SBAR(); GAPA(C1=__builtin_amdgcn_mfma_f32_32x32x16_bf16(kf[7],qr[3],C1,0,0,0),   P1[14],P1[15],0.f,0.f,       pw3[2]=PKW(P1,12),pw3[3]=PKW(P1,14), pw3); \
    l_reg+=sacc; \
    if(GK){DMA_K((t)+3,sl_cur);} if(GV){DMA_V((t)+1,sl_next);} \
    CMASK(C0,C1,t); \
    { float a=MX3(C0[0],C0[1],C1[0]),b=MX3(C0[2],C0[3],C1[1]); a=MX3(a,C1[2],C1[3]); \
      _Pragma("unroll") for(int r=4;r<16;r+=4){a=MX3(a,C0[r],C0[r+1]);b=MX3(b,C0[r+2],C0[r+3]);a=MX3(a,C1[r],C1[r+1]);b=MX3(b,C1[r+2],C1[r+3]);} \
      float rm=__builtin_fmaxf(a,b); { auto rr=__builtin_amdgcn_permlane32_swap(__float_as_uint(rm),__float_as_uint(rm),false,false); rm=__builtin_fmaxf(__uint_as_float(rr[0]),__uint_as_float(rr[1])); } \
      resc=false; \
      if(__builtin_expect(__any(rm>(float)THRL),0)){ const float dl=__builtin_fmaxf(rm,0.f); mhat+=dl; \
        _Pragma("unroll") for(int r=0;r<16;++r){C0[r]-=dl;C1[r]-=dl;} \
        { const float x_=NV((t)+1); _Pragma("unroll") for(int r=0;r<16;++r)negm[r]=x_; } asm volatile("":"+v"(negm)); \
        const float f=__builtin_amdgcn_exp2f(-dl); l_reg*=f; if(hi==0)wsf[r32]=f; resc=true; } } \
    SBAR(); \
    GAPB(o[0]=__builtin_amdgcn_mfma_f32_32x32x16_bf16(PAF(0),VFR(0),o[0],0,0,0), C0,0); \
    GAPB(o[1]=__builtin_amdgcn_mfma_f32_32x32x16_bf16(PAF(0),VFR(4),o[1],0,0,0), C0,4); \
    KRD(GL,0); GAPB(o[0]=__builtin_amdgcn_mfma_f32_32x32x16_bf16(PAF(1),VFR(1),o[0],0,0,0), C0,8); \
    KRD(GL,1); GAPB(o[1]=__builtin_amdgcn_mfma_f32_32x32x16_bf16(PAF(1),VFR(5),o[1],0,0,0), C0,12); \
    KRD(GL,2); GAPB(o[0]=__builtin_amdgcn_mfma_f32_32x32x16_bf16(PAF(2),VFR(2),o[0],0,0,0), C1,0); \
    KRD(GL,3); GAPB(o[1]=__builtin_amdgcn_mfma_f32_32x32x16_bf16(PAF(2),VFR(6),o[1],0,0,0), C1,4); \
    GAPB(o[0]=__builtin_amdgcn_mfma_f32_32x32x16_bf16(PAF(3),VFR(3),o[0],0,0,0), C1,8); \
    GAPB(o[1]=__builtin_amdgcn_mfma_f32_32x32x16_bf16(PAF(3),VFR(7),o[1],0,0,0), C1,12); \
    }while(0)
  int t=1;
  #undef CMASK
  #define CMASK(P0,P1,t) do{}while(0)
  #define BLKUPD(tn) do{ if((((tn)&3)==0)){ const float x_=NV(tn); _Pragma("unroll") for(int r=0;r<16;++r)negm[r]=x_; asm volatile("":"+v"(negm)); } }while(0)
  for(;t+9<NT;t+=2){
    STEP(pB0,pB1,pA0,pA1,t,true,true,true);     WAIT_BAR(2); RESC(); ROT(); BLKUPD(t+1);
    STEP(pA0,pA1,pB0,pB1,t+1,true,true,true);   WAIT_BAR(2); RESC(); ROT(); BLKUPD(t+2);
  }
  #undef CMASK
  #define CMASK(P0,P1,t) do{int jn_=(t)-(NT-8); if(jn_>=0)nearm(P0,P1,jn_,qrel,hi,tb);}while(0)
  #define ENDW(tt) do{ if((tt)+3<NT){WAIT_BAR(2);} else if((tt)+2<NT){WAIT_BAR(1);} else {WAIT_BAR(0);} }while(0)
  for(;t+1<NT;t+=2){
    STEP(pB0,pB1,pA0,pA1,t,(t+3<NT),(t+1<NT),(t+1<NT));       ENDW(t);   RESC(); ROT(); BLKUPD(t+1);
    STEP(pA0,pA1,pB0,pB1,t+1,(t+4<NT),(t+2<NT),(t+2<NT));     ENDW(t+1); RESC(); ROT(); BLKUPD(t+2);
  }
  STEP(pB0,pB1,pA0,pA1,NT-1,false,false,false); RESC();
  { float sacc=pB0[0]+pB0[1]; _Pragma("unroll") for(int r=2;r<16;++r)sacc+=pB0[r]; _Pragma("unroll") for(int r=0;r<16;++r)sacc+=pB1[r]; l_reg+=sacc;
    pw0=(u32x4){PKW(pB0,0),PKW(pB0,2),PKW(pB0,4),PKW(pB0,6)};pw1=(u32x4){PKW(pB0,8),PKW(pB0,10),PKW(pB0,12),PKW(pB0,14)};pw2=(u32x4){PKW(pB1,0),PKW(pB1,2),PKW(pB1,4),PKW(pB1,6)};pw3=(u32x4){PKW(pB1,8),PKW(pB1,10),PKW(pB1,12),PKW(pB1,14)};
    SBAR(); pv(o,vb0+sl_cur,PAF(0),PAF(1),PAF(2),PAF(3)); }
  #undef PKW
  #undef PAF
  #undef VFR
  #undef PIN
  #undef MX3
  #undef GAPA
  #undef GAPB
  #undef EX
  #undef VRD
  #undef KRD
  #undef STEP
  #undef ENDW
  {auto rr=__builtin_amdgcn_permlane32_swap(__float_as_uint(l_reg),__float_as_uint(l_reg),false,false);l_reg=__uint_as_float(rr[0])+__uint_as_float(rr[1]);}
  if(hi==0)wsf[32+r32]=l_reg;asm volatile("s_waitcnt lgkmcnt(0)":::"memory");
  float rli[16];
  #pragma unroll
  for(int r=0;r<16;++r)rli[r]=__builtin_amdgcn_rcpf(wsf[32+crow(r,hi)]);
  abf16*Ow=O+(rowbase+q0+wid*QBLK)*DMO+OCOL+h*D;
  { abf16*stg=(abf16*)(shm+LDS_OST)+wid*2048;
    #pragma unroll
    for(int r=0;r<16;++r){const int orow=crow(r,hi);
      #pragma unroll
      for(int d0=0;d0<2;++d0)stg[orow*64+d0*32+r32]=__float2bfloat16(o[d0][r]*rli[r]);}
    asm volatile("s_waitcnt lgkmcnt(0)":::"memory");
    #pragma unroll
    for(int i=0;i<4;++i){const int row=i*8+(lane>>3),ch=lane&7; const u32x4 v=*(const u32x4*)(stg+row*64+ch*8); ATTN_STORE16(Ow+(long)row*DMO+ch*8,v);} }
  asm volatile("s_waitcnt lgkmcnt(0)\n\ts_barrier":::"memory");
  #undef DMA_K
  #undef DMA_V
  #undef CMASK
  #undef START
  #undef RESC
  #undef ROT
  #undef NV
  #undef BLKUPD
}
constexpr int ATTN_LDS_BYTES=LDS_BYTES;
struct AttnTensors { const abf16* Q; const abf16* K; const abf16* V; abf16* O; const float* KMP; const float* BT; };
struct AttnUnit { int bh; int qb; };
struct StaticOrder {
  int vcu;
  __device__ __forceinline__ explicit StaticOrder(int vcu_):vcu(vcu_){}
  __device__ __forceinline__ bool next(int i,AttnUnit&u)const{ if(i>=4||vcu>=256)return false; const int s=vcu&3; u.bh=vcu>>2; u.qb=(i==0)?s:(i==1)?7-s:(i==2)?8+s:15-s; return true; }
};
template<class Sched,int THRL=8> __device__ __forceinline__ void attn_phase(int wave_,char*lds,const AttnTensors&T,const Sched&S){
  AttnUnit u;
  for(int i=0;S.next(i,u);++i){ attn_unit<THRL>(wave_,u.bh/NHEAD,u.bh%NHEAD,u.qb,T.Q,T.K,T.V,T.O,T.KMP,T.BT,lds); }
}
#undef SBAR
#undef WAIT_BAR
}


struct SsmOrder { int G, c, mode;
    __device__ __forceinline__ bool next(int i, pg8::Unit& u) const { const int L = i * G + c;
        if (mode == 1) { if (L >= 32) return false; u.pm = L; u.pn = L >> 1; u.aux = 0; return true; }
        if (L >= 128) return false; const int g = L >> 3; u.pm = g * 2 + ((L >> 2) & 1); u.pn = g * 4 + (L & 3); u.aux = L & 3; return true; } };
struct HalfOrder { int L;
    __device__ __forceinline__ bool next(int i, pg8::Unit& u) const { if (i > 0 || L < 0 || L >= 128) return false; u.pm = L; u.pn = 0; u.aux = 0; return true; } };
struct EpiZ { static constexpr bool PERM = false; float* ZB;
    __device__ __forceinline__ void operator()(const f32x4 (&acc)[2][2][4][2], const pg8::Unit& u, int wr, int wc, int fr_, int fq_) const {
        const int ln_ = lane_id(), fr = ln_ & 15, fq = ln_ >> 4; (void)fr_; (void)fq_;
        const int row0 = u.pm * 256 + wr * 64 + fr, col0 = wc * 32 + 4 * fq;
#pragma unroll
        for (int ai = 0; ai < 2; ++ai)
#pragma unroll
            for (int m = 0; m < 4; ++m)
#pragma unroll
                for (int n = 0; n < 2; ++n) *(f32x4*)(ZB + (size_t)(row0 + ai * 128 + m * 16) * 128 + col0 + n * 16) = acc[ai][0][m][n];
    } };
struct EpiSsm2 { static constexpr bool PERM = true; const bf16* UG; bf16* YS; const float* dvec;
    __device__ __forceinline__ void operator()(const f32x4 (&acc)[2][2][4][2], const pg8::Unit& u, int wr, int wc, int fr_, int fq_) const {
        const int ln_ = lane_id(), fr = ln_ & 15, fq = ln_ >> 4; (void)fr_; (void)fq_;
        const int g = u.pm >> 1, cr0 = (u.pm & 1) * 256 + wr * 64 + fr;
#pragma unroll
        for (int bj = 0; bj < 2; ++bj) { const int n0 = u.aux * 256 + bj * 128 + wc * 32 + 8 * fq, to = n0 >> 4, ho0 = n0 & 15;
            const f32x4 d0 = *(const f32x4*)(dvec + g * 16 + ho0), d1 = *(const f32x4*)(dvec + g * 16 + ho0 + 4);
#pragma unroll
            for (int ai = 0; ai < 2; ++ai)
#pragma unroll
                for (int m = 0; m < 4; ++m) { const int cr = cr0 + ai * 128 + m * 16;
                    const u32x4 uu = *(const u32x4*)(UG + ((size_t)(g * 512 + cr)) * UGP + n0);
                    const f32x4 a0 = acc[ai][bj][m][0], a1 = acc[ai][bj][m][1]; float y[8];
                    y[0] = gelu_tanh(a0[0] + d0[0] * bf2f(uu.x & 0xffffu)); y[1] = gelu_tanh(a0[1] + d0[1] * bf2f(uu.x >> 16));
                    y[2] = gelu_tanh(a0[2] + d0[2] * bf2f(uu.y & 0xffffu)); y[3] = gelu_tanh(a0[3] + d0[3] * bf2f(uu.y >> 16));
                    y[4] = gelu_tanh(a1[0] + d1[0] * bf2f(uu.z & 0xffffu)); y[5] = gelu_tanh(a1[1] + d1[1] * bf2f(uu.z >> 16));
                    y[6] = gelu_tanh(a1[2] + d1[2] * bf2f(uu.w & 0xffffu)); y[7] = gelu_tanh(a1[3] + d1[3] * bf2f(uu.w >> 16));
                    u32x4 w; w.x = pg8::cvt_pk_bf16(y[0], y[1]); w.y = pg8::cvt_pk_bf16(y[2], y[3]); w.z = pg8::cvt_pk_bf16(y[4], y[5]); w.w = pg8::cvt_pk_bf16(y[6], y[7]);
                    *(u32x4*)(YS + ((size_t)cr * 64 + to) * 256 + g * 16 + ho0) = w; } }
    } };
struct EpiGluE { static constexpr bool PERM = true; const bf16* YS; bf16* YMIX; const float* gb;
    __device__ __forceinline__ void operator()(const f32x4 (&acc)[2][2][4][2], const pg8::Unit& u, int wr, int wc, int fr_, int fq_) const {
        const int ln_ = lane_id(), fr = ln_ & 15, fq = ln_ >> 4; (void)fr_; (void)fq_;
        const int row0 = u.pm * 256 + wr * 64 + fr;
#pragma unroll
        for (int bj = 0; bj < 2; ++bj) { const int n0 = bj * 128 + wc * 32 + 8 * fq; const f32x4 b0 = *(const f32x4*)(gb + n0), b1 = *(const f32x4*)(gb + n0 + 4);
#pragma unroll
            for (int ai = 0; ai < 2; ++ai)
#pragma unroll
                for (int m = 0; m < 4; ++m) { const size_t r = (size_t)(row0 + ai * 128 + m * 16); const u32x4 yy = *(const u32x4*)(YS + r * 256 + n0);
                    const f32x4 a0 = acc[ai][bj][m][0] + b0, a1 = acc[ai][bj][m][1] + b1; float o[8];
                    o[0] = bf2f(yy.x & 0xffffu) * sigmoidf_(a0[0]); o[1] = bf2f(yy.x >> 16) * sigmoidf_(a0[1]); o[2] = bf2f(yy.y & 0xffffu) * sigmoidf_(a0[2]); o[3] = bf2f(yy.y >> 16) * sigmoidf_(a0[3]);
                    o[4] = bf2f(yy.z & 0xffffu) * sigmoidf_(a1[0]); o[5] = bf2f(yy.z >> 16) * sigmoidf_(a1[1]); o[6] = bf2f(yy.w & 0xffffu) * sigmoidf_(a1[2]); o[7] = bf2f(yy.w >> 16) * sigmoidf_(a1[3]);
                    u32x4 w; w.x = pg8::cvt_pk_bf16(o[0], o[1]); w.y = pg8::cvt_pk_bf16(o[2], o[3]); w.z = pg8::cvt_pk_bf16(o[4], o[5]); w.w = pg8::cvt_pk_bf16(o[6], o[7]);
                    *(u32x4*)(YMIX + r * 1024 + n0) = w; } }
    } };
struct EpiPoolE { static constexpr bool PERM = true; bf16* YMIX; const float* pb; const float* ps;
    __device__ __forceinline__ void operator()(const f32x4 (&acc)[2][2][4][2], const pg8::Unit& u, int wr, int wc, int fr_, int fq_) const {
        const int ln_ = lane_id(), fr = ln_ & 15, fq = ln_ >> 4; (void)fr_; (void)fq_;
        const int row0 = u.pm * 256 + wr * 64 + fr;
#pragma unroll
        for (int bj = 0; bj < 2; ++bj) { const int n0 = bj * 128 + wc * 32 + 8 * fq; const f32x4 b0 = *(const f32x4*)(pb + n0), b1 = *(const f32x4*)(pb + n0 + 4), s0 = *(const f32x4*)(ps + n0), s1 = *(const f32x4*)(ps + n0 + 4);
#pragma unroll
            for (int ai = 0; ai < 2; ++ai)
#pragma unroll
                for (int m = 0; m < 4; ++m) { const size_t r = (size_t)(row0 + ai * 128 + m * 16);
                    const f32x4 a0 = (acc[ai][bj][m][0] + b0) * s0, a1 = (acc[ai][bj][m][1] + b1) * s1;
                    u32x4 w; w.x = pg8::cvt_pk_bf16(a0[0], a0[1]); w.y = pg8::cvt_pk_bf16(a0[2], a0[3]); w.z = pg8::cvt_pk_bf16(a1[0], a1[1]); w.w = pg8::cvt_pk_bf16(a1[2], a1[3]);
                    *(u32x4*)(YMIX + r * 1024 + 256 + n0) = w; } }
    } };
__device__ __forceinline__ void ph_ssm_scan(const Ctx& F0, int l) {
    const Ctx F = launder(F0);
    for (int it = F.vcu + F.G * F.wave; it < SGN * NB; it += F.G * NWAVES) {
        const int g = it >> 3, b = it & 7, p = F.lane;
        const float are = F.in[4][(l * SGN + g) * SP + p], aim = F.in[5][(l * SGN + g) * SP + p], dt = expf(F.in[6][l * SGN + g]);
        float sn, cs; sincosf(aim * dt * 64.f, &sn, &cs); const float mg = expf(are * dt * 64.f), lr = mg * cs, li = mg * sn;
        const float* Z = (const float*)(F.ws + WS_ZB) + ((size_t)g * 512 + b * 64) * 128;
        bf16* U = P_UG(F) + ((size_t)g * 512 + b * 64) * UGP + 1024;
        float sr = 0.f, si = 0.f;
#pragma unroll 1
        for (int c0 = 0; c0 < 64; c0 += 16) {
            float zr[16], zi[16];
#pragma unroll
            for (int j = 0; j < 16; ++j) { zr[j] = Z[(c0 + j) * 128 + p]; zi[j] = Z[(c0 + j) * 128 + 64 + p]; }
#pragma unroll
            for (int j = 0; j < 16; ++j) {
                U[(size_t)(c0 + j) * UGP + p] = (bf16)f2bf(sr); U[(size_t)(c0 + j) * UGP + 64 + p] = (bf16)f2bf(si);
                const float nr = lr * sr - li * si + zr[j], ni = lr * si + li * sr + zi[j]; sr = nr; si = ni; }
        }
    }
}

namespace moba {
using bf16x8 = __attribute__((ext_vector_type(8))) short;
using s16x4 = __attribute__((ext_vector_type(4))) short;
using f32x16 = __attribute__((ext_vector_type(16))) float;
typedef short v4i16_t __attribute__((ext_vector_type(4)));
typedef float f32x2_t __attribute__((ext_vector_type(2))); typedef __bf16 bf16x2_t __attribute__((ext_vector_type(2)));
constexpr int L_K = 0, L_V = 16384, L_TB = 32768, L_KM = L_TB + 768 * 4, L_END = L_KM + 16 * 64 * 4;
__device__ __forceinline__ unsigned cvtpk(float lo, float hi) { f32x2_t v = {lo, hi}; bf16x2_t b = __builtin_convertvector(v, bf16x2_t); return __builtin_bit_cast(unsigned, b); }
__device__ __forceinline__ s16x4 vtr(const LAS char* p) { return __builtin_bit_cast(s16x4, __builtin_amdgcn_ds_read_tr16_b64_v4i16((LAS v4i16_t*)p)); }
__device__ __forceinline__ float hmax(float v) { const unsigned u = __builtin_bit_cast(unsigned, v); auto r = __builtin_amdgcn_permlane32_swap(u, u, false, false); return fmaxf(__builtin_bit_cast(float, (unsigned)r[0]), __builtin_bit_cast(float, (unsigned)r[1])); }
__device__ __forceinline__ float hsum(float v) { const unsigned u = __builtin_bit_cast(unsigned, v); auto r = __builtin_amdgcn_permlane32_swap(u, u, false, false); return __builtin_bit_cast(float, (unsigned)r[0]) + __builtin_bit_cast(float, (unsigned)r[1]); }

__device__ __forceinline__ void unit(int wave_, int b, int h, int qb, const bf16* Q, const bf16* K, const bf16* V, bf16* O, const float* KMP, const float* BT, LAS char* lds) {
    int lane_ = lane_id(); asm volatile("" : "+v"(lane_)); asm volatile("" : "+s"(b), "+s"(h), "+s"(qb), "+s"(wave_));
    const int wid = wave_, lane = lane_, tid = wid * 64 + lane, r32 = lane & 31, hi = lane >> 5;
    const int NT = 4 * qb + 4, q0 = qb * 256; const size_t rowbase = (size_t)b * SEQ;
    LAS float* tb = (LAS float*)(lds + L_TB); LAS float* km = (LAS float*)(lds + L_KM);
    const float bfar = BT[h * 132 + 128];
    for (int i = tid; i < 768; i += NTHREADS) { const int rel = i - 256; tb[i] = rel < 0 ? -1.0e30f : (rel < 128 ? BT[h * 132 + rel] - bfar : 0.f); }
    for (int i = tid; i < 16 * 64; i += NTHREADS) { const int j = i >> 6, d = i & 63, pm = b * 16 + j; km[i] = KMP[pm * 512 + h * 64 + d] + KMP[128 * 512 + pm * 512 + h * 64 + d]; }
    const bf16* ksrc = K + (rowbase + lane) * 512 + h * 64 + wid * 8;
    const bf16* vsrc = V + (rowbase + 16 * (wid & 3) + (lane >> 2)) * 512 + h * 64 + (wid >> 2) * 32 + (lane & 3) * 8;
    u32x4 kreg = *(const u32x4*)ksrc, vreg = *(const u32x4*)vsrc;
    bf16x8 qr[4];
    { const bf16* qw = Q + (rowbase + q0 + wid * 32 + r32) * 512 + h * 64 + hi * 8;
#pragma unroll
      for (int d0 = 0; d0 < 4; ++d0) qr[d0] = *(const bf16x8*)(qw + d0 * 16); }
    __syncthreads();
    unsigned selmask = 1u << qb;
    { float g[16];
#pragma unroll
      for (int j = 0; j < 16; ++j) g[j] = 0.f;
#pragma unroll
      for (int d0 = 0; d0 < 4; ++d0)
#pragma unroll
          for (int e = 0; e < 8; ++e) { const float qf = bf2f((unsigned)(unsigned short)qr[d0][e]);
#pragma unroll
              for (int j = 0; j < 16; ++j) g[j] += qf * km[j * 64 + d0 * 16 + hi * 8 + e]; }
#pragma unroll
      for (int j = 0; j < 16; ++j) g[j] = hsum(g[j]);
#pragma unroll
      for (int s = 0; s < 3; ++s) { float bv = -3.0e38f; int bi = -1;
#pragma unroll
          for (int j = 0; j < 16; ++j) { const bool ok = (j < qb) && !((selmask >> j) & 1u) && (g[j] > bv); bv = ok ? g[j] : bv; bi = ok ? j : bi; }
          if (bi >= 0) selmask |= 1u << bi; } }
    *(LAS u32x4*)(lds + L_K + wid * 1024 + lane * 16) = kreg; *(LAS u32x4*)(lds + L_V + wid * 1024 + lane * 16) = vreg;
    __syncthreads();
    const int qrel = wid * 32 + r32;
    const LAS char* kp0 = lds + L_K + hi * 1024 + r32 * 16;
    const LAS char* vp0 = lds + L_V + ((lane >> 4) & 1) * 32 + (lane & 3) * 8 + (4 * hi + ((lane & 15) >> 2)) * 64;
    float m = -1.0e20f, l = 0.f; f32x16 o0 = f32x16{}, o1 = f32x16{};
#pragma unroll 1
    for (int t = 0; t < NT; ++t) {
        const int buf = (t & 1) * 8192;
        if (t + 1 < NT) { kreg = *(const u32x4*)(ksrc + (size_t)(t + 1) * 64 * 512); vreg = *(const u32x4*)(vsrc + (size_t)(t + 1) * 64 * 512); }
        const float ci = ((selmask >> (t >> 2)) & 1u) ? bfar : -1.0e30f;
        f32x16 p0, p1;
#pragma unroll
        for (int r = 0; r < 16; ++r) { p0[r] = ci; p1[r] = ci; }
#pragma unroll
        for (int d0 = 0; d0 < 4; ++d0) { const bf16x8 a0 = *(const LAS bf16x8*)(kp0 + buf + d0 * 2048), a1 = *(const LAS bf16x8*)(kp0 + buf + d0 * 2048 + 512);
            p0 = __builtin_amdgcn_mfma_f32_32x32x16_bf16(a0, qr[d0], p0, 0, 0, 0); p1 = __builtin_amdgcn_mfma_f32_32x32x16_bf16(a1, qr[d0], p1, 0, 0, 0); }
        const int jn = t - (NT - 8);
        if (jn >= 0) { const LAS float* t0 = tb + (qrel - 64 * (jn - 4) - 4 * hi + 256);
#pragma unroll
            for (int r = 0; r < 16; ++r) { const int k = (r & 3) + 8 * (r >> 2); p0[r] += t0[-k]; p1[r] += t0[-k - 32]; } }
        float rm = fmaxf(p0[0], p1[0]);
#pragma unroll
        for (int r = 1; r < 16; ++r) rm = fmaxf(rm, fmaxf(p0[r], p1[r]));
        rm = hmax(rm);
        const float mn = fmaxf(fmaxf(m, rm), -1.0e20f), alpha = __builtin_amdgcn_exp2f(m - mn); m = mn;
        float s = 0.f;
#pragma unroll
        for (int r = 0; r < 16; ++r) { p0[r] = __builtin_amdgcn_exp2f(p0[r] - mn); p1[r] = __builtin_amdgcn_exp2f(p1[r] - mn); s += p0[r] + p1[r]; }
        l = l * alpha + s;
#pragma unroll
        for (int r = 0; r < 16; ++r) { o0[r] *= alpha; o1[r] *= alpha; }
        u32x4 pw[4];
#pragma unroll
        for (int q = 0; q < 4; ++q) { pw[0][q] = cvtpk(p0[2 * q], p0[2 * q + 1]); pw[1][q] = cvtpk(p0[8 + 2 * q], p0[9 + 2 * q]); pw[2][q] = cvtpk(p1[2 * q], p1[2 * q + 1]); pw[3][q] = cvtpk(p1[8 + 2 * q], p1[9 + 2 * q]); }
        const LAS char* vp = vp0 + buf;
#pragma unroll
        for (int k = 0; k < 4; ++k) {
            const s16x4 lo0 = vtr(vp + k * 1024), hi0 = vtr(vp + k * 1024 + 512), lo1 = vtr(vp + 4096 + k * 1024), hi1 = vtr(vp + 4096 + k * 1024 + 512);
            const bf16x8 v0 = (bf16x8){lo0[0], lo0[1], lo0[2], lo0[3], hi0[0], hi0[1], hi0[2], hi0[3]}, v1 = (bf16x8){lo1[0], lo1[1], lo1[2], lo1[3], hi1[0], hi1[1], hi1[2], hi1[3]};
            const bf16x8 pa = __builtin_bit_cast(bf16x8, pw[k]);
            o0 = __builtin_amdgcn_mfma_f32_32x32x16_bf16(v0, pa, o0, 0, 0, 0);
            o1 = __builtin_amdgcn_mfma_f32_32x32x16_bf16(v1, pa, o1, 0, 0, 0); }
        if (t + 1 < NT) { const int nb = ((t + 1) & 1) * 8192; *(LAS u32x4*)(lds + L_K + nb + wid * 1024 + lane * 16) = kreg; *(LAS u32x4*)(lds + L_V + nb + wid * 1024 + lane * 16) = vreg; }
        __syncthreads();
    }
    const float inv = 1.f / hsum(l);
    bf16* orow = O + (rowbase + q0 + wid * 32 + r32) * 1024 + 512 + h * 64 + 4 * hi;
#pragma unroll
    for (int g = 0; g < 4; ++g) { u32x2 w0, w1;
        w0.x = cvtpk(o0[4 * g] * inv, o0[4 * g + 1] * inv); w0.y = cvtpk(o0[4 * g + 2] * inv, o0[4 * g + 3] * inv);
        w1.x = cvtpk(o1[4 * g] * inv, o1[4 * g + 1] * inv); w1.y = cvtpk(o1[4 * g + 2] * inv, o1[4 * g + 3] * inv);
        *(u32x2*)(orow + 8 * g) = w0; *(u32x2*)(orow + 32 + 8 * g) = w1; }
}
__device__ __forceinline__ void phase(int wave, int vcu, const bf16* Q, const bf16* K, const bf16* V, bf16* O, const float* KMP, const float* BT, LAS char* lds) {
    if (vcu >= 256) return;
    const int s = vcu & 3, bh = vcu >> 2;
#pragma unroll 1
    for (int i = 0; i < 4; ++i) { const int qb = (i == 0) ? s : (i == 1) ? 7 - s : (i == 2) ? 8 + s : 15 - s; unit(wave, bh >> 3, bh & 7, qb, Q, K, V, O, KMP, BT, lds); }
}
}

template <class Epi>
__device__ __forceinline__ void naive_gemm(const Ctx& F0, const bf16* A, int lda, const float* Bw, int ldb, const float* kscale, int M, int N, int K, const Epi& epi) {
    const Ctx F = launder(F0);
    LAS float* As = (LAS float*)F.lds;
    LAS float* Bs = As + 16 * 132;
    const int tid = F.tid, ty = tid >> 4, tx = tid & 15;
    const int tm = M / 128, tn = N / 128;
    for (int tile = F.vcu; tile < tm * tn; tile += F.G) {
        const int m0 = (tile / tn) * 128, n0 = (tile % tn) * 128;
        float acc[4][8];
#pragma unroll
        for (int i = 0; i < 4; ++i)
#pragma unroll
            for (int j = 0; j < 8; ++j) acc[i][j] = 0.f;
        for (int k0 = 0; k0 < K; k0 += 16) {
            {
                const int row = tid >> 2, kq = (tid & 3) * 4;
                const u32x2 v = *(const u32x2*)(A + (size_t)(m0 + row) * lda + k0 + kq);
                As[(kq + 0) * 132 + row] = bf2f(v.x & 0xffffu); As[(kq + 1) * 132 + row] = bf2f(v.x >> 16);
                As[(kq + 2) * 132 + row] = bf2f(v.y & 0xffffu); As[(kq + 3) * 132 + row] = bf2f(v.y >> 16);
                const int kk = tid >> 5, nq = (tid & 31) * 4;
                f32x4 b = *(const f32x4*)(Bw + (size_t)(k0 + kk) * ldb + n0 + nq);
                const float s = kscale ? kscale[k0 + kk] : 1.f;
                b = b * s;
                *(LAS f32x4*)(Bs + kk * 128 + nq) = b;
            }
            __syncthreads();
#pragma unroll
            for (int kk = 0; kk < 16; ++kk) {
                const f32x4 a = *(const LAS f32x4*)(As + kk * 132 + ty * 4);
                const f32x4 b0 = *(const LAS f32x4*)(Bs + kk * 128 + tx * 8);
                const f32x4 b1 = *(const LAS f32x4*)(Bs + kk * 128 + tx * 8 + 4);
#pragma unroll
                for (int i = 0; i < 4; ++i) {
#pragma unroll
                    for (int j = 0; j < 4; ++j) { acc[i][j] += a[i] * b0[j]; acc[i][4 + j] += a[i] * b1[j]; }
                }
            }
            __syncthreads();
        }
#pragma unroll
        for (int i = 0; i < 4; ++i)
#pragma unroll
            for (int j = 0; j < 8; ++j) epi(m0 + ty * 4 + i, n0 + tx * 8 + j, acc[i][j]);
    }
}

struct EpiProj { Ctx F; __device__ __forceinline__ void operator()(int m, int n, float v) const { store_proj(F, m, n, v); } };
struct EpiGlu { bf16* ys; bf16* ymix; const float* gb;
    __device__ __forceinline__ void operator()(int m, int n, float v) const { const float y = bf2f(ys[(size_t)m * 256 + n]); ymix[(size_t)m * 1024 + n] = (bf16)f2bf(y * sigmoidf_(v + gb[n])); } };
struct EpiOut { const float* xin; float* R;
    __device__ __forceinline__ void operator()(int m, int n, float v) const { const size_t o = (size_t)m * D + n; R[o] = xin[o] + v; } };

__device__ __forceinline__ void ph_norm(const Ctx& F0, const float* xin) {
    const Ctx F = launder(F0);
    const int gw = F.vcu * NWAVES + F.wave, NGW = F.G * NWAVES;
    for (int m = gw; m < T; m += NGW) {
        const f32x4* xr = (const f32x4*)(xin + (size_t)m * D) + F.lane;
        f32x4 v[4]; float s = 0.f;
#pragma unroll
        for (int j = 0; j < 4; ++j) { v[j] = xr[64 * j]; s += (v[j].x * v[j].x + v[j].y * v[j].y) + (v[j].z * v[j].z + v[j].w * v[j].w); }
        const float rstd = 1.f / sqrtf(wave_sum(s) * (1.f / D) + RMS_EPS);
        unsigned long long* o8 = (unsigned long long*)(P_XB(F) + (size_t)m * D) + F.lane;
#pragma unroll
        for (int j = 0; j < 4; ++j) o8[64 * j] = (unsigned long long)pk2(v[j].x * rstd, v[j].y * rstd) | ((unsigned long long)pk2(v[j].z * rstd, v[j].w * rstd) << 32);
    }
}

__device__ __forceinline__ void ph_bias_table(const Ctx& F0) {
    const Ctx F = launder(F0);
    if (F.vcu == 0) {
        const float* rel_bias = F.in[1];
        for (int i = F.tid; i < 8 * 132; i += NTHREADS) {
            const int h = i / 132, r = i % 132;
            int bk;
            if (r < 16) bk = r;
            else { bk = 16 + (int)(logf((float)r / 16.f) / logf(8.f) * 16.f); if (bk > 31) bk = 31; }
            P_BT(F)[i] = rel_bias[bk * 8 + h] * LOG2E;
        }
    }
}

__device__ __forceinline__ void ph_kmean_naive(const Ctx& F0) {
    const Ctx F = launder(F0);
    const int gt = F.vcu * NTHREADS + F.tid, NGT = F.G * NTHREADS;
    for (int i = gt; i < 128 * 512; i += NGT) {
        const int pm = i >> 9, c = i & 511; float s = 0.f;
        for (int r = 0; r < 256; ++r) s += bf2f(P_KB(F)[(size_t)(pm * 256 + r) * 512 + c]);
        P_KMP(F)[i] = s; P_KMP(F)[128 * 512 + i] = 0.f;
    }
}

__device__ __forceinline__ void ph_ssm_naive(const Ctx& F0, int l) {
    const Ctx F = launder(F0);
    const int gw = F.vcu * NWAVES + F.wave, NGW = F.G * NWAVES;
    for (int it = gw; it < NB * SGN; it += NGW) {
        const int b = it / SGN, g = it % SGN, p = F.lane;
        const float are = F.in[4][(l * SGN + g) * SP + p], aim = F.in[5][(l * SGN + g) * SP + p];
        const float dt = __expf(F.in[6][l * SGN + g]);
        const float mag = expf(are * dt); float sn, cs; sincosf(aim * dt, &sn, &cs);
        const float lbr = mag * cs, lbi = mag * sn;
        const float nr = lbr - 1.f, ni = lbi, den = are * are + aim * aim;
        const float cr = (nr * are + ni * aim) / den, ci = (ni * are - nr * aim) / den;
        float bbr[16], bbi[16], ccr[16], cci[16];
#pragma unroll
        for (int h = 0; h < 16; ++h) {
            const float br = F.in[7][((size_t)(l * SGN + g) * SP + p) * SG + h], bi = F.in[8][((size_t)(l * SGN + g) * SP + p) * SG + h];
            bbr[h] = cr * br - ci * bi; bbi[h] = cr * bi + ci * br;
            ccr[h] = F.in[9][((size_t)(l * SGN + g) * SG + h) * SP + p]; cci[h] = F.in[10][((size_t)(l * SGN + g) * SG + h) * SP + p];
        }
        const float dh = (F.lane < 16) ? F.in[11][l * 256 + g * 16 + F.lane] : 0.f;
        float sr = 0.f, si = 0.f;
        for (int t = 0; t < SEQ; ++t) {
            const int m = b * SEQ + t;
            const bf16* up = P_UG(F) + ((size_t)(g * 512 + (m >> 6))) * UGP + (m & 63) * 16;
            const u32x4 u0 = *(const u32x4*)up, u1 = *(const u32x4*)(up + 8);
            float u[16];
            u[0] = bf2f(u0.x & 0xffffu); u[1] = bf2f(u0.x >> 16); u[2] = bf2f(u0.y & 0xffffu); u[3] = bf2f(u0.y >> 16);
            u[4] = bf2f(u0.z & 0xffffu); u[5] = bf2f(u0.z >> 16); u[6] = bf2f(u0.w & 0xffffu); u[7] = bf2f(u0.w >> 16);
            u[8] = bf2f(u1.x & 0xffffu); u[9] = bf2f(u1.x >> 16); u[10] = bf2f(u1.y & 0xffffu); u[11] = bf2f(u1.y >> 16);
            u[12] = bf2f(u1.z & 0xffffu); u[13] = bf2f(u1.z >> 16); u[14] = bf2f(u1.w & 0xffffu); u[15] = bf2f(u1.w >> 16);
            float bur = 0.f, bui = 0.f;
#pragma unroll
            for (int h = 0; h < 16; ++h) { bur += bbr[h] * u[h]; bui += bbi[h] * u[h]; }
            const float nsr = lbr * sr - lbi * si + bur, nsi = lbr * si + lbi * sr + bui;
            sr = nsr; si = nsi;
            float yo = 0.f, uo = 0.f;
#pragma unroll
            for (int h = 0; h < 16; ++h) {
                const float y = wave_sum(ccr[h] * sr - cci[h] * si);
                if (F.lane == h) { yo = y; uo = u[h]; }
            }
            if (F.lane < 16) P_YS(F)[(size_t)m * 256 + g * 16 + F.lane] = (bf16)f2bf(gelu_tanh(yo + dh * uo));
        }
    }
}

__device__ __forceinline__ void ph_pool_dl(const Ctx& F0) {
    const Ctx F = launder(F0);
    const int gt = F.vcu * NTHREADS + F.tid, NGT = F.G * NTHREADS;
    for (int it = gt; it < (T / 32) * 128; it += NGT) {
        const int cp = it & 127, chunk = it >> 7, c = cp * 2, gi = c >> 6, win = 2 << gi, m0 = chunk * 32, t0 = m0 & (SEQ - 1);
        const unsigned* P2 = (const unsigned*)P_PB(F) + cp; unsigned* D2 = (unsigned*)P_DL(F) + cp;
        float s0 = 0.f, s1 = 0.f;
        const int back = (t0 < win) ? t0 : win;
        for (int j = 1; j <= back; ++j) { const unsigned v = P2[(size_t)(m0 - j) * 128]; s0 += bf2f(v & 0xffffu); s1 += bf2f(v >> 16); }
#pragma unroll 4
        for (int i = 0; i < 32; ++i) { const int m = m0 + i, t = t0 + i;
            const unsigned v = P2[(size_t)m * 128]; const float p0 = bf2f(v & 0xffffu), p1 = bf2f(v >> 16);
            s0 += p0; s1 += p1;
            if (t >= win) { const unsigned o = P2[(size_t)(m - win) * 128]; s0 -= bf2f(o & 0xffffu); s1 -= bf2f(o >> 16); }
            const float inv = 1.f / (float)((t + 1 < win) ? t + 1 : win);
            D2[(size_t)m * 128] = pk2(s0 * inv - p0, s1 * inv - p1); }
    }
}
__device__ __forceinline__ void ph_pool_mm_naive(const Ctx& F0, int l) {
    const Ctx F = launder(F0);
    const int gt = F.vcu * NTHREADS + F.tid, NGT = F.G * NTHREADS;
    const float* w = F.in[14] + (size_t)l * 4 * 64 * 64;
    for (int i = gt; i < T * 256; i += NGT) {
        const int m = i >> 8, n = i & 255, gi = n >> 6, d = n & 63; float s = 0.f;
        for (int c = 0; c < 64; ++c) s += bf2f(P_DL(F)[(size_t)m * 256 + gi * 64 + c]) * w[(gi * 64 + c) * 64 + d];
        P_YMIX(F)[(size_t)m * 1024 + 256 + n] = (bf16)f2bf((s + F.in[15][l * 256 + n]) * F.in[16][l * 256 + n]);
    }
}

__device__ __forceinline__ void ph_attn_naive(const Ctx& F0) {
    const Ctx F = launder(F0);
    const int gw = F.vcu * NWAVES + F.wave, NGW = F.G * NWAVES, lane = F.lane;
    for (int it = gw; it < T * NHEAD; it += NGW) {
        const int h = it & 7, m = it >> 3, b = m >> 12, q = m & (SEQ - 1), qblk = q >> 8;
        const float qv = bf2f(P_QB(F)[(size_t)m * 512 + h * 64 + lane]);
        float mygate = -3.0e38f;
        for (int j = 0; j < qblk; ++j) {
            const int pm = b * NBLK + j;
            const float km = P_KMP(F)[pm * 512 + h * 64 + lane] + P_KMP(F)[128 * 512 + pm * 512 + h * 64 + lane];
            const float g = wave_sum(qv * km);
            if (lane == j) mygate = g;
        }
        int bsel0 = -1, bsel1 = -1, bsel2 = -1;
        const int nsel = qblk < 3 ? qblk : 3;
        for (int s = 0; s < nsel; ++s) {
            const float bv = wave_max(mygate);
            const unsigned long long bal = __ballot(mygate == bv);
            const int best = __builtin_ctzll(bal);
            if (s == 0) bsel0 = best; else if (s == 1) bsel1 = best; else bsel2 = best;
            if (lane == best) mygate = -3.0e38f;
        }
        float sc[16];
        float mx = -3.0e38f;
#pragma unroll
        for (int s = 0; s < 4; ++s) {
            const int blk = (s == 0) ? bsel0 : (s == 1) ? bsel1 : (s == 2) ? bsel2 : qblk;
#pragma unroll
            for (int c = 0; c < 4; ++c) {
                float v = -3.0e38f;
                if (blk >= 0) {
                    const int kpos = blk * 256 + c * 64 + lane, rel = q - kpos;
                    const bf16* kr = P_KB(F) + (size_t)(b * SEQ + kpos) * 512 + h * 64;
                    float dot = 0.f;
#pragma unroll
                    for (int d8 = 0; d8 < 8; ++d8) {
                        const u32x4 kk = *(const u32x4*)(kr + d8 * 8);
                        dot += __builtin_bit_cast(float, __builtin_amdgcn_readlane(__builtin_bit_cast(int, qv), d8 * 8 + 0)) * bf2f(kk.x & 0xffffu) + __builtin_bit_cast(float, __builtin_amdgcn_readlane(__builtin_bit_cast(int, qv), d8 * 8 + 1)) * bf2f(kk.x >> 16);
                        dot += __builtin_bit_cast(float, __builtin_amdgcn_readlane(__builtin_bit_cast(int, qv), d8 * 8 + 2)) * bf2f(kk.y & 0xffffu) + __builtin_bit_cast(float, __builtin_amdgcn_readlane(__builtin_bit_cast(int, qv), d8 * 8 + 3)) * bf2f(kk.y >> 16);
                        dot += __builtin_bit_cast(float, __builtin_amdgcn_readlane(__builtin_bit_cast(int, qv), d8 * 8 + 4)) * bf2f(kk.z & 0xffffu) + __builtin_bit_cast(float, __builtin_amdgcn_readlane(__builtin_bit_cast(int, qv), d8 * 8 + 5)) * bf2f(kk.z >> 16);
                        dot += __builtin_bit_cast(float, __builtin_amdgcn_readlane(__builtin_bit_cast(int, qv), d8 * 8 + 6)) * bf2f(kk.w & 0xffffu) + __builtin_bit_cast(float, __builtin_amdgcn_readlane(__builtin_bit_cast(int, qv), d8 * 8 + 7)) * bf2f(kk.w >> 16);
                    }
                    if (rel >= 0) v = dot + P_BT(F)[h * 132 + (rel < 128 ? rel : 128)];
                }
                sc[s * 4 + c] = v; mx = fmaxf(mx, v);
            }
        }
        mx = wave_max(mx);
        float sum = 0.f;
#pragma unroll
        for (int i = 0; i < 16; ++i) { sc[i] = (sc[i] > -1.0e38f) ? exp2f(sc[i] - mx) : 0.f; sum += sc[i]; }
        sum = wave_sum(sum);
        float o = 0.f;
#pragma unroll
        for (int s = 0; s < 4; ++s) {
            const int blk = (s == 0) ? bsel0 : (s == 1) ? bsel1 : (s == 2) ? bsel2 : qblk;
            if (blk >= 0) {
#pragma unroll
                for (int c = 0; c < 4; ++c) {
                    const bf16* vr = P_VB(F) + (size_t)(b * SEQ + blk * 256 + c * 64) * 512 + h * 64 + lane;
                    const float pc = sc[s * 4 + c];
                    for (int kk = 0; kk < 64; ++kk) {
                        const float p = __builtin_bit_cast(float, __builtin_amdgcn_readlane(__builtin_bit_cast(int, pc), kk));
                        o += p * bf2f(vr[(size_t)kk * 512]);
                    }
                }
            }
        }
        P_YMIX(F)[(size_t)m * 1024 + 512 + h * 64 + lane] = (bf16)f2bf(o / sum);
    }
}

__device__ __forceinline__ void ph_moe_naive(const Ctx& F0, int l) {
    const Ctx F = launder(F0);
    LAS float* h2 = (LAS float*)F.lds;
    LAS float* act = h2 + 1024;
    LAS float* red = act + 512;
    LAS float* lg = red + 32;
    LAS float* selw = lg + 24;
    const float* g2 = F.in[18] + l * D;
    const float* gw_ = F.in[19] + (size_t)l * D * 4; const float* gb_ = F.in[20] + l * 4;
    const float* rw_ = F.in[21] + (size_t)l * 4 * D * 4; const float* rb_ = F.in[22] + l * 16;
    const float* wg = F.in[23] + (size_t)l * 16 * D * 256; const float* wu = F.in[24] + (size_t)l * 16 * D * 256; const float* wd = F.in[25] + (size_t)l * 16 * 256 * D;
    const int tid = F.tid, lane = F.lane, wave = F.wave;
    for (int m = F.vcu; m < T; m += F.G) {
        float* xr = F.R + (size_t)m * D;
        const float x0 = xr[tid], x1 = xr[tid + 512];
        float s = wave_sum(x0 * x0 + x1 * x1);
        if (lane == 0) red[wave] = s;
        __syncthreads();
        float tot = 0.f;
#pragma unroll
        for (int w = 0; w < 8; ++w) tot += red[w];
        const float rstd = 1.f / sqrtf(tot * (1.f / D) + RMS_EPS);
        h2[tid] = x0 * rstd * g2[tid]; h2[tid + 512] = x1 * rstd * g2[tid + 512];
        __syncthreads();
        for (int j = wave; j < 20; j += NWAVES) {
            float a = 0.f;
            if (j < 4) { for (int k = lane; k < D; k += 64) a += h2[k] * gw_[k * 4 + j]; }
            else { const int g = (j - 4) >> 2, e = (j - 4) & 3; for (int k = lane; k < D; k += 64) a += h2[k] * rw_[((size_t)g * D + k) * 4 + e]; }
            a = wave_sum(a);
            if (lane == 0) lg[j] = a + (j < 4 ? gb_[j] : rb_[j - 4]);
        }
        __syncthreads();
        if (tid == 0) {
            int gs = 0; float gm = lg[0];
            for (int j = 1; j < 4; ++j) if (lg[j] > gm) { gm = lg[j]; gs = j; }
            float se = 0.f; for (int j = 0; j < 4; ++j) se += __expf(lg[j] - gm);
            const float gwt = 1.f / se;
            int e1 = 0; float v1 = lg[4 + gs * 4];
            for (int e = 1; e < 4; ++e) if (lg[4 + gs * 4 + e] > v1) { v1 = lg[4 + gs * 4 + e]; e1 = e; }
            int e2 = -1; float v2 = -3.0e38f;
            for (int e = 0; e < 4; ++e) if (e != e1 && lg[4 + gs * 4 + e] > v2) { v2 = lg[4 + gs * 4 + e]; e2 = e; }
            const float p2 = __expf(v2 - v1), w1 = 1.f / (1.f + p2), w2 = p2 / (1.f + p2);
            selw[0] = __builtin_bit_cast(float, gs * 4 + e1); selw[1] = __builtin_bit_cast(float, gs * 4 + e2);
            selw[2] = gwt * w1; selw[3] = gwt * w2;
        }
        __syncthreads();
        {
            const int slot = tid >> 8, f = tid & 255;
            const int e = __builtin_bit_cast(int, selw[slot]); const float cw = selw[2 + slot];
            const float* pg = wg + (size_t)e * D * 256 + f; const float* pu = wu + (size_t)e * D * 256 + f;
            float ag = 0.f, au = 0.f;
            for (int k = 0; k < D; ++k) { const float hv = h2[k]; ag += hv * pg[(size_t)k * 256]; au += hv * pu[(size_t)k * 256]; }
            act[slot * 256 + f] = ag * sigmoidf_(ag) * au * cw;
        }
        __syncthreads();
        {
            const int ea = __builtin_bit_cast(int, selw[0]), eb = __builtin_bit_cast(int, selw[1]);
            const float* pa = wd + (size_t)ea * 256 * D; const float* pb = wd + (size_t)eb * 256 * D;
            float y0 = 0.f, y1 = 0.f;
            for (int f = 0; f < 256; ++f) {
                const float a = act[f], b = act[256 + f];
                y0 += a * pa[(size_t)f * D + tid] + b * pb[(size_t)f * D + tid];
                y1 += a * pa[(size_t)f * D + tid + 512] + b * pb[(size_t)f * D + tid + 512];
            }
            xr[tid] = x0 + y0; xr[tid + 512] = x1 + y1;
        }
        __syncthreads();
    }
}

__device__ __forceinline__ void ph_final(const Ctx& F0) {
    const Ctx F = launder(F0);
    const int gw = F.vcu * NWAVES + F.wave, NGW = F.G * NWAVES;
    const f32x4* gf = (const f32x4*)F.in[26] + F.lane;
    for (int m = gw; m < T; m += NGW) {
        f32x4* xr = (f32x4*)(F.R + (size_t)m * D) + F.lane;
        f32x4 v[4]; float s = 0.f;
#pragma unroll
        for (int j = 0; j < 4; ++j) { v[j] = xr[64 * j]; s += (v[j].x * v[j].x + v[j].y * v[j].y) + (v[j].z * v[j].z + v[j].w * v[j].w); }
        const float rstd = 1.f / sqrtf(wave_sum(s) * (1.f / D) + RMS_EPS);
#pragma unroll
        for (int j = 0; j < 4; ++j) xr[64 * j] = v[j] * rstd * gf[64 * j];
    }
}

constexpr int LDS_BYTES = 147456;
constexpr int MISC_OFF = 131072 + 320;

__global__ void __launch_bounds__(NTHREADS, 2) mk_fwd(Args args) {
    extern __shared__ __attribute__((aligned(16))) unsigned char lds[];
    Ctx F;
    F.lds = (LAS unsigned char*)lds;
    F.wave = __builtin_amdgcn_readfirstlane((int)threadIdx.x >> 6);
    F.lane = lane_id(); F.tid = F.wave * 64 + F.lane;
    F.G = gridDim.x; { const int bx = blockIdx.x; F.vcu = (F.G % 8 == 0) ? (bx % 8) * (F.G / 8) + bx / 8 : bx; }
    F.in = (KargP)__builtin_amdgcn_kernarg_segment_ptr(); F.R = args.out; F.ws = args.ws;
    unsigned char* ws = args.ws;
    volatile LAS unsigned* MISC = (volatile LAS unsigned*)(F.lds + MISC_OFF);
    if (F.tid < 64) MISC[F.tid] = 0u;
    __syncthreads();
    XcdBarrier bar = xcd_barrier_post((unsigned*)(ws + WS_CTL) + CW_BAR, MISC + 8, F.tid == 0);
#define GRID_BAR() do { bar.bar = (unsigned*)(wsl(ws) + WS_CTL) + CW_BAR; xcd_barrier(bar, F.wave); } while (0)
#define FL launder(F)

    ph_bias_table(F);
#if USE_ENG_PROJ
    ph_prologue(F);
#endif
#pragma unroll 1
    for (int l = 0; l < DEPTH; ++l) {
        const float* xin = (l == 0) ? F.in[0] : F.R;
        ph_norm(F, xin);
        GRID_BAR();
#if USE_ENG_PROJ
        { pg8::Gemm g{P_XB(FL), (const bf16*)(wsl(ws) + WS_WIN) + (size_t)l * NPROJ * D, D, D, D}; pg8::StaticOrder S; S.init(T, NPROJ, sl(F.G), sl((int)blockIdx.x));
          EpiProjE E{P_UG(FL), P_PB(FL), P_QB(FL), P_KB(FL), P_VB(FL), P_KMP(FL)}; pg8::gemm_phase(F.lds, g, S, E, sl(F.wave)); }
#else
        { EpiProj E{F}; naive_gemm(F, P_XB(FL), D, F.in[3] + (size_t)l * D * NPROJ, NPROJ, F.in[2] + l * D, T, NPROJ, D, E); }
#endif
        GRID_BAR();
#if USE_ENG_SSM
        { pg8::Gemm g{P_UG(FL), (const bf16*)(wsl(ws) + WS_BZ) + (size_t)l * SGN * 256 * 1024, UGP, 1024, 1024}; SsmOrder S{sl(F.G), sl((int)blockIdx.x), 1};
          EpiZ E{(float*)(wsl(ws) + WS_ZB)}; pg8::gemm_phase(F.lds, g, S, E, sl(F.wave)); }
        ph_pool_dl(F);
        GRID_BAR();
        ph_ssm_scan(F, l);
        GRID_BAR();
        { pg8::Gemm g{P_UG(FL), (const bf16*)(wsl(ws) + WS_TG) + (size_t)l * SGN * 1024 * UGP, UGP, UGP, UGP}; SsmOrder S{sl(F.G), sl((int)blockIdx.x), 2};
          EpiSsm2 E{P_UG(FL), P_YS(FL), F.in[11] + l * 256}; pg8::gemm_phase(F.lds, g, S, E, sl(F.wave)); }
        GRID_BAR();
        { pg8::Gemm g{P_YS(FL), (const bf16*)(wsl(ws) + WS_GLUT) + (size_t)l * 65536, 256, 256, 256}; HalfOrder S{sl(F.vcu)};
          EpiGluE E{P_YS(FL), P_YMIX(FL), F.in[13] + l * 256}; pg8::gemm_phase(F.lds, g, S, E, sl(F.wave)); }
        { pg8::Gemm g{P_DL(FL), (const bf16*)(wsl(ws) + WS_POOLT) + (size_t)l * 65536, 256, 256, 256}; HalfOrder S{sl(F.vcu) - 128};
          EpiPoolE E{P_YMIX(FL), F.in[15] + l * 256, F.in[16] + l * 256}; pg8::gemm_phase(F.lds, g, S, E, sl(F.wave)); }
#else
        ph_ssm_naive(F, l);
#if !USE_ENG_PROJ
        ph_kmean_naive(F);
#endif
        ph_pool_dl(F);
        GRID_BAR();
        { EpiGlu E{P_YS(FL), P_YMIX(FL), F.in[13] + l * 256}; naive_gemm(F, P_YS(FL), 256, F.in[12] + (size_t)l * 256 * 256, 256, nullptr, T, 256, 256, E); }
        ph_pool_mm_naive(F, l);
#endif
#if USE_FAST_ATTN == 2
        moba::phase(sl(F.wave), sl(F.vcu), P_QB(FL), P_KB(FL), P_VB(FL), P_YMIX(FL), P_KMP(FL), P_BT(FL), (LAS char*)F.lds);
#elif USE_FAST_ATTN
        { const attn_body::AttnTensors AT{(const attn_body::abf16*)P_QB(FL), (const attn_body::abf16*)P_KB(FL), (const attn_body::abf16*)P_VB(FL), (attn_body::abf16*)P_YMIX(FL), P_KMP(FL), P_BT(FL)};
          const attn_body::StaticOrder S(sl(F.vcu)); attn_body::attn_phase<attn_body::StaticOrder>(sl(F.wave), (char*)lds, AT, S); }
#else
        ph_attn_naive(F);
#endif
        GRID_BAR();
#if USE_ENG_PROJ
        { pg8::Gemm g{P_YMIX(FL), (const bf16*)(wsl(ws) + WS_WOUT) + (size_t)l * D * D, D, D, D}; pg8::StaticOrder S; S.init(T, D, sl(F.G), sl((int)blockIdx.x));
          EpiOutE E{xin, F.R}; pg8::gemm_phase(F.lds, g, S, E, sl(F.wave)); }
#else
        { EpiOut E{xin, F.R}; naive_gemm(F, P_YMIX(FL), D, F.in[17] + (size_t)l * D * D, D, nullptr, T, D, D, E); }
#endif
        GRID_BAR();
#if USE_ENG_MOE
        ph_route(F, l);
        GRID_BAR();
        ph_place(F);
        GRID_BAR();
        { pg8::Gemm g{(const bf16*)(wsl(ws) + WS_XS), (const bf16*)(wsl(ws) + WS_GU) + (size_t)l * 16 * 512 * D, D, D, D}; MoeOrder S{(const int*)(wsl(ws) + WS_TILEB), sl(F.G), sl((int)blockIdx.x), false};
          EpiGU E{(bf16*)(wsl(ws) + WS_HACT), (const float*)(wsl(ws) + WS_ROWW)}; pg8::gemm_phase(F.lds, g, S, E, sl(F.wave)); }
        GRID_BAR();
        { pg8::Gemm g{(const bf16*)(wsl(ws) + WS_HACT), (const bf16*)(wsl(ws) + WS_WD) + (size_t)l * 24 * D * 512, 512, 512, 512}; MoeOrder S{(const int*)(wsl(ws) + WS_TILEB), sl(F.G), sl((int)blockIdx.x), true};
          EpiDown E{F.R, (const int*)(wsl(ws) + WS_ROWTOK)}; pg8::gemm_phase(F.lds, g, S, E, sl(F.wave)); }
        GRID_BAR();
#else
        ph_moe_naive(F, l);
        GRID_BAR();
#endif
    }
    ph_final(F);
}

extern "C" void kernel_launch(void* const* d_in, const int* in_sizes, int n_in, void* d_out, int out_size, void* d_ws, size_t ws_size, hipStream_t stream) {
    static int grid = 0;
    if (grid == 0) {
        if (n_in != 27 || out_size != T * D || ws_size < WS_END) { fprintf(stderr, "kernel_launch: unexpected shapes (n_in %d out %d ws %zu)\n", n_in, out_size, ws_size); grid = -1; return; }
        int dev = 0, cus = 0, per_cu = 0;
        if (hipGetDevice(&dev) != hipSuccess || hipDeviceGetAttribute(&cus, hipDeviceAttributeMultiprocessorCount, dev) != hipSuccess) { grid = -1; return; }
        if (hipFuncSetAttribute((const void*)mk_fwd, hipFuncAttributeMaxDynamicSharedMemorySize, LDS_BYTES) != hipSuccess) { fprintf(stderr, "kernel_launch: hipFuncSetAttribute failed\n"); grid = -1; return; }
        if (hipOccupancyMaxActiveBlocksPerMultiprocessor(&per_cu, (const void*)mk_fwd, NTHREADS, LDS_BYTES) != hipSuccess || per_cu < 1) { fprintf(stderr, "kernel_launch: occupancy query says %d\n", per_cu); per_cu = 1; }
        (void)hipGetLastError();
        grid = cus;
    }
    if (grid < 0) return;
    (void)hipMemsetAsync((char*)d_ws + WS_CTL, 0, CTL_ZERO_BYTES, stream);
    Args a{};
    for (int i = 0; i < 27; ++i) a.in[i] = (const float*)d_in[i];
    a.out = (float*)d_out; a.ws = (unsigned char*)d_ws; a.ph_lo = 0; a.ph_hi = 0;
    hipLaunchKernelGGL(mk_fwd, dim3(grid), dim3(NTHREADS), LDS_BYTES, stream, a);
}
```

```cpp
#include <hip/hip_runtime.h>
#include <hip/hip_bf16.h>
#include <cstdio>
#include <cstdint>

#define GAS __attribute__((address_space(1)))
#define LAS __attribute__((address_space(3)))
typedef unsigned short bf16;
typedef float f32x4 __attribute__((ext_vector_type(4)));
typedef unsigned u32x4 __attribute__((ext_vector_type(4)));
typedef unsigned u32x2 __attribute__((ext_vector_type(2)));

constexpr int NB = 8, SEQ = 4096, T = NB * SEQ, D = 1024, NPROJ = 2048, DEPTH = 2;
constexpr int NHEAD = 8, HD = 64, MBLK = 256, NBLK = SEQ / MBLK;
constexpr int SG = 16, SGN = 16, SP = 64, SCH = 64, UGP = 1152;
constexpr float RMS_EPS = 1e-6f;
constexpr float LOG2E = 1.4426950408889634f;
constexpr float C2 = 0.125f * LOG2E;
constexpr int NWAVES = 8, NTHREADS = 512;

constexpr size_t MiB = 1u << 20;
constexpr size_t WS_CTL = 0, CTL_ZERO_BYTES = 1 * MiB;
constexpr size_t WS_XB = 2 * MiB;
constexpr size_t WS_UG = 66 * MiB;
constexpr size_t WS_PB = 84 * MiB;
constexpr size_t WS_QB = 100 * MiB;
constexpr size_t WS_KB = 132 * MiB;
constexpr size_t WS_VB = 164 * MiB;
constexpr size_t WS_YMIX = 196 * MiB;
constexpr size_t WS_YS = 260 * MiB;
constexpr size_t WS_DL = 276 * MiB;
constexpr size_t WS_KMP = 292 * MiB;
constexpr size_t WS_BT = 293 * MiB;
constexpr size_t WS_WIN = 300 * MiB;
constexpr size_t WS_WOUT = 308 * MiB;
constexpr size_t WS_GU = 312 * MiB;
constexpr size_t WS_WD = 344 * MiB;
constexpr size_t WS_TG = 392 * MiB;
constexpr size_t WS_BZ = 464 * MiB;
constexpr size_t WS_GLUT = 480 * MiB;
constexpr size_t WS_POOLT = WS_GLUT + 512 * 1024;
constexpr size_t WS_ZB = 482 * MiB;
constexpr size_t WS_END = 486 * MiB;
constexpr int MOE_MAXT = 152;
constexpr size_t WS_XS = 66 * MiB;
constexpr size_t WS_HACT = 142 * MiB;
constexpr size_t WS_TOKB = 294 * MiB;
constexpr size_t WS_TOKR = WS_TOKB + 128 * 1024;
constexpr size_t WS_TOKW = WS_TOKB + 256 * 1024;
constexpr size_t WS_ROWTOK = 295 * MiB;
constexpr size_t WS_ROWW = WS_ROWTOK + 256 * 1024;
constexpr size_t WS_WGCNT = 296 * MiB;
constexpr size_t WS_TILEB = WS_WGCNT + 64 * 1024;

constexpr int CW_BAR = 4096;

__device__ __forceinline__ unsigned f2bf(float f) { unsigned u = __builtin_bit_cast(unsigned, f); return (u + 0x7fffu + ((u >> 16) & 1u)) >> 16; }
__device__ __forceinline__ float bf2f(unsigned h) { return __builtin_bit_cast(float, h << 16); }
__device__ __forceinline__ unsigned pk2(float lo, float hi) { return f2bf(lo) | (f2bf(hi) << 16); }
template <int O> __device__ __forceinline__ float xshfl(float v) {
    if constexpr (O < 32) return __builtin_bit_cast(float, __builtin_amdgcn_ds_swizzle(__builtin_bit_cast(int, v), (O << 10) | 0x1f));
    else { const unsigned u = __builtin_bit_cast(unsigned, v); auto r = __builtin_amdgcn_permlane32_swap(u, u, false, false);
           const float a = __builtin_bit_cast(float, (unsigned)r[0]), b = __builtin_bit_cast(float, (unsigned)r[1]); return (a == v && __builtin_bit_cast(unsigned, a) == u) ? b : a; }
}
__device__ __forceinline__ float wave_sum(float v) {
    v += xshfl<1>(v); v += xshfl<2>(v); v += xshfl<4>(v); v += xshfl<8>(v); v += xshfl<16>(v);
    const unsigned u = __builtin_bit_cast(unsigned, v); auto r = __builtin_amdgcn_permlane32_swap(u, u, false, false);
    return __builtin_bit_cast(float, (unsigned)r[0]) + __builtin_bit_cast(float, (unsigned)r[1]);
}
__device__ __forceinline__ float wave_max(float v) {
    v = fmaxf(v, xshfl<1>(v)); v = fmaxf(v, xshfl<2>(v)); v = fmaxf(v, xshfl<4>(v)); v = fmaxf(v, xshfl<8>(v)); v = fmaxf(v, xshfl<16>(v));
    const unsigned u = __builtin_bit_cast(unsigned, v); auto r = __builtin_amdgcn_permlane32_swap(u, u, false, false);
    return fmaxf(__builtin_bit_cast(float, (unsigned)r[0]), __builtin_bit_cast(float, (unsigned)r[1]));
}
__device__ __forceinline__ float gelu_tanh(float x) {
    const float u = 0.7978845608028654f * (x + 0.044715f * x * x * x);
    const float e = __expf(2.f * u);
    const float th = 1.f - 2.f / (e + 1.f);
    return 0.5f * x * (1.f + th);
}
__device__ __forceinline__ float sigmoidf_(float x) { return 1.f / (1.f + __expf(-x)); }

__device__ __forceinline__ int lane_id() { unsigned m; asm volatile("s_mov_b32 %0, -1" : "=s"(m)); return (int)__builtin_amdgcn_mbcnt_hi(m, __builtin_amdgcn_mbcnt_lo(m, 0u)); }

#define XB_TMO      128
#define XB_XCNT(j)  (256  + 64 * (j))
#define XB_XSUB(j)  (1280 + 64 * (j))
#define XB_XGEN(j)  (2304 + 64 * (j))
#define XB_TOP      3328
#define XB_TOPGEN   3392
#define XCD_BAR_WORDS 3456
#define XB_SPIN_CAP (1u << 22)
__device__ __forceinline__ unsigned xb_ld(unsigned* p)              { return __hip_atomic_load(p, __ATOMIC_RELAXED, __HIP_MEMORY_SCOPE_AGENT); }
__device__ __forceinline__ unsigned xb_add(unsigned* p, unsigned v) { return __hip_atomic_fetch_add(p, v, __ATOMIC_RELAXED, __HIP_MEMORY_SCOPE_AGENT); }
__device__ __forceinline__ unsigned xb_xcc_id() { return (unsigned)__builtin_amdgcn_s_getreg((3 << 11) | 20) & 0xFu; }
#define XB_SPIN(cond, bar) do { unsigned _sp = 0; while (cond) { __builtin_amdgcn_s_sleep(1); \
    if ((++_sp & 255u) == 0u) { if (xb_ld(&(bar)[XB_TMO])) break; if (_sp > XB_SPIN_CAP) { atomicAdd(&(bar)[XB_TMO], 1u); break; } } } } while (0)
struct XcdBarrier { unsigned* bar; unsigned x; volatile LAS unsigned* st; };
__device__ __forceinline__ XcdBarrier xcd_barrier_post(unsigned* bar, volatile LAS unsigned* st, bool t0) {
    XcdBarrier b; b.bar = bar; b.x = xb_xcc_id(); b.st = st;
    if (t0) (void)xb_add(&bar[XB_XCNT(b.x)], 1u);
    return b;
}
__device__ __forceinline__ void xcd_barrier_complete(unsigned* bar, unsigned x, unsigned& nloc, unsigned& nx) {
    const unsigned G = gridDim.x * gridDim.y * gridDim.z;
    unsigned sum, cnt, mine, sp = 0u;
    for (;;) {
        sum = 0u; cnt = 0u; mine = 0u;
#pragma unroll
        for (unsigned j = 0; j < 16; ++j) { const unsigned c = xb_ld(&bar[XB_XCNT(j)]); sum += c; cnt += (c > 0u) ? 1u : 0u; mine = (j == x) ? c : mine; }
        if (sum == G) break;
        __builtin_amdgcn_s_sleep(1);
        if ((++sp & 255u) == 0u) { if (xb_ld(&bar[XB_TMO])) break; if (sp > XB_SPIN_CAP) { atomicAdd(&bar[XB_TMO], 1u); break; } }
    }
    nloc = mine > 0u ? mine : 1u; nx = cnt > 0u ? cnt : 1u;
}
__device__ __forceinline__ void xcd_barrier(const XcdBarrier& b, int wave) {
    asm volatile("s_waitcnt vmcnt(0)" ::: "memory");
    __syncthreads();
    if (wave == 0 && lane_id() == 0) {
        unsigned* bar = b.bar;
        __builtin_amdgcn_s_waitcnt(0);
        unsigned nloc = b.st[0], nx = b.st[1];
        if (nloc == 0u) { xcd_barrier_complete(bar, b.x, nloc, nx); b.st[0] = nloc; b.st[1] = nx; }
        const unsigned old = xb_add(&bar[XB_XSUB(b.x)], 1u);
        const unsigned gen = old / nloc;
        if (old + 1u == (gen + 1u) * nloc) {
            __builtin_amdgcn_fence(__ATOMIC_RELEASE, "agent");
            asm volatile("s_waitcnt vmcnt(0)" ::: "memory");
            const unsigned og = xb_add(&bar[XB_TOP], 1u);
            const unsigned tg = og / nx;
            if (og + 1u == (tg + 1u) * nx) xb_add(&bar[XB_TOPGEN], 1u);
            else XB_SPIN(xb_ld(&bar[XB_TOPGEN]) == tg, bar);
            __builtin_amdgcn_fence(__ATOMIC_ACQUIRE, "agent");
            xb_add(&bar[XB_XGEN(b.x)], 1u);
            asm volatile("s_waitcnt vmcnt(0)" ::: "memory");
        } else {
            XB_SPIN(xb_ld(&bar[XB_XGEN(b.x)]) == gen, bar);
            __builtin_amdgcn_fence(__ATOMIC_ACQUIRE, "agent");
            asm volatile("s_waitcnt vmcnt(0)" ::: "memory");
        }
    }
    __syncthreads();
}

struct Args {
    const float* in[27];
    float* out;
    unsigned char* ws;
    int pad0, pad1;
};

typedef const float* fptr_t;
typedef __attribute__((address_space(4))) const fptr_t* KargP;
struct Ctx {
    LAS unsigned char* lds;
    int tid, lane, wave, vcu, G;
    KargP in;
    float* R;
    unsigned char* ws;
};
#define P_XB(F) ((bf16*)((F).ws + WS_XB))
#define P_UG(F) ((bf16*)((F).ws + WS_UG))
#define P_PB(F) ((bf16*)((F).ws + WS_PB))
#define P_QB(F) ((bf16*)((F).ws + WS_QB))
#define P_KB(F) ((bf16*)((F).ws + WS_KB))
#define P_VB(F) ((bf16*)((F).ws + WS_VB))
#define P_YMIX(F) ((bf16*)((F).ws + WS_YMIX))
#define P_YS(F) ((bf16*)((F).ws + WS_YS))
#define P_DL(F) ((bf16*)((F).ws + WS_DL))
#define P_KMP(F) ((float*)((F).ws + WS_KMP))
#define P_BT(F) ((float*)((F).ws + WS_BT))


__device__ __forceinline__ Ctx launder(const Ctx& F0) {
    Ctx F = F0;
    int ln = lane_id(); asm volatile("" : "+v"(ln));
    asm volatile("" : "+s"(F.wave), "+s"(F.vcu), "+s"(F.G));
    F.lane = ln; F.tid = F.wave * 64 + ln;
    KargP kp = (KargP)__builtin_amdgcn_kernarg_segment_ptr(); asm volatile("" : "+s"(kp));
    F.in = kp; F.R = (float*)kp[27]; F.ws = (unsigned char*)kp[28];
    return F;
}

__device__ __forceinline__ unsigned char* wsl(unsigned char* p) { asm volatile("" : "+s"(p)); return p; }
__device__ __forceinline__ int sl(int x) { asm volatile("" : "+s"(x)); return x; }

namespace pg8 {
typedef short bf16x8 __attribute__((ext_vector_type(8)));
constexpr int BM = 256, BK = 64, HALF = 128, HTB = HALF * BK * 2, STAGE_BYTES = 8 * HTB, NXCD = 8, WGM = 8;
__device__ __forceinline__ int lds_byte(int r, int c) { const int st = (r >> 4) * 2 + (c >> 5), rr = r & 15, cc = c & 31, ob = rr * 64 + cc * 2; return st * 1024 + (ob ^ (((ob >> 9) & 1) << 5)); }
__device__ __forceinline__ void stage_rc(int b, int& R, int& C) { const int st = b / 1024, sb = b % 1024, swz = sb ^ (((sb >> 9) & 1) << 5); R = (st >> 1) * 16 + swz / 64; C = (st & 1) * 32 + (swz % 64) / 2; }
__device__ __forceinline__ int perm32(int rho) { const int n = rho >> 4, i = rho & 15; return 8 * (i >> 2) + 4 * n + (i & 3); }

struct Unit { int pm, pn, aux; };
struct Gemm { const bf16* A; const bf16* Bt; int lda, ldb, K; };

struct StaticOrder {
    int nM, nN, nwg, G, c;
    __device__ void init(int M, int N, int G_, int c_) { nM = M / BM; nN = N / BM; nwg = nM * nN; G = G_; c = c_; }
    __device__ bool next(int i, Unit& u) const {
        const long L = (long)i * G + c; if (L >= nwg) return false;
        int wgid = (int)L; { const int q = nwg / NXCD, r = nwg % NXCD, xcd = wgid % NXCD, off = wgid / NXCD; wgid = (xcd < r ? xcd * (q + 1) : r * (q + 1) + (xcd - r) * q) + off; }
        const int nig = WGM * nN, gid = wgid / nig, fm = gid * WGM, gsz = (nM - fm) < WGM ? (nM - fm) : WGM;
        u.pm = fm + ((wgid % nig) % gsz); u.pn = (wgid % nig) / gsz; u.aux = 0; return true;
    }
};

__device__ __forceinline__ unsigned cvt_pk_bf16(float lo, float hi) { unsigned r; asm volatile("v_cvt_pk_bf16_f32 %0, %1, %2" : "=v"(r) : "v"(lo), "v"(hi)); return r; }

template <bool ALIGN = true, class Epi, class Sched>
__device__ __forceinline__ void gemm_phase(LAS unsigned char* lds, const Gemm g, const Sched& S, const Epi& E, int wave_) {
    int lane_ = lane_id(); asm volatile("" : "+v"(lane_)); asm volatile("" : "+s"(wave_));
    const int wid = wave_, lane = lane_, tid = wid * 64 + lane, wr = wid >> 2, wc = wid & 3, fr = lane & 15, fq = lane >> 4;
    const int K = g.K, nt = K / BK;
    unsigned voffA[2], voffB[2];
#pragma unroll
    for (int i = 0; i < 2; ++i) { int R, C; stage_rc(tid * 16 + i * 8192, R, C); const int Rb = Epi::PERM ? ((R & ~31) + perm32(R & 31)) : R;
        voffA[i] = (unsigned)(R * g.lda + C) * 2u; voffB[i] = (unsigned)(Rb * g.ldb + C) * 2u; }
    const size_t kstep = (size_t)(BK * 2);
    const size_t hstepA = (size_t)HALF * g.lda * 2, hstepB = (size_t)HALF * g.ldb * 2;
    const size_t tstepA = 2 * hstepA, tstepB = 2 * hstepB;
    const unsigned ldsw = (unsigned)wid * 1024u;
    const int aoff = lds_byte(wr * 64 + fr, fq * 8), boff = lds_byte(wc * 32 + fr, fq * 8);
#define PG8_SA(b, h) (((b) * 2 + (h)) * HTB)
#define PG8_SB(b, h) ((4 + (b) * 2 + (h)) * HTB)
#define PG8_STAGE(bufoff, gbase, voff) do { _Pragma("unroll") for (int _i = 0; _i < 2; ++_i) \
        __builtin_amdgcn_global_load_lds((const unsigned*)((const char*)(gbase) + (voff)[_i]), (LAS unsigned*)(lds + (bufoff) + ldsw + _i * 8192), 16, 0, 0); } while (0)
#define PG8_LDA(dst, b, h) do { _Pragma("unroll") for (int m = 0; m < 4; ++m) _Pragma("unroll") for (int k = 0; k < 2; ++k) dst[m][k] = *(const LAS bf16x8*)(lds + PG8_SA(b, h) + aoff + m * 2048 + k * 1024); } while (0)
#define PG8_LDB(dst, b, h) do { _Pragma("unroll") for (int n = 0; n < 2; ++n) _Pragma("unroll") for (int k = 0; k < 2; ++k) dst[n][k] = *(const LAS bf16x8*)(lds + PG8_SB(b, h) + boff + n * 2048 + k * 1024); } while (0)
#define PG8_MMA(ai, bj, At, Bt) do { __builtin_amdgcn_s_setprio(1); _Pragma("unroll") for (int m = 0; m < 4; ++m) _Pragma("unroll") for (int n = 0; n < 2; ++n) _Pragma("unroll") for (int k = 0; k < 2; ++k) \
        acc[ai][bj][m][n] = __builtin_amdgcn_mfma_f32_16x16x32_bf16(Bt[n][k], At[m][k], acc[ai][bj][m][n], 0, 0, 0); __builtin_amdgcn_s_setprio(0); } while (0)
#define PG8_WAIT_V(n) asm volatile("s_waitcnt vmcnt(" #n ")" ::: "memory")
#define PG8_WAIT_L(n) asm volatile("s_waitcnt lgkmcnt(" #n ")" ::: "memory")
#define PG8_BAR __builtin_amdgcn_s_barrier()
#define PG8_SCHED __builtin_amdgcn_sched_barrier(0)
    Unit cur, nxt; int ui = 0;
    if (!S.next(0, cur)) return;
    f32x4 acc[2][2][4][2];
#pragma unroll
    for (int a = 0; a < 2; ++a)
#pragma unroll
        for (int b = 0; b < 2; ++b)
#pragma unroll
            for (int m = 0; m < 4; ++m)
#pragma unroll
                for (int n = 0; n < 2; ++n) acc[a][b][m][n] = (f32x4){0.f, 0.f, 0.f, 0.f};
    bf16x8 At[4][2], B0[2][2], B1[2][2];
    const char* cA = (const char*)g.A + (size_t)cur.pm * tstepA; const char* cB = (const char*)g.Bt + (size_t)cur.pn * tstepB;
    PG8_STAGE(PG8_SB(0, 0), cB, voffB); PG8_STAGE(PG8_SB(0, 1), cB + hstepB, voffB); PG8_STAGE(PG8_SA(0, 0), cA, voffA); PG8_STAGE(PG8_SA(0, 1), cA + hstepA, voffA);
    if (wr == 1) PG8_BAR;
    PG8_WAIT_V(2); PG8_BAR;
    PG8_STAGE(PG8_SB(1, 0), cB + kstep, voffB); PG8_STAGE(PG8_SA(1, 0), cA + kstep, voffA); PG8_STAGE(PG8_SB(1, 1), cB + hstepB + kstep, voffB);
    PG8_WAIT_V(6); PG8_BAR;
    for (;;) {
        const bool has_next = S.next(ui + 1, nxt);
        const char* nA = has_next ? (const char*)g.A + (size_t)nxt.pm * tstepA : cA; const char* nB = has_next ? (const char*)g.Bt + (size_t)nxt.pn * tstepB : cB;
        for (int t = 0; t < nt; t += 2) {
            const bool last = (t == nt - 2);
            const char* a1 = cA + (size_t)(t + 1) * kstep;
            const char* a2 = last ? nA : cA + (size_t)(t + 2) * kstep; const char* b2 = last ? nB : cB + (size_t)(t + 2) * kstep;
            const char* a3 = a2 + kstep; const char* b3 = b2 + kstep;
            PG8_LDB(B0, 0, 0); PG8_LDB(B1, 0, 1); PG8_SCHED; PG8_LDA(At, 0, 0); PG8_STAGE(PG8_SA(1, 1), a1 + hstepA, voffA);
            PG8_WAIT_V(8); PG8_WAIT_L(0); PG8_BAR; PG8_MMA(0, 0, At, B0); PG8_MMA(0, 1, At, B1); PG8_BAR; PG8_SCHED;
            PG8_LDA(At, 0, 1); PG8_STAGE(PG8_SB(0, 0), b2, voffB); PG8_STAGE(PG8_SB(0, 1), b2 + hstepB, voffB); PG8_STAGE(PG8_SA(0, 0), a2, voffA);
            PG8_WAIT_V(8); PG8_WAIT_L(0); PG8_BAR; PG8_MMA(1, 0, At, B0); PG8_MMA(1, 1, At, B1); PG8_BAR; PG8_SCHED;
            PG8_LDB(B0, 1, 0); PG8_LDB(B1, 1, 1); PG8_SCHED; PG8_LDA(At, 1, 0); PG8_STAGE(PG8_SA(0, 1), a2 + hstepA, voffA);
            PG8_WAIT_V(8); PG8_WAIT_L(0); PG8_BAR; PG8_MMA(0, 0, At, B0); PG8_MMA(0, 1, At, B1); PG8_BAR; PG8_SCHED;
            PG8_LDA(At, 1, 1); PG8_STAGE(PG8_SB(1, 0), b3, voffB); PG8_STAGE(PG8_SB(1, 1), b3 + hstepB, voffB); PG8_STAGE(PG8_SA(1, 0), a3, voffA);
            PG8_WAIT_V(8); PG8_WAIT_L(0); PG8_BAR; PG8_MMA(1, 0, At, B0); PG8_MMA(1, 1, At, B1); PG8_BAR; PG8_SCHED;
        }
        if constexpr (ALIGN) { if (wr == 0) PG8_BAR; }
        E(acc, cur, wr, wc, fr, fq);
        if (!has_next) break;
#pragma unroll
        for (int a = 0; a < 2; ++a)
#pragma unroll
            for (int b = 0; b < 2; ++b)
#pragma unroll
                for (int m = 0; m < 4; ++m)
#pragma unroll
                    for (int n = 0; n < 2; ++n) acc[a][b][m][n] = (f32x4){0.f, 0.f, 0.f, 0.f};
        cur = nxt; cA = nA; cB = nB; ++ui;
        if constexpr (ALIGN) { if (wr == 1) PG8_BAR; }
    }
    PG8_WAIT_V(0);
    if constexpr (!ALIGN) { if (wr == 0) PG8_BAR; }
    PG8_BAR;
#undef PG8_SA
#undef PG8_SB
#undef PG8_STAGE
#undef PG8_LDA
#undef PG8_LDB
#undef PG8_MMA
#undef PG8_WAIT_V
#undef PG8_WAIT_L
#undef PG8_BAR
#undef PG8_SCHED
}
}


struct EpiProjE {
    static constexpr bool PERM = true;
    bf16 *UG, *PB, *QB, *KB, *VB; float* KMP;
    __device__ __forceinline__ void operator()(const f32x4 (&acc)[2][2][4][2], const pg8::Unit& u, int wr, int wc, int fr_, int fq_) const {
        const int ln_ = lane_id(), fr = ln_ & 15, fq = ln_ >> 4; (void)fr_; (void)fq_;
        const int pn = u.pn, row0 = u.pm * 256 + wr * 64 + fr, cl = wc * 32 + 8 * fq;
        if (pn == 0) {
#pragma unroll
            for (int ai = 0; ai < 2; ++ai)
#pragma unroll
                for (int m = 0; m < 4; ++m) { const int r = row0 + ai * 128 + m * 16;
#pragma unroll
                    for (int bj = 0; bj < 2; ++bj) { const int ch = bj * 128 + cl, g = ch >> 4, h0 = ch & 15;
                        const f32x4 v0 = acc[ai][bj][m][0], v1 = acc[ai][bj][m][1]; u32x4 w;
                        w.x = pg8::cvt_pk_bf16(v0[0], v0[1]); w.y = pg8::cvt_pk_bf16(v0[2], v0[3]); w.z = pg8::cvt_pk_bf16(v1[0], v1[1]); w.w = pg8::cvt_pk_bf16(v1[2], v1[3]);
                        *(u32x4*)(UG + ((size_t)(g * 512 + (r >> 6))) * UGP + (r & 63) * 16 + h0) = w; } }
        } else {
            bf16* base; int ldc, colt; float sc = 1.f;
            if (pn == 1) { base = PB; ldc = 256; colt = 0; }
            else if (pn < 4) { base = QB; ldc = 512; colt = (pn - 2) * 256; sc = C2; }
            else if (pn < 6) { base = KB; ldc = 512; colt = (pn - 4) * 256; }
            else { base = VB; ldc = 512; colt = (pn - 6) * 256; }
#pragma unroll
            for (int ai = 0; ai < 2; ++ai)
#pragma unroll
                for (int m = 0; m < 4; ++m) { bf16* rowp = base + (size_t)(row0 + ai * 128 + m * 16) * ldc + colt + cl;
#pragma unroll
                    for (int bj = 0; bj < 2; ++bj) { const f32x4 v0 = acc[ai][bj][m][0] * sc, v1 = acc[ai][bj][m][1] * sc; u32x4 w;
                        w.x = pg8::cvt_pk_bf16(v0[0], v0[1]); w.y = pg8::cvt_pk_bf16(v0[2], v0[3]); w.z = pg8::cvt_pk_bf16(v1[0], v1[1]); w.w = pg8::cvt_pk_bf16(v1[2], v1[3]);
                        *(u32x4*)(rowp + bj * 128) = w; } }
            if (pn >= 4 && pn < 6) {
#pragma unroll
                for (int bj = 0; bj < 2; ++bj)
#pragma unroll
                    for (int n = 0; n < 2; ++n) { f32x4 s = (f32x4){0.f, 0.f, 0.f, 0.f};
#pragma unroll
                        for (int ai = 0; ai < 2; ++ai)
#pragma unroll
                            for (int m = 0; m < 4; ++m) s += acc[ai][bj][m][n];
#pragma unroll
                        for (int i = 0; i < 4; ++i) { float t = s[i]; t += xshfl<1>(t); t += xshfl<2>(t); t += xshfl<4>(t); t += xshfl<8>(t); s[i] = t; }
                        if (fr == 0) *(f32x4*)(KMP + (size_t)wr * 128 * 512 + (size_t)u.pm * 512 + colt + bj * 128 + cl + 4 * n) = s; }
            }
        }
    }
};
struct EpiOutE {
    static constexpr bool PERM = false;
    const float* xin; float* R;
    __device__ __forceinline__ void operator()(const f32x4 (&acc)[2][2][4][2], const pg8::Unit& u, int wr, int wc, int fr_, int fq_) const {
        const int ln_ = lane_id(), fr = ln_ & 15, fq = ln_ >> 4; (void)fr_; (void)fq_;
        const int row0 = u.pm * 256 + wr * 64 + fr, col0 = u.pn * 256 + wc * 32 + 4 * fq;
#pragma unroll
        for (int ai = 0; ai < 2; ++ai)
#pragma unroll
            for (int m = 0; m < 4; ++m) { const size_t off = (size_t)(row0 + ai * 128 + m * 16) * D + col0;
#pragma unroll
                for (int bj = 0; bj < 2; ++bj)
#pragma unroll
                    for (int n = 0; n < 2; ++n) { const size_t o = off + bj * 128 + n * 16; *(f32x4*)(R + o) = *(const f32x4*)(xin + o) + acc[ai][bj][m][n]; }
                if (m & 1) asm volatile("" ::: "memory"); }
    }
};

__device__ __forceinline__ void transpose_item(const float* W, int K, int N, const float* kscale, bf16* WT, int ldo, int koff, int rowmode, LAS float* scr, int item, int lane) {
    const int nblk = N / 32, kb = item / nblk, nb = item % nblk, k0 = 64 * kb, n0 = 32 * nb;
#pragma unroll 8
    for (int i = 0; i < 32; ++i) { const int kk = 2 * i + (lane >> 5); const float s = kscale ? kscale[k0 + kk] : 1.f; scr[kk * 33 + (lane & 31)] = W[(size_t)(k0 + kk) * N + n0 + (lane & 31)] * s; }
    asm volatile("s_waitcnt lgkmcnt(0)" ::: "memory");
    const int c = lane & 7;
#pragma unroll
    for (int j = 0; j < 4; ++j) { const int n = (lane >> 3) + 8 * j; const LAS float* s = scr + (8 * c) * 33 + n;
        u32x4 o; o.x = pk2(s[0 * 33], s[1 * 33]); o.y = pk2(s[2 * 33], s[3 * 33]); o.z = pk2(s[4 * 33], s[5 * 33]); o.w = pk2(s[6 * 33], s[7 * 33]);
        const int nn = n0 + n, row = rowmode == 0 ? nn : (8 * (nn >> 2) + (nn & 3) + (rowmode == 2 ? 4 : 0));
        *(u32x4*)(WT + (size_t)row * ldo + koff + k0 + 8 * c) = o; }
    asm volatile("s_waitcnt lgkmcnt(0)" ::: "memory");
}
__device__ __forceinline__ void pair_decode(int pi, int& ea, int& eb) { ea = pi < 3 ? 0 : (pi < 5 ? 1 : 2); eb = pi < 3 ? pi + 1 : (pi < 5 ? pi - 1 : 3); }
__device__ __forceinline__ void ph_prologue(const Ctx& F0) {
    const Ctx F = launder(F0);
    LAS float* scr = (LAS float*)(F.lds + F.wave * 16384);
    const int gw = F.vcu * NWAVES + F.wave, NGW = F.G * NWAVES;
    constexpr int I_IN = (D / 64) * (NPROJ / 32), I_OUT = (D / 64) * (D / 32), I_GU1 = (D / 64) * (256 / 32), I_GU = 16 * 2 * I_GU1, I_WD1 = (256 / 64) * (D / 32), I_WD = 24 * 2 * I_WD1;
    constexpr int I_L = I_IN + I_OUT + I_GU + I_WD;
    for (int it = gw; it < DEPTH * I_L; it += NGW) {
        const int l = it / I_L; int r = it % I_L;
        if (r < I_IN) { transpose_item(F.in[3] + (size_t)l * D * NPROJ, D, NPROJ, F.in[2] + l * D, (bf16*)(F.ws + WS_WIN) + (size_t)l * NPROJ * D, D, 0, 0, scr, r, F.lane); continue; } r -= I_IN;
        if (r < I_OUT) { transpose_item(F.in[17] + (size_t)l * D * D, D, D, nullptr, (bf16*)(F.ws + WS_WOUT) + (size_t)l * D * D, D, 0, 0, scr, r, F.lane); continue; } r -= I_OUT;
        if (r < I_GU) { const int e = r / (2 * I_GU1), up = (r / I_GU1) & 1, item = r % I_GU1;
            transpose_item(F.in[up ? 24 : 23] + ((size_t)l * 16 + e) * D * 256, D, 256, F.in[18] + l * D, (bf16*)(F.ws + WS_GU) + ((size_t)l * 16 + e) * 512 * D, D, 0, 1 + up, scr, item, F.lane); continue; } r -= I_GU;
        { const int bk = r / (2 * I_WD1), half = (r / I_WD1) & 1, item = r % I_WD1, g = bk / 6; int ea, eb; pair_decode(bk % 6, ea, eb); const int e = g * 4 + (half ? eb : ea);
            transpose_item(F.in[25] + ((size_t)l * 16 + e) * 256 * D, 256, D, nullptr, (bf16*)(F.ws + WS_WD) + ((size_t)l * 24 + bk) * D * 512, 512, half * 256, 0, scr, item, F.lane); }
    }
    for (int it = gw; it < DEPTH * 32; it += NGW) { const int l = it >> 5;
        transpose_item(F.in[12] + (size_t)l * 256 * 256, 256, 256, nullptr, (bf16*)(F.ws + WS_GLUT) + (size_t)l * 65536, 256, 0, 0, scr, it & 31, F.lane); }
    { const int gt = F.vcu * NTHREADS + F.tid, NGT = F.G * NTHREADS;
      for (int i = gt; i < DEPTH * 65536; i += NGT) { const int l = i >> 16, n = (i >> 8) & 255, k = i & 255;
          const float v = ((n >> 6) == (k >> 6)) ? F.in[14][(((size_t)l * 4 + (n >> 6)) * 64 + (k & 63)) * 64 + (n & 63)] : 0.f;
          ((bf16*)(F.ws + WS_POOLT))[i] = (bf16)f2bf(v); } }
    for (int it = gw; it < DEPTH * SGN * 65; it += NGW) {
        const int l = it / (SGN * 65), g = (it / 65) % SGN, tau = it % 65, p = F.lane;
        const float are = F.in[4][(l * SGN + g) * SP + p], aim = F.in[5][(l * SGN + g) * SP + p], dt = expf(F.in[6][l * SGN + g]);
        float sn, cs; sincosf(aim * dt, &sn, &cs); const float mg = expf(are * dt), lbr = mg * cs, lbi = mg * sn;
        const float nr = lbr - 1.f, ni = lbi, den = are * are + aim * aim, cr = (nr * are + ni * aim) / den, ci = (ni * are - nr * aim) / den;
        float sn2, cs2; sincosf(aim * dt * (float)tau, &sn2, &cs2); const float mg2 = expf(are * dt * (float)tau), lr = mg2 * cs2, li = mg2 * sn2;
        float wr[16], wi[16];
#pragma unroll
        for (int h = 0; h < 16; ++h) { const float br = F.in[7][((size_t)(l * SGN + g) * SP + p) * SG + h], bi = F.in[8][((size_t)(l * SGN + g) * SP + p) * SG + h];
            const float bbr = cr * br - ci * bi, bbi = cr * bi + ci * br; wr[h] = lr * bbr - li * bbi; wi[h] = lr * bbi + li * bbr; }
        bf16* TG = (bf16*)(F.ws + WS_TG) + ((size_t)l * SGN + g) * 1024 * UGP;
        if (tau <= 63) {
            bf16* BZ = (bf16*)(F.ws + WS_BZ) + ((size_t)l * SGN + g) * 256 * 1024; const int s = 63 - tau;
            u32x4 o0, o1, o2, o3;
            o0.x = pk2(wr[0], wr[1]); o0.y = pk2(wr[2], wr[3]); o0.z = pk2(wr[4], wr[5]); o0.w = pk2(wr[6], wr[7]); o1.x = pk2(wr[8], wr[9]); o1.y = pk2(wr[10], wr[11]); o1.z = pk2(wr[12], wr[13]); o1.w = pk2(wr[14], wr[15]);
            o2.x = pk2(wi[0], wi[1]); o2.y = pk2(wi[2], wi[3]); o2.z = pk2(wi[4], wi[5]); o2.w = pk2(wi[6], wi[7]); o3.x = pk2(wi[8], wi[9]); o3.y = pk2(wi[10], wi[11]); o3.z = pk2(wi[12], wi[13]); o3.w = pk2(wi[14], wi[15]);
            *(u32x4*)(BZ + (size_t)p * 1024 + s * 16) = o0; *(u32x4*)(BZ + (size_t)p * 1024 + s * 16 + 8) = o1;
            *(u32x4*)(BZ + (size_t)(64 + p) * 1024 + s * 16) = o2; *(u32x4*)(BZ + (size_t)(64 + p) * 1024 + s * 16 + 8) = o3;
        }
#pragma unroll 1
        for (int ho = 0; ho < 16; ++ho) {
            const float ccr = F.in[9][((size_t)(l * SGN + g) * SG + ho) * SP + p], cci = F.in[10][((size_t)(l * SGN + g) * SG + ho) * SP + p];
            if (tau >= 1) { const int n = (tau - 1) * 16 + ho;
                TG[(size_t)n * UGP + 1024 + p] = (bf16)f2bf(ccr * lr - cci * li); TG[(size_t)n * UGP + 1088 + p] = (bf16)f2bf(-(ccr * li + cci * lr)); }
            if (tau <= 63) {
                float kv[16];
#pragma unroll
                for (int h = 0; h < 16; ++h) kv[h] = wave_sum(ccr * wr[h] - cci * wi[h]);
                u32x4 o0, o1; o0.x = pk2(kv[0], kv[1]); o0.y = pk2(kv[2], kv[3]); o0.z = pk2(kv[4], kv[5]); o0.w = pk2(kv[6], kv[7]); o1.x = pk2(kv[8], kv[9]); o1.y = pk2(kv[10], kv[11]); o1.z = pk2(kv[12], kv[13]); o1.w = pk2(kv[14], kv[15]);
                const int to = p;
                if (to >= tau) { bf16* d = TG + (size_t)(to * 16 + ho) * UGP + (to - tau) * 16; *(u32x4*)d = o0; *(u32x4*)(d + 8) = o1; }
                if (tau >= 1 && to + tau <= 63) { bf16* d = TG + (size_t)(to * 16 + ho) * UGP + (to + tau) * 16; const u32x4 z = (u32x4){0u, 0u, 0u, 0u}; *(u32x4*)d = z; *(u32x4*)(d + 8) = z; }
            }
        }
    }
}

__device__ __forceinline__ void route_token(float (&a)[20], float ssv, int m, int lane, const float* gb_, const float* rb_, int* tokb, float* tokr, float* tokw, LAS int* hist) {
        const float ssum = wave_sum(ssv);
#pragma unroll
        for (int j = 0; j < 20; ++j) a[j] = wave_sum(a[j]);
        const float rstd = 1.f / sqrtf(ssum * (1.f / D) + RMS_EPS);
        float lg0 = a[0] * rstd + gb_[0], lg1 = a[1] * rstd + gb_[1], lg2 = a[2] * rstd + gb_[2], lg3 = a[3] * rstd + gb_[3];
        int gs = 0; float gm = lg0;
        if (lg1 > gm) { gm = lg1; gs = 1; } if (lg2 > gm) { gm = lg2; gs = 2; } if (lg3 > gm) { gm = lg3; gs = 3; }
        const float gwt = 1.f / (__expf(lg0 - gm) + __expf(lg1 - gm) + __expf(lg2 - gm) + __expf(lg3 - gm));
        float q0 = a[4], q1 = a[5], q2 = a[6], q3 = a[7], q4 = a[8], q5 = a[9], q6 = a[10], q7 = a[11], q8 = a[12], q9 = a[13], q10 = a[14], q11 = a[15], q12 = a[16], q13 = a[17], q14 = a[18], q15 = a[19];
        asm volatile("" : "+v"(q0), "+v"(q1), "+v"(q2), "+v"(q3), "+v"(q4), "+v"(q5), "+v"(q6), "+v"(q7));
        asm volatile("" : "+v"(q8), "+v"(q9), "+v"(q10), "+v"(q11), "+v"(q12), "+v"(q13), "+v"(q14), "+v"(q15));
        float e0 = gs == 0 ? q0 : gs == 1 ? q4 : gs == 2 ? q8 : q12;
        float e1 = gs == 0 ? q1 : gs == 1 ? q5 : gs == 2 ? q9 : q13;
        float e2 = gs == 0 ? q2 : gs == 1 ? q6 : gs == 2 ? q10 : q14;
        float e3 = gs == 0 ? q3 : gs == 1 ? q7 : gs == 2 ? q11 : q15;
        e0 = e0 * rstd + rb_[gs * 4 + 0]; e1 = e1 * rstd + rb_[gs * 4 + 1]; e2 = e2 * rstd + rb_[gs * 4 + 2]; e3 = e3 * rstd + rb_[gs * 4 + 3];
        int t1 = 0; float v1 = e0;
        if (e1 > v1) { v1 = e1; t1 = 1; } if (e2 > v1) { v1 = e2; t1 = 2; } if (e3 > v1) { v1 = e3; t1 = 3; }
        int t2 = -1; float v2 = -3.0e38f;
        if (t1 != 0 && e0 > v2) { v2 = e0; t2 = 0; } if (t1 != 1 && e1 > v2) { v2 = e1; t2 = 1; } if (t1 != 2 && e2 > v2) { v2 = e2; t2 = 2; } if (t1 != 3 && e3 > v2) { v2 = e3; t2 = 3; }
        const float p2 = __expf(v2 - v1), w1 = gwt / (1.f + p2), w2 = gwt * p2 / (1.f + p2);
        const int lo = t1 < t2 ? t1 : t2, hi = t1 < t2 ? t2 : t1; const float wlo = t1 < t2 ? w1 : w2, whi = t1 < t2 ? w2 : w1;
        const int pi = lo == 0 ? hi - 1 : (lo == 1 ? hi + 1 : 5), bk = gs * 6 + pi;
        if (lane == 0) { tokb[m] = bk; tokr[m] = rstd; tokw[2 * m] = wlo; tokw[2 * m + 1] = whi; __hip_atomic_fetch_add(hist + bk, 1, __ATOMIC_RELAXED, __HIP_MEMORY_SCOPE_WORKGROUP); }
}
__device__ __forceinline__ void ph_route(const Ctx& F0, int l) {
    const Ctx F = launder(F0);
    LAS float* Wl = (LAS float*)F.lds;
    LAS int* hist = (LAS int*)(F.lds + 1024 * 20 * 4);
    const float* g2 = F.in[18] + l * D;
    const f32x4* gw4 = (const f32x4*)(F.in[19] + (size_t)l * D * 4); const f32x4* rw4 = (const f32x4*)(F.in[21] + (size_t)l * 4 * D * 4);
    const float* gb_ = F.in[20] + l * 4; const float* rb_ = F.in[22] + l * 16;
    for (int idx = F.tid; idx < D * 5; idx += NTHREADS) { const int k = idx % D, q = idx / D;
        f32x4 v = (q == 0) ? gw4[k] : rw4[(q - 1) * D + k]; v = v * g2[k];
        Wl[(q * 4 + 0) * D + k] = v[0]; Wl[(q * 4 + 1) * D + k] = v[1]; Wl[(q * 4 + 2) * D + k] = v[2]; Wl[(q * 4 + 3) * D + k] = v[3]; }
    if (F.tid < 32) hist[F.tid] = 0;
    __syncthreads();
    int* tokb = (int*)(F.ws + WS_TOKB); float* tokr = (float*)(F.ws + WS_TOKR); float* tokw = (float*)(F.ws + WS_TOKW);
#pragma unroll 1
    for (int i2 = 0; i2 < 16; i2 += 2) {
        const int m0 = F.vcu * 128 + F.wave * 16 + i2;
        const f32x4* xr = (const f32x4*)(F.R + (size_t)m0 * D) + F.lane;
        float a[2][20], ss[2];
#pragma unroll
        for (int t = 0; t < 2; ++t) { ss[t] = 0.f;
#pragma unroll
            for (int j = 0; j < 20; ++j) a[t][j] = 0.f; }
#pragma unroll 1
        for (int jj = 0; jj < 4; ++jj) { const f32x4 x0 = xr[64 * jj], x1 = xr[D / 4 + 64 * jj];
            ss[0] += (x0[0] * x0[0] + x0[1] * x0[1]) + (x0[2] * x0[2] + x0[3] * x0[3]); ss[1] += (x1[0] * x1[0] + x1[1] * x1[1]) + (x1[2] * x1[2] + x1[3] * x1[3]);
#pragma unroll
            for (int j = 0; j < 20; ++j) { const f32x4 w = *(const LAS f32x4*)(Wl + j * D + 256 * jj + 4 * F.lane);
                a[0][j] += (x0[0] * w[0] + x0[1] * w[1]) + (x0[2] * w[2] + x0[3] * w[3]); a[1][j] += (x1[0] * w[0] + x1[1] * w[1]) + (x1[2] * w[2] + x1[3] * w[3]); } }
        route_token(a[0], ss[0], m0, F.lane, gb_, rb_, tokb, tokr, tokw, hist);
        route_token(a[1], ss[1], m0 + 1, F.lane, gb_, rb_, tokb, tokr, tokw, hist);
    }
    __syncthreads();
    if (F.tid < 24) __hip_atomic_store((int*)(F.ws + WS_WGCNT) + F.vcu * 24 + F.tid, hist[F.tid], __ATOMIC_RELAXED, __HIP_MEMORY_SCOPE_AGENT);
}
__device__ __forceinline__ void ph_place(const Ctx& F0) {
    const Ctx F = launder(F0);
    LAS int* ptot = (LAS int*)F.lds;
    LAS int* pbef = ptot + 512;
    LAS int* bstart = pbef + 512;
    LAS int* btot = bstart + 32;
    LAS int* carry = btot + 32;
    LAS int* rowidx = carry + 32;
    const int* wgcnt = (const int*)(F.ws + WS_WGCNT);
    int* rowtok = (int*)(F.ws + WS_ROWTOK); float* roww = (float*)(F.ws + WS_ROWW); int* tileb = (int*)(F.ws + WS_TILEB);
    const int* tokb = (const int*)(F.ws + WS_TOKB); const float* tokr = (const float*)(F.ws + WS_TOKR); const float* tokw = (const float*)(F.ws + WS_TOKW);
    { const int p = F.tid >> 5, b = F.tid & 31; int tot = 0, bef = 0;
      if (b < 24) for (int v = p * 16; v < p * 16 + 16; ++v) { const int c = wgcnt[v * 24 + b]; tot += c; if (v < F.vcu) bef += c; }
      ptot[p * 32 + b] = tot; pbef[p * 32 + b] = bef; }
    __syncthreads();
    if (F.tid < 32) { int tot = 0, bef = 0; for (int p = 0; p < 16; ++p) { tot += ptot[p * 32 + F.tid]; bef += pbef[p * 32 + F.tid]; } btot[F.tid] = tot; carry[F.tid] = bef; }
    __syncthreads();
    if (F.tid == 0) { int s = 0; for (int b = 0; b < 24; ++b) { bstart[b] = s; s += (btot[b] + 255) & ~255; } bstart[24] = s; }
    __syncthreads();
    if (F.tid < 24) carry[F.tid] += bstart[F.tid];
    if (F.vcu == 0) {
        if (F.tid == 0) tileb[0] = bstart[24] >> 8;
        for (int b = 0; b < 24; ++b) { const int s = bstart[b], e = bstart[b + 1];
            for (int t = (s >> 8) + F.tid; t < (e >> 8); t += NTHREADS) tileb[1 + t] = b;
            for (int r = s + btot[b] + F.tid; r < e; r += NTHREADS) __hip_atomic_store(rowtok + r, -1, __ATOMIC_RELAXED, __HIP_MEMORY_SCOPE_AGENT); }
    }
    __syncthreads();
    if (F.wave == 0) {
        for (int pass = 0; pass < 2; ++pass) { const int i = pass * 64 + F.lane, bi = tokb[F.vcu * 128 + i]; int row = 0;
#pragma unroll 1
            for (int b = 0; b < 24; ++b) { const unsigned long long mask = __ballot(bi == b); const int c = carry[b];
                if (bi == b) row = c + __builtin_popcountll(mask & ((1ull << F.lane) - 1ull));
                asm volatile("s_waitcnt lgkmcnt(0)" ::: "memory");
                if (F.lane == 0) carry[b] = c + __builtin_popcountll(mask);
                asm volatile("s_waitcnt lgkmcnt(0)" ::: "memory"); }
            rowidx[i] = row; }
    }
    __syncthreads();
    bf16* XS = (bf16*)(F.ws + WS_XS);
    for (int i = 0; i < 16; ++i) {
        const int li = F.wave * 16 + i, m = F.vcu * 128 + li, row = rowidx[li]; const float rstd = tokr[m];
        if (F.lane == 0) {
            __hip_atomic_store(rowtok + row, m, __ATOMIC_RELAXED, __HIP_MEMORY_SCOPE_AGENT);
            const unsigned long long w2 = (unsigned long long)__builtin_bit_cast(unsigned, tokw[2 * m]) | ((unsigned long long)__builtin_bit_cast(unsigned, tokw[2 * m + 1]) << 32);
            __hip_atomic_store((unsigned long long*)(roww + 2 * row), w2, __ATOMIC_RELAXED, __HIP_MEMORY_SCOPE_AGENT); }
        const f32x4* xr = (const f32x4*)(F.R + (size_t)m * D) + F.lane;
        unsigned long long* o8 = (unsigned long long*)(XS + (size_t)row * D) + F.lane;
#pragma unroll
        for (int j = 0; j < 4; ++j) { const f32x4 v = xr[64 * j] * rstd; o8[64 * j] = (unsigned long long)pk2(v.x, v.y) | ((unsigned long long)pk2(v.z, v.w) << 32); }
    }
}
struct MoeOrder {
    const int* tileb; int G, c; bool down;
    __device__ __forceinline__ bool next(int i, pg8::Unit& u) const {
        const GAS int* tb_ = (const GAS int*)tileb;
        const int NT = __builtin_amdgcn_readfirstlane(tb_[0]), L = i * G + c; if (L >= NT * 4) return false;
        const int rt = L >> 2, pn = L & 3, b = __builtin_amdgcn_readfirstlane(tb_[1 + rt]);
        if (down) { u.pm = rt; u.pn = b * 4 + pn; u.aux = pn; }
        else { int ea, eb; pair_decode(b % 6, ea, eb); const int e = (b / 6) * 4 + (pn < 2 ? ea : eb); u.pm = rt; u.pn = e * 2 + (pn & 1); u.aux = pn; }
        return true;
    }
};
struct EpiGU {
    static constexpr bool PERM = true;
    bf16* H; const float* roww;
    __device__ __forceinline__ void operator()(const f32x4 (&acc)[2][2][4][2], const pg8::Unit& u, int wr, int wc, int fr_, int fq_) const {
        const int ln_ = lane_id(), fr = ln_ & 15, fq = ln_ >> 4; (void)fr_; (void)fq_;
        const int row0 = u.pm * 256 + wr * 64 + fr, cl = u.aux * 128 + 16 * wc + 4 * fq, ws = u.aux >> 1;
#pragma unroll
        for (int ai = 0; ai < 2; ++ai)
#pragma unroll
            for (int m = 0; m < 4; ++m) { const int r = row0 + ai * 128 + m * 16; const float w = roww[2 * r + ws];
#pragma unroll
                for (int bj = 0; bj < 2; ++bj) { const f32x4 g = acc[ai][bj][m][0], up = acc[ai][bj][m][1]; f32x4 a;
#pragma unroll
                    for (int i = 0; i < 4; ++i) a[i] = g[i] * sigmoidf_(g[i]) * up[i] * w;
                    u32x2 o; o.x = pg8::cvt_pk_bf16(a[0], a[1]); o.y = pg8::cvt_pk_bf16(a[2], a[3]);
                    *(u32x2*)(H + (size_t)r * 512 + cl + bj * 64) = o; } }
    }
};
struct EpiDown {
    static constexpr bool PERM = false;
    float* R; const int* rowtok;
    __device__ __forceinline__ void operator()(const f32x4 (&acc)[2][2][4][2], const pg8::Unit& u, int wr, int wc, int fr_, int fq_) const {
        const int ln_ = lane_id(), fr = ln_ & 15, fq = ln_ >> 4; (void)fr_; (void)fq_;
        const int row0 = u.pm * 256 + wr * 64 + fr, col0 = u.aux * 256 + wc * 32 + 4 * fq;
#pragma unroll
        for (int ai = 0; ai < 2; ++ai)
#pragma unroll
            for (int m = 0; m < 4; ++m) { const int tok = rowtok[row0 + ai * 128 + m * 16];
                if (tok >= 0) { float* rp = R + (size_t)tok * D + col0;
#pragma unroll
                    for (int bj = 0; bj < 2; ++bj)
#pragma unroll
                        for (int n = 0; n < 2; ++n) { float* p = rp + bj * 128 + n * 16; *(f32x4*)p = *(const f32x4*)p + acc[ai][bj][m][n]; } }
                if (m & 1) asm volatile("" ::: "memory"); }
    }
};

struct SsmOrder { int G, c, mode;
    __device__ __forceinline__ bool next(int i, pg8::Unit& u) const { const int L = i * G + c;
        if (mode == 1) { if (L >= 32) return false; u.pm = L; u.pn = L >> 1; u.aux = 0; return true; }
        if (L >= 128) return false; const int g = L >> 3; u.pm = g * 2 + ((L >> 2) & 1); u.pn = g * 4 + (L & 3); u.aux = L & 3; return true; } };
struct HalfOrder { int L;
    __device__ __forceinline__ bool next(int i, pg8::Unit& u) const { if (i > 0 || L < 0 || L >= 128) return false; u.pm = L; u.pn = 0; u.aux = 0; return true; } };
struct EpiZ { static constexpr bool PERM = false; float* ZB;
    __device__ __forceinline__ void operator()(const f32x4 (&acc)[2][2][4][2], const pg8::Unit& u, int wr, int wc, int fr_, int fq_) const {
        const int ln_ = lane_id(), fr = ln_ & 15, fq = ln_ >> 4; (void)fr_; (void)fq_;
        const int row0 = u.pm * 256 + wr * 64 + fr, col0 = wc * 32 + 4 * fq;
#pragma unroll
        for (int ai = 0; ai < 2; ++ai)
#pragma unroll
            for (int m = 0; m < 4; ++m)
#pragma unroll
                for (int n = 0; n < 2; ++n) *(f32x4*)(ZB + (size_t)(row0 + ai * 128 + m * 16) * 128 + col0 + n * 16) = acc[ai][0][m][n];
    } };
struct EpiSsm2 { static constexpr bool PERM = true; const bf16* UG; bf16* YS; const float* dvec;
    __device__ __forceinline__ void operator()(const f32x4 (&acc)[2][2][4][2], const pg8::Unit& u, int wr, int wc, int fr_, int fq_) const {
        const int ln_ = lane_id(), fr = ln_ & 15, fq = ln_ >> 4; (void)fr_; (void)fq_;
        const int g = u.pm >> 1, cr0 = (u.pm & 1) * 256 + wr * 64 + fr;
#pragma unroll
        for (int bj = 0; bj < 2; ++bj) { const int n0 = u.aux * 256 + bj * 128 + wc * 32 + 8 * fq, to = n0 >> 4, ho0 = n0 & 15;
            const f32x4 d0 = *(const f32x4*)(dvec + g * 16 + ho0), d1 = *(const f32x4*)(dvec + g * 16 + ho0 + 4);
#pragma unroll
            for (int ai = 0; ai < 2; ++ai)
#pragma unroll
                for (int m = 0; m < 4; ++m) { const int cr = cr0 + ai * 128 + m * 16;
                    const u32x4 uu = *(const u32x4*)(UG + ((size_t)(g * 512 + cr)) * UGP + n0);
                    const f32x4 a0 = acc[ai][bj][m][0], a1 = acc[ai][bj][m][1]; float y[8];
                    y[0] = gelu_tanh(a0[0] + d0[0] * bf2f(uu.x & 0xffffu)); y[1] = gelu_tanh(a0[1] + d0[1] * bf2f(uu.x >> 16));
                    y[2] = gelu_tanh(a0[2] + d0[2] * bf2f(uu.y & 0xffffu)); y[3] = gelu_tanh(a0[3] + d0[3] * bf2f(uu.y >> 16));
                    y[4] = gelu_tanh(a1[0] + d1[0] * bf2f(uu.z & 0xffffu)); y[5] = gelu_tanh(a1[1] + d1[1] * bf2f(uu.z >> 16));
                    y[6] = gelu_tanh(a1[2] + d1[2] * bf2f(uu.w & 0xffffu)); y[7] = gelu_tanh(a1[3] + d1[3] * bf2f(uu.w >> 16));
                    u32x4 w; w.x = pg8::cvt_pk_bf16(y[0], y[1]); w.y = pg8::cvt_pk_bf16(y[2], y[3]); w.z = pg8::cvt_pk_bf16(y[4], y[5]); w.w = pg8::cvt_pk_bf16(y[6], y[7]);
                    *(u32x4*)(YS + ((size_t)cr * 64 + to) * 256 + g * 16 + ho0) = w; } }
    } };
struct EpiGluE { static constexpr bool PERM = true; const bf16* YS; bf16* YMIX; const float* gb;
    __device__ __forceinline__ void operator()(const f32x4 (&acc)[2][2][4][2], const pg8::Unit& u, int wr, int wc, int fr_, int fq_) const {
        const int ln_ = lane_id(), fr = ln_ & 15, fq = ln_ >> 4; (void)fr_; (void)fq_;
        const int row0 = u.pm * 256 + wr * 64 + fr;
#pragma unroll
        for (int bj = 0; bj < 2; ++bj) { const int n0 = bj * 128 + wc * 32 + 8 * fq; const f32x4 b0 = *(const f32x4*)(gb + n0), b1 = *(const f32x4*)(gb + n0 + 4);
#pragma unroll
            for (int ai = 0; ai < 2; ++ai)
#pragma unroll
                for (int m = 0; m < 4; ++m) { const size_t r = (size_t)(row0 + ai * 128 + m * 16); const u32x4 yy = *(const u32x4*)(YS + r * 256 + n0);
                    const f32x4 a0 = acc[ai][bj][m][0] + b0, a1 = acc[ai][bj][m][1] + b1; float o[8];
                    o[0] = bf2f(yy.x & 0xffffu) * sigmoidf_(a0[0]); o[1] = bf2f(yy.x >> 16) * sigmoidf_(a0[1]); o[2] = bf2f(yy.y & 0xffffu) * sigmoidf_(a0[2]); o[3] = bf2f(yy.y >> 16) * sigmoidf_(a0[3]);
                    o[4] = bf2f(yy.z & 0xffffu) * sigmoidf_(a1[0]); o[5] = bf2f(yy.z >> 16) * sigmoidf_(a1[1]); o[6] = bf2f(yy.w & 0xffffu) * sigmoidf_(a1[2]); o[7] = bf2f(yy.w >> 16) * sigmoidf_(a1[3]);
                    u32x4 w; w.x = pg8::cvt_pk_bf16(o[0], o[1]); w.y = pg8::cvt_pk_bf16(o[2], o[3]); w.z = pg8::cvt_pk_bf16(o[4], o[5]); w.w = pg8::cvt_pk_bf16(o[6], o[7]);
                    *(u32x4*)(YMIX + r * 1024 + n0) = w; } }
    } };
struct EpiPoolE { static constexpr bool PERM = true; bf16* YMIX; const float* pb; const float* ps;
    __device__ __forceinline__ void operator()(const f32x4 (&acc)[2][2][4][2], const pg8::Unit& u, int wr, int wc, int fr_, int fq_) const {
        const int ln_ = lane_id(), fr = ln_ & 15, fq = ln_ >> 4; (void)fr_; (void)fq_;
        const int row0 = u.pm * 256 + wr * 64 + fr;
#pragma unroll
        for (int bj = 0; bj < 2; ++bj) { const int n0 = bj * 128 + wc * 32 + 8 * fq; const f32x4 b0 = *(const f32x4*)(pb + n0), b1 = *(const f32x4*)(pb + n0 + 4), s0 = *(const f32x4*)(ps + n0), s1 = *(const f32x4*)(ps + n0 + 4);
#pragma unroll
            for (int ai = 0; ai < 2; ++ai)
#pragma unroll
                for (int m = 0; m < 4; ++m) { const size_t r = (size_t)(row0 + ai * 128 + m * 16);
                    const f32x4 a0 = (acc[ai][bj][m][0] + b0) * s0, a1 = (acc[ai][bj][m][1] + b1) * s1;
                    u32x4 w; w.x = pg8::cvt_pk_bf16(a0[0], a0[1]); w.y = pg8::cvt_pk_bf16(a0[2], a0[3]); w.z = pg8::cvt_pk_bf16(a1[0], a1[1]); w.w = pg8::cvt_pk_bf16(a1[2], a1[3]);
                    *(u32x4*)(YMIX + r * 1024 + 256 + n0) = w; } }
    } };
__device__ __forceinline__ void ph_ssm_scan(const Ctx& F0, int l) {
    const Ctx F = launder(F0);
    for (int it = F.vcu + F.G * F.wave; it < SGN * NB; it += F.G * NWAVES) {
        const int g = it >> 3, b = it & 7, p = F.lane;
        const float are = F.in[4][(l * SGN + g) * SP + p], aim = F.in[5][(l * SGN + g) * SP + p], dt = expf(F.in[6][l * SGN + g]);
        float sn, cs; sincosf(aim * dt * 64.f, &sn, &cs); const float mg = expf(are * dt * 64.f), lr = mg * cs, li = mg * sn;
        const float* Z = (const float*)(F.ws + WS_ZB) + ((size_t)g * 512 + b * 64) * 128;
        bf16* U = P_UG(F) + ((size_t)g * 512 + b * 64) * UGP + 1024;
        float sr = 0.f, si = 0.f;
#pragma unroll 1
        for (int c0 = 0; c0 < 64; c0 += 16) {
            float zr[16], zi[16];
#pragma unroll
            for (int j = 0; j < 16; ++j) { zr[j] = Z[(c0 + j) * 128 + p]; zi[j] = Z[(c0 + j) * 128 + 64 + p]; }
#pragma unroll
            for (int j = 0; j < 16; ++j) {
                U[(size_t)(c0 + j) * UGP + p] = (bf16)f2bf(sr); U[(size_t)(c0 + j) * UGP + 64 + p] = (bf16)f2bf(si);
                const float nr = lr * sr - li * si + zr[j], ni = lr * si + li * sr + zi[j]; sr = nr; si = ni; }
        }
    }
}

namespace moba {
using bf16x8 = __attribute__((ext_vector_type(8))) short;
using s16x4 = __attribute__((ext_vector_type(4))) short;
using f32x16 = __attribute__((ext_vector_type(16))) float;
typedef short v4i16_t __attribute__((ext_vector_type(4)));
typedef float f32x2_t __attribute__((ext_vector_type(2))); typedef __bf16 bf16x2_t __attribute__((ext_vector_type(2)));
constexpr int L_K = 0, L_V = 32768, L_TB = 65536, L_KM = L_TB + 768 * 4, L_END = L_KM + 16 * 64 * 4;
__device__ __forceinline__ unsigned cvtpk(float lo, float hi) { f32x2_t v = {lo, hi}; bf16x2_t b = __builtin_convertvector(v, bf16x2_t); return __builtin_bit_cast(unsigned, b); }
__device__ __forceinline__ s16x4 vtr(const LAS char* p) { return __builtin_bit_cast(s16x4, __builtin_amdgcn_ds_read_tr16_b64_v4i16((LAS v4i16_t*)p)); }
__device__ __forceinline__ float hmax(float v) { const unsigned u = __builtin_bit_cast(unsigned, v); auto r = __builtin_amdgcn_permlane32_swap(u, u, false, false); return fmaxf(__builtin_bit_cast(float, (unsigned)r[0]), __builtin_bit_cast(float, (unsigned)r[1])); }
__device__ __forceinline__ float hsum(float v) { const unsigned u = __builtin_bit_cast(unsigned, v); auto r = __builtin_amdgcn_permlane32_swap(u, u, false, false); return __builtin_bit_cast(float, (unsigned)r[0]) + __builtin_bit_cast(float, (unsigned)r[1]); }

__device__ __forceinline__ void unit(int wave_, int b, int h, int qb, const bf16* Q, const bf16* K, const bf16* V, bf16* O, const float* KMP, const float* BT, LAS char* lds) {
    int lane_ = lane_id(); asm volatile("" : "+v"(lane_)); asm volatile("" : "+s"(b), "+s"(h), "+s"(qb), "+s"(wave_));
    const int wid = wave_, lane = lane_, tid = wid * 64 + lane, r32 = lane & 31, hi = lane >> 5;
    const int NT = 4 * qb + 4, q0 = qb * 256; const size_t rowbase = (size_t)b * SEQ;
    LAS float* tb = (LAS float*)(lds + L_TB); LAS float* km = (LAS float*)(lds + L_KM);
    const float bfar = BT[h * 132 + 128];
    for (int i = tid; i < 768; i += NTHREADS) { const int rel = i - 256; tb[i] = rel < 0 ? -1.0e30f : (rel < 128 ? BT[h * 132 + rel] - bfar : 0.f); }
    for (int i = tid; i < 16 * 64; i += NTHREADS) { const int j = i >> 6, d = i & 63, pm = b * 16 + j; km[i] = KMP[pm * 512 + h * 64 + d] + KMP[128 * 512 + pm * 512 + h * 64 + d]; }
    const bf16* ksrc = K + (rowbase + lane) * 512 + h * 64 + wid * 8;
    const bf16* vsrc = V + (rowbase + 16 * (wid & 3) + (lane >> 2)) * 512 + h * 64 + (wid >> 2) * 32 + (lane & 3) * 8;
    u32x4 kreg0 = *(const u32x4*)ksrc, vreg0 = *(const u32x4*)vsrc, kreg1 = *(const u32x4*)(ksrc + (size_t)64 * 512), vreg1 = *(const u32x4*)(vsrc + (size_t)64 * 512);
    bf16x8 qr[4];
    { const bf16* qw = Q + (rowbase + q0 + wid * 32 + r32) * 512 + h * 64 + hi * 8;
#pragma unroll
      for (int d0 = 0; d0 < 4; ++d0) qr[d0] = *(const bf16x8*)(qw + d0 * 16); }
    __syncthreads();
    unsigned selmask = 1u << qb;
    { float g[16];
#pragma unroll
      for (int j = 0; j < 16; ++j) g[j] = 0.f;
#pragma unroll
      for (int d0 = 0; d0 < 4; ++d0)
#pragma unroll
          for (int e = 0; e < 8; ++e) { const float qf = bf2f((unsigned)(unsigned short)qr[d0][e]);
#pragma unroll
              for (int j = 0; j < 16; ++j) g[j] += qf * km[j * 64 + d0 * 16 + hi * 8 + e]; }
#pragma unroll
      for (int j = 0; j < 16; ++j) g[j] = hsum(g[j]);
#pragma unroll
      for (int s = 0; s < 3; ++s) { float bv = -3.0e38f; int bi = -1;
#pragma unroll
          for (int j = 0; j < 16; ++j) { const bool ok = (j < qb) && !((selmask >> j) & 1u) && (g[j] > bv); bv = ok ? g[j] : bv; bi = ok ? j : bi; }
          if (bi >= 0) selmask |= 1u << bi; } }
    { LAS char* kd = lds + L_K + wid * 1024 + lane * 16; LAS char* vd = lds + L_V + wid * 1024 + lane * 16;
      *(LAS u32x4*)kd = kreg0; *(LAS u32x4*)vd = vreg0; *(LAS u32x4*)(kd + 8192) = kreg1; *(LAS u32x4*)(vd + 8192) = vreg1; }
    __syncthreads();
    const int qrel = wid * 32 + r32;
    const LAS char* kp0 = lds + L_K + hi * 1024 + r32 * 16;
    const LAS char* vp0 = lds + L_V + ((lane >> 4) & 1) * 32 + (lane & 3) * 8 + (4 * hi + ((lane & 15) >> 2)) * 64;
    float mref = 0.f, l = 0.f; f32x16 o0 = f32x16{}, o1 = f32x16{}; f32x16 cvec; bool newc = true;
    if (__builtin_amdgcn_readfirstlane(wid) >= 4) __builtin_amdgcn_s_setprio(1);
#define MOBA_QK(P0, P1, KB) do { { const bf16x8 a0 = *(const LAS bf16x8*)(kp0 + (KB)), a1 = *(const LAS bf16x8*)(kp0 + (KB) + 512); \
          P0 = __builtin_amdgcn_mfma_f32_32x32x16_bf16(a0, qr[0], cvec, 0, 0, 0); P1 = __builtin_amdgcn_mfma_f32_32x32x16_bf16(a1, qr[0], cvec, 0, 0, 0); } \
        _Pragma("unroll") for (int d0 = 1; d0 < 4; ++d0) { const bf16x8 a0 = *(const LAS bf16x8*)(kp0 + (KB) + d0 * 2048), a1 = *(const LAS bf16x8*)(kp0 + (KB) + d0 * 2048 + 512); \
            P0 = __builtin_amdgcn_mfma_f32_32x32x16_bf16(a0, qr[d0], P0, 0, 0, 0); P1 = __builtin_amdgcn_mfma_f32_32x32x16_bf16(a1, qr[d0], P1, 0, 0, 0); } } while (0)
#define MOBA_NEAR(P0, P1, TT) do { const int jn_ = (TT) - (NT - 8); if (jn_ >= 0) { const LAS float* t0 = tb + (qrel - 64 * (jn_ - 4) - 4 * hi + 256); \
            _Pragma("unroll") for (int r = 0; r < 16; ++r) { const int k = (r & 3) + 8 * (r >> 2); P0[r] += t0[-k]; P1[r] += t0[-k - 32]; } } } while (0)
#define MOBA_MAX(P0, P1, OUT) do { float ra = __builtin_fmaxf(__builtin_fmaxf(P0[0], P0[1]), P1[0]), rb = __builtin_fmaxf(__builtin_fmaxf(P0[2], P0[3]), P1[1]); \
        ra = __builtin_fmaxf(__builtin_fmaxf(ra, P1[2]), P1[3]); \
        _Pragma("unroll") for (int r = 4; r < 16; r += 4) { ra = __builtin_fmaxf(__builtin_fmaxf(ra, P0[r]), P0[r + 1]); rb = __builtin_fmaxf(__builtin_fmaxf(rb, P0[r + 2]), P0[r + 3]); \
            ra = __builtin_fmaxf(__builtin_fmaxf(ra, P1[r]), P1[r + 1]); rb = __builtin_fmaxf(__builtin_fmaxf(rb, P1[r + 2]), P1[r + 3]); } \
        OUT = __builtin_fmaxf(ra, rb); } while (0)
#define MOBA_VLD(VF, VB) do { const LAS char* vp = vp0 + (VB); \
        _Pragma("unroll") for (int k = 0; k < 4; ++k) { \
            const s16x4 lo0 = vtr(vp + k * 1024), hi0 = vtr(vp + k * 1024 + 512), lo1 = vtr(vp + 4096 + k * 1024), hi1 = vtr(vp + 4096 + k * 1024 + 512); \
            VF[2 * k] = (bf16x8){lo0[0], lo0[1], lo0[2], lo0[3], hi0[0], hi0[1], hi0[2], hi0[3]}; VF[2 * k + 1] = (bf16x8){lo1[0], lo1[1], lo1[2], lo1[3], hi1[0], hi1[1], hi1[2], hi1[3]}; } } while (0)
#define MOBA_PV(P0, P1, VF) do { u32x4 pw[4]; \
        _Pragma("unroll") for (int q = 0; q < 4; ++q) { pw[0][q] = cvtpk(P0[2 * q], P0[2 * q + 1]); pw[1][q] = cvtpk(P0[8 + 2 * q], P0[9 + 2 * q]); pw[2][q] = cvtpk(P1[2 * q], P1[2 * q + 1]); pw[3][q] = cvtpk(P1[8 + 2 * q], P1[9 + 2 * q]); } \
        _Pragma("unroll") for (int k = 0; k < 4; ++k) { const bf16x8 pa = __builtin_bit_cast(bf16x8, pw[k]); \
            o0 = __builtin_amdgcn_mfma_f32_32x32x16_bf16(VF[2 * k], pa, o0, 0, 0, 0); o1 = __builtin_amdgcn_mfma_f32_32x32x16_bf16(VF[2 * k + 1], pa, o1, 0, 0, 0); } } while (0)
#pragma unroll 1
    for (int t = 0; t < NT; t += 2) {
        const int half = ((t >> 1) & 1) * 16384;
        if (t + 2 < NT) { kreg0 = *(const u32x4*)(ksrc + (size_t)(t + 2) * 64 * 512); vreg0 = *(const u32x4*)(vsrc + (size_t)(t + 2) * 64 * 512);
                          kreg1 = *(const u32x4*)(ksrc + (size_t)(t + 3) * 64 * 512); vreg1 = *(const u32x4*)(vsrc + (size_t)(t + 3) * 64 * 512); }
        if (newc || (t & 3) == 0) { const float ci = ((selmask >> (t >> 2)) & 1u) ? (bfar - mref) : -1.0e30f;
#pragma unroll
            for (int r = 0; r < 16; ++r) cvec[r] = ci;
            newc = false; }
        f32x16 pa0, pa1, pb0, pb1;
        MOBA_QK(pa0, pa1, half); MOBA_QK(pb0, pb1, half + 8192);
        bf16x8 vfa[8], vfb[8];
        MOBA_VLD(vfa, half); __builtin_amdgcn_sched_barrier(0);
        MOBA_NEAR(pa0, pa1, t); MOBA_NEAR(pb0, pb1, t + 1);
        float rma, rmb; MOBA_MAX(pa0, pa1, rma); MOBA_MAX(pb0, pb1, rmb);
        const float rm = hmax(__builtin_fmaxf(rma, rmb));
        if (__any(rm > 8.f)) {
            const float dl = __builtin_fmaxf(rm, 0.f), alpha = __builtin_amdgcn_exp2f(-dl);
            mref += dl; l *= alpha; newc = true;
#pragma unroll
            for (int r = 0; r < 16; ++r) { pa0[r] -= dl; pa1[r] -= dl; pb0[r] -= dl; pb1[r] -= dl; o0[r] *= alpha; o1[r] *= alpha; } }
        float s0 = 0.f, s1 = 0.f;
#pragma unroll
        for (int r = 0; r < 16; ++r) { pa0[r] = __builtin_amdgcn_exp2f(pa0[r]); pa1[r] = __builtin_amdgcn_exp2f(pa1[r]); s0 += pa0[r]; s1 += pa1[r]; }
        MOBA_VLD(vfb, half + 8192); __builtin_amdgcn_sched_barrier(0);
        MOBA_PV(pa0, pa1, vfa);
#pragma unroll
        for (int r = 0; r < 16; ++r) { pb0[r] = __builtin_amdgcn_exp2f(pb0[r]); pb1[r] = __builtin_amdgcn_exp2f(pb1[r]); s0 += pb0[r]; s1 += pb1[r]; }
        l += s0 + s1;
        MOBA_PV(pb0, pb1, vfb);
        if (t + 2 < NT) { const int nh = 16384 - half; LAS char* kd = lds + L_K + nh + wid * 1024 + lane * 16; LAS char* vd = lds + L_V + nh + wid * 1024 + lane * 16;
            *(LAS u32x4*)kd = kreg0; *(LAS u32x4*)vd = vreg0; *(LAS u32x4*)(kd + 8192) = kreg1; *(LAS u32x4*)(vd + 8192) = vreg1; }
        __syncthreads();
    }
    __builtin_amdgcn_s_setprio(0);
#undef MOBA_QK
#undef MOBA_NEAR
#undef MOBA_MAX
#undef MOBA_PV
#undef MOBA_VLD
    const float inv = 1.f / hsum(l);
    bf16* orow = O + (rowbase + q0 + wid * 32 + r32) * 1024 + 512 + h * 64 + 4 * hi;
#pragma unroll
    for (int g = 0; g < 4; ++g) { u32x2 w0, w1;
        w0.x = cvtpk(o0[4 * g] * inv, o0[4 * g + 1] * inv); w0.y = cvtpk(o0[4 * g + 2] * inv, o0[4 * g + 3] * inv);
        w1.x = cvtpk(o1[4 * g] * inv, o1[4 * g + 1] * inv); w1.y = cvtpk(o1[4 * g + 2] * inv, o1[4 * g + 3] * inv);
        *(u32x2*)(orow + 8 * g) = w0; *(u32x2*)(orow + 32 + 8 * g) = w1; }
}
__device__ __forceinline__ void phase(int wave, int vcu, const bf16* Q, const bf16* K, const bf16* V, bf16* O, const float* KMP, const float* BT, LAS char* lds) {
    if (vcu >= 256) return;
    const int s = vcu & 3, bh = vcu >> 2;
#pragma unroll 1
    for (int i = 0; i < 4; ++i) { const int qb = (i == 0) ? s : (i == 1) ? 7 - s : (i == 2) ? 8 + s : 15 - s; unit(wave, bh >> 3, bh & 7, qb, Q, K, V, O, KMP, BT, lds); }
}
}

__device__ __forceinline__ void ph_norm(const Ctx& F0, const float* xin) {
    const Ctx F = launder(F0);
    const int gw = F.vcu * NWAVES + F.wave, NGW = F.G * NWAVES;
    for (int m = gw; m < T; m += NGW) {
        const f32x4* xr = (const f32x4*)(xin + (size_t)m * D) + F.lane;
        f32x4 v[4]; float s = 0.f;
#pragma unroll
        for (int j = 0; j < 4; ++j) { v[j] = xr[64 * j]; s += (v[j].x * v[j].x + v[j].y * v[j].y) + (v[j].z * v[j].z + v[j].w * v[j].w); }
        const float rstd = 1.f / sqrtf(wave_sum(s) * (1.f / D) + RMS_EPS);
        unsigned long long* o8 = (unsigned long long*)(P_XB(F) + (size_t)m * D) + F.lane;
#pragma unroll
        for (int j = 0; j < 4; ++j) o8[64 * j] = (unsigned long long)pk2(v[j].x * rstd, v[j].y * rstd) | ((unsigned long long)pk2(v[j].z * rstd, v[j].w * rstd) << 32);
    }
}

__device__ __forceinline__ void ph_bias_table(const Ctx& F0) {
    const Ctx F = launder(F0);
    if (F.vcu == 0) {
        const float* rel_bias = F.in[1];
        for (int i = F.tid; i < 8 * 132; i += NTHREADS) {
            const int h = i / 132, r = i % 132;
            int bk;
            if (r < 16) bk = r;
            else { bk = 16 + (int)(logf((float)r / 16.f) / logf(8.f) * 16.f); if (bk > 31) bk = 31; }
            P_BT(F)[i] = rel_bias[bk * 8 + h] * LOG2E;
        }
    }
}

__device__ __forceinline__ void ph_pool_dl(const Ctx& F0) {
    const Ctx F = launder(F0);
    const int gt = F.vcu * NTHREADS + F.tid, NGT = F.G * NTHREADS;
    for (int it = gt; it < (T / 32) * 128; it += NGT) {
        const int cp = it & 127, chunk = it >> 7, c = cp * 2, gi = c >> 6, win = 2 << gi, m0 = chunk * 32, t0 = m0 & (SEQ - 1);
        const unsigned* P2 = (const unsigned*)P_PB(F) + cp; unsigned* D2 = (unsigned*)P_DL(F) + cp;
        float s0 = 0.f, s1 = 0.f;
        const int back = (t0 < win) ? t0 : win;
        for (int j = 1; j <= back; ++j) { const unsigned v = P2[(size_t)(m0 - j) * 128]; s0 += bf2f(v & 0xffffu); s1 += bf2f(v >> 16); }
#pragma unroll 4
        for (int i = 0; i < 32; ++i) { const int m = m0 + i, t = t0 + i;
            const unsigned v = P2[(size_t)m * 128]; const float p0 = bf2f(v & 0xffffu), p1 = bf2f(v >> 16);
            s0 += p0; s1 += p1;
            if (t >= win) { const unsigned o = P2[(size_t)(m - win) * 128]; s0 -= bf2f(o & 0xffffu); s1 -= bf2f(o >> 16); }
            const float inv = 1.f / (float)((t + 1 < win) ? t + 1 : win);
            D2[(size_t)m * 128] = pk2(s0 * inv - p0, s1 * inv - p1); }
    }
}
__device__ __forceinline__ void ph_final(const Ctx& F0) {
    const Ctx F = launder(F0);
    const int gw = F.vcu * NWAVES + F.wave, NGW = F.G * NWAVES;
    const f32x4* gf = (const f32x4*)F.in[26] + F.lane;
    for (int m = gw; m < T; m += NGW) {
        f32x4* xr = (f32x4*)(F.R + (size_t)m * D) + F.lane;
        f32x4 v[4]; float s = 0.f;
#pragma unroll
        for (int j = 0; j < 4; ++j) { v[j] = xr[64 * j]; s += (v[j].x * v[j].x + v[j].y * v[j].y) + (v[j].z * v[j].z + v[j].w * v[j].w); }
        const float rstd = 1.f / sqrtf(wave_sum(s) * (1.f / D) + RMS_EPS);
#pragma unroll
        for (int j = 0; j < 4; ++j) xr[64 * j] = v[j] * rstd * gf[64 * j];
    }
}

constexpr int LDS_BYTES = 147456;
constexpr int MISC_OFF = 131072 + 320;

__global__ void __launch_bounds__(NTHREADS, 2) mk_fwd(Args args) {
    extern __shared__ __attribute__((aligned(16))) unsigned char lds[];
    Ctx F;
    F.lds = (LAS unsigned char*)lds;
    F.wave = __builtin_amdgcn_readfirstlane((int)threadIdx.x >> 6);
    F.lane = lane_id(); F.tid = F.wave * 64 + F.lane;
    F.G = gridDim.x; { const int bx = blockIdx.x; F.vcu = (F.G % 8 == 0) ? (bx % 8) * (F.G / 8) + bx / 8 : bx; }
    F.in = (KargP)__builtin_amdgcn_kernarg_segment_ptr(); F.R = args.out; F.ws = args.ws;
    unsigned char* ws = args.ws;
    volatile LAS unsigned* MISC = (volatile LAS unsigned*)(F.lds + MISC_OFF);
    if (F.tid < 64) MISC[F.tid] = 0u;
    __syncthreads();
    XcdBarrier bar = xcd_barrier_post((unsigned*)(ws + WS_CTL) + CW_BAR, MISC + 8, F.tid == 0);
#define GRID_BAR() do { bar.bar = (unsigned*)(wsl(ws) + WS_CTL) + CW_BAR; xcd_barrier(bar, F.wave); } while (0)
#define FL launder(F)

    ph_bias_table(F);
    ph_prologue(F);
#pragma unroll 1
    for (int l = 0; l < DEPTH; ++l) {
        const float* xin = (l == 0) ? F.in[0] : F.R;
        ph_norm(F, xin);
        GRID_BAR();
        { pg8::Gemm g{P_XB(FL), (const bf16*)(wsl(ws) + WS_WIN) + (size_t)l * NPROJ * D, D, D, D}; pg8::StaticOrder S; S.init(T, NPROJ, sl(F.G), sl((int)blockIdx.x));
          EpiProjE E{P_UG(FL), P_PB(FL), P_QB(FL), P_KB(FL), P_VB(FL), P_KMP(FL)}; pg8::gemm_phase(F.lds, g, S, E, sl(F.wave)); }
        GRID_BAR();
        { pg8::Gemm g{P_UG(FL), (const bf16*)(wsl(ws) + WS_BZ) + (size_t)l * SGN * 256 * 1024, UGP, 1024, 1024}; SsmOrder S{sl(F.G), sl((int)blockIdx.x), 1};
          EpiZ E{(float*)(wsl(ws) + WS_ZB)}; pg8::gemm_phase(F.lds, g, S, E, sl(F.wave)); }
        ph_pool_dl(F);
        GRID_BAR();
        ph_ssm_scan(F, l);
        GRID_BAR();
        { pg8::Gemm g{P_UG(FL), (const bf16*)(wsl(ws) + WS_TG) + (size_t)l * SGN * 1024 * UGP, UGP, UGP, UGP}; SsmOrder S{sl(F.G), sl((int)blockIdx.x), 2};
          EpiSsm2 E{P_UG(FL), P_YS(FL), F.in[11] + l * 256}; pg8::gemm_phase(F.lds, g, S, E, sl(F.wave)); }
        GRID_BAR();
        { pg8::Gemm g{P_YS(FL), (const bf16*)(wsl(ws) + WS_GLUT) + (size_t)l * 65536, 256, 256, 256}; HalfOrder S{sl(F.vcu)};
          EpiGluE E{P_YS(FL), P_YMIX(FL), F.in[13] + l * 256}; pg8::gemm_phase(F.lds, g, S, E, sl(F.wave)); }
        { pg8::Gemm g{P_DL(FL), (const bf16*)(wsl(ws) + WS_POOLT) + (size_t)l * 65536, 256, 256, 256}; HalfOrder S{sl(F.vcu) - 128};
          EpiPoolE E{P_YMIX(FL), F.in[15] + l * 256, F.in[16] + l * 256}; pg8::gemm_phase(F.lds, g, S, E, sl(F.wave)); }
        moba::phase(sl(F.wave), sl(F.vcu), P_QB(FL), P_KB(FL), P_VB(FL), P_YMIX(FL), P_KMP(FL), P_BT(FL), (LAS char*)F.lds);
        GRID_BAR();
        { pg8::Gemm g{P_YMIX(FL), (const bf16*)(wsl(ws) + WS_WOUT) + (size_t)l * D * D, D, D, D}; pg8::StaticOrder S; S.init(T, D, sl(F.G), sl((int)blockIdx.x));
          EpiOutE E{xin, F.R}; pg8::gemm_phase(F.lds, g, S, E, sl(F.wave)); }
        GRID_BAR();
        ph_route(F, l);
        GRID_BAR();
        ph_place(F);
        GRID_BAR();
        { pg8::Gemm g{(const bf16*)(wsl(ws) + WS_XS), (const bf16*)(wsl(ws) + WS_GU) + (size_t)l * 16 * 512 * D, D, D, D}; MoeOrder S{(const int*)(wsl(ws) + WS_TILEB), sl(F.G), sl((int)blockIdx.x), false};
          EpiGU E{(bf16*)(wsl(ws) + WS_HACT), (const float*)(wsl(ws) + WS_ROWW)}; pg8::gemm_phase(F.lds, g, S, E, sl(F.wave)); }
        GRID_BAR();
        { pg8::Gemm g{(const bf16*)(wsl(ws) + WS_HACT), (const bf16*)(wsl(ws) + WS_WD) + (size_t)l * 24 * D * 512, 512, 512, 512}; MoeOrder S{(const int*)(wsl(ws) + WS_TILEB), sl(F.G), sl((int)blockIdx.x), true};
          EpiDown E{F.R, (const int*)(wsl(ws) + WS_ROWTOK)}; pg8::gemm_phase(F.lds, g, S, E, sl(F.wave)); }
        GRID_BAR();
    }
    ph_final(F);
}

extern "C" void kernel_launch(void* const* d_in, const int* in_sizes, int n_in, void* d_out, int out_size, void* d_ws, size_t ws_size, hipStream_t stream) {
    static int grid = 0;
    if (grid == 0) {
        if (n_in != 27 || out_size != T * D || ws_size < WS_END) { fprintf(stderr, "kernel_launch: unexpected shapes (n_in %d out %d ws %zu)\n", n_in, out_size, ws_size); grid = -1; return; }
        int dev = 0, cus = 0, per_cu = 0;
        if (hipGetDevice(&dev) != hipSuccess || hipDeviceGetAttribute(&cus, hipDeviceAttributeMultiprocessorCount, dev) != hipSuccess) { grid = -1; return; }
        if (hipFuncSetAttribute((const void*)mk_fwd, hipFuncAttributeMaxDynamicSharedMemorySize, LDS_BYTES) != hipSuccess) { fprintf(stderr, "kernel_launch: hipFuncSetAttribute failed\n"); grid = -1; return; }
        if (hipOccupancyMaxActiveBlocksPerMultiprocessor(&per_cu, (const void*)mk_fwd, NTHREADS, LDS_BYTES) != hipSuccess || per_cu < 1) { fprintf(stderr, "kernel_launch: occupancy query says %d\n", per_cu); per_cu = 1; }
        (void)hipGetLastError();
        grid = cus;
    }
    if (grid < 0) return;
    (void)hipMemsetAsync((char*)d_ws + WS_CTL, 0, CTL_ZERO_BYTES, stream);
    Args a{};
    for (int i = 0; i < 27; ++i) a.in[i] = (const float*)d_in[i];
    a.out = (float*)d_out; a.ws = (unsigned char*)d_ws; a.pad0 = 0; a.pad1 = 0;
    hipLaunchKernelGGL(mk_fwd, dim3(grid), dim3(NTHREADS), LDS_BYTES, stream, a);
}
```

```cpp
#include <hip/hip_runtime.h>
#include <hip/hip_bf16.h>
#include <cstdio>
#include <cstdint>

#define GAS __attribute__((address_space(1)))
#define LAS __attribute__((address_space(3)))
typedef unsigned short bf16;
typedef float f32x4 __attribute__((ext_vector_type(4)));
typedef unsigned u32x4 __attribute__((ext_vector_type(4)));
typedef unsigned u32x2 __attribute__((ext_vector_type(2)));

constexpr int NB = 8, SEQ = 4096, T = NB * SEQ, D = 1024, NPROJ = 2048, DEPTH = 2;
constexpr int NHEAD = 8, HD = 64, MBLK = 256, NBLK = SEQ / MBLK;
constexpr int SG = 16, SGN = 16, SP = 64, SCH = 64, UGP = 1152;
constexpr float RMS_EPS = 1e-6f;
constexpr float LOG2E = 1.4426950408889634f;
constexpr float C2 = 0.125f * LOG2E;
constexpr int NWAVES = 8, NTHREADS = 512;

constexpr size_t MiB = 1u << 20;
constexpr size_t WS_CTL = 0, CTL_ZERO_BYTES = 1 * MiB;
constexpr size_t WS_XB = 2 * MiB;
constexpr size_t WS_UG = 66 * MiB;
constexpr size_t WS_PB = 84 * MiB;
constexpr size_t WS_QB = 100 * MiB;
constexpr size_t WS_KB = 132 * MiB;
constexpr size_t WS_VB = 164 * MiB;
constexpr size_t WS_YMIX = 196 * MiB;
constexpr size_t WS_YS = 260 * MiB;
constexpr size_t WS_DL = 276 * MiB;
constexpr size_t WS_KMP = 292 * MiB;
constexpr size_t WS_BT = 293 * MiB;
constexpr size_t WS_WIN = 300 * MiB;
constexpr size_t WS_WOUT = 308 * MiB;
constexpr size_t WS_GU = 312 * MiB;
constexpr size_t WS_WD = 344 * MiB;
constexpr size_t WS_TG = 392 * MiB;
constexpr size_t WS_BZ = 464 * MiB;
constexpr size_t WS_GLUT = 480 * MiB;
constexpr size_t WS_POOLT = WS_GLUT + 512 * 1024;
constexpr size_t WS_ZB = 482 * MiB;
constexpr size_t WS_END = 486 * MiB;
constexpr int MOE_MAXT = 152;
constexpr size_t WS_XS = 66 * MiB;
constexpr size_t WS_HACT = 142 * MiB;
constexpr size_t WS_TOKB = 294 * MiB;
constexpr size_t WS_TOKR = WS_TOKB + 128 * 1024;
constexpr size_t WS_TOKW = WS_TOKB + 256 * 1024;
constexpr size_t WS_ROWTOK = 295 * MiB;
constexpr size_t WS_ROWW = WS_ROWTOK + 256 * 1024;
constexpr size_t WS_ROWR = WS_ROWTOK + 576 * 1024;
constexpr size_t WS_RS1 = WS_ROWTOK + 768 * 1024;
constexpr size_t WS_WGCNT = 296 * MiB;
constexpr size_t WS_TILEB = WS_WGCNT + 64 * 1024;

constexpr int CW_BAR = 4096;

__device__ __forceinline__ unsigned f2bf(float f) { unsigned u = __builtin_bit_cast(unsigned, f); return (u + 0x7fffu + ((u >> 16) & 1u)) >> 16; }
__device__ __forceinline__ float bf2f(unsigned h) { return __builtin_bit_cast(float, h << 16); }
__device__ __forceinline__ unsigned pk2(float lo, float hi) { return f2bf(lo) | (f2bf(hi) << 16); }
template <int O> __device__ __forceinline__ float xshfl(float v) {
    if constexpr (O < 32) return __builtin_bit_cast(float, __builtin_amdgcn_ds_swizzle(__builtin_bit_cast(int, v), (O << 10) | 0x1f));
    else { const unsigned u = __builtin_bit_cast(unsigned, v); auto r = __builtin_amdgcn_permlane32_swap(u, u, false, false);
           const float a = __builtin_bit_cast(float, (unsigned)r[0]), b = __builtin_bit_cast(float, (unsigned)r[1]); return (a == v && __builtin_bit_cast(unsigned, a) == u) ? b : a; }
}
__device__ __forceinline__ float wave_sum(float v) {
    v += xshfl<1>(v); v += xshfl<2>(v); v += xshfl<4>(v); v += xshfl<8>(v); v += xshfl<16>(v);
    const unsigned u = __builtin_bit_cast(unsigned, v); auto r = __builtin_amdgcn_permlane32_swap(u, u, false, false);
    return __builtin_bit_cast(float, (unsigned)r[0]) + __builtin_bit_cast(float, (unsigned)r[1]);
}
__device__ __forceinline__ float wave_max(float v) {
    v = fmaxf(v, xshfl<1>(v)); v = fmaxf(v, xshfl<2>(v)); v = fmaxf(v, xshfl<4>(v)); v = fmaxf(v, xshfl<8>(v)); v = fmaxf(v, xshfl<16>(v));
    const unsigned u = __builtin_bit_cast(unsigned, v); auto r = __builtin_amdgcn_permlane32_swap(u, u, false, false);
    return fmaxf(__builtin_bit_cast(float, (unsigned)r[0]), __builtin_bit_cast(float, (unsigned)r[1]));
}
__device__ __forceinline__ float gelu_tanh(float x) {
    const float u = 0.7978845608028654f * (x + 0.044715f * x * x * x);
    const float e = __expf(2.f * u);
    const float th = 1.f - 2.f / (e + 1.f);
    return 0.5f * x * (1.f + th);
}
__device__ __forceinline__ float sigmoidf_(float x) { return 1.f / (1.f + __expf(-x)); }

__device__ __forceinline__ int lane_id() { unsigned m; asm volatile("s_mov_b32 %0, -1" : "=s"(m)); return (int)__builtin_amdgcn_mbcnt_hi(m, __builtin_amdgcn_mbcnt_lo(m, 0u)); }

#define XB_TMO      128
#define XB_XCNT(j)  (256  + 64 * (j))
#define XB_XSUB(j)  (1280 + 64 * (j))
#define XB_XGEN(j)  (2304 + 64 * (j))
#define XB_TOP      3328
#define XB_TOPGEN   3392
#define XCD_BAR_WORDS 3456
#define XB_SPIN_CAP (1u << 22)
__device__ __forceinline__ unsigned xb_ld(unsigned* p)              { return __hip_atomic_load(p, __ATOMIC_RELAXED, __HIP_MEMORY_SCOPE_AGENT); }
__device__ __forceinline__ unsigned xb_add(unsigned* p, unsigned v) { return __hip_atomic_fetch_add(p, v, __ATOMIC_RELAXED, __HIP_MEMORY_SCOPE_AGENT); }
__device__ __forceinline__ unsigned xb_xcc_id() { return (unsigned)__builtin_amdgcn_s_getreg((3 << 11) | 20) & 0xFu; }
#define XB_SPIN(cond, bar) do { unsigned _sp = 0; while (cond) { __builtin_amdgcn_s_sleep(1); \
    if ((++_sp & 255u) == 0u) { if (xb_ld(&(bar)[XB_TMO])) break; if (_sp > XB_SPIN_CAP) { atomicAdd(&(bar)[XB_TMO], 1u); break; } } } } while (0)
struct XcdBarrier { unsigned* bar; unsigned x; volatile LAS unsigned* st; };
__device__ __forceinline__ XcdBarrier xcd_barrier_post(unsigned* bar, volatile LAS unsigned* st, bool t0) {
    XcdBarrier b; b.bar = bar; b.x = xb_xcc_id(); b.st = st;
    if (t0) (void)xb_add(&bar[XB_XCNT(b.x)], 1u);
    return b;
}
__device__ __forceinline__ void xcd_barrier_complete(unsigned* bar, unsigned x, unsigned& nloc, unsigned& nx) {
    const unsigned G = gridDim.x * gridDim.y * gridDim.z;
    unsigned sum, cnt, mine, sp = 0u;
    for (;;) {
        sum = 0u; cnt = 0u; mine = 0u;
#pragma unroll
        for (unsigned j = 0; j < 16; ++j) { const unsigned c = xb_ld(&bar[XB_XCNT(j)]); sum += c; cnt += (c > 0u) ? 1u : 0u; mine = (j == x) ? c : mine; }
        if (sum == G) break;
        __builtin_amdgcn_s_sleep(1);
        if ((++sp & 255u) == 0u) { if (xb_ld(&bar[XB_TMO])) break; if (sp > XB_SPIN_CAP) { atomicAdd(&bar[XB_TMO], 1u); break; } }
    }
    nloc = mine > 0u ? mine : 1u; nx = cnt > 0u ? cnt : 1u;
}
__device__ __forceinline__ void xcd_barrier(const XcdBarrier& b, int wave) {
    asm volatile("s_waitcnt vmcnt(0)" ::: "memory");
    __syncthreads();
    if (wave == 0 && lane_id() == 0) {
        unsigned* bar = b.bar;
        __builtin_amdgcn_s_waitcnt(0);
        unsigned nloc = b.st[0], nx = b.st[1];
        if (nloc == 0u) { xcd_barrier_complete(bar, b.x, nloc, nx); b.st[0] = nloc; b.st[1] = nx; }
        const unsigned old = xb_add(&bar[XB_XSUB(b.x)], 1u);
        const unsigned gen = old / nloc;
        if (old + 1u == (gen + 1u) * nloc) {
            __builtin_amdgcn_fence(__ATOMIC_RELEASE, "agent");
            asm volatile("s_waitcnt vmcnt(0)" ::: "memory");
            const unsigned og = xb_add(&bar[XB_TOP], 1u);
            const unsigned tg = og / nx;
            if (og + 1u == (tg + 1u) * nx) xb_add(&bar[XB_TOPGEN], 1u);
            else XB_SPIN(xb_ld(&bar[XB_TOPGEN]) == tg, bar);
            __builtin_amdgcn_fence(__ATOMIC_ACQUIRE, "agent");
            xb_add(&bar[XB_XGEN(b.x)], 1u);
            asm volatile("s_waitcnt vmcnt(0)" ::: "memory");
        } else {
            XB_SPIN(xb_ld(&bar[XB_XGEN(b.x)]) == gen, bar);
            __builtin_amdgcn_fence(__ATOMIC_ACQUIRE, "agent");
            asm volatile("s_waitcnt vmcnt(0)" ::: "memory");
        }
    }
    __syncthreads();
}

struct Args {
    const float* in[27];
    float* out;
    unsigned char* ws;
    int pad0, pad1;
};

typedef const float* fptr_t;
typedef __attribute__((address_space(4))) const fptr_t* KargP;
struct Ctx {
    LAS unsigned char* lds;
    int tid, lane, wave, vcu, G;
    KargP in;
    float* R;
    unsigned char* ws;
};
#define P_XB(F) ((bf16*)((F).ws + WS_XB))
#define P_UG(F) ((bf16*)((F).ws + WS_UG))
#define P_PB(F) ((bf16*)((F).ws + WS_PB))
#define P_QB(F) ((bf16*)((F).ws + WS_QB))
#define P_KB(F) ((bf16*)((F).ws + WS_KB))
#define P_VB(F) ((bf16*)((F).ws + WS_VB))
#define P_YMIX(F) ((bf16*)((F).ws + WS_YMIX))
#define P_YS(F) ((bf16*)((F).ws + WS_YS))
#define P_DL(F) ((bf16*)((F).ws + WS_DL))
#define P_KMP(F) ((float*)((F).ws + WS_KMP))
#define P_BT(F) ((float*)((F).ws + WS_BT))


__device__ __forceinline__ Ctx launder(const Ctx& F0) {
    Ctx F = F0;
    int ln = lane_id(); asm volatile("" : "+v"(ln));
    asm volatile("" : "+s"(F.wave), "+s"(F.vcu), "+s"(F.G));
    F.lane = ln; F.tid = F.wave * 64 + ln;
    KargP kp = (KargP)__builtin_amdgcn_kernarg_segment_ptr(); asm volatile("" : "+s"(kp));
    F.in = kp; F.R = (float*)kp[27]; F.ws = (unsigned char*)kp[28];
    return F;
}

__device__ __forceinline__ unsigned char* wsl(unsigned char* p) { asm volatile("" : "+s"(p)); return p; }
__device__ __forceinline__ int sl(int x) { asm volatile("" : "+s"(x)); return x; }

namespace pg8 {
typedef short bf16x8 __attribute__((ext_vector_type(8)));
constexpr int BM = 256, BK = 64, HALF = 128, HTB = HALF * BK * 2, STAGE_BYTES = 8 * HTB, NXCD = 8, WGM = 8;
__device__ __forceinline__ int lds_byte(int r, int c) { const int st = (r >> 4) * 2 + (c >> 5), rr = r & 15, cc = c & 31, ob = rr * 64 + cc * 2; return st * 1024 + (ob ^ (((ob >> 9) & 1) << 5)); }
__device__ __forceinline__ void stage_rc(int b, int& R, int& C) { const int st = b / 1024, sb = b % 1024, swz = sb ^ (((sb >> 9) & 1) << 5); R = (st >> 1) * 16 + swz / 64; C = (st & 1) * 32 + (swz % 64) / 2; }
__device__ __forceinline__ int perm32(int rho) { const int n = rho >> 4, i = rho & 15; return 8 * (i >> 2) + 4 * n + (i & 3); }

struct Unit { int pm, pn, aux; };
struct Gemm { const bf16* A; const bf16* Bt; int lda, ldb, K; };

struct StaticOrder {
    int nM, nN, nwg, G, c;
    __device__ void init(int M, int N, int G_, int c_) { nM = M / BM; nN = N / BM; nwg = nM * nN; G = G_; c = c_; }
    __device__ bool next(int i, Unit& u) const {
        const long L = (long)i * G + c; if (L >= nwg) return false;
        int wgid = (int)L; { const int q = nwg / NXCD, r = nwg % NXCD, xcd = wgid % NXCD, off = wgid / NXCD; wgid = (xcd < r ? xcd * (q + 1) : r * (q + 1) + (xcd - r) * q) + off; }
        const int nig = WGM * nN, gid = wgid / nig, fm = gid * WGM, gsz = (nM - fm) < WGM ? (nM - fm) : WGM;
        u.pm = fm + ((wgid % nig) % gsz); u.pn = (wgid % nig) / gsz; u.aux = 0; return true;
    }
};

__device__ __forceinline__ unsigned cvt_pk_bf16(float lo, float hi) { unsigned r; asm volatile("v_cvt_pk_bf16_f32 %0, %1, %2" : "=v"(r) : "v"(lo), "v"(hi)); return r; }

template <bool ALIGN = true, class Epi, class Sched>
__device__ __forceinline__ void gemm_phase(LAS unsigned char* lds, const Gemm g, const Sched& S, const Epi& E, int wave_) {
    int lane_ = lane_id(); asm volatile("" : "+v"(lane_)); asm volatile("" : "+s"(wave_));
    const int wid = wave_, lane = lane_, tid = wid * 64 + lane, wr = wid >> 2, wc = wid & 3, fr = lane & 15, fq = lane >> 4;
    const int K = g.K, nt = K / BK;
    unsigned voffA[2], voffB[2];
#pragma unroll
    for (int i = 0; i < 2; ++i) { int R, C; stage_rc(tid * 16 + i * 8192, R, C); const int Rb = Epi::PERM ? ((R & ~31) + perm32(R & 31)) : R;
        voffA[i] = (unsigned)(R * g.lda + C) * 2u; voffB[i] = (unsigned)(Rb * g.ldb + C) * 2u; }
    const size_t kstep = (size_t)(BK * 2);
    const size_t hstepA = (size_t)HALF * g.lda * 2, hstepB = (size_t)HALF * g.ldb * 2;
    const size_t tstepA = 2 * hstepA, tstepB = 2 * hstepB;
    const unsigned ldsw = (unsigned)wid * 1024u;
    const int aoff = lds_byte(wr * 64 + fr, fq * 8), boff = lds_byte(wc * 32 + fr, fq * 8);
#define PG8_SA(b, h) (((b) * 2 + (h)) * HTB)
#define PG8_SB(b, h) ((4 + (b) * 2 + (h)) * HTB)
#define PG8_STAGE(bufoff, gbase, voff) do { _Pragma("unroll") for (int _i = 0; _i < 2; ++_i) \
        __builtin_amdgcn_global_load_lds((const unsigned*)((const char*)(gbase) + (voff)[_i]), (LAS unsigned*)(lds + (bufoff) + ldsw + _i * 8192), 16, 0, 0); } while (0)
#define PG8_LDA(dst, b, h) do { _Pragma("unroll") for (int m = 0; m < 4; ++m) _Pragma("unroll") for (int k = 0; k < 2; ++k) dst[m][k] = *(const LAS bf16x8*)(lds + PG8_SA(b, h) + aoff + m * 2048 + k * 1024); } while (0)
#define PG8_LDB(dst, b, h) do { _Pragma("unroll") for (int n = 0; n < 2; ++n) _Pragma("unroll") for (int k = 0; k < 2; ++k) dst[n][k] = *(const LAS bf16x8*)(lds + PG8_SB(b, h) + boff + n * 2048 + k * 1024); } while (0)
#define PG8_MMA(ai, bj, At, Bt) do { __builtin_amdgcn_s_setprio(1); _Pragma("unroll") for (int m = 0; m < 4; ++m) _Pragma("unroll") for (int n = 0; n < 2; ++n) _Pragma("unroll") for (int k = 0; k < 2; ++k) \
        acc[ai][bj][m][n] = __builtin_amdgcn_mfma_f32_16x16x32_bf16(Bt[n][k], At[m][k], acc[ai][bj][m][n], 0, 0, 0); __builtin_amdgcn_s_setprio(0); } while (0)
#define PG8_WAIT_V(n) asm volatile("s_waitcnt vmcnt(" #n ")" ::: "memory")
#define PG8_WAIT_L(n) asm volatile("s_waitcnt lgkmcnt(" #n ")" ::: "memory")
#define PG8_BAR __builtin_amdgcn_s_barrier()
#define PG8_SCHED __builtin_amdgcn_sched_barrier(0)
    Unit cur, nxt; int ui = 0;
    if (!S.next(0, cur)) return;
    f32x4 acc[2][2][4][2];
#pragma unroll
    for (int a = 0; a < 2; ++a)
#pragma unroll
        for (int b = 0; b < 2; ++b)
#pragma unroll
            for (int m = 0; m < 4; ++m)
#pragma unroll
                for (int n = 0; n < 2; ++n) acc[a][b][m][n] = (f32x4){0.f, 0.f, 0.f, 0.f};
    bf16x8 At[4][2], B0[2][2], B1[2][2];
    const char* cA = (const char*)g.A + (size_t)cur.pm * tstepA; const char* cB = (const char*)g.Bt + (size_t)cur.pn * tstepB;
    PG8_STAGE(PG8_SB(0, 0), cB, voffB); PG8_STAGE(PG8_SB(0, 1), cB + hstepB, voffB); PG8_STAGE(PG8_SA(0, 0), cA, voffA); PG8_STAGE(PG8_SA(0, 1), cA + hstepA, voffA);
    if (wr == 1) PG8_BAR;
    PG8_WAIT_V(2); PG8_BAR;
    PG8_STAGE(PG8_SB(1, 0), cB + kstep, voffB); PG8_STAGE(PG8_SA(1, 0), cA + kstep, voffA); PG8_STAGE(PG8_SB(1, 1), cB + hstepB + kstep, voffB);
    PG8_WAIT_V(6); PG8_BAR;
    for (;;) {
        const bool has_next = S.next(ui + 1, nxt);
        const char* nA = has_next ? (const char*)g.A + (size_t)nxt.pm * tstepA : cA; const char* nB = has_next ? (const char*)g.Bt + (size_t)nxt.pn * tstepB : cB;
        for (int t = 0; t < nt; t += 2) {
            const bool last = (t == nt - 2);
            const char* a1 = cA + (size_t)(t + 1) * kstep;
            const char* a2 = last ? nA : cA + (size_t)(t + 2) * kstep; const char* b2 = last ? nB : cB + (size_t)(t + 2) * kstep;
            const char* a3 = a2 + kstep; const char* b3 = b2 + kstep;
            PG8_LDB(B0, 0, 0); PG8_LDB(B1, 0, 1); PG8_SCHED; PG8_LDA(At, 0, 0); PG8_STAGE(PG8_SA(1, 1), a1 + hstepA, voffA);
            PG8_WAIT_V(8); PG8_WAIT_L(0); PG8_BAR; PG8_MMA(0, 0, At, B0); PG8_MMA(0, 1, At, B1); PG8_BAR; PG8_SCHED;
            PG8_LDA(At, 0, 1); PG8_STAGE(PG8_SB(0, 0), b2, voffB); PG8_STAGE(PG8_SB(0, 1), b2 + hstepB, voffB); PG8_STAGE(PG8_SA(0, 0), a2, voffA);
            PG8_WAIT_V(8); PG8_WAIT_L(0); PG8_BAR; PG8_MMA(1, 0, At, B0); PG8_MMA(1, 1, At, B1); PG8_BAR; PG8_SCHED;
            PG8_LDB(B0, 1, 0); PG8_LDB(B1, 1, 1); PG8_SCHED; PG8_LDA(At, 1, 0); PG8_STAGE(PG8_SA(0, 1), a2 + hstepA, voffA);
            PG8_WAIT_V(8); PG8_WAIT_L(0); PG8_BAR; PG8_MMA(0, 0, At, B0); PG8_MMA(0, 1, At, B1); PG8_BAR; PG8_SCHED;
            PG8_LDA(At, 1, 1); PG8_STAGE(PG8_SB(1, 0), b3, voffB); PG8_STAGE(PG8_SB(1, 1), b3 + hstepB, voffB); PG8_STAGE(PG8_SA(1, 0), a3, voffA);
            PG8_WAIT_V(8); PG8_WAIT_L(0); PG8_BAR; PG8_MMA(1, 0, At, B0); PG8_MMA(1, 1, At, B1); PG8_BAR; PG8_SCHED;
        }
        if constexpr (ALIGN) { if (wr == 0) PG8_BAR; }
        E(acc, cur, wr, wc, fr, fq);
        if (!has_next) break;
#pragma unroll
        for (int a = 0; a < 2; ++a)
#pragma unroll
            for (int b = 0; b < 2; ++b)
#pragma unroll
                for (int m = 0; m < 4; ++m)
#pragma unroll
                    for (int n = 0; n < 2; ++n) acc[a][b][m][n] = (f32x4){0.f, 0.f, 0.f, 0.f};
        cur = nxt; cA = nA; cB = nB; ++ui;
        if constexpr (ALIGN) { if (wr == 1) PG8_BAR; }
    }
    PG8_WAIT_V(0);
    if constexpr (!ALIGN) { if (wr == 0) PG8_BAR; }
    PG8_BAR;
#undef PG8_SA
#undef PG8_SB
#undef PG8_STAGE
#undef PG8_LDA
#undef PG8_LDB
#undef PG8_MMA
#undef PG8_WAIT_V
#undef PG8_WAIT_L
#undef PG8_BAR
#undef PG8_SCHED
}
}


struct EpiProjE {
    static constexpr bool PERM = true;
    bf16 *UG, *PB, *QB, *KB, *VB; float* KMP; const float* rs1;
    __device__ __forceinline__ void operator()(const f32x4 (&acc_)[2][2][4][2], const pg8::Unit& u, int wr, int wc, int fr_, int fq_) const {
        const int ln_ = lane_id(), fr = ln_ & 15, fq = ln_ >> 4; (void)fr_; (void)fq_;
        const int pn = u.pn, row0 = u.pm * 256 + wr * 64 + fr, cl = wc * 32 + 8 * fq;
        f32x4 acc[2][2][4][2];
#pragma unroll
        for (int ai = 0; ai < 2; ++ai)
#pragma unroll
            for (int m = 0; m < 4; ++m) { const float rs = rs1[row0 + ai * 128 + m * 16];
#pragma unroll
                for (int bj = 0; bj < 2; ++bj) { acc[ai][bj][m][0] = acc_[ai][bj][m][0] * rs; acc[ai][bj][m][1] = acc_[ai][bj][m][1] * rs; } }
        if (pn == 0) {
#pragma unroll
            for (int ai = 0; ai < 2; ++ai)
#pragma unroll
                for (int m = 0; m < 4; ++m) { const int r = row0 + ai * 128 + m * 16;
#pragma unroll
                    for (int bj = 0; bj < 2; ++bj) { const int ch = bj * 128 + cl, g = ch >> 4, h0 = ch & 15;
                        const f32x4 v0 = acc[ai][bj][m][0], v1 = acc[ai][bj][m][1]; u32x4 w;
                        w.x = pg8::cvt_pk_bf16(v0[0], v0[1]); w.y = pg8::cvt_pk_bf16(v0[2], v0[3]); w.z = pg8::cvt_pk_bf16(v1[0], v1[1]); w.w = pg8::cvt_pk_bf16(v1[2], v1[3]);
                        *(u32x4*)(UG + ((size_t)(g * 512 + (r >> 6))) * UGP + (r & 63) * 16 + h0) = w; } }
        } else {
            bf16* base; int ldc, colt; float sc = 1.f;
            if (pn == 1) { base = PB; ldc = 256; colt = 0; }
            else if (pn < 4) { base = QB; ldc = 512; colt = (pn - 2) * 256; sc = C2; }
            else if (pn < 6) { base = KB; ldc = 512; colt = (pn - 4) * 256; }
            else { base = VB; ldc = 512; colt = (pn - 6) * 256; }
#pragma unroll
            for (int ai = 0; ai < 2; ++ai)
#pragma unroll
                for (int m = 0; m < 4; ++m) { bf16* rowp = base + (size_t)(row0 + ai * 128 + m * 16) * ldc + colt + cl;
#pragma unroll
                    for (int bj = 0; bj < 2; ++bj) { const f32x4 v0 = acc[ai][bj][m][0] * sc, v1 = acc[ai][bj][m][1] * sc; u32x4 w;
                        w.x = pg8::cvt_pk_bf16(v0[0], v0[1]); w.y = pg8::cvt_pk_bf16(v0[2], v0[3]); w.z = pg8::cvt_pk_bf16(v1[0], v1[1]); w.w = pg8::cvt_pk_bf16(v1[2], v1[3]);
                        *(u32x4*)(rowp + bj * 128) = w; } }
            if (pn >= 4 && pn < 6) {
#pragma unroll
                for (int bj = 0; bj < 2; ++bj)
#pragma unroll
                    for (int n = 0; n < 2; ++n) { f32x4 s = (f32x4){0.f, 0.f, 0.f, 0.f};
#pragma unroll
                        for (int ai = 0; ai < 2; ++ai)
#pragma unroll
                            for (int m = 0; m < 4; ++m) s += acc[ai][bj][m][n];
#pragma unroll
                        for (int i = 0; i < 4; ++i) { float t = s[i]; t += xshfl<1>(t); t += xshfl<2>(t); t += xshfl<4>(t); t += xshfl<8>(t); s[i] = t; }
                        if (fr == 0) *(f32x4*)(KMP + (size_t)wr * 128 * 512 + (size_t)u.pm * 512 + colt + bj * 128 + cl + 4 * n) = s; }
            }
        }
    }
};
struct EpiOutE {
    static constexpr bool PERM = true;
    bf16* RB;
    __device__ __forceinline__ void operator()(const f32x4 (&acc)[2][2][4][2], const pg8::Unit& u, int wr, int wc, int fr_, int fq_) const {
        const int ln_ = lane_id(), fr = ln_ & 15, fq = ln_ >> 4; (void)fr_; (void)fq_;
        const int row0 = u.pm * 256 + wr * 64 + fr, col0 = u.pn * 256 + wc * 32 + 8 * fq;
#pragma unroll
        for (int ai = 0; ai < 2; ++ai)
#pragma unroll
            for (int m = 0; m < 4; ++m) { bf16* rp = RB + (size_t)(row0 + ai * 128 + m * 16) * D + col0;
#pragma unroll
                for (int bj = 0; bj < 2; ++bj) { const u32x4 x = *(const u32x4*)(rp + bj * 128); const f32x4 a0 = acc[ai][bj][m][0], a1 = acc[ai][bj][m][1]; u32x4 w;
                    w.x = pg8::cvt_pk_bf16(bf2f(x.x & 0xffffu) + a0[0], bf2f(x.x >> 16) + a0[1]); w.y = pg8::cvt_pk_bf16(bf2f(x.y & 0xffffu) + a0[2], bf2f(x.y >> 16) + a0[3]);
                    w.z = pg8::cvt_pk_bf16(bf2f(x.z & 0xffffu) + a1[0], bf2f(x.z >> 16) + a1[1]); w.w = pg8::cvt_pk_bf16(bf2f(x.w & 0xffffu) + a1[2], bf2f(x.w >> 16) + a1[3]);
                    *(u32x4*)(rp + bj * 128) = w; }
                if (m & 1) asm volatile("" ::: "memory"); }
    }
};

__device__ __forceinline__ void transpose_item(const float* W, int K, int N, const float* kscale, bf16* WT, int ldo, int koff, int rowmode, LAS float* scr, int item, int lane) {
    const int nblk = N / 32, kb = item / nblk, nb = item % nblk, k0 = 64 * kb, n0 = 32 * nb;
#pragma unroll 8
    for (int i = 0; i < 32; ++i) { const int kk = 2 * i + (lane >> 5); const float s = kscale ? kscale[k0 + kk] : 1.f; scr[kk * 33 + (lane & 31)] = W[(size_t)(k0 + kk) * N + n0 + (lane & 31)] * s; }
    asm volatile("s_waitcnt lgkmcnt(0)" ::: "memory");
    const int c = lane & 7;
#pragma unroll
    for (int j = 0; j < 4; ++j) { const int n = (lane >> 3) + 8 * j; const LAS float* s = scr + (8 * c) * 33 + n;
        u32x4 o; o.x = pk2(s[0 * 33], s[1 * 33]); o.y = pk2(s[2 * 33], s[3 * 33]); o.z = pk2(s[4 * 33], s[5 * 33]); o.w = pk2(s[6 * 33], s[7 * 33]);
        const int nn = n0 + n, row = rowmode == 0 ? nn : (8 * (nn >> 2) + (nn & 3) + (rowmode == 2 ? 4 : 0));
        *(u32x4*)(WT + (size_t)row * ldo + koff + k0 + 8 * c) = o; }
    asm volatile("s_waitcnt lgkmcnt(0)" ::: "memory");
}
__device__ __forceinline__ void pair_decode(int pi, int& ea, int& eb) { ea = pi < 3 ? 0 : (pi < 5 ? 1 : 2); eb = pi < 3 ? pi + 1 : (pi < 5 ? pi - 1 : 3); }
__device__ __forceinline__ void ph_prologue(const Ctx& F0) {
    const Ctx F = launder(F0);
    LAS float* scr = (LAS float*)(F.lds + F.wave * 16384);
    const int gw = F.vcu * NWAVES + F.wave, NGW = F.G * NWAVES;
    constexpr int I_IN = (D / 64) * (NPROJ / 32), I_OUT = (D / 64) * (D / 32), I_GU1 = (D / 64) * (256 / 32), I_GU = 16 * 2 * I_GU1, I_WD1 = (256 / 64) * (D / 32), I_WD = 24 * 2 * I_WD1;
    constexpr int I_L = I_IN + I_OUT + I_GU + I_WD;
    for (int it = gw; it < DEPTH * I_L; it += NGW) {
        const int l = it / I_L; int r = it % I_L;
        if (r < I_IN) { transpose_item(F.in[3] + (size_t)l * D * NPROJ, D, NPROJ, F.in[2] + l * D, (bf16*)(F.ws + WS_WIN) + (size_t)l * NPROJ * D, D, 0, 0, scr, r, F.lane); continue; } r -= I_IN;
        if (r < I_OUT) { transpose_item(F.in[17] + (size_t)l * D * D, D, D, nullptr, (bf16*)(F.ws + WS_WOUT) + (size_t)l * D * D, D, 0, 0, scr, r, F.lane); continue; } r -= I_OUT;
        if (r < I_GU) { const int e = r / (2 * I_GU1), up = (r / I_GU1) & 1, item = r % I_GU1;
            transpose_item(F.in[up ? 24 : 23] + ((size_t)l * 16 + e) * D * 256, D, 256, F.in[18] + l * D, (bf16*)(F.ws + WS_GU) + ((size_t)l * 16 + e) * 512 * D, D, 0, 1 + up, scr, item, F.lane); continue; } r -= I_GU;
        { const int bk = r / (2 * I_WD1), half = (r / I_WD1) & 1, item = r % I_WD1, g = bk / 6; int ea, eb; pair_decode(bk % 6, ea, eb); const int e = g * 4 + (half ? eb : ea);
            transpose_item(F.in[25] + ((size_t)l * 16 + e) * 256 * D, 256, D, nullptr, (bf16*)(F.ws + WS_WD) + ((size_t)l * 24 + bk) * D * 512, 512, half * 256, 0, scr, item, F.lane); }
    }
    for (int it = gw; it < DEPTH * 32; it += NGW) { const int l = it >> 5;
        transpose_item(F.in[12] + (size_t)l * 256 * 256, 256, 256, nullptr, (bf16*)(F.ws + WS_GLUT) + (size_t)l * 65536, 256, 0, 0, scr, it & 31, F.lane); }
    { const int gt = F.vcu * NTHREADS + F.tid, NGT = F.G * NTHREADS;
      for (int i = gt; i < DEPTH * 65536; i += NGT) { const int l = i >> 16, n = (i >> 8) & 255, k = i & 255;
          const float v = ((n >> 6) == (k >> 6)) ? F.in[14][(((size_t)l * 4 + (n >> 6)) * 64 + (k & 63)) * 64 + (n & 63)] : 0.f;
          ((bf16*)(F.ws + WS_POOLT))[i] = (bf16)f2bf(v); } }
    for (int it = gw; it < DEPTH * SGN * 65; it += NGW) {
        const int l = it / (SGN * 65), g = (it / 65) % SGN, tau = it % 65, p = F.lane;
        const float are = F.in[4][(l * SGN + g) * SP + p], aim = F.in[5][(l * SGN + g) * SP + p], dt = expf(F.in[6][l * SGN + g]);
        float sn, cs; sincosf(aim * dt, &sn, &cs); const float mg = expf(are * dt), lbr = mg * cs, lbi = mg * sn;
        const float nr = lbr - 1.f, ni = lbi, den = are * are + aim * aim, cr = (nr * are + ni * aim) / den, ci = (ni * are - nr * aim) / den;
        float sn2, cs2; sincosf(aim * dt * (float)tau, &sn2, &cs2); const float mg2 = expf(are * dt * (float)tau), lr = mg2 * cs2, li = mg2 * sn2;
        float wr[16], wi[16];
#pragma unroll
        for (int h = 0; h < 16; ++h) { const float br = F.in[7][((size_t)(l * SGN + g) * SP + p) * SG + h], bi = F.in[8][((size_t)(l * SGN + g) * SP + p) * SG + h];
            const float bbr = cr * br - ci * bi, bbi = cr * bi + ci * br; wr[h] = lr * bbr - li * bbi; wi[h] = lr * bbi + li * bbr; }
        bf16* TG = (bf16*)(F.ws + WS_TG) + ((size_t)l * SGN + g) * 1024 * UGP;
        if (tau <= 63) {
            bf16* BZ = (bf16*)(F.ws + WS_BZ) + ((size_t)l * SGN + g) * 256 * 1024; const int s = 63 - tau;
            u32x4 o0, o1, o2, o3;
            o0.x = pk2(wr[0], wr[1]); o0.y = pk2(wr[2], wr[3]); o0.z = pk2(wr[4], wr[5]); o0.w = pk2(wr[6], wr[7]); o1.x = pk2(wr[8], wr[9]); o1.y = pk2(wr[10], wr[11]); o1.z = pk2(wr[12], wr[13]); o1.w = pk2(wr[14], wr[15]);
            o2.x = pk2(wi[0], wi[1]); o2.y = pk2(wi[2], wi[3]); o2.z = pk2(wi[4], wi[5]); o2.w = pk2(wi[6], wi[7]); o3.x = pk2(wi[8], wi[9]); o3.y = pk2(wi[10], wi[11]); o3.z = pk2(wi[12], wi[13]); o3.w = pk2(wi[14], wi[15]);
            *(u32x4*)(BZ + (size_t)p * 1024 + s * 16) = o0; *(u32x4*)(BZ + (size_t)p * 1024 + s * 16 + 8) = o1;
            *(u32x4*)(BZ + (size_t)(64 + p) * 1024 + s * 16) = o2; *(u32x4*)(BZ + (size_t)(64 + p) * 1024 + s * 16 + 8) = o3;
        }
        LAS float* Wst = scr; LAS float* Kt = scr + 128 * 16;
        if (tau <= 63) {
#pragma unroll
            for (int q = 0; q < 4; ++q) { *(LAS f32x4*)(Wst + p * 16 + 4 * q) = (f32x4){wr[4 * q], wr[4 * q + 1], wr[4 * q + 2], wr[4 * q + 3]};
                                          *(LAS f32x4*)(Wst + (64 + p) * 16 + 4 * q) = (f32x4){wi[4 * q], wi[4 * q + 1], wi[4 * q + 2], wi[4 * q + 3]}; }
            const int arow = p & 15, kq = p >> 4; f32x4 kacc = (f32x4){0.f, 0.f, 0.f, 0.f};
            const float* cre = F.in[9] + ((size_t)(l * SGN + g) * SG + arow) * SP; const float* cim = F.in[10] + ((size_t)(l * SGN + g) * SG + arow) * SP;
#pragma unroll 8
            for (int s = 0; s < 32; ++s) { const int k = 4 * s + kq; const float av = (k < 64) ? cre[k] : -cim[k - 64]; const float bv = Wst[k * 16 + arow];
                kacc = __builtin_amdgcn_mfma_f32_16x16x4f32(av, bv, kacc, 0, 0, 0); }
#pragma unroll
            for (int r = 0; r < 4; ++r) Kt[(4 * kq + r) * 16 + arow] = kacc[r];
        }
#pragma unroll 1
        for (int ho = 0; ho < 16; ++ho) {
            const float ccr = F.in[9][((size_t)(l * SGN + g) * SG + ho) * SP + p], cci = F.in[10][((size_t)(l * SGN + g) * SG + ho) * SP + p];
            if (tau >= 1) { const int n = (tau - 1) * 16 + ho;
                TG[(size_t)n * UGP + 1024 + p] = (bf16)f2bf(ccr * lr - cci * li); TG[(size_t)n * UGP + 1088 + p] = (bf16)f2bf(-(ccr * li + cci * lr)); }
            if (tau <= 63) {
                float kv[16];
#pragma unroll
                for (int q = 0; q < 4; ++q) { const f32x4 t4 = *(const LAS f32x4*)(Kt + ho * 16 + 4 * q); kv[4 * q] = t4[0]; kv[4 * q + 1] = t4[1]; kv[4 * q + 2] = t4[2]; kv[4 * q + 3] = t4[3]; }
                u32x4 o0, o1; o0.x = pk2(kv[0], kv[1]); o0.y = pk2(kv[2], kv[3]); o0.z = pk2(kv[4], kv[5]); o0.w = pk2(kv[6], kv[7]); o1.x = pk2(kv[8], kv[9]); o1.y = pk2(kv[10], kv[11]); o1.z = pk2(kv[12], kv[13]); o1.w = pk2(kv[14], kv[15]);
                const int to = p;
                if (to >= tau) { bf16* d = TG + (size_t)(to * 16 + ho) * UGP + (to - tau) * 16; *(u32x4*)d = o0; *(u32x4*)(d + 8) = o1; }
                if (tau >= 1 && to + tau <= 63) { bf16* d = TG + (size_t)(to * 16 + ho) * UGP + (to + tau) * 16; const u32x4 z = (u32x4){0u, 0u, 0u, 0u}; *(u32x4*)d = z; *(u32x4*)(d + 8) = z; }
            }
        }
    }
}

__device__ __forceinline__ void route_token(float (&a)[20], float ssv, int m, int lane, const float* gb_, const float* rb_, int* tokb, float* tokr, float* tokw, LAS int* hist) {
        const float ssum = wave_sum(ssv);
#pragma unroll
        for (int j = 0; j < 20; ++j) a[j] = wave_sum(a[j]);
        const float rstd = 1.f / sqrtf(ssum * (1.f / D) + RMS_EPS);
        float lg0 = a[0] * rstd + gb_[0], lg1 = a[1] * rstd + gb_[1], lg2 = a[2] * rstd + gb_[2], lg3 = a[3] * rstd + gb_[3];
        int gs = 0; float gm = lg0;
        if (lg1 > gm) { gm = lg1; gs = 1; } if (lg2 > gm) { gm = lg2; gs = 2; } if (lg3 > gm) { gm = lg3; gs = 3; }
        const float gwt = 1.f / (__expf(lg0 - gm) + __expf(lg1 - gm) + __expf(lg2 - gm) + __expf(lg3 - gm));
        float q0 = a[4], q1 = a[5], q2 = a[6], q3 = a[7], q4 = a[8], q5 = a[9], q6 = a[10], q7 = a[11], q8 = a[12], q9 = a[13], q10 = a[14], q11 = a[15], q12 = a[16], q13 = a[17], q14 = a[18], q15 = a[19];
        asm volatile("" : "+v"(q0), "+v"(q1), "+v"(q2), "+v"(q3), "+v"(q4), "+v"(q5), "+v"(q6), "+v"(q7));
        asm volatile("" : "+v"(q8), "+v"(q9), "+v"(q10), "+v"(q11), "+v"(q12), "+v"(q13), "+v"(q14), "+v"(q15));
        float e0 = gs == 0 ? q0 : gs == 1 ? q4 : gs == 2 ? q8 : q12;
        float e1 = gs == 0 ? q1 : gs == 1 ? q5 : gs == 2 ? q9 : q13;
        float e2 = gs == 0 ? q2 : gs == 1 ? q6 : gs == 2 ? q10 : q14;
        float e3 = gs == 0 ? q3 : gs == 1 ? q7 : gs == 2 ? q11 : q15;
        e0 = e0 * rstd + rb_[gs * 4 + 0]; e1 = e1 * rstd + rb_[gs * 4 + 1]; e2 = e2 * rstd + rb_[gs * 4 + 2]; e3 = e3 * rstd + rb_[gs * 4 + 3];
        int t1 = 0; float v1 = e0;
        if (e1 > v1) { v1 = e1; t1 = 1; } if (e2 > v1) { v1 = e2; t1 = 2; } if (e3 > v1) { v1 = e3; t1 = 3; }
        int t2 = -1; float v2 = -3.0e38f;
        if (t1 != 0 && e0 > v2) { v2 = e0; t2 = 0; } if (t1 != 1 && e1 > v2) { v2 = e1; t2 = 1; } if (t1 != 2 && e2 > v2) { v2 = e2; t2 = 2; } if (t1 != 3 && e3 > v2) { v2 = e3; t2 = 3; }
        const float p2 = __expf(v2 - v1), w1 = gwt / (1.f + p2), w2 = gwt * p2 / (1.f + p2);
        const int lo = t1 < t2 ? t1 : t2, hi = t1 < t2 ? t2 : t1; const float wlo = t1 < t2 ? w1 : w2, whi = t1 < t2 ? w2 : w1;
        const int pi = lo == 0 ? hi - 1 : (lo == 1 ? hi + 1 : 5), bk = gs * 6 + pi;
        if (lane == 0) { tokb[m] = bk; tokr[m] = rstd; tokw[2 * m] = wlo; tokw[2 * m + 1] = whi; __hip_atomic_fetch_add(hist + bk, 1, __ATOMIC_RELAXED, __HIP_MEMORY_SCOPE_WORKGROUP); }
}
__device__ __forceinline__ void ph_route(const Ctx& F0, int l) {
    const Ctx F = launder(F0);
    LAS float* Wl = (LAS float*)F.lds;
    LAS int* hist = (LAS int*)(F.lds + 1024 * 20 * 4);
    const float* g2 = F.in[18] + l * D;
    const f32x4* gw4 = (const f32x4*)(F.in[19] + (size_t)l * D * 4); const f32x4* rw4 = (const f32x4*)(F.in[21] + (size_t)l * 4 * D * 4);
    const float* gb_ = F.in[20] + l * 4; const float* rb_ = F.in[22] + l * 16;
    for (int idx = F.tid; idx < D * 5; idx += NTHREADS) { const int k = idx % D, q = idx / D;
        f32x4 v = (q == 0) ? gw4[k] : rw4[(q - 1) * D + k]; v = v * g2[k];
        Wl[(q * 4 + 0) * D + k] = v[0]; Wl[(q * 4 + 1) * D + k] = v[1]; Wl[(q * 4 + 2) * D + k] = v[2]; Wl[(q * 4 + 3) * D + k] = v[3]; }
    if (F.tid < 32) hist[F.tid] = 0;
    __syncthreads();
    int* tokb = (int*)(F.ws + WS_TOKB); float* tokr = (float*)(F.ws + WS_TOKR); float* tokw = (float*)(F.ws + WS_TOKW);
#pragma unroll 1
    for (int i2 = 0; i2 < 16; i2 += 2) {
        const int m0 = F.vcu * 128 + F.wave * 16 + i2;
        const u32x2* xr = (const u32x2*)(P_XB(F) + (size_t)m0 * D) + F.lane;
        float a[2][20], ss[2];
#pragma unroll
        for (int t = 0; t < 2; ++t) { ss[t] = 0.f;
#pragma unroll
            for (int j = 0; j < 20; ++j) a[t][j] = 0.f; }
#pragma unroll 1
        for (int jj = 0; jj < 4; ++jj) { const u32x2 y0 = xr[64 * jj], y1 = xr[D / 4 + 64 * jj];
            const f32x4 x0 = (f32x4){bf2f(y0.x & 0xffffu), bf2f(y0.x >> 16), bf2f(y0.y & 0xffffu), bf2f(y0.y >> 16)}, x1 = (f32x4){bf2f(y1.x & 0xffffu), bf2f(y1.x >> 16), bf2f(y1.y & 0xffffu), bf2f(y1.y >> 16)};
            ss[0] += (x0[0] * x0[0] + x0[1] * x0[1]) + (x0[2] * x0[2] + x0[3] * x0[3]); ss[1] += (x1[0] * x1[0] + x1[1] * x1[1]) + (x1[2] * x1[2] + x1[3] * x1[3]);
#pragma unroll
            for (int j = 0; j < 20; ++j) { const f32x4 w = *(const LAS f32x4*)(Wl + j * D + 256 * jj + 4 * F.lane);
                a[0][j] += (x0[0] * w[0] + x0[1] * w[1]) + (x0[2] * w[2] + x0[3] * w[3]); a[1][j] += (x1[0] * w[0] + x1[1] * w[1]) + (x1[2] * w[2] + x1[3] * w[3]); } }
        route_token(a[0], ss[0], m0, F.lane, gb_, rb_, tokb, tokr, tokw, hist);
        route_token(a[1], ss[1], m0 + 1, F.lane, gb_, rb_, tokb, tokr, tokw, hist);
    }
    __syncthreads();
    if (F.tid < 24) __hip_atomic_store((int*)(F.ws + WS_WGCNT) + F.vcu * 24 + F.tid, hist[F.tid], __ATOMIC_RELAXED, __HIP_MEMORY_SCOPE_AGENT);
}
__device__ __forceinline__ void ph_place(const Ctx& F0) {
    const Ctx F = launder(F0);
    LAS int* ptot = (LAS int*)F.lds;
    LAS int* pbef = ptot + 512;
    LAS int* bstart = pbef + 512;
    LAS int* btot = bstart + 32;
    LAS int* carry = btot + 32;
    LAS int* rowidx = carry + 32;
    const int* wgcnt = (const int*)(F.ws + WS_WGCNT);
    int* rowtok = (int*)(F.ws + WS_ROWTOK); float* roww = (float*)(F.ws + WS_ROWW); int* tileb = (int*)(F.ws + WS_TILEB);
    const int* tokb = (const int*)(F.ws + WS_TOKB); const float* tokr = (const float*)(F.ws + WS_TOKR); const float* tokw = (const float*)(F.ws + WS_TOKW);
    { const int p = F.tid >> 5, b = F.tid & 31; int tot = 0, bef = 0;
      if (b < 24) for (int v = p * 16; v < p * 16 + 16; ++v) { const int c = wgcnt[v * 24 + b]; tot += c; if (v < F.vcu) bef += c; }
      ptot[p * 32 + b] = tot; pbef[p * 32 + b] = bef; }
    __syncthreads();
    if (F.tid < 32) { int tot = 0, bef = 0; for (int p = 0; p < 16; ++p) { tot += ptot[p * 32 + F.tid]; bef += pbef[p * 32 + F.tid]; } btot[F.tid] = tot; carry[F.tid] = bef; }
    __syncthreads();
    if (F.tid == 0) { int s = 0; for (int b = 0; b < 24; ++b) { bstart[b] = s; s += (btot[b] + 255) & ~255; } bstart[24] = s; }
    __syncthreads();
    if (F.tid < 24) carry[F.tid] += bstart[F.tid];
    if (F.vcu == 0) {
        if (F.tid == 0) tileb[0] = bstart[24] >> 8;
        for (int b = 0; b < 24; ++b) { const int s = bstart[b], e = bstart[b + 1];
            for (int t = (s >> 8) + F.tid; t < (e >> 8); t += NTHREADS) tileb[1 + t] = b;
            for (int r = s + btot[b] + F.tid; r < e; r += NTHREADS) __hip_atomic_store(rowtok + r, -1, __ATOMIC_RELAXED, __HIP_MEMORY_SCOPE_AGENT); }
    }
    __syncthreads();
    if (F.wave == 0) {
        for (int pass = 0; pass < 2; ++pass) { const int i = pass * 64 + F.lane, bi = tokb[F.vcu * 128 + i]; int row = 0;
#pragma unroll 1
            for (int b = 0; b < 24; ++b) { const unsigned long long mask = __ballot(bi == b); const int c = carry[b];
                if (bi == b) row = c + __builtin_popcountll(mask & ((1ull << F.lane) - 1ull));
                asm volatile("s_waitcnt lgkmcnt(0)" ::: "memory");
                if (F.lane == 0) carry[b] = c + __builtin_popcountll(mask);
                asm volatile("s_waitcnt lgkmcnt(0)" ::: "memory"); }
            rowidx[i] = row; }
    }
    __syncthreads();
    bf16* XS = (bf16*)(F.ws + WS_XS);
    for (int i = 0; i < 16; ++i) {
        const int li = F.wave * 16 + i, m = F.vcu * 128 + li, row = rowidx[li]; const float rstd = tokr[m];
        if (F.lane == 0) {
            __hip_atomic_store(rowtok + row, m, __ATOMIC_RELAXED, __HIP_MEMORY_SCOPE_AGENT);
            const unsigned long long w2 = (unsigned long long)__builtin_bit_cast(unsigned, tokw[2 * m]) | ((unsigned long long)__builtin_bit_cast(unsigned, tokw[2 * m + 1]) << 32);
            __hip_atomic_store((unsigned long long*)(roww + 2 * row), w2, __ATOMIC_RELAXED, __HIP_MEMORY_SCOPE_AGENT); }
        if (F.lane == 0) __hip_atomic_store((float*)(F.ws + WS_ROWR) + row, rstd, __ATOMIC_RELAXED, __HIP_MEMORY_SCOPE_AGENT);
        const u32x4* xr = (const u32x4*)(P_XB(F) + (size_t)m * D) + F.lane; u32x4* o16 = (u32x4*)(XS + (size_t)row * D) + F.lane;
        o16[0] = xr[0]; o16[64] = xr[64];
    }
}
struct MoeOrder {
    const int* tileb; int G, c; bool down;
    __device__ __forceinline__ bool next(int i, pg8::Unit& u) const {
        const GAS int* tb_ = (const GAS int*)tileb;
        const int NT = __builtin_amdgcn_readfirstlane(tb_[0]), L = i * G + c; if (L >= NT * 4) return false;
        const int rt = L >> 2, pn = L & 3, b = __builtin_amdgcn_readfirstlane(tb_[1 + rt]);
        if (down) { u.pm = rt; u.pn = b * 4 + pn; u.aux = pn; }
        else { int ea, eb; pair_decode(b % 6, ea, eb); const int e = (b / 6) * 4 + (pn < 2 ? ea : eb); u.pm = rt; u.pn = e * 2 + (pn & 1); u.aux = pn; }
        return true;
    }
};
struct EpiGU {
    static constexpr bool PERM = true;
    bf16* H; const float* roww; const float* rowr;
    __device__ __forceinline__ void operator()(const f32x4 (&acc)[2][2][4][2], const pg8::Unit& u, int wr, int wc, int fr_, int fq_) const {
        const int ln_ = lane_id(), fr = ln_ & 15, fq = ln_ >> 4; (void)fr_; (void)fq_;
        const int row0 = u.pm * 256 + wr * 64 + fr, cl = u.aux * 128 + 16 * wc + 4 * fq, ws = u.aux >> 1;
#pragma unroll
        for (int ai = 0; ai < 2; ++ai)
#pragma unroll
            for (int m = 0; m < 4; ++m) { const int r = row0 + ai * 128 + m * 16; const float rr = rowr[r], w = roww[2 * r + ws] * rr;
#pragma unroll
                for (int bj = 0; bj < 2; ++bj) { const f32x4 g = acc[ai][bj][m][0], up = acc[ai][bj][m][1]; f32x4 a;
#pragma unroll
                    for (int i = 0; i < 4; ++i) { const float gg = g[i] * rr; a[i] = gg * sigmoidf_(gg) * up[i] * w; }
                    u32x2 o; o.x = pg8::cvt_pk_bf16(a[0], a[1]); o.y = pg8::cvt_pk_bf16(a[2], a[3]);
                    *(u32x2*)(H + (size_t)r * 512 + cl + bj * 64) = o; } }
    }
};
struct EpiDown {
    static constexpr bool PERM = true;
    bf16* RB; const int* rowtok;
    __device__ __forceinline__ void operator()(const f32x4 (&acc)[2][2][4][2], const pg8::Unit& u, int wr, int wc, int fr_, int fq_) const {
        const int ln_ = lane_id(), fr = ln_ & 15, fq = ln_ >> 4; (void)fr_; (void)fq_;
        const int row0 = u.pm * 256 + wr * 64 + fr, col0 = u.aux * 256 + wc * 32 + 8 * fq;
#pragma unroll
        for (int ai = 0; ai < 2; ++ai)
#pragma unroll
            for (int m = 0; m < 4; ++m) { const int tok = rowtok[row0 + ai * 128 + m * 16];
                if (tok >= 0) { bf16* rp = RB + (size_t)tok * D + col0;
#pragma unroll
                    for (int bj = 0; bj < 2; ++bj) { const u32x4 x = *(const u32x4*)(rp + bj * 128); const f32x4 a0 = acc[ai][bj][m][0], a1 = acc[ai][bj][m][1]; u32x4 w;
                        w.x = pg8::cvt_pk_bf16(bf2f(x.x & 0xffffu) + a0[0], bf2f(x.x >> 16) + a0[1]); w.y = pg8::cvt_pk_bf16(bf2f(x.y & 0xffffu) + a0[2], bf2f(x.y >> 16) + a0[3]);
                        w.z = pg8::cvt_pk_bf16(bf2f(x.z & 0xffffu) + a1[0], bf2f(x.z >> 16) + a1[1]); w.w = pg8::cvt_pk_bf16(bf2f(x.w & 0xffffu) + a1[2], bf2f(x.w >> 16) + a1[3]);
                        *(u32x4*)(rp + bj * 128) = w; } }
                if (m & 1) asm volatile("" ::: "memory"); }
    }
};

struct SsmOrder { int G, c, mode;
    __device__ __forceinline__ bool next(int i, pg8::Unit& u) const { const int L = i * G + c;
        if (mode == 1) { if (L >= 32) return false; u.pm = L; u.pn = L >> 1; u.aux = 0; return true; }
        if (L >= 128) return false; const int g = L >> 3; u.pm = g * 2 + ((L >> 2) & 1); u.pn = g * 4 + (L & 3); u.aux = L & 3; return true; } };
struct HalfOrder { int L;
    __device__ __forceinline__ bool next(int i, pg8::Unit& u) const { if (i > 0 || L < 0 || L >= 128) return false; u.pm = L; u.pn = 0; u.aux = 0; return true; } };
struct EpiZ { static constexpr bool PERM = false; float* ZB;
    __device__ __forceinline__ void operator()(const f32x4 (&acc)[2][2][4][2], const pg8::Unit& u, int wr, int wc, int fr_, int fq_) const {
        const int ln_ = lane_id(), fr = ln_ & 15, fq = ln_ >> 4; (void)fr_; (void)fq_;
        const int row0 = u.pm * 256 + wr * 64 + fr, col0 = wc * 32 + 4 * fq;
#pragma unroll
        for (int ai = 0; ai < 2; ++ai)
#pragma unroll
            for (int m = 0; m < 4; ++m)
#pragma unroll
                for (int n = 0; n < 2; ++n) *(f32x4*)(ZB + (size_t)(row0 + ai * 128 + m * 16) * 128 + col0 + n * 16) = acc[ai][0][m][n];
    } };
struct EpiSsm2 { static constexpr bool PERM = true; const bf16* UG; bf16* YS; const float* dvec;
    __device__ __forceinline__ void operator()(const f32x4 (&acc)[2][2][4][2], const pg8::Unit& u, int wr, int wc, int fr_, int fq_) const {
        const int ln_ = lane_id(), fr = ln_ & 15, fq = ln_ >> 4; (void)fr_; (void)fq_;
        const int g = u.pm >> 1, cr0 = (u.pm & 1) * 256 + wr * 64 + fr;
#pragma unroll
        for (int bj = 0; bj < 2; ++bj) { const int n0 = u.aux * 256 + bj * 128 + wc * 32 + 8 * fq, to = n0 >> 4, ho0 = n0 & 15;
            const f32x4 d0 = *(const f32x4*)(dvec + g * 16 + ho0), d1 = *(const f32x4*)(dvec + g * 16 + ho0 + 4);
#pragma unroll
            for (int ai = 0; ai < 2; ++ai)
#pragma unroll
                for (int m = 0; m < 4; ++m) { const int cr = cr0 + ai * 128 + m * 16;
                    const u32x4 uu = *(const u32x4*)(UG + ((size_t)(g * 512 + cr)) * UGP + n0);
                    const f32x4 a0 = acc[ai][bj][m][0], a1 = acc[ai][bj][m][1]; float y[8];
                    y[0] = gelu_tanh(a0[0] + d0[0] * bf2f(uu.x & 0xffffu)); y[1] = gelu_tanh(a0[1] + d0[1] * bf2f(uu.x >> 16));
                    y[2] = gelu_tanh(a0[2] + d0[2] * bf2f(uu.y & 0xffffu)); y[3] = gelu_tanh(a0[3] + d0[3] * bf2f(uu.y >> 16));
                    y[4] = gelu_tanh(a1[0] + d1[0] * bf2f(uu.z & 0xffffu)); y[5] = gelu_tanh(a1[1] + d1[1] * bf2f(uu.z >> 16));
                    y[6] = gelu_tanh(a1[2] + d1[2] * bf2f(uu.w & 0xffffu)); y[7] = gelu_tanh(a1[3] + d1[3] * bf2f(uu.w >> 16));
                    u32x4 w; w.x = pg8::cvt_pk_bf16(y[0], y[1]); w.y = pg8::cvt_pk_bf16(y[2], y[3]); w.z = pg8::cvt_pk_bf16(y[4], y[5]); w.w = pg8::cvt_pk_bf16(y[6], y[7]);
                    *(u32x4*)(YS + ((size_t)cr * 64 + to) * 256 + g * 16 + ho0) = w; } }
    } };
struct EpiGluE { static constexpr bool PERM = true; const bf16* YS; bf16* YMIX; const float* gb;
    __device__ __forceinline__ void operator()(const f32x4 (&acc)[2][2][4][2], const pg8::Unit& u, int wr, int wc, int fr_, int fq_) const {
        const int ln_ = lane_id(), fr = ln_ & 15, fq = ln_ >> 4; (void)fr_; (void)fq_;
        const int row0 = u.pm * 256 + wr * 64 + fr;
#pragma unroll
        for (int bj = 0; bj < 2; ++bj) { const int n0 = bj * 128 + wc * 32 + 8 * fq; const f32x4 b0 = *(const f32x4*)(gb + n0), b1 = *(const f32x4*)(gb + n0 + 4);
#pragma unroll
            for (int ai = 0; ai < 2; ++ai)
#pragma unroll
                for (int m = 0; m < 4; ++m) { const size_t r = (size_t)(row0 + ai * 128 + m * 16); const u32x4 yy = *(const u32x4*)(YS + r * 256 + n0);
                    const f32x4 a0 = acc[ai][bj][m][0] + b0, a1 = acc[ai][bj][m][1] + b1; float o[8];
                    o[0] = bf2f(yy.x & 0xffffu) * sigmoidf_(a0[0]); o[1] = bf2f(yy.x >> 16) * sigmoidf_(a0[1]); o[2] = bf2f(yy.y & 0xffffu) * sigmoidf_(a0[2]); o[3] = bf2f(yy.y >> 16) * sigmoidf_(a0[3]);
                    o[4] = bf2f(yy.z & 0xffffu) * sigmoidf_(a1[0]); o[5] = bf2f(yy.z >> 16) * sigmoidf_(a1[1]); o[6] = bf2f(yy.w & 0xffffu) * sigmoidf_(a1[2]); o[7] = bf2f(yy.w >> 16) * sigmoidf_(a1[3]);
                    u32x4 w; w.x = pg8::cvt_pk_bf16(o[0], o[1]); w.y = pg8::cvt_pk_bf16(o[2], o[3]); w.z = pg8::cvt_pk_bf16(o[4], o[5]); w.w = pg8::cvt_pk_bf16(o[6], o[7]);
                    *(u32x4*)(YMIX + r * 1024 + n0) = w; } }
    } };
struct EpiPoolE { static constexpr bool PERM = true; bf16* YMIX; const float* pb; const float* ps;
    __device__ __forceinline__ void operator()(const f32x4 (&acc)[2][2][4][2], const pg8::Unit& u, int wr, int wc, int fr_, int fq_) const {
        const int ln_ = lane_id(), fr = ln_ & 15, fq = ln_ >> 4; (void)fr_; (void)fq_;
        const int row0 = u.pm * 256 + wr * 64 + fr;
#pragma unroll
        for (int bj = 0; bj < 2; ++bj) { const int n0 = bj * 128 + wc * 32 + 8 * fq; const f32x4 b0 = *(const f32x4*)(pb + n0), b1 = *(const f32x4*)(pb + n0 + 4), s0 = *(const f32x4*)(ps + n0), s1 = *(const f32x4*)(ps + n0 + 4);
#pragma unroll
            for (int ai = 0; ai < 2; ++ai)
#pragma unroll
                for (int m = 0; m < 4; ++m) { const size_t r = (size_t)(row0 + ai * 128 + m * 16);
                    const f32x4 a0 = (acc[ai][bj][m][0] + b0) * s0, a1 = (acc[ai][bj][m][1] + b1) * s1;
                    u32x4 w; w.x = pg8::cvt_pk_bf16(a0[0], a0[1]); w.y = pg8::cvt_pk_bf16(a0[2], a0[3]); w.z = pg8::cvt_pk_bf16(a1[0], a1[1]); w.w = pg8::cvt_pk_bf16(a1[2], a1[3]);
                    *(u32x4*)(YMIX + r * 1024 + 256 + n0) = w; } }
    } };
__device__ __forceinline__ void ph_ssm_scan(const Ctx& F0, int l) {
    const Ctx F = launder(F0);
    for (int it = F.vcu + F.G * F.wave; it < SGN * NB; it += F.G * NWAVES) {
        const int g = it >> 3, b = it & 7, p = F.lane;
        const float are = F.in[4][(l * SGN + g) * SP + p], aim = F.in[5][(l * SGN + g) * SP + p], dt = expf(F.in[6][l * SGN + g]);
        float sn, cs; sincosf(aim * dt * 64.f, &sn, &cs); const float mg = expf(are * dt * 64.f), lr = mg * cs, li = mg * sn;
        const float* Z = (const float*)(F.ws + WS_ZB) + ((size_t)g * 512 + b * 64) * 128;
        bf16* U = P_UG(F) + ((size_t)g * 512 + b * 64) * UGP + 1024;
        float sr = 0.f, si = 0.f;
#pragma unroll 1
        for (int c0 = 0; c0 < 64; c0 += 16) {
            float zr[16], zi[16];
#pragma unroll
            for (int j = 0; j < 16; ++j) { zr[j] = Z[(c0 + j) * 128 + p]; zi[j] = Z[(c0 + j) * 128 + 64 + p]; }
#pragma unroll
            for (int j = 0; j < 16; ++j) {
                U[(size_t)(c0 + j) * UGP + p] = (bf16)f2bf(sr); U[(size_t)(c0 + j) * UGP + 64 + p] = (bf16)f2bf(si);
                const float nr = lr * sr - li * si + zr[j], ni = lr * si + li * sr + zi[j]; sr = nr; si = ni; }
        }
    }
}

namespace moba {
using bf16x8 = __attribute__((ext_vector_type(8))) short;
using s16x4 = __attribute__((ext_vector_type(4))) short;
using f32x16 = __attribute__((ext_vector_type(16))) float;
typedef short v4i16_t __attribute__((ext_vector_type(4)));
typedef float f32x2_t __attribute__((ext_vector_type(2))); typedef __bf16 bf16x2_t __attribute__((ext_vector_type(2)));
constexpr int L_K = 0, L_V = 32768, L_TB = 65536, L_KM = L_TB + 768 * 4, L_END = L_KM + 16 * 64 * 4;
__device__ __forceinline__ unsigned cvtpk(float lo, float hi) { f32x2_t v = {lo, hi}; bf16x2_t b = __builtin_convertvector(v, bf16x2_t); return __builtin_bit_cast(unsigned, b); }
__device__ __forceinline__ s16x4 vtr(const LAS char* p) { return __builtin_bit_cast(s16x4, __builtin_amdgcn_ds_read_tr16_b64_v4i16((LAS v4i16_t*)p)); }
__device__ __forceinline__ float hmax(float v) { const unsigned u = __builtin_bit_cast(unsigned, v); auto r = __builtin_amdgcn_permlane32_swap(u, u, false, false); return fmaxf(__builtin_bit_cast(float, (unsigned)r[0]), __builtin_bit_cast(float, (unsigned)r[1])); }
__device__ __forceinline__ float hsum(float v) { const unsigned u = __builtin_bit_cast(unsigned, v); auto r = __builtin_amdgcn_permlane32_swap(u, u, false, false); return __builtin_bit_cast(float, (unsigned)r[0]) + __builtin_bit_cast(float, (unsigned)r[1]); }

__device__ __forceinline__ void unit(int wave_, int b, int h, int qb, const bf16* Q, const bf16* K, const bf16* V, bf16* O, const float* KMP, const float* BT, LAS char* lds) {
    int lane_ = lane_id(); asm volatile("" : "+v"(lane_)); asm volatile("" : "+s"(b), "+s"(h), "+s"(qb), "+s"(wave_));
    const int wid = wave_, lane = lane_, tid = wid * 64 + lane, r32 = lane & 31, hi = lane >> 5;
    const int NT = 4 * qb + 4, q0 = qb * 256; const size_t rowbase = (size_t)b * SEQ;
    LAS float* tb = (LAS float*)(lds + L_TB); LAS float* km = (LAS float*)(lds + L_KM);
    const float bfar = BT[h * 132 + 128];
    for (int i = tid; i < 768; i += NTHREADS) { const int rel = i - 256; tb[i] = rel < 0 ? -1.0e30f : (rel < 128 ? BT[h * 132 + rel] - bfar : 0.f); }
    for (int i = tid; i < 16 * 64; i += NTHREADS) { const int j = i >> 6, d = i & 63, pm = b * 16 + j; km[i] = KMP[pm * 512 + h * 64 + d] + KMP[128 * 512 + pm * 512 + h * 64 + d]; }
    const bf16* ksrc = K + (rowbase + lane) * 512 + h * 64 + wid * 8;
    const bf16* vsrc = V + (rowbase + 16 * (wid & 3) + (lane >> 2)) * 512 + h * 64 + (wid >> 2) * 32 + (lane & 3) * 8;
    u32x4 kreg0 = *(const u32x4*)ksrc, vreg0 = *(const u32x4*)vsrc, kreg1 = *(const u32x4*)(ksrc + (size_t)64 * 512), vreg1 = *(const u32x4*)(vsrc + (size_t)64 * 512);
    bf16x8 qr[4];
    { const bf16* qw = Q + (rowbase + q0 + wid * 32 + r32) * 512 + h * 64 + hi * 8;
#pragma unroll
      for (int d0 = 0; d0 < 4; ++d0) qr[d0] = *(const bf16x8*)(qw + d0 * 16); }
    __syncthreads();
    unsigned selmask = 1u << qb;
    { float g[16];
#pragma unroll
      for (int j = 0; j < 16; ++j) g[j] = 0.f;
#pragma unroll
      for (int d0 = 0; d0 < 4; ++d0)
#pragma unroll
          for (int e = 0; e < 8; ++e) { const float qf = bf2f((unsigned)(unsigned short)qr[d0][e]);
#pragma unroll
              for (int j = 0; j < 16; ++j) g[j] += qf * km[j * 64 + d0 * 16 + hi * 8 + e]; }
#pragma unroll
      for (int j = 0; j < 16; ++j) g[j] = hsum(g[j]);
#pragma unroll
      for (int s = 0; s < 3; ++s) { float bv = -3.0e38f; int bi = -1;
#pragma unroll
          for (int j = 0; j < 16; ++j) { const bool ok = (j < qb) && !((selmask >> j) & 1u) && (g[j] > bv); bv = ok ? g[j] : bv; bi = ok ? j : bi; }
          if (bi >= 0) selmask |= 1u << bi; } }
    { LAS char* kd = lds + L_K + wid * 1024 + lane * 16; LAS char* vd = lds + L_V + wid * 1024 + lane * 16;
      *(LAS u32x4*)kd = kreg0; *(LAS u32x4*)vd = vreg0; *(LAS u32x4*)(kd + 8192) = kreg1; *(LAS u32x4*)(vd + 8192) = vreg1; }
    __syncthreads();
    const int qrel = wid * 32 + r32;
    const LAS char* kp0 = lds + L_K + hi * 1024 + r32 * 16;
    const LAS char* vp0 = lds + L_V + ((lane >> 4) & 1) * 32 + (lane & 3) * 8 + (4 * hi + ((lane & 15) >> 2)) * 64;
    float mref = 0.f, l = 0.f; f32x16 o0 = f32x16{}, o1 = f32x16{}; f32x16 cvec; bool newc = true;
    if (__builtin_amdgcn_readfirstlane(wid) >= 4) __builtin_amdgcn_s_setprio(1);
#define MOBA_QK(P0, P1, KB) do { { const bf16x8 a0 = *(const LAS bf16x8*)(kp0 + (KB)), a1 = *(const LAS bf16x8*)(kp0 + (KB) + 512); \
          P0 = __builtin_amdgcn_mfma_f32_32x32x16_bf16(a0, qr[0], cvec, 0, 0, 0); P1 = __builtin_amdgcn_mfma_f32_32x32x16_bf16(a1, qr[0], cvec, 0, 0, 0); } \
        _Pragma("unroll") for (int d0 = 1; d0 < 4; ++d0) { const bf16x8 a0 = *(const LAS bf16x8*)(kp0 + (KB) + d0 * 2048), a1 = *(const LAS bf16x8*)(kp0 + (KB) + d0 * 2048 + 512); \
            P0 = __builtin_amdgcn_mfma_f32_32x32x16_bf16(a0, qr[d0], P0, 0, 0, 0); P1 = __builtin_amdgcn_mfma_f32_32x32x16_bf16(a1, qr[d0], P1, 0, 0, 0); } } while (0)
#define MOBA_NEAR(P0, P1, TT) do { const int jn_ = (TT) - (NT - 8); if (jn_ >= 0) { const LAS float* t0 = tb + (qrel - 64 * (jn_ - 4) - 4 * hi + 256); \
            _Pragma("unroll") for (int r = 0; r < 16; ++r) { const int k = (r & 3) + 8 * (r >> 2); P0[r] += t0[-k]; P1[r] += t0[-k - 32]; } } } while (0)
#define MOBA_MAX(P0, P1, OUT) do { float ra = __builtin_fmaxf(__builtin_fmaxf(P0[0], P0[1]), P1[0]), rb = __builtin_fmaxf(__builtin_fmaxf(P0[2], P0[3]), P1[1]); \
        ra = __builtin_fmaxf(__builtin_fmaxf(ra, P1[2]), P1[3]); \
        _Pragma("unroll") for (int r = 4; r < 16; r += 4) { ra = __builtin_fmaxf(__builtin_fmaxf(ra, P0[r]), P0[r + 1]); rb = __builtin_fmaxf(__builtin_fmaxf(rb, P0[r + 2]), P0[r + 3]); \
            ra = __builtin_fmaxf(__builtin_fmaxf(ra, P1[r]), P1[r + 1]); rb = __builtin_fmaxf(__builtin_fmaxf(rb, P1[r + 2]), P1[r + 3]); } \
        OUT = __builtin_fmaxf(ra, rb); } while (0)
#define MOBA_VLD(VF, VB) do { const LAS char* vp = vp0 + (VB); \
        _Pragma("unroll") for (int k = 0; k < 4; ++k) { \
            const s16x4 lo0 = vtr(vp + k * 1024), hi0 = vtr(vp + k * 1024 + 512), lo1 = vtr(vp + 4096 + k * 1024), hi1 = vtr(vp + 4096 + k * 1024 + 512); \
            VF[2 * k] = (bf16x8){lo0[0], lo0[1], lo0[2], lo0[3], hi0[0], hi0[1], hi0[2], hi0[3]}; VF[2 * k + 1] = (bf16x8){lo1[0], lo1[1], lo1[2], lo1[3], hi1[0], hi1[1], hi1[2], hi1[3]}; } } while (0)
#define MOBA_PV(P0, P1, VF) do { u32x4 pw[4]; \
        _Pragma("unroll") for (int q = 0; q < 4; ++q) { pw[0][q] = cvtpk(P0[2 * q], P0[2 * q + 1]); pw[1][q] = cvtpk(P0[8 + 2 * q], P0[9 + 2 * q]); pw[2][q] = cvtpk(P1[2 * q], P1[2 * q + 1]); pw[3][q] = cvtpk(P1[8 + 2 * q], P1[9 + 2 * q]); } \
        _Pragma("unroll") for (int k = 0; k < 4; ++k) { const bf16x8 pa = __builtin_bit_cast(bf16x8, pw[k]); \
            o0 = __builtin_amdgcn_mfma_f32_32x32x16_bf16(VF[2 * k], pa, o0, 0, 0, 0); o1 = __builtin_amdgcn_mfma_f32_32x32x16_bf16(VF[2 * k + 1], pa, o1, 0, 0, 0); } } while (0)
#pragma unroll 1
    for (int t = 0; t < NT; t += 2) {
        const int half = ((t >> 1) & 1) * 16384;
        if (t + 2 < NT) { kreg0 = *(const u32x4*)(ksrc + (size_t)(t + 2) * 64 * 512); vreg0 = *(const u32x4*)(vsrc + (size_t)(t + 2) * 64 * 512);
                          kreg1 = *(const u32x4*)(ksrc + (size_t)(t + 3) * 64 * 512); vreg1 = *(const u32x4*)(vsrc + (size_t)(t + 3) * 64 * 512); }
        if (newc || (t & 3) == 0) { const float ci = ((selmask >> (t >> 2)) & 1u) ? (bfar - mref) : -1.0e30f;
#pragma unroll
            for (int r = 0; r < 16; ++r) cvec[r] = ci;
            newc = false; }
        f32x16 pa0, pa1, pb0, pb1;
        MOBA_QK(pa0, pa1, half); MOBA_QK(pb0, pb1, half + 8192);
        bf16x8 vfa[8], vfb[8];
        MOBA_VLD(vfa, half); __builtin_amdgcn_sched_barrier(0);
        MOBA_NEAR(pa0, pa1, t); MOBA_NEAR(pb0, pb1, t + 1);
        float rma, rmb; MOBA_MAX(pa0, pa1, rma); MOBA_MAX(pb0, pb1, rmb);
        const float rm = hmax(__builtin_fmaxf(rma, rmb));
        if (__any(rm > 8.f)) {
            const float dl = __builtin_fmaxf(rm, 0.f), alpha = __builtin_amdgcn_exp2f(-dl);
            mref += dl; l *= alpha; newc = true;
#pragma unroll
            for (int r = 0; r < 16; ++r) { pa0[r] -= dl; pa1[r] -= dl; pb0[r] -= dl; pb1[r] -= dl; o0[r] *= alpha; o1[r] *= alpha; } }
        float s0 = 0.f, s1 = 0.f;
#pragma unroll
        for (int r = 0; r < 16; ++r) { pa0[r] = __builtin_amdgcn_exp2f(pa0[r]); pa1[r] = __builtin_amdgcn_exp2f(pa1[r]); s0 += pa0[r]; s1 += pa1[r]; }
        MOBA_VLD(vfb, half + 8192); __builtin_amdgcn_sched_barrier(0);
        MOBA_PV(pa0, pa1, vfa);
#pragma unroll
        for (int r = 0; r < 16; ++r) { pb0[r] = __builtin_amdgcn_exp2f(pb0[r]); pb1[r] = __builtin_amdgcn_exp2f(pb1[r]); s0 += pb0[r]; s1 += pb1[r]; }
        l += s0 + s1;
        MOBA_PV(pb0, pb1, vfb);
        if (t + 2 < NT) { const int nh = 16384 - half; LAS char* kd = lds + L_K + nh + wid * 1024 + lane * 16; LAS char* vd = lds + L_V + nh + wid * 1024 + lane * 16;
            *(LAS u32x4*)kd = kreg0; *(LAS u32x4*)vd = vreg0; *(LAS u32x4*)(kd + 8192) = kreg1; *(LAS u32x4*)(vd + 8192) = vreg1; }
        __syncthreads();
    }
    __builtin_amdgcn_s_setprio(0);
#undef MOBA_QK
#undef MOBA_NEAR
#undef MOBA_MAX
#undef MOBA_PV
#undef MOBA_VLD
    const float inv = 1.f / hsum(l);
    bf16* orow = O + (rowbase + q0 + wid * 32 + r32) * 1024 + 512 + h * 64 + 4 * hi;
#pragma unroll
    for (int g = 0; g < 4; ++g) { u32x2 w0, w1;
        w0.x = cvtpk(o0[4 * g] * inv, o0[4 * g + 1] * inv); w0.y = cvtpk(o0[4 * g + 2] * inv, o0[4 * g + 3] * inv);
        w1.x = cvtpk(o1[4 * g] * inv, o1[4 * g + 1] * inv); w1.y = cvtpk(o1[4 * g + 2] * inv, o1[4 * g + 3] * inv);
        *(u32x2*)(orow + 8 * g) = w0; *(u32x2*)(orow + 32 + 8 * g) = w1; }
}
__device__ __forceinline__ void phase(int wave, int vcu, const bf16* Q, const bf16* K, const bf16* V, bf16* O, const float* KMP, const float* BT, LAS char* lds) {
    if (vcu >= 256) return;
    const int s = vcu & 3, bh = vcu >> 2;
#pragma unroll 1
    for (int i = 0; i < 4; ++i) { const int qb = (i == 0) ? s : (i == 1) ? 7 - s : (i == 2) ? 8 + s : 15 - s; unit(wave, bh >> 3, bh & 7, qb, Q, K, V, O, KMP, BT, lds); }
}
}

__device__ __forceinline__ void ph_cvt_x(const Ctx& F0) {
    const Ctx F = launder(F0);
    const int gw = F.vcu * NWAVES + F.wave, NGW = F.G * NWAVES; float* rs1 = (float*)(F.ws + WS_RS1);
    for (int m = gw; m < T; m += NGW) {
        const f32x4* xr = (const f32x4*)(F.in[0] + (size_t)m * D) + F.lane;
        f32x4 v[4]; float s = 0.f;
#pragma unroll
        for (int j = 0; j < 4; ++j) { v[j] = xr[64 * j]; s += (v[j].x * v[j].x + v[j].y * v[j].y) + (v[j].z * v[j].z + v[j].w * v[j].w); }
        const float rstd = 1.f / sqrtf(wave_sum(s) * (1.f / D) + RMS_EPS);
        if (F.lane == 0) rs1[m] = rstd;
        unsigned long long* o8 = (unsigned long long*)(P_XB(F) + (size_t)m * D) + F.lane;
#pragma unroll
        for (int j = 0; j < 4; ++j) o8[64 * j] = (unsigned long long)pk2(v[j].x, v[j].y) | ((unsigned long long)pk2(v[j].z, v[j].w) << 32);
    }
}
__device__ __forceinline__ float row_ssq_bf16(const bf16* row, int lane) {
    const u32x4* xr = (const u32x4*)row + lane; float s = 0.f;
#pragma unroll
    for (int j = 0; j < 2; ++j) { const u32x4 x = xr[64 * j];
        const float a0 = bf2f(x.x & 0xffffu), a1 = bf2f(x.x >> 16), a2 = bf2f(x.y & 0xffffu), a3 = bf2f(x.y >> 16), a4 = bf2f(x.z & 0xffffu), a5 = bf2f(x.z >> 16), a6 = bf2f(x.w & 0xffffu), a7 = bf2f(x.w >> 16);
        s += ((a0 * a0 + a1 * a1) + (a2 * a2 + a3 * a3)) + ((a4 * a4 + a5 * a5) + (a6 * a6 + a7 * a7)); }
    return wave_sum(s);
}
__device__ __forceinline__ void ph_rstd(const Ctx& F0) {
    const Ctx F = launder(F0);
    const int gw = F.vcu * NWAVES + F.wave, NGW = F.G * NWAVES; float* rs1 = (float*)(F.ws + WS_RS1);
    for (int m = gw; m < T; m += NGW) { const float s = row_ssq_bf16(P_XB(F) + (size_t)m * D, F.lane); if (F.lane == 0) rs1[m] = 1.f / sqrtf(s * (1.f / D) + RMS_EPS); }
}

__device__ __forceinline__ void ph_bias_table(const Ctx& F0) {
    const Ctx F = launder(F0);
    if (F.vcu == 0) {
        const float* rel_bias = F.in[1];
        for (int i = F.tid; i < 8 * 132; i += NTHREADS) {
            const int h = i / 132, r = i % 132;
            int bk;
            if (r < 16) bk = r;
            else { bk = 16 + (int)(logf((float)r / 16.f) / logf(8.f) * 16.f); if (bk > 31) bk = 31; }
            P_BT(F)[i] = rel_bias[bk * 8 + h] * LOG2E;
        }
    }
}

__device__ __forceinline__ void ph_pool_dl(const Ctx& F0) {
    const Ctx F = launder(F0);
    const int gt = F.vcu * NTHREADS + F.tid, NGT = F.G * NTHREADS;
    for (int it = gt; it < (T / 32) * 128; it += NGT) {
        const int cp = it & 127, chunk = it >> 7, c = cp * 2, gi = c >> 6, win = 2 << gi, m0 = chunk * 32, t0 = m0 & (SEQ - 1);
        const unsigned* P2 = (const unsigned*)P_PB(F) + cp; unsigned* D2 = (unsigned*)P_DL(F) + cp;
        float s0 = 0.f, s1 = 0.f;
        const int back = (t0 < win) ? t0 : win;
        for (int j = 1; j <= back; ++j) { const unsigned v = P2[(size_t)(m0 - j) * 128]; s0 += bf2f(v & 0xffffu); s1 += bf2f(v >> 16); }
#pragma unroll 4
        for (int i = 0; i < 32; ++i) { const int m = m0 + i, t = t0 + i;
            const unsigned v = P2[(size_t)m * 128]; const float p0 = bf2f(v & 0xffffu), p1 = bf2f(v >> 16);
            s0 += p0; s1 += p1;
            if (t >= win) { const unsigned o = P2[(size_t)(m - win) * 128]; s0 -= bf2f(o & 0xffffu); s1 -= bf2f(o >> 16); }
            const float inv = 1.f / (float)((t + 1 < win) ? t + 1 : win);
            D2[(size_t)m * 128] = pk2(s0 * inv - p0, s1 * inv - p1); }
    }
}
__device__ __forceinline__ void ph_final(const Ctx& F0) {
    const Ctx F = launder(F0);
    const int gw = F.vcu * NWAVES + F.wave, NGW = F.G * NWAVES;
    const f32x4* gf = (const f32x4*)F.in[26];
    for (int m = gw; m < T; m += NGW) {
        const bf16* row = P_XB(F) + (size_t)m * D;
        const float rstd = 1.f / sqrtf(row_ssq_bf16(row, F.lane) * (1.f / D) + RMS_EPS);
        const u32x4* xr = (const u32x4*)row + F.lane; f32x4* orow = (f32x4*)(F.R + (size_t)m * D);
#pragma unroll
        for (int j = 0; j < 2; ++j) { const u32x4 x = xr[64 * j]; const int c4 = 2 * (64 * j + F.lane);
            orow[c4] = (f32x4){bf2f(x.x & 0xffffu), bf2f(x.x >> 16), bf2f(x.y & 0xffffu), bf2f(x.y >> 16)} * rstd * gf[c4];
            orow[c4 + 1] = (f32x4){bf2f(x.z & 0xffffu), bf2f(x.z >> 16), bf2f(x.w & 0xffffu), bf2f(x.w >> 16)} * rstd * gf[c4 + 1]; }
    }
}

constexpr int LDS_BYTES = 147456;
constexpr int MISC_OFF = 131072 + 320;

__global__ void __launch_bounds__(NTHREADS, 2) mk_fwd(Args args) {
    extern __shared__ __attribute__((aligned(16))) unsigned char lds[];
    Ctx F;
    F.lds = (LAS unsigned char*)lds;
    F.wave = __builtin_amdgcn_readfirstlane((int)threadIdx.x >> 6);
    F.lane = lane_id(); F.tid = F.wave * 64 + F.lane;
    F.G = gridDim.x; { const int bx = blockIdx.x; F.vcu = (F.G % 8 == 0) ? (bx % 8) * (F.G / 8) + bx / 8 : bx; }
    F.in = (KargP)__builtin_amdgcn_kernarg_segment_ptr(); F.R = args.out; F.ws = args.ws;
    unsigned char* ws = args.ws;
    volatile LAS unsigned* MISC = (volatile LAS unsigned*)(F.lds + MISC_OFF);
    if (F.tid < 64) MISC[F.tid] = 0u;
    __syncthreads();
    XcdBarrier bar = xcd_barrier_post((unsigned*)(ws + WS_CTL) + CW_BAR, MISC + 8, F.tid == 0);
#define GRID_BAR() do { bar.bar = (unsigned*)(wsl(ws) + WS_CTL) + CW_BAR; xcd_barrier(bar, F.wave); } while (0)
#define FL launder(F)

    ph_bias_table(F);
    ph_prologue(F);
#pragma unroll 1
    for (int l = 0; l < DEPTH; ++l) {
        if (l == 0) ph_cvt_x(F); else ph_rstd(F);
        GRID_BAR();
        { pg8::Gemm g{P_XB(FL), (const bf16*)(wsl(ws) + WS_WIN) + (size_t)l * NPROJ * D, D, D, D}; pg8::StaticOrder S; S.init(T, NPROJ, sl(F.G), sl((int)blockIdx.x));
          EpiProjE E{P_UG(FL), P_PB(FL), P_QB(FL), P_KB(FL), P_VB(FL), P_KMP(FL), (const float*)(wsl(ws) + WS_RS1)}; pg8::gemm_phase(F.lds, g, S, E, sl(F.wave)); }
        GRID_BAR();
        { pg8::Gemm g{P_UG(FL), (const bf16*)(wsl(ws) + WS_BZ) + (size_t)l * SGN * 256 * 1024, UGP, 1024, 1024}; SsmOrder S{sl(F.G), sl((int)blockIdx.x), 1};
          EpiZ E{(float*)(wsl(ws) + WS_ZB)}; pg8::gemm_phase(F.lds, g, S, E, sl(F.wave)); }
        ph_pool_dl(F);
        GRID_BAR();
        ph_ssm_scan(F, l);
        GRID_BAR();
        { pg8::Gemm g{P_UG(FL), (const bf16*)(wsl(ws) + WS_TG) + (size_t)l * SGN * 1024 * UGP, UGP, UGP, UGP}; SsmOrder S{sl(F.G), sl((int)blockIdx.x), 2};
          EpiSsm2 E{P_UG(FL), P_YS(FL), F.in[11] + l * 256}; pg8::gemm_phase(F.lds, g, S, E, sl(F.wave)); }
        GRID_BAR();
        { pg8::Gemm g{P_YS(FL), (const bf16*)(wsl(ws) + WS_GLUT) + (size_t)l * 65536, 256, 256, 256}; HalfOrder S{sl(F.vcu)};
          EpiGluE E{P_YS(FL), P_YMIX(FL), F.in[13] + l * 256}; pg8::gemm_phase(F.lds, g, S, E, sl(F.wave)); }
        { pg8::Gemm g{P_DL(FL), (const bf16*)(wsl(ws) + WS_POOLT) + (size_t)l * 65536, 256, 256, 256}; HalfOrder S{sl(F.vcu) - 128};
          EpiPoolE E{P_YMIX(FL), F.in[15] + l * 256, F.in[16] + l * 256}; pg8::gemm_phase(F.lds, g, S, E, sl(F.wave)); }
        moba::phase(sl(F.wave), sl(F.vcu), P_QB(FL), P_KB(FL), P_VB(FL), P_YMIX(FL), P_KMP(FL), P_BT(FL), (LAS char*)F.lds);
        GRID_BAR();
        { pg8::Gemm g{P_YMIX(FL), (const bf16*)(wsl(ws) + WS_WOUT) + (size_t)l * D * D, D, D, D}; pg8::StaticOrder S; S.init(T, D, sl(F.G), sl((int)blockIdx.x));
          EpiOutE E{P_XB(FL)}; pg8::gemm_phase(F.lds, g, S, E, sl(F.wave)); }
        GRID_BAR();
        ph_route(F, l);
        GRID_BAR();
        ph_place(F);
        GRID_BAR();
        { pg8::Gemm g{(const bf16*)(wsl(ws) + WS_XS), (const bf16*)(wsl(ws) + WS_GU) + (size_t)l * 16 * 512 * D, D, D, D}; MoeOrder S{(const int*)(wsl(ws) + WS_TILEB), sl(F.G), sl((int)blockIdx.x), false};
          EpiGU E{(bf16*)(wsl(ws) + WS_HACT), (const float*)(wsl(ws) + WS_ROWW), (const float*)(wsl(ws) + WS_ROWR)}; pg8::gemm_phase(F.lds, g, S, E, sl(F.wave)); }
        GRID_BAR();
        { pg8::Gemm g{(const bf16*)(wsl(ws) + WS_HACT), (const bf16*)(wsl(ws) + WS_WD) + (size_t)l * 24 * D * 512, 512, 512, 512}; MoeOrder S{(const int*)(wsl(ws) + WS_TILEB), sl(F.G), sl((int)blockIdx.x), true};
          EpiDown E{P_XB(FL), (const int*)(wsl(ws) + WS_ROWTOK)}; pg8::gemm_phase(F.lds, g, S, E, sl(F.wave)); }
        GRID_BAR();
    }
    ph_final(F);
}

extern "C" void kernel_launch(void* const* d_in, const int* in_sizes, int n_in, void* d_out, int out_size, void* d_ws, size_t ws_size, hipStream_t stream) {
    static int grid = 0;
    if (grid == 0) {
        if (n_in != 27 || out_size != T * D || ws_size < WS_END) { fprintf(stderr, "kernel_launch: unexpected shapes (n_in %d out %d ws %zu)\n", n_in, out_size, ws_size); grid = -1; return; }
        int dev = 0, cus = 0, per_cu = 0;
        if (hipGetDevice(&dev) != hipSuccess || hipDeviceGetAttribute(&cus, hipDeviceAttributeMultiprocessorCount, dev) != hipSuccess) { grid = -1; return; }
        if (hipFuncSetAttribute((const void*)mk_fwd, hipFuncAttributeMaxDynamicSharedMemorySize, LDS_BYTES) != hipSuccess) { fprintf(stderr, "kernel_launch: hipFuncSetAttribute failed\n"); grid = -1; return; }
        if (hipOccupancyMaxActiveBlocksPerMultiprocessor(&per_cu, (const void*)mk_fwd, NTHREADS, LDS_BYTES) != hipSuccess || per_cu < 1) { fprintf(stderr, "kernel_launch: occupancy query says %d\n", per_cu); per_cu = 1; }
        (void)hipGetLastError();
        grid = cus;
    }
    if (grid < 0) return;
    (void)hipMemsetAsync((char*)d_ws + WS_CTL, 0, CTL_ZERO_BYTES, stream);
    Args a{};
    for (int i = 0; i < 27; ++i) a.in[i] = (const float*)d_in[i];
    a.out = (float*)d_out; a.ws = (unsigned char*)d_ws; a.pad0 = 0; a.pad1 = 0;
    hipLaunchKernelGGL(mk_fwd, dim3(grid), dim3(NTHREADS), LDS_BYTES, stream, a);
}
```

```cpp
#include <hip/hip_runtime.h>
#include <hip/hip_bf16.h>
#include <cstdio>
#include <cstdint>

#define GAS __attribute__((address_space(1)))
#define LAS __attribute__((address_space(3)))
typedef unsigned short bf16;
typedef float f32x4 __attribute__((ext_vector_type(4)));
typedef unsigned u32x4 __attribute__((ext_vector_type(4)));
typedef unsigned u32x2 __attribute__((ext_vector_type(2)));

constexpr int NB = 8, SEQ = 4096, T = NB * SEQ, D = 1024, NPROJ = 2048, DEPTH = 2;
constexpr int NHEAD = 8, HD = 64, MBLK = 256, NBLK = SEQ / MBLK;
constexpr int SG = 16, SGN = 16, SP = 64, SCH = 64, UGP = 1152;
constexpr float RMS_EPS = 1e-6f;
constexpr float LOG2E = 1.4426950408889634f;
constexpr float C2 = 0.125f * LOG2E;
constexpr int NWAVES = 8, NTHREADS = 512;

constexpr size_t MiB = 1u << 20;
constexpr size_t WS_CTL = 0, CTL_ZERO_BYTES = 1 * MiB;
constexpr size_t WS_XB = 2 * MiB;
constexpr size_t WS_UG = 66 * MiB;
constexpr size_t WS_PB = 84 * MiB;
constexpr size_t WS_QB = 100 * MiB;
constexpr size_t WS_KB = 132 * MiB;
constexpr size_t WS_VB = 164 * MiB;
constexpr size_t WS_YMIX = 196 * MiB;
constexpr size_t WS_YS = 260 * MiB;
constexpr size_t WS_DL = 276 * MiB;
constexpr size_t WS_KMP = 292 * MiB;
constexpr size_t WS_BT = 293 * MiB;
constexpr size_t WS_WIN = 300 * MiB;
constexpr size_t WS_WOUT = 308 * MiB;
constexpr size_t WS_GU = 312 * MiB;
constexpr size_t WS_WD = 344 * MiB;
constexpr size_t WS_TG = 392 * MiB;
constexpr size_t WS_BZ = 464 * MiB;
constexpr size_t WS_GLUT = 480 * MiB;
constexpr size_t WS_POOLT = WS_GLUT + 512 * 1024;
constexpr size_t WS_ZB = 482 * MiB;
constexpr size_t WS_END = 486 * MiB;
constexpr int MOE_MAXT = 152;
constexpr size_t WS_XS = 66 * MiB;
constexpr size_t WS_HACT = 142 * MiB;
constexpr size_t WS_TOKB = 294 * MiB;
constexpr size_t WS_TOKR = WS_TOKB + 128 * 1024;
constexpr size_t WS_TOKW = WS_TOKB + 256 * 1024;
constexpr size_t WS_ROWTOK = 295 * MiB;
constexpr size_t WS_ROWW = WS_ROWTOK + 256 * 1024;
constexpr size_t WS_ROWR = WS_ROWTOK + 576 * 1024;
constexpr size_t WS_RS1 = WS_ROWTOK + 768 * 1024;
constexpr size_t WS_WGCNT = 296 * MiB;
constexpr size_t WS_TILEB = WS_WGCNT + 64 * 1024;

constexpr int CW_BAR = 4096;

__device__ __forceinline__ unsigned f2bf(float f) { unsigned u = __builtin_bit_cast(unsigned, f); return (u + 0x7fffu + ((u >> 16) & 1u)) >> 16; }
__device__ __forceinline__ float bf2f(unsigned h) { return __builtin_bit_cast(float, h << 16); }
__device__ __forceinline__ unsigned pk2(float lo, float hi) { return f2bf(lo) | (f2bf(hi) << 16); }
template <int O> __device__ __forceinline__ float xshfl(float v) {
    if constexpr (O < 32) return __builtin_bit_cast(float, __builtin_amdgcn_ds_swizzle(__builtin_bit_cast(int, v), (O << 10) | 0x1f));
    else { const unsigned u = __builtin_bit_cast(unsigned, v); auto r = __builtin_amdgcn_permlane32_swap(u, u, false, false);
           const float a = __builtin_bit_cast(float, (unsigned)r[0]), b = __builtin_bit_cast(float, (unsigned)r[1]); return (a == v && __builtin_bit_cast(unsigned, a) == u) ? b : a; }
}
__device__ __forceinline__ float wave_sum(float v) {
    v += xshfl<1>(v); v += xshfl<2>(v); v += xshfl<4>(v); v += xshfl<8>(v); v += xshfl<16>(v);
    const unsigned u = __builtin_bit_cast(unsigned, v); auto r = __builtin_amdgcn_permlane32_swap(u, u, false, false);
    return __builtin_bit_cast(float, (unsigned)r[0]) + __builtin_bit_cast(float, (unsigned)r[1]);
}
__device__ __forceinline__ float wave_max(float v) {
    v = fmaxf(v, xshfl<1>(v)); v = fmaxf(v, xshfl<2>(v)); v = fmaxf(v, xshfl<4>(v)); v = fmaxf(v, xshfl<8>(v)); v = fmaxf(v, xshfl<16>(v));
    const unsigned u = __builtin_bit_cast(unsigned, v); auto r = __builtin_amdgcn_permlane32_swap(u, u, false, false);
    return fmaxf(__builtin_bit_cast(float, (unsigned)r[0]), __builtin_bit_cast(float, (unsigned)r[1]));
}
__device__ __forceinline__ float gelu_tanh(float x) {
    const float u = 0.7978845608028654f * (x + 0.044715f * x * x * x);
    const float e = __expf(2.f * u);
    const float th = 1.f - 2.f / (e + 1.f);
    return 0.5f * x * (1.f + th);
}
__device__ __forceinline__ float sigmoidf_(float x) { return 1.f / (1.f + __expf(-x)); }

__device__ __forceinline__ int lane_id() { unsigned m; asm volatile("s_mov_b32 %0, -1" : "=s"(m)); return (int)__builtin_amdgcn_mbcnt_hi(m, __builtin_amdgcn_mbcnt_lo(m, 0u)); }

#define XB_TMO      128
#define XB_XCNT(j)  (256  + 64 * (j))
#define XB_XSUB(j)  (1280 + 64 * (j))
#define XB_XGEN(j)  (2304 + 64 * (j))
#define XB_TOP      3328
#define XB_TOPGEN   3392
#define XCD_BAR_WORDS 3456
#define XB_SPIN_CAP (1u << 22)
__device__ __forceinline__ unsigned xb_ld(unsigned* p)              { return __hip_atomic_load(p, __ATOMIC_RELAXED, __HIP_MEMORY_SCOPE_AGENT); }
__device__ __forceinline__ unsigned xb_add(unsigned* p, unsigned v) { return __hip_atomic_fetch_add(p, v, __ATOMIC_RELAXED, __HIP_MEMORY_SCOPE_AGENT); }
__device__ __forceinline__ unsigned xb_xcc_id() { return (unsigned)__builtin_amdgcn_s_getreg((3 << 11) | 20) & 0xFu; }
#define XB_SPIN(cond, bar) do { unsigned _sp = 0; while (cond) { __builtin_amdgcn_s_sleep(1); \
    if ((++_sp & 255u) == 0u) { if (xb_ld(&(bar)[XB_TMO])) break; if (_sp > XB_SPIN_CAP) { atomicAdd(&(bar)[XB_TMO], 1u); break; } } } } while (0)
struct XcdBarrier { unsigned* bar; unsigned x; volatile LAS unsigned* st; };
__device__ __forceinline__ XcdBarrier xcd_barrier_post(unsigned* bar, volatile LAS unsigned* st, bool t0) {
    XcdBarrier b; b.bar = bar; b.x = xb_xcc_id(); b.st = st;
    if (t0) (void)xb_add(&bar[XB_XCNT(b.x)], 1u);
    return b;
}
__device__ __forceinline__ void xcd_barrier_complete(unsigned* bar, unsigned x, unsigned& nloc, unsigned& nx) {
    const unsigned G = gridDim.x * gridDim.y * gridDim.z;
    unsigned sum, cnt, mine, sp = 0u;
    for (;;) {
        sum = 0u; cnt = 0u; mine = 0u;
#pragma unroll
        for (unsigned j = 0; j < 16; ++j) { const unsigned c = xb_ld(&bar[XB_XCNT(j)]); sum += c; cnt += (c > 0u) ? 1u : 0u; mine = (j == x) ? c : mine; }
        if (sum == G) break;
        __builtin_amdgcn_s_sleep(1);
        if ((++sp & 255u) == 0u) { if (xb_ld(&bar[XB_TMO])) break; if (sp > XB_SPIN_CAP) { atomicAdd(&bar[XB_TMO], 1u); break; } }
    }
    nloc = mine > 0u ? mine : 1u; nx = cnt > 0u ? cnt : 1u;
}
__device__ __forceinline__ void xcd_barrier(const XcdBarrier& b, int wave) {
    asm volatile("s_waitcnt vmcnt(0)" ::: "memory");
    __syncthreads();
    if (wave == 0 && lane_id() == 0) {
        unsigned* bar = b.bar;
        __builtin_amdgcn_s_waitcnt(0);
        unsigned nloc = b.st[0], nx = b.st[1];
        if (nloc == 0u) { xcd_barrier_complete(bar, b.x, nloc, nx); b.st[0] = nloc; b.st[1] = nx; }
        const unsigned old = xb_add(&bar[XB_XSUB(b.x)], 1u);
        const unsigned gen = old / nloc;
        if (old + 1u == (gen + 1u) * nloc) {
            __builtin_amdgcn_fence(__ATOMIC_RELEASE, "agent");
            asm volatile("s_waitcnt vmcnt(0)" ::: "memory");
            const unsigned og = xb_add(&bar[XB_TOP], 1u);
            const unsigned tg = og / nx;
            if (og + 1u == (tg + 1u) * nx) xb_add(&bar[XB_TOPGEN], 1u);
            else XB_SPIN(xb_ld(&bar[XB_TOPGEN]) == tg, bar);
            __builtin_amdgcn_fence(__ATOMIC_ACQUIRE, "agent");
            xb_add(&bar[XB_XGEN(b.x)], 1u);
            asm volatile("s_waitcnt vmcnt(0)" ::: "memory");
        } else {
            XB_SPIN(xb_ld(&bar[XB_XGEN(b.x)]) == gen, bar);
            __builtin_amdgcn_fence(__ATOMIC_ACQUIRE, "agent");
            asm volatile("s_waitcnt vmcnt(0)" ::: "memory");
        }
    }
    __syncthreads();
}

struct Args {
    const float* in[27];
    float* out;
    unsigned char* ws;
    int pad0, pad1;
};

typedef const float* fptr_t;
typedef __attribute__((address_space(4))) const fptr_t* KargP;
struct Ctx {
    LAS unsigned char* lds;
    int tid, lane, wave, vcu, G;
    KargP in;
    float* R;
    unsigned char* ws;
};
#define P_XB(F) ((bf16*)((F).ws + WS_XB))
#define P_UG(F) ((bf16*)((F).ws + WS_UG))
#define P_PB(F) ((bf16*)((F).ws + WS_PB))
#define P_QB(F) ((bf16*)((F).ws + WS_QB))
#define P_KB(F) ((bf16*)((F).ws + WS_KB))
#define P_VB(F) ((bf16*)((F).ws + WS_VB))
#define P_YMIX(F) ((bf16*)((F).ws + WS_YMIX))
#define P_YS(F) ((bf16*)((F).ws + WS_YS))
#define P_DL(F) ((bf16*)((F).ws + WS_DL))
#define P_KMP(F) ((float*)((F).ws + WS_KMP))
#define P_BT(F) ((float*)((F).ws + WS_BT))


__device__ __forceinline__ Ctx launder(const Ctx& F0) {
    Ctx F = F0;
    int ln = lane_id(); asm volatile("" : "+v"(ln));
    asm volatile("" : "+s"(F.wave), "+s"(F.vcu), "+s"(F.G));
    F.lane = ln; F.tid = F.wave * 64 + ln;
    KargP kp = (KargP)__builtin_amdgcn_kernarg_segment_ptr(); asm volatile("" : "+s"(kp));
    F.in = kp; F.R = (float*)kp[27]; F.ws = (unsigned char*)kp[28];
    return F;
}

__device__ __forceinline__ unsigned char* wsl(unsigned char* p) { asm volatile("" : "+s"(p)); return p; }
__device__ __forceinline__ int sl(int x) { asm volatile("" : "+s"(x)); return x; }

namespace pg8 {
typedef short bf16x8 __attribute__((ext_vector_type(8)));
constexpr int BM = 256, BK = 64, HALF = 128, HTB = HALF * BK * 2, STAGE_BYTES = 8 * HTB, NXCD = 8, WGM = 8;
__device__ __forceinline__ int lds_byte(int r, int c) { const int st = (r >> 4) * 2 + (c >> 5), rr = r & 15, cc = c & 31, ob = rr * 64 + cc * 2; return st * 1024 + (ob ^ (((ob >> 9) & 1) << 5)); }
__device__ __forceinline__ void stage_rc(int b, int& R, int& C) { const int st = b / 1024, sb = b % 1024, swz = sb ^ (((sb >> 9) & 1) << 5); R = (st >> 1) * 16 + swz / 64; C = (st & 1) * 32 + (swz % 64) / 2; }
__device__ __forceinline__ int perm32(int rho) { const int n = rho >> 4, i = rho & 15; return 8 * (i >> 2) + 4 * n + (i & 3); }

struct Unit { int pm, pn, aux; };
struct Gemm { const bf16* A; const bf16* Bt; int lda, ldb, K; };

struct StaticOrder {
    int nM, nN, nwg, G, c;
    __device__ void init(int M, int N, int G_, int c_) { nM = M / BM; nN = N / BM; nwg = nM * nN; G = G_; c = c_; }
    __device__ bool next(int i, Unit& u) const {
        const long L = (long)i * G + c; if (L >= nwg) return false;
        int wgid = (int)L; { const int q = nwg / NXCD, r = nwg % NXCD, xcd = wgid % NXCD, off = wgid / NXCD; wgid = (xcd < r ? xcd * (q + 1) : r * (q + 1) + (xcd - r) * q) + off; }
        const int nig = WGM * nN, gid = wgid / nig, fm = gid * WGM, gsz = (nM - fm) < WGM ? (nM - fm) : WGM;
        u.pm = fm + ((wgid % nig) % gsz); u.pn = (wgid % nig) / gsz; u.aux = 0; return true;
    }
};

__device__ __forceinline__ unsigned cvt_pk_bf16(float lo, float hi) { unsigned r; asm volatile("v_cvt_pk_bf16_f32 %0, %1, %2" : "=v"(r) : "v"(lo), "v"(hi)); return r; }

template <bool ALIGN = true, class Epi, class Sched>
__device__ __forceinline__ void gemm_phase(LAS unsigned char* lds, const Gemm g, const Sched& S, const Epi& E, int wave_) {
    int lane_ = lane_id(); asm volatile("" : "+v"(lane_)); asm volatile("" : "+s"(wave_));
    const int wid = wave_, lane = lane_, tid = wid * 64 + lane, wr = wid >> 2, wc = wid & 3, fr = lane & 15, fq = lane >> 4;
    const int K = g.K, nt = K / BK;
    unsigned voffA[2], voffB[2];
#pragma unroll
    for (int i = 0; i < 2; ++i) { int R, C; stage_rc(tid * 16 + i * 8192, R, C); const int Rb = Epi::PERM ? ((R & ~31) + perm32(R & 31)) : R;
        voffA[i] = (unsigned)(R * g.lda + C) * 2u; voffB[i] = (unsigned)(Rb * g.ldb + C) * 2u; }
    const size_t kstep = (size_t)(BK * 2);
    const size_t hstepA = (size_t)HALF * g.lda * 2, hstepB = (size_t)HALF * g.ldb * 2;
    const size_t tstepA = 2 * hstepA, tstepB = 2 * hstepB;
    const unsigned ldsw = (unsigned)wid * 1024u;
    const int aoff = lds_byte(wr * 64 + fr, fq * 8), boff = lds_byte(wc * 32 + fr, fq * 8);
#define PG8_SA(b, h) (((b) * 2 + (h)) * HTB)
#define PG8_SB(b, h) ((4 + (b) * 2 + (h)) * HTB)
#define PG8_STAGE(bufoff, gbase, voff) do { _Pragma("unroll") for (int _i = 0; _i < 2; ++_i) \
        __builtin_amdgcn_global_load_lds((const unsigned*)((const char*)(gbase) + (voff)[_i]), (LAS unsigned*)(lds + (bufoff) + ldsw + _i * 8192), 16, 0, 0); } while (0)
#define PG8_LDA(dst, b, h) do { _Pragma("unroll") for (int m = 0; m < 4; ++m) _Pragma("unroll") for (int k = 0; k < 2; ++k) dst[m][k] = *(const LAS bf16x8*)(lds + PG8_SA(b, h) + aoff + m * 2048 + k * 1024); } while (0)
#define PG8_LDB(dst, b, h) do { _Pragma("unroll") for (int n = 0; n < 2; ++n) _Pragma("unroll") for (int k = 0; k < 2; ++k) dst[n][k] = *(const LAS bf16x8*)(lds + PG8_SB(b, h) + boff + n * 2048 + k * 1024); } while (0)
#define PG8_MMA(ai, bj, At, Bt) do { __builtin_amdgcn_s_setprio(1); _Pragma("unroll") for (int m = 0; m < 4; ++m) _Pragma("unroll") for (int n = 0; n < 2; ++n) _Pragma("unroll") for (int k = 0; k < 2; ++k) \
        acc[ai][bj][m][n] = __builtin_amdgcn_mfma_f32_16x16x32_bf16(Bt[n][k], At[m][k], acc[ai][bj][m][n], 0, 0, 0); __builtin_amdgcn_s_setprio(0); } while (0)
#define PG8_WAIT_V(n) asm volatile("s_waitcnt vmcnt(" #n ")" ::: "memory")
#define PG8_WAIT_L(n) asm volatile("s_waitcnt lgkmcnt(" #n ")" ::: "memory")
#define PG8_BAR __builtin_amdgcn_s_barrier()
#define PG8_SCHED __builtin_amdgcn_sched_barrier(0)
    Unit cur, nxt; int ui = 0;
    if (!S.next(0, cur)) return;
    f32x4 acc[2][2][4][2];
#pragma unroll
    for (int a = 0; a < 2; ++a)
#pragma unroll
        for (int b = 0; b < 2; ++b)
#pragma unroll
            for (int m = 0; m < 4; ++m)
#pragma unroll
                for (int n = 0; n < 2; ++n) acc[a][b][m][n] = (f32x4){0.f, 0.f, 0.f, 0.f};
    bf16x8 At[4][2], B0[2][2], B1[2][2];
    const char* cA = (const char*)g.A + (size_t)cur.pm * tstepA; const char* cB = (const char*)g.Bt + (size_t)cur.pn * tstepB;
    PG8_STAGE(PG8_SB(0, 0), cB, voffB); PG8_STAGE(PG8_SB(0, 1), cB + hstepB, voffB); PG8_STAGE(PG8_SA(0, 0), cA, voffA); PG8_STAGE(PG8_SA(0, 1), cA + hstepA, voffA);
    if (wr == 1) PG8_BAR;
    PG8_WAIT_V(2); PG8_BAR;
    PG8_STAGE(PG8_SB(1, 0), cB + kstep, voffB); PG8_STAGE(PG8_SA(1, 0), cA + kstep, voffA); PG8_STAGE(PG8_SB(1, 1), cB + hstepB + kstep, voffB);
    PG8_WAIT_V(6); PG8_BAR;
    for (;;) {
        const bool has_next = S.next(ui + 1, nxt);
        const char* nA = has_next ? (const char*)g.A + (size_t)nxt.pm * tstepA : cA; const char* nB = has_next ? (const char*)g.Bt + (size_t)nxt.pn * tstepB : cB;
        for (int t = 0; t < nt; t += 2) {
            const bool last = (t == nt - 2);
            const char* a1 = cA + (size_t)(t + 1) * kstep;
            const char* a2 = last ? nA : cA + (size_t)(t + 2) * kstep; const char* b2 = last ? nB : cB + (size_t)(t + 2) * kstep;
            const char* a3 = a2 + kstep; const char* b3 = b2 + kstep;
            PG8_LDB(B0, 0, 0); PG8_LDB(B1, 0, 1); PG8_SCHED; PG8_LDA(At, 0, 0); PG8_STAGE(PG8_SA(1, 1), a1 + hstepA, voffA);
            PG8_WAIT_V(8); PG8_WAIT_L(0); PG8_BAR; PG8_MMA(0, 0, At, B0); PG8_MMA(0, 1, At, B1); PG8_BAR; PG8_SCHED;
            PG8_LDA(At, 0, 1); PG8_STAGE(PG8_SB(0, 0), b2, voffB); PG8_STAGE(PG8_SB(0, 1), b2 + hstepB, voffB); PG8_STAGE(PG8_SA(0, 0), a2, voffA);
            PG8_WAIT_V(8); PG8_WAIT_L(0); PG8_BAR; PG8_MMA(1, 0, At, B0); PG8_MMA(1, 1, At, B1); PG8_BAR; PG8_SCHED;
            PG8_LDB(B0, 1, 0); PG8_LDB(B1, 1, 1); PG8_SCHED; PG8_LDA(At, 1, 0); PG8_STAGE(PG8_SA(0, 1), a2 + hstepA, voffA);
            PG8_WAIT_V(8); PG8_WAIT_L(0); PG8_BAR; PG8_MMA(0, 0, At, B0); PG8_MMA(0, 1, At, B1); PG8_BAR; PG8_SCHED;
            PG8_LDA(At, 1, 1); PG8_STAGE(PG8_SB(1, 0), b3, voffB); PG8_STAGE(PG8_SB(1, 1), b3 + hstepB, voffB); PG8_STAGE(PG8_SA(1, 0), a3, voffA);
            PG8_WAIT_V(8); PG8_WAIT_L(0); PG8_BAR; PG8_MMA(1, 0, At, B0); PG8_MMA(1, 1, At, B1); PG8_BAR; PG8_SCHED;
        }
        if constexpr (ALIGN) { if (wr == 0) PG8_BAR; }
        E(acc, cur, wr, wc, fr, fq);
        if (!has_next) break;
#pragma unroll
        for (int a = 0; a < 2; ++a)
#pragma unroll
            for (int b = 0; b < 2; ++b)
#pragma unroll
                for (int m = 0; m < 4; ++m)
#pragma unroll
                    for (int n = 0; n < 2; ++n) acc[a][b][m][n] = (f32x4){0.f, 0.f, 0.f, 0.f};
        cur = nxt; cA = nA; cB = nB; ++ui;
        if constexpr (ALIGN) { if (wr == 1) PG8_BAR; }
    }
    PG8_WAIT_V(0);
    if constexpr (!ALIGN) { if (wr == 0) PG8_BAR; }
    PG8_BAR;
#undef PG8_SA
#undef PG8_SB
#undef PG8_STAGE
#undef PG8_LDA
#undef PG8_LDB
#undef PG8_MMA
#undef PG8_WAIT_V
#undef PG8_WAIT_L
#undef PG8_BAR
#undef PG8_SCHED
}
}


struct EpiProjE {
    static constexpr bool PERM = true;
    bf16 *UG, *PB, *QB, *KB, *VB; float* KMP; const float* rs1;
    __device__ __forceinline__ void operator()(const f32x4 (&acc_)[2][2][4][2], const pg8::Unit& u, int wr, int wc, int fr_, int fq_) const {
        const int ln_ = lane_id(), fr = ln_ & 15, fq = ln_ >> 4; (void)fr_; (void)fq_;
        const int pn = u.pn, row0 = u.pm * 256 + wr * 64 + fr, cl = wc * 32 + 8 * fq;
        f32x4 acc[2][2][4][2];
#pragma unroll
        for (int ai = 0; ai < 2; ++ai)
#pragma unroll
            for (int m = 0; m < 4; ++m) { const float rs = rs1[row0 + ai * 128 + m * 16];
#pragma unroll
                for (int bj = 0; bj < 2; ++bj) { acc[ai][bj][m][0] = acc_[ai][bj][m][0] * rs; acc[ai][bj][m][1] = acc_[ai][bj][m][1] * rs; } }
        if (pn == 0) {
#pragma unroll
            for (int ai = 0; ai < 2; ++ai)
#pragma unroll
                for (int m = 0; m < 4; ++m) { const int r = row0 + ai * 128 + m * 16;
#pragma unroll
                    for (int bj = 0; bj < 2; ++bj) { const int ch = bj * 128 + cl, g = ch >> 4, h0 = ch & 15;
                        const f32x4 v0 = acc[ai][bj][m][0], v1 = acc[ai][bj][m][1]; u32x4 w;
                        w.x = pg8::cvt_pk_bf16(v0[0], v0[1]); w.y = pg8::cvt_pk_bf16(v0[2], v0[3]); w.z = pg8::cvt_pk_bf16(v1[0], v1[1]); w.w = pg8::cvt_pk_bf16(v1[2], v1[3]);
                        *(u32x4*)(UG + ((size_t)(g * 512 + (r >> 6))) * UGP + (r & 63) * 16 + h0) = w; } }
        } else {
            bf16* base; int ldc, colt; float sc = 1.f;
            if (pn == 1) { base = PB; ldc = 256; colt = 0; }
            else if (pn < 4) { base = QB; ldc = 512; colt = (pn - 2) * 256; sc = C2; }
            else if (pn < 6) { base = KB; ldc = 512; colt = (pn - 4) * 256; }
            else { base = VB; ldc = 512; colt = (pn - 6) * 256; }
#pragma unroll
            for (int ai = 0; ai < 2; ++ai)
#pragma unroll
                for (int m = 0; m < 4; ++m) { bf16* rowp = base + (size_t)(row0 + ai * 128 + m * 16) * ldc + colt + cl;
#pragma unroll
                    for (int bj = 0; bj < 2; ++bj) { const f32x4 v0 = acc[ai][bj][m][0] * sc, v1 = acc[ai][bj][m][1] * sc; u32x4 w;
                        w.x = pg8::cvt_pk_bf16(v0[0], v0[1]); w.y = pg8::cvt_pk_bf16(v0[2], v0[3]); w.z = pg8::cvt_pk_bf16(v1[0], v1[1]); w.w = pg8::cvt_pk_bf16(v1[2], v1[3]);
                        *(u32x4*)(rowp + bj * 128) = w; } }
            if (pn >= 4 && pn < 6) {
#pragma unroll
                for (int bj = 0; bj < 2; ++bj)
#pragma unroll
                    for (int n = 0; n < 2; ++n) { f32x4 s = (f32x4){0.f, 0.f, 0.f, 0.f};
#pragma unroll
                        for (int ai = 0; ai < 2; ++ai)
#pragma unroll
                            for (int m = 0; m < 4; ++m) s += acc[ai][bj][m][n];
#pragma unroll
                        for (int i = 0; i < 4; ++i) { float t = s[i]; t += xshfl<1>(t); t += xshfl<2>(t); t += xshfl<4>(t); t += xshfl<8>(t); s[i] = t; }
                        if (fr == 0) *(f32x4*)(KMP + (size_t)wr * 128 * 512 + (size_t)u.pm * 512 + colt + bj * 128 + cl + 4 * n) = s; }
            }
        }
    }
};
struct EpiOutE {
    static constexpr bool PERM = true;
    bf16* RB;
    __device__ __forceinline__ void operator()(const f32x4 (&acc)[2][2][4][2], const pg8::Unit& u, int wr, int wc, int fr_, int fq_) const {
        const int ln_ = lane_id(), fr = ln_ & 15, fq = ln_ >> 4; (void)fr_; (void)fq_;
        const int row0 = u.pm * 256 + wr * 64 + fr, col0 = u.pn * 256 + wc * 32 + 8 * fq;
#pragma unroll
        for (int ai = 0; ai < 2; ++ai)
#pragma unroll
            for (int m = 0; m < 4; ++m) { bf16* rp = RB + (size_t)(row0 + ai * 128 + m * 16) * D + col0;
#pragma unroll
                for (int bj = 0; bj < 2; ++bj) { const u32x4 x = *(const u32x4*)(rp + bj * 128); const f32x4 a0 = acc[ai][bj][m][0], a1 = acc[ai][bj][m][1]; u32x4 w;
                    w.x = pg8::cvt_pk_bf16(bf2f(x.x & 0xffffu) + a0[0], bf2f(x.x >> 16) + a0[1]); w.y = pg8::cvt_pk_bf16(bf2f(x.y & 0xffffu) + a0[2], bf2f(x.y >> 16) + a0[3]);
                    w.z = pg8::cvt_pk_bf16(bf2f(x.z & 0xffffu) + a1[0], bf2f(x.z >> 16) + a1[1]); w.w = pg8::cvt_pk_bf16(bf2f(x.w & 0xffffu) + a1[2], bf2f(x.w >> 16) + a1[3]);
                    *(u32x4*)(rp + bj * 128) = w; }
                if (m & 1) asm volatile("" ::: "memory"); }
    }
};

__device__ __forceinline__ void transpose_item(const float* W, int K, int N, const float* kscale, bf16* WT, int ldo, int koff, int rowmode, LAS float* scr, int item, int lane) {
    const int nblk = N / 32, kb = item / nblk, nb = item % nblk, k0 = 64 * kb, n0 = 32 * nb;
#pragma unroll 8
    for (int i = 0; i < 32; ++i) { const int kk = 2 * i + (lane >> 5); const float s = kscale ? kscale[k0 + kk] : 1.f; scr[kk * 33 + (lane & 31)] = W[(size_t)(k0 + kk) * N + n0 + (lane & 31)] * s; }
    asm volatile("s_waitcnt lgkmcnt(0)" ::: "memory");
    const int c = lane & 7;
#pragma unroll
    for (int j = 0; j < 4; ++j) { const int n = (lane >> 3) + 8 * j; const LAS float* s = scr + (8 * c) * 33 + n;
        u32x4 o; o.x = pk2(s[0 * 33], s[1 * 33]); o.y = pk2(s[2 * 33], s[3 * 33]); o.z = pk2(s[4 * 33], s[5 * 33]); o.w = pk2(s[6 * 33], s[7 * 33]);
        const int nn = n0 + n, row = rowmode == 0 ? nn : (8 * (nn >> 2) + (nn & 3) + (rowmode == 2 ? 4 : 0));
        *(u32x4*)(WT + (size_t)row * ldo + koff + k0 + 8 * c) = o; }
    asm volatile("s_waitcnt lgkmcnt(0)" ::: "memory");
}
__device__ __forceinline__ void pair_decode(int pi, int& ea, int& eb) { ea = pi < 3 ? 0 : (pi < 5 ? 1 : 2); eb = pi < 3 ? pi + 1 : (pi < 5 ? pi - 1 : 3); }
__device__ __forceinline__ void ph_prologue(const Ctx& F0) {
    const Ctx F = launder(F0);
    LAS float* scr = (LAS float*)(F.lds + F.wave * 16384);
    const int gw = F.vcu * NWAVES + F.wave, NGW = F.G * NWAVES;
    constexpr int I_IN = (D / 64) * (NPROJ / 32), I_OUT = (D / 64) * (D / 32), I_GU1 = (D / 64) * (256 / 32), I_GU = 16 * 2 * I_GU1, I_WD1 = (256 / 64) * (D / 32), I_WD = 24 * 2 * I_WD1;
    constexpr int I_L = I_IN + I_OUT + I_GU + I_WD;
    for (int it = gw; it < DEPTH * I_L; it += NGW) {
        const int l = it / I_L; int r = it % I_L;
        if (r < I_IN) { transpose_item(F.in[3] + (size_t)l * D * NPROJ, D, NPROJ, F.in[2] + l * D, (bf16*)(F.ws + WS_WIN) + (size_t)l * NPROJ * D, D, 0, 0, scr, r, F.lane); continue; } r -= I_IN;
        if (r < I_OUT) { transpose_item(F.in[17] + (size_t)l * D * D, D, D, nullptr, (bf16*)(F.ws + WS_WOUT) + (size_t)l * D * D, D, 0, 0, scr, r, F.lane); continue; } r -= I_OUT;
        if (r < I_GU) { const int e = r / (2 * I_GU1), up = (r / I_GU1) & 1, item = r % I_GU1;
            transpose_item(F.in[up ? 24 : 23] + ((size_t)l * 16 + e) * D * 256, D, 256, F.in[18] + l * D, (bf16*)(F.ws + WS_GU) + ((size_t)l * 16 + e) * 512 * D, D, 0, 1 + up, scr, item, F.lane); continue; } r -= I_GU;
        { const int bk = r / (2 * I_WD1), half = (r / I_WD1) & 1, item = r % I_WD1, g = bk / 6; int ea, eb; pair_decode(bk % 6, ea, eb); const int e = g * 4 + (half ? eb : ea);
            transpose_item(F.in[25] + ((size_t)l * 16 + e) * 256 * D, 256, D, nullptr, (bf16*)(F.ws + WS_WD) + ((size_t)l * 24 + bk) * D * 512, 512, half * 256, 0, scr, item, F.lane); }
    }
    for (int it = gw; it < DEPTH * 32; it += NGW) { const int l = it >> 5;
        transpose_item(F.in[12] + (size_t)l * 256 * 256, 256, 256, nullptr, (bf16*)(F.ws + WS_GLUT) + (size_t)l * 65536, 256, 0, 0, scr, it & 31, F.lane); }
    { const int gt = F.vcu * NTHREADS + F.tid, NGT = F.G * NTHREADS;
      for (int i = gt; i < DEPTH * 65536; i += NGT) { const int l = i >> 16, n = (i >> 8) & 255, k = i & 255;
          const float v = ((n >> 6) == (k >> 6)) ? F.in[14][(((size_t)l * 4 + (n >> 6)) * 64 + (k & 63)) * 64 + (n & 63)] : 0.f;
          ((bf16*)(F.ws + WS_POOLT))[i] = (bf16)f2bf(v); } }
    for (int it = gw; it < DEPTH * SGN * 65; it += NGW) {
        const int l = it / (SGN * 65), g = (it / 65) % SGN, tau = it % 65, p = F.lane;
        const float are = F.in[4][(l * SGN + g) * SP + p], aim = F.in[5][(l * SGN + g) * SP + p], dt = expf(F.in[6][l * SGN + g]);
        float sn, cs; sincosf(aim * dt, &sn, &cs); const float mg = expf(are * dt), lbr = mg * cs, lbi = mg * sn;
        const float nr = lbr - 1.f, ni = lbi, den = are * are + aim * aim, cr = (nr * are + ni * aim) / den, ci = (ni * are - nr * aim) / den;
        float sn2, cs2; sincosf(aim * dt * (float)tau, &sn2, &cs2); const float mg2 = expf(are * dt * (float)tau), lr = mg2 * cs2, li = mg2 * sn2;
        float wr[16], wi[16];
#pragma unroll
        for (int h = 0; h < 16; ++h) { const float br = F.in[7][((size_t)(l * SGN + g) * SP + p) * SG + h], bi = F.in[8][((size_t)(l * SGN + g) * SP + p) * SG + h];
            const float bbr = cr * br - ci * bi, bbi = cr * bi + ci * br; wr[h] = lr * bbr - li * bbi; wi[h] = lr * bbi + li * bbr; }
        bf16* TG = (bf16*)(F.ws + WS_TG) + ((size_t)l * SGN + g) * 1024 * UGP;
        if (tau <= 63) {
            bf16* BZ = (bf16*)(F.ws + WS_BZ) + ((size_t)l * SGN + g) * 256 * 1024; const int s = 63 - tau;
            u32x4 o0, o1, o2, o3;
            o0.x = pk2(wr[0], wr[1]); o0.y = pk2(wr[2], wr[3]); o0.z = pk2(wr[4], wr[5]); o0.w = pk2(wr[6], wr[7]); o1.x = pk2(wr[8], wr[9]); o1.y = pk2(wr[10], wr[11]); o1.z = pk2(wr[12], wr[13]); o1.w = pk2(wr[14], wr[15]);
            o2.x = pk2(wi[0], wi[1]); o2.y = pk2(wi[2], wi[3]); o2.z = pk2(wi[4], wi[5]); o2.w = pk2(wi[6], wi[7]); o3.x = pk2(wi[8], wi[9]); o3.y = pk2(wi[10], wi[11]); o3.z = pk2(wi[12], wi[13]); o3.w = pk2(wi[14], wi[15]);
            *(u32x4*)(BZ + (size_t)p * 1024 + s * 16) = o0; *(u32x4*)(BZ + (size_t)p * 1024 + s * 16 + 8) = o1;
            *(u32x4*)(BZ + (size_t)(64 + p) * 1024 + s * 16) = o2; *(u32x4*)(BZ + (size_t)(64 + p) * 1024 + s * 16 + 8) = o3;
        }
        LAS float* Wst = scr; LAS float* Kt = scr + 128 * 16;
        if (tau <= 63) {
#pragma unroll
            for (int q = 0; q < 4; ++q) { *(LAS f32x4*)(Wst + p * 16 + 4 * q) = (f32x4){wr[4 * q], wr[4 * q + 1], wr[4 * q + 2], wr[4 * q + 3]};
                                          *(LAS f32x4*)(Wst + (64 + p) * 16 + 4 * q) = (f32x4){wi[4 * q], wi[4 * q + 1], wi[4 * q + 2], wi[4 * q + 3]}; }
            const int arow = p & 15, kq = p >> 4; f32x4 kacc = (f32x4){0.f, 0.f, 0.f, 0.f};
            const float* cre = F.in[9] + ((size_t)(l * SGN + g) * SG + arow) * SP; const float* cim = F.in[10] + ((size_t)(l * SGN + g) * SG + arow) * SP;
#pragma unroll 8
            for (int s = 0; s < 32; ++s) { const int k = 4 * s + kq; const float av = (k < 64) ? cre[k] : -cim[k - 64]; const float bv = Wst[k * 16 + arow];
                kacc = __builtin_amdgcn_mfma_f32_16x16x4f32(av, bv, kacc, 0, 0, 0); }
#pragma unroll
            for (int r = 0; r < 4; ++r) Kt[(4 * kq + r) * 16 + arow] = kacc[r];
        }
#pragma unroll 1
        for (int ho = 0; ho < 16; ++ho) {
            const float ccr = F.in[9][((size_t)(l * SGN + g) * SG + ho) * SP + p], cci = F.in[10][((size_t)(l * SGN + g) * SG + ho) * SP + p];
            if (tau >= 1) { const int n = (tau - 1) * 16 + ho;
                TG[(size_t)n * UGP + 1024 + p] = (bf16)f2bf(ccr * lr - cci * li); TG[(size_t)n * UGP + 1088 + p] = (bf16)f2bf(-(ccr * li + cci * lr)); }
            if (tau <= 63) {
                float kv[16];
#pragma unroll
                for (int q = 0; q < 4; ++q) { const f32x4 t4 = *(const LAS f32x4*)(Kt + ho * 16 + 4 * q); kv[4 * q] = t4[0]; kv[4 * q + 1] = t4[1]; kv[4 * q + 2] = t4[2]; kv[4 * q + 3] = t4[3]; }
                u32x4 o0, o1; o0.x = pk2(kv[0], kv[1]); o0.y = pk2(kv[2], kv[3]); o0.z = pk2(kv[4], kv[5]); o0.w = pk2(kv[6], kv[7]); o1.x = pk2(kv[8], kv[9]); o1.y = pk2(kv[10], kv[11]); o1.z = pk2(kv[12], kv[13]); o1.w = pk2(kv[14], kv[15]);
                const int to = p;
                if (to >= tau) { bf16* d = TG + (size_t)(to * 16 + ho) * UGP + (to - tau) * 16; *(u32x4*)d = o0; *(u32x4*)(d + 8) = o1; }
                if (tau >= 1 && to + tau <= 63) { bf16* d = TG + (size_t)(to * 16 + ho) * UGP + (to + tau) * 16; const u32x4 z = (u32x4){0u, 0u, 0u, 0u}; *(u32x4*)d = z; *(u32x4*)(d + 8) = z; }
            }
        }
    }
}

__device__ __forceinline__ void route_token(float (&a)[20], float ssv, int m, int lane, const float* gb_, const float* rb_, int* tokb, float* tokr, float* tokw, LAS int* hist) {
        const float ssum = wave_sum(ssv);
#pragma unroll
        for (int j = 0; j < 20; ++j) a[j] = wave_sum(a[j]);
        const float rstd = 1.f / sqrtf(ssum * (1.f / D) + RMS_EPS);
        float lg0 = a[0] * rstd + gb_[0], lg1 = a[1] * rstd + gb_[1], lg2 = a[2] * rstd + gb_[2], lg3 = a[3] * rstd + gb_[3];
        int gs = 0; float gm = lg0;
        if (lg1 > gm) { gm = lg1; gs = 1; } if (lg2 > gm) { gm = lg2; gs = 2; } if (lg3 > gm) { gm = lg3; gs = 3; }
        const float gwt = 1.f / (__expf(lg0 - gm) + __expf(lg1 - gm) + __expf(lg2 - gm) + __expf(lg3 - gm));
        float q0 = a[4], q1 = a[5], q2 = a[6], q3 = a[7], q4 = a[8], q5 = a[9], q6 = a[10], q7 = a[11], q8 = a[12], q9 = a[13], q10 = a[14], q11 = a[15], q12 = a[16], q13 = a[17], q14 = a[18], q15 = a[19];
        asm volatile("" : "+v"(q0), "+v"(q1), "+v"(q2), "+v"(q3), "+v"(q4), "+v"(q5), "+v"(q6), "+v"(q7));
        asm volatile("" : "+v"(q8), "+v"(q9), "+v"(q10), "+v"(q11), "+v"(q12), "+v"(q13), "+v"(q14), "+v"(q15));
        float e0 = gs == 0 ? q0 : gs == 1 ? q4 : gs == 2 ? q8 : q12;
        float e1 = gs == 0 ? q1 : gs == 1 ? q5 : gs == 2 ? q9 : q13;
        float e2 = gs == 0 ? q2 : gs == 1 ? q6 : gs == 2 ? q10 : q14;
        float e3 = gs == 0 ? q3 : gs == 1 ? q7 : gs == 2 ? q11 : q15;
        e0 = e0 * rstd + rb_[gs * 4 + 0]; e1 = e1 * rstd + rb_[gs * 4 + 1]; e2 = e2 * rstd + rb_[gs * 4 + 2]; e3 = e3 * rstd + rb_[gs * 4 + 3];
        int t1 = 0; float v1 = e0;
        if (e1 > v1) { v1 = e1; t1 = 1; } if (e2 > v1) { v1 = e2; t1 = 2; } if (e3 > v1) { v1 = e3; t1 = 3; }
        int t2 = -1; float v2 = -3.0e38f;
        if (t1 != 0 && e0 > v2) { v2 = e0; t2 = 0; } if (t1 != 1 && e1 > v2) { v2 = e1; t2 = 1; } if (t1 != 2 && e2 > v2) { v2 = e2; t2 = 2; } if (t1 != 3 && e3 > v2) { v2 = e3; t2 = 3; }
        const float p2 = __expf(v2 - v1), w1 = gwt / (1.f + p2), w2 = gwt * p2 / (1.f + p2);
        const int lo = t1 < t2 ? t1 : t2, hi = t1 < t2 ? t2 : t1; const float wlo = t1 < t2 ? w1 : w2, whi = t1 < t2 ? w2 : w1;
        const int pi = lo == 0 ? hi - 1 : (lo == 1 ? hi + 1 : 5), bk = gs * 6 + pi;
        if (lane == 0) { tokb[m] = bk; tokr[m] = rstd; tokw[2 * m] = wlo; tokw[2 * m + 1] = whi; __hip_atomic_fetch_add(hist + bk, 1, __ATOMIC_RELAXED, __HIP_MEMORY_SCOPE_WORKGROUP); }
}
__device__ __forceinline__ void ph_route(const Ctx& F0, int l) {
    const Ctx F = launder(F0);
    LAS float* Wl = (LAS float*)F.lds;
    LAS int* hist = (LAS int*)(F.lds + 1024 * 20 * 4);
    const float* g2 = F.in[18] + l * D;
    const f32x4* gw4 = (const f32x4*)(F.in[19] + (size_t)l * D * 4); const f32x4* rw4 = (const f32x4*)(F.in[21] + (size_t)l * 4 * D * 4);
    const float* gb_ = F.in[20] + l * 4; const float* rb_ = F.in[22] + l * 16;
    for (int idx = F.tid; idx < D * 5; idx += NTHREADS) { const int k = idx % D, q = idx / D;
        f32x4 v = (q == 0) ? gw4[k] : rw4[(q - 1) * D + k]; v = v * g2[k];
        Wl[(q * 4 + 0) * D + k] = v[0]; Wl[(q * 4 + 1) * D + k] = v[1]; Wl[(q * 4 + 2) * D + k] = v[2]; Wl[(q * 4 + 3) * D + k] = v[3]; }
    if (F.tid < 32) hist[F.tid] = 0;
    __syncthreads();
    int* tokb = (int*)(F.ws + WS_TOKB); float* tokr = (float*)(F.ws + WS_TOKR); float* tokw = (float*)(F.ws + WS_TOKW);
#pragma unroll 1
    for (int i2 = 0; i2 < 16; i2 += 2) {
        const int m0 = F.vcu * 128 + F.wave * 16 + i2;
        const u32x2* xr = (const u32x2*)(P_XB(F) + (size_t)m0 * D) + F.lane;
        float a[2][20], ss[2];
#pragma unroll
        for (int t = 0; t < 2; ++t) { ss[t] = 0.f;
#pragma unroll
            for (int j = 0; j < 20; ++j) a[t][j] = 0.f; }
#pragma unroll 1
        for (int jj = 0; jj < 4; ++jj) { const u32x2 y0 = xr[64 * jj], y1 = xr[D / 4 + 64 * jj];
            const f32x4 x0 = (f32x4){bf2f(y0.x & 0xffffu), bf2f(y0.x >> 16), bf2f(y0.y & 0xffffu), bf2f(y0.y >> 16)}, x1 = (f32x4){bf2f(y1.x & 0xffffu), bf2f(y1.x >> 16), bf2f(y1.y & 0xffffu), bf2f(y1.y >> 16)};
            ss[0] += (x0[0] * x0[0] + x0[1] * x0[1]) + (x0[2] * x0[2] + x0[3] * x0[3]); ss[1] += (x1[0] * x1[0] + x1[1] * x1[1]) + (x1[2] * x1[2] + x1[3] * x1[3]);
#pragma unroll
            for (int j = 0; j < 20; ++j) { const f32x4 w = *(const LAS f32x4*)(Wl + j * D + 256 * jj + 4 * F.lane);
                a[0][j] += (x0[0] * w[0] + x0[1] * w[1]) + (x0[2] * w[2] + x0[3] * w[3]); a[1][j] += (x1[0] * w[0] + x1[1] * w[1]) + (x1[2] * w[2] + x1[3] * w[3]); } }
        route_token(a[0], ss[0], m0, F.lane, gb_, rb_, tokb, tokr, tokw, hist);
        route_token(a[1], ss[1], m0 + 1, F.lane, gb_, rb_, tokb, tokr, tokw, hist);
    }
    __syncthreads();
    if (F.tid < 24) __hip_atomic_store((int*)(F.ws + WS_WGCNT) + F.vcu * 24 + F.tid, hist[F.tid], __ATOMIC_RELAXED, __HIP_MEMORY_SCOPE_AGENT);
}
__device__ __forceinline__ void ph_place(const Ctx& F0) {
    const Ctx F = launder(F0);
    LAS int* ptot = (LAS int*)F.lds;
    LAS int* pbef = ptot + 512;
    LAS int* bstart = pbef + 512;
    LAS int* btot = bstart + 32;
    LAS int* carry = btot + 32;
    LAS int* rowidx = carry + 32;
    const int* wgcnt = (const int*)(F.ws + WS_WGCNT);
    int* rowtok = (int*)(F.ws + WS_ROWTOK); float* roww = (float*)(F.ws + WS_ROWW); int* tileb = (int*)(F.ws + WS_TILEB);
    const int* tokb = (const int*)(F.ws + WS_TOKB); const float* tokr = (const float*)(F.ws + WS_TOKR); const float* tokw = (const float*)(F.ws + WS_TOKW);
    { const int p = F.tid >> 5, b = F.tid & 31; int tot = 0, bef = 0;
      if (b < 24) for (int v = p * 16; v < p * 16 + 16; ++v) { const int c = wgcnt[v * 24 + b]; tot += c; if (v < F.vcu) bef += c; }
      ptot[p * 32 + b] = tot; pbef[p * 32 + b] = bef; }
    __syncthreads();
    if (F.tid < 32) { int tot = 0, bef = 0; for (int p = 0; p < 16; ++p) { tot += ptot[p * 32 + F.tid]; bef += pbef[p * 32 + F.tid]; } btot[F.tid] = tot; carry[F.tid] = bef; }
    __syncthreads();
    if (F.tid == 0) { int s = 0; for (int b = 0; b < 24; ++b) { bstart[b] = s; s += (btot[b] + 255) & ~255; } bstart[24] = s; }
    __syncthreads();
    if (F.tid < 24) carry[F.tid] += bstart[F.tid];
    if (F.vcu == 0) {
        if (F.tid == 0) tileb[0] = bstart[24] >> 8;
        for (int b = 0; b < 24; ++b) { const int s = bstart[b], e = bstart[b + 1];
            for (int t = (s >> 8) + F.tid; t < (e >> 8); t += NTHREADS) tileb[1 + t] = b;
            for (int r = s + btot[b] + F.tid; r < e; r += NTHREADS) __hip_atomic_store(rowtok + r, -1, __ATOMIC_RELAXED, __HIP_MEMORY_SCOPE_AGENT); }
    }
    __syncthreads();
    if (F.wave == 0) {
        for (int pass = 0; pass < 2; ++pass) { const int i = pass * 64 + F.lane, bi = tokb[F.vcu * 128 + i]; int row = 0;
#pragma unroll 1
            for (int b = 0; b < 24; ++b) { const unsigned long long mask = __ballot(bi == b); const int c = carry[b];
                if (bi == b) row = c + __builtin_popcountll(mask & ((1ull << F.lane) - 1ull));
                asm volatile("s_waitcnt lgkmcnt(0)" ::: "memory");
                if (F.lane == 0) carry[b] = c + __builtin_popcountll(mask);
                asm volatile("s_waitcnt lgkmcnt(0)" ::: "memory"); }
            rowidx[i] = row; }
    }
    __syncthreads();
    bf16* XS = (bf16*)(F.ws + WS_XS);
    for (int i = 0; i < 16; ++i) {
        const int li = F.wave * 16 + i, m = F.vcu * 128 + li, row = rowidx[li]; const float rstd = tokr[m];
        if (F.lane == 0) {
            __hip_atomic_store(rowtok + row, m, __ATOMIC_RELAXED, __HIP_MEMORY_SCOPE_AGENT);
            const unsigned long long w2 = (unsigned long long)__builtin_bit_cast(unsigned, tokw[2 * m]) | ((unsigned long long)__builtin_bit_cast(unsigned, tokw[2 * m + 1]) << 32);
            __hip_atomic_store((unsigned long long*)(roww + 2 * row), w2, __ATOMIC_RELAXED, __HIP_MEMORY_SCOPE_AGENT); }
        if (F.lane == 0) __hip_atomic_store((float*)(F.ws + WS_ROWR) + row, rstd, __ATOMIC_RELAXED, __HIP_MEMORY_SCOPE_AGENT);
        const u32x4* xr = (const u32x4*)(P_XB(F) + (size_t)m * D) + F.lane; u32x4* o16 = (u32x4*)(XS + (size_t)row * D) + F.lane;
        o16[0] = xr[0]; o16[64] = xr[64];
    }
}
struct MoeOrder {
    const int* tileb; int G, c; bool down;
    __device__ __forceinline__ bool next(int i, pg8::Unit& u) const {
        const GAS int* tb_ = (const GAS int*)tileb;
        const int NT = __builtin_amdgcn_readfirstlane(tb_[0]), L = i * G + c; if (L >= NT * 4) return false;
        const int rt = L >> 2, pn = L & 3, b = __builtin_amdgcn_readfirstlane(tb_[1 + rt]);
        if (down) { u.pm = rt; u.pn = b * 4 + pn; u.aux = pn; }
        else { int ea, eb; pair_decode(b % 6, ea, eb); const int e = (b / 6) * 4 + (pn < 2 ? ea : eb); u.pm = rt; u.pn = e * 2 + (pn & 1); u.aux = pn; }
        return true;
    }
};
struct EpiGU {
    static constexpr bool PERM = true;
    bf16* H; const float* roww; const float* rowr;
    __device__ __forceinline__ void operator()(const f32x4 (&acc)[2][2][4][2], const pg8::Unit& u, int wr, int wc, int fr_, int fq_) const {
        const int ln_ = lane_id(), fr = ln_ & 15, fq = ln_ >> 4; (void)fr_; (void)fq_;
        const int row0 = u.pm * 256 + wr * 64 + fr, cl = u.aux * 128 + 16 * wc + 4 * fq, ws = u.aux >> 1;
#pragma unroll
        for (int ai = 0; ai < 2; ++ai)
#pragma unroll
            for (int m = 0; m < 4; ++m) { const int r = row0 + ai * 128 + m * 16; const float rr = rowr[r], w = roww[2 * r + ws] * rr;
#pragma unroll
                for (int bj = 0; bj < 2; ++bj) { const f32x4 g = acc[ai][bj][m][0], up = acc[ai][bj][m][1]; f32x4 a;
#pragma unroll
                    for (int i = 0; i < 4; ++i) { const float gg = g[i] * rr; a[i] = gg * sigmoidf_(gg) * up[i] * w; }
                    u32x2 o; o.x = pg8::cvt_pk_bf16(a[0], a[1]); o.y = pg8::cvt_pk_bf16(a[2], a[3]);
                    *(u32x2*)(H + (size_t)r * 512 + cl + bj * 64) = o; } }
    }
};
struct EpiDown {
    static constexpr bool PERM = true;
    bf16* RB; const int* rowtok;
    __device__ __forceinline__ void operator()(const f32x4 (&acc)[2][2][4][2], const pg8::Unit& u, int wr, int wc, int fr_, int fq_) const {
        const int ln_ = lane_id(), fr = ln_ & 15, fq = ln_ >> 4; (void)fr_; (void)fq_;
        const int row0 = u.pm * 256 + wr * 64 + fr, col0 = u.aux * 256 + wc * 32 + 8 * fq;
#pragma unroll
        for (int ai = 0; ai < 2; ++ai)
#pragma unroll
            for (int m = 0; m < 4; ++m) { const int tok = rowtok[row0 + ai * 128 + m * 16];
                if (tok >= 0) { bf16* rp = RB + (size_t)tok * D + col0;
#pragma unroll
                    for (int bj = 0; bj < 2; ++bj) { const u32x4 x = *(const u32x4*)(rp + bj * 128); const f32x4 a0 = acc[ai][bj][m][0], a1 = acc[ai][bj][m][1]; u32x4 w;
                        w.x = pg8::cvt_pk_bf16(bf2f(x.x & 0xffffu) + a0[0], bf2f(x.x >> 16) + a0[1]); w.y = pg8::cvt_pk_bf16(bf2f(x.y & 0xffffu) + a0[2], bf2f(x.y >> 16) + a0[3]);
                        w.z = pg8::cvt_pk_bf16(bf2f(x.z & 0xffffu) + a1[0], bf2f(x.z >> 16) + a1[1]); w.w = pg8::cvt_pk_bf16(bf2f(x.w & 0xffffu) + a1[2], bf2f(x.w >> 16) + a1[3]);
                        *(u32x4*)(rp + bj * 128) = w; } }
                if (m & 1) asm volatile("" ::: "memory"); }
    }
};

struct SsmOrder { int G, c, mode;
    __device__ __forceinline__ bool next(int i, pg8::Unit& u) const { const int L = i * G + c;
        if (mode == 1) { if (L >= 32) return false; u.pm = L; u.pn = L >> 1; u.aux = 0; return true; }
        if (L >= 128) return false; const int g = L >> 3; u.pm = g * 2 + ((L >> 2) & 1); u.pn = g * 4 + (L & 3); u.aux = L & 3; return true; } };
struct HalfOrder { int L;
    __device__ __forceinline__ bool next(int i, pg8::Unit& u) const { if (i > 0 || L < 0 || L >= 128) return false; u.pm = L; u.pn = 0; u.aux = 0; return true; } };
struct EpiZ { static constexpr bool PERM = false; float* ZB;
    __device__ __forceinline__ void operator()(const f32x4 (&acc)[2][2][4][2], const pg8::Unit& u, int wr, int wc, int fr_, int fq_) const {
        const int ln_ = lane_id(), fr = ln_ & 15, fq = ln_ >> 4; (void)fr_; (void)fq_;
        const int row0 = u.pm * 256 + wr * 64 + fr, col0 = wc * 32 + 4 * fq;
#pragma unroll
        for (int ai = 0; ai < 2; ++ai)
#pragma unroll
            for (int m = 0; m < 4; ++m)
#pragma unroll
                for (int n = 0; n < 2; ++n) *(f32x4*)(ZB + (size_t)(row0 + ai * 128 + m * 16) * 128 + col0 + n * 16) = acc[ai][0][m][n];
    } };
struct EpiSsm2 { static constexpr bool PERM = true; const bf16* UG; bf16* YS; const float* dvec;
    __device__ __forceinline__ void operator()(const f32x4 (&acc)[2][2][4][2], const pg8::Unit& u, int wr, int wc, int fr_, int fq_) const {
        const int ln_ = lane_id(), fr = ln_ & 15, fq = ln_ >> 4; (void)fr_; (void)fq_;
        const int g = u.pm >> 1, cr0 = (u.pm & 1) * 256 + wr * 64 + fr;
#pragma unroll
        for (int bj = 0; bj < 2; ++bj) { const int n0 = u.aux * 256 + bj * 128 + wc * 32 + 8 * fq, to = n0 >> 4, ho0 = n0 & 15;
            const f32x4 d0 = *(const f32x4*)(dvec + g * 16 + ho0), d1 = *(const f32x4*)(dvec + g * 16 + ho0 + 4);
#pragma unroll
            for (int ai = 0; ai < 2; ++ai)
#pragma unroll
                for (int m = 0; m < 4; ++m) { const int cr = cr0 + ai * 128 + m * 16;
                    const u32x4 uu = *(const u32x4*)(UG + ((size_t)(g * 512 + cr)) * UGP + n0);
                    const f32x4 a0 = acc[ai][bj][m][0], a1 = acc[ai][bj][m][1]; float y[8];
                    y[0] = gelu_tanh(a0[0] + d0[0] * bf2f(uu.x & 0xffffu)); y[1] = gelu_tanh(a0[1] + d0[1] * bf2f(uu.x >> 16));
                    y[2] = gelu_tanh(a0[2] + d0[2] * bf2f(uu.y & 0xffffu)); y[3] = gelu_tanh(a0[3] + d0[3] * bf2f(uu.y >> 16));
                    y[4] = gelu_tanh(a1[0] + d1[0] * bf2f(uu.z & 0xffffu)); y[5] = gelu_tanh(a1[1] + d1[1] * bf2f(uu.z >> 16));
                    y[6] = gelu_tanh(a1[2] + d1[2] * bf2f(uu.w & 0xffffu)); y[7] = gelu_tanh(a1[3] + d1[3] * bf2f(uu.w >> 16));
                    u32x4 w; w.x = pg8::cvt_pk_bf16(y[0], y[1]); w.y = pg8::cvt_pk_bf16(y[2], y[3]); w.z = pg8::cvt_pk_bf16(y[4], y[5]); w.w = pg8::cvt_pk_bf16(y[6], y[7]);
                    *(u32x4*)(YS + ((size_t)cr * 64 + to) * 256 + g * 16 + ho0) = w; } }
    } };
struct EpiGluE { static constexpr bool PERM = true; const bf16* YS; bf16* YMIX; const float* gb;
    __device__ __forceinline__ void operator()(const f32x4 (&acc)[2][2][4][2], const pg8::Unit& u, int wr, int wc, int fr_, int fq_) const {
        const int ln_ = lane_id(), fr = ln_ & 15, fq = ln_ >> 4; (void)fr_; (void)fq_;
        const int row0 = u.pm * 256 + wr * 64 + fr;
#pragma unroll
        for (int bj = 0; bj < 2; ++bj) { const int n0 = bj * 128 + wc * 32 + 8 * fq; const f32x4 b0 = *(const f32x4*)(gb + n0), b1 = *(const f32x4*)(gb + n0 + 4);
#pragma unroll
            for (int ai = 0; ai < 2; ++ai)
#pragma unroll
                for (int m = 0; m < 4; ++m) { const size_t r = (size_t)(row0 + ai * 128 + m * 16); const u32x4 yy = *(const u32x4*)(YS + r * 256 + n0);
                    const f32x4 a0 = acc[ai][bj][m][0] + b0, a1 = acc[ai][bj][m][1] + b1; float o[8];
                    o[0] = bf2f(yy.x & 0xffffu) * sigmoidf_(a0[0]); o[1] = bf2f(yy.x >> 16) * sigmoidf_(a0[1]); o[2] = bf2f(yy.y & 0xffffu) * sigmoidf_(a0[2]); o[3] = bf2f(yy.y >> 16) * sigmoidf_(a0[3]);
                    o[4] = bf2f(yy.z & 0xffffu) * sigmoidf_(a1[0]); o[5] = bf2f(yy.z >> 16) * sigmoidf_(a1[1]); o[6] = bf2f(yy.w & 0xffffu) * sigmoidf_(a1[2]); o[7] = bf2f(yy.w >> 16) * sigmoidf_(a1[3]);
                    u32x4 w; w.x = pg8::cvt_pk_bf16(o[0], o[1]); w.y = pg8::cvt_pk_bf16(o[2], o[3]); w.z = pg8::cvt_pk_bf16(o[4], o[5]); w.w = pg8::cvt_pk_bf16(o[6], o[7]);
                    *(u32x4*)(YMIX + r * 1024 + n0) = w; } }
    } };
struct EpiPoolE { static constexpr bool PERM = true; bf16* YMIX; const float* pb; const float* ps;
    __device__ __forceinline__ void operator()(const f32x4 (&acc)[2][2][4][2], const pg8::Unit& u, int wr, int wc, int fr_, int fq_) const {
        const int ln_ = lane_id(), fr = ln_ & 15, fq = ln_ >> 4; (void)fr_; (void)fq_;
        const int row0 = u.pm * 256 + wr * 64 + fr;
#pragma unroll
        for (int bj = 0; bj < 2; ++bj) { const int n0 = bj * 128 + wc * 32 + 8 * fq; const f32x4 b0 = *(const f32x4*)(pb + n0), b1 = *(const f32x4*)(pb + n0 + 4), s0 = *(const f32x4*)(ps + n0), s1 = *(const f32x4*)(ps + n0 + 4);
#pragma unroll
            for (int ai = 0; ai < 2; ++ai)
#pragma unroll
                for (int m = 0; m < 4; ++m) { const size_t r = (size_t)(row0 + ai * 128 + m * 16);
                    const f32x4 a0 = (acc[ai][bj][m][0] + b0) * s0, a1 = (acc[ai][bj][m][1] + b1) * s1;
                    u32x4 w; w.x = pg8::cvt_pk_bf16(a0[0], a0[1]); w.y = pg8::cvt_pk_bf16(a0[2], a0[3]); w.z = pg8::cvt_pk_bf16(a1[0], a1[1]); w.w = pg8::cvt_pk_bf16(a1[2], a1[3]);
                    *(u32x4*)(YMIX + r * 1024 + 256 + n0) = w; } }
    } };
__device__ __forceinline__ void ph_ssm_scan(const Ctx& F0, int l) {
    const Ctx F = launder(F0);
    for (int it = F.vcu + F.G * F.wave; it < SGN * NB; it += F.G * NWAVES) {
        const int g = it >> 3, b = it & 7, p = F.lane;
        const float are = F.in[4][(l * SGN + g) * SP + p], aim = F.in[5][(l * SGN + g) * SP + p], dt = expf(F.in[6][l * SGN + g]);
        float sn, cs; sincosf(aim * dt * 64.f, &sn, &cs); const float mg = expf(are * dt * 64.f), lr = mg * cs, li = mg * sn;
        const float* Z = (const float*)(F.ws + WS_ZB) + ((size_t)g * 512 + b * 64) * 128;
        bf16* U = P_UG(F) + ((size_t)g * 512 + b * 64) * UGP + 1024;
        float sr = 0.f, si = 0.f;
#pragma unroll 1
        for (int c0 = 0; c0 < 64; c0 += 16) {
            float zr[16], zi[16];
#pragma unroll
            for (int j = 0; j < 16; ++j) { zr[j] = Z[(c0 + j) * 128 + p]; zi[j] = Z[(c0 + j) * 128 + 64 + p]; }
#pragma unroll
            for (int j = 0; j < 16; ++j) {
                U[(size_t)(c0 + j) * UGP + p] = (bf16)f2bf(sr); U[(size_t)(c0 + j) * UGP + 64 + p] = (bf16)f2bf(si);
                const float nr = lr * sr - li * si + zr[j], ni = lr * si + li * sr + zi[j]; sr = nr; si = ni; }
        }
    }
}

namespace moba {
using bf16x8 = __attribute__((ext_vector_type(8))) short;
using s16x4 = __attribute__((ext_vector_type(4))) short;
using f32x16 = __attribute__((ext_vector_type(16))) float;
typedef short v4i16_t __attribute__((ext_vector_type(4)));
typedef float f32x2_t __attribute__((ext_vector_type(2))); typedef __bf16 bf16x2_t __attribute__((ext_vector_type(2)));
constexpr int L_K = 0, L_V = 49152, L_TB = 98304, L_KM = L_TB + 4 * 768 * 4, L_END = L_KM + 16 * 64 * 4;
__device__ __forceinline__ unsigned cvtpk(float lo, float hi) { f32x2_t v = {lo, hi}; bf16x2_t b = __builtin_convertvector(v, bf16x2_t); return __builtin_bit_cast(unsigned, b); }
__device__ __forceinline__ s16x4 vtr(const LAS char* p) { return __builtin_bit_cast(s16x4, __builtin_amdgcn_ds_read_tr16_b64_v4i16((LAS v4i16_t*)p)); }
__device__ __forceinline__ float hmax(float v) { const unsigned u = __builtin_bit_cast(unsigned, v); auto r = __builtin_amdgcn_permlane32_swap(u, u, false, false); return fmaxf(__builtin_bit_cast(float, (unsigned)r[0]), __builtin_bit_cast(float, (unsigned)r[1])); }
__device__ __forceinline__ float hsum(float v) { const unsigned u = __builtin_bit_cast(unsigned, v); auto r = __builtin_amdgcn_permlane32_swap(u, u, false, false); return __builtin_bit_cast(float, (unsigned)r[0]) + __builtin_bit_cast(float, (unsigned)r[1]); }

__device__ __forceinline__ void unit(int wave_, int b, int h, int qb, const bf16* Q, const bf16* K, const bf16* V, bf16* O, const float* KMP, const float* BT, LAS char* lds) {
    int lane_ = lane_id(); asm volatile("" : "+v"(lane_)); asm volatile("" : "+s"(b), "+s"(h), "+s"(qb), "+s"(wave_));
    const int wid = wave_, lane = lane_, tid = wid * 64 + lane, r32 = lane & 31, hi = lane >> 5;
    const int NT = 4 * qb + 4, q0 = qb * 256; const size_t rowbase = (size_t)b * SEQ;
    LAS float* tb = (LAS float*)(lds + L_TB); LAS float* km = (LAS float*)(lds + L_KM);
    const float bfar = BT[h * 132 + 128];
    const bf16* ksrc = K + (rowbase + lane) * 512 + h * 64 + wid * 8;
    const bf16* vsrc = V + (rowbase + 16 * (wid & 3) + (lane >> 2)) * 512 + h * 64 + (wid >> 2) * 32 + (lane & 3) * 8;
    u32x4 kreg0 = *(const u32x4*)ksrc, vreg0 = *(const u32x4*)vsrc, kreg1 = *(const u32x4*)(ksrc + (size_t)64 * 512), vreg1 = *(const u32x4*)(vsrc + (size_t)64 * 512);
    u32x4 kreg2 = *(const u32x4*)(ksrc + (size_t)128 * 512), vreg2 = *(const u32x4*)(vsrc + (size_t)128 * 512), kreg3 = *(const u32x4*)(ksrc + (size_t)192 * 512), vreg3 = *(const u32x4*)(vsrc + (size_t)192 * 512);
    bf16x8 qr[4];
    { const bf16* qw = Q + (rowbase + q0 + wid * 32 + r32) * 512 + h * 64 + hi * 8;
#pragma unroll
      for (int d0 = 0; d0 < 4; ++d0) qr[d0] = *(const bf16x8*)(qw + d0 * 16); }
    __syncthreads();
    unsigned selmask = 1u << qb;
    { float g[16];
#pragma unroll
      for (int j = 0; j < 16; ++j) g[j] = 0.f;
#pragma unroll
      for (int d0 = 0; d0 < 4; ++d0)
#pragma unroll
          for (int e = 0; e < 8; ++e) { const float qf = bf2f((unsigned)(unsigned short)qr[d0][e]);
#pragma unroll
              for (int j = 0; j < 16; ++j) g[j] += qf * km[j * 64 + d0 * 16 + hi * 8 + e]; }
#pragma unroll
      for (int j = 0; j < 16; ++j) g[j] = hsum(g[j]);
#pragma unroll
      for (int s = 0; s < 3; ++s) { float bv = -3.0e38f; int bi = -1;
#pragma unroll
          for (int j = 0; j < 16; ++j) { const bool ok = (j < qb) && !((selmask >> j) & 1u) && (g[j] > bv); bv = ok ? g[j] : bv; bi = ok ? j : bi; }
          if (bi >= 0) selmask |= 1u << bi; } }
    { LAS char* kd = lds + L_K + wid * 1024 + lane * 16; LAS char* vd = lds + L_V + wid * 1024 + lane * 16;
      *(LAS u32x4*)kd = kreg0; *(LAS u32x4*)vd = vreg0; *(LAS u32x4*)(kd + 8192) = kreg1; *(LAS u32x4*)(vd + 8192) = vreg1;
      *(LAS u32x4*)(kd + 16384) = kreg2; *(LAS u32x4*)(vd + 16384) = vreg2; *(LAS u32x4*)(kd + 24576) = kreg3; *(LAS u32x4*)(vd + 24576) = vreg3; }
    __syncthreads();
    const int qrel = wid * 32 + r32;
    const LAS char* kp0 = lds + L_K + hi * 1024 + r32 * 16;
    const LAS char* vp0 = lds + L_V + ((lane >> 4) & 1) * 32 + (lane & 3) * 8 + (4 * hi + ((lane & 15) >> 2)) * 64;
    float mref = 0.f, l = 0.f; f32x16 o0 = f32x16{}, o1 = f32x16{};
#define MOBA_CVEC(TT) f32x16 cvec; do { const float ci_ = ((selmask >> ((TT) >> 2)) & 1u) ? (bfar - mref) : -1.0e30f; _Pragma("unroll") for (int r = 0; r < 16; ++r) cvec[r] = ci_; } while (0)
#define MOBA_QK(P0, P1, KB) do { { const bf16x8 a0 = *(const LAS bf16x8*)(kp0 + (KB)), a1 = *(const LAS bf16x8*)(kp0 + (KB) + 512); \
          P0 = __builtin_amdgcn_mfma_f32_32x32x16_bf16(a0, qr[0], cvec, 0, 0, 0); P1 = __builtin_amdgcn_mfma_f32_32x32x16_bf16(a1, qr[0], cvec, 0, 0, 0); } \
        _Pragma("unroll") for (int d0 = 1; d0 < 4; ++d0) { const bf16x8 a0 = *(const LAS bf16x8*)(kp0 + (KB) + d0 * 2048), a1 = *(const LAS bf16x8*)(kp0 + (KB) + d0 * 2048 + 512); \
            P0 = __builtin_amdgcn_mfma_f32_32x32x16_bf16(a0, qr[d0], P0, 0, 0, 0); P1 = __builtin_amdgcn_mfma_f32_32x32x16_bf16(a1, qr[d0], P1, 0, 0, 0); } } while (0)
#define MOBA_NEARMAX(P0, P1, TT, OUT) do { const int jn_ = (TT) - (NT - 8); if (jn_ >= 0) { const int A_ = qrel - 64 * (jn_ - 4) - 4 * hi + 256, s_ = 767 - A_, c_ = s_ & 3; \
            const LAS f32x4* t4 = (const LAS f32x4*)(tb + c_ * 768 + (s_ - c_)); \
            _Pragma("unroll") for (int g = 0; g < 4; ++g) { const f32x4 x0 = t4[2 * g], x1 = t4[2 * g + 8]; \
                _Pragma("unroll") for (int j = 0; j < 4; ++j) { P0[4 * g + j] += x0[j]; P1[4 * g + j] += x1[j]; } } } \
        float ra = __builtin_fmaxf(__builtin_fmaxf(P0[0], P0[1]), P1[0]), rb = __builtin_fmaxf(__builtin_fmaxf(P0[2], P0[3]), P1[1]); \
        ra = __builtin_fmaxf(__builtin_fmaxf(ra, P1[2]), P1[3]); \
        _Pragma("unroll") for (int r = 4; r < 16; r += 4) { ra = __builtin_fmaxf(__builtin_fmaxf(ra, P0[r]), P0[r + 1]); rb = __builtin_fmaxf(__builtin_fmaxf(rb, P0[r + 2]), P0[r + 3]); \
            ra = __builtin_fmaxf(__builtin_fmaxf(ra, P1[r]), P1[r + 1]); rb = __builtin_fmaxf(__builtin_fmaxf(rb, P1[r + 2]), P1[r + 3]); } \
        OUT = hmax(__builtin_fmaxf(ra, rb)); } while (0)
#define MOBA_STEP(PC0, PC1, PN0, PN1, TT, KBN, VBC, HASN) do { \
        bf16x8 vf[8], kf[8]; \
        if (HASN) { _Pragma("unroll") for (int d0 = 0; d0 < 4; ++d0) { kf[2 * d0] = *(const LAS bf16x8*)(kp0 + (KBN) + d0 * 2048); kf[2 * d0 + 1] = *(const LAS bf16x8*)(kp0 + (KBN) + d0 * 2048 + 512); } } \
        __builtin_amdgcn_sched_barrier(0); \
        if (__any(rm > 8.f)) { const float dl = __builtin_fmaxf(rm, 0.f), alpha = __builtin_amdgcn_exp2f(-dl); mref += dl; l *= alpha; \
            _Pragma("unroll") for (int r = 0; r < 16; ++r) { PC0[r] -= dl; PC1[r] -= dl; o0[r] *= alpha; o1[r] *= alpha; } } \
        if (HASN) { MOBA_CVEC((TT) + 1);       \
                    PN0 = __builtin_amdgcn_mfma_f32_32x32x16_bf16(kf[0], qr[0], cvec, 0, 0, 0); PN1 = __builtin_amdgcn_mfma_f32_32x32x16_bf16(kf[1], qr[0], cvec, 0, 0, 0); \
                    _Pragma("unroll") for (int d0 = 1; d0 < 4; ++d0) { PN0 = __builtin_amdgcn_mfma_f32_32x32x16_bf16(kf[2 * d0], qr[d0], PN0, 0, 0, 0); PN1 = __builtin_amdgcn_mfma_f32_32x32x16_bf16(kf[2 * d0 + 1], qr[d0], PN1, 0, 0, 0); } } \
        { const LAS char* vp = vp0 + (VBC); \
        _Pragma("unroll") for (int k = 0; k < 4; ++k) { \
            const s16x4 lo0 = vtr(vp + k * 1024), hi0 = vtr(vp + k * 1024 + 512), lo1 = vtr(vp + 4096 + k * 1024), hi1 = vtr(vp + 4096 + k * 1024 + 512); \
            vf[2 * k] = (bf16x8){lo0[0], lo0[1], lo0[2], lo0[3], hi0[0], hi0[1], hi0[2], hi0[3]}; vf[2 * k + 1] = (bf16x8){lo1[0], lo1[1], lo1[2], lo1[3], hi1[0], hi1[1], hi1[2], hi1[3]}; } } \
        __builtin_amdgcn_sched_barrier(0); \
        float s0 = 0.f, s1 = 0.f; u32x4 pw[4]; \
        _Pragma("unroll") for (int r = 0; r < 16; ++r) { PC0[r] = __builtin_amdgcn_exp2f(PC0[r]); PC1[r] = __builtin_amdgcn_exp2f(PC1[r]); s0 += PC0[r]; s1 += PC1[r]; } \
        l += s0 + s1; \
        _Pragma("unroll") for (int q = 0; q < 4; ++q) { pw[0][q] = cvtpk(PC0[2 * q], PC0[2 * q + 1]); pw[1][q] = cvtpk(PC0[8 + 2 * q], PC0[9 + 2 * q]); pw[2][q] = cvtpk(PC1[2 * q], PC1[2 * q + 1]); pw[3][q] = cvtpk(PC1[8 + 2 * q], PC1[9 + 2 * q]); } \
        _Pragma("unroll") for (int k = 0; k < 4; ++k) { const bf16x8 pa = __builtin_bit_cast(bf16x8, pw[k]); \
            o0 = __builtin_amdgcn_mfma_f32_32x32x16_bf16(vf[2 * k], pa, o0, 0, 0, 0); o1 = __builtin_amdgcn_mfma_f32_32x32x16_bf16(vf[2 * k + 1], pa, o1, 0, 0, 0); } \
        if (HASN) MOBA_NEARMAX(PN0, PN1, (TT) + 1, rm); \
    } while (0)
    f32x16 pa0, pa1, pb0, pb1; float rm;
    { MOBA_CVEC(0); MOBA_QK(pa0, pa1, 0); } MOBA_NEARMAX(pa0, pa1, 0, rm);
    const int NP = NT >> 1;
    int bufc = 0, bufn = 16384, bufw = 32768;
#pragma unroll 1
    for (int ip = 0; ip < NP; ++ip) {
        const int t = 2 * ip;
        if (ip + 2 < NP) { kreg0 = *(const u32x4*)(ksrc + (size_t)(t + 4) * 64 * 512); vreg0 = *(const u32x4*)(vsrc + (size_t)(t + 4) * 64 * 512);
                           kreg1 = *(const u32x4*)(ksrc + (size_t)(t + 5) * 64 * 512); vreg1 = *(const u32x4*)(vsrc + (size_t)(t + 5) * 64 * 512); }
        MOBA_STEP(pa0, pa1, pb0, pb1, t, bufc + 8192, bufc, true);
        MOBA_STEP(pb0, pb1, pa0, pa1, t + 1, bufn, bufc + 8192, (t + 2 < NT));
        if (ip + 2 < NP) { LAS char* kd = lds + L_K + bufw + wid * 1024 + lane * 16; LAS char* vd = lds + L_V + bufw + wid * 1024 + lane * 16;
            *(LAS u32x4*)kd = kreg0; *(LAS u32x4*)vd = vreg0; *(LAS u32x4*)(kd + 8192) = kreg1; *(LAS u32x4*)(vd + 8192) = vreg1; }
        __syncthreads();
        { const int tmp = bufc; bufc = bufn; bufn = bufw; bufw = tmp; }
    }
#undef MOBA_CVEC
#undef MOBA_QK
#undef MOBA_NEARMAX
#undef MOBA_STEP
    const float inv = 1.f / hsum(l);
    bf16* orow = O + (rowbase + q0 + wid * 32 + r32) * 1024 + 512 + h * 64 + 8 * hi;
#pragma unroll
    for (int d0 = 0; d0 < 2; ++d0)
#pragma unroll
        for (int gp = 0; gp < 2; ++gp) { const f32x16& oo = d0 ? o1 : o0; const int ga = 8 * gp, gb = 8 * gp + 4;
            unsigned ax = cvtpk(oo[ga] * inv, oo[ga + 1] * inv), ay = cvtpk(oo[ga + 2] * inv, oo[ga + 3] * inv), bx = cvtpk(oo[gb] * inv, oo[gb + 1] * inv), by = cvtpk(oo[gb + 2] * inv, oo[gb + 3] * inv);
            { auto r = __builtin_amdgcn_permlane32_swap(ax, bx, false, false); ax = r[0]; bx = r[1]; }
            { auto r = __builtin_amdgcn_permlane32_swap(ay, by, false, false); ay = r[0]; by = r[1]; }
            *(u32x4*)(orow + 32 * d0 + 16 * gp) = (u32x4){ax, ay, bx, by}; }
}
__device__ __forceinline__ void phase(int wave, int vcu, const bf16* Q, const bf16* K, const bf16* V, bf16* O, const float* KMP, const float* BT, LAS char* lds) {
    if (vcu >= 256) return;
    const int s = vcu & 3, bh = vcu >> 2;
    {
        int lane_ = lane_id(); asm volatile("" : "+v"(lane_)); const int tid = wave * 64 + lane_, b = bh >> 3, h = bh & 7;
        LAS float* tb = (LAS float*)(lds + L_TB); LAS float* km = (LAS float*)(lds + L_KM); const float bfar = BT[h * 132 + 128];
        for (int i = tid; i < 4 * 768; i += NTHREADS) { const int c = i / 768, j = i % 768, src_ = 767 - (j + c), rel = src_ - 256; tb[i] = (src_ < 0 || rel < 0) ? -1.0e30f : (rel < 128 ? BT[h * 132 + rel] - bfar : 0.f); }
        for (int i = tid; i < 16 * 64; i += NTHREADS) { const int j = i >> 6, d = i & 63, pm = b * 16 + j; km[i] = KMP[pm * 512 + h * 64 + d] + KMP[128 * 512 + pm * 512 + h * 64 + d]; }
    }
#pragma unroll 1
    for (int i = 0; i < 4; ++i) { const int qb = (i == 0) ? s : (i == 1) ? 7 - s : (i == 2) ? 8 + s : 15 - s; unit(wave, bh >> 3, bh & 7, qb, Q, K, V, O, KMP, BT, lds); }
}
}

__device__ __forceinline__ void ph_cvt_x(const Ctx& F0) {
    const Ctx F = launder(F0);
    const int gw = F.vcu * NWAVES + F.wave, NGW = F.G * NWAVES; float* rs1 = (float*)(F.ws + WS_RS1);
    for (int m = gw; m < T; m += NGW) {
        const f32x4* xr = (const f32x4*)(F.in[0] + (size_t)m * D) + F.lane;
        f32x4 v[4]; float s = 0.f;
#pragma unroll
        for (int j = 0; j < 4; ++j) { v[j] = xr[64 * j]; s += (v[j].x * v[j].x + v[j].y * v[j].y) + (v[j].z * v[j].z + v[j].w * v[j].w); }
        const float rstd = 1.f / sqrtf(wave_sum(s) * (1.f / D) + RMS_EPS);
        if (F.lane == 0) rs1[m] = rstd;
        unsigned long long* o8 = (unsigned long long*)(P_XB(F) + (size_t)m * D) + F.lane;
#pragma unroll
        for (int j = 0; j < 4; ++j) o8[64 * j] = (unsigned long long)pk2(v[j].x, v[j].y) | ((unsigned long long)pk2(v[j].z, v[j].w) << 32);
    }
}
__device__ __forceinline__ float row_ssq_bf16(const bf16* row, int lane) {
    const u32x4* xr = (const u32x4*)row + lane; float s = 0.f;
#pragma unroll
    for (int j = 0; j < 2; ++j) { const u32x4 x = xr[64 * j];
        const float a0 = bf2f(x.x & 0xffffu), a1 = bf2f(x.x >> 16), a2 = bf2f(x.y & 0xffffu), a3 = bf2f(x.y >> 16), a4 = bf2f(x.z & 0xffffu), a5 = bf2f(x.z >> 16), a6 = bf2f(x.w & 0xffffu), a7 = bf2f(x.w >> 16);
        s += ((a0 * a0 + a1 * a1) + (a2 * a2 + a3 * a3)) + ((a4 * a4 + a5 * a5) + (a6 * a6 + a7 * a7)); }
    return wave_sum(s);
}
__device__ __forceinline__ void ph_rstd(const Ctx& F0) {
    const Ctx F = launder(F0);
    const int gw = F.vcu * NWAVES + F.wave, NGW = F.G * NWAVES; float* rs1 = (float*)(F.ws + WS_RS1);
    for (int m = gw; m < T; m += NGW) { const float s = row_ssq_bf16(P_XB(F) + (size_t)m * D, F.lane); if (F.lane == 0) rs1[m] = 1.f / sqrtf(s * (1.f / D) + RMS_EPS); }
}

__device__ __forceinline__ void ph_bias_table(const Ctx& F0) {
    const Ctx F = launder(F0);
    if (F.vcu == 0) {
        const float* rel_bias = F.in[1];
        for (int i = F.tid; i < 8 * 132; i += NTHREADS) {
            const int h = i / 132, r = i % 132;
            int bk;
            if (r < 16) bk = r;
            else { bk = 16 + (int)(logf((float)r / 16.f) / logf(8.f) * 16.f); if (bk > 31) bk = 31; }
            P_BT(F)[i] = rel_bias[bk * 8 + h] * LOG2E;
        }
    }
}

__device__ __forceinline__ void ph_pool_dl(const Ctx& F0) {
    const Ctx F = launder(F0);
    const int gt = F.vcu * NTHREADS + F.tid, NGT = F.G * NTHREADS;
    for (int it = gt; it < (T / 32) * 128; it += NGT) {
        const int cp = it & 127, chunk = it >> 7, c = cp * 2, gi = c >> 6, win = 2 << gi, m0 = chunk * 32, t0 = m0 & (SEQ - 1);
        const unsigned* P2 = (const unsigned*)P_PB(F) + cp; unsigned* D2 = (unsigned*)P_DL(F) + cp;
        float s0 = 0.f, s1 = 0.f;
        const int back = (t0 < win) ? t0 : win;
        for (int j = 1; j <= back; ++j) { const unsigned v = P2[(size_t)(m0 - j) * 128]; s0 += bf2f(v & 0xffffu); s1 += bf2f(v >> 16); }
#pragma unroll 4
        for (int i = 0; i < 32; ++i) { const int m = m0 + i, t = t0 + i;
            const unsigned v = P2[(size_t)m * 128]; const float p0 = bf2f(v & 0xffffu), p1 = bf2f(v >> 16);
            s0 += p0; s1 += p1;
            if (t >= win) { const unsigned o = P2[(size_t)(m - win) * 128]; s0 -= bf2f(o & 0xffffu); s1 -= bf2f(o >> 16); }
            const float inv = 1.f / (float)((t + 1 < win) ? t + 1 : win);
            D2[(size_t)m * 128] = pk2(s0 * inv - p0, s1 * inv - p1); }
    }
}
__device__ __forceinline__ void ph_final(const Ctx& F0) {
    const Ctx F = launder(F0);
    const int gw = F.vcu * NWAVES + F.wave, NGW = F.G * NWAVES;
    const f32x4* gf = (const f32x4*)F.in[26];
    for (int m = gw; m < T; m += NGW) {
        const bf16* row = P_XB(F) + (size_t)m * D;
        const float rstd = 1.f / sqrtf(row_ssq_bf16(row, F.lane) * (1.f / D) + RMS_EPS);
        const u32x4* xr = (const u32x4*)row + F.lane; f32x4* orow = (f32x4*)(F.R + (size_t)m * D);
#pragma unroll
        for (int j = 0; j < 2; ++j) { const u32x4 x = xr[64 * j]; const int c4 = 2 * (64 * j + F.lane);
            orow[c4] = (f32x4){bf2f(x.x & 0xffffu), bf2f(x.x >> 16), bf2f(x.y & 0xffffu), bf2f(x.y >> 16)} * rstd * gf[c4];
            orow[c4 + 1] = (f32x4){bf2f(x.z & 0xffffu), bf2f(x.z >> 16), bf2f(x.w & 0xffffu), bf2f(x.w >> 16)} * rstd * gf[c4 + 1]; }
    }
}

constexpr int LDS_BYTES = 147456;
constexpr int MISC_OFF = 131072 + 320;

__global__ void __launch_bounds__(NTHREADS, 2) mk_fwd(Args args) {
    extern __shared__ __attribute__((aligned(16))) unsigned char lds[];
    Ctx F;
    F.lds = (LAS unsigned char*)lds;
    F.wave = __builtin_amdgcn_readfirstlane((int)threadIdx.x >> 6);
    F.lane = lane_id(); F.tid = F.wave * 64 + F.lane;
    F.G = gridDim.x; { const int bx = blockIdx.x; F.vcu = (F.G % 8 == 0) ? (bx % 8) * (F.G / 8) + bx / 8 : bx; }
    F.in = (KargP)__builtin_amdgcn_kernarg_segment_ptr(); F.R = args.out; F.ws = args.ws;
    unsigned char* ws = args.ws;
    volatile LAS unsigned* MISC = (volatile LAS unsigned*)(F.lds + MISC_OFF);
    if (F.tid < 64) MISC[F.tid] = 0u;
    __syncthreads();
    XcdBarrier bar = xcd_barrier_post((unsigned*)(ws + WS_CTL) + CW_BAR, MISC + 8, F.tid == 0);
#define GRID_BAR() do { bar.bar = (unsigned*)(wsl(ws) + WS_CTL) + CW_BAR; xcd_barrier(bar, F.wave); } while (0)
#define FL launder(F)

    ph_bias_table(F);
    ph_prologue(F);
#pragma unroll 1
    for (int l = 0; l < DEPTH; ++l) {
        if (l == 0) ph_cvt_x(F); else ph_rstd(F);
        GRID_BAR();
        { pg8::Gemm g{P_XB(FL), (const bf16*)(wsl(ws) + WS_WIN) + (size_t)l * NPROJ * D, D, D, D}; pg8::StaticOrder S; S.init(T, NPROJ, sl(F.G), sl((int)blockIdx.x));
          EpiProjE E{P_UG(FL), P_PB(FL), P_QB(FL), P_KB(FL), P_VB(FL), P_KMP(FL), (const float*)(wsl(ws) + WS_RS1)}; pg8::gemm_phase(F.lds, g, S, E, sl(F.wave)); }
        GRID_BAR();
        { pg8::Gemm g{P_UG(FL), (const bf16*)(wsl(ws) + WS_BZ) + (size_t)l * SGN * 256 * 1024, UGP, 1024, 1024}; SsmOrder S{sl(F.G), sl((int)blockIdx.x), 1};
          EpiZ E{(float*)(wsl(ws) + WS_ZB)}; pg8::gemm_phase(F.lds, g, S, E, sl(F.wave)); }
        ph_pool_dl(F);
        moba::phase(sl(F.wave), sl(F.vcu), P_QB(FL), P_KB(FL), P_VB(FL), P_YMIX(FL), P_KMP(FL), P_BT(FL), (LAS char*)F.lds);
        GRID_BAR();
        ph_ssm_scan(F, l);
        GRID_BAR();
        { pg8::Gemm g{P_UG(FL), (const bf16*)(wsl(ws) + WS_TG) + (size_t)l * SGN * 1024 * UGP, UGP, UGP, UGP}; SsmOrder S{sl(F.G), sl((int)blockIdx.x), 2};
          EpiSsm2 E{P_UG(FL), P_YS(FL), F.in[11] + l * 256}; pg8::gemm_phase(F.lds, g, S, E, sl(F.wave)); }
        GRID_BAR();
        { pg8::Gemm g{P_YS(FL), (const bf16*)(wsl(ws) + WS_GLUT) + (size_t)l * 65536, 256, 256, 256}; HalfOrder S{sl(F.vcu)};
          EpiGluE E{P_YS(FL), P_YMIX(FL), F.in[13] + l * 256}; pg8::gemm_phase(F.lds, g, S, E, sl(F.wave)); }
        { pg8::Gemm g{P_DL(FL), (const bf16*)(wsl(ws) + WS_POOLT) + (size_t)l * 65536, 256, 256, 256}; HalfOrder S{sl(F.vcu) - 128};
          EpiPoolE E{P_YMIX(FL), F.in[15] + l * 256, F.in[16] + l * 256}; pg8::gemm_phase(F.lds, g, S, E, sl(F.wave)); }
        GRID_BAR();
        { pg8::Gemm g{P_YMIX(FL), (const bf16*)(wsl(ws) + WS_WOUT) + (size_t)l * D * D, D, D, D}; pg8::StaticOrder S; S.init(T, D, sl(F.G), sl((int)blockIdx.x));
          EpiOutE E{P_XB(FL)}; pg8::gemm_phase(F.lds, g, S, E, sl(F.wave)); }
        GRID_BAR();
        ph_route(F, l);
        GRID_BAR();
        ph_place(F);
        GRID_BAR();
        { pg8::Gemm g{(const bf16*)(wsl(ws) + WS_XS), (const bf16*)(wsl(ws) + WS_GU) + (size_t)l * 16 * 512 * D, D, D, D}; MoeOrder S{(const int*)(wsl(ws) + WS_TILEB), sl(F.G), sl((int)blockIdx.x), false};
          EpiGU E{(bf16*)(wsl(ws) + WS_HACT), (const float*)(wsl(ws) + WS_ROWW), (const float*)(wsl(ws) + WS_ROWR)}; pg8::gemm_phase(F.lds, g, S, E, sl(F.wave)); }
        GRID_BAR();
        { pg8::Gemm g{(const bf16*)(wsl(ws) + WS_HACT), (const bf16*)(wsl(ws) + WS_WD) + (size_t)l * 24 * D * 512, 512, 512, 512}; MoeOrder S{(const int*)(wsl(ws) + WS_TILEB), sl(F.G), sl((int)blockIdx.x), true};
          EpiDown E{P_XB(FL), (const int*)(wsl(ws) + WS_ROWTOK)}; pg8::gemm_phase(F.lds, g, S, E, sl(F.wave)); }
        GRID_BAR();
    }
    ph_final(F);
}

extern "C" void kernel_launch(void* const* d_in, const int* in_sizes, int n_in, void* d_out, int out_size, void* d_ws, size_t ws_size, hipStream_t stream) {
    static int grid = 0;
    if (grid == 0) {
        if (n_in != 27 || out_size != T * D || ws_size < WS_END) { fprintf(stderr, "kernel_launch: unexpected shapes (n_in %d out %d ws %zu)\n", n_in, out_size, ws_size); grid = -1; return; }
        int dev = 0, cus = 0, per_cu = 0;
        if (hipGetDevice(&dev) != hipSuccess || hipDeviceGetAttribute(&cus, hipDeviceAttributeMultiprocessorCount, dev) != hipSuccess) { grid = -1; return; }
        if (hipFuncSetAttribute((const void*)mk_fwd, hipFuncAttributeMaxDynamicSharedMemorySize, LDS_BYTES) != hipSuccess) { fprintf(stderr, "kernel_launch: hipFuncSetAttribute failed\n"); grid = -1; return; }
        if (hipOccupancyMaxActiveBlocksPerMultiprocessor(&per_cu, (const void*)mk_fwd, NTHREADS, LDS_BYTES) != hipSuccess || per_cu < 1) { fprintf(stderr, "kernel_launch: occupancy query says %d\n", per_cu); per_cu = 1; }
        (void)hipGetLastError();
        grid = cus;
    }
    if (grid < 0) return;
    (void)hipMemsetAsync((char*)d_ws + WS_CTL, 0, CTL_ZERO_BYTES, stream);
    Args a{};
    for (int i = 0; i < 27; ++i) a.in[i] = (const float*)d_in[i];
    a.out = (float*)d_out; a.ws = (unsigned char*)d_ws; a.pad0 = 0; a.pad1 = 0;
    hipLaunchKernelGGL(mk_fwd, dim3(grid), dim3(NTHREADS), LDS_BYTES, stream, a);
}
```

```cpp
#include <hip/hip_runtime.h>
#include <hip/hip_bf16.h>
#include <cstdio>
#include <cstdint>

#define GAS __attribute__((address_space(1)))
#define LAS __attribute__((address_space(3)))
typedef unsigned short bf16;
typedef float f32x4 __attribute__((ext_vector_type(4)));
typedef unsigned u32x4 __attribute__((ext_vector_type(4)));
typedef unsigned u32x2 __attribute__((ext_vector_type(2)));

constexpr int NB = 8, SEQ = 4096, T = NB * SEQ, D = 1024, NPROJ = 2048, DEPTH = 2;
constexpr int NHEAD = 8, HD = 64, MBLK = 256, NBLK = SEQ / MBLK;
constexpr int SG = 16, SGN = 16, SP = 64, SCH = 64, UGP = 1152;
constexpr float RMS_EPS = 1e-6f;
constexpr float LOG2E = 1.4426950408889634f;
constexpr float C2 = 0.125f * LOG2E;
constexpr int NWAVES = 8, NTHREADS = 512;

constexpr size_t MiB = 1u << 20;
constexpr size_t WS_CTL = 0, CTL_ZERO_BYTES = 1 * MiB;
constexpr size_t WS_XB = 2 * MiB;
constexpr size_t WS_UG = 66 * MiB;
constexpr size_t WS_PB = 84 * MiB;
constexpr size_t WS_QB = 100 * MiB;
constexpr size_t WS_KB = 132 * MiB;
constexpr size_t WS_VB = 164 * MiB;
constexpr size_t WS_YMIX = 196 * MiB;
constexpr size_t WS_YS = 260 * MiB;
constexpr size_t WS_DL = 276 * MiB;
constexpr size_t WS_KMP = 292 * MiB;
constexpr size_t WS_BT = 293 * MiB;
constexpr size_t WS_WIN = 300 * MiB;
constexpr size_t WS_WOUT = 308 * MiB;
constexpr size_t WS_GU = 312 * MiB;
constexpr size_t WS_WD = 344 * MiB;
constexpr size_t WS_TG = 392 * MiB;
constexpr size_t WS_BZ = 464 * MiB;
constexpr size_t WS_GLUT = 480 * MiB;
constexpr size_t WS_POOLT = WS_GLUT + 512 * 1024;
constexpr size_t WS_ZB = 482 * MiB;
constexpr size_t WS_END = 486 * MiB;
constexpr int MOE_MAXT = 152;
constexpr size_t WS_XS = 66 * MiB;
constexpr size_t WS_HACT = 142 * MiB;
constexpr size_t WS_TOKB = 294 * MiB;
constexpr size_t WS_TOKR = WS_TOKB + 128 * 1024;
constexpr size_t WS_TOKW = WS_TOKB + 256 * 1024;
constexpr size_t WS_ROWTOK = 295 * MiB;
constexpr size_t WS_ROWW = WS_ROWTOK + 256 * 1024;
constexpr size_t WS_ROWR = WS_ROWTOK + 576 * 1024;
constexpr size_t WS_RS1 = WS_ROWTOK + 768 * 1024;
constexpr size_t WS_WGCNT = 296 * MiB;
constexpr size_t WS_TILEB = WS_WGCNT + 64 * 1024;

constexpr int CW_BAR = 4096;

__device__ __forceinline__ unsigned f2bf(float f) { unsigned u = __builtin_bit_cast(unsigned, f); return (u + 0x7fffu + ((u >> 16) & 1u)) >> 16; }
__device__ __forceinline__ float bf2f(unsigned h) { return __builtin_bit_cast(float, h << 16); }
__device__ __forceinline__ unsigned pk2(float lo, float hi) { return f2bf(lo) | (f2bf(hi) << 16); }
template <int O> __device__ __forceinline__ float xshfl(float v) {
    if constexpr (O < 32) return __builtin_bit_cast(float, __builtin_amdgcn_ds_swizzle(__builtin_bit_cast(int, v), (O << 10) | 0x1f));
    else { const unsigned u = __builtin_bit_cast(unsigned, v); auto r = __builtin_amdgcn_permlane32_swap(u, u, false, false);
           const float a = __builtin_bit_cast(float, (unsigned)r[0]), b = __builtin_bit_cast(float, (unsigned)r[1]); return (a == v && __builtin_bit_cast(unsigned, a) == u) ? b : a; }
}
__device__ __forceinline__ float wave_sum(float v) {
    v += xshfl<1>(v); v += xshfl<2>(v); v += xshfl<4>(v); v += xshfl<8>(v); v += xshfl<16>(v);
    const unsigned u = __builtin_bit_cast(unsigned, v); auto r = __builtin_amdgcn_permlane32_swap(u, u, false, false);
    return __builtin_bit_cast(float, (unsigned)r[0]) + __builtin_bit_cast(float, (unsigned)r[1]);
}
__device__ __forceinline__ float wave_max(float v) {
    v = fmaxf(v, xshfl<1>(v)); v = fmaxf(v, xshfl<2>(v)); v = fmaxf(v, xshfl<4>(v)); v = fmaxf(v, xshfl<8>(v)); v = fmaxf(v, xshfl<16>(v));
    const unsigned u = __builtin_bit_cast(unsigned, v); auto r = __builtin_amdgcn_permlane32_swap(u, u, false, false);
    return fmaxf(__builtin_bit_cast(float, (unsigned)r[0]), __builtin_bit_cast(float, (unsigned)r[1]));
}
__device__ __forceinline__ float gelu_tanh(float x) {
    const float u = 0.7978845608028654f * (x + 0.044715f * x * x * x);
    const float e = __expf(2.f * u);
    const float th = 1.f - 2.f / (e + 1.f);
    return 0.5f * x * (1.f + th);
}
__device__ __forceinline__ float sigmoidf_(float x) { return 1.f / (1.f + __expf(-x)); }

__device__ __forceinline__ int lane_id() { unsigned m; asm volatile("s_mov_b32 %0, -1" : "=s"(m)); return (int)__builtin_amdgcn_mbcnt_hi(m, __builtin_amdgcn_mbcnt_lo(m, 0u)); }

#define XB_TMO      128
#define XB_XCNT(j)  (256  + 64 * (j))
#define XB_XSUB(j)  (1280 + 64 * (j))
#define XB_XGEN(j)  (2304 + 64 * (j))
#define XB_TOP      3328
#define XB_TOPGEN   3392
#define XCD_BAR_WORDS 3456
#define XB_SPIN_CAP (1u << 22)
__device__ __forceinline__ unsigned xb_ld(unsigned* p)              { return __hip_atomic_load(p, __ATOMIC_RELAXED, __HIP_MEMORY_SCOPE_AGENT); }
__device__ __forceinline__ unsigned xb_add(unsigned* p, unsigned v) { return __hip_atomic_fetch_add(p, v, __ATOMIC_RELAXED, __HIP_MEMORY_SCOPE_AGENT); }
__device__ __forceinline__ unsigned xb_xcc_id() { return (unsigned)__builtin_amdgcn_s_getreg((3 << 11) | 20) & 0xFu; }
#define XB_SPIN(cond, bar) do { unsigned _sp = 0; while (cond) { __builtin_amdgcn_s_sleep(1); \
    if ((++_sp & 255u) == 0u) { if (xb_ld(&(bar)[XB_TMO])) break; if (_sp > XB_SPIN_CAP) { atomicAdd(&(bar)[XB_TMO], 1u); break; } } } } while (0)
struct XcdBarrier { unsigned* bar; unsigned x; volatile LAS unsigned* st; };
__device__ __forceinline__ XcdBarrier xcd_barrier_post(unsigned* bar, volatile LAS unsigned* st, bool t0) {
    XcdBarrier b; b.bar = bar; b.x = xb_xcc_id(); b.st = st;
    if (t0) (void)xb_add(&bar[XB_XCNT(b.x)], 1u);
    return b;
}
__device__ __forceinline__ void xcd_barrier_complete(unsigned* bar, unsigned x, unsigned& nloc, unsigned& nx) {
    const unsigned G = gridDim.x * gridDim.y * gridDim.z;
    unsigned sum, cnt, mine, sp = 0u;
    for (;;) {
        sum = 0u; cnt = 0u; mine = 0u;
#pragma unroll
        for (unsigned j = 0; j < 16; ++j) { const unsigned c = xb_ld(&bar[XB_XCNT(j)]); sum += c; cnt += (c > 0u) ? 1u : 0u; mine = (j == x) ? c : mine; }
        if (sum == G) break;
        __builtin_amdgcn_s_sleep(1);
        if ((++sp & 255u) == 0u) { if (xb_ld(&bar[XB_TMO])) break; if (sp > XB_SPIN_CAP) { atomicAdd(&bar[XB_TMO], 1u); break; } }
    }
    nloc = mine > 0u ? mine : 1u; nx = cnt > 0u ? cnt : 1u;
}
__device__ __forceinline__ void xcd_barrier(const XcdBarrier& b, int wave) {
    asm volatile("s_waitcnt vmcnt(0)" ::: "memory");
    __syncthreads();
    if (wave == 0 && lane_id() == 0) {
        unsigned* bar = b.bar;
        __builtin_amdgcn_s_waitcnt(0);
        unsigned nloc = b.st[0], nx = b.st[1];
        if (nloc == 0u) { xcd_barrier_complete(bar, b.x, nloc, nx); b.st[0] = nloc; b.st[1] = nx; }
        const unsigned old = xb_add(&bar[XB_XSUB(b.x)], 1u);
        const unsigned gen = old / nloc;
        if (old + 1u == (gen + 1u) * nloc) {
            __builtin_amdgcn_fence(__ATOMIC_RELEASE, "agent");
            asm volatile("s_waitcnt vmcnt(0)" ::: "memory");
            const unsigned og = xb_add(&bar[XB_TOP], 1u);
            const unsigned tg = og / nx;
            if (og + 1u == (tg + 1u) * nx) xb_add(&bar[XB_TOPGEN], 1u);
            else XB_SPIN(xb_ld(&bar[XB_TOPGEN]) == tg, bar);
            __builtin_amdgcn_fence(__ATOMIC_ACQUIRE, "agent");
            xb_add(&bar[XB_XGEN(b.x)], 1u);
            asm volatile("s_waitcnt vmcnt(0)" ::: "memory");
        } else {
            XB_SPIN(xb_ld(&bar[XB_XGEN(b.x)]) == gen, bar);
            __builtin_amdgcn_fence(__ATOMIC_ACQUIRE, "agent");
            asm volatile("s_waitcnt vmcnt(0)" ::: "memory");
        }
    }
    __syncthreads();
}

struct Args {
    const float* in[27];
    float* out;
    unsigned char* ws;
    int pad0, pad1;
};

typedef const float* fptr_t;
typedef __attribute__((address_space(4))) const fptr_t* KargP;
struct Ctx {
    LAS unsigned char* lds;
    int tid, lane, wave, vcu, G;
    KargP in;
    float* R;
    unsigned char* ws;
};
#define P_XB(F) ((bf16*)((F).ws + WS_XB))
#define P_UG(F) ((bf16*)((F).ws + WS_UG))
#define P_PB(F) ((bf16*)((F).ws + WS_PB))
#define P_QB(F) ((bf16*)((F).ws + WS_QB))
#define P_KB(F) ((bf16*)((F).ws + WS_KB))
#define P_VB(F) ((bf16*)((F).ws + WS_VB))
#define P_YMIX(F) ((bf16*)((F).ws + WS_YMIX))
#define P_YS(F) ((bf16*)((F).ws + WS_YS))
#define P_DL(F) ((bf16*)((F).ws + WS_DL))
#define P_KMP(F) ((float*)((F).ws + WS_KMP))
#define P_BT(F) ((float*)((F).ws + WS_BT))


__device__ __forceinline__ Ctx launder(const Ctx& F0) {
    Ctx F = F0;
    int ln = lane_id(); asm volatile("" : "+v"(ln));
    asm volatile("" : "+s"(F.wave), "+s"(F.vcu), "+s"(F.G));
    F.lane = ln; F.tid = F.wave * 64 + ln;
    KargP kp = (KargP)__builtin_amdgcn_kernarg_segment_ptr(); asm volatile("" : "+s"(kp));
    F.in = kp; F.R = (float*)kp[27]; F.ws = (unsigned char*)kp[28];
    return F;
}

__device__ __forceinline__ unsigned char* wsl(unsigned char* p) { asm volatile("" : "+s"(p)); return p; }
__device__ __forceinline__ int sl(int x) { asm volatile("" : "+s"(x)); return x; }

namespace pg8 {
typedef short bf16x8 __attribute__((ext_vector_type(8)));
constexpr int BM = 256, BK = 64, HALF = 128, HTB = HALF * BK * 2, STAGE_BYTES = 8 * HTB, NXCD = 8, WGM = 8;
__device__ __forceinline__ int lds_byte(int r, int c) { const int st = (r >> 4) * 2 + (c >> 5), rr = r & 15, cc = c & 31, ob = rr * 64 + cc * 2; return st * 1024 + (ob ^ (((ob >> 9) & 1) << 5)); }
__device__ __forceinline__ void stage_rc(int b, int& R, int& C) { const int st = b / 1024, sb = b % 1024, swz = sb ^ (((sb >> 9) & 1) << 5); R = (st >> 1) * 16 + swz / 64; C = (st & 1) * 32 + (swz % 64) / 2; }
__device__ __forceinline__ int perm32(int rho) { const int n = rho >> 4, i = rho & 15; return 8 * (i >> 2) + 4 * n + (i & 3); }

struct Unit { int pm, pn, aux; };
struct Gemm { const bf16* A; const bf16* Bt; int lda, ldb, K; };

struct StaticOrder {
    int nM, nN, nwg, G, c;
    __device__ void init(int M, int N, int G_, int c_) { nM = M / BM; nN = N / BM; nwg = nM * nN; G = G_; c = c_; }
    __device__ bool next(int i, Unit& u) const {
        const long L = (long)i * G + c; if (L >= nwg) return false;
        int wgid = (int)L; { const int q = nwg / NXCD, r = nwg % NXCD, xcd = wgid % NXCD, off = wgid / NXCD; wgid = (xcd < r ? xcd * (q + 1) : r * (q + 1) + (xcd - r) * q) + off; }
        const int nig = WGM * nN, gid = wgid / nig, fm = gid * WGM, gsz = (nM - fm) < WGM ? (nM - fm) : WGM;
        u.pm = fm + ((wgid % nig) % gsz); u.pn = (wgid % nig) / gsz; u.aux = 0; return true;
    }
};

__device__ __forceinline__ unsigned cvt_pk_bf16(float lo, float hi) { unsigned r; asm volatile("v_cvt_pk_bf16_f32 %0, %1, %2" : "=v"(r) : "v"(lo), "v"(hi)); return r; }

template <bool ALIGN = true, class Epi, class Sched>
__device__ __forceinline__ void gemm_phase(LAS unsigned char* lds, const Gemm g, const Sched& S, const Epi& E, int wave_) {
    int lane_ = lane_id(); asm volatile("" : "+v"(lane_)); asm volatile("" : "+s"(wave_));
    const int wid = wave_, lane = lane_, tid = wid * 64 + lane, wr = wid >> 2, wc = wid & 3, fr = lane & 15, fq = lane >> 4;
    const int K = g.K, nt = K / BK;
    unsigned voffA[2], voffB[2];
#pragma unroll
    for (int i = 0; i < 2; ++i) { int R, C; stage_rc(tid * 16 + i * 8192, R, C); const int Rb = Epi::PERM ? ((R & ~31) + perm32(R & 31)) : R;
        voffA[i] = (unsigned)(R * g.lda + C) * 2u; voffB[i] = (unsigned)(Rb * g.ldb + C) * 2u; }
    const size_t kstep = (size_t)(BK * 2);
    const size_t hstepA = (size_t)HALF * g.lda * 2, hstepB = (size_t)HALF * g.ldb * 2;
    const size_t tstepA = 2 * hstepA, tstepB = 2 * hstepB;
    const unsigned ldsw = (unsigned)wid * 1024u;
    const int aoff = lds_byte(wr * 64 + fr, fq * 8), boff = lds_byte(wc * 32 + fr, fq * 8);
#define PG8_SA(b, h) (((b) * 2 + (h)) * HTB)
#define PG8_SB(b, h) ((4 + (b) * 2 + (h)) * HTB)
#define PG8_STAGE(bufoff, gbase, voff) do { _Pragma("unroll") for (int _i = 0; _i < 2; ++_i) \
        __builtin_amdgcn_global_load_lds((const unsigned*)((const char*)(gbase) + (voff)[_i]), (LAS unsigned*)(lds + (bufoff) + ldsw + _i * 8192), 16, 0, 0); } while (0)
#define PG8_LDA(dst, b, h) do { _Pragma("unroll") for (int m = 0; m < 4; ++m) _Pragma("unroll") for (int k = 0; k < 2; ++k) dst[m][k] = *(const LAS bf16x8*)(lds + PG8_SA(b, h) + aoff + m * 2048 + k * 1024); } while (0)
#define PG8_LDB(dst, b, h) do { _Pragma("unroll") for (int n = 0; n < 2; ++n) _Pragma("unroll") for (int k = 0; k < 2; ++k) dst[n][k] = *(const LAS bf16x8*)(lds + PG8_SB(b, h) + boff + n * 2048 + k * 1024); } while (0)
#define PG8_MMA(ai, bj, At, Bt) do { __builtin_amdgcn_s_setprio(1); _Pragma("unroll") for (int m = 0; m < 4; ++m) _Pragma("unroll") for (int n = 0; n < 2; ++n) _Pragma("unroll") for (int k = 0; k < 2; ++k) \
        acc[ai][bj][m][n] = __builtin_amdgcn_mfma_f32_16x16x32_bf16(Bt[n][k], At[m][k], acc[ai][bj][m][n], 0, 0, 0); __builtin_amdgcn_s_setprio(0); } while (0)
#define PG8_WAIT_V(n) asm volatile("s_waitcnt vmcnt(" #n ")" ::: "memory")
#define PG8_WAIT_L(n) asm volatile("s_waitcnt lgkmcnt(" #n ")" ::: "memory")
#define PG8_BAR __builtin_amdgcn_s_barrier()
#define PG8_SCHED __builtin_amdgcn_sched_barrier(0)
    Unit cur, nxt; int ui = 0;
    if (!S.next(0, cur)) return;
    f32x4 acc[2][2][4][2];
#pragma unroll
    for (int a = 0; a < 2; ++a)
#pragma unroll
        for (int b = 0; b < 2; ++b)
#pragma unroll
            for (int m = 0; m < 4; ++m)
#pragma unroll
                for (int n = 0; n < 2; ++n) acc[a][b][m][n] = (f32x4){0.f, 0.f, 0.f, 0.f};
    bf16x8 At[4][2], B0[2][2], B1[2][2];
    const char* cA = (const char*)g.A + (size_t)cur.pm * tstepA; const char* cB = (const char*)g.Bt + (size_t)cur.pn * tstepB;
    PG8_STAGE(PG8_SB(0, 0), cB, voffB); PG8_STAGE(PG8_SB(0, 1), cB + hstepB, voffB); PG8_STAGE(PG8_SA(0, 0), cA, voffA); PG8_STAGE(PG8_SA(0, 1), cA + hstepA, voffA);
    if (wr == 1) PG8_BAR;
    PG8_WAIT_V(2); PG8_BAR;
    PG8_STAGE(PG8_SB(1, 0), cB + kstep, voffB); PG8_STAGE(PG8_SA(1, 0), cA + kstep, voffA); PG8_STAGE(PG8_SB(1, 1), cB + hstepB + kstep, voffB);
    PG8_WAIT_V(6); PG8_BAR;
    for (;;) {
        const bool has_next = S.next(ui + 1, nxt);
        const char* nA = has_next ? (const char*)g.A + (size_t)nxt.pm * tstepA : cA; const char* nB = has_next ? (const char*)g.Bt + (size_t)nxt.pn * tstepB : cB;
        for (int t = 0; t < nt; t += 2) {
            const bool last = (t == nt - 2);
            const char* a1 = cA + (size_t)(t + 1) * kstep;
            const char* a2 = last ? nA : cA + (size_t)(t + 2) * kstep; const char* b2 = last ? nB : cB + (size_t)(t + 2) * kstep;
            const char* a3 = a2 + kstep; const char* b3 = b2 + kstep;
            PG8_LDB(B0, 0, 0); PG8_LDB(B1, 0, 1); PG8_SCHED; PG8_LDA(At, 0, 0); PG8_STAGE(PG8_SA(1, 1), a1 + hstepA, voffA);
            PG8_WAIT_V(8); PG8_WAIT_L(0); PG8_BAR; PG8_MMA(0, 0, At, B0); PG8_MMA(0, 1, At, B1); PG8_BAR; PG8_SCHED;
            PG8_LDA(At, 0, 1); PG8_STAGE(PG8_SB(0, 0), b2, voffB); PG8_STAGE(PG8_SB(0, 1), b2 + hstepB, voffB); PG8_STAGE(PG8_SA(0, 0), a2, voffA);
            PG8_WAIT_V(8); PG8_WAIT_L(0); PG8_BAR; PG8_MMA(1, 0, At, B0); PG8_MMA(1, 1, At, B1); PG8_BAR; PG8_SCHED;
            PG8_LDB(B0, 1, 0); PG8_LDB(B1, 1, 1); PG8_SCHED; PG8_LDA(At, 1, 0); PG8_STAGE(PG8_SA(0, 1), a2 + hstepA, voffA);
            PG8_WAIT_V(8); PG8_WAIT_L(0); PG8_BAR; PG8_MMA(0, 0, At, B0); PG8_MMA(0, 1, At, B1); PG8_BAR; PG8_SCHED;
            PG8_LDA(At, 1, 1); PG8_STAGE(PG8_SB(1, 0), b3, voffB); PG8_STAGE(PG8_SB(1, 1), b3 + hstepB, voffB); PG8_STAGE(PG8_SA(1, 0), a3, voffA);
            PG8_WAIT_V(8); PG8_WAIT_L(0); PG8_BAR; PG8_MMA(1, 0, At, B0); PG8_MMA(1, 1, At, B1); PG8_BAR; PG8_SCHED;
        }
        if constexpr (ALIGN) { if (wr == 0) PG8_BAR; }
        E(acc, cur, wr, wc, fr, fq);
        if (!has_next) break;
#pragma unroll
        for (int a = 0; a < 2; ++a)
#pragma unroll
            for (int b = 0; b < 2; ++b)
#pragma unroll
                for (int m = 0; m < 4; ++m)
#pragma unroll
                    for (int n = 0; n < 2; ++n) acc[a][b][m][n] = (f32x4){0.f, 0.f, 0.f, 0.f};
        cur = nxt; cA = nA; cB = nB; ++ui;
        if constexpr (ALIGN) { if (wr == 1) PG8_BAR; }
    }
    PG8_WAIT_V(0);
    if constexpr (!ALIGN) { if (wr == 0) PG8_BAR; }
    PG8_BAR;
#undef PG8_SA
#undef PG8_SB
#undef PG8_STAGE
#undef PG8_LDA
#undef PG8_LDB
#undef PG8_MMA
#undef PG8_WAIT_V
#undef PG8_WAIT_L
#undef PG8_BAR
#undef PG8_SCHED
}
}


struct EpiProjE {
    static constexpr bool PERM = true;
    bf16 *UG, *PB, *QB, *KB, *VB; float* KMP; const float* rs1;
    __device__ __forceinline__ void operator()(const f32x4 (&acc_)[2][2][4][2], const pg8::Unit& u, int wr, int wc, int fr_, int fq_) const {
        const int ln_ = lane_id(), fr = ln_ & 15, fq = ln_ >> 4; (void)fr_; (void)fq_;
        const int pn = u.pn, row0 = u.pm * 256 + wr * 64 + fr, cl = wc * 32 + 8 * fq;
        f32x4 acc[2][2][4][2];
#pragma unroll
        for (int ai = 0; ai < 2; ++ai)
#pragma unroll
            for (int m = 0; m < 4; ++m) { const float rs = rs1[row0 + ai * 128 + m * 16];
#pragma unroll
                for (int bj = 0; bj < 2; ++bj) { acc[ai][bj][m][0] = acc_[ai][bj][m][0] * rs; acc[ai][bj][m][1] = acc_[ai][bj][m][1] * rs; } }
        if (pn == 0) {
#pragma unroll
            for (int ai = 0; ai < 2; ++ai)
#pragma unroll
                for (int m = 0; m < 4; ++m) { const int r = row0 + ai * 128 + m * 16;
#pragma unroll
                    for (int bj = 0; bj < 2; ++bj) { const int ch = bj * 128 + cl, g = ch >> 4, h0 = ch & 15;
                        const f32x4 v0 = acc[ai][bj][m][0], v1 = acc[ai][bj][m][1]; u32x4 w;
                        w.x = pg8::cvt_pk_bf16(v0[0], v0[1]); w.y = pg8::cvt_pk_bf16(v0[2], v0[3]); w.z = pg8::cvt_pk_bf16(v1[0], v1[1]); w.w = pg8::cvt_pk_bf16(v1[2], v1[3]);
                        *(u32x4*)(UG + ((size_t)(g * 512 + (r >> 6))) * UGP + (r & 63) * 16 + h0) = w; } }
        } else {
            bf16* base; int ldc, colt; float sc = 1.f;
            if (pn == 1) { base = PB; ldc = 256; colt = 0; }
            else if (pn < 4) { base = QB; ldc = 512; colt = (pn - 2) * 256; sc = C2; }
            else if (pn < 6) { base = KB; ldc = 512; colt = (pn - 4) * 256; }
            else { base = VB; ldc = 512; colt = (pn - 6) * 256; }
#pragma unroll
            for (int ai = 0; ai < 2; ++ai)
#pragma unroll
                for (int m = 0; m < 4; ++m) { bf16* rowp = base + (size_t)(row0 + ai * 128 + m * 16) * ldc + colt + cl;
#pragma unroll
                    for (int bj = 0; bj < 2; ++bj) { const f32x4 v0 = acc[ai][bj][m][0] * sc, v1 = acc[ai][bj][m][1] * sc; u32x4 w;
                        w.x = pg8::cvt_pk_bf16(v0[0], v0[1]); w.y = pg8::cvt_pk_bf16(v0[2], v0[3]); w.z = pg8::cvt_pk_bf16(v1[0], v1[1]); w.w = pg8::cvt_pk_bf16(v1[2], v1[3]);
                        *(u32x4*)(rowp + bj * 128) = w; } }
            if (pn >= 4 && pn < 6) {
#pragma unroll
                for (int bj = 0; bj < 2; ++bj)
#pragma unroll
                    for (int n = 0; n < 2; ++n) { f32x4 s = (f32x4){0.f, 0.f, 0.f, 0.f};
#pragma unroll
                        for (int ai = 0; ai < 2; ++ai)
#pragma unroll
                            for (int m = 0; m < 4; ++m) s += acc[ai][bj][m][n];
#pragma unroll
                        for (int i = 0; i < 4; ++i) { float t = s[i]; t += xshfl<1>(t); t += xshfl<2>(t); t += xshfl<4>(t); t += xshfl<8>(t); s[i] = t; }
                        if (fr == 0) *(f32x4*)(KMP + (size_t)wr * 128 * 512 + (size_t)u.pm * 512 + colt + bj * 128 + cl + 4 * n) = s; }
            }
        }
    }
};
struct EpiOutE {
    static constexpr bool PERM = true;
    bf16* RB;
    __device__ __forceinline__ void operator()(const f32x4 (&acc)[2][2][4][2], const pg8::Unit& u, int wr, int wc, int fr_, int fq_) const {
        const int ln_ = lane_id(), fr = ln_ & 15, fq = ln_ >> 4; (void)fr_; (void)fq_;
        const int row0 = u.pm * 256 + wr * 64 + fr, col0 = u.pn * 256 + wc * 32 + 8 * fq;
#pragma unroll
        for (int ai = 0; ai < 2; ++ai)
#pragma unroll
            for (int m = 0; m < 4; ++m) { bf16* rp = RB + (size_t)(row0 + ai * 128 + m * 16) * D + col0;
#pragma unroll
                for (int bj = 0; bj < 2; ++bj) { const u32x4 x = *(const u32x4*)(rp + bj * 128); const f32x4 a0 = acc[ai][bj][m][0], a1 = acc[ai][bj][m][1]; u32x4 w;
                    w.x = pg8::cvt_pk_bf16(bf2f(x.x & 0xffffu) + a0[0], bf2f(x.x >> 16) + a0[1]); w.y = pg8::cvt_pk_bf16(bf2f(x.y & 0xffffu) + a0[2], bf2f(x.y >> 16) + a0[3]);
                    w.z = pg8::cvt_pk_bf16(bf2f(x.z & 0xffffu) + a1[0], bf2f(x.z >> 16) + a1[1]); w.w = pg8::cvt_pk_bf16(bf2f(x.w & 0xffffu) + a1[2], bf2f(x.w >> 16) + a1[3]);
                    *(u32x4*)(rp + bj * 128) = w; }
                if (m & 1) asm volatile("" ::: "memory"); }
    }
};

__device__ __forceinline__ void transpose_item(const float* W, int K, int N, const float* kscale, bf16* WT, int ldo, int koff, int rowmode, LAS float* scr, int item, int lane) {
    const int nblk = N / 32, kb = item / nblk, nb = item % nblk, k0 = 64 * kb, n0 = 32 * nb;
#pragma unroll 8
    for (int i = 0; i < 32; ++i) { const int kk = 2 * i + (lane >> 5); const float s = kscale ? kscale[k0 + kk] : 1.f; scr[kk * 33 + (lane & 31)] = W[(size_t)(k0 + kk) * N + n0 + (lane & 31)] * s; }
    asm volatile("s_waitcnt lgkmcnt(0)" ::: "memory");
    const int c = lane & 7;
#pragma unroll
    for (int j = 0; j < 4; ++j) { const int n = (lane >> 3) + 8 * j; const LAS float* s = scr + (8 * c) * 33 + n;
        u32x4 o; o.x = pk2(s[0 * 33], s[1 * 33]); o.y = pk2(s[2 * 33], s[3 * 33]); o.z = pk2(s[4 * 33], s[5 * 33]); o.w = pk2(s[6 * 33], s[7 * 33]);
        const int nn = n0 + n, row = rowmode == 0 ? nn : (8 * (nn >> 2) + (nn & 3) + (rowmode == 2 ? 4 : 0));
        *(u32x4*)(WT + (size_t)row * ldo + koff + k0 + 8 * c) = o; }
    asm volatile("s_waitcnt lgkmcnt(0)" ::: "memory");
}
__device__ __forceinline__ void pair_decode(int pi, int& ea, int& eb) { ea = pi < 3 ? 0 : (pi < 5 ? 1 : 2); eb = pi < 3 ? pi + 1 : (pi < 5 ? pi - 1 : 3); }
__device__ __forceinline__ void ph_prologue(const Ctx& F0) {
    const Ctx F = launder(F0);
    LAS float* scr = (LAS float*)(F.lds + F.wave * 16384);
    const int gw = F.vcu * NWAVES + F.wave, NGW = F.G * NWAVES;
    constexpr int I_IN = (D / 64) * (NPROJ / 32), I_OUT = (D / 64) * (D / 32), I_GU1 = (D / 64) * (256 / 32), I_GU = 16 * 2 * I_GU1, I_WD1 = (256 / 64) * (D / 32), I_WD = 24 * 2 * I_WD1;
    constexpr int I_L = I_IN + I_OUT + I_GU + I_WD;
    for (int it = gw; it < DEPTH * I_L; it += NGW) {
        const int l = it / I_L; int r = it % I_L;
        if (r < I_IN) { transpose_item(F.in[3] + (size_t)l * D * NPROJ, D, NPROJ, F.in[2] + l * D, (bf16*)(F.ws + WS_WIN) + (size_t)l * NPROJ * D, D, 0, 0, scr, r, F.lane); continue; } r -= I_IN;
        if (r < I_OUT) { transpose_item(F.in[17] + (size_t)l * D * D, D, D, nullptr, (bf16*)(F.ws + WS_WOUT) + (size_t)l * D * D, D, 0, 0, scr, r, F.lane); continue; } r -= I_OUT;
        if (r < I_GU) { const int e = r / (2 * I_GU1), up = (r / I_GU1) & 1, item = r % I_GU1;
            transpose_item(F.in[up ? 24 : 23] + ((size_t)l * 16 + e) * D * 256, D, 256, F.in[18] + l * D, (bf16*)(F.ws + WS_GU) + ((size_t)l * 16 + e) * 512 * D, D, 0, 1 + up, scr, item, F.lane); continue; } r -= I_GU;
        { const int bk = r / (2 * I_WD1), half = (r / I_WD1) & 1, item = r % I_WD1, g = bk / 6; int ea, eb; pair_decode(bk % 6, ea, eb); const int e = g * 4 + (half ? eb : ea);
            transpose_item(F.in[25] + ((size_t)l * 16 + e) * 256 * D, 256, D, nullptr, (bf16*)(F.ws + WS_WD) + ((size_t)l * 24 + bk) * D * 512, 512, half * 256, 0, scr, item, F.lane); }
    }
    for (int it = gw; it < DEPTH * 32; it += NGW) { const int l = it >> 5;
        transpose_item(F.in[12] + (size_t)l * 256 * 256, 256, 256, nullptr, (bf16*)(F.ws + WS_GLUT) + (size_t)l * 65536, 256, 0, 0, scr, it & 31, F.lane); }
    { const int gt = F.vcu * NTHREADS + F.tid, NGT = F.G * NTHREADS;
      for (int i = gt; i < DEPTH * 65536; i += NGT) { const int l = i >> 16, n = (i >> 8) & 255, k = i & 255;
          const float v = ((n >> 6) == (k >> 6)) ? F.in[14][(((size_t)l * 4 + (n >> 6)) * 64 + (k & 63)) * 64 + (n & 63)] : 0.f;
          ((bf16*)(F.ws + WS_POOLT))[i] = (bf16)f2bf(v); } }
    for (int it = gw; it < DEPTH * SGN * 65; it += NGW) {
        const int l = it / (SGN * 65), g = (it / 65) % SGN, tau = it % 65, p = F.lane;
        const float are = F.in[4][(l * SGN + g) * SP + p], aim = F.in[5][(l * SGN + g) * SP + p], dt = expf(F.in[6][l * SGN + g]);
        float sn, cs; sincosf(aim * dt, &sn, &cs); const float mg = expf(are * dt), lbr = mg * cs, lbi = mg * sn;
        const float nr = lbr - 1.f, ni = lbi, den = are * are + aim * aim, cr = (nr * are + ni * aim) / den, ci = (ni * are - nr * aim) / den;
        float sn2, cs2; sincosf(aim * dt * (float)tau, &sn2, &cs2); const float mg2 = expf(are * dt * (float)tau), lr = mg2 * cs2, li = mg2 * sn2;
        float wr[16], wi[16];
#pragma unroll
        for (int h = 0; h < 16; ++h) { const float br = F.in[7][((size_t)(l * SGN + g) * SP + p) * SG + h], bi = F.in[8][((size_t)(l * SGN + g) * SP + p) * SG + h];
            const float bbr = cr * br - ci * bi, bbi = cr * bi + ci * br; wr[h] = lr * bbr - li * bbi; wi[h] = lr * bbi + li * bbr; }
        bf16* TG = (bf16*)(F.ws + WS_TG) + ((size_t)l * SGN + g) * 1024 * UGP;
        if (tau <= 63) {
            bf16* BZ = (bf16*)(F.ws + WS_BZ) + ((size_t)l * SGN + g) * 256 * 1024; const int s = 63 - tau;
            u32x4 o0, o1, o2, o3;
            o0.x = pk2(wr[0], wr[1]); o0.y = pk2(wr[2], wr[3]); o0.z = pk2(wr[4], wr[5]); o0.w = pk2(wr[6], wr[7]); o1.x = pk2(wr[8], wr[9]); o1.y = pk2(wr[10], wr[11]); o1.z = pk2(wr[12], wr[13]); o1.w = pk2(wr[14], wr[15]);
            o2.x = pk2(wi[0], wi[1]); o2.y = pk2(wi[2], wi[3]); o2.z = pk2(wi[4], wi[5]); o2.w = pk2(wi[6], wi[7]); o3.x = pk2(wi[8], wi[9]); o3.y = pk2(wi[10], wi[11]); o3.z = pk2(wi[12], wi[13]); o3.w = pk2(wi[14], wi[15]);
            *(u32x4*)(BZ + (size_t)p * 1024 + s * 16) = o0; *(u32x4*)(BZ + (size_t)p * 1024 + s * 16 + 8) = o1;
            *(u32x4*)(BZ + (size_t)(64 + p) * 1024 + s * 16) = o2; *(u32x4*)(BZ + (size_t)(64 + p) * 1024 + s * 16 + 8) = o3;
        }
        LAS float* Wst = scr; LAS float* Kt = scr + 128 * 16;
        if (tau <= 63) {
#pragma unroll
            for (int q = 0; q < 4; ++q) { *(LAS f32x4*)(Wst + p * 16 + 4 * q) = (f32x4){wr[4 * q], wr[4 * q + 1], wr[4 * q + 2], wr[4 * q + 3]};
                                          *(LAS f32x4*)(Wst + (64 + p) * 16 + 4 * q) = (f32x4){wi[4 * q], wi[4 * q + 1], wi[4 * q + 2], wi[4 * q + 3]}; }
            const int arow = p & 15, kq = p >> 4; f32x4 kacc = (f32x4){0.f, 0.f, 0.f, 0.f};
            const float* cre = F.in[9] + ((size_t)(l * SGN + g) * SG + arow) * SP; const float* cim = F.in[10] + ((size_t)(l * SGN + g) * SG + arow) * SP;
#pragma unroll 8
            for (int s = 0; s < 32; ++s) { const int k = 4 * s + kq; const float av = (k < 64) ? cre[k] : -cim[k - 64]; const float bv = Wst[k * 16 + arow];
                kacc = __builtin_amdgcn_mfma_f32_16x16x4f32(av, bv, kacc, 0, 0, 0); }
#pragma unroll
            for (int r = 0; r < 4; ++r) Kt[(4 * kq + r) * 16 + arow] = kacc[r];
        }
#pragma unroll 1
        for (int ho = 0; ho < 16; ++ho) {
            const float ccr = F.in[9][((size_t)(l * SGN + g) * SG + ho) * SP + p], cci = F.in[10][((size_t)(l * SGN + g) * SG + ho) * SP + p];
            if (tau >= 1) { const int n = (tau - 1) * 16 + ho;
                TG[(size_t)n * UGP + 1024 + p] = (bf16)f2bf(ccr * lr - cci * li); TG[(size_t)n * UGP + 1088 + p] = (bf16)f2bf(-(ccr * li + cci * lr)); }
            if (tau <= 63) {
                float kv[16];
#pragma unroll
                for (int q = 0; q < 4; ++q) { const f32x4 t4 = *(const LAS f32x4*)(Kt + ho * 16 + 4 * q); kv[4 * q] = t4[0]; kv[4 * q + 1] = t4[1]; kv[4 * q + 2] = t4[2]; kv[4 * q + 3] = t4[3]; }
                u32x4 o0, o1; o0.x = pk2(kv[0], kv[1]); o0.y = pk2(kv[2], kv[3]); o0.z = pk2(kv[4], kv[5]); o0.w = pk2(kv[6], kv[7]); o1.x = pk2(kv[8], kv[9]); o1.y = pk2(kv[10], kv[11]); o1.z = pk2(kv[12], kv[13]); o1.w = pk2(kv[14], kv[15]);
                const int to = p;
                if (to >= tau) { bf16* d = TG + (size_t)(to * 16 + ho) * UGP + (to - tau) * 16; *(u32x4*)d = o0; *(u32x4*)(d + 8) = o1; }
                if (tau >= 1 && to + tau <= 63) { bf16* d = TG + (size_t)(to * 16 + ho) * UGP + (to + tau) * 16; const u32x4 z = (u32x4){0u, 0u, 0u, 0u}; *(u32x4*)d = z; *(u32x4*)(d + 8) = z; }
            }
        }
    }
}

__device__ __forceinline__ void route_finish(const float (&a)[20], float ssum, int m, bool act, const float* gb_, const float* rb_, int* tokb, float* tokr, float* tokw, LAS int* hist) {
        const float rstd = 1.f / sqrtf(ssum * (1.f / D) + RMS_EPS);
        float lg0 = a[0] * rstd + gb_[0], lg1 = a[1] * rstd + gb_[1], lg2 = a[2] * rstd + gb_[2], lg3 = a[3] * rstd + gb_[3];
        int gs = 0; float gm = lg0;
        if (lg1 > gm) { gm = lg1; gs = 1; } if (lg2 > gm) { gm = lg2; gs = 2; } if (lg3 > gm) { gm = lg3; gs = 3; }
        const float gwt = 1.f / (__expf(lg0 - gm) + __expf(lg1 - gm) + __expf(lg2 - gm) + __expf(lg3 - gm));
        float q0 = a[4], q1 = a[5], q2 = a[6], q3 = a[7], q4 = a[8], q5 = a[9], q6 = a[10], q7 = a[11], q8 = a[12], q9 = a[13], q10 = a[14], q11 = a[15], q12 = a[16], q13 = a[17], q14 = a[18], q15 = a[19];
        asm volatile("" : "+v"(q0), "+v"(q1), "+v"(q2), "+v"(q3), "+v"(q4), "+v"(q5), "+v"(q6), "+v"(q7));
        asm volatile("" : "+v"(q8), "+v"(q9), "+v"(q10), "+v"(q11), "+v"(q12), "+v"(q13), "+v"(q14), "+v"(q15));
        float e0 = gs == 0 ? q0 : gs == 1 ? q4 : gs == 2 ? q8 : q12;
        float e1 = gs == 0 ? q1 : gs == 1 ? q5 : gs == 2 ? q9 : q13;
        float e2 = gs == 0 ? q2 : gs == 1 ? q6 : gs == 2 ? q10 : q14;
        float e3 = gs == 0 ? q3 : gs == 1 ? q7 : gs == 2 ? q11 : q15;
        e0 = e0 * rstd + rb_[gs * 4 + 0]; e1 = e1 * rstd + rb_[gs * 4 + 1]; e2 = e2 * rstd + rb_[gs * 4 + 2]; e3 = e3 * rstd + rb_[gs * 4 + 3];
        int t1 = 0; float v1 = e0;
        if (e1 > v1) { v1 = e1; t1 = 1; } if (e2 > v1) { v1 = e2; t1 = 2; } if (e3 > v1) { v1 = e3; t1 = 3; }
        int t2 = -1; float v2 = -3.0e38f;
        if (t1 != 0 && e0 > v2) { v2 = e0; t2 = 0; } if (t1 != 1 && e1 > v2) { v2 = e1; t2 = 1; } if (t1 != 2 && e2 > v2) { v2 = e2; t2 = 2; } if (t1 != 3 && e3 > v2) { v2 = e3; t2 = 3; }
        const float p2 = __expf(v2 - v1), w1 = gwt / (1.f + p2), w2 = gwt * p2 / (1.f + p2);
        const int lo = t1 < t2 ? t1 : t2, hi = t1 < t2 ? t2 : t1; const float wlo = t1 < t2 ? w1 : w2, whi = t1 < t2 ? w2 : w1;
        const int pi = lo == 0 ? hi - 1 : (lo == 1 ? hi + 1 : 5), bk = gs * 6 + pi;
        if (act) { tokb[m] = bk; tokr[m] = rstd; tokw[2 * m] = wlo; tokw[2 * m + 1] = whi; __hip_atomic_fetch_add(hist + bk, 1, __ATOMIC_RELAXED, __HIP_MEMORY_SCOPE_WORKGROUP); }
}
__device__ __forceinline__ void ph_route(const Ctx& F0, int l) {
    const Ctx F = launder(F0);
    constexpr int WLD = 1032;
    LAS bf16* Wh = (LAS bf16*)F.lds;
    LAS bf16* Wlo = Wh + 20 * WLD;
    LAS float* LG = (LAS float*)(F.lds + 4 * 20 * WLD);
    LAS int* hist = (LAS int*)(F.lds + 4 * 20 * WLD + 8 * 320 * 4);
    const float* g2 = F.in[18] + l * D;
    const f32x4* gw4 = (const f32x4*)(F.in[19] + (size_t)l * D * 4); const f32x4* rw4 = (const f32x4*)(F.in[21] + (size_t)l * 4 * D * 4);
    const float* gb_ = F.in[20] + l * 4; const float* rb_ = F.in[22] + l * 16;
    for (int idx = F.tid; idx < D * 5; idx += NTHREADS) { const int k = idx % D, q = idx / D;
        f32x4 v = (q == 0) ? gw4[k] : rw4[(q - 1) * D + k]; v = v * g2[k];
#pragma unroll
        for (int i = 0; i < 4; ++i) { const unsigned h = f2bf(v[i]); Wh[(q * 4 + i) * WLD + k] = (bf16)h; Wlo[(q * 4 + i) * WLD + k] = (bf16)f2bf(v[i] - bf2f(h)); } }
    if (F.tid < 32) hist[F.tid] = 0;
    __syncthreads();
    int* tokb = (int*)(F.ws + WS_TOKB); float* tokr = (float*)(F.ws + WS_TOKR); float* tokw = (float*)(F.ws + WS_TOKW);
    const int i16 = F.lane & 15, kq = F.lane >> 4, m0 = F.vcu * 128 + F.wave * 16;
    const u32x4* xr = (const u32x4*)(P_XB(F) + (size_t)(m0 + i16) * D) + kq;
    const int c1 = 16 + (i16 & 3);
    const LAS bf16* bh0 = Wh + i16 * WLD + 8 * kq; const LAS bf16* bl0 = Wlo + i16 * WLD + 8 * kq;
    const LAS bf16* bh1 = Wh + c1 * WLD + 8 * kq;  const LAS bf16* bl1 = Wlo + c1 * WLD + 8 * kq;
    f32x4 acc0 = (f32x4){0.f, 0.f, 0.f, 0.f}, acc1 = acc0; float ss = 0.f;
#pragma unroll 4
    for (int c = 0; c < 32; ++c) {
        const u32x4 xa = xr[4 * c];
        const float x0 = bf2f(xa.x & 0xffffu), x1 = __builtin_bit_cast(float, xa.x & 0xffff0000u), x2 = bf2f(xa.y & 0xffffu), x3 = __builtin_bit_cast(float, xa.y & 0xffff0000u);
        const float x4 = bf2f(xa.z & 0xffffu), x5 = __builtin_bit_cast(float, xa.z & 0xffff0000u), x6 = bf2f(xa.w & 0xffffu), x7 = __builtin_bit_cast(float, xa.w & 0xffff0000u);
        ss += ((x0 * x0 + x1 * x1) + (x2 * x2 + x3 * x3)) + ((x4 * x4 + x5 * x5) + (x6 * x6 + x7 * x7));
        const pg8::bf16x8 av = __builtin_bit_cast(pg8::bf16x8, xa);
        const pg8::bf16x8 h0 = *(const LAS pg8::bf16x8*)(bh0 + 32 * c), l0 = *(const LAS pg8::bf16x8*)(bl0 + 32 * c);
        const pg8::bf16x8 h1 = *(const LAS pg8::bf16x8*)(bh1 + 32 * c), l1 = *(const LAS pg8::bf16x8*)(bl1 + 32 * c);
        acc0 = __builtin_amdgcn_mfma_f32_16x16x32_bf16(av, h0, acc0, 0, 0, 0); acc1 = __builtin_amdgcn_mfma_f32_16x16x32_bf16(av, h1, acc1, 0, 0, 0);
        acc0 = __builtin_amdgcn_mfma_f32_16x16x32_bf16(av, l0, acc0, 0, 0, 0); acc1 = __builtin_amdgcn_mfma_f32_16x16x32_bf16(av, l1, acc1, 0, 0, 0);
    }
    ss += xshfl<16>(ss);
    { const unsigned u = __builtin_bit_cast(unsigned, ss); auto r = __builtin_amdgcn_permlane32_swap(u, u, false, false);
      ss = __builtin_bit_cast(float, (unsigned)r[0]) + __builtin_bit_cast(float, (unsigned)r[1]); }
    LAS float* lg = LG + F.wave * 320;
#pragma unroll
    for (int r = 0; r < 4; ++r) { lg[(4 * kq + r) * 20 + i16] = acc0[r]; if (i16 < 4) lg[(4 * kq + r) * 20 + 16 + i16] = acc1[r]; }
    asm volatile("s_waitcnt lgkmcnt(0)" ::: "memory");
    float a[20];
#pragma unroll
    for (int j = 0; j < 5; ++j) { const f32x4 t4 = *(const LAS f32x4*)(lg + i16 * 20 + 4 * j); a[4 * j] = t4[0]; a[4 * j + 1] = t4[1]; a[4 * j + 2] = t4[2]; a[4 * j + 3] = t4[3]; }
    route_finish(a, ss, m0 + i16, kq == 0, gb_, rb_, tokb, tokr, tokw, hist);
    __syncthreads();
    if (F.tid < 24) __hip_atomic_store((int*)(F.ws + WS_WGCNT) + F.vcu * 24 + F.tid, hist[F.tid], __ATOMIC_RELAXED, __HIP_MEMORY_SCOPE_AGENT);
}
__device__ __forceinline__ void ph_place(const Ctx& F0) {
    const Ctx F = launder(F0);
    LAS int* ptot = (LAS int*)F.lds;
    LAS int* pbef = ptot + 512;
    LAS int* bstart = pbef + 512;
    LAS int* btot = bstart + 32;
    LAS int* carry = btot + 32;
    LAS int* rowidx = carry + 32;
    const int* wgcnt = (const int*)(F.ws + WS_WGCNT);
    int* rowtok = (int*)(F.ws + WS_ROWTOK); float* roww = (float*)(F.ws + WS_ROWW); int* tileb = (int*)(F.ws + WS_TILEB);
    const int* tokb = (const int*)(F.ws + WS_TOKB); const float* tokr = (const float*)(F.ws + WS_TOKR); const float* tokw = (const float*)(F.ws + WS_TOKW);
    { const int p = F.tid >> 5, b = F.tid & 31; int tot = 0, bef = 0;
      if (b < 24) for (int v = p * 16; v < p * 16 + 16; ++v) { const int c = wgcnt[v * 24 + b]; tot += c; if (v < F.vcu) bef += c; }
      ptot[p * 32 + b] = tot; pbef[p * 32 + b] = bef; }
    __syncthreads();
    if (F.tid < 32) { int tot = 0, bef = 0; for (int p = 0; p < 16; ++p) { tot += ptot[p * 32 + F.tid]; bef += pbef[p * 32 + F.tid]; } btot[F.tid] = tot; carry[F.tid] = bef; }
    __syncthreads();
    if (F.tid == 0) { int s = 0; for (int b = 0; b < 24; ++b) { bstart[b] = s; s += (btot[b] + 255) & ~255; } bstart[24] = s; }
    __syncthreads();
    if (F.tid < 24) carry[F.tid] += bstart[F.tid];
    if (F.vcu == 0) {
        if (F.tid == 0) tileb[0] = bstart[24] >> 8;
        for (int b = 0; b < 24; ++b) { const int s = bstart[b], e = bstart[b + 1];
            for (int t = (s >> 8) + F.tid; t < (e >> 8); t += NTHREADS) tileb[1 + t] = b;
            for (int r = s + btot[b] + F.tid; r < e; r += NTHREADS) __hip_atomic_store(rowtok + r, -1, __ATOMIC_RELAXED, __HIP_MEMORY_SCOPE_AGENT); }
    }
    __syncthreads();
    if (F.wave == 0) {
        for (int pass = 0; pass < 2; ++pass) { const int i = pass * 64 + F.lane, bi = tokb[F.vcu * 128 + i]; int row = 0;
#pragma unroll 1
            for (int b = 0; b < 24; ++b) { const unsigned long long mask = __ballot(bi == b); const int c = carry[b];
                if (bi == b) row = c + __builtin_popcountll(mask & ((1ull << F.lane) - 1ull));
                asm volatile("s_waitcnt lgkmcnt(0)" ::: "memory");
                if (F.lane == 0) carry[b] = c + __builtin_popcountll(mask);
                asm volatile("s_waitcnt lgkmcnt(0)" ::: "memory"); }
            rowidx[i] = row; }
    }
    __syncthreads();
    bf16* XS = (bf16*)(F.ws + WS_XS);
    for (int i = 0; i < 16; ++i) {
        const int li = F.wave * 16 + i, m = F.vcu * 128 + li, row = rowidx[li]; const float rstd = tokr[m];
        if (F.lane == 0) {
            __hip_atomic_store(rowtok + row, m, __ATOMIC_RELAXED, __HIP_MEMORY_SCOPE_AGENT);
            const unsigned long long w2 = (unsigned long long)__builtin_bit_cast(unsigned, tokw[2 * m]) | ((unsigned long long)__builtin_bit_cast(unsigned, tokw[2 * m + 1]) << 32);
            __hip_atomic_store((unsigned long long*)(roww + 2 * row), w2, __ATOMIC_RELAXED, __HIP_MEMORY_SCOPE_AGENT); }
        if (F.lane == 0) __hip_atomic_store((float*)(F.ws + WS_ROWR) + row, rstd, __ATOMIC_RELAXED, __HIP_MEMORY_SCOPE_AGENT);
        const u32x4* xr = (const u32x4*)(P_XB(F) + (size_t)m * D) + F.lane; u32x4* o16 = (u32x4*)(XS + (size_t)row * D) + F.lane;
        o16[0] = xr[0]; o16[64] = xr[64];
    }
}
struct MoeOrder {
    const int* tileb; int G, c; bool down;
    __device__ __forceinline__ bool next(int i, pg8::Unit& u) const {
        const GAS int* tb_ = (const GAS int*)tileb;
        const int NT = __builtin_amdgcn_readfirstlane(tb_[0]), L = i * G + c; if (L >= NT * 4) return false;
        const int rt = L >> 2, pn = L & 3, b = __builtin_amdgcn_readfirstlane(tb_[1 + rt]);
        if (down) { u.pm = rt; u.pn = b * 4 + pn; u.aux = pn; }
        else { int ea, eb; pair_decode(b % 6, ea, eb); const int e = (b / 6) * 4 + (pn < 2 ? ea : eb); u.pm = rt; u.pn = e * 2 + (pn & 1); u.aux = pn; }
        return true;
    }
};
struct EpiGU {
    static constexpr bool PERM = true;
    bf16* H; const float* roww; const float* rowr;
    __device__ __forceinline__ void operator()(const f32x4 (&acc)[2][2][4][2], const pg8::Unit& u, int wr, int wc, int fr_, int fq_) const {
        const int ln_ = lane_id(), fr = ln_ & 15, fq = ln_ >> 4; (void)fr_; (void)fq_;
        const int row0 = u.pm * 256 + wr * 64 + fr, cl = u.aux * 128 + 16 * wc + 4 * fq, ws = u.aux >> 1;
#pragma unroll
        for (int ai = 0; ai < 2; ++ai)
#pragma unroll
            for (int m = 0; m < 4; ++m) { const int r = row0 + ai * 128 + m * 16; const float rr = rowr[r], w = roww[2 * r + ws] * rr;
#pragma unroll
                for (int bj = 0; bj < 2; ++bj) { const f32x4 g = acc[ai][bj][m][0], up = acc[ai][bj][m][1]; f32x4 a;
#pragma unroll
                    for (int i = 0; i < 4; ++i) { const float gg = g[i] * rr; a[i] = gg * sigmoidf_(gg) * up[i] * w; }
                    u32x2 o; o.x = pg8::cvt_pk_bf16(a[0], a[1]); o.y = pg8::cvt_pk_bf16(a[2], a[3]);
                    *(u32x2*)(H + (size_t)r * 512 + cl + bj * 64) = o; } }
    }
};
struct EpiDown {
    static constexpr bool PERM = true;
    bf16* RB; const int* rowtok;
    __device__ __forceinline__ void operator()(const f32x4 (&acc)[2][2][4][2], const pg8::Unit& u, int wr, int wc, int fr_, int fq_) const {
        const int ln_ = lane_id(), fr = ln_ & 15, fq = ln_ >> 4; (void)fr_; (void)fq_;
        const int row0 = u.pm * 256 + wr * 64 + fr, col0 = u.aux * 256 + wc * 32 + 8 * fq;
#pragma unroll
        for (int ai = 0; ai < 2; ++ai)
#pragma unroll
            for (int m = 0; m < 4; ++m) { const int tok = rowtok[row0 + ai * 128 + m * 16];
                if (tok >= 0) { bf16* rp = RB + (size_t)tok * D + col0;
#pragma unroll
                    for (int bj = 0; bj < 2; ++bj) { const u32x4 x = *(const u32x4*)(rp + bj * 128); const f32x4 a0 = acc[ai][bj][m][0], a1 = acc[ai][bj][m][1]; u32x4 w;
                        w.x = pg8::cvt_pk_bf16(bf2f(x.x & 0xffffu) + a0[0], bf2f(x.x >> 16) + a0[1]); w.y = pg8::cvt_pk_bf16(bf2f(x.y & 0xffffu) + a0[2], bf2f(x.y >> 16) + a0[3]);
                        w.z = pg8::cvt_pk_bf16(bf2f(x.z & 0xffffu) + a1[0], bf2f(x.z >> 16) + a1[1]); w.w = pg8::cvt_pk_bf16(bf2f(x.w & 0xffffu) + a1[2], bf2f(x.w >> 16) + a1[3]);
                        *(u32x4*)(rp + bj * 128) = w; } }
                if (m & 1) asm volatile("" ::: "memory"); }
    }
};

struct SsmOrder { int G, c, mode;
    __device__ __forceinline__ bool next(int i, pg8::Unit& u) const { const int L = i * G + c;
        if (mode == 1) { if (L >= 32) return false; u.pm = L; u.pn = L >> 1; u.aux = 0; return true; }
        if (L >= 128) return false; const int g = L >> 3; u.pm = g * 2 + ((L >> 2) & 1); u.pn = g * 4 + (L & 3); u.aux = L & 3; return true; } };
struct HalfOrder { int L;
    __device__ __forceinline__ bool next(int i, pg8::Unit& u) const { if (i > 0 || L < 0 || L >= 128) return false; u.pm = L; u.pn = 0; u.aux = 0; return true; } };
struct EpiZ { static constexpr bool PERM = false; float* ZB;
    __device__ __forceinline__ void operator()(const f32x4 (&acc)[2][2][4][2], const pg8::Unit& u, int wr, int wc, int fr_, int fq_) const {
        const int ln_ = lane_id(), fr = ln_ & 15, fq = ln_ >> 4; (void)fr_; (void)fq_;
        const int row0 = u.pm * 256 + wr * 64 + fr, col0 = wc * 32 + 4 * fq;
#pragma unroll
        for (int ai = 0; ai < 2; ++ai)
#pragma unroll
            for (int m = 0; m < 4; ++m)
#pragma unroll
                for (int n = 0; n < 2; ++n) *(f32x4*)(ZB + (size_t)(row0 + ai * 128 + m * 16) * 128 + col0 + n * 16) = acc[ai][0][m][n];
    } };
struct EpiSsm2 { static constexpr bool PERM = true; const bf16* UG; bf16* YS; const float* dvec;
    __device__ __forceinline__ void operator()(const f32x4 (&acc)[2][2][4][2], const pg8::Unit& u, int wr, int wc, int fr_, int fq_) const {
        const int ln_ = lane_id(), fr = ln_ & 15, fq = ln_ >> 4; (void)fr_; (void)fq_;
        const int g = u.pm >> 1, cr0 = (u.pm & 1) * 256 + wr * 64 + fr;
#pragma unroll
        for (int bj = 0; bj < 2; ++bj) { const int n0 = u.aux * 256 + bj * 128 + wc * 32 + 8 * fq, to = n0 >> 4, ho0 = n0 & 15;
            const f32x4 d0 = *(const f32x4*)(dvec + g * 16 + ho0), d1 = *(const f32x4*)(dvec + g * 16 + ho0 + 4);
#pragma unroll
            for (int ai = 0; ai < 2; ++ai)
#pragma unroll
                for (int m = 0; m < 4; ++m) { const int cr = cr0 + ai * 128 + m * 16;
                    const u32x4 uu = *(const u32x4*)(UG + ((size_t)(g * 512 + cr)) * UGP + n0);
                    const f32x4 a0 = acc[ai][bj][m][0], a1 = acc[ai][bj][m][1]; float y[8];
                    y[0] = gelu_tanh(a0[0] + d0[0] * bf2f(uu.x & 0xffffu)); y[1] = gelu_tanh(a0[1] + d0[1] * bf2f(uu.x >> 16));
                    y[2] = gelu_tanh(a0[2] + d0[2] * bf2f(uu.y & 0xffffu)); y[3] = gelu_tanh(a0[3] + d0[3] * bf2f(uu.y >> 16));
                    y[4] = gelu_tanh(a1[0] + d1[0] * bf2f(uu.z & 0xffffu)); y[5] = gelu_tanh(a1[1] + d1[1] * bf2f(uu.z >> 16));
                    y[6] = gelu_tanh(a1[2] + d1[2] * bf2f(uu.w & 0xffffu)); y[7] = gelu_tanh(a1[3] + d1[3] * bf2f(uu.w >> 16));
                    u32x4 w; w.x = pg8::cvt_pk_bf16(y[0], y[1]); w.y = pg8::cvt_pk_bf16(y[2], y[3]); w.z = pg8::cvt_pk_bf16(y[4], y[5]); w.w = pg8::cvt_pk_bf16(y[6], y[7]);
                    *(u32x4*)(YS + ((size_t)cr * 64 + to) * 256 + g * 16 + ho0) = w; } }
    } };
struct EpiGluE { static constexpr bool PERM = true; const bf16* YS; bf16* YMIX; const float* gb;
    __device__ __forceinline__ void operator()(const f32x4 (&acc)[2][2][4][2], const pg8::Unit& u, int wr, int wc, int fr_, int fq_) const {
        const int ln_ = lane_id(), fr = ln_ & 15, fq = ln_ >> 4; (void)fr_; (void)fq_;
        const int row0 = u.pm * 256 + wr * 64 + fr;
#pragma unroll
        for (int bj = 0; bj < 2; ++bj) { const int n0 = bj * 128 + wc * 32 + 8 * fq; const f32x4 b0 = *(const f32x4*)(gb + n0), b1 = *(const f32x4*)(gb + n0 + 4);
#pragma unroll
            for (int ai = 0; ai < 2; ++ai)
#pragma unroll
                for (int m = 0; m < 4; ++m) { const size_t r = (size_t)(row0 + ai * 128 + m * 16); const u32x4 yy = *(const u32x4*)(YS + r * 256 + n0);
                    const f32x4 a0 = acc[ai][bj][m][0] + b0, a1 = acc[ai][bj][m][1] + b1; float o[8];
                    o[0] = bf2f(yy.x & 0xffffu) * sigmoidf_(a0[0]); o[1] = bf2f(yy.x >> 16) * sigmoidf_(a0[1]); o[2] = bf2f(yy.y & 0xffffu) * sigmoidf_(a0[2]); o[3] = bf2f(yy.y >> 16) * sigmoidf_(a0[3]);
                    o[4] = bf2f(yy.z & 0xffffu) * sigmoidf_(a1[0]); o[5] = bf2f(yy.z >> 16) * sigmoidf_(a1[1]); o[6] = bf2f(yy.w & 0xffffu) * sigmoidf_(a1[2]); o[7] = bf2f(yy.w >> 16) * sigmoidf_(a1[3]);
                    u32x4 w; w.x = pg8::cvt_pk_bf16(o[0], o[1]); w.y = pg8::cvt_pk_bf16(o[2], o[3]); w.z = pg8::cvt_pk_bf16(o[4], o[5]); w.w = pg8::cvt_pk_bf16(o[6], o[7]);
                    *(u32x4*)(YMIX + r * 1024 + n0) = w; } }
    } };
struct EpiPoolE { static constexpr bool PERM = true; bf16* YMIX; const float* pb; const float* ps;
    __device__ __forceinline__ void operator()(const f32x4 (&acc)[2][2][4][2], const pg8::Unit& u, int wr, int wc, int fr_, int fq_) const {
        const int ln_ = lane_id(), fr = ln_ & 15, fq = ln_ >> 4; (void)fr_; (void)fq_;
        const int row0 = u.pm * 256 + wr * 64 + fr;
#pragma unroll
        for (int bj = 0; bj < 2; ++bj) { const int n0 = bj * 128 + wc * 32 + 8 * fq; const f32x4 b0 = *(const f32x4*)(pb + n0), b1 = *(const f32x4*)(pb + n0 + 4), s0 = *(const f32x4*)(ps + n0), s1 = *(const f32x4*)(ps + n0 + 4);
#pragma unroll
            for (int ai = 0; ai < 2; ++ai)
#pragma unroll
                for (int m = 0; m < 4; ++m) { const size_t r = (size_t)(row0 + ai * 128 + m * 16);
                    const f32x4 a0 = (acc[ai][bj][m][0] + b0) * s0, a1 = (acc[ai][bj][m][1] + b1) * s1;
                    u32x4 w; w.x = pg8::cvt_pk_bf16(a0[0], a0[1]); w.y = pg8::cvt_pk_bf16(a0[2], a0[3]); w.z = pg8::cvt_pk_bf16(a1[0], a1[1]); w.w = pg8::cvt_pk_bf16(a1[2], a1[3]);
                    *(u32x4*)(YMIX + r * 1024 + 256 + n0) = w; } }
    } };
__device__ __forceinline__ void ph_ssm_scan(const Ctx& F0, int l) {
    const Ctx F = launder(F0);
    for (int it = F.vcu + F.G * F.wave; it < SGN * NB; it += F.G * NWAVES) {
        const int g = it >> 3, b = it & 7, p = F.lane;
        const float are = F.in[4][(l * SGN + g) * SP + p], aim = F.in[5][(l * SGN + g) * SP + p], dt = expf(F.in[6][l * SGN + g]);
        float sn, cs; sincosf(aim * dt * 64.f, &sn, &cs); const float mg = expf(are * dt * 64.f), lr = mg * cs, li = mg * sn;
        const float* Z = (const float*)(F.ws + WS_ZB) + ((size_t)g * 512 + b * 64) * 128;
        bf16* U = P_UG(F) + ((size_t)g * 512 + b * 64) * UGP + 1024;
        float sr = 0.f, si = 0.f;
#pragma unroll 1
        for (int c0 = 0; c0 < 64; c0 += 16) {
            float zr[16], zi[16];
#pragma unroll
            for (int j = 0; j < 16; ++j) { zr[j] = Z[(c0 + j) * 128 + p]; zi[j] = Z[(c0 + j) * 128 + 64 + p]; }
#pragma unroll
            for (int j = 0; j < 16; ++j) {
                U[(size_t)(c0 + j) * UGP + p] = (bf16)f2bf(sr); U[(size_t)(c0 + j) * UGP + 64 + p] = (bf16)f2bf(si);
                const float nr = lr * sr - li * si + zr[j], ni = lr * si + li * sr + zi[j]; sr = nr; si = ni; }
        }
    }
}

namespace moba {
using bf16x8 = __attribute__((ext_vector_type(8))) short;
using s16x4 = __attribute__((ext_vector_type(4))) short;
using f32x16 = __attribute__((ext_vector_type(16))) float;
typedef short v4i16_t __attribute__((ext_vector_type(4)));
typedef float f32x2_t __attribute__((ext_vector_type(2))); typedef __bf16 bf16x2_t __attribute__((ext_vector_type(2)));
constexpr int L_K = 0, L_V = 49152, L_TB = 98304, L_KM = L_TB + 4 * 768 * 4, L_END = L_KM + 16 * 64 * 4;
__device__ __forceinline__ unsigned cvtpk(float lo, float hi) { f32x2_t v = {lo, hi}; bf16x2_t b = __builtin_convertvector(v, bf16x2_t); return __builtin_bit_cast(unsigned, b); }
__device__ __forceinline__ s16x4 vtr(const LAS char* p) { return __builtin_bit_cast(s16x4, __builtin_amdgcn_ds_read_tr16_b64_v4i16((LAS v4i16_t*)p)); }
__device__ __forceinline__ float hmax(float v) { const unsigned u = __builtin_bit_cast(unsigned, v); auto r = __builtin_amdgcn_permlane32_swap(u, u, false, false); return fmaxf(__builtin_bit_cast(float, (unsigned)r[0]), __builtin_bit_cast(float, (unsigned)r[1])); }
__device__ __forceinline__ float hsum(float v) { const unsigned u = __builtin_bit_cast(unsigned, v); auto r = __builtin_amdgcn_permlane32_swap(u, u, false, false); return __builtin_bit_cast(float, (unsigned)r[0]) + __builtin_bit_cast(float, (unsigned)r[1]); }

__device__ __forceinline__ void unit(int wave_, int b, int h, int qb, const bf16* Q, const bf16* K, const bf16* V, bf16* O, const float* KMP, const float* BT, LAS char* lds) {
    int lane_ = lane_id(); asm volatile("" : "+v"(lane_)); asm volatile("" : "+s"(b), "+s"(h), "+s"(qb), "+s"(wave_));
    const int wid = wave_, lane = lane_, tid = wid * 64 + lane, r32 = lane & 31, hi = lane >> 5;
    const int NT = 4 * qb + 4, q0 = qb * 256; const size_t rowbase = (size_t)b * SEQ;
    LAS float* tb = (LAS float*)(lds + L_TB); LAS float* km = (LAS float*)(lds + L_KM);
    const float bfar = BT[h * 132 + 128];
    const bf16* ksrc = K + (rowbase + lane) * 512 + h * 64 + wid * 8;
    const bf16* vsrc = V + (rowbase + 16 * (wid & 3) + (lane >> 2)) * 512 + h * 64 + (wid >> 2) * 32 + (lane & 3) * 8;
    u32x4 kreg0 = *(const u32x4*)ksrc, vreg0 = *(const u32x4*)vsrc, kreg1 = *(const u32x4*)(ksrc + (size_t)64 * 512), vreg1 = *(const u32x4*)(vsrc + (size_t)64 * 512);
    u32x4 kreg2 = *(const u32x4*)(ksrc + (size_t)128 * 512), vreg2 = *(const u32x4*)(vsrc + (size_t)128 * 512), kreg3 = *(const u32x4*)(ksrc + (size_t)192 * 512), vreg3 = *(const u32x4*)(vsrc + (size_t)192 * 512);
    bf16x8 qr[4];
    { const bf16* qw = Q + (rowbase + q0 + wid * 32 + r32) * 512 + h * 64 + hi * 8;
#pragma unroll
      for (int d0 = 0; d0 < 4; ++d0) qr[d0] = *(const bf16x8*)(qw + d0 * 16); }
    __syncthreads();
    unsigned selmask = 1u << qb;
    { float g[16];
#pragma unroll
      for (int j = 0; j < 16; ++j) g[j] = 0.f;
#pragma unroll
      for (int d0 = 0; d0 < 4; ++d0)
#pragma unroll
          for (int e = 0; e < 8; ++e) { const float qf = bf2f((unsigned)(unsigned short)qr[d0][e]);
#pragma unroll
              for (int j = 0; j < 16; ++j) g[j] += qf * km[j * 64 + d0 * 16 + hi * 8 + e]; }
#pragma unroll
      for (int j = 0; j < 16; ++j) g[j] = hsum(g[j]);
#pragma unroll
      for (int s = 0; s < 3; ++s) { float bv = -3.0e38f; int bi = -1;
#pragma unroll
          for (int j = 0; j < 16; ++j) { const bool ok = (j < qb) && !((selmask >> j) & 1u) && (g[j] > bv); bv = ok ? g[j] : bv; bi = ok ? j : bi; }
          if (bi >= 0) selmask |= 1u << bi; } }
    { LAS char* kd = lds + L_K + wid * 1024 + lane * 16; LAS char* vd = lds + L_V + wid * 1024 + lane * 16;
      *(LAS u32x4*)kd = kreg0; *(LAS u32x4*)vd = vreg0; *(LAS u32x4*)(kd + 8192) = kreg1; *(LAS u32x4*)(vd + 8192) = vreg1;
      *(LAS u32x4*)(kd + 16384) = kreg2; *(LAS u32x4*)(vd + 16384) = vreg2; *(LAS u32x4*)(kd + 24576) = kreg3; *(LAS u32x4*)(vd + 24576) = vreg3; }
    __syncthreads();
    const int qrel = wid * 32 + r32;
    const LAS char* kp0 = lds + L_K + hi * 1024 + r32 * 16;
    const LAS char* vp0 = lds + L_V + ((lane >> 4) & 1) * 32 + (lane & 3) * 8 + (4 * hi + ((lane & 15) >> 2)) * 64;
    float mref = 0.f, l = 0.f; f32x16 o0 = f32x16{}, o1 = f32x16{};
#define MOBA_CVEC(TT) f32x16 cvec; do { const float ci_ = ((selmask >> ((TT) >> 2)) & 1u) ? (bfar - mref) : -1.0e30f; _Pragma("unroll") for (int r = 0; r < 16; ++r) cvec[r] = ci_; } while (0)
#define MOBA_QK(P0, P1, KB) do { { const bf16x8 a0 = *(const LAS bf16x8*)(kp0 + (KB)), a1 = *(const LAS bf16x8*)(kp0 + (KB) + 512); \
          P0 = __builtin_amdgcn_mfma_f32_32x32x16_bf16(a0, qr[0], cvec, 0, 0, 0); P1 = __builtin_amdgcn_mfma_f32_32x32x16_bf16(a1, qr[0], cvec, 0, 0, 0); } \
        _Pragma("unroll") for (int d0 = 1; d0 < 4; ++d0) { const bf16x8 a0 = *(const LAS bf16x8*)(kp0 + (KB) + d0 * 2048), a1 = *(const LAS bf16x8*)(kp0 + (KB) + d0 * 2048 + 512); \
            P0 = __builtin_amdgcn_mfma_f32_32x32x16_bf16(a0, qr[d0], P0, 0, 0, 0); P1 = __builtin_amdgcn_mfma_f32_32x32x16_bf16(a1, qr[d0], P1, 0, 0, 0); } } while (0)
#define MOBA_NEARMAX(P0, P1, TT, OUT) do { const int jn_ = (TT) - (NT - 8); if (jn_ >= 0) { const int A_ = qrel - 64 * (jn_ - 4) - 4 * hi + 256, s_ = 767 - A_, c_ = s_ & 3; \
            const LAS f32x4* t4 = (const LAS f32x4*)(tb + c_ * 768 + (s_ - c_)); \
            _Pragma("unroll") for (int g = 0; g < 4; ++g) { const f32x4 x0 = t4[2 * g], x1 = t4[2 * g + 8]; \
                _Pragma("unroll") for (int j = 0; j < 4; ++j) { P0[4 * g + j] += x0[j]; P1[4 * g + j] += x1[j]; } } } \
        float ra = __builtin_fmaxf(__builtin_fmaxf(P0[0], P0[1]), P1[0]), rb = __builtin_fmaxf(__builtin_fmaxf(P0[2], P0[3]), P1[1]); \
        ra = __builtin_fmaxf(__builtin_fmaxf(ra, P1[2]), P1[3]); \
        _Pragma("unroll") for (int r = 4; r < 16; r += 4) { ra = __builtin_fmaxf(__builtin_fmaxf(ra, P0[r]), P0[r + 1]); rb = __builtin_fmaxf(__builtin_fmaxf(rb, P0[r + 2]), P0[r + 3]); \
            ra = __builtin_fmaxf(__builtin_fmaxf(ra, P1[r]), P1[r + 1]); rb = __builtin_fmaxf(__builtin_fmaxf(rb, P1[r + 2]), P1[r + 3]); } \
        OUT = hmax(__builtin_fmaxf(ra, rb)); } while (0)
#define MOBA_STEP(PC0, PC1, PN0, PN1, TT, KBN, VBC, HASN) do { \
        bf16x8 vf[8], kf[8]; \
        if (HASN) { _Pragma("unroll") for (int d0 = 0; d0 < 4; ++d0) { kf[2 * d0] = *(const LAS bf16x8*)(kp0 + (KBN) + d0 * 2048); kf[2 * d0 + 1] = *(const LAS bf16x8*)(kp0 + (KBN) + d0 * 2048 + 512); } } \
        __builtin_amdgcn_sched_barrier(0); \
        if (__any(rm > 8.f)) { const float dl = __builtin_fmaxf(rm, 0.f), alpha = __builtin_amdgcn_exp2f(-dl); mref += dl; l *= alpha; \
            _Pragma("unroll") for (int r = 0; r < 16; ++r) { PC0[r] -= dl; PC1[r] -= dl; o0[r] *= alpha; o1[r] *= alpha; } } \
        if (HASN) { MOBA_CVEC((TT) + 1);       \
                    PN0 = __builtin_amdgcn_mfma_f32_32x32x16_bf16(kf[0], qr[0], cvec, 0, 0, 0); PN1 = __builtin_amdgcn_mfma_f32_32x32x16_bf16(kf[1], qr[0], cvec, 0, 0, 0); \
                    _Pragma("unroll") for (int d0 = 1; d0 < 4; ++d0) { PN0 = __builtin_amdgcn_mfma_f32_32x32x16_bf16(kf[2 * d0], qr[d0], PN0, 0, 0, 0); PN1 = __builtin_amdgcn_mfma_f32_32x32x16_bf16(kf[2 * d0 + 1], qr[d0], PN1, 0, 0, 0); } } \
        { const LAS char* vp = vp0 + (VBC); \
        _Pragma("unroll") for (int k = 0; k < 4; ++k) { \
            const s16x4 lo0 = vtr(vp + k * 1024), hi0 = vtr(vp + k * 1024 + 512), lo1 = vtr(vp + 4096 + k * 1024), hi1 = vtr(vp + 4096 + k * 1024 + 512); \
            vf[2 * k] = (bf16x8){lo0[0], lo0[1], lo0[2], lo0[3], hi0[0], hi0[1], hi0[2], hi0[3]}; vf[2 * k + 1] = (bf16x8){lo1[0], lo1[1], lo1[2], lo1[3], hi1[0], hi1[1], hi1[2], hi1[3]}; } } \
        __builtin_amdgcn_sched_barrier(0); \
        float s0 = 0.f, s1 = 0.f; u32x4 pw[4]; \
        _Pragma("unroll") for (int r = 0; r < 16; ++r) { PC0[r] = __builtin_amdgcn_exp2f(PC0[r]); PC1[r] = __builtin_amdgcn_exp2f(PC1[r]); s0 += PC0[r]; s1 += PC1[r]; } \
        l += s0 + s1; \
        _Pragma("unroll") for (int q = 0; q < 4; ++q) { pw[0][q] = cvtpk(PC0[2 * q], PC0[2 * q + 1]); pw[1][q] = cvtpk(PC0[8 + 2 * q], PC0[9 + 2 * q]); pw[2][q] = cvtpk(PC1[2 * q], PC1[2 * q + 1]); pw[3][q] = cvtpk(PC1[8 + 2 * q], PC1[9 + 2 * q]); } \
        _Pragma("unroll") for (int k = 0; k < 4; ++k) { const bf16x8 pa = __builtin_bit_cast(bf16x8, pw[k]); \
            o0 = __builtin_amdgcn_mfma_f32_32x32x16_bf16(vf[2 * k], pa, o0, 0, 0, 0); o1 = __builtin_amdgcn_mfma_f32_32x32x16_bf16(vf[2 * k + 1], pa, o1, 0, 0, 0); } \
        if (HASN) MOBA_NEARMAX(PN0, PN1, (TT) + 1, rm); \
    } while (0)
    f32x16 pa0, pa1, pb0, pb1; float rm;
    { MOBA_CVEC(0); MOBA_QK(pa0, pa1, 0); } MOBA_NEARMAX(pa0, pa1, 0, rm);
    const int NP = NT >> 1;
    int bufc = 0, bufn = 16384, bufw = 32768;
#pragma unroll 1
    for (int ip = 0; ip < NP; ++ip) {
        const int t = 2 * ip;
        if (ip + 2 < NP) { kreg0 = *(const u32x4*)(ksrc + (size_t)(t + 4) * 64 * 512); vreg0 = *(const u32x4*)(vsrc + (size_t)(t + 4) * 64 * 512);
                           kreg1 = *(const u32x4*)(ksrc + (size_t)(t + 5) * 64 * 512); vreg1 = *(const u32x4*)(vsrc + (size_t)(t + 5) * 64 * 512); }
        MOBA_STEP(pa0, pa1, pb0, pb1, t, bufc + 8192, bufc, true);
        MOBA_STEP(pb0, pb1, pa0, pa1, t + 1, bufn, bufc + 8192, (t + 2 < NT));
        if (ip + 2 < NP) { LAS char* kd = lds + L_K + bufw + wid * 1024 + lane * 16; LAS char* vd = lds + L_V + bufw + wid * 1024 + lane * 16;
            *(LAS u32x4*)kd = kreg0; *(LAS u32x4*)vd = vreg0; *(LAS u32x4*)(kd + 8192) = kreg1; *(LAS u32x4*)(vd + 8192) = vreg1; }
        __syncthreads();
        { const int tmp = bufc; bufc = bufn; bufn = bufw; bufw = tmp; }
    }
#undef MOBA_CVEC
#undef MOBA_QK
#undef MOBA_NEARMAX
#undef MOBA_STEP
    const float inv = 1.f / hsum(l);
    bf16* orow = O + (rowbase + q0 + wid * 32 + r32) * 1024 + 512 + h * 64 + 8 * hi;
#pragma unroll
    for (int d0 = 0; d0 < 2; ++d0)
#pragma unroll
        for (int gp = 0; gp < 2; ++gp) { const f32x16& oo = d0 ? o1 : o0; const int ga = 8 * gp, gb = 8 * gp + 4;
            unsigned ax = cvtpk(oo[ga] * inv, oo[ga + 1] * inv), ay = cvtpk(oo[ga + 2] * inv, oo[ga + 3] * inv), bx = cvtpk(oo[gb] * inv, oo[gb + 1] * inv), by = cvtpk(oo[gb + 2] * inv, oo[gb + 3] * inv);
            { auto r = __builtin_amdgcn_permlane32_swap(ax, bx, false, false); ax = r[0]; bx = r[1]; }
            { auto r = __builtin_amdgcn_permlane32_swap(ay, by, false, false); ay = r[0]; by = r[1]; }
            *(u32x4*)(orow + 32 * d0 + 16 * gp) = (u32x4){ax, ay, bx, by}; }
}
__device__ __forceinline__ void phase(int wave, int vcu, const bf16* Q, const bf16* K, const bf16* V, bf16* O, const float* KMP, const float* BT, LAS char* lds) {
    if (vcu >= 256) return;
    const int s = vcu & 3, bh = vcu >> 2;
    {
        int lane_ = lane_id(); asm volatile("" : "+v"(lane_)); const int tid = wave * 64 + lane_, b = bh >> 3, h = bh & 7;
        LAS float* tb = (LAS float*)(lds + L_TB); LAS float* km = (LAS float*)(lds + L_KM); const float bfar = BT[h * 132 + 128];
        for (int i = tid; i < 4 * 768; i += NTHREADS) { const int c = i / 768, j = i % 768, src_ = 767 - (j + c), rel = src_ - 256; tb[i] = (src_ < 0 || rel < 0) ? -1.0e30f : (rel < 128 ? BT[h * 132 + rel] - bfar : 0.f); }
        for (int i = tid; i < 16 * 64; i += NTHREADS) { const int j = i >> 6, d = i & 63, pm = b * 16 + j; km[i] = KMP[pm * 512 + h * 64 + d] + KMP[128 * 512 + pm * 512 + h * 64 + d]; }
    }
#pragma unroll 1
    for (int i = 0; i < 4; ++i) { const int qb = (i == 0) ? s : (i == 1) ? 7 - s : (i == 2) ? 8 + s : 15 - s; unit(wave, bh >> 3, bh & 7, qb, Q, K, V, O, KMP, BT, lds); }
}
}

__device__ __forceinline__ void ph_cvt_x(const Ctx& F0) {
    const Ctx F = launder(F0);
    const int gw = F.vcu * NWAVES + F.wave, NGW = F.G * NWAVES; float* rs1 = (float*)(F.ws + WS_RS1);
    for (int m = gw; m < T; m += NGW) {
        const f32x4* xr = (const f32x4*)(F.in[0] + (size_t)m * D) + F.lane;
        f32x4 v[4]; float s = 0.f;
#pragma unroll
        for (int j = 0; j < 4; ++j) { v[j] = xr[64 * j]; s += (v[j].x * v[j].x + v[j].y * v[j].y) + (v[j].z * v[j].z + v[j].w * v[j].w); }
        const float rstd = 1.f / sqrtf(wave_sum(s) * (1.f / D) + RMS_EPS);
        if (F.lane == 0) rs1[m] = rstd;
        unsigned long long* o8 = (unsigned long long*)(P_XB(F) + (size_t)m * D) + F.lane;
#pragma unroll
        for (int j = 0; j < 4; ++j) o8[64 * j] = (unsigned long long)pk2(v[j].x, v[j].y) | ((unsigned long long)pk2(v[j].z, v[j].w) << 32);
    }
}
__device__ __forceinline__ float row_ssq_bf16(const bf16* row, int lane) {
    const u32x4* xr = (const u32x4*)row + lane; float s = 0.f;
#pragma unroll
    for (int j = 0; j < 2; ++j) { const u32x4 x = xr[64 * j];
        const float a0 = bf2f(x.x & 0xffffu), a1 = bf2f(x.x >> 16), a2 = bf2f(x.y & 0xffffu), a3 = bf2f(x.y >> 16), a4 = bf2f(x.z & 0xffffu), a5 = bf2f(x.z >> 16), a6 = bf2f(x.w & 0xffffu), a7 = bf2f(x.w >> 16);
        s += ((a0 * a0 + a1 * a1) + (a2 * a2 + a3 * a3)) + ((a4 * a4 + a5 * a5) + (a6 * a6 + a7 * a7)); }
    return wave_sum(s);
}
__device__ __forceinline__ void ph_rstd(const Ctx& F0) {
    const Ctx F = launder(F0);
    const int gw = F.vcu * NWAVES + F.wave, NGW = F.G * NWAVES; float* rs1 = (float*)(F.ws + WS_RS1);
    for (int m = gw; m < T; m += NGW) { const float s = row_ssq_bf16(P_XB(F) + (size_t)m * D, F.lane); if (F.lane == 0) rs1[m] = 1.f / sqrtf(s * (1.f / D) + RMS_EPS); }
}

__device__ __forceinline__ void ph_bias_table(const Ctx& F0) {
    const Ctx F = launder(F0);
    if (F.vcu == 0) {
        const float* rel_bias = F.in[1];
        for (int i = F.tid; i < 8 * 132; i += NTHREADS) {
            const int h = i / 132, r = i % 132;
            int bk;
            if (r < 16) bk = r;
            else { bk = 16 + (int)(logf((float)r / 16.f) / logf(8.f) * 16.f); if (bk > 31) bk = 31; }
            P_BT(F)[i] = rel_bias[bk * 8 + h] * LOG2E;
        }
    }
}

__device__ __forceinline__ void ph_pool_dl(const Ctx& F0) {
    const Ctx F = launder(F0);
    const int gt = F.vcu * NTHREADS + F.tid, NGT = F.G * NTHREADS;
    for (int it = gt; it < (T / 32) * 128; it += NGT) {
        const int cp = it & 127, chunk = it >> 7, c = cp * 2, gi = c >> 6, win = 2 << gi, m0 = chunk * 32, t0 = m0 & (SEQ - 1);
        const unsigned* P2 = (const unsigned*)P_PB(F) + cp; unsigned* D2 = (unsigned*)P_DL(F) + cp;
        float s0 = 0.f, s1 = 0.f;
        const int back = (t0 < win) ? t0 : win;
        for (int j = 1; j <= back; ++j) { const unsigned v = P2[(size_t)(m0 - j) * 128]; s0 += bf2f(v & 0xffffu); s1 += bf2f(v >> 16); }
#pragma unroll 4
        for (int i = 0; i < 32; ++i) { const int m = m0 + i, t = t0 + i;
            const unsigned v = P2[(size_t)m * 128]; const float p0 = bf2f(v & 0xffffu), p1 = bf2f(v >> 16);
            s0 += p0; s1 += p1;
            if (t >= win) { const unsigned o = P2[(size_t)(m - win) * 128]; s0 -= bf2f(o & 0xffffu); s1 -= bf2f(o >> 16); }
            const float inv = 1.f / (float)((t + 1 < win) ? t + 1 : win);
            D2[(size_t)m * 128] = pk2(s0 * inv - p0, s1 * inv - p1); }
    }
}
__device__ __forceinline__ void ph_final(const Ctx& F0) {
    const Ctx F = launder(F0);
    const int gw = F.vcu * NWAVES + F.wave, NGW = F.G * NWAVES;
    const f32x4* gf = (const f32x4*)F.in[26];
    for (int m = gw; m < T; m += NGW) {
        const bf16* row = P_XB(F) + (size_t)m * D;
        const float rstd = 1.f / sqrtf(row_ssq_bf16(row, F.lane) * (1.f / D) + RMS_EPS);
        const u32x4* xr = (const u32x4*)row + F.lane; f32x4* orow = (f32x4*)(F.R + (size_t)m * D);
#pragma unroll
        for (int j = 0; j < 2; ++j) { const u32x4 x = xr[64 * j]; const int c4 = 2 * (64 * j + F.lane);
            orow[c4] = (f32x4){bf2f(x.x & 0xffffu), bf2f(x.x >> 16), bf2f(x.y & 0xffffu), bf2f(x.y >> 16)} * rstd * gf[c4];
            orow[c4 + 1] = (f32x4){bf2f(x.z & 0xffffu), bf2f(x.z >> 16), bf2f(x.w & 0xffffu), bf2f(x.w >> 16)} * rstd * gf[c4 + 1]; }
    }
}

constexpr int LDS_BYTES = 147456;
constexpr int MISC_OFF = 131072 + 320;

__global__ void __launch_bounds__(NTHREADS, 2) mk_fwd(Args args) {
    extern __shared__ __attribute__((aligned(16))) unsigned char lds[];
    Ctx F;
    F.lds = (LAS unsigned char*)lds;
    F.wave = __builtin_amdgcn_readfirstlane((int)threadIdx.x >> 6);
    F.lane = lane_id(); F.tid = F.wave * 64 + F.lane;
    F.G = gridDim.x; { const int bx = blockIdx.x; F.vcu = (F.G % 8 == 0) ? (bx % 8) * (F.G / 8) + bx / 8 : bx; }
    F.in = (KargP)__builtin_amdgcn_kernarg_segment_ptr(); F.R = args.out; F.ws = args.ws;
    unsigned char* ws = args.ws;
    volatile LAS unsigned* MISC = (volatile LAS unsigned*)(F.lds + MISC_OFF);
    if (F.tid < 64) MISC[F.tid] = 0u;
    __syncthreads();
    XcdBarrier bar = xcd_barrier_post((unsigned*)(ws + WS_CTL) + CW_BAR, MISC + 8, F.tid == 0);
#define GRID_BAR() do { bar.bar = (unsigned*)(wsl(ws) + WS_CTL) + CW_BAR; xcd_barrier(bar, F.wave); } while (0)
#define FL launder(F)

    ph_bias_table(F);
    ph_prologue(F);
#pragma unroll 1
    for (int l = 0; l < DEPTH; ++l) {
        if (l == 0) ph_cvt_x(F); else ph_rstd(F);
        GRID_BAR();
        { pg8::Gemm g{P_XB(FL), (const bf16*)(wsl(ws) + WS_WIN) + (size_t)l * NPROJ * D, D, D, D}; pg8::StaticOrder S; S.init(T, NPROJ, sl(F.G), sl((int)blockIdx.x));
          EpiProjE E{P_UG(FL), P_PB(FL), P_QB(FL), P_KB(FL), P_VB(FL), P_KMP(FL), (const float*)(wsl(ws) + WS_RS1)}; pg8::gemm_phase(F.lds, g, S, E, sl(F.wave)); }
        GRID_BAR();
        { pg8::Gemm g{P_UG(FL), (const bf16*)(wsl(ws) + WS_BZ) + (size_t)l * SGN * 256 * 1024, UGP, 1024, 1024}; SsmOrder S{sl(F.G), sl((int)blockIdx.x), 1};
          EpiZ E{(float*)(wsl(ws) + WS_ZB)}; pg8::gemm_phase(F.lds, g, S, E, sl(F.wave)); }
        ph_pool_dl(F);
        moba::phase(sl(F.wave), sl(F.vcu), P_QB(FL), P_KB(FL), P_VB(FL), P_YMIX(FL), P_KMP(FL), P_BT(FL), (LAS char*)F.lds);
        GRID_BAR();
        ph_ssm_scan(F, l);
        GRID_BAR();
        { pg8::Gemm g{P_UG(FL), (const bf16*)(wsl(ws) + WS_TG) + (size_t)l * SGN * 1024 * UGP, UGP, UGP, UGP}; SsmOrder S{sl(F.G), sl((int)blockIdx.x), 2};
          EpiSsm2 E{P_UG(FL), P_YS(FL), F.in[11] + l * 256}; pg8::gemm_phase(F.lds, g, S, E, sl(F.wave)); }
        GRID_BAR();
        { pg8::Gemm g{P_YS(FL), (const bf16*)(wsl(ws) + WS_GLUT) + (size_t)l * 65536, 256, 256, 256}; HalfOrder S{sl(F.vcu)};
          EpiGluE E{P_YS(FL), P_YMIX(FL), F.in[13] + l * 256}; pg8::gemm_phase(F.lds, g, S, E, sl(F.wave)); }
        { pg8::Gemm g{P_DL(FL), (const bf16*)(wsl(ws) + WS_POOLT) + (size_t)l * 65536, 256, 256, 256}; HalfOrder S{sl(F.vcu) - 128};
          EpiPoolE E{P_YMIX(FL), F.in[15] + l * 256, F.in[16] + l * 256}; pg8::gemm_phase(F.lds, g, S, E, sl(F.wave)); }
        GRID_BAR();
        { pg8::Gemm g{P_YMIX(FL), (const bf16*)(wsl(ws) + WS_WOUT) + (size_t)l * D * D, D, D, D}; pg8::StaticOrder S; S.init(T, D, sl(F.G), sl((int)blockIdx.x));
          EpiOutE E{P_XB(FL)}; pg8::gemm_phase(F.lds, g, S, E, sl(F.wave)); }
        GRID_BAR();
        ph_route(F, l);
        GRID_BAR();
        ph_place(F);
        GRID_BAR();
        { pg8::Gemm g{(const bf16*)(wsl(ws) + WS_XS), (const bf16*)(wsl(ws) + WS_GU) + (size_t)l * 16 * 512 * D, D, D, D}; MoeOrder S{(const int*)(wsl(ws) + WS_TILEB), sl(F.G), sl((int)blockIdx.x), false};
          EpiGU E{(bf16*)(wsl(ws) + WS_HACT), (const float*)(wsl(ws) + WS_ROWW), (const float*)(wsl(ws) + WS_ROWR)}; pg8::gemm_phase(F.lds, g, S, E, sl(F.wave)); }
        GRID_BAR();
        { pg8::Gemm g{(const bf16*)(wsl(ws) + WS_HACT), (const bf16*)(wsl(ws) + WS_WD) + (size_t)l * 24 * D * 512, 512, 512, 512}; MoeOrder S{(const int*)(wsl(ws) + WS_TILEB), sl(F.G), sl((int)blockIdx.x), true};
          EpiDown E{P_XB(FL), (const int*)(wsl(ws) + WS_ROWTOK)}; pg8::gemm_phase(F.lds, g, S, E, sl(F.wave)); }
        GRID_BAR();
    }
    ph_final(F);
}

extern "C" void kernel_launch(void* const* d_in, const int* in_sizes, int n_in, void* d_out, int out_size, void* d_ws, size_t ws_size, hipStream_t stream) {
    static int grid = 0;
    if (grid == 0) {
        if (n_in != 27 || out_size != T * D || ws_size < WS_END) { fprintf(stderr, "kernel_launch: unexpected shapes (n_in %d out %d ws %zu)\n", n_in, out_size, ws_size); grid = -1; return; }
        int dev = 0, cus = 0, per_cu = 0;
        if (hipGetDevice(&dev) != hipSuccess || hipDeviceGetAttribute(&cus, hipDeviceAttributeMultiprocessorCount, dev) != hipSuccess) { grid = -1; return; }
        if (hipFuncSetAttribute((const void*)mk_fwd, hipFuncAttributeMaxDynamicSharedMemorySize, LDS_BYTES) != hipSuccess) { fprintf(stderr, "kernel_launch: hipFuncSetAttribute failed\n"); grid = -1; return; }
        if (hipOccupancyMaxActiveBlocksPerMultiprocessor(&per_cu, (const void*)mk_fwd, NTHREADS, LDS_BYTES) != hipSuccess || per_cu < 1) { fprintf(stderr, "kernel_launch: occupancy query says %d\n", per_cu); per_cu = 1; }
        (void)hipGetLastError();
        grid = cus;
    }
    if (grid < 0) return;
    (void)hipMemsetAsync((char*)d_ws + WS_CTL, 0, CTL_ZERO_BYTES, stream);
    Args a{};
    for (int i = 0; i < 27; ++i) a.in[i] = (const float*)d_in[i];
    a.out = (float*)d_out; a.ws = (unsigned char*)d_ws; a.pad0 = 0; a.pad1 = 0;
    hipLaunchKernelGGL(mk_fwd, dim3(grid), dim3(NTHREADS), LDS_BYTES, stream, a);
}
```

```cpp
#include <hip/hip_runtime.h>
#include <hip/hip_bf16.h>
#include <cstdio>
#include <cstdint>

#define GAS __attribute__((address_space(1)))
#define LAS __attribute__((address_space(3)))
typedef unsigned short bf16;
typedef float f32x4 __attribute__((ext_vector_type(4)));
typedef unsigned u32x4 __attribute__((ext_vector_type(4)));
typedef unsigned u32x2 __attribute__((ext_vector_type(2)));

constexpr int NB = 8, SEQ = 4096, T = NB * SEQ, D = 1024, NPROJ = 2048, DEPTH = 2;
constexpr int NHEAD = 8, HD = 64, MBLK = 256, NBLK = SEQ / MBLK;
constexpr int SG = 16, SGN = 16, SP = 64, SCH = 64, UGP = 1152;
constexpr float RMS_EPS = 1e-6f;
constexpr float LOG2E = 1.4426950408889634f;
constexpr float C2 = 0.125f * LOG2E;
constexpr int NWAVES = 8, NTHREADS = 512;

constexpr size_t MiB = 1u << 20;
constexpr size_t WS_CTL = 0, CTL_ZERO_BYTES = 1 * MiB;
constexpr size_t WS_XB = 2 * MiB;
constexpr size_t WS_UG = 66 * MiB;
constexpr size_t WS_PB = 84 * MiB;
constexpr size_t WS_QB = 100 * MiB;
constexpr size_t WS_KB = 132 * MiB;
constexpr size_t WS_VB = 164 * MiB;
constexpr size_t WS_YMIX = 196 * MiB;
constexpr size_t WS_YS = 260 * MiB;
constexpr size_t WS_DL = 276 * MiB;
constexpr size_t WS_KMP = 292 * MiB;
constexpr size_t WS_BT = 293 * MiB;
constexpr size_t WS_WIN = 300 * MiB;
constexpr size_t WS_WOUT = 308 * MiB;
constexpr size_t WS_GU = 312 * MiB;
constexpr size_t WS_WD = 344 * MiB;
constexpr size_t WS_TG = 392 * MiB;
constexpr size_t WS_BZ = 464 * MiB;
constexpr size_t WS_GLUT = 480 * MiB;
constexpr size_t WS_POOLT = WS_GLUT + 512 * 1024;
constexpr size_t WS_ZB = 482 * MiB;
constexpr size_t WS_END = 486 * MiB;
constexpr int MOE_MAXT = 152;
constexpr size_t WS_XS = 66 * MiB;
constexpr size_t WS_HACT = 142 * MiB;
constexpr size_t WS_TOKB = 294 * MiB;
constexpr size_t WS_TOKR = WS_TOKB + 128 * 1024;
constexpr size_t WS_TOKW = WS_TOKB + 256 * 1024;
constexpr size_t WS_ROWTOK = 295 * MiB;
constexpr size_t WS_ROWW = WS_ROWTOK + 256 * 1024;
constexpr size_t WS_ROWR = WS_ROWTOK + 576 * 1024;
constexpr size_t WS_RS1 = WS_ROWTOK + 768 * 1024;
constexpr size_t WS_WGCNT = 296 * MiB;
constexpr size_t WS_TILEB = WS_WGCNT + 64 * 1024;

constexpr int CW_BAR = 4096;

__device__ __forceinline__ unsigned f2bf(float f) { unsigned u = __builtin_bit_cast(unsigned, f); return (u + 0x7fffu + ((u >> 16) & 1u)) >> 16; }
__device__ __forceinline__ float bf2f(unsigned h) { return __builtin_bit_cast(float, h << 16); }
__device__ __forceinline__ unsigned pk2(float lo, float hi) { return f2bf(lo) | (f2bf(hi) << 16); }
template <int O> __device__ __forceinline__ float xshfl(float v) {
    if constexpr (O < 32) return __builtin_bit_cast(float, __builtin_amdgcn_ds_swizzle(__builtin_bit_cast(int, v), (O << 10) | 0x1f));
    else { const unsigned u = __builtin_bit_cast(unsigned, v); auto r = __builtin_amdgcn_permlane32_swap(u, u, false, false);
           const float a = __builtin_bit_cast(float, (unsigned)r[0]), b = __builtin_bit_cast(float, (unsigned)r[1]); return (a == v && __builtin_bit_cast(unsigned, a) == u) ? b : a; }
}
__device__ __forceinline__ float wave_sum(float v) {
    v += xshfl<1>(v); v += xshfl<2>(v); v += xshfl<4>(v); v += xshfl<8>(v); v += xshfl<16>(v);
    const unsigned u = __builtin_bit_cast(unsigned, v); auto r = __builtin_amdgcn_permlane32_swap(u, u, false, false);
    return __builtin_bit_cast(float, (unsigned)r[0]) + __builtin_bit_cast(float, (unsigned)r[1]);
}
__device__ __forceinline__ float wave_max(float v) {
    v = fmaxf(v, xshfl<1>(v)); v = fmaxf(v, xshfl<2>(v)); v = fmaxf(v, xshfl<4>(v)); v = fmaxf(v, xshfl<8>(v)); v = fmaxf(v, xshfl<16>(v));
    const unsigned u = __builtin_bit_cast(unsigned, v); auto r = __builtin_amdgcn_permlane32_swap(u, u, false, false);
    return fmaxf(__builtin_bit_cast(float, (unsigned)r[0]), __builtin_bit_cast(float, (unsigned)r[1]));
}
__device__ __forceinline__ float gelu_tanh(float x) {
    const float u = 0.7978845608028654f * (x + 0.044715f * x * x * x);
    const float e = __expf(2.f * u);
    const float th = 1.f - 2.f / (e + 1.f);
    return 0.5f * x * (1.f + th);
}
__device__ __forceinline__ float sigmoidf_(float x) { return 1.f / (1.f + __expf(-x)); }

__device__ __forceinline__ int lane_id() { unsigned m; asm volatile("s_mov_b32 %0, -1" : "=s"(m)); return (int)__builtin_amdgcn_mbcnt_hi(m, __builtin_amdgcn_mbcnt_lo(m, 0u)); }

#define XB_TMO      128
#define XB_XCNT(j)  (256  + 64 * (j))
#define XB_XSUB(j)  (1280 + 64 * (j))
#define XB_XGEN(j)  (2304 + 64 * (j))
#define XB_TOP      3328
#define XB_TOPGEN   3392
#define XCD_BAR_WORDS 3456
#define XB_SPIN_CAP (1u << 22)
__device__ __forceinline__ unsigned xb_ld(unsigned* p)              { return __hip_atomic_load(p, __ATOMIC_RELAXED, __HIP_MEMORY_SCOPE_AGENT); }
__device__ __forceinline__ unsigned xb_add(unsigned* p, unsigned v) { return __hip_atomic_fetch_add(p, v, __ATOMIC_RELAXED, __HIP_MEMORY_SCOPE_AGENT); }
__device__ __forceinline__ unsigned xb_xcc_id() { return (unsigned)__builtin_amdgcn_s_getreg((3 << 11) | 20) & 0xFu; }
#define XB_SPIN(cond, bar) do { unsigned _sp = 0; while (cond) { __builtin_amdgcn_s_sleep(1); \
    if ((++_sp & 255u) == 0u) { if (xb_ld(&(bar)[XB_TMO])) break; if (_sp > XB_SPIN_CAP) { atomicAdd(&(bar)[XB_TMO], 1u); break; } } } } while (0)
struct XcdBarrier { unsigned* bar; unsigned x; volatile LAS unsigned* st; };
__device__ __forceinline__ XcdBarrier xcd_barrier_post(unsigned* bar, volatile LAS unsigned* st, bool t0) {
    XcdBarrier b; b.bar = bar; b.x = xb_xcc_id(); b.st = st;
    if (t0) (void)xb_add(&bar[XB_XCNT(b.x)], 1u);
    return b;
}
__device__ __forceinline__ void xcd_barrier_complete(unsigned* bar, unsigned x, unsigned& nloc, unsigned& nx) {
    const unsigned G = gridDim.x * gridDim.y * gridDim.z;
    unsigned sum, cnt, mine, sp = 0u;
    for (;;) {
        sum = 0u; cnt = 0u; mine = 0u;
#pragma unroll
        for (unsigned j = 0; j < 16; ++j) { const unsigned c = xb_ld(&bar[XB_XCNT(j)]); sum += c; cnt += (c > 0u) ? 1u : 0u; mine = (j == x) ? c : mine; }
        if (sum == G) break;
        __builtin_amdgcn_s_sleep(1);
        if ((++sp & 255u) == 0u) { if (xb_ld(&bar[XB_TMO])) break; if (sp > XB_SPIN_CAP) { atomicAdd(&bar[XB_TMO], 1u); break; } }
    }
    nloc = mine > 0u ? mine : 1u; nx = cnt > 0u ? cnt : 1u;
}
__device__ __forceinline__ void xcd_barrier(const XcdBarrier& b, int wave) {
    asm volatile("s_waitcnt vmcnt(0)" ::: "memory");
    __syncthreads();
    if (wave == 0 && lane_id() == 0) {
        unsigned* bar = b.bar;
        __builtin_amdgcn_s_waitcnt(0);
        unsigned nloc = b.st[0], nx = b.st[1];
        if (nloc == 0u) { xcd_barrier_complete(bar, b.x, nloc, nx); b.st[0] = nloc; b.st[1] = nx; }
        const unsigned old = xb_add(&bar[XB_XSUB(b.x)], 1u);
        const unsigned gen = old / nloc;
        if (old + 1u == (gen + 1u) * nloc) {
            __builtin_amdgcn_fence(__ATOMIC_RELEASE, "agent");
            asm volatile("s_waitcnt vmcnt(0)" ::: "memory");
            const unsigned og = xb_add(&bar[XB_TOP], 1u);
            const unsigned tg = og / nx;
            if (og + 1u == (tg + 1u) * nx) xb_add(&bar[XB_TOPGEN], 1u);
            else XB_SPIN(xb_ld(&bar[XB_TOPGEN]) == tg, bar);
            __builtin_amdgcn_fence(__ATOMIC_ACQUIRE, "agent");
            xb_add(&bar[XB_XGEN(b.x)], 1u);
            asm volatile("s_waitcnt vmcnt(0)" ::: "memory");
        } else {
            XB_SPIN(xb_ld(&bar[XB_XGEN(b.x)]) == gen, bar);
            __builtin_amdgcn_fence(__ATOMIC_ACQUIRE, "agent");
            asm volatile("s_waitcnt vmcnt(0)" ::: "memory");
        }
    }
    __syncthreads();
}

struct Args {
    const float* in[27];
    float* out;
    unsigned char* ws;
    int pad0, pad1;
};

typedef const float* fptr_t;
typedef __attribute__((address_space(4))) const fptr_t* KargP;
struct Ctx {
    LAS unsigned char* lds;
    int tid, lane, wave, vcu, G;
    KargP in;
    float* R;
    unsigned char* ws;
};
#define P_XB(F) ((bf16*)((F).ws + WS_XB))
#define P_UG(F) ((bf16*)((F).ws + WS_UG))
#define P_PB(F) ((bf16*)((F).ws + WS_PB))
#define P_QB(F) ((bf16*)((F).ws + WS_QB))
#define P_KB(F) ((bf16*)((F).ws + WS_KB))
#define P_VB(F) ((bf16*)((F).ws + WS_VB))
#define P_YMIX(F) ((bf16*)((F).ws + WS_YMIX))
#define P_YS(F) ((bf16*)((F).ws + WS_YS))
#define P_DL(F) ((bf16*)((F).ws + WS_DL))
#define P_KMP(F) ((float*)((F).ws + WS_KMP))
#define P_BT(F) ((float*)((F).ws + WS_BT))


__device__ __forceinline__ Ctx launder(const Ctx& F0) {
    Ctx F = F0;
    int ln = lane_id(); asm volatile("" : "+v"(ln));
    asm volatile("" : "+s"(F.wave), "+s"(F.vcu), "+s"(F.G));
    F.lane = ln; F.tid = F.wave * 64 + ln;
    KargP kp = (KargP)__builtin_amdgcn_kernarg_segment_ptr(); asm volatile("" : "+s"(kp));
    F.in = kp; F.R = (float*)kp[27]; F.ws = (unsigned char*)kp[28];
    return F;
}

__device__ __forceinline__ unsigned char* wsl(unsigned char* p) { asm volatile("" : "+s"(p)); return p; }
__device__ __forceinline__ int sl(int x) { asm volatile("" : "+s"(x)); return x; }

namespace pg8 {
typedef short bf16x8 __attribute__((ext_vector_type(8)));
constexpr int BM = 256, BK = 64, HALF = 128, HTB = HALF * BK * 2, STAGE_BYTES = 8 * HTB, NXCD = 8, WGM = 8;
__device__ __forceinline__ int lds_byte(int r, int c) { const int st = (r >> 4) * 2 + (c >> 5), rr = r & 15, cc = c & 31, ob = rr * 64 + cc * 2; return st * 1024 + (ob ^ (((ob >> 9) & 1) << 5)); }
__device__ __forceinline__ void stage_rc(int b, int& R, int& C) { const int st = b / 1024, sb = b % 1024, swz = sb ^ (((sb >> 9) & 1) << 5); R = (st >> 1) * 16 + swz / 64; C = (st & 1) * 32 + (swz % 64) / 2; }
__device__ __forceinline__ int perm32(int rho) { const int n = rho >> 4, i = rho & 15; return 8 * (i >> 2) + 4 * n + (i & 3); }

struct Unit { int pm, pn, aux; };
struct Gemm { const bf16* A; const bf16* Bt; int lda, ldb, K; };

struct StaticOrder {
    int nM, nN, nwg, G, c;
    __device__ void init(int M, int N, int G_, int c_) { nM = M / BM; nN = N / BM; nwg = nM * nN; G = G_; c = c_; }
    __device__ bool next(int i, Unit& u) const {
        const long L = (long)i * G + c; if (L >= nwg) return false;
        int wgid = (int)L; { const int q = nwg / NXCD, r = nwg % NXCD, xcd = wgid % NXCD, off = wgid / NXCD; wgid = (xcd < r ? xcd * (q + 1) : r * (q + 1) + (xcd - r) * q) + off; }
        const int nig = WGM * nN, gid = wgid / nig, fm = gid * WGM, gsz = (nM - fm) < WGM ? (nM - fm) : WGM;
        u.pm = fm + ((wgid % nig) % gsz); u.pn = (wgid % nig) / gsz; u.aux = 0; return true;
    }
};

__device__ __forceinline__ unsigned cvt_pk_bf16(float lo, float hi) { unsigned r; asm volatile("v_cvt_pk_bf16_f32 %0, %1, %2" : "=v"(r) : "v"(lo), "v"(hi)); return r; }

template <bool ALIGN = true, class Epi, class Sched>
__device__ __forceinline__ void gemm_phase(LAS unsigned char* lds, const Gemm g, const Sched& S, const Epi& E, int wave_) {
    int lane_ = lane_id(); asm volatile("" : "+v"(lane_)); asm volatile("" : "+s"(wave_));
    const int wid = wave_, lane = lane_, tid = wid * 64 + lane, wr = wid >> 2, wc = wid & 3, fr = lane & 15, fq = lane >> 4;
    const int K = g.K, nt = K / BK;
    unsigned voffA[2], voffB[2];
#pragma unroll
    for (int i = 0; i < 2; ++i) { int R, C; stage_rc(tid * 16 + i * 8192, R, C); const int Rb = Epi::PERM ? ((R & ~31) + perm32(R & 31)) : R;
        voffA[i] = (unsigned)(R * g.lda + C) * 2u; voffB[i] = (unsigned)(Rb * g.ldb + C) * 2u; }
    const size_t kstep = (size_t)(BK * 2);
    const size_t hstepA = (size_t)HALF * g.lda * 2, hstepB = (size_t)HALF * g.ldb * 2;
    const size_t tstepA = 2 * hstepA, tstepB = 2 * hstepB;
    const unsigned ldsw = (unsigned)wid * 1024u;
    const int aoff = lds_byte(wr * 64 + fr, fq * 8), boff = lds_byte(wc * 32 + fr, fq * 8);
#define PG8_SA(b, h) (((b) * 2 + (h)) * HTB)
#define PG8_SB(b, h) ((4 + (b) * 2 + (h)) * HTB)
#define PG8_STAGE(bufoff, gbase, voff) do { _Pragma("unroll") for (int _i = 0; _i < 2; ++_i) \
        __builtin_amdgcn_global_load_lds((const unsigned*)((const char*)(gbase) + (voff)[_i]), (LAS unsigned*)(lds + (bufoff) + ldsw + _i * 8192), 16, 0, 0); } while (0)
#define PG8_LDA(dst, b, h) do { _Pragma("unroll") for (int m = 0; m < 4; ++m) _Pragma("unroll") for (int k = 0; k < 2; ++k) dst[m][k] = *(const LAS bf16x8*)(lds + PG8_SA(b, h) + aoff + m * 2048 + k * 1024); } while (0)
#define PG8_LDB(dst, b, h) do { _Pragma("unroll") for (int n = 0; n < 2; ++n) _Pragma("unroll") for (int k = 0; k < 2; ++k) dst[n][k] = *(const LAS bf16x8*)(lds + PG8_SB(b, h) + boff + n * 2048 + k * 1024); } while (0)
#define PG8_MMA(ai, bj, At, Bt) do { __builtin_amdgcn_s_setprio(1); _Pragma("unroll") for (int m = 0; m < 4; ++m) _Pragma("unroll") for (int n = 0; n < 2; ++n) _Pragma("unroll") for (int k = 0; k < 2; ++k) \
        acc[ai][bj][m][n] = __builtin_amdgcn_mfma_f32_16x16x32_bf16(Bt[n][k], At[m][k], acc[ai][bj][m][n], 0, 0, 0); __builtin_amdgcn_s_setprio(0); } while (0)
#define PG8_WAIT_V(n) asm volatile("s_waitcnt vmcnt(" #n ")" ::: "memory")
#define PG8_WAIT_L(n) asm volatile("s_waitcnt lgkmcnt(" #n ")" ::: "memory")
#define PG8_BAR __builtin_amdgcn_s_barrier()
#define PG8_SCHED __builtin_amdgcn_sched_barrier(0)
    Unit cur, nxt; int ui = 0;
    if (!S.next(0, cur)) return;
    f32x4 acc[2][2][4][2];
#pragma unroll
    for (int a = 0; a < 2; ++a)
#pragma unroll
        for (int b = 0; b < 2; ++b)
#pragma unroll
            for (int m = 0; m < 4; ++m)
#pragma unroll
                for (int n = 0; n < 2; ++n) acc[a][b][m][n] = (f32x4){0.f, 0.f, 0.f, 0.f};
    bf16x8 At[4][2], B0[2][2], B1[2][2];
    const char* cA = (const char*)g.A + (size_t)cur.pm * tstepA; const char* cB = (const char*)g.Bt + (size_t)cur.pn * tstepB;
    PG8_STAGE(PG8_SB(0, 0), cB, voffB); PG8_STAGE(PG8_SB(0, 1), cB + hstepB, voffB); PG8_STAGE(PG8_SA(0, 0), cA, voffA); PG8_STAGE(PG8_SA(0, 1), cA + hstepA, voffA);
    if (wr == 1) PG8_BAR;
    PG8_WAIT_V(2); PG8_BAR;
    PG8_STAGE(PG8_SB(1, 0), cB + kstep, voffB); PG8_STAGE(PG8_SA(1, 0), cA + kstep, voffA); PG8_STAGE(PG8_SB(1, 1), cB + hstepB + kstep, voffB);
    PG8_WAIT_V(6); PG8_BAR;
    for (;;) {
        const bool has_next = S.next(ui + 1, nxt);
        const char* nA = has_next ? (const char*)g.A + (size_t)nxt.pm * tstepA : cA; const char* nB = has_next ? (const char*)g.Bt + (size_t)nxt.pn * tstepB : cB;
        for (int t = 0; t < nt; t += 2) {
            const bool last = (t == nt - 2);
            const char* a1 = cA + (size_t)(t + 1) * kstep;
            const char* a2 = last ? nA : cA + (size_t)(t + 2) * kstep; const char* b2 = last ? nB : cB + (size_t)(t + 2) * kstep;
            const char* a3 = a2 + kstep; const char* b3 = b2 + kstep;
            PG8_LDB(B0, 0, 0); PG8_LDB(B1, 0, 1); PG8_SCHED; PG8_LDA(At, 0, 0); PG8_STAGE(PG8_SA(1, 1), a1 + hstepA, voffA);
            PG8_WAIT_V(8); PG8_WAIT_L(0); PG8_BAR; PG8_MMA(0, 0, At, B0); PG8_MMA(0, 1, At, B1); PG8_BAR; PG8_SCHED;
            PG8_LDA(At, 0, 1); PG8_STAGE(PG8_SB(0, 0), b2, voffB); PG8_STAGE(PG8_SB(0, 1), b2 + hstepB, voffB); PG8_STAGE(PG8_SA(0, 0), a2, voffA);
            PG8_WAIT_V(8); PG8_WAIT_L(0); PG8_BAR; PG8_MMA(1, 0, At, B0); PG8_MMA(1, 1, At, B1); PG8_BAR; PG8_SCHED;
            PG8_LDB(B0, 1, 0); PG8_LDB(B1, 1, 1); PG8_SCHED; PG8_LDA(At, 1, 0); PG8_STAGE(PG8_SA(0, 1), a2 + hstepA, voffA);
            PG8_WAIT_V(8); PG8_WAIT_L(0); PG8_BAR; PG8_MMA(0, 0, At, B0); PG8_MMA(0, 1, At, B1); PG8_BAR; PG8_SCHED;
            PG8_LDA(At, 1, 1); PG8_STAGE(PG8_SB(1, 0), b3, voffB); PG8_STAGE(PG8_SB(1, 1), b3 + hstepB, voffB); PG8_STAGE(PG8_SA(1, 0), a3, voffA);
            PG8_WAIT_V(8); PG8_WAIT_L(0); PG8_BAR; PG8_MMA(1, 0, At, B0); PG8_MMA(1, 1, At, B1); PG8_BAR; PG8_SCHED;
        }
        if constexpr (ALIGN) { if (wr == 0) PG8_BAR; }
        E(acc, cur, wr, wc, fr, fq);
        if (!has_next) break;
#pragma unroll
        for (int a = 0; a < 2; ++a)
#pragma unroll
            for (int b = 0; b < 2; ++b)
#pragma unroll
                for (int m = 0; m < 4; ++m)
#pragma unroll
                    for (int n = 0; n < 2; ++n) acc[a][b][m][n] = (f32x4){0.f, 0.f, 0.f, 0.f};
        cur = nxt; cA = nA; cB = nB; ++ui;
        if constexpr (ALIGN) { if (wr == 1) PG8_BAR; }
    }
    PG8_WAIT_V(0);
    if constexpr (!ALIGN) { if (wr == 0) PG8_BAR; }
    PG8_BAR;
#undef PG8_SA
#undef PG8_SB
#undef PG8_STAGE
#undef PG8_LDA
#undef PG8_LDB
#undef PG8_MMA
#undef PG8_WAIT_V
#undef PG8_WAIT_L
#undef PG8_BAR
#undef PG8_SCHED
}
}


struct EpiProjE {
    static constexpr bool PERM = true;
    bf16 *UG, *PB, *QB, *KB, *VB; float* KMP; const float* rs1;
    __device__ __forceinline__ void operator()(const f32x4 (&acc_)[2][2][4][2], const pg8::Unit& u, int wr, int wc, int fr_, int fq_) const {
        const int ln_ = lane_id(), fr = ln_ & 15, fq = ln_ >> 4; (void)fr_; (void)fq_;
        const int pn = u.pn, row0 = u.pm * 256 + wr * 64 + fr, cl = wc * 32 + 8 * fq;
        f32x4 acc[2][2][4][2];
#pragma unroll
        for (int ai = 0; ai < 2; ++ai)
#pragma unroll
            for (int m = 0; m < 4; ++m) { const float rs = rs1[row0 + ai * 128 + m * 16];
#pragma unroll
                for (int bj = 0; bj < 2; ++bj) { acc[ai][bj][m][0] = acc_[ai][bj][m][0] * rs; acc[ai][bj][m][1] = acc_[ai][bj][m][1] * rs; } }
        if (pn == 0) {
#pragma unroll
            for (int ai = 0; ai < 2; ++ai)
#pragma unroll
                for (int m = 0; m < 4; ++m) { const int r = row0 + ai * 128 + m * 16;
#pragma unroll
                    for (int bj = 0; bj < 2; ++bj) { const int ch = bj * 128 + cl, g = ch >> 4, h0 = ch & 15;
                        const f32x4 v0 = acc[ai][bj][m][0], v1 = acc[ai][bj][m][1]; u32x4 w;
                        w.x = pg8::cvt_pk_bf16(v0[0], v0[1]); w.y = pg8::cvt_pk_bf16(v0[2], v0[3]); w.z = pg8::cvt_pk_bf16(v1[0], v1[1]); w.w = pg8::cvt_pk_bf16(v1[2], v1[3]);
                        *(u32x4*)(UG + ((size_t)(g * 512 + (r >> 6))) * UGP + (r & 63) * 16 + h0) = w; } }
        } else {
            bf16* base; int ldc, colt; float sc = 1.f;
            if (pn == 1) { base = PB; ldc = 256; colt = 0; }
            else if (pn < 4) { base = QB; ldc = 512; colt = (pn - 2) * 256; sc = C2; }
            else if (pn < 6) { base = KB; ldc = 512; colt = (pn - 4) * 256; }
            else { base = VB; ldc = 512; colt = (pn - 6) * 256; }
#pragma unroll
            for (int ai = 0; ai < 2; ++ai)
#pragma unroll
                for (int m = 0; m < 4; ++m) { bf16* rowp = base + (size_t)(row0 + ai * 128 + m * 16) * ldc + colt + cl;
#pragma unroll
                    for (int bj = 0; bj < 2; ++bj) { const f32x4 v0 = acc[ai][bj][m][0] * sc, v1 = acc[ai][bj][m][1] * sc; u32x4 w;
                        w.x = pg8::cvt_pk_bf16(v0[0], v0[1]); w.y = pg8::cvt_pk_bf16(v0[2], v0[3]); w.z = pg8::cvt_pk_bf16(v1[0], v1[1]); w.w = pg8::cvt_pk_bf16(v1[2], v1[3]);
                        *(u32x4*)(rowp + bj * 128) = w; } }
            if (pn >= 4 && pn < 6) {
#pragma unroll
                for (int bj = 0; bj < 2; ++bj)
#pragma unroll
                    for (int n = 0; n < 2; ++n) { f32x4 s = (f32x4){0.f, 0.f, 0.f, 0.f};
#pragma unroll
                        for (int ai = 0; ai < 2; ++ai)
#pragma unroll
                            for (int m = 0; m < 4; ++m) s += acc[ai][bj][m][n];
#pragma unroll
                        for (int i = 0; i < 4; ++i) { float t = s[i]; t += xshfl<1>(t); t += xshfl<2>(t); t += xshfl<4>(t); t += xshfl<8>(t); s[i] = t; }
                        if (fr == 0) *(f32x4*)(KMP + (size_t)wr * 128 * 512 + (size_t)u.pm * 512 + colt + bj * 128 + cl + 4 * n) = s; }
            }
        }
    }
};
struct EpiOutE {
    static constexpr bool PERM = true;
    bf16* RB;
    __device__ __forceinline__ void operator()(const f32x4 (&acc)[2][2][4][2], const pg8::Unit& u, int wr, int wc, int fr_, int fq_) const {
        const int ln_ = lane_id(), fr = ln_ & 15, fq = ln_ >> 4; (void)fr_; (void)fq_;
        const int row0 = u.pm * 256 + wr * 64 + fr, col0 = u.pn * 256 + wc * 32 + 8 * fq;
#pragma unroll
        for (int ai = 0; ai < 2; ++ai)
#pragma unroll
            for (int m = 0; m < 4; ++m) { bf16* rp = RB + (size_t)(row0 + ai * 128 + m * 16) * D + col0;
#pragma unroll
                for (int bj = 0; bj < 2; ++bj) { const u32x4 x = *(const u32x4*)(rp + bj * 128); const f32x4 a0 = acc[ai][bj][m][0], a1 = acc[ai][bj][m][1]; u32x4 w;
                    w.x = pg8::cvt_pk_bf16(bf2f(x.x & 0xffffu) + a0[0], bf2f(x.x >> 16) + a0[1]); w.y = pg8::cvt_pk_bf16(bf2f(x.y & 0xffffu) + a0[2], bf2f(x.y >> 16) + a0[3]);
                    w.z = pg8::cvt_pk_bf16(bf2f(x.z & 0xffffu) + a1[0], bf2f(x.z >> 16) + a1[1]); w.w = pg8::cvt_pk_bf16(bf2f(x.w & 0xffffu) + a1[2], bf2f(x.w >> 16) + a1[3]);
                    *(u32x4*)(rp + bj * 128) = w; }
                if (m & 1) asm volatile("" ::: "memory"); }
    }
};

__device__ __forceinline__ void transpose_item(const float* W, int K, int N, const float* kscale, bf16* WT, int ldo, int koff, int rowmode, LAS float* scr, int item, int lane) {
    const int nblk = N / 32, kb = item / nblk, nb = item % nblk, k0 = 64 * kb, n0 = 32 * nb;
    { const int r8 = lane >> 3, c4 = lane & 7; f32x4 v[8];
#pragma unroll
      for (int i = 0; i < 8; ++i) v[i] = *(const f32x4*)(W + (size_t)(k0 + 8 * i + r8) * N + n0 + 4 * c4);
#pragma unroll
      for (int i = 0; i < 8; ++i) { const int kk = 8 * i + r8; const float s = kscale ? kscale[k0 + kk] : 1.f; LAS float* d = scr + kk * 33 + 4 * c4;
          d[0] = v[i][0] * s; d[1] = v[i][1] * s; d[2] = v[i][2] * s; d[3] = v[i][3] * s; } }
    asm volatile("s_waitcnt lgkmcnt(0)" ::: "memory");
    const int c = lane & 7;
#pragma unroll
    for (int j = 0; j < 4; ++j) { const int n = (lane >> 3) + 8 * j; const LAS float* s = scr + (8 * c) * 33 + n;
        u32x4 o; o.x = pk2(s[0 * 33], s[1 * 33]); o.y = pk2(s[2 * 33], s[3 * 33]); o.z = pk2(s[4 * 33], s[5 * 33]); o.w = pk2(s[6 * 33], s[7 * 33]);
        const int nn = n0 + n, row = rowmode == 0 ? nn : (8 * (nn >> 2) + (nn & 3) + (rowmode == 2 ? 4 : 0));
        *(u32x4*)(WT + (size_t)row * ldo + koff + k0 + 8 * c) = o; }
    asm volatile("s_waitcnt lgkmcnt(0)" ::: "memory");
}
__device__ __forceinline__ void pair_decode(int pi, int& ea, int& eb) { ea = pi < 3 ? 0 : (pi < 5 ? 1 : 2); eb = pi < 3 ? pi + 1 : (pi < 5 ? pi - 1 : 3); }
__device__ __forceinline__ void ph_prologue(const Ctx& F0) {
    const Ctx F = launder(F0);
    LAS float* scr = (LAS float*)(F.lds + F.wave * 16384);
    const int gw = F.vcu * NWAVES + F.wave, NGW = F.G * NWAVES;
    constexpr int I_IN = (D / 64) * (NPROJ / 32), I_OUT = (D / 64) * (D / 32), I_GU1 = (D / 64) * (256 / 32), I_GU = 16 * 2 * I_GU1, I_WD1 = (256 / 64) * (D / 32), I_WD = 24 * 2 * I_WD1;
    constexpr int I_L = I_IN + I_OUT + I_GU + I_WD;
    for (int it = gw; it < DEPTH * I_L; it += NGW) {
        const int l = it / I_L; int r = it % I_L;
        if (r < I_IN) { transpose_item(F.in[3] + (size_t)l * D * NPROJ, D, NPROJ, F.in[2] + l * D, (bf16*)(F.ws + WS_WIN) + (size_t)l * NPROJ * D, D, 0, 0, scr, r, F.lane); continue; } r -= I_IN;
        if (r < I_OUT) { transpose_item(F.in[17] + (size_t)l * D * D, D, D, nullptr, (bf16*)(F.ws + WS_WOUT) + (size_t)l * D * D, D, 0, 0, scr, r, F.lane); continue; } r -= I_OUT;
        if (r < I_GU) { const int e = r / (2 * I_GU1), up = (r / I_GU1) & 1, item = r % I_GU1;
            transpose_item(F.in[up ? 24 : 23] + ((size_t)l * 16 + e) * D * 256, D, 256, F.in[18] + l * D, (bf16*)(F.ws + WS_GU) + ((size_t)l * 16 + e) * 512 * D, D, 0, 1 + up, scr, item, F.lane); continue; } r -= I_GU;
        { const int bk = r / (2 * I_WD1), half = (r / I_WD1) & 1, item = r % I_WD1, g = bk / 6; int ea, eb; pair_decode(bk % 6, ea, eb); const int e = g * 4 + (half ? eb : ea);
            transpose_item(F.in[25] + ((size_t)l * 16 + e) * 256 * D, 256, D, nullptr, (bf16*)(F.ws + WS_WD) + ((size_t)l * 24 + bk) * D * 512, 512, half * 256, 0, scr, item, F.lane); }
    }
    for (int it = gw; it < DEPTH * 32; it += NGW) { const int l = it >> 5;
        transpose_item(F.in[12] + (size_t)l * 256 * 256, 256, 256, nullptr, (bf16*)(F.ws + WS_GLUT) + (size_t)l * 65536, 256, 0, 0, scr, it & 31, F.lane); }
    { const int gt = F.vcu * NTHREADS + F.tid, NGT = F.G * NTHREADS;
      for (int i = gt; i < DEPTH * 65536; i += NGT) { const int l = i >> 16, n = (i >> 8) & 255, k = i & 255;
          const float v = ((n >> 6) == (k >> 6)) ? F.in[14][(((size_t)l * 4 + (n >> 6)) * 64 + (k & 63)) * 64 + (n & 63)] : 0.f;
          ((bf16*)(F.ws + WS_POOLT))[i] = (bf16)f2bf(v); } }
    for (int it = gw; it < DEPTH * SGN * 65; it += NGW) {
        const int l = it / (SGN * 65), g = (it / 65) % SGN, tau = it % 65, p = F.lane;
        const float are = F.in[4][(l * SGN + g) * SP + p], aim = F.in[5][(l * SGN + g) * SP + p], dt = expf(F.in[6][l * SGN + g]);
        float sn, cs; sincosf(aim * dt, &sn, &cs); const float mg = expf(are * dt), lbr = mg * cs, lbi = mg * sn;
        const float nr = lbr - 1.f, ni = lbi, den = are * are + aim * aim, cr = (nr * are + ni * aim) / den, ci = (ni * are - nr * aim) / den;
        float sn2, cs2; sincosf(aim * dt * (float)tau, &sn2, &cs2); const float mg2 = expf(are * dt * (float)tau), lr = mg2 * cs2, li = mg2 * sn2;
        float wr[16], wi[16];
#pragma unroll
        for (int h = 0; h < 16; ++h) { const float br = F.in[7][((size_t)(l * SGN + g) * SP + p) * SG + h], bi = F.in[8][((size_t)(l * SGN + g) * SP + p) * SG + h];
            const float bbr = cr * br - ci * bi, bbi = cr * bi + ci * br; wr[h] = lr * bbr - li * bbi; wi[h] = lr * bbi + li * bbr; }
        bf16* TG = (bf16*)(F.ws + WS_TG) + ((size_t)l * SGN + g) * 1024 * UGP;
        if (tau <= 63) {
            bf16* BZ = (bf16*)(F.ws + WS_BZ) + ((size_t)l * SGN + g) * 256 * 1024; const int s = 63 - tau;
            u32x4 o0, o1, o2, o3;
            o0.x = pk2(wr[0], wr[1]); o0.y = pk2(wr[2], wr[3]); o0.z = pk2(wr[4], wr[5]); o0.w = pk2(wr[6], wr[7]); o1.x = pk2(wr[8], wr[9]); o1.y = pk2(wr[10], wr[11]); o1.z = pk2(wr[12], wr[13]); o1.w = pk2(wr[14], wr[15]);
            o2.x = pk2(wi[0], wi[1]); o2.y = pk2(wi[2], wi[3]); o2.z = pk2(wi[4], wi[5]); o2.w = pk2(wi[6], wi[7]); o3.x = pk2(wi[8], wi[9]); o3.y = pk2(wi[10], wi[11]); o3.z = pk2(wi[12], wi[13]); o3.w = pk2(wi[14], wi[15]);
            *(u32x4*)(BZ + (size_t)p * 1024 + s * 16) = o0; *(u32x4*)(BZ + (size_t)p * 1024 + s * 16 + 8) = o1;
            *(u32x4*)(BZ + (size_t)(64 + p) * 1024 + s * 16) = o2; *(u32x4*)(BZ + (size_t)(64 + p) * 1024 + s * 16 + 8) = o3;
        }
        LAS float* Wst = scr; LAS float* Kt = scr + 128 * 16;
        if (tau <= 63) {
#pragma unroll
            for (int q = 0; q < 4; ++q) { *(LAS f32x4*)(Wst + p * 16 + 4 * q) = (f32x4){wr[4 * q], wr[4 * q + 1], wr[4 * q + 2], wr[4 * q + 3]};
                                          *(LAS f32x4*)(Wst + (64 + p) * 16 + 4 * q) = (f32x4){wi[4 * q], wi[4 * q + 1], wi[4 * q + 2], wi[4 * q + 3]}; }
            const int arow = p & 15, kq = p >> 4; f32x4 kacc = (f32x4){0.f, 0.f, 0.f, 0.f};
            const float* cre = F.in[9] + ((size_t)(l * SGN + g) * SG + arow) * SP; const float* cim = F.in[10] + ((size_t)(l * SGN + g) * SG + arow) * SP;
#pragma unroll 8
            for (int s = 0; s < 32; ++s) { const int k = 4 * s + kq; const float av = (k < 64) ? cre[k] : -cim[k - 64]; const float bv = Wst[k * 16 + arow];
                kacc = __builtin_amdgcn_mfma_f32_16x16x4f32(av, bv, kacc, 0, 0, 0); }
#pragma unroll
            for (int r = 0; r < 4; ++r) Kt[(4 * kq + r) * 16 + arow] = kacc[r];
        }
#pragma unroll 1
        for (int ho = 0; ho < 16; ++ho) {
            const float ccr = F.in[9][((size_t)(l * SGN + g) * SG + ho) * SP + p], cci = F.in[10][((size_t)(l * SGN + g) * SG + ho) * SP + p];
            if (tau >= 1) { const int n = (tau - 1) * 16 + ho;
                TG[(size_t)n * UGP + 1024 + p] = (bf16)f2bf(ccr * lr - cci * li); TG[(size_t)n * UGP + 1088 + p] = (bf16)f2bf(-(ccr * li + cci * lr)); }
            if (tau <= 63) {
                float kv[16];
#pragma unroll
                for (int q = 0; q < 4; ++q) { const f32x4 t4 = *(const LAS f32x4*)(Kt + ho * 16 + 4 * q); kv[4 * q] = t4[0]; kv[4 * q + 1] = t4[1]; kv[4 * q + 2] = t4[2]; kv[4 * q + 3] = t4[3]; }
                u32x4 o0, o1; o0.x = pk2(kv[0], kv[1]); o0.y = pk2(kv[2], kv[3]); o0.z = pk2(kv[4], kv[5]); o0.w = pk2(kv[6], kv[7]); o1.x = pk2(kv[8], kv[9]); o1.y = pk2(kv[10], kv[11]); o1.z = pk2(kv[12], kv[13]); o1.w = pk2(kv[14], kv[15]);
                const int to = p;
                if (to >= tau) { bf16* d = TG + (size_t)(to * 16 + ho) * UGP + (to - tau) * 16; *(u32x4*)d = o0; *(u32x4*)(d + 8) = o1; }
                if (tau >= 1 && to + tau <= 63) { bf16* d = TG + (size_t)(to * 16 + ho) * UGP + (to + tau) * 16; const u32x4 z = (u32x4){0u, 0u, 0u, 0u}; *(u32x4*)d = z; *(u32x4*)(d + 8) = z; }
            }
        }
    }
}

__device__ __forceinline__ void route_finish(const float (&a)[20], float ssum, int m, bool act, const float* gb_, const float* rb_, int* tokb, float* tokr, float* tokw, LAS int* hist) {
        const float rstd = 1.f / sqrtf(ssum * (1.f / D) + RMS_EPS);
        float lg0 = a[0] * rstd + gb_[0], lg1 = a[1] * rstd + gb_[1], lg2 = a[2] * rstd + gb_[2], lg3 = a[3] * rstd + gb_[3];
        int gs = 0; float gm = lg0;
        if (lg1 > gm) { gm = lg1; gs = 1; } if (lg2 > gm) { gm = lg2; gs = 2; } if (lg3 > gm) { gm = lg3; gs = 3; }
        const float gwt = 1.f / (__expf(lg0 - gm) + __expf(lg1 - gm) + __expf(lg2 - gm) + __expf(lg3 - gm));
        float q0 = a[4], q1 = a[5], q2 = a[6], q3 = a[7], q4 = a[8], q5 = a[9], q6 = a[10], q7 = a[11], q8 = a[12], q9 = a[13], q10 = a[14], q11 = a[15], q12 = a[16], q13 = a[17], q14 = a[18], q15 = a[19];
        asm volatile("" : "+v"(q0), "+v"(q1), "+v"(q2), "+v"(q3), "+v"(q4), "+v"(q5), "+v"(q6), "+v"(q7));
        asm volatile("" : "+v"(q8), "+v"(q9), "+v"(q10), "+v"(q11), "+v"(q12), "+v"(q13), "+v"(q14), "+v"(q15));
        float e0 = gs == 0 ? q0 : gs == 1 ? q4 : gs == 2 ? q8 : q12;
        float e1 = gs == 0 ? q1 : gs == 1 ? q5 : gs == 2 ? q9 : q13;
        float e2 = gs == 0 ? q2 : gs == 1 ? q6 : gs == 2 ? q10 : q14;
        float e3 = gs == 0 ? q3 : gs == 1 ? q7 : gs == 2 ? q11 : q15;
        e0 = e0 * rstd + rb_[gs * 4 + 0]; e1 = e1 * rstd + rb_[gs * 4 + 1]; e2 = e2 * rstd + rb_[gs * 4 + 2]; e3 = e3 * rstd + rb_[gs * 4 + 3];
        int t1 = 0; float v1 = e0;
        if (e1 > v1) { v1 = e1; t1 = 1; } if (e2 > v1) { v1 = e2; t1 = 2; } if (e3 > v1) { v1 = e3; t1 = 3; }
        int t2 = -1; float v2 = -3.0e38f;
        if (t1 != 0 && e0 > v2) { v2 = e0; t2 = 0; } if (t1 != 1 && e1 > v2) { v2 = e1; t2 = 1; } if (t1 != 2 && e2 > v2) { v2 = e2; t2 = 2; } if (t1 != 3 && e3 > v2) { v2 = e3; t2 = 3; }
        const float p2 = __expf(v2 - v1), w1 = gwt / (1.f + p2), w2 = gwt * p2 / (1.f + p2);
        const int lo = t1 < t2 ? t1 : t2, hi = t1 < t2 ? t2 : t1; const float wlo = t1 < t2 ? w1 : w2, whi = t1 < t2 ? w2 : w1;
        const int pi = lo == 0 ? hi - 1 : (lo == 1 ? hi + 1 : 5), bk = gs * 6 + pi;
        if (act) { tokb[m] = bk; tokr[m] = rstd; tokw[2 * m] = wlo; tokw[2 * m + 1] = whi; __hip_atomic_fetch_add(hist + bk, 1, __ATOMIC_RELAXED, __HIP_MEMORY_SCOPE_WORKGROUP); }
}
__device__ __forceinline__ void ph_route(const Ctx& F0, int l) {
    const Ctx F = launder(F0);
    constexpr int WLD = 1032;
    LAS bf16* Wh = (LAS bf16*)F.lds;
    LAS bf16* Wlo = Wh + 20 * WLD;
    LAS float* LG = (LAS float*)(F.lds + 4 * 20 * WLD);
    LAS int* hist = (LAS int*)(F.lds + 4 * 20 * WLD + 8 * 320 * 4);
    const float* g2 = F.in[18] + l * D;
    const f32x4* gw4 = (const f32x4*)(F.in[19] + (size_t)l * D * 4); const f32x4* rw4 = (const f32x4*)(F.in[21] + (size_t)l * 4 * D * 4);
    const float* gb_ = F.in[20] + l * 4; const float* rb_ = F.in[22] + l * 16;
    for (int idx = F.tid; idx < D * 5; idx += NTHREADS) { const int k = idx % D, q = idx / D;
        f32x4 v = (q == 0) ? gw4[k] : rw4[(q - 1) * D + k]; v = v * g2[k];
#pragma unroll
        for (int i = 0; i < 4; ++i) { const unsigned h = f2bf(v[i]); Wh[(q * 4 + i) * WLD + k] = (bf16)h; Wlo[(q * 4 + i) * WLD + k] = (bf16)f2bf(v[i] - bf2f(h)); } }
    if (F.tid < 32) hist[F.tid] = 0;
    __syncthreads();
    int* tokb = (int*)(F.ws + WS_TOKB); float* tokr = (float*)(F.ws + WS_TOKR); float* tokw = (float*)(F.ws + WS_TOKW);
    const int i16 = F.lane & 15, kq = F.lane >> 4, m0 = F.vcu * 128 + F.wave * 16;
    const u32x4* xr = (const u32x4*)(P_XB(F) + (size_t)(m0 + i16) * D) + kq;
    const int c1 = 16 + (i16 & 3);
    const LAS bf16* bh0 = Wh + i16 * WLD + 8 * kq; const LAS bf16* bl0 = Wlo + i16 * WLD + 8 * kq;
    const LAS bf16* bh1 = Wh + c1 * WLD + 8 * kq;  const LAS bf16* bl1 = Wlo + c1 * WLD + 8 * kq;
    f32x4 acc0 = (f32x4){0.f, 0.f, 0.f, 0.f}, acc1 = acc0; float ss = 0.f;
#pragma unroll 4
    for (int c = 0; c < 32; ++c) {
        const u32x4 xa = xr[4 * c];
        const float x0 = bf2f(xa.x & 0xffffu), x1 = __builtin_bit_cast(float, xa.x & 0xffff0000u), x2 = bf2f(xa.y & 0xffffu), x3 = __builtin_bit_cast(float, xa.y & 0xffff0000u);
        const float x4 = bf2f(xa.z & 0xffffu), x5 = __builtin_bit_cast(float, xa.z & 0xffff0000u), x6 = bf2f(xa.w & 0xffffu), x7 = __builtin_bit_cast(float, xa.w & 0xffff0000u);
        ss += ((x0 * x0 + x1 * x1) + (x2 * x2 + x3 * x3)) + ((x4 * x4 + x5 * x5) + (x6 * x6 + x7 * x7));
        const pg8::bf16x8 av = __builtin_bit_cast(pg8::bf16x8, xa);
        const pg8::bf16x8 h0 = *(const LAS pg8::bf16x8*)(bh0 + 32 * c), l0 = *(const LAS pg8::bf16x8*)(bl0 + 32 * c);
        const pg8::bf16x8 h1 = *(const LAS pg8::bf16x8*)(bh1 + 32 * c), l1 = *(const LAS pg8::bf16x8*)(bl1 + 32 * c);
        acc0 = __builtin_amdgcn_mfma_f32_16x16x32_bf16(av, h0, acc0, 0, 0, 0); acc1 = __builtin_amdgcn_mfma_f32_16x16x32_bf16(av, h1, acc1, 0, 0, 0);
        acc0 = __builtin_amdgcn_mfma_f32_16x16x32_bf16(av, l0, acc0, 0, 0, 0); acc1 = __builtin_amdgcn_mfma_f32_16x16x32_bf16(av, l1, acc1, 0, 0, 0);
    }
    ss += xshfl<16>(ss);
    { const unsigned u = __builtin_bit_cast(unsigned, ss); auto r = __builtin_amdgcn_permlane32_swap(u, u, false, false);
      ss = __builtin_bit_cast(float, (unsigned)r[0]) + __builtin_bit_cast(float, (unsigned)r[1]); }
    LAS float* lg = LG + F.wave * 320;
#pragma unroll
    for (int r = 0; r < 4; ++r) { lg[(4 * kq + r) * 20 + i16] = acc0[r]; if (i16 < 4) lg[(4 * kq + r) * 20 + 16 + i16] = acc1[r]; }
    asm volatile("s_waitcnt lgkmcnt(0)" ::: "memory");
    float a[20];
#pragma unroll
    for (int j = 0; j < 5; ++j) { const f32x4 t4 = *(const LAS f32x4*)(lg + i16 * 20 + 4 * j); a[4 * j] = t4[0]; a[4 * j + 1] = t4[1]; a[4 * j + 2] = t4[2]; a[4 * j + 3] = t4[3]; }
    route_finish(a, ss, m0 + i16, kq == 0, gb_, rb_, tokb, tokr, tokw, hist);
    __syncthreads();
    if (F.tid < 24) __hip_atomic_store((int*)(F.ws + WS_WGCNT) + F.vcu * 24 + F.tid, hist[F.tid], __ATOMIC_RELAXED, __HIP_MEMORY_SCOPE_AGENT);
}
__device__ __forceinline__ void ph_place(const Ctx& F0) {
    const Ctx F = launder(F0);
    LAS int* ptot = (LAS int*)F.lds;
    LAS int* pbef = ptot + 512;
    LAS int* bstart = pbef + 512;
    LAS int* btot = bstart + 32;
    LAS int* carry = btot + 32;
    LAS int* rowidx = carry + 32;
    const int* wgcnt = (const int*)(F.ws + WS_WGCNT);
    int* rowtok = (int*)(F.ws + WS_ROWTOK); float* roww = (float*)(F.ws + WS_ROWW); int* tileb = (int*)(F.ws + WS_TILEB);
    const int* tokb = (const int*)(F.ws + WS_TOKB); const float* tokr = (const float*)(F.ws + WS_TOKR); const float* tokw = (const float*)(F.ws + WS_TOKW);
    { const int p = F.tid >> 5, b = F.tid & 31; int tot = 0, bef = 0;
      if (b < 24) for (int v = p * 16; v < p * 16 + 16; ++v) { const int c = wgcnt[v * 24 + b]; tot += c; if (v < F.vcu) bef += c; }
      ptot[p * 32 + b] = tot; pbef[p * 32 + b] = bef; }
    __syncthreads();
    if (F.tid < 32) { int tot = 0, bef = 0; for (int p = 0; p < 16; ++p) { tot += ptot[p * 32 + F.tid]; bef += pbef[p * 32 + F.tid]; } btot[F.tid] = tot; carry[F.tid] = bef; }
    __syncthreads();
    if (F.tid == 0) { int s = 0; for (int b = 0; b < 24; ++b) { bstart[b] = s; s += (btot[b] + 255) & ~255; } bstart[24] = s; }
    __syncthreads();
    if (F.tid < 24) carry[F.tid] += bstart[F.tid];
    if (F.vcu == 0) {
        if (F.tid == 0) tileb[0] = bstart[24] >> 8;
        for (int b = 0; b < 24; ++b) { const int s = bstart[b], e = bstart[b + 1];
            for (int t = (s >> 8) + F.tid; t < (e >> 8); t += NTHREADS) tileb[1 + t] = b;
            for (int r = s + btot[b] + F.tid; r < e; r += NTHREADS) __hip_atomic_store(rowtok + r, -1, __ATOMIC_RELAXED, __HIP_MEMORY_SCOPE_AGENT); }
    }
    __syncthreads();
    if (F.wave == 0) {
        for (int pass = 0; pass < 2; ++pass) { const int i = pass * 64 + F.lane, bi = tokb[F.vcu * 128 + i]; int row = 0;
#pragma unroll 1
            for (int b = 0; b < 24; ++b) { const unsigned long long mask = __ballot(bi == b); const int c = carry[b];
                if (bi == b) row = c + __builtin_popcountll(mask & ((1ull << F.lane) - 1ull));
                asm volatile("s_waitcnt lgkmcnt(0)" ::: "memory");
                if (F.lane == 0) carry[b] = c + __builtin_popcountll(mask);
                asm volatile("s_waitcnt lgkmcnt(0)" ::: "memory"); }
            rowidx[i] = row; }
    }
    __syncthreads();
    bf16* XS = (bf16*)(F.ws + WS_XS);
    for (int i = 0; i < 16; ++i) {
        const int li = F.wave * 16 + i, m = F.vcu * 128 + li, row = rowidx[li]; const float rstd = tokr[m];
        if (F.lane == 0) {
            __hip_atomic_store(rowtok + row, m, __ATOMIC_RELAXED, __HIP_MEMORY_SCOPE_AGENT);
            const unsigned long long w2 = (unsigned long long)__builtin_bit_cast(unsigned, tokw[2 * m]) | ((unsigned long long)__builtin_bit_cast(unsigned, tokw[2 * m + 1]) << 32);
            __hip_atomic_store((unsigned long long*)(roww + 2 * row), w2, __ATOMIC_RELAXED, __HIP_MEMORY_SCOPE_AGENT); }
        if (F.lane == 0) __hip_atomic_store((float*)(F.ws + WS_ROWR) + row, rstd, __ATOMIC_RELAXED, __HIP_MEMORY_SCOPE_AGENT);
        const u32x4* xr = (const u32x4*)(P_XB(F) + (size_t)m * D) + F.lane; u32x4* o16 = (u32x4*)(XS + (size_t)row * D) + F.lane;
        o16[0] = xr[0]; o16[64] = xr[64];
    }
}
struct MoeOrder {
    const int* tileb; int G, c; bool down;
    __device__ __forceinline__ bool next(int i, pg8::Unit& u) const {
        const GAS int* tb_ = (const GAS int*)tileb;
        const int NT = __builtin_amdgcn_readfirstlane(tb_[0]), L = i * G + c; if (L >= NT * 4) return false;
        const int rt = L >> 2, pn = L & 3, b = __builtin_amdgcn_readfirstlane(tb_[1 + rt]);
        if (down) { u.pm = rt; u.pn = b * 4 + pn; u.aux = pn; }
        else { int ea, eb; pair_decode(b % 6, ea, eb); const int e = (b / 6) * 4 + (pn < 2 ? ea : eb); u.pm = rt; u.pn = e * 2 + (pn & 1); u.aux = pn; }
        return true;
    }
};
struct EpiGU {
    static constexpr bool PERM = true;
    bf16* H; const float* roww; const float* rowr;
    __device__ __forceinline__ void operator()(const f32x4 (&acc)[2][2][4][2], const pg8::Unit& u, int wr, int wc, int fr_, int fq_) const {
        const int ln_ = lane_id(), fr = ln_ & 15, fq = ln_ >> 4; (void)fr_; (void)fq_;
        const int row0 = u.pm * 256 + wr * 64 + fr, cl = u.aux * 128 + 16 * wc + 4 * fq, ws = u.aux >> 1;
#pragma unroll
        for (int ai = 0; ai < 2; ++ai)
#pragma unroll
            for (int m = 0; m < 4; ++m) { const int r = row0 + ai * 128 + m * 16; const float rr = rowr[r], w = roww[2 * r + ws] * rr;
#pragma unroll
                for (int bj = 0; bj < 2; ++bj) { const f32x4 g = acc[ai][bj][m][0], up = acc[ai][bj][m][1]; f32x4 a;
#pragma unroll
                    for (int i = 0; i < 4; ++i) { const float gg = g[i] * rr; a[i] = gg * sigmoidf_(gg) * up[i] * w; }
                    u32x2 o; o.x = pg8::cvt_pk_bf16(a[0], a[1]); o.y = pg8::cvt_pk_bf16(a[2], a[3]);
                    *(u32x2*)(H + (size_t)r * 512 + cl + bj * 64) = o; } }
    }
};
struct EpiDown {
    static constexpr bool PERM = true;
    bf16* RB; const int* rowtok;
    __device__ __forceinline__ void operator()(const f32x4 (&acc)[2][2][4][2], const pg8::Unit& u, int wr, int wc, int fr_, int fq_) const {
        const int ln_ = lane_id(), fr = ln_ & 15, fq = ln_ >> 4; (void)fr_; (void)fq_;
        const int row0 = u.pm * 256 + wr * 64 + fr, col0 = u.aux * 256 + wc * 32 + 8 * fq;
#pragma unroll
        for (int ai = 0; ai < 2; ++ai)
#pragma unroll
            for (int m = 0; m < 4; ++m) { const int tok = rowtok[row0 + ai * 128 + m * 16];
                if (tok >= 0) { bf16* rp = RB + (size_t)tok * D + col0;
#pragma unroll
                    for (int bj = 0; bj < 2; ++bj) { const u32x4 x = *(const u32x4*)(rp + bj * 128); const f32x4 a0 = acc[ai][bj][m][0], a1 = acc[ai][bj][m][1]; u32x4 w;
                        w.x = pg8::cvt_pk_bf16(bf2f(x.x & 0xffffu) + a0[0], bf2f(x.x >> 16) + a0[1]); w.y = pg8::cvt_pk_bf16(bf2f(x.y & 0xffffu) + a0[2], bf2f(x.y >> 16) + a0[3]);
                        w.z = pg8::cvt_pk_bf16(bf2f(x.z & 0xffffu) + a1[0], bf2f(x.z >> 16) + a1[1]); w.w = pg8::cvt_pk_bf16(bf2f(x.w & 0xffffu) + a1[2], bf2f(x.w >> 16) + a1[3]);
                        *(u32x4*)(rp + bj * 128) = w; } }
                if (m & 1) asm volatile("" ::: "memory"); }
    }
};

struct SsmOrder { int G, c, mode;
    __device__ __forceinline__ bool next(int i, pg8::Unit& u) const { const int L = i * G + c;
        if (mode == 1) { if (L >= 32) return false; u.pm = L; u.pn = L >> 1; u.aux = 0; return true; }
        if (L >= 128) return false; const int g = L >> 3; u.pm = g * 2 + ((L >> 2) & 1); u.pn = g * 4 + (L & 3); u.aux = L & 3; return true; } };
struct HalfOrder { int L;
    __device__ __forceinline__ bool next(int i, pg8::Unit& u) const { if (i > 0 || L < 0 || L >= 128) return false; u.pm = L; u.pn = 0; u.aux = 0; return true; } };
struct EpiZ { static constexpr bool PERM = false; float* ZB;
    __device__ __forceinline__ void operator()(const f32x4 (&acc)[2][2][4][2], const pg8::Unit& u, int wr, int wc, int fr_, int fq_) const {
        const int ln_ = lane_id(), fr = ln_ & 15, fq = ln_ >> 4; (void)fr_; (void)fq_;
        const int row0 = u.pm * 256 + wr * 64 + fr, col0 = wc * 32 + 4 * fq;
#pragma unroll
        for (int ai = 0; ai < 2; ++ai)
#pragma unroll
            for (int m = 0; m < 4; ++m)
#pragma unroll
                for (int n = 0; n < 2; ++n) *(f32x4*)(ZB + (size_t)(row0 + ai * 128 + m * 16) * 128 + col0 + n * 16) = acc[ai][0][m][n];
    } };
struct EpiSsm2 { static constexpr bool PERM = true; const bf16* UG; bf16* YS; const float* dvec;
    __device__ __forceinline__ void operator()(const f32x4 (&acc)[2][2][4][2], const pg8::Unit& u, int wr, int wc, int fr_, int fq_) const {
        const int ln_ = lane_id(), fr = ln_ & 15, fq = ln_ >> 4; (void)fr_; (void)fq_;
        const int g = u.pm >> 1, cr0 = (u.pm & 1) * 256 + wr * 64 + fr;
#pragma unroll
        for (int bj = 0; bj < 2; ++bj) { const int n0 = u.aux * 256 + bj * 128 + wc * 32 + 8 * fq, to = n0 >> 4, ho0 = n0 & 15;
            const f32x4 d0 = *(const f32x4*)(dvec + g * 16 + ho0), d1 = *(const f32x4*)(dvec + g * 16 + ho0 + 4);
#pragma unroll
            for (int ai = 0; ai < 2; ++ai)
#pragma unroll
                for (int m = 0; m < 4; ++m) { const int cr = cr0 + ai * 128 + m * 16;
                    const u32x4 uu = *(const u32x4*)(UG + ((size_t)(g * 512 + cr)) * UGP + n0);
                    const f32x4 a0 = acc[ai][bj][m][0], a1 = acc[ai][bj][m][1]; float y[8];
                    y[0] = gelu_tanh(a0[0] + d0[0] * bf2f(uu.x & 0xffffu)); y[1] = gelu_tanh(a0[1] + d0[1] * bf2f(uu.x >> 16));
                    y[2] = gelu_tanh(a0[2] + d0[2] * bf2f(uu.y & 0xffffu)); y[3] = gelu_tanh(a0[3] + d0[3] * bf2f(uu.y >> 16));
                    y[4] = gelu_tanh(a1[0] + d1[0] * bf2f(uu.z & 0xffffu)); y[5] = gelu_tanh(a1[1] + d1[1] * bf2f(uu.z >> 16));
                    y[6] = gelu_tanh(a1[2] + d1[2] * bf2f(uu.w & 0xffffu)); y[7] = gelu_tanh(a1[3] + d1[3] * bf2f(uu.w >> 16));
                    u32x4 w; w.x = pg8::cvt_pk_bf16(y[0], y[1]); w.y = pg8::cvt_pk_bf16(y[2], y[3]); w.z = pg8::cvt_pk_bf16(y[4], y[5]); w.w = pg8::cvt_pk_bf16(y[6], y[7]);
                    *(u32x4*)(YS + ((size_t)cr * 64 + to) * 256 + g * 16 + ho0) = w; } }
    } };
struct EpiGluE { static constexpr bool PERM = true; const bf16* YS; bf16* YMIX; const float* gb;
    __device__ __forceinline__ void operator()(const f32x4 (&acc)[2][2][4][2], const pg8::Unit& u, int wr, int wc, int fr_, int fq_) const {
        const int ln_ = lane_id(), fr = ln_ & 15, fq = ln_ >> 4; (void)fr_; (void)fq_;
        const int row0 = u.pm * 256 + wr * 64 + fr;
#pragma unroll
        for (int bj = 0; bj < 2; ++bj) { const int n0 = bj * 128 + wc * 32 + 8 * fq; const f32x4 b0 = *(const f32x4*)(gb + n0), b1 = *(const f32x4*)(gb + n0 + 4);
#pragma unroll
            for (int ai = 0; ai < 2; ++ai)
#pragma unroll
                for (int m = 0; m < 4; ++m) { const size_t r = (size_t)(row0 + ai * 128 + m * 16); const u32x4 yy = *(const u32x4*)(YS + r * 256 + n0);
                    const f32x4 a0 = acc[ai][bj][m][0] + b0, a1 = acc[ai][bj][m][1] + b1; float o[8];
                    o[0] = bf2f(yy.x & 0xffffu) * sigmoidf_(a0[0]); o[1] = bf2f(yy.x >> 16) * sigmoidf_(a0[1]); o[2] = bf2f(yy.y & 0xffffu) * sigmoidf_(a0[2]); o[3] = bf2f(yy.y >> 16) * sigmoidf_(a0[3]);
                    o[4] = bf2f(yy.z & 0xffffu) * sigmoidf_(a1[0]); o[5] = bf2f(yy.z >> 16) * sigmoidf_(a1[1]); o[6] = bf2f(yy.w & 0xffffu) * sigmoidf_(a1[2]); o[7] = bf2f(yy.w >> 16) * sigmoidf_(a1[3]);
                    u32x4 w; w.x = pg8::cvt_pk_bf16(o[0], o[1]); w.y = pg8::cvt_pk_bf16(o[2], o[3]); w.z = pg8::cvt_pk_bf16(o[4], o[5]); w.w = pg8::cvt_pk_bf16(o[6], o[7]);
                    *(u32x4*)(YMIX + r * 1024 + n0) = w; } }
    } };
struct EpiPoolE { static constexpr bool PERM = true; bf16* YMIX; const float* pb; const float* ps;
    __device__ __forceinline__ void operator()(const f32x4 (&acc)[2][2][4][2], const pg8::Unit& u, int wr, int wc, int fr_, int fq_) const {
        const int ln_ = lane_id(), fr = ln_ & 15, fq = ln_ >> 4; (void)fr_; (void)fq_;
        const int row0 = u.pm * 256 + wr * 64 + fr;
#pragma unroll
        for (int bj = 0; bj < 2; ++bj) { const int n0 = bj * 128 + wc * 32 + 8 * fq; const f32x4 b0 = *(const f32x4*)(pb + n0), b1 = *(const f32x4*)(pb + n0 + 4), s0 = *(const f32x4*)(ps + n0), s1 = *(const f32x4*)(ps + n0 + 4);
#pragma unroll
            for (int ai = 0; ai < 2; ++ai)
#pragma unroll
                for (int m = 0; m < 4; ++m) { const size_t r = (size_t)(row0 + ai * 128 + m * 16);
                    const f32x4 a0 = (acc[ai][bj][m][0] + b0) * s0, a1 = (acc[ai][bj][m][1] + b1) * s1;
                    u32x4 w; w.x = pg8::cvt_pk_bf16(a0[0], a0[1]); w.y = pg8::cvt_pk_bf16(a0[2], a0[3]); w.z = pg8::cvt_pk_bf16(a1[0], a1[1]); w.w = pg8::cvt_pk_bf16(a1[2], a1[3]);
                    *(u32x4*)(YMIX + r * 1024 + 256 + n0) = w; } }
    } };
__device__ __forceinline__ void ph_ssm_scan(const Ctx& F0, int l) {
    const Ctx F = launder(F0);
    for (int it = F.vcu + F.G * F.wave; it < SGN * NB; it += F.G * NWAVES) {
        const int g = it >> 3, b = it & 7, p = F.lane;
        const float are = F.in[4][(l * SGN + g) * SP + p], aim = F.in[5][(l * SGN + g) * SP + p], dt = expf(F.in[6][l * SGN + g]);
        float sn, cs; sincosf(aim * dt * 64.f, &sn, &cs); const float mg = expf(are * dt * 64.f), lr = mg * cs, li = mg * sn;
        const float* Z = (const float*)(F.ws + WS_ZB) + ((size_t)g * 512 + b * 64) * 128;
        bf16* U = P_UG(F) + ((size_t)g * 512 + b * 64) * UGP + 1024;
        float sr = 0.f, si = 0.f;
#pragma unroll 1
        for (int c0 = 0; c0 < 64; c0 += 16) {
            float zr[16], zi[16];
#pragma unroll
            for (int j = 0; j < 16; ++j) { zr[j] = Z[(c0 + j) * 128 + p]; zi[j] = Z[(c0 + j) * 128 + 64 + p]; }
#pragma unroll
            for (int j = 0; j < 16; ++j) {
                U[(size_t)(c0 + j) * UGP + p] = (bf16)f2bf(sr); U[(size_t)(c0 + j) * UGP + 64 + p] = (bf16)f2bf(si);
                const float nr = lr * sr - li * si + zr[j], ni = lr * si + li * sr + zi[j]; sr = nr; si = ni; }
        }
    }
}

namespace moba {
using bf16x8 = __attribute__((ext_vector_type(8))) short;
using s16x4 = __attribute__((ext_vector_type(4))) short;
using f32x16 = __attribute__((ext_vector_type(16))) float;
typedef short v4i16_t __attribute__((ext_vector_type(4)));
typedef float f32x2_t __attribute__((ext_vector_type(2))); typedef __bf16 bf16x2_t __attribute__((ext_vector_type(2)));
constexpr int L_K = 0, L_V = 49152, L_TB = 98304, L_KM = L_TB + 4 * 768 * 4, L_END = L_KM + 16 * 64 * 4;
__device__ __forceinline__ unsigned cvtpk(float lo, float hi) { f32x2_t v = {lo, hi}; bf16x2_t b = __builtin_convertvector(v, bf16x2_t); return __builtin_bit_cast(unsigned, b); }
__device__ __forceinline__ s16x4 vtr(const LAS char* p) { return __builtin_bit_cast(s16x4, __builtin_amdgcn_ds_read_tr16_b64_v4i16((LAS v4i16_t*)p)); }
__device__ __forceinline__ float hmax(float v) { const unsigned u = __builtin_bit_cast(unsigned, v); auto r = __builtin_amdgcn_permlane32_swap(u, u, false, false); return fmaxf(__builtin_bit_cast(float, (unsigned)r[0]), __builtin_bit_cast(float, (unsigned)r[1])); }
__device__ __forceinline__ float hsum(float v) { const unsigned u = __builtin_bit_cast(unsigned, v); auto r = __builtin_amdgcn_permlane32_swap(u, u, false, false); return __builtin_bit_cast(float, (unsigned)r[0]) + __builtin_bit_cast(float, (unsigned)r[1]); }

__device__ __forceinline__ void unit(int wave_, int b, int h, int qb, const bf16* Q, const bf16* K, const bf16* V, bf16* O, const float* KMP, const float* BT, LAS char* lds) {
    int lane_ = lane_id(); asm volatile("" : "+v"(lane_)); asm volatile("" : "+s"(b), "+s"(h), "+s"(qb), "+s"(wave_));
    const int wid = wave_, lane = lane_, tid = wid * 64 + lane, r32 = lane & 31, hi = lane >> 5;
    const int NT = 4 * qb + 4, q0 = qb * 256; const size_t rowbase = (size_t)b * SEQ;
    LAS float* tb = (LAS float*)(lds + L_TB); LAS float* km = (LAS float*)(lds + L_KM);
    const float bfar = BT[h * 132 + 128];
    const bf16* ksrc = K + (rowbase + lane) * 512 + h * 64 + wid * 8;
    const bf16* vsrc = V + (rowbase + 16 * (wid & 3) + (lane >> 2)) * 512 + h * 64 + (wid >> 2) * 32 + (lane & 3) * 8;
    u32x4 kreg0 = *(const u32x4*)ksrc, vreg0 = *(const u32x4*)vsrc, kreg1 = *(const u32x4*)(ksrc + (size_t)64 * 512), vreg1 = *(const u32x4*)(vsrc + (size_t)64 * 512);
    u32x4 kreg2 = *(const u32x4*)(ksrc + (size_t)128 * 512), vreg2 = *(const u32x4*)(vsrc + (size_t)128 * 512), kreg3 = *(const u32x4*)(ksrc + (size_t)192 * 512), vreg3 = *(const u32x4*)(vsrc + (size_t)192 * 512);
    bf16x8 qr[4];
    { const bf16* qw = Q + (rowbase + q0 + wid * 32 + r32) * 512 + h * 64 + hi * 8;
#pragma unroll
      for (int d0 = 0; d0 < 4; ++d0) qr[d0] = *(const bf16x8*)(qw + d0 * 16); }
    __syncthreads();
    unsigned selmask = 1u << qb;
    { float g[16];
#pragma unroll
      for (int j = 0; j < 16; ++j) g[j] = 0.f;
#pragma unroll
      for (int d0 = 0; d0 < 4; ++d0)
#pragma unroll
          for (int e = 0; e < 8; ++e) { const float qf = bf2f((unsigned)(unsigned short)qr[d0][e]);
#pragma unroll
              for (int j = 0; j < 16; ++j) g[j] += qf * km[j * 64 + d0 * 16 + hi * 8 + e]; }
#pragma unroll
      for (int j = 0; j < 16; ++j) g[j] = hsum(g[j]);
#pragma unroll
      for (int s = 0; s < 3; ++s) { float bv = -3.0e38f; int bi = -1;
#pragma unroll
          for (int j = 0; j < 16; ++j) { const bool ok = (j < qb) && !((selmask >> j) & 1u) && (g[j] > bv); bv = ok ? g[j] : bv; bi = ok ? j : bi; }
          if (bi >= 0) selmask |= 1u << bi; } }
    { LAS char* kd = lds + L_K + wid * 1024 + lane * 16; LAS char* vd = lds + L_V + wid * 1024 + lane * 16;
      *(LAS u32x4*)kd = kreg0; *(LAS u32x4*)vd = vreg0; *(LAS u32x4*)(kd + 8192) = kreg1; *(LAS u32x4*)(vd + 8192) = vreg1;
      *(LAS u32x4*)(kd + 16384) = kreg2; *(LAS u32x4*)(vd + 16384) = vreg2; *(LAS u32x4*)(kd + 24576) = kreg3; *(LAS u32x4*)(vd + 24576) = vreg3; }
    __syncthreads();
    const int qrel = wid * 32 + r32;
    const LAS char* kp0 = lds + L_K + hi * 1024 + r32 * 16;
    const LAS char* vp0 = lds + L_V + ((lane >> 4) & 1) * 32 + (lane & 3) * 8 + (4 * hi + ((lane & 15) >> 2)) * 64;
    float mref = 0.f, l = 0.f; f32x16 o0 = f32x16{}, o1 = f32x16{};
#define MOBA_CVEC(TT) f32x16 cvec; do { const float ci_ = ((selmask >> ((TT) >> 2)) & 1u) ? (bfar - mref) : -1.0e30f; _Pragma("unroll") for (int r = 0; r < 16; ++r) cvec[r] = ci_; } while (0)
#define MOBA_QK(P0, P1, KB) do { { const bf16x8 a0 = *(const LAS bf16x8*)(kp0 + (KB)), a1 = *(const LAS bf16x8*)(kp0 + (KB) + 512); \
          P0 = __builtin_amdgcn_mfma_f32_32x32x16_bf16(a0, qr[0], cvec, 0, 0, 0); P1 = __builtin_amdgcn_mfma_f32_32x32x16_bf16(a1, qr[0], cvec, 0, 0, 0); } \
        _Pragma("unroll") for (int d0 = 1; d0 < 4; ++d0) { const bf16x8 a0 = *(const LAS bf16x8*)(kp0 + (KB) + d0 * 2048), a1 = *(const LAS bf16x8*)(kp0 + (KB) + d0 * 2048 + 512); \
            P0 = __builtin_amdgcn_mfma_f32_32x32x16_bf16(a0, qr[d0], P0, 0, 0, 0); P1 = __builtin_amdgcn_mfma_f32_32x32x16_bf16(a1, qr[d0], P1, 0, 0, 0); } } while (0)
#define MOBA_NEARMAX(P0, P1, TT, OUT) do { const int jn_ = (TT) - (NT - 8); if (jn_ >= 0) { const int A_ = qrel - 64 * (jn_ - 4) - 4 * hi + 256, s_ = 767 - A_, c_ = s_ & 3; \
            const LAS f32x4* t4 = (const LAS f32x4*)(tb + c_ * 768 + (s_ - c_)); \
            _Pragma("unroll") for (int g = 0; g < 4; ++g) { const f32x4 x0 = t4[2 * g], x1 = t4[2 * g + 8]; \
                _Pragma("unroll") for (int j = 0; j < 4; ++j) { P0[4 * g + j] += x0[j]; P1[4 * g + j] += x1[j]; } } } \
        float ra = __builtin_fmaxf(__builtin_fmaxf(P0[0], P0[1]), P1[0]), rb = __builtin_fmaxf(__builtin_fmaxf(P0[2], P0[3]), P1[1]); \
        ra = __builtin_fmaxf(__builtin_fmaxf(ra, P1[2]), P1[3]); \
        _Pragma("unroll") for (int r = 4; r < 16; r += 4) { ra = __builtin_fmaxf(__builtin_fmaxf(ra, P0[r]), P0[r + 1]); rb = __builtin_fmaxf(__builtin_fmaxf(rb, P0[r + 2]), P0[r + 3]); \
            ra = __builtin_fmaxf(__builtin_fmaxf(ra, P1[r]), P1[r + 1]); rb = __builtin_fmaxf(__builtin_fmaxf(rb, P1[r + 2]), P1[r + 3]); } \
        OUT = hmax(__builtin_fmaxf(ra, rb)); } while (0)
#define MOBA_STEP(PC0, PC1, PN0, PN1, TT, KBN, VBC, HASN) do { \
        bf16x8 vf[8], kf[8]; \
        if (HASN) { _Pragma("unroll") for (int d0 = 0; d0 < 4; ++d0) { kf[2 * d0] = *(const LAS bf16x8*)(kp0 + (KBN) + d0 * 2048); kf[2 * d0 + 1] = *(const LAS bf16x8*)(kp0 + (KBN) + d0 * 2048 + 512); } } \
        __builtin_amdgcn_sched_barrier(0); \
        if (__any(rm > 8.f)) { const float dl = __builtin_fmaxf(rm, 0.f), alpha = __builtin_amdgcn_exp2f(-dl); mref += dl; l *= alpha; \
            _Pragma("unroll") for (int r = 0; r < 16; ++r) { PC0[r] -= dl; PC1[r] -= dl; o0[r] *= alpha; o1[r] *= alpha; } } \
        if (HASN) { MOBA_CVEC((TT) + 1);       \
                    PN0 = __builtin_amdgcn_mfma_f32_32x32x16_bf16(kf[0], qr[0], cvec, 0, 0, 0); PN1 = __builtin_amdgcn_mfma_f32_32x32x16_bf16(kf[1], qr[0], cvec, 0, 0, 0); \
                    _Pragma("unroll") for (int d0 = 1; d0 < 4; ++d0) { PN0 = __builtin_amdgcn_mfma_f32_32x32x16_bf16(kf[2 * d0], qr[d0], PN0, 0, 0, 0); PN1 = __builtin_amdgcn_mfma_f32_32x32x16_bf16(kf[2 * d0 + 1], qr[d0], PN1, 0, 0, 0); } } \
        { const LAS char* vp = vp0 + (VBC); \
        _Pragma("unroll") for (int k = 0; k < 4; ++k) { \
            const s16x4 lo0 = vtr(vp + k * 1024), hi0 = vtr(vp + k * 1024 + 512), lo1 = vtr(vp + 4096 + k * 1024), hi1 = vtr(vp + 4096 + k * 1024 + 512); \
            vf[2 * k] = (bf16x8){lo0[0], lo0[1], lo0[2], lo0[3], hi0[0], hi0[1], hi0[2], hi0[3]}; vf[2 * k + 1] = (bf16x8){lo1[0], lo1[1], lo1[2], lo1[3], hi1[0], hi1[1], hi1[2], hi1[3]}; } } \
        __builtin_amdgcn_sched_barrier(0); \
        float s0 = 0.f, s1 = 0.f; u32x4 pw[4]; \
        _Pragma("unroll") for (int r = 0; r < 16; ++r) { PC0[r] = __builtin_amdgcn_exp2f(PC0[r]); PC1[r] = __builtin_amdgcn_exp2f(PC1[r]); s0 += PC0[r]; s1 += PC1[r]; } \
        l += s0 + s1; \
        _Pragma("unroll") for (int q = 0; q < 4; ++q) { pw[0][q] = cvtpk(PC0[2 * q], PC0[2 * q + 1]); pw[1][q] = cvtpk(PC0[8 + 2 * q], PC0[9 + 2 * q]); pw[2][q] = cvtpk(PC1[2 * q], PC1[2 * q + 1]); pw[3][q] = cvtpk(PC1[8 + 2 * q], PC1[9 + 2 * q]); } \
        _Pragma("unroll") for (int k = 0; k < 4; ++k) { const bf16x8 pa = __builtin_bit_cast(bf16x8, pw[k]); \
            o0 = __builtin_amdgcn_mfma_f32_32x32x16_bf16(vf[2 * k], pa, o0, 0, 0, 0); o1 = __builtin_amdgcn_mfma_f32_32x32x16_bf16(vf[2 * k + 1], pa, o1, 0, 0, 0); } \
        if (HASN) MOBA_NEARMAX(PN0, PN1, (TT) + 1, rm); \
    } while (0)
    f32x16 pa0, pa1, pb0, pb1; float rm;
    { MOBA_CVEC(0); MOBA_QK(pa0, pa1, 0); } MOBA_NEARMAX(pa0, pa1, 0, rm);
    const int NP = NT >> 1;
    int bufc = 0, bufn = 16384, bufw = 32768;
#pragma unroll 1
    for (int ip = 0; ip < NP; ++ip) {
        const int t = 2 * ip;
        if (ip + 2 < NP) { kreg0 = *(const u32x4*)(ksrc + (size_t)(t + 4) * 64 * 512); vreg0 = *(const u32x4*)(vsrc + (size_t)(t + 4) * 64 * 512);
                           kreg1 = *(const u32x4*)(ksrc + (size_t)(t + 5) * 64 * 512); vreg1 = *(const u32x4*)(vsrc + (size_t)(t + 5) * 64 * 512); }
        MOBA_STEP(pa0, pa1, pb0, pb1, t, bufc + 8192, bufc, true);
        MOBA_STEP(pb0, pb1, pa0, pa1, t + 1, bufn, bufc + 8192, (t + 2 < NT));
        if (ip + 2 < NP) { LAS char* kd = lds + L_K + bufw + wid * 1024 + lane * 16; LAS char* vd = lds + L_V + bufw + wid * 1024 + lane * 16;
            *(LAS u32x4*)kd = kreg0; *(LAS u32x4*)vd = vreg0; *(LAS u32x4*)(kd + 8192) = kreg1; *(LAS u32x4*)(vd + 8192) = vreg1; }
        __syncthreads();
        { const int tmp = bufc; bufc = bufn; bufn = bufw; bufw = tmp; }
    }
#undef MOBA_CVEC
#undef MOBA_QK
#undef MOBA_NEARMAX
#undef MOBA_STEP
    const float inv = 1.f / hsum(l);
    bf16* orow = O + (rowbase + q0 + wid * 32 + r32) * 1024 + 512 + h * 64 + 8 * hi;
#pragma unroll
    for (int d0 = 0; d0 < 2; ++d0)
#pragma unroll
        for (int gp = 0; gp < 2; ++gp) { const f32x16& oo = d0 ? o1 : o0; const int ga = 8 * gp, gb = 8 * gp + 4;
            unsigned ax = cvtpk(oo[ga] * inv, oo[ga + 1] * inv), ay = cvtpk(oo[ga + 2] * inv, oo[ga + 3] * inv), bx = cvtpk(oo[gb] * inv, oo[gb + 1] * inv), by = cvtpk(oo[gb + 2] * inv, oo[gb + 3] * inv);
            { auto r = __builtin_amdgcn_permlane32_swap(ax, bx, false, false); ax = r[0]; bx = r[1]; }
            { auto r = __builtin_amdgcn_permlane32_swap(ay, by, false, false); ay = r[0]; by = r[1]; }
            *(u32x4*)(orow + 32 * d0 + 16 * gp) = (u32x4){ax, ay, bx, by}; }
}
__device__ __forceinline__ void phase(int wave, int vcu, const bf16* Q, const bf16* K, const bf16* V, bf16* O, const float* KMP, const float* BT, LAS char* lds) {
    if (vcu >= 256) return;
    const int s = vcu & 3, bh = vcu >> 2;
    {
        int lane_ = lane_id(); asm volatile("" : "+v"(lane_)); const int tid = wave * 64 + lane_, b = bh >> 3, h = bh & 7;
        LAS float* tb = (LAS float*)(lds + L_TB); LAS float* km = (LAS float*)(lds + L_KM); const float bfar = BT[h * 132 + 128];
        for (int i = tid; i < 4 * 768; i += NTHREADS) { const int c = i / 768, j = i % 768, src_ = 767 - (j + c), rel = src_ - 256; tb[i] = (src_ < 0 || rel < 0) ? -1.0e30f : (rel < 128 ? BT[h * 132 + rel] - bfar : 0.f); }
        for (int i = tid; i < 16 * 64; i += NTHREADS) { const int j = i >> 6, d = i & 63, pm = b * 16 + j; km[i] = KMP[pm * 512 + h * 64 + d] + KMP[128 * 512 + pm * 512 + h * 64 + d]; }
    }
#pragma unroll 1
    for (int i = 0; i < 4; ++i) { const int qb = (i == 0) ? s : (i == 1) ? 7 - s : (i == 2) ? 8 + s : 15 - s; unit(wave, bh >> 3, bh & 7, qb, Q, K, V, O, KMP, BT, lds); }
}
}

__device__ __forceinline__ void ph_cvt_x(const Ctx& F0) {
    const Ctx F = launder(F0);
    const int gw = F.vcu * NWAVES + F.wave, NGW = F.G * NWAVES; float* rs1 = (float*)(F.ws + WS_RS1);
    for (int m = gw; m < T; m += NGW) {
        const f32x4* xr = (const f32x4*)(F.in[0] + (size_t)m * D) + F.lane;
        f32x4 v[4]; float s = 0.f;
#pragma unroll
        for (int j = 0; j < 4; ++j) { v[j] = xr[64 * j]; s += (v[j].x * v[j].x + v[j].y * v[j].y) + (v[j].z * v[j].z + v[j].w * v[j].w); }
        const float rstd = 1.f / sqrtf(wave_sum(s) * (1.f / D) + RMS_EPS);
        if (F.lane == 0) rs1[m] = rstd;
        unsigned long long* o8 = (unsigned long long*)(P_XB(F) + (size_t)m * D) + F.lane;
#pragma unroll
        for (int j = 0; j < 4; ++j) o8[64 * j] = (unsigned long long)pk2(v[j].x, v[j].y) | ((unsigned long long)pk2(v[j].z, v[j].w) << 32);
    }
}
__device__ __forceinline__ float row_ssq_bf16(const bf16* row, int lane) {
    const u32x4* xr = (const u32x4*)row + lane; float s = 0.f;
#pragma unroll
    for (int j = 0; j < 2; ++j) { const u32x4 x = xr[64 * j];
        const float a0 = bf2f(x.x & 0xffffu), a1 = bf2f(x.x >> 16), a2 = bf2f(x.y & 0xffffu), a3 = bf2f(x.y >> 16), a4 = bf2f(x.z & 0xffffu), a5 = bf2f(x.z >> 16), a6 = bf2f(x.w & 0xffffu), a7 = bf2f(x.w >> 16);
        s += ((a0 * a0 + a1 * a1) + (a2 * a2 + a3 * a3)) + ((a4 * a4 + a5 * a5) + (a6 * a6 + a7 * a7)); }
    return wave_sum(s);
}
__device__ __forceinline__ void ph_rstd(const Ctx& F0) {
    const Ctx F = launder(F0);
    const int gw = F.vcu * NWAVES + F.wave, NGW = F.G * NWAVES; float* rs1 = (float*)(F.ws + WS_RS1);
    for (int m = gw; m < T; m += NGW) { const float s = row_ssq_bf16(P_XB(F) + (size_t)m * D, F.lane); if (F.lane == 0) rs1[m] = 1.f / sqrtf(s * (1.f / D) + RMS_EPS); }
}

__device__ __forceinline__ void ph_bias_table(const Ctx& F0) {
    const Ctx F = launder(F0);
    if (F.vcu == 0) {
        const float* rel_bias = F.in[1];
        for (int i = F.tid; i < 8 * 132; i += NTHREADS) {
            const int h = i / 132, r = i % 132;
            int bk;
            if (r < 16) bk = r;
            else { bk = 16 + (int)(logf((float)r / 16.f) / logf(8.f) * 16.f); if (bk > 31) bk = 31; }
            P_BT(F)[i] = rel_bias[bk * 8 + h] * LOG2E;
        }
    }
}

__device__ __forceinline__ void ph_pool_dl(const Ctx& F0) {
    const Ctx F = launder(F0);
    const int gt = F.vcu * NTHREADS + F.tid, NGT = F.G * NTHREADS;
    for (int it = gt; it < (T / 32) * 128; it += NGT) {
        const int cp = it & 127, chunk = it >> 7, c = cp * 2, gi = c >> 6, win = 2 << gi, m0 = chunk * 32, t0 = m0 & (SEQ - 1);
        const unsigned* P2 = (const unsigned*)P_PB(F) + cp; unsigned* D2 = (unsigned*)P_DL(F) + cp;
        float s0 = 0.f, s1 = 0.f;
        const int back = (t0 < win) ? t0 : win;
        for (int j = 1; j <= back; ++j) { const unsigned v = P2[(size_t)(m0 - j) * 128]; s0 += bf2f(v & 0xffffu); s1 += bf2f(v >> 16); }
#pragma unroll 4
        for (int i = 0; i < 32; ++i) { const int m = m0 + i, t = t0 + i;
            const unsigned v = P2[(size_t)m * 128]; const float p0 = bf2f(v & 0xffffu), p1 = bf2f(v >> 16);
            s0 += p0; s1 += p1;
            if (t >= win) { const unsigned o = P2[(size_t)(m - win) * 128]; s0 -= bf2f(o & 0xffffu); s1 -= bf2f(o >> 16); }
            const float inv = 1.f / (float)((t + 1 < win) ? t + 1 : win);
            D2[(size_t)m * 128] = pk2(s0 * inv - p0, s1 * inv - p1); }
    }
}
__device__ __forceinline__ void ph_final(const Ctx& F0) {
    const Ctx F = launder(F0);
    const int gw = F.vcu * NWAVES + F.wave, NGW = F.G * NWAVES;
    const f32x4* gf = (const f32x4*)F.in[26];
    for (int m = gw; m < T; m += NGW) {
        const bf16* row = P_XB(F) + (size_t)m * D;
        const float rstd = 1.f / sqrtf(row_ssq_bf16(row, F.lane) * (1.f / D) + RMS_EPS);
        const u32x4* xr = (const u32x4*)row + F.lane; f32x4* orow = (f32x4*)(F.R + (size_t)m * D);
#pragma unroll
        for (int j = 0; j < 2; ++j) { const u32x4 x = xr[64 * j]; const int c4 = 2 * (64 * j + F.lane);
            orow[c4] = (f32x4){bf2f(x.x & 0xffffu), bf2f(x.x >> 16), bf2f(x.y & 0xffffu), bf2f(x.y >> 16)} * rstd * gf[c4];
            orow[c4 + 1] = (f32x4){bf2f(x.z & 0xffffu), bf2f(x.z >> 16), bf2f(x.w & 0xffffu), bf2f(x.w >> 16)} * rstd * gf[c4 + 1]; }
    }
}

constexpr int LDS_BYTES = 147456;
constexpr int MISC_OFF = 131072 + 320;

__global__ void __launch_bounds__(NTHREADS, 2) mk_fwd(Args args) {
    extern __shared__ __attribute__((aligned(16))) unsigned char lds[];
    Ctx F;
    F.lds = (LAS unsigned char*)lds;
    F.wave = __builtin_amdgcn_readfirstlane((int)threadIdx.x >> 6);
    F.lane = lane_id(); F.tid = F.wave * 64 + F.lane;
    F.G = gridDim.x; { const int bx = blockIdx.x; F.vcu = (F.G % 8 == 0) ? (bx % 8) * (F.G / 8) + bx / 8 : bx; }
    F.in = (KargP)__builtin_amdgcn_kernarg_segment_ptr(); F.R = args.out; F.ws = args.ws;
    unsigned char* ws = args.ws;
    volatile LAS unsigned* MISC = (volatile LAS unsigned*)(F.lds + MISC_OFF);
    if (F.tid < 64) MISC[F.tid] = 0u;
    __syncthreads();
    XcdBarrier bar = xcd_barrier_post((unsigned*)(ws + WS_CTL) + CW_BAR, MISC + 8, F.tid == 0);
#define GRID_BAR() do { bar.bar = (unsigned*)(wsl(ws) + WS_CTL) + CW_BAR; xcd_barrier(bar, F.wave); } while (0)
#define FL launder(F)

    ph_bias_table(F);
    ph_prologue(F);
#pragma unroll 1
    for (int l = 0; l < DEPTH; ++l) {
        if (l == 0) ph_cvt_x(F); else ph_rstd(F);
        GRID_BAR();
        { pg8::Gemm g{P_XB(FL), (const bf16*)(wsl(ws) + WS_WIN) + (size_t)l * NPROJ * D, D, D, D}; pg8::StaticOrder S; S.init(T, NPROJ, sl(F.G), sl((int)blockIdx.x));
          EpiProjE E{P_UG(FL), P_PB(FL), P_QB(FL), P_KB(FL), P_VB(FL), P_KMP(FL), (const float*)(wsl(ws) + WS_RS1)}; pg8::gemm_phase(F.lds, g, S, E, sl(F.wave)); }
        GRID_BAR();
        { pg8::Gemm g{P_UG(FL), (const bf16*)(wsl(ws) + WS_BZ) + (size_t)l * SGN * 256 * 1024, UGP, 1024, 1024}; SsmOrder S{sl(F.G), sl((int)blockIdx.x), 1};
          EpiZ E{(float*)(wsl(ws) + WS_ZB)}; pg8::gemm_phase(F.lds, g, S, E, sl(F.wave)); }
        ph_pool_dl(F);
        moba::phase(sl(F.wave), sl(F.vcu), P_QB(FL), P_KB(FL), P_VB(FL), P_YMIX(FL), P_KMP(FL), P_BT(FL), (LAS char*)F.lds);
        GRID_BAR();
        ph_ssm_scan(F, l);
        GRID_BAR();
        { pg8::Gemm g{P_UG(FL), (const bf16*)(wsl(ws) + WS_TG) + (size_t)l * SGN * 1024 * UGP, UGP, UGP, UGP}; SsmOrder S{sl(F.G), sl((int)blockIdx.x), 2};
          EpiSsm2 E{P_UG(FL), P_YS(FL), F.in[11] + l * 256}; pg8::gemm_phase(F.lds, g, S, E, sl(F.wave)); }
        GRID_BAR();
        { pg8::Gemm g{P_YS(FL), (const bf16*)(wsl(ws) + WS_GLUT) + (size_t)l * 65536, 256, 256, 256}; HalfOrder S{sl(F.vcu)};
          EpiGluE E{P_YS(FL), P_YMIX(FL), F.in[13] + l * 256}; pg8::gemm_phase(F.lds, g, S, E, sl(F.wave)); }
        { pg8::Gemm g{P_DL(FL), (const bf16*)(wsl(ws) + WS_POOLT) + (size_t)l * 65536, 256, 256, 256}; HalfOrder S{sl(F.vcu) - 128};
          EpiPoolE E{P_YMIX(FL), F.in[15] + l * 256, F.in[16] + l * 256}; pg8::gemm_phase(F.lds, g, S, E, sl(F.wave)); }
        GRID_BAR();
        { pg8::Gemm g{P_YMIX(FL), (const bf16*)(wsl(ws) + WS_WOUT) + (size_t)l * D * D, D, D, D}; pg8::StaticOrder S; S.init(T, D, sl(F.G), sl((int)blockIdx.x));
          EpiOutE E{P_XB(FL)}; pg8::gemm_phase(F.lds, g, S, E, sl(F.wave)); }
        GRID_BAR();
        ph_route(F, l);
        GRID_BAR();
        ph_place(F);
        GRID_BAR();
        { pg8::Gemm g{(const bf16*)(wsl(ws) + WS_XS), (const bf16*)(wsl(ws) + WS_GU) + (size_t)l * 16 * 512 * D, D, D, D}; MoeOrder S{(const int*)(wsl(ws) + WS_TILEB), sl(F.G), sl((int)blockIdx.x), false};
          EpiGU E{(bf16*)(wsl(ws) + WS_HACT), (const float*)(wsl(ws) + WS_ROWW), (const float*)(wsl(ws) + WS_ROWR)}; pg8::gemm_phase(F.lds, g, S, E, sl(F.wave)); }
        GRID_BAR();
        { pg8::Gemm g{(const bf16*)(wsl(ws) + WS_HACT), (const bf16*)(wsl(ws) + WS_WD) + (size_t)l * 24 * D * 512, 512, 512, 512}; MoeOrder S{(const int*)(wsl(ws) + WS_TILEB), sl(F.G), sl((int)blockIdx.x), true};
          EpiDown E{P_XB(FL), (const int*)(wsl(ws) + WS_ROWTOK)}; pg8::gemm_phase(F.lds, g, S, E, sl(F.wave)); }
        GRID_BAR();
    }
    ph_final(F);
}

extern "C" void kernel_launch(void* const* d_in, const int* in_sizes, int n_in, void* d_out, int out_size, void* d_ws, size_t ws_size, hipStream_t stream) {
    static int grid = 0;
    if (grid == 0) {
        if (n_in != 27 || out_size != T * D || ws_size < WS_END) { fprintf(stderr, "kernel_launch: unexpected shapes (n_in %d out %d ws %zu)\n", n_in, out_size, ws_size); grid = -1; return; }
        int dev = 0, cus = 0, per_cu = 0;
        if (hipGetDevice(&dev) != hipSuccess || hipDeviceGetAttribute(&cus, hipDeviceAttributeMultiprocessorCount, dev) != hipSuccess) { grid = -1; return; }
        if (hipFuncSetAttribute((const void*)mk_fwd, hipFuncAttributeMaxDynamicSharedMemorySize, LDS_BYTES) != hipSuccess) { fprintf(stderr, "kernel_launch: hipFuncSetAttribute failed\n"); grid = -1; return; }
        if (hipOccupancyMaxActiveBlocksPerMultiprocessor(&per_cu, (const void*)mk_fwd, NTHREADS, LDS_BYTES) != hipSuccess || per_cu < 1) { fprintf(stderr, "kernel_launch: occupancy query says %d\n", per_cu); per_cu = 1; }
        (void)hipGetLastError();
        grid = cus;
    }
    if (grid < 0) return;
    (void)hipMemsetAsync((char*)d_ws + WS_CTL, 0, CTL_ZERO_BYTES, stream);
    Args a{};
    for (int i = 0; i < 27; ++i) a.in[i] = (const float*)d_in[i];
    a.out = (float*)d_out; a.ws = (unsigned char*)d_ws; a.pad0 = 0; a.pad1 = 0;
    hipLaunchKernelGGL(mk_fwd, dim3(grid), dim3(NTHREADS), LDS_BYTES, stream, a);
}
```

```cpp
#include <hip/hip_runtime.h>
#include <hip/hip_bf16.h>
#include <cstdio>
#include <cstdint>

#define GAS __attribute__((address_space(1)))
#define LAS __attribute__((address_space(3)))
typedef unsigned short bf16;
typedef float f32x4 __attribute__((ext_vector_type(4)));
typedef unsigned u32x4 __attribute__((ext_vector_type(4)));
typedef unsigned u32x2 __attribute__((ext_vector_type(2)));

constexpr int NB = 8, SEQ = 4096, T = NB * SEQ, D = 1024, NPROJ = 2048, DEPTH = 2;
constexpr int NHEAD = 8, HD = 64, MBLK = 256, NBLK = SEQ / MBLK;
constexpr int SG = 16, SGN = 16, SP = 64, SCH = 64, UGP = 1152;
constexpr float RMS_EPS = 1e-6f;
constexpr float LOG2E = 1.4426950408889634f;
constexpr float C2 = 0.125f * LOG2E;
constexpr int NWAVES = 8, NTHREADS = 512;

constexpr size_t MiB = 1u << 20;
constexpr size_t WS_CTL = 0, CTL_ZERO_BYTES = 1 * MiB;
constexpr size_t WS_XB = 2 * MiB;
constexpr size_t WS_UG = 66 * MiB;
constexpr size_t WS_PB = 84 * MiB;
constexpr size_t WS_QB = 100 * MiB;
constexpr size_t WS_KB = 132 * MiB;
constexpr size_t WS_VB = 164 * MiB;
constexpr size_t WS_YMIX = 196 * MiB;
constexpr size_t WS_YS = 260 * MiB;
constexpr size_t WS_DL = 276 * MiB;
constexpr size_t WS_KMP = 292 * MiB;
constexpr size_t WS_BT = 293 * MiB;
constexpr size_t WS_KT = 297 * MiB;
constexpr size_t WS_WIN = 300 * MiB;
constexpr size_t WS_WOUT = 308 * MiB;
constexpr size_t WS_GU = 312 * MiB;
constexpr size_t WS_WD = 344 * MiB;
constexpr size_t WS_TG = 392 * MiB;
constexpr size_t WS_BZ = 464 * MiB;
constexpr size_t WS_GLUT = 480 * MiB;
constexpr size_t WS_POOLT = WS_GLUT + 512 * 1024;
constexpr size_t WS_ZB = 482 * MiB;
constexpr size_t WS_END = 486 * MiB;
constexpr int MOE_MAXT = 152;
constexpr size_t WS_XS = 66 * MiB;
constexpr size_t WS_HACT = 142 * MiB;
constexpr size_t WS_TOKB = 294 * MiB;
constexpr size_t WS_TOKR = WS_TOKB + 128 * 1024;
constexpr size_t WS_TOKW = WS_TOKB + 256 * 1024;
constexpr size_t WS_ROWTOK = 295 * MiB;
constexpr size_t WS_ROWW = WS_ROWTOK + 256 * 1024;
constexpr size_t WS_ROWR = WS_ROWTOK + 576 * 1024;
constexpr size_t WS_RS1 = WS_ROWTOK + 768 * 1024;
constexpr size_t WS_WGCNT = 296 * MiB;
constexpr size_t WS_TILEB = WS_WGCNT + 64 * 1024;

constexpr int CW_BAR = 4096;

__device__ __forceinline__ unsigned f2bf(float f) { unsigned u = __builtin_bit_cast(unsigned, f); return (u + 0x7fffu + ((u >> 16) & 1u)) >> 16; }
__device__ __forceinline__ float bf2f(unsigned h) { return __builtin_bit_cast(float, h << 16); }
__device__ __forceinline__ unsigned pk2(float lo, float hi) { return f2bf(lo) | (f2bf(hi) << 16); }
template <int O> __device__ __forceinline__ float xshfl(float v) {
    if constexpr (O < 32) return __builtin_bit_cast(float, __builtin_amdgcn_ds_swizzle(__builtin_bit_cast(int, v), (O << 10) | 0x1f));
    else { const unsigned u = __builtin_bit_cast(unsigned, v); auto r = __builtin_amdgcn_permlane32_swap(u, u, false, false);
           const float a = __builtin_bit_cast(float, (unsigned)r[0]), b = __builtin_bit_cast(float, (unsigned)r[1]); return (a == v && __builtin_bit_cast(unsigned, a) == u) ? b : a; }
}
__device__ __forceinline__ float wave_sum(float v) {
    v += xshfl<1>(v); v += xshfl<2>(v); v += xshfl<4>(v); v += xshfl<8>(v); v += xshfl<16>(v);
    const unsigned u = __builtin_bit_cast(unsigned, v); auto r = __builtin_amdgcn_permlane32_swap(u, u, false, false);
    return __builtin_bit_cast(float, (unsigned)r[0]) + __builtin_bit_cast(float, (unsigned)r[1]);
}
__device__ __forceinline__ float wave_max(float v) {
    v = fmaxf(v, xshfl<1>(v)); v = fmaxf(v, xshfl<2>(v)); v = fmaxf(v, xshfl<4>(v)); v = fmaxf(v, xshfl<8>(v)); v = fmaxf(v, xshfl<16>(v));
    const unsigned u = __builtin_bit_cast(unsigned, v); auto r = __builtin_amdgcn_permlane32_swap(u, u, false, false);
    return fmaxf(__builtin_bit_cast(float, (unsigned)r[0]), __builtin_bit_cast(float, (unsigned)r[1]));
}
__device__ __forceinline__ float gelu_tanh(float x) {
    const float u = 0.7978845608028654f * (x + 0.044715f * x * x * x);
    const float e = __expf(2.f * u);
    const float th = 1.f - 2.f / (e + 1.f);
    return 0.5f * x * (1.f + th);
}
__device__ __forceinline__ float sigmoidf_(float x) { return 1.f / (1.f + __expf(-x)); }

__device__ __forceinline__ int lane_id() { unsigned m; asm volatile("s_mov_b32 %0, -1" : "=s"(m)); return (int)__builtin_amdgcn_mbcnt_hi(m, __builtin_amdgcn_mbcnt_lo(m, 0u)); }

#define XB_TMO      128
#define XB_XCNT(j)  (256  + 64 * (j))
#define XB_XSUB(j)  (1280 + 64 * (j))
#define XB_XGEN(j)  (2304 + 64 * (j))
#define XB_TOP      3328
#define XB_TOPGEN   3392
#define XCD_BAR_WORDS 3456
#define XB_SPIN_CAP (1u << 22)
__device__ __forceinline__ unsigned xb_ld(unsigned* p)              { return __hip_atomic_load(p, __ATOMIC_RELAXED, __HIP_MEMORY_SCOPE_AGENT); }
__device__ __forceinline__ unsigned xb_add(unsigned* p, unsigned v) { return __hip_atomic_fetch_add(p, v, __ATOMIC_RELAXED, __HIP_MEMORY_SCOPE_AGENT); }
__device__ __forceinline__ unsigned xb_xcc_id() { return (unsigned)__builtin_amdgcn_s_getreg((3 << 11) | 20) & 0xFu; }
#define XB_SPIN(cond, bar) do { unsigned _sp = 0; while (cond) { __builtin_amdgcn_s_sleep(1); \
    if ((++_sp & 255u) == 0u) { if (xb_ld(&(bar)[XB_TMO])) break; if (_sp > XB_SPIN_CAP) { atomicAdd(&(bar)[XB_TMO], 1u); break; } } } } while (0)
struct XcdBarrier { unsigned* bar; unsigned x; volatile LAS unsigned* st; };
__device__ __forceinline__ XcdBarrier xcd_barrier_post(unsigned* bar, volatile LAS unsigned* st, bool t0) {
    XcdBarrier b; b.bar = bar; b.x = xb_xcc_id(); b.st = st;
    if (t0) (void)xb_add(&bar[XB_XCNT(b.x)], 1u);
    return b;
}
__device__ __forceinline__ void xcd_barrier_complete(unsigned* bar, unsigned x, unsigned& nloc, unsigned& nx) {
    const unsigned G = gridDim.x * gridDim.y * gridDim.z;
    unsigned sum, cnt, mine, sp = 0u;
    for (;;) {
        sum = 0u; cnt = 0u; mine = 0u;
#pragma unroll
        for (unsigned j = 0; j < 16; ++j) { const unsigned c = xb_ld(&bar[XB_XCNT(j)]); sum += c; cnt += (c > 0u) ? 1u : 0u; mine = (j == x) ? c : mine; }
        if (sum == G) break;
        __builtin_amdgcn_s_sleep(1);
        if ((++sp & 255u) == 0u) { if (xb_ld(&bar[XB_TMO])) break; if (sp > XB_SPIN_CAP) { atomicAdd(&bar[XB_TMO], 1u); break; } }
    }
    nloc = mine > 0u ? mine : 1u; nx = cnt > 0u ? cnt : 1u;
}
__device__ __forceinline__ void xcd_barrier(const XcdBarrier& b, int wave) {
    asm volatile("s_waitcnt vmcnt(0)" ::: "memory");
    __syncthreads();
    if (wave == 0 && lane_id() == 0) {
        unsigned* bar = b.bar;
        __builtin_amdgcn_s_waitcnt(0);
        unsigned nloc = b.st[0], nx = b.st[1];
        if (nloc == 0u) { xcd_barrier_complete(bar, b.x, nloc, nx); b.st[0] = nloc; b.st[1] = nx; }
        const unsigned old = xb_add(&bar[XB_XSUB(b.x)], 1u);
        const unsigned gen = old / nloc;
        if (old + 1u == (gen + 1u) * nloc) {
            __builtin_amdgcn_fence(__ATOMIC_RELEASE, "agent");
            asm volatile("s_waitcnt vmcnt(0)" ::: "memory");
            const unsigned og = xb_add(&bar[XB_TOP], 1u);
            const unsigned tg = og / nx;
            if (og + 1u == (tg + 1u) * nx) xb_add(&bar[XB_TOPGEN], 1u);
            else XB_SPIN(xb_ld(&bar[XB_TOPGEN]) == tg, bar);
            __builtin_amdgcn_fence(__ATOMIC_ACQUIRE, "agent");
            xb_add(&bar[XB_XGEN(b.x)], 1u);
            asm volatile("s_waitcnt vmcnt(0)" ::: "memory");
        } else {
            XB_SPIN(xb_ld(&bar[XB_XGEN(b.x)]) == gen, bar);
            __builtin_amdgcn_fence(__ATOMIC_ACQUIRE, "agent");
            asm volatile("s_waitcnt vmcnt(0)" ::: "memory");
        }
    }
    __syncthreads();
}

struct Args {
    const float* in[27];
    float* out;
    unsigned char* ws;
    int pad0, pad1;
};

typedef const float* fptr_t;
typedef __attribute__((address_space(4))) const fptr_t* KargP;
struct Ctx {
    LAS unsigned char* lds;
    int tid, lane, wave, vcu, G;
    KargP in;
    float* R;
    unsigned char* ws;
};
#define P_XB(F) ((bf16*)((F).ws + WS_XB))
#define P_UG(F) ((bf16*)((F).ws + WS_UG))
#define P_PB(F) ((bf16*)((F).ws + WS_PB))
#define P_QB(F) ((bf16*)((F).ws + WS_QB))
#define P_KB(F) ((bf16*)((F).ws + WS_KB))
#define P_VB(F) ((bf16*)((F).ws + WS_VB))
#define P_YMIX(F) ((bf16*)((F).ws + WS_YMIX))
#define P_YS(F) ((bf16*)((F).ws + WS_YS))
#define P_DL(F) ((bf16*)((F).ws + WS_DL))
#define P_KMP(F) ((float*)((F).ws + WS_KMP))
#define P_BT(F) ((float*)((F).ws + WS_BT))


__device__ __forceinline__ Ctx launder(const Ctx& F0) {
    Ctx F = F0;
    int ln = lane_id(); asm volatile("" : "+v"(ln));
    asm volatile("" : "+s"(F.wave), "+s"(F.vcu), "+s"(F.G));
    F.lane = ln; F.tid = F.wave * 64 + ln;
    KargP kp = (KargP)__builtin_amdgcn_kernarg_segment_ptr(); asm volatile("" : "+s"(kp));
    F.in = kp; F.R = (float*)kp[27]; F.ws = (unsigned char*)kp[28];
    return F;
}

__device__ __forceinline__ unsigned char* wsl(unsigned char* p) { asm volatile("" : "+s"(p)); return p; }
__device__ __forceinline__ int sl(int x) { asm volatile("" : "+s"(x)); return x; }

namespace pg8 {
typedef short bf16x8 __attribute__((ext_vector_type(8)));
constexpr int BM = 256, BK = 64, HALF = 128, HTB = HALF * BK * 2, STAGE_BYTES = 8 * HTB, NXCD = 8, WGM = 8;
__device__ __forceinline__ int lds_byte(int r, int c) { const int st = (r >> 4) * 2 + (c >> 5), rr = r & 15, cc = c & 31, ob = rr * 64 + cc * 2; return st * 1024 + (ob ^ (((ob >> 9) & 1) << 5)); }
__device__ __forceinline__ void stage_rc(int b, int& R, int& C) { const int st = b / 1024, sb = b % 1024, swz = sb ^ (((sb >> 9) & 1) << 5); R = (st >> 1) * 16 + swz / 64; C = (st & 1) * 32 + (swz % 64) / 2; }
__device__ __forceinline__ int perm32(int rho) { const int n = rho >> 4, i = rho & 15; return 8 * (i >> 2) + 4 * n + (i & 3); }

struct Unit { int pm, pn, aux; };
struct Gemm { const bf16* A; const bf16* Bt; int lda, ldb, K; };

struct StaticOrder {
    int nM, nN, nwg, G, c;
    __device__ void init(int M, int N, int G_, int c_) { nM = M / BM; nN = N / BM; nwg = nM * nN; G = G_; c = c_; }
    __device__ bool next(int i, Unit& u) const {
        const long L = (long)i * G + c; if (L >= nwg) return false;
        int wgid = (int)L; { const int q = nwg / NXCD, r = nwg % NXCD, xcd = wgid % NXCD, off = wgid / NXCD; wgid = (xcd < r ? xcd * (q + 1) : r * (q + 1) + (xcd - r) * q) + off; }
        const int nig = WGM * nN, gid = wgid / nig, fm = gid * WGM, gsz = (nM - fm) < WGM ? (nM - fm) : WGM;
        u.pm = fm + ((wgid % nig) % gsz); u.pn = (wgid % nig) / gsz; u.aux = 0; return true;
    }
};

__device__ __forceinline__ unsigned cvt_pk_bf16(float lo, float hi) { unsigned r; asm volatile("v_cvt_pk_bf16_f32 %0, %1, %2" : "=v"(r) : "v"(lo), "v"(hi)); return r; }

template <bool ALIGN = true, class Epi, class Sched>
__device__ __forceinline__ void gemm_phase(LAS unsigned char* lds, const Gemm g, const Sched& S, const Epi& E, int wave_) {
    int lane_ = lane_id(); asm volatile("" : "+v"(lane_)); asm volatile("" : "+s"(wave_));
    const int wid = wave_, lane = lane_, tid = wid * 64 + lane, wr = wid >> 2, wc = wid & 3, fr = lane & 15, fq = lane >> 4;
    const int K = g.K, nt = K / BK;
    unsigned voffA[2], voffB[2];
#pragma unroll
    for (int i = 0; i < 2; ++i) { int R, C; stage_rc(tid * 16 + i * 8192, R, C); const int Rb = Epi::PERM ? ((R & ~31) + perm32(R & 31)) : R;
        voffA[i] = (unsigned)(R * g.lda + C) * 2u; voffB[i] = (unsigned)(Rb * g.ldb + C) * 2u; }
    const size_t kstep = (size_t)(BK * 2);
    const size_t hstepA = (size_t)HALF * g.lda * 2, hstepB = (size_t)HALF * g.ldb * 2;
    const size_t tstepA = 2 * hstepA, tstepB = 2 * hstepB;
    const unsigned ldsw = (unsigned)wid * 1024u;
    const int aoff = lds_byte(wr * 64 + fr, fq * 8), boff = lds_byte(wc * 32 + fr, fq * 8);
#define PG8_SA(b, h) (((b) * 2 + (h)) * HTB)
#define PG8_SB(b, h) ((4 + (b) * 2 + (h)) * HTB)
#define PG8_STAGE(bufoff, gbase, voff) do { _Pragma("unroll") for (int _i = 0; _i < 2; ++_i) \
        __builtin_amdgcn_global_load_lds((const unsigned*)((const char*)(gbase) + (voff)[_i]), (LAS unsigned*)(lds + (bufoff) + ldsw + _i * 8192), 16, 0, 0); } while (0)
#define PG8_LDA(dst, b, h) do { _Pragma("unroll") for (int m = 0; m < 4; ++m) _Pragma("unroll") for (int k = 0; k < 2; ++k) dst[m][k] = *(const LAS bf16x8*)(lds + PG8_SA(b, h) + aoff + m * 2048 + k * 1024); } while (0)
#define PG8_LDB(dst, b, h) do { _Pragma("unroll") for (int n = 0; n < 2; ++n) _Pragma("unroll") for (int k = 0; k < 2; ++k) dst[n][k] = *(const LAS bf16x8*)(lds + PG8_SB(b, h) + boff + n * 2048 + k * 1024); } while (0)
#define PG8_MMA(ai, bj, At, Bt) do { __builtin_amdgcn_s_setprio(1); _Pragma("unroll") for (int m = 0; m < 4; ++m) _Pragma("unroll") for (int n = 0; n < 2; ++n) _Pragma("unroll") for (int k = 0; k < 2; ++k) \
        acc[ai][bj][m][n] = __builtin_amdgcn_mfma_f32_16x16x32_bf16(Bt[n][k], At[m][k], acc[ai][bj][m][n], 0, 0, 0); __builtin_amdgcn_s_setprio(0); } while (0)
#define PG8_WAIT_V(n) asm volatile("s_waitcnt vmcnt(" #n ")" ::: "memory")
#define PG8_WAIT_L(n) asm volatile("s_waitcnt lgkmcnt(" #n ")" ::: "memory")
#define PG8_BAR __builtin_amdgcn_s_barrier()
#define PG8_SCHED __builtin_amdgcn_sched_barrier(0)
    Unit cur, nxt; int ui = 0;
    if (!S.next(0, cur)) return;
    f32x4 acc[2][2][4][2];
#pragma unroll
    for (int a = 0; a < 2; ++a)
#pragma unroll
        for (int b = 0; b < 2; ++b)
#pragma unroll
            for (int m = 0; m < 4; ++m)
#pragma unroll
                for (int n = 0; n < 2; ++n) acc[a][b][m][n] = (f32x4){0.f, 0.f, 0.f, 0.f};
    bf16x8 At[4][2], B0[2][2], B1[2][2];
    const char* cA = (const char*)g.A + (size_t)cur.pm * tstepA; const char* cB = (const char*)g.Bt + (size_t)cur.pn * tstepB;
    PG8_STAGE(PG8_SB(0, 0), cB, voffB); PG8_STAGE(PG8_SB(0, 1), cB + hstepB, voffB); PG8_STAGE(PG8_SA(0, 0), cA, voffA); PG8_STAGE(PG8_SA(0, 1), cA + hstepA, voffA);
    if (wr == 1) PG8_BAR;
    PG8_WAIT_V(2); PG8_BAR;
    PG8_STAGE(PG8_SB(1, 0), cB + kstep, voffB); PG8_STAGE(PG8_SA(1, 0), cA + kstep, voffA); PG8_STAGE(PG8_SB(1, 1), cB + hstepB + kstep, voffB);
    PG8_WAIT_V(6); PG8_BAR;
    for (;;) {
        const bool has_next = S.next(ui + 1, nxt);
        const char* nA = has_next ? (const char*)g.A + (size_t)nxt.pm * tstepA : cA; const char* nB = has_next ? (const char*)g.Bt + (size_t)nxt.pn * tstepB : cB;
        for (int t = 0; t < nt; t += 2) {
            const bool last = (t == nt - 2);
            const char* a1 = cA + (size_t)(t + 1) * kstep;
            const char* a2 = last ? nA : cA + (size_t)(t + 2) * kstep; const char* b2 = last ? nB : cB + (size_t)(t + 2) * kstep;
            const char* a3 = a2 + kstep; const char* b3 = b2 + kstep;
            PG8_LDB(B0, 0, 0); PG8_LDB(B1, 0, 1); PG8_SCHED; PG8_LDA(At, 0, 0); PG8_STAGE(PG8_SA(1, 1), a1 + hstepA, voffA);
            PG8_WAIT_V(8); PG8_WAIT_L(0); PG8_BAR; PG8_MMA(0, 0, At, B0); PG8_MMA(0, 1, At, B1); PG8_BAR; PG8_SCHED;
            PG8_LDA(At, 0, 1); PG8_STAGE(PG8_SB(0, 0), b2, voffB); PG8_STAGE(PG8_SB(0, 1), b2 + hstepB, voffB); PG8_STAGE(PG8_SA(0, 0), a2, voffA);
            PG8_WAIT_V(8); PG8_WAIT_L(0); PG8_BAR; PG8_MMA(1, 0, At, B0); PG8_MMA(1, 1, At, B1); PG8_BAR; PG8_SCHED;
            PG8_LDB(B0, 1, 0); PG8_LDB(B1, 1, 1); PG8_SCHED; PG8_LDA(At, 1, 0); PG8_STAGE(PG8_SA(0, 1), a2 + hstepA, voffA);
            PG8_WAIT_V(8); PG8_WAIT_L(0); PG8_BAR; PG8_MMA(0, 0, At, B0); PG8_MMA(0, 1, At, B1); PG8_BAR; PG8_SCHED;
            PG8_LDA(At, 1, 1); PG8_STAGE(PG8_SB(1, 0), b3, voffB); PG8_STAGE(PG8_SB(1, 1), b3 + hstepB, voffB); PG8_STAGE(PG8_SA(1, 0), a3, voffA);
            PG8_WAIT_V(8); PG8_WAIT_L(0); PG8_BAR; PG8_MMA(1, 0, At, B0); PG8_MMA(1, 1, At, B1); PG8_BAR; PG8_SCHED;
        }
        if constexpr (ALIGN) { if (wr == 0) PG8_BAR; }
        E(acc, cur, wr, wc, fr, fq);
        if (!has_next) break;
#pragma unroll
        for (int a = 0; a < 2; ++a)
#pragma unroll
            for (int b = 0; b < 2; ++b)
#pragma unroll
                for (int m = 0; m < 4; ++m)
#pragma unroll
                    for (int n = 0; n < 2; ++n) acc[a][b][m][n] = (f32x4){0.f, 0.f, 0.f, 0.f};
        cur = nxt; cA = nA; cB = nB; ++ui;
        if constexpr (ALIGN) { if (wr == 1) PG8_BAR; }
    }
    PG8_WAIT_V(0);
    if constexpr (!ALIGN) { if (wr == 0) PG8_BAR; }
    PG8_BAR;
#undef PG8_SA
#undef PG8_SB
#undef PG8_STAGE
#undef PG8_LDA
#undef PG8_LDB
#undef PG8_MMA
#undef PG8_WAIT_V
#undef PG8_WAIT_L
#undef PG8_BAR
#undef PG8_SCHED
}
}


struct EpiProjE {
    static constexpr bool PERM = true;
    bf16 *UG, *PB, *QB, *KB, *VB; float* KMP; const float* rs1;
    __device__ __forceinline__ void operator()(const f32x4 (&acc_)[2][2][4][2], const pg8::Unit& u, int wr, int wc, int fr_, int fq_) const {
        const int ln_ = lane_id(), fr = ln_ & 15, fq = ln_ >> 4; (void)fr_; (void)fq_;
        const int pn = u.pn, row0 = u.pm * 256 + wr * 64 + fr, cl = wc * 32 + 8 * fq;
        f32x4 acc[2][2][4][2];
#pragma unroll
        for (int ai = 0; ai < 2; ++ai)
#pragma unroll
            for (int m = 0; m < 4; ++m) { const float rs = rs1[row0 + ai * 128 + m * 16];
#pragma unroll
                for (int bj = 0; bj < 2; ++bj) { acc[ai][bj][m][0] = acc_[ai][bj][m][0] * rs; acc[ai][bj][m][1] = acc_[ai][bj][m][1] * rs; } }
        if (pn == 0) {
#pragma unroll
            for (int ai = 0; ai < 2; ++ai)
#pragma unroll
                for (int m = 0; m < 4; ++m) { const int r = row0 + ai * 128 + m * 16;
#pragma unroll
                    for (int bj = 0; bj < 2; ++bj) { const int ch = bj * 128 + cl, g = ch >> 4, h0 = ch & 15;
                        const f32x4 v0 = acc[ai][bj][m][0], v1 = acc[ai][bj][m][1]; u32x4 w;
                        w.x = pg8::cvt_pk_bf16(v0[0], v0[1]); w.y = pg8::cvt_pk_bf16(v0[2], v0[3]); w.z = pg8::cvt_pk_bf16(v1[0], v1[1]); w.w = pg8::cvt_pk_bf16(v1[2], v1[3]);
                        *(u32x4*)(UG + ((size_t)(g * 512 + (r >> 6))) * UGP + (r & 63) * 16 + h0) = w; } }
        } else {
            bf16* base; int ldc, colt; float sc = 1.f;
            if (pn == 1) { base = PB; ldc = 256; colt = 0; }
            else if (pn < 4) { base = QB; ldc = 512; colt = (pn - 2) * 256; sc = C2; }
            else if (pn < 6) { base = KB; ldc = 512; colt = (pn - 4) * 256; }
            else { base = VB; ldc = 512; colt = (pn - 6) * 256; }
#pragma unroll
            for (int ai = 0; ai < 2; ++ai)
#pragma unroll
                for (int m = 0; m < 4; ++m) { bf16* rowp = base + (size_t)(row0 + ai * 128 + m * 16) * ldc + colt + cl;
#pragma unroll
                    for (int bj = 0; bj < 2; ++bj) { const f32x4 v0 = acc[ai][bj][m][0] * sc, v1 = acc[ai][bj][m][1] * sc; u32x4 w;
                        w.x = pg8::cvt_pk_bf16(v0[0], v0[1]); w.y = pg8::cvt_pk_bf16(v0[2], v0[3]); w.z = pg8::cvt_pk_bf16(v1[0], v1[1]); w.w = pg8::cvt_pk_bf16(v1[2], v1[3]);
                        *(u32x4*)(rowp + bj * 128) = w; } }
            if (pn >= 4 && pn < 6) {
#pragma unroll
                for (int bj = 0; bj < 2; ++bj)
#pragma unroll
                    for (int n = 0; n < 2; ++n) { f32x4 s = (f32x4){0.f, 0.f, 0.f, 0.f};
#pragma unroll
                        for (int ai = 0; ai < 2; ++ai)
#pragma unroll
                            for (int m = 0; m < 4; ++m) s += acc[ai][bj][m][n];
#pragma unroll
                        for (int i = 0; i < 4; ++i) { float t = s[i]; t += xshfl<1>(t); t += xshfl<2>(t); t += xshfl<4>(t); t += xshfl<8>(t); s[i] = t; }
                        if (fr == 0) *(f32x4*)(KMP + (size_t)wr * 128 * 512 + (size_t)u.pm * 512 + colt + bj * 128 + cl + 4 * n) = s; }
            }
        }
    }
};
struct EpiOutE {
    static constexpr bool PERM = true;
    bf16* RB;
    __device__ __forceinline__ void operator()(const f32x4 (&acc)[2][2][4][2], const pg8::Unit& u, int wr, int wc, int fr_, int fq_) const {
        const int ln_ = lane_id(), fr = ln_ & 15, fq = ln_ >> 4; (void)fr_; (void)fq_;
        const int row0 = u.pm * 256 + wr * 64 + fr, col0 = u.pn * 256 + wc * 32 + 8 * fq;
#pragma unroll
        for (int ai = 0; ai < 2; ++ai)
#pragma unroll
            for (int m = 0; m < 4; ++m) { bf16* rp = RB + (size_t)(row0 + ai * 128 + m * 16) * D + col0;
#pragma unroll
                for (int bj = 0; bj < 2; ++bj) { const u32x4 x = *(const u32x4*)(rp + bj * 128); const f32x4 a0 = acc[ai][bj][m][0], a1 = acc[ai][bj][m][1]; u32x4 w;
                    w.x = pg8::cvt_pk_bf16(bf2f(x.x & 0xffffu) + a0[0], bf2f(x.x >> 16) + a0[1]); w.y = pg8::cvt_pk_bf16(bf2f(x.y & 0xffffu) + a0[2], bf2f(x.y >> 16) + a0[3]);
                    w.z = pg8::cvt_pk_bf16(bf2f(x.z & 0xffffu) + a1[0], bf2f(x.z >> 16) + a1[1]); w.w = pg8::cvt_pk_bf16(bf2f(x.w & 0xffffu) + a1[2], bf2f(x.w >> 16) + a1[3]);
                    *(u32x4*)(rp + bj * 128) = w; }
                if (m & 1) asm volatile("" ::: "memory"); }
    }
};

__device__ __forceinline__ void transpose_item(const float* W, int K, int N, const float* kscale, bf16* WT, int ldo, int koff, int rowmode, LAS float* scr, int item, int lane) {
    const int nblk = N / 32, kb = item / nblk, nb = item % nblk, k0 = 64 * kb, n0 = 32 * nb;
    { const int r8 = lane >> 3, c4 = lane & 7; f32x4 v[8];
#pragma unroll
      for (int i = 0; i < 8; ++i) v[i] = *(const f32x4*)(W + (size_t)(k0 + 8 * i + r8) * N + n0 + 4 * c4);
#pragma unroll
      for (int i = 0; i < 8; ++i) { const int kk = 8 * i + r8; const float s = kscale ? kscale[k0 + kk] : 1.f; LAS float* d = scr + kk * 33 + 4 * c4;
          d[0] = v[i][0] * s; d[1] = v[i][1] * s; d[2] = v[i][2] * s; d[3] = v[i][3] * s; } }
    asm volatile("s_waitcnt lgkmcnt(0)" ::: "memory");
    const int c = lane & 7;
#pragma unroll
    for (int j = 0; j < 4; ++j) { const int n = (lane >> 3) + 8 * j; const LAS float* s = scr + (8 * c) * 33 + n;
        u32x4 o; o.x = pk2(s[0 * 33], s[1 * 33]); o.y = pk2(s[2 * 33], s[3 * 33]); o.z = pk2(s[4 * 33], s[5 * 33]); o.w = pk2(s[6 * 33], s[7 * 33]);
        const int nn = n0 + n, row = rowmode == 0 ? nn : (8 * (nn >> 2) + (nn & 3) + (rowmode == 2 ? 4 : 0));
        *(u32x4*)(WT + (size_t)row * ldo + koff + k0 + 8 * c) = o; }
    asm volatile("s_waitcnt lgkmcnt(0)" ::: "memory");
}
__device__ __forceinline__ void pair_decode(int pi, int& ea, int& eb) { ea = pi < 3 ? 0 : (pi < 5 ? 1 : 2); eb = pi < 3 ? pi + 1 : (pi < 5 ? pi - 1 : 3); }
__device__ __forceinline__ void ph_prologue(const Ctx& F0) {
    const Ctx F = launder(F0);
    LAS float* scr = (LAS float*)(F.lds + F.wave * 16384);
    const int gw = F.vcu * NWAVES + F.wave, NGW = F.G * NWAVES;
    constexpr int I_IN = (D / 64) * (NPROJ / 32), I_OUT = (D / 64) * (D / 32), I_GU1 = (D / 64) * (256 / 32), I_GU = 16 * 2 * I_GU1, I_WD1 = (256 / 64) * (D / 32), I_WD = 24 * 2 * I_WD1;
    constexpr int I_L = I_IN + I_OUT + I_GU + I_WD;
    for (int it = gw; it < DEPTH * I_L; it += NGW) {
        const int l = it / I_L; int r = it % I_L;
        if (r < I_IN) { transpose_item(F.in[3] + (size_t)l * D * NPROJ, D, NPROJ, F.in[2] + l * D, (bf16*)(F.ws + WS_WIN) + (size_t)l * NPROJ * D, D, 0, 0, scr, r, F.lane); continue; } r -= I_IN;
        if (r < I_OUT) { transpose_item(F.in[17] + (size_t)l * D * D, D, D, nullptr, (bf16*)(F.ws + WS_WOUT) + (size_t)l * D * D, D, 0, 0, scr, r, F.lane); continue; } r -= I_OUT;
        if (r < I_GU) { const int e = r / (2 * I_GU1), up = (r / I_GU1) & 1, item = r % I_GU1;
            transpose_item(F.in[up ? 24 : 23] + ((size_t)l * 16 + e) * D * 256, D, 256, F.in[18] + l * D, (bf16*)(F.ws + WS_GU) + ((size_t)l * 16 + e) * 512 * D, D, 0, 1 + up, scr, item, F.lane); continue; } r -= I_GU;
        { const int bk = r / (2 * I_WD1), half = (r / I_WD1) & 1, item = r % I_WD1, g = bk / 6; int ea, eb; pair_decode(bk % 6, ea, eb); const int e = g * 4 + (half ? eb : ea);
            transpose_item(F.in[25] + ((size_t)l * 16 + e) * 256 * D, 256, D, nullptr, (bf16*)(F.ws + WS_WD) + ((size_t)l * 24 + bk) * D * 512, 512, half * 256, 0, scr, item, F.lane); }
    }
    for (int it = gw; it < DEPTH * 32; it += NGW) { const int l = it >> 5;
        transpose_item(F.in[12] + (size_t)l * 256 * 256, 256, 256, nullptr, (bf16*)(F.ws + WS_GLUT) + (size_t)l * 65536, 256, 0, 0, scr, it & 31, F.lane); }
    { const int gt = F.vcu * NTHREADS + F.tid, NGT = F.G * NTHREADS;
      for (int i = gt; i < DEPTH * 65536; i += NGT) { const int l = i >> 16, n = (i >> 8) & 255, k = i & 255;
          const float v = ((n >> 6) == (k >> 6)) ? F.in[14][(((size_t)l * 4 + (n >> 6)) * 64 + (k & 63)) * 64 + (n & 63)] : 0.f;
          ((bf16*)(F.ws + WS_POOLT))[i] = (bf16)f2bf(v); } }
    for (int it = gw; it < DEPTH * SGN * 65; it += NGW) {
        const int l = it / (SGN * 65), g = (it / 65) % SGN, tau = it % 65, p = F.lane;
        const float are = F.in[4][(l * SGN + g) * SP + p], aim = F.in[5][(l * SGN + g) * SP + p], dt = expf(F.in[6][l * SGN + g]);
        float sn, cs; sincosf(aim * dt, &sn, &cs); const float mg = expf(are * dt), lbr = mg * cs, lbi = mg * sn;
        const float nr = lbr - 1.f, ni = lbi, den = are * are + aim * aim, cr = (nr * are + ni * aim) / den, ci = (ni * are - nr * aim) / den;
        float sn2, cs2; sincosf(aim * dt * (float)tau, &sn2, &cs2); const float mg2 = expf(are * dt * (float)tau), lr = mg2 * cs2, li = mg2 * sn2;
        float wr[16], wi[16];
#pragma unroll
        for (int h = 0; h < 16; ++h) { const float br = F.in[7][((size_t)(l * SGN + g) * SP + p) * SG + h], bi = F.in[8][((size_t)(l * SGN + g) * SP + p) * SG + h];
            const float bbr = cr * br - ci * bi, bbi = cr * bi + ci * br; wr[h] = lr * bbr - li * bbi; wi[h] = lr * bbi + li * bbr; }
        bf16* TG = (bf16*)(F.ws + WS_TG) + ((size_t)l * SGN + g) * 1024 * UGP;
        if (tau <= 63) {
            bf16* BZ = (bf16*)(F.ws + WS_BZ) + ((size_t)l * SGN + g) * 256 * 1024; const int s = 63 - tau;
            u32x4 o0, o1, o2, o3;
            o0.x = pk2(wr[0], wr[1]); o0.y = pk2(wr[2], wr[3]); o0.z = pk2(wr[4], wr[5]); o0.w = pk2(wr[6], wr[7]); o1.x = pk2(wr[8], wr[9]); o1.y = pk2(wr[10], wr[11]); o1.z = pk2(wr[12], wr[13]); o1.w = pk2(wr[14], wr[15]);
            o2.x = pk2(wi[0], wi[1]); o2.y = pk2(wi[2], wi[3]); o2.z = pk2(wi[4], wi[5]); o2.w = pk2(wi[6], wi[7]); o3.x = pk2(wi[8], wi[9]); o3.y = pk2(wi[10], wi[11]); o3.z = pk2(wi[12], wi[13]); o3.w = pk2(wi[14], wi[15]);
            *(u32x4*)(BZ + (size_t)p * 1024 + s * 16) = o0; *(u32x4*)(BZ + (size_t)p * 1024 + s * 16 + 8) = o1;
            *(u32x4*)(BZ + (size_t)(64 + p) * 1024 + s * 16) = o2; *(u32x4*)(BZ + (size_t)(64 + p) * 1024 + s * 16 + 8) = o3;
        }
        LAS float* Wst = scr; LAS float* Kt = scr + 128 * 16;
        if (tau <= 63) {
#pragma unroll
            for (int q = 0; q < 4; ++q) { *(LAS f32x4*)(Wst + p * 16 + 4 * q) = (f32x4){wr[4 * q], wr[4 * q + 1], wr[4 * q + 2], wr[4 * q + 3]};
                                          *(LAS f32x4*)(Wst + (64 + p) * 16 + 4 * q) = (f32x4){wi[4 * q], wi[4 * q + 1], wi[4 * q + 2], wi[4 * q + 3]}; }
            const int arow = p & 15, kq = p >> 4; f32x4 kacc = (f32x4){0.f, 0.f, 0.f, 0.f};
            const float* cre = F.in[9] + ((size_t)(l * SGN + g) * SG + arow) * SP; const float* cim = F.in[10] + ((size_t)(l * SGN + g) * SG + arow) * SP;
#pragma unroll 8
            for (int s = 0; s < 32; ++s) { const int k = 4 * s + kq; const float av = (k < 64) ? cre[k] : -cim[k - 64]; const float bv = Wst[k * 16 + arow];
                kacc = __builtin_amdgcn_mfma_f32_16x16x4f32(av, bv, kacc, 0, 0, 0); }
#pragma unroll
            for (int r = 0; r < 4; ++r) Kt[(4 * kq + r) * 16 + arow] = kacc[r];
            asm volatile("s_waitcnt lgkmcnt(0)" ::: "memory");
            const f32x4 t4 = *(const LAS f32x4*)(Kt + 4 * p);
            u32x2 o; o.x = pk2(t4[0], t4[1]); o.y = pk2(t4[2], t4[3]);
            *(u32x2*)((bf16*)(F.ws + WS_KT) + ((size_t)(l * SGN + g) * 64 + tau) * 256 + 4 * p) = o;
        }
        if (tau >= 1) {
#pragma unroll 4
            for (int ho = 0; ho < 16; ++ho) {
                const float ccr = F.in[9][((size_t)(l * SGN + g) * SG + ho) * SP + p], cci = F.in[10][((size_t)(l * SGN + g) * SG + ho) * SP + p];
                const int n = (tau - 1) * 16 + ho;
                TG[(size_t)n * UGP + 1024 + p] = (bf16)f2bf(ccr * lr - cci * li); TG[(size_t)n * UGP + 1088 + p] = (bf16)f2bf(-(ccr * li + cci * lr)); }
        }
    }
}

__device__ __forceinline__ void route_finish(const float (&a)[20], float ssum, int m, bool act, const float* gb_, const float* rb_, int* tokb, float* tokr, float* tokw, LAS int* hist) {
        const float rstd = 1.f / sqrtf(ssum * (1.f / D) + RMS_EPS);
        float lg0 = a[0] * rstd + gb_[0], lg1 = a[1] * rstd + gb_[1], lg2 = a[2] * rstd + gb_[2], lg3 = a[3] * rstd + gb_[3];
        int gs = 0; float gm = lg0;
        if (lg1 > gm) { gm = lg1; gs = 1; } if (lg2 > gm) { gm = lg2; gs = 2; } if (lg3 > gm) { gm = lg3; gs = 3; }
        const float gwt = 1.f / (__expf(lg0 - gm) + __expf(lg1 - gm) + __expf(lg2 - gm) + __expf(lg3 - gm));
        float q0 = a[4], q1 = a[5], q2 = a[6], q3 = a[7], q4 = a[8], q5 = a[9], q6 = a[10], q7 = a[11], q8 = a[12], q9 = a[13], q10 = a[14], q11 = a[15], q12 = a[16], q13 = a[17], q14 = a[18], q15 = a[19];
        asm volatile("" : "+v"(q0), "+v"(q1), "+v"(q2), "+v"(q3), "+v"(q4), "+v"(q5), "+v"(q6), "+v"(q7));
        asm volatile("" : "+v"(q8), "+v"(q9), "+v"(q10), "+v"(q11), "+v"(q12), "+v"(q13), "+v"(q14), "+v"(q15));
        float e0 = gs == 0 ? q0 : gs == 1 ? q4 : gs == 2 ? q8 : q12;
        float e1 = gs == 0 ? q1 : gs == 1 ? q5 : gs == 2 ? q9 : q13;
        float e2 = gs == 0 ? q2 : gs == 1 ? q6 : gs == 2 ? q10 : q14;
        float e3 = gs == 0 ? q3 : gs == 1 ? q7 : gs == 2 ? q11 : q15;
        e0 = e0 * rstd + rb_[gs * 4 + 0]; e1 = e1 * rstd + rb_[gs * 4 + 1]; e2 = e2 * rstd + rb_[gs * 4 + 2]; e3 = e3 * rstd + rb_[gs * 4 + 3];
        int t1 = 0; float v1 = e0;
        if (e1 > v1) { v1 = e1; t1 = 1; } if (e2 > v1) { v1 = e2; t1 = 2; } if (e3 > v1) { v1 = e3; t1 = 3; }
        int t2 = -1; float v2 = -3.0e38f;
        if (t1 != 0 && e0 > v2) { v2 = e0; t2 = 0; } if (t1 != 1 && e1 > v2) { v2 = e1; t2 = 1; } if (t1 != 2 && e2 > v2) { v2 = e2; t2 = 2; } if (t1 != 3 && e3 > v2) { v2 = e3; t2 = 3; }
        const float p2 = __expf(v2 - v1), w1 = gwt / (1.f + p2), w2 = gwt * p2 / (1.f + p2);
        const int lo = t1 < t2 ? t1 : t2, hi = t1 < t2 ? t2 : t1; const float wlo = t1 < t2 ? w1 : w2, whi = t1 < t2 ? w2 : w1;
        const int pi = lo == 0 ? hi - 1 : (lo == 1 ? hi + 1 : 5), bk = gs * 6 + pi;
        if (act) { tokb[m] = bk; tokr[m] = rstd; tokw[2 * m] = wlo; tokw[2 * m + 1] = whi; __hip_atomic_fetch_add(hist + bk, 1, __ATOMIC_RELAXED, __HIP_MEMORY_SCOPE_WORKGROUP); }
}
__device__ __forceinline__ void ph_route(const Ctx& F0, int l) {
    const Ctx F = launder(F0);
    constexpr int WLD = 1032;
    LAS bf16* Wh = (LAS bf16*)F.lds;
    LAS bf16* Wlo = Wh + 20 * WLD;
    LAS float* LG = (LAS float*)(F.lds + 4 * 20 * WLD);
    LAS int* hist = (LAS int*)(F.lds + 4 * 20 * WLD + 8 * 320 * 4);
    const float* g2 = F.in[18] + l * D;
    const f32x4* gw4 = (const f32x4*)(F.in[19] + (size_t)l * D * 4); const f32x4* rw4 = (const f32x4*)(F.in[21] + (size_t)l * 4 * D * 4);
    const float* gb_ = F.in[20] + l * 4; const float* rb_ = F.in[22] + l * 16;
    for (int idx = F.tid; idx < D * 5; idx += NTHREADS) { const int k = idx % D, q = idx / D;
        f32x4 v = (q == 0) ? gw4[k] : rw4[(q - 1) * D + k]; v = v * g2[k];
#pragma unroll
        for (int i = 0; i < 4; ++i) { const unsigned h = f2bf(v[i]); Wh[(q * 4 + i) * WLD + k] = (bf16)h; Wlo[(q * 4 + i) * WLD + k] = (bf16)f2bf(v[i] - bf2f(h)); } }
    if (F.tid < 32) hist[F.tid] = 0;
    __syncthreads();
    int* tokb = (int*)(F.ws + WS_TOKB); float* tokr = (float*)(F.ws + WS_TOKR); float* tokw = (float*)(F.ws + WS_TOKW);
    const int i16 = F.lane & 15, kq = F.lane >> 4, m0 = F.vcu * 128 + F.wave * 16;
    const u32x4* xr = (const u32x4*)(P_XB(F) + (size_t)(m0 + i16) * D) + kq;
    const int c1 = 16 + (i16 & 3);
    const LAS bf16* bh0 = Wh + i16 * WLD + 8 * kq; const LAS bf16* bl0 = Wlo + i16 * WLD + 8 * kq;
    const LAS bf16* bh1 = Wh + c1 * WLD + 8 * kq;  const LAS bf16* bl1 = Wlo + c1 * WLD + 8 * kq;
    f32x4 acc0 = (f32x4){0.f, 0.f, 0.f, 0.f}, acc1 = acc0; float ss = 0.f;
#pragma unroll 4
    for (int c = 0; c < 32; ++c) {
        const u32x4 xa = xr[4 * c];
        const float x0 = bf2f(xa.x & 0xffffu), x1 = __builtin_bit_cast(float, xa.x & 0xffff0000u), x2 = bf2f(xa.y & 0xffffu), x3 = __builtin_bit_cast(float, xa.y & 0xffff0000u);
        const float x4 = bf2f(xa.z & 0xffffu), x5 = __builtin_bit_cast(float, xa.z & 0xffff0000u), x6 = bf2f(xa.w & 0xffffu), x7 = __builtin_bit_cast(float, xa.w & 0xffff0000u);
        ss += ((x0 * x0 + x1 * x1) + (x2 * x2 + x3 * x3)) + ((x4 * x4 + x5 * x5) + (x6 * x6 + x7 * x7));
        const pg8::bf16x8 av = __builtin_bit_cast(pg8::bf16x8, xa);
        const pg8::bf16x8 h0 = *(const LAS pg8::bf16x8*)(bh0 + 32 * c), l0 = *(const LAS pg8::bf16x8*)(bl0 + 32 * c);
        const pg8::bf16x8 h1 = *(const LAS pg8::bf16x8*)(bh1 + 32 * c), l1 = *(const LAS pg8::bf16x8*)(bl1 + 32 * c);
        acc0 = __builtin_amdgcn_mfma_f32_16x16x32_bf16(av, h0, acc0, 0, 0, 0); acc1 = __builtin_amdgcn_mfma_f32_16x16x32_bf16(av, h1, acc1, 0, 0, 0);
        acc0 = __builtin_amdgcn_mfma_f32_16x16x32_bf16(av, l0, acc0, 0, 0, 0); acc1 = __builtin_amdgcn_mfma_f32_16x16x32_bf16(av, l1, acc1, 0, 0, 0);
    }
    ss += xshfl<16>(ss);
    { const unsigned u = __builtin_bit_cast(unsigned, ss); auto r = __builtin_amdgcn_permlane32_swap(u, u, false, false);
      ss = __builtin_bit_cast(float, (unsigned)r[0]) + __builtin_bit_cast(float, (unsigned)r[1]); }
    LAS float* lg = LG + F.wave * 320;
#pragma unroll
    for (int r = 0; r < 4; ++r) { lg[(4 * kq + r) * 20 + i16] = acc0[r]; if (i16 < 4) lg[(4 * kq + r) * 20 + 16 + i16] = acc1[r]; }
    asm volatile("s_waitcnt lgkmcnt(0)" ::: "memory");
    float a[20];
#pragma unroll
    for (int j = 0; j < 5; ++j) { const f32x4 t4 = *(const LAS f32x4*)(lg + i16 * 20 + 4 * j); a[4 * j] = t4[0]; a[4 * j + 1] = t4[1]; a[4 * j + 2] = t4[2]; a[4 * j + 3] = t4[3]; }
    route_finish(a, ss, m0 + i16, kq == 0, gb_, rb_, tokb, tokr, tokw, hist);
    __syncthreads();
    if (F.tid < 24) __hip_atomic_store((int*)(F.ws + WS_WGCNT) + F.vcu * 24 + F.tid, hist[F.tid], __ATOMIC_RELAXED, __HIP_MEMORY_SCOPE_AGENT);
}
__device__ __forceinline__ void ph_place(const Ctx& F0) {
    const Ctx F = launder(F0);
    LAS int* ptot = (LAS int*)F.lds;
    LAS int* pbef = ptot + 512;
    LAS int* bstart = pbef + 512;
    LAS int* btot = bstart + 32;
    LAS int* carry = btot + 32;
    LAS int* rowidx = carry + 32;
    const int* wgcnt = (const int*)(F.ws + WS_WGCNT);
    int* rowtok = (int*)(F.ws + WS_ROWTOK); float* roww = (float*)(F.ws + WS_ROWW); int* tileb = (int*)(F.ws + WS_TILEB);
    const int* tokb = (const int*)(F.ws + WS_TOKB); const float* tokr = (const float*)(F.ws + WS_TOKR); const float* tokw = (const float*)(F.ws + WS_TOKW);
    { const int p = F.tid >> 5, b = F.tid & 31; int tot = 0, bef = 0;
      if (b < 24) for (int v = p * 16; v < p * 16 + 16; ++v) { const int c = wgcnt[v * 24 + b]; tot += c; if (v < F.vcu) bef += c; }
      ptot[p * 32 + b] = tot; pbef[p * 32 + b] = bef; }
    __syncthreads();
    if (F.tid < 32) { int tot = 0, bef = 0; for (int p = 0; p < 16; ++p) { tot += ptot[p * 32 + F.tid]; bef += pbef[p * 32 + F.tid]; } btot[F.tid] = tot; carry[F.tid] = bef; }
    __syncthreads();
    if (F.tid == 0) { int s = 0; for (int b = 0; b < 24; ++b) { bstart[b] = s; s += (btot[b] + 255) & ~255; } bstart[24] = s; }
    __syncthreads();
    if (F.tid < 24) carry[F.tid] += bstart[F.tid];
    if (F.vcu == 0) {
        if (F.tid == 0) tileb[0] = bstart[24] >> 8;
        for (int b = 0; b < 24; ++b) { const int s = bstart[b], e = bstart[b + 1];
            for (int t = (s >> 8) + F.tid; t < (e >> 8); t += NTHREADS) tileb[1 + t] = b;
            for (int r = s + btot[b] + F.tid; r < e; r += NTHREADS) __hip_atomic_store(rowtok + r, -1, __ATOMIC_RELAXED, __HIP_MEMORY_SCOPE_AGENT); }
    }
    __syncthreads();
    if (F.wave == 0) {
        for (int pass = 0; pass < 2; ++pass) { const int i = pass * 64 + F.lane, bi = tokb[F.vcu * 128 + i]; int row = 0;
#pragma unroll 1
            for (int b = 0; b < 24; ++b) { const unsigned long long mask = __ballot(bi == b); const int c = carry[b];
                if (bi == b) row = c + __builtin_popcountll(mask & ((1ull << F.lane) - 1ull));
                asm volatile("s_waitcnt lgkmcnt(0)" ::: "memory");
                if (F.lane == 0) carry[b] = c + __builtin_popcountll(mask);
                asm volatile("s_waitcnt lgkmcnt(0)" ::: "memory"); }
            rowidx[i] = row; }
    }
    __syncthreads();
    bf16* XS = (bf16*)(F.ws + WS_XS);
    for (int i = 0; i < 16; ++i) {
        const int li = F.wave * 16 + i, m = F.vcu * 128 + li, row = rowidx[li]; const float rstd = tokr[m];
        if (F.lane == 0) {
            __hip_atomic_store(rowtok + row, m, __ATOMIC_RELAXED, __HIP_MEMORY_SCOPE_AGENT);
            const unsigned long long w2 = (unsigned long long)__builtin_bit_cast(unsigned, tokw[2 * m]) | ((unsigned long long)__builtin_bit_cast(unsigned, tokw[2 * m + 1]) << 32);
            __hip_atomic_store((unsigned long long*)(roww + 2 * row), w2, __ATOMIC_RELAXED, __HIP_MEMORY_SCOPE_AGENT); }
        if (F.lane == 0) __hip_atomic_store((float*)(F.ws + WS_ROWR) + row, rstd, __ATOMIC_RELAXED, __HIP_MEMORY_SCOPE_AGENT);
        const u32x4* xr = (const u32x4*)(P_XB(F) + (size_t)m * D) + F.lane; u32x4* o16 = (u32x4*)(XS + (size_t)row * D) + F.lane;
        o16[0] = xr[0]; o16[64] = xr[64];
    }
}
struct MoeOrder {
    const int* tileb; int G, c; bool down;
    __device__ __forceinline__ bool next(int i, pg8::Unit& u) const {
        const GAS int* tb_ = (const GAS int*)tileb;
        const int NT = __builtin_amdgcn_readfirstlane(tb_[0]), L = i * G + c; if (L >= NT * 4) return false;
        const int rt = L >> 2, pn = L & 3, b = __builtin_amdgcn_readfirstlane(tb_[1 + rt]);
        if (down) { u.pm = rt; u.pn = b * 4 + pn; u.aux = pn; }
        else { int ea, eb; pair_decode(b % 6, ea, eb); const int e = (b / 6) * 4 + (pn < 2 ? ea : eb); u.pm = rt; u.pn = e * 2 + (pn & 1); u.aux = pn; }
        return true;
    }
};
struct EpiGU {
    static constexpr bool PERM = true;
    bf16* H; const float* roww; const float* rowr;
    __device__ __forceinline__ void operator()(const f32x4 (&acc)[2][2][4][2], const pg8::Unit& u, int wr, int wc, int fr_, int fq_) const {
        const int ln_ = lane_id(), fr = ln_ & 15, fq = ln_ >> 4; (void)fr_; (void)fq_;
        const int row0 = u.pm * 256 + wr * 64 + fr, cl = u.aux * 128 + 16 * wc + 4 * fq, ws = u.aux >> 1;
#pragma unroll
        for (int ai = 0; ai < 2; ++ai)
#pragma unroll
            for (int m = 0; m < 4; ++m) { const int r = row0 + ai * 128 + m * 16; const float rr = rowr[r], w = roww[2 * r + ws] * rr;
#pragma unroll
                for (int bj = 0; bj < 2; ++bj) { const f32x4 g = acc[ai][bj][m][0], up = acc[ai][bj][m][1]; f32x4 a;
#pragma unroll
                    for (int i = 0; i < 4; ++i) { const float gg = g[i] * rr; a[i] = gg * sigmoidf_(gg) * up[i] * w; }
                    u32x2 o; o.x = pg8::cvt_pk_bf16(a[0], a[1]); o.y = pg8::cvt_pk_bf16(a[2], a[3]);
                    *(u32x2*)(H + (size_t)r * 512 + cl + bj * 64) = o; } }
    }
};
struct EpiDown {
    static constexpr bool PERM = true;
    bf16* RB; const int* rowtok;
    __device__ __forceinline__ void operator()(const f32x4 (&acc)[2][2][4][2], const pg8::Unit& u, int wr, int wc, int fr_, int fq_) const {
        const int ln_ = lane_id(), fr = ln_ & 15, fq = ln_ >> 4; (void)fr_; (void)fq_;
        const int row0 = u.pm * 256 + wr * 64 + fr, col0 = u.aux * 256 + wc * 32 + 8 * fq;
#pragma unroll
        for (int ai = 0; ai < 2; ++ai)
#pragma unroll
            for (int m = 0; m < 4; ++m) { const int tok = rowtok[row0 + ai * 128 + m * 16];
                if (tok >= 0) { bf16* rp = RB + (size_t)tok * D + col0;
#pragma unroll
                    for (int bj = 0; bj < 2; ++bj) { const u32x4 x = *(const u32x4*)(rp + bj * 128); const f32x4 a0 = acc[ai][bj][m][0], a1 = acc[ai][bj][m][1]; u32x4 w;
                        w.x = pg8::cvt_pk_bf16(bf2f(x.x & 0xffffu) + a0[0], bf2f(x.x >> 16) + a0[1]); w.y = pg8::cvt_pk_bf16(bf2f(x.y & 0xffffu) + a0[2], bf2f(x.y >> 16) + a0[3]);
                        w.z = pg8::cvt_pk_bf16(bf2f(x.z & 0xffffu) + a1[0], bf2f(x.z >> 16) + a1[1]); w.w = pg8::cvt_pk_bf16(bf2f(x.w & 0xffffu) + a1[2], bf2f(x.w >> 16) + a1[3]);
                        *(u32x4*)(rp + bj * 128) = w; } }
                if (m & 1) asm volatile("" ::: "memory"); }
    }
};

struct SsmOrder { int G, c, mode;
    __device__ __forceinline__ bool next(int i, pg8::Unit& u) const { const int L = i * G + c;
        if (mode == 1) { if (L >= 32) return false; u.pm = L; u.pn = L >> 1; u.aux = 0; return true; }
        if (L >= 128) return false; const int g = L >> 3; u.pm = g * 2 + ((L >> 2) & 1); u.pn = g * 4 + (L & 3); u.aux = L & 3; return true; } };
struct HalfOrder { int L;
    __device__ __forceinline__ bool next(int i, pg8::Unit& u) const { if (i > 0 || L < 0 || L >= 128) return false; u.pm = L; u.pn = 0; u.aux = 0; return true; } };
struct EpiZ { static constexpr bool PERM = false; float* ZB;
    __device__ __forceinline__ void operator()(const f32x4 (&acc)[2][2][4][2], const pg8::Unit& u, int wr, int wc, int fr_, int fq_) const {
        const int ln_ = lane_id(), fr = ln_ & 15, fq = ln_ >> 4; (void)fr_; (void)fq_;
        const int row0 = u.pm * 256 + wr * 64 + fr, col0 = wc * 32 + 4 * fq;
#pragma unroll
        for (int ai = 0; ai < 2; ++ai)
#pragma unroll
            for (int m = 0; m < 4; ++m)
#pragma unroll
                for (int n = 0; n < 2; ++n) *(f32x4*)(ZB + (size_t)(row0 + ai * 128 + m * 16) * 128 + col0 + n * 16) = acc[ai][0][m][n];
    } };
struct EpiSsm2 { static constexpr bool PERM = true; const bf16* UG; bf16* YS; const float* dvec;
    __device__ __forceinline__ void operator()(const f32x4 (&acc)[2][2][4][2], const pg8::Unit& u, int wr, int wc, int fr_, int fq_) const {
        const int ln_ = lane_id(), fr = ln_ & 15, fq = ln_ >> 4; (void)fr_; (void)fq_;
        const int g = u.pm >> 1, cr0 = (u.pm & 1) * 256 + wr * 64 + fr;
#pragma unroll
        for (int bj = 0; bj < 2; ++bj) { const int n0 = u.aux * 256 + bj * 128 + wc * 32 + 8 * fq, to = n0 >> 4, ho0 = n0 & 15;
            const f32x4 d0 = *(const f32x4*)(dvec + g * 16 + ho0), d1 = *(const f32x4*)(dvec + g * 16 + ho0 + 4);
#pragma unroll
            for (int ai = 0; ai < 2; ++ai)
#pragma unroll
                for (int m = 0; m < 4; ++m) { const int cr = cr0 + ai * 128 + m * 16;
                    const u32x4 uu = *(const u32x4*)(UG + ((size_t)(g * 512 + cr)) * UGP + n0);
                    const f32x4 a0 = acc[ai][bj][m][0], a1 = acc[ai][bj][m][1]; float y[8];
                    y[0] = gelu_tanh(a0[0] + d0[0] * bf2f(uu.x & 0xffffu)); y[1] = gelu_tanh(a0[1] + d0[1] * bf2f(uu.x >> 16));
                    y[2] = gelu_tanh(a0[2] + d0[2] * bf2f(uu.y & 0xffffu)); y[3] = gelu_tanh(a0[3] + d0[3] * bf2f(uu.y >> 16));
                    y[4] = gelu_tanh(a1[0] + d1[0] * bf2f(uu.z & 0xffffu)); y[5] = gelu_tanh(a1[1] + d1[1] * bf2f(uu.z >> 16));
                    y[6] = gelu_tanh(a1[2] + d1[2] * bf2f(uu.w & 0xffffu)); y[7] = gelu_tanh(a1[3] + d1[3] * bf2f(uu.w >> 16));
                    u32x4 w; w.x = pg8::cvt_pk_bf16(y[0], y[1]); w.y = pg8::cvt_pk_bf16(y[2], y[3]); w.z = pg8::cvt_pk_bf16(y[4], y[5]); w.w = pg8::cvt_pk_bf16(y[6], y[7]);
                    *(u32x4*)(YS + ((size_t)cr * 64 + to) * 256 + g * 16 + ho0) = w; } }
    } };
struct EpiGluE { static constexpr bool PERM = true; const bf16* YS; bf16* YMIX; const float* gb;
    __device__ __forceinline__ void operator()(const f32x4 (&acc)[2][2][4][2], const pg8::Unit& u, int wr, int wc, int fr_, int fq_) const {
        const int ln_ = lane_id(), fr = ln_ & 15, fq = ln_ >> 4; (void)fr_; (void)fq_;
        const int row0 = u.pm * 256 + wr * 64 + fr;
#pragma unroll
        for (int bj = 0; bj < 2; ++bj) { const int n0 = bj * 128 + wc * 32 + 8 * fq; const f32x4 b0 = *(const f32x4*)(gb + n0), b1 = *(const f32x4*)(gb + n0 + 4);
#pragma unroll
            for (int ai = 0; ai < 2; ++ai)
#pragma unroll
                for (int m = 0; m < 4; ++m) { const size_t r = (size_t)(row0 + ai * 128 + m * 16); const u32x4 yy = *(const u32x4*)(YS + r * 256 + n0);
                    const f32x4 a0 = acc[ai][bj][m][0] + b0, a1 = acc[ai][bj][m][1] + b1; float o[8];
                    o[0] = bf2f(yy.x & 0xffffu) * sigmoidf_(a0[0]); o[1] = bf2f(yy.x >> 16) * sigmoidf_(a0[1]); o[2] = bf2f(yy.y & 0xffffu) * sigmoidf_(a0[2]); o[3] = bf2f(yy.y >> 16) * sigmoidf_(a0[3]);
                    o[4] = bf2f(yy.z & 0xffffu) * sigmoidf_(a1[0]); o[5] = bf2f(yy.z >> 16) * sigmoidf_(a1[1]); o[6] = bf2f(yy.w & 0xffffu) * sigmoidf_(a1[2]); o[7] = bf2f(yy.w >> 16) * sigmoidf_(a1[3]);
                    u32x4 w; w.x = pg8::cvt_pk_bf16(o[0], o[1]); w.y = pg8::cvt_pk_bf16(o[2], o[3]); w.z = pg8::cvt_pk_bf16(o[4], o[5]); w.w = pg8::cvt_pk_bf16(o[6], o[7]);
                    *(u32x4*)(YMIX + r * 1024 + n0) = w; } }
    } };
struct EpiPoolE { static constexpr bool PERM = true; bf16* YMIX; const float* pb; const float* ps;
    __device__ __forceinline__ void operator()(const f32x4 (&acc)[2][2][4][2], const pg8::Unit& u, int wr, int wc, int fr_, int fq_) const {
        const int ln_ = lane_id(), fr = ln_ & 15, fq = ln_ >> 4; (void)fr_; (void)fq_;
        const int row0 = u.pm * 256 + wr * 64 + fr;
#pragma unroll
        for (int bj = 0; bj < 2; ++bj) { const int n0 = bj * 128 + wc * 32 + 8 * fq; const f32x4 b0 = *(const f32x4*)(pb + n0), b1 = *(const f32x4*)(pb + n0 + 4), s0 = *(const f32x4*)(ps + n0), s1 = *(const f32x4*)(ps + n0 + 4);
#pragma unroll
            for (int ai = 0; ai < 2; ++ai)
#pragma unroll
                for (int m = 0; m < 4; ++m) { const size_t r = (size_t)(row0 + ai * 128 + m * 16);
                    const f32x4 a0 = (acc[ai][bj][m][0] + b0) * s0, a1 = (acc[ai][bj][m][1] + b1) * s1;
                    u32x4 w; w.x = pg8::cvt_pk_bf16(a0[0], a0[1]); w.y = pg8::cvt_pk_bf16(a0[2], a0[3]); w.z = pg8::cvt_pk_bf16(a1[0], a1[1]); w.w = pg8::cvt_pk_bf16(a1[2], a1[3]);
                    *(u32x4*)(YMIX + r * 1024 + 256 + n0) = w; } }
    } };
__device__ __forceinline__ void ph_tg_expand(const Ctx& F0, int l) {
    const Ctx F = launder(F0);
    if (F.wave == 0) return;
    const int gw = F.vcu * 7 + (F.wave - 1), NGW = F.G * 7;
    const bf16* KT = (const bf16*)(F.ws + WS_KT) + (size_t)l * SGN * 64 * 256;
    bf16* TG0 = (bf16*)(F.ws + WS_TG) + (size_t)l * SGN * 1024 * UGP;
#pragma unroll 2
    for (int r = gw; r < SGN * 1024; r += NGW) { const int g = r >> 10, n = r & 1023, to = n >> 4, ho = n & 15;
        bf16* d = TG0 + ((size_t)g * 1024 + n) * UGP;
#pragma unroll
        for (int half = 0; half < 2; ++half) { const int ti = half * 32 + (F.lane >> 1), tau = to - ti;
            u32x4 v = (u32x4){0u, 0u, 0u, 0u};
            if (tau >= 0) v = *(const u32x4*)(KT + (((size_t)g * 64 + tau) * 16 + ho) * 16 + (F.lane & 1) * 8);
            *(u32x4*)(d + half * 512 + F.lane * 8) = v; } }
}
__device__ __forceinline__ void ph_ssm_scan(const Ctx& F0, int l) {
    const Ctx F = launder(F0);
    for (int it = F.vcu + F.G * F.wave; it < SGN * NB; it += F.G * NWAVES) {
        const int g = it >> 3, b = it & 7, p = F.lane;
        const float are = F.in[4][(l * SGN + g) * SP + p], aim = F.in[5][(l * SGN + g) * SP + p], dt = expf(F.in[6][l * SGN + g]);
        float sn, cs; sincosf(aim * dt * 64.f, &sn, &cs); const float mg = expf(are * dt * 64.f), lr = mg * cs, li = mg * sn;
        const float* Z = (const float*)(F.ws + WS_ZB) + ((size_t)g * 512 + b * 64) * 128;
        bf16* U = P_UG(F) + ((size_t)g * 512 + b * 64) * UGP + 1024;
        float sr = 0.f, si = 0.f;
#pragma unroll 1
        for (int c0 = 0; c0 < 64; c0 += 16) {
            float zr[16], zi[16];
#pragma unroll
            for (int j = 0; j < 16; ++j) { zr[j] = Z[(c0 + j) * 128 + p]; zi[j] = Z[(c0 + j) * 128 + 64 + p]; }
#pragma unroll
            for (int j = 0; j < 16; ++j) {
                U[(size_t)(c0 + j) * UGP + p] = (bf16)f2bf(sr); U[(size_t)(c0 + j) * UGP + 64 + p] = (bf16)f2bf(si);
                const float nr = lr * sr - li * si + zr[j], ni = lr * si + li * sr + zi[j]; sr = nr; si = ni; }
        }
    }
}

namespace moba {
using bf16x8 = __attribute__((ext_vector_type(8))) short;
using s16x4 = __attribute__((ext_vector_type(4))) short;
using f32x16 = __attribute__((ext_vector_type(16))) float;
typedef short v4i16_t __attribute__((ext_vector_type(4)));
typedef float f32x2_t __attribute__((ext_vector_type(2))); typedef __bf16 bf16x2_t __attribute__((ext_vector_type(2)));
constexpr int L_K = 0, L_V = 49152, L_TB = 98304, L_KM = L_TB + 4 * 768 * 4, L_END = L_KM + 16 * 64 * 4;
__device__ __forceinline__ unsigned cvtpk(float lo, float hi) { f32x2_t v = {lo, hi}; bf16x2_t b = __builtin_convertvector(v, bf16x2_t); return __builtin_bit_cast(unsigned, b); }
__device__ __forceinline__ s16x4 vtr(const LAS char* p) { return __builtin_bit_cast(s16x4, __builtin_amdgcn_ds_read_tr16_b64_v4i16((LAS v4i16_t*)p)); }
__device__ __forceinline__ float hmax(float v) { const unsigned u = __builtin_bit_cast(unsigned, v); auto r = __builtin_amdgcn_permlane32_swap(u, u, false, false); return fmaxf(__builtin_bit_cast(float, (unsigned)r[0]), __builtin_bit_cast(float, (unsigned)r[1])); }
__device__ __forceinline__ float hsum(float v) { const unsigned u = __builtin_bit_cast(unsigned, v); auto r = __builtin_amdgcn_permlane32_swap(u, u, false, false); return __builtin_bit_cast(float, (unsigned)r[0]) + __builtin_bit_cast(float, (unsigned)r[1]); }

__device__ __forceinline__ void unit(int wave_, int b, int h, int qb, const bf16* Q, const bf16* K, const bf16* V, bf16* O, const float* KMP, const float* BT, LAS char* lds) {
    int lane_ = lane_id(); asm volatile("" : "+v"(lane_)); asm volatile("" : "+s"(b), "+s"(h), "+s"(qb), "+s"(wave_));
    const int wid = wave_, lane = lane_, tid = wid * 64 + lane, r32 = lane & 31, hi = lane >> 5;
    const int NT = 4 * qb + 4, q0 = qb * 256; const size_t rowbase = (size_t)b * SEQ;
    LAS float* tb = (LAS float*)(lds + L_TB); LAS float* km = (LAS float*)(lds + L_KM);
    const float bfar = BT[h * 132 + 128];
    const bf16* ksrc = K + (rowbase + lane) * 512 + h * 64 + wid * 8;
    const bf16* vsrc = V + (rowbase + 16 * (wid & 3) + (lane >> 2)) * 512 + h * 64 + (wid >> 2) * 32 + (lane & 3) * 8;
    u32x4 kreg0 = *(const u32x4*)ksrc, vreg0 = *(const u32x4*)vsrc, kreg1 = *(const u32x4*)(ksrc + (size_t)64 * 512), vreg1 = *(const u32x4*)(vsrc + (size_t)64 * 512);
    u32x4 kreg2 = *(const u32x4*)(ksrc + (size_t)128 * 512), vreg2 = *(const u32x4*)(vsrc + (size_t)128 * 512), kreg3 = *(const u32x4*)(ksrc + (size_t)192 * 512), vreg3 = *(const u32x4*)(vsrc + (size_t)192 * 512);
    bf16x8 qr[4];
    { const bf16* qw = Q + (rowbase + q0 + wid * 32 + r32) * 512 + h * 64 + hi * 8;
#pragma unroll
      for (int d0 = 0; d0 < 4; ++d0) qr[d0] = *(const bf16x8*)(qw + d0 * 16); }
    __syncthreads();
    unsigned selmask = 1u << qb;
    { float g[16];
#pragma unroll
      for (int j = 0; j < 16; ++j) g[j] = 0.f;
#pragma unroll
      for (int d0 = 0; d0 < 4; ++d0)
#pragma unroll
          for (int e = 0; e < 8; ++e) { const float qf = bf2f((unsigned)(unsigned short)qr[d0][e]);
#pragma unroll
              for (int j = 0; j < 16; ++j) g[j] += qf * km[j * 64 + d0 * 16 + hi * 8 + e]; }
#pragma unroll
      for (int j = 0; j < 16; ++j) g[j] = hsum(g[j]);
#pragma unroll
      for (int s = 0; s < 3; ++s) { float bv = -3.0e38f; int bi = -1;
#pragma unroll
          for (int j = 0; j < 16; ++j) { const bool ok = (j < qb) && !((selmask >> j) & 1u) && (g[j] > bv); bv = ok ? g[j] : bv; bi = ok ? j : bi; }
          if (bi >= 0) selmask |= 1u << bi; } }
    { LAS char* kd = lds + L_K + wid * 1024 + lane * 16; LAS char* vd = lds + L_V + wid * 1024 + lane * 16;
      *(LAS u32x4*)kd = kreg0; *(LAS u32x4*)vd = vreg0; *(LAS u32x4*)(kd + 8192) = kreg1; *(LAS u32x4*)(vd + 8192) = vreg1;
      *(LAS u32x4*)(kd + 16384) = kreg2; *(LAS u32x4*)(vd + 16384) = vreg2; *(LAS u32x4*)(kd + 24576) = kreg3; *(LAS u32x4*)(vd + 24576) = vreg3; }
    __syncthreads();
    const int qrel = wid * 32 + r32;
    const LAS char* kp0 = lds + L_K + hi * 1024 + r32 * 16;
    const LAS char* vp0 = lds + L_V + ((lane >> 4) & 1) * 32 + (lane & 3) * 8 + (4 * hi + ((lane & 15) >> 2)) * 64;
    float mref = 0.f, l = 0.f; f32x16 o0 = f32x16{}, o1 = f32x16{};
#define MOBA_CVEC(TT) f32x16 cvec; do { const float ci_ = ((selmask >> ((TT) >> 2)) & 1u) ? (bfar - mref) : -1.0e30f; _Pragma("unroll") for (int r = 0; r < 16; ++r) cvec[r] = ci_; } while (0)
#define MOBA_QK(P0, P1, KB) do { { const bf16x8 a0 = *(const LAS bf16x8*)(kp0 + (KB)), a1 = *(const LAS bf16x8*)(kp0 + (KB) + 512); \
          P0 = __builtin_amdgcn_mfma_f32_32x32x16_bf16(a0, qr[0], cvec, 0, 0, 0); P1 = __builtin_amdgcn_mfma_f32_32x32x16_bf16(a1, qr[0], cvec, 0, 0, 0); } \
        _Pragma("unroll") for (int d0 = 1; d0 < 4; ++d0) { const bf16x8 a0 = *(const LAS bf16x8*)(kp0 + (KB) + d0 * 2048), a1 = *(const LAS bf16x8*)(kp0 + (KB) + d0 * 2048 + 512); \
            P0 = __builtin_amdgcn_mfma_f32_32x32x16_bf16(a0, qr[d0], P0, 0, 0, 0); P1 = __builtin_amdgcn_mfma_f32_32x32x16_bf16(a1, qr[d0], P1, 0, 0, 0); } } while (0)
#define MOBA_NEARMAX(P0, P1, TT, OUT) do { const int jn_ = (TT) - (NT - 8); if (jn_ >= 0) { const int A_ = qrel - 64 * (jn_ - 4) - 4 * hi + 256, s_ = 767 - A_, c_ = s_ & 3; \
            const LAS f32x4* t4 = (const LAS f32x4*)(tb + c_ * 768 + (s_ - c_)); \
            _Pragma("unroll") for (int g = 0; g < 4; ++g) { const f32x4 x0 = t4[2 * g], x1 = t4[2 * g + 8]; \
                _Pragma("unroll") for (int j = 0; j < 4; ++j) { P0[4 * g + j] += x0[j]; P1[4 * g + j] += x1[j]; } } } \
        float ra = __builtin_fmaxf(__builtin_fmaxf(P0[0], P0[1]), P1[0]), rb = __builtin_fmaxf(__builtin_fmaxf(P0[2], P0[3]), P1[1]); \
        ra = __builtin_fmaxf(__builtin_fmaxf(ra, P1[2]), P1[3]); \
        _Pragma("unroll") for (int r = 4; r < 16; r += 4) { ra = __builtin_fmaxf(__builtin_fmaxf(ra, P0[r]), P0[r + 1]); rb = __builtin_fmaxf(__builtin_fmaxf(rb, P0[r + 2]), P0[r + 3]); \
            ra = __builtin_fmaxf(__builtin_fmaxf(ra, P1[r]), P1[r + 1]); rb = __builtin_fmaxf(__builtin_fmaxf(rb, P1[r + 2]), P1[r + 3]); } \
        OUT = hmax(__builtin_fmaxf(ra, rb)); } while (0)
#define MOBA_STEP(PC0, PC1, PN0, PN1, TT, KBN, VBC, HASN) do { \
        bf16x8 vf[8], kf[8]; \
        if (HASN) { _Pragma("unroll") for (int d0 = 0; d0 < 4; ++d0) { kf[2 * d0] = *(const LAS bf16x8*)(kp0 + (KBN) + d0 * 2048); kf[2 * d0 + 1] = *(const LAS bf16x8*)(kp0 + (KBN) + d0 * 2048 + 512); } } \
        __builtin_amdgcn_sched_barrier(0); \
        if (__any(rm > 8.f)) { const float dl = __builtin_fmaxf(rm, 0.f), alpha = __builtin_amdgcn_exp2f(-dl); mref += dl; l *= alpha; \
            _Pragma("unroll") for (int r = 0; r < 16; ++r) { PC0[r] -= dl; PC1[r] -= dl; o0[r] *= alpha; o1[r] *= alpha; } } \
        if (HASN) { MOBA_CVEC((TT) + 1);       \
                    PN0 = __builtin_amdgcn_mfma_f32_32x32x16_bf16(kf[0], qr[0], cvec, 0, 0, 0); PN1 = __builtin_amdgcn_mfma_f32_32x32x16_bf16(kf[1], qr[0], cvec, 0, 0, 0); \
                    _Pragma("unroll") for (int d0 = 1; d0 < 4; ++d0) { PN0 = __builtin_amdgcn_mfma_f32_32x32x16_bf16(kf[2 * d0], qr[d0], PN0, 0, 0, 0); PN1 = __builtin_amdgcn_mfma_f32_32x32x16_bf16(kf[2 * d0 + 1], qr[d0], PN1, 0, 0, 0); } } \
        { const LAS char* vp = vp0 + (VBC); \
        _Pragma("unroll") for (int k = 0; k < 4; ++k) { \
            const s16x4 lo0 = vtr(vp + k * 1024), hi0 = vtr(vp + k * 1024 + 512), lo1 = vtr(vp + 4096 + k * 1024), hi1 = vtr(vp + 4096 + k * 1024 + 512); \
            vf[2 * k] = (bf16x8){lo0[0], lo0[1], lo0[2], lo0[3], hi0[0], hi0[1], hi0[2], hi0[3]}; vf[2 * k + 1] = (bf16x8){lo1[0], lo1[1], lo1[2], lo1[3], hi1[0], hi1[1], hi1[2], hi1[3]}; } } \
        __builtin_amdgcn_sched_barrier(0); \
        float s0 = 0.f, s1 = 0.f; u32x4 pw[4]; \
        _Pragma("unroll") for (int r = 0; r < 16; ++r) { PC0[r] = __builtin_amdgcn_exp2f(PC0[r]); PC1[r] = __builtin_amdgcn_exp2f(PC1[r]); s0 += PC0[r]; s1 += PC1[r]; } \
        l += s0 + s1; \
        _Pragma("unroll") for (int q = 0; q < 4; ++q) { pw[0][q] = cvtpk(PC0[2 * q], PC0[2 * q + 1]); pw[1][q] = cvtpk(PC0[8 + 2 * q], PC0[9 + 2 * q]); pw[2][q] = cvtpk(PC1[2 * q], PC1[2 * q + 1]); pw[3][q] = cvtpk(PC1[8 + 2 * q], PC1[9 + 2 * q]); } \
        _Pragma("unroll") for (int k = 0; k < 4; ++k) { const bf16x8 pa = __builtin_bit_cast(bf16x8, pw[k]); \
            o0 = __builtin_amdgcn_mfma_f32_32x32x16_bf16(vf[2 * k], pa, o0, 0, 0, 0); o1 = __builtin_amdgcn_mfma_f32_32x32x16_bf16(vf[2 * k + 1], pa, o1, 0, 0, 0); } \
        if (HASN) MOBA_NEARMAX(PN0, PN1, (TT) + 1, rm); \
    } while (0)
    f32x16 pa0, pa1, pb0, pb1; float rm;
    { MOBA_CVEC(0); MOBA_QK(pa0, pa1, 0); } MOBA_NEARMAX(pa0, pa1, 0, rm);
    const int NP = NT >> 1;
    int bufc = 0, bufn = 16384, bufw = 32768;
#pragma unroll 1
    for (int ip = 0; ip < NP; ++ip) {
        const int t = 2 * ip;
        if (ip + 2 < NP) { kreg0 = *(const u32x4*)(ksrc + (size_t)(t + 4) * 64 * 512); vreg0 = *(const u32x4*)(vsrc + (size_t)(t + 4) * 64 * 512);
                           kreg1 = *(const u32x4*)(ksrc + (size_t)(t + 5) * 64 * 512); vreg1 = *(const u32x4*)(vsrc + (size_t)(t + 5) * 64 * 512); }
        MOBA_STEP(pa0, pa1, pb0, pb1, t, bufc + 8192, bufc, true);
        MOBA_STEP(pb0, pb1, pa0, pa1, t + 1, bufn, bufc + 8192, (t + 2 < NT));
        if (ip + 2 < NP) { LAS char* kd = lds + L_K + bufw + wid * 1024 + lane * 16; LAS char* vd = lds + L_V + bufw + wid * 1024 + lane * 16;
            *(LAS u32x4*)kd = kreg0; *(LAS u32x4*)vd = vreg0; *(LAS u32x4*)(kd + 8192) = kreg1; *(LAS u32x4*)(vd + 8192) = vreg1; }
        __syncthreads();
        { const int tmp = bufc; bufc = bufn; bufn = bufw; bufw = tmp; }
    }
#undef MOBA_CVEC
#undef MOBA_QK
#undef MOBA_NEARMAX
#undef MOBA_STEP
    const float inv = 1.f / hsum(l);
    bf16* orow = O + (rowbase + q0 + wid * 32 + r32) * 1024 + 512 + h * 64 + 8 * hi;
#pragma unroll
    for (int d0 = 0; d0 < 2; ++d0)
#pragma unroll
        for (int gp = 0; gp < 2; ++gp) { const f32x16& oo = d0 ? o1 : o0; const int ga = 8 * gp, gb = 8 * gp + 4;
            unsigned ax = cvtpk(oo[ga] * inv, oo[ga + 1] * inv), ay = cvtpk(oo[ga + 2] * inv, oo[ga + 3] * inv), bx = cvtpk(oo[gb] * inv, oo[gb + 1] * inv), by = cvtpk(oo[gb + 2] * inv, oo[gb + 3] * inv);
            { auto r = __builtin_amdgcn_permlane32_swap(ax, bx, false, false); ax = r[0]; bx = r[1]; }
            { auto r = __builtin_amdgcn_permlane32_swap(ay, by, false, false); ay = r[0]; by = r[1]; }
            *(u32x4*)(orow + 32 * d0 + 16 * gp) = (u32x4){ax, ay, bx, by}; }
}
__device__ __forceinline__ void phase(int wave, int vcu, const bf16* Q, const bf16* K, const bf16* V, bf16* O, const float* KMP, const float* BT, LAS char* lds) {
    if (vcu >= 256) return;
    const int s = vcu & 3, bh = vcu >> 2;
    {
        int lane_ = lane_id(); asm volatile("" : "+v"(lane_)); const int tid = wave * 64 + lane_, b = bh >> 3, h = bh & 7;
        LAS float* tb = (LAS float*)(lds + L_TB); LAS float* km = (LAS float*)(lds + L_KM); const float bfar = BT[h * 132 + 128];
        for (int i = tid; i < 4 * 768; i += NTHREADS) { const int c = i / 768, j = i % 768, src_ = 767 - (j + c), rel = src_ - 256; tb[i] = (src_ < 0 || rel < 0) ? -1.0e30f : (rel < 128 ? BT[h * 132 + rel] - bfar : 0.f); }
        for (int i = tid; i < 16 * 64; i += NTHREADS) { const int j = i >> 6, d = i & 63, pm = b * 16 + j; km[i] = KMP[pm * 512 + h * 64 + d] + KMP[128 * 512 + pm * 512 + h * 64 + d]; }
    }
#pragma unroll 1
    for (int i = 0; i < 4; ++i) { const int qb = (i == 0) ? s : (i == 1) ? 7 - s : (i == 2) ? 8 + s : 15 - s; unit(wave, bh >> 3, bh & 7, qb, Q, K, V, O, KMP, BT, lds); }
}
}

__device__ __forceinline__ void ph_cvt_x(const Ctx& F0) {
    const Ctx F = launder(F0);
    const int gw = F.vcu * NWAVES + F.wave, NGW = F.G * NWAVES; float* rs1 = (float*)(F.ws + WS_RS1);
    for (int m = gw; m < T; m += NGW) {
        const f32x4* xr = (const f32x4*)(F.in[0] + (size_t)m * D) + F.lane;
        f32x4 v[4]; float s = 0.f;
#pragma unroll
        for (int j = 0; j < 4; ++j) { v[j] = xr[64 * j]; s += (v[j].x * v[j].x + v[j].y * v[j].y) + (v[j].z * v[j].z + v[j].w * v[j].w); }
        const float rstd = 1.f / sqrtf(wave_sum(s) * (1.f / D) + RMS_EPS);
        if (F.lane == 0) rs1[m] = rstd;
        unsigned long long* o8 = (unsigned long long*)(P_XB(F) + (size_t)m * D) + F.lane;
#pragma unroll
        for (int j = 0; j < 4; ++j) o8[64 * j] = (unsigned long long)pk2(v[j].x, v[j].y) | ((unsigned long long)pk2(v[j].z, v[j].w) << 32);
    }
}
__device__ __forceinline__ float row_ssq_bf16(const bf16* row, int lane) {
    const u32x4* xr = (const u32x4*)row + lane; float s = 0.f;
#pragma unroll
    for (int j = 0; j < 2; ++j) { const u32x4 x = xr[64 * j];
        const float a0 = bf2f(x.x & 0xffffu), a1 = bf2f(x.x >> 16), a2 = bf2f(x.y & 0xffffu), a3 = bf2f(x.y >> 16), a4 = bf2f(x.z & 0xffffu), a5 = bf2f(x.z >> 16), a6 = bf2f(x.w & 0xffffu), a7 = bf2f(x.w >> 16);
        s += ((a0 * a0 + a1 * a1) + (a2 * a2 + a3 * a3)) + ((a4 * a4 + a5 * a5) + (a6 * a6 + a7 * a7)); }
    return wave_sum(s);
}
__device__ __forceinline__ void ph_rstd(const Ctx& F0) {
    const Ctx F = launder(F0);
    const int gw = F.vcu * NWAVES + F.wave, NGW = F.G * NWAVES; float* rs1 = (float*)(F.ws + WS_RS1);
    for (int m = gw; m < T; m += NGW) { const float s = row_ssq_bf16(P_XB(F) + (size_t)m * D, F.lane); if (F.lane == 0) rs1[m] = 1.f / sqrtf(s * (1.f / D) + RMS_EPS); }
}

__device__ __forceinline__ void ph_bias_table(const Ctx& F0) {
    const Ctx F = launder(F0);
    if (F.vcu == 0) {
        const float* rel_bias = F.in[1];
        for (int i = F.tid; i < 8 * 132; i += NTHREADS) {
            const int h = i / 132, r = i % 132;
            int bk;
            if (r < 16) bk = r;
            else { bk = 16 + (int)(logf((float)r / 16.f) / logf(8.f) * 16.f); if (bk > 31) bk = 31; }
            P_BT(F)[i] = rel_bias[bk * 8 + h] * LOG2E;
        }
    }
}

__device__ __forceinline__ void ph_pool_dl(const Ctx& F0) {
    const Ctx F = launder(F0);
    const int gt = F.vcu * NTHREADS + F.tid, NGT = F.G * NTHREADS;
    for (int it = gt; it < (T / 32) * 128; it += NGT) {
        const int cp = it & 127, chunk = it >> 7, c = cp * 2, gi = c >> 6, win = 2 << gi, m0 = chunk * 32, t0 = m0 & (SEQ - 1);
        const unsigned* P2 = (const unsigned*)P_PB(F) + cp; unsigned* D2 = (unsigned*)P_DL(F) + cp;
        float s0 = 0.f, s1 = 0.f;
        const int back = (t0 < win) ? t0 : win;
        for (int j = 1; j <= back; ++j) { const unsigned v = P2[(size_t)(m0 - j) * 128]; s0 += bf2f(v & 0xffffu); s1 += bf2f(v >> 16); }
#pragma unroll 4
        for (int i = 0; i < 32; ++i) { const int m = m0 + i, t = t0 + i;
            const unsigned v = P2[(size_t)m * 128]; const float p0 = bf2f(v & 0xffffu), p1 = bf2f(v >> 16);
            s0 += p0; s1 += p1;
            if (t >= win) { const unsigned o = P2[(size_t)(m - win) * 128]; s0 -= bf2f(o & 0xffffu); s1 -= bf2f(o >> 16); }
            const float inv = 1.f / (float)((t + 1 < win) ? t + 1 : win);
            D2[(size_t)m * 128] = pk2(s0 * inv - p0, s1 * inv - p1); }
    }
}
__device__ __forceinline__ void ph_final(const Ctx& F0) {
    const Ctx F = launder(F0);
    const int gw = F.vcu * NWAVES + F.wave, NGW = F.G * NWAVES;
    const f32x4* gf = (const f32x4*)F.in[26];
    for (int m = gw; m < T; m += NGW) {
        const bf16* row = P_XB(F) + (size_t)m * D;
        const float rstd = 1.f / sqrtf(row_ssq_bf16(row, F.lane) * (1.f / D) + RMS_EPS);
        const u32x4* xr = (const u32x4*)row + F.lane; f32x4* orow = (f32x4*)(F.R + (size_t)m * D);
#pragma unroll
        for (int j = 0; j < 2; ++j) { const u32x4 x = xr[64 * j]; const int c4 = 2 * (64 * j + F.lane);
            orow[c4] = (f32x4){bf2f(x.x & 0xffffu), bf2f(x.x >> 16), bf2f(x.y & 0xffffu), bf2f(x.y >> 16)} * rstd * gf[c4];
            orow[c4 + 1] = (f32x4){bf2f(x.z & 0xffffu), bf2f(x.z >> 16), bf2f(x.w & 0xffffu), bf2f(x.w >> 16)} * rstd * gf[c4 + 1]; }
    }
}

constexpr int LDS_BYTES = 147456;
constexpr int MISC_OFF = 131072 + 320;

__global__ void __launch_bounds__(NTHREADS, 2) mk_fwd(Args args) {
    extern __shared__ __attribute__((aligned(16))) unsigned char lds[];
    Ctx F;
    F.lds = (LAS unsigned char*)lds;
    F.wave = __builtin_amdgcn_readfirstlane((int)threadIdx.x >> 6);
    F.lane = lane_id(); F.tid = F.wave * 64 + F.lane;
    F.G = gridDim.x; { const int bx = blockIdx.x; F.vcu = (F.G % 8 == 0) ? (bx % 8) * (F.G / 8) + bx / 8 : bx; }
    F.in = (KargP)__builtin_amdgcn_kernarg_segment_ptr(); F.R = args.out; F.ws = args.ws;
    unsigned char* ws = args.ws;
    volatile LAS unsigned* MISC = (volatile LAS unsigned*)(F.lds + MISC_OFF);
    if (F.tid < 64) MISC[F.tid] = 0u;
    __syncthreads();
    XcdBarrier bar = xcd_barrier_post((unsigned*)(ws + WS_CTL) + CW_BAR, MISC + 8, F.tid == 0);
#define GRID_BAR() do { bar.bar = (unsigned*)(wsl(ws) + WS_CTL) + CW_BAR; xcd_barrier(bar, F.wave); } while (0)
#define FL launder(F)

    ph_bias_table(F);
    ph_prologue(F);
#pragma unroll 1
    for (int l = 0; l < DEPTH; ++l) {
        if (l == 0) ph_cvt_x(F); else ph_rstd(F);
        GRID_BAR();
        { pg8::Gemm g{P_XB(FL), (const bf16*)(wsl(ws) + WS_WIN) + (size_t)l * NPROJ * D, D, D, D}; pg8::StaticOrder S; S.init(T, NPROJ, sl(F.G), sl((int)blockIdx.x));
          EpiProjE E{P_UG(FL), P_PB(FL), P_QB(FL), P_KB(FL), P_VB(FL), P_KMP(FL), (const float*)(wsl(ws) + WS_RS1)}; pg8::gemm_phase(F.lds, g, S, E, sl(F.wave)); }
        GRID_BAR();
        { pg8::Gemm g{P_UG(FL), (const bf16*)(wsl(ws) + WS_BZ) + (size_t)l * SGN * 256 * 1024, UGP, 1024, 1024}; SsmOrder S{sl(F.G), sl((int)blockIdx.x), 1};
          EpiZ E{(float*)(wsl(ws) + WS_ZB)}; pg8::gemm_phase(F.lds, g, S, E, sl(F.wave)); }
        ph_pool_dl(F);
        moba::phase(sl(F.wave), sl(F.vcu), P_QB(FL), P_KB(FL), P_VB(FL), P_YMIX(FL), P_KMP(FL), P_BT(FL), (LAS char*)F.lds);
        GRID_BAR();
        ph_ssm_scan(F, l);
        ph_tg_expand(F, l);
        GRID_BAR();
        { pg8::Gemm g{P_UG(FL), (const bf16*)(wsl(ws) + WS_TG) + (size_t)l * SGN * 1024 * UGP, UGP, UGP, UGP}; SsmOrder S{sl(F.G), sl((int)blockIdx.x), 2};
          EpiSsm2 E{P_UG(FL), P_YS(FL), F.in[11] + l * 256}; pg8::gemm_phase(F.lds, g, S, E, sl(F.wave)); }
        GRID_BAR();
        { pg8::Gemm g{P_YS(FL), (const bf16*)(wsl(ws) + WS_GLUT) + (size_t)l * 65536, 256, 256, 256}; HalfOrder S{sl(F.vcu)};
          EpiGluE E{P_YS(FL), P_YMIX(FL), F.in[13] + l * 256}; pg8::gemm_phase(F.lds, g, S, E, sl(F.wave)); }
        { pg8::Gemm g{P_DL(FL), (const bf16*)(wsl(ws) + WS_POOLT) + (size_t)l * 65536, 256, 256, 256}; HalfOrder S{sl(F.vcu) - 128};
          EpiPoolE E{P_YMIX(FL), F.in[15] + l * 256, F.in[16] + l * 256}; pg8::gemm_phase(F.lds, g, S, E, sl(F.wave)); }
        GRID_BAR();
        { pg8::Gemm g{P_YMIX(FL), (const bf16*)(wsl(ws) + WS_WOUT) + (size_t)l * D * D, D, D, D}; pg8::StaticOrder S; S.init(T, D, sl(F.G), sl((int)blockIdx.x));
          EpiOutE E{P_XB(FL)}; pg8::gemm_phase(F.lds, g, S, E, sl(F.wave)); }
        GRID_BAR();
        ph_route(F, l);
        GRID_BAR();
        ph_place(F);
        GRID_BAR();
        { pg8::Gemm g{(const bf16*)(wsl(ws) + WS_XS), (const bf16*)(wsl(ws) + WS_GU) + (size_t)l * 16 * 512 * D, D, D, D}; MoeOrder S{(const int*)(wsl(ws) + WS_TILEB), sl(F.G), sl((int)blockIdx.x), false};
          EpiGU E{(bf16*)(wsl(ws) + WS_HACT), (const float*)(wsl(ws) + WS_ROWW), (const float*)(wsl(ws) + WS_ROWR)}; pg8::gemm_phase(F.lds, g, S, E, sl(F.wave)); }
        GRID_BAR();
        { pg8::Gemm g{(const bf16*)(wsl(ws) + WS_HACT), (const bf16*)(wsl(ws) + WS_WD) + (size_t)l * 24 * D * 512, 512, 512, 512}; MoeOrder S{(const int*)(wsl(ws) + WS_TILEB), sl(F.G), sl((int)blockIdx.x), true};
          EpiDown E{P_XB(FL), (const int*)(wsl(ws) + WS_ROWTOK)}; pg8::gemm_phase(F.lds, g, S, E, sl(F.wave)); }
        GRID_BAR();
    }
    ph_final(F);
}

extern "C" void kernel_launch(void* const* d_in, const int* in_sizes, int n_in, void* d_out, int out_size, void* d_ws, size_t ws_size, hipStream_t stream) {
    static int grid = 0;
    if (grid == 0) {
        if (n_in != 27 || out_size != T * D || ws_size < WS_END) { fprintf(stderr, "kernel_launch: unexpected shapes (n_in %d out %d ws %zu)\n", n_in, out_size, ws_size); grid = -1; return; }
        int dev = 0, cus = 0, per_cu = 0;
        if (hipGetDevice(&dev) != hipSuccess || hipDeviceGetAttribute(&cus, hipDeviceAttributeMultiprocessorCount, dev) != hipSuccess) { grid = -1; return; }
        if (hipFuncSetAttribute((const void*)mk_fwd, hipFuncAttributeMaxDynamicSharedMemorySize, LDS_BYTES) != hipSuccess) { fprintf(stderr, "kernel_launch: hipFuncSetAttribute failed\n"); grid = -1; return; }
        if (hipOccupancyMaxActiveBlocksPerMultiprocessor(&per_cu, (const void*)mk_fwd, NTHREADS, LDS_BYTES) != hipSuccess || per_cu < 1) { fprintf(stderr, "kernel_launch: occupancy query says %d\n", per_cu); per_cu = 1; }
        (void)hipGetLastError();
        grid = cus;
    }
    if (grid < 0) return;
    (void)hipMemsetAsync((char*)d_ws + WS_CTL, 0, CTL_ZERO_BYTES, stream);
    Args a{};
    for (int i = 0; i < 27; ++i) a.in[i] = (const float*)d_in[i];
    a.out = (float*)d_out; a.ws = (unsigned char*)d_ws; a.pad0 = 0; a.pad1 = 0;
    hipLaunchKernelGGL(mk_fwd, dim3(grid), dim3(NTHREADS), LDS_BYTES, stream, a);
}
```

```cpp
#include <hip/hip_runtime.h>
#include <hip/hip_bf16.h>
#include <cstdio>
#include <cstdint>

#define GAS __attribute__((address_space(1)))
#define LAS __attribute__((address_space(3)))
typedef unsigned short bf16;
typedef float f32x4 __attribute__((ext_vector_type(4)));
typedef unsigned u32x4 __attribute__((ext_vector_type(4)));
typedef unsigned u32x2 __attribute__((ext_vector_type(2)));

constexpr int NB = 8, SEQ = 4096, T = NB * SEQ, D = 1024, NPROJ = 2048, DEPTH = 2;
constexpr int NHEAD = 8, HD = 64, MBLK = 256, NBLK = SEQ / MBLK;
constexpr int SG = 16, SGN = 16, SP = 64, SCH = 64, UGP = 1152;
constexpr float RMS_EPS = 1e-6f;
constexpr float LOG2E = 1.4426950408889634f;
constexpr float C2 = 0.125f * LOG2E;
constexpr int NWAVES = 8, NTHREADS = 512;

constexpr size_t MiB = 1u << 20;
constexpr size_t WS_CTL = 0, CTL_ZERO_BYTES = 1 * MiB;
constexpr size_t WS_XB = 2 * MiB;
constexpr size_t WS_UG = 66 * MiB;
constexpr size_t WS_PB = 84 * MiB;
constexpr size_t WS_QB = 100 * MiB;
constexpr size_t WS_KB = 132 * MiB;
constexpr size_t WS_VB = 164 * MiB;
constexpr size_t WS_YMIX = 196 * MiB;
constexpr size_t WS_YS = 260 * MiB;
constexpr size_t WS_DL = 276 * MiB;
constexpr size_t WS_KMP = 292 * MiB;
constexpr size_t WS_BT = 293 * MiB;
constexpr size_t WS_KT = 297 * MiB;
constexpr size_t WS_SEL = 298 * MiB;
constexpr size_t WS_WIN = 300 * MiB;
constexpr size_t WS_WOUT = 308 * MiB;
constexpr size_t WS_GU = 312 * MiB;
constexpr size_t WS_WD = 344 * MiB;
constexpr size_t WS_TG = 392 * MiB;
constexpr size_t WS_BZ = 464 * MiB;
constexpr size_t WS_GLUT = 480 * MiB;
constexpr size_t WS_POOLT = WS_GLUT + 512 * 1024;
constexpr size_t WS_ZB = 482 * MiB;
constexpr size_t WS_P2B = 486 * MiB;
constexpr size_t WS_ML = 502 * MiB;
constexpr size_t WS_END = 508 * MiB;
constexpr int MOE_MAXT = 152;
constexpr size_t WS_XS = 66 * MiB;
constexpr size_t WS_HACT = 142 * MiB;
constexpr size_t WS_TOKB = 294 * MiB;
constexpr size_t WS_TOKR = WS_TOKB + 128 * 1024;
constexpr size_t WS_TOKW = WS_TOKB + 256 * 1024;
constexpr size_t WS_ROWTOK = 295 * MiB;
constexpr size_t WS_ROWW = WS_ROWTOK + 256 * 1024;
constexpr size_t WS_ROWR = WS_ROWTOK + 576 * 1024;
constexpr size_t WS_RS1 = WS_ROWTOK + 768 * 1024;
constexpr size_t WS_WGCNT = 296 * MiB;
constexpr size_t WS_TILEB = WS_WGCNT + 64 * 1024;

constexpr int CW_BAR = 4096;

__device__ __forceinline__ unsigned f2bf(float f) { unsigned u = __builtin_bit_cast(unsigned, f); return (u + 0x7fffu + ((u >> 16) & 1u)) >> 16; }
__device__ __forceinline__ float bf2f(unsigned h) { return __builtin_bit_cast(float, h << 16); }
__device__ __forceinline__ unsigned pk2(float lo, float hi) { return f2bf(lo) | (f2bf(hi) << 16); }
template <int O> __device__ __forceinline__ float xshfl(float v) {
    if constexpr (O < 32) return __builtin_bit_cast(float, __builtin_amdgcn_ds_swizzle(__builtin_bit_cast(int, v), (O << 10) | 0x1f));
    else { const unsigned u = __builtin_bit_cast(unsigned, v); auto r = __builtin_amdgcn_permlane32_swap(u, u, false, false);
           const float a = __builtin_bit_cast(float, (unsigned)r[0]), b = __builtin_bit_cast(float, (unsigned)r[1]); return (a == v && __builtin_bit_cast(unsigned, a) == u) ? b : a; }
}
__device__ __forceinline__ float wave_sum(float v) {
    v += xshfl<1>(v); v += xshfl<2>(v); v += xshfl<4>(v); v += xshfl<8>(v); v += xshfl<16>(v);
    const unsigned u = __builtin_bit_cast(unsigned, v); auto r = __builtin_amdgcn_permlane32_swap(u, u, false, false);
    return __builtin_bit_cast(float, (unsigned)r[0]) + __builtin_bit_cast(float, (unsigned)r[1]);
}
__device__ __forceinline__ float wave_max(float v) {
    v = fmaxf(v, xshfl<1>(v)); v = fmaxf(v, xshfl<2>(v)); v = fmaxf(v, xshfl<4>(v)); v = fmaxf(v, xshfl<8>(v)); v = fmaxf(v, xshfl<16>(v));
    const unsigned u = __builtin_bit_cast(unsigned, v); auto r = __builtin_amdgcn_permlane32_swap(u, u, false, false);
    return fmaxf(__builtin_bit_cast(float, (unsigned)r[0]), __builtin_bit_cast(float, (unsigned)r[1]));
}
__device__ __forceinline__ float gelu_tanh(float x) {
    const float u = 0.7978845608028654f * (x + 0.044715f * x * x * x);
    const float e = __expf(2.f * u);
    const float th = 1.f - 2.f / (e + 1.f);
    return 0.5f * x * (1.f + th);
}
__device__ __forceinline__ float sigmoidf_(float x) { return 1.f / (1.f + __expf(-x)); }

__device__ __forceinline__ int lane_id() { unsigned m; asm volatile("s_mov_b32 %0, -1" : "=s"(m)); return (int)__builtin_amdgcn_mbcnt_hi(m, __builtin_amdgcn_mbcnt_lo(m, 0u)); }

#define XB_TMO      128
#define XB_XCNT(j)  (256  + 64 * (j))
#define XB_XSUB(j)  (1280 + 64 * (j))
#define XB_XGEN(j)  (2304 + 64 * (j))
#define XB_TOP      3328
#define XB_TOPGEN   3392
#define XCD_BAR_WORDS 3456
#define XB_SPIN_CAP (1u << 22)
__device__ __forceinline__ unsigned xb_ld(unsigned* p)              { return __hip_atomic_load(p, __ATOMIC_RELAXED, __HIP_MEMORY_SCOPE_AGENT); }
__device__ __forceinline__ unsigned xb_add(unsigned* p, unsigned v) { return __hip_atomic_fetch_add(p, v, __ATOMIC_RELAXED, __HIP_MEMORY_SCOPE_AGENT); }
__device__ __forceinline__ unsigned xb_xcc_id() { return (unsigned)__builtin_amdgcn_s_getreg((3 << 11) | 20) & 0xFu; }
#define XB_SPIN(cond, bar) do { unsigned _sp = 0; while (cond) { __builtin_amdgcn_s_sleep(1); \
    if ((++_sp & 255u) == 0u) { if (xb_ld(&(bar)[XB_TMO])) break; if (_sp > XB_SPIN_CAP) { atomicAdd(&(bar)[XB_TMO], 1u); break; } } } } while (0)
struct XcdBarrier { unsigned* bar; unsigned x; volatile LAS unsigned* st; };
__device__ __forceinline__ XcdBarrier xcd_barrier_post(unsigned* bar, volatile LAS unsigned* st, bool t0) {
    XcdBarrier b; b.bar = bar; b.x = xb_xcc_id(); b.st = st;
    if (t0) (void)xb_add(&bar[XB_XCNT(b.x)], 1u);
    return b;
}
__device__ __forceinline__ void xcd_barrier_complete(unsigned* bar, unsigned x, unsigned& nloc, unsigned& nx) {
    const unsigned G = gridDim.x * gridDim.y * gridDim.z;
    unsigned sum, cnt, mine, sp = 0u;
    for (;;) {
        sum = 0u; cnt = 0u; mine = 0u;
#pragma unroll
        for (unsigned j = 0; j < 16; ++j) { const unsigned c = xb_ld(&bar[XB_XCNT(j)]); sum += c; cnt += (c > 0u) ? 1u : 0u; mine = (j == x) ? c : mine; }
        if (sum == G) break;
        __builtin_amdgcn_s_sleep(1);
        if ((++sp & 255u) == 0u) { if (xb_ld(&bar[XB_TMO])) break; if (sp > XB_SPIN_CAP) { atomicAdd(&bar[XB_TMO], 1u); break; } }
    }
    nloc = mine > 0u ? mine : 1u; nx = cnt > 0u ? cnt : 1u;
}
__device__ __forceinline__ void xcd_barrier(const XcdBarrier& b, int wave) {
    asm volatile("s_waitcnt vmcnt(0)" ::: "memory");
    __syncthreads();
    if (wave == 0 && lane_id() == 0) {
        unsigned* bar = b.bar;
        __builtin_amdgcn_s_waitcnt(0);
        unsigned nloc = b.st[0], nx = b.st[1];
        if (nloc == 0u) { xcd_barrier_complete(bar, b.x, nloc, nx); b.st[0] = nloc; b.st[1] = nx; }
        const unsigned old = xb_add(&bar[XB_XSUB(b.x)], 1u);
        const unsigned gen = old / nloc;
        if (old + 1u == (gen + 1u) * nloc) {
            __builtin_amdgcn_fence(__ATOMIC_RELEASE, "agent");
            asm volatile("s_waitcnt vmcnt(0)" ::: "memory");
            const unsigned og = xb_add(&bar[XB_TOP], 1u);
            const unsigned tg = og / nx;
            if (og + 1u == (tg + 1u) * nx) xb_add(&bar[XB_TOPGEN], 1u);
            else XB_SPIN(xb_ld(&bar[XB_TOPGEN]) == tg, bar);
            __builtin_amdgcn_fence(__ATOMIC_ACQUIRE, "agent");
            xb_add(&bar[XB_XGEN(b.x)], 1u);
            asm volatile("s_waitcnt vmcnt(0)" ::: "memory");
        } else {
            XB_SPIN(xb_ld(&bar[XB_XGEN(b.x)]) == gen, bar);
            __builtin_amdgcn_fence(__ATOMIC_ACQUIRE, "agent");
            asm volatile("s_waitcnt vmcnt(0)" ::: "memory");
        }
    }
    __syncthreads();
}

struct Args {
    const float* in[27];
    float* out;
    unsigned char* ws;
    int pad0, pad1;
};

typedef const float* fptr_t;
typedef __attribute__((address_space(4))) const fptr_t* KargP;
struct Ctx {
    LAS unsigned char* lds;
    int tid, lane, wave, vcu, G;
    KargP in;
    float* R;
    unsigned char* ws;
};
#define P_XB(F) ((bf16*)((F).ws + WS_XB))
#define P_UG(F) ((bf16*)((F).ws + WS_UG))
#define P_PB(F) ((bf16*)((F).ws + WS_PB))
#define P_QB(F) ((bf16*)((F).ws + WS_QB))
#define P_KB(F) ((bf16*)((F).ws + WS_KB))
#define P_VB(F) ((bf16*)((F).ws + WS_VB))
#define P_YMIX(F) ((bf16*)((F).ws + WS_YMIX))
#define P_YS(F) ((bf16*)((F).ws + WS_YS))
#define P_DL(F) ((bf16*)((F).ws + WS_DL))
#define P_KMP(F) ((float*)((F).ws + WS_KMP))
#define P_BT(F) ((float*)((F).ws + WS_BT))


__device__ __forceinline__ Ctx launder(const Ctx& F0) {
    Ctx F = F0;
    int ln = lane_id(); asm volatile("" : "+v"(ln));
    asm volatile("" : "+s"(F.wave), "+s"(F.vcu), "+s"(F.G));
    F.lane = ln; F.tid = F.wave * 64 + ln;
    KargP kp = (KargP)__builtin_amdgcn_kernarg_segment_ptr(); asm volatile("" : "+s"(kp));
    F.in = kp; F.R = (float*)kp[27]; F.ws = (unsigned char*)kp[28];
    return F;
}

__device__ __forceinline__ unsigned char* wsl(unsigned char* p) { asm volatile("" : "+s"(p)); return p; }
__device__ __forceinline__ int sl(int x) { asm volatile("" : "+s"(x)); return x; }

namespace pg8 {
typedef short bf16x8 __attribute__((ext_vector_type(8)));
constexpr int BM = 256, BK = 64, HALF = 128, HTB = HALF * BK * 2, STAGE_BYTES = 8 * HTB, NXCD = 8, WGM = 8;
__device__ __forceinline__ int lds_byte(int r, int c) { const int st = (r >> 4) * 2 + (c >> 5), rr = r & 15, cc = c & 31, ob = rr * 64 + cc * 2; return st * 1024 + (ob ^ (((ob >> 9) & 1) << 5)); }
__device__ __forceinline__ void stage_rc(int b, int& R, int& C) { const int st = b / 1024, sb = b % 1024, swz = sb ^ (((sb >> 9) & 1) << 5); R = (st >> 1) * 16 + swz / 64; C = (st & 1) * 32 + (swz % 64) / 2; }
__device__ __forceinline__ int perm32(int rho) { const int n = rho >> 4, i = rho & 15; return 8 * (i >> 2) + 4 * n + (i & 3); }

struct Unit { int pm, pn, aux; };
struct Gemm { const bf16* A; const bf16* Bt; int lda, ldb, K; };

struct StaticOrder {
    int nM, nN, nwg, G, c;
    __device__ void init(int M, int N, int G_, int c_) { nM = M / BM; nN = N / BM; nwg = nM * nN; G = G_; c = c_; }
    __device__ bool next(int i, Unit& u) const {
        const long L = (long)i * G + c; if (L >= nwg) return false;
        int wgid = (int)L; { const int q = nwg / NXCD, r = nwg % NXCD, xcd = wgid % NXCD, off = wgid / NXCD; wgid = (xcd < r ? xcd * (q + 1) : r * (q + 1) + (xcd - r) * q) + off; }
        const int nig = WGM * nN, gid = wgid / nig, fm = gid * WGM, gsz = (nM - fm) < WGM ? (nM - fm) : WGM;
        u.pm = fm + ((wgid % nig) % gsz); u.pn = (wgid % nig) / gsz; u.aux = 0; return true;
    }
};

__device__ __forceinline__ unsigned cvt_pk_bf16(float lo, float hi) { unsigned r; asm volatile("v_cvt_pk_bf16_f32 %0, %1, %2" : "=v"(r) : "v"(lo), "v"(hi)); return r; }

template <bool ALIGN = true, class Epi, class Sched>
__device__ __forceinline__ void gemm_phase(LAS unsigned char* lds, const Gemm g, const Sched& S, const Epi& E, int wave_) {
    int lane_ = lane_id(); asm volatile("" : "+v"(lane_)); asm volatile("" : "+s"(wave_));
    const int wid = wave_, lane = lane_, tid = wid * 64 + lane, wr = wid >> 2, wc = wid & 3, fr = lane & 15, fq = lane >> 4;
    const int K = g.K, nt = K / BK;
    unsigned voffA[2], voffB[2];
#pragma unroll
    for (int i = 0; i < 2; ++i) { int R, C; stage_rc(tid * 16 + i * 8192, R, C); const int Rb = Epi::PERM ? ((R & ~31) + perm32(R & 31)) : R;
        voffA[i] = (unsigned)(R * g.lda + C) * 2u; voffB[i] = (unsigned)(Rb * g.ldb + C) * 2u; }
    const size_t kstep = (size_t)(BK * 2);
    const size_t hstepA = (size_t)HALF * g.lda * 2, hstepB = (size_t)HALF * g.ldb * 2;
    const size_t tstepA = 2 * hstepA, tstepB = 2 * hstepB;
    const unsigned ldsw = (unsigned)wid * 1024u;
    const int aoff = lds_byte(wr * 64 + fr, fq * 8), boff = lds_byte(wc * 32 + fr, fq * 8);
#define PG8_SA(b, h) (((b) * 2 + (h)) * HTB)
#define PG8_SB(b, h) ((4 + (b) * 2 + (h)) * HTB)
#define PG8_STAGE(bufoff, gbase, voff) do { _Pragma("unroll") for (int _i = 0; _i < 2; ++_i) \
        __builtin_amdgcn_global_load_lds((const unsigned*)((const char*)(gbase) + (voff)[_i]), (LAS unsigned*)(lds + (bufoff) + ldsw + _i * 8192), 16, 0, 0); } while (0)
#define PG8_LDA(dst, b, h) do { _Pragma("unroll") for (int m = 0; m < 4; ++m) _Pragma("unroll") for (int k = 0; k < 2; ++k) dst[m][k] = *(const LAS bf16x8*)(lds + PG8_SA(b, h) + aoff + m * 2048 + k * 1024); } while (0)
#define PG8_LDB(dst, b, h) do { _Pragma("unroll") for (int n = 0; n < 2; ++n) _Pragma("unroll") for (int k = 0; k < 2; ++k) dst[n][k] = *(const LAS bf16x8*)(lds + PG8_SB(b, h) + boff + n * 2048 + k * 1024); } while (0)
#define PG8_MMA(ai, bj, At, Bt) do { __builtin_amdgcn_s_setprio(1); _Pragma("unroll") for (int m = 0; m < 4; ++m) _Pragma("unroll") for (int n = 0; n < 2; ++n) _Pragma("unroll") for (int k = 0; k < 2; ++k) \
        acc[ai][bj][m][n] = __builtin_amdgcn_mfma_f32_16x16x32_bf16(Bt[n][k], At[m][k], acc[ai][bj][m][n], 0, 0, 0); __builtin_amdgcn_s_setprio(0); } while (0)
#define PG8_WAIT_V(n) asm volatile("s_waitcnt vmcnt(" #n ")" ::: "memory")
#define PG8_WAIT_L(n) asm volatile("s_waitcnt lgkmcnt(" #n ")" ::: "memory")
#define PG8_BAR __builtin_amdgcn_s_barrier()
#define PG8_SCHED __builtin_amdgcn_sched_barrier(0)
    Unit cur, nxt; int ui = 0;
    if (!S.next(0, cur)) return;
    f32x4 acc[2][2][4][2];
#pragma unroll
    for (int a = 0; a < 2; ++a)
#pragma unroll
        for (int b = 0; b < 2; ++b)
#pragma unroll
            for (int m = 0; m < 4; ++m)
#pragma unroll
                for (int n = 0; n < 2; ++n) acc[a][b][m][n] = (f32x4){0.f, 0.f, 0.f, 0.f};
    bf16x8 At[4][2], B0[2][2], B1[2][2];
    const char* cA = (const char*)g.A + (size_t)cur.pm * tstepA; const char* cB = (const char*)g.Bt + (size_t)cur.pn * tstepB;
    PG8_STAGE(PG8_SB(0, 0), cB, voffB); PG8_STAGE(PG8_SB(0, 1), cB + hstepB, voffB); PG8_STAGE(PG8_SA(0, 0), cA, voffA); PG8_STAGE(PG8_SA(0, 1), cA + hstepA, voffA);
    if (wr == 1) PG8_BAR;
    PG8_WAIT_V(2); PG8_BAR;
    PG8_STAGE(PG8_SB(1, 0), cB + kstep, voffB); PG8_STAGE(PG8_SA(1, 0), cA + kstep, voffA); PG8_STAGE(PG8_SB(1, 1), cB + hstepB + kstep, voffB);
    PG8_WAIT_V(6); PG8_BAR;
    for (;;) {
        const bool has_next = S.next(ui + 1, nxt);
        const char* nA = has_next ? (const char*)g.A + (size_t)nxt.pm * tstepA : cA; const char* nB = has_next ? (const char*)g.Bt + (size_t)nxt.pn * tstepB : cB;
        for (int t = 0; t < nt; t += 2) {
            const bool last = (t == nt - 2);
            const char* a1 = cA + (size_t)(t + 1) * kstep;
            const char* a2 = last ? nA : cA + (size_t)(t + 2) * kstep; const char* b2 = last ? nB : cB + (size_t)(t + 2) * kstep;
            const char* a3 = a2 + kstep; const char* b3 = b2 + kstep;
            PG8_LDB(B0, 0, 0); PG8_LDB(B1, 0, 1); PG8_SCHED; PG8_LDA(At, 0, 0); PG8_STAGE(PG8_SA(1, 1), a1 + hstepA, voffA);
            PG8_WAIT_V(8); PG8_WAIT_L(0); PG8_BAR; PG8_MMA(0, 0, At, B0); PG8_MMA(0, 1, At, B1); PG8_BAR; PG8_SCHED;
            PG8_LDA(At, 0, 1); PG8_STAGE(PG8_SB(0, 0), b2, voffB); PG8_STAGE(PG8_SB(0, 1), b2 + hstepB, voffB); PG8_STAGE(PG8_SA(0, 0), a2, voffA);
            PG8_WAIT_V(8); PG8_WAIT_L(0); PG8_BAR; PG8_MMA(1, 0, At, B0); PG8_MMA(1, 1, At, B1); PG8_BAR; PG8_SCHED;
            PG8_LDB(B0, 1, 0); PG8_LDB(B1, 1, 1); PG8_SCHED; PG8_LDA(At, 1, 0); PG8_STAGE(PG8_SA(0, 1), a2 + hstepA, voffA);
            PG8_WAIT_V(8); PG8_WAIT_L(0); PG8_BAR; PG8_MMA(0, 0, At, B0); PG8_MMA(0, 1, At, B1); PG8_BAR; PG8_SCHED;
            PG8_LDA(At, 1, 1); PG8_STAGE(PG8_SB(1, 0), b3, voffB); PG8_STAGE(PG8_SB(1, 1), b3 + hstepB, voffB); PG8_STAGE(PG8_SA(1, 0), a3, voffA);
            PG8_WAIT_V(8); PG8_WAIT_L(0); PG8_BAR; PG8_MMA(1, 0, At, B0); PG8_MMA(1, 1, At, B1); PG8_BAR; PG8_SCHED;
        }
        if constexpr (ALIGN) { if (wr == 0) PG8_BAR; }
        E(acc, cur, wr, wc, fr, fq);
        if (!has_next) break;
#pragma unroll
        for (int a = 0; a < 2; ++a)
#pragma unroll
            for (int b = 0; b < 2; ++b)
#pragma unroll
                for (int m = 0; m < 4; ++m)
#pragma unroll
                    for (int n = 0; n < 2; ++n) acc[a][b][m][n] = (f32x4){0.f, 0.f, 0.f, 0.f};
        cur = nxt; cA = nA; cB = nB; ++ui;
        if constexpr (ALIGN) { if (wr == 1) PG8_BAR; }
    }
    PG8_WAIT_V(0);
    if constexpr (!ALIGN) { if (wr == 0) PG8_BAR; }
    PG8_BAR;
#undef PG8_SA
#undef PG8_SB
#undef PG8_STAGE
#undef PG8_LDA
#undef PG8_LDB
#undef PG8_MMA
#undef PG8_WAIT_V
#undef PG8_WAIT_L
#undef PG8_BAR
#undef PG8_SCHED
}
}


struct EpiProjE {
    static constexpr bool PERM = true;
    bf16 *UG, *PB, *QB, *KB, *VB; float* KMP; const float* rs1;
    __device__ __forceinline__ void operator()(const f32x4 (&acc_)[2][2][4][2], const pg8::Unit& u, int wr, int wc, int fr_, int fq_) const {
        const int ln_ = lane_id(), fr = ln_ & 15, fq = ln_ >> 4; (void)fr_; (void)fq_;
        const int pn = u.pn, row0 = u.pm * 256 + wr * 64 + fr, cl = wc * 32 + 8 * fq;
        f32x4 acc[2][2][4][2];
#pragma unroll
        for (int ai = 0; ai < 2; ++ai)
#pragma unroll
            for (int m = 0; m < 4; ++m) { const float rs = rs1[row0 + ai * 128 + m * 16];
#pragma unroll
                for (int bj = 0; bj < 2; ++bj) { acc[ai][bj][m][0] = acc_[ai][bj][m][0] * rs; acc[ai][bj][m][1] = acc_[ai][bj][m][1] * rs; } }
        if (pn == 0) {
#pragma unroll
            for (int ai = 0; ai < 2; ++ai)
#pragma unroll
                for (int m = 0; m < 4; ++m) { const int r = row0 + ai * 128 + m * 16;
#pragma unroll
                    for (int bj = 0; bj < 2; ++bj) { const int ch = bj * 128 + cl, g = ch >> 4, h0 = ch & 15;
                        const f32x4 v0 = acc[ai][bj][m][0], v1 = acc[ai][bj][m][1]; u32x4 w;
                        w.x = pg8::cvt_pk_bf16(v0[0], v0[1]); w.y = pg8::cvt_pk_bf16(v0[2], v0[3]); w.z = pg8::cvt_pk_bf16(v1[0], v1[1]); w.w = pg8::cvt_pk_bf16(v1[2], v1[3]);
                        *(u32x4*)(UG + ((size_t)(g * 512 + (r >> 6))) * UGP + (r & 63) * 16 + h0) = w; } }
        } else {
            bf16* base; int ldc, colt; float sc = 1.f;
            if (pn == 1) { base = PB; ldc = 256; colt = 0; }
            else if (pn < 4) { base = QB; ldc = 512; colt = (pn - 2) * 256; sc = C2; }
            else if (pn < 6) { base = KB; ldc = 512; colt = (pn - 4) * 256; }
            else { base = VB; ldc = 512; colt = (pn - 6) * 256; }
#pragma unroll
            for (int ai = 0; ai < 2; ++ai)
#pragma unroll
                for (int m = 0; m < 4; ++m) { bf16* rowp = base + (size_t)(row0 + ai * 128 + m * 16) * ldc + colt + cl;
#pragma unroll
                    for (int bj = 0; bj < 2; ++bj) { const f32x4 v0 = acc[ai][bj][m][0] * sc, v1 = acc[ai][bj][m][1] * sc; u32x4 w;
                        w.x = pg8::cvt_pk_bf16(v0[0], v0[1]); w.y = pg8::cvt_pk_bf16(v0[2], v0[3]); w.z = pg8::cvt_pk_bf16(v1[0], v1[1]); w.w = pg8::cvt_pk_bf16(v1[2], v1[3]);
                        *(u32x4*)(rowp + bj * 128) = w; } }
            if (pn >= 4 && pn < 6) {
#pragma unroll
                for (int bj = 0; bj < 2; ++bj)
#pragma unroll
                    for (int n = 0; n < 2; ++n) { f32x4 s = (f32x4){0.f, 0.f, 0.f, 0.f};
#pragma unroll
                        for (int ai = 0; ai < 2; ++ai)
#pragma unroll
                            for (int m = 0; m < 4; ++m) s += acc[ai][bj][m][n];
#pragma unroll
                        for (int i = 0; i < 4; ++i) { float t = s[i]; t += xshfl<1>(t); t += xshfl<2>(t); t += xshfl<4>(t); t += xshfl<8>(t); s[i] = t; }
                        if (fr == 0) *(f32x4*)(KMP + (size_t)wr * 128 * 512 + (size_t)u.pm * 512 + colt + bj * 128 + cl + 4 * n) = s; }
            }
        }
    }
};
struct EpiOutE {
    static constexpr bool PERM = true;
    bf16* RB;
    __device__ __forceinline__ void operator()(const f32x4 (&acc)[2][2][4][2], const pg8::Unit& u, int wr, int wc, int fr_, int fq_) const {
        const int ln_ = lane_id(), fr = ln_ & 15, fq = ln_ >> 4; (void)fr_; (void)fq_;
        const int row0 = u.pm * 256 + wr * 64 + fr, col0 = u.pn * 256 + wc * 32 + 8 * fq;
#pragma unroll
        for (int ai = 0; ai < 2; ++ai)
#pragma unroll
            for (int m = 0; m < 4; ++m) { bf16* rp = RB + (size_t)(row0 + ai * 128 + m * 16) * D + col0;
#pragma unroll
                for (int bj = 0; bj < 2; ++bj) { const u32x4 x = *(const u32x4*)(rp + bj * 128); const f32x4 a0 = acc[ai][bj][m][0], a1 = acc[ai][bj][m][1]; u32x4 w;
                    w.x = pg8::cvt_pk_bf16(bf2f(x.x & 0xffffu) + a0[0], bf2f(x.x >> 16) + a0[1]); w.y = pg8::cvt_pk_bf16(bf2f(x.y & 0xffffu) + a0[2], bf2f(x.y >> 16) + a0[3]);
                    w.z = pg8::cvt_pk_bf16(bf2f(x.z & 0xffffu) + a1[0], bf2f(x.z >> 16) + a1[1]); w.w = pg8::cvt_pk_bf16(bf2f(x.w & 0xffffu) + a1[2], bf2f(x.w >> 16) + a1[3]);
                    *(u32x4*)(rp + bj * 128) = w; }
                if (m & 1) asm volatile("" ::: "memory"); }
    }
};

__device__ __forceinline__ void transpose_item(const float* W, int K, int N, const float* kscale, bf16* WT, int ldo, int koff, int rowmode, LAS float* scr, int item, int lane) {
    const int nblk = N / 32, kb = item / nblk, nb = item % nblk, k0 = 64 * kb, n0 = 32 * nb;
    { const int r8 = lane >> 3, c4 = lane & 7; f32x4 v[8];
#pragma unroll
      for (int i = 0; i < 8; ++i) v[i] = *(const f32x4*)(W + (size_t)(k0 + 8 * i + r8) * N + n0 + 4 * c4);
#pragma unroll
      for (int i = 0; i < 8; ++i) { const int kk = 8 * i + r8; const float s = kscale ? kscale[k0 + kk] : 1.f; LAS float* d = scr + kk * 33 + 4 * c4;
          d[0] = v[i][0] * s; d[1] = v[i][1] * s; d[2] = v[i][2] * s; d[3] = v[i][3] * s; } }
    asm volatile("s_waitcnt lgkmcnt(0)" ::: "memory");
    const int c = lane & 7;
#pragma unroll
    for (int j = 0; j < 4; ++j) { const int n = (lane >> 3) + 8 * j; const LAS float* s = scr + (8 * c) * 33 + n;
        u32x4 o; o.x = pk2(s[0 * 33], s[1 * 33]); o.y = pk2(s[2 * 33], s[3 * 33]); o.z = pk2(s[4 * 33], s[5 * 33]); o.w = pk2(s[6 * 33], s[7 * 33]);
        const int nn = n0 + n, row = rowmode == 0 ? nn : (8 * (nn >> 2) + (nn & 3) + (rowmode == 2 ? 4 : 0));
        *(u32x4*)(WT + (size_t)row * ldo + koff + k0 + 8 * c) = o; }
    asm volatile("s_waitcnt lgkmcnt(0)" ::: "memory");
}
__device__ __forceinline__ void pair_decode(int pi, int& ea, int& eb) { ea = pi < 3 ? 0 : (pi < 5 ? 1 : 2); eb = pi < 3 ? pi + 1 : (pi < 5 ? pi - 1 : 3); }
__device__ __forceinline__ void ph_prologue(const Ctx& F0) {
    const Ctx F = launder(F0);
    LAS float* scr = (LAS float*)(F.lds + F.wave * 16384);
    const int gw = F.vcu * NWAVES + F.wave, NGW = F.G * NWAVES;
    constexpr int I_IN = (D / 64) * (NPROJ / 32), I_OUT = (D / 64) * (D / 32), I_GU1 = (D / 64) * (256 / 32), I_GU = 16 * 2 * I_GU1, I_WD1 = (256 / 64) * (D / 32), I_WD = 24 * 2 * I_WD1;
    constexpr int I_L = I_IN + I_OUT + I_GU + I_WD;
    for (int it = gw; it < DEPTH * I_L; it += NGW) {
        const int l = it / I_L; int r = it % I_L;
        if (r < I_IN) { transpose_item(F.in[3] + (size_t)l * D * NPROJ, D, NPROJ, F.in[2] + l * D, (bf16*)(F.ws + WS_WIN) + (size_t)l * NPROJ * D, D, 0, 0, scr, r, F.lane); continue; } r -= I_IN;
        if (r < I_OUT) { transpose_item(F.in[17] + (size_t)l * D * D, D, D, nullptr, (bf16*)(F.ws + WS_WOUT) + (size_t)l * D * D, D, 0, 0, scr, r, F.lane); continue; } r -= I_OUT;
        if (r < I_GU) { const int e = r / (2 * I_GU1), up = (r / I_GU1) & 1, item = r % I_GU1;
            transpose_item(F.in[up ? 24 : 23] + ((size_t)l * 16 + e) * D * 256, D, 256, F.in[18] + l * D, (bf16*)(F.ws + WS_GU) + ((size_t)l * 16 + e) * 512 * D, D, 0, 1 + up, scr, item, F.lane); continue; } r -= I_GU;
        { const int bk = r / (2 * I_WD1), half = (r / I_WD1) & 1, item = r % I_WD1, g = bk / 6; int ea, eb; pair_decode(bk % 6, ea, eb); const int e = g * 4 + (half ? eb : ea);
            transpose_item(F.in[25] + ((size_t)l * 16 + e) * 256 * D, 256, D, nullptr, (bf16*)(F.ws + WS_WD) + ((size_t)l * 24 + bk) * D * 512, 512, half * 256, 0, scr, item, F.lane); }
    }
    for (int it = gw; it < DEPTH * 32; it += NGW) { const int l = it >> 5;
        transpose_item(F.in[12] + (size_t)l * 256 * 256, 256, 256, nullptr, (bf16*)(F.ws + WS_GLUT) + (size_t)l * 65536, 256, 0, 0, scr, it & 31, F.lane); }
    { const int gt = F.vcu * NTHREADS + F.tid, NGT = F.G * NTHREADS;
      for (int i = gt; i < DEPTH * 65536; i += NGT) { const int l = i >> 16, n = (i >> 8) & 255, k = i & 255;
          const float v = ((n >> 6) == (k >> 6)) ? F.in[14][(((size_t)l * 4 + (n >> 6)) * 64 + (k & 63)) * 64 + (n & 63)] : 0.f;
          ((bf16*)(F.ws + WS_POOLT))[i] = (bf16)f2bf(v); } }
    for (int it = gw; it < DEPTH * SGN * 65; it += NGW) {
        const int l = it / (SGN * 65), g = (it / 65) % SGN, tau = it % 65, p = F.lane;
        const float are = F.in[4][(l * SGN + g) * SP + p], aim = F.in[5][(l * SGN + g) * SP + p], dt = expf(F.in[6][l * SGN + g]);
        float sn, cs; sincosf(aim * dt, &sn, &cs); const float mg = expf(are * dt), lbr = mg * cs, lbi = mg * sn;
        const float nr = lbr - 1.f, ni = lbi, den = are * are + aim * aim, cr = (nr * are + ni * aim) / den, ci = (ni * are - nr * aim) / den;
        float sn2, cs2; sincosf(aim * dt * (float)tau, &sn2, &cs2); const float mg2 = expf(are * dt * (float)tau), lr = mg2 * cs2, li = mg2 * sn2;
        float wr[16], wi[16];
#pragma unroll
        for (int h = 0; h < 16; ++h) { const float br = F.in[7][((size_t)(l * SGN + g) * SP + p) * SG + h], bi = F.in[8][((size_t)(l * SGN + g) * SP + p) * SG + h];
            const float bbr = cr * br - ci * bi, bbi = cr * bi + ci * br; wr[h] = lr * bbr - li * bbi; wi[h] = lr * bbi + li * bbr; }
        bf16* TG = (bf16*)(F.ws + WS_TG) + ((size_t)l * SGN + g) * 1024 * UGP;
        if (tau <= 63) {
            bf16* BZ = (bf16*)(F.ws + WS_BZ) + ((size_t)l * SGN + g) * 256 * 1024; const int s = 63 - tau;
            u32x4 o0, o1, o2, o3;
            o0.x = pk2(wr[0], wr[1]); o0.y = pk2(wr[2], wr[3]); o0.z = pk2(wr[4], wr[5]); o0.w = pk2(wr[6], wr[7]); o1.x = pk2(wr[8], wr[9]); o1.y = pk2(wr[10], wr[11]); o1.z = pk2(wr[12], wr[13]); o1.w = pk2(wr[14], wr[15]);
            o2.x = pk2(wi[0], wi[1]); o2.y = pk2(wi[2], wi[3]); o2.z = pk2(wi[4], wi[5]); o2.w = pk2(wi[6], wi[7]); o3.x = pk2(wi[8], wi[9]); o3.y = pk2(wi[10], wi[11]); o3.z = pk2(wi[12], wi[13]); o3.w = pk2(wi[14], wi[15]);
            *(u32x4*)(BZ + (size_t)p * 1024 + s * 16) = o0; *(u32x4*)(BZ + (size_t)p * 1024 + s * 16 + 8) = o1;
            *(u32x4*)(BZ + (size_t)(64 + p) * 1024 + s * 16) = o2; *(u32x4*)(BZ + (size_t)(64 + p) * 1024 + s * 16 + 8) = o3;
        }
        LAS float* Wst = scr; LAS float* Kt = scr + 128 * 16;
        if (tau <= 63) {
#pragma unroll
            for (int q = 0; q < 4; ++q) { *(LAS f32x4*)(Wst + p * 16 + 4 * q) = (f32x4){wr[4 * q], wr[4 * q + 1], wr[4 * q + 2], wr[4 * q + 3]};
                                          *(LAS f32x4*)(Wst + (64 + p) * 16 + 4 * q) = (f32x4){wi[4 * q], wi[4 * q + 1], wi[4 * q + 2], wi[4 * q + 3]}; }
            const int arow = p & 15, kq = p >> 4; f32x4 kacc = (f32x4){0.f, 0.f, 0.f, 0.f};
            const float* cre = F.in[9] + ((size_t)(l * SGN + g) * SG + arow) * SP; const float* cim = F.in[10] + ((size_t)(l * SGN + g) * SG + arow) * SP;
#pragma unroll 8
            for (int s = 0; s < 32; ++s) { const int k = 4 * s + kq; const float av = (k < 64) ? cre[k] : -cim[k - 64]; const float bv = Wst[k * 16 + arow];
                kacc = __builtin_amdgcn_mfma_f32_16x16x4f32(av, bv, kacc, 0, 0, 0); }
#pragma unroll
            for (int r = 0; r < 4; ++r) Kt[(4 * kq + r) * 16 + arow] = kacc[r];
            asm volatile("s_waitcnt lgkmcnt(0)" ::: "memory");
            const f32x4 t4 = *(const LAS f32x4*)(Kt + 4 * p);
            u32x2 o; o.x = pk2(t4[0], t4[1]); o.y = pk2(t4[2], t4[3]);
            *(u32x2*)((bf16*)(F.ws + WS_KT) + ((size_t)(l * SGN + g) * 64 + tau) * 256 + 4 * p) = o;
        }
        if (tau >= 1) {
#pragma unroll 4
            for (int ho = 0; ho < 16; ++ho) {
                const float ccr = F.in[9][((size_t)(l * SGN + g) * SG + ho) * SP + p], cci = F.in[10][((size_t)(l * SGN + g) * SG + ho) * SP + p];
                const int n = (tau - 1) * 16 + ho;
                TG[(size_t)n * UGP + 1024 + p] = (bf16)f2bf(ccr * lr - cci * li); TG[(size_t)n * UGP + 1088 + p] = (bf16)f2bf(-(ccr * li + cci * lr)); }
        }
    }
}

__device__ __forceinline__ void route_finish(const float (&a)[20], float ssum, int m, bool act, const float* gb_, const float* rb_, int* tokb, float* tokr, float* tokw, LAS int* hist) {
        const float rstd = 1.f / sqrtf(ssum * (1.f / D) + RMS_EPS);
        float lg0 = a[0] * rstd + gb_[0], lg1 = a[1] * rstd + gb_[1], lg2 = a[2] * rstd + gb_[2], lg3 = a[3] * rstd + gb_[3];
        int gs = 0; float gm = lg0;
        if (lg1 > gm) { gm = lg1; gs = 1; } if (lg2 > gm) { gm = lg2; gs = 2; } if (lg3 > gm) { gm = lg3; gs = 3; }
        const float gwt = 1.f / (__expf(lg0 - gm) + __expf(lg1 - gm) + __expf(lg2 - gm) + __expf(lg3 - gm));
        float q0 = a[4], q1 = a[5], q2 = a[6], q3 = a[7], q4 = a[8], q5 = a[9], q6 = a[10], q7 = a[11], q8 = a[12], q9 = a[13], q10 = a[14], q11 = a[15], q12 = a[16], q13 = a[17], q14 = a[18], q15 = a[19];
        asm volatile("" : "+v"(q0), "+v"(q1), "+v"(q2), "+v"(q3), "+v"(q4), "+v"(q5), "+v"(q6), "+v"(q7));
        asm volatile("" : "+v"(q8), "+v"(q9), "+v"(q10), "+v"(q11), "+v"(q12), "+v"(q13), "+v"(q14), "+v"(q15));
        float e0 = gs == 0 ? q0 : gs == 1 ? q4 : gs == 2 ? q8 : q12;
        float e1 = gs == 0 ? q1 : gs == 1 ? q5 : gs == 2 ? q9 : q13;
        float e2 = gs == 0 ? q2 : gs == 1 ? q6 : gs == 2 ? q10 : q14;
        float e3 = gs == 0 ? q3 : gs == 1 ? q7 : gs == 2 ? q11 : q15;
        e0 = e0 * rstd + rb_[gs * 4 + 0]; e1 = e1 * rstd + rb_[gs * 4 + 1]; e2 = e2 * rstd + rb_[gs * 4 + 2]; e3 = e3 * rstd + rb_[gs * 4 + 3];
        int t1 = 0; float v1 = e0;
        if (e1 > v1) { v1 = e1; t1 = 1; } if (e2 > v1) { v1 = e2; t1 = 2; } if (e3 > v1) { v1 = e3; t1 = 3; }
        int t2 = -1; float v2 = -3.0e38f;
        if (t1 != 0 && e0 > v2) { v2 = e0; t2 = 0; } if (t1 != 1 && e1 > v2) { v2 = e1; t2 = 1; } if (t1 != 2 && e2 > v2) { v2 = e2; t2 = 2; } if (t1 != 3 && e3 > v2) { v2 = e3; t2 = 3; }
        const float p2 = __expf(v2 - v1), w1 = gwt / (1.f + p2), w2 = gwt * p2 / (1.f + p2);
        const int lo = t1 < t2 ? t1 : t2, hi = t1 < t2 ? t2 : t1; const float wlo = t1 < t2 ? w1 : w2, whi = t1 < t2 ? w2 : w1;
        const int pi = lo == 0 ? hi - 1 : (lo == 1 ? hi + 1 : 5), bk = gs * 6 + pi;
        if (act) { tokb[m] = bk; tokr[m] = rstd; tokw[2 * m] = wlo; tokw[2 * m + 1] = whi; __hip_atomic_fetch_add(hist + bk, 1, __ATOMIC_RELAXED, __HIP_MEMORY_SCOPE_WORKGROUP); }
}
__device__ __forceinline__ void ph_route(const Ctx& F0, int l) {
    const Ctx F = launder(F0);
    constexpr int WLD = 1032;
    LAS bf16* Wh = (LAS bf16*)F.lds;
    LAS bf16* Wlo = Wh + 20 * WLD;
    LAS float* LG = (LAS float*)(F.lds + 4 * 20 * WLD);
    LAS int* hist = (LAS int*)(F.lds + 4 * 20 * WLD + 8 * 320 * 4);
    const float* g2 = F.in[18] + l * D;
    const f32x4* gw4 = (const f32x4*)(F.in[19] + (size_t)l * D * 4); const f32x4* rw4 = (const f32x4*)(F.in[21] + (size_t)l * 4 * D * 4);
    const float* gb_ = F.in[20] + l * 4; const float* rb_ = F.in[22] + l * 16;
    for (int idx = F.tid; idx < D * 5; idx += NTHREADS) { const int k = idx % D, q = idx / D;
        f32x4 v = (q == 0) ? gw4[k] : rw4[(q - 1) * D + k]; v = v * g2[k];
#pragma unroll
        for (int i = 0; i < 4; ++i) { const unsigned h = f2bf(v[i]); Wh[(q * 4 + i) * WLD + k] = (bf16)h; Wlo[(q * 4 + i) * WLD + k] = (bf16)f2bf(v[i] - bf2f(h)); } }
    if (F.tid < 32) hist[F.tid] = 0;
    __syncthreads();
    int* tokb = (int*)(F.ws + WS_TOKB); float* tokr = (float*)(F.ws + WS_TOKR); float* tokw = (float*)(F.ws + WS_TOKW);
    const int i16 = F.lane & 15, kq = F.lane >> 4, m0 = F.vcu * 128 + F.wave * 16;
    const u32x4* xr = (const u32x4*)(P_XB(F) + (size_t)(m0 + i16) * D) + kq;
    const int c1 = 16 + (i16 & 3);
    const LAS bf16* bh0 = Wh + i16 * WLD + 8 * kq; const LAS bf16* bl0 = Wlo + i16 * WLD + 8 * kq;
    const LAS bf16* bh1 = Wh + c1 * WLD + 8 * kq;  const LAS bf16* bl1 = Wlo + c1 * WLD + 8 * kq;
    f32x4 acc0 = (f32x4){0.f, 0.f, 0.f, 0.f}, acc1 = acc0; float ss = 0.f;
#pragma unroll 4
    for (int c = 0; c < 32; ++c) {
        const u32x4 xa = xr[4 * c];
        const float x0 = bf2f(xa.x & 0xffffu), x1 = __builtin_bit_cast(float, xa.x & 0xffff0000u), x2 = bf2f(xa.y & 0xffffu), x3 = __builtin_bit_cast(float, xa.y & 0xffff0000u);
        const float x4 = bf2f(xa.z & 0xffffu), x5 = __builtin_bit_cast(float, xa.z & 0xffff0000u), x6 = bf2f(xa.w & 0xffffu), x7 = __builtin_bit_cast(float, xa.w & 0xffff0000u);
        ss += ((x0 * x0 + x1 * x1) + (x2 * x2 + x3 * x3)) + ((x4 * x4 + x5 * x5) + (x6 * x6 + x7 * x7));
        const pg8::bf16x8 av = __builtin_bit_cast(pg8::bf16x8, xa);
        const pg8::bf16x8 h0 = *(const LAS pg8::bf16x8*)(bh0 + 32 * c), l0 = *(const LAS pg8::bf16x8*)(bl0 + 32 * c);
        const pg8::bf16x8 h1 = *(const LAS pg8::bf16x8*)(bh1 + 32 * c), l1 = *(const LAS pg8::bf16x8*)(bl1 + 32 * c);
        acc0 = __builtin_amdgcn_mfma_f32_16x16x32_bf16(av, h0, acc0, 0, 0, 0); acc1 = __builtin_amdgcn_mfma_f32_16x16x32_bf16(av, h1, acc1, 0, 0, 0);
        acc0 = __builtin_amdgcn_mfma_f32_16x16x32_bf16(av, l0, acc0, 0, 0, 0); acc1 = __builtin_amdgcn_mfma_f32_16x16x32_bf16(av, l1, acc1, 0, 0, 0);
    }
    ss += xshfl<16>(ss);
    { const unsigned u = __builtin_bit_cast(unsigned, ss); auto r = __builtin_amdgcn_permlane32_swap(u, u, false, false);
      ss = __builtin_bit_cast(float, (unsigned)r[0]) + __builtin_bit_cast(float, (unsigned)r[1]); }
    LAS float* lg = LG + F.wave * 320;
#pragma unroll
    for (int r = 0; r < 4; ++r) { lg[(4 * kq + r) * 20 + i16] = acc0[r]; if (i16 < 4) lg[(4 * kq + r) * 20 + 16 + i16] = acc1[r]; }
    asm volatile("s_waitcnt lgkmcnt(0)" ::: "memory");
    float a[20];
#pragma unroll
    for (int j = 0; j < 5; ++j) { const f32x4 t4 = *(const LAS f32x4*)(lg + i16 * 20 + 4 * j); a[4 * j] = t4[0]; a[4 * j + 1] = t4[1]; a[4 * j + 2] = t4[2]; a[4 * j + 3] = t4[3]; }
    route_finish(a, ss, m0 + i16, kq == 0, gb_, rb_, tokb, tokr, tokw, hist);
    __syncthreads();
    if (F.tid < 24) __hip_atomic_store((int*)(F.ws + WS_WGCNT) + F.vcu * 24 + F.tid, hist[F.tid], __ATOMIC_RELAXED, __HIP_MEMORY_SCOPE_AGENT);
}
__device__ __forceinline__ void ph_place(const Ctx& F0) {
    const Ctx F = launder(F0);
    LAS int* ptot = (LAS int*)F.lds;
    LAS int* pbef = ptot + 512;
    LAS int* bstart = pbef + 512;
    LAS int* btot = bstart + 32;
    LAS int* carry = btot + 32;
    LAS int* rowidx = carry + 32;
    const int* wgcnt = (const int*)(F.ws + WS_WGCNT);
    int* rowtok = (int*)(F.ws + WS_ROWTOK); float* roww = (float*)(F.ws + WS_ROWW); int* tileb = (int*)(F.ws + WS_TILEB);
    const int* tokb = (const int*)(F.ws + WS_TOKB); const float* tokr = (const float*)(F.ws + WS_TOKR); const float* tokw = (const float*)(F.ws + WS_TOKW);
    { const int p = F.tid >> 5, b = F.tid & 31; int tot = 0, bef = 0;
      if (b < 24) for (int v = p * 16; v < p * 16 + 16; ++v) { const int c = wgcnt[v * 24 + b]; tot += c; if (v < F.vcu) bef += c; }
      ptot[p * 32 + b] = tot; pbef[p * 32 + b] = bef; }
    __syncthreads();
    if (F.tid < 32) { int tot = 0, bef = 0; for (int p = 0; p < 16; ++p) { tot += ptot[p * 32 + F.tid]; bef += pbef[p * 32 + F.tid]; } btot[F.tid] = tot; carry[F.tid] = bef; }
    __syncthreads();
    if (F.tid == 0) { int s = 0; for (int b = 0; b < 24; ++b) { bstart[b] = s; s += (btot[b] + 255) & ~255; } bstart[24] = s; }
    __syncthreads();
    if (F.tid < 24) carry[F.tid] += bstart[F.tid];
    if (F.vcu == 0) {
        if (F.tid == 0) tileb[0] = bstart[24] >> 8;
        for (int b = 0; b < 24; ++b) { const int s = bstart[b], e = bstart[b + 1];
            for (int t = (s >> 8) + F.tid; t < (e >> 8); t += NTHREADS) tileb[1 + t] = b;
            for (int r = s + btot[b] + F.tid; r < e; r += NTHREADS) __hip_atomic_store(rowtok + r, -1, __ATOMIC_RELAXED, __HIP_MEMORY_SCOPE_AGENT); }
    }
    __syncthreads();
    if (F.wave == 0) {
        for (int pass = 0; pass < 2; ++pass) { const int i = pass * 64 + F.lane, bi = tokb[F.vcu * 128 + i]; int row = 0;
#pragma unroll 1
            for (int b = 0; b < 24; ++b) { const unsigned long long mask = __ballot(bi == b); const int c = carry[b];
                if (bi == b) row = c + __builtin_popcountll(mask & ((1ull << F.lane) - 1ull));
                asm volatile("s_waitcnt lgkmcnt(0)" ::: "memory");
                if (F.lane == 0) carry[b] = c + __builtin_popcountll(mask);
                asm volatile("s_waitcnt lgkmcnt(0)" ::: "memory"); }
            rowidx[i] = row; }
    }
    __syncthreads();
    bf16* XS = (bf16*)(F.ws + WS_XS);
    for (int i = 0; i < 16; ++i) {
        const int li = F.wave * 16 + i, m = F.vcu * 128 + li, row = rowidx[li]; const float rstd = tokr[m];
        if (F.lane == 0) {
            __hip_atomic_store(rowtok + row, m, __ATOMIC_RELAXED, __HIP_MEMORY_SCOPE_AGENT);
            const unsigned long long w2 = (unsigned long long)__builtin_bit_cast(unsigned, tokw[2 * m]) | ((unsigned long long)__builtin_bit_cast(unsigned, tokw[2 * m + 1]) << 32);
            __hip_atomic_store((unsigned long long*)(roww + 2 * row), w2, __ATOMIC_RELAXED, __HIP_MEMORY_SCOPE_AGENT); }
        if (F.lane == 0) __hip_atomic_store((float*)(F.ws + WS_ROWR) + row, rstd, __ATOMIC_RELAXED, __HIP_MEMORY_SCOPE_AGENT);
        const u32x4* xr = (const u32x4*)(P_XB(F) + (size_t)m * D) + F.lane; u32x4* o16 = (u32x4*)(XS + (size_t)row * D) + F.lane;
        o16[0] = xr[0]; o16[64] = xr[64];
    }
}
struct MoeOrder {
    const int* tileb; int G, c; bool down;
    __device__ __forceinline__ bool next(int i, pg8::Unit& u) const {
        const GAS int* tb_ = (const GAS int*)tileb;
        const int NT = __builtin_amdgcn_readfirstlane(tb_[0]), L = i * G + c; if (L >= NT * 4) return false;
        const int rt = L >> 2, pn = L & 3, b = __builtin_amdgcn_readfirstlane(tb_[1 + rt]);
        if (down) { u.pm = rt; u.pn = b * 4 + pn; u.aux = pn; }
        else { int ea, eb; pair_decode(b % 6, ea, eb); const int e = (b / 6) * 4 + (pn < 2 ? ea : eb); u.pm = rt; u.pn = e * 2 + (pn & 1); u.aux = pn; }
        return true;
    }
};
struct EpiGU {
    static constexpr bool PERM = true;
    bf16* H; const float* roww; const float* rowr;
    __device__ __forceinline__ void operator()(const f32x4 (&acc)[2][2][4][2], const pg8::Unit& u, int wr, int wc, int fr_, int fq_) const {
        const int ln_ = lane_id(), fr = ln_ & 15, fq = ln_ >> 4; (void)fr_; (void)fq_;
        const int row0 = u.pm * 256 + wr * 64 + fr, cl = u.aux * 128 + 16 * wc + 4 * fq, ws = u.aux >> 1;
#pragma unroll
        for (int ai = 0; ai < 2; ++ai)
#pragma unroll
            for (int m = 0; m < 4; ++m) { const int r = row0 + ai * 128 + m * 16; const float rr = rowr[r], w = roww[2 * r + ws] * rr;
#pragma unroll
                for (int bj = 0; bj < 2; ++bj) { const f32x4 g = acc[ai][bj][m][0], up = acc[ai][bj][m][1]; f32x4 a;
#pragma unroll
                    for (int i = 0; i < 4; ++i) { const float gg = g[i] * rr; a[i] = gg * sigmoidf_(gg) * up[i] * w; }
                    u32x2 o; o.x = pg8::cvt_pk_bf16(a[0], a[1]); o.y = pg8::cvt_pk_bf16(a[2], a[3]);
                    *(u32x2*)(H + (size_t)r * 512 + cl + bj * 64) = o; } }
    }
};
struct EpiDown {
    static constexpr bool PERM = true;
    bf16* RB; const int* rowtok;
    __device__ __forceinline__ void operator()(const f32x4 (&acc)[2][2][4][2], const pg8::Unit& u, int wr, int wc, int fr_, int fq_) const {
        const int ln_ = lane_id(), fr = ln_ & 15, fq = ln_ >> 4; (void)fr_; (void)fq_;
        const int row0 = u.pm * 256 + wr * 64 + fr, col0 = u.aux * 256 + wc * 32 + 8 * fq;
#pragma unroll
        for (int ai = 0; ai < 2; ++ai)
#pragma unroll
            for (int m = 0; m < 4; ++m) { const int tok = rowtok[row0 + ai * 128 + m * 16];
                if (tok >= 0) { bf16* rp = RB + (size_t)tok * D + col0;
#pragma unroll
                    for (int bj = 0; bj < 2; ++bj) { const u32x4 x = *(const u32x4*)(rp + bj * 128); const f32x4 a0 = acc[ai][bj][m][0], a1 = acc[ai][bj][m][1]; u32x4 w;
                        w.x = pg8::cvt_pk_bf16(bf2f(x.x & 0xffffu) + a0[0], bf2f(x.x >> 16) + a0[1]); w.y = pg8::cvt_pk_bf16(bf2f(x.y & 0xffffu) + a0[2], bf2f(x.y >> 16) + a0[3]);
                        w.z = pg8::cvt_pk_bf16(bf2f(x.z & 0xffffu) + a1[0], bf2f(x.z >> 16) + a1[1]); w.w = pg8::cvt_pk_bf16(bf2f(x.w & 0xffffu) + a1[2], bf2f(x.w >> 16) + a1[3]);
                        *(u32x4*)(rp + bj * 128) = w; } }
                if (m & 1) asm volatile("" ::: "memory"); }
    }
};

struct SsmOrder { int G, c, mode;
    __device__ __forceinline__ bool next(int i, pg8::Unit& u) const { const int L = i * G + c;
        if (mode == 1) { if (L >= 32) return false; u.pm = L; u.pn = L >> 1; u.aux = 0; return true; }
        if (L >= 128) return false; const int g = L >> 3; u.pm = g * 2 + ((L >> 2) & 1); u.pn = g * 4 + (L & 3); u.aux = L & 3; return true; } };
struct HalfOrder { int L;
    __device__ __forceinline__ bool next(int i, pg8::Unit& u) const { if (i > 0 || L < 0 || L >= 128) return false; u.pm = L; u.pn = 0; u.aux = 0; return true; } };
struct EpiZ { static constexpr bool PERM = false; float* ZB;
    __device__ __forceinline__ void operator()(const f32x4 (&acc)[2][2][4][2], const pg8::Unit& u, int wr, int wc, int fr_, int fq_) const {
        const int ln_ = lane_id(), fr = ln_ & 15, fq = ln_ >> 4; (void)fr_; (void)fq_;
        const int row0 = u.pm * 256 + wr * 64 + fr, col0 = wc * 32 + 4 * fq;
#pragma unroll
        for (int ai = 0; ai < 2; ++ai)
#pragma unroll
            for (int m = 0; m < 4; ++m)
#pragma unroll
                for (int n = 0; n < 2; ++n) *(f32x4*)(ZB + (size_t)(row0 + ai * 128 + m * 16) * 128 + col0 + n * 16) = acc[ai][0][m][n];
    } };
struct EpiSsm2 { static constexpr bool PERM = true; const bf16* UG; bf16* YS; const float* dvec;
    __device__ __forceinline__ void operator()(const f32x4 (&acc)[2][2][4][2], const pg8::Unit& u, int wr, int wc, int fr_, int fq_) const {
        const int ln_ = lane_id(), fr = ln_ & 15, fq = ln_ >> 4; (void)fr_; (void)fq_;
        const int g = u.pm >> 1, cr0 = (u.pm & 1) * 256 + wr * 64 + fr;
#pragma unroll
        for (int bj = 0; bj < 2; ++bj) { const int n0 = u.aux * 256 + bj * 128 + wc * 32 + 8 * fq, to = n0 >> 4, ho0 = n0 & 15;
            const f32x4 d0 = *(const f32x4*)(dvec + g * 16 + ho0), d1 = *(const f32x4*)(dvec + g * 16 + ho0 + 4);
#pragma unroll
            for (int ai = 0; ai < 2; ++ai)
#pragma unroll
                for (int m = 0; m < 4; ++m) { const int cr = cr0 + ai * 128 + m * 16;
                    const u32x4 uu = *(const u32x4*)(UG + ((size_t)(g * 512 + cr)) * UGP + n0);
                    const f32x4 a0 = acc[ai][bj][m][0], a1 = acc[ai][bj][m][1]; float y[8];
                    y[0] = gelu_tanh(a0[0] + d0[0] * bf2f(uu.x & 0xffffu)); y[1] = gelu_tanh(a0[1] + d0[1] * bf2f(uu.x >> 16));
                    y[2] = gelu_tanh(a0[2] + d0[2] * bf2f(uu.y & 0xffffu)); y[3] = gelu_tanh(a0[3] + d0[3] * bf2f(uu.y >> 16));
                    y[4] = gelu_tanh(a1[0] + d1[0] * bf2f(uu.z & 0xffffu)); y[5] = gelu_tanh(a1[1] + d1[1] * bf2f(uu.z >> 16));
                    y[6] = gelu_tanh(a1[2] + d1[2] * bf2f(uu.w & 0xffffu)); y[7] = gelu_tanh(a1[3] + d1[3] * bf2f(uu.w >> 16));
                    u32x4 w; w.x = pg8::cvt_pk_bf16(y[0], y[1]); w.y = pg8::cvt_pk_bf16(y[2], y[3]); w.z = pg8::cvt_pk_bf16(y[4], y[5]); w.w = pg8::cvt_pk_bf16(y[6], y[7]);
                    *(u32x4*)(YS + ((size_t)cr * 64 + to) * 256 + g * 16 + ho0) = w; } }
    } };
struct EpiGluE { static constexpr bool PERM = true; const bf16* YS; bf16* YMIX; const float* gb;
    __device__ __forceinline__ void operator()(const f32x4 (&acc)[2][2][4][2], const pg8::Unit& u, int wr, int wc, int fr_, int fq_) const {
        const int ln_ = lane_id(), fr = ln_ & 15, fq = ln_ >> 4; (void)fr_; (void)fq_;
        const int row0 = u.pm * 256 + wr * 64 + fr;
#pragma unroll
        for (int bj = 0; bj < 2; ++bj) { const int n0 = bj * 128 + wc * 32 + 8 * fq; const f32x4 b0 = *(const f32x4*)(gb + n0), b1 = *(const f32x4*)(gb + n0 + 4);
#pragma unroll
            for (int ai = 0; ai < 2; ++ai)
#pragma unroll
                for (int m = 0; m < 4; ++m) { const size_t r = (size_t)(row0 + ai * 128 + m * 16); const u32x4 yy = *(const u32x4*)(YS + r * 256 + n0);
                    const f32x4 a0 = acc[ai][bj][m][0] + b0, a1 = acc[ai][bj][m][1] + b1; float o[8];
                    o[0] = bf2f(yy.x & 0xffffu) * sigmoidf_(a0[0]); o[1] = bf2f(yy.x >> 16) * sigmoidf_(a0[1]); o[2] = bf2f(yy.y & 0xffffu) * sigmoidf_(a0[2]); o[3] = bf2f(yy.y >> 16) * sigmoidf_(a0[3]);
                    o[4] = bf2f(yy.z & 0xffffu) * sigmoidf_(a1[0]); o[5] = bf2f(yy.z >> 16) * sigmoidf_(a1[1]); o[6] = bf2f(yy.w & 0xffffu) * sigmoidf_(a1[2]); o[7] = bf2f(yy.w >> 16) * sigmoidf_(a1[3]);
                    u32x4 w; w.x = pg8::cvt_pk_bf16(o[0], o[1]); w.y = pg8::cvt_pk_bf16(o[2], o[3]); w.z = pg8::cvt_pk_bf16(o[4], o[5]); w.w = pg8::cvt_pk_bf16(o[6], o[7]);
                    *(u32x4*)(YMIX + r * 1024 + n0) = w; } }
    } };
struct EpiPoolE { static constexpr bool PERM = true; bf16* YMIX; const float* pb; const float* ps;
    __device__ __forceinline__ void operator()(const f32x4 (&acc)[2][2][4][2], const pg8::Unit& u, int wr, int wc, int fr_, int fq_) const {
        const int ln_ = lane_id(), fr = ln_ & 15, fq = ln_ >> 4; (void)fr_; (void)fq_;
        const int row0 = u.pm * 256 + wr * 64 + fr;
#pragma unroll
        for (int bj = 0; bj < 2; ++bj) { const int n0 = bj * 128 + wc * 32 + 8 * fq; const f32x4 b0 = *(const f32x4*)(pb + n0), b1 = *(const f32x4*)(pb + n0 + 4), s0 = *(const f32x4*)(ps + n0), s1 = *(const f32x4*)(ps + n0 + 4);
#pragma unroll
            for (int ai = 0; ai < 2; ++ai)
#pragma unroll
                for (int m = 0; m < 4; ++m) { const size_t r = (size_t)(row0 + ai * 128 + m * 16);
                    const f32x4 a0 = (acc[ai][bj][m][0] + b0) * s0, a1 = (acc[ai][bj][m][1] + b1) * s1;
                    u32x4 w; w.x = pg8::cvt_pk_bf16(a0[0], a0[1]); w.y = pg8::cvt_pk_bf16(a0[2], a0[3]); w.z = pg8::cvt_pk_bf16(a1[0], a1[1]); w.w = pg8::cvt_pk_bf16(a1[2], a1[3]);
                    *(u32x4*)(YMIX + r * 1024 + 256 + n0) = w; } }
    } };
__device__ __forceinline__ void ph_tg_expand(const Ctx& F0, int l) {
    const Ctx F = launder(F0);
    if (F.wave == 0) return;
    const int gw = F.vcu * 7 + (F.wave - 1), NGW = F.G * 7;
    const bf16* KT = (const bf16*)(F.ws + WS_KT) + (size_t)l * SGN * 64 * 256;
    bf16* TG0 = (bf16*)(F.ws + WS_TG) + (size_t)l * SGN * 1024 * UGP;
#pragma unroll 2
    for (int r = gw; r < SGN * 1024; r += NGW) { const int g = r >> 10, n = r & 1023, to = n >> 4, ho = n & 15;
        bf16* d = TG0 + ((size_t)g * 1024 + n) * UGP;
#pragma unroll
        for (int half = 0; half < 2; ++half) { const int ti = half * 32 + (F.lane >> 1), tau = to - ti;
            u32x4 v = (u32x4){0u, 0u, 0u, 0u};
            if (tau >= 0) v = *(const u32x4*)(KT + (((size_t)g * 64 + tau) * 16 + ho) * 16 + (F.lane & 1) * 8);
            *(u32x4*)(d + half * 512 + F.lane * 8) = v; } }
}
__device__ __forceinline__ void ph_ssm_scan(const Ctx& F0, int l) {
    const Ctx F = launder(F0);
    for (int it = F.vcu + F.G * F.wave; it < SGN * NB; it += F.G * NWAVES) {
        const int g = it >> 3, b = it & 7, p = F.lane;
        const float are = F.in[4][(l * SGN + g) * SP + p], aim = F.in[5][(l * SGN + g) * SP + p], dt = expf(F.in[6][l * SGN + g]);
        float sn, cs; sincosf(aim * dt * 64.f, &sn, &cs); const float mg = expf(are * dt * 64.f), lr = mg * cs, li = mg * sn;
        const float* Z = (const float*)(F.ws + WS_ZB) + ((size_t)g * 512 + b * 64) * 128;
        bf16* U = P_UG(F) + ((size_t)g * 512 + b * 64) * UGP + 1024;
        float sr = 0.f, si = 0.f;
#pragma unroll 1
        for (int c0 = 0; c0 < 64; c0 += 16) {
            float zr[16], zi[16];
#pragma unroll
            for (int j = 0; j < 16; ++j) { zr[j] = Z[(c0 + j) * 128 + p]; zi[j] = Z[(c0 + j) * 128 + 64 + p]; }
#pragma unroll
            for (int j = 0; j < 16; ++j) {
                U[(size_t)(c0 + j) * UGP + p] = (bf16)f2bf(sr); U[(size_t)(c0 + j) * UGP + 64 + p] = (bf16)f2bf(si);
                const float nr = lr * sr - li * si + zr[j], ni = lr * si + li * sr + zi[j]; sr = nr; si = ni; }
        }
    }
}

namespace moba {
using bf16x8 = __attribute__((ext_vector_type(8))) short;
using s16x4 = __attribute__((ext_vector_type(4))) short;
using f32x16 = __attribute__((ext_vector_type(16))) float;
typedef short v4i16_t __attribute__((ext_vector_type(4)));
typedef float f32x2_t __attribute__((ext_vector_type(2))); typedef __bf16 bf16x2_t __attribute__((ext_vector_type(2)));
constexpr int L_K = 0, L_V = 49152, L_TB = 98304, L_KM = L_TB + 4 * 768 * 4, L_END = L_KM + 16 * 64 * 4;
__device__ __forceinline__ unsigned cvtpk(float lo, float hi) { f32x2_t v = {lo, hi}; bf16x2_t b = __builtin_convertvector(v, bf16x2_t); return __builtin_bit_cast(unsigned, b); }
__device__ __forceinline__ s16x4 vtr(const LAS char* p) { return __builtin_bit_cast(s16x4, __builtin_amdgcn_ds_read_tr16_b64_v4i16((LAS v4i16_t*)p)); }
__device__ __forceinline__ float hmax(float v) { const unsigned u = __builtin_bit_cast(unsigned, v); auto r = __builtin_amdgcn_permlane32_swap(u, u, false, false); return fmaxf(__builtin_bit_cast(float, (unsigned)r[0]), __builtin_bit_cast(float, (unsigned)r[1])); }
__device__ __forceinline__ float hsum(float v) { const unsigned u = __builtin_bit_cast(unsigned, v); auto r = __builtin_amdgcn_permlane32_swap(u, u, false, false); return __builtin_bit_cast(float, (unsigned)r[0]) + __builtin_bit_cast(float, (unsigned)r[1]); }

constexpr int L_LIST = L_END, L_WCNT = 32768;
#define MOBA_CVEC() f32x16 cvec; do { const float ci_ = bfar - mref; _Pragma("unroll") for (int r = 0; r < 16; ++r) cvec[r] = ci_; } while (0)
#define MOBA_QK(P0, P1, KB) do { { const bf16x8 a0 = *(const LAS bf16x8*)(kp0 + (KB)), a1 = *(const LAS bf16x8*)(kp0 + (KB) + 512); \
          P0 = __builtin_amdgcn_mfma_f32_32x32x16_bf16(a0, qr[0], cvec, 0, 0, 0); P1 = __builtin_amdgcn_mfma_f32_32x32x16_bf16(a1, qr[0], cvec, 0, 0, 0); } \
        _Pragma("unroll") for (int d0 = 1; d0 < 4; ++d0) { const bf16x8 a0 = *(const LAS bf16x8*)(kp0 + (KB) + d0 * 2048), a1 = *(const LAS bf16x8*)(kp0 + (KB) + d0 * 2048 + 512); \
            P0 = __builtin_amdgcn_mfma_f32_32x32x16_bf16(a0, qr[d0], P0, 0, 0, 0); P1 = __builtin_amdgcn_mfma_f32_32x32x16_bf16(a1, qr[d0], P1, 0, 0, 0); } } while (0)
#define MOBA_NEARMAX(P0, P1, JN, OUT) do { const int jn_ = (JN); if (jn_ >= 0) { const int A_ = qrel - 64 * (jn_ - 4) - 4 * hi + 256, s_ = 767 - A_, c_ = s_ & 3; \
            const LAS f32x4* t4 = (const LAS f32x4*)(tb + c_ * 768 + (s_ - c_)); \
            _Pragma("unroll") for (int g = 0; g < 4; ++g) { const f32x4 x0 = t4[2 * g], x1 = t4[2 * g + 8]; \
                _Pragma("unroll") for (int j = 0; j < 4; ++j) { P0[4 * g + j] += x0[j]; P1[4 * g + j] += x1[j]; } } } \
        float ra = __builtin_fmaxf(__builtin_fmaxf(P0[0], P0[1]), P1[0]), rb = __builtin_fmaxf(__builtin_fmaxf(P0[2], P0[3]), P1[1]); \
        ra = __builtin_fmaxf(__builtin_fmaxf(ra, P1[2]), P1[3]); \
        _Pragma("unroll") for (int r = 4; r < 16; r += 4) { ra = __builtin_fmaxf(__builtin_fmaxf(ra, P0[r]), P0[r + 1]); rb = __builtin_fmaxf(__builtin_fmaxf(rb, P0[r + 2]), P0[r + 3]); \
            ra = __builtin_fmaxf(__builtin_fmaxf(ra, P1[r]), P1[r + 1]); rb = __builtin_fmaxf(__builtin_fmaxf(rb, P1[r + 2]), P1[r + 3]); } \
        OUT = hmax(__builtin_fmaxf(ra, rb)); } while (0)
#define MOBA_STEP(PC0, PC1, PN0, PN1, JNN, KBN, VBC, HASN) do { \
        bf16x8 vf[8], kf[8]; \
        if (HASN) { _Pragma("unroll") for (int d0 = 0; d0 < 4; ++d0) { kf[2 * d0] = *(const LAS bf16x8*)(kp0 + (KBN) + d0 * 2048); kf[2 * d0 + 1] = *(const LAS bf16x8*)(kp0 + (KBN) + d0 * 2048 + 512); } } \
        __builtin_amdgcn_sched_barrier(0); \
        if (__any(rm > 8.f)) { const float dl = __builtin_fmaxf(rm, 0.f), alpha = __builtin_amdgcn_exp2f(-dl); mref += dl; l *= alpha; \
            _Pragma("unroll") for (int r = 0; r < 16; ++r) { PC0[r] -= dl; PC1[r] -= dl; o0[r] *= alpha; o1[r] *= alpha; } } \
        if (HASN) { MOBA_CVEC(); \
                    PN0 = __builtin_amdgcn_mfma_f32_32x32x16_bf16(kf[0], qr[0], cvec, 0, 0, 0); PN1 = __builtin_amdgcn_mfma_f32_32x32x16_bf16(kf[1], qr[0], cvec, 0, 0, 0); \
                    _Pragma("unroll") for (int d0 = 1; d0 < 4; ++d0) { PN0 = __builtin_amdgcn_mfma_f32_32x32x16_bf16(kf[2 * d0], qr[d0], PN0, 0, 0, 0); PN1 = __builtin_amdgcn_mfma_f32_32x32x16_bf16(kf[2 * d0 + 1], qr[d0], PN1, 0, 0, 0); } } \
        { const LAS char* vp = vp0 + (VBC); \
        _Pragma("unroll") for (int k = 0; k < 4; ++k) { \
            const s16x4 lo0 = vtr(vp + k * 1024), hi0 = vtr(vp + k * 1024 + 512), lo1 = vtr(vp + 4096 + k * 1024), hi1 = vtr(vp + 4096 + k * 1024 + 512); \
            vf[2 * k] = (bf16x8){lo0[0], lo0[1], lo0[2], lo0[3], hi0[0], hi0[1], hi0[2], hi0[3]}; vf[2 * k + 1] = (bf16x8){lo1[0], lo1[1], lo1[2], lo1[3], hi1[0], hi1[1], hi1[2], hi1[3]}; } } \
        __builtin_amdgcn_sched_barrier(0); \
        float s0 = 0.f, s1 = 0.f; u32x4 pw[4]; \
        _Pragma("unroll") for (int r = 0; r < 16; ++r) { PC0[r] = __builtin_amdgcn_exp2f(PC0[r]); PC1[r] = __builtin_amdgcn_exp2f(PC1[r]); s0 += PC0[r]; s1 += PC1[r]; } \
        l += s0 + s1; \
        _Pragma("unroll") for (int q = 0; q < 4; ++q) { pw[0][q] = cvtpk(PC0[2 * q], PC0[2 * q + 1]); pw[1][q] = cvtpk(PC0[8 + 2 * q], PC0[9 + 2 * q]); pw[2][q] = cvtpk(PC1[2 * q], PC1[2 * q + 1]); pw[3][q] = cvtpk(PC1[8 + 2 * q], PC1[9 + 2 * q]); } \
        _Pragma("unroll") for (int k = 0; k < 4; ++k) { const bf16x8 pa = __builtin_bit_cast(bf16x8, pw[k]); \
            o0 = __builtin_amdgcn_mfma_f32_32x32x16_bf16(vf[2 * k], pa, o0, 0, 0, 0); o1 = __builtin_amdgcn_mfma_f32_32x32x16_bf16(vf[2 * k + 1], pa, o1, 0, 0, 0); } \
        if (HASN) MOBA_NEARMAX(PN0, PN1, JNN, rm); \
    } while (0)
#define MOBA_BLOCK4(JN0) \
    float mref = 0.f, l = 0.f; f32x16 o0 = f32x16{}, o1 = f32x16{}; f32x16 pa0, pa1, pb0, pb1; float rm; \
    { const int jn0_ = (JN0); \
      { MOBA_CVEC(); MOBA_QK(pa0, pa1, 0); } MOBA_NEARMAX(pa0, pa1, jn0_, rm); \
      MOBA_STEP(pa0, pa1, pb0, pb1, (jn0_ < 0 ? -1 : jn0_ + 1), 8192, 0, true); \
      MOBA_STEP(pb0, pb1, pa0, pa1, (jn0_ < 0 ? -1 : jn0_ + 2), 16384, 8192, true); \
      MOBA_STEP(pa0, pa1, pb0, pb1, (jn0_ < 0 ? -1 : jn0_ + 3), 24576, 16384, true); \
      MOBA_STEP(pb0, pb1, pa0, pa1, -1, 0, 24576, false); }
__device__ __forceinline__ void load_block(const bf16* K, const bf16* V, size_t row0, int h, int wid, int lane, LAS char* lds) {
    const bf16* ksrc = K + (row0 + lane) * 512 + h * 64 + wid * 8;
    const bf16* vsrc = V + (row0 + 16 * (wid & 3) + (lane >> 2)) * 512 + h * 64 + (wid >> 2) * 32 + (lane & 3) * 8;
    u32x4 kr[4], vr[4];
#pragma unroll
    for (int t = 0; t < 4; ++t) { kr[t] = *(const u32x4*)(ksrc + (size_t)t * 64 * 512); vr[t] = *(const u32x4*)(vsrc + (size_t)t * 64 * 512); }
    LAS char* kd = lds + L_K + wid * 1024 + lane * 16; LAS char* vd = lds + L_V + wid * 1024 + lane * 16;
#pragma unroll
    for (int t = 0; t < 4; ++t) { *(LAS u32x4*)(kd + t * 8192) = kr[t]; *(LAS u32x4*)(vd + t * 8192) = vr[t]; }
}
__device__ __forceinline__ void fill_bias_table(const float* BT, int h, int tid, LAS float* tb) {
    const float bfar = BT[h * 132 + 128];
    for (int i = tid; i < 4 * 768; i += NTHREADS) { const int c = i / 768, j = i % 768, src_ = 767 - (j + c), rel = src_ - 256; tb[i] = (src_ < 0 || rel < 0) ? -1.0e30f : (rel < 128 ? BT[h * 132 + rel] - bfar : 0.f); }
}
__device__ __forceinline__ void sel_phase(int wave_, int vcu, const bf16* Q, const float* KMP, unsigned* SEL, LAS char* lds) {
    if (vcu >= 256) return;
    int lane_ = lane_id(); asm volatile("" : "+v"(lane_)); asm volatile("" : "+s"(wave_));
    const int wid = wave_, lane = lane_, tid = wid * 64 + lane, r32 = lane & 31, hi = lane >> 5;
    const int bh = vcu >> 2, s = vcu & 3, b = bh >> 3, h = bh & 7;
    LAS float* km = (LAS float*)(lds + L_KM);
    __syncthreads();
    for (int i = tid; i < 16 * 64; i += NTHREADS) { const int j = i >> 6, d = i & 63, pm = b * 16 + j; km[i] = KMP[pm * 512 + h * 64 + d] + KMP[128 * 512 + pm * 512 + h * 64 + d]; }
    __syncthreads();
#pragma unroll 1
    for (int u = 0; u < 4; ++u) {
        asm volatile("" ::: "memory");
        const int qb = 4 * s + u, q = qb * 256 + wid * 32 + r32;
        const bf16* qw = Q + ((size_t)b * SEQ + q) * 512 + h * 64 + hi * 8;
        bf16x8 qr[4];
#pragma unroll
        for (int d0 = 0; d0 < 4; ++d0) qr[d0] = *(const bf16x8*)(qw + d0 * 16);
        float g[16];
#pragma unroll
        for (int j = 0; j < 16; ++j) g[j] = 0.f;
#pragma unroll
        for (int d0 = 0; d0 < 4; ++d0)
#pragma unroll
            for (int e = 0; e < 8; ++e) { const float qf = bf2f((unsigned)(unsigned short)qr[d0][e]);
#pragma unroll
                for (int j = 0; j < 16; ++j) g[j] += qf * km[j * 64 + d0 * 16 + hi * 8 + e]; }
#pragma unroll
        for (int j = 0; j < 16; ++j) g[j] = hsum(g[j]);
        unsigned selmask = 0u;
#pragma unroll
        for (int s3 = 0; s3 < 3; ++s3) { float bv = -3.0e38f; int bi = -1;
#pragma unroll
            for (int j = 0; j < 16; ++j) { const bool ok = (j < qb) && !((selmask >> j) & 1u) && (g[j] > bv); bv = ok ? g[j] : bv; bi = ok ? j : bi; }
            if (bi >= 0) selmask |= 1u << bi; }
        if (hi == 0) SEL[(size_t)bh * SEQ + q] = selmask;
    }
}
__device__ __forceinline__ bf16* pslot(int slot, size_t t, int h, bf16* YM, bf16* P2A, bf16* P2B) {
    return slot == 0 ? YM + t * 1024 + h * 64 : slot == 1 ? YM + t * 1024 + 512 + h * 64 : (t < (size_t)(T / 2) ? P2A + t * 512 : P2B + (t - (size_t)(T / 2)) * 512) + h * 64;
}
__device__ __forceinline__ void gather_phase(int wave_, int vcu, const bf16* Q, const bf16* K, const bf16* V, bf16* YM, bf16* P2A, bf16* P2B, float* ML, const unsigned* SEL, const float* BT, LAS char* lds) {
    if (vcu >= 256) return;
    int lane_ = lane_id(); asm volatile("" : "+v"(lane_)); asm volatile("" : "+s"(wave_));
    const int wid = wave_, lane = lane_, tid = wid * 64 + lane, r32 = lane & 31, hi = lane >> 5;
    const int bh = vcu >> 2, s = vcu & 3, b = bh >> 3, h = bh & 7;
    const size_t rowbase = (size_t)b * SEQ;
    LAS float* tb = (LAS float*)(lds + L_TB); LAS int* list = (LAS int*)(lds + L_LIST); LAS int* wcnt = (LAS int*)(lds + L_WCNT);
    const float bfar = BT[h * 132 + 128];
    fill_bias_table(BT, h, tid, tb);
    const unsigned* selrow = SEL + (size_t)bh * SEQ;
    const LAS char* kp0 = lds + L_K + hi * 1024 + r32 * 16;
    const LAS char* vp0 = lds + L_V + ((lane >> 4) & 1) * 32 + (lane & 3) * 8 + (4 * hi + ((lane & 15) >> 2)) * 64;
    const unsigned code = s == 0 ? 0xFFFA70u : s == 1 ? 0xFFE961u : s == 2 ? 0xFFFB32u : 0xFDC854u;
#pragma unroll 1
    for (int ik = 0; ik < 6; ++ik) {
        const int kb = (int)((code >> (4 * ik)) & 15u); if (kb == 15) break;
        __syncthreads();
        load_block(K, V, rowbase + (size_t)kb * 256, h, wid, lane, lds);
        const int qs = (kb + 1) * 256, R = (SEQ - qs) >> 3;
        unsigned long long bal[8]; int cnt = 0;
#pragma unroll
        for (int i = 0; i < 8; ++i) { const int off = i * 64 + lane; const bool in = off < R; const unsigned m = in ? selrow[qs + wid * R + off] : 0u;
            bal[i] = __ballot(in && ((m >> kb) & 1u)); cnt += __builtin_popcountll(bal[i]); }
        if (lane == 0) wcnt[wid] = cnt;
        __syncthreads();
        int base = 0, n = 0;
#pragma unroll
        for (int w = 0; w < 8; ++w) { const int c = wcnt[w]; n += c; base += (w < wid) ? c : 0; }
#pragma unroll
        for (int i = 0; i < 8; ++i) { const unsigned long long m = bal[i];
            if ((m >> lane) & 1ull) list[base + __builtin_popcountll(m & ((1ull << lane) - 1ull))] = qs + wid * R + i * 64 + lane;
            base += __builtin_popcountll(m); }
        __syncthreads();
        const int ntask = (n + 31) >> 5;
#pragma unroll 1
        for (int tk = wid; tk < ntask; tk += 8) {
            const int li = tk * 32 + r32; const bool valid = li < n; const int qi = list[valid ? li : n - 1];
            const unsigned sm = selrow[qi]; const int slot = __builtin_popcount(sm & ((1u << kb) - 1u));
            bf16x8 qr[4];
            { const bf16* qw = Q + (rowbase + qi) * 512 + h * 64 + hi * 8;
#pragma unroll
              for (int d0 = 0; d0 < 4; ++d0) qr[d0] = *(const bf16x8*)(qw + d0 * 16); }
            const int qd = qi - qs, qrel = qd < 255 ? qd : 255;
            const bool nearw = __any(qd < 128);
            MOBA_BLOCK4(nearw ? 0 : -1)
            const float lt = hsum(l), inv = 1.f / lt; const size_t t = rowbase + qi;
            bf16* orow = pslot(slot, t, h, YM, P2A, P2B) + 8 * hi;
#pragma unroll
            for (int d0 = 0; d0 < 2; ++d0)
#pragma unroll
                for (int gp = 0; gp < 2; ++gp) { const f32x16& oo = d0 ? o1 : o0; const int ga = 8 * gp, gb = 8 * gp + 4;
                    unsigned ax = cvtpk(oo[ga] * inv, oo[ga + 1] * inv), ay = cvtpk(oo[ga + 2] * inv, oo[ga + 3] * inv), bx = cvtpk(oo[gb] * inv, oo[gb + 1] * inv), by = cvtpk(oo[gb + 2] * inv, oo[gb + 3] * inv);
                    { auto r = __builtin_amdgcn_permlane32_swap(ax, bx, false, false); ax = r[0]; bx = r[1]; }
                    { auto r = __builtin_amdgcn_permlane32_swap(ay, by, false, false); ay = r[0]; by = r[1]; }
                    if (valid) *(u32x4*)(orow + 32 * d0 + 16 * gp) = (u32x4){ax, ay, bx, by}; }
            if (valid && hi == 0) { float* ml = ML + ((t * 8 + h) * 3 + slot) * 2; ml[0] = mref; ml[1] = lt; }
        }
    }
}
__device__ __forceinline__ void diag_unit(int wid, int lane, int b, int h, int qb, const bf16* Q, const bf16* K, const bf16* V, bf16* YM, const bf16* P2A, const bf16* P2B, const float* ML, float bfar, LAS char* lds) {
    const int r32 = lane & 31, hi = lane >> 5; const size_t rowbase = (size_t)b * SEQ;
    LAS float* tb = (LAS float*)(lds + L_TB);
    const LAS char* kp0 = lds + L_K + hi * 1024 + r32 * 16;
    const LAS char* vp0 = lds + L_V + ((lane >> 4) & 1) * 32 + (lane & 3) * 8 + (4 * hi + ((lane & 15) >> 2)) * 64;
    __syncthreads();
    load_block(K, V, rowbase + (size_t)qb * 256, h, wid, lane, lds);
    const int qrel = wid * 32 + r32; const size_t t = rowbase + qb * 256 + qrel;
    bf16x8 qr[4];
    { const bf16* qw = Q + t * 512 + h * 64 + hi * 8;
#pragma unroll
      for (int d0 = 0; d0 < 4; ++d0) qr[d0] = *(const bf16x8*)(qw + d0 * 16); }
    __syncthreads();
    MOBA_BLOCK4(4)
    const int nsl = qb < 3 ? qb : 3;
    const float* ml = ML + (t * 8 + h) * 6;
    float m0 = -3.0e38f, m1 = -3.0e38f, m2 = -3.0e38f, l0 = 0.f, l1 = 0.f, l2 = 0.f;
    if (nsl > 0) { m0 = ml[0]; l0 = ml[1]; } if (nsl > 1) { m1 = ml[2]; l1 = ml[3]; } if (nsl > 2) { m2 = ml[4]; l2 = ml[5]; }
    const float M = __builtin_fmaxf(__builtin_fmaxf(mref, m0), __builtin_fmaxf(m1, m2));
    const float w0 = __builtin_amdgcn_exp2f(mref - M), wa = l0 * __builtin_amdgcn_exp2f(m0 - M), wb = l1 * __builtin_amdgcn_exp2f(m1 - M), wc = l2 * __builtin_amdgcn_exp2f(m2 - M);
    const float inv = 1.f / (hsum(l) * w0 + wa + wb + wc);
    const float s0 = w0 * inv, sa = wa * inv, sb = wb * inv, sc = wc * inv;
    const bf16* pA = YM + t * 1024 + h * 64 + 4 * hi; const bf16* pB = YM + t * 1024 + 512 + h * 64 + 4 * hi;
    const bf16* pC = (t < (size_t)(T / 2) ? P2A + t * 512 : P2B + (t - (size_t)(T / 2)) * 512) + h * 64 + 4 * hi;
    bf16* orow = YM + t * 1024 + 512 + h * 64 + 8 * hi;
#pragma unroll
    for (int d0 = 0; d0 < 2; ++d0)
#pragma unroll
        for (int gp = 0; gp < 2; ++gp) { const f32x16& oo = d0 ? o1 : o0; const int ga = 8 * gp, gb = 8 * gp + 4, dof = 32 * d0 + 16 * gp;
            float a0 = oo[ga] * s0, a1 = oo[ga + 1] * s0, a2 = oo[ga + 2] * s0, a3 = oo[ga + 3] * s0, b0 = oo[gb] * s0, b1 = oo[gb + 1] * s0, b2 = oo[gb + 2] * s0, b3 = oo[gb + 3] * s0;
#define MOBA_ACC(P, W) { const u32x2 xa = *(const u32x2*)((P) + dof), xb = *(const u32x2*)((P) + dof + 8); \
              a0 += (W) * bf2f(xa.x & 0xffffu); a1 += (W) * __builtin_bit_cast(float, xa.x & 0xffff0000u); a2 += (W) * bf2f(xa.y & 0xffffu); a3 += (W) * __builtin_bit_cast(float, xa.y & 0xffff0000u); \
              b0 += (W) * bf2f(xb.x & 0xffffu); b1 += (W) * __builtin_bit_cast(float, xb.x & 0xffff0000u); b2 += (W) * bf2f(xb.y & 0xffffu); b3 += (W) * __builtin_bit_cast(float, xb.y & 0xffff0000u); }
            if (nsl > 0) MOBA_ACC(pA, sa) if (nsl > 1) MOBA_ACC(pB, sb) if (nsl > 2) MOBA_ACC(pC, sc)
#undef MOBA_ACC
            unsigned ax = cvtpk(a0, a1), ay = cvtpk(a2, a3), bx = cvtpk(b0, b1), by = cvtpk(b2, b3);
            { auto r = __builtin_amdgcn_permlane32_swap(ax, bx, false, false); ax = r[0]; bx = r[1]; }
            { auto r = __builtin_amdgcn_permlane32_swap(ay, by, false, false); ay = r[0]; by = r[1]; }
            *(u32x4*)(orow + dof) = (u32x4){ax, ay, bx, by}; }
}
__device__ __forceinline__ void diag_phase(int wave_, int vcu, const bf16* Q, const bf16* K, const bf16* V, bf16* YM, const bf16* P2A, const bf16* P2B, const float* ML, const float* BT, LAS char* lds) {
    if (vcu >= 256) return;
    int lane_ = lane_id(); asm volatile("" : "+v"(lane_)); asm volatile("" : "+s"(wave_));
    const int s = vcu & 3, bh = vcu >> 2, h = bh & 7;
    fill_bias_table(BT, h, wave_ * 64 + lane_, (LAS float*)(lds + L_TB));
    const float bfar = BT[h * 132 + 128];
#pragma unroll 1
    for (int i = 0; i < 4; ++i) { const int qb = (i == 0) ? s : (i == 1) ? 7 - s : (i == 2) ? 8 + s : 15 - s; diag_unit(wave_, lane_, bh >> 3, h, qb, Q, K, V, YM, P2A, P2B, ML, bfar, lds); }
}
#undef MOBA_CVEC
#undef MOBA_QK
#undef MOBA_NEARMAX
#undef MOBA_STEP
#undef MOBA_BLOCK4
}

__device__ __forceinline__ void ph_cvt_x(const Ctx& F0) {
    const Ctx F = launder(F0);
    const int gw = F.vcu * NWAVES + F.wave, NGW = F.G * NWAVES; float* rs1 = (float*)(F.ws + WS_RS1);
    for (int m = gw; m < T; m += NGW) {
        const f32x4* xr = (const f32x4*)(F.in[0] + (size_t)m * D) + F.lane;
        f32x4 v[4]; float s = 0.f;
#pragma unroll
        for (int j = 0; j < 4; ++j) { v[j] = xr[64 * j]; s += (v[j].x * v[j].x + v[j].y * v[j].y) + (v[j].z * v[j].z + v[j].w * v[j].w); }
        const float rstd = 1.f / sqrtf(wave_sum(s) * (1.f / D) + RMS_EPS);
        if (F.lane == 0) rs1[m] = rstd;
        unsigned long long* o8 = (unsigned long long*)(P_XB(F) + (size_t)m * D) + F.lane;
#pragma unroll
        for (int j = 0; j < 4; ++j) o8[64 * j] = (unsigned long long)pk2(v[j].x, v[j].y) | ((unsigned long long)pk2(v[j].z, v[j].w) << 32);
    }
}
__device__ __forceinline__ float row_ssq_bf16(const bf16* row, int lane) {
    const u32x4* xr = (const u32x4*)row + lane; float s = 0.f;
#pragma unroll
    for (int j = 0; j < 2; ++j) { const u32x4 x = xr[64 * j];
        const float a0 = bf2f(x.x & 0xffffu), a1 = bf2f(x.x >> 16), a2 = bf2f(x.y & 0xffffu), a3 = bf2f(x.y >> 16), a4 = bf2f(x.z & 0xffffu), a5 = bf2f(x.z >> 16), a6 = bf2f(x.w & 0xffffu), a7 = bf2f(x.w >> 16);
        s += ((a0 * a0 + a1 * a1) + (a2 * a2 + a3 * a3)) + ((a4 * a4 + a5 * a5) + (a6 * a6 + a7 * a7)); }
    return wave_sum(s);
}
__device__ __forceinline__ void ph_rstd(const Ctx& F0) {
    const Ctx F = launder(F0);
    const int gw = F.vcu * NWAVES + F.wave, NGW = F.G * NWAVES; float* rs1 = (float*)(F.ws + WS_RS1);
    for (int m = gw; m < T; m += NGW) { const float s = row_ssq_bf16(P_XB(F) + (size_t)m * D, F.lane); if (F.lane == 0) rs1[m] = 1.f / sqrtf(s * (1.f / D) + RMS_EPS); }
}

__device__ __forceinline__ void ph_bias_table(const Ctx& F0) {
    const Ctx F = launder(F0);
    if (F.vcu == 0) {
        const float* rel_bias = F.in[1];
        for (int i = F.tid; i < 8 * 132; i += NTHREADS) {
            const int h = i / 132, r = i % 132;
            int bk;
            if (r < 16) bk = r;
            else { bk = 16 + (int)(logf((float)r / 16.f) / logf(8.f) * 16.f); if (bk > 31) bk = 31; }
            P_BT(F)[i] = rel_bias[bk * 8 + h] * LOG2E;
        }
    }
}

__device__ __forceinline__ void ph_pool_dl(const Ctx& F0) {
    const Ctx F = launder(F0);
    const int gt = F.vcu * NTHREADS + F.tid, NGT = F.G * NTHREADS;
    for (int it = gt; it < (T / 32) * 128; it += NGT) {
        const int cp = it & 127, chunk = it >> 7, c = cp * 2, gi = c >> 6, win = 2 << gi, m0 = chunk * 32, t0 = m0 & (SEQ - 1);
        const unsigned* P2 = (const unsigned*)P_PB(F) + cp; unsigned* D2 = (unsigned*)P_DL(F) + cp;
        float s0 = 0.f, s1 = 0.f;
        const int back = (t0 < win) ? t0 : win;
        for (int j = 1; j <= back; ++j) { const unsigned v = P2[(size_t)(m0 - j) * 128]; s0 += bf2f(v & 0xffffu); s1 += bf2f(v >> 16); }
#pragma unroll 4
        for (int i = 0; i < 32; ++i) { const int m = m0 + i, t = t0 + i;
            const unsigned v = P2[(size_t)m * 128]; const float p0 = bf2f(v & 0xffffu), p1 = bf2f(v >> 16);
            s0 += p0; s1 += p1;
            if (t >= win) { const unsigned o = P2[(size_t)(m - win) * 128]; s0 -= bf2f(o & 0xffffu); s1 -= bf2f(o >> 16); }
            const float inv = 1.f / (float)((t + 1 < win) ? t + 1 : win);
            D2[(size_t)m * 128] = pk2(s0 * inv - p0, s1 * inv - p1); }
    }
}
__device__ __forceinline__ void ph_final(const Ctx& F0) {
    const Ctx F = launder(F0);
    const int gw = F.vcu * NWAVES + F.wave, NGW = F.G * NWAVES;
    const f32x4* gf = (const f32x4*)F.in[26];
    for (int m = gw; m < T; m += NGW) {
        const bf16* row = P_XB(F) + (size_t)m * D;
        const float rstd = 1.f / sqrtf(row_ssq_bf16(row, F.lane) * (1.f / D) + RMS_EPS);
        const u32x4* xr = (const u32x4*)row + F.lane; f32x4* orow = (f32x4*)(F.R + (size_t)m * D);
#pragma unroll
        for (int j = 0; j < 2; ++j) { const u32x4 x = xr[64 * j]; const int c4 = 2 * (64 * j + F.lane);
            orow[c4] = (f32x4){bf2f(x.x & 0xffffu), bf2f(x.x >> 16), bf2f(x.y & 0xffffu), bf2f(x.y >> 16)} * rstd * gf[c4];
            orow[c4 + 1] = (f32x4){bf2f(x.z & 0xffffu), bf2f(x.z >> 16), bf2f(x.w & 0xffffu), bf2f(x.w >> 16)} * rstd * gf[c4 + 1]; }
    }
}

constexpr int LDS_BYTES = 147456;
constexpr int MISC_OFF = 131072 + 320;

__global__ void __launch_bounds__(NTHREADS, 2) mk_fwd(Args args) {
    extern __shared__ __attribute__((aligned(16))) unsigned char lds[];
    Ctx F;
    F.lds = (LAS unsigned char*)lds;
    F.wave = __builtin_amdgcn_readfirstlane((int)threadIdx.x >> 6);
    F.lane = lane_id(); F.tid = F.wave * 64 + F.lane;
    F.G = gridDim.x; { const int bx = blockIdx.x; F.vcu = (F.G % 8 == 0) ? (bx % 8) * (F.G / 8) + bx / 8 : bx; }
    F.in = (KargP)__builtin_amdgcn_kernarg_segment_ptr(); F.R = args.out; F.ws = args.ws;
    unsigned char* ws = args.ws;
    volatile LAS unsigned* MISC = (volatile LAS unsigned*)(F.lds + MISC_OFF);
    if (F.tid < 64) MISC[F.tid] = 0u;
    __syncthreads();
    XcdBarrier bar = xcd_barrier_post((unsigned*)(ws + WS_CTL) + CW_BAR, MISC + 8, F.tid == 0);
#define GRID_BAR() do { bar.bar = (unsigned*)(wsl(ws) + WS_CTL) + CW_BAR; xcd_barrier(bar, F.wave); } while (0)
#define FL launder(F)

    ph_bias_table(F);
    ph_prologue(F);
#pragma unroll 1
    for (int l = 0; l < DEPTH; ++l) {
        if (l == 0) ph_cvt_x(F); else ph_rstd(F);
        GRID_BAR();
        { pg8::Gemm g{P_XB(FL), (const bf16*)(wsl(ws) + WS_WIN) + (size_t)l * NPROJ * D, D, D, D}; pg8::StaticOrder S; S.init(T, NPROJ, sl(F.G), sl((int)blockIdx.x));
          EpiProjE E{P_UG(FL), P_PB(FL), P_QB(FL), P_KB(FL), P_VB(FL), P_KMP(FL), (const float*)(wsl(ws) + WS_RS1)}; pg8::gemm_phase(F.lds, g, S, E, sl(F.wave)); }
        GRID_BAR();
        { pg8::Gemm g{P_UG(FL), (const bf16*)(wsl(ws) + WS_BZ) + (size_t)l * SGN * 256 * 1024, UGP, 1024, 1024}; SsmOrder S{sl(F.G), sl((int)blockIdx.x), 1};
          EpiZ E{(float*)(wsl(ws) + WS_ZB)}; pg8::gemm_phase(F.lds, g, S, E, sl(F.wave)); }
        ph_pool_dl(F);
        moba::sel_phase(sl(F.wave), sl(F.vcu), P_QB(FL), P_KMP(FL), (unsigned*)(wsl(ws) + WS_SEL), (LAS char*)F.lds);
        GRID_BAR();
        moba::gather_phase(sl(F.wave), sl(F.vcu), P_QB(FL), P_KB(FL), P_VB(FL), P_YMIX(FL), P_YS(FL), (bf16*)(wsl(ws) + WS_P2B), (float*)(wsl(ws) + WS_ML), (const unsigned*)(wsl(ws) + WS_SEL), P_BT(FL), (LAS char*)F.lds);
        GRID_BAR();
        ph_ssm_scan(F, l);
        ph_tg_expand(F, l);
        moba::diag_phase(sl(F.wave), sl(F.vcu), P_QB(FL), P_KB(FL), P_VB(FL), P_YMIX(FL), P_YS(FL), (const bf16*)(wsl(ws) + WS_P2B), (const float*)(wsl(ws) + WS_ML), P_BT(FL), (LAS char*)F.lds);
        GRID_BAR();
        { pg8::Gemm g{P_UG(FL), (const bf16*)(wsl(ws) + WS_TG) + (size_t)l * SGN * 1024 * UGP, UGP, UGP, UGP}; SsmOrder S{sl(F.G), sl((int)blockIdx.x), 2};
          EpiSsm2 E{P_UG(FL), P_YS(FL), F.in[11] + l * 256}; pg8::gemm_phase(F.lds, g, S, E, sl(F.wave)); }
        GRID_BAR();
        { pg8::Gemm g{P_YS(FL), (const bf16*)(wsl(ws) + WS_GLUT) + (size_t)l * 65536, 256, 256, 256}; HalfOrder S{sl(F.vcu)};
          EpiGluE E{P_YS(FL), P_YMIX(FL), F.in[13] + l * 256}; pg8::gemm_phase(F.lds, g, S, E, sl(F.wave)); }
        { pg8::Gemm g{P_DL(FL), (const bf16*)(wsl(ws) + WS_POOLT) + (size_t)l * 65536, 256, 256, 256}; HalfOrder S{sl(F.vcu) - 128};
          EpiPoolE E{P_YMIX(FL), F.in[15] + l * 256, F.in[16] + l * 256}; pg8::gemm_phase(F.lds, g, S, E, sl(F.wave)); }
        GRID_BAR();
        { pg8::Gemm g{P_YMIX(FL), (const bf16*)(wsl(ws) + WS_WOUT) + (size_t)l * D * D, D, D, D}; pg8::StaticOrder S; S.init(T, D, sl(F.G), sl((int)blockIdx.x));
          EpiOutE E{P_XB(FL)}; pg8::gemm_phase(F.lds, g, S, E, sl(F.wave)); }
        GRID_BAR();
        ph_route(F, l);
        GRID_BAR();
        ph_place(F);
        GRID_BAR();
        { pg8::Gemm g{(const bf16*)(wsl(ws) + WS_XS), (const bf16*)(wsl(ws) + WS_GU) + (size_t)l * 16 * 512 * D, D, D, D}; MoeOrder S{(const int*)(wsl(ws) + WS_TILEB), sl(F.G), sl((int)blockIdx.x), false};
          EpiGU E{(bf16*)(wsl(ws) + WS_HACT), (const float*)(wsl(ws) + WS_ROWW), (const float*)(wsl(ws) + WS_ROWR)}; pg8::gemm_phase(F.lds, g, S, E, sl(F.wave)); }
        GRID_BAR();
        { pg8::Gemm g{(const bf16*)(wsl(ws) + WS_HACT), (const bf16*)(wsl(ws) + WS_WD) + (size_t)l * 24 * D * 512, 512, 512, 512}; MoeOrder S{(const int*)(wsl(ws) + WS_TILEB), sl(F.G), sl((int)blockIdx.x), true};
          EpiDown E{P_XB(FL), (const int*)(wsl(ws) + WS_ROWTOK)}; pg8::gemm_phase(F.lds, g, S, E, sl(F.wave)); }
        GRID_BAR();
    }
    ph_final(F);
}

extern "C" void kernel_launch(void* const* d_in, const int* in_sizes, int n_in, void* d_out, int out_size, void* d_ws, size_t ws_size, hipStream_t stream) {
    static int grid = 0;
    if (grid == 0) {
        if (n_in != 27 || out_size != T * D || ws_size < WS_END) { fprintf(stderr, "kernel_launch: unexpected shapes (n_in %d out %d ws %zu)\n", n_in, out_size, ws_size); grid = -1; return; }
        int dev = 0, cus = 0, per_cu = 0;
        if (hipGetDevice(&dev) != hipSuccess || hipDeviceGetAttribute(&cus, hipDeviceAttributeMultiprocessorCount, dev) != hipSuccess) { grid = -1; return; }
        if (hipFuncSetAttribute((const void*)mk_fwd, hipFuncAttributeMaxDynamicSharedMemorySize, LDS_BYTES) != hipSuccess) { fprintf(stderr, "kernel_launch: hipFuncSetAttribute failed\n"); grid = -1; return; }
        if (hipOccupancyMaxActiveBlocksPerMultiprocessor(&per_cu, (const void*)mk_fwd, NTHREADS, LDS_BYTES) != hipSuccess || per_cu < 1) { fprintf(stderr, "kernel_launch: occupancy query says %d\n", per_cu); per_cu = 1; }
        (void)hipGetLastError();
        grid = cus;
    }
    if (grid < 0) return;
    (void)hipMemsetAsync((char*)d_ws + WS_CTL, 0, CTL_ZERO_BYTES, stream);
    Args a{};
    for (int i = 0; i < 27; ++i) a.in[i] = (const float*)d_in[i];
    a.out = (float*)d_out; a.ws = (unsigned char*)d_ws; a.pad0 = 0; a.pad1 = 0;
    hipLaunchKernelGGL(mk_fwd, dim3(grid), dim3(NTHREADS), LDS_BYTES, stream, a);
}
```

```cpp
#include <hip/hip_runtime.h>
#include <hip/hip_bf16.h>
#include <cstdio>
#include <cstdint>

#define GAS __attribute__((address_space(1)))
#define LAS __attribute__((address_space(3)))
typedef unsigned short bf16;
typedef float f32x4 __attribute__((ext_vector_type(4)));
typedef unsigned u32x4 __attribute__((ext_vector_type(4)));
typedef unsigned u32x2 __attribute__((ext_vector_type(2)));

constexpr int NB = 8, SEQ = 4096, T = NB * SEQ, D = 1024, NPROJ = 2048, DEPTH = 2;
constexpr int NHEAD = 8, HD = 64, MBLK = 256, NBLK = SEQ / MBLK;
constexpr int SG = 16, SGN = 16, SP = 64, SCH = 64, UGP = 1152;
constexpr float RMS_EPS = 1e-6f;
constexpr float LOG2E = 1.4426950408889634f;
constexpr float C2 = 0.125f * LOG2E;
constexpr int NWAVES = 8, NTHREADS = 512;

constexpr size_t MiB = 1u << 20;
constexpr size_t WS_CTL = 0, CTL_ZERO_BYTES = 1 * MiB;
constexpr size_t WS_XB = 2 * MiB;
constexpr size_t WS_UG = 66 * MiB;
constexpr size_t WS_PB = 84 * MiB;
constexpr size_t WS_QB = 100 * MiB;
constexpr size_t WS_KB = 132 * MiB;
constexpr size_t WS_VB = 164 * MiB;
constexpr size_t WS_YMIX = 196 * MiB;
constexpr size_t WS_YS = 260 * MiB;
constexpr size_t WS_DL = 276 * MiB;
constexpr size_t WS_KMP = 292 * MiB;
constexpr size_t WS_BT = 293 * MiB;
constexpr size_t WS_KT = 297 * MiB;
constexpr size_t WS_SEL = 298 * MiB;
constexpr size_t WS_WIN = 300 * MiB;
constexpr size_t WS_WOUT = 308 * MiB;
constexpr size_t WS_GU = 312 * MiB;
constexpr size_t WS_WD = 344 * MiB;
constexpr size_t WS_TG = 392 * MiB;
constexpr size_t WS_BZ = 464 * MiB;
constexpr size_t WS_GLUT = 480 * MiB;
constexpr size_t WS_POOLT = WS_GLUT + 512 * 1024;
constexpr size_t WS_ZB = 482 * MiB;
constexpr size_t WS_P2B = 486 * MiB;
constexpr size_t WS_ML = 502 * MiB;
constexpr size_t WS_END = 508 * MiB;
constexpr int MOE_MAXT = 152;
constexpr size_t WS_XS = 66 * MiB;
constexpr size_t WS_HACT = 142 * MiB;
constexpr size_t WS_TOKB = 294 * MiB;
constexpr size_t WS_TOKR = WS_TOKB + 128 * 1024;
constexpr size_t WS_TOKW = WS_TOKB + 256 * 1024;
constexpr size_t WS_ROWTOK = 295 * MiB;
constexpr size_t WS_ROWW = WS_ROWTOK + 256 * 1024;
constexpr size_t WS_ROWR = WS_ROWTOK + 576 * 1024;
constexpr size_t WS_RS1 = WS_ROWTOK + 768 * 1024;
constexpr size_t WS_WGCNT = 296 * MiB;
constexpr size_t WS_TILEB = WS_WGCNT + 64 * 1024;

constexpr int CW_BAR = 4096;

__device__ __forceinline__ unsigned f2bf(float f) { unsigned u = __builtin_bit_cast(unsigned, f); return (u + 0x7fffu + ((u >> 16) & 1u)) >> 16; }
__device__ __forceinline__ float bf2f(unsigned h) { return __builtin_bit_cast(float, h << 16); }
__device__ __forceinline__ unsigned pk2(float lo, float hi) { return f2bf(lo) | (f2bf(hi) << 16); }
template <int O> __device__ __forceinline__ float xshfl(float v) {
    if constexpr (O < 32) return __builtin_bit_cast(float, __builtin_amdgcn_ds_swizzle(__builtin_bit_cast(int, v), (O << 10) | 0x1f));
    else { const unsigned u = __builtin_bit_cast(unsigned, v); auto r = __builtin_amdgcn_permlane32_swap(u, u, false, false);
           const float a = __builtin_bit_cast(float, (unsigned)r[0]), b = __builtin_bit_cast(float, (unsigned)r[1]); return (a == v && __builtin_bit_cast(unsigned, a) == u) ? b : a; }
}
__device__ __forceinline__ float wave_sum(float v) {
    v += xshfl<1>(v); v += xshfl<2>(v); v += xshfl<4>(v); v += xshfl<8>(v); v += xshfl<16>(v);
    const unsigned u = __builtin_bit_cast(unsigned, v); auto r = __builtin_amdgcn_permlane32_swap(u, u, false, false);
    return __builtin_bit_cast(float, (unsigned)r[0]) + __builtin_bit_cast(float, (unsigned)r[1]);
}
__device__ __forceinline__ float wave_max(float v) {
    v = fmaxf(v, xshfl<1>(v)); v = fmaxf(v, xshfl<2>(v)); v = fmaxf(v, xshfl<4>(v)); v = fmaxf(v, xshfl<8>(v)); v = fmaxf(v, xshfl<16>(v));
    const unsigned u = __builtin_bit_cast(unsigned, v); auto r = __builtin_amdgcn_permlane32_swap(u, u, false, false);
    return fmaxf(__builtin_bit_cast(float, (unsigned)r[0]), __builtin_bit_cast(float, (unsigned)r[1]));
}
__device__ __forceinline__ float gelu_tanh(float x) {
    const float u = 0.7978845608028654f * (x + 0.044715f * x * x * x);
    const float e = __expf(2.f * u);
    const float th = 1.f - 2.f / (e + 1.f);
    return 0.5f * x * (1.f + th);
}
__device__ __forceinline__ float sigmoidf_(float x) { return 1.f / (1.f + __expf(-x)); }

__device__ __forceinline__ int lane_id() { unsigned m; asm volatile("s_mov_b32 %0, -1" : "=s"(m)); return (int)__builtin_amdgcn_mbcnt_hi(m, __builtin_amdgcn_mbcnt_lo(m, 0u)); }

#define XB_TMO      128
#define XB_XCNT(j)  (256  + 64 * (j))
#define XB_XSUB(j)  (1280 + 64 * (j))
#define XB_XGEN(j)  (2304 + 64 * (j))
#define XB_TOP      3328
#define XB_TOPGEN   3392
#define XCD_BAR_WORDS 3456
#define XB_SPIN_CAP (1u << 22)
__device__ __forceinline__ unsigned xb_ld(unsigned* p)              { return __hip_atomic_load(p, __ATOMIC_RELAXED, __HIP_MEMORY_SCOPE_AGENT); }
__device__ __forceinline__ unsigned xb_add(unsigned* p, unsigned v) { return __hip_atomic_fetch_add(p, v, __ATOMIC_RELAXED, __HIP_MEMORY_SCOPE_AGENT); }
__device__ __forceinline__ unsigned xb_xcc_id() { return (unsigned)__builtin_amdgcn_s_getreg((3 << 11) | 20) & 0xFu; }
#define XB_SPIN(cond, bar) do { unsigned _sp = 0; while (cond) { __builtin_amdgcn_s_sleep(1); \
    if ((++_sp & 255u) == 0u) { if (xb_ld(&(bar)[XB_TMO])) break; if (_sp > XB_SPIN_CAP) { atomicAdd(&(bar)[XB_TMO], 1u); break; } } } } while (0)
struct XcdBarrier { unsigned* bar; unsigned x; volatile LAS unsigned* st; };
__device__ __forceinline__ XcdBarrier xcd_barrier_post(unsigned* bar, volatile LAS unsigned* st, bool t0) {
    XcdBarrier b; b.bar = bar; b.x = xb_xcc_id(); b.st = st;
    if (t0) (void)xb_add(&bar[XB_XCNT(b.x)], 1u);
    return b;
}
__device__ __forceinline__ void xcd_barrier_complete(unsigned* bar, unsigned x, unsigned& nloc, unsigned& nx) {
    const unsigned G = gridDim.x * gridDim.y * gridDim.z;
    unsigned sum, cnt, mine, sp = 0u;
    for (;;) {
        sum = 0u; cnt = 0u; mine = 0u;
#pragma unroll
        for (unsigned j = 0; j < 16; ++j) { const unsigned c = xb_ld(&bar[XB_XCNT(j)]); sum += c; cnt += (c > 0u) ? 1u : 0u; mine = (j == x) ? c : mine; }
        if (sum == G) break;
        __builtin_amdgcn_s_sleep(1);
        if ((++sp & 255u) == 0u) { if (xb_ld(&bar[XB_TMO])) break; if (sp > XB_SPIN_CAP) { atomicAdd(&bar[XB_TMO], 1u); break; } }
    }
    nloc = mine > 0u ? mine : 1u; nx = cnt > 0u ? cnt : 1u;
}
__device__ __forceinline__ void xcd_barrier(const XcdBarrier& b, int wave) {
    asm volatile("s_waitcnt vmcnt(0)" ::: "memory");
    __syncthreads();
    if (wave == 0 && lane_id() == 0) {
        unsigned* bar = b.bar;
        __builtin_amdgcn_s_waitcnt(0);
        unsigned nloc = b.st[0], nx = b.st[1];
        if (nloc == 0u) { xcd_barrier_complete(bar, b.x, nloc, nx); b.st[0] = nloc; b.st[1] = nx; }
        const unsigned old = xb_add(&bar[XB_XSUB(b.x)], 1u);
        const unsigned gen = old / nloc;
        if (old + 1u == (gen + 1u) * nloc) {
            __builtin_amdgcn_fence(__ATOMIC_RELEASE, "agent");
            asm volatile("s_waitcnt vmcnt(0)" ::: "memory");
            const unsigned og = xb_add(&bar[XB_TOP], 1u);
            const unsigned tg = og / nx;
            if (og + 1u == (tg + 1u) * nx) xb_add(&bar[XB_TOPGEN], 1u);
            else XB_SPIN(xb_ld(&bar[XB_TOPGEN]) == tg, bar);
            __builtin_amdgcn_fence(__ATOMIC_ACQUIRE, "agent");
            xb_add(&bar[XB_XGEN(b.x)], 1u);
            asm volatile("s_waitcnt vmcnt(0)" ::: "memory");
        } else {
            XB_SPIN(xb_ld(&bar[XB_XGEN(b.x)]) == gen, bar);
            __builtin_amdgcn_fence(__ATOMIC_ACQUIRE, "agent");
            asm volatile("s_waitcnt vmcnt(0)" ::: "memory");
        }
    }
    __syncthreads();
}

struct Args {
    const float* in[27];
    float* out;
    unsigned char* ws;
    int pad0, pad1;
};

typedef const float* fptr_t;
typedef __attribute__((address_space(4))) const fptr_t* KargP;
struct Ctx {
    LAS unsigned char* lds;
    int tid, lane, wave, vcu, G;
    KargP in;
    float* R;
    unsigned char* ws;
};
#define P_XB(F) ((bf16*)((F).ws + WS_XB))
#define P_UG(F) ((bf16*)((F).ws + WS_UG))
#define P_PB(F) ((bf16*)((F).ws + WS_PB))
#define P_QB(F) ((bf16*)((F).ws + WS_QB))
#define P_KB(F) ((bf16*)((F).ws + WS_KB))
#define P_VB(F) ((bf16*)((F).ws + WS_VB))
#define P_YMIX(F) ((bf16*)((F).ws + WS_YMIX))
#define P_YS(F) ((bf16*)((F).ws + WS_YS))
#define P_DL(F) ((bf16*)((F).ws + WS_DL))
#define P_KMP(F) ((float*)((F).ws + WS_KMP))
#define P_BT(F) ((float*)((F).ws + WS_BT))


__device__ __forceinline__ Ctx launder(const Ctx& F0) {
    Ctx F = F0;
    int ln = lane_id(); asm volatile("" : "+v"(ln));
    asm volatile("" : "+s"(F.wave), "+s"(F.vcu), "+s"(F.G));
    F.lane = ln; F.tid = F.wave * 64 + ln;
    KargP kp = (KargP)__builtin_amdgcn_kernarg_segment_ptr(); asm volatile("" : "+s"(kp));
    F.in = kp; F.R = (float*)kp[27]; F.ws = (unsigned char*)kp[28];
    return F;
}

__device__ __forceinline__ unsigned char* wsl(unsigned char* p) { asm volatile("" : "+s"(p)); return p; }
__device__ __forceinline__ int sl(int x) { asm volatile("" : "+s"(x)); return x; }

namespace pg8 {
typedef short bf16x8 __attribute__((ext_vector_type(8)));
constexpr int BM = 256, BK = 64, HALF = 128, HTB = HALF * BK * 2, STAGE_BYTES = 8 * HTB, NXCD = 8, WGM = 8;
__device__ __forceinline__ int lds_byte(int r, int c) { const int st = (r >> 4) * 2 + (c >> 5), rr = r & 15, cc = c & 31, ob = rr * 64 + cc * 2; return st * 1024 + (ob ^ (((ob >> 9) & 1) << 5)); }
__device__ __forceinline__ void stage_rc(int b, int& R, int& C) { const int st = b / 1024, sb = b % 1024, swz = sb ^ (((sb >> 9) & 1) << 5); R = (st >> 1) * 16 + swz / 64; C = (st & 1) * 32 + (swz % 64) / 2; }
__device__ __forceinline__ int perm32(int rho) { const int n = rho >> 4, i = rho & 15; return 8 * (i >> 2) + 4 * n + (i & 3); }

struct Unit { int pm, pn, aux; };
struct Gemm { const bf16* A; const bf16* Bt; int lda, ldb, K; };

struct StaticOrder {
    int nM, nN, nwg, G, c;
    __device__ void init(int M, int N, int G_, int c_) { nM = M / BM; nN = N / BM; nwg = nM * nN; G = G_; c = c_; }
    __device__ bool next(int i, Unit& u) const {
        const long L = (long)i * G + c; if (L >= nwg) return false;
        int wgid = (int)L; { const int q = nwg / NXCD, r = nwg % NXCD, xcd = wgid % NXCD, off = wgid / NXCD; wgid = (xcd < r ? xcd * (q + 1) : r * (q + 1) + (xcd - r) * q) + off; }
        const int nig = WGM * nN, gid = wgid / nig, fm = gid * WGM, gsz = (nM - fm) < WGM ? (nM - fm) : WGM;
        u.pm = fm + ((wgid % nig) % gsz); u.pn = (wgid % nig) / gsz; u.aux = 0; return true;
    }
};

__device__ __forceinline__ unsigned cvt_pk_bf16(float lo, float hi) { unsigned r; asm volatile("v_cvt_pk_bf16_f32 %0, %1, %2" : "=v"(r) : "v"(lo), "v"(hi)); return r; }

template <bool ALIGN = true, class Epi, class Sched>
__device__ __forceinline__ void gemm_phase(LAS unsigned char* lds, const Gemm g, const Sched& S, const Epi& E, int wave_) {
    int lane_ = lane_id(); asm volatile("" : "+v"(lane_)); asm volatile("" : "+s"(wave_));
    const int wid = wave_, lane = lane_, tid = wid * 64 + lane, wr = wid >> 2, wc = wid & 3, fr = lane & 15, fq = lane >> 4;
    const int K = g.K, nt = K / BK;
    unsigned voffA[2], voffB[2];
#pragma unroll
    for (int i = 0; i < 2; ++i) { int R, C; stage_rc(tid * 16 + i * 8192, R, C); const int Rb = Epi::PERM ? ((R & ~31) + perm32(R & 31)) : R;
        voffA[i] = (unsigned)(R * g.lda + C) * 2u; voffB[i] = (unsigned)(Rb * g.ldb + C) * 2u; }
    const size_t kstep = (size_t)(BK * 2);
    const size_t hstepA = (size_t)HALF * g.lda * 2, hstepB = (size_t)HALF * g.ldb * 2;
    const size_t tstepA = 2 * hstepA, tstepB = 2 * hstepB;
    const unsigned ldsw = (unsigned)wid * 1024u;
    const int aoff = lds_byte(wr * 64 + fr, fq * 8), boff = lds_byte(wc * 32 + fr, fq * 8);
#define PG8_SA(b, h) (((b) * 2 + (h)) * HTB)
#define PG8_SB(b, h) ((4 + (b) * 2 + (h)) * HTB)
#define PG8_STAGE(bufoff, gbase, voff) do { _Pragma("unroll") for (int _i = 0; _i < 2; ++_i) \
        __builtin_amdgcn_global_load_lds((const unsigned*)((const char*)(gbase) + (voff)[_i]), (LAS unsigned*)(lds + (bufoff) + ldsw + _i * 8192), 16, 0, 0); } while (0)
#define PG8_LDA(dst, b, h) do { _Pragma("unroll") for (int m = 0; m < 4; ++m) _Pragma("unroll") for (int k = 0; k < 2; ++k) dst[m][k] = *(const LAS bf16x8*)(lds + PG8_SA(b, h) + aoff + m * 2048 + k * 1024); } while (0)
#define PG8_LDB(dst, b, h) do { _Pragma("unroll") for (int n = 0; n < 2; ++n) _Pragma("unroll") for (int k = 0; k < 2; ++k) dst[n][k] = *(const LAS bf16x8*)(lds + PG8_SB(b, h) + boff + n * 2048 + k * 1024); } while (0)
#define PG8_MMA(ai, bj, At, Bt) do { __builtin_amdgcn_s_setprio(1); _Pragma("unroll") for (int m = 0; m < 4; ++m) _Pragma("unroll") for (int n = 0; n < 2; ++n) _Pragma("unroll") for (int k = 0; k < 2; ++k) \
        acc[ai][bj][m][n] = __builtin_amdgcn_mfma_f32_16x16x32_bf16(Bt[n][k], At[m][k], acc[ai][bj][m][n], 0, 0, 0); __builtin_amdgcn_s_setprio(0); } while (0)
#define PG8_WAIT_V(n) asm volatile("s_waitcnt vmcnt(" #n ")" ::: "memory")
#define PG8_WAIT_L(n) asm volatile("s_waitcnt lgkmcnt(" #n ")" ::: "memory")
#define PG8_BAR __builtin_amdgcn_s_barrier()
#define PG8_SCHED __builtin_amdgcn_sched_barrier(0)
    Unit cur, nxt; int ui = 0;
    if (!S.next(0, cur)) return;
    f32x4 acc[2][2][4][2];
#pragma unroll
    for (int a = 0; a < 2; ++a)
#pragma unroll
        for (int b = 0; b < 2; ++b)
#pragma unroll
            for (int m = 0; m < 4; ++m)
#pragma unroll
                for (int n = 0; n < 2; ++n) acc[a][b][m][n] = (f32x4){0.f, 0.f, 0.f, 0.f};
    bf16x8 At[4][2], B0[2][2], B1[2][2];
    const char* cA = (const char*)g.A + (size_t)cur.pm * tstepA; const char* cB = (const char*)g.Bt + (size_t)cur.pn * tstepB;
    PG8_STAGE(PG8_SB(0, 0), cB, voffB); PG8_STAGE(PG8_SB(0, 1), cB + hstepB, voffB); PG8_STAGE(PG8_SA(0, 0), cA, voffA); PG8_STAGE(PG8_SA(0, 1), cA + hstepA, voffA);
    if (wr == 1) PG8_BAR;
    PG8_WAIT_V(2); PG8_BAR;
    PG8_STAGE(PG8_SB(1, 0), cB + kstep, voffB); PG8_STAGE(PG8_SA(1, 0), cA + kstep, voffA); PG8_STAGE(PG8_SB(1, 1), cB + hstepB + kstep, voffB);
    PG8_WAIT_V(6); PG8_BAR;
    for (;;) {
        const bool has_next = S.next(ui + 1, nxt);
        const char* nA = has_next ? (const char*)g.A + (size_t)nxt.pm * tstepA : cA; const char* nB = has_next ? (const char*)g.Bt + (size_t)nxt.pn * tstepB : cB;
        for (int t = 0; t < nt; t += 2) {
            const bool last = (t == nt - 2);
            const char* a1 = cA + (size_t)(t + 1) * kstep;
            const char* a2 = last ? nA : cA + (size_t)(t + 2) * kstep; const char* b2 = last ? nB : cB + (size_t)(t + 2) * kstep;
            const char* a3 = a2 + kstep; const char* b3 = b2 + kstep;
            PG8_LDB(B0, 0, 0); PG8_LDB(B1, 0, 1); PG8_SCHED; PG8_LDA(At, 0, 0); PG8_STAGE(PG8_SA(1, 1), a1 + hstepA, voffA);
            PG8_WAIT_V(8); PG8_WAIT_L(0); PG8_BAR; PG8_MMA(0, 0, At, B0); PG8_MMA(0, 1, At, B1); PG8_BAR; PG8_SCHED;
            PG8_LDA(At, 0, 1); PG8_STAGE(PG8_SB(0, 0), b2, voffB); PG8_STAGE(PG8_SB(0, 1), b2 + hstepB, voffB); PG8_STAGE(PG8_SA(0, 0), a2, voffA);
            PG8_WAIT_V(8); PG8_WAIT_L(0); PG8_BAR; PG8_MMA(1, 0, At, B0); PG8_MMA(1, 1, At, B1); PG8_BAR; PG8_SCHED;
            PG8_LDB(B0, 1, 0); PG8_LDB(B1, 1, 1); PG8_SCHED; PG8_LDA(At, 1, 0); PG8_STAGE(PG8_SA(0, 1), a2 + hstepA, voffA);
            PG8_WAIT_V(8); PG8_WAIT_L(0); PG8_BAR; PG8_MMA(0, 0, At, B0); PG8_MMA(0, 1, At, B1); PG8_BAR; PG8_SCHED;
            PG8_LDA(At, 1, 1); PG8_STAGE(PG8_SB(1, 0), b3, voffB); PG8_STAGE(PG8_SB(1, 1), b3 + hstepB, voffB); PG8_STAGE(PG8_SA(1, 0), a3, voffA);
            PG8_WAIT_V(8); PG8_WAIT_L(0); PG8_BAR; PG8_MMA(1, 0, At, B0); PG8_MMA(1, 1, At, B1); PG8_BAR; PG8_SCHED;
        }
        if constexpr (ALIGN) { if (wr == 0) PG8_BAR; }
        E(acc, cur, wr, wc, fr, fq);
        if (!has_next) break;
#pragma unroll
        for (int a = 0; a < 2; ++a)
#pragma unroll
            for (int b = 0; b < 2; ++b)
#pragma unroll
                for (int m = 0; m < 4; ++m)
#pragma unroll
                    for (int n = 0; n < 2; ++n) acc[a][b][m][n] = (f32x4){0.f, 0.f, 0.f, 0.f};
        cur = nxt; cA = nA; cB = nB; ++ui;
        if constexpr (ALIGN) { if (wr == 1) PG8_BAR; }
    }
    PG8_WAIT_V(0);
    if constexpr (!ALIGN) { if (wr == 0) PG8_BAR; }
    PG8_BAR;
#undef PG8_SA
#undef PG8_SB
#undef PG8_STAGE
#undef PG8_LDA
#undef PG8_LDB
#undef PG8_MMA
#undef PG8_WAIT_V
#undef PG8_WAIT_L
#undef PG8_BAR
#undef PG8_SCHED
}
}


struct EpiProjE {
    static constexpr bool PERM = true;
    bf16 *UG, *PB, *QB, *KB, *VB; float* KMP; const float* rs1;
    __device__ __forceinline__ void operator()(const f32x4 (&acc_)[2][2][4][2], const pg8::Unit& u, int wr, int wc, int fr_, int fq_) const {
        const int ln_ = lane_id(), fr = ln_ & 15, fq = ln_ >> 4; (void)fr_; (void)fq_;
        const int pn = u.pn, row0 = u.pm * 256 + wr * 64 + fr, cl = wc * 32 + 8 * fq;
        f32x4 acc[2][2][4][2];
#pragma unroll
        for (int ai = 0; ai < 2; ++ai)
#pragma unroll
            for (int m = 0; m < 4; ++m) { const float rs = rs1[row0 + ai * 128 + m * 16];
#pragma unroll
                for (int bj = 0; bj < 2; ++bj) { acc[ai][bj][m][0] = acc_[ai][bj][m][0] * rs; acc[ai][bj][m][1] = acc_[ai][bj][m][1] * rs; } }
        if (pn == 0) {
#pragma unroll
            for (int ai = 0; ai < 2; ++ai)
#pragma unroll
                for (int m = 0; m < 4; ++m) { const int r = row0 + ai * 128 + m * 16;
#pragma unroll
                    for (int bj = 0; bj < 2; ++bj) { const int ch = bj * 128 + cl, g = ch >> 4, h0 = ch & 15;
                        const f32x4 v0 = acc[ai][bj][m][0], v1 = acc[ai][bj][m][1]; u32x4 w;
                        w.x = pg8::cvt_pk_bf16(v0[0], v0[1]); w.y = pg8::cvt_pk_bf16(v0[2], v0[3]); w.z = pg8::cvt_pk_bf16(v1[0], v1[1]); w.w = pg8::cvt_pk_bf16(v1[2], v1[3]);
                        *(u32x4*)(UG + ((size_t)(g * 512 + (r >> 6))) * UGP + (r & 63) * 16 + h0) = w; } }
        } else {
            bf16* base; int ldc, colt; float sc = 1.f;
            if (pn == 1) { base = PB; ldc = 256; colt = 0; }
            else if (pn < 4) { base = QB; ldc = 512; colt = (pn - 2) * 256; sc = C2; }
            else if (pn < 6) { base = KB; ldc = 512; colt = (pn - 4) * 256; }
            else { base = VB; ldc = 512; colt = (pn - 6) * 256; }
#pragma unroll
            for (int ai = 0; ai < 2; ++ai)
#pragma unroll
                for (int m = 0; m < 4; ++m) { bf16* rowp = base + (size_t)(row0 + ai * 128 + m * 16) * ldc + colt + cl;
#pragma unroll
                    for (int bj = 0; bj < 2; ++bj) { const f32x4 v0 = acc[ai][bj][m][0] * sc, v1 = acc[ai][bj][m][1] * sc; u32x4 w;
                        w.x = pg8::cvt_pk_bf16(v0[0], v0[1]); w.y = pg8::cvt_pk_bf16(v0[2], v0[3]); w.z = pg8::cvt_pk_bf16(v1[0], v1[1]); w.w = pg8::cvt_pk_bf16(v1[2], v1[3]);
                        *(u32x4*)(rowp + bj * 128) = w; } }
            if (pn >= 4 && pn < 6) {
#pragma unroll
                for (int bj = 0; bj < 2; ++bj)
#pragma unroll
                    for (int n = 0; n < 2; ++n) { f32x4 s = (f32x4){0.f, 0.f, 0.f, 0.f};
#pragma unroll
                        for (int ai = 0; ai < 2; ++ai)
#pragma unroll
                            for (int m = 0; m < 4; ++m) s += acc[ai][bj][m][n];
#pragma unroll
                        for (int i = 0; i < 4; ++i) { float t = s[i]; t += xshfl<1>(t); t += xshfl<2>(t); t += xshfl<4>(t); t += xshfl<8>(t); s[i] = t; }
                        if (fr == 0) *(f32x4*)(KMP + (size_t)wr * 128 * 512 + (size_t)u.pm * 512 + colt + bj * 128 + cl + 4 * n) = s; }
            }
        }
    }
};
struct EpiOutE {
    static constexpr bool PERM = true;
    bf16* RB;
    __device__ __forceinline__ void operator()(const f32x4 (&acc)[2][2][4][2], const pg8::Unit& u, int wr, int wc, int fr_, int fq_) const {
        const int ln_ = lane_id(), fr = ln_ & 15, fq = ln_ >> 4; (void)fr_; (void)fq_;
        const int row0 = u.pm * 256 + wr * 64 + fr, col0 = u.pn * 256 + wc * 32 + 8 * fq;
#pragma unroll
        for (int ai = 0; ai < 2; ++ai)
#pragma unroll
            for (int m = 0; m < 4; ++m) { bf16* rp = RB + (size_t)(row0 + ai * 128 + m * 16) * D + col0;
#pragma unroll
                for (int bj = 0; bj < 2; ++bj) { const u32x4 x = *(const u32x4*)(rp + bj * 128); const f32x4 a0 = acc[ai][bj][m][0], a1 = acc[ai][bj][m][1]; u32x4 w;
                    w.x = pg8::cvt_pk_bf16(bf2f(x.x & 0xffffu) + a0[0], bf2f(x.x >> 16) + a0[1]); w.y = pg8::cvt_pk_bf16(bf2f(x.y & 0xffffu) + a0[2], bf2f(x.y >> 16) + a0[3]);
                    w.z = pg8::cvt_pk_bf16(bf2f(x.z & 0xffffu) + a1[0], bf2f(x.z >> 16) + a1[1]); w.w = pg8::cvt_pk_bf16(bf2f(x.w & 0xffffu) + a1[2], bf2f(x.w >> 16) + a1[3]);
                    *(u32x4*)(rp + bj * 128) = w; }
                if (m & 1) asm volatile("" ::: "memory"); }
    }
};

__device__ __forceinline__ void transpose_item(const float* W, int K, int N, const float* kscale, bf16* WT, int ldo, int koff, int rowmode, LAS float* scr, int item, int lane) {
    const int nblk = N / 32, kb = item / nblk, nb = item % nblk, k0 = 64 * kb, n0 = 32 * nb;
    { const int r8 = lane >> 3, c4 = lane & 7; f32x4 v[8];
#pragma unroll
      for (int i = 0; i < 8; ++i) v[i] = *(const f32x4*)(W + (size_t)(k0 + 8 * i + r8) * N + n0 + 4 * c4);
#pragma unroll
      for (int i = 0; i < 8; ++i) { const int kk = 8 * i + r8; const float s = kscale ? kscale[k0 + kk] : 1.f; LAS float* d = scr + kk * 33 + 4 * c4;
          d[0] = v[i][0] * s; d[1] = v[i][1] * s; d[2] = v[i][2] * s; d[3] = v[i][3] * s; } }
    asm volatile("s_waitcnt lgkmcnt(0)" ::: "memory");
    const int c = lane & 7;
#pragma unroll
    for (int j = 0; j < 4; ++j) { const int n = (lane >> 3) + 8 * j; const LAS float* s = scr + (8 * c) * 33 + n;
        u32x4 o; o.x = pk2(s[0 * 33], s[1 * 33]); o.y = pk2(s[2 * 33], s[3 * 33]); o.z = pk2(s[4 * 33], s[5 * 33]); o.w = pk2(s[6 * 33], s[7 * 33]);
        const int nn = n0 + n, row = rowmode == 0 ? nn : (8 * (nn >> 2) + (nn & 3) + (rowmode == 2 ? 4 : 0));
        *(u32x4*)(WT + (size_t)row * ldo + koff + k0 + 8 * c) = o; }
    asm volatile("s_waitcnt lgkmcnt(0)" ::: "memory");
}
__device__ __forceinline__ void pair_decode(int pi, int& ea, int& eb) { ea = pi < 3 ? 0 : (pi < 5 ? 1 : 2); eb = pi < 3 ? pi + 1 : (pi < 5 ? pi - 1 : 3); }
__device__ __forceinline__ void ph_prologue(const Ctx& F0) {
    const Ctx F = launder(F0);
    LAS float* scr = (LAS float*)(F.lds + F.wave * 16384);
    const int gw = F.vcu * NWAVES + F.wave, NGW = F.G * NWAVES;
    constexpr int I_IN = (D / 64) * (NPROJ / 32), I_OUT = (D / 64) * (D / 32), I_GU1 = (D / 64) * (256 / 32), I_GU = 16 * 2 * I_GU1, I_WD1 = (256 / 64) * (D / 32), I_WD = 24 * 2 * I_WD1;
    constexpr int I_L = I_IN + I_OUT + I_GU + I_WD;
    for (int it = gw; it < DEPTH * I_L; it += NGW) {
        const int l = it / I_L; int r = it % I_L;
        if (r < I_IN) { transpose_item(F.in[3] + (size_t)l * D * NPROJ, D, NPROJ, F.in[2] + l * D, (bf16*)(F.ws + WS_WIN) + (size_t)l * NPROJ * D, D, 0, 0, scr, r, F.lane); continue; } r -= I_IN;
        if (r < I_OUT) { transpose_item(F.in[17] + (size_t)l * D * D, D, D, nullptr, (bf16*)(F.ws + WS_WOUT) + (size_t)l * D * D, D, 0, 0, scr, r, F.lane); continue; } r -= I_OUT;
        if (r < I_GU) { const int e = r / (2 * I_GU1), up = (r / I_GU1) & 1, item = r % I_GU1;
            transpose_item(F.in[up ? 24 : 23] + ((size_t)l * 16 + e) * D * 256, D, 256, F.in[18] + l * D, (bf16*)(F.ws + WS_GU) + ((size_t)l * 16 + e) * 512 * D, D, 0, 1 + up, scr, item, F.lane); continue; } r -= I_GU;
        { const int bk = r / (2 * I_WD1), half = (r / I_WD1) & 1, item = r % I_WD1, g = bk / 6; int ea, eb; pair_decode(bk % 6, ea, eb); const int e = g * 4 + (half ? eb : ea);
            transpose_item(F.in[25] + ((size_t)l * 16 + e) * 256 * D, 256, D, nullptr, (bf16*)(F.ws + WS_WD) + ((size_t)l * 24 + bk) * D * 512, 512, half * 256, 0, scr, item, F.lane); }
    }
    for (int it = gw; it < DEPTH * 32; it += NGW) { const int l = it >> 5;
        transpose_item(F.in[12] + (size_t)l * 256 * 256, 256, 256, nullptr, (bf16*)(F.ws + WS_GLUT) + (size_t)l * 65536, 256, 0, 0, scr, it & 31, F.lane); }
    { const int gt = F.vcu * NTHREADS + F.tid, NGT = F.G * NTHREADS;
      for (int i = gt; i < DEPTH * 65536; i += NGT) { const int l = i >> 16, n = (i >> 8) & 255, k = i & 255;
          const float v = ((n >> 6) == (k >> 6)) ? F.in[14][(((size_t)l * 4 + (n >> 6)) * 64 + (k & 63)) * 64 + (n & 63)] : 0.f;
          ((bf16*)(F.ws + WS_POOLT))[i] = (bf16)f2bf(v); } }
    for (int it = gw; it < DEPTH * SGN * 65; it += NGW) {
        const int l = it / (SGN * 65), g = (it / 65) % SGN, tau = it % 65, p = F.lane;
        const float are = F.in[4][(l * SGN + g) * SP + p], aim = F.in[5][(l * SGN + g) * SP + p], dt = expf(F.in[6][l * SGN + g]);
        float sn, cs; sincosf(aim * dt, &sn, &cs); const float mg = expf(are * dt), lbr = mg * cs, lbi = mg * sn;
        const float nr = lbr - 1.f, ni = lbi, den = are * are + aim * aim, cr = (nr * are + ni * aim) / den, ci = (ni * are - nr * aim) / den;
        float sn2, cs2; sincosf(aim * dt * (float)tau, &sn2, &cs2); const float mg2 = expf(are * dt * (float)tau), lr = mg2 * cs2, li = mg2 * sn2;
        float wr[16], wi[16];
#pragma unroll
        for (int h = 0; h < 16; ++h) { const float br = F.in[7][((size_t)(l * SGN + g) * SP + p) * SG + h], bi = F.in[8][((size_t)(l * SGN + g) * SP + p) * SG + h];
            const float bbr = cr * br - ci * bi, bbi = cr * bi + ci * br; wr[h] = lr * bbr - li * bbi; wi[h] = lr * bbi + li * bbr; }
        bf16* TG = (bf16*)(F.ws + WS_TG) + ((size_t)l * SGN + g) * 1024 * UGP;
        if (tau <= 63) {
            bf16* BZ = (bf16*)(F.ws + WS_BZ) + ((size_t)l * SGN + g) * 256 * 1024; const int s = 63 - tau;
            u32x4 o0, o1, o2, o3;
            o0.x = pk2(wr[0], wr[1]); o0.y = pk2(wr[2], wr[3]); o0.z = pk2(wr[4], wr[5]); o0.w = pk2(wr[6], wr[7]); o1.x = pk2(wr[8], wr[9]); o1.y = pk2(wr[10], wr[11]); o1.z = pk2(wr[12], wr[13]); o1.w = pk2(wr[14], wr[15]);
            o2.x = pk2(wi[0], wi[1]); o2.y = pk2(wi[2], wi[3]); o2.z = pk2(wi[4], wi[5]); o2.w = pk2(wi[6], wi[7]); o3.x = pk2(wi[8], wi[9]); o3.y = pk2(wi[10], wi[11]); o3.z = pk2(wi[12], wi[13]); o3.w = pk2(wi[14], wi[15]);
            *(u32x4*)(BZ + (size_t)p * 1024 + s * 16) = o0; *(u32x4*)(BZ + (size_t)p * 1024 + s * 16 + 8) = o1;
            *(u32x4*)(BZ + (size_t)(64 + p) * 1024 + s * 16) = o2; *(u32x4*)(BZ + (size_t)(64 + p) * 1024 + s * 16 + 8) = o3;
        }
        LAS float* Wst = scr; LAS float* Kt = scr + 128 * 16;
        if (tau <= 63) {
#pragma unroll
            for (int q = 0; q < 4; ++q) { *(LAS f32x4*)(Wst + p * 16 + 4 * q) = (f32x4){wr[4 * q], wr[4 * q + 1], wr[4 * q + 2], wr[4 * q + 3]};
                                          *(LAS f32x4*)(Wst + (64 + p) * 16 + 4 * q) = (f32x4){wi[4 * q], wi[4 * q + 1], wi[4 * q + 2], wi[4 * q + 3]}; }
            const int arow = p & 15, kq = p >> 4; f32x4 kacc = (f32x4){0.f, 0.f, 0.f, 0.f};
            const float* cre = F.in[9] + ((size_t)(l * SGN + g) * SG + arow) * SP; const float* cim = F.in[10] + ((size_t)(l * SGN + g) * SG + arow) * SP;
#pragma unroll 8
            for (int s = 0; s < 32; ++s) { const int k = 4 * s + kq; const float av = (k < 64) ? cre[k] : -cim[k - 64]; const float bv = Wst[k * 16 + arow];
                kacc = __builtin_amdgcn_mfma_f32_16x16x4f32(av, bv, kacc, 0, 0, 0); }
#pragma unroll
            for (int r = 0; r < 4; ++r) Kt[(4 * kq + r) * 16 + arow] = kacc[r];
            asm volatile("s_waitcnt lgkmcnt(0)" ::: "memory");
            const f32x4 t4 = *(const LAS f32x4*)(Kt + 4 * p);
            u32x2 o; o.x = pk2(t4[0], t4[1]); o.y = pk2(t4[2], t4[3]);
            *(u32x2*)((bf16*)(F.ws + WS_KT) + ((size_t)(l * SGN + g) * 64 + tau) * 256 + 4 * p) = o;
        }
        if (tau >= 1) {
#pragma unroll 4
            for (int ho = 0; ho < 16; ++ho) {
                const float ccr = F.in[9][((size_t)(l * SGN + g) * SG + ho) * SP + p], cci = F.in[10][((size_t)(l * SGN + g) * SG + ho) * SP + p];
                const int n = (tau - 1) * 16 + ho;
                TG[(size_t)n * UGP + 1024 + p] = (bf16)f2bf(ccr * lr - cci * li); TG[(size_t)n * UGP + 1088 + p] = (bf16)f2bf(-(ccr * li + cci * lr)); }
        }
    }
}

__device__ __forceinline__ void route_finish(const float (&a)[20], float ssum, int m, bool act, const float* gb_, const float* rb_, int* tokb, float* tokr, float* tokw, LAS int* hist) {
        const float rstd = 1.f / sqrtf(ssum * (1.f / D) + RMS_EPS);
        float lg0 = a[0] * rstd + gb_[0], lg1 = a[1] * rstd + gb_[1], lg2 = a[2] * rstd + gb_[2], lg3 = a[3] * rstd + gb_[3];
        int gs = 0; float gm = lg0;
        if (lg1 > gm) { gm = lg1; gs = 1; } if (lg2 > gm) { gm = lg2; gs = 2; } if (lg3 > gm) { gm = lg3; gs = 3; }
        const float gwt = 1.f / (__expf(lg0 - gm) + __expf(lg1 - gm) + __expf(lg2 - gm) + __expf(lg3 - gm));
        float q0 = a[4], q1 = a[5], q2 = a[6], q3 = a[7], q4 = a[8], q5 = a[9], q6 = a[10], q7 = a[11], q8 = a[12], q9 = a[13], q10 = a[14], q11 = a[15], q12 = a[16], q13 = a[17], q14 = a[18], q15 = a[19];
        asm volatile("" : "+v"(q0), "+v"(q1), "+v"(q2), "+v"(q3), "+v"(q4), "+v"(q5), "+v"(q6), "+v"(q7));
        asm volatile("" : "+v"(q8), "+v"(q9), "+v"(q10), "+v"(q11), "+v"(q12), "+v"(q13), "+v"(q14), "+v"(q15));
        float e0 = gs == 0 ? q0 : gs == 1 ? q4 : gs == 2 ? q8 : q12;
        float e1 = gs == 0 ? q1 : gs == 1 ? q5 : gs == 2 ? q9 : q13;
        float e2 = gs == 0 ? q2 : gs == 1 ? q6 : gs == 2 ? q10 : q14;
        float e3 = gs == 0 ? q3 : gs == 1 ? q7 : gs == 2 ? q11 : q15;
        e0 = e0 * rstd + rb_[gs * 4 + 0]; e1 = e1 * rstd + rb_[gs * 4 + 1]; e2 = e2 * rstd + rb_[gs * 4 + 2]; e3 = e3 * rstd + rb_[gs * 4 + 3];
        int t1 = 0; float v1 = e0;
        if (e1 > v1) { v1 = e1; t1 = 1; } if (e2 > v1) { v1 = e2; t1 = 2; } if (e3 > v1) { v1 = e3; t1 = 3; }
        int t2 = -1; float v2 = -3.0e38f;
        if (t1 != 0 && e0 > v2) { v2 = e0; t2 = 0; } if (t1 != 1 && e1 > v2) { v2 = e1; t2 = 1; } if (t1 != 2 && e2 > v2) { v2 = e2; t2 = 2; } if (t1 != 3 && e3 > v2) { v2 = e3; t2 = 3; }
        const float p2 = __expf(v2 - v1), w1 = gwt / (1.f + p2), w2 = gwt * p2 / (1.f + p2);
        const int lo = t1 < t2 ? t1 : t2, hi = t1 < t2 ? t2 : t1; const float wlo = t1 < t2 ? w1 : w2, whi = t1 < t2 ? w2 : w1;
        const int pi = lo == 0 ? hi - 1 : (lo == 1 ? hi + 1 : 5), bk = gs * 6 + pi;
        if (act) { tokb[m] = bk; tokr[m] = rstd; tokw[2 * m] = wlo; tokw[2 * m + 1] = whi; __hip_atomic_fetch_add(hist + bk, 1, __ATOMIC_RELAXED, __HIP_MEMORY_SCOPE_WORKGROUP); }
}
__device__ __forceinline__ void ph_route(const Ctx& F0, int l) {
    const Ctx F = launder(F0);
    constexpr int WLD = 1032;
    LAS bf16* Wh = (LAS bf16*)F.lds;
    LAS bf16* Wlo = Wh + 20 * WLD;
    LAS float* LG = (LAS float*)(F.lds + 4 * 20 * WLD);
    LAS int* hist = (LAS int*)(F.lds + 4 * 20 * WLD + 8 * 320 * 4);
    const float* g2 = F.in[18] + l * D;
    const f32x4* gw4 = (const f32x4*)(F.in[19] + (size_t)l * D * 4); const f32x4* rw4 = (const f32x4*)(F.in[21] + (size_t)l * 4 * D * 4);
    const float* gb_ = F.in[20] + l * 4; const float* rb_ = F.in[22] + l * 16;
    for (int idx = F.tid; idx < D * 5; idx += NTHREADS) { const int k = idx % D, q = idx / D;
        f32x4 v = (q == 0) ? gw4[k] : rw4[(q - 1) * D + k]; v = v * g2[k];
#pragma unroll
        for (int i = 0; i < 4; ++i) { const unsigned h = f2bf(v[i]); Wh[(q * 4 + i) * WLD + k] = (bf16)h; Wlo[(q * 4 + i) * WLD + k] = (bf16)f2bf(v[i] - bf2f(h)); } }
    if (F.tid < 32) hist[F.tid] = 0;
    __syncthreads();
    int* tokb = (int*)(F.ws + WS_TOKB); float* tokr = (float*)(F.ws + WS_TOKR); float* tokw = (float*)(F.ws + WS_TOKW);
    const int i16 = F.lane & 15, kq = F.lane >> 4, m0 = F.vcu * 128 + F.wave * 16;
    const u32x4* xr = (const u32x4*)(P_XB(F) + (size_t)(m0 + i16) * D) + kq;
    const int c1 = 16 + (i16 & 3);
    const LAS bf16* bh0 = Wh + i16 * WLD + 8 * kq; const LAS bf16* bl0 = Wlo + i16 * WLD + 8 * kq;
    const LAS bf16* bh1 = Wh + c1 * WLD + 8 * kq;  const LAS bf16* bl1 = Wlo + c1 * WLD + 8 * kq;
    f32x4 acc0 = (f32x4){0.f, 0.f, 0.f, 0.f}, acc1 = acc0; float ss = 0.f;
#pragma unroll 4
    for (int c = 0; c < 32; ++c) {
        const u32x4 xa = xr[4 * c];
        const float x0 = bf2f(xa.x & 0xffffu), x1 = __builtin_bit_cast(float, xa.x & 0xffff0000u), x2 = bf2f(xa.y & 0xffffu), x3 = __builtin_bit_cast(float, xa.y & 0xffff0000u);
        const float x4 = bf2f(xa.z & 0xffffu), x5 = __builtin_bit_cast(float, xa.z & 0xffff0000u), x6 = bf2f(xa.w & 0xffffu), x7 = __builtin_bit_cast(float, xa.w & 0xffff0000u);
        ss += ((x0 * x0 + x1 * x1) + (x2 * x2 + x3 * x3)) + ((x4 * x4 + x5 * x5) + (x6 * x6 + x7 * x7));
        const pg8::bf16x8 av = __builtin_bit_cast(pg8::bf16x8, xa);
        const pg8::bf16x8 h0 = *(const LAS pg8::bf16x8*)(bh0 + 32 * c), l0 = *(const LAS pg8::bf16x8*)(bl0 + 32 * c);
        const pg8::bf16x8 h1 = *(const LAS pg8::bf16x8*)(bh1 + 32 * c), l1 = *(const LAS pg8::bf16x8*)(bl1 + 32 * c);
        acc0 = __builtin_amdgcn_mfma_f32_16x16x32_bf16(av, h0, acc0, 0, 0, 0); acc1 = __builtin_amdgcn_mfma_f32_16x16x32_bf16(av, h1, acc1, 0, 0, 0);
        acc0 = __builtin_amdgcn_mfma_f32_16x16x32_bf16(av, l0, acc0, 0, 0, 0); acc1 = __builtin_amdgcn_mfma_f32_16x16x32_bf16(av, l1, acc1, 0, 0, 0);
    }
    ss += xshfl<16>(ss);
    { const unsigned u = __builtin_bit_cast(unsigned, ss); auto r = __builtin_amdgcn_permlane32_swap(u, u, false, false);
      ss = __builtin_bit_cast(float, (unsigned)r[0]) + __builtin_bit_cast(float, (unsigned)r[1]); }
    LAS float* lg = LG + F.wave * 320;
#pragma unroll
    for (int r = 0; r < 4; ++r) { lg[(4 * kq + r) * 20 + i16] = acc0[r]; if (i16 < 4) lg[(4 * kq + r) * 20 + 16 + i16] = acc1[r]; }
    asm volatile("s_waitcnt lgkmcnt(0)" ::: "memory");
    float a[20];
#pragma unroll
    for (int j = 0; j < 5; ++j) { const f32x4 t4 = *(const LAS f32x4*)(lg + i16 * 20 + 4 * j); a[4 * j] = t4[0]; a[4 * j + 1] = t4[1]; a[4 * j + 2] = t4[2]; a[4 * j + 3] = t4[3]; }
    route_finish(a, ss, m0 + i16, kq == 0, gb_, rb_, tokb, tokr, tokw, hist);
    __syncthreads();
    if (F.tid < 24) __hip_atomic_store((int*)(F.ws + WS_WGCNT) + F.vcu * 24 + F.tid, hist[F.tid], __ATOMIC_RELAXED, __HIP_MEMORY_SCOPE_AGENT);
}
__device__ __forceinline__ void ph_place(const Ctx& F0) {
    const Ctx F = launder(F0);
    LAS int* ptot = (LAS int*)F.lds;
    LAS int* pbef = ptot + 512;
    LAS int* bstart = pbef + 512;
    LAS int* btot = bstart + 32;
    LAS int* carry = btot + 32;
    LAS int* rowidx = carry + 32;
    const int* wgcnt = (const int*)(F.ws + WS_WGCNT);
    int* rowtok = (int*)(F.ws + WS_ROWTOK); float* roww = (float*)(F.ws + WS_ROWW); int* tileb = (int*)(F.ws + WS_TILEB);
    const int* tokb = (const int*)(F.ws + WS_TOKB); const float* tokr = (const float*)(F.ws + WS_TOKR); const float* tokw = (const float*)(F.ws + WS_TOKW);
    { const int p = F.tid >> 5, b = F.tid & 31; int tot = 0, bef = 0;
      if (b < 24) for (int v = p * 16; v < p * 16 + 16; ++v) { const int c = wgcnt[v * 24 + b]; tot += c; if (v < F.vcu) bef += c; }
      ptot[p * 32 + b] = tot; pbef[p * 32 + b] = bef; }
    __syncthreads();
    if (F.tid < 32) { int tot = 0, bef = 0; for (int p = 0; p < 16; ++p) { tot += ptot[p * 32 + F.tid]; bef += pbef[p * 32 + F.tid]; } btot[F.tid] = tot; carry[F.tid] = bef; }
    __syncthreads();
    if (F.tid == 0) { int s = 0; for (int b = 0; b < 24; ++b) { bstart[b] = s; s += (btot[b] + 255) & ~255; } bstart[24] = s; }
    __syncthreads();
    if (F.tid < 24) carry[F.tid] += bstart[F.tid];
    if (F.vcu == 0) {
        if (F.tid == 0) tileb[0] = bstart[24] >> 8;
        for (int b = 0; b < 24; ++b) { const int s = bstart[b], e = bstart[b + 1];
            for (int t = (s >> 8) + F.tid; t < (e >> 8); t += NTHREADS) tileb[1 + t] = b;
            for (int r = s + btot[b] + F.tid; r < e; r += NTHREADS) __hip_atomic_store(rowtok + r, -1, __ATOMIC_RELAXED, __HIP_MEMORY_SCOPE_AGENT); }
    }
    __syncthreads();
    if (F.wave == 0) {
        for (int pass = 0; pass < 2; ++pass) { const int i = pass * 64 + F.lane, bi = tokb[F.vcu * 128 + i]; int row = 0;
#pragma unroll 1
            for (int b = 0; b < 24; ++b) { const unsigned long long mask = __ballot(bi == b); const int c = carry[b];
                if (bi == b) row = c + __builtin_popcountll(mask & ((1ull << F.lane) - 1ull));
                asm volatile("s_waitcnt lgkmcnt(0)" ::: "memory");
                if (F.lane == 0) carry[b] = c + __builtin_popcountll(mask);
                asm volatile("s_waitcnt lgkmcnt(0)" ::: "memory"); }
            rowidx[i] = row; }
    }
    __syncthreads();
    bf16* XS = (bf16*)(F.ws + WS_XS);
    for (int i = 0; i < 16; ++i) {
        const int li = F.wave * 16 + i, m = F.vcu * 128 + li, row = rowidx[li]; const float rstd = tokr[m];
        if (F.lane == 0) {
            __hip_atomic_store(rowtok + row, m, __ATOMIC_RELAXED, __HIP_MEMORY_SCOPE_AGENT);
            const unsigned long long w2 = (unsigned long long)__builtin_bit_cast(unsigned, tokw[2 * m]) | ((unsigned long long)__builtin_bit_cast(unsigned, tokw[2 * m + 1]) << 32);
            __hip_atomic_store((unsigned long long*)(roww + 2 * row), w2, __ATOMIC_RELAXED, __HIP_MEMORY_SCOPE_AGENT); }
        if (F.lane == 0) __hip_atomic_store((float*)(F.ws + WS_ROWR) + row, rstd, __ATOMIC_RELAXED, __HIP_MEMORY_SCOPE_AGENT);
        const u32x4* xr = (const u32x4*)(P_XB(F) + (size_t)m * D) + F.lane; u32x4* o16 = (u32x4*)(XS + (size_t)row * D) + F.lane;
        o16[0] = xr[0]; o16[64] = xr[64];
    }
}
struct MoeOrder {
    const int* tileb; int G, c; bool down;
    __device__ __forceinline__ bool next(int i, pg8::Unit& u) const {
        const GAS int* tb_ = (const GAS int*)tileb;
        const int NT = __builtin_amdgcn_readfirstlane(tb_[0]), L = i * G + c; if (L >= NT * 4) return false;
        const int rt = L >> 2, pn = L & 3, b = __builtin_amdgcn_readfirstlane(tb_[1 + rt]);
        if (down) { u.pm = rt; u.pn = b * 4 + pn; u.aux = pn; }
        else { int ea, eb; pair_decode(b % 6, ea, eb); const int e = (b / 6) * 4 + (pn < 2 ? ea : eb); u.pm = rt; u.pn = e * 2 + (pn & 1); u.aux = pn; }
        return true;
    }
};
struct EpiGU {
    static constexpr bool PERM = true;
    bf16* H; const float* roww; const float* rowr;
    __device__ __forceinline__ void operator()(const f32x4 (&acc)[2][2][4][2], const pg8::Unit& u, int wr, int wc, int fr_, int fq_) const {
        const int ln_ = lane_id(), fr = ln_ & 15, fq = ln_ >> 4; (void)fr_; (void)fq_;
        const int row0 = u.pm * 256 + wr * 64 + fr, cl = u.aux * 128 + 16 * wc + 4 * fq, ws = u.aux >> 1;
#pragma unroll
        for (int ai = 0; ai < 2; ++ai)
#pragma unroll
            for (int m = 0; m < 4; ++m) { const int r = row0 + ai * 128 + m * 16; const float rr = rowr[r], w = roww[2 * r + ws] * rr;
#pragma unroll
                for (int bj = 0; bj < 2; ++bj) { const f32x4 g = acc[ai][bj][m][0], up = acc[ai][bj][m][1]; f32x4 a;
#pragma unroll
                    for (int i = 0; i < 4; ++i) { const float gg = g[i] * rr; a[i] = gg * sigmoidf_(gg) * up[i] * w; }
                    u32x2 o; o.x = pg8::cvt_pk_bf16(a[0], a[1]); o.y = pg8::cvt_pk_bf16(a[2], a[3]);
                    *(u32x2*)(H + (size_t)r * 512 + cl + bj * 64) = o; } }
    }
};
struct EpiDown {
    static constexpr bool PERM = true;
    bf16* RB; const int* rowtok;
    __device__ __forceinline__ void operator()(const f32x4 (&acc)[2][2][4][2], const pg8::Unit& u, int wr, int wc, int fr_, int fq_) const {
        const int ln_ = lane_id(), fr = ln_ & 15, fq = ln_ >> 4; (void)fr_; (void)fq_;
        const int row0 = u.pm * 256 + wr * 64 + fr, col0 = u.aux * 256 + wc * 32 + 8 * fq;
#pragma unroll
        for (int ai = 0; ai < 2; ++ai)
#pragma unroll
            for (int m = 0; m < 4; ++m) { const int tok = rowtok[row0 + ai * 128 + m * 16];
                if (tok >= 0) { bf16* rp = RB + (size_t)tok * D + col0;
#pragma unroll
                    for (int bj = 0; bj < 2; ++bj) { const u32x4 x = *(const u32x4*)(rp + bj * 128); const f32x4 a0 = acc[ai][bj][m][0], a1 = acc[ai][bj][m][1]; u32x4 w;
                        w.x = pg8::cvt_pk_bf16(bf2f(x.x & 0xffffu) + a0[0], bf2f(x.x >> 16) + a0[1]); w.y = pg8::cvt_pk_bf16(bf2f(x.y & 0xffffu) + a0[2], bf2f(x.y >> 16) + a0[3]);
                        w.z = pg8::cvt_pk_bf16(bf2f(x.z & 0xffffu) + a1[0], bf2f(x.z >> 16) + a1[1]); w.w = pg8::cvt_pk_bf16(bf2f(x.w & 0xffffu) + a1[2], bf2f(x.w >> 16) + a1[3]);
                        *(u32x4*)(rp + bj * 128) = w; } }
                if (m & 1) asm volatile("" ::: "memory"); }
    }
};

struct SsmOrder { int G, c, mode;
    __device__ __forceinline__ bool next(int i, pg8::Unit& u) const { const int L = i * G + c;
        if (mode == 1) { if (L >= 32) return false; u.pm = L; u.pn = L >> 1; u.aux = 0; return true; }
        if (L >= 128) return false; const int g = L >> 3; u.pm = g * 2 + ((L >> 2) & 1); u.pn = g * 4 + (L & 3); u.aux = L & 3; return true; } };
struct HalfOrder { int L;
    __device__ __forceinline__ bool next(int i, pg8::Unit& u) const { if (i > 0 || L < 0 || L >= 128) return false; u.pm = L; u.pn = 0; u.aux = 0; return true; } };
struct EpiZ { static constexpr bool PERM = false; float* ZB;
    __device__ __forceinline__ void operator()(const f32x4 (&acc)[2][2][4][2], const pg8::Unit& u, int wr, int wc, int fr_, int fq_) const {
        const int ln_ = lane_id(), fr = ln_ & 15, fq = ln_ >> 4; (void)fr_; (void)fq_;
        const int row0 = u.pm * 256 + wr * 64 + fr, col0 = wc * 32 + 4 * fq;
#pragma unroll
        for (int ai = 0; ai < 2; ++ai)
#pragma unroll
            for (int m = 0; m < 4; ++m)
#pragma unroll
                for (int n = 0; n < 2; ++n) *(f32x4*)(ZB + (size_t)(row0 + ai * 128 + m * 16) * 128 + col0 + n * 16) = acc[ai][0][m][n];
    } };
struct EpiSsm2 { static constexpr bool PERM = true; const bf16* UG; bf16* YS; const float* dvec;
    __device__ __forceinline__ void operator()(const f32x4 (&acc)[2][2][4][2], const pg8::Unit& u, int wr, int wc, int fr_, int fq_) const {
        const int ln_ = lane_id(), fr = ln_ & 15, fq = ln_ >> 4; (void)fr_; (void)fq_;
        const int g = u.pm >> 1, cr0 = (u.pm & 1) * 256 + wr * 64 + fr;
#pragma unroll
        for (int bj = 0; bj < 2; ++bj) { const int n0 = u.aux * 256 + bj * 128 + wc * 32 + 8 * fq, to = n0 >> 4, ho0 = n0 & 15;
            const f32x4 d0 = *(const f32x4*)(dvec + g * 16 + ho0), d1 = *(const f32x4*)(dvec + g * 16 + ho0 + 4);
#pragma unroll
            for (int ai = 0; ai < 2; ++ai)
#pragma unroll
                for (int m = 0; m < 4; ++m) { const int cr = cr0 + ai * 128 + m * 16;
                    const u32x4 uu = *(const u32x4*)(UG + ((size_t)(g * 512 + cr)) * UGP + n0);
                    const f32x4 a0 = acc[ai][bj][m][0], a1 = acc[ai][bj][m][1]; float y[8];
                    y[0] = gelu_tanh(a0[0] + d0[0] * bf2f(uu.x & 0xffffu)); y[1] = gelu_tanh(a0[1] + d0[1] * bf2f(uu.x >> 16));
                    y[2] = gelu_tanh(a0[2] + d0[2] * bf2f(uu.y & 0xffffu)); y[3] = gelu_tanh(a0[3] + d0[3] * bf2f(uu.y >> 16));
                    y[4] = gelu_tanh(a1[0] + d1[0] * bf2f(uu.z & 0xffffu)); y[5] = gelu_tanh(a1[1] + d1[1] * bf2f(uu.z >> 16));
                    y[6] = gelu_tanh(a1[2] + d1[2] * bf2f(uu.w & 0xffffu)); y[7] = gelu_tanh(a1[3] + d1[3] * bf2f(uu.w >> 16));
                    u32x4 w; w.x = pg8::cvt_pk_bf16(y[0], y[1]); w.y = pg8::cvt_pk_bf16(y[2], y[3]); w.z = pg8::cvt_pk_bf16(y[4], y[5]); w.w = pg8::cvt_pk_bf16(y[6], y[7]);
                    *(u32x4*)(YS + ((size_t)cr * 64 + to) * 256 + g * 16 + ho0) = w; } }
    } };
struct EpiGluE { static constexpr bool PERM = true; const bf16* YS; bf16* YMIX; const float* gb;
    __device__ __forceinline__ void operator()(const f32x4 (&acc)[2][2][4][2], const pg8::Unit& u, int wr, int wc, int fr_, int fq_) const {
        const int ln_ = lane_id(), fr = ln_ & 15, fq = ln_ >> 4; (void)fr_; (void)fq_;
        const int row0 = u.pm * 256 + wr * 64 + fr;
#pragma unroll
        for (int bj = 0; bj < 2; ++bj) { const int n0 = bj * 128 + wc * 32 + 8 * fq; const f32x4 b0 = *(const f32x4*)(gb + n0), b1 = *(const f32x4*)(gb + n0 + 4);
#pragma unroll
            for (int ai = 0; ai < 2; ++ai)
#pragma unroll
                for (int m = 0; m < 4; ++m) { const size_t r = (size_t)(row0 + ai * 128 + m * 16); const u32x4 yy = *(const u32x4*)(YS + r * 256 + n0);
                    const f32x4 a0 = acc[ai][bj][m][0] + b0, a1 = acc[ai][bj][m][1] + b1; float o[8];
                    o[0] = bf2f(yy.x & 0xffffu) * sigmoidf_(a0[0]); o[1] = bf2f(yy.x >> 16) * sigmoidf_(a0[1]); o[2] = bf2f(yy.y & 0xffffu) * sigmoidf_(a0[2]); o[3] = bf2f(yy.y >> 16) * sigmoidf_(a0[3]);
                    o[4] = bf2f(yy.z & 0xffffu) * sigmoidf_(a1[0]); o[5] = bf2f(yy.z >> 16) * sigmoidf_(a1[1]); o[6] = bf2f(yy.w & 0xffffu) * sigmoidf_(a1[2]); o[7] = bf2f(yy.w >> 16) * sigmoidf_(a1[3]);
                    u32x4 w; w.x = pg8::cvt_pk_bf16(o[0], o[1]); w.y = pg8::cvt_pk_bf16(o[2], o[3]); w.z = pg8::cvt_pk_bf16(o[4], o[5]); w.w = pg8::cvt_pk_bf16(o[6], o[7]);
                    *(u32x4*)(YMIX + r * 1024 + n0) = w; } }
    } };
struct EpiPoolE { static constexpr bool PERM = true; bf16* YMIX; const float* pb; const float* ps;
    __device__ __forceinline__ void operator()(const f32x4 (&acc)[2][2][4][2], const pg8::Unit& u, int wr, int wc, int fr_, int fq_) const {
        const int ln_ = lane_id(), fr = ln_ & 15, fq = ln_ >> 4; (void)fr_; (void)fq_;
        const int row0 = u.pm * 256 + wr * 64 + fr;
#pragma unroll
        for (int bj = 0; bj < 2; ++bj) { const int n0 = bj * 128 + wc * 32 + 8 * fq; const f32x4 b0 = *(const f32x4*)(pb + n0), b1 = *(const f32x4*)(pb + n0 + 4), s0 = *(const f32x4*)(ps + n0), s1 = *(const f32x4*)(ps + n0 + 4);
#pragma unroll
            for (int ai = 0; ai < 2; ++ai)
#pragma unroll
                for (int m = 0; m < 4; ++m) { const size_t r = (size_t)(row0 + ai * 128 + m * 16);
                    const f32x4 a0 = (acc[ai][bj][m][0] + b0) * s0, a1 = (acc[ai][bj][m][1] + b1) * s1;
                    u32x4 w; w.x = pg8::cvt_pk_bf16(a0[0], a0[1]); w.y = pg8::cvt_pk_bf16(a0[2], a0[3]); w.z = pg8::cvt_pk_bf16(a1[0], a1[1]); w.w = pg8::cvt_pk_bf16(a1[2], a1[3]);
                    *(u32x4*)(YMIX + r * 1024 + 256 + n0) = w; } }
    } };
__device__ __forceinline__ void ph_tg_expand(const Ctx& F0, int l) {
    const Ctx F = launder(F0);
    if (F.wave == 0) return;
    const int gw = F.vcu * 7 + (F.wave - 1), NGW = F.G * 7;
    const bf16* KT = (const bf16*)(F.ws + WS_KT) + (size_t)l * SGN * 64 * 256;
    bf16* TG0 = (bf16*)(F.ws + WS_TG) + (size_t)l * SGN * 1024 * UGP;
#pragma unroll 2
    for (int r = gw; r < SGN * 1024; r += NGW) { const int g = r >> 10, n = r & 1023, to = n >> 4, ho = n & 15;
        bf16* d = TG0 + ((size_t)g * 1024 + n) * UGP;
#pragma unroll
        for (int half = 0; half < 2; ++half) { const int ti = half * 32 + (F.lane >> 1), tau = to - ti;
            u32x4 v = (u32x4){0u, 0u, 0u, 0u};
            if (tau >= 0) v = *(const u32x4*)(KT + (((size_t)g * 64 + tau) * 16 + ho) * 16 + (F.lane & 1) * 8);
            *(u32x4*)(d + half * 512 + F.lane * 8) = v; } }
}
__device__ __forceinline__ void ph_ssm_scan(const Ctx& F0, int l) {
    const Ctx F = launder(F0);
    for (int it = F.vcu + F.G * F.wave; it < SGN * NB; it += F.G * NWAVES) {
        const int g = it >> 3, b = it & 7, p = F.lane;
        const float are = F.in[4][(l * SGN + g) * SP + p], aim = F.in[5][(l * SGN + g) * SP + p], dt = expf(F.in[6][l * SGN + g]);
        float sn, cs; sincosf(aim * dt * 64.f, &sn, &cs); const float mg = expf(are * dt * 64.f), lr = mg * cs, li = mg * sn;
        const float* Z = (const float*)(F.ws + WS_ZB) + ((size_t)g * 512 + b * 64) * 128;
        bf16* U = P_UG(F) + ((size_t)g * 512 + b * 64) * UGP + 1024;
        float sr = 0.f, si = 0.f;
#pragma unroll 1
        for (int c0 = 0; c0 < 64; c0 += 32) {
            float zr[32], zi[32];
#pragma unroll
            for (int j = 0; j < 32; ++j) { zr[j] = Z[(c0 + j) * 128 + p]; zi[j] = Z[(c0 + j) * 128 + 64 + p]; }
#pragma unroll
            for (int j = 0; j < 32; ++j) {
                U[(size_t)(c0 + j) * UGP + p] = (bf16)f2bf(sr); U[(size_t)(c0 + j) * UGP + 64 + p] = (bf16)f2bf(si);
                const float nr = lr * sr - li * si + zr[j], ni = lr * si + li * sr + zi[j]; sr = nr; si = ni; }
        }
    }
}

namespace moba {
using bf16x8 = __attribute__((ext_vector_type(8))) short;
using s16x4 = __attribute__((ext_vector_type(4))) short;
using f32x16 = __attribute__((ext_vector_type(16))) float;
typedef short v4i16_t __attribute__((ext_vector_type(4)));
typedef float f32x2_t __attribute__((ext_vector_type(2))); typedef __bf16 bf16x2_t __attribute__((ext_vector_type(2)));
constexpr int L_K = 0, L_V = 49152, L_TB = 98304, L_KM = L_TB + 4 * 768 * 4, L_END = L_KM + 16 * 64 * 4;
__device__ __forceinline__ unsigned cvtpk(float lo, float hi) { f32x2_t v = {lo, hi}; bf16x2_t b = __builtin_convertvector(v, bf16x2_t); return __builtin_bit_cast(unsigned, b); }
__device__ __forceinline__ s16x4 vtr(const LAS char* p) { return __builtin_bit_cast(s16x4, __builtin_amdgcn_ds_read_tr16_b64_v4i16((LAS v4i16_t*)p)); }
__device__ __forceinline__ float hmax(float v) { const unsigned u = __builtin_bit_cast(unsigned, v); auto r = __builtin_amdgcn_permlane32_swap(u, u, false, false); return fmaxf(__builtin_bit_cast(float, (unsigned)r[0]), __builtin_bit_cast(float, (unsigned)r[1])); }
__device__ __forceinline__ float hsum(float v) { const unsigned u = __builtin_bit_cast(unsigned, v); auto r = __builtin_amdgcn_permlane32_swap(u, u, false, false); return __builtin_bit_cast(float, (unsigned)r[0]) + __builtin_bit_cast(float, (unsigned)r[1]); }

constexpr int L_LIST = L_END, L_WCNT = 32768;
#define MOBA_CVEC() f32x16 cvec; do { const float ci_ = bfar - mref; _Pragma("unroll") for (int r = 0; r < 16; ++r) cvec[r] = ci_; } while (0)
#define MOBA_QK(P0, P1, KB) do { { const bf16x8 a0 = *(const LAS bf16x8*)(kp0 + (KB)), a1 = *(const LAS bf16x8*)(kp0 + (KB) + 512); \
          P0 = __builtin_amdgcn_mfma_f32_32x32x16_bf16(a0, qr[0], cvec, 0, 0, 0); P1 = __builtin_amdgcn_mfma_f32_32x32x16_bf16(a1, qr[0], cvec, 0, 0, 0); } \
        _Pragma("unroll") for (int d0 = 1; d0 < 4; ++d0) { const bf16x8 a0 = *(const LAS bf16x8*)(kp0 + (KB) + d0 * 2048), a1 = *(const LAS bf16x8*)(kp0 + (KB) + d0 * 2048 + 512); \
            P0 = __builtin_amdgcn_mfma_f32_32x32x16_bf16(a0, qr[d0], P0, 0, 0, 0); P1 = __builtin_amdgcn_mfma_f32_32x32x16_bf16(a1, qr[d0], P1, 0, 0, 0); } } while (0)
#define MOBA_NEARMAX(P0, P1, JN, OUT) do { const int jn_ = (JN); if (jn_ >= 0) { const int A_ = qrel - 64 * (jn_ - 4) - 4 * hi + 256, s_ = 767 - A_, c_ = s_ & 3; \
            const LAS f32x4* t4 = (const LAS f32x4*)(tb + c_ * 768 + (s_ - c_)); \
            _Pragma("unroll") for (int g = 0; g < 4; ++g) { const f32x4 x0 = t4[2 * g], x1 = t4[2 * g + 8]; \
                _Pragma("unroll") for (int j = 0; j < 4; ++j) { P0[4 * g + j] += x0[j]; P1[4 * g + j] += x1[j]; } } } \
        float ra = __builtin_fmaxf(__builtin_fmaxf(P0[0], P0[1]), P1[0]), rb = __builtin_fmaxf(__builtin_fmaxf(P0[2], P0[3]), P1[1]); \
        ra = __builtin_fmaxf(__builtin_fmaxf(ra, P1[2]), P1[3]); \
        _Pragma("unroll") for (int r = 4; r < 16; r += 4) { ra = __builtin_fmaxf(__builtin_fmaxf(ra, P0[r]), P0[r + 1]); rb = __builtin_fmaxf(__builtin_fmaxf(rb, P0[r + 2]), P0[r + 3]); \
            ra = __builtin_fmaxf(__builtin_fmaxf(ra, P1[r]), P1[r + 1]); rb = __builtin_fmaxf(__builtin_fmaxf(rb, P1[r + 2]), P1[r + 3]); } \
        OUT = hmax(__builtin_fmaxf(ra, rb)); } while (0)
#define MOBA_STEP(PC0, PC1, PN0, PN1, JNN, KBN, VBC, HASN) do { \
        bf16x8 vf[8], kf[8]; \
        if (HASN) { _Pragma("unroll") for (int d0 = 0; d0 < 4; ++d0) { kf[2 * d0] = *(const LAS bf16x8*)(kp0 + (KBN) + d0 * 2048); kf[2 * d0 + 1] = *(const LAS bf16x8*)(kp0 + (KBN) + d0 * 2048 + 512); } } \
        __builtin_amdgcn_sched_barrier(0); \
        if (__any(rm > 8.f)) { const float dl = __builtin_fmaxf(rm, 0.f), alpha = __builtin_amdgcn_exp2f(-dl); mref += dl; l *= alpha; \
            _Pragma("unroll") for (int r = 0; r < 16; ++r) { PC0[r] -= dl; PC1[r] -= dl; o0[r] *= alpha; o1[r] *= alpha; } } \
        if (HASN) { MOBA_CVEC(); \
                    PN0 = __builtin_amdgcn_mfma_f32_32x32x16_bf16(kf[0], qr[0], cvec, 0, 0, 0); PN1 = __builtin_amdgcn_mfma_f32_32x32x16_bf16(kf[1], qr[0], cvec, 0, 0, 0); \
                    _Pragma("unroll") for (int d0 = 1; d0 < 4; ++d0) { PN0 = __builtin_amdgcn_mfma_f32_32x32x16_bf16(kf[2 * d0], qr[d0], PN0, 0, 0, 0); PN1 = __builtin_amdgcn_mfma_f32_32x32x16_bf16(kf[2 * d0 + 1], qr[d0], PN1, 0, 0, 0); } } \
        { const LAS char* vp = vp0 + (VBC); \
        _Pragma("unroll") for (int k = 0; k < 4; ++k) { \
            const s16x4 lo0 = vtr(vp + k * 1024), hi0 = vtr(vp + k * 1024 + 512), lo1 = vtr(vp + 4096 + k * 1024), hi1 = vtr(vp + 4096 + k * 1024 + 512); \
            vf[2 * k] = (bf16x8){lo0[0], lo0[1], lo0[2], lo0[3], hi0[0], hi0[1], hi0[2], hi0[3]}; vf[2 * k + 1] = (bf16x8){lo1[0], lo1[1], lo1[2], lo1[3], hi1[0], hi1[1], hi1[2], hi1[3]}; } } \
        __builtin_amdgcn_sched_barrier(0); \
        float s0 = 0.f, s1 = 0.f; u32x4 pw[4]; \
        _Pragma("unroll") for (int r = 0; r < 16; ++r) { PC0[r] = __builtin_amdgcn_exp2f(PC0[r]); PC1[r] = __builtin_amdgcn_exp2f(PC1[r]); s0 += PC0[r]; s1 += PC1[r]; } \
        l += s0 + s1; \
        _Pragma("unroll") for (int q = 0; q < 4; ++q) { pw[0][q] = cvtpk(PC0[2 * q], PC0[2 * q + 1]); pw[1][q] = cvtpk(PC0[8 + 2 * q], PC0[9 + 2 * q]); pw[2][q] = cvtpk(PC1[2 * q], PC1[2 * q + 1]); pw[3][q] = cvtpk(PC1[8 + 2 * q], PC1[9 + 2 * q]); } \
        _Pragma("unroll") for (int k = 0; k < 4; ++k) { const bf16x8 pa = __builtin_bit_cast(bf16x8, pw[k]); \
            o0 = __builtin_amdgcn_mfma_f32_32x32x16_bf16(vf[2 * k], pa, o0, 0, 0, 0); o1 = __builtin_amdgcn_mfma_f32_32x32x16_bf16(vf[2 * k + 1], pa, o1, 0, 0, 0); } \
        if (HASN) MOBA_NEARMAX(PN0, PN1, JNN, rm); \
    } while (0)
#define MOBA_BLOCK4(JN0) \
    float mref = 0.f, l = 0.f; f32x16 o0 = f32x16{}, o1 = f32x16{}; f32x16 pa0, pa1, pb0, pb1; float rm; \
    { const int jn0_ = (JN0); \
      { MOBA_CVEC(); MOBA_QK(pa0, pa1, 0); } MOBA_NEARMAX(pa0, pa1, jn0_, rm); \
      MOBA_STEP(pa0, pa1, pb0, pb1, (jn0_ < 0 ? -1 : jn0_ + 1), 8192, 0, true); \
      MOBA_STEP(pb0, pb1, pa0, pa1, (jn0_ < 0 ? -1 : jn0_ + 2), 16384, 8192, true); \
      MOBA_STEP(pa0, pa1, pb0, pb1, (jn0_ < 0 ? -1 : jn0_ + 3), 24576, 16384, true); \
      MOBA_STEP(pb0, pb1, pa0, pa1, -1, 0, 24576, false); }
__device__ __forceinline__ void load_block(const bf16* K, const bf16* V, size_t row0, int h, int wid, int lane, LAS char* lds) {
    const bf16* ksrc = K + (row0 + lane) * 512 + h * 64 + wid * 8;
    const bf16* vsrc = V + (row0 + 16 * (wid & 3) + (lane >> 2)) * 512 + h * 64 + (wid >> 2) * 32 + (lane & 3) * 8;
    u32x4 kr[4], vr[4];
#pragma unroll
    for (int t = 0; t < 4; ++t) { kr[t] = *(const u32x4*)(ksrc + (size_t)t * 64 * 512); vr[t] = *(const u32x4*)(vsrc + (size_t)t * 64 * 512); }
    LAS char* kd = lds + L_K + wid * 1024 + lane * 16; LAS char* vd = lds + L_V + wid * 1024 + lane * 16;
#pragma unroll
    for (int t = 0; t < 4; ++t) { *(LAS u32x4*)(kd + t * 8192) = kr[t]; *(LAS u32x4*)(vd + t * 8192) = vr[t]; }
}
__device__ __forceinline__ void fill_bias_table(const float* BT, int h, int tid, LAS float* tb) {
    const float bfar = BT[h * 132 + 128];
    for (int i = tid; i < 4 * 768; i += NTHREADS) { const int c = i / 768, j = i % 768, src_ = 767 - (j + c), rel = src_ - 256; tb[i] = (src_ < 0 || rel < 0) ? -1.0e30f : (rel < 128 ? BT[h * 132 + rel] - bfar : 0.f); }
}
__device__ __forceinline__ void sel_phase(int wave_, int vcu, int G, const bf16* Q, const float* KMP, unsigned* SEL, LAS char* lds) {
    const int w0 = G > 64 ? 32 : 0, nw = G - w0; if (vcu < w0) return;
    int lane_ = lane_id(); asm volatile("" : "+v"(lane_)); asm volatile("" : "+s"(wave_));
    const int wid = wave_, lane = lane_, tid = wid * 64 + lane, r32 = lane & 31, hi = lane >> 5;
    const int ub = ((vcu - w0) * 1024) / nw, ue = ((vcu - w0 + 1) * 1024) / nw;
    LAS float* km = (LAS float*)(lds + L_KM);
    int bhc = -1;
#pragma unroll 1
    for (int u = ub; u < ue; ++u) {
        const int bh = u >> 4, qb = u & 15, b = bh >> 3, h = bh & 7;
        if (bh != bhc) { bhc = bh;
            __syncthreads();
            for (int i = tid; i < 16 * 64; i += NTHREADS) { const int j = i >> 6, d = i & 63, pm = b * 16 + j; km[i] = KMP[pm * 512 + h * 64 + d] + KMP[128 * 512 + pm * 512 + h * 64 + d]; }
            __syncthreads(); }
        asm volatile("" ::: "memory");
        const int q = qb * 256 + wid * 32 + r32;
        const bf16* qw = Q + ((size_t)b * SEQ + q) * 512 + h * 64 + hi * 8;
        bf16x8 qr[4];
#pragma unroll
        for (int d0 = 0; d0 < 4; ++d0) qr[d0] = *(const bf16x8*)(qw + d0 * 16);
        float g[16];
#pragma unroll
        for (int j = 0; j < 16; ++j) g[j] = 0.f;
#pragma unroll
        for (int d0 = 0; d0 < 4; ++d0)
#pragma unroll
            for (int j = 0; j < 16; ++j) { const f32x4 ka = *(const LAS f32x4*)(km + j * 64 + d0 * 16 + hi * 8), kb4 = *(const LAS f32x4*)(km + j * 64 + d0 * 16 + hi * 8 + 4);
#pragma unroll
                for (int e = 0; e < 4; ++e) { g[j] += bf2f((unsigned)(unsigned short)qr[d0][e]) * ka[e]; }
#pragma unroll
                for (int e = 0; e < 4; ++e) { g[j] += bf2f((unsigned)(unsigned short)qr[d0][4 + e]) * kb4[e]; } }
#pragma unroll
        for (int j = 0; j < 16; ++j) g[j] = hsum(g[j]);
        unsigned selmask = 0u;
#pragma unroll
        for (int s3 = 0; s3 < 3; ++s3) { float bv = -3.0e38f; int bi = -1;
#pragma unroll
            for (int j = 0; j < 16; ++j) { const bool ok = (j < qb) && !((selmask >> j) & 1u) && (g[j] > bv); bv = ok ? g[j] : bv; bi = ok ? j : bi; }
            if (bi >= 0) selmask |= 1u << bi; }
        if (hi == 0) SEL[(size_t)bh * SEQ + q] = selmask;
    }
}
__device__ __forceinline__ bf16* pslot(int slot, size_t t, int h, bf16* YM, bf16* P2A, bf16* P2B) {
    return slot == 0 ? YM + t * 1024 + h * 64 : slot == 1 ? YM + t * 1024 + 512 + h * 64 : (t < (size_t)(T / 2) ? P2A + t * 512 : P2B + (t - (size_t)(T / 2)) * 512) + h * 64;
}
__device__ __forceinline__ void gather_phase(int wave_, int vcu, const bf16* Q, const bf16* K, const bf16* V, bf16* YM, bf16* P2A, bf16* P2B, float* ML, const unsigned* SEL, const float* BT, LAS char* lds) {
    if (vcu >= 256) return;
    int lane_ = lane_id(); asm volatile("" : "+v"(lane_)); asm volatile("" : "+s"(wave_));
    const int wid = wave_, lane = lane_, tid = wid * 64 + lane, r32 = lane & 31, hi = lane >> 5;
    const int bh = vcu >> 2, s = vcu & 3, b = bh >> 3, h = bh & 7;
    const size_t rowbase = (size_t)b * SEQ;
    LAS float* tb = (LAS float*)(lds + L_TB); LAS int* list = (LAS int*)(lds + L_LIST); LAS int* wcnt = (LAS int*)(lds + L_WCNT);
    const float bfar = BT[h * 132 + 128];
    fill_bias_table(BT, h, tid, tb);
    const unsigned* selrow = SEL + (size_t)bh * SEQ;
    const LAS char* kp0 = lds + L_K + hi * 1024 + r32 * 16;
    const LAS char* vp0 = lds + L_V + ((lane >> 4) & 1) * 32 + (lane & 3) * 8 + (4 * hi + ((lane & 15) >> 2)) * 64;
    const unsigned code = s == 0 ? 0xFFFA70u : s == 1 ? 0xFFE961u : s == 2 ? 0xFFFB32u : 0xFDC854u;
#pragma unroll 1
    for (int ik = 0; ik < 6; ++ik) {
        const int kb = (int)((code >> (4 * ik)) & 15u); if (kb == 15) break;
        __syncthreads();
        load_block(K, V, rowbase + (size_t)kb * 256, h, wid, lane, lds);
        const int qs = (kb + 1) * 256, R = (SEQ - qs) >> 3;
        unsigned long long bal[8]; int cnt = 0;
#pragma unroll
        for (int i = 0; i < 8; ++i) { const int off = i * 64 + lane; const bool in = off < R; const unsigned m = in ? selrow[qs + wid * R + off] : 0u;
            bal[i] = __ballot(in && ((m >> kb) & 1u)); cnt += __builtin_popcountll(bal[i]); }
        if (lane == 0) wcnt[wid] = cnt;
        __syncthreads();
        int base = 0, n = 0;
#pragma unroll
        for (int w = 0; w < 8; ++w) { const int c = wcnt[w]; n += c; base += (w < wid) ? c : 0; }
#pragma unroll
        for (int i = 0; i < 8; ++i) { const unsigned long long m = bal[i];
            if ((m >> lane) & 1ull) list[base + __builtin_popcountll(m & ((1ull << lane) - 1ull))] = qs + wid * R + i * 64 + lane;
            base += __builtin_popcountll(m); }
        __syncthreads();
        const int ntask = (n + 31) >> 5;
#pragma unroll 1
        for (int tk = wid; tk < ntask; tk += 8) {
            const int li = tk * 32 + r32; const bool valid = li < n; const int qi = list[valid ? li : n - 1];
            const unsigned sm = selrow[qi]; const int slot = __builtin_popcount(sm & ((1u << kb) - 1u));
            bf16x8 qr[4];
            { const bf16* qw = Q + (rowbase + qi) * 512 + h * 64 + hi * 8;
#pragma unroll
              for (int d0 = 0; d0 < 4; ++d0) qr[d0] = *(const bf16x8*)(qw + d0 * 16); }
            const int qd = qi - qs, qrel = qd < 255 ? qd : 255;
            const bool nearw = __any(qd < 128);
            MOBA_BLOCK4(nearw ? 0 : -1)
            const float lt = hsum(l), inv = 1.f / lt; const size_t t = rowbase + qi;
            bf16* orow = pslot(slot, t, h, YM, P2A, P2B) + 8 * hi;
#pragma unroll
            for (int d0 = 0; d0 < 2; ++d0)
#pragma unroll
                for (int gp = 0; gp < 2; ++gp) { const f32x16& oo = d0 ? o1 : o0; const int ga = 8 * gp, gb = 8 * gp + 4;
                    unsigned ax = cvtpk(oo[ga] * inv, oo[ga + 1] * inv), ay = cvtpk(oo[ga + 2] * inv, oo[ga + 3] * inv), bx = cvtpk(oo[gb] * inv, oo[gb + 1] * inv), by = cvtpk(oo[gb + 2] * inv, oo[gb + 3] * inv);
                    { auto r = __builtin_amdgcn_permlane32_swap(ax, bx, false, false); ax = r[0]; bx = r[1]; }
                    { auto r = __builtin_amdgcn_permlane32_swap(ay, by, false, false); ay = r[0]; by = r[1]; }
                    if (valid) *(u32x4*)(orow + 32 * d0 + 16 * gp) = (u32x4){ax, ay, bx, by}; }
            if (valid && hi == 0) { float* ml = ML + ((t * 8 + h) * 3 + slot) * 2; ml[0] = mref; ml[1] = lt; }
        }
    }
}
__device__ __forceinline__ void diag_unit(int wid, int lane, int b, int h, int qb, const bf16* Q, const bf16* K, const bf16* V, bf16* YM, const bf16* P2A, const bf16* P2B, const float* ML, float bfar, LAS char* lds) {
    const int r32 = lane & 31, hi = lane >> 5; const size_t rowbase = (size_t)b * SEQ;
    LAS float* tb = (LAS float*)(lds + L_TB);
    const LAS char* kp0 = lds + L_K + hi * 1024 + r32 * 16;
    const LAS char* vp0 = lds + L_V + ((lane >> 4) & 1) * 32 + (lane & 3) * 8 + (4 * hi + ((lane & 15) >> 2)) * 64;
    __syncthreads();
    load_block(K, V, rowbase + (size_t)qb * 256, h, wid, lane, lds);
    const int qrel = wid * 32 + r32; const size_t t = rowbase + qb * 256 + qrel;
    bf16x8 qr[4];
    { const bf16* qw = Q + t * 512 + h * 64 + hi * 8;
#pragma unroll
      for (int d0 = 0; d0 < 4; ++d0) qr[d0] = *(const bf16x8*)(qw + d0 * 16); }
    __syncthreads();
    MOBA_BLOCK4(4)
    const int nsl = qb < 3 ? qb : 3;
    const float* ml = ML + (t * 8 + h) * 6;
    float m0 = -3.0e38f, m1 = -3.0e38f, m2 = -3.0e38f, l0 = 0.f, l1 = 0.f, l2 = 0.f;
    if (nsl > 0) { m0 = ml[0]; l0 = ml[1]; } if (nsl > 1) { m1 = ml[2]; l1 = ml[3]; } if (nsl > 2) { m2 = ml[4]; l2 = ml[5]; }
    const float M = __builtin_fmaxf(__builtin_fmaxf(mref, m0), __builtin_fmaxf(m1, m2));
    const float w0 = __builtin_amdgcn_exp2f(mref - M), wa = l0 * __builtin_amdgcn_exp2f(m0 - M), wb = l1 * __builtin_amdgcn_exp2f(m1 - M), wc = l2 * __builtin_amdgcn_exp2f(m2 - M);
    const float inv = 1.f / (hsum(l) * w0 + wa + wb + wc);
    const float s0 = w0 * inv, sa = wa * inv, sb = wb * inv, sc = wc * inv;
    const bf16* pA = YM + t * 1024 + h * 64 + 4 * hi; const bf16* pB = YM + t * 1024 + 512 + h * 64 + 4 * hi;
    const bf16* pC = (t < (size_t)(T / 2) ? P2A + t * 512 : P2B + (t - (size_t)(T / 2)) * 512) + h * 64 + 4 * hi;
    bf16* orow = YM + t * 1024 + 512 + h * 64 + 8 * hi;
#pragma unroll
    for (int d0 = 0; d0 < 2; ++d0)
#pragma unroll
        for (int gp = 0; gp < 2; ++gp) { const f32x16& oo = d0 ? o1 : o0; const int ga = 8 * gp, gb = 8 * gp + 4, dof = 32 * d0 + 16 * gp;
            float a0 = oo[ga] * s0, a1 = oo[ga + 1] * s0, a2 = oo[ga + 2] * s0, a3 = oo[ga + 3] * s0, b0 = oo[gb] * s0, b1 = oo[gb + 1] * s0, b2 = oo[gb + 2] * s0, b3 = oo[gb + 3] * s0;
#define MOBA_ACC(P, W) { const u32x2 xa = *(const u32x2*)((P) + dof), xb = *(const u32x2*)((P) + dof + 8); \
              a0 += (W) * bf2f(xa.x & 0xffffu); a1 += (W) * __builtin_bit_cast(float, xa.x & 0xffff0000u); a2 += (W) * bf2f(xa.y & 0xffffu); a3 += (W) * __builtin_bit_cast(float, xa.y & 0xffff0000u); \
              b0 += (W) * bf2f(xb.x & 0xffffu); b1 += (W) * __builtin_bit_cast(float, xb.x & 0xffff0000u); b2 += (W) * bf2f(xb.y & 0xffffu); b3 += (W) * __builtin_bit_cast(float, xb.y & 0xffff0000u); }
            if (nsl > 0) MOBA_ACC(pA, sa) if (nsl > 1) MOBA_ACC(pB, sb) if (nsl > 2) MOBA_ACC(pC, sc)
#undef MOBA_ACC
            unsigned ax = cvtpk(a0, a1), ay = cvtpk(a2, a3), bx = cvtpk(b0, b1), by = cvtpk(b2, b3);
            { auto r = __builtin_amdgcn_permlane32_swap(ax, bx, false, false); ax = r[0]; bx = r[1]; }
            { auto r = __builtin_amdgcn_permlane32_swap(ay, by, false, false); ay = r[0]; by = r[1]; }
            *(u32x4*)(orow + dof) = (u32x4){ax, ay, bx, by}; }
}
__device__ __forceinline__ void diag_phase(int wave_, int vcu, const bf16* Q, const bf16* K, const bf16* V, bf16* YM, const bf16* P2A, const bf16* P2B, const float* ML, const float* BT, LAS char* lds) {
    if (vcu >= 256) return;
    int lane_ = lane_id(); asm volatile("" : "+v"(lane_)); asm volatile("" : "+s"(wave_));
    const int s = vcu & 3, bh = vcu >> 2, h = bh & 7;
    fill_bias_table(BT, h, wave_ * 64 + lane_, (LAS float*)(lds + L_TB));
    const float bfar = BT[h * 132 + 128];
#pragma unroll 1
    for (int i = 0; i < 4; ++i) { const int qb = (i == 0) ? s : (i == 1) ? 7 - s : (i == 2) ? 8 + s : 15 - s; diag_unit(wave_, lane_, bh >> 3, h, qb, Q, K, V, YM, P2A, P2B, ML, bfar, lds); }
}
#undef MOBA_CVEC
#undef MOBA_QK
#undef MOBA_NEARMAX
#undef MOBA_STEP
#undef MOBA_BLOCK4
}

__device__ __forceinline__ void ph_cvt_x(const Ctx& F0) {
    const Ctx F = launder(F0);
    const int gw = F.vcu * NWAVES + F.wave, NGW = F.G * NWAVES; float* rs1 = (float*)(F.ws + WS_RS1);
    for (int m = gw; m < T; m += NGW) {
        const f32x4* xr = (const f32x4*)(F.in[0] + (size_t)m * D) + F.lane;
        f32x4 v[4]; float s = 0.f;
#pragma unroll
        for (int j = 0; j < 4; ++j) { v[j] = xr[64 * j]; s += (v[j].x * v[j].x + v[j].y * v[j].y) + (v[j].z * v[j].z + v[j].w * v[j].w); }
        const float rstd = 1.f / sqrtf(wave_sum(s) * (1.f / D) + RMS_EPS);
        if (F.lane == 0) rs1[m] = rstd;
        unsigned long long* o8 = (unsigned long long*)(P_XB(F) + (size_t)m * D) + F.lane;
#pragma unroll
        for (int j = 0; j < 4; ++j) o8[64 * j] = (unsigned long long)pk2(v[j].x, v[j].y) | ((unsigned long long)pk2(v[j].z, v[j].w) << 32);
    }
}
__device__ __forceinline__ float row_ssq_bf16(const bf16* row, int lane) {
    const u32x4* xr = (const u32x4*)row + lane; float s = 0.f;
#pragma unroll
    for (int j = 0; j < 2; ++j) { const u32x4 x = xr[64 * j];
        const float a0 = bf2f(x.x & 0xffffu), a1 = bf2f(x.x >> 16), a2 = bf2f(x.y & 0xffffu), a3 = bf2f(x.y >> 16), a4 = bf2f(x.z & 0xffffu), a5 = bf2f(x.z >> 16), a6 = bf2f(x.w & 0xffffu), a7 = bf2f(x.w >> 16);
        s += ((a0 * a0 + a1 * a1) + (a2 * a2 + a3 * a3)) + ((a4 * a4 + a5 * a5) + (a6 * a6 + a7 * a7)); }
    return wave_sum(s);
}
__device__ __forceinline__ void ph_rstd(const Ctx& F0) {
    const Ctx F = launder(F0);
    const int gw = F.vcu * NWAVES + F.wave, NGW = F.G * NWAVES; float* rs1 = (float*)(F.ws + WS_RS1);
    for (int m = gw; m < T; m += NGW) { const float s = row_ssq_bf16(P_XB(F) + (size_t)m * D, F.lane); if (F.lane == 0) rs1[m] = 1.f / sqrtf(s * (1.f / D) + RMS_EPS); }
}

__device__ __forceinline__ void ph_bias_table(const Ctx& F0) {
    const Ctx F = launder(F0);
    if (F.vcu == 0) {
        const float* rel_bias = F.in[1];
        for (int i = F.tid; i < 8 * 132; i += NTHREADS) {
            const int h = i / 132, r = i % 132;
            int bk;
            if (r < 16) bk = r;
            else { bk = 16 + (int)(logf((float)r / 16.f) / logf(8.f) * 16.f); if (bk > 31) bk = 31; }
            P_BT(F)[i] = rel_bias[bk * 8 + h] * LOG2E;
        }
    }
}

__device__ __forceinline__ void ph_pool_dl(const Ctx& F0) {
    const Ctx F = launder(F0);
    const int gt = F.vcu * NTHREADS + F.tid, NGT = F.G * NTHREADS;
    for (int it = gt; it < (T / 32) * 128; it += NGT) {
        const int cp = it & 127, chunk = it >> 7, c = cp * 2, gi = c >> 6, win = 2 << gi, m0 = chunk * 32, t0 = m0 & (SEQ - 1);
        const unsigned* P2 = (const unsigned*)P_PB(F) + cp; unsigned* D2 = (unsigned*)P_DL(F) + cp;
        float s0 = 0.f, s1 = 0.f;
        const int back = (t0 < win) ? t0 : win;
        for (int j = 1; j <= back; ++j) { const unsigned v = P2[(size_t)(m0 - j) * 128]; s0 += bf2f(v & 0xffffu); s1 += bf2f(v >> 16); }
#pragma unroll 4
        for (int i = 0; i < 32; ++i) { const int m = m0 + i, t = t0 + i;
            const unsigned v = P2[(size_t)m * 128]; const float p0 = bf2f(v & 0xffffu), p1 = bf2f(v >> 16);
            s0 += p0; s1 += p1;
            if (t >= win) { const unsigned o = P2[(size_t)(m - win) * 128]; s0 -= bf2f(o & 0xffffu); s1 -= bf2f(o >> 16); }
            const float inv = 1.f / (float)((t + 1 < win) ? t + 1 : win);
            D2[(size_t)m * 128] = pk2(s0 * inv - p0, s1 * inv - p1); }
    }
}
__device__ __forceinline__ void ph_final(const Ctx& F0) {
    const Ctx F = launder(F0);
    const int gw = F.vcu * NWAVES + F.wave, NGW = F.G * NWAVES;
    const f32x4* gf = (const f32x4*)F.in[26];
    for (int m = gw; m < T; m += NGW) {
        const bf16* row = P_XB(F) + (size_t)m * D;
        const float rstd = 1.f / sqrtf(row_ssq_bf16(row, F.lane) * (1.f / D) + RMS_EPS);
        const u32x4* xr = (const u32x4*)row + F.lane; f32x4* orow = (f32x4*)(F.R + (size_t)m * D);
#pragma unroll
        for (int j = 0; j < 2; ++j) { const u32x4 x = xr[64 * j]; const int c4 = 2 * (64 * j + F.lane);
            orow[c4] = (f32x4){bf2f(x.x & 0xffffu), bf2f(x.x >> 16), bf2f(x.y & 0xffffu), bf2f(x.y >> 16)} * rstd * gf[c4];
            orow[c4 + 1] = (f32x4){bf2f(x.z & 0xffffu), bf2f(x.z >> 16), bf2f(x.w & 0xffffu), bf2f(x.w >> 16)} * rstd * gf[c4 + 1]; }
    }
}

constexpr int LDS_BYTES = 147456;
constexpr int MISC_OFF = 131072 + 320;

__global__ void __launch_bounds__(NTHREADS, 2) mk_fwd(Args args) {
    extern __shared__ __attribute__((aligned(16))) unsigned char lds[];
    Ctx F;
    F.lds = (LAS unsigned char*)lds;
    F.wave = __builtin_amdgcn_readfirstlane((int)threadIdx.x >> 6);
    F.lane = lane_id(); F.tid = F.wave * 64 + F.lane;
    F.G = gridDim.x; { const int bx = blockIdx.x; F.vcu = (F.G % 8 == 0) ? (bx % 8) * (F.G / 8) + bx / 8 : bx; }
    F.in = (KargP)__builtin_amdgcn_kernarg_segment_ptr(); F.R = args.out; F.ws = args.ws;
    unsigned char* ws = args.ws;
    volatile LAS unsigned* MISC = (volatile LAS unsigned*)(F.lds + MISC_OFF);
    if (F.tid < 64) MISC[F.tid] = 0u;
    __syncthreads();
    XcdBarrier bar = xcd_barrier_post((unsigned*)(ws + WS_CTL) + CW_BAR, MISC + 8, F.tid == 0);
#define GRID_BAR() do { bar.bar = (unsigned*)(wsl(ws) + WS_CTL) + CW_BAR; xcd_barrier(bar, F.wave); } while (0)
#define FL launder(F)

    ph_bias_table(F);
    ph_prologue(F);
#pragma unroll 1
    for (int l = 0; l < DEPTH; ++l) {
        if (l == 0) ph_cvt_x(F); else ph_rstd(F);
        GRID_BAR();
        { pg8::Gemm g{P_XB(FL), (const bf16*)(wsl(ws) + WS_WIN) + (size_t)l * NPROJ * D, D, D, D}; pg8::StaticOrder S; S.init(T, NPROJ, sl(F.G), sl((int)blockIdx.x));
          EpiProjE E{P_UG(FL), P_PB(FL), P_QB(FL), P_KB(FL), P_VB(FL), P_KMP(FL), (const float*)(wsl(ws) + WS_RS1)}; pg8::gemm_phase(F.lds, g, S, E, sl(F.wave)); }
        GRID_BAR();
        { pg8::Gemm g{P_UG(FL), (const bf16*)(wsl(ws) + WS_BZ) + (size_t)l * SGN * 256 * 1024, UGP, 1024, 1024}; SsmOrder S{sl(F.G), sl((int)blockIdx.x), 1};
          EpiZ E{(float*)(wsl(ws) + WS_ZB)}; pg8::gemm_phase(F.lds, g, S, E, sl(F.wave)); }
        ph_pool_dl(F);
        moba::sel_phase(sl(F.wave), sl((int)blockIdx.x), sl(F.G), P_QB(FL), P_KMP(FL), (unsigned*)(wsl(ws) + WS_SEL), (LAS char*)F.lds);
        GRID_BAR();
        moba::gather_phase(sl(F.wave), sl(F.vcu), P_QB(FL), P_KB(FL), P_VB(FL), P_YMIX(FL), P_YS(FL), (bf16*)(wsl(ws) + WS_P2B), (float*)(wsl(ws) + WS_ML), (const unsigned*)(wsl(ws) + WS_SEL), P_BT(FL), (LAS char*)F.lds);
        GRID_BAR();
        ph_ssm_scan(F, l);
        ph_tg_expand(F, l);
        moba::diag_phase(sl(F.wave), sl(F.vcu), P_QB(FL), P_KB(FL), P_VB(FL), P_YMIX(FL), P_YS(FL), (const bf16*)(wsl(ws) + WS_P2B), (const float*)(wsl(ws) + WS_ML), P_BT(FL), (LAS char*)F.lds);
        GRID_BAR();
        { pg8::Gemm g{P_UG(FL), (const bf16*)(wsl(ws) + WS_TG) + (size_t)l * SGN * 1024 * UGP, UGP, UGP, UGP}; SsmOrder S{sl(F.G), sl((int)blockIdx.x), 2};
          EpiSsm2 E{P_UG(FL), P_YS(FL), F.in[11] + l * 256}; pg8::gemm_phase(F.lds, g, S, E, sl(F.wave)); }
        GRID_BAR();
        { pg8::Gemm g{P_YS(FL), (const bf16*)(wsl(ws) + WS_GLUT) + (size_t)l * 65536, 256, 256, 256}; HalfOrder S{sl(F.vcu)};
          EpiGluE E{P_YS(FL), P_YMIX(FL), F.in[13] + l * 256}; pg8::gemm_phase(F.lds, g, S, E, sl(F.wave)); }
        { pg8::Gemm g{P_DL(FL), (const bf16*)(wsl(ws) + WS_POOLT) + (size_t)l * 65536, 256, 256, 256}; HalfOrder S{sl(F.vcu) - 128};
          EpiPoolE E{P_YMIX(FL), F.in[15] + l * 256, F.in[16] + l * 256}; pg8::gemm_phase(F.lds, g, S, E, sl(F.wave)); }
        GRID_BAR();
        { pg8::Gemm g{P_YMIX(FL), (const bf16*)(wsl(ws) + WS_WOUT) + (size_t)l * D * D, D, D, D}; pg8::StaticOrder S; S.init(T, D, sl(F.G), sl((int)blockIdx.x));
          EpiOutE E{P_XB(FL)}; pg8::gemm_phase(F.lds, g, S, E, sl(F.wave)); }
        GRID_BAR();
        ph_route(F, l);
        GRID_BAR();
        ph_place(F);
        GRID_BAR();
        { pg8::Gemm g{(const bf16*)(wsl(ws) + WS_XS), (const bf16*)(wsl(ws) + WS_GU) + (size_t)l * 16 * 512 * D, D, D, D}; MoeOrder S{(const int*)(wsl(ws) + WS_TILEB), sl(F.G), sl((int)blockIdx.x), false};
          EpiGU E{(bf16*)(wsl(ws) + WS_HACT), (const float*)(wsl(ws) + WS_ROWW), (const float*)(wsl(ws) + WS_ROWR)}; pg8::gemm_phase(F.lds, g, S, E, sl(F.wave)); }
        GRID_BAR();
        { pg8::Gemm g{(const bf16*)(wsl(ws) + WS_HACT), (const bf16*)(wsl(ws) + WS_WD) + (size_t)l * 24 * D * 512, 512, 512, 512}; MoeOrder S{(const int*)(wsl(ws) + WS_TILEB), sl(F.G), sl((int)blockIdx.x), true};
          EpiDown E{P_XB(FL), (const int*)(wsl(ws) + WS_ROWTOK)}; pg8::gemm_phase(F.lds, g, S, E, sl(F.wave)); }
        GRID_BAR();
    }
    ph_final(F);
}

extern "C" void kernel_launch(void* const* d_in, const int* in_sizes, int n_in, void* d_out, int out_size, void* d_ws, size_t ws_size, hipStream_t stream) {
    static int grid = 0;
    if (grid == 0) {
        if (n_in != 27 || out_size != T * D || ws_size < WS_END) { fprintf(stderr, "kernel_launch: unexpected shapes (n_in %d out %d ws %zu)\n", n_in, out_size, ws_size); grid = -1; return; }
        int dev = 0, cus = 0, per_cu = 0;
        if (hipGetDevice(&dev) != hipSuccess || hipDeviceGetAttribute(&cus, hipDeviceAttributeMultiprocessorCount, dev) != hipSuccess) { grid = -1; return; }
        if (hipFuncSetAttribute((const void*)mk_fwd, hipFuncAttributeMaxDynamicSharedMemorySize, LDS_BYTES) != hipSuccess) { fprintf(stderr, "kernel_launch: hipFuncSetAttribute failed\n"); grid = -1; return; }
        if (hipOccupancyMaxActiveBlocksPerMultiprocessor(&per_cu, (const void*)mk_fwd, NTHREADS, LDS_BYTES) != hipSuccess || per_cu < 1) { fprintf(stderr, "kernel_launch: occupancy query says %d\n", per_cu); per_cu = 1; }
        (void)hipGetLastError();
        grid = cus;
    }
    if (grid < 0) return;
    (void)hipMemsetAsync((char*)d_ws + WS_CTL, 0, CTL_ZERO_BYTES, stream);
    Args a{};
    for (int i = 0; i < 27; ++i) a.in[i] = (const float*)d_in[i];
    a.out = (float*)d_out; a.ws = (unsigned char*)d_ws; a.pad0 = 0; a.pad1 = 0;
    hipLaunchKernelGGL(mk_fwd, dim3(grid), dim3(NTHREADS), LDS_BYTES, stream, a);
}
```

```cpp
#include <hip/hip_runtime.h>
#include <hip/hip_bf16.h>
#include <cstdio>
#include <cstdint>

#define GAS __attribute__((address_space(1)))
#define LAS __attribute__((address_space(3)))
typedef unsigned short bf16;
typedef float f32x4 __attribute__((ext_vector_type(4)));
typedef unsigned u32x4 __attribute__((ext_vector_type(4)));
typedef unsigned u32x2 __attribute__((ext_vector_type(2)));

constexpr int NB = 8, SEQ = 4096, T = NB * SEQ, D = 1024, NPROJ = 2048, DEPTH = 2;
constexpr int NHEAD = 8, HD = 64, MBLK = 256, NBLK = SEQ / MBLK;
constexpr int SG = 16, SGN = 16, SP = 64, SCH = 64, UGP = 1152;
constexpr float RMS_EPS = 1e-6f;
constexpr float LOG2E = 1.4426950408889634f;
constexpr float C2 = 0.125f * LOG2E;
constexpr int NWAVES = 8, NTHREADS = 512;

constexpr size_t MiB = 1u << 20;
constexpr size_t WS_CTL = 0, CTL_ZERO_BYTES = 1 * MiB;
constexpr size_t WS_XB = 2 * MiB;
constexpr size_t WS_UG = 66 * MiB;
constexpr size_t WS_PB = 84 * MiB;
constexpr size_t WS_QB = 100 * MiB;
constexpr size_t WS_KB = 132 * MiB;
constexpr size_t WS_VB = 164 * MiB;
constexpr size_t WS_YMIX = 196 * MiB;
constexpr size_t WS_YS = 260 * MiB;
constexpr size_t WS_DL = 276 * MiB;
constexpr size_t WS_KMP = 292 * MiB;
constexpr size_t WS_BT = 293 * MiB;
constexpr size_t WS_KT = 297 * MiB;
constexpr size_t WS_SEL = 298 * MiB;
constexpr size_t WS_WIN = 300 * MiB;
constexpr size_t WS_WOUT = 308 * MiB;
constexpr size_t WS_GU = 312 * MiB;
constexpr size_t WS_WD = 344 * MiB;
constexpr size_t WS_TG = 392 * MiB;
constexpr size_t WS_BZ = 464 * MiB;
constexpr size_t WS_GLUT = 480 * MiB;
constexpr size_t WS_POOLT = WS_GLUT + 512 * 1024;
constexpr size_t WS_ZB = 482 * MiB;
constexpr size_t WS_P2B = 486 * MiB;
constexpr size_t WS_ML = 502 * MiB;
constexpr size_t WS_END = 508 * MiB;
constexpr int MOE_MAXT = 152;
constexpr size_t WS_XS = 66 * MiB;
constexpr size_t WS_HACT = 142 * MiB;
constexpr size_t WS_TOKB = 294 * MiB;
constexpr size_t WS_TOKR = WS_TOKB + 128 * 1024;
constexpr size_t WS_TOKW = WS_TOKB + 256 * 1024;
constexpr size_t WS_ROWTOK = 295 * MiB;
constexpr size_t WS_ROWW = WS_ROWTOK + 256 * 1024;
constexpr size_t WS_ROWR = WS_ROWTOK + 576 * 1024;
constexpr size_t WS_RS1 = WS_ROWTOK + 768 * 1024;
constexpr size_t WS_WGCNT = 296 * MiB;
constexpr size_t WS_TILEB = WS_WGCNT + 64 * 1024;

constexpr int CW_BAR = 4096;

__device__ __forceinline__ unsigned f2bf(float f) { unsigned u = __builtin_bit_cast(unsigned, f); return (u + 0x7fffu + ((u >> 16) & 1u)) >> 16; }
__device__ __forceinline__ float bf2f(unsigned h) { return __builtin_bit_cast(float, h << 16); }
__device__ __forceinline__ unsigned pk2(float lo, float hi) { return f2bf(lo) | (f2bf(hi) << 16); }
template <int O> __device__ __forceinline__ float xshfl(float v) {
    if constexpr (O < 32) return __builtin_bit_cast(float, __builtin_amdgcn_ds_swizzle(__builtin_bit_cast(int, v), (O << 10) | 0x1f));
    else { const unsigned u = __builtin_bit_cast(unsigned, v); auto r = __builtin_amdgcn_permlane32_swap(u, u, false, false);
           const float a = __builtin_bit_cast(float, (unsigned)r[0]), b = __builtin_bit_cast(float, (unsigned)r[1]); return (a == v && __builtin_bit_cast(unsigned, a) == u) ? b : a; }
}
__device__ __forceinline__ float wave_sum(float v) {
    v += xshfl<1>(v); v += xshfl<2>(v); v += xshfl<4>(v); v += xshfl<8>(v); v += xshfl<16>(v);
    const unsigned u = __builtin_bit_cast(unsigned, v); auto r = __builtin_amdgcn_permlane32_swap(u, u, false, false);
    return __builtin_bit_cast(float, (unsigned)r[0]) + __builtin_bit_cast(float, (unsigned)r[1]);
}
__device__ __forceinline__ float wave_max(float v) {
    v = fmaxf(v, xshfl<1>(v)); v = fmaxf(v, xshfl<2>(v)); v = fmaxf(v, xshfl<4>(v)); v = fmaxf(v, xshfl<8>(v)); v = fmaxf(v, xshfl<16>(v));
    const unsigned u = __builtin_bit_cast(unsigned, v); auto r = __builtin_amdgcn_permlane32_swap(u, u, false, false);
    return fmaxf(__builtin_bit_cast(float, (unsigned)r[0]), __builtin_bit_cast(float, (unsigned)r[1]));
}
__device__ __forceinline__ float gelu_tanh(float x) {
    const float u = 0.7978845608028654f * (x + 0.044715f * x * x * x);
    const float e = __expf(2.f * u);
    const float th = 1.f - 2.f / (e + 1.f);
    return 0.5f * x * (1.f + th);
}
__device__ __forceinline__ float sigmoidf_(float x) { return 1.f / (1.f + __expf(-x)); }

__device__ __forceinline__ int lane_id() { unsigned m; asm volatile("s_mov_b32 %0, -1" : "=s"(m)); return (int)__builtin_amdgcn_mbcnt_hi(m, __builtin_amdgcn_mbcnt_lo(m, 0u)); }

#define XB_TMO      128
#define XB_XCNT(j)  (256  + 64 * (j))
#define XB_XSUB(j)  (1280 + 64 * (j))
#define XB_XGEN(j)  (2304 + 64 * (j))
#define XB_TOP      3328
#define XB_TOPGEN   3392
#define XCD_BAR_WORDS 3456
#define XB_SPIN_CAP (1u << 22)
__device__ __forceinline__ unsigned xb_ld(unsigned* p)              { return __hip_atomic_load(p, __ATOMIC_RELAXED, __HIP_MEMORY_SCOPE_AGENT); }
__device__ __forceinline__ unsigned xb_add(unsigned* p, unsigned v) { return __hip_atomic_fetch_add(p, v, __ATOMIC_RELAXED, __HIP_MEMORY_SCOPE_AGENT); }
__device__ __forceinline__ unsigned xb_xcc_id() { return (unsigned)__builtin_amdgcn_s_getreg((3 << 11) | 20) & 0xFu; }
#define XB_SPIN(cond, bar) do { unsigned _sp = 0; while (cond) { __builtin_amdgcn_s_sleep(1); \
    if ((++_sp & 255u) == 0u) { if (xb_ld(&(bar)[XB_TMO])) break; if (_sp > XB_SPIN_CAP) { atomicAdd(&(bar)[XB_TMO], 1u); break; } } } } while (0)
struct XcdBarrier { unsigned* bar; unsigned x; volatile LAS unsigned* st; };
__device__ __forceinline__ XcdBarrier xcd_barrier_post(unsigned* bar, volatile LAS unsigned* st, bool t0) {
    XcdBarrier b; b.bar = bar; b.x = xb_xcc_id(); b.st = st;
    if (t0) (void)xb_add(&bar[XB_XCNT(b.x)], 1u);
    return b;
}
__device__ __forceinline__ void xcd_barrier_complete(unsigned* bar, unsigned x, unsigned& nloc, unsigned& nx) {
    const unsigned G = gridDim.x * gridDim.y * gridDim.z;
    unsigned sum, cnt, mine, sp = 0u;
    for (;;) {
        sum = 0u; cnt = 0u; mine = 0u;
#pragma unroll
        for (unsigned j = 0; j < 16; ++j) { const unsigned c = xb_ld(&bar[XB_XCNT(j)]); sum += c; cnt += (c > 0u) ? 1u : 0u; mine = (j == x) ? c : mine; }
        if (sum == G) break;
        __builtin_amdgcn_s_sleep(1);
        if ((++sp & 255u) == 0u) { if (xb_ld(&bar[XB_TMO])) break; if (sp > XB_SPIN_CAP) { atomicAdd(&bar[XB_TMO], 1u); break; } }
    }
    nloc = mine > 0u ? mine : 1u; nx = cnt > 0u ? cnt : 1u;
}
__device__ __forceinline__ void xcd_barrier(const XcdBarrier& b, int wave) {
    asm volatile("s_waitcnt vmcnt(0)" ::: "memory");
    __syncthreads();
    if (wave == 0 && lane_id() == 0) {
        unsigned* bar = b.bar;
        __builtin_amdgcn_s_waitcnt(0);
        unsigned nloc = b.st[0], nx = b.st[1];
        if (nloc == 0u) { xcd_barrier_complete(bar, b.x, nloc, nx); b.st[0] = nloc; b.st[1] = nx; }
        const unsigned old = xb_add(&bar[XB_XSUB(b.x)], 1u);
        const unsigned gen = old / nloc;
        if (old + 1u == (gen + 1u) * nloc) {
            __builtin_amdgcn_fence(__ATOMIC_RELEASE, "agent");
            asm volatile("s_waitcnt vmcnt(0)" ::: "memory");
            const unsigned og = xb_add(&bar[XB_TOP], 1u);
            const unsigned tg = og / nx;
            if (og + 1u == (tg + 1u) * nx) xb_add(&bar[XB_TOPGEN], 1u);
            else XB_SPIN(xb_ld(&bar[XB_TOPGEN]) == tg, bar);
            __builtin_amdgcn_fence(__ATOMIC_ACQUIRE, "agent");
            xb_add(&bar[XB_XGEN(b.x)], 1u);
            asm volatile("s_waitcnt vmcnt(0)" ::: "memory");
        } else {
            XB_SPIN(xb_ld(&bar[XB_XGEN(b.x)]) == gen, bar);
            __builtin_amdgcn_fence(__ATOMIC_ACQUIRE, "agent");
            asm volatile("s_waitcnt vmcnt(0)" ::: "memory");
        }
    }
    __syncthreads();
}

struct Args {
    const float* in[27];
    float* out;
    unsigned char* ws;
    int pad0, pad1;
};

typedef const float* fptr_t;
typedef __attribute__((address_space(4))) const fptr_t* KargP;
struct Ctx {
    LAS unsigned char* lds;
    int tid, lane, wave, vcu, G;
    KargP in;
    float* R;
    unsigned char* ws;
};
#define P_XB(F) ((bf16*)((F).ws + WS_XB))
#define P_UG(F) ((bf16*)((F).ws + WS_UG))
#define P_PB(F) ((bf16*)((F).ws + WS_PB))
#define P_QB(F) ((bf16*)((F).ws + WS_QB))
#define P_KB(F) ((bf16*)((F).ws + WS_KB))
#define P_VB(F) ((bf16*)((F).ws + WS_VB))
#define P_YMIX(F) ((bf16*)((F).ws + WS_YMIX))
#define P_YS(F) ((bf16*)((F).ws + WS_YS))
#define P_DL(F) ((bf16*)((F).ws + WS_DL))
#define P_KMP(F) ((float*)((F).ws + WS_KMP))
#define P_BT(F) ((float*)((F).ws + WS_BT))


__device__ __forceinline__ Ctx launder(const Ctx& F0) {
    Ctx F = F0;
    int ln = lane_id(); asm volatile("" : "+v"(ln));
    asm volatile("" : "+s"(F.wave), "+s"(F.vcu), "+s"(F.G));
    F.lane = ln; F.tid = F.wave * 64 + ln;
    KargP kp = (KargP)__builtin_amdgcn_kernarg_segment_ptr(); asm volatile("" : "+s"(kp));
    F.in = kp; F.R = (float*)kp[27]; F.ws = (unsigned char*)kp[28];
    return F;
}

__device__ __forceinline__ unsigned char* wsl(unsigned char* p) { asm volatile("" : "+s"(p)); return p; }
__device__ __forceinline__ int sl(int x) { asm volatile("" : "+s"(x)); return x; }

namespace pg8 {
typedef short bf16x8 __attribute__((ext_vector_type(8)));
constexpr int BM = 256, BK = 64, HALF = 128, HTB = HALF * BK * 2, STAGE_BYTES = 8 * HTB, NXCD = 8, WGM = 8;
__device__ __forceinline__ int lds_byte(int r, int c) { const int st = (r >> 4) * 2 + (c >> 5), rr = r & 15, cc = c & 31, ob = rr * 64 + cc * 2; return st * 1024 + (ob ^ (((ob >> 9) & 1) << 5)); }
__device__ __forceinline__ void stage_rc(int b, int& R, int& C) { const int st = b / 1024, sb = b % 1024, swz = sb ^ (((sb >> 9) & 1) << 5); R = (st >> 1) * 16 + swz / 64; C = (st & 1) * 32 + (swz % 64) / 2; }
__device__ __forceinline__ int perm32(int rho) { const int n = rho >> 4, i = rho & 15; return 8 * (i >> 2) + 4 * n + (i & 3); }

struct Unit { int pm, pn, aux; };
struct Gemm { const bf16* A; const bf16* Bt; int lda, ldb, K; };

struct StaticOrder {
    int nM, nN, nwg, G, c;
    __device__ void init(int M, int N, int G_, int c_) { nM = M / BM; nN = N / BM; nwg = nM * nN; G = G_; c = c_; }
    __device__ bool next(int i, Unit& u) const {
        const long L = (long)i * G + c; if (L >= nwg) return false;
        int wgid = (int)L; { const int q = nwg / NXCD, r = nwg % NXCD, xcd = wgid % NXCD, off = wgid / NXCD; wgid = (xcd < r ? xcd * (q + 1) : r * (q + 1) + (xcd - r) * q) + off; }
        const int nig = WGM * nN, gid = wgid / nig, fm = gid * WGM, gsz = (nM - fm) < WGM ? (nM - fm) : WGM;
        u.pm = fm + ((wgid % nig) % gsz); u.pn = (wgid % nig) / gsz; u.aux = 0; return true;
    }
};

__device__ __forceinline__ unsigned cvt_pk_bf16(float lo, float hi) { unsigned r; asm volatile("v_cvt_pk_bf16_f32 %0, %1, %2" : "=v"(r) : "v"(lo), "v"(hi)); return r; }

template <bool ALIGN = true, class Epi, class Sched>
__device__ __forceinline__ void gemm_phase(LAS unsigned char* lds, const Gemm g, const Sched& S, const Epi& E, int wave_) {
    int lane_ = lane_id(); asm volatile("" : "+v"(lane_)); asm volatile("" : "+s"(wave_));
    const int wid = wave_, lane = lane_, tid = wid * 64 + lane, wr = wid >> 2, wc = wid & 3, fr = lane & 15, fq = lane >> 4;
    const int K = g.K, nt = K / BK;
    unsigned voffA[2], voffB[2];
#pragma unroll
    for (int i = 0; i < 2; ++i) { int R, C; stage_rc(tid * 16 + i * 8192, R, C); const int Rb = Epi::PERM ? ((R & ~31) + perm32(R & 31)) : R;
        voffA[i] = (unsigned)(R * g.lda + C) * 2u; voffB[i] = (unsigned)(Rb * g.ldb + C) * 2u; }
    const size_t kstep = (size_t)(BK * 2);
    const size_t hstepA = (size_t)HALF * g.lda * 2, hstepB = (size_t)HALF * g.ldb * 2;
    const size_t tstepA = 2 * hstepA, tstepB = 2 * hstepB;
    const unsigned ldsw = (unsigned)wid * 1024u;
    const int aoff = lds_byte(wr * 64 + fr, fq * 8), boff = lds_byte(wc * 32 + fr, fq * 8);
#define PG8_SA(b, h) (((b) * 2 + (h)) * HTB)
#define PG8_SB(b, h) ((4 + (b) * 2 + (h)) * HTB)
#define PG8_STAGE(bufoff, gbase, voff) do { _Pragma("unroll") for (int _i = 0; _i < 2; ++_i) \
        __builtin_amdgcn_global_load_lds((const unsigned*)((const char*)(gbase) + (voff)[_i]), (LAS unsigned*)(lds + (bufoff) + ldsw + _i * 8192), 16, 0, 0); } while (0)
#define PG8_LDA(dst, b, h) do { _Pragma("unroll") for (int m = 0; m < 4; ++m) _Pragma("unroll") for (int k = 0; k < 2; ++k) dst[m][k] = *(const LAS bf16x8*)(lds + PG8_SA(b, h) + aoff + m * 2048 + k * 1024); } while (0)
#define PG8_LDB(dst, b, h) do { _Pragma("unroll") for (int n = 0; n < 2; ++n) _Pragma("unroll") for (int k = 0; k < 2; ++k) dst[n][k] = *(const LAS bf16x8*)(lds + PG8_SB(b, h) + boff + n * 2048 + k * 1024); } while (0)
#define PG8_MMA(ai, bj, At, Bt) do { __builtin_amdgcn_s_setprio(1); _Pragma("unroll") for (int m = 0; m < 4; ++m) _Pragma("unroll") for (int n = 0; n < 2; ++n) _Pragma("unroll") for (int k = 0; k < 2; ++k) \
        acc[ai][bj][m][n] = __builtin_amdgcn_mfma_f32_16x16x32_bf16(Bt[n][k], At[m][k], acc[ai][bj][m][n], 0, 0, 0); __builtin_amdgcn_s_setprio(0); } while (0)
#define PG8_WAIT_V(n) asm volatile("s_waitcnt vmcnt(" #n ")" ::: "memory")
#define PG8_WAIT_L(n) asm volatile("s_waitcnt lgkmcnt(" #n ")" ::: "memory")
#define PG8_BAR __builtin_amdgcn_s_barrier()
#define PG8_SCHED __builtin_amdgcn_sched_barrier(0)
    Unit cur, nxt; int ui = 0;
    if (!S.next(0, cur)) return;
    f32x4 acc[2][2][4][2];
#pragma unroll
    for (int a = 0; a < 2; ++a)
#pragma unroll
        for (int b = 0; b < 2; ++b)
#pragma unroll
            for (int m = 0; m < 4; ++m)
#pragma unroll
                for (int n = 0; n < 2; ++n) acc[a][b][m][n] = (f32x4){0.f, 0.f, 0.f, 0.f};
    bf16x8 At[4][2], B0[2][2], B1[2][2];
    const char* cA = (const char*)g.A + (size_t)cur.pm * tstepA; const char* cB = (const char*)g.Bt + (size_t)cur.pn * tstepB;
    PG8_STAGE(PG8_SB(0, 0), cB, voffB); PG8_STAGE(PG8_SB(0, 1), cB + hstepB, voffB); PG8_STAGE(PG8_SA(0, 0), cA, voffA); PG8_STAGE(PG8_SA(0, 1), cA + hstepA, voffA);
    if (wr == 1) PG8_BAR;
    PG8_WAIT_V(2); PG8_BAR;
    PG8_STAGE(PG8_SB(1, 0), cB + kstep, voffB); PG8_STAGE(PG8_SA(1, 0), cA + kstep, voffA); PG8_STAGE(PG8_SB(1, 1), cB + hstepB + kstep, voffB);
    PG8_WAIT_V(6); PG8_BAR;
    for (;;) {
        const bool has_next = S.next(ui + 1, nxt);
        const char* nA = has_next ? (const char*)g.A + (size_t)nxt.pm * tstepA : cA; const char* nB = has_next ? (const char*)g.Bt + (size_t)nxt.pn * tstepB : cB;
        for (int t = 0; t < nt; t += 2) {
            const bool last = (t == nt - 2);
            const char* a1 = cA + (size_t)(t + 1) * kstep;
            const char* a2 = last ? nA : cA + (size_t)(t + 2) * kstep; const char* b2 = last ? nB : cB + (size_t)(t + 2) * kstep;
            const char* a3 = a2 + kstep; const char* b3 = b2 + kstep;
            PG8_LDB(B0, 0, 0); PG8_LDB(B1, 0, 1); PG8_SCHED; PG8_LDA(At, 0, 0); PG8_STAGE(PG8_SA(1, 1), a1 + hstepA, voffA);
            PG8_WAIT_V(8); PG8_WAIT_L(0); PG8_BAR; PG8_MMA(0, 0, At, B0); PG8_MMA(0, 1, At, B1); PG8_BAR; PG8_SCHED;
            PG8_LDA(At, 0, 1); PG8_STAGE(PG8_SB(0, 0), b2, voffB); PG8_STAGE(PG8_SB(0, 1), b2 + hstepB, voffB); PG8_STAGE(PG8_SA(0, 0), a2, voffA);
            PG8_WAIT_V(8); PG8_WAIT_L(0); PG8_BAR; PG8_MMA(1, 0, At, B0); PG8_MMA(1, 1, At, B1); PG8_BAR; PG8_SCHED;
            PG8_LDB(B0, 1, 0); PG8_LDB(B1, 1, 1); PG8_SCHED; PG8_LDA(At, 1, 0); PG8_STAGE(PG8_SA(0, 1), a2 + hstepA, voffA);
            PG8_WAIT_V(8); PG8_WAIT_L(0); PG8_BAR; PG8_MMA(0, 0, At, B0); PG8_MMA(0, 1, At, B1); PG8_BAR; PG8_SCHED;
            PG8_LDA(At, 1, 1); PG8_STAGE(PG8_SB(1, 0), b3, voffB); PG8_STAGE(PG8_SB(1, 1), b3 + hstepB, voffB); PG8_STAGE(PG8_SA(1, 0), a3, voffA);
            PG8_WAIT_V(8); PG8_WAIT_L(0); PG8_BAR; PG8_MMA(1, 0, At, B0); PG8_MMA(1, 1, At, B1); PG8_BAR; PG8_SCHED;
        }
        if constexpr (ALIGN) { if (wr == 0) PG8_BAR; }
        E(acc, cur, wr, wc, fr, fq);
        if (!has_next) break;
#pragma unroll
        for (int a = 0; a < 2; ++a)
#pragma unroll
            for (int b = 0; b < 2; ++b)
#pragma unroll
                for (int m = 0; m < 4; ++m)
#pragma unroll
                    for (int n = 0; n < 2; ++n) acc[a][b][m][n] = (f32x4){0.f, 0.f, 0.f, 0.f};
        cur = nxt; cA = nA; cB = nB; ++ui;
        if constexpr (ALIGN) { if (wr == 1) PG8_BAR; }
    }
    PG8_WAIT_V(0);
    if constexpr (!ALIGN) { if (wr == 0) PG8_BAR; }
    PG8_BAR;
#undef PG8_SA
#undef PG8_SB
#undef PG8_STAGE
#undef PG8_LDA
#undef PG8_LDB
#undef PG8_MMA
#undef PG8_WAIT_V
#undef PG8_WAIT_L
#undef PG8_BAR
#undef PG8_SCHED
}
}


struct EpiProjE {
    static constexpr bool PERM = true;
    bf16 *UG, *PB, *QB, *KB, *VB; float* KMP; const float* rs1;
    __device__ __forceinline__ void operator()(const f32x4 (&acc_)[2][2][4][2], const pg8::Unit& u, int wr, int wc, int fr_, int fq_) const {
        const int ln_ = lane_id(), fr = ln_ & 15, fq = ln_ >> 4; (void)fr_; (void)fq_;
        const int pn = u.pn, row0 = u.pm * 256 + wr * 64 + fr, cl = wc * 32 + 8 * fq;
        f32x4 acc[2][2][4][2];
#pragma unroll
        for (int ai = 0; ai < 2; ++ai)
#pragma unroll
            for (int m = 0; m < 4; ++m) { const float rs = rs1[row0 + ai * 128 + m * 16];
#pragma unroll
                for (int bj = 0; bj < 2; ++bj) { acc[ai][bj][m][0] = acc_[ai][bj][m][0] * rs; acc[ai][bj][m][1] = acc_[ai][bj][m][1] * rs; } }
        if (pn == 0) {
#pragma unroll
            for (int ai = 0; ai < 2; ++ai)
#pragma unroll
                for (int m = 0; m < 4; ++m) { const int r = row0 + ai * 128 + m * 16;
#pragma unroll
                    for (int bj = 0; bj < 2; ++bj) { const int ch = bj * 128 + cl, g = ch >> 4, h0 = ch & 15;
                        const f32x4 v0 = acc[ai][bj][m][0], v1 = acc[ai][bj][m][1]; u32x4 w;
                        w.x = pg8::cvt_pk_bf16(v0[0], v0[1]); w.y = pg8::cvt_pk_bf16(v0[2], v0[3]); w.z = pg8::cvt_pk_bf16(v1[0], v1[1]); w.w = pg8::cvt_pk_bf16(v1[2], v1[3]);
                        *(u32x4*)(UG + ((size_t)(g * 512 + (r >> 6))) * UGP + (r & 63) * 16 + h0) = w; } }
        } else {
            bf16* base; int ldc, colt; float sc = 1.f;
            if (pn == 1) { base = PB; ldc = 256; colt = 0; }
            else if (pn < 4) { base = QB; ldc = 512; colt = (pn - 2) * 256; sc = C2; }
            else if (pn < 6) { base = KB; ldc = 512; colt = (pn - 4) * 256; }
            else { base = VB; ldc = 512; colt = (pn - 6) * 256; }
#pragma unroll
            for (int ai = 0; ai < 2; ++ai)
#pragma unroll
                for (int m = 0; m < 4; ++m) { bf16* rowp = base + (size_t)(row0 + ai * 128 + m * 16) * ldc + colt + cl;
#pragma unroll
                    for (int bj = 0; bj < 2; ++bj) { const f32x4 v0 = acc[ai][bj][m][0] * sc, v1 = acc[ai][bj][m][1] * sc; u32x4 w;
                        w.x = pg8::cvt_pk_bf16(v0[0], v0[1]); w.y = pg8::cvt_pk_bf16(v0[2], v0[3]); w.z = pg8::cvt_pk_bf16(v1[0], v1[1]); w.w = pg8::cvt_pk_bf16(v1[2], v1[3]);
                        *(u32x4*)(rowp + bj * 128) = w; } }
            if (pn >= 4 && pn < 6) {
#pragma unroll
                for (int bj = 0; bj < 2; ++bj)
#pragma unroll
                    for (int n = 0; n < 2; ++n) { f32x4 s = (f32x4){0.f, 0.f, 0.f, 0.f};
#pragma unroll
                        for (int ai = 0; ai < 2; ++ai)
#pragma unroll
                            for (int m = 0; m < 4; ++m) s += acc[ai][bj][m][n];
#pragma unroll
                        for (int i = 0; i < 4; ++i) { float t = s[i]; t += xshfl<1>(t); t += xshfl<2>(t); t += xshfl<4>(t); t += xshfl<8>(t); s[i] = t; }
                        if (fr == 0) *(f32x4*)(KMP + (size_t)wr * 128 * 512 + (size_t)u.pm * 512 + colt + bj * 128 + cl + 4 * n) = s; }
            }
        }
    }
};
struct EpiOutE {
    static constexpr bool PERM = true;
    bf16* RB;
    __device__ __forceinline__ void operator()(const f32x4 (&acc)[2][2][4][2], const pg8::Unit& u, int wr, int wc, int fr_, int fq_) const {
        const int ln_ = lane_id(), fr = ln_ & 15, fq = ln_ >> 4; (void)fr_; (void)fq_;
        const int row0 = u.pm * 256 + wr * 64 + fr, col0 = u.pn * 256 + wc * 32 + 8 * fq;
#pragma unroll
        for (int ai = 0; ai < 2; ++ai)
#pragma unroll
            for (int m = 0; m < 4; ++m) { bf16* rp = RB + (size_t)(row0 + ai * 128 + m * 16) * D + col0;
#pragma unroll
                for (int bj = 0; bj < 2; ++bj) { const u32x4 x = *(const u32x4*)(rp + bj * 128); const f32x4 a0 = acc[ai][bj][m][0], a1 = acc[ai][bj][m][1]; u32x4 w;
                    w.x = pg8::cvt_pk_bf16(bf2f(x.x & 0xffffu) + a0[0], bf2f(x.x >> 16) + a0[1]); w.y = pg8::cvt_pk_bf16(bf2f(x.y & 0xffffu) + a0[2], bf2f(x.y >> 16) + a0[3]);
                    w.z = pg8::cvt_pk_bf16(bf2f(x.z & 0xffffu) + a1[0], bf2f(x.z >> 16) + a1[1]); w.w = pg8::cvt_pk_bf16(bf2f(x.w & 0xffffu) + a1[2], bf2f(x.w >> 16) + a1[3]);
                    *(u32x4*)(rp + bj * 128) = w; }
                if (m & 1) asm volatile("" ::: "memory"); }
    }
};

__device__ __forceinline__ void transpose_item(const float* W, int K, int N, const float* kscale, bf16* WT, int ldo, int koff, int rowmode, LAS float* scr, int item, int lane) {
    const int nblk = N / 32, kb = item / nblk, nb = item % nblk, k0 = 64 * kb, n0 = 32 * nb;
    { const int r8 = lane >> 3, c4 = lane & 7; f32x4 v[8];
#pragma unroll
      for (int i = 0; i < 8; ++i) v[i] = *(const f32x4*)(W + (size_t)(k0 + 8 * i + r8) * N + n0 + 4 * c4);
#pragma unroll
      for (int i = 0; i < 8; ++i) { const int kk = 8 * i + r8; const float s = kscale ? kscale[k0 + kk] : 1.f; LAS float* d = scr + kk * 33 + 4 * c4;
          d[0] = v[i][0] * s; d[1] = v[i][1] * s; d[2] = v[i][2] * s; d[3] = v[i][3] * s; } }
    asm volatile("s_waitcnt lgkmcnt(0)" ::: "memory");
    const int c = lane & 7;
#pragma unroll
    for (int j = 0; j < 4; ++j) { const int n = (lane >> 3) + 8 * j; const LAS float* s = scr + (8 * c) * 33 + n;
        u32x4 o; o.x = pk2(s[0 * 33], s[1 * 33]); o.y = pk2(s[2 * 33], s[3 * 33]); o.z = pk2(s[4 * 33], s[5 * 33]); o.w = pk2(s[6 * 33], s[7 * 33]);
        const int nn = n0 + n, row = rowmode == 0 ? nn : (8 * (nn >> 2) + (nn & 3) + (rowmode == 2 ? 4 : 0));
        *(u32x4*)(WT + (size_t)row * ldo + koff + k0 + 8 * c) = o; }
    asm volatile("s_waitcnt lgkmcnt(0)" ::: "memory");
}
__device__ __forceinline__ void pair_decode(int pi, int& ea, int& eb) { ea = pi < 3 ? 0 : (pi < 5 ? 1 : 2); eb = pi < 3 ? pi + 1 : (pi < 5 ? pi - 1 : 3); }
__device__ __forceinline__ void ph_prologue(const Ctx& F0) {
    const Ctx F = launder(F0);
    LAS float* scr = (LAS float*)(F.lds + F.wave * 16384);
    const int gw = F.vcu * NWAVES + F.wave, NGW = F.G * NWAVES;
    constexpr int I_IN = (D / 64) * (NPROJ / 32), I_OUT = (D / 64) * (D / 32), I_GU1 = (D / 64) * (256 / 32), I_GU = 16 * 2 * I_GU1, I_WD1 = (256 / 64) * (D / 32), I_WD = 24 * 2 * I_WD1;
    constexpr int I_L = I_IN + I_OUT + I_GU + I_WD;
    for (int it = gw; it < DEPTH * I_L; it += NGW) {
        const int l = it / I_L; int r = it % I_L;
        if (r < I_IN) { transpose_item(F.in[3] + (size_t)l * D * NPROJ, D, NPROJ, F.in[2] + l * D, (bf16*)(F.ws + WS_WIN) + (size_t)l * NPROJ * D, D, 0, 0, scr, r, F.lane); continue; } r -= I_IN;
        if (r < I_OUT) { transpose_item(F.in[17] + (size_t)l * D * D, D, D, nullptr, (bf16*)(F.ws + WS_WOUT) + (size_t)l * D * D, D, 0, 0, scr, r, F.lane); continue; } r -= I_OUT;
        if (r < I_GU) { const int e = r / (2 * I_GU1), up = (r / I_GU1) & 1, item = r % I_GU1;
            transpose_item(F.in[up ? 24 : 23] + ((size_t)l * 16 + e) * D * 256, D, 256, F.in[18] + l * D, (bf16*)(F.ws + WS_GU) + ((size_t)l * 16 + e) * 512 * D, D, 0, 1 + up, scr, item, F.lane); continue; } r -= I_GU;
        { const int bk = r / (2 * I_WD1), half = (r / I_WD1) & 1, item = r % I_WD1, g = bk / 6; int ea, eb; pair_decode(bk % 6, ea, eb); const int e = g * 4 + (half ? eb : ea);
            transpose_item(F.in[25] + ((size_t)l * 16 + e) * 256 * D, 256, D, nullptr, (bf16*)(F.ws + WS_WD) + ((size_t)l * 24 + bk) * D * 512, 512, half * 256, 0, scr, item, F.lane); }
    }
    for (int it = gw; it < DEPTH * 32; it += NGW) { const int l = it >> 5;
        transpose_item(F.in[12] + (size_t)l * 256 * 256, 256, 256, nullptr, (bf16*)(F.ws + WS_GLUT) + (size_t)l * 65536, 256, 0, 0, scr, it & 31, F.lane); }
    { const int gt = F.vcu * NTHREADS + F.tid, NGT = F.G * NTHREADS;
      for (int i = gt; i < DEPTH * 65536; i += NGT) { const int l = i >> 16, n = (i >> 8) & 255, k = i & 255;
          const float v = ((n >> 6) == (k >> 6)) ? F.in[14][(((size_t)l * 4 + (n >> 6)) * 64 + (k & 63)) * 64 + (n & 63)] : 0.f;
          ((bf16*)(F.ws + WS_POOLT))[i] = (bf16)f2bf(v); } }
    for (int it = gw; it < DEPTH * SGN * 65; it += NGW) {
        const int l = it / (SGN * 65), g = (it / 65) % SGN, tau = it % 65, p = F.lane;
        const float are = F.in[4][(l * SGN + g) * SP + p], aim = F.in[5][(l * SGN + g) * SP + p], dt = expf(F.in[6][l * SGN + g]);
        float sn, cs; sincosf(aim * dt, &sn, &cs); const float mg = expf(are * dt), lbr = mg * cs, lbi = mg * sn;
        const float nr = lbr - 1.f, ni = lbi, den = are * are + aim * aim, cr = (nr * are + ni * aim) / den, ci = (ni * are - nr * aim) / den;
        float sn2, cs2; sincosf(aim * dt * (float)tau, &sn2, &cs2); const float mg2 = expf(are * dt * (float)tau), lr = mg2 * cs2, li = mg2 * sn2;
        float wr[16], wi[16];
#pragma unroll
        for (int h = 0; h < 16; ++h) { const float br = F.in[7][((size_t)(l * SGN + g) * SP + p) * SG + h], bi = F.in[8][((size_t)(l * SGN + g) * SP + p) * SG + h];
            const float bbr = cr * br - ci * bi, bbi = cr * bi + ci * br; wr[h] = lr * bbr - li * bbi; wi[h] = lr * bbi + li * bbr; }
        bf16* TG = (bf16*)(F.ws + WS_TG) + ((size_t)l * SGN + g) * 1024 * UGP;
        if (tau <= 63) {
            bf16* BZ = (bf16*)(F.ws + WS_BZ) + ((size_t)l * SGN + g) * 256 * 1024; const int s = 63 - tau;
            u32x4 o0, o1, o2, o3;
            o0.x = pk2(wr[0], wr[1]); o0.y = pk2(wr[2], wr[3]); o0.z = pk2(wr[4], wr[5]); o0.w = pk2(wr[6], wr[7]); o1.x = pk2(wr[8], wr[9]); o1.y = pk2(wr[10], wr[11]); o1.z = pk2(wr[12], wr[13]); o1.w = pk2(wr[14], wr[15]);
            o2.x = pk2(wi[0], wi[1]); o2.y = pk2(wi[2], wi[3]); o2.z = pk2(wi[4], wi[5]); o2.w = pk2(wi[6], wi[7]); o3.x = pk2(wi[8], wi[9]); o3.y = pk2(wi[10], wi[11]); o3.z = pk2(wi[12], wi[13]); o3.w = pk2(wi[14], wi[15]);
            *(u32x4*)(BZ + (size_t)p * 1024 + s * 16) = o0; *(u32x4*)(BZ + (size_t)p * 1024 + s * 16 + 8) = o1;
            *(u32x4*)(BZ + (size_t)(64 + p) * 1024 + s * 16) = o2; *(u32x4*)(BZ + (size_t)(64 + p) * 1024 + s * 16 + 8) = o3;
        }
        LAS float* Wst = scr; LAS float* Kt = scr + 128 * 16;
        if (tau <= 63) {
#pragma unroll
            for (int q = 0; q < 4; ++q) { *(LAS f32x4*)(Wst + p * 16 + 4 * q) = (f32x4){wr[4 * q], wr[4 * q + 1], wr[4 * q + 2], wr[4 * q + 3]};
                                          *(LAS f32x4*)(Wst + (64 + p) * 16 + 4 * q) = (f32x4){wi[4 * q], wi[4 * q + 1], wi[4 * q + 2], wi[4 * q + 3]}; }
            const int arow = p & 15, kq = p >> 4; f32x4 kacc = (f32x4){0.f, 0.f, 0.f, 0.f};
            const float* cre = F.in[9] + ((size_t)(l * SGN + g) * SG + arow) * SP; const float* cim = F.in[10] + ((size_t)(l * SGN + g) * SG + arow) * SP;
#pragma unroll 8
            for (int s = 0; s < 32; ++s) { const int k = 4 * s + kq; const float av = (k < 64) ? cre[k] : -cim[k - 64]; const float bv = Wst[k * 16 + arow];
                kacc = __builtin_amdgcn_mfma_f32_16x16x4f32(av, bv, kacc, 0, 0, 0); }
#pragma unroll
            for (int r = 0; r < 4; ++r) Kt[(4 * kq + r) * 16 + arow] = kacc[r];
            asm volatile("s_waitcnt lgkmcnt(0)" ::: "memory");
            const f32x4 t4 = *(const LAS f32x4*)(Kt + 4 * p);
            u32x2 o; o.x = pk2(t4[0], t4[1]); o.y = pk2(t4[2], t4[3]);
            *(u32x2*)((bf16*)(F.ws + WS_KT) + ((size_t)(l * SGN + g) * 64 + tau) * 256 + 4 * p) = o;
        }
        if (tau >= 1) {
#pragma unroll 4
            for (int ho = 0; ho < 16; ++ho) {
                const float ccr = F.in[9][((size_t)(l * SGN + g) * SG + ho) * SP + p], cci = F.in[10][((size_t)(l * SGN + g) * SG + ho) * SP + p];
                const int n = (tau - 1) * 16 + ho;
                TG[(size_t)n * UGP + 1024 + p] = (bf16)f2bf(ccr * lr - cci * li); TG[(size_t)n * UGP + 1088 + p] = (bf16)f2bf(-(ccr * li + cci * lr)); }
        }
    }
}

__device__ __forceinline__ void route_finish(const float (&a)[20], float ssum, int m, bool act, const float* gb_, const float* rb_, int* tokb, float* tokr, float* tokw, LAS int* hist) {
        const float rstd = 1.f / sqrtf(ssum * (1.f / D) + RMS_EPS);
        float lg0 = a[0] * rstd + gb_[0], lg1 = a[1] * rstd + gb_[1], lg2 = a[2] * rstd + gb_[2], lg3 = a[3] * rstd + gb_[3];
        int gs = 0; float gm = lg0;
        if (lg1 > gm) { gm = lg1; gs = 1; } if (lg2 > gm) { gm = lg2; gs = 2; } if (lg3 > gm) { gm = lg3; gs = 3; }
        const float gwt = 1.f / (__expf(lg0 - gm) + __expf(lg1 - gm) + __expf(lg2 - gm) + __expf(lg3 - gm));
        float q0 = a[4], q1 = a[5], q2 = a[6], q3 = a[7], q4 = a[8], q5 = a[9], q6 = a[10], q7 = a[11], q8 = a[12], q9 = a[13], q10 = a[14], q11 = a[15], q12 = a[16], q13 = a[17], q14 = a[18], q15 = a[19];
        asm volatile("" : "+v"(q0), "+v"(q1), "+v"(q2), "+v"(q3), "+v"(q4), "+v"(q5), "+v"(q6), "+v"(q7));
        asm volatile("" : "+v"(q8), "+v"(q9), "+v"(q10), "+v"(q11), "+v"(q12), "+v"(q13), "+v"(q14), "+v"(q15));
        float e0 = gs == 0 ? q0 : gs == 1 ? q4 : gs == 2 ? q8 : q12;
        float e1 = gs == 0 ? q1 : gs == 1 ? q5 : gs == 2 ? q9 : q13;
        float e2 = gs == 0 ? q2 : gs == 1 ? q6 : gs == 2 ? q10 : q14;
        float e3 = gs == 0 ? q3 : gs == 1 ? q7 : gs == 2 ? q11 : q15;
        e0 = e0 * rstd + rb_[gs * 4 + 0]; e1 = e1 * rstd + rb_[gs * 4 + 1]; e2 = e2 * rstd + rb_[gs * 4 + 2]; e3 = e3 * rstd + rb_[gs * 4 + 3];
        int t1 = 0; float v1 = e0;
        if (e1 > v1) { v1 = e1; t1 = 1; } if (e2 > v1) { v1 = e2; t1 = 2; } if (e3 > v1) { v1 = e3; t1 = 3; }
        int t2 = -1; float v2 = -3.0e38f;
        if (t1 != 0 && e0 > v2) { v2 = e0; t2 = 0; } if (t1 != 1 && e1 > v2) { v2 = e1; t2 = 1; } if (t1 != 2 && e2 > v2) { v2 = e2; t2 = 2; } if (t1 != 3 && e3 > v2) { v2 = e3; t2 = 3; }
        const float p2 = __expf(v2 - v1), w1 = gwt / (1.f + p2), w2 = gwt * p2 / (1.f + p2);
        const int lo = t1 < t2 ? t1 : t2, hi = t1 < t2 ? t2 : t1; const float wlo = t1 < t2 ? w1 : w2, whi = t1 < t2 ? w2 : w1;
        const int pi = lo == 0 ? hi - 1 : (lo == 1 ? hi + 1 : 5), bk = gs * 6 + pi;
        if (act) { tokb[m] = bk; tokr[m] = rstd; tokw[2 * m] = wlo; tokw[2 * m + 1] = whi; __hip_atomic_fetch_add(hist + bk, 1, __ATOMIC_RELAXED, __HIP_MEMORY_SCOPE_WORKGROUP); }
}
__device__ __forceinline__ void ph_route(const Ctx& F0, int l) {
    const Ctx F = launder(F0);
    constexpr int WLD = 1032;
    LAS bf16* Wh = (LAS bf16*)F.lds;
    LAS bf16* Wlo = Wh + 20 * WLD;
    LAS float* LG = (LAS float*)(F.lds + 4 * 20 * WLD);
    LAS int* hist = (LAS int*)(F.lds + 4 * 20 * WLD + 8 * 320 * 4);
    const float* g2 = F.in[18] + l * D;
    const f32x4* gw4 = (const f32x4*)(F.in[19] + (size_t)l * D * 4); const f32x4* rw4 = (const f32x4*)(F.in[21] + (size_t)l * 4 * D * 4);
    const float* gb_ = F.in[20] + l * 4; const float* rb_ = F.in[22] + l * 16;
    for (int idx = F.tid; idx < D * 5; idx += NTHREADS) { const int k = idx % D, q = idx / D;
        f32x4 v = (q == 0) ? gw4[k] : rw4[(q - 1) * D + k]; v = v * g2[k];
#pragma unroll
        for (int i = 0; i < 4; ++i) { const unsigned h = f2bf(v[i]); Wh[(q * 4 + i) * WLD + k] = (bf16)h; Wlo[(q * 4 + i) * WLD + k] = (bf16)f2bf(v[i] - bf2f(h)); } }
    if (F.tid < 32) hist[F.tid] = 0;
    __syncthreads();
    int* tokb = (int*)(F.ws + WS_TOKB); float* tokr = (float*)(F.ws + WS_TOKR); float* tokw = (float*)(F.ws + WS_TOKW);
    const int i16 = F.lane & 15, kq = F.lane >> 4, m0 = F.vcu * 128 + F.wave * 16;
    const u32x4* xr = (const u32x4*)(P_XB(F) + (size_t)(m0 + i16) * D) + kq;
    const int c1 = 16 + (i16 & 3);
    const LAS bf16* bh0 = Wh + i16 * WLD + 8 * kq; const LAS bf16* bl0 = Wlo + i16 * WLD + 8 * kq;
    const LAS bf16* bh1 = Wh + c1 * WLD + 8 * kq;  const LAS bf16* bl1 = Wlo + c1 * WLD + 8 * kq;
    f32x4 acc0 = (f32x4){0.f, 0.f, 0.f, 0.f}, acc1 = acc0; float ss = 0.f;
#pragma unroll 4
    for (int c = 0; c < 32; ++c) {
        const u32x4 xa = xr[4 * c];
        const float x0 = bf2f(xa.x & 0xffffu), x1 = __builtin_bit_cast(float, xa.x & 0xffff0000u), x2 = bf2f(xa.y & 0xffffu), x3 = __builtin_bit_cast(float, xa.y & 0xffff0000u);
        const float x4 = bf2f(xa.z & 0xffffu), x5 = __builtin_bit_cast(float, xa.z & 0xffff0000u), x6 = bf2f(xa.w & 0xffffu), x7 = __builtin_bit_cast(float, xa.w & 0xffff0000u);
        ss += ((x0 * x0 + x1 * x1) + (x2 * x2 + x3 * x3)) + ((x4 * x4 + x5 * x5) + (x6 * x6 + x7 * x7));
        const pg8::bf16x8 av = __builtin_bit_cast(pg8::bf16x8, xa);
        const pg8::bf16x8 h0 = *(const LAS pg8::bf16x8*)(bh0 + 32 * c), l0 = *(const LAS pg8::bf16x8*)(bl0 + 32 * c);
        const pg8::bf16x8 h1 = *(const LAS pg8::bf16x8*)(bh1 + 32 * c), l1 = *(const LAS pg8::bf16x8*)(bl1 + 32 * c);
        acc0 = __builtin_amdgcn_mfma_f32_16x16x32_bf16(av, h0, acc0, 0, 0, 0); acc1 = __builtin_amdgcn_mfma_f32_16x16x32_bf16(av, h1, acc1, 0, 0, 0);
        acc0 = __builtin_amdgcn_mfma_f32_16x16x32_bf16(av, l0, acc0, 0, 0, 0); acc1 = __builtin_amdgcn_mfma_f32_16x16x32_bf16(av, l1, acc1, 0, 0, 0);
    }
    ss += xshfl<16>(ss);
    { const unsigned u = __builtin_bit_cast(unsigned, ss); auto r = __builtin_amdgcn_permlane32_swap(u, u, false, false);
      ss = __builtin_bit_cast(float, (unsigned)r[0]) + __builtin_bit_cast(float, (unsigned)r[1]); }
    LAS float* lg = LG + F.wave * 320;
#pragma unroll
    for (int r = 0; r < 4; ++r) { lg[(4 * kq + r) * 20 + i16] = acc0[r]; if (i16 < 4) lg[(4 * kq + r) * 20 + 16 + i16] = acc1[r]; }
    asm volatile("s_waitcnt lgkmcnt(0)" ::: "memory");
    float a[20];
#pragma unroll
    for (int j = 0; j < 5; ++j) { const f32x4 t4 = *(const LAS f32x4*)(lg + i16 * 20 + 4 * j); a[4 * j] = t4[0]; a[4 * j + 1] = t4[1]; a[4 * j + 2] = t4[2]; a[4 * j + 3] = t4[3]; }
    route_finish(a, ss, m0 + i16, kq == 0, gb_, rb_, tokb, tokr, tokw, hist);
    __syncthreads();
    if (F.tid < 24) __hip_atomic_store((int*)(F.ws + WS_WGCNT) + F.vcu * 24 + F.tid, hist[F.tid], __ATOMIC_RELAXED, __HIP_MEMORY_SCOPE_AGENT);
}
__device__ __forceinline__ void ph_place(const Ctx& F0) {
    const Ctx F = launder(F0);
    LAS int* ptot = (LAS int*)F.lds;
    LAS int* pbef = ptot + 512;
    LAS int* bstart = pbef + 512;
    LAS int* btot = bstart + 32;
    LAS int* carry = btot + 32;
    LAS int* rowidx = carry + 32;
    const int* wgcnt = (const int*)(F.ws + WS_WGCNT);
    int* rowtok = (int*)(F.ws + WS_ROWTOK); float* roww = (float*)(F.ws + WS_ROWW); int* tileb = (int*)(F.ws + WS_TILEB);
    const int* tokb = (const int*)(F.ws + WS_TOKB); const float* tokr = (const float*)(F.ws + WS_TOKR); const float* tokw = (const float*)(F.ws + WS_TOKW);
    { const int p = F.tid >> 5, b = F.tid & 31; int tot = 0, bef = 0;
      if (b < 24) for (int v = p * 16; v < p * 16 + 16; ++v) { const int c = wgcnt[v * 24 + b]; tot += c; if (v < F.vcu) bef += c; }
      ptot[p * 32 + b] = tot; pbef[p * 32 + b] = bef; }
    __syncthreads();
    if (F.tid < 32) { int tot = 0, bef = 0; for (int p = 0; p < 16; ++p) { tot += ptot[p * 32 + F.tid]; bef += pbef[p * 32 + F.tid]; } btot[F.tid] = tot; carry[F.tid] = bef; }
    __syncthreads();
    if (F.tid == 0) { int s = 0; for (int b = 0; b < 24; ++b) { bstart[b] = s; s += (btot[b] + 255) & ~255; } bstart[24] = s; }
    __syncthreads();
    if (F.tid < 24) carry[F.tid] += bstart[F.tid];
    if (F.vcu == 0) {
        if (F.tid == 0) tileb[0] = bstart[24] >> 8;
        for (int b = 0; b < 24; ++b) { const int s = bstart[b], e = bstart[b + 1];
            for (int t = (s >> 8) + F.tid; t < (e >> 8); t += NTHREADS) tileb[1 + t] = b;
            for (int r = s + btot[b] + F.tid; r < e; r += NTHREADS) __hip_atomic_store(rowtok + r, -1, __ATOMIC_RELAXED, __HIP_MEMORY_SCOPE_AGENT); }
    }
    __syncthreads();
    if (F.wave == 0) {
        for (int pass = 0; pass < 2; ++pass) { const int i = pass * 64 + F.lane, bi = tokb[F.vcu * 128 + i]; int row = 0;
#pragma unroll 1
            for (int b = 0; b < 24; ++b) { const unsigned long long mask = __ballot(bi == b); const int c = carry[b];
                if (bi == b) row = c + __builtin_popcountll(mask & ((1ull << F.lane) - 1ull));
                asm volatile("s_waitcnt lgkmcnt(0)" ::: "memory");
                if (F.lane == 0) carry[b] = c + __builtin_popcountll(mask);
                asm volatile("s_waitcnt lgkmcnt(0)" ::: "memory"); }
            rowidx[i] = row; }
    }
    __syncthreads();
    bf16* XS = (bf16*)(F.ws + WS_XS);
    for (int i = 0; i < 16; ++i) {
        const int li = F.wave * 16 + i, m = F.vcu * 128 + li, row = rowidx[li]; const float rstd = tokr[m];
        if (F.lane == 0) {
            __hip_atomic_store(rowtok + row, m, __ATOMIC_RELAXED, __HIP_MEMORY_SCOPE_AGENT);
            const unsigned long long w2 = (unsigned long long)__builtin_bit_cast(unsigned, tokw[2 * m]) | ((unsigned long long)__builtin_bit_cast(unsigned, tokw[2 * m + 1]) << 32);
            __hip_atomic_store((unsigned long long*)(roww + 2 * row), w2, __ATOMIC_RELAXED, __HIP_MEMORY_SCOPE_AGENT); }
        if (F.lane == 0) __hip_atomic_store((float*)(F.ws + WS_ROWR) + row, rstd, __ATOMIC_RELAXED, __HIP_MEMORY_SCOPE_AGENT);
        const u32x4* xr = (const u32x4*)(P_XB(F) + (size_t)m * D) + F.lane; u32x4* o16 = (u32x4*)(XS + (size_t)row * D) + F.lane;
        o16[0] = xr[0]; o16[64] = xr[64];
    }
}
struct MoeOrder {
    const int* tileb; int G, c; bool down;
    __device__ __forceinline__ bool next(int i, pg8::Unit& u) const {
        const GAS int* tb_ = (const GAS int*)tileb;
        const int NT = __builtin_amdgcn_readfirstlane(tb_[0]), L = i * G + c; if (L >= NT * 4) return false;
        const int rt = L >> 2, pn = L & 3, b = __builtin_amdgcn_readfirstlane(tb_[1 + rt]);
        if (down) { u.pm = rt; u.pn = b * 4 + pn; u.aux = pn; }
        else { int ea, eb; pair_decode(b % 6, ea, eb); const int e = (b / 6) * 4 + (pn < 2 ? ea : eb); u.pm = rt; u.pn = e * 2 + (pn & 1); u.aux = pn; }
        return true;
    }
};
struct EpiGU {
    static constexpr bool PERM = true;
    bf16* H; const float* roww; const float* rowr;
    __device__ __forceinline__ void operator()(const f32x4 (&acc)[2][2][4][2], const pg8::Unit& u, int wr, int wc, int fr_, int fq_) const {
        const int ln_ = lane_id(), fr = ln_ & 15, fq = ln_ >> 4; (void)fr_; (void)fq_;
        const int row0 = u.pm * 256 + wr * 64 + fr, cl = u.aux * 128 + 16 * wc + 4 * fq, ws = u.aux >> 1;
#pragma unroll
        for (int ai = 0; ai < 2; ++ai)
#pragma unroll
            for (int m = 0; m < 4; ++m) { const int r = row0 + ai * 128 + m * 16; const float rr = rowr[r], w = roww[2 * r + ws] * rr;
#pragma unroll
                for (int bj = 0; bj < 2; ++bj) { const f32x4 g = acc[ai][bj][m][0], up = acc[ai][bj][m][1]; f32x4 a;
#pragma unroll
                    for (int i = 0; i < 4; ++i) { const float gg = g[i] * rr; a[i] = gg * sigmoidf_(gg) * up[i] * w; }
                    u32x2 o; o.x = pg8::cvt_pk_bf16(a[0], a[1]); o.y = pg8::cvt_pk_bf16(a[2], a[3]);
                    *(u32x2*)(H + (size_t)r * 512 + cl + bj * 64) = o; } }
    }
};
struct EpiDown {
    static constexpr bool PERM = true;
    bf16* RB; const int* rowtok;
    __device__ __forceinline__ void operator()(const f32x4 (&acc)[2][2][4][2], const pg8::Unit& u, int wr, int wc, int fr_, int fq_) const {
        const int ln_ = lane_id(), fr = ln_ & 15, fq = ln_ >> 4; (void)fr_; (void)fq_;
        const int row0 = u.pm * 256 + wr * 64 + fr, col0 = u.aux * 256 + wc * 32 + 8 * fq;
#pragma unroll
        for (int ai = 0; ai < 2; ++ai)
#pragma unroll
            for (int m = 0; m < 4; ++m) { const int tok = rowtok[row0 + ai * 128 + m * 16];
                if (tok >= 0) { bf16* rp = RB + (size_t)tok * D + col0;
#pragma unroll
                    for (int bj = 0; bj < 2; ++bj) { const u32x4 x = *(const u32x4*)(rp + bj * 128); const f32x4 a0 = acc[ai][bj][m][0], a1 = acc[ai][bj][m][1]; u32x4 w;
                        w.x = pg8::cvt_pk_bf16(bf2f(x.x & 0xffffu) + a0[0], bf2f(x.x >> 16) + a0[1]); w.y = pg8::cvt_pk_bf16(bf2f(x.y & 0xffffu) + a0[2], bf2f(x.y >> 16) + a0[3]);
                        w.z = pg8::cvt_pk_bf16(bf2f(x.z & 0xffffu) + a1[0], bf2f(x.z >> 16) + a1[1]); w.w = pg8::cvt_pk_bf16(bf2f(x.w & 0xffffu) + a1[2], bf2f(x.w >> 16) + a1[3]);
                        *(u32x4*)(rp + bj * 128) = w; } }
                if (m & 1) asm volatile("" ::: "memory"); }
    }
};

struct SsmOrder { int G, c, mode;
    __device__ __forceinline__ bool next(int i, pg8::Unit& u) const { const int L = i * G + c;
        if (mode == 1) { if (L >= 32) return false; u.pm = L; u.pn = L >> 1; u.aux = 0; return true; }
        if (L >= 128) return false; const int g = L >> 3; u.pm = g * 2 + ((L >> 2) & 1); u.pn = g * 4 + (L & 3); u.aux = L & 3; return true; } };
struct HalfOrder { int L;
    __device__ __forceinline__ bool next(int i, pg8::Unit& u) const { if (i > 0 || L < 0 || L >= 128) return false; u.pm = L; u.pn = 0; u.aux = 0; return true; } };
struct EpiZ { static constexpr bool PERM = false; float* ZB;
    __device__ __forceinline__ void operator()(const f32x4 (&acc)[2][2][4][2], const pg8::Unit& u, int wr, int wc, int fr_, int fq_) const {
        const int ln_ = lane_id(), fr = ln_ & 15, fq = ln_ >> 4; (void)fr_; (void)fq_;
        const int row0 = u.pm * 256 + wr * 64 + fr, col0 = wc * 32 + 4 * fq;
#pragma unroll
        for (int ai = 0; ai < 2; ++ai)
#pragma unroll
            for (int m = 0; m < 4; ++m)
#pragma unroll
                for (int n = 0; n < 2; ++n) *(f32x4*)(ZB + (size_t)(row0 + ai * 128 + m * 16) * 128 + col0 + n * 16) = acc[ai][0][m][n];
    } };
struct EpiSsm2 { static constexpr bool PERM = true; const bf16* UG; bf16* YS; const float* dvec;
    __device__ __forceinline__ void operator()(const f32x4 (&acc)[2][2][4][2], const pg8::Unit& u, int wr, int wc, int fr_, int fq_) const {
        const int ln_ = lane_id(), fr = ln_ & 15, fq = ln_ >> 4; (void)fr_; (void)fq_;
        const int g = u.pm >> 1, cr0 = (u.pm & 1) * 256 + wr * 64 + fr;
#pragma unroll
        for (int bj = 0; bj < 2; ++bj) { const int n0 = u.aux * 256 + bj * 128 + wc * 32 + 8 * fq, to = n0 >> 4, ho0 = n0 & 15;
            const f32x4 d0 = *(const f32x4*)(dvec + g * 16 + ho0), d1 = *(const f32x4*)(dvec + g * 16 + ho0 + 4);
#pragma unroll
            for (int ai = 0; ai < 2; ++ai)
#pragma unroll
                for (int m = 0; m < 4; ++m) { const int cr = cr0 + ai * 128 + m * 16;
                    const u32x4 uu = *(const u32x4*)(UG + ((size_t)(g * 512 + cr)) * UGP + n0);
                    const f32x4 a0 = acc[ai][bj][m][0], a1 = acc[ai][bj][m][1]; float y[8];
                    y[0] = gelu_tanh(a0[0] + d0[0] * bf2f(uu.x & 0xffffu)); y[1] = gelu_tanh(a0[1] + d0[1] * bf2f(uu.x >> 16));
                    y[2] = gelu_tanh(a0[2] + d0[2] * bf2f(uu.y & 0xffffu)); y[3] = gelu_tanh(a0[3] + d0[3] * bf2f(uu.y >> 16));
                    y[4] = gelu_tanh(a1[0] + d1[0] * bf2f(uu.z & 0xffffu)); y[5] = gelu_tanh(a1[1] + d1[1] * bf2f(uu.z >> 16));
                    y[6] = gelu_tanh(a1[2] + d1[2] * bf2f(uu.w & 0xffffu)); y[7] = gelu_tanh(a1[3] + d1[3] * bf2f(uu.w >> 16));
                    u32x4 w; w.x = pg8::cvt_pk_bf16(y[0], y[1]); w.y = pg8::cvt_pk_bf16(y[2], y[3]); w.z = pg8::cvt_pk_bf16(y[4], y[5]); w.w = pg8::cvt_pk_bf16(y[6], y[7]);
                    *(u32x4*)(YS + ((size_t)cr * 64 + to) * 256 + g * 16 + ho0) = w; } }
    } };
struct EpiGluE { static constexpr bool PERM = true; const bf16* YS; bf16* YMIX; const float* gb;
    __device__ __forceinline__ void operator()(const f32x4 (&acc)[2][2][4][2], const pg8::Unit& u, int wr, int wc, int fr_, int fq_) const {
        const int ln_ = lane_id(), fr = ln_ & 15, fq = ln_ >> 4; (void)fr_; (void)fq_;
        const int row0 = u.pm * 256 + wr * 64 + fr;
#pragma unroll
        for (int bj = 0; bj < 2; ++bj) { const int n0 = bj * 128 + wc * 32 + 8 * fq; const f32x4 b0 = *(const f32x4*)(gb + n0), b1 = *(const f32x4*)(gb + n0 + 4);
#pragma unroll
            for (int ai = 0; ai < 2; ++ai)
#pragma unroll
                for (int m = 0; m < 4; ++m) { const size_t r = (size_t)(row0 + ai * 128 + m * 16); const u32x4 yy = *(const u32x4*)(YS + r * 256 + n0);
                    const f32x4 a0 = acc[ai][bj][m][0] + b0, a1 = acc[ai][bj][m][1] + b1; float o[8];
                    o[0] = bf2f(yy.x & 0xffffu) * sigmoidf_(a0[0]); o[1] = bf2f(yy.x >> 16) * sigmoidf_(a0[1]); o[2] = bf2f(yy.y & 0xffffu) * sigmoidf_(a0[2]); o[3] = bf2f(yy.y >> 16) * sigmoidf_(a0[3]);
                    o[4] = bf2f(yy.z & 0xffffu) * sigmoidf_(a1[0]); o[5] = bf2f(yy.z >> 16) * sigmoidf_(a1[1]); o[6] = bf2f(yy.w & 0xffffu) * sigmoidf_(a1[2]); o[7] = bf2f(yy.w >> 16) * sigmoidf_(a1[3]);
                    u32x4 w; w.x = pg8::cvt_pk_bf16(o[0], o[1]); w.y = pg8::cvt_pk_bf16(o[2], o[3]); w.z = pg8::cvt_pk_bf16(o[4], o[5]); w.w = pg8::cvt_pk_bf16(o[6], o[7]);
                    *(u32x4*)(YMIX + r * 1024 + n0) = w; } }
    } };
struct EpiPoolE { static constexpr bool PERM = true; bf16* YMIX; const float* pb; const float* ps;
    __device__ __forceinline__ void operator()(const f32x4 (&acc)[2][2][4][2], const pg8::Unit& u, int wr, int wc, int fr_, int fq_) const {
        const int ln_ = lane_id(), fr = ln_ & 15, fq = ln_ >> 4; (void)fr_; (void)fq_;
        const int row0 = u.pm * 256 + wr * 64 + fr;
#pragma unroll
        for (int bj = 0; bj < 2; ++bj) { const int n0 = bj * 128 + wc * 32 + 8 * fq; const f32x4 b0 = *(const f32x4*)(pb + n0), b1 = *(const f32x4*)(pb + n0 + 4), s0 = *(const f32x4*)(ps + n0), s1 = *(const f32x4*)(ps + n0 + 4);
#pragma unroll
            for (int ai = 0; ai < 2; ++ai)
#pragma unroll
                for (int m = 0; m < 4; ++m) { const size_t r = (size_t)(row0 + ai * 128 + m * 16);
                    const f32x4 a0 = (acc[ai][bj][m][0] + b0) * s0, a1 = (acc[ai][bj][m][1] + b1) * s1;
                    u32x4 w; w.x = pg8::cvt_pk_bf16(a0[0], a0[1]); w.y = pg8::cvt_pk_bf16(a0[2], a0[3]); w.z = pg8::cvt_pk_bf16(a1[0], a1[1]); w.w = pg8::cvt_pk_bf16(a1[2], a1[3]);
                    *(u32x4*)(YMIX + r * 1024 + 256 + n0) = w; } }
    } };
__device__ __forceinline__ void ph_tg_expand(const Ctx& F0, int l) {
    const Ctx F = launder(F0);
    if (F.wave == 0) return;
    const int gw = F.vcu * 7 + (F.wave - 1), NGW = F.G * 7;
    const bf16* KT = (const bf16*)(F.ws + WS_KT) + (size_t)l * SGN * 64 * 256;
    bf16* TG0 = (bf16*)(F.ws + WS_TG) + (size_t)l * SGN * 1024 * UGP;
#pragma unroll 2
    for (int r = gw; r < SGN * 1024; r += NGW) { const int g = r >> 10, n = r & 1023, to = n >> 4, ho = n & 15;
        bf16* d = TG0 + ((size_t)g * 1024 + n) * UGP;
#pragma unroll
        for (int half = 0; half < 2; ++half) { const int ti = half * 32 + (F.lane >> 1), tau = to - ti;
            u32x4 v = (u32x4){0u, 0u, 0u, 0u};
            if (tau >= 0) v = *(const u32x4*)(KT + (((size_t)g * 64 + tau) * 16 + ho) * 16 + (F.lane & 1) * 8);
            *(u32x4*)(d + half * 512 + F.lane * 8) = v; } }
}
__device__ __forceinline__ void ph_ssm_scan(const Ctx& F0, int l) {
    const Ctx F = launder(F0);
    for (int it = F.vcu + F.G * F.wave; it < SGN * NB; it += F.G * NWAVES) {
        const int g = it >> 3, b = it & 7, p = F.lane;
        const float are = F.in[4][(l * SGN + g) * SP + p], aim = F.in[5][(l * SGN + g) * SP + p], dt = expf(F.in[6][l * SGN + g]);
        float sn, cs; sincosf(aim * dt * 64.f, &sn, &cs); const float mg = expf(are * dt * 64.f), lr = mg * cs, li = mg * sn;
        const float* Z = (const float*)(F.ws + WS_ZB) + ((size_t)g * 512 + b * 64) * 128;
        bf16* U = P_UG(F) + ((size_t)g * 512 + b * 64) * UGP + 1024;
        float sr = 0.f, si = 0.f;
#pragma unroll 1
        for (int c0 = 0; c0 < 64; c0 += 32) {
            float zr[32], zi[32];
#pragma unroll
            for (int j = 0; j < 32; ++j) { zr[j] = Z[(c0 + j) * 128 + p]; zi[j] = Z[(c0 + j) * 128 + 64 + p]; }
#pragma unroll
            for (int j = 0; j < 32; ++j) {
                U[(size_t)(c0 + j) * UGP + p] = (bf16)f2bf(sr); U[(size_t)(c0 + j) * UGP + 64 + p] = (bf16)f2bf(si);
                const float nr = lr * sr - li * si + zr[j], ni = lr * si + li * sr + zi[j]; sr = nr; si = ni; }
        }
    }
}

namespace moba {
using bf16x8 = __attribute__((ext_vector_type(8))) short;
using s16x4 = __attribute__((ext_vector_type(4))) short;
using f32x16 = __attribute__((ext_vector_type(16))) float;
typedef short v4i16_t __attribute__((ext_vector_type(4)));
typedef float f32x2_t __attribute__((ext_vector_type(2))); typedef __bf16 bf16x2_t __attribute__((ext_vector_type(2)));
constexpr int L_K = 0, L_V = 49152, L_TB = 98304, L_KM = L_TB + 4 * 768 * 4, L_END = L_KM + 16 * 64 * 4;
__device__ __forceinline__ unsigned cvtpk(float lo, float hi) { f32x2_t v = {lo, hi}; bf16x2_t b = __builtin_convertvector(v, bf16x2_t); return __builtin_bit_cast(unsigned, b); }
__device__ __forceinline__ s16x4 vtr(const LAS char* p) { return __builtin_bit_cast(s16x4, __builtin_amdgcn_ds_read_tr16_b64_v4i16((LAS v4i16_t*)p)); }
__device__ __forceinline__ float hmax(float v) { const unsigned u = __builtin_bit_cast(unsigned, v); auto r = __builtin_amdgcn_permlane32_swap(u, u, false, false); return fmaxf(__builtin_bit_cast(float, (unsigned)r[0]), __builtin_bit_cast(float, (unsigned)r[1])); }
__device__ __forceinline__ float hsum(float v) { const unsigned u = __builtin_bit_cast(unsigned, v); auto r = __builtin_amdgcn_permlane32_swap(u, u, false, false); return __builtin_bit_cast(float, (unsigned)r[0]) + __builtin_bit_cast(float, (unsigned)r[1]); }

constexpr int L_LIST = L_END, L_WCNT = 32768;
#define MOBA_CVEC() f32x16 cvec; do { const float ci_ = bfar - mref; _Pragma("unroll") for (int r = 0; r < 16; ++r) cvec[r] = ci_; } while (0)
#define MOBA_QK(P0, P1, KB) do { { const bf16x8 a0 = *(const LAS bf16x8*)(kp0 + (KB)), a1 = *(const LAS bf16x8*)(kp0 + (KB) + 512); \
          P0 = __builtin_amdgcn_mfma_f32_32x32x16_bf16(a0, qr[0], cvec, 0, 0, 0); P1 = __builtin_amdgcn_mfma_f32_32x32x16_bf16(a1, qr[0], cvec, 0, 0, 0); } \
        _Pragma("unroll") for (int d0 = 1; d0 < 4; ++d0) { const bf16x8 a0 = *(const LAS bf16x8*)(kp0 + (KB) + d0 * 2048), a1 = *(const LAS bf16x8*)(kp0 + (KB) + d0 * 2048 + 512); \
            P0 = __builtin_amdgcn_mfma_f32_32x32x16_bf16(a0, qr[d0], P0, 0, 0, 0); P1 = __builtin_amdgcn_mfma_f32_32x32x16_bf16(a1, qr[d0], P1, 0, 0, 0); } } while (0)
#define MOBA_NEARMAX(P0, P1, JN, OUT) do { const int jn_ = (JN); if (jn_ >= 0) { const int A_ = qrel - 64 * (jn_ - 4) - 4 * hi + 256, s_ = 767 - A_, c_ = s_ & 3; \
            const LAS f32x4* t4 = (const LAS f32x4*)(tb + c_ * 768 + (s_ - c_)); \
            _Pragma("unroll") for (int g = 0; g < 4; ++g) { const f32x4 x0 = t4[2 * g], x1 = t4[2 * g + 8]; \
                _Pragma("unroll") for (int j = 0; j < 4; ++j) { P0[4 * g + j] += x0[j]; P1[4 * g + j] += x1[j]; } } } \
        float ra = __builtin_fmaxf(__builtin_fmaxf(P0[0], P0[1]), P1[0]), rb = __builtin_fmaxf(__builtin_fmaxf(P0[2], P0[3]), P1[1]); \
        ra = __builtin_fmaxf(__builtin_fmaxf(ra, P1[2]), P1[3]); \
        _Pragma("unroll") for (int r = 4; r < 16; r += 4) { ra = __builtin_fmaxf(__builtin_fmaxf(ra, P0[r]), P0[r + 1]); rb = __builtin_fmaxf(__builtin_fmaxf(rb, P0[r + 2]), P0[r + 3]); \
            ra = __builtin_fmaxf(__builtin_fmaxf(ra, P1[r]), P1[r + 1]); rb = __builtin_fmaxf(__builtin_fmaxf(rb, P1[r + 2]), P1[r + 3]); } \
        OUT = hmax(__builtin_fmaxf(ra, rb)); } while (0)
#define MOBA_STEP(PC0, PC1, PN0, PN1, JNN, KBN, VBC, HASN) do { \
        bf16x8 vf[8], kf[8]; \
        if (HASN) { _Pragma("unroll") for (int d0 = 0; d0 < 4; ++d0) { kf[2 * d0] = *(const LAS bf16x8*)(kp0 + (KBN) + d0 * 2048); kf[2 * d0 + 1] = *(const LAS bf16x8*)(kp0 + (KBN) + d0 * 2048 + 512); } } \
        __builtin_amdgcn_sched_barrier(0); \
        if (__any(rm > 8.f)) { const float dl = __builtin_fmaxf(rm, 0.f), alpha = __builtin_amdgcn_exp2f(-dl); mref += dl; l *= alpha; \
            _Pragma("unroll") for (int r = 0; r < 16; ++r) { PC0[r] -= dl; PC1[r] -= dl; o0[r] *= alpha; o1[r] *= alpha; } } \
        if (HASN) { MOBA_CVEC(); \
                    PN0 = __builtin_amdgcn_mfma_f32_32x32x16_bf16(kf[0], qr[0], cvec, 0, 0, 0); PN1 = __builtin_amdgcn_mfma_f32_32x32x16_bf16(kf[1], qr[0], cvec, 0, 0, 0); \
                    _Pragma("unroll") for (int d0 = 1; d0 < 4; ++d0) { PN0 = __builtin_amdgcn_mfma_f32_32x32x16_bf16(kf[2 * d0], qr[d0], PN0, 0, 0, 0); PN1 = __builtin_amdgcn_mfma_f32_32x32x16_bf16(kf[2 * d0 + 1], qr[d0], PN1, 0, 0, 0); } } \
        { const LAS char* vp = vp0 + (VBC); \
        _Pragma("unroll") for (int k = 0; k < 4; ++k) { \
            const s16x4 lo0 = vtr(vp + k * 1024), hi0 = vtr(vp + k * 1024 + 512), lo1 = vtr(vp + 4096 + k * 1024), hi1 = vtr(vp + 4096 + k * 1024 + 512); \
            vf[2 * k] = (bf16x8){lo0[0], lo0[1], lo0[2], lo0[3], hi0[0], hi0[1], hi0[2], hi0[3]}; vf[2 * k + 1] = (bf16x8){lo1[0], lo1[1], lo1[2], lo1[3], hi1[0], hi1[1], hi1[2], hi1[3]}; } } \
        __builtin_amdgcn_sched_barrier(0); \
        float s0 = 0.f, s1 = 0.f; u32x4 pw[4]; \
        _Pragma("unroll") for (int r = 0; r < 16; ++r) { PC0[r] = __builtin_amdgcn_exp2f(PC0[r]); PC1[r] = __builtin_amdgcn_exp2f(PC1[r]); s0 += PC0[r]; s1 += PC1[r]; } \
        l += s0 + s1; \
        _Pragma("unroll") for (int q = 0; q < 4; ++q) { pw[0][q] = cvtpk(PC0[2 * q], PC0[2 * q + 1]); pw[1][q] = cvtpk(PC0[8 + 2 * q], PC0[9 + 2 * q]); pw[2][q] = cvtpk(PC1[2 * q], PC1[2 * q + 1]); pw[3][q] = cvtpk(PC1[8 + 2 * q], PC1[9 + 2 * q]); } \
        _Pragma("unroll") for (int k = 0; k < 4; ++k) { const bf16x8 pa = __builtin_bit_cast(bf16x8, pw[k]); \
            o0 = __builtin_amdgcn_mfma_f32_32x32x16_bf16(vf[2 * k], pa, o0, 0, 0, 0); o1 = __builtin_amdgcn_mfma_f32_32x32x16_bf16(vf[2 * k + 1], pa, o1, 0, 0, 0); } \
        if (HASN) MOBA_NEARMAX(PN0, PN1, JNN, rm); \
    } while (0)
#define MOBA_BLOCK4(JN0) \
    float mref = 0.f, l = 0.f; f32x16 o0 = f32x16{}, o1 = f32x16{}; f32x16 pa0, pa1, pb0, pb1; float rm; \
    { const int jn0_ = (JN0); \
      { MOBA_CVEC(); MOBA_QK(pa0, pa1, 0); } MOBA_NEARMAX(pa0, pa1, jn0_, rm); \
      MOBA_STEP(pa0, pa1, pb0, pb1, (jn0_ < 0 ? -1 : jn0_ + 1), 8192, 0, true); \
      MOBA_STEP(pb0, pb1, pa0, pa1, (jn0_ < 0 ? -1 : jn0_ + 2), 16384, 8192, true); \
      MOBA_STEP(pa0, pa1, pb0, pb1, (jn0_ < 0 ? -1 : jn0_ + 3), 24576, 16384, true); \
      MOBA_STEP(pb0, pb1, pa0, pa1, -1, 0, 24576, false); }
__device__ __forceinline__ void load_block(const bf16* K, const bf16* V, size_t row0, int h, int wid, int lane, LAS char* lds) {
    const bf16* ksrc = K + (row0 + lane) * 512 + h * 64 + wid * 8;
    const bf16* vsrc = V + (row0 + 16 * (wid & 3) + (lane >> 2)) * 512 + h * 64 + (wid >> 2) * 32 + (lane & 3) * 8;
    u32x4 kr[4], vr[4];
#pragma unroll
    for (int t = 0; t < 4; ++t) { kr[t] = *(const u32x4*)(ksrc + (size_t)t * 64 * 512); vr[t] = *(const u32x4*)(vsrc + (size_t)t * 64 * 512); }
    LAS char* kd = lds + L_K + wid * 1024 + lane * 16; LAS char* vd = lds + L_V + wid * 1024 + lane * 16;
#pragma unroll
    for (int t = 0; t < 4; ++t) { *(LAS u32x4*)(kd + t * 8192) = kr[t]; *(LAS u32x4*)(vd + t * 8192) = vr[t]; }
}
__device__ __forceinline__ void fill_bias_table(const float* BT, int h, int tid, LAS float* tb) {
    const float bfar = BT[h * 132 + 128];
    for (int i = tid; i < 4 * 768; i += NTHREADS) { const int c = i / 768, j = i % 768, src_ = 767 - (j + c), rel = src_ - 256; tb[i] = (src_ < 0 || rel < 0) ? -1.0e30f : (rel < 128 ? BT[h * 132 + rel] - bfar : 0.f); }
}
__device__ __forceinline__ void sel_phase(int wave_, int vcu, int G, const bf16* Q, const float* KMP, unsigned* SEL, LAS char* lds) {
    const int w0 = G > 64 ? 32 : 0, nw = G - w0; if (vcu < w0) return;
    int lane_ = lane_id(); asm volatile("" : "+v"(lane_)); asm volatile("" : "+s"(wave_));
    const int wid = wave_, lane = lane_, tid = wid * 64 + lane, r32 = lane & 31, hi = lane >> 5;
    const int ub = ((vcu - w0) * 1024) / nw, ue = ((vcu - w0 + 1) * 1024) / nw;
    LAS float* km = (LAS float*)(lds + L_KM);
    int bhc = -1;
#pragma unroll 1
    for (int u = ub; u < ue; ++u) {
        const int bh = u >> 4, qb = u & 15, b = bh >> 3, h = bh & 7;
        if (bh != bhc) { bhc = bh;
            __syncthreads();
            for (int i = tid; i < 16 * 64; i += NTHREADS) { const int j = i >> 6, d = i & 63, pm = b * 16 + j; km[i] = KMP[pm * 512 + h * 64 + d] + KMP[128 * 512 + pm * 512 + h * 64 + d]; }
            __syncthreads(); }
        asm volatile("" ::: "memory");
        const int q = qb * 256 + wid * 32 + r32;
        const bf16* qw = Q + ((size_t)b * SEQ + q) * 512 + h * 64 + hi * 8;
        bf16x8 qr[4];
#pragma unroll
        for (int d0 = 0; d0 < 4; ++d0) qr[d0] = *(const bf16x8*)(qw + d0 * 16);
        float g[16];
#pragma unroll
        for (int j = 0; j < 16; ++j) g[j] = 0.f;
#pragma unroll
        for (int d0 = 0; d0 < 4; ++d0)
#pragma unroll
            for (int j = 0; j < 16; ++j) { const f32x4 ka = *(const LAS f32x4*)(km + j * 64 + d0 * 16 + hi * 8), kb4 = *(const LAS f32x4*)(km + j * 64 + d0 * 16 + hi * 8 + 4);
#pragma unroll
                for (int e = 0; e < 4; ++e) { g[j] += bf2f((unsigned)(unsigned short)qr[d0][e]) * ka[e]; }
#pragma unroll
                for (int e = 0; e < 4; ++e) { g[j] += bf2f((unsigned)(unsigned short)qr[d0][4 + e]) * kb4[e]; } }
#pragma unroll
        for (int j = 0; j < 16; ++j) g[j] = hsum(g[j]);
        unsigned selmask = 0u;
#pragma unroll
        for (int s3 = 0; s3 < 3; ++s3) { float bv = -3.0e38f; int bi = -1;
#pragma unroll
            for (int j = 0; j < 16; ++j) { const bool ok = (j < qb) && !((selmask >> j) & 1u) && (g[j] > bv); bv = ok ? g[j] : bv; bi = ok ? j : bi; }
            if (bi >= 0) selmask |= 1u << bi; }
        if (hi == 0) SEL[(size_t)bh * SEQ + q] = selmask;
    }
}
__device__ __forceinline__ bf16* pslot(int slot, size_t t, int h, bf16* YM, bf16* P2A, bf16* P2B) {
    return slot == 0 ? YM + t * 1024 + h * 64 : slot == 1 ? YM + t * 1024 + 512 + h * 64 : (t < (size_t)(T / 2) ? P2A + t * 512 : P2B + (t - (size_t)(T / 2)) * 512) + h * 64;
}
__device__ __forceinline__ void gather_phase(int wave_, int vcu, const bf16* Q, const bf16* K, const bf16* V, bf16* YM, bf16* P2A, bf16* P2B, float* ML, const unsigned* SEL, const float* BT, LAS char* lds) {
    if (vcu >= 256) return;
    int lane_ = lane_id(); asm volatile("" : "+v"(lane_)); asm volatile("" : "+s"(wave_));
    const int wid = wave_, lane = lane_, tid = wid * 64 + lane, r32 = lane & 31, hi = lane >> 5;
    const int bh = vcu >> 2, s = vcu & 3, b = bh >> 3, h = bh & 7;
    const size_t rowbase = (size_t)b * SEQ;
    LAS float* tb = (LAS float*)(lds + L_TB); LAS int* list = (LAS int*)(lds + L_LIST); LAS int* wcnt = (LAS int*)(lds + L_WCNT);
    const float bfar = BT[h * 132 + 128];
    fill_bias_table(BT, h, tid, tb);
    const unsigned* selrow = SEL + (size_t)bh * SEQ;
    const LAS char* kp0 = lds + L_K + hi * 1024 + r32 * 16;
    const LAS char* vp0 = lds + L_V + ((lane >> 4) & 1) * 32 + (lane & 3) * 8 + (4 * hi + ((lane & 15) >> 2)) * 64;
    const unsigned code = s == 0 ? 0xFFFA70u : s == 1 ? 0xFFE961u : s == 2 ? 0xFFFB32u : 0xFDC854u;
#pragma unroll 1
    for (int ik = 0; ik < 6; ++ik) {
        const int kb = (int)((code >> (4 * ik)) & 15u); if (kb == 15) break;
        __syncthreads();
        load_block(K, V, rowbase + (size_t)kb * 256, h, wid, lane, lds);
        const int qs = (kb + 1) * 256, R = (SEQ - qs) >> 3;
        unsigned long long bal[8]; int cnt = 0;
#pragma unroll
        for (int i = 0; i < 8; ++i) { const int off = i * 64 + lane; const bool in = off < R; const unsigned m = in ? selrow[qs + wid * R + off] : 0u;
            bal[i] = __ballot(in && ((m >> kb) & 1u)); cnt += __builtin_popcountll(bal[i]); }
        if (lane == 0) wcnt[wid] = cnt;
        __syncthreads();
        int base = 0, n = 0;
#pragma unroll
        for (int w = 0; w < 8; ++w) { const int c = wcnt[w]; n += c; base += (w < wid) ? c : 0; }
#pragma unroll
        for (int i = 0; i < 8; ++i) { const unsigned long long m = bal[i];
            if ((m >> lane) & 1ull) list[base + __builtin_popcountll(m & ((1ull << lane) - 1ull))] = qs + wid * R + i * 64 + lane;
            base += __builtin_popcountll(m); }
        __syncthreads();
        const int ntask = (n + 31) >> 5;
#pragma unroll 1
        for (int tk = wid; tk < ntask; tk += 8) {
            const int li = tk * 32 + r32; const bool valid = li < n; const int qi = list[valid ? li : n - 1];
            const unsigned sm = selrow[qi]; const int slot = __builtin_popcount(sm & ((1u << kb) - 1u));
            bf16x8 qr[4];
            { const bf16* qw = Q + (rowbase + qi) * 512 + h * 64 + hi * 8;
#pragma unroll
              for (int d0 = 0; d0 < 4; ++d0) qr[d0] = *(const bf16x8*)(qw + d0 * 16); }
            const int qd = qi - qs, qrel = qd < 255 ? qd : 255;
            const bool nearw = __any(qd < 128);
            MOBA_BLOCK4(nearw ? 0 : -1)
            const float lt = hsum(l), inv = 1.f / lt; const size_t t = rowbase + qi;
            bf16* orow = pslot(slot, t, h, YM, P2A, P2B) + 8 * hi;
#pragma unroll
            for (int d0 = 0; d0 < 2; ++d0)
#pragma unroll
                for (int gp = 0; gp < 2; ++gp) { const f32x16& oo = d0 ? o1 : o0; const int ga = 8 * gp, gb = 8 * gp + 4;
                    unsigned ax = cvtpk(oo[ga] * inv, oo[ga + 1] * inv), ay = cvtpk(oo[ga + 2] * inv, oo[ga + 3] * inv), bx = cvtpk(oo[gb] * inv, oo[gb + 1] * inv), by = cvtpk(oo[gb + 2] * inv, oo[gb + 3] * inv);
                    { auto r = __builtin_amdgcn_permlane32_swap(ax, bx, false, false); ax = r[0]; bx = r[1]; }
                    { auto r = __builtin_amdgcn_permlane32_swap(ay, by, false, false); ay = r[0]; by = r[1]; }
                    if (valid) *(u32x4*)(orow + 32 * d0 + 16 * gp) = (u32x4){ax, ay, bx, by}; }
            if (valid && hi == 0) { float* ml = ML + ((t * 8 + h) * 3 + slot) * 2; ml[0] = mref; ml[1] = lt; }
        }
    }
}
__device__ __forceinline__ void diag_unit(int wid, int lane, int b, int h, int qb, const bf16* Q, const bf16* K, const bf16* V, bf16* YM, const bf16* P2A, const bf16* P2B, const float* ML, float bfar, LAS char* lds) {
    const int r32 = lane & 31, hi = lane >> 5; const size_t rowbase = (size_t)b * SEQ;
    LAS float* tb = (LAS float*)(lds + L_TB);
    const LAS char* kp0 = lds + L_K + hi * 1024 + r32 * 16;
    const LAS char* vp0 = lds + L_V + ((lane >> 4) & 1) * 32 + (lane & 3) * 8 + (4 * hi + ((lane & 15) >> 2)) * 64;
    __syncthreads();
    load_block(K, V, rowbase + (size_t)qb * 256, h, wid, lane, lds);
    const int qrel = wid * 32 + r32; const size_t t = rowbase + qb * 256 + qrel;
    bf16x8 qr[4];
    { const bf16* qw = Q + t * 512 + h * 64 + hi * 8;
#pragma unroll
      for (int d0 = 0; d0 < 4; ++d0) qr[d0] = *(const bf16x8*)(qw + d0 * 16); }
    __syncthreads();
    MOBA_BLOCK4(4)
    const int nsl = qb < 3 ? qb : 3;
    const float* ml = ML + (t * 8 + h) * 6;
    const bf16* pA = YM + t * 1024 + h * 64 + 8 * hi; const bf16* pB = YM + t * 1024 + 512 + h * 64 + 8 * hi;
    const bf16* pC = (t < (size_t)(T / 2) ? P2A + t * 512 : P2B + (t - (size_t)(T / 2)) * 512) + h * 64 + 8 * hi;
    float m0 = -3.0e38f, m1 = -3.0e38f, m2 = -3.0e38f, l0 = 0.f, l1 = 0.f, l2 = 0.f;
    u32x4 xA[4], xB[4], xC[4];
#pragma unroll
    for (int c = 0; c < 4; ++c) { xA[c] = (u32x4){0u, 0u, 0u, 0u}; xB[c] = xA[c]; xC[c] = xA[c]; }
    if (nsl > 0) { m0 = ml[0]; l0 = ml[1];
#pragma unroll
        for (int c = 0; c < 4; ++c) xA[c] = *(const u32x4*)(pA + 16 * c); }
    if (nsl > 1) { m1 = ml[2]; l1 = ml[3];
#pragma unroll
        for (int c = 0; c < 4; ++c) xB[c] = *(const u32x4*)(pB + 16 * c); }
    if (nsl > 2) { m2 = ml[4]; l2 = ml[5];
#pragma unroll
        for (int c = 0; c < 4; ++c) xC[c] = *(const u32x4*)(pC + 16 * c); }
    const float M = __builtin_fmaxf(__builtin_fmaxf(mref, m0), __builtin_fmaxf(m1, m2));
    const float w0 = __builtin_amdgcn_exp2f(mref - M), wa = l0 * __builtin_amdgcn_exp2f(m0 - M), wb = l1 * __builtin_amdgcn_exp2f(m1 - M), wc = l2 * __builtin_amdgcn_exp2f(m2 - M);
    const float inv = 1.f / (hsum(l) * w0 + wa + wb + wc);
    const float s0 = w0 * inv, sa = wa * inv, sb = wb * inv, sc = wc * inv;
    bf16* orow = YM + t * 1024 + 512 + h * 64 + 8 * hi;
#pragma unroll
    for (int d0 = 0; d0 < 2; ++d0)
#pragma unroll
        for (int gp = 0; gp < 2; ++gp) { const f32x16& oo = d0 ? o1 : o0; const int ga = 8 * gp, gb = 8 * gp + 4, dof = 32 * d0 + 16 * gp, cc = 2 * d0 + gp;
            float a0 = oo[ga] * s0, a1 = oo[ga + 1] * s0, a2 = oo[ga + 2] * s0, a3 = oo[ga + 3] * s0, b0 = oo[gb] * s0, b1 = oo[gb + 1] * s0, b2 = oo[gb + 2] * s0, b3 = oo[gb + 3] * s0;
#define MOBA_ACC(X, W) { unsigned fx = X[cc].x, fy = X[cc].y, sx = X[cc].z, sy = X[cc].w; \
              { auto r = __builtin_amdgcn_permlane32_swap(fx, sx, false, false); fx = r[0]; sx = r[1]; } { auto r = __builtin_amdgcn_permlane32_swap(fy, sy, false, false); fy = r[0]; sy = r[1]; } \
              a0 += (W) * bf2f(fx & 0xffffu); a1 += (W) * __builtin_bit_cast(float, fx & 0xffff0000u); a2 += (W) * bf2f(fy & 0xffffu); a3 += (W) * __builtin_bit_cast(float, fy & 0xffff0000u); \
              b0 += (W) * bf2f(sx & 0xffffu); b1 += (W) * __builtin_bit_cast(float, sx & 0xffff0000u); b2 += (W) * bf2f(sy & 0xffffu); b3 += (W) * __builtin_bit_cast(float, sy & 0xffff0000u); }
            MOBA_ACC(xA, sa) MOBA_ACC(xB, sb) MOBA_ACC(xC, sc)
#undef MOBA_ACC
            unsigned ax = cvtpk(a0, a1), ay = cvtpk(a2, a3), bx = cvtpk(b0, b1), by = cvtpk(b2, b3);
            { auto r = __builtin_amdgcn_permlane32_swap(ax, bx, false, false); ax = r[0]; bx = r[1]; }
            { auto r = __builtin_amdgcn_permlane32_swap(ay, by, false, false); ay = r[0]; by = r[1]; }
            *(u32x4*)(orow + dof) = (u32x4){ax, ay, bx, by}; }
}
__device__ __forceinline__ void diag_phase(int wave_, int vcu, const bf16* Q, const bf16* K, const bf16* V, bf16* YM, const bf16* P2A, const bf16* P2B, const float* ML, const float* BT, LAS char* lds) {
    if (vcu >= 256) return;
    int lane_ = lane_id(); asm volatile("" : "+v"(lane_)); asm volatile("" : "+s"(wave_));
    const int s = vcu & 3, bh = vcu >> 2, h = bh & 7;
    fill_bias_table(BT, h, wave_ * 64 + lane_, (LAS float*)(lds + L_TB));
    const float bfar = BT[h * 132 + 128];
#pragma unroll 1
    for (int i = 0; i < 4; ++i) { const int qb = (i == 0) ? s : (i == 1) ? 7 - s : (i == 2) ? 8 + s : 15 - s; diag_unit(wave_, lane_, bh >> 3, h, qb, Q, K, V, YM, P2A, P2B, ML, bfar, lds); }
}
#undef MOBA_CVEC
#undef MOBA_QK
#undef MOBA_NEARMAX
#undef MOBA_STEP
#undef MOBA_BLOCK4
}

__device__ __forceinline__ void ph_cvt_x(const Ctx& F0) {
    const Ctx F = launder(F0);
    const int gw = F.vcu * NWAVES + F.wave, NGW = F.G * NWAVES; float* rs1 = (float*)(F.ws + WS_RS1);
    for (int m = gw; m < T; m += NGW) {
        const f32x4* xr = (const f32x4*)(F.in[0] + (size_t)m * D) + F.lane;
        f32x4 v[4]; float s = 0.f;
#pragma unroll
        for (int j = 0; j < 4; ++j) { v[j] = xr[64 * j]; s += (v[j].x * v[j].x + v[j].y * v[j].y) + (v[j].z * v[j].z + v[j].w * v[j].w); }
        const float rstd = 1.f / sqrtf(wave_sum(s) * (1.f / D) + RMS_EPS);
        if (F.lane == 0) rs1[m] = rstd;
        unsigned long long* o8 = (unsigned long long*)(P_XB(F) + (size_t)m * D) + F.lane;
#pragma unroll
        for (int j = 0; j < 4; ++j) o8[64 * j] = (unsigned long long)pk2(v[j].x, v[j].y) | ((unsigned long long)pk2(v[j].z, v[j].w) << 32);
    }
}
__device__ __forceinline__ float row_ssq_bf16(const bf16* row, int lane) {
    const u32x4* xr = (const u32x4*)row + lane; float s = 0.f;
#pragma unroll
    for (int j = 0; j < 2; ++j) { const u32x4 x = xr[64 * j];
        const float a0 = bf2f(x.x & 0xffffu), a1 = bf2f(x.x >> 16), a2 = bf2f(x.y & 0xffffu), a3 = bf2f(x.y >> 16), a4 = bf2f(x.z & 0xffffu), a5 = bf2f(x.z >> 16), a6 = bf2f(x.w & 0xffffu), a7 = bf2f(x.w >> 16);
        s += ((a0 * a0 + a1 * a1) + (a2 * a2 + a3 * a3)) + ((a4 * a4 + a5 * a5) + (a6 * a6 + a7 * a7)); }
    return wave_sum(s);
}
__device__ __forceinline__ void ph_rstd(const Ctx& F0) {
    const Ctx F = launder(F0);
    const int gw = F.vcu * NWAVES + F.wave, NGW = F.G * NWAVES; float* rs1 = (float*)(F.ws + WS_RS1);
    for (int m = gw; m < T; m += NGW) { const float s = row_ssq_bf16(P_XB(F) + (size_t)m * D, F.lane); if (F.lane == 0) rs1[m] = 1.f / sqrtf(s * (1.f / D) + RMS_EPS); }
}

__device__ __forceinline__ void ph_bias_table(const Ctx& F0) {
    const Ctx F = launder(F0);
    if (F.vcu == 0) {
        const float* rel_bias = F.in[1];
        for (int i = F.tid; i < 8 * 132; i += NTHREADS) {
            const int h = i / 132, r = i % 132;
            int bk;
            if (r < 16) bk = r;
            else { bk = 16 + (int)(logf((float)r / 16.f) / logf(8.f) * 16.f); if (bk > 31) bk = 31; }
            P_BT(F)[i] = rel_bias[bk * 8 + h] * LOG2E;
        }
    }
}

__device__ __forceinline__ void ph_pool_dl(const Ctx& F0) {
    const Ctx F = launder(F0);
    const int gt = F.vcu * NTHREADS + F.tid, NGT = F.G * NTHREADS;
    for (int it = gt; it < (T / 32) * 128; it += NGT) {
        const int cp = it & 127, chunk = it >> 7, c = cp * 2, gi = c >> 6, win = 2 << gi, m0 = chunk * 32, t0 = m0 & (SEQ - 1);
        const unsigned* P2 = (const unsigned*)P_PB(F) + cp; unsigned* D2 = (unsigned*)P_DL(F) + cp;
        float s0 = 0.f, s1 = 0.f;
        const int back = (t0 < win) ? t0 : win;
        for (int j = 1; j <= back; ++j) { const unsigned v = P2[(size_t)(m0 - j) * 128]; s0 += bf2f(v & 0xffffu); s1 += bf2f(v >> 16); }
#pragma unroll 4
        for (int i = 0; i < 32; ++i) { const int m = m0 + i, t = t0 + i;
            const unsigned v = P2[(size_t)m * 128]; const float p0 = bf2f(v & 0xffffu), p1 = bf2f(v >> 16);
            s0 += p0; s1 += p1;
            if (t >= win) { const unsigned o = P2[(size_t)(m - win) * 128]; s0 -= bf2f(o & 0xffffu); s1 -= bf2f(o >> 16); }
            const float inv = 1.f / (float)((t + 1 < win) ? t + 1 : win);
            D2[(size_t)m * 128] = pk2(s0 * inv - p0, s1 * inv - p1); }
    }
}
__device__ __forceinline__ void ph_final(const Ctx& F0) {
    const Ctx F = launder(F0);
    const int gw = F.vcu * NWAVES + F.wave, NGW = F.G * NWAVES;
    const f32x4* gf = (const f32x4*)F.in[26];
    for (int m = gw; m < T; m += NGW) {
        const bf16* row = P_XB(F) + (size_t)m * D;
        const float rstd = 1.f / sqrtf(row_ssq_bf16(row, F.lane) * (1.f / D) + RMS_EPS);
        const u32x4* xr = (const u32x4*)row + F.lane; f32x4* orow = (f32x4*)(F.R + (size_t)m * D);
#pragma unroll
        for (int j = 0; j < 2; ++j) { const u32x4 x = xr[64 * j]; const int c4 = 2 * (64 * j + F.lane);
            orow[c4] = (f32x4){bf2f(x.x & 0xffffu), bf2f(x.x >> 16), bf2f(x.y & 0xffffu), bf2f(x.y >> 16)} * rstd * gf[c4];
            orow[c4 + 1] = (f32x4){bf2f(x.z & 0xffffu), bf2f(x.z >> 16), bf2f(x.w & 0xffffu), bf2f(x.w >> 16)} * rstd * gf[c4 + 1]; }
    }
}

constexpr int LDS_BYTES = 147456;
constexpr int MISC_OFF = 131072 + 320;

__global__ void __launch_bounds__(NTHREADS, 2) mk_fwd(Args args) {
    extern __shared__ __attribute__((aligned(16))) unsigned char lds[];
    Ctx F;
    F.lds = (LAS unsigned char*)lds;
    F.wave = __builtin_amdgcn_readfirstlane((int)threadIdx.x >> 6);
    F.lane = lane_id(); F.tid = F.wave * 64 + F.lane;
    F.G = gridDim.x; { const int bx = blockIdx.x; F.vcu = (F.G % 8 == 0) ? (bx % 8) * (F.G / 8) + bx / 8 : bx; }
    F.in = (KargP)__builtin_amdgcn_kernarg_segment_ptr(); F.R = args.out; F.ws = args.ws;
    unsigned char* ws = args.ws;
    volatile LAS unsigned* MISC = (volatile LAS unsigned*)(F.lds + MISC_OFF);
    if (F.tid < 64) MISC[F.tid] = 0u;
    __syncthreads();
    XcdBarrier bar = xcd_barrier_post((unsigned*)(ws + WS_CTL) + CW_BAR, MISC + 8, F.tid == 0);
#define GRID_BAR() do { bar.bar = (unsigned*)(wsl(ws) + WS_CTL) + CW_BAR; xcd_barrier(bar, F.wave); } while (0)
#define FL launder(F)

    ph_bias_table(F);
    ph_prologue(F);
#pragma unroll 1
    for (int l = 0; l < DEPTH; ++l) {
        if (l == 0) ph_cvt_x(F); else ph_rstd(F);
        GRID_BAR();
        { pg8::Gemm g{P_XB(FL), (const bf16*)(wsl(ws) + WS_WIN) + (size_t)l * NPROJ * D, D, D, D}; pg8::StaticOrder S; S.init(T, NPROJ, sl(F.G), sl((int)blockIdx.x));
          EpiProjE E{P_UG(FL), P_PB(FL), P_QB(FL), P_KB(FL), P_VB(FL), P_KMP(FL), (const float*)(wsl(ws) + WS_RS1)}; pg8::gemm_phase(F.lds, g, S, E, sl(F.wave)); }
        GRID_BAR();
        { pg8::Gemm g{P_UG(FL), (const bf16*)(wsl(ws) + WS_BZ) + (size_t)l * SGN * 256 * 1024, UGP, 1024, 1024}; SsmOrder S{sl(F.G), sl((int)blockIdx.x), 1};
          EpiZ E{(float*)(wsl(ws) + WS_ZB)}; pg8::gemm_phase(F.lds, g, S, E, sl(F.wave)); }
        ph_pool_dl(F);
        moba::sel_phase(sl(F.wave), sl((int)blockIdx.x), sl(F.G), P_QB(FL), P_KMP(FL), (unsigned*)(wsl(ws) + WS_SEL), (LAS char*)F.lds);
        GRID_BAR();
        moba::gather_phase(sl(F.wave), sl(F.vcu), P_QB(FL), P_KB(FL), P_VB(FL), P_YMIX(FL), P_YS(FL), (bf16*)(wsl(ws) + WS_P2B), (float*)(wsl(ws) + WS_ML), (const unsigned*)(wsl(ws) + WS_SEL), P_BT(FL), (LAS char*)F.lds);
        GRID_BAR();
        ph_ssm_scan(F, l);
        ph_tg_expand(F, l);
        moba::diag_phase(sl(F.wave), sl(F.vcu), P_QB(FL), P_KB(FL), P_VB(FL), P_YMIX(FL), P_YS(FL), (const bf16*)(wsl(ws) + WS_P2B), (const float*)(wsl(ws) + WS_ML), P_BT(FL), (LAS char*)F.lds);
        GRID_BAR();
        { pg8::Gemm g{P_UG(FL), (const bf16*)(wsl(ws) + WS_TG) + (size_t)l * SGN * 1024 * UGP, UGP, UGP, UGP}; SsmOrder S{sl(F.G), sl((int)blockIdx.x), 2};
          EpiSsm2 E{P_UG(FL), P_YS(FL), F.in[11] + l * 256}; pg8::gemm_phase(F.lds, g, S, E, sl(F.wave)); }
        GRID_BAR();
        { pg8::Gemm g{P_YS(FL), (const bf16*)(wsl(ws) + WS_GLUT) + (size_t)l * 65536, 256, 256, 256}; HalfOrder S{sl(F.vcu)};
          EpiGluE E{P_YS(FL), P_YMIX(FL), F.in[13] + l * 256}; pg8::gemm_phase(F.lds, g, S, E, sl(F.wave)); }
        { pg8::Gemm g{P_DL(FL), (const bf16*)(wsl(ws) + WS_POOLT) + (size_t)l * 65536, 256, 256, 256}; HalfOrder S{sl(F.vcu) - 128};
          EpiPoolE E{P_YMIX(FL), F.in[15] + l * 256, F.in[16] + l * 256}; pg8::gemm_phase(F.lds, g, S, E, sl(F.wave)); }
        GRID_BAR();
        { pg8::Gemm g{P_YMIX(FL), (const bf16*)(wsl(ws) + WS_WOUT) + (size_t)l * D * D, D, D, D}; pg8::StaticOrder S; S.init(T, D, sl(F.G), sl((int)blockIdx.x));
          EpiOutE E{P_XB(FL)}; pg8::gemm_phase(F.lds, g, S, E, sl(F.wave)); }
        GRID_BAR();
        ph_route(F, l);
        GRID_BAR();
        ph_place(F);
        GRID_BAR();
        { pg8::Gemm g{(const bf16*)(wsl(ws) + WS_XS), (const bf16*)(wsl(ws) + WS_GU) + (size_t)l * 16 * 512 * D, D, D, D}; MoeOrder S{(const int*)(wsl(ws) + WS_TILEB), sl(F.G), sl((int)blockIdx.x), false};
          EpiGU E{(bf16*)(wsl(ws) + WS_HACT), (const float*)(wsl(ws) + WS_ROWW), (const float*)(wsl(ws) + WS_ROWR)}; pg8::gemm_phase(F.lds, g, S, E, sl(F.wave)); }
        GRID_BAR();
        { pg8::Gemm g{(const bf16*)(wsl(ws) + WS_HACT), (const bf16*)(wsl(ws) + WS_WD) + (size_t)l * 24 * D * 512, 512, 512, 512}; MoeOrder S{(const int*)(wsl(ws) + WS_TILEB), sl(F.G), sl((int)blockIdx.x), true};
          EpiDown E{P_XB(FL), (const int*)(wsl(ws) + WS_ROWTOK)}; pg8::gemm_phase(F.lds, g, S, E, sl(F.wave)); }
        GRID_BAR();
    }
    ph_final(F);
}

extern "C" void kernel_launch(void* const* d_in, const int* in_sizes, int n_in, void* d_out, int out_size, void* d_ws, size_t ws_size, hipStream_t stream) {
    static int grid = 0;
    if (grid == 0) {
        if (n_in != 27 || out_size != T * D || ws_size < WS_END) { fprintf(stderr, "kernel_launch: unexpected shapes (n_in %d out %d ws %zu)\n", n_in, out_size, ws_size); grid = -1; return; }
        int dev = 0, cus = 0, per_cu = 0;
        if (hipGetDevice(&dev) != hipSuccess || hipDeviceGetAttribute(&cus, hipDeviceAttributeMultiprocessorCount, dev) != hipSuccess) { grid = -1; return; }
        if (hipFuncSetAttribute((const void*)mk_fwd, hipFuncAttributeMaxDynamicSharedMemorySize, LDS_BYTES) != hipSuccess) { fprintf(stderr, "kernel_launch: hipFuncSetAttribute failed\n"); grid = -1; return; }
        if (hipOccupancyMaxActiveBlocksPerMultiprocessor(&per_cu, (const void*)mk_fwd, NTHREADS, LDS_BYTES) != hipSuccess || per_cu < 1) { fprintf(stderr, "kernel_launch: occupancy query says %d\n", per_cu); per_cu = 1; }
        (void)hipGetLastError();
        grid = cus;
    }
    if (grid < 0) return;
    (void)hipMemsetAsync((char*)d_ws + WS_CTL, 0, CTL_ZERO_BYTES, stream);
    Args a{};
    for (int i = 0; i < 27; ++i) a.in[i] = (const float*)d_in[i];
    a.out = (float*)d_out; a.ws = (unsigned char*)d_ws; a.pad0 = 0; a.pad1 = 0;
    hipLaunchKernelGGL(mk_fwd, dim3(grid), dim3(NTHREADS), LDS_BYTES, stream, a);
}
```

```cpp
#include <hip/hip_runtime.h>
#include <hip/hip_bf16.h>
#include <cstdio>
#include <cstdint>

#define GAS __attribute__((address_space(1)))
#define LAS __attribute__((address_space(3)))
typedef unsigned short bf16;
typedef float f32x4 __attribute__((ext_vector_type(4)));
typedef unsigned u32x4 __attribute__((ext_vector_type(4)));
typedef unsigned u32x2 __attribute__((ext_vector_type(2)));

constexpr int NB = 8, SEQ = 4096, T = NB * SEQ, D = 1024, NPROJ = 2048, DEPTH = 2;
constexpr int NHEAD = 8, HD = 64, MBLK = 256, NBLK = SEQ / MBLK;
constexpr int SG = 16, SGN = 16, SP = 64, SCH = 64, UGP = 1152;
constexpr float RMS_EPS = 1e-6f;
constexpr float LOG2E = 1.4426950408889634f;
constexpr float C2 = 0.125f * LOG2E;
constexpr int NWAVES = 8, NTHREADS = 512;

constexpr size_t MiB = 1u << 20;
constexpr size_t WS_CTL = 0, CTL_ZERO_BYTES = 1 * MiB;
constexpr size_t WS_XB = 2 * MiB;
constexpr size_t WS_UG = 66 * MiB;
constexpr size_t WS_PB = 84 * MiB;
constexpr size_t WS_QB = 100 * MiB;
constexpr size_t WS_KB = 132 * MiB;
constexpr size_t WS_VB = 164 * MiB;
constexpr size_t WS_YMIX = 196 * MiB;
constexpr size_t WS_YS = 260 * MiB;
constexpr size_t WS_DL = 276 * MiB;
constexpr size_t WS_KMP = 292 * MiB;
constexpr size_t WS_BT = 293 * MiB;
constexpr size_t WS_KT = 297 * MiB;
constexpr size_t WS_SEL = 298 * MiB;
constexpr size_t WS_WIN = 300 * MiB;
constexpr size_t WS_WOUT = 308 * MiB;
constexpr size_t WS_GU = 312 * MiB;
constexpr size_t WS_WD = 344 * MiB;
constexpr size_t WS_TG = 392 * MiB;
constexpr size_t WS_BZ = 464 * MiB;
constexpr size_t WS_GLUT = 480 * MiB;
constexpr size_t WS_POOLT = WS_GLUT + 512 * 1024;
constexpr size_t WS_ZB = 482 * MiB;
constexpr size_t WS_P2B = 486 * MiB;
constexpr size_t WS_ML = 502 * MiB;
constexpr size_t WS_END = 508 * MiB;
constexpr int MOE_MAXT = 152;
constexpr size_t WS_XS = 66 * MiB;
constexpr size_t WS_HACT = 142 * MiB;
constexpr size_t WS_TOKB = 294 * MiB;
constexpr size_t WS_TOKR = WS_TOKB + 128 * 1024;
constexpr size_t WS_TOKW = WS_TOKB + 256 * 1024;
constexpr size_t WS_ROWTOK = 295 * MiB;
constexpr size_t WS_ROWW = WS_ROWTOK + 256 * 1024;
constexpr size_t WS_ROWR = WS_ROWTOK + 576 * 1024;
constexpr size_t WS_RS1 = WS_ROWTOK + 768 * 1024;
constexpr size_t WS_WGCNT = 296 * MiB;
constexpr size_t WS_TILEB = WS_WGCNT + 64 * 1024;

constexpr int CW_BAR = 4096;

__device__ __forceinline__ unsigned f2bf(float f) { unsigned u = __builtin_bit_cast(unsigned, f); return (u + 0x7fffu + ((u >> 16) & 1u)) >> 16; }
__device__ __forceinline__ float bf2f(unsigned h) { return __builtin_bit_cast(float, h << 16); }
__device__ __forceinline__ unsigned pk2(float lo, float hi) { return f2bf(lo) | (f2bf(hi) << 16); }
template <int O> __device__ __forceinline__ float xshfl(float v) {
    if constexpr (O < 32) return __builtin_bit_cast(float, __builtin_amdgcn_ds_swizzle(__builtin_bit_cast(int, v), (O << 10) | 0x1f));
    else { const unsigned u = __builtin_bit_cast(unsigned, v); auto r = __builtin_amdgcn_permlane32_swap(u, u, false, false);
           const float a = __builtin_bit_cast(float, (unsigned)r[0]), b = __builtin_bit_cast(float, (unsigned)r[1]); return (a == v && __builtin_bit_cast(unsigned, a) == u) ? b : a; }
}
__device__ __forceinline__ float wave_sum(float v) {
    v += xshfl<1>(v); v += xshfl<2>(v); v += xshfl<4>(v); v += xshfl<8>(v); v += xshfl<16>(v);
    const unsigned u = __builtin_bit_cast(unsigned, v); auto r = __builtin_amdgcn_permlane32_swap(u, u, false, false);
    return __builtin_bit_cast(float, (unsigned)r[0]) + __builtin_bit_cast(float, (unsigned)r[1]);
}
__device__ __forceinline__ float wave_max(float v) {
    v = fmaxf(v, xshfl<1>(v)); v = fmaxf(v, xshfl<2>(v)); v = fmaxf(v, xshfl<4>(v)); v = fmaxf(v, xshfl<8>(v)); v = fmaxf(v, xshfl<16>(v));
    const unsigned u = __builtin_bit_cast(unsigned, v); auto r = __builtin_amdgcn_permlane32_swap(u, u, false, false);
    return fmaxf(__builtin_bit_cast(float, (unsigned)r[0]), __builtin_bit_cast(float, (unsigned)r[1]));
}
__device__ __forceinline__ float gelu_tanh(float x) {
    const float u = 0.7978845608028654f * (x + 0.044715f * x * x * x);
    const float e = __expf(2.f * u);
    const float th = 1.f - 2.f / (e + 1.f);
    return 0.5f * x * (1.f + th);
}
__device__ __forceinline__ float sigmoidf_(float x) { return 1.f / (1.f + __expf(-x)); }

__device__ __forceinline__ int lane_id() { unsigned m; asm volatile("s_mov_b32 %0, -1" : "=s"(m)); return (int)__builtin_amdgcn_mbcnt_hi(m, __builtin_amdgcn_mbcnt_lo(m, 0u)); }

#define XB_TMO      128
#define XB_XCNT(j)  (256  + 64 * (j))
#define XB_XSUB(j)  (1280 + 64 * (j))
#define XB_XGEN(j)  (2304 + 64 * (j))
#define XB_TOP      3328
#define XB_TOPGEN   3392
#define XCD_BAR_WORDS 3456
#define XB_SPIN_CAP (1u << 22)
__device__ __forceinline__ unsigned xb_ld(unsigned* p)              { return __hip_atomic_load(p, __ATOMIC_RELAXED, __HIP_MEMORY_SCOPE_AGENT); }
__device__ __forceinline__ unsigned xb_add(unsigned* p, unsigned v) { return __hip_atomic_fetch_add(p, v, __ATOMIC_RELAXED, __HIP_MEMORY_SCOPE_AGENT); }
__device__ __forceinline__ unsigned xb_xcc_id() { return (unsigned)__builtin_amdgcn_s_getreg((3 << 11) | 20) & 0xFu; }
#define XB_SPIN(cond, bar) do { unsigned _sp = 0; while (cond) { __builtin_amdgcn_s_sleep(1); \
    if ((++_sp & 255u) == 0u) { if (xb_ld(&(bar)[XB_TMO])) break; if (_sp > XB_SPIN_CAP) { atomicAdd(&(bar)[XB_TMO], 1u); break; } } } } while (0)
struct XcdBarrier { unsigned* bar; unsigned x; volatile LAS unsigned* st; };
__device__ __forceinline__ XcdBarrier xcd_barrier_post(unsigned* bar, volatile LAS unsigned* st, bool t0) {
    XcdBarrier b; b.bar = bar; b.x = xb_xcc_id(); b.st = st;
    if (t0) (void)xb_add(&bar[XB_XCNT(b.x)], 1u);
    return b;
}
__device__ __forceinline__ void xcd_barrier_complete(unsigned* bar, unsigned x, unsigned& nloc, unsigned& nx) {
    const unsigned G = gridDim.x * gridDim.y * gridDim.z;
    unsigned sum, cnt, mine, sp = 0u;
    for (;;) {
        sum = 0u; cnt = 0u; mine = 0u;
#pragma unroll
        for (unsigned j = 0; j < 16; ++j) { const unsigned c = xb_ld(&bar[XB_XCNT(j)]); sum += c; cnt += (c > 0u) ? 1u : 0u; mine = (j == x) ? c : mine; }
        if (sum == G) break;
        __builtin_amdgcn_s_sleep(1);
        if ((++sp & 255u) == 0u) { if (xb_ld(&bar[XB_TMO])) break; if (sp > XB_SPIN_CAP) { atomicAdd(&bar[XB_TMO], 1u); break; } }
    }
    nloc = mine > 0u ? mine : 1u; nx = cnt > 0u ? cnt : 1u;
}
__device__ __forceinline__ void xcd_barrier(const XcdBarrier& b, int wave) {
    asm volatile("s_waitcnt vmcnt(0)" ::: "memory");
    __syncthreads();
    if (wave == 0 && lane_id() == 0) {
        unsigned* bar = b.bar;
        __builtin_amdgcn_s_waitcnt(0);
        unsigned nloc = b.st[0], nx = b.st[1];
        if (nloc == 0u) { xcd_barrier_complete(bar, b.x, nloc, nx); b.st[0] = nloc; b.st[1] = nx; }
        const unsigned old = xb_add(&bar[XB_XSUB(b.x)], 1u);
        const unsigned gen = old / nloc;
        if (old + 1u == (gen + 1u) * nloc) {
            __builtin_amdgcn_fence(__ATOMIC_RELEASE, "agent");
            asm volatile("s_waitcnt vmcnt(0)" ::: "memory");
            const unsigned og = xb_add(&bar[XB_TOP], 1u);
            const unsigned tg = og / nx;
            if (og + 1u == (tg + 1u) * nx) xb_add(&bar[XB_TOPGEN], 1u);
            else XB_SPIN(xb_ld(&bar[XB_TOPGEN]) == tg, bar);
            __builtin_amdgcn_fence(__ATOMIC_ACQUIRE, "agent");
            xb_add(&bar[XB_XGEN(b.x)], 1u);
            asm volatile("s_waitcnt vmcnt(0)" ::: "memory");
        } else {
            XB_SPIN(xb_ld(&bar[XB_XGEN(b.x)]) == gen, bar);
            __builtin_amdgcn_fence(__ATOMIC_ACQUIRE, "agent");
            asm volatile("s_waitcnt vmcnt(0)" ::: "memory");
        }
    }
    __syncthreads();
}

struct Args {
    const float* in[27];
    float* out;
    unsigned char* ws;
    int pad0, pad1;
};

typedef const float* fptr_t;
typedef __attribute__((address_space(4))) const fptr_t* KargP;
struct Ctx {
    LAS unsigned char* lds;
    int tid, lane, wave, vcu, G;
    KargP in;
    float* R;
    unsigned char* ws;
};
#define P_XB(F) ((bf16*)((F).ws + WS_XB))
#define P_UG(F) ((bf16*)((F).ws + WS_UG))
#define P_PB(F) ((bf16*)((F).ws + WS_PB))
#define P_QB(F) ((bf16*)((F).ws + WS_QB))
#define P_KB(F) ((bf16*)((F).ws + WS_KB))
#define P_VB(F) ((bf16*)((F).ws + WS_VB))
#define P_YMIX(F) ((bf16*)((F).ws + WS_YMIX))
#define P_YS(F) ((bf16*)((F).ws + WS_YS))
#define P_DL(F) ((bf16*)((F).ws + WS_DL))
#define P_KMP(F) ((float*)((F).ws + WS_KMP))
#define P_BT(F) ((float*)((F).ws + WS_BT))


__device__ __forceinline__ Ctx launder(const Ctx& F0) {
    Ctx F = F0;
    int ln = lane_id(); asm volatile("" : "+v"(ln));
    asm volatile("" : "+s"(F.wave), "+s"(F.vcu), "+s"(F.G));
    F.lane = ln; F.tid = F.wave * 64 + ln;
    KargP kp = (KargP)__builtin_amdgcn_kernarg_segment_ptr(); asm volatile("" : "+s"(kp));
    F.in = kp; F.R = (float*)kp[27]; F.ws = (unsigned char*)kp[28];
    return F;
}

__device__ __forceinline__ unsigned char* wsl(unsigned char* p) { asm volatile("" : "+s"(p)); return p; }
__device__ __forceinline__ int sl(int x) { asm volatile("" : "+s"(x)); return x; }

namespace pg8 {
typedef short bf16x8 __attribute__((ext_vector_type(8)));
constexpr int BM = 256, BK = 64, HALF = 128, HTB = HALF * BK * 2, STAGE_BYTES = 8 * HTB, NXCD = 8, WGM = 8;
__device__ __forceinline__ int lds_byte(int r, int c) { const int st = (r >> 4) * 2 + (c >> 5), rr = r & 15, cc = c & 31, ob = rr * 64 + cc * 2; return st * 1024 + (ob ^ (((ob >> 9) & 1) << 5)); }
__device__ __forceinline__ void stage_rc(int b, int& R, int& C) { const int st = b / 1024, sb = b % 1024, swz = sb ^ (((sb >> 9) & 1) << 5); R = (st >> 1) * 16 + swz / 64; C = (st & 1) * 32 + (swz % 64) / 2; }
__device__ __forceinline__ int perm32(int rho) { const int n = rho >> 4, i = rho & 15; return 8 * (i >> 2) + 4 * n + (i & 3); }

struct Unit { int pm, pn, aux; };
struct Gemm { const bf16* A; const bf16* Bt; int lda, ldb, K; };

struct StaticOrder {
    int nM, nN, nwg, G, c;
    __device__ void init(int M, int N, int G_, int c_) { nM = M / BM; nN = N / BM; nwg = nM * nN; G = G_; c = c_; }
    __device__ bool next(int i, Unit& u) const {
        const long L = (long)i * G + c; if (L >= nwg) return false;
        int wgid = (int)L; { const int q = nwg / NXCD, r = nwg % NXCD, xcd = wgid % NXCD, off = wgid / NXCD; wgid = (xcd < r ? xcd * (q + 1) : r * (q + 1) + (xcd - r) * q) + off; }
        const int nig = WGM * nN, gid = wgid / nig, fm = gid * WGM, gsz = (nM - fm) < WGM ? (nM - fm) : WGM;
        u.pm = fm + ((wgid % nig) % gsz); u.pn = (wgid % nig) / gsz; u.aux = 0; return true;
    }
};

__device__ __forceinline__ unsigned cvt_pk_bf16(float lo, float hi) { unsigned r; asm volatile("v_cvt_pk_bf16_f32 %0, %1, %2" : "=v"(r) : "v"(lo), "v"(hi)); return r; }

template <bool ALIGN = true, class Epi, class Sched>
__device__ __forceinline__ void gemm_phase(LAS unsigned char* lds, const Gemm g, const Sched& S, const Epi& E, int wave_) {
    int lane_ = lane_id(); asm volatile("" : "+v"(lane_)); asm volatile("" : "+s"(wave_));
    const int wid = wave_, lane = lane_, tid = wid * 64 + lane, wr = wid >> 2, wc = wid & 3, fr = lane & 15, fq = lane >> 4;
    const int K = g.K, nt = K / BK;
    unsigned voffA[2], voffB[2];
#pragma unroll
    for (int i = 0; i < 2; ++i) { int R, C; stage_rc(tid * 16 + i * 8192, R, C); const int Rb = Epi::PERM ? ((R & ~31) + perm32(R & 31)) : R;
        voffA[i] = (unsigned)(R * g.lda + C) * 2u; voffB[i] = (unsigned)(Rb * g.ldb + C) * 2u; }
    const size_t kstep = (size_t)(BK * 2);
    const size_t hstepA = (size_t)HALF * g.lda * 2, hstepB = (size_t)HALF * g.ldb * 2;
    const size_t tstepA = 2 * hstepA, tstepB = 2 * hstepB;
    const unsigned ldsw = (unsigned)wid * 1024u;
    const int aoff = lds_byte(wr * 64 + fr, fq * 8), boff = lds_byte(wc * 32 + fr, fq * 8);
#define PG8_SA(b, h) (((b) * 2 + (h)) * HTB)
#define PG8_SB(b, h) ((4 + (b) * 2 + (h)) * HTB)
#define PG8_STAGE(bufoff, gbase, voff) do { _Pragma("unroll") for (int _i = 0; _i < 2; ++_i) \
        __builtin_amdgcn_global_load_lds((const unsigned*)((const char*)(gbase) + (voff)[_i]), (LAS unsigned*)(lds + (bufoff) + ldsw + _i * 8192), 16, 0, 0); } while (0)
#define PG8_LDA(dst, b, h) do { _Pragma("unroll") for (int m = 0; m < 4; ++m) _Pragma("unroll") for (int k = 0; k < 2; ++k) dst[m][k] = *(const LAS bf16x8*)(lds + PG8_SA(b, h) + aoff + m * 2048 + k * 1024); } while (0)
#define PG8_LDB(dst, b, h) do { _Pragma("unroll") for (int n = 0; n < 2; ++n) _Pragma("unroll") for (int k = 0; k < 2; ++k) dst[n][k] = *(const LAS bf16x8*)(lds + PG8_SB(b, h) + boff + n * 2048 + k * 1024); } while (0)
#define PG8_MMA(ai, bj, At, Bt) do { __builtin_amdgcn_s_setprio(1); _Pragma("unroll") for (int m = 0; m < 4; ++m) _Pragma("unroll") for (int n = 0; n < 2; ++n) _Pragma("unroll") for (int k = 0; k < 2; ++k) \
        acc[ai][bj][m][n] = __builtin_amdgcn_mfma_f32_16x16x32_bf16(Bt[n][k], At[m][k], acc[ai][bj][m][n], 0, 0, 0); __builtin_amdgcn_s_setprio(0); } while (0)
#define PG8_WAIT_V(n) asm volatile("s_waitcnt vmcnt(" #n ")" ::: "memory")
#define PG8_WAIT_L(n) asm volatile("s_waitcnt lgkmcnt(" #n ")" ::: "memory")
#define PG8_BAR __builtin_amdgcn_s_barrier()
#define PG8_SCHED __builtin_amdgcn_sched_barrier(0)
    Unit cur, nxt; int ui = 0;
    if (!S.next(0, cur)) return;
    f32x4 acc[2][2][4][2];
#pragma unroll
    for (int a = 0; a < 2; ++a)
#pragma unroll
        for (int b = 0; b < 2; ++b)
#pragma unroll
            for (int m = 0; m < 4; ++m)
#pragma unroll
                for (int n = 0; n < 2; ++n) acc[a][b][m][n] = (f32x4){0.f, 0.f, 0.f, 0.f};
    bf16x8 At[4][2], B0[2][2], B1[2][2];
    const char* cA = (const char*)g.A + (size_t)cur.pm * tstepA; const char* cB = (const char*)g.Bt + (size_t)cur.pn * tstepB;
    PG8_STAGE(PG8_SB(0, 0), cB, voffB); PG8_STAGE(PG8_SB(0, 1), cB + hstepB, voffB); PG8_STAGE(PG8_SA(0, 0), cA, voffA); PG8_STAGE(PG8_SA(0, 1), cA + hstepA, voffA);
    if (wr == 1) PG8_BAR;
    PG8_WAIT_V(2); PG8_BAR;
    PG8_STAGE(PG8_SB(1, 0), cB + kstep, voffB); PG8_STAGE(PG8_SA(1, 0), cA + kstep, voffA); PG8_STAGE(PG8_SB(1, 1), cB + hstepB + kstep, voffB);
    PG8_WAIT_V(6); PG8_BAR;
    for (;;) {
        const bool has_next = S.next(ui + 1, nxt);
        const char* nA = has_next ? (const char*)g.A + (size_t)nxt.pm * tstepA : cA; const char* nB = has_next ? (const char*)g.Bt + (size_t)nxt.pn * tstepB : cB;
        for (int t = 0; t < nt; t += 2) {
            const bool last = (t == nt - 2);
            const char* a1 = cA + (size_t)(t + 1) * kstep;
            const char* a2 = last ? nA : cA + (size_t)(t + 2) * kstep; const char* b2 = last ? nB : cB + (size_t)(t + 2) * kstep;
            const char* a3 = a2 + kstep; const char* b3 = b2 + kstep;
            PG8_LDB(B0, 0, 0); PG8_LDB(B1, 0, 1); PG8_SCHED; PG8_LDA(At, 0, 0); PG8_STAGE(PG8_SA(1, 1), a1 + hstepA, voffA);
            PG8_WAIT_V(8); PG8_WAIT_L(0); PG8_BAR; PG8_MMA(0, 0, At, B0); PG8_MMA(0, 1, At, B1); PG8_BAR; PG8_SCHED;
            PG8_LDA(At, 0, 1); PG8_STAGE(PG8_SB(0, 0), b2, voffB); PG8_STAGE(PG8_SB(0, 1), b2 + hstepB, voffB); PG8_STAGE(PG8_SA(0, 0), a2, voffA);
            PG8_WAIT_V(8); PG8_WAIT_L(0); PG8_BAR; PG8_MMA(1, 0, At, B0); PG8_MMA(1, 1, At, B1); PG8_BAR; PG8_SCHED;
            PG8_LDB(B0, 1, 0); PG8_LDB(B1, 1, 1); PG8_SCHED; PG8_LDA(At, 1, 0); PG8_STAGE(PG8_SA(0, 1), a2 + hstepA, voffA);
            PG8_WAIT_V(8); PG8_WAIT_L(0); PG8_BAR; PG8_MMA(0, 0, At, B0); PG8_MMA(0, 1, At, B1); PG8_BAR; PG8_SCHED;
            PG8_LDA(At, 1, 1); PG8_STAGE(PG8_SB(1, 0), b3, voffB); PG8_STAGE(PG8_SB(1, 1), b3 + hstepB, voffB); PG8_STAGE(PG8_SA(1, 0), a3, voffA);
            PG8_WAIT_V(8); PG8_WAIT_L(0); PG8_BAR; PG8_MMA(1, 0, At, B0); PG8_MMA(1, 1, At, B1); PG8_BAR; PG8_SCHED;
        }
        if constexpr (ALIGN) { if (wr == 0) PG8_BAR; }
        E(acc, cur, wr, wc, fr, fq);
        if (!has_next) break;
#pragma unroll
        for (int a = 0; a < 2; ++a)
#pragma unroll
            for (int b = 0; b < 2; ++b)
#pragma unroll
                for (int m = 0; m < 4; ++m)
#pragma unroll
                    for (int n = 0; n < 2; ++n) acc[a][b][m][n] = (f32x4){0.f, 0.f, 0.f, 0.f};
        cur = nxt; cA = nA; cB = nB; ++ui;
        if constexpr (ALIGN) { if (wr == 1) PG8_BAR; }
    }
    PG8_WAIT_V(0);
    if constexpr (!ALIGN) { if (wr == 0) PG8_BAR; }
    PG8_BAR;
#undef PG8_SA
#undef PG8_SB
#undef PG8_STAGE
#undef PG8_LDA
#undef PG8_LDB
#undef PG8_MMA
#undef PG8_WAIT_V
#undef PG8_WAIT_L
#undef PG8_BAR
#undef PG8_SCHED
}
}


struct EpiProjE {
    static constexpr bool PERM = true;
    bf16 *UG, *PB, *QB, *KB, *VB; float* KMP; const float* rs1;
    __device__ __forceinline__ void operator()(const f32x4 (&acc_)[2][2][4][2], const pg8::Unit& u, int wr, int wc, int fr_, int fq_) const {
        const int ln_ = lane_id(), fr = ln_ & 15, fq = ln_ >> 4; (void)fr_; (void)fq_;
        const int pn = u.pn, row0 = u.pm * 256 + wr * 64 + fr, cl = wc * 32 + 8 * fq;
        f32x4 acc[2][2][4][2];
#pragma unroll
        for (int ai = 0; ai < 2; ++ai)
#pragma unroll
            for (int m = 0; m < 4; ++m) { const float rs = rs1[row0 + ai * 128 + m * 16];
#pragma unroll
                for (int bj = 0; bj < 2; ++bj) { acc[ai][bj][m][0] = acc_[ai][bj][m][0] * rs; acc[ai][bj][m][1] = acc_[ai][bj][m][1] * rs; } }
        if (pn == 0) {
#pragma unroll
            for (int ai = 0; ai < 2; ++ai)
#pragma unroll
                for (int m = 0; m < 4; ++m) { const int r = row0 + ai * 128 + m * 16;
#pragma unroll
                    for (int bj = 0; bj < 2; ++bj) { const int ch = bj * 128 + cl, g = ch >> 4, h0 = ch & 15;
                        const f32x4 v0 = acc[ai][bj][m][0], v1 = acc[ai][bj][m][1]; u32x4 w;
                        w.x = pg8::cvt_pk_bf16(v0[0], v0[1]); w.y = pg8::cvt_pk_bf16(v0[2], v0[3]); w.z = pg8::cvt_pk_bf16(v1[0], v1[1]); w.w = pg8::cvt_pk_bf16(v1[2], v1[3]);
                        *(u32x4*)(UG + ((size_t)(g * 512 + (r >> 6))) * UGP + (r & 63) * 16 + h0) = w; } }
        } else {
            bf16* base; int ldc, colt; float sc = 1.f;
            if (pn == 1) { base = PB; ldc = 256; colt = 0; }
            else if (pn < 4) { base = QB; ldc = 512; colt = (pn - 2) * 256; sc = C2; }
            else if (pn < 6) { base = KB; ldc = 512; colt = (pn - 4) * 256; }
            else { base = VB; ldc = 512; colt = (pn - 6) * 256; }
#pragma unroll
            for (int ai = 0; ai < 2; ++ai)
#pragma unroll
                for (int m = 0; m < 4; ++m) { bf16* rowp = base + (size_t)(row0 + ai * 128 + m * 16) * ldc + colt + cl;
#pragma unroll
                    for (int bj = 0; bj < 2; ++bj) { const f32x4 v0 = acc[ai][bj][m][0] * sc, v1 = acc[ai][bj][m][1] * sc; u32x4 w;
                        w.x = pg8::cvt_pk_bf16(v0[0], v0[1]); w.y = pg8::cvt_pk_bf16(v0[2], v0[3]); w.z = pg8::cvt_pk_bf16(v1[0], v1[1]); w.w = pg8::cvt_pk_bf16(v1[2], v1[3]);
                        *(u32x4*)(rowp + bj * 128) = w; } }
            if (pn >= 4 && pn < 6) {
#pragma unroll
                for (int bj = 0; bj < 2; ++bj)
#pragma unroll
                    for (int n = 0; n < 2; ++n) { f32x4 s = (f32x4){0.f, 0.f, 0.f, 0.f};
#pragma unroll
                        for (int ai = 0; ai < 2; ++ai)
#pragma unroll
                            for (int m = 0; m < 4; ++m) s += acc[ai][bj][m][n];
#pragma unroll
                        for (int i = 0; i < 4; ++i) { float t = s[i]; t += xshfl<1>(t); t += xshfl<2>(t); t += xshfl<4>(t); t += xshfl<8>(t); s[i] = t; }
                        if (fr == 0) *(f32x4*)(KMP + (size_t)wr * 128 * 512 + (size_t)u.pm * 512 + colt + bj * 128 + cl + 4 * n) = s; }
            }
        }
    }
};
struct EpiOutE {
    static constexpr bool PERM = true;
    bf16* RB;
    __device__ __forceinline__ void operator()(const f32x4 (&acc)[2][2][4][2], const pg8::Unit& u, int wr, int wc, int fr_, int fq_) const {
        const int ln_ = lane_id(), fr = ln_ & 15, fq = ln_ >> 4; (void)fr_; (void)fq_;
        const int row0 = u.pm * 256 + wr * 64 + fr, col0 = u.pn * 256 + wc * 32 + 8 * fq;
#pragma unroll
        for (int ai = 0; ai < 2; ++ai) { u32x4 x[4][2];
#pragma unroll
            for (int m = 0; m < 4; ++m) { const bf16* rp = RB + (size_t)(row0 + ai * 128 + m * 16) * D + col0; x[m][0] = *(const u32x4*)rp; x[m][1] = *(const u32x4*)(rp + 128); }
#pragma unroll
            for (int m = 0; m < 4; ++m) { bf16* rp = RB + (size_t)(row0 + ai * 128 + m * 16) * D + col0;
#pragma unroll
                for (int bj = 0; bj < 2; ++bj) { const u32x4 xx = x[m][bj]; const f32x4 a0 = acc[ai][bj][m][0], a1 = acc[ai][bj][m][1]; u32x4 w;
                    w.x = pg8::cvt_pk_bf16(bf2f(xx.x & 0xffffu) + a0[0], bf2f(xx.x >> 16) + a0[1]); w.y = pg8::cvt_pk_bf16(bf2f(xx.y & 0xffffu) + a0[2], bf2f(xx.y >> 16) + a0[3]);
                    w.z = pg8::cvt_pk_bf16(bf2f(xx.z & 0xffffu) + a1[0], bf2f(xx.z >> 16) + a1[1]); w.w = pg8::cvt_pk_bf16(bf2f(xx.w & 0xffffu) + a1[2], bf2f(xx.w >> 16) + a1[3]);
                    *(u32x4*)(rp + bj * 128) = w; } }
            asm volatile("" ::: "memory"); }
    }
};

__device__ __forceinline__ void transpose_item(const float* W, int K, int N, const float* kscale, bf16* WT, int ldo, int koff, int rowmode, LAS float* scr, int item, int lane) {
    const int nblk = N / 32, kb = item / nblk, nb = item % nblk, k0 = 64 * kb, n0 = 32 * nb;
    { const int r8 = lane >> 3, c4 = lane & 7; f32x4 v[8];
#pragma unroll
      for (int i = 0; i < 8; ++i) v[i] = *(const f32x4*)(W + (size_t)(k0 + 8 * i + r8) * N + n0 + 4 * c4);
#pragma unroll
      for (int i = 0; i < 8; ++i) { const int kk = 8 * i + r8; const float s = kscale ? kscale[k0 + kk] : 1.f; LAS float* d = scr + kk * 33 + 4 * c4;
          d[0] = v[i][0] * s; d[1] = v[i][1] * s; d[2] = v[i][2] * s; d[3] = v[i][3] * s; } }
    asm volatile("s_waitcnt lgkmcnt(0)" ::: "memory");
    const int c = lane & 7;
#pragma unroll
    for (int j = 0; j < 4; ++j) { const int n = (lane >> 3) + 8 * j; const LAS float* s = scr + (8 * c) * 33 + n;
        u32x4 o; o.x = pk2(s[0 * 33], s[1 * 33]); o.y = pk2(s[2 * 33], s[3 * 33]); o.z = pk2(s[4 * 33], s[5 * 33]); o.w = pk2(s[6 * 33], s[7 * 33]);
        const int nn = n0 + n, row = rowmode == 0 ? nn : (8 * (nn >> 2) + (nn & 3) + (rowmode == 2 ? 4 : 0));
        *(u32x4*)(WT + (size_t)row * ldo + koff + k0 + 8 * c) = o; }
    asm volatile("s_waitcnt lgkmcnt(0)" ::: "memory");
}
__device__ __forceinline__ void pair_decode(int pi, int& ea, int& eb) { ea = pi < 3 ? 0 : (pi < 5 ? 1 : 2); eb = pi < 3 ? pi + 1 : (pi < 5 ? pi - 1 : 3); }
__device__ __forceinline__ void ph_prologue(const Ctx& F0) {
    const Ctx F = launder(F0);
    LAS float* scr = (LAS float*)(F.lds + F.wave * 16384);
    const int gw = F.vcu * NWAVES + F.wave, NGW = F.G * NWAVES;
    constexpr int I_IN = (D / 64) * (NPROJ / 32), I_OUT = (D / 64) * (D / 32), I_GU1 = (D / 64) * (256 / 32), I_GU = 16 * 2 * I_GU1, I_WD1 = (256 / 64) * (D / 32), I_WD = 24 * 2 * I_WD1;
    constexpr int I_L = I_IN + I_OUT + I_GU + I_WD;
    for (int it = gw; it < DEPTH * I_L; it += NGW) {
        const int l = it / I_L; int r = it % I_L;
        if (r < I_IN) { transpose_item(F.in[3] + (size_t)l * D * NPROJ, D, NPROJ, F.in[2] + l * D, (bf16*)(F.ws + WS_WIN) + (size_t)l * NPROJ * D, D, 0, 0, scr, r, F.lane); continue; } r -= I_IN;
        if (r < I_OUT) { transpose_item(F.in[17] + (size_t)l * D * D, D, D, nullptr, (bf16*)(F.ws + WS_WOUT) + (size_t)l * D * D, D, 0, 0, scr, r, F.lane); continue; } r -= I_OUT;
        if (r < I_GU) { const int e = r / (2 * I_GU1), up = (r / I_GU1) & 1, item = r % I_GU1;
            transpose_item(F.in[up ? 24 : 23] + ((size_t)l * 16 + e) * D * 256, D, 256, F.in[18] + l * D, (bf16*)(F.ws + WS_GU) + ((size_t)l * 16 + e) * 512 * D, D, 0, 1 + up, scr, item, F.lane); continue; } r -= I_GU;
        { const int bk = r / (2 * I_WD1), half = (r / I_WD1) & 1, item = r % I_WD1, g = bk / 6; int ea, eb; pair_decode(bk % 6, ea, eb); const int e = g * 4 + (half ? eb : ea);
            transpose_item(F.in[25] + ((size_t)l * 16 + e) * 256 * D, 256, D, nullptr, (bf16*)(F.ws + WS_WD) + ((size_t)l * 24 + bk) * D * 512, 512, half * 256, 0, scr, item, F.lane); }
    }
    for (int it = gw; it < DEPTH * 32; it += NGW) { const int l = it >> 5;
        transpose_item(F.in[12] + (size_t)l * 256 * 256, 256, 256, nullptr, (bf16*)(F.ws + WS_GLUT) + (size_t)l * 65536, 256, 0, 0, scr, it & 31, F.lane); }
    { const int gt = F.vcu * NTHREADS + F.tid, NGT = F.G * NTHREADS;
      for (int i = gt; i < DEPTH * 65536; i += NGT) { const int l = i >> 16, n = (i >> 8) & 255, k = i & 255;
          const float v = ((n >> 6) == (k >> 6)) ? F.in[14][(((size_t)l * 4 + (n >> 6)) * 64 + (k & 63)) * 64 + (n & 63)] : 0.f;
          ((bf16*)(F.ws + WS_POOLT))[i] = (bf16)f2bf(v); } }
    for (int it = gw; it < DEPTH * SGN * 65; it += NGW) {
        const int l = it / (SGN * 65), g = (it / 65) % SGN, tau = it % 65, p = F.lane;
        const float are = F.in[4][(l * SGN + g) * SP + p], aim = F.in[5][(l * SGN + g) * SP + p], dt = expf(F.in[6][l * SGN + g]);
        float sn, cs; sincosf(aim * dt, &sn, &cs); const float mg = expf(are * dt), lbr = mg * cs, lbi = mg * sn;
        const float nr = lbr - 1.f, ni = lbi, den = are * are + aim * aim, cr = (nr * are + ni * aim) / den, ci = (ni * are - nr * aim) / den;
        float sn2, cs2; sincosf(aim * dt * (float)tau, &sn2, &cs2); const float mg2 = expf(are * dt * (float)tau), lr = mg2 * cs2, li = mg2 * sn2;
        float wr[16], wi[16];
#pragma unroll
        for (int h = 0; h < 16; ++h) { const float br = F.in[7][((size_t)(l * SGN + g) * SP + p) * SG + h], bi = F.in[8][((size_t)(l * SGN + g) * SP + p) * SG + h];
            const float bbr = cr * br - ci * bi, bbi = cr * bi + ci * br; wr[h] = lr * bbr - li * bbi; wi[h] = lr * bbi + li * bbr; }
        bf16* TG = (bf16*)(F.ws + WS_TG) + ((size_t)l * SGN + g) * 1024 * UGP;
        if (tau <= 63) {
            bf16* BZ = (bf16*)(F.ws + WS_BZ) + ((size_t)l * SGN + g) * 256 * 1024; const int s = 63 - tau;
            u32x4 o0, o1, o2, o3;
            o0.x = pk2(wr[0], wr[1]); o0.y = pk2(wr[2], wr[3]); o0.z = pk2(wr[4], wr[5]); o0.w = pk2(wr[6], wr[7]); o1.x = pk2(wr[8], wr[9]); o1.y = pk2(wr[10], wr[11]); o1.z = pk2(wr[12], wr[13]); o1.w = pk2(wr[14], wr[15]);
            o2.x = pk2(wi[0], wi[1]); o2.y = pk2(wi[2], wi[3]); o2.z = pk2(wi[4], wi[5]); o2.w = pk2(wi[6], wi[7]); o3.x = pk2(wi[8], wi[9]); o3.y = pk2(wi[10], wi[11]); o3.z = pk2(wi[12], wi[13]); o3.w = pk2(wi[14], wi[15]);
            *(u32x4*)(BZ + (size_t)p * 1024 + s * 16) = o0; *(u32x4*)(BZ + (size_t)p * 1024 + s * 16 + 8) = o1;
            *(u32x4*)(BZ + (size_t)(64 + p) * 1024 + s * 16) = o2; *(u32x4*)(BZ + (size_t)(64 + p) * 1024 + s * 16 + 8) = o3;
        }
        LAS float* Wst = scr; LAS float* Kt = scr + 128 * 16;
        if (tau <= 63) {
#pragma unroll
            for (int q = 0; q < 4; ++q) { *(LAS f32x4*)(Wst + p * 16 + 4 * q) = (f32x4){wr[4 * q], wr[4 * q + 1], wr[4 * q + 2], wr[4 * q + 3]};
                                          *(LAS f32x4*)(Wst + (64 + p) * 16 + 4 * q) = (f32x4){wi[4 * q], wi[4 * q + 1], wi[4 * q + 2], wi[4 * q + 3]}; }
            const int arow = p & 15, kq = p >> 4; f32x4 kacc = (f32x4){0.f, 0.f, 0.f, 0.f};
            const float* cre = F.in[9] + ((size_t)(l * SGN + g) * SG + arow) * SP; const float* cim = F.in[10] + ((size_t)(l * SGN + g) * SG + arow) * SP;
#pragma unroll 8
            for (int s = 0; s < 32; ++s) { const int k = 4 * s + kq; const float av = (k < 64) ? cre[k] : -cim[k - 64]; const float bv = Wst[k * 16 + arow];
                kacc = __builtin_amdgcn_mfma_f32_16x16x4f32(av, bv, kacc, 0, 0, 0); }
#pragma unroll
            for (int r = 0; r < 4; ++r) Kt[(4 * kq + r) * 16 + arow] = kacc[r];
            asm volatile("s_waitcnt lgkmcnt(0)" ::: "memory");
            const f32x4 t4 = *(const LAS f32x4*)(Kt + 4 * p);
            u32x2 o; o.x = pk2(t4[0], t4[1]); o.y = pk2(t4[2], t4[3]);
            *(u32x2*)((bf16*)(F.ws + WS_KT) + ((size_t)(l * SGN + g) * 64 + tau) * 256 + 4 * p) = o;
        }
        if (tau >= 1) {
#pragma unroll 4
            for (int ho = 0; ho < 16; ++ho) {
                const float ccr = F.in[9][((size_t)(l * SGN + g) * SG + ho) * SP + p], cci = F.in[10][((size_t)(l * SGN + g) * SG + ho) * SP + p];
                const int n = (tau - 1) * 16 + ho;
                TG[(size_t)n * UGP + 1024 + p] = (bf16)f2bf(ccr * lr - cci * li); TG[(size_t)n * UGP + 1088 + p] = (bf16)f2bf(-(ccr * li + cci * lr)); }
        }
    }
}

__device__ __forceinline__ void route_finish(const float (&a)[20], float ssum, int m, bool act, const float* gb_, const float* rb_, int* tokb, float* tokr, float* tokw, LAS int* hist) {
        const float rstd = 1.f / sqrtf(ssum * (1.f / D) + RMS_EPS);
        float lg0 = a[0] * rstd + gb_[0], lg1 = a[1] * rstd + gb_[1], lg2 = a[2] * rstd + gb_[2], lg3 = a[3] * rstd + gb_[3];
        int gs = 0; float gm = lg0;
        if (lg1 > gm) { gm = lg1; gs = 1; } if (lg2 > gm) { gm = lg2; gs = 2; } if (lg3 > gm) { gm = lg3; gs = 3; }
        const float gwt = 1.f / (__expf(lg0 - gm) + __expf(lg1 - gm) + __expf(lg2 - gm) + __expf(lg3 - gm));
        float q0 = a[4], q1 = a[5], q2 = a[6], q3 = a[7], q4 = a[8], q5 = a[9], q6 = a[10], q7 = a[11], q8 = a[12], q9 = a[13], q10 = a[14], q11 = a[15], q12 = a[16], q13 = a[17], q14 = a[18], q15 = a[19];
        asm volatile("" : "+v"(q0), "+v"(q1), "+v"(q2), "+v"(q3), "+v"(q4), "+v"(q5), "+v"(q6), "+v"(q7));
        asm volatile("" : "+v"(q8), "+v"(q9), "+v"(q10), "+v"(q11), "+v"(q12), "+v"(q13), "+v"(q14), "+v"(q15));
        float e0 = gs == 0 ? q0 : gs == 1 ? q4 : gs == 2 ? q8 : q12;
        float e1 = gs == 0 ? q1 : gs == 1 ? q5 : gs == 2 ? q9 : q13;
        float e2 = gs == 0 ? q2 : gs == 1 ? q6 : gs == 2 ? q10 : q14;
        float e3 = gs == 0 ? q3 : gs == 1 ? q7 : gs == 2 ? q11 : q15;
        e0 = e0 * rstd + rb_[gs * 4 + 0]; e1 = e1 * rstd + rb_[gs * 4 + 1]; e2 = e2 * rstd + rb_[gs * 4 + 2]; e3 = e3 * rstd + rb_[gs * 4 + 3];
        int t1 = 0; float v1 = e0;
        if (e1 > v1) { v1 = e1; t1 = 1; } if (e2 > v1) { v1 = e2; t1 = 2; } if (e3 > v1) { v1 = e3; t1 = 3; }
        int t2 = -1; float v2 = -3.0e38f;
        if (t1 != 0 && e0 > v2) { v2 = e0; t2 = 0; } if (t1 != 1 && e1 > v2) { v2 = e1; t2 = 1; } if (t1 != 2 && e2 > v2) { v2 = e2; t2 = 2; } if (t1 != 3 && e3 > v2) { v2 = e3; t2 = 3; }
        const float p2 = __expf(v2 - v1), w1 = gwt / (1.f + p2), w2 = gwt * p2 / (1.f + p2);
        const int lo = t1 < t2 ? t1 : t2, hi = t1 < t2 ? t2 : t1; const float wlo = t1 < t2 ? w1 : w2, whi = t1 < t2 ? w2 : w1;
        const int pi = lo == 0 ? hi - 1 : (lo == 1 ? hi + 1 : 5), bk = gs * 6 + pi;
        if (act) { tokb[m] = bk; tokr[m] = rstd; tokw[2 * m] = wlo; tokw[2 * m + 1] = whi; __hip_atomic_fetch_add(hist + bk, 1, __ATOMIC_RELAXED, __HIP_MEMORY_SCOPE_WORKGROUP); }
}
__device__ __forceinline__ void ph_route(const Ctx& F0, int l) {
    const Ctx F = launder(F0);
    constexpr int WLD = 1032;
    LAS bf16* Wh = (LAS bf16*)F.lds;
    LAS bf16* Wlo = Wh + 20 * WLD;
    LAS float* LG = (LAS float*)(F.lds + 4 * 20 * WLD);
    LAS int* hist = (LAS int*)(F.lds + 4 * 20 * WLD + 8 * 320 * 4);
    const float* g2 = F.in[18] + l * D;
    const f32x4* gw4 = (const f32x4*)(F.in[19] + (size_t)l * D * 4); const f32x4* rw4 = (const f32x4*)(F.in[21] + (size_t)l * 4 * D * 4);
    const float* gb_ = F.in[20] + l * 4; const float* rb_ = F.in[22] + l * 16;
    for (int idx = F.tid; idx < D * 5; idx += NTHREADS) { const int k = idx % D, q = idx / D;
        f32x4 v = (q == 0) ? gw4[k] : rw4[(q - 1) * D + k]; v = v * g2[k];
#pragma unroll
        for (int i = 0; i < 4; ++i) { const unsigned h = f2bf(v[i]); Wh[(q * 4 + i) * WLD + k] = (bf16)h; Wlo[(q * 4 + i) * WLD + k] = (bf16)f2bf(v[i] - bf2f(h)); } }
    if (F.tid < 32) hist[F.tid] = 0;
    __syncthreads();
    int* tokb = (int*)(F.ws + WS_TOKB); float* tokr = (float*)(F.ws + WS_TOKR); float* tokw = (float*)(F.ws + WS_TOKW);
    const int i16 = F.lane & 15, kq = F.lane >> 4, m0 = F.vcu * 128 + F.wave * 16;
    const u32x4* xr = (const u32x4*)(P_XB(F) + (size_t)(m0 + i16) * D) + kq;
    const int c1 = 16 + (i16 & 3);
    const LAS bf16* bh0 = Wh + i16 * WLD + 8 * kq; const LAS bf16* bl0 = Wlo + i16 * WLD + 8 * kq;
    const LAS bf16* bh1 = Wh + c1 * WLD + 8 * kq;  const LAS bf16* bl1 = Wlo + c1 * WLD + 8 * kq;
    f32x4 acc0 = (f32x4){0.f, 0.f, 0.f, 0.f}, acc1 = acc0; float ss = 0.f;
#pragma unroll 4
    for (int c = 0; c < 32; ++c) {
        const u32x4 xa = xr[4 * c];
        const float x0 = bf2f(xa.x & 0xffffu), x1 = __builtin_bit_cast(float, xa.x & 0xffff0000u), x2 = bf2f(xa.y & 0xffffu), x3 = __builtin_bit_cast(float, xa.y & 0xffff0000u);
        const float x4 = bf2f(xa.z & 0xffffu), x5 = __builtin_bit_cast(float, xa.z & 0xffff0000u), x6 = bf2f(xa.w & 0xffffu), x7 = __builtin_bit_cast(float, xa.w & 0xffff0000u);
        ss += ((x0 * x0 + x1 * x1) + (x2 * x2 + x3 * x3)) + ((x4 * x4 + x5 * x5) + (x6 * x6 + x7 * x7));
        const pg8::bf16x8 av = __builtin_bit_cast(pg8::bf16x8, xa);
        const pg8::bf16x8 h0 = *(const LAS pg8::bf16x8*)(bh0 + 32 * c), l0 = *(const LAS pg8::bf16x8*)(bl0 + 32 * c);
        const pg8::bf16x8 h1 = *(const LAS pg8::bf16x8*)(bh1 + 32 * c), l1 = *(const LAS pg8::bf16x8*)(bl1 + 32 * c);
        acc0 = __builtin_amdgcn_mfma_f32_16x16x32_bf16(av, h0, acc0, 0, 0, 0); acc1 = __builtin_amdgcn_mfma_f32_16x16x32_bf16(av, h1, acc1, 0, 0, 0);
        acc0 = __builtin_amdgcn_mfma_f32_16x16x32_bf16(av, l0, acc0, 0, 0, 0); acc1 = __builtin_amdgcn_mfma_f32_16x16x32_bf16(av, l1, acc1, 0, 0, 0);
    }
    ss += xshfl<16>(ss);
    { const unsigned u = __builtin_bit_cast(unsigned, ss); auto r = __builtin_amdgcn_permlane32_swap(u, u, false, false);
      ss = __builtin_bit_cast(float, (unsigned)r[0]) + __builtin_bit_cast(float, (unsigned)r[1]); }
    LAS float* lg = LG + F.wave * 320;
#pragma unroll
    for (int r = 0; r < 4; ++r) { lg[(4 * kq + r) * 20 + i16] = acc0[r]; if (i16 < 4) lg[(4 * kq + r) * 20 + 16 + i16] = acc1[r]; }
    asm volatile("s_waitcnt lgkmcnt(0)" ::: "memory");
    float a[20];
#pragma unroll
    for (int j = 0; j < 5; ++j) { const f32x4 t4 = *(const LAS f32x4*)(lg + i16 * 20 + 4 * j); a[4 * j] = t4[0]; a[4 * j + 1] = t4[1]; a[4 * j + 2] = t4[2]; a[4 * j + 3] = t4[3]; }
    route_finish(a, ss, m0 + i16, kq == 0, gb_, rb_, tokb, tokr, tokw, hist);
    __syncthreads();
    if (F.tid < 24) __hip_atomic_store((int*)(F.ws + WS_WGCNT) + F.vcu * 24 + F.tid, hist[F.tid], __ATOMIC_RELAXED, __HIP_MEMORY_SCOPE_AGENT);
}
__device__ __forceinline__ void ph_place(const Ctx& F0) {
    const Ctx F = launder(F0);
    LAS int* ptot = (LAS int*)F.lds;
    LAS int* pbef = ptot + 512;
    LAS int* bstart = pbef + 512;
    LAS int* btot = bstart + 32;
    LAS int* carry = btot + 32;
    LAS int* rowidx = carry + 32;
    const int* wgcnt = (const int*)(F.ws + WS_WGCNT);
    int* rowtok = (int*)(F.ws + WS_ROWTOK); float* roww = (float*)(F.ws + WS_ROWW); int* tileb = (int*)(F.ws + WS_TILEB);
    const int* tokb = (const int*)(F.ws + WS_TOKB); const float* tokr = (const float*)(F.ws + WS_TOKR); const float* tokw = (const float*)(F.ws + WS_TOKW);
    { const int p = F.tid >> 5, b = F.tid & 31; int tot = 0, bef = 0;
      if (b < 24) for (int v = p * 16; v < p * 16 + 16; ++v) { const int c = wgcnt[v * 24 + b]; tot += c; if (v < F.vcu) bef += c; }
      ptot[p * 32 + b] = tot; pbef[p * 32 + b] = bef; }
    __syncthreads();
    if (F.tid < 32) { int tot = 0, bef = 0; for (int p = 0; p < 16; ++p) { tot += ptot[p * 32 + F.tid]; bef += pbef[p * 32 + F.tid]; } btot[F.tid] = tot; carry[F.tid] = bef; }
    __syncthreads();
    if (F.tid == 0) { int s = 0; for (int b = 0; b < 24; ++b) { bstart[b] = s; s += (btot[b] + 255) & ~255; } bstart[24] = s; }
    __syncthreads();
    if (F.tid < 24) carry[F.tid] += bstart[F.tid];
    if (F.vcu == 0) {
        if (F.tid == 0) tileb[0] = bstart[24] >> 8;
        for (int b = 0; b < 24; ++b) { const int s = bstart[b], e = bstart[b + 1];
            for (int t = (s >> 8) + F.tid; t < (e >> 8); t += NTHREADS) tileb[1 + t] = b;
            for (int r = s + btot[b] + F.tid; r < e; r += NTHREADS) __hip_atomic_store(rowtok + r, -1, __ATOMIC_RELAXED, __HIP_MEMORY_SCOPE_AGENT); }
    }
    __syncthreads();
    if (F.wave == 0) {
        for (int pass = 0; pass < 2; ++pass) { const int i = pass * 64 + F.lane, bi = tokb[F.vcu * 128 + i]; int row = 0;
#pragma unroll 1
            for (int b = 0; b < 24; ++b) { const unsigned long long mask = __ballot(bi == b); const int c = carry[b];
                if (bi == b) row = c + __builtin_popcountll(mask & ((1ull << F.lane) - 1ull));
                asm volatile("s_waitcnt lgkmcnt(0)" ::: "memory");
                if (F.lane == 0) carry[b] = c + __builtin_popcountll(mask);
                asm volatile("s_waitcnt lgkmcnt(0)" ::: "memory"); }
            rowidx[i] = row; }
    }
    __syncthreads();
    bf16* XS = (bf16*)(F.ws + WS_XS);
    for (int i = 0; i < 16; ++i) {
        const int li = F.wave * 16 + i, m = F.vcu * 128 + li, row = rowidx[li]; const float rstd = tokr[m];
        if (F.lane == 0) {
            __hip_atomic_store(rowtok + row, m, __ATOMIC_RELAXED, __HIP_MEMORY_SCOPE_AGENT);
            const unsigned long long w2 = (unsigned long long)__builtin_bit_cast(unsigned, tokw[2 * m]) | ((unsigned long long)__builtin_bit_cast(unsigned, tokw[2 * m + 1]) << 32);
            __hip_atomic_store((unsigned long long*)(roww + 2 * row), w2, __ATOMIC_RELAXED, __HIP_MEMORY_SCOPE_AGENT); }
        if (F.lane == 0) __hip_atomic_store((float*)(F.ws + WS_ROWR) + row, rstd, __ATOMIC_RELAXED, __HIP_MEMORY_SCOPE_AGENT);
        const u32x4* xr = (const u32x4*)(P_XB(F) + (size_t)m * D) + F.lane; u32x4* o16 = (u32x4*)(XS + (size_t)row * D) + F.lane;
        o16[0] = xr[0]; o16[64] = xr[64];
    }
}
struct MoeOrder {
    const int* tileb; int G, c; bool down;
    __device__ __forceinline__ bool next(int i, pg8::Unit& u) const {
        const GAS int* tb_ = (const GAS int*)tileb;
        const int NT = __builtin_amdgcn_readfirstlane(tb_[0]), L = i * G + c; if (L >= NT * 4) return false;
        const int rt = L >> 2, pn = L & 3, b = __builtin_amdgcn_readfirstlane(tb_[1 + rt]);
        if (down) { u.pm = rt; u.pn = b * 4 + pn; u.aux = pn; }
        else { int ea, eb; pair_decode(b % 6, ea, eb); const int e = (b / 6) * 4 + (pn < 2 ? ea : eb); u.pm = rt; u.pn = e * 2 + (pn & 1); u.aux = pn; }
        return true;
    }
};
struct EpiGU {
    static constexpr bool PERM = true;
    bf16* H; const float* roww; const float* rowr;
    __device__ __forceinline__ void operator()(const f32x4 (&acc)[2][2][4][2], const pg8::Unit& u, int wr, int wc, int fr_, int fq_) const {
        const int ln_ = lane_id(), fr = ln_ & 15, fq = ln_ >> 4; (void)fr_; (void)fq_;
        const int row0 = u.pm * 256 + wr * 64 + fr, cl = u.aux * 128 + 16 * wc + 4 * fq, ws = u.aux >> 1;
#pragma unroll
        for (int ai = 0; ai < 2; ++ai)
#pragma unroll
            for (int m = 0; m < 4; ++m) { const int r = row0 + ai * 128 + m * 16; const float rr = rowr[r], w = roww[2 * r + ws] * rr;
#pragma unroll
                for (int bj = 0; bj < 2; ++bj) { const f32x4 g = acc[ai][bj][m][0], up = acc[ai][bj][m][1]; f32x4 a;
#pragma unroll
                    for (int i = 0; i < 4; ++i) { const float gg = g[i] * rr; a[i] = gg * sigmoidf_(gg) * up[i] * w; }
                    u32x2 o; o.x = pg8::cvt_pk_bf16(a[0], a[1]); o.y = pg8::cvt_pk_bf16(a[2], a[3]);
                    *(u32x2*)(H + (size_t)r * 512 + cl + bj * 64) = o; } }
    }
};
struct EpiDown {
    static constexpr bool PERM = true;
    bf16* RB; const int* rowtok;
    __device__ __forceinline__ void operator()(const f32x4 (&acc)[2][2][4][2], const pg8::Unit& u, int wr, int wc, int fr_, int fq_) const {
        const int ln_ = lane_id(), fr = ln_ & 15, fq = ln_ >> 4; (void)fr_; (void)fq_;
        const int row0 = u.pm * 256 + wr * 64 + fr, col0 = u.aux * 256 + wc * 32 + 8 * fq;
        int tok[8];
#pragma unroll
        for (int i = 0; i < 8; ++i) tok[i] = rowtok[row0 + (i >> 2) * 128 + (i & 3) * 16];
#pragma unroll
        for (int ai = 0; ai < 2; ++ai) { u32x4 x[4][2];
#pragma unroll
            for (int m = 0; m < 4; ++m) { const int tk = tok[ai * 4 + m]; const bf16* rp = RB + (size_t)(tk < 0 ? 0 : tk) * D + col0; x[m][0] = *(const u32x4*)rp; x[m][1] = *(const u32x4*)(rp + 128); }
#pragma unroll
            for (int m = 0; m < 4; ++m) { const int tk = tok[ai * 4 + m]; bf16* rp = RB + (size_t)(tk < 0 ? 0 : tk) * D + col0;
#pragma unroll
                for (int bj = 0; bj < 2; ++bj) { const u32x4 xx = x[m][bj]; const f32x4 a0 = acc[ai][bj][m][0], a1 = acc[ai][bj][m][1]; u32x4 w;
                    w.x = pg8::cvt_pk_bf16(bf2f(xx.x & 0xffffu) + a0[0], bf2f(xx.x >> 16) + a0[1]); w.y = pg8::cvt_pk_bf16(bf2f(xx.y & 0xffffu) + a0[2], bf2f(xx.y >> 16) + a0[3]);
                    w.z = pg8::cvt_pk_bf16(bf2f(xx.z & 0xffffu) + a1[0], bf2f(xx.z >> 16) + a1[1]); w.w = pg8::cvt_pk_bf16(bf2f(xx.w & 0xffffu) + a1[2], bf2f(xx.w >> 16) + a1[3]);
                    if (tk >= 0) *(u32x4*)(rp + bj * 128) = w; } }
            asm volatile("" ::: "memory"); }
    }
};

struct SsmOrder { int G, c, mode;
    __device__ __forceinline__ bool next(int i, pg8::Unit& u) const { const int L = i * G + c;
        if (mode == 1) { if (L >= 32) return false; u.pm = L; u.pn = L >> 1; u.aux = 0; return true; }
        if (L >= 128) return false; const int g = L >> 3; u.pm = g * 2 + ((L >> 2) & 1); u.pn = g * 4 + (L & 3); u.aux = L & 3; return true; } };
struct HalfOrder { int L;
    __device__ __forceinline__ bool next(int i, pg8::Unit& u) const { if (i > 0 || L < 0 || L >= 128) return false; u.pm = L; u.pn = 0; u.aux = 0; return true; } };
struct EpiZ { static constexpr bool PERM = false; float* ZB;
    __device__ __forceinline__ void operator()(const f32x4 (&acc)[2][2][4][2], const pg8::Unit& u, int wr, int wc, int fr_, int fq_) const {
        const int ln_ = lane_id(), fr = ln_ & 15, fq = ln_ >> 4; (void)fr_; (void)fq_;
        const int row0 = u.pm * 256 + wr * 64 + fr, col0 = wc * 32 + 4 * fq;
#pragma unroll
        for (int ai = 0; ai < 2; ++ai)
#pragma unroll
            for (int m = 0; m < 4; ++m)
#pragma unroll
                for (int n = 0; n < 2; ++n) *(f32x4*)(ZB + (size_t)(row0 + ai * 128 + m * 16) * 128 + col0 + n * 16) = acc[ai][0][m][n];
    } };
struct EpiSsm2 { static constexpr bool PERM = true; const bf16* UG; bf16* YS; const float* dvec;
    __device__ __forceinline__ void operator()(const f32x4 (&acc)[2][2][4][2], const pg8::Unit& u, int wr, int wc, int fr_, int fq_) const {
        const int ln_ = lane_id(), fr = ln_ & 15, fq = ln_ >> 4; (void)fr_; (void)fq_;
        const int g = u.pm >> 1, cr0 = (u.pm & 1) * 256 + wr * 64 + fr;
#pragma unroll
        for (int bj = 0; bj < 2; ++bj) { const int n0 = u.aux * 256 + bj * 128 + wc * 32 + 8 * fq, to = n0 >> 4, ho0 = n0 & 15;
            const f32x4 d0 = *(const f32x4*)(dvec + g * 16 + ho0), d1 = *(const f32x4*)(dvec + g * 16 + ho0 + 4);
#pragma unroll
            for (int ai = 0; ai < 2; ++ai)
#pragma unroll
                for (int m = 0; m < 4; ++m) { const int cr = cr0 + ai * 128 + m * 16;
                    const u32x4 uu = *(const u32x4*)(UG + ((size_t)(g * 512 + cr)) * UGP + n0);
                    const f32x4 a0 = acc[ai][bj][m][0], a1 = acc[ai][bj][m][1]; float y[8];
                    y[0] = gelu_tanh(a0[0] + d0[0] * bf2f(uu.x & 0xffffu)); y[1] = gelu_tanh(a0[1] + d0[1] * bf2f(uu.x >> 16));
                    y[2] = gelu_tanh(a0[2] + d0[2] * bf2f(uu.y & 0xffffu)); y[3] = gelu_tanh(a0[3] + d0[3] * bf2f(uu.y >> 16));
                    y[4] = gelu_tanh(a1[0] + d1[0] * bf2f(uu.z & 0xffffu)); y[5] = gelu_tanh(a1[1] + d1[1] * bf2f(uu.z >> 16));
                    y[6] = gelu_tanh(a1[2] + d1[2] * bf2f(uu.w & 0xffffu)); y[7] = gelu_tanh(a1[3] + d1[3] * bf2f(uu.w >> 16));
                    u32x4 w; w.x = pg8::cvt_pk_bf16(y[0], y[1]); w.y = pg8::cvt_pk_bf16(y[2], y[3]); w.z = pg8::cvt_pk_bf16(y[4], y[5]); w.w = pg8::cvt_pk_bf16(y[6], y[7]);
                    *(u32x4*)(YS + ((size_t)cr * 64 + to) * 256 + g * 16 + ho0) = w; } }
    } };
struct EpiGluE { static constexpr bool PERM = true; const bf16* YS; bf16* YMIX; const float* gb;
    __device__ __forceinline__ void operator()(const f32x4 (&acc)[2][2][4][2], const pg8::Unit& u, int wr, int wc, int fr_, int fq_) const {
        const int ln_ = lane_id(), fr = ln_ & 15, fq = ln_ >> 4; (void)fr_; (void)fq_;
        const int row0 = u.pm * 256 + wr * 64 + fr;
#pragma unroll
        for (int bj = 0; bj < 2; ++bj) { const int n0 = bj * 128 + wc * 32 + 8 * fq; const f32x4 b0 = *(const f32x4*)(gb + n0), b1 = *(const f32x4*)(gb + n0 + 4);
#pragma unroll
            for (int ai = 0; ai < 2; ++ai)
#pragma unroll
                for (int m = 0; m < 4; ++m) { const size_t r = (size_t)(row0 + ai * 128 + m * 16); const u32x4 yy = *(const u32x4*)(YS + r * 256 + n0);
                    const f32x4 a0 = acc[ai][bj][m][0] + b0, a1 = acc[ai][bj][m][1] + b1; float o[8];
                    o[0] = bf2f(yy.x & 0xffffu) * sigmoidf_(a0[0]); o[1] = bf2f(yy.x >> 16) * sigmoidf_(a0[1]); o[2] = bf2f(yy.y & 0xffffu) * sigmoidf_(a0[2]); o[3] = bf2f(yy.y >> 16) * sigmoidf_(a0[3]);
                    o[4] = bf2f(yy.z & 0xffffu) * sigmoidf_(a1[0]); o[5] = bf2f(yy.z >> 16) * sigmoidf_(a1[1]); o[6] = bf2f(yy.w & 0xffffu) * sigmoidf_(a1[2]); o[7] = bf2f(yy.w >> 16) * sigmoidf_(a1[3]);
                    u32x4 w; w.x = pg8::cvt_pk_bf16(o[0], o[1]); w.y = pg8::cvt_pk_bf16(o[2], o[3]); w.z = pg8::cvt_pk_bf16(o[4], o[5]); w.w = pg8::cvt_pk_bf16(o[6], o[7]);
                    *(u32x4*)(YMIX + r * 1024 + n0) = w; } }
    } };
struct EpiPoolE { static constexpr bool PERM = true; bf16* YMIX; const float* pb; const float* ps;
    __device__ __forceinline__ void operator()(const f32x4 (&acc)[2][2][4][2], const pg8::Unit& u, int wr, int wc, int fr_, int fq_) const {
        const int ln_ = lane_id(), fr = ln_ & 15, fq = ln_ >> 4; (void)fr_; (void)fq_;
        const int row0 = u.pm * 256 + wr * 64 + fr;
#pragma unroll
        for (int bj = 0; bj < 2; ++bj) { const int n0 = bj * 128 + wc * 32 + 8 * fq; const f32x4 b0 = *(const f32x4*)(pb + n0), b1 = *(const f32x4*)(pb + n0 + 4), s0 = *(const f32x4*)(ps + n0), s1 = *(const f32x4*)(ps + n0 + 4);
#pragma unroll
            for (int ai = 0; ai < 2; ++ai)
#pragma unroll
                for (int m = 0; m < 4; ++m) { const size_t r = (size_t)(row0 + ai * 128 + m * 16);
                    const f32x4 a0 = (acc[ai][bj][m][0] + b0) * s0, a1 = (acc[ai][bj][m][1] + b1) * s1;
                    u32x4 w; w.x = pg8::cvt_pk_bf16(a0[0], a0[1]); w.y = pg8::cvt_pk_bf16(a0[2], a0[3]); w.z = pg8::cvt_pk_bf16(a1[0], a1[1]); w.w = pg8::cvt_pk_bf16(a1[2], a1[3]);
                    *(u32x4*)(YMIX + r * 1024 + 256 + n0) = w; } }
    } };
__device__ __forceinline__ void ph_tg_expand(const Ctx& F0, int l) {
    const Ctx F = launder(F0);
    if (F.wave == 0) return;
    const int gw = F.vcu * 7 + (F.wave - 1), NGW = F.G * 7;
    const bf16* KT = (const bf16*)(F.ws + WS_KT) + (size_t)l * SGN * 64 * 256;
    bf16* TG0 = (bf16*)(F.ws + WS_TG) + (size_t)l * SGN * 1024 * UGP;
#pragma unroll 2
    for (int r = gw; r < SGN * 1024; r += NGW) { const int g = r >> 10, n = r & 1023, to = n >> 4, ho = n & 15;
        bf16* d = TG0 + ((size_t)g * 1024 + n) * UGP;
#pragma unroll
        for (int half = 0; half < 2; ++half) { const int ti = half * 32 + (F.lane >> 1), tau = to - ti;
            u32x4 v = (u32x4){0u, 0u, 0u, 0u};
            if (tau >= 0) v = *(const u32x4*)(KT + (((size_t)g * 64 + tau) * 16 + ho) * 16 + (F.lane & 1) * 8);
            *(u32x4*)(d + half * 512 + F.lane * 8) = v; } }
}
__device__ __forceinline__ void ph_ssm_scan(const Ctx& F0, int l) {
    const Ctx F = launder(F0);
    for (int it = F.vcu + F.G * F.wave; it < SGN * NB; it += F.G * NWAVES) {
        const int g = it >> 3, b = it & 7, p = F.lane;
        const float are = F.in[4][(l * SGN + g) * SP + p], aim = F.in[5][(l * SGN + g) * SP + p], dt = expf(F.in[6][l * SGN + g]);
        float sn, cs; sincosf(aim * dt * 64.f, &sn, &cs); const float mg = expf(are * dt * 64.f), lr = mg * cs, li = mg * sn;
        const float* Z = (const float*)(F.ws + WS_ZB) + ((size_t)g * 512 + b * 64) * 128;
        bf16* U = P_UG(F) + ((size_t)g * 512 + b * 64) * UGP + 1024;
        float sr = 0.f, si = 0.f;
#pragma unroll 1
        for (int c0 = 0; c0 < 64; c0 += 32) {
            float zr[32], zi[32];
#pragma unroll
            for (int j = 0; j < 32; ++j) { zr[j] = Z[(c0 + j) * 128 + p]; zi[j] = Z[(c0 + j) * 128 + 64 + p]; }
#pragma unroll
            for (int j = 0; j < 32; ++j) {
                U[(size_t)(c0 + j) * UGP + p] = (bf16)f2bf(sr); U[(size_t)(c0 + j) * UGP + 64 + p] = (bf16)f2bf(si);
                const float nr = lr * sr - li * si + zr[j], ni = lr * si + li * sr + zi[j]; sr = nr; si = ni; }
        }
    }
}

namespace moba {
using bf16x8 = __attribute__((ext_vector_type(8))) short;
using s16x4 = __attribute__((ext_vector_type(4))) short;
using f32x16 = __attribute__((ext_vector_type(16))) float;
typedef short v4i16_t __attribute__((ext_vector_type(4)));
typedef float f32x2_t __attribute__((ext_vector_type(2))); typedef __bf16 bf16x2_t __attribute__((ext_vector_type(2)));
constexpr int L_K = 0, L_V = 49152, L_TB = 98304, L_KM = L_TB + 4 * 768 * 4, L_END = L_KM + 16 * 64 * 4;
__device__ __forceinline__ unsigned cvtpk(float lo, float hi) { f32x2_t v = {lo, hi}; bf16x2_t b = __builtin_convertvector(v, bf16x2_t); return __builtin_bit_cast(unsigned, b); }
__device__ __forceinline__ s16x4 vtr(const LAS char* p) { return __builtin_bit_cast(s16x4, __builtin_amdgcn_ds_read_tr16_b64_v4i16((LAS v4i16_t*)p)); }
__device__ __forceinline__ float hmax(float v) { const unsigned u = __builtin_bit_cast(unsigned, v); auto r = __builtin_amdgcn_permlane32_swap(u, u, false, false); return fmaxf(__builtin_bit_cast(float, (unsigned)r[0]), __builtin_bit_cast(float, (unsigned)r[1])); }
__device__ __forceinline__ float hsum(float v) { const unsigned u = __builtin_bit_cast(unsigned, v); auto r = __builtin_amdgcn_permlane32_swap(u, u, false, false); return __builtin_bit_cast(float, (unsigned)r[0]) + __builtin_bit_cast(float, (unsigned)r[1]); }

constexpr int L_LIST = L_END, L_WCNT = 32768;
#define MOBA_CVEC() f32x16 cvec; do { const float ci_ = bfar - mref; _Pragma("unroll") for (int r = 0; r < 16; ++r) cvec[r] = ci_; } while (0)
#define MOBA_QK(P0, P1, KB) do { { const bf16x8 a0 = *(const LAS bf16x8*)(kp0 + (KB)), a1 = *(const LAS bf16x8*)(kp0 + (KB) + 512); \
          P0 = __builtin_amdgcn_mfma_f32_32x32x16_bf16(a0, qr[0], cvec, 0, 0, 0); P1 = __builtin_amdgcn_mfma_f32_32x32x16_bf16(a1, qr[0], cvec, 0, 0, 0); } \
        _Pragma("unroll") for (int d0 = 1; d0 < 4; ++d0) { const bf16x8 a0 = *(const LAS bf16x8*)(kp0 + (KB) + d0 * 2048), a1 = *(const LAS bf16x8*)(kp0 + (KB) + d0 * 2048 + 512); \
            P0 = __builtin_amdgcn_mfma_f32_32x32x16_bf16(a0, qr[d0], P0, 0, 0, 0); P1 = __builtin_amdgcn_mfma_f32_32x32x16_bf16(a1, qr[d0], P1, 0, 0, 0); } } while (0)
#define MOBA_NEARMAX(P0, P1, JN, OUT) do { const int jn_ = (JN); if (jn_ >= 0) { const int A_ = qrel - 64 * (jn_ - 4) - 4 * hi + 256, s_ = 767 - A_, c_ = s_ & 3; \
            const LAS f32x4* t4 = (const LAS f32x4*)(tb + c_ * 768 + (s_ - c_)); \
            _Pragma("unroll") for (int g = 0; g < 4; ++g) { const f32x4 x0 = t4[2 * g], x1 = t4[2 * g + 8]; \
                _Pragma("unroll") for (int j = 0; j < 4; ++j) { P0[4 * g + j] += x0[j]; P1[4 * g + j] += x1[j]; } } } \
        float ra = __builtin_fmaxf(__builtin_fmaxf(P0[0], P0[1]), P1[0]), rb = __builtin_fmaxf(__builtin_fmaxf(P0[2], P0[3]), P1[1]); \
        ra = __builtin_fmaxf(__builtin_fmaxf(ra, P1[2]), P1[3]); \
        _Pragma("unroll") for (int r = 4; r < 16; r += 4) { ra = __builtin_fmaxf(__builtin_fmaxf(ra, P0[r]), P0[r + 1]); rb = __builtin_fmaxf(__builtin_fmaxf(rb, P0[r + 2]), P0[r + 3]); \
            ra = __builtin_fmaxf(__builtin_fmaxf(ra, P1[r]), P1[r + 1]); rb = __builtin_fmaxf(__builtin_fmaxf(rb, P1[r + 2]), P1[r + 3]); } \
        OUT = hmax(__builtin_fmaxf(ra, rb)); } while (0)
#define MOBA_STEP(PC0, PC1, PN0, PN1, JNN, KBN, VBC, HASN) do { \
        bf16x8 vf[8], kf[8]; \
        if (HASN) { _Pragma("unroll") for (int d0 = 0; d0 < 4; ++d0) { kf[2 * d0] = *(const LAS bf16x8*)(kp0 + (KBN) + d0 * 2048); kf[2 * d0 + 1] = *(const LAS bf16x8*)(kp0 + (KBN) + d0 * 2048 + 512); } } \
        __builtin_amdgcn_sched_barrier(0); \
        if (__any(rm > 8.f)) { const float dl = __builtin_fmaxf(rm, 0.f), alpha = __builtin_amdgcn_exp2f(-dl); mref += dl; l *= alpha; \
            _Pragma("unroll") for (int r = 0; r < 16; ++r) { PC0[r] -= dl; PC1[r] -= dl; o0[r] *= alpha; o1[r] *= alpha; } } \
        if (HASN) { MOBA_CVEC(); \
                    PN0 = __builtin_amdgcn_mfma_f32_32x32x16_bf16(kf[0], qr[0], cvec, 0, 0, 0); PN1 = __builtin_amdgcn_mfma_f32_32x32x16_bf16(kf[1], qr[0], cvec, 0, 0, 0); \
                    _Pragma("unroll") for (int d0 = 1; d0 < 4; ++d0) { PN0 = __builtin_amdgcn_mfma_f32_32x32x16_bf16(kf[2 * d0], qr[d0], PN0, 0, 0, 0); PN1 = __builtin_amdgcn_mfma_f32_32x32x16_bf16(kf[2 * d0 + 1], qr[d0], PN1, 0, 0, 0); } } \
        { const LAS char* vp = vp0 + (VBC); \
        _Pragma("unroll") for (int k = 0; k < 4; ++k) { \
            const s16x4 lo0 = vtr(vp + k * 1024), hi0 = vtr(vp + k * 1024 + 512), lo1 = vtr(vp + 4096 + k * 1024), hi1 = vtr(vp + 4096 + k * 1024 + 512); \
            vf[2 * k] = (bf16x8){lo0[0], lo0[1], lo0[2], lo0[3], hi0[0], hi0[1], hi0[2], hi0[3]}; vf[2 * k + 1] = (bf16x8){lo1[0], lo1[1], lo1[2], lo1[3], hi1[0], hi1[1], hi1[2], hi1[3]}; } } \
        __builtin_amdgcn_sched_barrier(0); \
        float s0 = 0.f, s1 = 0.f; u32x4 pw[4]; \
        _Pragma("unroll") for (int r = 0; r < 16; ++r) { PC0[r] = __builtin_amdgcn_exp2f(PC0[r]); PC1[r] = __builtin_amdgcn_exp2f(PC1[r]); s0 += PC0[r]; s1 += PC1[r]; } \
        l += s0 + s1; \
        _Pragma("unroll") for (int q = 0; q < 4; ++q) { pw[0][q] = cvtpk(PC0[2 * q], PC0[2 * q + 1]); pw[1][q] = cvtpk(PC0[8 + 2 * q], PC0[9 + 2 * q]); pw[2][q] = cvtpk(PC1[2 * q], PC1[2 * q + 1]); pw[3][q] = cvtpk(PC1[8 + 2 * q], PC1[9 + 2 * q]); } \
        _Pragma("unroll") for (int k = 0; k < 4; ++k) { const bf16x8 pa = __builtin_bit_cast(bf16x8, pw[k]); \
            o0 = __builtin_amdgcn_mfma_f32_32x32x16_bf16(vf[2 * k], pa, o0, 0, 0, 0); o1 = __builtin_amdgcn_mfma_f32_32x32x16_bf16(vf[2 * k + 1], pa, o1, 0, 0, 0); } \
        if (HASN) MOBA_NEARMAX(PN0, PN1, JNN, rm); \
    } while (0)
#define MOBA_BLOCK4(JN0, PRE4) \
    float mref = 0.f, l = 0.f; f32x16 o0 = f32x16{}, o1 = f32x16{}; f32x16 pa0, pa1, pb0, pb1; float rm; \
    { const int jn0_ = (JN0); \
      { MOBA_CVEC(); MOBA_QK(pa0, pa1, 0); } MOBA_NEARMAX(pa0, pa1, jn0_, rm); \
      MOBA_STEP(pa0, pa1, pb0, pb1, (jn0_ < 0 ? -1 : jn0_ + 1), 8192, 0, true); \
      MOBA_STEP(pb0, pb1, pa0, pa1, (jn0_ < 0 ? -1 : jn0_ + 2), 16384, 8192, true); \
      MOBA_STEP(pa0, pa1, pb0, pb1, (jn0_ < 0 ? -1 : jn0_ + 3), 24576, 16384, true); \
      PRE4; \
      MOBA_STEP(pb0, pb1, pa0, pa1, -1, 0, 24576, false); }
__device__ __forceinline__ void load_block(const bf16* K, const bf16* V, size_t row0, int h, int wid, int lane, LAS char* lds) {
    const bf16* ksrc = K + (row0 + lane) * 512 + h * 64 + wid * 8;
    const bf16* vsrc = V + (row0 + 16 * (wid & 3) + (lane >> 2)) * 512 + h * 64 + (wid >> 2) * 32 + (lane & 3) * 8;
    u32x4 kr[4], vr[4];
#pragma unroll
    for (int t = 0; t < 4; ++t) { kr[t] = *(const u32x4*)(ksrc + (size_t)t * 64 * 512); vr[t] = *(const u32x4*)(vsrc + (size_t)t * 64 * 512); }
    LAS char* kd = lds + L_K + wid * 1024 + lane * 16; LAS char* vd = lds + L_V + wid * 1024 + lane * 16;
#pragma unroll
    for (int t = 0; t < 4; ++t) { *(LAS u32x4*)(kd + t * 8192) = kr[t]; *(LAS u32x4*)(vd + t * 8192) = vr[t]; }
}
__device__ __forceinline__ void fill_bias_table(const float* BT, int h, int tid, LAS float* tb) {
    const float bfar = BT[h * 132 + 128];
    for (int i = tid; i < 4 * 768; i += NTHREADS) { const int c = i / 768, j = i % 768, src_ = 767 - (j + c), rel = src_ - 256; tb[i] = (src_ < 0 || rel < 0) ? -1.0e30f : (rel < 128 ? BT[h * 132 + rel] - bfar : 0.f); }
}
__device__ __forceinline__ void sel_phase(int wave_, int vcu, int G, const bf16* Q, const float* KMP, unsigned* SEL, LAS char* lds) {
    const int w0 = G > 64 ? 32 : 0, nw = G - w0; if (vcu < w0) return;
    int lane_ = lane_id(); asm volatile("" : "+v"(lane_)); asm volatile("" : "+s"(wave_));
    const int wid = wave_, lane = lane_, tid = wid * 64 + lane, r32 = lane & 31, hi = lane >> 5;
    const int ub = ((vcu - w0) * 1024) / nw, ue = ((vcu - w0 + 1) * 1024) / nw;
    LAS float* km = (LAS float*)(lds + L_KM);
    int bhc = -1;
#pragma unroll 1
    for (int u = ub; u < ue; ++u) {
        const int bh = u >> 4, qb = u & 15, b = bh >> 3, h = bh & 7;
        if (bh != bhc) { bhc = bh;
            __syncthreads();
            for (int i = tid; i < 16 * 64; i += NTHREADS) { const int j = i >> 6, d = i & 63, pm = b * 16 + j; km[i] = KMP[pm * 512 + h * 64 + d] + KMP[128 * 512 + pm * 512 + h * 64 + d]; }
            __syncthreads(); }
        asm volatile("" ::: "memory");
        const int q = qb * 256 + wid * 32 + r32;
        const bf16* qw = Q + ((size_t)b * SEQ + q) * 512 + h * 64 + hi * 8;
        bf16x8 qr[4];
#pragma unroll
        for (int d0 = 0; d0 < 4; ++d0) qr[d0] = *(const bf16x8*)(qw + d0 * 16);
        float g[16];
#pragma unroll
        for (int j = 0; j < 16; ++j) g[j] = 0.f;
#pragma unroll
        for (int d0 = 0; d0 < 4; ++d0)
#pragma unroll
            for (int j = 0; j < 16; ++j) { const f32x4 ka = *(const LAS f32x4*)(km + j * 64 + d0 * 16 + hi * 8), kb4 = *(const LAS f32x4*)(km + j * 64 + d0 * 16 + hi * 8 + 4);
#pragma unroll
                for (int e = 0; e < 4; ++e) { g[j] += bf2f((unsigned)(unsigned short)qr[d0][e]) * ka[e]; }
#pragma unroll
                for (int e = 0; e < 4; ++e) { g[j] += bf2f((unsigned)(unsigned short)qr[d0][4 + e]) * kb4[e]; } }
#pragma unroll
        for (int j = 0; j < 16; ++j) g[j] = hsum(g[j]);
        unsigned selmask = 0u;
#pragma unroll
        for (int s3 = 0; s3 < 3; ++s3) { float bv = -3.0e38f; int bi = -1;
#pragma unroll
            for (int j = 0; j < 16; ++j) { const bool ok = (j < qb) && !((selmask >> j) & 1u) && (g[j] > bv); bv = ok ? g[j] : bv; bi = ok ? j : bi; }
            if (bi >= 0) selmask |= 1u << bi; }
        if (hi == 0) SEL[(size_t)bh * SEQ + q] = selmask;
    }
}
__device__ __forceinline__ bf16* pslot(int slot, size_t t, int h, bf16* YM, bf16* P2A, bf16* P2B) {
    return slot == 0 ? YM + t * 1024 + h * 64 : slot == 1 ? YM + t * 1024 + 512 + h * 64 : (t < (size_t)(T / 2) ? P2A + t * 512 : P2B + (t - (size_t)(T / 2)) * 512) + h * 64;
}
__device__ __forceinline__ void gather_phase(int wave_, int vcu, const bf16* Q, const bf16* K, const bf16* V, bf16* YM, bf16* P2A, bf16* P2B, float* ML, const unsigned* SEL, const float* BT, LAS char* lds) {
    if (vcu >= 256) return;
    int lane_ = lane_id(); asm volatile("" : "+v"(lane_)); asm volatile("" : "+s"(wave_));
    const int wid = wave_, lane = lane_, tid = wid * 64 + lane, r32 = lane & 31, hi = lane >> 5;
    const int bh = vcu >> 2, s = vcu & 3, b = bh >> 3, h = bh & 7;
    const size_t rowbase = (size_t)b * SEQ;
    LAS float* tb = (LAS float*)(lds + L_TB); LAS int* list = (LAS int*)(lds + L_LIST); LAS int* wcnt = (LAS int*)(lds + L_WCNT);
    const float bfar = BT[h * 132 + 128];
    fill_bias_table(BT, h, tid, tb);
    const unsigned* selrow = SEL + (size_t)bh * SEQ;
    const LAS char* kp0 = lds + L_K + hi * 1024 + r32 * 16;
    const LAS char* vp0 = lds + L_V + ((lane >> 4) & 1) * 32 + (lane & 3) * 8 + (4 * hi + ((lane & 15) >> 2)) * 64;
    const unsigned code = s == 0 ? 0xFFFA70u : s == 1 ? 0xFFE961u : s == 2 ? 0xFFFB32u : 0xFDC854u;
    u32x4 kr[4], vr[4]; unsigned msel[8];
#define MOBA_GFETCH(KB) do { const size_t row0 = rowbase + (size_t)(KB) * 256; int lg_ = lane_id(); asm volatile("" : "+v"(lg_));     \
        const bf16* ksrc = K + (row0 + lg_) * 512 + h * 64 + wid * 8; \
        const bf16* vsrc = V + (row0 + 16 * (wid & 3) + (lg_ >> 2)) * 512 + h * 64 + (wid >> 2) * 32 + (lg_ & 3) * 8; \
        _Pragma("unroll") for (int t = 0; t < 4; ++t) { kr[t] = *(const u32x4*)(ksrc + (size_t)t * 64 * 512); vr[t] = *(const u32x4*)(vsrc + (size_t)t * 64 * 512); } \
        const int qs_ = ((KB) + 1) * 256, R_ = (SEQ - qs_) >> 3; \
        _Pragma("unroll") for (int i = 0; i < 8; ++i) { const int off = i * 64 + lg_; msel[i] = off < R_ ? selrow[qs_ + wid * R_ + off] : 0u; } } while (0)
    MOBA_GFETCH((int)(code & 15u));
#pragma unroll 1
    for (int ik = 0; ik < 6; ++ik) {
        const int kb = (int)((code >> (4 * ik)) & 15u); if (kb == 15) break;
        const int kbn = (int)((code >> (4 * ik + 4)) & 15u);
        __syncthreads();
        { LAS char* kd = lds + L_K + wid * 1024 + lane * 16; LAS char* vd = lds + L_V + wid * 1024 + lane * 16;
#pragma unroll
          for (int t = 0; t < 4; ++t) { *(LAS u32x4*)(kd + t * 8192) = kr[t]; *(LAS u32x4*)(vd + t * 8192) = vr[t]; } }
        const int qs = (kb + 1) * 256, R = (SEQ - qs) >> 3;
        unsigned long long bal[8]; int cnt = 0;
#pragma unroll
        for (int i = 0; i < 8; ++i) { bal[i] = __ballot((msel[i] >> kb) & 1u); cnt += __builtin_popcountll(bal[i]); }
        if (lane == 0) wcnt[wid] = cnt;
        __syncthreads();
        int base = 0, n = 0;
#pragma unroll
        for (int w = 0; w < 8; ++w) { const int c = wcnt[w]; n += c; base += (w < wid) ? c : 0; }
#pragma unroll
        for (int i = 0; i < 8; ++i) { const unsigned long long m = bal[i];
            if ((m >> lane) & 1ull) list[base + __builtin_popcountll(m & ((1ull << lane) - 1ull))] = qs + wid * R + i * 64 + lane;
            base += __builtin_popcountll(m); }
        __syncthreads();
        const int ntask = (n + 31) >> 5;
        int tk = wid, qin = 0; bool vn = false; unsigned smn = 0u; bf16x8 qn[4];
#define MOBA_QFETCH() do { const int li_ = tk * 32 + r32; vn = li_ < n; { const int lv_ = list[vn ? li_ : (n > 0 ? n - 1 : 0)]; qin = n > 0 ? lv_ : qs; } smn = selrow[qin]; \
            const bf16* qw = Q + (rowbase + qin) * 512 + h * 64 + hi * 8; \
            _Pragma("unroll") for (int d0 = 0; d0 < 4; ++d0) qn[d0] = *(const bf16x8*)(qw + d0 * 16); } while (0)
        MOBA_QFETCH();
#pragma unroll 1
        while (tk < ntask) {
            const int qi = qin; const bool valid = vn; const unsigned sm = smn;
            bf16x8 qr[4];
#pragma unroll
            for (int d0 = 0; d0 < 4; ++d0) qr[d0] = qn[d0];
            tk += 8;
            const int slot = __builtin_popcount(sm & ((1u << kb) - 1u));
            const int qd = qi - qs, qrel = qd < 255 ? qd : 255;
            const bool nearw = __any(qd < 128);
            MOBA_BLOCK4(nearw ? 0 : -1, MOBA_QFETCH())
            const float lt = hsum(l), inv = 1.f / lt; const size_t t = rowbase + qi;
            bf16* orow = pslot(slot, t, h, YM, P2A, P2B) + 8 * hi;
#pragma unroll
            for (int d0 = 0; d0 < 2; ++d0)
#pragma unroll
                for (int gp = 0; gp < 2; ++gp) { const f32x16& oo = d0 ? o1 : o0; const int ga = 8 * gp, gb = 8 * gp + 4;
                    unsigned ax = cvtpk(oo[ga] * inv, oo[ga + 1] * inv), ay = cvtpk(oo[ga + 2] * inv, oo[ga + 3] * inv), bx = cvtpk(oo[gb] * inv, oo[gb + 1] * inv), by = cvtpk(oo[gb + 2] * inv, oo[gb + 3] * inv);
                    { auto r = __builtin_amdgcn_permlane32_swap(ax, bx, false, false); ax = r[0]; bx = r[1]; }
                    { auto r = __builtin_amdgcn_permlane32_swap(ay, by, false, false); ay = r[0]; by = r[1]; }
                    if (valid) *(u32x4*)(orow + 32 * d0 + 16 * gp) = (u32x4){ax, ay, bx, by}; }
            if (valid && hi == 0) { float* ml = ML + ((t * 8 + h) * 3 + slot) * 2; ml[0] = mref; ml[1] = lt; }
        }
#undef MOBA_QFETCH
        MOBA_GFETCH(kbn);
    }
#undef MOBA_GFETCH
}
__device__ __forceinline__ void diag_unit(int wid, int lane, int b, int h, int qb, const bf16* Q, const bf16* K, const bf16* V, bf16* YM, const bf16* P2A, const bf16* P2B, const float* ML, float bfar, LAS char* lds) {
    const int r32 = lane & 31, hi = lane >> 5; const size_t rowbase = (size_t)b * SEQ;
    LAS float* tb = (LAS float*)(lds + L_TB);
    const LAS char* kp0 = lds + L_K + hi * 1024 + r32 * 16;
    const LAS char* vp0 = lds + L_V + ((lane >> 4) & 1) * 32 + (lane & 3) * 8 + (4 * hi + ((lane & 15) >> 2)) * 64;
    __syncthreads();
    load_block(K, V, rowbase + (size_t)qb * 256, h, wid, lane, lds);
    const int qrel = wid * 32 + r32; const size_t t = rowbase + qb * 256 + qrel;
    bf16x8 qr[4];
    { const bf16* qw = Q + t * 512 + h * 64 + hi * 8;
#pragma unroll
      for (int d0 = 0; d0 < 4; ++d0) qr[d0] = *(const bf16x8*)(qw + d0 * 16); }
    __syncthreads();
    MOBA_BLOCK4(4, (void)0)
    const int nsl = qb < 3 ? qb : 3;
    const float* ml = ML + (t * 8 + h) * 6;
    const bf16* pA = YM + t * 1024 + h * 64 + 8 * hi; const bf16* pB = YM + t * 1024 + 512 + h * 64 + 8 * hi;
    const bf16* pC = (t < (size_t)(T / 2) ? P2A + t * 512 : P2B + (t - (size_t)(T / 2)) * 512) + h * 64 + 8 * hi;
    float m0 = -3.0e38f, m1 = -3.0e38f, m2 = -3.0e38f, l0 = 0.f, l1 = 0.f, l2 = 0.f;
    u32x4 xA[4], xB[4], xC[4];
#pragma unroll
    for (int c = 0; c < 4; ++c) { xA[c] = (u32x4){0u, 0u, 0u, 0u}; xB[c] = xA[c]; xC[c] = xA[c]; }
    if (nsl > 0) { m0 = ml[0]; l0 = ml[1];
#pragma unroll
        for (int c = 0; c < 4; ++c) xA[c] = *(const u32x4*)(pA + 16 * c); }
    if (nsl > 1) { m1 = ml[2]; l1 = ml[3];
#pragma unroll
        for (int c = 0; c < 4; ++c) xB[c] = *(const u32x4*)(pB + 16 * c); }
    if (nsl > 2) { m2 = ml[4]; l2 = ml[5];
#pragma unroll
        for (int c = 0; c < 4; ++c) xC[c] = *(const u32x4*)(pC + 16 * c); }
    const float M = __builtin_fmaxf(__builtin_fmaxf(mref, m0), __builtin_fmaxf(m1, m2));
    const float w0 = __builtin_amdgcn_exp2f(mref - M), wa = l0 * __builtin_amdgcn_exp2f(m0 - M), wb = l1 * __builtin_amdgcn_exp2f(m1 - M), wc = l2 * __builtin_amdgcn_exp2f(m2 - M);
    const float inv = 1.f / (hsum(l) * w0 + wa + wb + wc);
    const float s0 = w0 * inv, sa = wa * inv, sb = wb * inv, sc = wc * inv;
    bf16* orow = YM + t * 1024 + 512 + h * 64 + 8 * hi;
#pragma unroll
    for (int d0 = 0; d0 < 2; ++d0)
#pragma unroll
        for (int gp = 0; gp < 2; ++gp) { const f32x16& oo = d0 ? o1 : o0; const int ga = 8 * gp, gb = 8 * gp + 4, dof = 32 * d0 + 16 * gp, cc = 2 * d0 + gp;
            float a0 = oo[ga] * s0, a1 = oo[ga + 1] * s0, a2 = oo[ga + 2] * s0, a3 = oo[ga + 3] * s0, b0 = oo[gb] * s0, b1 = oo[gb + 1] * s0, b2 = oo[gb + 2] * s0, b3 = oo[gb + 3] * s0;
#define MOBA_ACC(X, W) { unsigned fx = X[cc].x, fy = X[cc].y, sx = X[cc].z, sy = X[cc].w; \
              { auto r = __builtin_amdgcn_permlane32_swap(fx, sx, false, false); fx = r[0]; sx = r[1]; } { auto r = __builtin_amdgcn_permlane32_swap(fy, sy, false, false); fy = r[0]; sy = r[1]; } \
              a0 += (W) * bf2f(fx & 0xffffu); a1 += (W) * __builtin_bit_cast(float, fx & 0xffff0000u); a2 += (W) * bf2f(fy & 0xffffu); a3 += (W) * __builtin_bit_cast(float, fy & 0xffff0000u); \
              b0 += (W) * bf2f(sx & 0xffffu); b1 += (W) * __builtin_bit_cast(float, sx & 0xffff0000u); b2 += (W) * bf2f(sy & 0xffffu); b3 += (W) * __builtin_bit_cast(float, sy & 0xffff0000u); }
            MOBA_ACC(xA, sa) MOBA_ACC(xB, sb) MOBA_ACC(xC, sc)
#undef MOBA_ACC
            unsigned ax = cvtpk(a0, a1), ay = cvtpk(a2, a3), bx = cvtpk(b0, b1), by = cvtpk(b2, b3);
            { auto r = __builtin_amdgcn_permlane32_swap(ax, bx, false, false); ax = r[0]; bx = r[1]; }
            { auto r = __builtin_amdgcn_permlane32_swap(ay, by, false, false); ay = r[0]; by = r[1]; }
            *(u32x4*)(orow + dof) = (u32x4){ax, ay, bx, by}; }
}
__device__ __forceinline__ void diag_phase(int wave_, int vcu, const bf16* Q, const bf16* K, const bf16* V, bf16* YM, const bf16* P2A, const bf16* P2B, const float* ML, const float* BT, LAS char* lds) {
    if (vcu >= 256) return;
    int lane_ = lane_id(); asm volatile("" : "+v"(lane_)); asm volatile("" : "+s"(wave_));
    const int s = vcu & 3, bh = vcu >> 2, h = bh & 7;
    fill_bias_table(BT, h, wave_ * 64 + lane_, (LAS float*)(lds + L_TB));
    const float bfar = BT[h * 132 + 128];
#pragma unroll 1
    for (int i = 0; i < 4; ++i) { const int qb = (i == 0) ? s : (i == 1) ? 7 - s : (i == 2) ? 8 + s : 15 - s; diag_unit(wave_, lane_, bh >> 3, h, qb, Q, K, V, YM, P2A, P2B, ML, bfar, lds); }
}
#undef MOBA_CVEC
#undef MOBA_QK
#undef MOBA_NEARMAX
#undef MOBA_STEP
#undef MOBA_BLOCK4
}

__device__ __forceinline__ void ph_cvt_x(const Ctx& F0) {
    const Ctx F = launder(F0);
    const int gw = F.vcu * NWAVES + F.wave, NGW = F.G * NWAVES; float* rs1 = (float*)(F.ws + WS_RS1);
    for (int m = gw; m < T; m += NGW) {
        const f32x4* xr = (const f32x4*)(F.in[0] + (size_t)m * D) + F.lane;
        f32x4 v[4]; float s = 0.f;
#pragma unroll
        for (int j = 0; j < 4; ++j) { v[j] = xr[64 * j]; s += (v[j].x * v[j].x + v[j].y * v[j].y) + (v[j].z * v[j].z + v[j].w * v[j].w); }
        const float rstd = 1.f / sqrtf(wave_sum(s) * (1.f / D) + RMS_EPS);
        if (F.lane == 0) rs1[m] = rstd;
        unsigned long long* o8 = (unsigned long long*)(P_XB(F) + (size_t)m * D) + F.lane;
#pragma unroll
        for (int j = 0; j < 4; ++j) o8[64 * j] = (unsigned long long)pk2(v[j].x, v[j].y) | ((unsigned long long)pk2(v[j].z, v[j].w) << 32);
    }
}
__device__ __forceinline__ float row_ssq_bf16(const bf16* row, int lane) {
    const u32x4* xr = (const u32x4*)row + lane; float s = 0.f;
#pragma unroll
    for (int j = 0; j < 2; ++j) { const u32x4 x = xr[64 * j];
        const float a0 = bf2f(x.x & 0xffffu), a1 = bf2f(x.x >> 16), a2 = bf2f(x.y & 0xffffu), a3 = bf2f(x.y >> 16), a4 = bf2f(x.z & 0xffffu), a5 = bf2f(x.z >> 16), a6 = bf2f(x.w & 0xffffu), a7 = bf2f(x.w >> 16);
        s += ((a0 * a0 + a1 * a1) + (a2 * a2 + a3 * a3)) + ((a4 * a4 + a5 * a5) + (a6 * a6 + a7 * a7)); }
    return wave_sum(s);
}
__device__ __forceinline__ void ph_rstd(const Ctx& F0) {
    const Ctx F = launder(F0);
    const int gw = F.vcu * NWAVES + F.wave, NGW = F.G * NWAVES; float* rs1 = (float*)(F.ws + WS_RS1);
    for (int m = gw; m < T; m += NGW) { const float s = row_ssq_bf16(P_XB(F) + (size_t)m * D, F.lane); if (F.lane == 0) rs1[m] = 1.f / sqrtf(s * (1.f / D) + RMS_EPS); }
}

__device__ __forceinline__ void ph_bias_table(const Ctx& F0) {
    const Ctx F = launder(F0);
    if (F.vcu == 0) {
        const float* rel_bias = F.in[1];
        for (int i = F.tid; i < 8 * 132; i += NTHREADS) {
            const int h = i / 132, r = i % 132;
            int bk;
            if (r < 16) bk = r;
            else { bk = 16 + (int)(logf((float)r / 16.f) / logf(8.f) * 16.f); if (bk > 31) bk = 31; }
            P_BT(F)[i] = rel_bias[bk * 8 + h] * LOG2E;
        }
    }
}

__device__ __forceinline__ void ph_pool_dl(const Ctx& F0) {
    const Ctx F = launder(F0);
    const int gt = F.vcu * NTHREADS + F.tid, NGT = F.G * NTHREADS;
    for (int it = gt; it < (T / 32) * 128; it += NGT) {
        const int cp = it & 127, chunk = it >> 7, c = cp * 2, gi = c >> 6, win = 2 << gi, m0 = chunk * 32, t0 = m0 & (SEQ - 1);
        const unsigned* P2 = (const unsigned*)P_PB(F) + cp; unsigned* D2 = (unsigned*)P_DL(F) + cp;
        float s0 = 0.f, s1 = 0.f;
        const int back = (t0 < win) ? t0 : win;
        for (int j = 1; j <= back; ++j) { const unsigned v = P2[(size_t)(m0 - j) * 128]; s0 += bf2f(v & 0xffffu); s1 += bf2f(v >> 16); }
#pragma unroll 4
        for (int i = 0; i < 32; ++i) { const int m = m0 + i, t = t0 + i;
            const unsigned v = P2[(size_t)m * 128]; const float p0 = bf2f(v & 0xffffu), p1 = bf2f(v >> 16);
            s0 += p0; s1 += p1;
            if (t >= win) { const unsigned o = P2[(size_t)(m - win) * 128]; s0 -= bf2f(o & 0xffffu); s1 -= bf2f(o >> 16); }
            const float inv = 1.f / (float)((t + 1 < win) ? t + 1 : win);
            D2[(size_t)m * 128] = pk2(s0 * inv - p0, s1 * inv - p1); }
    }
}
__device__ __forceinline__ void ph_final(const Ctx& F0) {
    const Ctx F = launder(F0);
    const int gw = F.vcu * NWAVES + F.wave, NGW = F.G * NWAVES;
    const f32x4* gf = (const f32x4*)F.in[26];
    for (int m = gw; m < T; m += NGW) {
        const bf16* row = P_XB(F) + (size_t)m * D;
        const float rstd = 1.f / sqrtf(row_ssq_bf16(row, F.lane) * (1.f / D) + RMS_EPS);
        const u32x4* xr = (const u32x4*)row + F.lane; f32x4* orow = (f32x4*)(F.R + (size_t)m * D);
#pragma unroll
        for (int j = 0; j < 2; ++j) { const u32x4 x = xr[64 * j]; const int c4 = 2 * (64 * j + F.lane);
            orow[c4] = (f32x4){bf2f(x.x & 0xffffu), bf2f(x.x >> 16), bf2f(x.y & 0xffffu), bf2f(x.y >> 16)} * rstd * gf[c4];
            orow[c4 + 1] = (f32x4){bf2f(x.z & 0xffffu), bf2f(x.z >> 16), bf2f(x.w & 0xffffu), bf2f(x.w >> 16)} * rstd * gf[c4 + 1]; }
    }
}

constexpr int LDS_BYTES = 147456;
constexpr int MISC_OFF = 131072 + 320;

__global__ void __launch_bounds__(NTHREADS, 2) mk_fwd(Args args) {
    extern __shared__ __attribute__((aligned(16))) unsigned char lds[];
    Ctx F;
    F.lds = (LAS unsigned char*)lds;
    F.wave = __builtin_amdgcn_readfirstlane((int)threadIdx.x >> 6);
    F.lane = lane_id(); F.tid = F.wave * 64 + F.lane;
    F.G = gridDim.x; { const int bx = blockIdx.x; F.vcu = (F.G % 8 == 0) ? (bx % 8) * (F.G / 8) + bx / 8 : bx; }
    F.in = (KargP)__builtin_amdgcn_kernarg_segment_ptr(); F.R = args.out; F.ws = args.ws;
    unsigned char* ws = args.ws;
    volatile LAS unsigned* MISC = (volatile LAS unsigned*)(F.lds + MISC_OFF);
    if (F.tid < 64) MISC[F.tid] = 0u;
    __syncthreads();
    XcdBarrier bar = xcd_barrier_post((unsigned*)(ws + WS_CTL) + CW_BAR, MISC + 8, F.tid == 0);
#define GRID_BAR() do { bar.bar = (unsigned*)(wsl(ws) + WS_CTL) + CW_BAR; xcd_barrier(bar, F.wave); } while (0)
#define FL launder(F)

    ph_bias_table(F);
    ph_prologue(F);
#pragma unroll 1
    for (int l = 0; l < DEPTH; ++l) {
        if (l == 0) ph_cvt_x(F); else ph_rstd(F);
        GRID_BAR();
        { pg8::Gemm g{P_XB(FL), (const bf16*)(wsl(ws) + WS_WIN) + (size_t)l * NPROJ * D, D, D, D}; pg8::StaticOrder S; S.init(T, NPROJ, sl(F.G), sl((int)blockIdx.x));
          EpiProjE E{P_UG(FL), P_PB(FL), P_QB(FL), P_KB(FL), P_VB(FL), P_KMP(FL), (const float*)(wsl(ws) + WS_RS1)}; pg8::gemm_phase(F.lds, g, S, E, sl(F.wave)); }
        GRID_BAR();
        { pg8::Gemm g{P_UG(FL), (const bf16*)(wsl(ws) + WS_BZ) + (size_t)l * SGN * 256 * 1024, UGP, 1024, 1024}; SsmOrder S{sl(F.G), sl((int)blockIdx.x), 1};
          EpiZ E{(float*)(wsl(ws) + WS_ZB)}; pg8::gemm_phase(F.lds, g, S, E, sl(F.wave)); }
        ph_pool_dl(F);
        moba::sel_phase(sl(F.wave), sl((int)blockIdx.x), sl(F.G), P_QB(FL), P_KMP(FL), (unsigned*)(wsl(ws) + WS_SEL), (LAS char*)F.lds);
        GRID_BAR();
        moba::gather_phase(sl(F.wave), sl(F.vcu), P_QB(FL), P_KB(FL), P_VB(FL), P_YMIX(FL), P_YS(FL), (bf16*)(wsl(ws) + WS_P2B), (float*)(wsl(ws) + WS_ML), (const unsigned*)(wsl(ws) + WS_SEL), P_BT(FL), (LAS char*)F.lds);
        GRID_BAR();
        ph_ssm_scan(F, l);
        ph_tg_expand(F, l);
        moba::diag_phase(sl(F.wave), sl(F.vcu), P_QB(FL), P_KB(FL), P_VB(FL), P_YMIX(FL), P_YS(FL), (const bf16*)(wsl(ws) + WS_P2B), (const float*)(wsl(ws) + WS_ML), P_BT(FL), (LAS char*)F.lds);
        GRID_BAR();
        { pg8::Gemm g{P_UG(FL), (const bf16*)(wsl(ws) + WS_TG) + (size_t)l * SGN * 1024 * UGP, UGP, UGP, UGP}; SsmOrder S{sl(F.G), sl((int)blockIdx.x), 2};
          EpiSsm2 E{P_UG(FL), P_YS(FL), F.in[11] + l * 256}; pg8::gemm_phase(F.lds, g, S, E, sl(F.wave)); }
        GRID_BAR();
        { pg8::Gemm g{P_YS(FL), (const bf16*)(wsl(ws) + WS_GLUT) + (size_t)l * 65536, 256, 256, 256}; HalfOrder S{sl(F.vcu)};
          EpiGluE E{P_YS(FL), P_YMIX(FL), F.in[13] + l * 256}; pg8::gemm_phase(F.lds, g, S, E, sl(F.wave)); }
        { pg8::Gemm g{P_DL(FL), (const bf16*)(wsl(ws) + WS_POOLT) + (size_t)l * 65536, 256, 256, 256}; HalfOrder S{sl(F.vcu) - 128};
          EpiPoolE E{P_YMIX(FL), F.in[15] + l * 256, F.in[16] + l * 256}; pg8::gemm_phase(F.lds, g, S, E, sl(F.wave)); }
        GRID_BAR();
        { pg8::Gemm g{P_YMIX(FL), (const bf16*)(wsl(ws) + WS_WOUT) + (size_t)l * D * D, D, D, D}; pg8::StaticOrder S; S.init(T, D, sl(F.G), sl((int)blockIdx.x));
          EpiOutE E{P_XB(FL)}; pg8::gemm_phase(F.lds, g, S, E, sl(F.wave)); }
        GRID_BAR();
        ph_route(F, l);
        GRID_BAR();
        ph_place(F);
        GRID_BAR();
        { pg8::Gemm g{(const bf16*)(wsl(ws) + WS_XS), (const bf16*)(wsl(ws) + WS_GU) + (size_t)l * 16 * 512 * D, D, D, D}; MoeOrder S{(const int*)(wsl(ws) + WS_TILEB), sl(F.G), sl((int)blockIdx.x), false};
          EpiGU E{(bf16*)(wsl(ws) + WS_HACT), (const float*)(wsl(ws) + WS_ROWW), (const float*)(wsl(ws) + WS_ROWR)}; pg8::gemm_phase(F.lds, g, S, E, sl(F.wave)); }
        GRID_BAR();
        { pg8::Gemm g{(const bf16*)(wsl(ws) + WS_HACT), (const bf16*)(wsl(ws) + WS_WD) + (size_t)l * 24 * D * 512, 512, 512, 512}; MoeOrder S{(const int*)(wsl(ws) + WS_TILEB), sl(F.G), sl((int)blockIdx.x), true};
          EpiDown E{P_XB(FL), (const int*)(wsl(ws) + WS_ROWTOK)}; pg8::gemm_phase(F.lds, g, S, E, sl(F.wave)); }
        GRID_BAR();
    }
    ph_final(F);
}

extern "C" void kernel_launch(void* const* d_in, const int* in_sizes, int n_in, void* d_out, int out_size, void* d_ws, size_t ws_size, hipStream_t stream) {
    static int grid = 0;
    if (grid == 0) {
        if (n_in != 27 || out_size != T * D || ws_size < WS_END) { fprintf(stderr, "kernel_launch: unexpected shapes (n_in %d out %d ws %zu)\n", n_in, out_size, ws_size); grid = -1; return; }
        int dev = 0, cus = 0, per_cu = 0;
        if (hipGetDevice(&dev) != hipSuccess || hipDeviceGetAttribute(&cus, hipDeviceAttributeMultiprocessorCount, dev) != hipSuccess) { grid = -1; return; }
        if (hipFuncSetAttribute((const void*)mk_fwd, hipFuncAttributeMaxDynamicSharedMemorySize, LDS_BYTES) != hipSuccess) { fprintf(stderr, "kernel_launch: hipFuncSetAttribute failed\n"); grid = -1; return; }
        if (hipOccupancyMaxActiveBlocksPerMultiprocessor(&per_cu, (const void*)mk_fwd, NTHREADS, LDS_BYTES) != hipSuccess || per_cu < 1) { fprintf(stderr, "kernel_launch: occupancy query says %d\n", per_cu); per_cu = 1; }
        (void)hipGetLastError();
        grid = cus;
    }
    if (grid < 0) return;
    (void)hipMemsetAsync((char*)d_ws + WS_CTL, 0, CTL_ZERO_BYTES, stream);
    Args a{};
    for (int i = 0; i < 27; ++i) a.in[i] = (const float*)d_in[i];
    a.out = (float*)d_out; a.ws = (unsigned char*)d_ws; a.pad0 = 0; a.pad1 = 0;
    hipLaunchKernelGGL(mk_fwd, dim3(grid), dim3(NTHREADS), LDS_BYTES, stream, a);
}
```

```cpp
#include <hip/hip_runtime.h>
#include <hip/hip_bf16.h>
#include <cstdio>
#include <cstdint>

#define GAS __attribute__((address_space(1)))
#define LAS __attribute__((address_space(3)))
typedef unsigned short bf16;
typedef float f32x4 __attribute__((ext_vector_type(4)));
typedef unsigned u32x4 __attribute__((ext_vector_type(4)));
typedef unsigned u32x2 __attribute__((ext_vector_type(2)));

constexpr int NB = 8, SEQ = 4096, T = NB * SEQ, D = 1024, NPROJ = 2048, DEPTH = 2;
constexpr int NHEAD = 8, HD = 64, MBLK = 256, NBLK = SEQ / MBLK;
constexpr int SG = 16, SGN = 16, SP = 64, SCH = 64, UGP = 1152;
constexpr float RMS_EPS = 1e-6f;
constexpr float LOG2E = 1.4426950408889634f;
constexpr float C2 = 0.125f * LOG2E;
constexpr int NWAVES = 8, NTHREADS = 512;

constexpr size_t MiB = 1u << 20;
constexpr size_t WS_CTL = 0, CTL_ZERO_BYTES = 1 * MiB;
constexpr size_t WS_XB = 2 * MiB;
constexpr size_t WS_UG = 66 * MiB;
constexpr size_t WS_PB = 84 * MiB;
constexpr size_t WS_QB = 100 * MiB;
constexpr size_t WS_KB = 132 * MiB;
constexpr size_t WS_VB = 164 * MiB;
constexpr size_t WS_YMIX = 196 * MiB;
constexpr size_t WS_YS = 260 * MiB;
constexpr size_t WS_DL = 276 * MiB;
constexpr size_t WS_KMP = 292 * MiB;
constexpr size_t WS_BT = 293 * MiB;
constexpr size_t WS_KT = 297 * MiB;
constexpr size_t WS_SEL = 298 * MiB;
constexpr size_t WS_WIN = 300 * MiB;
constexpr size_t WS_WOUT = 308 * MiB;
constexpr size_t WS_GU = 312 * MiB;
constexpr size_t WS_WD = 344 * MiB;
constexpr size_t WS_TG = 392 * MiB;
constexpr size_t WS_BZ = 464 * MiB;
constexpr size_t WS_GLUT = 480 * MiB;
constexpr size_t WS_POOLT = WS_GLUT + 512 * 1024;
constexpr size_t WS_ZB = 482 * MiB;
constexpr size_t WS_P2B = 486 * MiB;
constexpr size_t WS_ML = 502 * MiB;
constexpr size_t WS_END = 508 * MiB;
constexpr int MOE_MAXT = 152;
constexpr size_t WS_XS = 66 * MiB;
constexpr size_t WS_HACT = 142 * MiB;
constexpr size_t WS_TOKB = 294 * MiB;
constexpr size_t WS_TOKR = WS_TOKB + 128 * 1024;
constexpr size_t WS_TOKW = WS_TOKB + 256 * 1024;
constexpr size_t WS_ROWTOK = 295 * MiB;
constexpr size_t WS_ROWW = WS_ROWTOK + 256 * 1024;
constexpr size_t WS_ROWR = WS_ROWTOK + 576 * 1024;
constexpr size_t WS_RS1 = WS_ROWTOK + 768 * 1024;
constexpr size_t WS_WGCNT = 296 * MiB;
constexpr size_t WS_TILEB = WS_WGCNT + 64 * 1024;

constexpr int CW_BAR = 4096;

__device__ __forceinline__ unsigned f2bf(float f) { unsigned u = __builtin_bit_cast(unsigned, f); return (u + 0x7fffu + ((u >> 16) & 1u)) >> 16; }
__device__ __forceinline__ float bf2f(unsigned h) { return __builtin_bit_cast(float, h << 16); }
__device__ __forceinline__ unsigned pk2(float lo, float hi) { return f2bf(lo) | (f2bf(hi) << 16); }
template <int O> __device__ __forceinline__ float xshfl(float v) {
    if constexpr (O < 32) return __builtin_bit_cast(float, __builtin_amdgcn_ds_swizzle(__builtin_bit_cast(int, v), (O << 10) | 0x1f));
    else { const unsigned u = __builtin_bit_cast(unsigned, v); auto r = __builtin_amdgcn_permlane32_swap(u, u, false, false);
           const float a = __builtin_bit_cast(float, (unsigned)r[0]), b = __builtin_bit_cast(float, (unsigned)r[1]); return (a == v && __builtin_bit_cast(unsigned, a) == u) ? b : a; }
}
__device__ __forceinline__ float wave_sum(float v) {
    v += xshfl<1>(v); v += xshfl<2>(v); v += xshfl<4>(v); v += xshfl<8>(v); v += xshfl<16>(v);
    const unsigned u = __builtin_bit_cast(unsigned, v); auto r = __builtin_amdgcn_permlane32_swap(u, u, false, false);
    return __builtin_bit_cast(float, (unsigned)r[0]) + __builtin_bit_cast(float, (unsigned)r[1]);
}
__device__ __forceinline__ float wave_max(float v) {
    v = fmaxf(v, xshfl<1>(v)); v = fmaxf(v, xshfl<2>(v)); v = fmaxf(v, xshfl<4>(v)); v = fmaxf(v, xshfl<8>(v)); v = fmaxf(v, xshfl<16>(v));
    const unsigned u = __builtin_bit_cast(unsigned, v); auto r = __builtin_amdgcn_permlane32_swap(u, u, false, false);
    return fmaxf(__builtin_bit_cast(float, (unsigned)r[0]), __builtin_bit_cast(float, (unsigned)r[1]));
}
__device__ __forceinline__ float gelu_tanh(float x) {
    const float u = 0.7978845608028654f * (x + 0.044715f * x * x * x);
    const float e = __expf(2.f * u);
    const float th = 1.f - 2.f / (e + 1.f);
    return 0.5f * x * (1.f + th);
}
__device__ __forceinline__ float sigmoidf_(float x) { return 1.f / (1.f + __expf(-x)); }

__device__ __forceinline__ int lane_id() { unsigned m; asm volatile("s_mov_b32 %0, -1" : "=s"(m)); return (int)__builtin_amdgcn_mbcnt_hi(m, __builtin_amdgcn_mbcnt_lo(m, 0u)); }

#define XB_TMO      128
#define XB_XCNT(j)  (256  + 64 * (j))
#define XB_XSUB(j)  (1280 + 64 * (j))
#define XB_XGEN(j)  (2304 + 64 * (j))
#define XB_TOP      3328
#define XB_TOPGEN   3392
#define XCD_BAR_WORDS 3456
#define XB_SPIN_CAP (1u << 22)
__device__ __forceinline__ unsigned xb_ld(unsigned* p)              { return __hip_atomic_load(p, __ATOMIC_RELAXED, __HIP_MEMORY_SCOPE_AGENT); }
__device__ __forceinline__ unsigned xb_add(unsigned* p, unsigned v) { return __hip_atomic_fetch_add(p, v, __ATOMIC_RELAXED, __HIP_MEMORY_SCOPE_AGENT); }
__device__ __forceinline__ unsigned xb_xcc_id() { return (unsigned)__builtin_amdgcn_s_getreg((3 << 11) | 20) & 0xFu; }
#define XB_SPIN(cond, bar) do { unsigned _sp = 0; while (cond) { __builtin_amdgcn_s_sleep(1); \
    if ((++_sp & 255u) == 0u) { if (xb_ld(&(bar)[XB_TMO])) break; if (_sp > XB_SPIN_CAP) { atomicAdd(&(bar)[XB_TMO], 1u); break; } } } } while (0)
struct XcdBarrier { unsigned* bar; unsigned x; volatile LAS unsigned* st; };
__device__ __forceinline__ XcdBarrier xcd_barrier_post(unsigned* bar, volatile LAS unsigned* st, bool t0) {
    XcdBarrier b; b.bar = bar; b.x = xb_xcc_id(); b.st = st;
    if (t0) (void)xb_add(&bar[XB_XCNT(b.x)], 1u);
    return b;
}
__device__ __forceinline__ void xcd_barrier_complete(unsigned* bar, unsigned x, unsigned& nloc, unsigned& nx) {
    const unsigned G = gridDim.x * gridDim.y * gridDim.z;
    unsigned sum, cnt, mine, sp = 0u;
    for (;;) {
        sum = 0u; cnt = 0u; mine = 0u;
#pragma unroll
        for (unsigned j = 0; j < 16; ++j) { const unsigned c = xb_ld(&bar[XB_XCNT(j)]); sum += c; cnt += (c > 0u) ? 1u : 0u; mine = (j == x) ? c : mine; }
        if (sum == G) break;
        __builtin_amdgcn_s_sleep(1);
        if ((++sp & 255u) == 0u) { if (xb_ld(&bar[XB_TMO])) break; if (sp > XB_SPIN_CAP) { atomicAdd(&bar[XB_TMO], 1u); break; } }
    }
    nloc = mine > 0u ? mine : 1u; nx = cnt > 0u ? cnt : 1u;
}
__device__ __forceinline__ void xcd_barrier(const XcdBarrier& b, int wave) {
    asm volatile("s_waitcnt vmcnt(0)" ::: "memory");
    __syncthreads();
    if (wave == 0 && lane_id() == 0) {
        unsigned* bar = b.bar;
        __builtin_amdgcn_s_waitcnt(0);
        unsigned nloc = b.st[0], nx = b.st[1];
        if (nloc == 0u) { xcd_barrier_complete(bar, b.x, nloc, nx); b.st[0] = nloc; b.st[1] = nx; }
        const unsigned old = xb_add(&bar[XB_XSUB(b.x)], 1u);
        const unsigned gen = old / nloc;
        if (old + 1u == (gen + 1u) * nloc) {
            __builtin_amdgcn_fence(__ATOMIC_RELEASE, "agent");
            asm volatile("s_waitcnt vmcnt(0)" ::: "memory");
            const unsigned og = xb_add(&bar[XB_TOP], 1u);
            const unsigned tg = og / nx;
            if (og + 1u == (tg + 1u) * nx) xb_add(&bar[XB_TOPGEN], 1u);
            else XB_SPIN(xb_ld(&bar[XB_TOPGEN]) == tg, bar);
            __builtin_amdgcn_fence(__ATOMIC_ACQUIRE, "agent");
            xb_add(&bar[XB_XGEN(b.x)], 1u);
            asm volatile("s_waitcnt vmcnt(0)" ::: "memory");
        } else {
            XB_SPIN(xb_ld(&bar[XB_XGEN(b.x)]) == gen, bar);
            __builtin_amdgcn_fence(__ATOMIC_ACQUIRE, "agent");
            asm volatile("s_waitcnt vmcnt(0)" ::: "memory");
        }
    }
    __syncthreads();
}

struct Args {
    const float* in[27];
    float* out;
    unsigned char* ws;
    int pad0, pad1;
};

typedef const float* fptr_t;
typedef __attribute__((address_space(4))) const fptr_t* KargP;
struct Ctx {
    LAS unsigned char* lds;
    int tid, lane, wave, vcu, G;
    KargP in;
    float* R;
    unsigned char* ws;
};
#define P_XB(F) ((bf16*)((F).ws + WS_XB))
#define P_UG(F) ((bf16*)((F).ws + WS_UG))
#define P_PB(F) ((bf16*)((F).ws + WS_PB))
#define P_QB(F) ((bf16*)((F).ws + WS_QB))
#define P_KB(F) ((bf16*)((F).ws + WS_KB))
#define P_VB(F) ((bf16*)((F).ws + WS_VB))
#define P_YMIX(F) ((bf16*)((F).ws + WS_YMIX))
#define P_YS(F) ((bf16*)((F).ws + WS_YS))
#define P_DL(F) ((bf16*)((F).ws + WS_DL))
#define P_KMP(F) ((float*)((F).ws + WS_KMP))
#define P_BT(F) ((float*)((F).ws + WS_BT))


__device__ __forceinline__ Ctx launder(const Ctx& F0) {
    Ctx F = F0;
    int ln = lane_id(); asm volatile("" : "+v"(ln));
    asm volatile("" : "+s"(F.wave), "+s"(F.vcu), "+s"(F.G));
    F.lane = ln; F.tid = F.wave * 64 + ln;
    KargP kp = (KargP)__builtin_amdgcn_kernarg_segment_ptr(); asm volatile("" : "+s"(kp));
    F.in = kp; F.R = (float*)kp[27]; F.ws = (unsigned char*)kp[28];
    return F;
}

__device__ __forceinline__ unsigned char* wsl(unsigned char* p) { asm volatile("" : "+s"(p)); return p; }
__device__ __forceinline__ int sl(int x) { asm volatile("" : "+s"(x)); return x; }

namespace pg8 {
typedef short bf16x8 __attribute__((ext_vector_type(8)));
constexpr int BM = 256, BK = 64, HALF = 128, HTB = HALF * BK * 2, STAGE_BYTES = 8 * HTB, NXCD = 8, WGM = 8;
__device__ __forceinline__ int lds_byte(int r, int c) { const int st = (r >> 4) * 2 + (c >> 5), rr = r & 15, cc = c & 31, ob = rr * 64 + cc * 2; return st * 1024 + (ob ^ (((ob >> 9) & 1) << 5)); }
__device__ __forceinline__ void stage_rc(int b, int& R, int& C) { const int st = b / 1024, sb = b % 1024, swz = sb ^ (((sb >> 9) & 1) << 5); R = (st >> 1) * 16 + swz / 64; C = (st & 1) * 32 + (swz % 64) / 2; }
__device__ __forceinline__ int perm32(int rho) { const int n = rho >> 4, i = rho & 15; return 8 * (i >> 2) + 4 * n + (i & 3); }

struct Unit { int pm, pn, aux; };
struct Gemm { const bf16* A; const bf16* Bt; int lda, ldb, K; };

struct StaticOrder {
    int nM, nN, nwg, G, c;
    __device__ void init(int M, int N, int G_, int c_) { nM = M / BM; nN = N / BM; nwg = nM * nN; G = G_; c = c_; }
    __device__ bool next(int i, Unit& u) const {
        const long L = (long)i * G + c; if (L >= nwg) return false;
        int wgid = (int)L; { const int q = nwg / NXCD, r = nwg % NXCD, xcd = wgid % NXCD, off = wgid / NXCD; wgid = (xcd < r ? xcd * (q + 1) : r * (q + 1) + (xcd - r) * q) + off; }
        const int nig = WGM * nN, gid = wgid / nig, fm = gid * WGM, gsz = (nM - fm) < WGM ? (nM - fm) : WGM;
        u.pm = fm + ((wgid % nig) % gsz); u.pn = (wgid % nig) / gsz; u.aux = 0; return true;
    }
};

__device__ __forceinline__ unsigned cvt_pk_bf16(float lo, float hi) { unsigned r; asm volatile("v_cvt_pk_bf16_f32 %0, %1, %2" : "=v"(r) : "v"(lo), "v"(hi)); return r; }

template <bool ALIGN = true, class Epi, class Sched>
__device__ __forceinline__ void gemm_phase(LAS unsigned char* lds, const Gemm g, const Sched& S, const Epi& E, int wave_) {
    int lane_ = lane_id(); asm volatile("" : "+v"(lane_)); asm volatile("" : "+s"(wave_));
    const int wid = wave_, lane = lane_, tid = wid * 64 + lane, wr = wid >> 2, wc = wid & 3, fr = lane & 15, fq = lane >> 4;
    const int K = g.K, nt = K / BK;
    unsigned voffA[2], voffB[2];
#pragma unroll
    for (int i = 0; i < 2; ++i) { int R, C; stage_rc(tid * 16 + i * 8192, R, C); const int Rb = Epi::PERM ? ((R & ~31) + perm32(R & 31)) : R;
        voffA[i] = (unsigned)(R * g.lda + C) * 2u; voffB[i] = (unsigned)(Rb * g.ldb + C) * 2u; }
    const size_t kstep = (size_t)(BK * 2);
    const size_t hstepA = (size_t)HALF * g.lda * 2, hstepB = (size_t)HALF * g.ldb * 2;
    const size_t tstepA = 2 * hstepA, tstepB = 2 * hstepB;
    const unsigned ldsw = (unsigned)wid * 1024u;
    const int aoff = lds_byte(wr * 64 + fr, fq * 8), boff = lds_byte(wc * 32 + fr, fq * 8);
#define PG8_SA(b, h) (((b) * 2 + (h)) * HTB)
#define PG8_SB(b, h) ((4 + (b) * 2 + (h)) * HTB)
#define PG8_STAGE(bufoff, gbase, voff) do { _Pragma("unroll") for (int _i = 0; _i < 2; ++_i) \
        __builtin_amdgcn_global_load_lds((const unsigned*)((const char*)(gbase) + (voff)[_i]), (LAS unsigned*)(lds + (bufoff) + ldsw + _i * 8192), 16, 0, 0); } while (0)
#define PG8_LDA(dst, b, h) do { _Pragma("unroll") for (int m = 0; m < 4; ++m) _Pragma("unroll") for (int k = 0; k < 2; ++k) dst[m][k] = *(const LAS bf16x8*)(lds + PG8_SA(b, h) + aoff + m * 2048 + k * 1024); } while (0)
#define PG8_LDB(dst, b, h) do { _Pragma("unroll") for (int n = 0; n < 2; ++n) _Pragma("unroll") for (int k = 0; k < 2; ++k) dst[n][k] = *(const LAS bf16x8*)(lds + PG8_SB(b, h) + boff + n * 2048 + k * 1024); } while (0)
#define PG8_MMA(ai, bj, At, Bt) do { __builtin_amdgcn_s_setprio(1); _Pragma("unroll") for (int m = 0; m < 4; ++m) _Pragma("unroll") for (int n = 0; n < 2; ++n) _Pragma("unroll") for (int k = 0; k < 2; ++k) \
        acc[ai][bj][m][n] = __builtin_amdgcn_mfma_f32_16x16x32_bf16(Bt[n][k], At[m][k], acc[ai][bj][m][n], 0, 0, 0); __builtin_amdgcn_s_setprio(0); } while (0)
#define PG8_WAIT_V(n) asm volatile("s_waitcnt vmcnt(" #n ")" ::: "memory")
#define PG8_WAIT_L(n) asm volatile("s_waitcnt lgkmcnt(" #n ")" ::: "memory")
#define PG8_BAR __builtin_amdgcn_s_barrier()
#define PG8_SCHED __builtin_amdgcn_sched_barrier(0)
    Unit cur, nxt; int ui = 0;
    if (!S.next(0, cur)) return;
    f32x4 acc[2][2][4][2];
#pragma unroll
    for (int a = 0; a < 2; ++a)
#pragma unroll
        for (int b = 0; b < 2; ++b)
#pragma unroll
            for (int m = 0; m < 4; ++m)
#pragma unroll
                for (int n = 0; n < 2; ++n) acc[a][b][m][n] = (f32x4){0.f, 0.f, 0.f, 0.f};
    bf16x8 At[4][2], B0[2][2], B1[2][2];
    const char* cA = (const char*)g.A + (size_t)cur.pm * tstepA; const char* cB = (const char*)g.Bt + (size_t)cur.pn * tstepB;
    PG8_STAGE(PG8_SB(0, 0), cB, voffB); PG8_STAGE(PG8_SB(0, 1), cB + hstepB, voffB); PG8_STAGE(PG8_SA(0, 0), cA, voffA); PG8_STAGE(PG8_SA(0, 1), cA + hstepA, voffA);
    if (wr == 1) PG8_BAR;
    PG8_WAIT_V(2); PG8_BAR;
    PG8_STAGE(PG8_SB(1, 0), cB + kstep, voffB); PG8_STAGE(PG8_SA(1, 0), cA + kstep, voffA); PG8_STAGE(PG8_SB(1, 1), cB + hstepB + kstep, voffB);
    PG8_WAIT_V(6); PG8_BAR;
    for (;;) {
        const bool has_next = S.next(ui + 1, nxt);
        const char* nA = has_next ? (const char*)g.A + (size_t)nxt.pm * tstepA : cA; const char* nB = has_next ? (const char*)g.Bt + (size_t)nxt.pn * tstepB : cB;
        for (int t = 0; t < nt; t += 2) {
            const bool last = (t == nt - 2);
            const char* a1 = cA + (size_t)(t + 1) * kstep;
            const char* a2 = last ? nA : cA + (size_t)(t + 2) * kstep; const char* b2 = last ? nB : cB + (size_t)(t + 2) * kstep;
            const char* a3 = a2 + kstep; const char* b3 = b2 + kstep;
            PG8_LDB(B0, 0, 0); PG8_LDB(B1, 0, 1); PG8_SCHED; PG8_LDA(At, 0, 0); PG8_STAGE(PG8_SA(1, 1), a1 + hstepA, voffA);
            PG8_WAIT_V(8); PG8_WAIT_L(0); PG8_BAR; PG8_MMA(0, 0, At, B0); PG8_MMA(0, 1, At, B1); PG8_BAR; PG8_SCHED;
            PG8_LDA(At, 0, 1); PG8_STAGE(PG8_SB(0, 0), b2, voffB); PG8_STAGE(PG8_SB(0, 1), b2 + hstepB, voffB); PG8_STAGE(PG8_SA(0, 0), a2, voffA);
            PG8_WAIT_V(8); PG8_WAIT_L(0); PG8_BAR; PG8_MMA(1, 0, At, B0); PG8_MMA(1, 1, At, B1); PG8_BAR; PG8_SCHED;
            PG8_LDB(B0, 1, 0); PG8_LDB(B1, 1, 1); PG8_SCHED; PG8_LDA(At, 1, 0); PG8_STAGE(PG8_SA(0, 1), a2 + hstepA, voffA);
            PG8_WAIT_V(8); PG8_WAIT_L(0); PG8_BAR; PG8_MMA(0, 0, At, B0); PG8_MMA(0, 1, At, B1); PG8_BAR; PG8_SCHED;
            PG8_LDA(At, 1, 1); PG8_STAGE(PG8_SB(1, 0), b3, voffB); PG8_STAGE(PG8_SB(1, 1), b3 + hstepB, voffB); PG8_STAGE(PG8_SA(1, 0), a3, voffA);
            PG8_WAIT_V(8); PG8_WAIT_L(0); PG8_BAR; PG8_MMA(1, 0, At, B0); PG8_MMA(1, 1, At, B1); PG8_BAR; PG8_SCHED;
        }
        if constexpr (ALIGN) { if (wr == 0) PG8_BAR; }
        E(acc, cur, wr, wc, fr, fq);
        if (!has_next) break;
#pragma unroll
        for (int a = 0; a < 2; ++a)
#pragma unroll
            for (int b = 0; b < 2; ++b)
#pragma unroll
                for (int m = 0; m < 4; ++m)
#pragma unroll
                    for (int n = 0; n < 2; ++n) acc[a][b][m][n] = (f32x4){0.f, 0.f, 0.f, 0.f};
        cur = nxt; cA = nA; cB = nB; ++ui;
        if constexpr (ALIGN) { if (wr == 1) PG8_BAR; }
    }
    PG8_WAIT_V(0);
    if constexpr (!ALIGN) { if (wr == 0) PG8_BAR; }
    PG8_BAR;
#undef PG8_SA
#undef PG8_SB
#undef PG8_STAGE
#undef PG8_LDA
#undef PG8_LDB
#undef PG8_MMA
#undef PG8_WAIT_V
#undef PG8_WAIT_L
#undef PG8_BAR
#undef PG8_SCHED
}
}


struct EpiProjE {
    static constexpr bool PERM = true;
    bf16 *UG, *PB, *QB, *KB, *VB; float* KMP; const float* rs1;
    __device__ __forceinline__ void operator()(const f32x4 (&acc_)[2][2][4][2], const pg8::Unit& u, int wr, int wc, int fr_, int fq_) const {
        const int ln_ = lane_id(), fr = ln_ & 15, fq = ln_ >> 4; (void)fr_; (void)fq_;
        const int pn = u.pn, row0 = u.pm * 256 + wr * 64 + fr, cl = wc * 32 + 8 * fq;
        f32x4 acc[2][2][4][2];
#pragma unroll
        for (int ai = 0; ai < 2; ++ai)
#pragma unroll
            for (int m = 0; m < 4; ++m) { const float rs = rs1[row0 + ai * 128 + m * 16];
#pragma unroll
                for (int bj = 0; bj < 2; ++bj) { acc[ai][bj][m][0] = acc_[ai][bj][m][0] * rs; acc[ai][bj][m][1] = acc_[ai][bj][m][1] * rs; } }
        if (pn == 0) {
#pragma unroll
            for (int ai = 0; ai < 2; ++ai)
#pragma unroll
                for (int m = 0; m < 4; ++m) { const int r = row0 + ai * 128 + m * 16;
#pragma unroll
                    for (int bj = 0; bj < 2; ++bj) { const int ch = bj * 128 + cl, g = ch >> 4, h0 = ch & 15;
                        const f32x4 v0 = acc[ai][bj][m][0], v1 = acc[ai][bj][m][1]; u32x4 w;
                        w.x = pg8::cvt_pk_bf16(v0[0], v0[1]); w.y = pg8::cvt_pk_bf16(v0[2], v0[3]); w.z = pg8::cvt_pk_bf16(v1[0], v1[1]); w.w = pg8::cvt_pk_bf16(v1[2], v1[3]);
                        *(u32x4*)(UG + ((size_t)(g * 512 + (r >> 6))) * UGP + (r & 63) * 16 + h0) = w; } }
        } else {
            bf16* base; int ldc, colt; float sc = 1.f;
            if (pn == 1) { base = PB; ldc = 256; colt = 0; }
            else if (pn < 4) { base = QB; ldc = 512; colt = (pn - 2) * 256; sc = C2; }
            else if (pn < 6) { base = KB; ldc = 512; colt = (pn - 4) * 256; }
            else { base = VB; ldc = 512; colt = (pn - 6) * 256; }
#pragma unroll
            for (int ai = 0; ai < 2; ++ai)
#pragma unroll
                for (int m = 0; m < 4; ++m) { bf16* rowp = base + (size_t)(row0 + ai * 128 + m * 16) * ldc + colt + cl;
#pragma unroll
                    for (int bj = 0; bj < 2; ++bj) { const f32x4 v0 = acc[ai][bj][m][0] * sc, v1 = acc[ai][bj][m][1] * sc; u32x4 w;
                        w.x = pg8::cvt_pk_bf16(v0[0], v0[1]); w.y = pg8::cvt_pk_bf16(v0[2], v0[3]); w.z = pg8::cvt_pk_bf16(v1[0], v1[1]); w.w = pg8::cvt_pk_bf16(v1[2], v1[3]);
                        *(u32x4*)(rowp + bj * 128) = w; } }
            if (pn >= 4 && pn < 6) {
#pragma unroll
                for (int bj = 0; bj < 2; ++bj)
#pragma unroll
                    for (int n = 0; n < 2; ++n) { f32x4 s = (f32x4){0.f, 0.f, 0.f, 0.f};
#pragma unroll
                        for (int ai = 0; ai < 2; ++ai)
#pragma unroll
                            for (int m = 0; m < 4; ++m) s += acc[ai][bj][m][n];
#pragma unroll
                        for (int i = 0; i < 4; ++i) { float t = s[i]; t += xshfl<1>(t); t += xshfl<2>(t); t += xshfl<4>(t); t += xshfl<8>(t); s[i] = t; }
                        if (fr == 0) *(f32x4*)(KMP + (size_t)wr * 128 * 512 + (size_t)u.pm * 512 + colt + bj * 128 + cl + 4 * n) = s; }
            }
        }
    }
};
struct EpiOutE {
    static constexpr bool PERM = true;
    bf16* RB;
    __device__ __forceinline__ void operator()(const f32x4 (&acc)[2][2][4][2], const pg8::Unit& u, int wr, int wc, int fr_, int fq_) const {
        const int ln_ = lane_id(), fr = ln_ & 15, fq = ln_ >> 4; (void)fr_; (void)fq_;
        const int row0 = u.pm * 256 + wr * 64 + fr, col0 = u.pn * 256 + wc * 32 + 8 * fq;
#pragma unroll
        for (int ai = 0; ai < 2; ++ai) { u32x4 x[4][2];
#pragma unroll
            for (int m = 0; m < 4; ++m) { const bf16* rp = RB + (size_t)(row0 + ai * 128 + m * 16) * D + col0; x[m][0] = *(const u32x4*)rp; x[m][1] = *(const u32x4*)(rp + 128); }
#pragma unroll
            for (int m = 0; m < 4; ++m) { bf16* rp = RB + (size_t)(row0 + ai * 128 + m * 16) * D + col0;
#pragma unroll
                for (int bj = 0; bj < 2; ++bj) { const u32x4 xx = x[m][bj]; const f32x4 a0 = acc[ai][bj][m][0], a1 = acc[ai][bj][m][1]; u32x4 w;
                    w.x = pg8::cvt_pk_bf16(bf2f(xx.x & 0xffffu) + a0[0], bf2f(xx.x >> 16) + a0[1]); w.y = pg8::cvt_pk_bf16(bf2f(xx.y & 0xffffu) + a0[2], bf2f(xx.y >> 16) + a0[3]);
                    w.z = pg8::cvt_pk_bf16(bf2f(xx.z & 0xffffu) + a1[0], bf2f(xx.z >> 16) + a1[1]); w.w = pg8::cvt_pk_bf16(bf2f(xx.w & 0xffffu) + a1[2], bf2f(xx.w >> 16) + a1[3]);
                    *(u32x4*)(rp + bj * 128) = w; } }
            asm volatile("" ::: "memory"); }
    }
};

__device__ __forceinline__ void transpose_item(const float* W, int K, int N, const float* kscale, bf16* WT, int ldo, int koff, int rowmode, LAS float* scr, int item, int lane) {
    const int nblk = N / 32, kb = item / nblk, nb = item % nblk, k0 = 64 * kb, n0 = 32 * nb;
    { const int r8 = lane >> 3, c4 = lane & 7; f32x4 v[8];
#pragma unroll
      for (int i = 0; i < 8; ++i) v[i] = *(const f32x4*)(W + (size_t)(k0 + 8 * i + r8) * N + n0 + 4 * c4);
#pragma unroll
      for (int i = 0; i < 8; ++i) { const int kk = 8 * i + r8; const float s = kscale ? kscale[k0 + kk] : 1.f; LAS float* d = scr + kk * 33 + 4 * c4;
          d[0] = v[i][0] * s; d[1] = v[i][1] * s; d[2] = v[i][2] * s; d[3] = v[i][3] * s; } }
    asm volatile("s_waitcnt lgkmcnt(0)" ::: "memory");
    const int c = lane & 7;
#pragma unroll
    for (int j = 0; j < 4; ++j) { const int n = (lane >> 3) + 8 * j; const LAS float* s = scr + (8 * c) * 33 + n;
        u32x4 o; o.x = pk2(s[0 * 33], s[1 * 33]); o.y = pk2(s[2 * 33], s[3 * 33]); o.z = pk2(s[4 * 33], s[5 * 33]); o.w = pk2(s[6 * 33], s[7 * 33]);
        const int nn = n0 + n, row = rowmode == 0 ? nn : (8 * (nn >> 2) + (nn & 3) + (rowmode == 2 ? 4 : 0));
        *(u32x4*)(WT + (size_t)row * ldo + koff + k0 + 8 * c) = o; }
    asm volatile("s_waitcnt lgkmcnt(0)" ::: "memory");
}
__device__ __forceinline__ void pair_decode(int pi, int& ea, int& eb) { ea = pi < 3 ? 0 : (pi < 5 ? 1 : 2); eb = pi < 3 ? pi + 1 : (pi < 5 ? pi - 1 : 3); }
__device__ __forceinline__ void ph_prologue(const Ctx& F0) {
    const Ctx F = launder(F0);
    LAS float* scr = (LAS float*)(F.lds + F.wave * 16384);
    const int gw = F.vcu * NWAVES + F.wave, NGW = F.G * NWAVES;
    constexpr int I_IN = (D / 64) * (NPROJ / 32), I_OUT = (D / 64) * (D / 32), I_GU1 = (D / 64) * (256 / 32), I_GU = 16 * 2 * I_GU1, I_WD1 = (256 / 64) * (D / 32), I_WD = 24 * 2 * I_WD1;
    constexpr int I_L = I_IN + I_OUT + I_GU + I_WD;
    for (int it = gw; it < DEPTH * I_L; it += NGW) {
        const int l = it / I_L; int r = it % I_L;
        if (r < I_IN) { transpose_item(F.in[3] + (size_t)l * D * NPROJ, D, NPROJ, F.in[2] + l * D, (bf16*)(F.ws + WS_WIN) + (size_t)l * NPROJ * D, D, 0, 0, scr, r, F.lane); continue; } r -= I_IN;
        if (r < I_OUT) { transpose_item(F.in[17] + (size_t)l * D * D, D, D, nullptr, (bf16*)(F.ws + WS_WOUT) + (size_t)l * D * D, D, 0, 0, scr, r, F.lane); continue; } r -= I_OUT;
        if (r < I_GU) { const int e = r / (2 * I_GU1), up = (r / I_GU1) & 1, item = r % I_GU1;
            transpose_item(F.in[up ? 24 : 23] + ((size_t)l * 16 + e) * D * 256, D, 256, F.in[18] + l * D, (bf16*)(F.ws + WS_GU) + ((size_t)l * 16 + e) * 512 * D, D, 0, 1 + up, scr, item, F.lane); continue; } r -= I_GU;
        { const int bk = r / (2 * I_WD1), half = (r / I_WD1) & 1, item = r % I_WD1, g = bk / 6; int ea, eb; pair_decode(bk % 6, ea, eb); const int e = g * 4 + (half ? eb : ea);
            transpose_item(F.in[25] + ((size_t)l * 16 + e) * 256 * D, 256, D, nullptr, (bf16*)(F.ws + WS_WD) + ((size_t)l * 24 + bk) * D * 512, 512, half * 256, 0, scr, item, F.lane); }
    }
    for (int it = gw; it < DEPTH * 32; it += NGW) { const int l = it >> 5;
        transpose_item(F.in[12] + (size_t)l * 256 * 256, 256, 256, nullptr, (bf16*)(F.ws + WS_GLUT) + (size_t)l * 65536, 256, 0, 0, scr, it & 31, F.lane); }
    { const int gt = F.vcu * NTHREADS + F.tid, NGT = F.G * NTHREADS;
      for (int i = gt; i < DEPTH * 65536; i += NGT) { const int l = i >> 16, n = (i >> 8) & 255, k = i & 255;
          const float v = ((n >> 6) == (k >> 6)) ? F.in[14][(((size_t)l * 4 + (n >> 6)) * 64 + (k & 63)) * 64 + (n & 63)] : 0.f;
          ((bf16*)(F.ws + WS_POOLT))[i] = (bf16)f2bf(v); } }
    for (int it = gw; it < DEPTH * SGN * 65; it += NGW) {
        const int l = it / (SGN * 65), g = (it / 65) % SGN, tau = it % 65, p = F.lane;
        const float are = F.in[4][(l * SGN + g) * SP + p], aim = F.in[5][(l * SGN + g) * SP + p], dt = expf(F.in[6][l * SGN + g]);
        float sn, cs; sincosf(aim * dt, &sn, &cs); const float mg = expf(are * dt), lbr = mg * cs, lbi = mg * sn;
        const float nr = lbr - 1.f, ni = lbi, den = are * are + aim * aim, cr = (nr * are + ni * aim) / den, ci = (ni * are - nr * aim) / den;
        float sn2, cs2; sincosf(aim * dt * (float)tau, &sn2, &cs2); const float mg2 = expf(are * dt * (float)tau), lr = mg2 * cs2, li = mg2 * sn2;
        float wr[16], wi[16];
#pragma unroll
        for (int h = 0; h < 16; ++h) { const float br = F.in[7][((size_t)(l * SGN + g) * SP + p) * SG + h], bi = F.in[8][((size_t)(l * SGN + g) * SP + p) * SG + h];
            const float bbr = cr * br - ci * bi, bbi = cr * bi + ci * br; wr[h] = lr * bbr - li * bbi; wi[h] = lr * bbi + li * bbr; }
        bf16* TG = (bf16*)(F.ws + WS_TG) + ((size_t)l * SGN + g) * 1024 * UGP;
        if (tau <= 63) {
            bf16* BZ = (bf16*)(F.ws + WS_BZ) + ((size_t)l * SGN + g) * 256 * 1024; const int s = 63 - tau;
            u32x4 o0, o1, o2, o3;
            o0.x = pk2(wr[0], wr[1]); o0.y = pk2(wr[2], wr[3]); o0.z = pk2(wr[4], wr[5]); o0.w = pk2(wr[6], wr[7]); o1.x = pk2(wr[8], wr[9]); o1.y = pk2(wr[10], wr[11]); o1.z = pk2(wr[12], wr[13]); o1.w = pk2(wr[14], wr[15]);
            o2.x = pk2(wi[0], wi[1]); o2.y = pk2(wi[2], wi[3]); o2.z = pk2(wi[4], wi[5]); o2.w = pk2(wi[6], wi[7]); o3.x = pk2(wi[8], wi[9]); o3.y = pk2(wi[10], wi[11]); o3.z = pk2(wi[12], wi[13]); o3.w = pk2(wi[14], wi[15]);
            *(u32x4*)(BZ + (size_t)p * 1024 + s * 16) = o0; *(u32x4*)(BZ + (size_t)p * 1024 + s * 16 + 8) = o1;
            *(u32x4*)(BZ + (size_t)(64 + p) * 1024 + s * 16) = o2; *(u32x4*)(BZ + (size_t)(64 + p) * 1024 + s * 16 + 8) = o3;
        }
        LAS float* Wst = scr; LAS float* Kt = scr + 128 * 16;
        if (tau <= 63) {
#pragma unroll
            for (int q = 0; q < 4; ++q) { *(LAS f32x4*)(Wst + p * 16 + 4 * q) = (f32x4){wr[4 * q], wr[4 * q + 1], wr[4 * q + 2], wr[4 * q + 3]};
                                          *(LAS f32x4*)(Wst + (64 + p) * 16 + 4 * q) = (f32x4){wi[4 * q], wi[4 * q + 1], wi[4 * q + 2], wi[4 * q + 3]}; }
            const int arow = p & 15, kq = p >> 4; f32x4 kacc = (f32x4){0.f, 0.f, 0.f, 0.f};
            const float* cre = F.in[9] + ((size_t)(l * SGN + g) * SG + arow) * SP; const float* cim = F.in[10] + ((size_t)(l * SGN + g) * SG + arow) * SP;
#pragma unroll 8
            for (int s = 0; s < 32; ++s) { const int k = 4 * s + kq; const float av = (k < 64) ? cre[k] : -cim[k - 64]; const float bv = Wst[k * 16 + arow];
                kacc = __builtin_amdgcn_mfma_f32_16x16x4f32(av, bv, kacc, 0, 0, 0); }
#pragma unroll
            for (int r = 0; r < 4; ++r) Kt[(4 * kq + r) * 16 + arow] = kacc[r];
            asm volatile("s_waitcnt lgkmcnt(0)" ::: "memory");
            const f32x4 t4 = *(const LAS f32x4*)(Kt + 4 * p);
            u32x2 o; o.x = pk2(t4[0], t4[1]); o.y = pk2(t4[2], t4[3]);
            *(u32x2*)((bf16*)(F.ws + WS_KT) + ((size_t)(l * SGN + g) * 64 + tau) * 256 + 4 * p) = o;
        }
        if (tau >= 1) {
#pragma unroll 4
            for (int ho = 0; ho < 16; ++ho) {
                const float ccr = F.in[9][((size_t)(l * SGN + g) * SG + ho) * SP + p], cci = F.in[10][((size_t)(l * SGN + g) * SG + ho) * SP + p];
                const int n = (tau - 1) * 16 + ho;
                TG[(size_t)n * UGP + 1024 + p] = (bf16)f2bf(ccr * lr - cci * li); TG[(size_t)n * UGP + 1088 + p] = (bf16)f2bf(-(ccr * li + cci * lr)); }
        }
    }
}

__device__ __forceinline__ void route_finish(const float (&a)[20], float ssum, int m, bool act, const float* gb_, const float* rb_, int* tokb, float* tokr, float* tokw, LAS int* hist) {
        const float rstd = 1.f / sqrtf(ssum * (1.f / D) + RMS_EPS);
        float lg0 = a[0] * rstd + gb_[0], lg1 = a[1] * rstd + gb_[1], lg2 = a[2] * rstd + gb_[2], lg3 = a[3] * rstd + gb_[3];
        int gs = 0; float gm = lg0;
        if (lg1 > gm) { gm = lg1; gs = 1; } if (lg2 > gm) { gm = lg2; gs = 2; } if (lg3 > gm) { gm = lg3; gs = 3; }
        const float gwt = 1.f / (__expf(lg0 - gm) + __expf(lg1 - gm) + __expf(lg2 - gm) + __expf(lg3 - gm));
        float q0 = a[4], q1 = a[5], q2 = a[6], q3 = a[7], q4 = a[8], q5 = a[9], q6 = a[10], q7 = a[11], q8 = a[12], q9 = a[13], q10 = a[14], q11 = a[15], q12 = a[16], q13 = a[17], q14 = a[18], q15 = a[19];
        asm volatile("" : "+v"(q0), "+v"(q1), "+v"(q2), "+v"(q3), "+v"(q4), "+v"(q5), "+v"(q6), "+v"(q7));
        asm volatile("" : "+v"(q8), "+v"(q9), "+v"(q10), "+v"(q11), "+v"(q12), "+v"(q13), "+v"(q14), "+v"(q15));
        float e0 = gs == 0 ? q0 : gs == 1 ? q4 : gs == 2 ? q8 : q12;
        float e1 = gs == 0 ? q1 : gs == 1 ? q5 : gs == 2 ? q9 : q13;
        float e2 = gs == 0 ? q2 : gs == 1 ? q6 : gs == 2 ? q10 : q14;
        float e3 = gs == 0 ? q3 : gs == 1 ? q7 : gs == 2 ? q11 : q15;
        e0 = e0 * rstd + rb_[gs * 4 + 0]; e1 = e1 * rstd + rb_[gs * 4 + 1]; e2 = e2 * rstd + rb_[gs * 4 + 2]; e3 = e3 * rstd + rb_[gs * 4 + 3];
        int t1 = 0; float v1 = e0;
        if (e1 > v1) { v1 = e1; t1 = 1; } if (e2 > v1) { v1 = e2; t1 = 2; } if (e3 > v1) { v1 = e3; t1 = 3; }
        int t2 = -1; float v2 = -3.0e38f;
        if (t1 != 0 && e0 > v2) { v2 = e0; t2 = 0; } if (t1 != 1 && e1 > v2) { v2 = e1; t2 = 1; } if (t1 != 2 && e2 > v2) { v2 = e2; t2 = 2; } if (t1 != 3 && e3 > v2) { v2 = e3; t2 = 3; }
        const float p2 = __expf(v2 - v1), w1 = gwt / (1.f + p2), w2 = gwt * p2 / (1.f + p2);
        const int lo = t1 < t2 ? t1 : t2, hi = t1 < t2 ? t2 : t1; const float wlo = t1 < t2 ? w1 : w2, whi = t1 < t2 ? w2 : w1;
        const int pi = lo == 0 ? hi - 1 : (lo == 1 ? hi + 1 : 5), bk = gs * 6 + pi;
        if (act) { tokb[m] = bk; tokr[m] = rstd; tokw[2 * m] = wlo; tokw[2 * m + 1] = whi; __hip_atomic_fetch_add(hist + bk, 1, __ATOMIC_RELAXED, __HIP_MEMORY_SCOPE_WORKGROUP); }
}
__device__ __forceinline__ void ph_route(const Ctx& F0, int l) {
    const Ctx F = launder(F0);
    constexpr int WLD = 1032;
    LAS bf16* Wh = (LAS bf16*)F.lds;
    LAS bf16* Wlo = Wh + 20 * WLD;
    LAS float* LG = (LAS float*)(F.lds + 4 * 20 * WLD);
    LAS int* hist = (LAS int*)(F.lds + 4 * 20 * WLD + 8 * 320 * 4);
    const float* g2 = F.in[18] + l * D;
    const f32x4* gw4 = (const f32x4*)(F.in[19] + (size_t)l * D * 4); const f32x4* rw4 = (const f32x4*)(F.in[21] + (size_t)l * 4 * D * 4);
    const float* gb_ = F.in[20] + l * 4; const float* rb_ = F.in[22] + l * 16;
    for (int idx = F.tid; idx < D * 5; idx += NTHREADS) { const int k = idx % D, q = idx / D;
        f32x4 v = (q == 0) ? gw4[k] : rw4[(q - 1) * D + k]; v = v * g2[k];
#pragma unroll
        for (int i = 0; i < 4; ++i) { const unsigned h = f2bf(v[i]); Wh[(q * 4 + i) * WLD + k] = (bf16)h; Wlo[(q * 4 + i) * WLD + k] = (bf16)f2bf(v[i] - bf2f(h)); } }
    if (F.tid < 32) hist[F.tid] = 0;
    __syncthreads();
    int* tokb = (int*)(F.ws + WS_TOKB); float* tokr = (float*)(F.ws + WS_TOKR); float* tokw = (float*)(F.ws + WS_TOKW);
    const int i16 = F.lane & 15, kq = F.lane >> 4, m0 = F.vcu * 128 + F.wave * 16;
    const u32x4* xr = (const u32x4*)(P_XB(F) + (size_t)(m0 + i16) * D) + kq;
    const int c1 = 16 + (i16 & 3);
    const LAS bf16* bh0 = Wh + i16 * WLD + 8 * kq; const LAS bf16* bl0 = Wlo + i16 * WLD + 8 * kq;
    const LAS bf16* bh1 = Wh + c1 * WLD + 8 * kq;  const LAS bf16* bl1 = Wlo + c1 * WLD + 8 * kq;
    f32x4 acc0 = (f32x4){0.f, 0.f, 0.f, 0.f}, acc1 = acc0; float ss = 0.f;
#pragma unroll 4
    for (int c = 0; c < 32; ++c) {
        const u32x4 xa = xr[4 * c];
        const float x0 = bf2f(xa.x & 0xffffu), x1 = __builtin_bit_cast(float, xa.x & 0xffff0000u), x2 = bf2f(xa.y & 0xffffu), x3 = __builtin_bit_cast(float, xa.y & 0xffff0000u);
        const float x4 = bf2f(xa.z & 0xffffu), x5 = __builtin_bit_cast(float, xa.z & 0xffff0000u), x6 = bf2f(xa.w & 0xffffu), x7 = __builtin_bit_cast(float, xa.w & 0xffff0000u);
        ss += ((x0 * x0 + x1 * x1) + (x2 * x2 + x3 * x3)) + ((x4 * x4 + x5 * x5) + (x6 * x6 + x7 * x7));
        const pg8::bf16x8 av = __builtin_bit_cast(pg8::bf16x8, xa);
        const pg8::bf16x8 h0 = *(const LAS pg8::bf16x8*)(bh0 + 32 * c), l0 = *(const LAS pg8::bf16x8*)(bl0 + 32 * c);
        const pg8::bf16x8 h1 = *(const LAS pg8::bf16x8*)(bh1 + 32 * c), l1 = *(const LAS pg8::bf16x8*)(bl1 + 32 * c);
        acc0 = __builtin_amdgcn_mfma_f32_16x16x32_bf16(av, h0, acc0, 0, 0, 0); acc1 = __builtin_amdgcn_mfma_f32_16x16x32_bf16(av, h1, acc1, 0, 0, 0);
        acc0 = __builtin_amdgcn_mfma_f32_16x16x32_bf16(av, l0, acc0, 0, 0, 0); acc1 = __builtin_amdgcn_mfma_f32_16x16x32_bf16(av, l1, acc1, 0, 0, 0);
    }
    ss += xshfl<16>(ss);
    { const unsigned u = __builtin_bit_cast(unsigned, ss); auto r = __builtin_amdgcn_permlane32_swap(u, u, false, false);
      ss = __builtin_bit_cast(float, (unsigned)r[0]) + __builtin_bit_cast(float, (unsigned)r[1]); }
    LAS float* lg = LG + F.wave * 320;
#pragma unroll
    for (int r = 0; r < 4; ++r) { lg[(4 * kq + r) * 20 + i16] = acc0[r]; if (i16 < 4) lg[(4 * kq + r) * 20 + 16 + i16] = acc1[r]; }
    asm volatile("s_waitcnt lgkmcnt(0)" ::: "memory");
    float a[20];
#pragma unroll
    for (int j = 0; j < 5; ++j) { const f32x4 t4 = *(const LAS f32x4*)(lg + i16 * 20 + 4 * j); a[4 * j] = t4[0]; a[4 * j + 1] = t4[1]; a[4 * j + 2] = t4[2]; a[4 * j + 3] = t4[3]; }
    route_finish(a, ss, m0 + i16, kq == 0, gb_, rb_, tokb, tokr, tokw, hist);
    __syncthreads();
    if (F.tid < 24) __hip_atomic_store((int*)(F.ws + WS_WGCNT) + F.vcu * 24 + F.tid, hist[F.tid], __ATOMIC_RELAXED, __HIP_MEMORY_SCOPE_AGENT);
}
__device__ __forceinline__ void ph_place(const Ctx& F0) {
    const Ctx F = launder(F0);
    LAS int* ptot = (LAS int*)F.lds;
    LAS int* pbef = ptot + 512;
    LAS int* bstart = pbef + 512;
    LAS int* btot = bstart + 32;
    LAS int* carry = btot + 32;
    LAS int* rowidx = carry + 32;
    const int* wgcnt = (const int*)(F.ws + WS_WGCNT);
    int* rowtok = (int*)(F.ws + WS_ROWTOK); float* roww = (float*)(F.ws + WS_ROWW); int* tileb = (int*)(F.ws + WS_TILEB);
    const int* tokb = (const int*)(F.ws + WS_TOKB); const float* tokr = (const float*)(F.ws + WS_TOKR); const float* tokw = (const float*)(F.ws + WS_TOKW);
    { const int p = F.tid >> 5, b = F.tid & 31; int tot = 0, bef = 0;
      if (b < 24) for (int v = p * 16; v < p * 16 + 16; ++v) { const int c = wgcnt[v * 24 + b]; tot += c; if (v < F.vcu) bef += c; }
      ptot[p * 32 + b] = tot; pbef[p * 32 + b] = bef; }
    __syncthreads();
    if (F.tid < 32) { int tot = 0, bef = 0; for (int p = 0; p < 16; ++p) { tot += ptot[p * 32 + F.tid]; bef += pbef[p * 32 + F.tid]; } btot[F.tid] = tot; carry[F.tid] = bef; }
    __syncthreads();
    if (F.tid == 0) { int s = 0; for (int b = 0; b < 24; ++b) { bstart[b] = s; s += (btot[b] + 255) & ~255; } bstart[24] = s; }
    __syncthreads();
    if (F.tid < 24) carry[F.tid] += bstart[F.tid];
    if (F.vcu == 0) {
        if (F.tid == 0) tileb[0] = bstart[24] >> 8;
        for (int b = 0; b < 24; ++b) { const int s = bstart[b], e = bstart[b + 1];
            for (int t = (s >> 8) + F.tid; t < (e >> 8); t += NTHREADS) tileb[1 + t] = b;
            for (int r = s + btot[b] + F.tid; r < e; r += NTHREADS) __hip_atomic_store(rowtok + r, -1, __ATOMIC_RELAXED, __HIP_MEMORY_SCOPE_AGENT); }
    }
    __syncthreads();
    if (F.wave == 0) {
        for (int pass = 0; pass < 2; ++pass) { const int i = pass * 64 + F.lane, bi = tokb[F.vcu * 128 + i]; int row = 0;
#pragma unroll 1
            for (int b = 0; b < 24; ++b) { const unsigned long long mask = __ballot(bi == b); const int c = carry[b];
                if (bi == b) row = c + __builtin_popcountll(mask & ((1ull << F.lane) - 1ull));
                asm volatile("s_waitcnt lgkmcnt(0)" ::: "memory");
                if (F.lane == 0) carry[b] = c + __builtin_popcountll(mask);
                asm volatile("s_waitcnt lgkmcnt(0)" ::: "memory"); }
            rowidx[i] = row; }
    }
    __syncthreads();
    bf16* XS = (bf16*)(F.ws + WS_XS);
#pragma unroll 1
    for (int i0 = 0; i0 < 16; i0 += 8) {
        u32x4 xa[8], xb[8]; int rw[8];
#pragma unroll
        for (int j = 0; j < 8; ++j) { const int li = F.wave * 16 + i0 + j, m = F.vcu * 128 + li; rw[j] = rowidx[li];
            const u32x4* xr = (const u32x4*)(P_XB(F) + (size_t)m * D) + F.lane; xa[j] = xr[0]; xb[j] = xr[64]; }
        if (F.lane < 8) { const int li = F.wave * 16 + i0 + F.lane, m = F.vcu * 128 + li, row = rowidx[li];
            const float rstd = tokr[m];
            const unsigned long long w2 = (unsigned long long)__builtin_bit_cast(unsigned, tokw[2 * m]) | ((unsigned long long)__builtin_bit_cast(unsigned, tokw[2 * m + 1]) << 32);
            __hip_atomic_store(rowtok + row, m, __ATOMIC_RELAXED, __HIP_MEMORY_SCOPE_AGENT);
            __hip_atomic_store((unsigned long long*)(roww + 2 * row), w2, __ATOMIC_RELAXED, __HIP_MEMORY_SCOPE_AGENT);
            __hip_atomic_store((float*)(F.ws + WS_ROWR) + row, rstd, __ATOMIC_RELAXED, __HIP_MEMORY_SCOPE_AGENT); }
#pragma unroll
        for (int j = 0; j < 8; ++j) { u32x4* o16 = (u32x4*)(XS + (size_t)rw[j] * D) + F.lane; o16[0] = xa[j]; o16[64] = xb[j]; }
    }
}
struct MoeOrder {
    const int* tileb; int G, c; bool down;
    __device__ __forceinline__ bool next(int i, pg8::Unit& u) const {
        const GAS int* tb_ = (const GAS int*)tileb;
        const int NT = __builtin_amdgcn_readfirstlane(tb_[0]), L = i * G + c; if (L >= NT * 4) return false;
        const int rt = L >> 2, pn = L & 3, b = __builtin_amdgcn_readfirstlane(tb_[1 + rt]);
        if (down) { u.pm = rt; u.pn = b * 4 + pn; u.aux = pn; }
        else { int ea, eb; pair_decode(b % 6, ea, eb); const int e = (b / 6) * 4 + (pn < 2 ? ea : eb); u.pm = rt; u.pn = e * 2 + (pn & 1); u.aux = pn; }
        return true;
    }
};
struct EpiGU {
    static constexpr bool PERM = true;
    bf16* H; const float* roww; const float* rowr;
    __device__ __forceinline__ void operator()(const f32x4 (&acc)[2][2][4][2], const pg8::Unit& u, int wr, int wc, int fr_, int fq_) const {
        const int ln_ = lane_id(), fr = ln_ & 15, fq = ln_ >> 4; (void)fr_; (void)fq_;
        const int row0 = u.pm * 256 + wr * 64 + fr, cl = u.aux * 128 + 16 * wc + 4 * fq, ws = u.aux >> 1;
#pragma unroll
        for (int ai = 0; ai < 2; ++ai)
#pragma unroll
            for (int m = 0; m < 4; ++m) { const int r = row0 + ai * 128 + m * 16; const float rr = rowr[r], w = roww[2 * r + ws] * rr;
#pragma unroll
                for (int bj = 0; bj < 2; ++bj) { const f32x4 g = acc[ai][bj][m][0], up = acc[ai][bj][m][1]; f32x4 a;
#pragma unroll
                    for (int i = 0; i < 4; ++i) { const float gg = g[i] * rr; a[i] = gg * sigmoidf_(gg) * up[i] * w; }
                    u32x2 o; o.x = pg8::cvt_pk_bf16(a[0], a[1]); o.y = pg8::cvt_pk_bf16(a[2], a[3]);
                    *(u32x2*)(H + (size_t)r * 512 + cl + bj * 64) = o; } }
    }
};
struct EpiDown {
    static constexpr bool PERM = true;
    bf16* RB; const int* rowtok;
    __device__ __forceinline__ void operator()(const f32x4 (&acc)[2][2][4][2], const pg8::Unit& u, int wr, int wc, int fr_, int fq_) const {
        const int ln_ = lane_id(), fr = ln_ & 15, fq = ln_ >> 4; (void)fr_; (void)fq_;
        const int row0 = u.pm * 256 + wr * 64 + fr, col0 = u.aux * 256 + wc * 32 + 8 * fq;
        int tok[8];
#pragma unroll
        for (int i = 0; i < 8; ++i) tok[i] = rowtok[row0 + (i >> 2) * 128 + (i & 3) * 16];
#pragma unroll
        for (int ai = 0; ai < 2; ++ai) { u32x4 x[4][2];
#pragma unroll
            for (int m = 0; m < 4; ++m) { const int tk = tok[ai * 4 + m]; const bf16* rp = RB + (size_t)(tk < 0 ? 0 : tk) * D + col0; x[m][0] = *(const u32x4*)rp; x[m][1] = *(const u32x4*)(rp + 128); }
#pragma unroll
            for (int m = 0; m < 4; ++m) { const int tk = tok[ai * 4 + m]; bf16* rp = RB + (size_t)(tk < 0 ? 0 : tk) * D + col0;
#pragma unroll
                for (int bj = 0; bj < 2; ++bj) { const u32x4 xx = x[m][bj]; const f32x4 a0 = acc[ai][bj][m][0], a1 = acc[ai][bj][m][1]; u32x4 w;
                    w.x = pg8::cvt_pk_bf16(bf2f(xx.x & 0xffffu) + a0[0], bf2f(xx.x >> 16) + a0[1]); w.y = pg8::cvt_pk_bf16(bf2f(xx.y & 0xffffu) + a0[2], bf2f(xx.y >> 16) + a0[3]);
                    w.z = pg8::cvt_pk_bf16(bf2f(xx.z & 0xffffu) + a1[0], bf2f(xx.z >> 16) + a1[1]); w.w = pg8::cvt_pk_bf16(bf2f(xx.w & 0xffffu) + a1[2], bf2f(xx.w >> 16) + a1[3]);
                    if (tk >= 0) *(u32x4*)(rp + bj * 128) = w; } }
            asm volatile("" ::: "memory"); }
    }
};

struct SsmOrder { int G, c, mode;
    __device__ __forceinline__ bool next(int i, pg8::Unit& u) const { const int L = i * G + c;
        if (mode == 1) { if (L >= 32) return false; u.pm = L; u.pn = L >> 1; u.aux = 0; return true; }
        if (L >= 128) return false; const int g = L >> 3; u.pm = g * 2 + ((L >> 2) & 1); u.pn = g * 4 + (L & 3); u.aux = L & 3; return true; } };
struct HalfOrder { int L;
    __device__ __forceinline__ bool next(int i, pg8::Unit& u) const { if (i > 0 || L < 0 || L >= 128) return false; u.pm = L; u.pn = 0; u.aux = 0; return true; } };
struct EpiZ { static constexpr bool PERM = false; float* ZB;
    __device__ __forceinline__ void operator()(const f32x4 (&acc)[2][2][4][2], const pg8::Unit& u, int wr, int wc, int fr_, int fq_) const {
        const int ln_ = lane_id(), fr = ln_ & 15, fq = ln_ >> 4; (void)fr_; (void)fq_;
        const int row0 = u.pm * 256 + wr * 64 + fr, col0 = wc * 32 + 4 * fq;
#pragma unroll
        for (int ai = 0; ai < 2; ++ai)
#pragma unroll
            for (int m = 0; m < 4; ++m)
#pragma unroll
                for (int n = 0; n < 2; ++n) *(f32x4*)(ZB + (size_t)(row0 + ai * 128 + m * 16) * 128 + col0 + n * 16) = acc[ai][0][m][n];
    } };
struct EpiSsm2 { static constexpr bool PERM = true; const bf16* UG; bf16* YS; const float* dvec;
    __device__ __forceinline__ void operator()(const f32x4 (&acc)[2][2][4][2], const pg8::Unit& u, int wr, int wc, int fr_, int fq_) const {
        const int ln_ = lane_id(), fr = ln_ & 15, fq = ln_ >> 4; (void)fr_; (void)fq_;
        const int g = u.pm >> 1, cr0 = (u.pm & 1) * 256 + wr * 64 + fr;
#pragma unroll
        for (int bj = 0; bj < 2; ++bj) { const int n0 = u.aux * 256 + bj * 128 + wc * 32 + 8 * fq, to = n0 >> 4, ho0 = n0 & 15;
            const f32x4 d0 = *(const f32x4*)(dvec + g * 16 + ho0), d1 = *(const f32x4*)(dvec + g * 16 + ho0 + 4);
#pragma unroll
            for (int ai = 0; ai < 2; ++ai)
#pragma unroll
                for (int m = 0; m < 4; ++m) { const int cr = cr0 + ai * 128 + m * 16;
                    const u32x4 uu = *(const u32x4*)(UG + ((size_t)(g * 512 + cr)) * UGP + n0);
                    const f32x4 a0 = acc[ai][bj][m][0], a1 = acc[ai][bj][m][1]; float y[8];
                    y[0] = gelu_tanh(a0[0] + d0[0] * bf2f(uu.x & 0xffffu)); y[1] = gelu_tanh(a0[1] + d0[1] * bf2f(uu.x >> 16));
                    y[2] = gelu_tanh(a0[2] + d0[2] * bf2f(uu.y & 0xffffu)); y[3] = gelu_tanh(a0[3] + d0[3] * bf2f(uu.y >> 16));
                    y[4] = gelu_tanh(a1[0] + d1[0] * bf2f(uu.z & 0xffffu)); y[5] = gelu_tanh(a1[1] + d1[1] * bf2f(uu.z >> 16));
                    y[6] = gelu_tanh(a1[2] + d1[2] * bf2f(uu.w & 0xffffu)); y[7] = gelu_tanh(a1[3] + d1[3] * bf2f(uu.w >> 16));
                    u32x4 w; w.x = pg8::cvt_pk_bf16(y[0], y[1]); w.y = pg8::cvt_pk_bf16(y[2], y[3]); w.z = pg8::cvt_pk_bf16(y[4], y[5]); w.w = pg8::cvt_pk_bf16(y[6], y[7]);
                    *(u32x4*)(YS + ((size_t)cr * 64 + to) * 256 + g * 16 + ho0) = w; } }
    } };
struct EpiGluE { static constexpr bool PERM = true; const bf16* YS; bf16* YMIX; const float* gb;
    __device__ __forceinline__ void operator()(const f32x4 (&acc)[2][2][4][2], const pg8::Unit& u, int wr, int wc, int fr_, int fq_) const {
        const int ln_ = lane_id(), fr = ln_ & 15, fq = ln_ >> 4; (void)fr_; (void)fq_;
        const int row0 = u.pm * 256 + wr * 64 + fr;
#pragma unroll
        for (int bj = 0; bj < 2; ++bj) { const int n0 = bj * 128 + wc * 32 + 8 * fq; const f32x4 b0 = *(const f32x4*)(gb + n0), b1 = *(const f32x4*)(gb + n0 + 4);
#pragma unroll
            for (int ai = 0; ai < 2; ++ai)
#pragma unroll
                for (int m = 0; m < 4; ++m) { const size_t r = (size_t)(row0 + ai * 128 + m * 16); const u32x4 yy = *(const u32x4*)(YS + r * 256 + n0);
                    const f32x4 a0 = acc[ai][bj][m][0] + b0, a1 = acc[ai][bj][m][1] + b1; float o[8];
                    o[0] = bf2f(yy.x & 0xffffu) * sigmoidf_(a0[0]); o[1] = bf2f(yy.x >> 16) * sigmoidf_(a0[1]); o[2] = bf2f(yy.y & 0xffffu) * sigmoidf_(a0[2]); o[3] = bf2f(yy.y >> 16) * sigmoidf_(a0[3]);
                    o[4] = bf2f(yy.z & 0xffffu) * sigmoidf_(a1[0]); o[5] = bf2f(yy.z >> 16) * sigmoidf_(a1[1]); o[6] = bf2f(yy.w & 0xffffu) * sigmoidf_(a1[2]); o[7] = bf2f(yy.w >> 16) * sigmoidf_(a1[3]);
                    u32x4 w; w.x = pg8::cvt_pk_bf16(o[0], o[1]); w.y = pg8::cvt_pk_bf16(o[2], o[3]); w.z = pg8::cvt_pk_bf16(o[4], o[5]); w.w = pg8::cvt_pk_bf16(o[6], o[7]);
                    *(u32x4*)(YMIX + r * 1024 + n0) = w; } }
    } };
struct EpiPoolE { static constexpr bool PERM = true; bf16* YMIX; const float* pb; const float* ps;
    __device__ __forceinline__ void operator()(const f32x4 (&acc)[2][2][4][2], const pg8::Unit& u, int wr, int wc, int fr_, int fq_) const {
        const int ln_ = lane_id(), fr = ln_ & 15, fq = ln_ >> 4; (void)fr_; (void)fq_;
        const int row0 = u.pm * 256 + wr * 64 + fr;
#pragma unroll
        for (int bj = 0; bj < 2; ++bj) { const int n0 = bj * 128 + wc * 32 + 8 * fq; const f32x4 b0 = *(const f32x4*)(pb + n0), b1 = *(const f32x4*)(pb + n0 + 4), s0 = *(const f32x4*)(ps + n0), s1 = *(const f32x4*)(ps + n0 + 4);
#pragma unroll
            for (int ai = 0; ai < 2; ++ai)
#pragma unroll
                for (int m = 0; m < 4; ++m) { const size_t r = (size_t)(row0 + ai * 128 + m * 16);
                    const f32x4 a0 = (acc[ai][bj][m][0] + b0) * s0, a1 = (acc[ai][bj][m][1] + b1) * s1;
                    u32x4 w; w.x = pg8::cvt_pk_bf16(a0[0], a0[1]); w.y = pg8::cvt_pk_bf16(a0[2], a0[3]); w.z = pg8::cvt_pk_bf16(a1[0], a1[1]); w.w = pg8::cvt_pk_bf16(a1[2], a1[3]);
                    *(u32x4*)(YMIX + r * 1024 + 256 + n0) = w; } }
    } };
__device__ __forceinline__ void ph_tg_expand(const Ctx& F0, int l) {
    const Ctx F = launder(F0);
    if (F.wave == 0) return;
    const int gw = F.vcu * 7 + (F.wave - 1), NGW = F.G * 7;
    const bf16* KT = (const bf16*)(F.ws + WS_KT) + (size_t)l * SGN * 64 * 256;
    bf16* TG0 = (bf16*)(F.ws + WS_TG) + (size_t)l * SGN * 1024 * UGP;
#pragma unroll 2
    for (int r = gw; r < SGN * 1024; r += NGW) { const int g = r >> 10, n = r & 1023, to = n >> 4, ho = n & 15;
        bf16* d = TG0 + ((size_t)g * 1024 + n) * UGP;
#pragma unroll
        for (int half = 0; half < 2; ++half) { const int ti = half * 32 + (F.lane >> 1), tau = to - ti;
            u32x4 v = (u32x4){0u, 0u, 0u, 0u};
            if (tau >= 0) v = *(const u32x4*)(KT + (((size_t)g * 64 + tau) * 16 + ho) * 16 + (F.lane & 1) * 8);
            *(u32x4*)(d + half * 512 + F.lane * 8) = v; } }
}
__device__ __forceinline__ void ph_ssm_scan(const Ctx& F0, int l) {
    const Ctx F = launder(F0);
    for (int it = F.vcu + F.G * F.wave; it < SGN * NB; it += F.G * NWAVES) {
        const int g = it >> 3, b = it & 7, p = F.lane;
        const float are = F.in[4][(l * SGN + g) * SP + p], aim = F.in[5][(l * SGN + g) * SP + p], dt = expf(F.in[6][l * SGN + g]);
        float sn, cs; sincosf(aim * dt * 64.f, &sn, &cs); const float mg = expf(are * dt * 64.f), lr = mg * cs, li = mg * sn;
        const float* Z = (const float*)(F.ws + WS_ZB) + ((size_t)g * 512 + b * 64) * 128;
        bf16* U = P_UG(F) + ((size_t)g * 512 + b * 64) * UGP + 1024;
        float sr = 0.f, si = 0.f;
#pragma unroll 1
        for (int c0 = 0; c0 < 64; c0 += 32) {
            float zr[32], zi[32];
#pragma unroll
            for (int j = 0; j < 32; ++j) { zr[j] = Z[(c0 + j) * 128 + p]; zi[j] = Z[(c0 + j) * 128 + 64 + p]; }
#pragma unroll
            for (int j = 0; j < 32; ++j) {
                U[(size_t)(c0 + j) * UGP + p] = (bf16)f2bf(sr); U[(size_t)(c0 + j) * UGP + 64 + p] = (bf16)f2bf(si);
                const float nr = lr * sr - li * si + zr[j], ni = lr * si + li * sr + zi[j]; sr = nr; si = ni; }
        }
    }
}

namespace moba {
using bf16x8 = __attribute__((ext_vector_type(8))) short;
using s16x4 = __attribute__((ext_vector_type(4))) short;
using f32x16 = __attribute__((ext_vector_type(16))) float;
typedef short v4i16_t __attribute__((ext_vector_type(4)));
typedef float f32x2_t __attribute__((ext_vector_type(2))); typedef __bf16 bf16x2_t __attribute__((ext_vector_type(2)));
constexpr int L_K = 0, L_V = 49152, L_TB = 98304, L_KM = L_TB + 4 * 768 * 4, L_END = L_KM + 16 * 64 * 4;
__device__ __forceinline__ unsigned cvtpk(float lo, float hi) { f32x2_t v = {lo, hi}; bf16x2_t b = __builtin_convertvector(v, bf16x2_t); return __builtin_bit_cast(unsigned, b); }
__device__ __forceinline__ s16x4 vtr(const LAS char* p) { return __builtin_bit_cast(s16x4, __builtin_amdgcn_ds_read_tr16_b64_v4i16((LAS v4i16_t*)p)); }
__device__ __forceinline__ float hmax(float v) { const unsigned u = __builtin_bit_cast(unsigned, v); auto r = __builtin_amdgcn_permlane32_swap(u, u, false, false); return fmaxf(__builtin_bit_cast(float, (unsigned)r[0]), __builtin_bit_cast(float, (unsigned)r[1])); }
__device__ __forceinline__ float hsum(float v) { const unsigned u = __builtin_bit_cast(unsigned, v); auto r = __builtin_amdgcn_permlane32_swap(u, u, false, false); return __builtin_bit_cast(float, (unsigned)r[0]) + __builtin_bit_cast(float, (unsigned)r[1]); }

constexpr int L_LIST = L_END, L_WCNT = 32768;
#define MOBA_CVEC() f32x16 cvec; do { const float ci_ = bfar - mref; _Pragma("unroll") for (int r = 0; r < 16; ++r) cvec[r] = ci_; } while (0)
#define MOBA_QK(P0, P1, KB) do { { const bf16x8 a0 = *(const LAS bf16x8*)(kp0 + (KB)), a1 = *(const LAS bf16x8*)(kp0 + (KB) + 512); \
          P0 = __builtin_amdgcn_mfma_f32_32x32x16_bf16(a0, qr[0], cvec, 0, 0, 0); P1 = __builtin_amdgcn_mfma_f32_32x32x16_bf16(a1, qr[0], cvec, 0, 0, 0); } \
        _Pragma("unroll") for (int d0 = 1; d0 < 4; ++d0) { const bf16x8 a0 = *(const LAS bf16x8*)(kp0 + (KB) + d0 * 2048), a1 = *(const LAS bf16x8*)(kp0 + (KB) + d0 * 2048 + 512); \
            P0 = __builtin_amdgcn_mfma_f32_32x32x16_bf16(a0, qr[d0], P0, 0, 0, 0); P1 = __builtin_amdgcn_mfma_f32_32x32x16_bf16(a1, qr[d0], P1, 0, 0, 0); } } while (0)
#define MOBA_NEARMAX(P0, P1, JN, OUT) do { const int jn_ = (JN); if (jn_ >= 0) { const int A_ = qrel - 64 * (jn_ - 4) - 4 * hi + 256, s_ = 767 - A_, c_ = s_ & 3; \
            const LAS f32x4* t4 = (const LAS f32x4*)(tb + c_ * 768 + (s_ - c_)); \
            _Pragma("unroll") for (int g = 0; g < 4; ++g) { const f32x4 x0 = t4[2 * g], x1 = t4[2 * g + 8]; \
                _Pragma("unroll") for (int j = 0; j < 4; ++j) { P0[4 * g + j] += x0[j]; P1[4 * g + j] += x1[j]; } } } \
        float ra = __builtin_fmaxf(__builtin_fmaxf(P0[0], P0[1]), P1[0]), rb = __builtin_fmaxf(__builtin_fmaxf(P0[2], P0[3]), P1[1]); \
        ra = __builtin_fmaxf(__builtin_fmaxf(ra, P1[2]), P1[3]); \
        _Pragma("unroll") for (int r = 4; r < 16; r += 4) { ra = __builtin_fmaxf(__builtin_fmaxf(ra, P0[r]), P0[r + 1]); rb = __builtin_fmaxf(__builtin_fmaxf(rb, P0[r + 2]), P0[r + 3]); \
            ra = __builtin_fmaxf(__builtin_fmaxf(ra, P1[r]), P1[r + 1]); rb = __builtin_fmaxf(__builtin_fmaxf(rb, P1[r + 2]), P1[r + 3]); } \
        OUT = hmax(__builtin_fmaxf(ra, rb)); } while (0)
#define MOBA_STEP(PC0, PC1, PN0, PN1, JNN, KBN, VBC, HASN) do { \
        bf16x8 vf[8], kf[8]; \
        if (HASN) { _Pragma("unroll") for (int d0 = 0; d0 < 4; ++d0) { kf[2 * d0] = *(const LAS bf16x8*)(kp0 + (KBN) + d0 * 2048); kf[2 * d0 + 1] = *(const LAS bf16x8*)(kp0 + (KBN) + d0 * 2048 + 512); } } \
        __builtin_amdgcn_sched_barrier(0); \
        if (__any(rm > 8.f)) { const float dl = __builtin_fmaxf(rm, 0.f), alpha = __builtin_amdgcn_exp2f(-dl); mref += dl; l *= alpha; \
            _Pragma("unroll") for (int r = 0; r < 16; ++r) { PC0[r] -= dl; PC1[r] -= dl; o0[r] *= alpha; o1[r] *= alpha; } } \
        if (HASN) { MOBA_CVEC(); \
                    PN0 = __builtin_amdgcn_mfma_f32_32x32x16_bf16(kf[0], qr[0], cvec, 0, 0, 0); PN1 = __builtin_amdgcn_mfma_f32_32x32x16_bf16(kf[1], qr[0], cvec, 0, 0, 0); \
                    _Pragma("unroll") for (int d0 = 1; d0 < 4; ++d0) { PN0 = __builtin_amdgcn_mfma_f32_32x32x16_bf16(kf[2 * d0], qr[d0], PN0, 0, 0, 0); PN1 = __builtin_amdgcn_mfma_f32_32x32x16_bf16(kf[2 * d0 + 1], qr[d0], PN1, 0, 0, 0); } } \
        { const LAS char* vp = vp0 + (VBC); \
        _Pragma("unroll") for (int k = 0; k < 4; ++k) { \
            const s16x4 lo0 = vtr(vp + k * 1024), hi0 = vtr(vp + k * 1024 + 512), lo1 = vtr(vp + 4096 + k * 1024), hi1 = vtr(vp + 4096 + k * 1024 + 512); \
            vf[2 * k] = (bf16x8){lo0[0], lo0[1], lo0[2], lo0[3], hi0[0], hi0[1], hi0[2], hi0[3]}; vf[2 * k + 1] = (bf16x8){lo1[0], lo1[1], lo1[2], lo1[3], hi1[0], hi1[1], hi1[2], hi1[3]}; } } \
        __builtin_amdgcn_sched_barrier(0); \
        float s0 = 0.f, s1 = 0.f; u32x4 pw[4]; \
        _Pragma("unroll") for (int r = 0; r < 16; ++r) { PC0[r] = __builtin_amdgcn_exp2f(PC0[r]); PC1[r] = __builtin_amdgcn_exp2f(PC1[r]); s0 += PC0[r]; s1 += PC1[r]; } \
        l += s0 + s1; \
        _Pragma("unroll") for (int q = 0; q < 4; ++q) { pw[0][q] = cvtpk(PC0[2 * q], PC0[2 * q + 1]); pw[1][q] = cvtpk(PC0[8 + 2 * q], PC0[9 + 2 * q]); pw[2][q] = cvtpk(PC1[2 * q], PC1[2 * q + 1]); pw[3][q] = cvtpk(PC1[8 + 2 * q], PC1[9 + 2 * q]); } \
        _Pragma("unroll") for (int k = 0; k < 4; ++k) { const bf16x8 pa = __builtin_bit_cast(bf16x8, pw[k]); \
            o0 = __builtin_amdgcn_mfma_f32_32x32x16_bf16(vf[2 * k], pa, o0, 0, 0, 0); o1 = __builtin_amdgcn_mfma_f32_32x32x16_bf16(vf[2 * k + 1], pa, o1, 0, 0, 0); } \
        if (HASN) MOBA_NEARMAX(PN0, PN1, JNN, rm); \
    } while (0)
#define MOBA_BLOCK4(JN0, PRE4) \
    float mref = 0.f, l = 0.f; f32x16 o0 = f32x16{}, o1 = f32x16{}; f32x16 pa0, pa1, pb0, pb1; float rm; \
    { const int jn0_ = (JN0); \
      { MOBA_CVEC(); MOBA_QK(pa0, pa1, 0); } MOBA_NEARMAX(pa0, pa1, jn0_, rm); \
      MOBA_STEP(pa0, pa1, pb0, pb1, (jn0_ < 0 ? -1 : jn0_ + 1), 8192, 0, true); \
      MOBA_STEP(pb0, pb1, pa0, pa1, (jn0_ < 0 ? -1 : jn0_ + 2), 16384, 8192, true); \
      MOBA_STEP(pa0, pa1, pb0, pb1, (jn0_ < 0 ? -1 : jn0_ + 3), 24576, 16384, true); \
      PRE4; \
      MOBA_STEP(pb0, pb1, pa0, pa1, -1, 0, 24576, false); }
__device__ __forceinline__ void load_block(const bf16* K, const bf16* V, size_t row0, int h, int wid, int lane, LAS char* lds) {
    const bf16* ksrc = K + (row0 + lane) * 512 + h * 64 + wid * 8;
    const bf16* vsrc = V + (row0 + 16 * (wid & 3) + (lane >> 2)) * 512 + h * 64 + (wid >> 2) * 32 + (lane & 3) * 8;
    u32x4 kr[4], vr[4];
#pragma unroll
    for (int t = 0; t < 4; ++t) { kr[t] = *(const u32x4*)(ksrc + (size_t)t * 64 * 512); vr[t] = *(const u32x4*)(vsrc + (size_t)t * 64 * 512); }
    LAS char* kd = lds + L_K + wid * 1024 + lane * 16; LAS char* vd = lds + L_V + wid * 1024 + lane * 16;
#pragma unroll
    for (int t = 0; t < 4; ++t) { *(LAS u32x4*)(kd + t * 8192) = kr[t]; *(LAS u32x4*)(vd + t * 8192) = vr[t]; }
}
__device__ __forceinline__ void fill_bias_table(const float* BT, int h, int tid, LAS float* tb) {
    const float bfar = BT[h * 132 + 128];
    for (int i = tid; i < 4 * 768; i += NTHREADS) { const int c = i / 768, j = i % 768, src_ = 767 - (j + c), rel = src_ - 256; tb[i] = (src_ < 0 || rel < 0) ? -1.0e30f : (rel < 128 ? BT[h * 132 + rel] - bfar : 0.f); }
}
__device__ __forceinline__ void sel_phase(int wave_, int vcu, int G, const bf16* Q, const float* KMP, unsigned* SEL, LAS char* lds) {
    const int w0 = G > 64 ? 32 : 0, nw = G - w0; if (vcu < w0) return;
    int lane_ = lane_id(); asm volatile("" : "+v"(lane_)); asm volatile("" : "+s"(wave_));
    const int wid = wave_, lane = lane_, tid = wid * 64 + lane, r32 = lane & 31, hi = lane >> 5;
    const int ub = ((vcu - w0) * 1024) / nw, ue = ((vcu - w0 + 1) * 1024) / nw;
    LAS float* km = (LAS float*)(lds + L_KM);
    int bhc = -1;
#pragma unroll 1
    for (int u = ub; u < ue; ++u) {
        const int bh = u >> 4, qb = u & 15, b = bh >> 3, h = bh & 7;
        if (bh != bhc) { bhc = bh;
            __syncthreads();
            for (int i = tid; i < 16 * 64; i += NTHREADS) { const int j = i >> 6, d = i & 63, pm = b * 16 + j; km[i] = KMP[pm * 512 + h * 64 + d] + KMP[128 * 512 + pm * 512 + h * 64 + d]; }
            __syncthreads(); }
        asm volatile("" ::: "memory");
        const int q = qb * 256 + wid * 32 + r32;
        const bf16* qw = Q + ((size_t)b * SEQ + q) * 512 + h * 64 + hi * 8;
        bf16x8 qr[4];
#pragma unroll
        for (int d0 = 0; d0 < 4; ++d0) qr[d0] = *(const bf16x8*)(qw + d0 * 16);
        float g[16];
#pragma unroll
        for (int j = 0; j < 16; ++j) g[j] = 0.f;
#pragma unroll
        for (int d0 = 0; d0 < 4; ++d0)
#pragma unroll
            for (int j = 0; j < 16; ++j) { const f32x4 ka = *(const LAS f32x4*)(km + j * 64 + d0 * 16 + hi * 8), kb4 = *(const LAS f32x4*)(km + j * 64 + d0 * 16 + hi * 8 + 4);
#pragma unroll
                for (int e = 0; e < 4; ++e) { g[j] += bf2f((unsigned)(unsigned short)qr[d0][e]) * ka[e]; }
#pragma unroll
                for (int e = 0; e < 4; ++e) { g[j] += bf2f((unsigned)(unsigned short)qr[d0][4 + e]) * kb4[e]; } }
#pragma unroll
        for (int j = 0; j < 16; ++j) g[j] = hsum(g[j]);
        unsigned selmask = 0u;
#pragma unroll
        for (int s3 = 0; s3 < 3; ++s3) { float bv = -3.0e38f; int bi = -1;
#pragma unroll
            for (int j = 0; j < 16; ++j) { const bool ok = (j < qb) && !((selmask >> j) & 1u) && (g[j] > bv); bv = ok ? g[j] : bv; bi = ok ? j : bi; }
            if (bi >= 0) selmask |= 1u << bi; }
        if (hi == 0) SEL[(size_t)bh * SEQ + q] = selmask;
    }
}
__device__ __forceinline__ bf16* pslot(int slot, size_t t, int h, bf16* YM, bf16* P2A, bf16* P2B) {
    return slot == 0 ? YM + t * 1024 + h * 64 : slot == 1 ? YM + t * 1024 + 512 + h * 64 : (t < (size_t)(T / 2) ? P2A + t * 512 : P2B + (t - (size_t)(T / 2)) * 512) + h * 64;
}
__device__ __forceinline__ void gather_phase(int wave_, int vcu, const bf16* Q, const bf16* K, const bf16* V, bf16* YM, bf16* P2A, bf16* P2B, float* ML, const unsigned* SEL, const float* BT, LAS char* lds) {
    if (vcu >= 256) return;
    int lane_ = lane_id(); asm volatile("" : "+v"(lane_)); asm volatile("" : "+s"(wave_));
    const int wid = wave_, lane = lane_, tid = wid * 64 + lane, r32 = lane & 31, hi = lane >> 5;
    const int bh = vcu >> 2, s = vcu & 3, b = bh >> 3, h = bh & 7;
    const size_t rowbase = (size_t)b * SEQ;
    LAS float* tb = (LAS float*)(lds + L_TB); LAS int* list = (LAS int*)(lds + L_LIST); LAS int* wcnt = (LAS int*)(lds + L_WCNT);
    const float bfar = BT[h * 132 + 128];
    fill_bias_table(BT, h, tid, tb);
    const unsigned* selrow = SEL + (size_t)bh * SEQ;
    const LAS char* kp0 = lds + L_K + hi * 1024 + r32 * 16;
    const LAS char* vp0 = lds + L_V + ((lane >> 4) & 1) * 32 + (lane & 3) * 8 + (4 * hi + ((lane & 15) >> 2)) * 64;
    const unsigned code = s == 0 ? 0xFFFA70u : s == 1 ? 0xFFE961u : s == 2 ? 0xFFFB32u : 0xFDC854u;
    u32x4 kr[4], vr[4]; unsigned msel[8];
#define MOBA_GFETCH(KB) do { const size_t row0 = rowbase + (size_t)(KB) * 256; int lg_ = lane_id(); asm volatile("" : "+v"(lg_));     \
        const bf16* ksrc = K + (row0 + lg_) * 512 + h * 64 + wid * 8; \
        const bf16* vsrc = V + (row0 + 16 * (wid & 3) + (lg_ >> 2)) * 512 + h * 64 + (wid >> 2) * 32 + (lg_ & 3) * 8; \
        _Pragma("unroll") for (int t = 0; t < 4; ++t) { kr[t] = *(const u32x4*)(ksrc + (size_t)t * 64 * 512); vr[t] = *(const u32x4*)(vsrc + (size_t)t * 64 * 512); } \
        const int qs_ = ((KB) + 1) * 256, R_ = (SEQ - qs_) >> 3; \
        _Pragma("unroll") for (int i = 0; i < 8; ++i) { const int off = i * 64 + lg_; msel[i] = off < R_ ? selrow[qs_ + wid * R_ + off] : 0u; } } while (0)
    MOBA_GFETCH((int)(code & 15u));
#pragma unroll 1
    for (int ik = 0; ik < 6; ++ik) {
        const int kb = (int)((code >> (4 * ik)) & 15u); if (kb == 15) break;
        const int kbn = (int)((code >> (4 * ik + 4)) & 15u);
        __syncthreads();
        { LAS char* kd = lds + L_K + wid * 1024 + lane * 16; LAS char* vd = lds + L_V + wid * 1024 + lane * 16;
#pragma unroll
          for (int t = 0; t < 4; ++t) { *(LAS u32x4*)(kd + t * 8192) = kr[t]; *(LAS u32x4*)(vd + t * 8192) = vr[t]; } }
        const int qs = (kb + 1) * 256, R = (SEQ - qs) >> 3;
        unsigned long long bal[8]; int cnt = 0;
#pragma unroll
        for (int i = 0; i < 8; ++i) { bal[i] = __ballot((msel[i] >> kb) & 1u); cnt += __builtin_popcountll(bal[i]); }
        if (lane == 0) wcnt[wid] = cnt;
        __syncthreads();
        int base = 0, n = 0;
#pragma unroll
        for (int w = 0; w < 8; ++w) { const int c = wcnt[w]; n += c; base += (w < wid) ? c : 0; }
#pragma unroll
        for (int i = 0; i < 8; ++i) { const unsigned long long m = bal[i];
            if ((m >> lane) & 1ull) list[base + __builtin_popcountll(m & ((1ull << lane) - 1ull))] = qs + wid * R + i * 64 + lane;
            base += __builtin_popcountll(m); }
        __syncthreads();
        const int ntask = (n + 31) >> 5;
        int tk = wid, qin = 0; bool vn = false; unsigned smn = 0u; bf16x8 qn[4];
#define MOBA_QFETCH() do { const int li_ = tk * 32 + r32; vn = li_ < n; { const int lv_ = list[vn ? li_ : (n > 0 ? n - 1 : 0)]; qin = n > 0 ? lv_ : qs; } smn = selrow[qin]; \
            const bf16* qw = Q + (rowbase + qin) * 512 + h * 64 + hi * 8; \
            _Pragma("unroll") for (int d0 = 0; d0 < 4; ++d0) qn[d0] = *(const bf16x8*)(qw + d0 * 16); } while (0)
        MOBA_QFETCH();
#pragma unroll 1
        while (tk < ntask) {
            const int qi = qin; const bool valid = vn; const unsigned sm = smn;
            bf16x8 qr[4];
#pragma unroll
            for (int d0 = 0; d0 < 4; ++d0) qr[d0] = qn[d0];
            tk += 8;
            const int slot = __builtin_popcount(sm & ((1u << kb) - 1u));
            const int qd = qi - qs, qrel = qd < 255 ? qd : 255;
            const bool nearw = __any(qd < 128);
            MOBA_BLOCK4(nearw ? 0 : -1, MOBA_QFETCH())
            const float lt = hsum(l), inv = 1.f / lt; const size_t t = rowbase + qi;
            bf16* orow = pslot(slot, t, h, YM, P2A, P2B) + 8 * hi;
#pragma unroll
            for (int d0 = 0; d0 < 2; ++d0)
#pragma unroll
                for (int gp = 0; gp < 2; ++gp) { const f32x16& oo = d0 ? o1 : o0; const int ga = 8 * gp, gb = 8 * gp + 4;
                    unsigned ax = cvtpk(oo[ga] * inv, oo[ga + 1] * inv), ay = cvtpk(oo[ga + 2] * inv, oo[ga + 3] * inv), bx = cvtpk(oo[gb] * inv, oo[gb + 1] * inv), by = cvtpk(oo[gb + 2] * inv, oo[gb + 3] * inv);
                    { auto r = __builtin_amdgcn_permlane32_swap(ax, bx, false, false); ax = r[0]; bx = r[1]; }
                    { auto r = __builtin_amdgcn_permlane32_swap(ay, by, false, false); ay = r[0]; by = r[1]; }
                    if (valid) *(u32x4*)(orow + 32 * d0 + 16 * gp) = (u32x4){ax, ay, bx, by}; }
            if (valid && hi == 0) { float* ml = ML + ((t * 8 + h) * 3 + slot) * 2; ml[0] = mref; ml[1] = lt; }
        }
#undef MOBA_QFETCH
        MOBA_GFETCH(kbn);
    }
#undef MOBA_GFETCH
}
__device__ __forceinline__ void diag_unit(int wid, int lane, int b, int h, int qb, const bf16* Q, const bf16* K, const bf16* V, bf16* YM, const bf16* P2A, const bf16* P2B, const float* ML, float bfar, LAS char* lds) {
    const int r32 = lane & 31, hi = lane >> 5; const size_t rowbase = (size_t)b * SEQ;
    LAS float* tb = (LAS float*)(lds + L_TB);
    const LAS char* kp0 = lds + L_K + hi * 1024 + r32 * 16;
    const LAS char* vp0 = lds + L_V + ((lane >> 4) & 1) * 32 + (lane & 3) * 8 + (4 * hi + ((lane & 15) >> 2)) * 64;
    __syncthreads();
    load_block(K, V, rowbase + (size_t)qb * 256, h, wid, lane, lds);
    const int qrel = wid * 32 + r32; const size_t t = rowbase + qb * 256 + qrel;
    bf16x8 qr[4];
    { const bf16* qw = Q + t * 512 + h * 64 + hi * 8;
#pragma unroll
      for (int d0 = 0; d0 < 4; ++d0) qr[d0] = *(const bf16x8*)(qw + d0 * 16); }
    __syncthreads();
    MOBA_BLOCK4(4, (void)0)
    const int nsl = qb < 3 ? qb : 3;
    const float* ml = ML + (t * 8 + h) * 6;
    const bf16* pA = YM + t * 1024 + h * 64 + 8 * hi; const bf16* pB = YM + t * 1024 + 512 + h * 64 + 8 * hi;
    const bf16* pC = (t < (size_t)(T / 2) ? P2A + t * 512 : P2B + (t - (size_t)(T / 2)) * 512) + h * 64 + 8 * hi;
    float m0 = -3.0e38f, m1 = -3.0e38f, m2 = -3.0e38f, l0 = 0.f, l1 = 0.f, l2 = 0.f;
    u32x4 xA[4], xB[4], xC[4];
#pragma unroll
    for (int c = 0; c < 4; ++c) { xA[c] = (u32x4){0u, 0u, 0u, 0u}; xB[c] = xA[c]; xC[c] = xA[c]; }
    if (nsl > 0) { m0 = ml[0]; l0 = ml[1];
#pragma unroll
        for (int c = 0; c < 4; ++c) xA[c] = *(const u32x4*)(pA + 16 * c); }
    if (nsl > 1) { m1 = ml[2]; l1 = ml[3];
#pragma unroll
        for (int c = 0; c < 4; ++c) xB[c] = *(const u32x4*)(pB + 16 * c); }
    if (nsl > 2) { m2 = ml[4]; l2 = ml[5];
#pragma unroll
        for (int c = 0; c < 4; ++c) xC[c] = *(const u32x4*)(pC + 16 * c); }
    const float M = __builtin_fmaxf(__builtin_fmaxf(mref, m0), __builtin_fmaxf(m1, m2));
    const float w0 = __builtin_amdgcn_exp2f(mref - M), wa = l0 * __builtin_amdgcn_exp2f(m0 - M), wb = l1 * __builtin_amdgcn_exp2f(m1 - M), wc = l2 * __builtin_amdgcn_exp2f(m2 - M);
    const float inv = 1.f / (hsum(l) * w0 + wa + wb + wc);
    const float s0 = w0 * inv, sa = wa * inv, sb = wb * inv, sc = wc * inv;
    bf16* orow = YM + t * 1024 + 512 + h * 64 + 8 * hi;
#pragma unroll
    for (int d0 = 0; d0 < 2; ++d0)
#pragma unroll
        for (int gp = 0; gp < 2; ++gp) { const f32x16& oo = d0 ? o1 : o0; const int ga = 8 * gp, gb = 8 * gp + 4, dof = 32 * d0 + 16 * gp, cc = 2 * d0 + gp;
            float a0 = oo[ga] * s0, a1 = oo[ga + 1] * s0, a2 = oo[ga + 2] * s0, a3 = oo[ga + 3] * s0, b0 = oo[gb] * s0, b1 = oo[gb + 1] * s0, b2 = oo[gb + 2] * s0, b3 = oo[gb + 3] * s0;
#define MOBA_ACC(X, W) { unsigned fx = X[cc].x, fy = X[cc].y, sx = X[cc].z, sy = X[cc].w; \
              { auto r = __builtin_amdgcn_permlane32_swap(fx, sx, false, false); fx = r[0]; sx = r[1]; } { auto r = __builtin_amdgcn_permlane32_swap(fy, sy, false, false); fy = r[0]; sy = r[1]; } \
              a0 += (W) * bf2f(fx & 0xffffu); a1 += (W) * __builtin_bit_cast(float, fx & 0xffff0000u); a2 += (W) * bf2f(fy & 0xffffu); a3 += (W) * __builtin_bit_cast(float, fy & 0xffff0000u); \
              b0 += (W) * bf2f(sx & 0xffffu); b1 += (W) * __builtin_bit_cast(float, sx & 0xffff0000u); b2 += (W) * bf2f(sy & 0xffffu); b3 += (W) * __builtin_bit_cast(float, sy & 0xffff0000u); }
            MOBA_ACC(xA, sa) MOBA_ACC(xB, sb) MOBA_ACC(xC, sc)
#undef MOBA_ACC
            unsigned ax = cvtpk(a0, a1), ay = cvtpk(a2, a3), bx = cvtpk(b0, b1), by = cvtpk(b2, b3);
            { auto r = __builtin_amdgcn_permlane32_swap(ax, bx, false, false); ax = r[0]; bx = r[1]; }
            { auto r = __builtin_amdgcn_permlane32_swap(ay, by, false, false); ay = r[0]; by = r[1]; }
            *(u32x4*)(orow + dof) = (u32x4){ax, ay, bx, by}; }
}
__device__ __forceinline__ void diag_phase(int wave_, int vcu, const bf16* Q, const bf16* K, const bf16* V, bf16* YM, const bf16* P2A, const bf16* P2B, const float* ML, const float* BT, LAS char* lds) {
    if (vcu >= 256) return;
    int lane_ = lane_id(); asm volatile("" : "+v"(lane_)); asm volatile("" : "+s"(wave_));
    const int s = vcu & 3, bh = vcu >> 2, h = bh & 7;
    fill_bias_table(BT, h, wave_ * 64 + lane_, (LAS float*)(lds + L_TB));
    const float bfar = BT[h * 132 + 128];
#pragma unroll 1
    for (int i = 0; i < 4; ++i) { const int qb = (i == 0) ? s : (i == 1) ? 7 - s : (i == 2) ? 8 + s : 15 - s; diag_unit(wave_, lane_, bh >> 3, h, qb, Q, K, V, YM, P2A, P2B, ML, bfar, lds); }
}
#undef MOBA_CVEC
#undef MOBA_QK
#undef MOBA_NEARMAX
#undef MOBA_STEP
#undef MOBA_BLOCK4
}

__device__ __forceinline__ void ph_cvt_x(const Ctx& F0) {
    const Ctx F = launder(F0);
    const int gw = F.vcu * NWAVES + F.wave, NGW = F.G * NWAVES; float* rs1 = (float*)(F.ws + WS_RS1);
    for (int m = gw; m < T; m += 2 * NGW) {
        f32x4 v[2][4];
#pragma unroll
        for (int r = 0; r < 2; ++r) { const int mr = m + r * NGW < T ? m + r * NGW : T - 1; const f32x4* xr = (const f32x4*)(F.in[0] + (size_t)mr * D) + F.lane;
#pragma unroll
            for (int j = 0; j < 4; ++j) v[r][j] = xr[64 * j]; }
#pragma unroll
        for (int r = 0; r < 2; ++r) { float s = 0.f;
#pragma unroll
            for (int j = 0; j < 4; ++j) s += (v[r][j].x * v[r][j].x + v[r][j].y * v[r][j].y) + (v[r][j].z * v[r][j].z + v[r][j].w * v[r][j].w);
            const float rstd = 1.f / sqrtf(wave_sum(s) * (1.f / D) + RMS_EPS);
            if (m + r * NGW >= T) continue;
            if (F.lane == 0) rs1[m + r * NGW] = rstd;
            unsigned long long* o8 = (unsigned long long*)(P_XB(F) + (size_t)(m + r * NGW) * D) + F.lane;
#pragma unroll
            for (int j = 0; j < 4; ++j) o8[64 * j] = (unsigned long long)pk2(v[r][j].x, v[r][j].y) | ((unsigned long long)pk2(v[r][j].z, v[r][j].w) << 32); }
    }
}
__device__ __forceinline__ float row_ssq_bf16(const bf16* row, int lane) {
    const u32x4* xr = (const u32x4*)row + lane; float s = 0.f;
#pragma unroll
    for (int j = 0; j < 2; ++j) { const u32x4 x = xr[64 * j];
        const float a0 = bf2f(x.x & 0xffffu), a1 = bf2f(x.x >> 16), a2 = bf2f(x.y & 0xffffu), a3 = bf2f(x.y >> 16), a4 = bf2f(x.z & 0xffffu), a5 = bf2f(x.z >> 16), a6 = bf2f(x.w & 0xffffu), a7 = bf2f(x.w >> 16);
        s += ((a0 * a0 + a1 * a1) + (a2 * a2 + a3 * a3)) + ((a4 * a4 + a5 * a5) + (a6 * a6 + a7 * a7)); }
    return wave_sum(s);
}
__device__ __forceinline__ void ph_rstd(const Ctx& F0) {
    const Ctx F = launder(F0);
    const int gw = F.vcu * NWAVES + F.wave, NGW = F.G * NWAVES; float* rs1 = (float*)(F.ws + WS_RS1);
    for (int m = gw; m < T; m += 4 * NGW) {
        u32x4 x[4][2];
#pragma unroll
        for (int r = 0; r < 4; ++r) { const int mr = m + r * NGW < T ? m + r * NGW : T - 1; const u32x4* xr = (const u32x4*)(P_XB(F) + (size_t)mr * D) + F.lane; x[r][0] = xr[0]; x[r][1] = xr[64]; }
#pragma unroll
        for (int r = 0; r < 4; ++r) { float s = 0.f;
#pragma unroll
            for (int j = 0; j < 2; ++j) { const u32x4 q = x[r][j];
                const float a0 = bf2f(q.x & 0xffffu), a1 = bf2f(q.x >> 16), a2 = bf2f(q.y & 0xffffu), a3 = bf2f(q.y >> 16), a4 = bf2f(q.z & 0xffffu), a5 = bf2f(q.z >> 16), a6 = bf2f(q.w & 0xffffu), a7 = bf2f(q.w >> 16);
                s += ((a0 * a0 + a1 * a1) + (a2 * a2 + a3 * a3)) + ((a4 * a4 + a5 * a5) + (a6 * a6 + a7 * a7)); }
            s = wave_sum(s); if (F.lane == 0 && m + r * NGW < T) rs1[m + r * NGW] = 1.f / sqrtf(s * (1.f / D) + RMS_EPS); } }
}

__device__ __forceinline__ void ph_bias_table(const Ctx& F0) {
    const Ctx F = launder(F0);
    if (F.vcu == 0) {
        const float* rel_bias = F.in[1];
        for (int i = F.tid; i < 8 * 132; i += NTHREADS) {
            const int h = i / 132, r = i % 132;
            int bk;
            if (r < 16) bk = r;
            else { bk = 16 + (int)(logf((float)r / 16.f) / logf(8.f) * 16.f); if (bk > 31) bk = 31; }
            P_BT(F)[i] = rel_bias[bk * 8 + h] * LOG2E;
        }
    }
}

__device__ __forceinline__ void ph_pool_dl(const Ctx& F0) {
    const Ctx F = launder(F0);
    const int gt = F.vcu * NTHREADS + F.tid, NGT = F.G * NTHREADS;
    for (int it = gt; it < (T / 32) * 128; it += NGT) {
        const int cp = it & 127, chunk = it >> 7, c = cp * 2, gi = c >> 6, win = 2 << gi, m0 = chunk * 32, t0 = m0 & (SEQ - 1);
        const unsigned* __restrict__ P2 = (const unsigned*)P_PB(F) + cp; unsigned* __restrict__ D2 = (unsigned*)P_DL(F) + cp;
        float s0 = 0.f, s1 = 0.f;
        const int back = (t0 < win) ? t0 : win;
        for (int j = 1; j <= back; ++j) { const unsigned v = P2[(size_t)(m0 - j) * 128]; s0 += bf2f(v & 0xffffu); s1 += bf2f(v >> 16); }
#pragma unroll 4
        for (int i = 0; i < 32; ++i) { const int m = m0 + i, t = t0 + i;
            const unsigned v = P2[(size_t)m * 128]; const float p0 = bf2f(v & 0xffffu), p1 = bf2f(v >> 16);
            s0 += p0; s1 += p1;
            if (t >= win) { const unsigned o = P2[(size_t)(m - win) * 128]; s0 -= bf2f(o & 0xffffu); s1 -= bf2f(o >> 16); }
            const float inv = 1.f / (float)((t + 1 < win) ? t + 1 : win);
            D2[(size_t)m * 128] = pk2(s0 * inv - p0, s1 * inv - p1); }
    }
}
__device__ __forceinline__ void ph_final(const Ctx& F0) {
    const Ctx F = launder(F0);
    const int gw = F.vcu * NWAVES + F.wave, NGW = F.G * NWAVES;
    const f32x4* gf = (const f32x4*)F.in[26];
    for (int m = gw; m < T; m += 2 * NGW) {
        u32x4 x[2][2];
#pragma unroll
        for (int r = 0; r < 2; ++r) { const int mr = m + r * NGW < T ? m + r * NGW : T - 1; const u32x4* xr = (const u32x4*)(P_XB(F) + (size_t)mr * D) + F.lane; x[r][0] = xr[0]; x[r][1] = xr[64]; }
#pragma unroll
        for (int r = 0; r < 2; ++r) { float s = 0.f;
#pragma unroll
            for (int j = 0; j < 2; ++j) { const u32x4 q = x[r][j];
                const float a0 = bf2f(q.x & 0xffffu), a1 = bf2f(q.x >> 16), a2 = bf2f(q.y & 0xffffu), a3 = bf2f(q.y >> 16), a4 = bf2f(q.z & 0xffffu), a5 = bf2f(q.z >> 16), a6 = bf2f(q.w & 0xffffu), a7 = bf2f(q.w >> 16);
                s += ((a0 * a0 + a1 * a1) + (a2 * a2 + a3 * a3)) + ((a4 * a4 + a5 * a5) + (a6 * a6 + a7 * a7)); }
            const float rstd = 1.f / sqrtf(wave_sum(s) * (1.f / D) + RMS_EPS);
            if (m + r * NGW >= T) continue;
            f32x4* orow = (f32x4*)(F.R + (size_t)(m + r * NGW) * D);
#pragma unroll
            for (int j = 0; j < 2; ++j) { const u32x4 q = x[r][j]; const int c4 = 2 * (64 * j + F.lane);
                orow[c4] = (f32x4){bf2f(q.x & 0xffffu), bf2f(q.x >> 16), bf2f(q.y & 0xffffu), bf2f(q.y >> 16)} * rstd * gf[c4];
                orow[c4 + 1] = (f32x4){bf2f(q.z & 0xffffu), bf2f(q.z >> 16), bf2f(q.w & 0xffffu), bf2f(q.w >> 16)} * rstd * gf[c4 + 1]; } }
    }
}

constexpr int LDS_BYTES = 147456;
constexpr int MISC_OFF = 131072 + 320;

__global__ void __launch_bounds__(NTHREADS, 2) mk_fwd(Args args) {
    extern __shared__ __attribute__((aligned(16))) unsigned char lds[];
    Ctx F;
    F.lds = (LAS unsigned char*)lds;
    F.wave = __builtin_amdgcn_readfirstlane((int)threadIdx.x >> 6);
    F.lane = lane_id(); F.tid = F.wave * 64 + F.lane;
    F.G = gridDim.x; { const int bx = blockIdx.x; F.vcu = (F.G % 8 == 0) ? (bx % 8) * (F.G / 8) + bx / 8 : bx; }
    F.in = (KargP)__builtin_amdgcn_kernarg_segment_ptr(); F.R = args.out; F.ws = args.ws;
    unsigned char* ws = args.ws;
    volatile LAS unsigned* MISC = (volatile LAS unsigned*)(F.lds + MISC_OFF);
    if (F.tid < 64) MISC[F.tid] = 0u;
    __syncthreads();
    XcdBarrier bar = xcd_barrier_post((unsigned*)(ws + WS_CTL) + CW_BAR, MISC + 8, F.tid == 0);
#define GRID_BAR() do { bar.bar = (unsigned*)(wsl(ws) + WS_CTL) + CW_BAR; xcd_barrier(bar, F.wave); } while (0)
#define FL launder(F)

    ph_bias_table(F);
    ph_prologue(F);
#pragma unroll 1
    for (int l = 0; l < DEPTH; ++l) {
        if (l == 0) ph_cvt_x(F); else ph_rstd(F);
        GRID_BAR();
        { pg8::Gemm g{P_XB(FL), (const bf16*)(wsl(ws) + WS_WIN) + (size_t)l * NPROJ * D, D, D, D}; pg8::StaticOrder S; S.init(T, NPROJ, sl(F.G), sl((int)blockIdx.x));
          EpiProjE E{P_UG(FL), P_PB(FL), P_QB(FL), P_KB(FL), P_VB(FL), P_KMP(FL), (const float*)(wsl(ws) + WS_RS1)}; pg8::gemm_phase(F.lds, g, S, E, sl(F.wave)); }
        GRID_BAR();
        { pg8::Gemm g{P_UG(FL), (const bf16*)(wsl(ws) + WS_BZ) + (size_t)l * SGN * 256 * 1024, UGP, 1024, 1024}; SsmOrder S{sl(F.G), sl((int)blockIdx.x), 1};
          EpiZ E{(float*)(wsl(ws) + WS_ZB)}; pg8::gemm_phase(F.lds, g, S, E, sl(F.wave)); }
        ph_pool_dl(F);
        moba::sel_phase(sl(F.wave), sl((int)blockIdx.x), sl(F.G), P_QB(FL), P_KMP(FL), (unsigned*)(wsl(ws) + WS_SEL), (LAS char*)F.lds);
        GRID_BAR();
        moba::gather_phase(sl(F.wave), sl(F.vcu), P_QB(FL), P_KB(FL), P_VB(FL), P_YMIX(FL), P_YS(FL), (bf16*)(wsl(ws) + WS_P2B), (float*)(wsl(ws) + WS_ML), (const unsigned*)(wsl(ws) + WS_SEL), P_BT(FL), (LAS char*)F.lds);
        GRID_BAR();
        ph_ssm_scan(F, l);
        ph_tg_expand(F, l);
        moba::diag_phase(sl(F.wave), sl(F.vcu), P_QB(FL), P_KB(FL), P_VB(FL), P_YMIX(FL), P_YS(FL), (const bf16*)(wsl(ws) + WS_P2B), (const float*)(wsl(ws) + WS_ML), P_BT(FL), (LAS char*)F.lds);
        GRID_BAR();
        { pg8::Gemm g{P_UG(FL), (const bf16*)(wsl(ws) + WS_TG) + (size_t)l * SGN * 1024 * UGP, UGP, UGP, UGP}; SsmOrder S{sl(F.G), sl((int)blockIdx.x), 2};
          EpiSsm2 E{P_UG(FL), P_YS(FL), F.in[11] + l * 256}; pg8::gemm_phase(F.lds, g, S, E, sl(F.wave)); }
        GRID_BAR();
        { pg8::Gemm g{P_YS(FL), (const bf16*)(wsl(ws) + WS_GLUT) + (size_t)l * 65536, 256, 256, 256}; HalfOrder S{sl(F.vcu)};
          EpiGluE E{P_YS(FL), P_YMIX(FL), F.in[13] + l * 256}; pg8::gemm_phase(F.lds, g, S, E, sl(F.wave)); }
        { pg8::Gemm g{P_DL(FL), (const bf16*)(wsl(ws) + WS_POOLT) + (size_t)l * 65536, 256, 256, 256}; HalfOrder S{sl(F.vcu) - 128};
          EpiPoolE E{P_YMIX(FL), F.in[15] + l * 256, F.in[16] + l * 256}; pg8::gemm_phase(F.lds, g, S, E, sl(F.wave)); }
        GRID_BAR();
        { pg8::Gemm g{P_YMIX(FL), (const bf16*)(wsl(ws) + WS_WOUT) + (size_t)l * D * D, D, D, D}; pg8::StaticOrder S; S.init(T, D, sl(F.G), sl((int)blockIdx.x));
          EpiOutE E{P_XB(FL)}; pg8::gemm_phase(F.lds, g, S, E, sl(F.wave)); }
        GRID_BAR();
        ph_route(F, l);
        GRID_BAR();
        ph_place(F);
        GRID_BAR();
        { pg8::Gemm g{(const bf16*)(wsl(ws) + WS_XS), (const bf16*)(wsl(ws) + WS_GU) + (size_t)l * 16 * 512 * D, D, D, D}; MoeOrder S{(const int*)(wsl(ws) + WS_TILEB), sl(F.G), sl((int)blockIdx.x), false};
          EpiGU E{(bf16*)(wsl(ws) + WS_HACT), (const float*)(wsl(ws) + WS_ROWW), (const float*)(wsl(ws) + WS_ROWR)}; pg8::gemm_phase(F.lds, g, S, E, sl(F.wave)); }
        GRID_BAR();
        { pg8::Gemm g{(const bf16*)(wsl(ws) + WS_HACT), (const bf16*)(wsl(ws) + WS_WD) + (size_t)l * 24 * D * 512, 512, 512, 512}; MoeOrder S{(const int*)(wsl(ws) + WS_TILEB), sl(F.G), sl((int)blockIdx.x), true};
          EpiDown E{P_XB(FL), (const int*)(wsl(ws) + WS_ROWTOK)}; pg8::gemm_phase(F.lds, g, S, E, sl(F.wave)); }
        GRID_BAR();
    }
    ph_final(F);
}

extern "C" void kernel_launch(void* const* d_in, const int* in_sizes, int n_in, void* d_out, int out_size, void* d_ws, size_t ws_size, hipStream_t stream) {
    static int grid = 0;
    if (grid == 0) {
        if (n_in != 27 || out_size != T * D || ws_size < WS_END) { fprintf(stderr, "kernel_launch: unexpected shapes (n_in %d out %d ws %zu)\n", n_in, out_size, ws_size); grid = -1; return; }
        int dev = 0, cus = 0, per_cu = 0;
        if (hipGetDevice(&dev) != hipSuccess || hipDeviceGetAttribute(&cus, hipDeviceAttributeMultiprocessorCount, dev) != hipSuccess) { grid = -1; return; }
        if (hipFuncSetAttribute((const void*)mk_fwd, hipFuncAttributeMaxDynamicSharedMemorySize, LDS_BYTES) != hipSuccess) { fprintf(stderr, "kernel_launch: hipFuncSetAttribute failed\n"); grid = -1; return; }
        if (hipOccupancyMaxActiveBlocksPerMultiprocessor(&per_cu, (const void*)mk_fwd, NTHREADS, LDS_BYTES) != hipSuccess || per_cu < 1) { fprintf(stderr, "kernel_launch: occupancy query says %d\n", per_cu); per_cu = 1; }
        (void)hipGetLastError();
        grid = cus;
    }
    if (grid < 0) return;
    (void)hipMemsetAsync((char*)d_ws + WS_CTL, 0, CTL_ZERO_BYTES, stream);
    Args a{};
    for (int i = 0; i < 27; ++i) a.in[i] = (const float*)d_in[i];
    a.out = (float*)d_out; a.ws = (unsigned char*)d_ws; a.pad0 = 0; a.pad1 = 0;
    hipLaunchKernelGGL(mk_fwd, dim3(grid), dim3(NTHREADS), LDS_BYTES, stream, a);
}
```

```cpp
#include <hip/hip_runtime.h>
#include <hip/hip_bf16.h>
#include <cstdio>
#include <cstdint>

#define GAS __attribute__((address_space(1)))
#define LAS __attribute__((address_space(3)))
typedef unsigned short bf16;
typedef float f32x4 __attribute__((ext_vector_type(4)));
typedef unsigned u32x4 __attribute__((ext_vector_type(4)));
typedef unsigned u32x2 __attribute__((ext_vector_type(2)));

constexpr int NB = 8, SEQ = 4096, T = NB * SEQ, D = 1024, NPROJ = 2048, DEPTH = 2;
constexpr int NHEAD = 8, HD = 64, MBLK = 256, NBLK = SEQ / MBLK;
constexpr int SG = 16, SGN = 16, SP = 64, SCH = 64, UGP = 1152;
constexpr float RMS_EPS = 1e-6f;
constexpr float LOG2E = 1.4426950408889634f;
constexpr float C2 = 0.125f * LOG2E;
constexpr int NWAVES = 8, NTHREADS = 512;

constexpr size_t MiB = 1u << 20;
constexpr size_t WS_CTL = 0, CTL_ZERO_BYTES = 1 * MiB;
constexpr size_t WS_XB = 2 * MiB;
constexpr size_t WS_UG = 66 * MiB;
constexpr size_t WS_PB = 84 * MiB;
constexpr size_t WS_QB = 100 * MiB;
constexpr size_t WS_KB = 132 * MiB;
constexpr size_t WS_VB = 164 * MiB;
constexpr size_t WS_YMIX = 196 * MiB;
constexpr size_t WS_YS = 260 * MiB;
constexpr size_t WS_DL = 276 * MiB;
constexpr size_t WS_KMP = 292 * MiB;
constexpr size_t WS_BT = 293 * MiB;
constexpr size_t WS_KT = 297 * MiB;
constexpr size_t WS_SEL = 298 * MiB;
constexpr size_t WS_WIN = 300 * MiB;
constexpr size_t WS_WOUT = 308 * MiB;
constexpr size_t WS_GU = 312 * MiB;
constexpr size_t WS_WD = 344 * MiB;
constexpr size_t WS_TG = 392 * MiB;
constexpr size_t WS_BZ = 464 * MiB;
constexpr size_t WS_GLUT = 480 * MiB;
constexpr size_t WS_POOLT = WS_GLUT + 512 * 1024;
constexpr size_t WS_ZB = 482 * MiB;
constexpr size_t WS_P2B = 486 * MiB;
constexpr size_t WS_ML = 502 * MiB;
constexpr size_t WS_END = 508 * MiB;
constexpr int MOE_MAXT = 152;
constexpr size_t WS_XS = 66 * MiB;
constexpr size_t WS_HACT = 142 * MiB;
constexpr size_t WS_TOKB = 294 * MiB;
constexpr size_t WS_TOKR = WS_TOKB + 128 * 1024;
constexpr size_t WS_TOKW = WS_TOKB + 256 * 1024;
constexpr size_t WS_ROWTOK = 295 * MiB;
constexpr size_t WS_ROWW = WS_ROWTOK + 256 * 1024;
constexpr size_t WS_ROWR = WS_ROWTOK + 576 * 1024;
constexpr size_t WS_RS1 = WS_ROWTOK + 768 * 1024;
constexpr size_t WS_WGCNT = 296 * MiB;
constexpr size_t WS_TILEB = WS_WGCNT + 64 * 1024;

constexpr int CW_BAR = 4096;

__device__ __forceinline__ unsigned f2bf(float f) { unsigned u = __builtin_bit_cast(unsigned, f); return (u + 0x7fffu + ((u >> 16) & 1u)) >> 16; }
__device__ __forceinline__ float bf2f(unsigned h) { return __builtin_bit_cast(float, h << 16); }
__device__ __forceinline__ unsigned pk2(float lo, float hi) { return f2bf(lo) | (f2bf(hi) << 16); }
template <int O> __device__ __forceinline__ float xshfl(float v) {
    if constexpr (O < 32) return __builtin_bit_cast(float, __builtin_amdgcn_ds_swizzle(__builtin_bit_cast(int, v), (O << 10) | 0x1f));
    else { const unsigned u = __builtin_bit_cast(unsigned, v); auto r = __builtin_amdgcn_permlane32_swap(u, u, false, false);
           const float a = __builtin_bit_cast(float, (unsigned)r[0]), b = __builtin_bit_cast(float, (unsigned)r[1]); return (a == v && __builtin_bit_cast(unsigned, a) == u) ? b : a; }
}
__device__ __forceinline__ float wave_sum(float v) {
    v += xshfl<1>(v); v += xshfl<2>(v); v += xshfl<4>(v); v += xshfl<8>(v); v += xshfl<16>(v);
    const unsigned u = __builtin_bit_cast(unsigned, v); auto r = __builtin_amdgcn_permlane32_swap(u, u, false, false);
    return __builtin_bit_cast(float, (unsigned)r[0]) + __builtin_bit_cast(float, (unsigned)r[1]);
}
__device__ __forceinline__ float wave_max(float v) {
    v = fmaxf(v, xshfl<1>(v)); v = fmaxf(v, xshfl<2>(v)); v = fmaxf(v, xshfl<4>(v)); v = fmaxf(v, xshfl<8>(v)); v = fmaxf(v, xshfl<16>(v));
    const unsigned u = __builtin_bit_cast(unsigned, v); auto r = __builtin_amdgcn_permlane32_swap(u, u, false, false);
    return fmaxf(__builtin_bit_cast(float, (unsigned)r[0]), __builtin_bit_cast(float, (unsigned)r[1]));
}
__device__ __forceinline__ float gelu_tanh(float x) {
    const float u = 0.7978845608028654f * (x + 0.044715f * x * x * x);
    const float e = __expf(2.f * u);
    const float th = 1.f - 2.f / (e + 1.f);
    return 0.5f * x * (1.f + th);
}
__device__ __forceinline__ float sigmoidf_(float x) { return 1.f / (1.f + __expf(-x)); }

__device__ __forceinline__ int lane_id() { unsigned m; asm volatile("s_mov_b32 %0, -1" : "=s"(m)); return (int)__builtin_amdgcn_mbcnt_hi(m, __builtin_amdgcn_mbcnt_lo(m, 0u)); }

#define XB_TMO      128
#define XB_XCNT(j)  (256  + 64 * (j))
#define XB_XSUB(j)  (1280 + 64 * (j))
#define XB_XGEN(j)  (2304 + 64 * (j))
#define XB_TOP      3328
#define XB_TOPGEN   3392
#define XCD_BAR_WORDS 3456
#define XB_SPIN_CAP (1u << 22)
__device__ __forceinline__ unsigned xb_ld(unsigned* p)              { return __hip_atomic_load(p, __ATOMIC_RELAXED, __HIP_MEMORY_SCOPE_AGENT); }
__device__ __forceinline__ unsigned xb_add(unsigned* p, unsigned v) { return __hip_atomic_fetch_add(p, v, __ATOMIC_RELAXED, __HIP_MEMORY_SCOPE_AGENT); }
__device__ __forceinline__ unsigned xb_xcc_id() { return (unsigned)__builtin_amdgcn_s_getreg((3 << 11) | 20) & 0xFu; }
#define XB_SPIN(cond, bar) do { unsigned _sp = 0; while (cond) { __builtin_amdgcn_s_sleep(1); \
    if ((++_sp & 255u) == 0u) { if (xb_ld(&(bar)[XB_TMO])) break; if (_sp > XB_SPIN_CAP) { atomicAdd(&(bar)[XB_TMO], 1u); break; } } } } while (0)
struct XcdBarrier { unsigned* bar; unsigned x; volatile LAS unsigned* st; };
__device__ __forceinline__ XcdBarrier xcd_barrier_post(unsigned* bar, volatile LAS unsigned* st, bool t0) {
    XcdBarrier b; b.bar = bar; b.x = xb_xcc_id(); b.st = st;
    if (t0) (void)xb_add(&bar[XB_XCNT(b.x)], 1u);
    return b;
}
__device__ __forceinline__ void xcd_barrier_complete(unsigned* bar, unsigned x, unsigned& nloc, unsigned& nx) {
    const unsigned G = gridDim.x * gridDim.y * gridDim.z;
    unsigned sum, cnt, mine, sp = 0u;
    for (;;) {
        sum = 0u; cnt = 0u; mine = 0u;
#pragma unroll
        for (unsigned j = 0; j < 16; ++j) { const unsigned c = xb_ld(&bar[XB_XCNT(j)]); sum += c; cnt += (c > 0u) ? 1u : 0u; mine = (j == x) ? c : mine; }
        if (sum == G) break;
        __builtin_amdgcn_s_sleep(1);
        if ((++sp & 255u) == 0u) { if (xb_ld(&bar[XB_TMO])) break; if (sp > XB_SPIN_CAP) { atomicAdd(&bar[XB_TMO], 1u); break; } }
    }
    nloc = mine > 0u ? mine : 1u; nx = cnt > 0u ? cnt : 1u;
}
__device__ __forceinline__ void xcd_barrier(const XcdBarrier& b, int wave) {
    asm volatile("s_waitcnt vmcnt(0)" ::: "memory");
    __syncthreads();
    if (wave == 0 && lane_id() == 0) {
        unsigned* bar = b.bar;
        __builtin_amdgcn_s_waitcnt(0);
        unsigned nloc = b.st[0], nx = b.st[1];
        if (nloc == 0u) { xcd_barrier_complete(bar, b.x, nloc, nx); b.st[0] = nloc; b.st[1] = nx; }
        const unsigned old = xb_add(&bar[XB_XSUB(b.x)], 1u);
        const unsigned gen = old / nloc;
        if (old + 1u == (gen + 1u) * nloc) {
            __builtin_amdgcn_fence(__ATOMIC_RELEASE, "agent");
            asm volatile("s_waitcnt vmcnt(0)" ::: "memory");
            const unsigned og = xb_add(&bar[XB_TOP], 1u);
            const unsigned tg = og / nx;
            if (og + 1u == (tg + 1u) * nx) xb_add(&bar[XB_TOPGEN], 1u);
            else XB_SPIN(xb_ld(&bar[XB_TOPGEN]) == tg, bar);
            __builtin_amdgcn_fence(__ATOMIC_ACQUIRE, "agent");
            xb_add(&bar[XB_XGEN(b.x)], 1u);
            asm volatile("s_waitcnt vmcnt(0)" ::: "memory");
        } else {
            XB_SPIN(xb_ld(&bar[XB_XGEN(b.x)]) == gen, bar);
            __builtin_amdgcn_fence(__ATOMIC_ACQUIRE, "agent");
            asm volatile("s_waitcnt vmcnt(0)" ::: "memory");
        }
    }
    __syncthreads();
}

struct Args {
    const float* in[27];
    float* out;
    unsigned char* ws;
    int pad0, pad1;
};

typedef const float* fptr_t;
typedef __attribute__((address_space(4))) const fptr_t* KargP;
struct Ctx {
    LAS unsigned char* lds;
    int tid, lane, wave, vcu, G;
    KargP in;
    float* R;
    unsigned char* ws;
};
#define P_XB(F) ((bf16*)((F).ws + WS_XB))
#define P_UG(F) ((bf16*)((F).ws + WS_UG))
#define P_PB(F) ((bf16*)((F).ws + WS_PB))
#define P_QB(F) ((bf16*)((F).ws + WS_QB))
#define P_KB(F) ((bf16*)((F).ws + WS_KB))
#define P_VB(F) ((bf16*)((F).ws + WS_VB))
#define P_YMIX(F) ((bf16*)((F).ws + WS_YMIX))
#define P_YS(F) ((bf16*)((F).ws + WS_YS))
#define P_DL(F) ((bf16*)((F).ws + WS_DL))
#define P_KMP(F) ((float*)((F).ws + WS_KMP))
#define P_BT(F) ((float*)((F).ws + WS_BT))


__device__ __forceinline__ Ctx launder(const Ctx& F0) {
    Ctx F = F0;
    int ln = lane_id(); asm volatile("" : "+v"(ln));
    asm volatile("" : "+s"(F.wave), "+s"(F.vcu), "+s"(F.G));
    F.lane = ln; F.tid = F.wave * 64 + ln;
    KargP kp = (KargP)__builtin_amdgcn_kernarg_segment_ptr(); asm volatile("" : "+s"(kp));
    F.in = kp; F.R = (float*)kp[27]; F.ws = (unsigned char*)kp[28];
    return F;
}

__device__ __forceinline__ unsigned char* wsl(unsigned char* p) { asm volatile("" : "+s"(p)); return p; }
__device__ __forceinline__ int sl(int x) { asm volatile("" : "+s"(x)); return x; }

namespace pg8 {
typedef short bf16x8 __attribute__((ext_vector_type(8)));
constexpr int BM = 256, BK = 64, HALF = 128, HTB = HALF * BK * 2, STAGE_BYTES = 8 * HTB, NXCD = 8, WGM = 8;
__device__ __forceinline__ int lds_byte(int r, int c) { const int st = (r >> 4) * 2 + (c >> 5), rr = r & 15, cc = c & 31, ob = rr * 64 + cc * 2; return st * 1024 + (ob ^ (((ob >> 9) & 1) << 5)); }
__device__ __forceinline__ void stage_rc(int b, int& R, int& C) { const int st = b / 1024, sb = b % 1024, swz = sb ^ (((sb >> 9) & 1) << 5); R = (st >> 1) * 16 + swz / 64; C = (st & 1) * 32 + (swz % 64) / 2; }
__device__ __forceinline__ int perm32(int rho) { const int n = rho >> 4, i = rho & 15; return 8 * (i >> 2) + 4 * n + (i & 3); }

struct Unit { int pm, pn, aux; };
struct Gemm { const bf16* A; const bf16* Bt; int lda, ldb, K; };

struct StaticOrder {
    int nM, nN, nwg, G, c;
    __device__ void init(int M, int N, int G_, int c_) { nM = M / BM; nN = N / BM; nwg = nM * nN; G = G_; c = c_; }
    __device__ bool next(int i, Unit& u) const {
        const long L = (long)i * G + c; if (L >= nwg) return false;
        int wgid = (int)L; { const int q = nwg / NXCD, r = nwg % NXCD, xcd = wgid % NXCD, off = wgid / NXCD; wgid = (xcd < r ? xcd * (q + 1) : r * (q + 1) + (xcd - r) * q) + off; }
        const int nig = WGM * nN, gid = wgid / nig, fm = gid * WGM, gsz = (nM - fm) < WGM ? (nM - fm) : WGM;
        u.pm = fm + ((wgid % nig) % gsz); u.pn = (wgid % nig) / gsz; u.aux = 0; return true;
    }
};

__device__ __forceinline__ unsigned cvt_pk_bf16(float lo, float hi) { unsigned r; asm volatile("v_cvt_pk_bf16_f32 %0, %1, %2" : "=v"(r) : "v"(lo), "v"(hi)); return r; }

template <bool ALIGN = true, bool GATHER = false, class Epi, class Sched>
__device__ __forceinline__ void gemm_phase(LAS unsigned char* lds, const Gemm g, const Sched& S, const Epi& E, int wave_, const int* gidx = nullptr) {
    int lane_ = lane_id(); asm volatile("" : "+v"(lane_)); asm volatile("" : "+s"(wave_));
    const int wid = wave_, lane = lane_, tid = wid * 64 + lane, wr = wid >> 2, wc = wid & 3, fr = lane & 15, fq = lane >> 4;
    const int K = g.K, nt = K / BK;
    unsigned voffA[2], voffA1[2], voffB[2];
#pragma unroll
    for (int i = 0; i < 2; ++i) { int R, C; stage_rc(tid * 16 + i * 8192, R, C); const int Rb = Epi::PERM ? ((R & ~31) + perm32(R & 31)) : R;
        voffA[i] = (unsigned)(R * g.lda + C) * 2u; voffB[i] = (unsigned)(Rb * g.ldb + C) * 2u; voffA1[i] = voffA[i] + (unsigned)(HALF * g.lda * 2); }
    const size_t kstep = (size_t)(BK * 2);
    const size_t hstepA = (size_t)HALF * g.lda * 2, hstepB = (size_t)HALF * g.ldb * 2;
    const size_t tstepA = 2 * hstepA, tstepB = 2 * hstepB;
    const unsigned ldsw = (unsigned)wid * 1024u;
    const int aoff = lds_byte(wr * 64 + fr, fq * 8), boff = lds_byte(wc * 32 + fr, fq * 8);
#define PG8_SA(b, h) (((b) * 2 + (h)) * HTB)
#define PG8_SB(b, h) ((4 + (b) * 2 + (h)) * HTB)
#define PG8_STAGE(bufoff, gbase, voff) do { _Pragma("unroll") for (int _i = 0; _i < 2; ++_i) \
        __builtin_amdgcn_global_load_lds((const unsigned*)((const char*)(gbase) + (voff)[_i]), (LAS unsigned*)(lds + (bufoff) + ldsw + _i * 8192), 16, 0, 0); } while (0)
#define PG8_LDA(dst, b, h) do { _Pragma("unroll") for (int m = 0; m < 4; ++m) _Pragma("unroll") for (int k = 0; k < 2; ++k) dst[m][k] = *(const LAS bf16x8*)(lds + PG8_SA(b, h) + aoff + m * 2048 + k * 1024); } while (0)
#define PG8_LDB(dst, b, h) do { _Pragma("unroll") for (int n = 0; n < 2; ++n) _Pragma("unroll") for (int k = 0; k < 2; ++k) dst[n][k] = *(const LAS bf16x8*)(lds + PG8_SB(b, h) + boff + n * 2048 + k * 1024); } while (0)
#define PG8_MMA(ai, bj, At, Bt) do { __builtin_amdgcn_s_setprio(1); _Pragma("unroll") for (int m = 0; m < 4; ++m) _Pragma("unroll") for (int n = 0; n < 2; ++n) _Pragma("unroll") for (int k = 0; k < 2; ++k) \
        acc[ai][bj][m][n] = __builtin_amdgcn_mfma_f32_16x16x32_bf16(Bt[n][k], At[m][k], acc[ai][bj][m][n], 0, 0, 0); __builtin_amdgcn_s_setprio(0); } while (0)
#define PG8_GLOOK(PM) do { if constexpr (GATHER) { _Pragma("unroll") for (int _i = 0; _i < 2; ++_i) { int R_, C_; stage_rc(tid * 16 + _i * 8192, R_, C_); \
        int t0_ = gidx[(PM) * 256 + R_], t1_ = gidx[(PM) * 256 + HALF + R_]; t0_ = t0_ < 0 ? 0 : t0_; t1_ = t1_ < 0 ? 0 : t1_; \
        voffA[_i] = (unsigned)(t0_ * g.lda + C_) * 2u; voffA1[_i] = (unsigned)(t1_ * g.lda + C_) * 2u; } } } while (0)
#define PG8_WAIT_V(n) asm volatile("s_waitcnt vmcnt(" #n ")" ::: "memory")
#define PG8_WAIT_L(n) asm volatile("s_waitcnt lgkmcnt(" #n ")" ::: "memory")
#define PG8_BAR __builtin_amdgcn_s_barrier()
#define PG8_SCHED __builtin_amdgcn_sched_barrier(0)
    Unit cur, nxt; int ui = 0;
    if (!S.next(0, cur)) return;
    f32x4 acc[2][2][4][2];
#pragma unroll
    for (int a = 0; a < 2; ++a)
#pragma unroll
        for (int b = 0; b < 2; ++b)
#pragma unroll
            for (int m = 0; m < 4; ++m)
#pragma unroll
                for (int n = 0; n < 2; ++n) acc[a][b][m][n] = (f32x4){0.f, 0.f, 0.f, 0.f};
    bf16x8 At[4][2], B0[2][2], B1[2][2];
    const char* cA = (const char*)g.A + (GATHER ? (size_t)0 : (size_t)cur.pm * tstepA); const char* cB = (const char*)g.Bt + (size_t)cur.pn * tstepB;
    PG8_GLOOK(cur.pm);
    PG8_STAGE(PG8_SB(0, 0), cB, voffB); PG8_STAGE(PG8_SB(0, 1), cB + hstepB, voffB); PG8_STAGE(PG8_SA(0, 0), cA, voffA); PG8_STAGE(PG8_SA(0, 1), cA, voffA1);
    if (wr == 1) PG8_BAR;
    PG8_WAIT_V(2); PG8_BAR;
    PG8_STAGE(PG8_SB(1, 0), cB + kstep, voffB); PG8_STAGE(PG8_SA(1, 0), cA + kstep, voffA); PG8_STAGE(PG8_SB(1, 1), cB + hstepB + kstep, voffB);
    PG8_WAIT_V(6); PG8_BAR;
    for (;;) {
        const bool has_next = S.next(ui + 1, nxt);
        const char* nA = has_next ? (const char*)g.A + (GATHER ? (size_t)0 : (size_t)nxt.pm * tstepA) : cA; const char* nB = has_next ? (const char*)g.Bt + (size_t)nxt.pn * tstepB : cB;
        for (int t = 0; t < nt; t += 2) {
            const bool last = (t == nt - 2);
            const char* a1 = cA + (size_t)(t + 1) * kstep;
            const char* a2 = last ? nA : cA + (size_t)(t + 2) * kstep; const char* b2 = last ? nB : cB + (size_t)(t + 2) * kstep;
            const char* a3 = a2 + kstep; const char* b3 = b2 + kstep;
            PG8_LDB(B0, 0, 0); PG8_LDB(B1, 0, 1); PG8_SCHED; PG8_LDA(At, 0, 0); PG8_STAGE(PG8_SA(1, 1), a1, voffA1);
            PG8_WAIT_V(8); PG8_WAIT_L(0); PG8_BAR; PG8_MMA(0, 0, At, B0); PG8_MMA(0, 1, At, B1); PG8_BAR; PG8_SCHED;
            if constexpr (GATHER) { if (last && has_next) PG8_GLOOK(nxt.pm); }
            PG8_LDA(At, 0, 1); PG8_STAGE(PG8_SB(0, 0), b2, voffB); PG8_STAGE(PG8_SB(0, 1), b2 + hstepB, voffB); PG8_STAGE(PG8_SA(0, 0), a2, voffA);
            PG8_WAIT_V(8); PG8_WAIT_L(0); PG8_BAR; PG8_MMA(1, 0, At, B0); PG8_MMA(1, 1, At, B1); PG8_BAR; PG8_SCHED;
            PG8_LDB(B0, 1, 0); PG8_LDB(B1, 1, 1); PG8_SCHED; PG8_LDA(At, 1, 0); PG8_STAGE(PG8_SA(0, 1), a2, voffA1);
            PG8_WAIT_V(8); PG8_WAIT_L(0); PG8_BAR; PG8_MMA(0, 0, At, B0); PG8_MMA(0, 1, At, B1); PG8_BAR; PG8_SCHED;
            PG8_LDA(At, 1, 1); PG8_STAGE(PG8_SB(1, 0), b3, voffB); PG8_STAGE(PG8_SB(1, 1), b3 + hstepB, voffB); PG8_STAGE(PG8_SA(1, 0), a3, voffA);
            PG8_WAIT_V(8); PG8_WAIT_L(0); PG8_BAR; PG8_MMA(1, 0, At, B0); PG8_MMA(1, 1, At, B1); PG8_BAR; PG8_SCHED;
        }
        if constexpr (ALIGN) { if (wr == 0) PG8_BAR; }
        E(acc, cur, wr, wc, fr, fq);
        if (!has_next) break;
#pragma unroll
        for (int a = 0; a < 2; ++a)
#pragma unroll
            for (int b = 0; b < 2; ++b)
#pragma unroll
                for (int m = 0; m < 4; ++m)
#pragma unroll
                    for (int n = 0; n < 2; ++n) acc[a][b][m][n] = (f32x4){0.f, 0.f, 0.f, 0.f};
        cur = nxt; cA = nA; cB = nB; ++ui;
        if constexpr (ALIGN) { if (wr == 1) PG8_BAR; }
    }
    PG8_WAIT_V(0);
    if constexpr (!ALIGN) { if (wr == 0) PG8_BAR; }
    PG8_BAR;
#undef PG8_SA
#undef PG8_SB
#undef PG8_STAGE
#undef PG8_LDA
#undef PG8_LDB
#undef PG8_MMA
#undef PG8_WAIT_V
#undef PG8_WAIT_L
#undef PG8_BAR
#undef PG8_SCHED
}
}


struct EpiProjE {
    static constexpr bool PERM = true;
    bf16 *UG, *PB, *QB, *KB, *VB; float* KMP; const float* rs1;
    __device__ __forceinline__ void operator()(const f32x4 (&acc_)[2][2][4][2], const pg8::Unit& u, int wr, int wc, int fr_, int fq_) const {
        const int ln_ = lane_id(), fr = ln_ & 15, fq = ln_ >> 4; (void)fr_; (void)fq_;
        const int pn = u.pn, row0 = u.pm * 256 + wr * 64 + fr, cl = wc * 32 + 8 * fq;
        f32x4 acc[2][2][4][2];
#pragma unroll
        for (int ai = 0; ai < 2; ++ai)
#pragma unroll
            for (int m = 0; m < 4; ++m) { const float rs = rs1[row0 + ai * 128 + m * 16];
#pragma unroll
                for (int bj = 0; bj < 2; ++bj) { acc[ai][bj][m][0] = acc_[ai][bj][m][0] * rs; acc[ai][bj][m][1] = acc_[ai][bj][m][1] * rs; } }
        if (pn == 0) {
#pragma unroll
            for (int ai = 0; ai < 2; ++ai)
#pragma unroll
                for (int m = 0; m < 4; ++m) { const int r = row0 + ai * 128 + m * 16;
#pragma unroll
                    for (int bj = 0; bj < 2; ++bj) { const int ch = bj * 128 + cl, g = ch >> 4, h0 = ch & 15;
                        const f32x4 v0 = acc[ai][bj][m][0], v1 = acc[ai][bj][m][1]; u32x4 w;
                        w.x = pg8::cvt_pk_bf16(v0[0], v0[1]); w.y = pg8::cvt_pk_bf16(v0[2], v0[3]); w.z = pg8::cvt_pk_bf16(v1[0], v1[1]); w.w = pg8::cvt_pk_bf16(v1[2], v1[3]);
                        *(u32x4*)(UG + ((size_t)(g * 512 + (r >> 6))) * UGP + (r & 63) * 16 + h0) = w; } }
        } else {
            bf16* base; int ldc, colt; float sc = 1.f;
            if (pn == 1) { base = PB; ldc = 256; colt = 0; }
            else if (pn < 4) { base = QB; ldc = 512; colt = (pn - 2) * 256; sc = C2; }
            else if (pn < 6) { base = KB; ldc = 512; colt = (pn - 4) * 256; }
            else { base = VB; ldc = 512; colt = (pn - 6) * 256; }
#pragma unroll
            for (int ai = 0; ai < 2; ++ai)
#pragma unroll
                for (int m = 0; m < 4; ++m) { bf16* rowp = base + (size_t)(row0 + ai * 128 + m * 16) * ldc + colt + cl;
#pragma unroll
                    for (int bj = 0; bj < 2; ++bj) { const f32x4 v0 = acc[ai][bj][m][0] * sc, v1 = acc[ai][bj][m][1] * sc; u32x4 w;
                        w.x = pg8::cvt_pk_bf16(v0[0], v0[1]); w.y = pg8::cvt_pk_bf16(v0[2], v0[3]); w.z = pg8::cvt_pk_bf16(v1[0], v1[1]); w.w = pg8::cvt_pk_bf16(v1[2], v1[3]);
                        *(u32x4*)(rowp + bj * 128) = w; } }
            if (pn >= 4 && pn < 6) {
#pragma unroll
                for (int bj = 0; bj < 2; ++bj)
#pragma unroll
                    for (int n = 0; n < 2; ++n) { f32x4 s = (f32x4){0.f, 0.f, 0.f, 0.f};
#pragma unroll
                        for (int ai = 0; ai < 2; ++ai)
#pragma unroll
                            for (int m = 0; m < 4; ++m) s += acc[ai][bj][m][n];
#pragma unroll
                        for (int i = 0; i < 4; ++i) { float t = s[i]; t += xshfl<1>(t); t += xshfl<2>(t); t += xshfl<4>(t); t += xshfl<8>(t); s[i] = t; }
                        if (fr == 0) *(f32x4*)(KMP + (size_t)wr * 128 * 512 + (size_t)u.pm * 512 + colt + bj * 128 + cl + 4 * n) = s; }
            }
        }
    }
};
struct EpiOutE {
    static constexpr bool PERM = true;
    bf16* RB;
    __device__ __forceinline__ void operator()(const f32x4 (&acc)[2][2][4][2], const pg8::Unit& u, int wr, int wc, int fr_, int fq_) const {
        const int ln_ = lane_id(), fr = ln_ & 15, fq = ln_ >> 4; (void)fr_; (void)fq_;
        const int row0 = u.pm * 256 + wr * 64 + fr, col0 = u.pn * 256 + wc * 32 + 8 * fq;
#pragma unroll
        for (int ai = 0; ai < 2; ++ai) { u32x4 x[4][2];
#pragma unroll
            for (int m = 0; m < 4; ++m) { const bf16* rp = RB + (size_t)(row0 + ai * 128 + m * 16) * D + col0; x[m][0] = *(const u32x4*)rp; x[m][1] = *(const u32x4*)(rp + 128); }
#pragma unroll
            for (int m = 0; m < 4; ++m) { bf16* rp = RB + (size_t)(row0 + ai * 128 + m * 16) * D + col0;
#pragma unroll
                for (int bj = 0; bj < 2; ++bj) { const u32x4 xx = x[m][bj]; const f32x4 a0 = acc[ai][bj][m][0], a1 = acc[ai][bj][m][1]; u32x4 w;
                    w.x = pg8::cvt_pk_bf16(bf2f(xx.x & 0xffffu) + a0[0], bf2f(xx.x >> 16) + a0[1]); w.y = pg8::cvt_pk_bf16(bf2f(xx.y & 0xffffu) + a0[2], bf2f(xx.y >> 16) + a0[3]);
                    w.z = pg8::cvt_pk_bf16(bf2f(xx.z & 0xffffu) + a1[0], bf2f(xx.z >> 16) + a1[1]); w.w = pg8::cvt_pk_bf16(bf2f(xx.w & 0xffffu) + a1[2], bf2f(xx.w >> 16) + a1[3]);
                    *(u32x4*)(rp + bj * 128) = w; } }
            asm volatile("" ::: "memory"); }
    }
};

__device__ __forceinline__ void transpose_item(const float* W, int K, int N, const float* kscale, bf16* WT, int ldo, int koff, int rowmode, LAS float* scr, int item, int lane) {
    const int nblk = N / 32, kb = item / nblk, nb = item % nblk, k0 = 64 * kb, n0 = 32 * nb;
    { const int r8 = lane >> 3, c4 = lane & 7; f32x4 v[8];
#pragma unroll
      for (int i = 0; i < 8; ++i) v[i] = *(const f32x4*)(W + (size_t)(k0 + 8 * i + r8) * N + n0 + 4 * c4);
#pragma unroll
      for (int i = 0; i < 8; ++i) { const int kk = 8 * i + r8; const float s = kscale ? kscale[k0 + kk] : 1.f; LAS float* d = scr + kk * 33 + 4 * c4;
          d[0] = v[i][0] * s; d[1] = v[i][1] * s; d[2] = v[i][2] * s; d[3] = v[i][3] * s; } }
    asm volatile("s_waitcnt lgkmcnt(0)" ::: "memory");
    const int c = lane & 7;
#pragma unroll
    for (int j = 0; j < 4; ++j) { const int n = (lane >> 3) + 8 * j; const LAS float* s = scr + (8 * c) * 33 + n;
        u32x4 o; o.x = pk2(s[0 * 33], s[1 * 33]); o.y = pk2(s[2 * 33], s[3 * 33]); o.z = pk2(s[4 * 33], s[5 * 33]); o.w = pk2(s[6 * 33], s[7 * 33]);
        const int nn = n0 + n, row = rowmode == 0 ? nn : (8 * (nn >> 2) + (nn & 3) + (rowmode == 2 ? 4 : 0));
        *(u32x4*)(WT + (size_t)row * ldo + koff + k0 + 8 * c) = o; }
    asm volatile("s_waitcnt lgkmcnt(0)" ::: "memory");
}
__device__ __forceinline__ void pair_decode(int pi, int& ea, int& eb) { ea = pi < 3 ? 0 : (pi < 5 ? 1 : 2); eb = pi < 3 ? pi + 1 : (pi < 5 ? pi - 1 : 3); }
__device__ __forceinline__ void ph_prologue(const Ctx& F0) {
    const Ctx F = launder(F0);
    LAS float* scr = (LAS float*)(F.lds + F.wave * 16384);
    const int gw = F.vcu * NWAVES + F.wave, NGW = F.G * NWAVES;
    constexpr int I_IN = (D / 64) * (NPROJ / 32), I_OUT = (D / 64) * (D / 32), I_GU1 = (D / 64) * (256 / 32), I_GU = 16 * 2 * I_GU1, I_WD1 = (256 / 64) * (D / 32), I_WD = 24 * 2 * I_WD1;
    constexpr int I_L = I_IN + I_OUT + I_GU + I_WD;
    for (int it = gw; it < DEPTH * I_L; it += NGW) {
        const int l = it / I_L; int r = it % I_L;
        if (r < I_IN) { transpose_item(F.in[3] + (size_t)l * D * NPROJ, D, NPROJ, F.in[2] + l * D, (bf16*)(F.ws + WS_WIN) + (size_t)l * NPROJ * D, D, 0, 0, scr, r, F.lane); continue; } r -= I_IN;
        if (r < I_OUT) { transpose_item(F.in[17] + (size_t)l * D * D, D, D, nullptr, (bf16*)(F.ws + WS_WOUT) + (size_t)l * D * D, D, 0, 0, scr, r, F.lane); continue; } r -= I_OUT;
        if (r < I_GU) { const int e = r / (2 * I_GU1), up = (r / I_GU1) & 1, item = r % I_GU1;
            transpose_item(F.in[up ? 24 : 23] + ((size_t)l * 16 + e) * D * 256, D, 256, F.in[18] + l * D, (bf16*)(F.ws + WS_GU) + ((size_t)l * 16 + e) * 512 * D, D, 0, 1 + up, scr, item, F.lane); continue; } r -= I_GU;
        { const int bk = r / (2 * I_WD1), half = (r / I_WD1) & 1, item = r % I_WD1, g = bk / 6; int ea, eb; pair_decode(bk % 6, ea, eb); const int e = g * 4 + (half ? eb : ea);
            transpose_item(F.in[25] + ((size_t)l * 16 + e) * 256 * D, 256, D, nullptr, (bf16*)(F.ws + WS_WD) + ((size_t)l * 24 + bk) * D * 512, 512, half * 256, 0, scr, item, F.lane); }
    }
    for (int it = gw; it < DEPTH * 32; it += NGW) { const int l = it >> 5;
        transpose_item(F.in[12] + (size_t)l * 256 * 256, 256, 256, nullptr, (bf16*)(F.ws + WS_GLUT) + (size_t)l * 65536, 256, 0, 0, scr, it & 31, F.lane); }
    { const int gt = F.vcu * NTHREADS + F.tid, NGT = F.G * NTHREADS;
      for (int i = gt; i < DEPTH * 65536; i += NGT) { const int l = i >> 16, n = (i >> 8) & 255, k = i & 255;
          const float v = ((n >> 6) == (k >> 6)) ? F.in[14][(((size_t)l * 4 + (n >> 6)) * 64 + (k & 63)) * 64 + (n & 63)] : 0.f;
          ((bf16*)(F.ws + WS_POOLT))[i] = (bf16)f2bf(v); } }
    for (int it = gw; it < DEPTH * SGN * 65; it += NGW) {
        const int l = it / (SGN * 65), g = (it / 65) % SGN, tau = it % 65, p = F.lane;
        const float are = F.in[4][(l * SGN + g) * SP + p], aim = F.in[5][(l * SGN + g) * SP + p], dt = expf(F.in[6][l * SGN + g]);
        float sn, cs; sincosf(aim * dt, &sn, &cs); const float mg = expf(are * dt), lbr = mg * cs, lbi = mg * sn;
        const float nr = lbr - 1.f, ni = lbi, den = are * are + aim * aim, cr = (nr * are + ni * aim) / den, ci = (ni * are - nr * aim) / den;
        float sn2, cs2; sincosf(aim * dt * (float)tau, &sn2, &cs2); const float mg2 = expf(are * dt * (float)tau), lr = mg2 * cs2, li = mg2 * sn2;
        float wr[16], wi[16];
#pragma unroll
        for (int h = 0; h < 16; ++h) { const float br = F.in[7][((size_t)(l * SGN + g) * SP + p) * SG + h], bi = F.in[8][((size_t)(l * SGN + g) * SP + p) * SG + h];
            const float bbr = cr * br - ci * bi, bbi = cr * bi + ci * br; wr[h] = lr * bbr - li * bbi; wi[h] = lr * bbi + li * bbr; }
        bf16* TG = (bf16*)(F.ws + WS_TG) + ((size_t)l * SGN + g) * 1024 * UGP;
        if (tau <= 63) {
            bf16* BZ = (bf16*)(F.ws + WS_BZ) + ((size_t)l * SGN + g) * 256 * 1024; const int s = 63 - tau;
            u32x4 o0, o1, o2, o3;
            o0.x = pk2(wr[0], wr[1]); o0.y = pk2(wr[2], wr[3]); o0.z = pk2(wr[4], wr[5]); o0.w = pk2(wr[6], wr[7]); o1.x = pk2(wr[8], wr[9]); o1.y = pk2(wr[10], wr[11]); o1.z = pk2(wr[12], wr[13]); o1.w = pk2(wr[14], wr[15]);
            o2.x = pk2(wi[0], wi[1]); o2.y = pk2(wi[2], wi[3]); o2.z = pk2(wi[4], wi[5]); o2.w = pk2(wi[6], wi[7]); o3.x = pk2(wi[8], wi[9]); o3.y = pk2(wi[10], wi[11]); o3.z = pk2(wi[12], wi[13]); o3.w = pk2(wi[14], wi[15]);
            *(u32x4*)(BZ + (size_t)p * 1024 + s * 16) = o0; *(u32x4*)(BZ + (size_t)p * 1024 + s * 16 + 8) = o1;
            *(u32x4*)(BZ + (size_t)(64 + p) * 1024 + s * 16) = o2; *(u32x4*)(BZ + (size_t)(64 + p) * 1024 + s * 16 + 8) = o3;
        }
        LAS float* Wst = scr; LAS float* Kt = scr + 128 * 16;
        if (tau <= 63) {
#pragma unroll
            for (int q = 0; q < 4; ++q) { *(LAS f32x4*)(Wst + p * 16 + 4 * q) = (f32x4){wr[4 * q], wr[4 * q + 1], wr[4 * q + 2], wr[4 * q + 3]};
                                          *(LAS f32x4*)(Wst + (64 + p) * 16 + 4 * q) = (f32x4){wi[4 * q], wi[4 * q + 1], wi[4 * q + 2], wi[4 * q + 3]}; }
            const int arow = p & 15, kq = p >> 4; f32x4 kacc = (f32x4){0.f, 0.f, 0.f, 0.f};
            const float* cre = F.in[9] + ((size_t)(l * SGN + g) * SG + arow) * SP; const float* cim = F.in[10] + ((size_t)(l * SGN + g) * SG + arow) * SP;
#pragma unroll 8
            for (int s = 0; s < 32; ++s) { const int k = 4 * s + kq; const float av = (k < 64) ? cre[k] : -cim[k - 64]; const float bv = Wst[k * 16 + arow];
                kacc = __builtin_amdgcn_mfma_f32_16x16x4f32(av, bv, kacc, 0, 0, 0); }
#pragma unroll
            for (int r = 0; r < 4; ++r) Kt[(4 * kq + r) * 16 + arow] = kacc[r];
            asm volatile("s_waitcnt lgkmcnt(0)" ::: "memory");
            const f32x4 t4 = *(const LAS f32x4*)(Kt + 4 * p);
            u32x2 o; o.x = pk2(t4[0], t4[1]); o.y = pk2(t4[2], t4[3]);
            *(u32x2*)((bf16*)(F.ws + WS_KT) + ((size_t)(l * SGN + g) * 64 + tau) * 256 + 4 * p) = o;
        }
        if (tau >= 1) {
#pragma unroll 4
            for (int ho = 0; ho < 16; ++ho) {
                const float ccr = F.in[9][((size_t)(l * SGN + g) * SG + ho) * SP + p], cci = F.in[10][((size_t)(l * SGN + g) * SG + ho) * SP + p];
                const int n = (tau - 1) * 16 + ho;
                TG[(size_t)n * UGP + 1024 + p] = (bf16)f2bf(ccr * lr - cci * li); TG[(size_t)n * UGP + 1088 + p] = (bf16)f2bf(-(ccr * li + cci * lr)); }
        }
    }
}

__device__ __forceinline__ void route_finish(const float (&a)[20], float ssum, int m, bool act, const float* gb_, const float* rb_, int* tokb, float* tokr, float* tokw, LAS int* hist) {
        const float rstd = 1.f / sqrtf(ssum * (1.f / D) + RMS_EPS);
        float lg0 = a[0] * rstd + gb_[0], lg1 = a[1] * rstd + gb_[1], lg2 = a[2] * rstd + gb_[2], lg3 = a[3] * rstd + gb_[3];
        int gs = 0; float gm = lg0;
        if (lg1 > gm) { gm = lg1; gs = 1; } if (lg2 > gm) { gm = lg2; gs = 2; } if (lg3 > gm) { gm = lg3; gs = 3; }
        const float gwt = 1.f / (__expf(lg0 - gm) + __expf(lg1 - gm) + __expf(lg2 - gm) + __expf(lg3 - gm));
        float q0 = a[4], q1 = a[5], q2 = a[6], q3 = a[7], q4 = a[8], q5 = a[9], q6 = a[10], q7 = a[11], q8 = a[12], q9 = a[13], q10 = a[14], q11 = a[15], q12 = a[16], q13 = a[17], q14 = a[18], q15 = a[19];
        asm volatile("" : "+v"(q0), "+v"(q1), "+v"(q2), "+v"(q3), "+v"(q4), "+v"(q5), "+v"(q6), "+v"(q7));
        asm volatile("" : "+v"(q8), "+v"(q9), "+v"(q10), "+v"(q11), "+v"(q12), "+v"(q13), "+v"(q14), "+v"(q15));
        float e0 = gs == 0 ? q0 : gs == 1 ? q4 : gs == 2 ? q8 : q12;
        float e1 = gs == 0 ? q1 : gs == 1 ? q5 : gs == 2 ? q9 : q13;
        float e2 = gs == 0 ? q2 : gs == 1 ? q6 : gs == 2 ? q10 : q14;
        float e3 = gs == 0 ? q3 : gs == 1 ? q7 : gs == 2 ? q11 : q15;
        e0 = e0 * rstd + rb_[gs * 4 + 0]; e1 = e1 * rstd + rb_[gs * 4 + 1]; e2 = e2 * rstd + rb_[gs * 4 + 2]; e3 = e3 * rstd + rb_[gs * 4 + 3];
        int t1 = 0; float v1 = e0;
        if (e1 > v1) { v1 = e1; t1 = 1; } if (e2 > v1) { v1 = e2; t1 = 2; } if (e3 > v1) { v1 = e3; t1 = 3; }
        int t2 = -1; float v2 = -3.0e38f;
        if (t1 != 0 && e0 > v2) { v2 = e0; t2 = 0; } if (t1 != 1 && e1 > v2) { v2 = e1; t2 = 1; } if (t1 != 2 && e2 > v2) { v2 = e2; t2 = 2; } if (t1 != 3 && e3 > v2) { v2 = e3; t2 = 3; }
        const float p2 = __expf(v2 - v1), w1 = gwt / (1.f + p2), w2 = gwt * p2 / (1.f + p2);
        const int lo = t1 < t2 ? t1 : t2, hi = t1 < t2 ? t2 : t1; const float wlo = t1 < t2 ? w1 : w2, whi = t1 < t2 ? w2 : w1;
        const int pi = lo == 0 ? hi - 1 : (lo == 1 ? hi + 1 : 5), bk = gs * 6 + pi;
        if (act) { tokb[m] = bk; tokr[m] = rstd; tokw[2 * m] = wlo; tokw[2 * m + 1] = whi; __hip_atomic_fetch_add(hist + bk, 1, __ATOMIC_RELAXED, __HIP_MEMORY_SCOPE_WORKGROUP); }
}
__device__ __forceinline__ void ph_route(const Ctx& F0, int l) {
    const Ctx F = launder(F0);
    constexpr int WLD = 1032;
    LAS bf16* Wh = (LAS bf16*)F.lds;
    LAS bf16* Wlo = Wh + 20 * WLD;
    LAS float* LG = (LAS float*)(F.lds + 4 * 20 * WLD);
    LAS int* hist = (LAS int*)(F.lds + 4 * 20 * WLD + 8 * 320 * 4);
    const float* g2 = F.in[18] + l * D;
    const f32x4* gw4 = (const f32x4*)(F.in[19] + (size_t)l * D * 4); const f32x4* rw4 = (const f32x4*)(F.in[21] + (size_t)l * 4 * D * 4);
    const float* gb_ = F.in[20] + l * 4; const float* rb_ = F.in[22] + l * 16;
    for (int idx = F.tid; idx < D * 5; idx += NTHREADS) { const int k = idx % D, q = idx / D;
        f32x4 v = (q == 0) ? gw4[k] : rw4[(q - 1) * D + k]; v = v * g2[k];
#pragma unroll
        for (int i = 0; i < 4; ++i) { const unsigned h = f2bf(v[i]); Wh[(q * 4 + i) * WLD + k] = (bf16)h; Wlo[(q * 4 + i) * WLD + k] = (bf16)f2bf(v[i] - bf2f(h)); } }
    if (F.tid < 32) hist[F.tid] = 0;
    __syncthreads();
    int* tokb = (int*)(F.ws + WS_TOKB); float* tokr = (float*)(F.ws + WS_TOKR); float* tokw = (float*)(F.ws + WS_TOKW);
    const int i16 = F.lane & 15, kq = F.lane >> 4, m0 = F.vcu * 128 + F.wave * 16;
    const u32x4* xr = (const u32x4*)(P_XB(F) + (size_t)(m0 + i16) * D) + kq;
    const int c1 = 16 + (i16 & 3);
    const LAS bf16* bh0 = Wh + i16 * WLD + 8 * kq; const LAS bf16* bl0 = Wlo + i16 * WLD + 8 * kq;
    const LAS bf16* bh1 = Wh + c1 * WLD + 8 * kq;  const LAS bf16* bl1 = Wlo + c1 * WLD + 8 * kq;
    f32x4 acc0 = (f32x4){0.f, 0.f, 0.f, 0.f}, acc1 = acc0; float ss = 0.f;
#pragma unroll 4
    for (int c = 0; c < 32; ++c) {
        const u32x4 xa = xr[4 * c];
        const float x0 = bf2f(xa.x & 0xffffu), x1 = __builtin_bit_cast(float, xa.x & 0xffff0000u), x2 = bf2f(xa.y & 0xffffu), x3 = __builtin_bit_cast(float, xa.y & 0xffff0000u);
        const float x4 = bf2f(xa.z & 0xffffu), x5 = __builtin_bit_cast(float, xa.z & 0xffff0000u), x6 = bf2f(xa.w & 0xffffu), x7 = __builtin_bit_cast(float, xa.w & 0xffff0000u);
        ss += ((x0 * x0 + x1 * x1) + (x2 * x2 + x3 * x3)) + ((x4 * x4 + x5 * x5) + (x6 * x6 + x7 * x7));
        const pg8::bf16x8 av = __builtin_bit_cast(pg8::bf16x8, xa);
        const pg8::bf16x8 h0 = *(const LAS pg8::bf16x8*)(bh0 + 32 * c), l0 = *(const LAS pg8::bf16x8*)(bl0 + 32 * c);
        const pg8::bf16x8 h1 = *(const LAS pg8::bf16x8*)(bh1 + 32 * c), l1 = *(const LAS pg8::bf16x8*)(bl1 + 32 * c);
        acc0 = __builtin_amdgcn_mfma_f32_16x16x32_bf16(av, h0, acc0, 0, 0, 0); acc1 = __builtin_amdgcn_mfma_f32_16x16x32_bf16(av, h1, acc1, 0, 0, 0);
        acc0 = __builtin_amdgcn_mfma_f32_16x16x32_bf16(av, l0, acc0, 0, 0, 0); acc1 = __builtin_amdgcn_mfma_f32_16x16x32_bf16(av, l1, acc1, 0, 0, 0);
    }
    ss += xshfl<16>(ss);
    { const unsigned u = __builtin_bit_cast(unsigned, ss); auto r = __builtin_amdgcn_permlane32_swap(u, u, false, false);
      ss = __builtin_bit_cast(float, (unsigned)r[0]) + __builtin_bit_cast(float, (unsigned)r[1]); }
    LAS float* lg = LG + F.wave * 320;
#pragma unroll
    for (int r = 0; r < 4; ++r) { lg[(4 * kq + r) * 20 + i16] = acc0[r]; if (i16 < 4) lg[(4 * kq + r) * 20 + 16 + i16] = acc1[r]; }
    asm volatile("s_waitcnt lgkmcnt(0)" ::: "memory");
    float a[20];
#pragma unroll
    for (int j = 0; j < 5; ++j) { const f32x4 t4 = *(const LAS f32x4*)(lg + i16 * 20 + 4 * j); a[4 * j] = t4[0]; a[4 * j + 1] = t4[1]; a[4 * j + 2] = t4[2]; a[4 * j + 3] = t4[3]; }
    route_finish(a, ss, m0 + i16, kq == 0, gb_, rb_, tokb, tokr, tokw, hist);
    __syncthreads();
    if (F.tid < 24) __hip_atomic_store((int*)(F.ws + WS_WGCNT) + F.vcu * 24 + F.tid, hist[F.tid], __ATOMIC_RELAXED, __HIP_MEMORY_SCOPE_AGENT);
}
__device__ __forceinline__ void ph_place(const Ctx& F0) {
    const Ctx F = launder(F0);
    LAS int* ptot = (LAS int*)F.lds;
    LAS int* pbef = ptot + 512;
    LAS int* bstart = pbef + 512;
    LAS int* btot = bstart + 32;
    LAS int* carry = btot + 32;
    LAS int* rowidx = carry + 32;
    const int* wgcnt = (const int*)(F.ws + WS_WGCNT);
    int* rowtok = (int*)(F.ws + WS_ROWTOK); float* roww = (float*)(F.ws + WS_ROWW); int* tileb = (int*)(F.ws + WS_TILEB);
    const int* tokb = (const int*)(F.ws + WS_TOKB); const float* tokr = (const float*)(F.ws + WS_TOKR); const float* tokw = (const float*)(F.ws + WS_TOKW);
    { const int p = F.tid >> 5, b = F.tid & 31; int tot = 0, bef = 0;
      if (b < 24) for (int v = p * 16; v < p * 16 + 16; ++v) { const int c = wgcnt[v * 24 + b]; tot += c; if (v < F.vcu) bef += c; }
      ptot[p * 32 + b] = tot; pbef[p * 32 + b] = bef; }
    __syncthreads();
    if (F.tid < 32) { int tot = 0, bef = 0; for (int p = 0; p < 16; ++p) { tot += ptot[p * 32 + F.tid]; bef += pbef[p * 32 + F.tid]; } btot[F.tid] = tot; carry[F.tid] = bef; }
    __syncthreads();
    if (F.tid == 0) { int s = 0; for (int b = 0; b < 24; ++b) { bstart[b] = s; s += (btot[b] + 255) & ~255; } bstart[24] = s; }
    __syncthreads();
    if (F.tid < 24) carry[F.tid] += bstart[F.tid];
    if (F.vcu == 0) {
        if (F.tid == 0) tileb[0] = bstart[24] >> 8;
        for (int b = 0; b < 24; ++b) { const int s = bstart[b], e = bstart[b + 1];
            for (int t = (s >> 8) + F.tid; t < (e >> 8); t += NTHREADS) tileb[1 + t] = b;
            for (int r = s + btot[b] + F.tid; r < e; r += NTHREADS) __hip_atomic_store(rowtok + r, -1, __ATOMIC_RELAXED, __HIP_MEMORY_SCOPE_AGENT); }
    }
    __syncthreads();
    if (F.wave == 0) {
        for (int pass = 0; pass < 2; ++pass) { const int i = pass * 64 + F.lane, bi = tokb[F.vcu * 128 + i]; int row = 0;
#pragma unroll 1
            for (int b = 0; b < 24; ++b) { const unsigned long long mask = __ballot(bi == b); const int c = carry[b];
                if (bi == b) row = c + __builtin_popcountll(mask & ((1ull << F.lane) - 1ull));
                asm volatile("s_waitcnt lgkmcnt(0)" ::: "memory");
                if (F.lane == 0) carry[b] = c + __builtin_popcountll(mask);
                asm volatile("s_waitcnt lgkmcnt(0)" ::: "memory"); }
            rowidx[i] = row; }
    }
    __syncthreads();
    if (F.lane < 16) { const int li = F.wave * 16 + F.lane, m = F.vcu * 128 + li, row = rowidx[li];
        const float rstd = tokr[m];
        const unsigned long long w2 = (unsigned long long)__builtin_bit_cast(unsigned, tokw[2 * m]) | ((unsigned long long)__builtin_bit_cast(unsigned, tokw[2 * m + 1]) << 32);
        __hip_atomic_store(rowtok + row, m, __ATOMIC_RELAXED, __HIP_MEMORY_SCOPE_AGENT);
        __hip_atomic_store((unsigned long long*)(roww + 2 * row), w2, __ATOMIC_RELAXED, __HIP_MEMORY_SCOPE_AGENT);
        __hip_atomic_store((float*)(F.ws + WS_ROWR) + row, rstd, __ATOMIC_RELAXED, __HIP_MEMORY_SCOPE_AGENT); }
}
struct MoeOrder {
    int G, c; bool down; int NT, bks;
    __device__ __forceinline__ void init(const int* tileb) {
        const GAS int* tb_ = (const GAS int*)tileb;
        const int nt_ = tb_[0]; int r0 = c >> 2, r1 = (G + c) >> 2, r2 = (2 * G + c) >> 2, r3 = (3 * G + c) >> 2;
        r0 = r0 < MOE_MAXT ? r0 : MOE_MAXT - 1; r1 = r1 < MOE_MAXT ? r1 : MOE_MAXT - 1; r2 = r2 < MOE_MAXT ? r2 : MOE_MAXT - 1; r3 = r3 < MOE_MAXT ? r3 : MOE_MAXT - 1;
        const int b0 = tb_[1 + r0], b1 = tb_[1 + r1], b2 = tb_[1 + r2], b3 = tb_[1 + r3];
        int n_ = __builtin_amdgcn_readfirstlane(nt_), p_ = __builtin_amdgcn_readfirstlane((b0 & 255) | ((b1 & 255) << 8) | ((b2 & 255) << 16) | ((b3 & 255) << 24));
        asm volatile("" : "+s"(n_), "+s"(p_)); NT = n_; bks = p_;
    }
    __device__ __forceinline__ bool next(int i, pg8::Unit& u) const {
        const int L = i * G + c; if (i > 3 || L >= NT * 4) return false;
        const int rt = L >> 2, pn = L & 3, b = (bks >> (8 * i)) & 255;
        if (down) { u.pm = rt; u.pn = b * 4 + pn; u.aux = pn; }
        else { int ea, eb; pair_decode(b % 6, ea, eb); const int e = (b / 6) * 4 + (pn < 2 ? ea : eb); u.pm = rt; u.pn = e * 2 + (pn & 1); u.aux = pn; }
        return true;
    }
};
struct EpiGU {
    static constexpr bool PERM = true;
    bf16* H; const float* roww; const float* rowr;
    __device__ __forceinline__ void operator()(const f32x4 (&acc)[2][2][4][2], const pg8::Unit& u, int wr, int wc, int fr_, int fq_) const {
        const int ln_ = lane_id(), fr = ln_ & 15, fq = ln_ >> 4; (void)fr_; (void)fq_;
        const int row0 = u.pm * 256 + wr * 64 + fr, cl = u.aux * 128 + 16 * wc + 4 * fq, ws = u.aux >> 1;
#pragma unroll
        for (int ai = 0; ai < 2; ++ai)
#pragma unroll
            for (int m = 0; m < 4; ++m) { const int r = row0 + ai * 128 + m * 16; const float rr = rowr[r], w = roww[2 * r + ws] * rr;
#pragma unroll
                for (int bj = 0; bj < 2; ++bj) { const f32x4 g = acc[ai][bj][m][0], up = acc[ai][bj][m][1]; f32x4 a;
#pragma unroll
                    for (int i = 0; i < 4; ++i) { const float gg = g[i] * rr; a[i] = gg * sigmoidf_(gg) * up[i] * w; }
                    u32x2 o; o.x = pg8::cvt_pk_bf16(a[0], a[1]); o.y = pg8::cvt_pk_bf16(a[2], a[3]);
                    *(u32x2*)(H + (size_t)r * 512 + cl + bj * 64) = o; } }
    }
};
struct EpiDown {
    static constexpr bool PERM = true;
    bf16* RB; const int* rowtok;
    __device__ __forceinline__ void operator()(const f32x4 (&acc)[2][2][4][2], const pg8::Unit& u, int wr, int wc, int fr_, int fq_) const {
        const int ln_ = lane_id(), fr = ln_ & 15, fq = ln_ >> 4; (void)fr_; (void)fq_;
        const int row0 = u.pm * 256 + wr * 64 + fr, col0 = u.aux * 256 + wc * 32 + 8 * fq;
        int tok[8];
#pragma unroll
        for (int i = 0; i < 8; ++i) tok[i] = rowtok[row0 + (i >> 2) * 128 + (i & 3) * 16];
#pragma unroll
        for (int ai = 0; ai < 2; ++ai) { u32x4 x[4][2];
#pragma unroll
            for (int m = 0; m < 4; ++m) { const int tk = tok[ai * 4 + m]; const bf16* rp = RB + (size_t)(tk < 0 ? 0 : tk) * D + col0; x[m][0] = *(const u32x4*)rp; x[m][1] = *(const u32x4*)(rp + 128); }
#pragma unroll
            for (int m = 0; m < 4; ++m) { const int tk = tok[ai * 4 + m]; bf16* rp = RB + (size_t)(tk < 0 ? 0 : tk) * D + col0;
#pragma unroll
                for (int bj = 0; bj < 2; ++bj) { const u32x4 xx = x[m][bj]; const f32x4 a0 = acc[ai][bj][m][0], a1 = acc[ai][bj][m][1]; u32x4 w;
                    w.x = pg8::cvt_pk_bf16(bf2f(xx.x & 0xffffu) + a0[0], bf2f(xx.x >> 16) + a0[1]); w.y = pg8::cvt_pk_bf16(bf2f(xx.y & 0xffffu) + a0[2], bf2f(xx.y >> 16) + a0[3]);
                    w.z = pg8::cvt_pk_bf16(bf2f(xx.z & 0xffffu) + a1[0], bf2f(xx.z >> 16) + a1[1]); w.w = pg8::cvt_pk_bf16(bf2f(xx.w & 0xffffu) + a1[2], bf2f(xx.w >> 16) + a1[3]);
                    if (tk >= 0) *(u32x4*)(rp + bj * 128) = w; } }
            asm volatile("" ::: "memory"); }
    }
};

struct SsmOrder { int G, c, mode;
    __device__ __forceinline__ bool next(int i, pg8::Unit& u) const { const int L = i * G + c;
        if (mode == 1) { if (L >= 32) return false; u.pm = L; u.pn = L >> 1; u.aux = 0; return true; }
        if (L >= 128) return false; const int g = L >> 3; u.pm = g * 2 + ((L >> 2) & 1); u.pn = g * 4 + (L & 3); u.aux = L & 3; return true; } };
struct HalfOrder { int L;
    __device__ __forceinline__ bool next(int i, pg8::Unit& u) const { if (i > 0 || L < 0 || L >= 128) return false; u.pm = L; u.pn = 0; u.aux = 0; return true; } };
struct EpiZ { static constexpr bool PERM = false; float* ZB;
    __device__ __forceinline__ void operator()(const f32x4 (&acc)[2][2][4][2], const pg8::Unit& u, int wr, int wc, int fr_, int fq_) const {
        const int ln_ = lane_id(), fr = ln_ & 15, fq = ln_ >> 4; (void)fr_; (void)fq_;
        const int row0 = u.pm * 256 + wr * 64 + fr, col0 = wc * 32 + 4 * fq;
#pragma unroll
        for (int ai = 0; ai < 2; ++ai)
#pragma unroll
            for (int m = 0; m < 4; ++m)
#pragma unroll
                for (int n = 0; n < 2; ++n) *(f32x4*)(ZB + (size_t)(row0 + ai * 128 + m * 16) * 128 + col0 + n * 16) = acc[ai][0][m][n];
    } };
struct EpiSsm2 { static constexpr bool PERM = true; const bf16* UG; bf16* YS; const float* dvec;
    __device__ __forceinline__ void operator()(const f32x4 (&acc)[2][2][4][2], const pg8::Unit& u, int wr, int wc, int fr_, int fq_) const {
        const int ln_ = lane_id(), fr = ln_ & 15, fq = ln_ >> 4; (void)fr_; (void)fq_;
        const int g = u.pm >> 1, cr0 = (u.pm & 1) * 256 + wr * 64 + fr;
#pragma unroll
        for (int bj = 0; bj < 2; ++bj) { const int n0 = u.aux * 256 + bj * 128 + wc * 32 + 8 * fq, to = n0 >> 4, ho0 = n0 & 15;
            const f32x4 d0 = *(const f32x4*)(dvec + g * 16 + ho0), d1 = *(const f32x4*)(dvec + g * 16 + ho0 + 4);
#pragma unroll
            for (int ai = 0; ai < 2; ++ai)
#pragma unroll
                for (int m = 0; m < 4; ++m) { const int cr = cr0 + ai * 128 + m * 16;
                    const u32x4 uu = *(const u32x4*)(UG + ((size_t)(g * 512 + cr)) * UGP + n0);
                    const f32x4 a0 = acc[ai][bj][m][0], a1 = acc[ai][bj][m][1]; float y[8];
                    y[0] = gelu_tanh(a0[0] + d0[0] * bf2f(uu.x & 0xffffu)); y[1] = gelu_tanh(a0[1] + d0[1] * bf2f(uu.x >> 16));
                    y[2] = gelu_tanh(a0[2] + d0[2] * bf2f(uu.y & 0xffffu)); y[3] = gelu_tanh(a0[3] + d0[3] * bf2f(uu.y >> 16));
                    y[4] = gelu_tanh(a1[0] + d1[0] * bf2f(uu.z & 0xffffu)); y[5] = gelu_tanh(a1[1] + d1[1] * bf2f(uu.z >> 16));
                    y[6] = gelu_tanh(a1[2] + d1[2] * bf2f(uu.w & 0xffffu)); y[7] = gelu_tanh(a1[3] + d1[3] * bf2f(uu.w >> 16));
                    u32x4 w; w.x = pg8::cvt_pk_bf16(y[0], y[1]); w.y = pg8::cvt_pk_bf16(y[2], y[3]); w.z = pg8::cvt_pk_bf16(y[4], y[5]); w.w = pg8::cvt_pk_bf16(y[6], y[7]);
                    *(u32x4*)(YS + ((size_t)cr * 64 + to) * 256 + g * 16 + ho0) = w; } }
    } };
struct EpiGluE { static constexpr bool PERM = true; const bf16* YS; bf16* YMIX; const float* gb;
    __device__ __forceinline__ void operator()(const f32x4 (&acc)[2][2][4][2], const pg8::Unit& u, int wr, int wc, int fr_, int fq_) const {
        const int ln_ = lane_id(), fr = ln_ & 15, fq = ln_ >> 4; (void)fr_; (void)fq_;
        const int row0 = u.pm * 256 + wr * 64 + fr;
#pragma unroll
        for (int bj = 0; bj < 2; ++bj) { const int n0 = bj * 128 + wc * 32 + 8 * fq; const f32x4 b0 = *(const f32x4*)(gb + n0), b1 = *(const f32x4*)(gb + n0 + 4);
#pragma unroll
            for (int ai = 0; ai < 2; ++ai)
#pragma unroll
                for (int m = 0; m < 4; ++m) { const size_t r = (size_t)(row0 + ai * 128 + m * 16); const u32x4 yy = *(const u32x4*)(YS + r * 256 + n0);
                    const f32x4 a0 = acc[ai][bj][m][0] + b0, a1 = acc[ai][bj][m][1] + b1; float o[8];
                    o[0] = bf2f(yy.x & 0xffffu) * sigmoidf_(a0[0]); o[1] = bf2f(yy.x >> 16) * sigmoidf_(a0[1]); o[2] = bf2f(yy.y & 0xffffu) * sigmoidf_(a0[2]); o[3] = bf2f(yy.y >> 16) * sigmoidf_(a0[3]);
                    o[4] = bf2f(yy.z & 0xffffu) * sigmoidf_(a1[0]); o[5] = bf2f(yy.z >> 16) * sigmoidf_(a1[1]); o[6] = bf2f(yy.w & 0xffffu) * sigmoidf_(a1[2]); o[7] = bf2f(yy.w >> 16) * sigmoidf_(a1[3]);
                    u32x4 w; w.x = pg8::cvt_pk_bf16(o[0], o[1]); w.y = pg8::cvt_pk_bf16(o[2], o[3]); w.z = pg8::cvt_pk_bf16(o[4], o[5]); w.w = pg8::cvt_pk_bf16(o[6], o[7]);
                    *(u32x4*)(YMIX + r * 1024 + n0) = w; } }
    } };
struct EpiPoolE { static constexpr bool PERM = true; bf16* YMIX; const float* pb; const float* ps;
    __device__ __forceinline__ void operator()(const f32x4 (&acc)[2][2][4][2], const pg8::Unit& u, int wr, int wc, int fr_, int fq_) const {
        const int ln_ = lane_id(), fr = ln_ & 15, fq = ln_ >> 4; (void)fr_; (void)fq_;
        const int row0 = u.pm * 256 + wr * 64 + fr;
#pragma unroll
        for (int bj = 0; bj < 2; ++bj) { const int n0 = bj * 128 + wc * 32 + 8 * fq; const f32x4 b0 = *(const f32x4*)(pb + n0), b1 = *(const f32x4*)(pb + n0 + 4), s0 = *(const f32x4*)(ps + n0), s1 = *(const f32x4*)(ps + n0 + 4);
#pragma unroll
            for (int ai = 0; ai < 2; ++ai)
#pragma unroll
                for (int m = 0; m < 4; ++m) { const size_t r = (size_t)(row0 + ai * 128 + m * 16);
                    const f32x4 a0 = (acc[ai][bj][m][0] + b0) * s0, a1 = (acc[ai][bj][m][1] + b1) * s1;
                    u32x4 w; w.x = pg8::cvt_pk_bf16(a0[0], a0[1]); w.y = pg8::cvt_pk_bf16(a0[2], a0[3]); w.z = pg8::cvt_pk_bf16(a1[0], a1[1]); w.w = pg8::cvt_pk_bf16(a1[2], a1[3]);
                    *(u32x4*)(YMIX + r * 1024 + 256 + n0) = w; } }
    } };
__device__ __forceinline__ void ph_tg_expand(const Ctx& F0, int l) {
    const Ctx F = launder(F0);
    if (F.wave == 0) return;
    const int gw = F.vcu * 7 + (F.wave - 1), NGW = F.G * 7;
    const bf16* KT = (const bf16*)(F.ws + WS_KT) + (size_t)l * SGN * 64 * 256;
    bf16* TG0 = (bf16*)(F.ws + WS_TG) + (size_t)l * SGN * 1024 * UGP;
#pragma unroll 2
    for (int r = gw; r < SGN * 1024; r += NGW) { const int g = r >> 10, n = r & 1023, to = n >> 4, ho = n & 15;
        bf16* d = TG0 + ((size_t)g * 1024 + n) * UGP;
#pragma unroll
        for (int half = 0; half < 2; ++half) { const int ti = half * 32 + (F.lane >> 1), tau = to - ti;
            u32x4 v = (u32x4){0u, 0u, 0u, 0u};
            if (tau >= 0) v = *(const u32x4*)(KT + (((size_t)g * 64 + tau) * 16 + ho) * 16 + (F.lane & 1) * 8);
            *(u32x4*)(d + half * 512 + F.lane * 8) = v; } }
}
__device__ __forceinline__ void ph_ssm_scan(const Ctx& F0, int l) {
    const Ctx F = launder(F0);
    for (int it = F.vcu + F.G * F.wave; it < SGN * NB; it += F.G * NWAVES) {
        const int g = it >> 3, b = it & 7, p = F.lane;
        const float are = F.in[4][(l * SGN + g) * SP + p], aim = F.in[5][(l * SGN + g) * SP + p], dt = expf(F.in[6][l * SGN + g]);
        float sn, cs; sincosf(aim * dt * 64.f, &sn, &cs); const float mg = expf(are * dt * 64.f), lr = mg * cs, li = mg * sn;
        const float* Z = (const float*)(F.ws + WS_ZB) + ((size_t)g * 512 + b * 64) * 128;
        bf16* U = P_UG(F) + ((size_t)g * 512 + b * 64) * UGP + 1024;
        float sr = 0.f, si = 0.f;
#pragma unroll 1
        for (int c0 = 0; c0 < 64; c0 += 32) {
            float zr[32], zi[32];
#pragma unroll
            for (int j = 0; j < 32; ++j) { zr[j] = Z[(c0 + j) * 128 + p]; zi[j] = Z[(c0 + j) * 128 + 64 + p]; }
#pragma unroll
            for (int j = 0; j < 32; ++j) {
                U[(size_t)(c0 + j) * UGP + p] = (bf16)f2bf(sr); U[(size_t)(c0 + j) * UGP + 64 + p] = (bf16)f2bf(si);
                const float nr = lr * sr - li * si + zr[j], ni = lr * si + li * sr + zi[j]; sr = nr; si = ni; }
        }
    }
}

namespace moba {
using bf16x8 = __attribute__((ext_vector_type(8))) short;
using s16x4 = __attribute__((ext_vector_type(4))) short;
using f32x16 = __attribute__((ext_vector_type(16))) float;
typedef short v4i16_t __attribute__((ext_vector_type(4)));
typedef float f32x2_t __attribute__((ext_vector_type(2))); typedef __bf16 bf16x2_t __attribute__((ext_vector_type(2)));
constexpr int L_K = 0, L_V = 49152, L_TB = 98304, L_KM = L_TB + 4 * 768 * 4, L_END = L_KM + 16 * 64 * 4;
__device__ __forceinline__ unsigned cvtpk(float lo, float hi) { f32x2_t v = {lo, hi}; bf16x2_t b = __builtin_convertvector(v, bf16x2_t); return __builtin_bit_cast(unsigned, b); }
__device__ __forceinline__ s16x4 vtr(const LAS char* p) { return __builtin_bit_cast(s16x4, __builtin_amdgcn_ds_read_tr16_b64_v4i16((LAS v4i16_t*)p)); }
__device__ __forceinline__ float hmax(float v) { const unsigned u = __builtin_bit_cast(unsigned, v); auto r = __builtin_amdgcn_permlane32_swap(u, u, false, false); return fmaxf(__builtin_bit_cast(float, (unsigned)r[0]), __builtin_bit_cast(float, (unsigned)r[1])); }
__device__ __forceinline__ float hsum(float v) { const unsigned u = __builtin_bit_cast(unsigned, v); auto r = __builtin_amdgcn_permlane32_swap(u, u, false, false); return __builtin_bit_cast(float, (unsigned)r[0]) + __builtin_bit_cast(float, (unsigned)r[1]); }

constexpr int L_LIST = L_END, L_WCNT = 32768;
#define MOBA_CVEC() f32x16 cvec; do { const float ci_ = bfar - mref; _Pragma("unroll") for (int r = 0; r < 16; ++r) cvec[r] = ci_; } while (0)
#define MOBA_QK(P0, P1, KB) do { { const bf16x8 a0 = *(const LAS bf16x8*)(kp0 + (KB)), a1 = *(const LAS bf16x8*)(kp0 + (KB) + 512); \
          P0 = __builtin_amdgcn_mfma_f32_32x32x16_bf16(a0, qr[0], cvec, 0, 0, 0); P1 = __builtin_amdgcn_mfma_f32_32x32x16_bf16(a1, qr[0], cvec, 0, 0, 0); } \
        _Pragma("unroll") for (int d0 = 1; d0 < 4; ++d0) { const bf16x8 a0 = *(const LAS bf16x8*)(kp0 + (KB) + d0 * 2048), a1 = *(const LAS bf16x8*)(kp0 + (KB) + d0 * 2048 + 512); \
            P0 = __builtin_amdgcn_mfma_f32_32x32x16_bf16(a0, qr[d0], P0, 0, 0, 0); P1 = __builtin_amdgcn_mfma_f32_32x32x16_bf16(a1, qr[d0], P1, 0, 0, 0); } } while (0)
#define MOBA_NEARMAX(P0, P1, JN, OUT) do { const int jn_ = (JN); if (jn_ >= 0) { const int A_ = qrel - 64 * (jn_ - 4) - 4 * hi + 256, s_ = 767 - A_, c_ = s_ & 3; \
            const LAS f32x4* t4 = (const LAS f32x4*)(tb + c_ * 768 + (s_ - c_)); \
            _Pragma("unroll") for (int g = 0; g < 4; ++g) { const f32x4 x0 = t4[2 * g], x1 = t4[2 * g + 8]; \
                _Pragma("unroll") for (int j = 0; j < 4; ++j) { P0[4 * g + j] += x0[j]; P1[4 * g + j] += x1[j]; } } } \
        float ra = __builtin_fmaxf(__builtin_fmaxf(P0[0], P0[1]), P1[0]), rb = __builtin_fmaxf(__builtin_fmaxf(P0[2], P0[3]), P1[1]); \
        ra = __builtin_fmaxf(__builtin_fmaxf(ra, P1[2]), P1[3]); \
        _Pragma("unroll") for (int r = 4; r < 16; r += 4) { ra = __builtin_fmaxf(__builtin_fmaxf(ra, P0[r]), P0[r + 1]); rb = __builtin_fmaxf(__builtin_fmaxf(rb, P0[r + 2]), P0[r + 3]); \
            ra = __builtin_fmaxf(__builtin_fmaxf(ra, P1[r]), P1[r + 1]); rb = __builtin_fmaxf(__builtin_fmaxf(rb, P1[r + 2]), P1[r + 3]); } \
        OUT = hmax(__builtin_fmaxf(ra, rb)); } while (0)
#define MOBA_STEP(PC0, PC1, PN0, PN1, JNN, KBN, VBC, HASN) do { \
        bf16x8 vf[8], kf[8]; \
        if (HASN) { _Pragma("unroll") for (int d0 = 0; d0 < 4; ++d0) { kf[2 * d0] = *(const LAS bf16x8*)(kp0 + (KBN) + d0 * 2048); kf[2 * d0 + 1] = *(const LAS bf16x8*)(kp0 + (KBN) + d0 * 2048 + 512); } } \
        __builtin_amdgcn_sched_barrier(0); \
        if (__any(rm > 8.f)) { const float dl = __builtin_fmaxf(rm, 0.f), alpha = __builtin_amdgcn_exp2f(-dl); mref += dl; l *= alpha; \
            _Pragma("unroll") for (int r = 0; r < 16; ++r) { PC0[r] -= dl; PC1[r] -= dl; o0[r] *= alpha; o1[r] *= alpha; } } \
        if (HASN) { MOBA_CVEC(); \
                    PN0 = __builtin_amdgcn_mfma_f32_32x32x16_bf16(kf[0], qr[0], cvec, 0, 0, 0); PN1 = __builtin_amdgcn_mfma_f32_32x32x16_bf16(kf[1], qr[0], cvec, 0, 0, 0); \
                    _Pragma("unroll") for (int d0 = 1; d0 < 4; ++d0) { PN0 = __builtin_amdgcn_mfma_f32_32x32x16_bf16(kf[2 * d0], qr[d0], PN0, 0, 0, 0); PN1 = __builtin_amdgcn_mfma_f32_32x32x16_bf16(kf[2 * d0 + 1], qr[d0], PN1, 0, 0, 0); } } \
        { const LAS char* vp = vp0 + (VBC); \
        _Pragma("unroll") for (int k = 0; k < 4; ++k) { \
            const s16x4 lo0 = vtr(vp + k * 1024), hi0 = vtr(vp + k * 1024 + 512), lo1 = vtr(vp + 4096 + k * 1024), hi1 = vtr(vp + 4096 + k * 1024 + 512); \
            vf[2 * k] = (bf16x8){lo0[0], lo0[1], lo0[2], lo0[3], hi0[0], hi0[1], hi0[2], hi0[3]}; vf[2 * k + 1] = (bf16x8){lo1[0], lo1[1], lo1[2], lo1[3], hi1[0], hi1[1], hi1[2], hi1[3]}; } } \
        __builtin_amdgcn_sched_barrier(0); \
        float s0 = 0.f, s1 = 0.f; u32x4 pw[4]; \
        _Pragma("unroll") for (int r = 0; r < 16; ++r) { PC0[r] = __builtin_amdgcn_exp2f(PC0[r]); PC1[r] = __builtin_amdgcn_exp2f(PC1[r]); s0 += PC0[r]; s1 += PC1[r]; } \
        l += s0 + s1; \
        _Pragma("unroll") for (int q = 0; q < 4; ++q) { pw[0][q] = cvtpk(PC0[2 * q], PC0[2 * q + 1]); pw[1][q] = cvtpk(PC0[8 + 2 * q], PC0[9 + 2 * q]); pw[2][q] = cvtpk(PC1[2 * q], PC1[2 * q + 1]); pw[3][q] = cvtpk(PC1[8 + 2 * q], PC1[9 + 2 * q]); } \
        _Pragma("unroll") for (int k = 0; k < 4; ++k) { const bf16x8 pa = __builtin_bit_cast(bf16x8, pw[k]); \
            o0 = __builtin_amdgcn_mfma_f32_32x32x16_bf16(vf[2 * k], pa, o0, 0, 0, 0); o1 = __builtin_amdgcn_mfma_f32_32x32x16_bf16(vf[2 * k + 1], pa, o1, 0, 0, 0); } \
        if (HASN) MOBA_NEARMAX(PN0, PN1, JNN, rm); \
    } while (0)
#define MOBA_BLOCK4(JN0, PRE4) \
    float mref = 0.f, l = 0.f; f32x16 o0 = f32x16{}, o1 = f32x16{}; f32x16 pa0, pa1, pb0, pb1; float rm; \
    { const int jn0_ = (JN0); \
      { MOBA_CVEC(); MOBA_QK(pa0, pa1, 0); } MOBA_NEARMAX(pa0, pa1, jn0_, rm); \
      MOBA_STEP(pa0, pa1, pb0, pb1, (jn0_ < 0 ? -1 : jn0_ + 1), 8192, 0, true); \
      MOBA_STEP(pb0, pb1, pa0, pa1, (jn0_ < 0 ? -1 : jn0_ + 2), 16384, 8192, true); \
      MOBA_STEP(pa0, pa1, pb0, pb1, (jn0_ < 0 ? -1 : jn0_ + 3), 24576, 16384, true); \
      PRE4; \
      MOBA_STEP(pb0, pb1, pa0, pa1, -1, 0, 24576, false); }
__device__ __forceinline__ void load_block(const bf16* K, const bf16* V, size_t row0, int h, int wid, int lane, LAS char* lds) {
    const bf16* ksrc = K + (row0 + lane) * 512 + h * 64 + wid * 8;
    const bf16* vsrc = V + (row0 + 16 * (wid & 3) + (lane >> 2)) * 512 + h * 64 + (wid >> 2) * 32 + (lane & 3) * 8;
    u32x4 kr[4], vr[4];
#pragma unroll
    for (int t = 0; t < 4; ++t) { kr[t] = *(const u32x4*)(ksrc + (size_t)t * 64 * 512); vr[t] = *(const u32x4*)(vsrc + (size_t)t * 64 * 512); }
    LAS char* kd = lds + L_K + wid * 1024 + lane * 16; LAS char* vd = lds + L_V + wid * 1024 + lane * 16;
#pragma unroll
    for (int t = 0; t < 4; ++t) { *(LAS u32x4*)(kd + t * 8192) = kr[t]; *(LAS u32x4*)(vd + t * 8192) = vr[t]; }
}
__device__ __forceinline__ void fill_bias_table(const float* BT, int h, int tid, LAS float* tb) {
    const float bfar = BT[h * 132 + 128];
    for (int i = tid; i < 4 * 768; i += NTHREADS) { const int c = i / 768, j = i % 768, src_ = 767 - (j + c), rel = src_ - 256; tb[i] = (src_ < 0 || rel < 0) ? -1.0e30f : (rel < 128 ? BT[h * 132 + rel] - bfar : 0.f); }
}
__device__ __forceinline__ void sel_phase(int wave_, int vcu, int G, const bf16* Q, const float* KMP, unsigned* SEL, LAS char* lds) {
    const int w0 = G > 64 ? 32 : 0, nw = G - w0; if (vcu < w0) return;
    int lane_ = lane_id(); asm volatile("" : "+v"(lane_)); asm volatile("" : "+s"(wave_));
    const int wid = wave_, lane = lane_, tid = wid * 64 + lane, r32 = lane & 31, hi = lane >> 5;
    const int ub = ((vcu - w0) * 1024) / nw, ue = ((vcu - w0 + 1) * 1024) / nw;
    LAS float* km = (LAS float*)(lds + L_KM);
    int bhc = -1;
#pragma unroll 1
    for (int u = ub; u < ue; ++u) {
        const int bh = u >> 4, qb = u & 15, b = bh >> 3, h = bh & 7;
        if (bh != bhc) { bhc = bh;
            __syncthreads();
            for (int i = tid; i < 16 * 64; i += NTHREADS) { const int j = i >> 6, d = i & 63, pm = b * 16 + j; km[i] = KMP[pm * 512 + h * 64 + d] + KMP[128 * 512 + pm * 512 + h * 64 + d]; }
            __syncthreads(); }
        asm volatile("" ::: "memory");
        const int q = qb * 256 + wid * 32 + r32;
        const bf16* qw = Q + ((size_t)b * SEQ + q) * 512 + h * 64 + hi * 8;
        bf16x8 qr[4];
#pragma unroll
        for (int d0 = 0; d0 < 4; ++d0) qr[d0] = *(const bf16x8*)(qw + d0 * 16);
        float g[16];
#pragma unroll
        for (int j = 0; j < 16; ++j) g[j] = 0.f;
#pragma unroll
        for (int d0 = 0; d0 < 4; ++d0)
#pragma unroll
            for (int j = 0; j < 16; ++j) { const f32x4 ka = *(const LAS f32x4*)(km + j * 64 + d0 * 16 + hi * 8), kb4 = *(const LAS f32x4*)(km + j * 64 + d0 * 16 + hi * 8 + 4);
#pragma unroll
                for (int e = 0; e < 4; ++e) { g[j] += bf2f((unsigned)(unsigned short)qr[d0][e]) * ka[e]; }
#pragma unroll
                for (int e = 0; e < 4; ++e) { g[j] += bf2f((unsigned)(unsigned short)qr[d0][4 + e]) * kb4[e]; } }
#pragma unroll
        for (int j = 0; j < 16; ++j) g[j] = hsum(g[j]);
        unsigned selmask = 0u;
#pragma unroll
        for (int s3 = 0; s3 < 3; ++s3) { float bv = -3.0e38f; int bi = -1;
#pragma unroll
            for (int j = 0; j < 16; ++j) { const bool ok = (j < qb) && !((selmask >> j) & 1u) && (g[j] > bv); bv = ok ? g[j] : bv; bi = ok ? j : bi; }
            if (bi >= 0) selmask |= 1u << bi; }
        if (hi == 0) SEL[(size_t)bh * SEQ + q] = selmask;
    }
}
__device__ __forceinline__ bf16* pslot(int slot, size_t t, int h, bf16* YM, bf16* P2A, bf16* P2B) {
    return slot == 0 ? YM + t * 1024 + h * 64 : slot == 1 ? YM + t * 1024 + 512 + h * 64 : (t < (size_t)(T / 2) ? P2A + t * 512 : P2B + (t - (size_t)(T / 2)) * 512) + h * 64;
}
__device__ __forceinline__ void gather_phase(int wave_, int vcu, const bf16* Q, const bf16* K, const bf16* V, bf16* YM, bf16* P2A, bf16* P2B, float* ML, const unsigned* SEL, const float* BT, LAS char* lds) {
    if (vcu >= 256) return;
    int lane_ = lane_id(); asm volatile("" : "+v"(lane_)); asm volatile("" : "+s"(wave_));
    const int wid = wave_, lane = lane_, tid = wid * 64 + lane, r32 = lane & 31, hi = lane >> 5;
    const int bh = vcu >> 2, s = vcu & 3, b = bh >> 3, h = bh & 7;
    const size_t rowbase = (size_t)b * SEQ;
    LAS float* tb = (LAS float*)(lds + L_TB); LAS int* list = (LAS int*)(lds + L_LIST); LAS int* wcnt = (LAS int*)(lds + L_WCNT);
    const float bfar = BT[h * 132 + 128];
    fill_bias_table(BT, h, tid, tb);
    const unsigned* selrow = SEL + (size_t)bh * SEQ;
    const LAS char* kp0 = lds + L_K + hi * 1024 + r32 * 16;
    const LAS char* vp0 = lds + L_V + ((lane >> 4) & 1) * 32 + (lane & 3) * 8 + (4 * hi + ((lane & 15) >> 2)) * 64;
    const unsigned code = s == 0 ? 0xFFFA70u : s == 1 ? 0xFFE961u : s == 2 ? 0xFFFB32u : 0xFDC854u;
    u32x4 kr[4], vr[4]; unsigned msel[8];
#define MOBA_GFETCH(KB) do { const size_t row0 = rowbase + (size_t)(KB) * 256; int lg_ = lane_id(); asm volatile("" : "+v"(lg_));     \
        const bf16* ksrc = K + (row0 + lg_) * 512 + h * 64 + wid * 8; \
        const bf16* vsrc = V + (row0 + 16 * (wid & 3) + (lg_ >> 2)) * 512 + h * 64 + (wid >> 2) * 32 + (lg_ & 3) * 8; \
        _Pragma("unroll") for (int t = 0; t < 4; ++t) { kr[t] = *(const u32x4*)(ksrc + (size_t)t * 64 * 512); vr[t] = *(const u32x4*)(vsrc + (size_t)t * 64 * 512); } \
        const int qs_ = ((KB) + 1) * 256, R_ = (SEQ - qs_) >> 3; \
        _Pragma("unroll") for (int i = 0; i < 8; ++i) { const int off = i * 64 + lg_; msel[i] = off < R_ ? selrow[qs_ + wid * R_ + off] : 0u; } } while (0)
    MOBA_GFETCH((int)(code & 15u));
#pragma unroll 1
    for (int ik = 0; ik < 6; ++ik) {
        const int kb = (int)((code >> (4 * ik)) & 15u); if (kb == 15) break;
        const int kbn = (int)((code >> (4 * ik + 4)) & 15u);
        __syncthreads();
        { LAS char* kd = lds + L_K + wid * 1024 + lane * 16; LAS char* vd = lds + L_V + wid * 1024 + lane * 16;
#pragma unroll
          for (int t = 0; t < 4; ++t) { *(LAS u32x4*)(kd + t * 8192) = kr[t]; *(LAS u32x4*)(vd + t * 8192) = vr[t]; } }
        const int qs = (kb + 1) * 256, R = (SEQ - qs) >> 3;
        unsigned long long bal[8]; int cnt = 0;
#pragma unroll
        for (int i = 0; i < 8; ++i) { bal[i] = __ballot((msel[i] >> kb) & 1u); cnt += __builtin_popcountll(bal[i]); }
        if (lane == 0) wcnt[wid] = cnt;
        __syncthreads();
        int base = 0, n = 0;
#pragma unroll
        for (int w = 0; w < 8; ++w) { const int c = wcnt[w]; n += c; base += (w < wid) ? c : 0; }
#pragma unroll
        for (int i = 0; i < 8; ++i) { const unsigned long long m = bal[i];
            if ((m >> lane) & 1ull) list[base + __builtin_popcountll(m & ((1ull << lane) - 1ull))] = qs + wid * R + i * 64 + lane;
            base += __builtin_popcountll(m); }
        __syncthreads();
        const int ntask = (n + 31) >> 5;
        int tk = wid, qin = 0; bool vn = false; unsigned smn = 0u; bf16x8 qn[4];
#define MOBA_QFETCH() do { const int li_ = tk * 32 + r32; vn = li_ < n; { const int lv_ = list[vn ? li_ : (n > 0 ? n - 1 : 0)]; qin = n > 0 ? lv_ : qs; } smn = selrow[qin]; \
            const bf16* qw = Q + (rowbase + qin) * 512 + h * 64 + hi * 8; \
            _Pragma("unroll") for (int d0 = 0; d0 < 4; ++d0) qn[d0] = *(const bf16x8*)(qw + d0 * 16); } while (0)
        MOBA_QFETCH();
#pragma unroll 1
        while (tk < ntask) {
            const int qi = qin; const bool valid = vn; const unsigned sm = smn;
            bf16x8 qr[4];
#pragma unroll
            for (int d0 = 0; d0 < 4; ++d0) qr[d0] = qn[d0];
            tk += 8;
            const int slot = __builtin_popcount(sm & ((1u << kb) - 1u));
            const int qd = qi - qs, qrel = qd < 255 ? qd : 255;
            const bool nearw = __any(qd < 128);
            MOBA_BLOCK4(nearw ? 0 : -1, MOBA_QFETCH())
            const float lt = hsum(l), inv = 1.f / lt; const size_t t = rowbase + qi;
            bf16* orow = pslot(slot, t, h, YM, P2A, P2B) + 8 * hi;
#pragma unroll
            for (int d0 = 0; d0 < 2; ++d0)
#pragma unroll
                for (int gp = 0; gp < 2; ++gp) { const f32x16& oo = d0 ? o1 : o0; const int ga = 8 * gp, gb = 8 * gp + 4;
                    unsigned ax = cvtpk(oo[ga] * inv, oo[ga + 1] * inv), ay = cvtpk(oo[ga + 2] * inv, oo[ga + 3] * inv), bx = cvtpk(oo[gb] * inv, oo[gb + 1] * inv), by = cvtpk(oo[gb + 2] * inv, oo[gb + 3] * inv);
                    { auto r = __builtin_amdgcn_permlane32_swap(ax, bx, false, false); ax = r[0]; bx = r[1]; }
                    { auto r = __builtin_amdgcn_permlane32_swap(ay, by, false, false); ay = r[0]; by = r[1]; }
                    if (valid) *(u32x4*)(orow + 32 * d0 + 16 * gp) = (u32x4){ax, ay, bx, by}; }
            if (valid && hi == 0) { float* ml = ML + ((t * 8 + h) * 3 + slot) * 2; ml[0] = mref; ml[1] = lt; }
        }
#undef MOBA_QFETCH
        MOBA_GFETCH(kbn);
    }
#undef MOBA_GFETCH
}
__device__ __forceinline__ void diag_unit(int wid, int lane, int b, int h, int qb, const bf16* Q, const bf16* K, const bf16* V, bf16* YM, const bf16* P2A, const bf16* P2B, const float* ML, float bfar, LAS char* lds) {
    const int r32 = lane & 31, hi = lane >> 5; const size_t rowbase = (size_t)b * SEQ;
    LAS float* tb = (LAS float*)(lds + L_TB);
    const LAS char* kp0 = lds + L_K + hi * 1024 + r32 * 16;
    const LAS char* vp0 = lds + L_V + ((lane >> 4) & 1) * 32 + (lane & 3) * 8 + (4 * hi + ((lane & 15) >> 2)) * 64;
    __syncthreads();
    load_block(K, V, rowbase + (size_t)qb * 256, h, wid, lane, lds);
    const int qrel = wid * 32 + r32; const size_t t = rowbase + qb * 256 + qrel;
    bf16x8 qr[4];
    { const bf16* qw = Q + t * 512 + h * 64 + hi * 8;
#pragma unroll
      for (int d0 = 0; d0 < 4; ++d0) qr[d0] = *(const bf16x8*)(qw + d0 * 16); }
    __syncthreads();
    MOBA_BLOCK4(4, (void)0)
    const int nsl = qb < 3 ? qb : 3;
    const float* ml = ML + (t * 8 + h) * 6;
    const bf16* pA = YM + t * 1024 + h * 64 + 8 * hi; const bf16* pB = YM + t * 1024 + 512 + h * 64 + 8 * hi;
    const bf16* pC = (t < (size_t)(T / 2) ? P2A + t * 512 : P2B + (t - (size_t)(T / 2)) * 512) + h * 64 + 8 * hi;
    float m0 = -3.0e38f, m1 = -3.0e38f, m2 = -3.0e38f, l0 = 0.f, l1 = 0.f, l2 = 0.f;
    u32x4 xA[4], xB[4], xC[4];
#pragma unroll
    for (int c = 0; c < 4; ++c) { xA[c] = (u32x4){0u, 0u, 0u, 0u}; xB[c] = xA[c]; xC[c] = xA[c]; }
    if (nsl > 0) { m0 = ml[0]; l0 = ml[1];
#pragma unroll
        for (int c = 0; c < 4; ++c) xA[c] = *(const u32x4*)(pA + 16 * c); }
    if (nsl > 1) { m1 = ml[2]; l1 = ml[3];
#pragma unroll
        for (int c = 0; c < 4; ++c) xB[c] = *(const u32x4*)(pB + 16 * c); }
    if (nsl > 2) { m2 = ml[4]; l2 = ml[5];
#pragma unroll
        for (int c = 0; c < 4; ++c) xC[c] = *(const u32x4*)(pC + 16 * c); }
    const float M = __builtin_fmaxf(__builtin_fmaxf(mref, m0), __builtin_fmaxf(m1, m2));
    const float w0 = __builtin_amdgcn_exp2f(mref - M), wa = l0 * __builtin_amdgcn_exp2f(m0 - M), wb = l1 * __builtin_amdgcn_exp2f(m1 - M), wc = l2 * __builtin_amdgcn_exp2f(m2 - M);
    const float inv = 1.f / (hsum(l) * w0 + wa + wb + wc);
    const float s0 = w0 * inv, sa = wa * inv, sb = wb * inv, sc = wc * inv;
    bf16* orow = YM + t * 1024 + 512 + h * 64 + 8 * hi;
#pragma unroll
    for (int d0 = 0; d0 < 2; ++d0)
#pragma unroll
        for (int gp = 0; gp < 2; ++gp) { const f32x16& oo = d0 ? o1 : o0; const int ga = 8 * gp, gb = 8 * gp + 4, dof = 32 * d0 + 16 * gp, cc = 2 * d0 + gp;
            float a0 = oo[ga] * s0, a1 = oo[ga + 1] * s0, a2 = oo[ga + 2] * s0, a3 = oo[ga + 3] * s0, b0 = oo[gb] * s0, b1 = oo[gb + 1] * s0, b2 = oo[gb + 2] * s0, b3 = oo[gb + 3] * s0;
#define MOBA_ACC(X, W) { unsigned fx = X[cc].x, fy = X[cc].y, sx = X[cc].z, sy = X[cc].w; \
              { auto r = __builtin_amdgcn_permlane32_swap(fx, sx, false, false); fx = r[0]; sx = r[1]; } { auto r = __builtin_amdgcn_permlane32_swap(fy, sy, false, false); fy = r[0]; sy = r[1]; } \
              a0 += (W) * bf2f(fx & 0xffffu); a1 += (W) * __builtin_bit_cast(float, fx & 0xffff0000u); a2 += (W) * bf2f(fy & 0xffffu); a3 += (W) * __builtin_bit_cast(float, fy & 0xffff0000u); \
              b0 += (W) * bf2f(sx & 0xffffu); b1 += (W) * __builtin_bit_cast(float, sx & 0xffff0000u); b2 += (W) * bf2f(sy & 0xffffu); b3 += (W) * __builtin_bit_cast(float, sy & 0xffff0000u); }
            MOBA_ACC(xA, sa) MOBA_ACC(xB, sb) MOBA_ACC(xC, sc)
#undef MOBA_ACC
            unsigned ax = cvtpk(a0, a1), ay = cvtpk(a2, a3), bx = cvtpk(b0, b1), by = cvtpk(b2, b3);
            { auto r = __builtin_amdgcn_permlane32_swap(ax, bx, false, false); ax = r[0]; bx = r[1]; }
            { auto r = __builtin_amdgcn_permlane32_swap(ay, by, false, false); ay = r[0]; by = r[1]; }
            *(u32x4*)(orow + dof) = (u32x4){ax, ay, bx, by}; }
}
__device__ __forceinline__ void diag_phase(int wave_, int vcu, const bf16* Q, const bf16* K, const bf16* V, bf16* YM, const bf16* P2A, const bf16* P2B, const float* ML, const float* BT, LAS char* lds) {
    if (vcu >= 256) return;
    int lane_ = lane_id(); asm volatile("" : "+v"(lane_)); asm volatile("" : "+s"(wave_));
    const int s = vcu & 3, bh = vcu >> 2, h = bh & 7;
    fill_bias_table(BT, h, wave_ * 64 + lane_, (LAS float*)(lds + L_TB));
    const float bfar = BT[h * 132 + 128];
#pragma unroll 1
    for (int i = 0; i < 4; ++i) { const int qb = (i == 0) ? s : (i == 1) ? 7 - s : (i == 2) ? 8 + s : 15 - s; diag_unit(wave_, lane_, bh >> 3, h, qb, Q, K, V, YM, P2A, P2B, ML, bfar, lds); }
}
#undef MOBA_CVEC
#undef MOBA_QK
#undef MOBA_NEARMAX
#undef MOBA_STEP
#undef MOBA_BLOCK4
}

__device__ __forceinline__ void ph_cvt_x(const Ctx& F0) {
    const Ctx F = launder(F0);
    const int gw = F.vcu * NWAVES + F.wave, NGW = F.G * NWAVES; float* rs1 = (float*)(F.ws + WS_RS1);
    for (int m = gw; m < T; m += 2 * NGW) {
        f32x4 v[2][4];
#pragma unroll
        for (int r = 0; r < 2; ++r) { const int mr = m + r * NGW < T ? m + r * NGW : T - 1; const f32x4* xr = (const f32x4*)(F.in[0] + (size_t)mr * D) + F.lane;
#pragma unroll
            for (int j = 0; j < 4; ++j) v[r][j] = xr[64 * j]; }
#pragma unroll
        for (int r = 0; r < 2; ++r) { float s = 0.f;
#pragma unroll
            for (int j = 0; j < 4; ++j) s += (v[r][j].x * v[r][j].x + v[r][j].y * v[r][j].y) + (v[r][j].z * v[r][j].z + v[r][j].w * v[r][j].w);
            const float rstd = 1.f / sqrtf(wave_sum(s) * (1.f / D) + RMS_EPS);
            if (m + r * NGW >= T) continue;
            if (F.lane == 0) rs1[m + r * NGW] = rstd;
            unsigned long long* o8 = (unsigned long long*)(P_XB(F) + (size_t)(m + r * NGW) * D) + F.lane;
#pragma unroll
            for (int j = 0; j < 4; ++j) o8[64 * j] = (unsigned long long)pk2(v[r][j].x, v[r][j].y) | ((unsigned long long)pk2(v[r][j].z, v[r][j].w) << 32); }
    }
}
__device__ __forceinline__ float row_ssq_bf16(const bf16* row, int lane) {
    const u32x4* xr = (const u32x4*)row + lane; float s = 0.f;
#pragma unroll
    for (int j = 0; j < 2; ++j) { const u32x4 x = xr[64 * j];
        const float a0 = bf2f(x.x & 0xffffu), a1 = bf2f(x.x >> 16), a2 = bf2f(x.y & 0xffffu), a3 = bf2f(x.y >> 16), a4 = bf2f(x.z & 0xffffu), a5 = bf2f(x.z >> 16), a6 = bf2f(x.w & 0xffffu), a7 = bf2f(x.w >> 16);
        s += ((a0 * a0 + a1 * a1) + (a2 * a2 + a3 * a3)) + ((a4 * a4 + a5 * a5) + (a6 * a6 + a7 * a7)); }
    return wave_sum(s);
}
__device__ __forceinline__ void ph_rstd(const Ctx& F0) {
    const Ctx F = launder(F0);
    const int gw = F.vcu * NWAVES + F.wave, NGW = F.G * NWAVES; float* rs1 = (float*)(F.ws + WS_RS1);
    for (int m = gw; m < T; m += 4 * NGW) {
        u32x4 x[4][2];
#pragma unroll
        for (int r = 0; r < 4; ++r) { const int mr = m + r * NGW < T ? m + r * NGW : T - 1; const u32x4* xr = (const u32x4*)(P_XB(F) + (size_t)mr * D) + F.lane; x[r][0] = xr[0]; x[r][1] = xr[64]; }
#pragma unroll
        for (int r = 0; r < 4; ++r) { float s = 0.f;
#pragma unroll
            for (int j = 0; j < 2; ++j) { const u32x4 q = x[r][j];
                const float a0 = bf2f(q.x & 0xffffu), a1 = bf2f(q.x >> 16), a2 = bf2f(q.y & 0xffffu), a3 = bf2f(q.y >> 16), a4 = bf2f(q.z & 0xffffu), a5 = bf2f(q.z >> 16), a6 = bf2f(q.w & 0xffffu), a7 = bf2f(q.w >> 16);
                s += ((a0 * a0 + a1 * a1) + (a2 * a2 + a3 * a3)) + ((a4 * a4 + a5 * a5) + (a6 * a6 + a7 * a7)); }
            s = wave_sum(s); if (F.lane == 0 && m + r * NGW < T) rs1[m + r * NGW] = 1.f / sqrtf(s * (1.f / D) + RMS_EPS); } }
}

__device__ __forceinline__ void ph_bias_table(const Ctx& F0) {
    const Ctx F = launder(F0);
    if (F.vcu == 0) {
        const float* rel_bias = F.in[1];
        for (int i = F.tid; i < 8 * 132; i += NTHREADS) {
            const int h = i / 132, r = i % 132;
            int bk;
            if (r < 16) bk = r;
            else { bk = 16 + (int)(logf((float)r / 16.f) / logf(8.f) * 16.f); if (bk > 31) bk = 31; }
            P_BT(F)[i] = rel_bias[bk * 8 + h] * LOG2E;
        }
    }
}

__device__ __forceinline__ void ph_pool_dl(const Ctx& F0) {
    const Ctx F = launder(F0);
    const int gt = F.vcu * NTHREADS + F.tid, NGT = F.G * NTHREADS;
    for (int it = gt; it < (T / 32) * 128; it += NGT) {
        const int cp = it & 127, chunk = it >> 7, c = cp * 2, gi = c >> 6, win = 2 << gi, m0 = chunk * 32, t0 = m0 & (SEQ - 1);
        const unsigned* __restrict__ P2 = (const unsigned*)P_PB(F) + cp; unsigned* __restrict__ D2 = (unsigned*)P_DL(F) + cp;
        float s0 = 0.f, s1 = 0.f;
        const int back = (t0 < win) ? t0 : win;
        for (int j = 1; j <= back; ++j) { const unsigned v = P2[(size_t)(m0 - j) * 128]; s0 += bf2f(v & 0xffffu); s1 += bf2f(v >> 16); }
#pragma unroll 4
        for (int i = 0; i < 32; ++i) { const int m = m0 + i, t = t0 + i;
            const unsigned v = P2[(size_t)m * 128]; const float p0 = bf2f(v & 0xffffu), p1 = bf2f(v >> 16);
            s0 += p0; s1 += p1;
            if (t >= win) { const unsigned o = P2[(size_t)(m - win) * 128]; s0 -= bf2f(o & 0xffffu); s1 -= bf2f(o >> 16); }
            const float inv = 1.f / (float)((t + 1 < win) ? t + 1 : win);
            D2[(size_t)m * 128] = pk2(s0 * inv - p0, s1 * inv - p1); }
    }
}
__device__ __forceinline__ void ph_final(const Ctx& F0) {
    const Ctx F = launder(F0);
    const int gw = F.vcu * NWAVES + F.wave, NGW = F.G * NWAVES;
    const f32x4* gf = (const f32x4*)F.in[26];
    for (int m = gw; m < T; m += 2 * NGW) {
        u32x4 x[2][2];
#pragma unroll
        for (int r = 0; r < 2; ++r) { const int mr = m + r * NGW < T ? m + r * NGW : T - 1; const u32x4* xr = (const u32x4*)(P_XB(F) + (size_t)mr * D) + F.lane; x[r][0] = xr[0]; x[r][1] = xr[64]; }
#pragma unroll
        for (int r = 0; r < 2; ++r) { float s = 0.f;
#pragma unroll
            for (int j = 0; j < 2; ++j) { const u32x4 q = x[r][j];
                const float a0 = bf2f(q.x & 0xffffu), a1 = bf2f(q.x >> 16), a2 = bf2f(q.y & 0xffffu), a3 = bf2f(q.y >> 16), a4 = bf2f(q.z & 0xffffu), a5 = bf2f(q.z >> 16), a6 = bf2f(q.w & 0xffffu), a7 = bf2f(q.w >> 16);
                s += ((a0 * a0 + a1 * a1) + (a2 * a2 + a3 * a3)) + ((a4 * a4 + a5 * a5) + (a6 * a6 + a7 * a7)); }
            const float rstd = 1.f / sqrtf(wave_sum(s) * (1.f / D) + RMS_EPS);
            if (m + r * NGW >= T) continue;
            f32x4* orow = (f32x4*)(F.R + (size_t)(m + r * NGW) * D);
#pragma unroll
            for (int j = 0; j < 2; ++j) { const u32x4 q = x[r][j]; const int c4 = 2 * (64 * j + F.lane);
                orow[c4] = (f32x4){bf2f(q.x & 0xffffu), bf2f(q.x >> 16), bf2f(q.y & 0xffffu), bf2f(q.y >> 16)} * rstd * gf[c4];
                orow[c4 + 1] = (f32x4){bf2f(q.z & 0xffffu), bf2f(q.z >> 16), bf2f(q.w & 0xffffu), bf2f(q.w >> 16)} * rstd * gf[c4 + 1]; } }
    }
}

constexpr int LDS_BYTES = 147456;
constexpr int MISC_OFF = 131072 + 320;

__global__ void __launch_bounds__(NTHREADS, 2) mk_fwd(Args args) {
    extern __shared__ __attribute__((aligned(16))) unsigned char lds[];
    Ctx F;
    F.lds = (LAS unsigned char*)lds;
    F.wave = __builtin_amdgcn_readfirstlane((int)threadIdx.x >> 6);
    F.lane = lane_id(); F.tid = F.wave * 64 + F.lane;
    F.G = gridDim.x; { const int bx = blockIdx.x; F.vcu = (F.G % 8 == 0) ? (bx % 8) * (F.G / 8) + bx / 8 : bx; }
    F.in = (KargP)__builtin_amdgcn_kernarg_segment_ptr(); F.R = args.out; F.ws = args.ws;
    unsigned char* ws = args.ws;
    volatile LAS unsigned* MISC = (volatile LAS unsigned*)(F.lds + MISC_OFF);
    if (F.tid < 64) MISC[F.tid] = 0u;
    __syncthreads();
    XcdBarrier bar = xcd_barrier_post((unsigned*)(ws + WS_CTL) + CW_BAR, MISC + 8, F.tid == 0);
#define GRID_BAR() do { bar.bar = (unsigned*)(wsl(ws) + WS_CTL) + CW_BAR; xcd_barrier(bar, F.wave); } while (0)
#define FL launder(F)

    ph_bias_table(F);
    ph_prologue(F);
#pragma unroll 1
    for (int l = 0; l < DEPTH; ++l) {
        if (l == 0) ph_cvt_x(F); else ph_rstd(F);
        GRID_BAR();
        { pg8::Gemm g{P_XB(FL), (const bf16*)(wsl(ws) + WS_WIN) + (size_t)l * NPROJ * D, D, D, D}; pg8::StaticOrder S; S.init(T, NPROJ, sl(F.G), sl((int)blockIdx.x));
          EpiProjE E{P_UG(FL), P_PB(FL), P_QB(FL), P_KB(FL), P_VB(FL), P_KMP(FL), (const float*)(wsl(ws) + WS_RS1)}; pg8::gemm_phase(F.lds, g, S, E, sl(F.wave)); }
        GRID_BAR();
        { pg8::Gemm g{P_UG(FL), (const bf16*)(wsl(ws) + WS_BZ) + (size_t)l * SGN * 256 * 1024, UGP, 1024, 1024}; SsmOrder S{sl(F.G), sl((int)blockIdx.x), 1};
          EpiZ E{(float*)(wsl(ws) + WS_ZB)}; pg8::gemm_phase(F.lds, g, S, E, sl(F.wave)); }
        ph_pool_dl(F);
        moba::sel_phase(sl(F.wave), sl((int)blockIdx.x), sl(F.G), P_QB(FL), P_KMP(FL), (unsigned*)(wsl(ws) + WS_SEL), (LAS char*)F.lds);
        GRID_BAR();
        moba::gather_phase(sl(F.wave), sl(F.vcu), P_QB(FL), P_KB(FL), P_VB(FL), P_YMIX(FL), P_YS(FL), (bf16*)(wsl(ws) + WS_P2B), (float*)(wsl(ws) + WS_ML), (const unsigned*)(wsl(ws) + WS_SEL), P_BT(FL), (LAS char*)F.lds);
        GRID_BAR();
        ph_ssm_scan(F, l);
        ph_tg_expand(F, l);
        moba::diag_phase(sl(F.wave), sl(F.vcu), P_QB(FL), P_KB(FL), P_VB(FL), P_YMIX(FL), P_YS(FL), (const bf16*)(wsl(ws) + WS_P2B), (const float*)(wsl(ws) + WS_ML), P_BT(FL), (LAS char*)F.lds);
        GRID_BAR();
        { pg8::Gemm g{P_UG(FL), (const bf16*)(wsl(ws) + WS_TG) + (size_t)l * SGN * 1024 * UGP, UGP, UGP, UGP}; SsmOrder S{sl(F.G), sl((int)blockIdx.x), 2};
          EpiSsm2 E{P_UG(FL), P_YS(FL), F.in[11] + l * 256}; pg8::gemm_phase(F.lds, g, S, E, sl(F.wave)); }
        GRID_BAR();
        { pg8::Gemm g{P_YS(FL), (const bf16*)(wsl(ws) + WS_GLUT) + (size_t)l * 65536, 256, 256, 256}; HalfOrder S{sl(F.vcu)};
          EpiGluE E{P_YS(FL), P_YMIX(FL), F.in[13] + l * 256}; pg8::gemm_phase(F.lds, g, S, E, sl(F.wave)); }
        { pg8::Gemm g{P_DL(FL), (const bf16*)(wsl(ws) + WS_POOLT) + (size_t)l * 65536, 256, 256, 256}; HalfOrder S{sl(F.vcu) - 128};
          EpiPoolE E{P_YMIX(FL), F.in[15] + l * 256, F.in[16] + l * 256}; pg8::gemm_phase(F.lds, g, S, E, sl(F.wave)); }
        GRID_BAR();
        { pg8::Gemm g{P_YMIX(FL), (const bf16*)(wsl(ws) + WS_WOUT) + (size_t)l * D * D, D, D, D}; pg8::StaticOrder S; S.init(T, D, sl(F.G), sl((int)blockIdx.x));
          EpiOutE E{P_XB(FL)}; pg8::gemm_phase(F.lds, g, S, E, sl(F.wave)); }
        GRID_BAR();
        ph_route(F, l);
        GRID_BAR();
        ph_place(F);
        GRID_BAR();
        { pg8::Gemm g{P_XB(FL), (const bf16*)(wsl(ws) + WS_GU) + (size_t)l * 16 * 512 * D, D, D, D}; MoeOrder S{sl(F.G), sl((int)blockIdx.x), false, 0, 0}; S.init((const int*)(wsl(ws) + WS_TILEB));
          EpiGU E{(bf16*)(wsl(ws) + WS_HACT), (const float*)(wsl(ws) + WS_ROWW), (const float*)(wsl(ws) + WS_ROWR)}; pg8::gemm_phase<true, true>(F.lds, g, S, E, sl(F.wave), (const int*)(wsl(ws) + WS_ROWTOK)); }
        GRID_BAR();
        { pg8::Gemm g{(const bf16*)(wsl(ws) + WS_HACT), (const bf16*)(wsl(ws) + WS_WD) + (size_t)l * 24 * D * 512, 512, 512, 512}; MoeOrder S{sl(F.G), sl((int)blockIdx.x), true, 0, 0}; S.init((const int*)(wsl(ws) + WS_TILEB));
          EpiDown E{P_XB(FL), (const int*)(wsl(ws) + WS_ROWTOK)}; pg8::gemm_phase(F.lds, g, S, E, sl(F.wave)); }
        GRID_BAR();
    }
    ph_final(F);
}

extern "C" void kernel_launch(void* const* d_in, const int* in_sizes, int n_in, void* d_out, int out_size, void* d_ws, size_t ws_size, hipStream_t stream) {
    static int grid = 0;
    if (grid == 0) {
        if (n_in != 27 || out_size != T * D || ws_size < WS_END) { fprintf(stderr, "kernel_launch: unexpected shapes (n_in %d out %d ws %zu)\n", n_in, out_size, ws_size); grid = -1; return; }
        int dev = 0, cus = 0, per_cu = 0;
        if (hipGetDevice(&dev) != hipSuccess || hipDeviceGetAttribute(&cus, hipDeviceAttributeMultiprocessorCount, dev) != hipSuccess) { grid = -1; return; }
        if (hipFuncSetAttribute((const void*)mk_fwd, hipFuncAttributeMaxDynamicSharedMemorySize, LDS_BYTES) != hipSuccess) { fprintf(stderr, "kernel_launch: hipFuncSetAttribute failed\n"); grid = -1; return; }
        if (hipOccupancyMaxActiveBlocksPerMultiprocessor(&per_cu, (const void*)mk_fwd, NTHREADS, LDS_BYTES) != hipSuccess || per_cu < 1) { fprintf(stderr, "kernel_launch: occupancy query says %d\n", per_cu); per_cu = 1; }
        (void)hipGetLastError();
        grid = cus;
    }
    if (grid < 0) return;
    (void)hipMemsetAsync((char*)d_ws + WS_CTL, 0, CTL_ZERO_BYTES, stream);
    Args a{};
    for (int i = 0; i < 27; ++i) a.in[i] = (const float*)d_in[i];
    a.out = (float*)d_out; a.ws = (unsigned char*)d_ws; a.pad0 = 0; a.pad1 = 0;
    hipLaunchKernelGGL(mk_fwd, dim3(grid), dim3(NTHREADS), LDS_BYTES, stream, a);
}
```

```cpp
#include <hip/hip_runtime.h>
#include <hip/hip_bf16.h>
#include <cstdio>
#include <cstdint>

#define GAS __attribute__((address_space(1)))
#define LAS __attribute__((address_space(3)))
typedef unsigned short bf16;
typedef float f32x4 __attribute__((ext_vector_type(4)));
typedef unsigned u32x4 __attribute__((ext_vector_type(4)));
typedef unsigned u32x2 __attribute__((ext_vector_type(2)));

constexpr int NB = 8, SEQ = 4096, T = NB * SEQ, D = 1024, NPROJ = 2048, DEPTH = 2;
constexpr int NHEAD = 8, HD = 64, MBLK = 256, NBLK = SEQ / MBLK;
constexpr int SG = 16, SGN = 16, SP = 64, SCH = 64, UGP = 1152;
constexpr float RMS_EPS = 1e-6f;
constexpr float LOG2E = 1.4426950408889634f;
constexpr float C2 = 0.125f * LOG2E;
constexpr int NWAVES = 8, NTHREADS = 512;

constexpr size_t MiB = 1u << 20;
constexpr size_t WS_CTL = 0, CTL_ZERO_BYTES = 1 * MiB;
constexpr size_t WS_XB = 2 * MiB;
constexpr size_t WS_UG = 66 * MiB;
constexpr size_t WS_PB = 84 * MiB;
constexpr size_t WS_QB = 100 * MiB;
constexpr size_t WS_KB = 132 * MiB;
constexpr size_t WS_VB = 164 * MiB;
constexpr size_t WS_YMIX = 196 * MiB;
constexpr size_t WS_YS = 260 * MiB;
constexpr size_t WS_DL = 276 * MiB;
constexpr size_t WS_KMP = 292 * MiB;
constexpr size_t WS_BT = 293 * MiB;
constexpr size_t WS_KT = 297 * MiB;
constexpr size_t WS_SEL = 298 * MiB;
constexpr size_t WS_WIN = 300 * MiB;
constexpr size_t WS_WOUT = 308 * MiB;
constexpr size_t WS_GU = 312 * MiB;
constexpr size_t WS_WD = 344 * MiB;
constexpr size_t WS_TG = 392 * MiB;
constexpr size_t WS_BZ = 464 * MiB;
constexpr size_t WS_GLUT = 480 * MiB;
constexpr size_t WS_POOLT = WS_GLUT + 512 * 1024;
constexpr size_t WS_ZB = 482 * MiB;
constexpr size_t WS_P2B = 486 * MiB;
constexpr size_t WS_ML = 502 * MiB;
constexpr size_t WS_END = 508 * MiB;
constexpr int MOE_MAXT = 152;
constexpr size_t WS_XS = 66 * MiB;
constexpr size_t WS_HACT = 142 * MiB;
constexpr size_t WS_TOKB = 294 * MiB;
constexpr size_t WS_TOKR = WS_TOKB + 128 * 1024;
constexpr size_t WS_TOKW = WS_TOKB + 256 * 1024;
constexpr size_t WS_ROWTOK = 295 * MiB;
constexpr size_t WS_ROWW = WS_ROWTOK + 256 * 1024;
constexpr size_t WS_ROWR = WS_ROWTOK + 576 * 1024;
constexpr size_t WS_RS1 = WS_ROWTOK + 768 * 1024;
constexpr size_t WS_WGCNT = 296 * MiB;
constexpr size_t WS_TILEB = WS_WGCNT + 64 * 1024;

constexpr int CW_BAR = 4096;

__device__ __forceinline__ unsigned f2bf(float f) { unsigned u = __builtin_bit_cast(unsigned, f); return (u + 0x7fffu + ((u >> 16) & 1u)) >> 16; }
__device__ __forceinline__ float bf2f(unsigned h) { return __builtin_bit_cast(float, h << 16); }
__device__ __forceinline__ unsigned pk2(float lo, float hi) { return f2bf(lo) | (f2bf(hi) << 16); }
template <int O> __device__ __forceinline__ float xshfl(float v) {
    if constexpr (O < 32) return __builtin_bit_cast(float, __builtin_amdgcn_ds_swizzle(__builtin_bit_cast(int, v), (O << 10) | 0x1f));
    else { const unsigned u = __builtin_bit_cast(unsigned, v); auto r = __builtin_amdgcn_permlane32_swap(u, u, false, false);
           const float a = __builtin_bit_cast(float, (unsigned)r[0]), b = __builtin_bit_cast(float, (unsigned)r[1]); return (a == v && __builtin_bit_cast(unsigned, a) == u) ? b : a; }
}
__device__ __forceinline__ float wave_sum(float v) {
    v += xshfl<1>(v); v += xshfl<2>(v); v += xshfl<4>(v); v += xshfl<8>(v); v += xshfl<16>(v);
    const unsigned u = __builtin_bit_cast(unsigned, v); auto r = __builtin_amdgcn_permlane32_swap(u, u, false, false);
    return __builtin_bit_cast(float, (unsigned)r[0]) + __builtin_bit_cast(float, (unsigned)r[1]);
}
__device__ __forceinline__ float wave_max(float v) {
    v = fmaxf(v, xshfl<1>(v)); v = fmaxf(v, xshfl<2>(v)); v = fmaxf(v, xshfl<4>(v)); v = fmaxf(v, xshfl<8>(v)); v = fmaxf(v, xshfl<16>(v));
    const unsigned u = __builtin_bit_cast(unsigned, v); auto r = __builtin_amdgcn_permlane32_swap(u, u, false, false);
    return fmaxf(__builtin_bit_cast(float, (unsigned)r[0]), __builtin_bit_cast(float, (unsigned)r[1]));
}
__device__ __forceinline__ float gelu_tanh(float x) {
    const float u = 0.7978845608028654f * (x + 0.044715f * x * x * x);
    const float e = __expf(2.f * u);
    const float th = 1.f - 2.f / (e + 1.f);
    return 0.5f * x * (1.f + th);
}
__device__ __forceinline__ float sigmoidf_(float x) { return 1.f / (1.f + __expf(-x)); }

__device__ __forceinline__ int lane_id() { unsigned m; asm volatile("s_mov_b32 %0, -1" : "=s"(m)); return (int)__builtin_amdgcn_mbcnt_hi(m, __builtin_amdgcn_mbcnt_lo(m, 0u)); }

#define XB_TMO      128
#define XB_XCNT(j)  (256  + 64 * (j))
#define XB_XSUB(j)  (1280 + 64 * (j))
#define XB_XGEN(j)  (2304 + 64 * (j))
#define XB_TOP      3328
#define XB_TOPGEN   3392
#define XCD_BAR_WORDS 3456
#define XB_SPIN_CAP (1u << 22)
__device__ __forceinline__ unsigned xb_ld(unsigned* p)              { return __hip_atomic_load(p, __ATOMIC_RELAXED, __HIP_MEMORY_SCOPE_AGENT); }
__device__ __forceinline__ unsigned xb_add(unsigned* p, unsigned v) { return __hip_atomic_fetch_add(p, v, __ATOMIC_RELAXED, __HIP_MEMORY_SCOPE_AGENT); }
__device__ __forceinline__ unsigned xb_xcc_id() { return (unsigned)__builtin_amdgcn_s_getreg((3 << 11) | 20) & 0xFu; }
#define XB_SPIN(cond, bar) do { unsigned _sp = 0; while (cond) { __builtin_amdgcn_s_sleep(1); \
    if ((++_sp & 255u) == 0u) { if (xb_ld(&(bar)[XB_TMO])) break; if (_sp > XB_SPIN_CAP) { atomicAdd(&(bar)[XB_TMO], 1u); break; } } } } while (0)
struct XcdBarrier { unsigned* bar; unsigned x; volatile LAS unsigned* st; };
__device__ __forceinline__ XcdBarrier xcd_barrier_post(unsigned* bar, volatile LAS unsigned* st, bool t0) {
    XcdBarrier b; b.bar = bar; b.x = xb_xcc_id(); b.st = st;
    if (t0) (void)xb_add(&bar[XB_XCNT(b.x)], 1u);
    return b;
}
__device__ __forceinline__ void xcd_barrier_complete(unsigned* bar, unsigned x, unsigned& nloc, unsigned& nx) {
    const unsigned G = gridDim.x * gridDim.y * gridDim.z;
    unsigned sum, cnt, mine, sp = 0u;
    for (;;) {
        sum = 0u; cnt = 0u; mine = 0u;
#pragma unroll
        for (unsigned j = 0; j < 16; ++j) { const unsigned c = xb_ld(&bar[XB_XCNT(j)]); sum += c; cnt += (c > 0u) ? 1u : 0u; mine = (j == x) ? c : mine; }
        if (sum == G) break;
        __builtin_amdgcn_s_sleep(1);
        if ((++sp & 255u) == 0u) { if (xb_ld(&bar[XB_TMO])) break; if (sp > XB_SPIN_CAP) { atomicAdd(&bar[XB_TMO], 1u); break; } }
    }
    nloc = mine > 0u ? mine : 1u; nx = cnt > 0u ? cnt : 1u;
}
__device__ __forceinline__ void xcd_barrier(const XcdBarrier& b, int wave) {
    asm volatile("s_waitcnt vmcnt(0)" ::: "memory");
    __syncthreads();
    if (wave == 0 && lane_id() == 0) {
        unsigned* bar = b.bar;
        __builtin_amdgcn_s_waitcnt(0);
        unsigned nloc = b.st[0], nx = b.st[1];
        if (nloc == 0u) { xcd_barrier_complete(bar, b.x, nloc, nx); b.st[0] = nloc; b.st[1] = nx; }
        const unsigned old = xb_add(&bar[XB_XSUB(b.x)], 1u);
        const unsigned gen = old / nloc;
        if (old + 1u == (gen + 1u) * nloc) {
            __builtin_amdgcn_fence(__ATOMIC_RELEASE, "agent");
            asm volatile("s_waitcnt vmcnt(0)" ::: "memory");
            const unsigned og = xb_add(&bar[XB_TOP], 1u);
            const unsigned tg = og / nx;
            if (og + 1u == (tg + 1u) * nx) xb_add(&bar[XB_TOPGEN], 1u);
            else XB_SPIN(xb_ld(&bar[XB_TOPGEN]) == tg, bar);
            __builtin_amdgcn_fence(__ATOMIC_ACQUIRE, "agent");
            xb_add(&bar[XB_XGEN(b.x)], 1u);
            asm volatile("s_waitcnt vmcnt(0)" ::: "memory");
        } else {
            XB_SPIN(xb_ld(&bar[XB_XGEN(b.x)]) == gen, bar);
            __builtin_amdgcn_fence(__ATOMIC_ACQUIRE, "agent");
            asm volatile("s_waitcnt vmcnt(0)" ::: "memory");
        }
    }
    __syncthreads();
}

struct Args {
    const float* in[27];
    float* out;
    unsigned char* ws;
    int pad0, pad1;
};

typedef const float* fptr_t;
typedef __attribute__((address_space(4))) const fptr_t* KargP;
struct Ctx {
    LAS unsigned char* lds;
    int tid, lane, wave, vcu, G;
    KargP in;
    float* R;
    unsigned char* ws;
};
#define P_XB(F) ((bf16*)((F).ws + WS_XB))
#define P_UG(F) ((bf16*)((F).ws + WS_UG))
#define P_PB(F) ((bf16*)((F).ws + WS_PB))
#define P_QB(F) ((bf16*)((F).ws + WS_QB))
#define P_KB(F) ((bf16*)((F).ws + WS_KB))
#define P_VB(F) ((bf16*)((F).ws + WS_VB))
#define P_YMIX(F) ((bf16*)((F).ws + WS_YMIX))
#define P_YS(F) ((bf16*)((F).ws + WS_YS))
#define P_DL(F) ((bf16*)((F).ws + WS_DL))
#define P_KMP(F) ((float*)((F).ws + WS_KMP))
#define P_BT(F) ((float*)((F).ws + WS_BT))


__device__ __forceinline__ Ctx launder(const Ctx& F0) {
    Ctx F = F0;
    int ln = lane_id(); asm volatile("" : "+v"(ln));
    asm volatile("" : "+s"(F.wave), "+s"(F.vcu), "+s"(F.G));
    F.lane = ln; F.tid = F.wave * 64 + ln;
    KargP kp = (KargP)__builtin_amdgcn_kernarg_segment_ptr(); asm volatile("" : "+s"(kp));
    F.in = kp; F.R = (float*)kp[27]; F.ws = (unsigned char*)kp[28];
    return F;
}

__device__ __forceinline__ unsigned char* wsl(unsigned char* p) { asm volatile("" : "+s"(p)); return p; }
__device__ __forceinline__ int sl(int x) { asm volatile("" : "+s"(x)); return x; }

namespace pg8 {
typedef short bf16x8 __attribute__((ext_vector_type(8)));
constexpr int BM = 256, BK = 64, HALF = 128, HTB = HALF * BK * 2, STAGE_BYTES = 8 * HTB, NXCD = 8, WGM = 8;
__device__ __forceinline__ int lds_byte(int r, int c) { const int st = (r >> 4) * 2 + (c >> 5), rr = r & 15, cc = c & 31, ob = rr * 64 + cc * 2; return st * 1024 + (ob ^ (((ob >> 9) & 1) << 5)); }
__device__ __forceinline__ void stage_rc(int b, int& R, int& C) { const int st = b / 1024, sb = b % 1024, swz = sb ^ (((sb >> 9) & 1) << 5); R = (st >> 1) * 16 + swz / 64; C = (st & 1) * 32 + (swz % 64) / 2; }
__device__ __forceinline__ int perm32(int rho) { const int n = rho >> 4, i = rho & 15; return 8 * (i >> 2) + 4 * n + (i & 3); }

struct Unit { int pm, pn, aux; };
struct Gemm { const bf16* A; const bf16* Bt; int lda, ldb, K; };

struct StaticOrder {
    int nM, nN, nwg, G, c;
    __device__ void init(int M, int N, int G_, int c_) { nM = M / BM; nN = N / BM; nwg = nM * nN; G = G_; c = c_; }
    __device__ bool next(int i, Unit& u) const {
        const long L = (long)i * G + c; if (L >= nwg) return false;
        int wgid = (int)L; { const int q = nwg / NXCD, r = nwg % NXCD, xcd = wgid % NXCD, off = wgid / NXCD; wgid = (xcd < r ? xcd * (q + 1) : r * (q + 1) + (xcd - r) * q) + off; }
        const int nig = WGM * nN, gid = wgid / nig, fm = gid * WGM, gsz = (nM - fm) < WGM ? (nM - fm) : WGM;
        u.pm = fm + ((wgid % nig) % gsz); u.pn = (wgid % nig) / gsz; u.aux = 0; return true;
    }
};

__device__ __forceinline__ unsigned cvt_pk_bf16(float lo, float hi) { unsigned r; asm volatile("v_cvt_pk_bf16_f32 %0, %1, %2" : "=v"(r) : "v"(lo), "v"(hi)); return r; }

template <bool ALIGN = true, bool GATHER = false, class Epi, class Sched>
__device__ __forceinline__ void gemm_phase(LAS unsigned char* lds, const Gemm g, const Sched& S, const Epi& E, int wave_, const int* gidx = nullptr) {
    int lane_ = lane_id(); asm volatile("" : "+v"(lane_)); asm volatile("" : "+s"(wave_));
    const int wid = wave_, lane = lane_, tid = wid * 64 + lane, wr = wid >> 2, wc = wid & 3, fr = lane & 15, fq = lane >> 4;
    const int K = g.K, nt = K / BK;
    unsigned voffA[2], voffA1[2], voffB[2];
#pragma unroll
    for (int i = 0; i < 2; ++i) { int R, C; stage_rc(tid * 16 + i * 8192, R, C); const int Rb = Epi::PERM ? ((R & ~31) + perm32(R & 31)) : R;
        voffA[i] = (unsigned)(R * g.lda + C) * 2u; voffB[i] = (unsigned)(Rb * g.ldb + C) * 2u; voffA1[i] = voffA[i] + (unsigned)(HALF * g.lda * 2); }
    const size_t kstep = (size_t)(BK * 2);
    const size_t hstepA = (size_t)HALF * g.lda * 2, hstepB = (size_t)HALF * g.ldb * 2;
    const size_t tstepA = 2 * hstepA, tstepB = 2 * hstepB;
    const unsigned ldsw = (unsigned)wid * 1024u;
    const int aoff = lds_byte(wr * 64 + fr, fq * 8), boff = lds_byte(wc * 32 + fr, fq * 8);
#define PG8_SA(b, h) (((b) * 2 + (h)) * HTB)
#define PG8_SB(b, h) ((4 + (b) * 2 + (h)) * HTB)
#define PG8_STAGE(bufoff, gbase, voff) do { _Pragma("unroll") for (int _i = 0; _i < 2; ++_i) \
        __builtin_amdgcn_global_load_lds((const unsigned*)((const char*)(gbase) + (voff)[_i]), (LAS unsigned*)(lds + (bufoff) + ldsw + _i * 8192), 16, 0, 0); } while (0)
#define PG8_LDA(dst, b, h) do { _Pragma("unroll") for (int m = 0; m < 4; ++m) _Pragma("unroll") for (int k = 0; k < 2; ++k) dst[m][k] = *(const LAS bf16x8*)(lds + PG8_SA(b, h) + aoff + m * 2048 + k * 1024); } while (0)
#define PG8_LDB(dst, b, h) do { _Pragma("unroll") for (int n = 0; n < 2; ++n) _Pragma("unroll") for (int k = 0; k < 2; ++k) dst[n][k] = *(const LAS bf16x8*)(lds + PG8_SB(b, h) + boff + n * 2048 + k * 1024); } while (0)
#define PG8_MMA(ai, bj, At, Bt) do { __builtin_amdgcn_s_setprio(1); _Pragma("unroll") for (int m = 0; m < 4; ++m) _Pragma("unroll") for (int n = 0; n < 2; ++n) _Pragma("unroll") for (int k = 0; k < 2; ++k) \
        acc[ai][bj][m][n] = __builtin_amdgcn_mfma_f32_16x16x32_bf16(Bt[n][k], At[m][k], acc[ai][bj][m][n], 0, 0, 0); __builtin_amdgcn_s_setprio(0); } while (0)
#define PG8_GLOOK(PM) do { if constexpr (GATHER) { _Pragma("unroll") for (int _i = 0; _i < 2; ++_i) { int R_, C_; stage_rc(tid * 16 + _i * 8192, R_, C_); \
        int t0_ = gidx[(PM) * 256 + R_], t1_ = gidx[(PM) * 256 + HALF + R_]; t0_ = t0_ < 0 ? 0 : t0_; t1_ = t1_ < 0 ? 0 : t1_; \
        voffA[_i] = (unsigned)(t0_ * g.lda + C_) * 2u; voffA1[_i] = (unsigned)(t1_ * g.lda + C_) * 2u; } } } while (0)
#define PG8_WAIT_V(n) asm volatile("s_waitcnt vmcnt(" #n ")" ::: "memory")
#define PG8_WAIT_L(n) asm volatile("s_waitcnt lgkmcnt(" #n ")" ::: "memory")
#define PG8_BAR __builtin_amdgcn_s_barrier()
#define PG8_SCHED __builtin_amdgcn_sched_barrier(0)
    Unit cur, nxt; int ui = 0;
    if (!S.next(0, cur)) return;
    f32x4 acc[2][2][4][2];
#pragma unroll
    for (int a = 0; a < 2; ++a)
#pragma unroll
        for (int b = 0; b < 2; ++b)
#pragma unroll
            for (int m = 0; m < 4; ++m)
#pragma unroll
                for (int n = 0; n < 2; ++n) acc[a][b][m][n] = (f32x4){0.f, 0.f, 0.f, 0.f};
    bf16x8 At[4][2], B0[2][2], B1[2][2];
    const char* cA = (const char*)g.A + (GATHER ? (size_t)0 : (size_t)cur.pm * tstepA); const char* cB = (const char*)g.Bt + (size_t)cur.pn * tstepB;
    PG8_GLOOK(cur.pm);
    PG8_STAGE(PG8_SB(0, 0), cB, voffB); PG8_STAGE(PG8_SB(0, 1), cB + hstepB, voffB); PG8_STAGE(PG8_SA(0, 0), cA, voffA); PG8_STAGE(PG8_SA(0, 1), cA, voffA1);
    if (wr == 1) PG8_BAR;
    PG8_WAIT_V(2); PG8_BAR;
    PG8_STAGE(PG8_SB(1, 0), cB + kstep, voffB); PG8_STAGE(PG8_SA(1, 0), cA + kstep, voffA); PG8_STAGE(PG8_SB(1, 1), cB + hstepB + kstep, voffB);
    PG8_WAIT_V(6); PG8_BAR;
    for (;;) {
        const bool has_next = S.next(ui + 1, nxt);
        const char* nA = has_next ? (const char*)g.A + (GATHER ? (size_t)0 : (size_t)nxt.pm * tstepA) : cA; const char* nB = has_next ? (const char*)g.Bt + (size_t)nxt.pn * tstepB : cB;
        for (int t = 0; t < nt; t += 2) {
            const bool last = (t == nt - 2);
            const char* a1 = cA + (size_t)(t + 1) * kstep;
            const char* a2 = last ? nA : cA + (size_t)(t + 2) * kstep; const char* b2 = last ? nB : cB + (size_t)(t + 2) * kstep;
            const char* a3 = a2 + kstep; const char* b3 = b2 + kstep;
            PG8_LDB(B0, 0, 0); PG8_LDB(B1, 0, 1); PG8_SCHED; PG8_LDA(At, 0, 0); PG8_STAGE(PG8_SA(1, 1), a1, voffA1);
            PG8_WAIT_V(8); PG8_WAIT_L(0); PG8_BAR; PG8_MMA(0, 0, At, B0); PG8_MMA(0, 1, At, B1); PG8_BAR; PG8_SCHED;
            if constexpr (GATHER) { if (last && has_next) PG8_GLOOK(nxt.pm); }
            PG8_LDA(At, 0, 1); PG8_STAGE(PG8_SB(0, 0), b2, voffB); PG8_STAGE(PG8_SB(0, 1), b2 + hstepB, voffB); PG8_STAGE(PG8_SA(0, 0), a2, voffA);
            PG8_WAIT_V(8); PG8_WAIT_L(0); PG8_BAR; PG8_MMA(1, 0, At, B0); PG8_MMA(1, 1, At, B1); PG8_BAR; PG8_SCHED;
            PG8_LDB(B0, 1, 0); PG8_LDB(B1, 1, 1); PG8_SCHED; PG8_LDA(At, 1, 0); PG8_STAGE(PG8_SA(0, 1), a2, voffA1);
            PG8_WAIT_V(8); PG8_WAIT_L(0); PG8_BAR; PG8_MMA(0, 0, At, B0); PG8_MMA(0, 1, At, B1); PG8_BAR; PG8_SCHED;
            PG8_LDA(At, 1, 1); PG8_STAGE(PG8_SB(1, 0), b3, voffB); PG8_STAGE(PG8_SB(1, 1), b3 + hstepB, voffB); PG8_STAGE(PG8_SA(1, 0), a3, voffA);
            PG8_WAIT_V(8); PG8_WAIT_L(0); PG8_BAR; PG8_MMA(1, 0, At, B0); PG8_MMA(1, 1, At, B1); PG8_BAR; PG8_SCHED;
        }
        if constexpr (ALIGN) { if (wr == 0) PG8_BAR; }
        E(acc, cur, wr, wc, fr, fq);
        if (!has_next) break;
#pragma unroll
        for (int a = 0; a < 2; ++a)
#pragma unroll
            for (int b = 0; b < 2; ++b)
#pragma unroll
                for (int m = 0; m < 4; ++m)
#pragma unroll
                    for (int n = 0; n < 2; ++n) acc[a][b][m][n] = (f32x4){0.f, 0.f, 0.f, 0.f};
        cur = nxt; cA = nA; cB = nB; ++ui;
        if constexpr (ALIGN) { if (wr == 1) PG8_BAR; }
    }
    PG8_WAIT_V(0);
    if constexpr (!ALIGN) { if (wr == 0) PG8_BAR; }
    PG8_BAR;
#undef PG8_SA
#undef PG8_SB
#undef PG8_STAGE
#undef PG8_LDA
#undef PG8_LDB
#undef PG8_MMA
#undef PG8_WAIT_V
#undef PG8_WAIT_L
#undef PG8_BAR
#undef PG8_SCHED
}
}


struct EpiProjE {
    static constexpr bool PERM = true;
    bf16 *UG, *PB, *QB, *KB, *VB; float* KMP; const float* rs1;
    __device__ __forceinline__ void operator()(const f32x4 (&acc_)[2][2][4][2], const pg8::Unit& u, int wr, int wc, int fr_, int fq_) const {
        const int ln_ = lane_id(), fr = ln_ & 15, fq = ln_ >> 4; (void)fr_; (void)fq_;
        const int pn = u.pn, row0 = u.pm * 256 + wr * 64 + fr, cl = wc * 32 + 8 * fq;
        f32x4 acc[2][2][4][2];
#pragma unroll
        for (int ai = 0; ai < 2; ++ai)
#pragma unroll
            for (int m = 0; m < 4; ++m) { const float rs = rs1[row0 + ai * 128 + m * 16];
#pragma unroll
                for (int bj = 0; bj < 2; ++bj) { acc[ai][bj][m][0] = acc_[ai][bj][m][0] * rs; acc[ai][bj][m][1] = acc_[ai][bj][m][1] * rs; } }
        if (pn == 0) {
#pragma unroll
            for (int ai = 0; ai < 2; ++ai)
#pragma unroll
                for (int m = 0; m < 4; ++m) { const int r = row0 + ai * 128 + m * 16;
#pragma unroll
                    for (int bj = 0; bj < 2; ++bj) { const int ch = bj * 128 + cl, g = ch >> 4, h0 = ch & 15;
                        const f32x4 v0 = acc[ai][bj][m][0], v1 = acc[ai][bj][m][1]; u32x4 w;
                        w.x = pg8::cvt_pk_bf16(v0[0], v0[1]); w.y = pg8::cvt_pk_bf16(v0[2], v0[3]); w.z = pg8::cvt_pk_bf16(v1[0], v1[1]); w.w = pg8::cvt_pk_bf16(v1[2], v1[3]);
                        *(u32x4*)(UG + ((size_t)(g * 512 + (r >> 6))) * UGP + (r & 63) * 16 + h0) = w; } }
        } else {
            bf16* base; int ldc, colt; float sc = 1.f;
            if (pn == 1) { base = PB; ldc = 256; colt = 0; }
            else if (pn < 4) { base = QB; ldc = 512; colt = (pn - 2) * 256; sc = C2; }
            else if (pn < 6) { base = KB; ldc = 512; colt = (pn - 4) * 256; }
            else { base = VB; ldc = 512; colt = (pn - 6) * 256; }
#pragma unroll
            for (int ai = 0; ai < 2; ++ai)
#pragma unroll
                for (int m = 0; m < 4; ++m) { bf16* rowp = base + (size_t)(row0 + ai * 128 + m * 16) * ldc + colt + cl;
#pragma unroll
                    for (int bj = 0; bj < 2; ++bj) { const f32x4 v0 = acc[ai][bj][m][0] * sc, v1 = acc[ai][bj][m][1] * sc; u32x4 w;
                        w.x = pg8::cvt_pk_bf16(v0[0], v0[1]); w.y = pg8::cvt_pk_bf16(v0[2], v0[3]); w.z = pg8::cvt_pk_bf16(v1[0], v1[1]); w.w = pg8::cvt_pk_bf16(v1[2], v1[3]);
                        *(u32x4*)(rowp + bj * 128) = w; } }
            if (pn >= 4 && pn < 6) {
#pragma unroll
                for (int bj = 0; bj < 2; ++bj)
#pragma unroll
                    for (int n = 0; n < 2; ++n) { f32x4 s = (f32x4){0.f, 0.f, 0.f, 0.f};
#pragma unroll
                        for (int ai = 0; ai < 2; ++ai)
#pragma unroll
                            for (int m = 0; m < 4; ++m) s += acc[ai][bj][m][n];
#pragma unroll
                        for (int i = 0; i < 4; ++i) { float t = s[i]; t += xshfl<1>(t); t += xshfl<2>(t); t += xshfl<4>(t); t += xshfl<8>(t); s[i] = t; }
                        if (fr == 0) *(f32x4*)(KMP + (size_t)wr * 128 * 512 + (size_t)u.pm * 512 + colt + bj * 128 + cl + 4 * n) = s; }
            }
        }
    }
};
struct EpiOutE {
    static constexpr bool PERM = true;
    bf16* RB;
    __device__ __forceinline__ void operator()(const f32x4 (&acc)[2][2][4][2], const pg8::Unit& u, int wr, int wc, int fr_, int fq_) const {
        const int ln_ = lane_id(), fr = ln_ & 15, fq = ln_ >> 4; (void)fr_; (void)fq_;
        const int row0 = u.pm * 256 + wr * 64 + fr, col0 = u.pn * 256 + wc * 32 + 8 * fq;
#pragma unroll
        for (int ai = 0; ai < 2; ++ai) { u32x4 x[4][2];
#pragma unroll
            for (int m = 0; m < 4; ++m) { const bf16* rp = RB + (size_t)(row0 + ai * 128 + m * 16) * D + col0; x[m][0] = *(const u32x4*)rp; x[m][1] = *(const u32x4*)(rp + 128); }
#pragma unroll
            for (int m = 0; m < 4; ++m) { bf16* rp = RB + (size_t)(row0 + ai * 128 + m * 16) * D + col0;
#pragma unroll
                for (int bj = 0; bj < 2; ++bj) { const u32x4 xx = x[m][bj]; const f32x4 a0 = acc[ai][bj][m][0], a1 = acc[ai][bj][m][1]; u32x4 w;
                    w.x = pg8::cvt_pk_bf16(bf2f(xx.x & 0xffffu) + a0[0], bf2f(xx.x >> 16) + a0[1]); w.y = pg8::cvt_pk_bf16(bf2f(xx.y & 0xffffu) + a0[2], bf2f(xx.y >> 16) + a0[3]);
                    w.z = pg8::cvt_pk_bf16(bf2f(xx.z & 0xffffu) + a1[0], bf2f(xx.z >> 16) + a1[1]); w.w = pg8::cvt_pk_bf16(bf2f(xx.w & 0xffffu) + a1[2], bf2f(xx.w >> 16) + a1[3]);
                    *(u32x4*)(rp + bj * 128) = w; } }
            asm volatile("" ::: "memory"); }
    }
};

__device__ __forceinline__ void transpose_item(const float* W, int K, int N, const float* kscale, bf16* WT, int ldo, int koff, int rowmode, LAS float* scr, int item, int lane) {
    const int nblk = N / 32, kb = item / nblk, nb = item % nblk, k0 = 64 * kb, n0 = 32 * nb;
    { const int r8 = lane >> 3, c4 = lane & 7; f32x4 v[8];
#pragma unroll
      for (int i = 0; i < 8; ++i) v[i] = *(const f32x4*)(W + (size_t)(k0 + 8 * i + r8) * N + n0 + 4 * c4);
#pragma unroll
      for (int i = 0; i < 8; ++i) { const int kk = 8 * i + r8; const float s = kscale ? kscale[k0 + kk] : 1.f; LAS float* d = scr + kk * 33 + 4 * c4;
          d[0] = v[i][0] * s; d[1] = v[i][1] * s; d[2] = v[i][2] * s; d[3] = v[i][3] * s; } }
    asm volatile("s_waitcnt lgkmcnt(0)" ::: "memory");
    const int c = lane & 7;
#pragma unroll
    for (int j = 0; j < 4; ++j) { const int n = (lane >> 3) + 8 * j; const LAS float* s = scr + (8 * c) * 33 + n;
        u32x4 o; o.x = pk2(s[0 * 33], s[1 * 33]); o.y = pk2(s[2 * 33], s[3 * 33]); o.z = pk2(s[4 * 33], s[5 * 33]); o.w = pk2(s[6 * 33], s[7 * 33]);
        const int nn = n0 + n, row = rowmode == 0 ? nn : (8 * (nn >> 2) + (nn & 3) + (rowmode == 2 ? 4 : 0));
        *(u32x4*)(WT + (size_t)row * ldo + koff + k0 + 8 * c) = o; }
    asm volatile("s_waitcnt lgkmcnt(0)" ::: "memory");
}
__device__ __forceinline__ void pair_decode(int pi, int& ea, int& eb) { ea = pi < 3 ? 0 : (pi < 5 ? 1 : 2); eb = pi < 3 ? pi + 1 : (pi < 5 ? pi - 1 : 3); }
__device__ __forceinline__ void ph_prologue(const Ctx& F0) {
    const Ctx F = launder(F0);
    LAS float* scr = (LAS float*)(F.lds + F.wave * 16384);
    const int gw = F.vcu * NWAVES + F.wave, NGW = F.G * NWAVES;
    constexpr int I_IN = (D / 64) * (NPROJ / 32), I_OUT = (D / 64) * (D / 32), I_GU1 = (D / 64) * (256 / 32), I_GU = 16 * 2 * I_GU1, I_WD1 = (256 / 64) * (D / 32), I_WD = 24 * 2 * I_WD1;
    constexpr int I_L = I_IN + I_OUT + I_GU + I_WD;
    for (int it = gw; it < DEPTH * I_L; it += NGW) {
        const int l = it / I_L; int r = it % I_L;
        if (r < I_IN) { transpose_item(F.in[3] + (size_t)l * D * NPROJ, D, NPROJ, F.in[2] + l * D, (bf16*)(F.ws + WS_WIN) + (size_t)l * NPROJ * D, D, 0, 0, scr, r, F.lane); continue; } r -= I_IN;
        if (r < I_OUT) { transpose_item(F.in[17] + (size_t)l * D * D, D, D, nullptr, (bf16*)(F.ws + WS_WOUT) + (size_t)l * D * D, D, 0, 0, scr, r, F.lane); continue; } r -= I_OUT;
        if (r < I_GU) { const int e = r / (2 * I_GU1), up = (r / I_GU1) & 1, item = r % I_GU1;
            transpose_item(F.in[up ? 24 : 23] + ((size_t)l * 16 + e) * D * 256, D, 256, F.in[18] + l * D, (bf16*)(F.ws + WS_GU) + ((size_t)l * 16 + e) * 512 * D, D, 0, 1 + up, scr, item, F.lane); continue; } r -= I_GU;
        { const int bk = r / (2 * I_WD1), half = (r / I_WD1) & 1, item = r % I_WD1, g = bk / 6; int ea, eb; pair_decode(bk % 6, ea, eb); const int e = g * 4 + (half ? eb : ea);
            transpose_item(F.in[25] + ((size_t)l * 16 + e) * 256 * D, 256, D, nullptr, (bf16*)(F.ws + WS_WD) + ((size_t)l * 24 + bk) * D * 512, 512, half * 256, 0, scr, item, F.lane); }
    }
    for (int it = gw; it < DEPTH * 32; it += NGW) { const int l = it >> 5;
        transpose_item(F.in[12] + (size_t)l * 256 * 256, 256, 256, nullptr, (bf16*)(F.ws + WS_GLUT) + (size_t)l * 65536, 256, 0, 0, scr, it & 31, F.lane); }
    { const int gt = F.vcu * NTHREADS + F.tid, NGT = F.G * NTHREADS;
      for (int i = gt; i < DEPTH * 65536; i += NGT) { const int l = i >> 16, n = (i >> 8) & 255, k = i & 255;
          const float v = ((n >> 6) == (k >> 6)) ? F.in[14][(((size_t)l * 4 + (n >> 6)) * 64 + (k & 63)) * 64 + (n & 63)] : 0.f;
          ((bf16*)(F.ws + WS_POOLT))[i] = (bf16)f2bf(v); } }
    for (int it = gw; it < DEPTH * SGN * 65; it += NGW) {
        const int l = it / (SGN * 65), g = (it / 65) % SGN, tau = it % 65, p = F.lane;
        const float are = F.in[4][(l * SGN + g) * SP + p], aim = F.in[5][(l * SGN + g) * SP + p], dt = expf(F.in[6][l * SGN + g]);
        float sn, cs; sincosf(aim * dt, &sn, &cs); const float mg = expf(are * dt), lbr = mg * cs, lbi = mg * sn;
        const float nr = lbr - 1.f, ni = lbi, den = are * are + aim * aim, cr = (nr * are + ni * aim) / den, ci = (ni * are - nr * aim) / den;
        float sn2, cs2; sincosf(aim * dt * (float)tau, &sn2, &cs2); const float mg2 = expf(are * dt * (float)tau), lr = mg2 * cs2, li = mg2 * sn2;
        float wr[16], wi[16];
#pragma unroll
        for (int h = 0; h < 16; ++h) { const float br = F.in[7][((size_t)(l * SGN + g) * SP + p) * SG + h], bi = F.in[8][((size_t)(l * SGN + g) * SP + p) * SG + h];
            const float bbr = cr * br - ci * bi, bbi = cr * bi + ci * br; wr[h] = lr * bbr - li * bbi; wi[h] = lr * bbi + li * bbr; }
        bf16* TG = (bf16*)(F.ws + WS_TG) + ((size_t)l * SGN + g) * 1024 * UGP;
        if (tau <= 63) {
            bf16* BZ = (bf16*)(F.ws + WS_BZ) + ((size_t)l * SGN + g) * 256 * 1024; const int s = 63 - tau;
            u32x4 o0, o1, o2, o3;
            o0.x = pk2(wr[0], wr[1]); o0.y = pk2(wr[2], wr[3]); o0.z = pk2(wr[4], wr[5]); o0.w = pk2(wr[6], wr[7]); o1.x = pk2(wr[8], wr[9]); o1.y = pk2(wr[10], wr[11]); o1.z = pk2(wr[12], wr[13]); o1.w = pk2(wr[14], wr[15]);
            o2.x = pk2(wi[0], wi[1]); o2.y = pk2(wi[2], wi[3]); o2.z = pk2(wi[4], wi[5]); o2.w = pk2(wi[6], wi[7]); o3.x = pk2(wi[8], wi[9]); o3.y = pk2(wi[10], wi[11]); o3.z = pk2(wi[12], wi[13]); o3.w = pk2(wi[14], wi[15]);
            *(u32x4*)(BZ + (size_t)p * 1024 + s * 16) = o0; *(u32x4*)(BZ + (size_t)p * 1024 + s * 16 + 8) = o1;
            *(u32x4*)(BZ + (size_t)(64 + p) * 1024 + s * 16) = o2; *(u32x4*)(BZ + (size_t)(64 + p) * 1024 + s * 16 + 8) = o3;
        }
        LAS float* Wst = scr; LAS float* Kt = scr + 128 * 16;
        if (tau <= 63) {
#pragma unroll
            for (int q = 0; q < 4; ++q) { *(LAS f32x4*)(Wst + p * 16 + 4 * q) = (f32x4){wr[4 * q], wr[4 * q + 1], wr[4 * q + 2], wr[4 * q + 3]};
                                          *(LAS f32x4*)(Wst + (64 + p) * 16 + 4 * q) = (f32x4){wi[4 * q], wi[4 * q + 1], wi[4 * q + 2], wi[4 * q + 3]}; }
            const int arow = p & 15, kq = p >> 4; f32x4 kacc = (f32x4){0.f, 0.f, 0.f, 0.f};
            const float* cre = F.in[9] + ((size_t)(l * SGN + g) * SG + arow) * SP; const float* cim = F.in[10] + ((size_t)(l * SGN + g) * SG + arow) * SP;
#pragma unroll 8
            for (int s = 0; s < 32; ++s) { const int k = 4 * s + kq; const float av = (k < 64) ? cre[k] : -cim[k - 64]; const float bv = Wst[k * 16 + arow];
                kacc = __builtin_amdgcn_mfma_f32_16x16x4f32(av, bv, kacc, 0, 0, 0); }
#pragma unroll
            for (int r = 0; r < 4; ++r) Kt[(4 * kq + r) * 16 + arow] = kacc[r];
            asm volatile("s_waitcnt lgkmcnt(0)" ::: "memory");
            const f32x4 t4 = *(const LAS f32x4*)(Kt + 4 * p);
            u32x2 o; o.x = pk2(t4[0], t4[1]); o.y = pk2(t4[2], t4[3]);
            *(u32x2*)((bf16*)(F.ws + WS_KT) + ((size_t)(l * SGN + g) * 64 + tau) * 256 + 4 * p) = o;
        }
        if (tau >= 1) {
#pragma unroll 4
            for (int ho = 0; ho < 16; ++ho) {
                const float ccr = F.in[9][((size_t)(l * SGN + g) * SG + ho) * SP + p], cci = F.in[10][((size_t)(l * SGN + g) * SG + ho) * SP + p];
                const int n = (tau - 1) * 16 + ho;
                TG[(size_t)n * UGP + 1024 + p] = (bf16)f2bf(ccr * lr - cci * li); TG[(size_t)n * UGP + 1088 + p] = (bf16)f2bf(-(ccr * li + cci * lr)); }
        }
    }
}

__device__ __forceinline__ void route_finish(const float (&a)[20], float ssum, int m, bool act, const float* gb_, const float* rb_, int* tokb, float* tokr, float* tokw, LAS int* hist) {
        const float rstd = 1.f / sqrtf(ssum * (1.f / D) + RMS_EPS);
        float lg0 = a[0] * rstd + gb_[0], lg1 = a[1] * rstd + gb_[1], lg2 = a[2] * rstd + gb_[2], lg3 = a[3] * rstd + gb_[3];
        int gs = 0; float gm = lg0;
        if (lg1 > gm) { gm = lg1; gs = 1; } if (lg2 > gm) { gm = lg2; gs = 2; } if (lg3 > gm) { gm = lg3; gs = 3; }
        const float gwt = 1.f / (__expf(lg0 - gm) + __expf(lg1 - gm) + __expf(lg2 - gm) + __expf(lg3 - gm));
        float q0 = a[4], q1 = a[5], q2 = a[6], q3 = a[7], q4 = a[8], q5 = a[9], q6 = a[10], q7 = a[11], q8 = a[12], q9 = a[13], q10 = a[14], q11 = a[15], q12 = a[16], q13 = a[17], q14 = a[18], q15 = a[19];
        asm volatile("" : "+v"(q0), "+v"(q1), "+v"(q2), "+v"(q3), "+v"(q4), "+v"(q5), "+v"(q6), "+v"(q7));
        asm volatile("" : "+v"(q8), "+v"(q9), "+v"(q10), "+v"(q11), "+v"(q12), "+v"(q13), "+v"(q14), "+v"(q15));
        float e0 = gs == 0 ? q0 : gs == 1 ? q4 : gs == 2 ? q8 : q12;
        float e1 = gs == 0 ? q1 : gs == 1 ? q5 : gs == 2 ? q9 : q13;
        float e2 = gs == 0 ? q2 : gs == 1 ? q6 : gs == 2 ? q10 : q14;
        float e3 = gs == 0 ? q3 : gs == 1 ? q7 : gs == 2 ? q11 : q15;
        e0 = e0 * rstd + rb_[gs * 4 + 0]; e1 = e1 * rstd + rb_[gs * 4 + 1]; e2 = e2 * rstd + rb_[gs * 4 + 2]; e3 = e3 * rstd + rb_[gs * 4 + 3];
        int t1 = 0; float v1 = e0;
        if (e1 > v1) { v1 = e1; t1 = 1; } if (e2 > v1) { v1 = e2; t1 = 2; } if (e3 > v1) { v1 = e3; t1 = 3; }
        int t2 = -1; float v2 = -3.0e38f;
        if (t1 != 0 && e0 > v2) { v2 = e0; t2 = 0; } if (t1 != 1 && e1 > v2) { v2 = e1; t2 = 1; } if (t1 != 2 && e2 > v2) { v2 = e2; t2 = 2; } if (t1 != 3 && e3 > v2) { v2 = e3; t2 = 3; }
        const float p2 = __expf(v2 - v1), w1 = gwt / (1.f + p2), w2 = gwt * p2 / (1.f + p2);
        const int lo = t1 < t2 ? t1 : t2, hi = t1 < t2 ? t2 : t1; const float wlo = t1 < t2 ? w1 : w2, whi = t1 < t2 ? w2 : w1;
        const int pi = lo == 0 ? hi - 1 : (lo == 1 ? hi + 1 : 5), bk = gs * 6 + pi;
        if (act) { tokb[m] = bk; tokr[m] = rstd; tokw[2 * m] = wlo; tokw[2 * m + 1] = whi; __hip_atomic_fetch_add(hist + bk, 1, __ATOMIC_RELAXED, __HIP_MEMORY_SCOPE_WORKGROUP); }
}
__device__ __forceinline__ void ph_route(const Ctx& F0, int l) {
    const Ctx F = launder(F0);
    constexpr int WLD = 1032;
    LAS bf16* Wh = (LAS bf16*)F.lds;
    LAS bf16* Wlo = Wh + 20 * WLD;
    LAS float* LG = (LAS float*)(F.lds + 4 * 20 * WLD);
    LAS int* hist = (LAS int*)(F.lds + 4 * 20 * WLD + 8 * 320 * 4);
    const float* g2 = F.in[18] + l * D;
    const f32x4* gw4 = (const f32x4*)(F.in[19] + (size_t)l * D * 4); const f32x4* rw4 = (const f32x4*)(F.in[21] + (size_t)l * 4 * D * 4);
    const float* gb_ = F.in[20] + l * 4; const float* rb_ = F.in[22] + l * 16;
    for (int idx = F.tid; idx < D * 5; idx += NTHREADS) { const int k = idx % D, q = idx / D;
        f32x4 v = (q == 0) ? gw4[k] : rw4[(q - 1) * D + k]; v = v * g2[k];
#pragma unroll
        for (int i = 0; i < 4; ++i) { const unsigned h = f2bf(v[i]); Wh[(q * 4 + i) * WLD + k] = (bf16)h; Wlo[(q * 4 + i) * WLD + k] = (bf16)f2bf(v[i] - bf2f(h)); } }
    if (F.tid < 32) hist[F.tid] = 0;
    __syncthreads();
    int* tokb = (int*)(F.ws + WS_TOKB); float* tokr = (float*)(F.ws + WS_TOKR); float* tokw = (float*)(F.ws + WS_TOKW);
    const int i16 = F.lane & 15, kq = F.lane >> 4, m0 = F.vcu * 128 + F.wave * 16;
    const u32x4* xr = (const u32x4*)(P_XB(F) + (size_t)(m0 + i16) * D) + kq;
    const int c1 = 16 + (i16 & 3);
    const LAS bf16* bh0 = Wh + i16 * WLD + 8 * kq; const LAS bf16* bl0 = Wlo + i16 * WLD + 8 * kq;
    const LAS bf16* bh1 = Wh + c1 * WLD + 8 * kq;  const LAS bf16* bl1 = Wlo + c1 * WLD + 8 * kq;
    f32x4 acc0 = (f32x4){0.f, 0.f, 0.f, 0.f}, acc1 = acc0; float ss = 0.f;
#pragma unroll 4
    for (int c = 0; c < 32; ++c) {
        const u32x4 xa = xr[4 * c];
        const float x0 = bf2f(xa.x & 0xffffu), x1 = __builtin_bit_cast(float, xa.x & 0xffff0000u), x2 = bf2f(xa.y & 0xffffu), x3 = __builtin_bit_cast(float, xa.y & 0xffff0000u);
        const float x4 = bf2f(xa.z & 0xffffu), x5 = __builtin_bit_cast(float, xa.z & 0xffff0000u), x6 = bf2f(xa.w & 0xffffu), x7 = __builtin_bit_cast(float, xa.w & 0xffff0000u);
        ss += ((x0 * x0 + x1 * x1) + (x2 * x2 + x3 * x3)) + ((x4 * x4 + x5 * x5) + (x6 * x6 + x7 * x7));
        const pg8::bf16x8 av = __builtin_bit_cast(pg8::bf16x8, xa);
        const pg8::bf16x8 h0 = *(const LAS pg8::bf16x8*)(bh0 + 32 * c), l0 = *(const LAS pg8::bf16x8*)(bl0 + 32 * c);
        const pg8::bf16x8 h1 = *(const LAS pg8::bf16x8*)(bh1 + 32 * c), l1 = *(const LAS pg8::bf16x8*)(bl1 + 32 * c);
        acc0 = __builtin_amdgcn_mfma_f32_16x16x32_bf16(av, h0, acc0, 0, 0, 0); acc1 = __builtin_amdgcn_mfma_f32_16x16x32_bf16(av, h1, acc1, 0, 0, 0);
        acc0 = __builtin_amdgcn_mfma_f32_16x16x32_bf16(av, l0, acc0, 0, 0, 0); acc1 = __builtin_amdgcn_mfma_f32_16x16x32_bf16(av, l1, acc1, 0, 0, 0);
    }
    ss += xshfl<16>(ss);
    { const unsigned u = __builtin_bit_cast(unsigned, ss); auto r = __builtin_amdgcn_permlane32_swap(u, u, false, false);
      ss = __builtin_bit_cast(float, (unsigned)r[0]) + __builtin_bit_cast(float, (unsigned)r[1]); }
    LAS float* lg = LG + F.wave * 320;
#pragma unroll
    for (int r = 0; r < 4; ++r) { lg[(4 * kq + r) * 20 + i16] = acc0[r]; if (i16 < 4) lg[(4 * kq + r) * 20 + 16 + i16] = acc1[r]; }
    asm volatile("s_waitcnt lgkmcnt(0)" ::: "memory");
    float a[20];
#pragma unroll
    for (int j = 0; j < 5; ++j) { const f32x4 t4 = *(const LAS f32x4*)(lg + i16 * 20 + 4 * j); a[4 * j] = t4[0]; a[4 * j + 1] = t4[1]; a[4 * j + 2] = t4[2]; a[4 * j + 3] = t4[3]; }
    route_finish(a, ss, m0 + i16, kq == 0, gb_, rb_, tokb, tokr, tokw, hist);
    __syncthreads();
    if (F.tid < 24) __hip_atomic_store((int*)(F.ws + WS_WGCNT) + F.vcu * 24 + F.tid, hist[F.tid], __ATOMIC_RELAXED, __HIP_MEMORY_SCOPE_AGENT);
}
__device__ __forceinline__ void ph_place(const Ctx& F0) {
    const Ctx F = launder(F0);
    LAS int* ptot = (LAS int*)F.lds;
    LAS int* pbef = ptot + 512;
    LAS int* bstart = pbef + 512;
    LAS int* btot = bstart + 32;
    LAS int* carry = btot + 32;
    LAS int* rowidx = carry + 32;
    const int* wgcnt = (const int*)(F.ws + WS_WGCNT);
    int* rowtok = (int*)(F.ws + WS_ROWTOK); float* roww = (float*)(F.ws + WS_ROWW); int* tileb = (int*)(F.ws + WS_TILEB);
    const int* tokb = (const int*)(F.ws + WS_TOKB); const float* tokr = (const float*)(F.ws + WS_TOKR); const float* tokw = (const float*)(F.ws + WS_TOKW);
    { const int p = F.tid >> 5, b = F.tid & 31; int tot = 0, bef = 0;
      if (b < 24) for (int v = p * 16; v < p * 16 + 16; ++v) { const int c = wgcnt[v * 24 + b]; tot += c; if (v < F.vcu) bef += c; }
      ptot[p * 32 + b] = tot; pbef[p * 32 + b] = bef; }
    __syncthreads();
    if (F.tid < 32) { int tot = 0, bef = 0; for (int p = 0; p < 16; ++p) { tot += ptot[p * 32 + F.tid]; bef += pbef[p * 32 + F.tid]; } btot[F.tid] = tot; carry[F.tid] = bef; }
    __syncthreads();
    if (F.tid == 0) { int s = 0; for (int b = 0; b < 24; ++b) { bstart[b] = s; s += (btot[b] + 255) & ~255; } bstart[24] = s; }
    __syncthreads();
    if (F.tid < 24) carry[F.tid] += bstart[F.tid];
    if (F.vcu == 0) {
        if (F.tid == 0) tileb[0] = bstart[24] >> 8;
        for (int b = 0; b < 24; ++b) { const int s = bstart[b], e = bstart[b + 1];
            for (int t = (s >> 8) + F.tid; t < (e >> 8); t += NTHREADS) tileb[1 + t] = b;
            for (int r = s + btot[b] + F.tid; r < e; r += NTHREADS) __hip_atomic_store(rowtok + r, -1, __ATOMIC_RELAXED, __HIP_MEMORY_SCOPE_AGENT); }
    }
    __syncthreads();
    if (F.wave == 0) {
        for (int pass = 0; pass < 2; ++pass) { const int i = pass * 64 + F.lane, bi = tokb[F.vcu * 128 + i]; int row = 0;
#pragma unroll 1
            for (int b = 0; b < 24; ++b) { const unsigned long long mask = __ballot(bi == b); const int c = carry[b];
                if (bi == b) row = c + __builtin_popcountll(mask & ((1ull << F.lane) - 1ull));
                asm volatile("s_waitcnt lgkmcnt(0)" ::: "memory");
                if (F.lane == 0) carry[b] = c + __builtin_popcountll(mask);
                asm volatile("s_waitcnt lgkmcnt(0)" ::: "memory"); }
            rowidx[i] = row; }
    }
    __syncthreads();
    if (F.lane < 16) { const int li = F.wave * 16 + F.lane, m = F.vcu * 128 + li, row = rowidx[li];
        const float rstd = tokr[m];
        const unsigned long long w2 = (unsigned long long)__builtin_bit_cast(unsigned, tokw[2 * m]) | ((unsigned long long)__builtin_bit_cast(unsigned, tokw[2 * m + 1]) << 32);
        __hip_atomic_store(rowtok + row, m, __ATOMIC_RELAXED, __HIP_MEMORY_SCOPE_AGENT);
        __hip_atomic_store((unsigned long long*)(roww + 2 * row), w2, __ATOMIC_RELAXED, __HIP_MEMORY_SCOPE_AGENT);
        __hip_atomic_store((float*)(F.ws + WS_ROWR) + row, rstd, __ATOMIC_RELAXED, __HIP_MEMORY_SCOPE_AGENT); }
}
struct MoeOrder {
    int G, c; bool down; int NT, bks;
    __device__ __forceinline__ void init(const int* tileb) {
        const GAS int* tb_ = (const GAS int*)tileb;
        const int nt_ = tb_[0]; int r0 = c >> 2, r1 = (G + c) >> 2, r2 = (2 * G + c) >> 2, r3 = (3 * G + c) >> 2;
        r0 = r0 < MOE_MAXT ? r0 : MOE_MAXT - 1; r1 = r1 < MOE_MAXT ? r1 : MOE_MAXT - 1; r2 = r2 < MOE_MAXT ? r2 : MOE_MAXT - 1; r3 = r3 < MOE_MAXT ? r3 : MOE_MAXT - 1;
        const int b0 = tb_[1 + r0], b1 = tb_[1 + r1], b2 = tb_[1 + r2], b3 = tb_[1 + r3];
        int n_ = __builtin_amdgcn_readfirstlane(nt_), p_ = __builtin_amdgcn_readfirstlane((b0 & 255) | ((b1 & 255) << 8) | ((b2 & 255) << 16) | ((b3 & 255) << 24));
        asm volatile("" : "+s"(n_), "+s"(p_)); NT = n_; bks = p_;
    }
    __device__ __forceinline__ bool next(int i, pg8::Unit& u) const {
        const int L = i * G + c; if (i > 3 || L >= NT * 4) return false;
        const int rt = L >> 2, pn = L & 3, b = (bks >> (8 * i)) & 255;
        if (down) { u.pm = rt; u.pn = b * 4 + pn; u.aux = pn; }
        else { int ea, eb; pair_decode(b % 6, ea, eb); const int e = (b / 6) * 4 + (pn < 2 ? ea : eb); u.pm = rt; u.pn = e * 2 + (pn & 1); u.aux = pn; }
        return true;
    }
};
struct EpiGU {
    static constexpr bool PERM = true;
    bf16* H; const float* roww; const float* rowr;
    __device__ __forceinline__ void operator()(const f32x4 (&acc)[2][2][4][2], const pg8::Unit& u, int wr, int wc, int fr_, int fq_) const {
        const int ln_ = lane_id(), fr = ln_ & 15, fq = ln_ >> 4; (void)fr_; (void)fq_;
        const int row0 = u.pm * 256 + wr * 64 + fr, cl = u.aux * 128 + 16 * wc + 4 * fq, ws = u.aux >> 1;
#pragma unroll
        for (int ai = 0; ai < 2; ++ai)
#pragma unroll
            for (int m = 0; m < 4; ++m) { const int r = row0 + ai * 128 + m * 16; const float rr = rowr[r], w = roww[2 * r + ws] * rr;
#pragma unroll
                for (int bj = 0; bj < 2; ++bj) { const f32x4 g = acc[ai][bj][m][0], up = acc[ai][bj][m][1]; f32x4 a;
#pragma unroll
                    for (int i = 0; i < 4; ++i) { const float gg = g[i] * rr; a[i] = gg * sigmoidf_(gg) * up[i] * w; }
                    u32x2 o; o.x = pg8::cvt_pk_bf16(a[0], a[1]); o.y = pg8::cvt_pk_bf16(a[2], a[3]);
                    *(u32x2*)(H + (size_t)r * 512 + cl + bj * 64) = o; } }
    }
};
struct EpiDown {
    static constexpr bool PERM = true;
    bf16* RB; const int* rowtok;
    __device__ __forceinline__ void operator()(const f32x4 (&acc)[2][2][4][2], const pg8::Unit& u, int wr, int wc, int fr_, int fq_) const {
        const int ln_ = lane_id(), fr = ln_ & 15, fq = ln_ >> 4; (void)fr_; (void)fq_;
        const int row0 = u.pm * 256 + wr * 64 + fr, col0 = u.aux * 256 + wc * 32 + 8 * fq;
        int tok[8];
#pragma unroll
        for (int i = 0; i < 8; ++i) tok[i] = rowtok[row0 + (i >> 2) * 128 + (i & 3) * 16];
#pragma unroll
        for (int ai = 0; ai < 2; ++ai) { u32x4 x[4][2];
#pragma unroll
            for (int m = 0; m < 4; ++m) { const int tk = tok[ai * 4 + m]; const bf16* rp = RB + (size_t)(tk < 0 ? 0 : tk) * D + col0; x[m][0] = *(const u32x4*)rp; x[m][1] = *(const u32x4*)(rp + 128); }
#pragma unroll
            for (int m = 0; m < 4; ++m) { const int tk = tok[ai * 4 + m]; bf16* rp = RB + (size_t)(tk < 0 ? 0 : tk) * D + col0;
#pragma unroll
                for (int bj = 0; bj < 2; ++bj) { const u32x4 xx = x[m][bj]; const f32x4 a0 = acc[ai][bj][m][0], a1 = acc[ai][bj][m][1]; u32x4 w;
                    w.x = pg8::cvt_pk_bf16(bf2f(xx.x & 0xffffu) + a0[0], bf2f(xx.x >> 16) + a0[1]); w.y = pg8::cvt_pk_bf16(bf2f(xx.y & 0xffffu) + a0[2], bf2f(xx.y >> 16) + a0[3]);
                    w.z = pg8::cvt_pk_bf16(bf2f(xx.z & 0xffffu) + a1[0], bf2f(xx.z >> 16) + a1[1]); w.w = pg8::cvt_pk_bf16(bf2f(xx.w & 0xffffu) + a1[2], bf2f(xx.w >> 16) + a1[3]);
                    if (tk >= 0) *(u32x4*)(rp + bj * 128) = w; } }
            asm volatile("" ::: "memory"); }
    }
};

struct SsmOrder { int G, c, mode;
    __device__ __forceinline__ bool next(int i, pg8::Unit& u) const { const int L = i * G + c;
        if (mode == 1) { if (L >= 32) return false; u.pm = L; u.pn = L >> 1; u.aux = 0; return true; }
        if (L >= 128) return false; const int g = L >> 3; u.pm = g * 2 + ((L >> 2) & 1); u.pn = g * 4 + (L & 3); u.aux = L & 3; return true; } };
struct HalfOrder { int L;
    __device__ __forceinline__ bool next(int i, pg8::Unit& u) const { if (i > 0 || L < 0 || L >= 128) return false; u.pm = L; u.pn = 0; u.aux = 0; return true; } };
struct EpiZ { static constexpr bool PERM = false; float* ZB;
    __device__ __forceinline__ void operator()(const f32x4 (&acc)[2][2][4][2], const pg8::Unit& u, int wr, int wc, int fr_, int fq_) const {
        const int ln_ = lane_id(), fr = ln_ & 15, fq = ln_ >> 4; (void)fr_; (void)fq_;
        const int row0 = u.pm * 256 + wr * 64 + fr, col0 = wc * 32 + 4 * fq;
#pragma unroll
        for (int ai = 0; ai < 2; ++ai)
#pragma unroll
            for (int m = 0; m < 4; ++m)
#pragma unroll
                for (int n = 0; n < 2; ++n) *(f32x4*)(ZB + (size_t)(row0 + ai * 128 + m * 16) * 128 + col0 + n * 16) = acc[ai][0][m][n];
    } };
struct EpiSsm2 { static constexpr bool PERM = true; const bf16* UG; bf16* YS; const float* dvec;
    __device__ __forceinline__ void operator()(const f32x4 (&acc)[2][2][4][2], const pg8::Unit& u, int wr, int wc, int fr_, int fq_) const {
        const int ln_ = lane_id(), fr = ln_ & 15, fq = ln_ >> 4; (void)fr_; (void)fq_;
        const int g = u.pm >> 1, cr0 = (u.pm & 1) * 256 + wr * 64 + fr;
#pragma unroll
        for (int bj = 0; bj < 2; ++bj) { const int n0 = u.aux * 256 + bj * 128 + wc * 32 + 8 * fq, to = n0 >> 4, ho0 = n0 & 15;
            const f32x4 d0 = *(const f32x4*)(dvec + g * 16 + ho0), d1 = *(const f32x4*)(dvec + g * 16 + ho0 + 4);
#pragma unroll
            for (int ai = 0; ai < 2; ++ai)
#pragma unroll
                for (int m = 0; m < 4; ++m) { const int cr = cr0 + ai * 128 + m * 16;
                    const u32x4 uu = *(const u32x4*)(UG + ((size_t)(g * 512 + cr)) * UGP + n0);
                    const f32x4 a0 = acc[ai][bj][m][0], a1 = acc[ai][bj][m][1]; float y[8];
                    y[0] = gelu_tanh(a0[0] + d0[0] * bf2f(uu.x & 0xffffu)); y[1] = gelu_tanh(a0[1] + d0[1] * bf2f(uu.x >> 16));
                    y[2] = gelu_tanh(a0[2] + d0[2] * bf2f(uu.y & 0xffffu)); y[3] = gelu_tanh(a0[3] + d0[3] * bf2f(uu.y >> 16));
                    y[4] = gelu_tanh(a1[0] + d1[0] * bf2f(uu.z & 0xffffu)); y[5] = gelu_tanh(a1[1] + d1[1] * bf2f(uu.z >> 16));
                    y[6] = gelu_tanh(a1[2] + d1[2] * bf2f(uu.w & 0xffffu)); y[7] = gelu_tanh(a1[3] + d1[3] * bf2f(uu.w >> 16));
                    u32x4 w; w.x = pg8::cvt_pk_bf16(y[0], y[1]); w.y = pg8::cvt_pk_bf16(y[2], y[3]); w.z = pg8::cvt_pk_bf16(y[4], y[5]); w.w = pg8::cvt_pk_bf16(y[6], y[7]);
                    *(u32x4*)(YS + ((size_t)cr * 64 + to) * 256 + g * 16 + ho0) = w; } }
    } };
struct EpiGluE { static constexpr bool PERM = true; const bf16* YS; bf16* YMIX; const float* gb;
    __device__ __forceinline__ void operator()(const f32x4 (&acc)[2][2][4][2], const pg8::Unit& u, int wr, int wc, int fr_, int fq_) const {
        const int ln_ = lane_id(), fr = ln_ & 15, fq = ln_ >> 4; (void)fr_; (void)fq_;
        const int row0 = u.pm * 256 + wr * 64 + fr;
#pragma unroll
        for (int bj = 0; bj < 2; ++bj) { const int n0 = bj * 128 + wc * 32 + 8 * fq; const f32x4 b0 = *(const f32x4*)(gb + n0), b1 = *(const f32x4*)(gb + n0 + 4);
#pragma unroll
            for (int ai = 0; ai < 2; ++ai)
#pragma unroll
                for (int m = 0; m < 4; ++m) { const size_t r = (size_t)(row0 + ai * 128 + m * 16); const u32x4 yy = *(const u32x4*)(YS + r * 256 + n0);
                    const f32x4 a0 = acc[ai][bj][m][0] + b0, a1 = acc[ai][bj][m][1] + b1; float o[8];
                    o[0] = bf2f(yy.x & 0xffffu) * sigmoidf_(a0[0]); o[1] = bf2f(yy.x >> 16) * sigmoidf_(a0[1]); o[2] = bf2f(yy.y & 0xffffu) * sigmoidf_(a0[2]); o[3] = bf2f(yy.y >> 16) * sigmoidf_(a0[3]);
                    o[4] = bf2f(yy.z & 0xffffu) * sigmoidf_(a1[0]); o[5] = bf2f(yy.z >> 16) * sigmoidf_(a1[1]); o[6] = bf2f(yy.w & 0xffffu) * sigmoidf_(a1[2]); o[7] = bf2f(yy.w >> 16) * sigmoidf_(a1[3]);
                    u32x4 w; w.x = pg8::cvt_pk_bf16(o[0], o[1]); w.y = pg8::cvt_pk_bf16(o[2], o[3]); w.z = pg8::cvt_pk_bf16(o[4], o[5]); w.w = pg8::cvt_pk_bf16(o[6], o[7]);
                    *(u32x4*)(YMIX + r * 1024 + n0) = w; } }
    } };
struct EpiPoolE { static constexpr bool PERM = true; bf16* YMIX; const float* pb; const float* ps;
    __device__ __forceinline__ void operator()(const f32x4 (&acc)[2][2][4][2], const pg8::Unit& u, int wr, int wc, int fr_, int fq_) const {
        const int ln_ = lane_id(), fr = ln_ & 15, fq = ln_ >> 4; (void)fr_; (void)fq_;
        const int row0 = u.pm * 256 + wr * 64 + fr;
#pragma unroll
        for (int bj = 0; bj < 2; ++bj) { const int n0 = bj * 128 + wc * 32 + 8 * fq; const f32x4 b0 = *(const f32x4*)(pb + n0), b1 = *(const f32x4*)(pb + n0 + 4), s0 = *(const f32x4*)(ps + n0), s1 = *(const f32x4*)(ps + n0 + 4);
#pragma unroll
            for (int ai = 0; ai < 2; ++ai)
#pragma unroll
                for (int m = 0; m < 4; ++m) { const size_t r = (size_t)(row0 + ai * 128 + m * 16);
                    const f32x4 a0 = (acc[ai][bj][m][0] + b0) * s0, a1 = (acc[ai][bj][m][1] + b1) * s1;
                    u32x4 w; w.x = pg8::cvt_pk_bf16(a0[0], a0[1]); w.y = pg8::cvt_pk_bf16(a0[2], a0[3]); w.z = pg8::cvt_pk_bf16(a1[0], a1[1]); w.w = pg8::cvt_pk_bf16(a1[2], a1[3]);
                    *(u32x4*)(YMIX + r * 1024 + 256 + n0) = w; } }
    } };
__device__ __forceinline__ void ph_tg_expand(const Ctx& F0, int l, int bx, int w0) {
    const Ctx F = launder(F0);
    if (bx < w0) return;
    const int gw = (bx - w0) * NWAVES + F.wave, NGW = (F.G - w0) * NWAVES;
    const bf16* KT = (const bf16*)(F.ws + WS_KT) + (size_t)l * SGN * 64 * 256;
    bf16* TG0 = (bf16*)(F.ws + WS_TG) + (size_t)l * SGN * 1024 * UGP;
#pragma unroll 2
    for (int r = gw; r < SGN * 1024; r += NGW) { const int g = r >> 10, n = r & 1023, to = n >> 4, ho = n & 15;
        bf16* d = TG0 + ((size_t)g * 1024 + n) * UGP;
#pragma unroll
        for (int half = 0; half < 2; ++half) { const int ti = half * 32 + (F.lane >> 1), tau = to - ti;
            u32x4 v = (u32x4){0u, 0u, 0u, 0u};
            if (tau >= 0) v = *(const u32x4*)(KT + (((size_t)g * 64 + tau) * 16 + ho) * 16 + (F.lane & 1) * 8);
            *(u32x4*)(d + half * 512 + F.lane * 8) = v; } }
}
__device__ __forceinline__ void ph_ssm_scan(const Ctx& F0, int l) {
    const Ctx F = launder(F0);
    if (F.wave != 0 || (F.vcu & 1) != 0 || F.vcu >= 256) return;
    for (int it = (F.vcu >> 2) * 2 + ((F.vcu >> 1) & 1); it < SGN * NB; it += SGN * NB) {
        const int g = it >> 3, b = it & 7, p = F.lane;
        const float are = F.in[4][(l * SGN + g) * SP + p], aim = F.in[5][(l * SGN + g) * SP + p], dt = expf(F.in[6][l * SGN + g]);
        float sn, cs; sincosf(aim * dt * 64.f, &sn, &cs); const float mg = expf(are * dt * 64.f), lr = mg * cs, li = mg * sn;
        const float* Z = (const float*)(F.ws + WS_ZB) + ((size_t)g * 512 + b * 64) * 128;
        bf16* U = P_UG(F) + ((size_t)g * 512 + b * 64) * UGP + 1024;
        float sr = 0.f, si = 0.f;
#pragma unroll 1
        for (int c0 = 0; c0 < 64; c0 += 32) {
            float zr[32], zi[32];
#pragma unroll
            for (int j = 0; j < 32; ++j) { zr[j] = Z[(c0 + j) * 128 + p]; zi[j] = Z[(c0 + j) * 128 + 64 + p]; }
#pragma unroll
            for (int j = 0; j < 32; ++j) {
                U[(size_t)(c0 + j) * UGP + p] = (bf16)f2bf(sr); U[(size_t)(c0 + j) * UGP + 64 + p] = (bf16)f2bf(si);
                const float nr = lr * sr - li * si + zr[j], ni = lr * si + li * sr + zi[j]; sr = nr; si = ni; }
        }
    }
}

namespace moba {
using bf16x8 = __attribute__((ext_vector_type(8))) short;
using s16x4 = __attribute__((ext_vector_type(4))) short;
using f32x16 = __attribute__((ext_vector_type(16))) float;
typedef short v4i16_t __attribute__((ext_vector_type(4)));
typedef float f32x2_t __attribute__((ext_vector_type(2))); typedef __bf16 bf16x2_t __attribute__((ext_vector_type(2)));
constexpr int L_K = 0, L_V = 49152, L_TB = 98304, L_KM = L_TB + 4 * 768 * 4, L_END = L_KM + 16 * 64 * 4;
__device__ __forceinline__ unsigned cvtpk(float lo, float hi) { f32x2_t v = {lo, hi}; bf16x2_t b = __builtin_convertvector(v, bf16x2_t); return __builtin_bit_cast(unsigned, b); }
__device__ __forceinline__ s16x4 vtr(const LAS char* p) { return __builtin_bit_cast(s16x4, __builtin_amdgcn_ds_read_tr16_b64_v4i16((LAS v4i16_t*)p)); }
__device__ __forceinline__ float hmax(float v) { const unsigned u = __builtin_bit_cast(unsigned, v); auto r = __builtin_amdgcn_permlane32_swap(u, u, false, false); return fmaxf(__builtin_bit_cast(float, (unsigned)r[0]), __builtin_bit_cast(float, (unsigned)r[1])); }
__device__ __forceinline__ float hsum(float v) { const unsigned u = __builtin_bit_cast(unsigned, v); auto r = __builtin_amdgcn_permlane32_swap(u, u, false, false); return __builtin_bit_cast(float, (unsigned)r[0]) + __builtin_bit_cast(float, (unsigned)r[1]); }

constexpr int L_LIST = L_END, L_WCNT = 32768;
#define MOBA_CVEC() f32x16 cvec; do { const float ci_ = bfar - mref; _Pragma("unroll") for (int r = 0; r < 16; ++r) cvec[r] = ci_; } while (0)
#define MOBA_QK(P0, P1, KB) do { { const bf16x8 a0 = *(const LAS bf16x8*)(kp0 + (KB)), a1 = *(const LAS bf16x8*)(kp0 + (KB) + 512); \
          P0 = __builtin_amdgcn_mfma_f32_32x32x16_bf16(a0, qr[0], cvec, 0, 0, 0); P1 = __builtin_amdgcn_mfma_f32_32x32x16_bf16(a1, qr[0], cvec, 0, 0, 0); } \
        _Pragma("unroll") for (int d0 = 1; d0 < 4; ++d0) { const bf16x8 a0 = *(const LAS bf16x8*)(kp0 + (KB) + d0 * 2048), a1 = *(const LAS bf16x8*)(kp0 + (KB) + d0 * 2048 + 512); \
            P0 = __builtin_amdgcn_mfma_f32_32x32x16_bf16(a0, qr[d0], P0, 0, 0, 0); P1 = __builtin_amdgcn_mfma_f32_32x32x16_bf16(a1, qr[d0], P1, 0, 0, 0); } } while (0)
#define MOBA_NEARMAX(P0, P1, JN, OUT) do { const int jn_ = (JN); if (jn_ >= 0) { const int A_ = qrel - 64 * (jn_ - 4) - 4 * hi + 256, s_ = 767 - A_, c_ = s_ & 3; \
            const LAS f32x4* t4 = (const LAS f32x4*)(tb + c_ * 768 + (s_ - c_)); \
            _Pragma("unroll") for (int g = 0; g < 4; ++g) { const f32x4 x0 = t4[2 * g], x1 = t4[2 * g + 8]; \
                _Pragma("unroll") for (int j = 0; j < 4; ++j) { P0[4 * g + j] += x0[j]; P1[4 * g + j] += x1[j]; } } } \
        float ra = __builtin_fmaxf(__builtin_fmaxf(P0[0], P0[1]), P1[0]), rb = __builtin_fmaxf(__builtin_fmaxf(P0[2], P0[3]), P1[1]); \
        ra = __builtin_fmaxf(__builtin_fmaxf(ra, P1[2]), P1[3]); \
        _Pragma("unroll") for (int r = 4; r < 16; r += 4) { ra = __builtin_fmaxf(__builtin_fmaxf(ra, P0[r]), P0[r + 1]); rb = __builtin_fmaxf(__builtin_fmaxf(rb, P0[r + 2]), P0[r + 3]); \
            ra = __builtin_fmaxf(__builtin_fmaxf(ra, P1[r]), P1[r + 1]); rb = __builtin_fmaxf(__builtin_fmaxf(rb, P1[r + 2]), P1[r + 3]); } \
        OUT = hmax(__builtin_fmaxf(ra, rb)); } while (0)
#define MOBA_STEP(PC0, PC1, PN0, PN1, JNN, KBN, VBC, HASN) do { \
        bf16x8 vf[8], kf[8]; \
        if (HASN) { _Pragma("unroll") for (int d0 = 0; d0 < 4; ++d0) { kf[2 * d0] = *(const LAS bf16x8*)(kp0 + (KBN) + d0 * 2048); kf[2 * d0 + 1] = *(const LAS bf16x8*)(kp0 + (KBN) + d0 * 2048 + 512); } } \
        __builtin_amdgcn_sched_barrier(0); \
        if (__any(rm > 8.f)) { const float dl = __builtin_fmaxf(rm, 0.f), alpha = __builtin_amdgcn_exp2f(-dl); mref += dl; l *= alpha; \
            _Pragma("unroll") for (int r = 0; r < 16; ++r) { PC0[r] -= dl; PC1[r] -= dl; o0[r] *= alpha; o1[r] *= alpha; } } \
        if (HASN) { MOBA_CVEC(); \
                    PN0 = __builtin_amdgcn_mfma_f32_32x32x16_bf16(kf[0], qr[0], cvec, 0, 0, 0); PN1 = __builtin_amdgcn_mfma_f32_32x32x16_bf16(kf[1], qr[0], cvec, 0, 0, 0); \
                    _Pragma("unroll") for (int d0 = 1; d0 < 4; ++d0) { PN0 = __builtin_amdgcn_mfma_f32_32x32x16_bf16(kf[2 * d0], qr[d0], PN0, 0, 0, 0); PN1 = __builtin_amdgcn_mfma_f32_32x32x16_bf16(kf[2 * d0 + 1], qr[d0], PN1, 0, 0, 0); } } \
        { const LAS char* vp = vp0 + (VBC); \
        _Pragma("unroll") for (int k = 0; k < 4; ++k) { \
            const s16x4 lo0 = vtr(vp + k * 1024), hi0 = vtr(vp + k * 1024 + 512), lo1 = vtr(vp + 4096 + k * 1024), hi1 = vtr(vp + 4096 + k * 1024 + 512); \
            vf[2 * k] = (bf16x8){lo0[0], lo0[1], lo0[2], lo0[3], hi0[0], hi0[1], hi0[2], hi0[3]}; vf[2 * k + 1] = (bf16x8){lo1[0], lo1[1], lo1[2], lo1[3], hi1[0], hi1[1], hi1[2], hi1[3]}; } } \
        __builtin_amdgcn_sched_barrier(0); \
        float s0 = 0.f, s1 = 0.f; u32x4 pw[4]; \
        _Pragma("unroll") for (int r = 0; r < 16; ++r) { PC0[r] = __builtin_amdgcn_exp2f(PC0[r]); PC1[r] = __builtin_amdgcn_exp2f(PC1[r]); s0 += PC0[r]; s1 += PC1[r]; } \
        l += s0 + s1; \
        _Pragma("unroll") for (int q = 0; q < 4; ++q) { pw[0][q] = cvtpk(PC0[2 * q], PC0[2 * q + 1]); pw[1][q] = cvtpk(PC0[8 + 2 * q], PC0[9 + 2 * q]); pw[2][q] = cvtpk(PC1[2 * q], PC1[2 * q + 1]); pw[3][q] = cvtpk(PC1[8 + 2 * q], PC1[9 + 2 * q]); } \
        _Pragma("unroll") for (int k = 0; k < 4; ++k) { const bf16x8 pa = __builtin_bit_cast(bf16x8, pw[k]); \
            o0 = __builtin_amdgcn_mfma_f32_32x32x16_bf16(vf[2 * k], pa, o0, 0, 0, 0); o1 = __builtin_amdgcn_mfma_f32_32x32x16_bf16(vf[2 * k + 1], pa, o1, 0, 0, 0); } \
        if (HASN) MOBA_NEARMAX(PN0, PN1, JNN, rm); \
    } while (0)
#define MOBA_BLOCK4(JN0, PRE4) \
    float mref = 0.f, l = 0.f; f32x16 o0 = f32x16{}, o1 = f32x16{}; f32x16 pa0, pa1, pb0, pb1; float rm; \
    { const int jn0_ = (JN0); \
      { MOBA_CVEC(); MOBA_QK(pa0, pa1, 0); } MOBA_NEARMAX(pa0, pa1, jn0_, rm); \
      MOBA_STEP(pa0, pa1, pb0, pb1, (jn0_ < 0 ? -1 : jn0_ + 1), 8192, 0, true); \
      MOBA_STEP(pb0, pb1, pa0, pa1, (jn0_ < 0 ? -1 : jn0_ + 2), 16384, 8192, true); \
      MOBA_STEP(pa0, pa1, pb0, pb1, (jn0_ < 0 ? -1 : jn0_ + 3), 24576, 16384, true); \
      PRE4; \
      MOBA_STEP(pb0, pb1, pa0, pa1, -1, 0, 24576, false); }
__device__ __forceinline__ void load_block(const bf16* K, const bf16* V, size_t row0, int h, int wid, int lane, LAS char* lds) {
    const bf16* ksrc = K + (row0 + lane) * 512 + h * 64 + wid * 8;
    const bf16* vsrc = V + (row0 + 16 * (wid & 3) + (lane >> 2)) * 512 + h * 64 + (wid >> 2) * 32 + (lane & 3) * 8;
    u32x4 kr[4], vr[4];
#pragma unroll
    for (int t = 0; t < 4; ++t) { kr[t] = *(const u32x4*)(ksrc + (size_t)t * 64 * 512); vr[t] = *(const u32x4*)(vsrc + (size_t)t * 64 * 512); }
    LAS char* kd = lds + L_K + wid * 1024 + lane * 16; LAS char* vd = lds + L_V + wid * 1024 + lane * 16;
#pragma unroll
    for (int t = 0; t < 4; ++t) { *(LAS u32x4*)(kd + t * 8192) = kr[t]; *(LAS u32x4*)(vd + t * 8192) = vr[t]; }
}
__device__ __forceinline__ void fill_bias_table(const float* BT, int h, int tid, LAS float* tb) {
    const float bfar = BT[h * 132 + 128];
    for (int i = tid; i < 4 * 768; i += NTHREADS) { const int c = i / 768, j = i % 768, src_ = 767 - (j + c), rel = src_ - 256; tb[i] = (src_ < 0 || rel < 0) ? -1.0e30f : (rel < 128 ? BT[h * 132 + rel] - bfar : 0.f); }
}
__device__ __forceinline__ void sel_phase(int wave_, int vcu, int G, const bf16* Q, const float* KMP, unsigned* SEL, LAS char* lds) {
    const int w0 = G > 64 ? 32 : 0, nw = G - w0; if (vcu < w0) return;
    int lane_ = lane_id(); asm volatile("" : "+v"(lane_)); asm volatile("" : "+s"(wave_));
    const int wid = wave_, lane = lane_, tid = wid * 64 + lane, r32 = lane & 31, hi = lane >> 5;
    const int ub = ((vcu - w0) * 1024) / nw, ue = ((vcu - w0 + 1) * 1024) / nw;
    LAS float* km = (LAS float*)(lds + L_KM);
    int bhc = -1;
#pragma unroll 1
    for (int u = ub; u < ue; ++u) {
        const int bh = u >> 4, qb = u & 15, b = bh >> 3, h = bh & 7;
        if (bh != bhc) { bhc = bh;
            __syncthreads();
            for (int i = tid; i < 16 * 64; i += NTHREADS) { const int j = i >> 6, d = i & 63, pm = b * 16 + j; km[i] = KMP[pm * 512 + h * 64 + d] + KMP[128 * 512 + pm * 512 + h * 64 + d]; }
            __syncthreads(); }
        asm volatile("" ::: "memory");
        const int q = qb * 256 + wid * 32 + r32;
        const bf16* qw = Q + ((size_t)b * SEQ + q) * 512 + h * 64 + hi * 8;
        bf16x8 qr[4];
#pragma unroll
        for (int d0 = 0; d0 < 4; ++d0) qr[d0] = *(const bf16x8*)(qw + d0 * 16);
        float g[16];
#pragma unroll
        for (int j = 0; j < 16; ++j) g[j] = 0.f;
#pragma unroll
        for (int d0 = 0; d0 < 4; ++d0)
#pragma unroll
            for (int j = 0; j < 16; ++j) { const f32x4 ka = *(const LAS f32x4*)(km + j * 64 + d0 * 16 + hi * 8), kb4 = *(const LAS f32x4*)(km + j * 64 + d0 * 16 + hi * 8 + 4);
#pragma unroll
                for (int e = 0; e < 4; ++e) { g[j] += bf2f((unsigned)(unsigned short)qr[d0][e]) * ka[e]; }
#pragma unroll
                for (int e = 0; e < 4; ++e) { g[j] += bf2f((unsigned)(unsigned short)qr[d0][4 + e]) * kb4[e]; } }
#pragma unroll
        for (int j = 0; j < 16; ++j) g[j] = hsum(g[j]);
        unsigned selmask = 0u;
#pragma unroll
        for (int s3 = 0; s3 < 3; ++s3) { float bv = -3.0e38f; int bi = -1;
#pragma unroll
            for (int j = 0; j < 16; ++j) { const bool ok = (j < qb) && !((selmask >> j) & 1u) && (g[j] > bv); bv = ok ? g[j] : bv; bi = ok ? j : bi; }
            if (bi >= 0) selmask |= 1u << bi; }
        if (hi == 0) SEL[(size_t)bh * SEQ + q] = selmask;
    }
}
__device__ __forceinline__ bf16* pslot(int slot, size_t t, int h, bf16* YM, bf16* P2A, bf16* P2B) {
    return slot == 0 ? YM + t * 1024 + h * 64 : slot == 1 ? YM + t * 1024 + 512 + h * 64 : (t < (size_t)(T / 2) ? P2A + t * 512 : P2B + (t - (size_t)(T / 2)) * 512) + h * 64;
}
__device__ __forceinline__ void gather_phase(int wave_, int vcu, const bf16* Q, const bf16* K, const bf16* V, bf16* YM, bf16* P2A, bf16* P2B, float* ML, const unsigned* SEL, const float* BT, LAS char* lds) {
    if (vcu >= 256) return;
    int lane_ = lane_id(); asm volatile("" : "+v"(lane_)); asm volatile("" : "+s"(wave_));
    const int wid = wave_, lane = lane_, tid = wid * 64 + lane, r32 = lane & 31, hi = lane >> 5;
    const int bh = vcu >> 2, s = vcu & 3, b = bh >> 3, h = bh & 7;
    const size_t rowbase = (size_t)b * SEQ;
    LAS float* tb = (LAS float*)(lds + L_TB); LAS int* list = (LAS int*)(lds + L_LIST); LAS int* wcnt = (LAS int*)(lds + L_WCNT);
    const float bfar = BT[h * 132 + 128];
    fill_bias_table(BT, h, tid, tb);
    const unsigned* selrow = SEL + (size_t)bh * SEQ;
    const LAS char* kp0 = lds + L_K + hi * 1024 + r32 * 16;
    const LAS char* vp0 = lds + L_V + ((lane >> 4) & 1) * 32 + (lane & 3) * 8 + (4 * hi + ((lane & 15) >> 2)) * 64;
    const unsigned code = s == 0 ? 0xFFFA70u : s == 1 ? 0xFFE961u : s == 2 ? 0xFFFB32u : 0xFDC854u;
    u32x4 kr[4], vr[4]; unsigned msel[8];
#define MOBA_GFETCH(KB) do { const size_t row0 = rowbase + (size_t)(KB) * 256; int lg_ = lane_id(); asm volatile("" : "+v"(lg_));     \
        const bf16* ksrc = K + (row0 + lg_) * 512 + h * 64 + wid * 8; \
        const bf16* vsrc = V + (row0 + 16 * (wid & 3) + (lg_ >> 2)) * 512 + h * 64 + (wid >> 2) * 32 + (lg_ & 3) * 8; \
        _Pragma("unroll") for (int t = 0; t < 4; ++t) { kr[t] = *(const u32x4*)(ksrc + (size_t)t * 64 * 512); vr[t] = *(const u32x4*)(vsrc + (size_t)t * 64 * 512); } \
        const int qs_ = ((KB) + 1) * 256, R_ = (SEQ - qs_) >> 3; \
        _Pragma("unroll") for (int i = 0; i < 8; ++i) { const int off = i * 64 + lg_; msel[i] = off < R_ ? selrow[qs_ + wid * R_ + off] : 0u; } } while (0)
    MOBA_GFETCH((int)(code & 15u));
#pragma unroll 1
    for (int ik = 0; ik < 6; ++ik) {
        const int kb = (int)((code >> (4 * ik)) & 15u); if (kb == 15) break;
        const int kbn = (int)((code >> (4 * ik + 4)) & 15u);
        __syncthreads();
        { LAS char* kd = lds + L_K + wid * 1024 + lane * 16; LAS char* vd = lds + L_V + wid * 1024 + lane * 16;
#pragma unroll
          for (int t = 0; t < 4; ++t) { *(LAS u32x4*)(kd + t * 8192) = kr[t]; *(LAS u32x4*)(vd + t * 8192) = vr[t]; } }
        const int qs = (kb + 1) * 256, R = (SEQ - qs) >> 3;
        unsigned long long bal[8]; int cnt = 0;
#pragma unroll
        for (int i = 0; i < 8; ++i) { bal[i] = __ballot((msel[i] >> kb) & 1u); cnt += __builtin_popcountll(bal[i]); }
        if (lane == 0) wcnt[wid] = cnt;
        __syncthreads();
        int base = 0, n = 0;
#pragma unroll
        for (int w = 0; w < 8; ++w) { const int c = wcnt[w]; n += c; base += (w < wid) ? c : 0; }
#pragma unroll
        for (int i = 0; i < 8; ++i) { const unsigned long long m = bal[i];
            if ((m >> lane) & 1ull) list[base + __builtin_popcountll(m & ((1ull << lane) - 1ull))] = qs + wid * R + i * 64 + lane;
            base += __builtin_popcountll(m); }
        __syncthreads();
        const int ntask = (n + 31) >> 5;
        int tk = wid, qin = 0; bool vn = false; unsigned smn = 0u; bf16x8 qn[4];
#define MOBA_QFETCH() do { const int li_ = tk * 32 + r32; vn = li_ < n; { const int lv_ = list[vn ? li_ : (n > 0 ? n - 1 : 0)]; qin = n > 0 ? lv_ : qs; } smn = selrow[qin]; \
            const bf16* qw = Q + (rowbase + qin) * 512 + h * 64 + hi * 8; \
            _Pragma("unroll") for (int d0 = 0; d0 < 4; ++d0) qn[d0] = *(const bf16x8*)(qw + d0 * 16); } while (0)
        MOBA_QFETCH();
#pragma unroll 1
        while (tk < ntask) {
            const int qi = qin; const bool valid = vn; const unsigned sm = smn;
            bf16x8 qr[4];
#pragma unroll
            for (int d0 = 0; d0 < 4; ++d0) qr[d0] = qn[d0];
            tk += 8;
            const int slot = __builtin_popcount(sm & ((1u << kb) - 1u));
            const int qd = qi - qs, qrel = qd < 255 ? qd : 255;
            const bool nearw = __any(qd < 128);
            MOBA_BLOCK4(nearw ? 0 : -1, MOBA_QFETCH())
            const float lt = hsum(l), inv = 1.f / lt; const size_t t = rowbase + qi;
            bf16* orow = pslot(slot, t, h, YM, P2A, P2B) + 8 * hi;
#pragma unroll
            for (int d0 = 0; d0 < 2; ++d0)
#pragma unroll
                for (int gp = 0; gp < 2; ++gp) { const f32x16& oo = d0 ? o1 : o0; const int ga = 8 * gp, gb = 8 * gp + 4;
                    unsigned ax = cvtpk(oo[ga] * inv, oo[ga + 1] * inv), ay = cvtpk(oo[ga + 2] * inv, oo[ga + 3] * inv), bx = cvtpk(oo[gb] * inv, oo[gb + 1] * inv), by = cvtpk(oo[gb + 2] * inv, oo[gb + 3] * inv);
                    { auto r = __builtin_amdgcn_permlane32_swap(ax, bx, false, false); ax = r[0]; bx = r[1]; }
                    { auto r = __builtin_amdgcn_permlane32_swap(ay, by, false, false); ay = r[0]; by = r[1]; }
                    if (valid) *(u32x4*)(orow + 32 * d0 + 16 * gp) = (u32x4){ax, ay, bx, by}; }
            if (valid && hi == 0) { float* ml = ML + ((t * 8 + h) * 3 + slot) * 2; ml[0] = mref; ml[1] = lt; }
        }
#undef MOBA_QFETCH
        MOBA_GFETCH(kbn);
    }
#undef MOBA_GFETCH
}
__device__ __forceinline__ void diag_unit(int wid, int lane, int b, int h, int qb, const bf16* Q, const bf16* K, const bf16* V, bf16* YM, const bf16* P2A, const bf16* P2B, const float* ML, float bfar, LAS char* lds) {
    const int r32 = lane & 31, hi = lane >> 5; const size_t rowbase = (size_t)b * SEQ;
    LAS float* tb = (LAS float*)(lds + L_TB);
    const LAS char* kp0 = lds + L_K + hi * 1024 + r32 * 16;
    const LAS char* vp0 = lds + L_V + ((lane >> 4) & 1) * 32 + (lane & 3) * 8 + (4 * hi + ((lane & 15) >> 2)) * 64;
    __syncthreads();
    load_block(K, V, rowbase + (size_t)qb * 256, h, wid, lane, lds);
    const int qrel = wid * 32 + r32; const size_t t = rowbase + qb * 256 + qrel;
    bf16x8 qr[4];
    { const bf16* qw = Q + t * 512 + h * 64 + hi * 8;
#pragma unroll
      for (int d0 = 0; d0 < 4; ++d0) qr[d0] = *(const bf16x8*)(qw + d0 * 16); }
    __syncthreads();
    MOBA_BLOCK4(4, (void)0)
    const int nsl = qb < 3 ? qb : 3;
    const float* ml = ML + (t * 8 + h) * 6;
    const bf16* pA = YM + t * 1024 + h * 64 + 8 * hi; const bf16* pB = YM + t * 1024 + 512 + h * 64 + 8 * hi;
    const bf16* pC = (t < (size_t)(T / 2) ? P2A + t * 512 : P2B + (t - (size_t)(T / 2)) * 512) + h * 64 + 8 * hi;
    float m0 = -3.0e38f, m1 = -3.0e38f, m2 = -3.0e38f, l0 = 0.f, l1 = 0.f, l2 = 0.f;
    u32x4 xA[4], xB[4], xC[4];
#pragma unroll
    for (int c = 0; c < 4; ++c) { xA[c] = (u32x4){0u, 0u, 0u, 0u}; xB[c] = xA[c]; xC[c] = xA[c]; }
    if (nsl > 0) { m0 = ml[0]; l0 = ml[1];
#pragma unroll
        for (int c = 0; c < 4; ++c) xA[c] = *(const u32x4*)(pA + 16 * c); }
    if (nsl > 1) { m1 = ml[2]; l1 = ml[3];
#pragma unroll
        for (int c = 0; c < 4; ++c) xB[c] = *(const u32x4*)(pB + 16 * c); }
    if (nsl > 2) { m2 = ml[4]; l2 = ml[5];
#pragma unroll
        for (int c = 0; c < 4; ++c) xC[c] = *(const u32x4*)(pC + 16 * c); }
    const float M = __builtin_fmaxf(__builtin_fmaxf(mref, m0), __builtin_fmaxf(m1, m2));
    const float w0 = __builtin_amdgcn_exp2f(mref - M), wa = l0 * __builtin_amdgcn_exp2f(m0 - M), wb = l1 * __builtin_amdgcn_exp2f(m1 - M), wc = l2 * __builtin_amdgcn_exp2f(m2 - M);
    const float inv = 1.f / (hsum(l) * w0 + wa + wb + wc);
    const float s0 = w0 * inv, sa = wa * inv, sb = wb * inv, sc = wc * inv;
    bf16* orow = YM + t * 1024 + 512 + h * 64 + 8 * hi;
#pragma unroll
    for (int d0 = 0; d0 < 2; ++d0)
#pragma unroll
        for (int gp = 0; gp < 2; ++gp) { const f32x16& oo = d0 ? o1 : o0; const int ga = 8 * gp, gb = 8 * gp + 4, dof = 32 * d0 + 16 * gp, cc = 2 * d0 + gp;
            float a0 = oo[ga] * s0, a1 = oo[ga + 1] * s0, a2 = oo[ga + 2] * s0, a3 = oo[ga + 3] * s0, b0 = oo[gb] * s0, b1 = oo[gb + 1] * s0, b2 = oo[gb + 2] * s0, b3 = oo[gb + 3] * s0;
#define MOBA_ACC(X, W) { unsigned fx = X[cc].x, fy = X[cc].y, sx = X[cc].z, sy = X[cc].w; \
              { auto r = __builtin_amdgcn_permlane32_swap(fx, sx, false, false); fx = r[0]; sx = r[1]; } { auto r = __builtin_amdgcn_permlane32_swap(fy, sy, false, false); fy = r[0]; sy = r[1]; } \
              a0 += (W) * bf2f(fx & 0xffffu); a1 += (W) * __builtin_bit_cast(float, fx & 0xffff0000u); a2 += (W) * bf2f(fy & 0xffffu); a3 += (W) * __builtin_bit_cast(float, fy & 0xffff0000u); \
              b0 += (W) * bf2f(sx & 0xffffu); b1 += (W) * __builtin_bit_cast(float, sx & 0xffff0000u); b2 += (W) * bf2f(sy & 0xffffu); b3 += (W) * __builtin_bit_cast(float, sy & 0xffff0000u); }
            MOBA_ACC(xA, sa) MOBA_ACC(xB, sb) MOBA_ACC(xC, sc)
#undef MOBA_ACC
            unsigned ax = cvtpk(a0, a1), ay = cvtpk(a2, a3), bx = cvtpk(b0, b1), by = cvtpk(b2, b3);
            { auto r = __builtin_amdgcn_permlane32_swap(ax, bx, false, false); ax = r[0]; bx = r[1]; }
            { auto r = __builtin_amdgcn_permlane32_swap(ay, by, false, false); ay = r[0]; by = r[1]; }
            *(u32x4*)(orow + dof) = (u32x4){ax, ay, bx, by}; }
}
__device__ __forceinline__ void diag_phase(int wave_, int ubeg, int uend, const bf16* Q, const bf16* K, const bf16* V, bf16* YM, const bf16* P2A, const bf16* P2B, const float* ML, const float* BT, LAS char* lds) {
    int lane_ = lane_id(); asm volatile("" : "+v"(lane_)); asm volatile("" : "+s"(wave_));
    int hc = -1; float bfar = 0.f;
#pragma unroll 1
    for (int u = ubeg; u < uend; ++u) {
        const int bh = u >> 4, qb = u & 15, h = bh & 7;
        if (h != hc) { hc = h; __syncthreads(); fill_bias_table(BT, h, wave_ * 64 + lane_, (LAS float*)(lds + L_TB)); bfar = BT[h * 132 + 128]; }
        diag_unit(wave_, lane_, bh >> 3, h, qb, Q, K, V, YM, P2A, P2B, ML, bfar, lds); }
}
#undef MOBA_CVEC
#undef MOBA_QK
#undef MOBA_NEARMAX
#undef MOBA_STEP
#undef MOBA_BLOCK4
}

__device__ __forceinline__ void ph_cvt_x(const Ctx& F0) {
    const Ctx F = launder(F0);
    const int gw = F.vcu * NWAVES + F.wave, NGW = F.G * NWAVES; float* rs1 = (float*)(F.ws + WS_RS1);
    for (int m = gw; m < T; m += 2 * NGW) {
        f32x4 v[2][4];
#pragma unroll
        for (int r = 0; r < 2; ++r) { const int mr = m + r * NGW < T ? m + r * NGW : T - 1; const f32x4* xr = (const f32x4*)(F.in[0] + (size_t)mr * D) + F.lane;
#pragma unroll
            for (int j = 0; j < 4; ++j) v[r][j] = xr[64 * j]; }
#pragma unroll
        for (int r = 0; r < 2; ++r) { float s = 0.f;
#pragma unroll
            for (int j = 0; j < 4; ++j) s += (v[r][j].x * v[r][j].x + v[r][j].y * v[r][j].y) + (v[r][j].z * v[r][j].z + v[r][j].w * v[r][j].w);
            const float rstd = 1.f / sqrtf(wave_sum(s) * (1.f / D) + RMS_EPS);
            if (m + r * NGW >= T) continue;
            if (F.lane == 0) rs1[m + r * NGW] = rstd;
            unsigned long long* o8 = (unsigned long long*)(P_XB(F) + (size_t)(m + r * NGW) * D) + F.lane;
#pragma unroll
            for (int j = 0; j < 4; ++j) o8[64 * j] = (unsigned long long)pk2(v[r][j].x, v[r][j].y) | ((unsigned long long)pk2(v[r][j].z, v[r][j].w) << 32); }
    }
}
__device__ __forceinline__ float row_ssq_bf16(const bf16* row, int lane) {
    const u32x4* xr = (const u32x4*)row + lane; float s = 0.f;
#pragma unroll
    for (int j = 0; j < 2; ++j) { const u32x4 x = xr[64 * j];
        const float a0 = bf2f(x.x & 0xffffu), a1 = bf2f(x.x >> 16), a2 = bf2f(x.y & 0xffffu), a3 = bf2f(x.y >> 16), a4 = bf2f(x.z & 0xffffu), a5 = bf2f(x.z >> 16), a6 = bf2f(x.w & 0xffffu), a7 = bf2f(x.w >> 16);
        s += ((a0 * a0 + a1 * a1) + (a2 * a2 + a3 * a3)) + ((a4 * a4 + a5 * a5) + (a6 * a6 + a7 * a7)); }
    return wave_sum(s);
}
__device__ __forceinline__ void ph_rstd(const Ctx& F0) {
    const Ctx F = launder(F0);
    const int gw = F.vcu * NWAVES + F.wave, NGW = F.G * NWAVES; float* rs1 = (float*)(F.ws + WS_RS1);
    for (int m = gw; m < T; m += 4 * NGW) {
        u32x4 x[4][2];
#pragma unroll
        for (int r = 0; r < 4; ++r) { const int mr = m + r * NGW < T ? m + r * NGW : T - 1; const u32x4* xr = (const u32x4*)(P_XB(F) + (size_t)mr * D) + F.lane; x[r][0] = xr[0]; x[r][1] = xr[64]; }
#pragma unroll
        for (int r = 0; r < 4; ++r) { float s = 0.f;
#pragma unroll
            for (int j = 0; j < 2; ++j) { const u32x4 q = x[r][j];
                const float a0 = bf2f(q.x & 0xffffu), a1 = bf2f(q.x >> 16), a2 = bf2f(q.y & 0xffffu), a3 = bf2f(q.y >> 16), a4 = bf2f(q.z & 0xffffu), a5 = bf2f(q.z >> 16), a6 = bf2f(q.w & 0xffffu), a7 = bf2f(q.w >> 16);
                s += ((a0 * a0 + a1 * a1) + (a2 * a2 + a3 * a3)) + ((a4 * a4 + a5 * a5) + (a6 * a6 + a7 * a7)); }
            s = wave_sum(s); if (F.lane == 0 && m + r * NGW < T) rs1[m + r * NGW] = 1.f / sqrtf(s * (1.f / D) + RMS_EPS); } }
}

__device__ __forceinline__ void ph_bias_table(const Ctx& F0) {
    const Ctx F = launder(F0);
    if (F.vcu == 0) {
        const float* rel_bias = F.in[1];
        for (int i = F.tid; i < 8 * 132; i += NTHREADS) {
            const int h = i / 132, r = i % 132;
            int bk;
            if (r < 16) bk = r;
            else { bk = 16 + (int)(logf((float)r / 16.f) / logf(8.f) * 16.f); if (bk > 31) bk = 31; }
            P_BT(F)[i] = rel_bias[bk * 8 + h] * LOG2E;
        }
    }
}

__device__ __forceinline__ void ph_pool_dl(const Ctx& F0) {
    const Ctx F = launder(F0);
    const int gt = F.vcu * NTHREADS + F.tid, NGT = F.G * NTHREADS;
    for (int it = gt; it < (T / 32) * 128; it += NGT) {
        const int cp = it & 127, chunk = it >> 7, c = cp * 2, gi = c >> 6, win = 2 << gi, m0 = chunk * 32, t0 = m0 & (SEQ - 1);
        const unsigned* __restrict__ P2 = (const unsigned*)P_PB(F) + cp; unsigned* __restrict__ D2 = (unsigned*)P_DL(F) + cp;
        float s0 = 0.f, s1 = 0.f;
        const int back = (t0 < win) ? t0 : win;
        for (int j = 1; j <= back; ++j) { const unsigned v = P2[(size_t)(m0 - j) * 128]; s0 += bf2f(v & 0xffffu); s1 += bf2f(v >> 16); }
#pragma unroll 4
        for (int i = 0; i < 32; ++i) { const int m = m0 + i, t = t0 + i;
            const unsigned v = P2[(size_t)m * 128]; const float p0 = bf2f(v & 0xffffu), p1 = bf2f(v >> 16);
            s0 += p0; s1 += p1;
            if (t >= win) { const unsigned o = P2[(size_t)(m - win) * 128]; s0 -= bf2f(o & 0xffffu); s1 -= bf2f(o >> 16); }
            const float inv = 1.f / (float)((t + 1 < win) ? t + 1 : win);
            D2[(size_t)m * 128] = pk2(s0 * inv - p0, s1 * inv - p1); }
    }
}
__device__ __forceinline__ void ph_final(const Ctx& F0) {
    const Ctx F = launder(F0);
    const int gw = F.vcu * NWAVES + F.wave, NGW = F.G * NWAVES;
    const f32x4* gf = (const f32x4*)F.in[26];
    for (int m = gw; m < T; m += 2 * NGW) {
        u32x4 x[2][2];
#pragma unroll
        for (int r = 0; r < 2; ++r) { const int mr = m + r * NGW < T ? m + r * NGW : T - 1; const u32x4* xr = (const u32x4*)(P_XB(F) + (size_t)mr * D) + F.lane; x[r][0] = xr[0]; x[r][1] = xr[64]; }
#pragma unroll
        for (int r = 0; r < 2; ++r) { float s = 0.f;
#pragma unroll
            for (int j = 0; j < 2; ++j) { const u32x4 q = x[r][j];
                const float a0 = bf2f(q.x & 0xffffu), a1 = bf2f(q.x >> 16), a2 = bf2f(q.y & 0xffffu), a3 = bf2f(q.y >> 16), a4 = bf2f(q.z & 0xffffu), a5 = bf2f(q.z >> 16), a6 = bf2f(q.w & 0xffffu), a7 = bf2f(q.w >> 16);
                s += ((a0 * a0 + a1 * a1) + (a2 * a2 + a3 * a3)) + ((a4 * a4 + a5 * a5) + (a6 * a6 + a7 * a7)); }
            const float rstd = 1.f / sqrtf(wave_sum(s) * (1.f / D) + RMS_EPS);
            if (m + r * NGW >= T) continue;
            f32x4* orow = (f32x4*)(F.R + (size_t)(m + r * NGW) * D);
#pragma unroll
            for (int j = 0; j < 2; ++j) { const u32x4 q = x[r][j]; const int c4 = 2 * (64 * j + F.lane);
                orow[c4] = (f32x4){bf2f(q.x & 0xffffu), bf2f(q.x >> 16), bf2f(q.y & 0xffffu), bf2f(q.y >> 16)} * rstd * gf[c4];
                orow[c4 + 1] = (f32x4){bf2f(q.z & 0xffffu), bf2f(q.z >> 16), bf2f(q.w & 0xffffu), bf2f(q.w >> 16)} * rstd * gf[c4 + 1]; } }
    }
}

constexpr int LDS_BYTES = 147456;
constexpr int MISC_OFF = 131072 + 320;

__global__ void __launch_bounds__(NTHREADS, 2) mk_fwd(Args args) {
    extern __shared__ __attribute__((aligned(16))) unsigned char lds[];
    Ctx F;
    F.lds = (LAS unsigned char*)lds;
    F.wave = __builtin_amdgcn_readfirstlane((int)threadIdx.x >> 6);
    F.lane = lane_id(); F.tid = F.wave * 64 + F.lane;
    F.G = gridDim.x; { const int bx = blockIdx.x; F.vcu = (F.G % 8 == 0) ? (bx % 8) * (F.G / 8) + bx / 8 : bx; }
    F.in = (KargP)__builtin_amdgcn_kernarg_segment_ptr(); F.R = args.out; F.ws = args.ws;
    unsigned char* ws = args.ws;
    volatile LAS unsigned* MISC = (volatile LAS unsigned*)(F.lds + MISC_OFF);
    if (F.tid < 64) MISC[F.tid] = 0u;
    __syncthreads();
    XcdBarrier bar = xcd_barrier_post((unsigned*)(ws + WS_CTL) + CW_BAR, MISC + 8, F.tid == 0);
#define GRID_BAR() do { bar.bar = (unsigned*)(wsl(ws) + WS_CTL) + CW_BAR; xcd_barrier(bar, F.wave); } while (0)
#define FL launder(F)

    ph_bias_table(F);
    ph_prologue(F);
#pragma unroll 1
    for (int l = 0; l < DEPTH; ++l) {
        if (l == 0) ph_cvt_x(F); else ph_rstd(F);
        GRID_BAR();
        { pg8::Gemm g{P_XB(FL), (const bf16*)(wsl(ws) + WS_WIN) + (size_t)l * NPROJ * D, D, D, D}; pg8::StaticOrder S; S.init(T, NPROJ, sl(F.G), sl((int)blockIdx.x));
          EpiProjE E{P_UG(FL), P_PB(FL), P_QB(FL), P_KB(FL), P_VB(FL), P_KMP(FL), (const float*)(wsl(ws) + WS_RS1)}; pg8::gemm_phase(F.lds, g, S, E, sl(F.wave)); }
        GRID_BAR();
        { pg8::Gemm g{P_UG(FL), (const bf16*)(wsl(ws) + WS_BZ) + (size_t)l * SGN * 256 * 1024, UGP, 1024, 1024}; SsmOrder S{sl(F.G), sl((int)blockIdx.x), 1};
          EpiZ E{(float*)(wsl(ws) + WS_ZB)}; pg8::gemm_phase(F.lds, g, S, E, sl(F.wave)); }
        ph_pool_dl(F);
        moba::sel_phase(sl(F.wave), sl((int)blockIdx.x), sl(F.G), P_QB(FL), P_KMP(FL), (unsigned*)(wsl(ws) + WS_SEL), (LAS char*)F.lds);
        ph_tg_expand(F, l, sl((int)blockIdx.x), sl(F.G) > 64 ? 32 : 0);
        GRID_BAR();
        ph_ssm_scan(F, l);
        moba::gather_phase(sl(F.wave), sl(F.vcu), P_QB(FL), P_KB(FL), P_VB(FL), P_YMIX(FL), P_PB(FL), (bf16*)(wsl(ws) + WS_P2B), (float*)(wsl(ws) + WS_ML), (const unsigned*)(wsl(ws) + WS_SEL), P_BT(FL), (LAS char*)F.lds);
        GRID_BAR();
        { pg8::Gemm g{P_UG(FL), (const bf16*)(wsl(ws) + WS_TG) + (size_t)l * SGN * 1024 * UGP, UGP, UGP, UGP}; SsmOrder S{sl(F.G), sl((int)blockIdx.x), 2};
          EpiSsm2 E{P_UG(FL), P_YS(FL), F.in[11] + l * 256}; pg8::gemm_phase(F.lds, g, S, E, sl(F.wave)); }
        { const int bx = sl((int)blockIdx.x), G_ = sl(F.G); int ub, ue;
          if (G_ == 256) { ub = bx < 128 ? 3 * bx : 384 + 5 * (bx - 128); ue = ub + (bx < 128 ? 3 : 5); } else { ub = (bx * 1024) / G_; ue = ((bx + 1) * 1024) / G_; }
          moba::diag_phase(sl(F.wave), ub, ue, P_QB(FL), P_KB(FL), P_VB(FL), P_YMIX(FL), P_PB(FL), (const bf16*)(wsl(ws) + WS_P2B), (const float*)(wsl(ws) + WS_ML), P_BT(FL), (LAS char*)F.lds); }
        GRID_BAR();
        { pg8::Gemm g{P_YS(FL), (const bf16*)(wsl(ws) + WS_GLUT) + (size_t)l * 65536, 256, 256, 256}; HalfOrder S{sl(F.vcu)};
          EpiGluE E{P_YS(FL), P_YMIX(FL), F.in[13] + l * 256}; pg8::gemm_phase(F.lds, g, S, E, sl(F.wave)); }
        { pg8::Gemm g{P_DL(FL), (const bf16*)(wsl(ws) + WS_POOLT) + (size_t)l * 65536, 256, 256, 256}; HalfOrder S{sl(F.vcu) - 128};
          EpiPoolE E{P_YMIX(FL), F.in[15] + l * 256, F.in[16] + l * 256}; pg8::gemm_phase(F.lds, g, S, E, sl(F.wave)); }
        GRID_BAR();
        { pg8::Gemm g{P_YMIX(FL), (const bf16*)(wsl(ws) + WS_WOUT) + (size_t)l * D * D, D, D, D}; pg8::StaticOrder S; S.init(T, D, sl(F.G), sl((int)blockIdx.x));
          EpiOutE E{P_XB(FL)}; pg8::gemm_phase(F.lds, g, S, E, sl(F.wave)); }
        GRID_BAR();
        ph_route(F, l);
        GRID_BAR();
        ph_place(F);
        GRID_BAR();
        { pg8::Gemm g{P_XB(FL), (const bf16*)(wsl(ws) + WS_GU) + (size_t)l * 16 * 512 * D, D, D, D}; MoeOrder S{sl(F.G), sl((int)blockIdx.x), false, 0, 0}; S.init((const int*)(wsl(ws) + WS_TILEB));
          EpiGU E{(bf16*)(wsl(ws) + WS_HACT), (const float*)(wsl(ws) + WS_ROWW), (const float*)(wsl(ws) + WS_ROWR)}; pg8::gemm_phase<true, true>(F.lds, g, S, E, sl(F.wave), (const int*)(wsl(ws) + WS_ROWTOK)); }
        GRID_BAR();
        { pg8::Gemm g{(const bf16*)(wsl(ws) + WS_HACT), (const bf16*)(wsl(ws) + WS_WD) + (size_t)l * 24 * D * 512, 512, 512, 512}; MoeOrder S{sl(F.G), sl((int)blockIdx.x), true, 0, 0}; S.init((const int*)(wsl(ws) + WS_TILEB));
          EpiDown E{P_XB(FL), (const int*)(wsl(ws) + WS_ROWTOK)}; pg8::gemm_phase(F.lds, g, S, E, sl(F.wave)); }
        GRID_BAR();
    }
    ph_final(F);
}

extern "C" void kernel_launch(void* const* d_in, const int* in_sizes, int n_in, void* d_out, int out_size, void* d_ws, size_t ws_size, hipStream_t stream) {
    static int grid = 0;
    if (grid == 0) {
        if (n_in != 27 || out_size != T * D || ws_size < WS_END) { fprintf(stderr, "kernel_launch: unexpected shapes (n_in %d out %d ws %zu)\n", n_in, out_size, ws_size); grid = -1; return; }
        int dev = 0, cus = 0, per_cu = 0;
        if (hipGetDevice(&dev) != hipSuccess || hipDeviceGetAttribute(&cus, hipDeviceAttributeMultiprocessorCount, dev) != hipSuccess) { grid = -1; return; }
        if (hipFuncSetAttribute((const void*)mk_fwd, hipFuncAttributeMaxDynamicSharedMemorySize, LDS_BYTES) != hipSuccess) { fprintf(stderr, "kernel_launch: hipFuncSetAttribute failed\n"); grid = -1; return; }
        if (hipOccupancyMaxActiveBlocksPerMultiprocessor(&per_cu, (const void*)mk_fwd, NTHREADS, LDS_BYTES) != hipSuccess || per_cu < 1) { fprintf(stderr, "kernel_launch: occupancy query says %d\n", per_cu); per_cu = 1; }
        (void)hipGetLastError();
        grid = cus;
    }
    if (grid < 0) return;
    (void)hipMemsetAsync((char*)d_ws + WS_CTL, 0, CTL_ZERO_BYTES, stream);
    Args a{};
    for (int i = 0; i < 27; ++i) a.in[i] = (const float*)d_in[i];
    a.out = (float*)d_out; a.ws = (unsigned char*)d_ws; a.pad0 = 0; a.pad1 = 0;
    hipLaunchKernelGGL(mk_fwd, dim3(grid), dim3(NTHREADS), LDS_BYTES, stream, a);
}
```

```cpp
#include <hip/hip_runtime.h>
#include <hip/hip_bf16.h>
#include <cstdio>
#include <cstdint>

#define GAS __attribute__((address_space(1)))
#define LAS __attribute__((address_space(3)))
typedef unsigned short bf16;
typedef float f32x4 __attribute__((ext_vector_type(4)));
typedef unsigned u32x4 __attribute__((ext_vector_type(4)));
typedef unsigned u32x2 __attribute__((ext_vector_type(2)));

constexpr int NB = 8, SEQ = 4096, T = NB * SEQ, D = 1024, NPROJ = 2048, DEPTH = 2;
constexpr int NHEAD = 8, HD = 64, MBLK = 256, NBLK = SEQ / MBLK;
constexpr int SG = 16, SGN = 16, SP = 64, SCH = 64, UGP = 1152, UOF = 128;
constexpr float RMS_EPS = 1e-6f;
constexpr float LOG2E = 1.4426950408889634f;
constexpr float C2 = 0.125f * LOG2E;
constexpr int NWAVES = 8, NTHREADS = 512;

constexpr size_t MiB = 1u << 20;
constexpr size_t WS_CTL = 0, CTL_ZERO_BYTES = 1 * MiB;
constexpr size_t WS_XB = 2 * MiB;
constexpr size_t WS_UG = 66 * MiB;
constexpr size_t WS_PB = 84 * MiB;
constexpr size_t WS_QB = 100 * MiB;
constexpr size_t WS_KB = 132 * MiB;
constexpr size_t WS_VB = 164 * MiB;
constexpr size_t WS_YMIX = 196 * MiB;
constexpr size_t WS_YS = 260 * MiB;
constexpr size_t WS_DL = 276 * MiB;
constexpr size_t WS_KMP = 292 * MiB;
constexpr size_t WS_BT = 293 * MiB;
constexpr size_t WS_KT = 297 * MiB;
constexpr size_t WS_SEL = 298 * MiB;
constexpr size_t WS_WIN = 300 * MiB;
constexpr size_t WS_WOUT = 308 * MiB;
constexpr size_t WS_GU = 312 * MiB;
constexpr size_t WS_WD = 344 * MiB;
constexpr size_t WS_TG = 392 * MiB;
constexpr size_t WS_BZ = 464 * MiB;
constexpr size_t WS_GLUT = 480 * MiB;
constexpr size_t WS_POOLT = WS_GLUT + 512 * 1024;
constexpr size_t WS_ZB = 482 * MiB;
constexpr size_t WS_P2B = 486 * MiB;
constexpr size_t WS_ML = 502 * MiB;
constexpr size_t WS_END = 508 * MiB;
constexpr int MOE_MAXT = 152;
constexpr size_t WS_XS = 66 * MiB;
constexpr size_t WS_HACT = 142 * MiB;
constexpr size_t WS_TOKB = 294 * MiB;
constexpr size_t WS_TOKR = WS_TOKB + 128 * 1024;
constexpr size_t WS_TOKW = WS_TOKB + 256 * 1024;
constexpr size_t WS_ROWTOK = 295 * MiB;
constexpr size_t WS_ROWW = WS_ROWTOK + 256 * 1024;
constexpr size_t WS_ROWR = WS_ROWTOK + 576 * 1024;
constexpr size_t WS_RS1 = WS_ROWTOK + 768 * 1024;
constexpr size_t WS_WGCNT = 296 * MiB;
constexpr size_t WS_TILEB = WS_WGCNT + 64 * 1024;

constexpr int CW_BAR = 4096;

__device__ __forceinline__ unsigned f2bf(float f) { unsigned u = __builtin_bit_cast(unsigned, f); return (u + 0x7fffu + ((u >> 16) & 1u)) >> 16; }
__device__ __forceinline__ float bf2f(unsigned h) { return __builtin_bit_cast(float, h << 16); }
__device__ __forceinline__ unsigned pk2(float lo, float hi) { return f2bf(lo) | (f2bf(hi) << 16); }
template <int O> __device__ __forceinline__ float xshfl(float v) {
    if constexpr (O < 32) return __builtin_bit_cast(float, __builtin_amdgcn_ds_swizzle(__builtin_bit_cast(int, v), (O << 10) | 0x1f));
    else { const unsigned u = __builtin_bit_cast(unsigned, v); auto r = __builtin_amdgcn_permlane32_swap(u, u, false, false);
           const float a = __builtin_bit_cast(float, (unsigned)r[0]), b = __builtin_bit_cast(float, (unsigned)r[1]); return (a == v && __builtin_bit_cast(unsigned, a) == u) ? b : a; }
}
__device__ __forceinline__ float wave_sum(float v) {
    v += xshfl<1>(v); v += xshfl<2>(v); v += xshfl<4>(v); v += xshfl<8>(v); v += xshfl<16>(v);
    const unsigned u = __builtin_bit_cast(unsigned, v); auto r = __builtin_amdgcn_permlane32_swap(u, u, false, false);
    return __builtin_bit_cast(float, (unsigned)r[0]) + __builtin_bit_cast(float, (unsigned)r[1]);
}
__device__ __forceinline__ float wave_max(float v) {
    v = fmaxf(v, xshfl<1>(v)); v = fmaxf(v, xshfl<2>(v)); v = fmaxf(v, xshfl<4>(v)); v = fmaxf(v, xshfl<8>(v)); v = fmaxf(v, xshfl<16>(v));
    const unsigned u = __builtin_bit_cast(unsigned, v); auto r = __builtin_amdgcn_permlane32_swap(u, u, false, false);
    return fmaxf(__builtin_bit_cast(float, (unsigned)r[0]), __builtin_bit_cast(float, (unsigned)r[1]));
}
__device__ __forceinline__ float gelu_tanh(float x) {
    const float u = 0.7978845608028654f * (x + 0.044715f * x * x * x);
    const float e = __expf(2.f * u);
    const float th = 1.f - 2.f / (e + 1.f);
    return 0.5f * x * (1.f + th);
}
__device__ __forceinline__ float sigmoidf_(float x) { return 1.f / (1.f + __expf(-x)); }

__device__ __forceinline__ int lane_id() { unsigned m; asm volatile("s_mov_b32 %0, -1" : "=s"(m)); return (int)__builtin_amdgcn_mbcnt_hi(m, __builtin_amdgcn_mbcnt_lo(m, 0u)); }

#define XB_TMO      128
#define XB_XCNT(j)  (256  + 64 * (j))
#define XB_XSUB(j)  (1280 + 64 * (j))
#define XB_XGEN(j)  (2304 + 64 * (j))
#define XB_TOP      3328
#define XB_TOPGEN   3392
#define XCD_BAR_WORDS 3456
#define XB_SPIN_CAP (1u << 22)
__device__ __forceinline__ unsigned xb_ld(unsigned* p)              { return __hip_atomic_load(p, __ATOMIC_RELAXED, __HIP_MEMORY_SCOPE_AGENT); }
__device__ __forceinline__ unsigned xb_add(unsigned* p, unsigned v) { return __hip_atomic_fetch_add(p, v, __ATOMIC_RELAXED, __HIP_MEMORY_SCOPE_AGENT); }
__device__ __forceinline__ unsigned xb_xcc_id() { return (unsigned)__builtin_amdgcn_s_getreg((3 << 11) | 20) & 0xFu; }
#define XB_SPIN(cond, bar) do { unsigned _sp = 0; while (cond) { __builtin_amdgcn_s_sleep(1); \
    if ((++_sp & 255u) == 0u) { if (xb_ld(&(bar)[XB_TMO])) break; if (_sp > XB_SPIN_CAP) { atomicAdd(&(bar)[XB_TMO], 1u); break; } } } } while (0)
struct XcdBarrier { unsigned* bar; unsigned x; volatile LAS unsigned* st; };
__device__ __forceinline__ XcdBarrier xcd_barrier_post(unsigned* bar, volatile LAS unsigned* st, bool t0) {
    XcdBarrier b; b.bar = bar; b.x = xb_xcc_id(); b.st = st;
    if (t0) (void)xb_add(&bar[XB_XCNT(b.x)], 1u);
    return b;
}
__device__ __forceinline__ void xcd_barrier_complete(unsigned* bar, unsigned x, unsigned& nloc, unsigned& nx) {
    const unsigned G = gridDim.x * gridDim.y * gridDim.z;
    unsigned sum, cnt, mine, sp = 0u;
    for (;;) {
        sum = 0u; cnt = 0u; mine = 0u;
#pragma unroll
        for (unsigned j = 0; j < 16; ++j) { const unsigned c = xb_ld(&bar[XB_XCNT(j)]); sum += c; cnt += (c > 0u) ? 1u : 0u; mine = (j == x) ? c : mine; }
        if (sum == G) break;
        __builtin_amdgcn_s_sleep(1);
        if ((++sp & 255u) == 0u) { if (xb_ld(&bar[XB_TMO])) break; if (sp > XB_SPIN_CAP) { atomicAdd(&bar[XB_TMO], 1u); break; } }
    }
    nloc = mine > 0u ? mine : 1u; nx = cnt > 0u ? cnt : 1u;
}
__device__ __forceinline__ void xcd_barrier(const XcdBarrier& b, int wave) {
    asm volatile("s_waitcnt vmcnt(0)" ::: "memory");
    __syncthreads();
    if (wave == 0 && lane_id() == 0) {
        unsigned* bar = b.bar;
        __builtin_amdgcn_s_waitcnt(0);
        unsigned nloc = b.st[0], nx = b.st[1];
        if (nloc == 0u) { xcd_barrier_complete(bar, b.x, nloc, nx); b.st[0] = nloc; b.st[1] = nx; }
        const unsigned old = xb_add(&bar[XB_XSUB(b.x)], 1u);
        const unsigned gen = old / nloc;
        if (old + 1u == (gen + 1u) * nloc) {
            __builtin_amdgcn_fence(__ATOMIC_RELEASE, "agent");
            asm volatile("s_waitcnt vmcnt(0)" ::: "memory");
            const unsigned og = xb_add(&bar[XB_TOP], 1u);
            const unsigned tg = og / nx;
            if (og + 1u == (tg + 1u) * nx) xb_add(&bar[XB_TOPGEN], 1u);
            else XB_SPIN(xb_ld(&bar[XB_TOPGEN]) == tg, bar);
            __builtin_amdgcn_fence(__ATOMIC_ACQUIRE, "agent");
            xb_add(&bar[XB_XGEN(b.x)], 1u);
            asm volatile("s_waitcnt vmcnt(0)" ::: "memory");
        } else {
            XB_SPIN(xb_ld(&bar[XB_XGEN(b.x)]) == gen, bar);
            __builtin_amdgcn_fence(__ATOMIC_ACQUIRE, "agent");
            asm volatile("s_waitcnt vmcnt(0)" ::: "memory");
        }
    }
    __syncthreads();
}

struct Args {
    const float* in[27];
    float* out;
    unsigned char* ws;
    int pad0, pad1;
};

typedef const float* fptr_t;
typedef __attribute__((address_space(4))) const fptr_t* KargP;
struct Ctx {
    LAS unsigned char* lds;
    int tid, lane, wave, vcu, G;
    KargP in;
    float* R;
    unsigned char* ws;
};
#define P_XB(F) ((bf16*)((F).ws + WS_XB))
#define P_UG(F) ((bf16*)((F).ws + WS_UG))
#define P_PB(F) ((bf16*)((F).ws + WS_PB))
#define P_QB(F) ((bf16*)((F).ws + WS_QB))
#define P_KB(F) ((bf16*)((F).ws + WS_KB))
#define P_VB(F) ((bf16*)((F).ws + WS_VB))
#define P_YMIX(F) ((bf16*)((F).ws + WS_YMIX))
#define P_YS(F) ((bf16*)((F).ws + WS_YS))
#define P_DL(F) ((bf16*)((F).ws + WS_DL))
#define P_KMP(F) ((float*)((F).ws + WS_KMP))
#define P_BT(F) ((float*)((F).ws + WS_BT))


__device__ __forceinline__ Ctx launder(const Ctx& F0) {
    Ctx F = F0;
    int ln = lane_id(); asm volatile("" : "+v"(ln));
    asm volatile("" : "+s"(F.wave), "+s"(F.vcu), "+s"(F.G));
    F.lane = ln; F.tid = F.wave * 64 + ln;
    KargP kp = (KargP)__builtin_amdgcn_kernarg_segment_ptr(); asm volatile("" : "+s"(kp));
    F.in = kp; F.R = (float*)kp[27]; F.ws = (unsigned char*)kp[28];
    return F;
}

__device__ __forceinline__ unsigned char* wsl(unsigned char* p) { asm volatile("" : "+s"(p)); return p; }
__device__ __forceinline__ int sl(int x) { asm volatile("" : "+s"(x)); return x; }

namespace pg8 {
typedef short bf16x8 __attribute__((ext_vector_type(8)));
constexpr int BM = 256, BK = 64, HALF = 128, HTB = HALF * BK * 2, STAGE_BYTES = 8 * HTB, NXCD = 8, WGM = 8;
__device__ __forceinline__ int lds_byte(int r, int c) { const int st = (r >> 4) * 2 + (c >> 5), rr = r & 15, cc = c & 31, ob = rr * 64 + cc * 2; return st * 1024 + (ob ^ (((ob >> 9) & 1) << 5)); }
__device__ __forceinline__ void stage_rc(int b, int& R, int& C) { const int st = b / 1024, sb = b % 1024, swz = sb ^ (((sb >> 9) & 1) << 5); R = (st >> 1) * 16 + swz / 64; C = (st & 1) * 32 + (swz % 64) / 2; }
__device__ __forceinline__ int perm32(int rho) { const int n = rho >> 4, i = rho & 15; return 8 * (i >> 2) + 4 * n + (i & 3); }

struct Unit { int pm, pn, aux, kt; };
struct Gemm { const bf16* A; const bf16* Bt; int lda, ldb, K; };

struct StaticOrder {
    int nM, nN, nwg, G, c;
    __device__ void init(int M, int N, int G_, int c_) { nM = M / BM; nN = N / BM; nwg = nM * nN; G = G_; c = c_; }
    __device__ bool next(int i, Unit& u) const {
        const long L = (long)i * G + c; if (L >= nwg) return false;
        int wgid = (int)L; { const int q = nwg / NXCD, r = nwg % NXCD, xcd = wgid % NXCD, off = wgid / NXCD; wgid = (xcd < r ? xcd * (q + 1) : r * (q + 1) + (xcd - r) * q) + off; }
        const int nig = WGM * nN, gid = wgid / nig, fm = gid * WGM, gsz = (nM - fm) < WGM ? (nM - fm) : WGM;
        u.pm = fm + ((wgid % nig) % gsz); u.pn = (wgid % nig) / gsz; u.aux = 0; return true;
    }
};

__device__ __forceinline__ unsigned cvt_pk_bf16(float lo, float hi) { unsigned r; asm volatile("v_cvt_pk_bf16_f32 %0, %1, %2" : "=v"(r) : "v"(lo), "v"(hi)); return r; }

template <bool ALIGN = true, bool GATHER = false, class Epi, class Sched>
__device__ __forceinline__ void gemm_phase(LAS unsigned char* lds, const Gemm g, const Sched& S, const Epi& E, int wave_, const int* gidx = nullptr) {
    int lane_ = lane_id(); asm volatile("" : "+v"(lane_)); asm volatile("" : "+s"(wave_));
    const int wid = wave_, lane = lane_, tid = wid * 64 + lane, wr = wid >> 2, wc = wid & 3, fr = lane & 15, fq = lane >> 4;
    const int K = g.K, ntd = K / BK; int nt = ntd;
    unsigned voffA[2], voffA1[2], voffB[2];
#pragma unroll
    for (int i = 0; i < 2; ++i) { int R, C; stage_rc(tid * 16 + i * 8192, R, C); const int Rb = Epi::PERM ? ((R & ~31) + perm32(R & 31)) : R;
        voffA[i] = (unsigned)(R * g.lda + C) * 2u; voffB[i] = (unsigned)(Rb * g.ldb + C) * 2u; voffA1[i] = voffA[i] + (unsigned)(HALF * g.lda * 2); }
    const size_t kstep = (size_t)(BK * 2);
    const size_t hstepA = (size_t)HALF * g.lda * 2, hstepB = (size_t)HALF * g.ldb * 2;
    const size_t tstepA = 2 * hstepA, tstepB = 2 * hstepB;
    const unsigned ldsw = (unsigned)wid * 1024u;
    const int aoff = lds_byte(wr * 64 + fr, fq * 8), boff = lds_byte(wc * 32 + fr, fq * 8);
#define PG8_SA(b, h) (((b) * 2 + (h)) * HTB)
#define PG8_SB(b, h) ((4 + (b) * 2 + (h)) * HTB)
#define PG8_STAGE(bufoff, gbase, voff) do { _Pragma("unroll") for (int _i = 0; _i < 2; ++_i) \
        __builtin_amdgcn_global_load_lds((const unsigned*)((const char*)(gbase) + (voff)[_i]), (LAS unsigned*)(lds + (bufoff) + ldsw + _i * 8192), 16, 0, 0); } while (0)
#define PG8_LDA(dst, b, h) do { _Pragma("unroll") for (int m = 0; m < 4; ++m) _Pragma("unroll") for (int k = 0; k < 2; ++k) dst[m][k] = *(const LAS bf16x8*)(lds + PG8_SA(b, h) + aoff + m * 2048 + k * 1024); } while (0)
#define PG8_LDB(dst, b, h) do { _Pragma("unroll") for (int n = 0; n < 2; ++n) _Pragma("unroll") for (int k = 0; k < 2; ++k) dst[n][k] = *(const LAS bf16x8*)(lds + PG8_SB(b, h) + boff + n * 2048 + k * 1024); } while (0)
#define PG8_MMA(ai, bj, At, Bt) do { __builtin_amdgcn_s_setprio(1); _Pragma("unroll") for (int m = 0; m < 4; ++m) _Pragma("unroll") for (int n = 0; n < 2; ++n) _Pragma("unroll") for (int k = 0; k < 2; ++k) \
        acc[ai][bj][m][n] = __builtin_amdgcn_mfma_f32_16x16x32_bf16(Bt[n][k], At[m][k], acc[ai][bj][m][n], 0, 0, 0); __builtin_amdgcn_s_setprio(0); } while (0)
#define PG8_GLOOK(PM) do { if constexpr (GATHER) { _Pragma("unroll") for (int _i = 0; _i < 2; ++_i) { int R_, C_; stage_rc(tid * 16 + _i * 8192, R_, C_); \
        int t0_ = gidx[(PM) * 256 + R_], t1_ = gidx[(PM) * 256 + HALF + R_]; t0_ = t0_ < 0 ? 0 : t0_; t1_ = t1_ < 0 ? 0 : t1_; \
        voffA[_i] = (unsigned)(t0_ * g.lda + C_) * 2u; voffA1[_i] = (unsigned)(t1_ * g.lda + C_) * 2u; } } } while (0)
#define PG8_WAIT_V(n) asm volatile("s_waitcnt vmcnt(" #n ")" ::: "memory")
#define PG8_WAIT_L(n) asm volatile("s_waitcnt lgkmcnt(" #n ")" ::: "memory")
#define PG8_BAR __builtin_amdgcn_s_barrier()
#define PG8_SCHED __builtin_amdgcn_sched_barrier(0)
    Unit cur{0, 0, 0, 0}, nxt{0, 0, 0, 0}; int ui = 0;
    if (!S.next(0, cur)) return;
    nt = cur.kt ? cur.kt : ntd;
    f32x4 acc[2][2][4][2];
#pragma unroll
    for (int a = 0; a < 2; ++a)
#pragma unroll
        for (int b = 0; b < 2; ++b)
#pragma unroll
            for (int m = 0; m < 4; ++m)
#pragma unroll
                for (int n = 0; n < 2; ++n) acc[a][b][m][n] = (f32x4){0.f, 0.f, 0.f, 0.f};
    bf16x8 At[4][2], B0[2][2], B1[2][2];
    const char* cA = (const char*)g.A + (GATHER ? (size_t)0 : (size_t)cur.pm * tstepA); const char* cB = (const char*)g.Bt + (size_t)cur.pn * tstepB;
    PG8_GLOOK(cur.pm);
    PG8_STAGE(PG8_SB(0, 0), cB, voffB); PG8_STAGE(PG8_SB(0, 1), cB + hstepB, voffB); PG8_STAGE(PG8_SA(0, 0), cA, voffA); PG8_STAGE(PG8_SA(0, 1), cA, voffA1);
    if (wr == 1) PG8_BAR;
    PG8_WAIT_V(2); PG8_BAR;
    PG8_STAGE(PG8_SB(1, 0), cB + kstep, voffB); PG8_STAGE(PG8_SA(1, 0), cA + kstep, voffA); PG8_STAGE(PG8_SB(1, 1), cB + hstepB + kstep, voffB);
    PG8_WAIT_V(6); PG8_BAR;
    for (;;) {
        const bool has_next = S.next(ui + 1, nxt);
        const char* nA = has_next ? (const char*)g.A + (GATHER ? (size_t)0 : (size_t)nxt.pm * tstepA) : cA; const char* nB = has_next ? (const char*)g.Bt + (size_t)nxt.pn * tstepB : cB;
        for (int t = 0; t < nt; t += 2) {
            const bool last = (t == nt - 2);
            const char* a1 = cA + (size_t)(t + 1) * kstep;
            const char* a2 = last ? nA : cA + (size_t)(t + 2) * kstep; const char* b2 = last ? nB : cB + (size_t)(t + 2) * kstep;
            const char* a3 = a2 + kstep; const char* b3 = b2 + kstep;
            PG8_LDB(B0, 0, 0); PG8_LDB(B1, 0, 1); PG8_SCHED; PG8_LDA(At, 0, 0); PG8_STAGE(PG8_SA(1, 1), a1, voffA1);
            PG8_WAIT_V(8); PG8_WAIT_L(0); PG8_BAR; PG8_MMA(0, 0, At, B0); PG8_MMA(0, 1, At, B1); PG8_BAR; PG8_SCHED;
            if constexpr (GATHER) { if (last && has_next) PG8_GLOOK(nxt.pm); }
            PG8_LDA(At, 0, 1); PG8_STAGE(PG8_SB(0, 0), b2, voffB); PG8_STAGE(PG8_SB(0, 1), b2 + hstepB, voffB); PG8_STAGE(PG8_SA(0, 0), a2, voffA);
            PG8_WAIT_V(8); PG8_WAIT_L(0); PG8_BAR; PG8_MMA(1, 0, At, B0); PG8_MMA(1, 1, At, B1); PG8_BAR; PG8_SCHED;
            PG8_LDB(B0, 1, 0); PG8_LDB(B1, 1, 1); PG8_SCHED; PG8_LDA(At, 1, 0); PG8_STAGE(PG8_SA(0, 1), a2, voffA1);
            PG8_WAIT_V(8); PG8_WAIT_L(0); PG8_BAR; PG8_MMA(0, 0, At, B0); PG8_MMA(0, 1, At, B1); PG8_BAR; PG8_SCHED;
            PG8_LDA(At, 1, 1); PG8_STAGE(PG8_SB(1, 0), b3, voffB); PG8_STAGE(PG8_SB(1, 1), b3 + hstepB, voffB); PG8_STAGE(PG8_SA(1, 0), a3, voffA);
            PG8_WAIT_V(8); PG8_WAIT_L(0); PG8_BAR; PG8_MMA(1, 0, At, B0); PG8_MMA(1, 1, At, B1); PG8_BAR; PG8_SCHED;
        }
        if constexpr (ALIGN) { if (wr == 0) PG8_BAR; }
        E(acc, cur, wr, wc, fr, fq);
        if (!has_next) break;
#pragma unroll
        for (int a = 0; a < 2; ++a)
#pragma unroll
            for (int b = 0; b < 2; ++b)
#pragma unroll
                for (int m = 0; m < 4; ++m)
#pragma unroll
                    for (int n = 0; n < 2; ++n) acc[a][b][m][n] = (f32x4){0.f, 0.f, 0.f, 0.f};
        cur = nxt; cA = nA; cB = nB; ++ui; nt = cur.kt ? cur.kt : ntd;
        if constexpr (ALIGN) { if (wr == 1) PG8_BAR; }
    }
    PG8_WAIT_V(0);
    if constexpr (!ALIGN) { if (wr == 0) PG8_BAR; }
    PG8_BAR;
#undef PG8_SA
#undef PG8_SB
#undef PG8_STAGE
#undef PG8_LDA
#undef PG8_LDB
#undef PG8_MMA
#undef PG8_WAIT_V
#undef PG8_WAIT_L
#undef PG8_BAR
#undef PG8_SCHED
}
}


struct EpiProjE {
    static constexpr bool PERM = true;
    bf16 *UG, *PB, *QB, *KB, *VB; float* KMP; const float* rs1;
    __device__ __forceinline__ void operator()(const f32x4 (&acc_)[2][2][4][2], const pg8::Unit& u, int wr, int wc, int fr_, int fq_) const {
        const int ln_ = lane_id(), fr = ln_ & 15, fq = ln_ >> 4; (void)fr_; (void)fq_;
        const int pn = u.pn, row0 = u.pm * 256 + wr * 64 + fr, cl = wc * 32 + 8 * fq;
        f32x4 acc[2][2][4][2];
#pragma unroll
        for (int ai = 0; ai < 2; ++ai)
#pragma unroll
            for (int m = 0; m < 4; ++m) { const float rs = rs1[row0 + ai * 128 + m * 16];
#pragma unroll
                for (int bj = 0; bj < 2; ++bj) { acc[ai][bj][m][0] = acc_[ai][bj][m][0] * rs; acc[ai][bj][m][1] = acc_[ai][bj][m][1] * rs; } }
        if (pn == 0) {
#pragma unroll
            for (int ai = 0; ai < 2; ++ai)
#pragma unroll
                for (int m = 0; m < 4; ++m) { const int r = row0 + ai * 128 + m * 16;
#pragma unroll
                    for (int bj = 0; bj < 2; ++bj) { const int ch = bj * 128 + cl, g = ch >> 4, h0 = ch & 15;
                        const f32x4 v0 = acc[ai][bj][m][0], v1 = acc[ai][bj][m][1]; u32x4 w;
                        w.x = pg8::cvt_pk_bf16(v0[0], v0[1]); w.y = pg8::cvt_pk_bf16(v0[2], v0[3]); w.z = pg8::cvt_pk_bf16(v1[0], v1[1]); w.w = pg8::cvt_pk_bf16(v1[2], v1[3]);
                        *(u32x4*)(UG + ((size_t)(g * 512 + (r >> 6))) * UGP + UOF + (r & 63) * 16 + h0) = w; } }
        } else {
            bf16* base; int ldc, colt; float sc = 1.f;
            if (pn == 1) { base = PB; ldc = 256; colt = 0; }
            else if (pn < 4) { base = QB; ldc = 512; colt = (pn - 2) * 256; sc = C2; }
            else if (pn < 6) { base = KB; ldc = 512; colt = (pn - 4) * 256; }
            else { base = VB; ldc = 512; colt = (pn - 6) * 256; }
#pragma unroll
            for (int ai = 0; ai < 2; ++ai)
#pragma unroll
                for (int m = 0; m < 4; ++m) { bf16* rowp = base + (size_t)(row0 + ai * 128 + m * 16) * ldc + colt + cl;
#pragma unroll
                    for (int bj = 0; bj < 2; ++bj) { const f32x4 v0 = acc[ai][bj][m][0] * sc, v1 = acc[ai][bj][m][1] * sc; u32x4 w;
                        w.x = pg8::cvt_pk_bf16(v0[0], v0[1]); w.y = pg8::cvt_pk_bf16(v0[2], v0[3]); w.z = pg8::cvt_pk_bf16(v1[0], v1[1]); w.w = pg8::cvt_pk_bf16(v1[2], v1[3]);
                        *(u32x4*)(rowp + bj * 128) = w; } }
            if (pn >= 4 && pn < 6) {
#pragma unroll
                for (int bj = 0; bj < 2; ++bj)
#pragma unroll
                    for (int n = 0; n < 2; ++n) { f32x4 s = (f32x4){0.f, 0.f, 0.f, 0.f};
#pragma unroll
                        for (int ai = 0; ai < 2; ++ai)
#pragma unroll
                            for (int m = 0; m < 4; ++m) s += acc[ai][bj][m][n];
#pragma unroll
                        for (int i = 0; i < 4; ++i) { float t = s[i]; t += xshfl<1>(t); t += xshfl<2>(t); t += xshfl<4>(t); t += xshfl<8>(t); s[i] = t; }
                        if (fr == 0) *(f32x4*)(KMP + (size_t)wr * 128 * 512 + (size_t)u.pm * 512 + colt + bj * 128 + cl + 4 * n) = s; }
            }
        }
    }
};
struct EpiOutE {
    static constexpr bool PERM = true;
    bf16* RB;
    __device__ __forceinline__ void operator()(const f32x4 (&acc)[2][2][4][2], const pg8::Unit& u, int wr, int wc, int fr_, int fq_) const {
        const int ln_ = lane_id(), fr = ln_ & 15, fq = ln_ >> 4; (void)fr_; (void)fq_;
        const int row0 = u.pm * 256 + wr * 64 + fr, col0 = u.pn * 256 + wc * 32 + 8 * fq;
#pragma unroll
        for (int ai = 0; ai < 2; ++ai) { u32x4 x[4][2];
#pragma unroll
            for (int m = 0; m < 4; ++m) { const bf16* rp = RB + (size_t)(row0 + ai * 128 + m * 16) * D + col0; x[m][0] = *(const u32x4*)rp; x[m][1] = *(const u32x4*)(rp + 128); }
#pragma unroll
            for (int m = 0; m < 4; ++m) { bf16* rp = RB + (size_t)(row0 + ai * 128 + m * 16) * D + col0;
#pragma unroll
                for (int bj = 0; bj < 2; ++bj) { const u32x4 xx = x[m][bj]; const f32x4 a0 = acc[ai][bj][m][0], a1 = acc[ai][bj][m][1]; u32x4 w;
                    w.x = pg8::cvt_pk_bf16(bf2f(xx.x & 0xffffu) + a0[0], bf2f(xx.x >> 16) + a0[1]); w.y = pg8::cvt_pk_bf16(bf2f(xx.y & 0xffffu) + a0[2], bf2f(xx.y >> 16) + a0[3]);
                    w.z = pg8::cvt_pk_bf16(bf2f(xx.z & 0xffffu) + a1[0], bf2f(xx.z >> 16) + a1[1]); w.w = pg8::cvt_pk_bf16(bf2f(xx.w & 0xffffu) + a1[2], bf2f(xx.w >> 16) + a1[3]);
                    *(u32x4*)(rp + bj * 128) = w; } }
            asm volatile("" ::: "memory"); }
    }
};

__device__ __forceinline__ void transpose_item(const float* W, int K, int N, const float* kscale, bf16* WT, int ldo, int koff, int rowmode, LAS float* scr, int item, int lane) {
    const int nblk = N / 32, kb = item / nblk, nb = item % nblk, k0 = 64 * kb, n0 = 32 * nb;
    { const int r8 = lane >> 3, c4 = lane & 7; f32x4 v[8];
#pragma unroll
      for (int i = 0; i < 8; ++i) v[i] = *(const f32x4*)(W + (size_t)(k0 + 8 * i + r8) * N + n0 + 4 * c4);
#pragma unroll
      for (int i = 0; i < 8; ++i) { const int kk = 8 * i + r8; const float s = kscale ? kscale[k0 + kk] : 1.f; LAS float* d = scr + kk * 33 + 4 * c4;
          d[0] = v[i][0] * s; d[1] = v[i][1] * s; d[2] = v[i][2] * s; d[3] = v[i][3] * s; } }
    asm volatile("s_waitcnt lgkmcnt(0)" ::: "memory");
    const int c = lane & 7;
#pragma unroll
    for (int j = 0; j < 4; ++j) { const int n = (lane >> 3) + 8 * j; const LAS float* s = scr + (8 * c) * 33 + n;
        u32x4 o; o.x = pk2(s[0 * 33], s[1 * 33]); o.y = pk2(s[2 * 33], s[3 * 33]); o.z = pk2(s[4 * 33], s[5 * 33]); o.w = pk2(s[6 * 33], s[7 * 33]);
        const int nn = n0 + n, row = rowmode == 0 ? nn : (8 * (nn >> 2) + (nn & 3) + (rowmode == 2 ? 4 : 0));
        *(u32x4*)(WT + (size_t)row * ldo + koff + k0 + 8 * c) = o; }
    asm volatile("s_waitcnt lgkmcnt(0)" ::: "memory");
}
__device__ __forceinline__ void pair_decode(int pi, int& ea, int& eb) { ea = pi < 3 ? 0 : (pi < 5 ? 1 : 2); eb = pi < 3 ? pi + 1 : (pi < 5 ? pi - 1 : 3); }
__device__ __forceinline__ void ph_prologue(const Ctx& F0) {
    const Ctx F = launder(F0);
    LAS float* scr = (LAS float*)(F.lds + F.wave * 16384);
    const int gw = F.vcu * NWAVES + F.wave, NGW = F.G * NWAVES;
    constexpr int I_IN = (D / 64) * (NPROJ / 32), I_OUT = (D / 64) * (D / 32), I_GU1 = (D / 64) * (256 / 32), I_GU = 16 * 2 * I_GU1, I_WD1 = (256 / 64) * (D / 32), I_WD = 24 * 2 * I_WD1;
    constexpr int I_L = I_IN + I_OUT + I_GU + I_WD;
    for (int it = gw; it < DEPTH * I_L; it += NGW) {
        const int l = it / I_L; int r = it % I_L;
        if (r < I_IN) { transpose_item(F.in[3] + (size_t)l * D * NPROJ, D, NPROJ, F.in[2] + l * D, (bf16*)(F.ws + WS_WIN) + (size_t)l * NPROJ * D, D, 0, 0, scr, r, F.lane); continue; } r -= I_IN;
        if (r < I_OUT) { transpose_item(F.in[17] + (size_t)l * D * D, D, D, nullptr, (bf16*)(F.ws + WS_WOUT) + (size_t)l * D * D, D, 0, 0, scr, r, F.lane); continue; } r -= I_OUT;
        if (r < I_GU) { const int e = r / (2 * I_GU1), up = (r / I_GU1) & 1, item = r % I_GU1;
            transpose_item(F.in[up ? 24 : 23] + ((size_t)l * 16 + e) * D * 256, D, 256, F.in[18] + l * D, (bf16*)(F.ws + WS_GU) + ((size_t)l * 16 + e) * 512 * D, D, 0, 1 + up, scr, item, F.lane); continue; } r -= I_GU;
        { const int bk = r / (2 * I_WD1), half = (r / I_WD1) & 1, item = r % I_WD1, g = bk / 6; int ea, eb; pair_decode(bk % 6, ea, eb); const int e = g * 4 + (half ? eb : ea);
            transpose_item(F.in[25] + ((size_t)l * 16 + e) * 256 * D, 256, D, nullptr, (bf16*)(F.ws + WS_WD) + ((size_t)l * 24 + bk) * D * 512, 512, half * 256, 0, scr, item, F.lane); }
    }
    for (int it = gw; it < DEPTH * 32; it += NGW) { const int l = it >> 5;
        transpose_item(F.in[12] + (size_t)l * 256 * 256, 256, 256, nullptr, (bf16*)(F.ws + WS_GLUT) + (size_t)l * 65536, 256, 0, 0, scr, it & 31, F.lane); }
    { const int gt = F.vcu * NTHREADS + F.tid, NGT = F.G * NTHREADS;
      for (int i = gt; i < DEPTH * 65536; i += NGT) { const int l = i >> 16, n = (i >> 8) & 255, k = i & 255;
          const float v = ((n >> 6) == (k >> 6)) ? F.in[14][(((size_t)l * 4 + (n >> 6)) * 64 + (k & 63)) * 64 + (n & 63)] : 0.f;
          ((bf16*)(F.ws + WS_POOLT))[i] = (bf16)f2bf(v); } }
    for (int it = gw; it < DEPTH * SGN * 65; it += NGW) {
        const int l = it / (SGN * 65), g = (it / 65) % SGN, tau = it % 65, p = F.lane;
        const float are = F.in[4][(l * SGN + g) * SP + p], aim = F.in[5][(l * SGN + g) * SP + p], dt = expf(F.in[6][l * SGN + g]);
        float sn, cs; sincosf(aim * dt, &sn, &cs); const float mg = expf(are * dt), lbr = mg * cs, lbi = mg * sn;
        const float nr = lbr - 1.f, ni = lbi, den = are * are + aim * aim, cr = (nr * are + ni * aim) / den, ci = (ni * are - nr * aim) / den;
        float sn2, cs2; sincosf(aim * dt * (float)tau, &sn2, &cs2); const float mg2 = expf(are * dt * (float)tau), lr = mg2 * cs2, li = mg2 * sn2;
        float wr[16], wi[16];
#pragma unroll
        for (int h = 0; h < 16; ++h) { const float br = F.in[7][((size_t)(l * SGN + g) * SP + p) * SG + h], bi = F.in[8][((size_t)(l * SGN + g) * SP + p) * SG + h];
            const float bbr = cr * br - ci * bi, bbi = cr * bi + ci * br; wr[h] = lr * bbr - li * bbi; wi[h] = lr * bbi + li * bbr; }
        bf16* TG = (bf16*)(F.ws + WS_TG) + ((size_t)l * SGN + g) * 1024 * UGP;
        if (tau <= 63) {
            bf16* BZ = (bf16*)(F.ws + WS_BZ) + ((size_t)l * SGN + g) * 256 * 1024; const int s = 63 - tau;
            u32x4 o0, o1, o2, o3;
            o0.x = pk2(wr[0], wr[1]); o0.y = pk2(wr[2], wr[3]); o0.z = pk2(wr[4], wr[5]); o0.w = pk2(wr[6], wr[7]); o1.x = pk2(wr[8], wr[9]); o1.y = pk2(wr[10], wr[11]); o1.z = pk2(wr[12], wr[13]); o1.w = pk2(wr[14], wr[15]);
            o2.x = pk2(wi[0], wi[1]); o2.y = pk2(wi[2], wi[3]); o2.z = pk2(wi[4], wi[5]); o2.w = pk2(wi[6], wi[7]); o3.x = pk2(wi[8], wi[9]); o3.y = pk2(wi[10], wi[11]); o3.z = pk2(wi[12], wi[13]); o3.w = pk2(wi[14], wi[15]);
            *(u32x4*)(BZ + (size_t)p * 1024 + s * 16) = o0; *(u32x4*)(BZ + (size_t)p * 1024 + s * 16 + 8) = o1;
            *(u32x4*)(BZ + (size_t)(64 + p) * 1024 + s * 16) = o2; *(u32x4*)(BZ + (size_t)(64 + p) * 1024 + s * 16 + 8) = o3;
        }
        LAS float* Wst = scr; LAS float* Kt = scr + 128 * 16;
        if (tau <= 63) {
#pragma unroll
            for (int q = 0; q < 4; ++q) { *(LAS f32x4*)(Wst + p * 16 + 4 * q) = (f32x4){wr[4 * q], wr[4 * q + 1], wr[4 * q + 2], wr[4 * q + 3]};
                                          *(LAS f32x4*)(Wst + (64 + p) * 16 + 4 * q) = (f32x4){wi[4 * q], wi[4 * q + 1], wi[4 * q + 2], wi[4 * q + 3]}; }
            const int arow = p & 15, kq = p >> 4; f32x4 kacc = (f32x4){0.f, 0.f, 0.f, 0.f};
            const float* cre = F.in[9] + ((size_t)(l * SGN + g) * SG + arow) * SP; const float* cim = F.in[10] + ((size_t)(l * SGN + g) * SG + arow) * SP;
#pragma unroll 8
            for (int s = 0; s < 32; ++s) { const int k = 4 * s + kq; const float av = (k < 64) ? cre[k] : -cim[k - 64]; const float bv = Wst[k * 16 + arow];
                kacc = __builtin_amdgcn_mfma_f32_16x16x4f32(av, bv, kacc, 0, 0, 0); }
#pragma unroll
            for (int r = 0; r < 4; ++r) Kt[(4 * kq + r) * 16 + arow] = kacc[r];
            asm volatile("s_waitcnt lgkmcnt(0)" ::: "memory");
            const f32x4 t4 = *(const LAS f32x4*)(Kt + 4 * p);
            u32x2 o; o.x = pk2(t4[0], t4[1]); o.y = pk2(t4[2], t4[3]);
            *(u32x2*)((bf16*)(F.ws + WS_KT) + ((size_t)(l * SGN + g) * 64 + tau) * 256 + 4 * p) = o;
        }
        if (tau >= 1) {
#pragma unroll 4
            for (int ho = 0; ho < 16; ++ho) {
                const float ccr = F.in[9][((size_t)(l * SGN + g) * SG + ho) * SP + p], cci = F.in[10][((size_t)(l * SGN + g) * SG + ho) * SP + p];
                const int n = (tau - 1) * 16 + ho;
                TG[(size_t)n * UGP + p] = (bf16)f2bf(ccr * lr - cci * li); TG[(size_t)n * UGP + 64 + p] = (bf16)f2bf(-(ccr * li + cci * lr)); }
        }
    }
}

__device__ __forceinline__ void route_finish(const float (&a)[20], float ssum, int m, bool act, const float* gb_, const float* rb_, int* tokb, float* tokr, float* tokw, LAS int* hist) {
        const float rstd = 1.f / sqrtf(ssum * (1.f / D) + RMS_EPS);
        float lg0 = a[0] * rstd + gb_[0], lg1 = a[1] * rstd + gb_[1], lg2 = a[2] * rstd + gb_[2], lg3 = a[3] * rstd + gb_[3];
        int gs = 0; float gm = lg0;
        if (lg1 > gm) { gm = lg1; gs = 1; } if (lg2 > gm) { gm = lg2; gs = 2; } if (lg3 > gm) { gm = lg3; gs = 3; }
        const float gwt = 1.f / (__expf(lg0 - gm) + __expf(lg1 - gm) + __expf(lg2 - gm) + __expf(lg3 - gm));
        float q0 = a[4], q1 = a[5], q2 = a[6], q3 = a[7], q4 = a[8], q5 = a[9], q6 = a[10], q7 = a[11], q8 = a[12], q9 = a[13], q10 = a[14], q11 = a[15], q12 = a[16], q13 = a[17], q14 = a[18], q15 = a[19];
        asm volatile("" : "+v"(q0), "+v"(q1), "+v"(q2), "+v"(q3), "+v"(q4), "+v"(q5), "+v"(q6), "+v"(q7));
        asm volatile("" : "+v"(q8), "+v"(q9), "+v"(q10), "+v"(q11), "+v"(q12), "+v"(q13), "+v"(q14), "+v"(q15));
        float e0 = gs == 0 ? q0 : gs == 1 ? q4 : gs == 2 ? q8 : q12;
        float e1 = gs == 0 ? q1 : gs == 1 ? q5 : gs == 2 ? q9 : q13;
        float e2 = gs == 0 ? q2 : gs == 1 ? q6 : gs == 2 ? q10 : q14;
        float e3 = gs == 0 ? q3 : gs == 1 ? q7 : gs == 2 ? q11 : q15;
        e0 = e0 * rstd + rb_[gs * 4 + 0]; e1 = e1 * rstd + rb_[gs * 4 + 1]; e2 = e2 * rstd + rb_[gs * 4 + 2]; e3 = e3 * rstd + rb_[gs * 4 + 3];
        int t1 = 0; float v1 = e0;
        if (e1 > v1) { v1 = e1; t1 = 1; } if (e2 > v1) { v1 = e2; t1 = 2; } if (e3 > v1) { v1 = e3; t1 = 3; }
        int t2 = -1; float v2 = -3.0e38f;
        if (t1 != 0 && e0 > v2) { v2 = e0; t2 = 0; } if (t1 != 1 && e1 > v2) { v2 = e1; t2 = 1; } if (t1 != 2 && e2 > v2) { v2 = e2; t2 = 2; } if (t1 != 3 && e3 > v2) { v2 = e3; t2 = 3; }
        const float p2 = __expf(v2 - v1), w1 = gwt / (1.f + p2), w2 = gwt * p2 / (1.f + p2);
        const int lo = t1 < t2 ? t1 : t2, hi = t1 < t2 ? t2 : t1; const float wlo = t1 < t2 ? w1 : w2, whi = t1 < t2 ? w2 : w1;
        const int pi = lo == 0 ? hi - 1 : (lo == 1 ? hi + 1 : 5), bk = gs * 6 + pi;
        if (act) { tokb[m] = bk; tokr[m] = rstd; tokw[2 * m] = wlo; tokw[2 * m + 1] = whi; __hip_atomic_fetch_add(hist + bk, 1, __ATOMIC_RELAXED, __HIP_MEMORY_SCOPE_WORKGROUP); }
}
__device__ __forceinline__ void ph_route(const Ctx& F0, int l) {
    const Ctx F = launder(F0);
    constexpr int WLD = 1032;
    LAS bf16* Wh = (LAS bf16*)F.lds;
    LAS bf16* Wlo = Wh + 20 * WLD;
    LAS float* LG = (LAS float*)(F.lds + 4 * 20 * WLD);
    LAS int* hist = (LAS int*)(F.lds + 4 * 20 * WLD + 8 * 320 * 4);
    const float* g2 = F.in[18] + l * D;
    const f32x4* gw4 = (const f32x4*)(F.in[19] + (size_t)l * D * 4); const f32x4* rw4 = (const f32x4*)(F.in[21] + (size_t)l * 4 * D * 4);
    const float* gb_ = F.in[20] + l * 4; const float* rb_ = F.in[22] + l * 16;
    for (int idx = F.tid; idx < D * 5; idx += NTHREADS) { const int k = idx % D, q = idx / D;
        f32x4 v = (q == 0) ? gw4[k] : rw4[(q - 1) * D + k]; v = v * g2[k];
#pragma unroll
        for (int i = 0; i < 4; ++i) { const unsigned h = f2bf(v[i]); Wh[(q * 4 + i) * WLD + k] = (bf16)h; Wlo[(q * 4 + i) * WLD + k] = (bf16)f2bf(v[i] - bf2f(h)); } }
    if (F.tid < 32) hist[F.tid] = 0;
    __syncthreads();
    int* tokb = (int*)(F.ws + WS_TOKB); float* tokr = (float*)(F.ws + WS_TOKR); float* tokw = (float*)(F.ws + WS_TOKW);
    const int i16 = F.lane & 15, kq = F.lane >> 4, m0 = F.vcu * 128 + F.wave * 16;
    const u32x4* xr = (const u32x4*)(P_XB(F) + (size_t)(m0 + i16) * D) + kq;
    const int c1 = 16 + (i16 & 3);
    const LAS bf16* bh0 = Wh + i16 * WLD + 8 * kq; const LAS bf16* bl0 = Wlo + i16 * WLD + 8 * kq;
    const LAS bf16* bh1 = Wh + c1 * WLD + 8 * kq;  const LAS bf16* bl1 = Wlo + c1 * WLD + 8 * kq;
    f32x4 acc0 = (f32x4){0.f, 0.f, 0.f, 0.f}, acc1 = acc0; float ss = 0.f;
#pragma unroll 4
    for (int c = 0; c < 32; ++c) {
        const u32x4 xa = xr[4 * c];
        const float x0 = bf2f(xa.x & 0xffffu), x1 = __builtin_bit_cast(float, xa.x & 0xffff0000u), x2 = bf2f(xa.y & 0xffffu), x3 = __builtin_bit_cast(float, xa.y & 0xffff0000u);
        const float x4 = bf2f(xa.z & 0xffffu), x5 = __builtin_bit_cast(float, xa.z & 0xffff0000u), x6 = bf2f(xa.w & 0xffffu), x7 = __builtin_bit_cast(float, xa.w & 0xffff0000u);
        ss += ((x0 * x0 + x1 * x1) + (x2 * x2 + x3 * x3)) + ((x4 * x4 + x5 * x5) + (x6 * x6 + x7 * x7));
        const pg8::bf16x8 av = __builtin_bit_cast(pg8::bf16x8, xa);
        const pg8::bf16x8 h0 = *(const LAS pg8::bf16x8*)(bh0 + 32 * c), l0 = *(const LAS pg8::bf16x8*)(bl0 + 32 * c);
        const pg8::bf16x8 h1 = *(const LAS pg8::bf16x8*)(bh1 + 32 * c), l1 = *(const LAS pg8::bf16x8*)(bl1 + 32 * c);
        acc0 = __builtin_amdgcn_mfma_f32_16x16x32_bf16(av, h0, acc0, 0, 0, 0); acc1 = __builtin_amdgcn_mfma_f32_16x16x32_bf16(av, h1, acc1, 0, 0, 0);
        acc0 = __builtin_amdgcn_mfma_f32_16x16x32_bf16(av, l0, acc0, 0, 0, 0); acc1 = __builtin_amdgcn_mfma_f32_16x16x32_bf16(av, l1, acc1, 0, 0, 0);
    }
    ss += xshfl<16>(ss);
    { const unsigned u = __builtin_bit_cast(unsigned, ss); auto r = __builtin_amdgcn_permlane32_swap(u, u, false, false);
      ss = __builtin_bit_cast(float, (unsigned)r[0]) + __builtin_bit_cast(float, (unsigned)r[1]); }
    LAS float* lg = LG + F.wave * 320;
#pragma unroll
    for (int r = 0; r < 4; ++r) { lg[(4 * kq + r) * 20 + i16] = acc0[r]; if (i16 < 4) lg[(4 * kq + r) * 20 + 16 + i16] = acc1[r]; }
    asm volatile("s_waitcnt lgkmcnt(0)" ::: "memory");
    float a[20];
#pragma unroll
    for (int j = 0; j < 5; ++j) { const f32x4 t4 = *(const LAS f32x4*)(lg + i16 * 20 + 4 * j); a[4 * j] = t4[0]; a[4 * j + 1] = t4[1]; a[4 * j + 2] = t4[2]; a[4 * j + 3] = t4[3]; }
    route_finish(a, ss, m0 + i16, kq == 0, gb_, rb_, tokb, tokr, tokw, hist);
    __syncthreads();
    if (F.tid < 24) __hip_atomic_store((int*)(F.ws + WS_WGCNT) + F.vcu * 24 + F.tid, hist[F.tid], __ATOMIC_RELAXED, __HIP_MEMORY_SCOPE_AGENT);
}
__device__ __forceinline__ void ph_place(const Ctx& F0) {
    const Ctx F = launder(F0);
    LAS int* ptot = (LAS int*)F.lds;
    LAS int* pbef = ptot + 512;
    LAS int* bstart = pbef + 512;
    LAS int* btot = bstart + 32;
    LAS int* carry = btot + 32;
    LAS int* rowidx = carry + 32;
    const int* wgcnt = (const int*)(F.ws + WS_WGCNT);
    int* rowtok = (int*)(F.ws + WS_ROWTOK); float* roww = (float*)(F.ws + WS_ROWW); int* tileb = (int*)(F.ws + WS_TILEB);
    const int* tokb = (const int*)(F.ws + WS_TOKB); const float* tokr = (const float*)(F.ws + WS_TOKR); const float* tokw = (const float*)(F.ws + WS_TOKW);
    { const int p = F.tid >> 5, b = F.tid & 31; int tot = 0, bef = 0;
      if (b < 24) for (int v = p * 16; v < p * 16 + 16; ++v) { const int c = wgcnt[v * 24 + b]; tot += c; if (v < F.vcu) bef += c; }
      ptot[p * 32 + b] = tot; pbef[p * 32 + b] = bef; }
    __syncthreads();
    if (F.tid < 32) { int tot = 0, bef = 0; for (int p = 0; p < 16; ++p) { tot += ptot[p * 32 + F.tid]; bef += pbef[p * 32 + F.tid]; } btot[F.tid] = tot; carry[F.tid] = bef; }
    __syncthreads();
    if (F.tid == 0) { int s = 0; for (int b = 0; b < 24; ++b) { bstart[b] = s; s += (btot[b] + 255) & ~255; } bstart[24] = s; }
    __syncthreads();
    if (F.tid < 24) carry[F.tid] += bstart[F.tid];
    if (F.vcu == 0) {
        if (F.tid == 0) tileb[0] = bstart[24] >> 8;
        for (int b = 0; b < 24; ++b) { const int s = bstart[b], e = bstart[b + 1];
            for (int t = (s >> 8) + F.tid; t < (e >> 8); t += NTHREADS) tileb[1 + t] = b;
            for (int r = s + btot[b] + F.tid; r < e; r += NTHREADS) __hip_atomic_store(rowtok + r, -1, __ATOMIC_RELAXED, __HIP_MEMORY_SCOPE_AGENT); }
    }
    __syncthreads();
    if (F.wave == 0) {
        for (int pass = 0; pass < 2; ++pass) { const int i = pass * 64 + F.lane, bi = tokb[F.vcu * 128 + i]; int row = 0;
#pragma unroll 1
            for (int b = 0; b < 24; ++b) { const unsigned long long mask = __ballot(bi == b); const int c = carry[b];
                if (bi == b) row = c + __builtin_popcountll(mask & ((1ull << F.lane) - 1ull));
                asm volatile("s_waitcnt lgkmcnt(0)" ::: "memory");
                if (F.lane == 0) carry[b] = c + __builtin_popcountll(mask);
                asm volatile("s_waitcnt lgkmcnt(0)" ::: "memory"); }
            rowidx[i] = row; }
    }
    __syncthreads();
    if (F.lane < 16) { const int li = F.wave * 16 + F.lane, m = F.vcu * 128 + li, row = rowidx[li];
        const float rstd = tokr[m];
        const unsigned long long w2 = (unsigned long long)__builtin_bit_cast(unsigned, tokw[2 * m]) | ((unsigned long long)__builtin_bit_cast(unsigned, tokw[2 * m + 1]) << 32);
        __hip_atomic_store(rowtok + row, m, __ATOMIC_RELAXED, __HIP_MEMORY_SCOPE_AGENT);
        __hip_atomic_store((unsigned long long*)(roww + 2 * row), w2, __ATOMIC_RELAXED, __HIP_MEMORY_SCOPE_AGENT);
        __hip_atomic_store((float*)(F.ws + WS_ROWR) + row, rstd, __ATOMIC_RELAXED, __HIP_MEMORY_SCOPE_AGENT); }
}
struct MoeOrder {
    int G, c; bool down; int NT, bks;
    __device__ __forceinline__ void init(const int* tileb) {
        const GAS int* tb_ = (const GAS int*)tileb;
        const int nt_ = tb_[0]; int r0 = c >> 2, r1 = (G + c) >> 2, r2 = (2 * G + c) >> 2, r3 = (3 * G + c) >> 2;
        r0 = r0 < MOE_MAXT ? r0 : MOE_MAXT - 1; r1 = r1 < MOE_MAXT ? r1 : MOE_MAXT - 1; r2 = r2 < MOE_MAXT ? r2 : MOE_MAXT - 1; r3 = r3 < MOE_MAXT ? r3 : MOE_MAXT - 1;
        const int b0 = tb_[1 + r0], b1 = tb_[1 + r1], b2 = tb_[1 + r2], b3 = tb_[1 + r3];
        int n_ = __builtin_amdgcn_readfirstlane(nt_), p_ = __builtin_amdgcn_readfirstlane((b0 & 255) | ((b1 & 255) << 8) | ((b2 & 255) << 16) | ((b3 & 255) << 24));
        asm volatile("" : "+s"(n_), "+s"(p_)); NT = n_; bks = p_;
    }
    __device__ __forceinline__ bool next(int i, pg8::Unit& u) const {
        const int L = i * G + c; if (i > 3 || L >= NT * 4) return false;
        const int rt = L >> 2, pn = L & 3, b = (bks >> (8 * i)) & 255;
        if (down) { u.pm = rt; u.pn = b * 4 + pn; u.aux = pn; }
        else { int ea, eb; pair_decode(b % 6, ea, eb); const int e = (b / 6) * 4 + (pn < 2 ? ea : eb); u.pm = rt; u.pn = e * 2 + (pn & 1); u.aux = pn; }
        return true;
    }
};
struct EpiGU {
    static constexpr bool PERM = true;
    bf16* H; const float* roww; const float* rowr;
    __device__ __forceinline__ void operator()(const f32x4 (&acc)[2][2][4][2], const pg8::Unit& u, int wr, int wc, int fr_, int fq_) const {
        const int ln_ = lane_id(), fr = ln_ & 15, fq = ln_ >> 4; (void)fr_; (void)fq_;
        const int row0 = u.pm * 256 + wr * 64 + fr, cl = u.aux * 128 + 16 * wc + 4 * fq, ws = u.aux >> 1;
#pragma unroll
        for (int ai = 0; ai < 2; ++ai)
#pragma unroll
            for (int m = 0; m < 4; ++m) { const int r = row0 + ai * 128 + m * 16; const float rr = rowr[r], w = roww[2 * r + ws] * rr;
#pragma unroll
                for (int bj = 0; bj < 2; ++bj) { const f32x4 g = acc[ai][bj][m][0], up = acc[ai][bj][m][1]; f32x4 a;
#pragma unroll
                    for (int i = 0; i < 4; ++i) { const float gg = g[i] * rr; a[i] = gg * sigmoidf_(gg) * up[i] * w; }
                    u32x2 o; o.x = pg8::cvt_pk_bf16(a[0], a[1]); o.y = pg8::cvt_pk_bf16(a[2], a[3]);
                    *(u32x2*)(H + (size_t)r * 512 + cl + bj * 64) = o; } }
    }
};
struct EpiDown {
    static constexpr bool PERM = true;
    bf16* RB; const int* rowtok;
    __device__ __forceinline__ void operator()(const f32x4 (&acc)[2][2][4][2], const pg8::Unit& u, int wr, int wc, int fr_, int fq_) const {
        const int ln_ = lane_id(), fr = ln_ & 15, fq = ln_ >> 4; (void)fr_; (void)fq_;
        const int row0 = u.pm * 256 + wr * 64 + fr, col0 = u.aux * 256 + wc * 32 + 8 * fq;
        int tok[8];
#pragma unroll
        for (int i = 0; i < 8; ++i) tok[i] = rowtok[row0 + (i >> 2) * 128 + (i & 3) * 16];
#pragma unroll
        for (int ai = 0; ai < 2; ++ai) { u32x4 x[4][2];
#pragma unroll
            for (int m = 0; m < 4; ++m) { const int tk = tok[ai * 4 + m]; const bf16* rp = RB + (size_t)(tk < 0 ? 0 : tk) * D + col0; x[m][0] = *(const u32x4*)rp; x[m][1] = *(const u32x4*)(rp + 128); }
#pragma unroll
            for (int m = 0; m < 4; ++m) { const int tk = tok[ai * 4 + m]; bf16* rp = RB + (size_t)(tk < 0 ? 0 : tk) * D + col0;
#pragma unroll
                for (int bj = 0; bj < 2; ++bj) { const u32x4 xx = x[m][bj]; const f32x4 a0 = acc[ai][bj][m][0], a1 = acc[ai][bj][m][1]; u32x4 w;
                    w.x = pg8::cvt_pk_bf16(bf2f(xx.x & 0xffffu) + a0[0], bf2f(xx.x >> 16) + a0[1]); w.y = pg8::cvt_pk_bf16(bf2f(xx.y & 0xffffu) + a0[2], bf2f(xx.y >> 16) + a0[3]);
                    w.z = pg8::cvt_pk_bf16(bf2f(xx.z & 0xffffu) + a1[0], bf2f(xx.z >> 16) + a1[1]); w.w = pg8::cvt_pk_bf16(bf2f(xx.w & 0xffffu) + a1[2], bf2f(xx.w >> 16) + a1[3]);
                    if (tk >= 0) *(u32x4*)(rp + bj * 128) = w; } }
            asm volatile("" ::: "memory"); }
    }
};

struct SsmOrder { int G, c, mode;
    __device__ __forceinline__ bool next(int i, pg8::Unit& u) const { const int L = i * G + c;
        if (mode == 1) { if (L >= 32) return false; u.pm = L; u.pn = L >> 1; u.aux = 0; return true; }
        if (L >= 128) return false; const int g = L >> 3; u.pm = g * 2 + ((L >> 2) & 1); u.pn = g * 4 + (L & 3); u.aux = L & 3; u.kt = 2 + 4 * ((L & 3) + 1); return true; } };
struct HalfOrder { int L;
    __device__ __forceinline__ bool next(int i, pg8::Unit& u) const { if (i > 0 || L < 0 || L >= 128) return false; u.pm = L; u.pn = 0; u.aux = 0; return true; } };
struct EpiZ { static constexpr bool PERM = false; float* ZB;
    __device__ __forceinline__ void operator()(const f32x4 (&acc)[2][2][4][2], const pg8::Unit& u, int wr, int wc, int fr_, int fq_) const {
        const int ln_ = lane_id(), fr = ln_ & 15, fq = ln_ >> 4; (void)fr_; (void)fq_;
        const int row0 = u.pm * 256 + wr * 64 + fr, col0 = wc * 32 + 4 * fq;
#pragma unroll
        for (int ai = 0; ai < 2; ++ai)
#pragma unroll
            for (int m = 0; m < 4; ++m)
#pragma unroll
                for (int n = 0; n < 2; ++n) *(f32x4*)(ZB + (size_t)(row0 + ai * 128 + m * 16) * 128 + col0 + n * 16) = acc[ai][0][m][n];
    } };
struct EpiSsm2 { static constexpr bool PERM = true; const bf16* UG; bf16* YS; const float* dvec;
    __device__ __forceinline__ void operator()(const f32x4 (&acc)[2][2][4][2], const pg8::Unit& u, int wr, int wc, int fr_, int fq_) const {
        const int ln_ = lane_id(), fr = ln_ & 15, fq = ln_ >> 4; (void)fr_; (void)fq_;
        const int g = u.pm >> 1, cr0 = (u.pm & 1) * 256 + wr * 64 + fr;
#pragma unroll
        for (int bj = 0; bj < 2; ++bj) { const int n0 = u.aux * 256 + bj * 128 + wc * 32 + 8 * fq, to = n0 >> 4, ho0 = n0 & 15;
            const f32x4 d0 = *(const f32x4*)(dvec + g * 16 + ho0), d1 = *(const f32x4*)(dvec + g * 16 + ho0 + 4);
#pragma unroll
            for (int ai = 0; ai < 2; ++ai)
#pragma unroll
                for (int m = 0; m < 4; ++m) { const int cr = cr0 + ai * 128 + m * 16;
                    const u32x4 uu = *(const u32x4*)(UG + ((size_t)(g * 512 + cr)) * UGP + UOF + n0);
                    const f32x4 a0 = acc[ai][bj][m][0], a1 = acc[ai][bj][m][1]; float y[8];
                    y[0] = gelu_tanh(a0[0] + d0[0] * bf2f(uu.x & 0xffffu)); y[1] = gelu_tanh(a0[1] + d0[1] * bf2f(uu.x >> 16));
                    y[2] = gelu_tanh(a0[2] + d0[2] * bf2f(uu.y & 0xffffu)); y[3] = gelu_tanh(a0[3] + d0[3] * bf2f(uu.y >> 16));
                    y[4] = gelu_tanh(a1[0] + d1[0] * bf2f(uu.z & 0xffffu)); y[5] = gelu_tanh(a1[1] + d1[1] * bf2f(uu.z >> 16));
                    y[6] = gelu_tanh(a1[2] + d1[2] * bf2f(uu.w & 0xffffu)); y[7] = gelu_tanh(a1[3] + d1[3] * bf2f(uu.w >> 16));
                    u32x4 w; w.x = pg8::cvt_pk_bf16(y[0], y[1]); w.y = pg8::cvt_pk_bf16(y[2], y[3]); w.z = pg8::cvt_pk_bf16(y[4], y[5]); w.w = pg8::cvt_pk_bf16(y[6], y[7]);
                    *(u32x4*)(YS + ((size_t)cr * 64 + to) * 256 + g * 16 + ho0) = w; } }
    } };
struct EpiGluE { static constexpr bool PERM = true; const bf16* YS; bf16* YMIX; const float* gb;
    __device__ __forceinline__ void operator()(const f32x4 (&acc)[2][2][4][2], const pg8::Unit& u, int wr, int wc, int fr_, int fq_) const {
        const int ln_ = lane_id(), fr = ln_ & 15, fq = ln_ >> 4; (void)fr_; (void)fq_;
        const int row0 = u.pm * 256 + wr * 64 + fr;
#pragma unroll
        for (int bj = 0; bj < 2; ++bj) { const int n0 = bj * 128 + wc * 32 + 8 * fq; const f32x4 b0 = *(const f32x4*)(gb + n0), b1 = *(const f32x4*)(gb + n0 + 4);
#pragma unroll
            for (int ai = 0; ai < 2; ++ai)
#pragma unroll
                for (int m = 0; m < 4; ++m) { const size_t r = (size_t)(row0 + ai * 128 + m * 16); const u32x4 yy = *(const u32x4*)(YS + r * 256 + n0);
                    const f32x4 a0 = acc[ai][bj][m][0] + b0, a1 = acc[ai][bj][m][1] + b1; float o[8];
                    o[0] = bf2f(yy.x & 0xffffu) * sigmoidf_(a0[0]); o[1] = bf2f(yy.x >> 16) * sigmoidf_(a0[1]); o[2] = bf2f(yy.y & 0xffffu) * sigmoidf_(a0[2]); o[3] = bf2f(yy.y >> 16) * sigmoidf_(a0[3]);
                    o[4] = bf2f(yy.z & 0xffffu) * sigmoidf_(a1[0]); o[5] = bf2f(yy.z >> 16) * sigmoidf_(a1[1]); o[6] = bf2f(yy.w & 0xffffu) * sigmoidf_(a1[2]); o[7] = bf2f(yy.w >> 16) * sigmoidf_(a1[3]);
                    u32x4 w; w.x = pg8::cvt_pk_bf16(o[0], o[1]); w.y = pg8::cvt_pk_bf16(o[2], o[3]); w.z = pg8::cvt_pk_bf16(o[4], o[5]); w.w = pg8::cvt_pk_bf16(o[6], o[7]);
                    *(u32x4*)(YMIX + r * 1024 + n0) = w; } }
    } };
struct EpiPoolE { static constexpr bool PERM = true; bf16* YMIX; const float* pb; const float* ps;
    __device__ __forceinline__ void operator()(const f32x4 (&acc)[2][2][4][2], const pg8::Unit& u, int wr, int wc, int fr_, int fq_) const {
        const int ln_ = lane_id(), fr = ln_ & 15, fq = ln_ >> 4; (void)fr_; (void)fq_;
        const int row0 = u.pm * 256 + wr * 64 + fr;
#pragma unroll
        for (int bj = 0; bj < 2; ++bj) { const int n0 = bj * 128 + wc * 32 + 8 * fq; const f32x4 b0 = *(const f32x4*)(pb + n0), b1 = *(const f32x4*)(pb + n0 + 4), s0 = *(const f32x4*)(ps + n0), s1 = *(const f32x4*)(ps + n0 + 4);
#pragma unroll
            for (int ai = 0; ai < 2; ++ai)
#pragma unroll
                for (int m = 0; m < 4; ++m) { const size_t r = (size_t)(row0 + ai * 128 + m * 16);
                    const f32x4 a0 = (acc[ai][bj][m][0] + b0) * s0, a1 = (acc[ai][bj][m][1] + b1) * s1;
                    u32x4 w; w.x = pg8::cvt_pk_bf16(a0[0], a0[1]); w.y = pg8::cvt_pk_bf16(a0[2], a0[3]); w.z = pg8::cvt_pk_bf16(a1[0], a1[1]); w.w = pg8::cvt_pk_bf16(a1[2], a1[3]);
                    *(u32x4*)(YMIX + r * 1024 + 256 + n0) = w; } }
    } };
__device__ __forceinline__ void ph_tg_expand(const Ctx& F0, int l, int bx, int w0) {
    const Ctx F = launder(F0);
    if (bx < w0) return;
    const int gw = (bx - w0) * NWAVES + F.wave, NGW = (F.G - w0) * NWAVES;
    const bf16* KT = (const bf16*)(F.ws + WS_KT) + (size_t)l * SGN * 64 * 256;
    bf16* TG0 = (bf16*)(F.ws + WS_TG) + (size_t)l * SGN * 1024 * UGP;
#pragma unroll 2
    for (int r = gw; r < SGN * 1024; r += NGW) { const int g = r >> 10, n = r & 1023, to = n >> 4, ho = n & 15;
        bf16* d = TG0 + ((size_t)g * 1024 + n) * UGP;
#pragma unroll
        for (int half = 0; half < 2; ++half) { const int ti = half * 32 + (F.lane >> 1), tau = to - ti;
            u32x4 v = (u32x4){0u, 0u, 0u, 0u};
            if (tau >= 0) v = *(const u32x4*)(KT + (((size_t)g * 64 + tau) * 16 + ho) * 16 + (F.lane & 1) * 8);
            if (half * 512 + F.lane * 8 < ((n >> 8) + 1) * 256) *(u32x4*)(d + UOF + half * 512 + F.lane * 8) = v; } }
}
__device__ __forceinline__ void ph_ssm_scan(const Ctx& F0, int l) {
    const Ctx F = launder(F0);
    if (F.wave != 0 || (F.vcu & 1) != 0 || F.vcu >= 256) return;
    for (int it = (F.vcu >> 2) * 2 + ((F.vcu >> 1) & 1); it < SGN * NB; it += SGN * NB) {
        const int g = it >> 3, b = it & 7, p = F.lane;
        const float are = F.in[4][(l * SGN + g) * SP + p], aim = F.in[5][(l * SGN + g) * SP + p], dt = expf(F.in[6][l * SGN + g]);
        float sn, cs; sincosf(aim * dt * 64.f, &sn, &cs); const float mg = expf(are * dt * 64.f), lr = mg * cs, li = mg * sn;
        const float* Z = (const float*)(F.ws + WS_ZB) + ((size_t)g * 512 + b * 64) * 128;
        bf16* U = P_UG(F) + ((size_t)g * 512 + b * 64) * UGP;
        float sr = 0.f, si = 0.f;
#pragma unroll 1
        for (int c0 = 0; c0 < 64; c0 += 32) {
            float zr[32], zi[32];
#pragma unroll
            for (int j = 0; j < 32; ++j) { zr[j] = Z[(c0 + j) * 128 + p]; zi[j] = Z[(c0 + j) * 128 + 64 + p]; }
#pragma unroll
            for (int j = 0; j < 32; ++j) {
                U[(size_t)(c0 + j) * UGP + p] = (bf16)f2bf(sr); U[(size_t)(c0 + j) * UGP + 64 + p] = (bf16)f2bf(si);
                const float nr = lr * sr - li * si + zr[j], ni = lr * si + li * sr + zi[j]; sr = nr; si = ni; }
        }
    }
}

namespace moba {
using bf16x8 = __attribute__((ext_vector_type(8))) short;
using s16x4 = __attribute__((ext_vector_type(4))) short;
using f32x16 = __attribute__((ext_vector_type(16))) float;
typedef short v4i16_t __attribute__((ext_vector_type(4)));
typedef float f32x2_t __attribute__((ext_vector_type(2))); typedef __bf16 bf16x2_t __attribute__((ext_vector_type(2)));
constexpr int L_K = 0, L_V = 49152, L_TB = 98304, L_KM = L_TB + 4 * 768 * 4, L_END = L_KM + 16 * 64 * 4;
__device__ __forceinline__ unsigned cvtpk(float lo, float hi) { f32x2_t v = {lo, hi}; bf16x2_t b = __builtin_convertvector(v, bf16x2_t); return __builtin_bit_cast(unsigned, b); }
__device__ __forceinline__ s16x4 vtr(const LAS char* p) { return __builtin_bit_cast(s16x4, __builtin_amdgcn_ds_read_tr16_b64_v4i16((LAS v4i16_t*)p)); }
__device__ __forceinline__ float hmax(float v) { const unsigned u = __builtin_bit_cast(unsigned, v); auto r = __builtin_amdgcn_permlane32_swap(u, u, false, false); return fmaxf(__builtin_bit_cast(float, (unsigned)r[0]), __builtin_bit_cast(float, (unsigned)r[1])); }
__device__ __forceinline__ float hsum(float v) { const unsigned u = __builtin_bit_cast(unsigned, v); auto r = __builtin_amdgcn_permlane32_swap(u, u, false, false); return __builtin_bit_cast(float, (unsigned)r[0]) + __builtin_bit_cast(float, (unsigned)r[1]); }

constexpr int L_LIST = L_END, L_WCNT = 32768;
#define MOBA_CVEC() f32x16 cvec; do { const float ci_ = bfar - mref; _Pragma("unroll") for (int r = 0; r < 16; ++r) cvec[r] = ci_; } while (0)
#define MOBA_QK(P0, P1, KB) do { { const bf16x8 a0 = *(const LAS bf16x8*)(kp0 + (KB)), a1 = *(const LAS bf16x8*)(kp0 + (KB) + 512); \
          P0 = __builtin_amdgcn_mfma_f32_32x32x16_bf16(a0, qr[0], cvec, 0, 0, 0); P1 = __builtin_amdgcn_mfma_f32_32x32x16_bf16(a1, qr[0], cvec, 0, 0, 0); } \
        _Pragma("unroll") for (int d0 = 1; d0 < 4; ++d0) { const bf16x8 a0 = *(const LAS bf16x8*)(kp0 + (KB) + d0 * 2048), a1 = *(const LAS bf16x8*)(kp0 + (KB) + d0 * 2048 + 512); \
            P0 = __builtin_amdgcn_mfma_f32_32x32x16_bf16(a0, qr[d0], P0, 0, 0, 0); P1 = __builtin_amdgcn_mfma_f32_32x32x16_bf16(a1, qr[d0], P1, 0, 0, 0); } } while (0)
#define MOBA_NEARMAX(P0, P1, JN, OUT) do { const int jn_ = (JN); if (jn_ >= 0) { const int A_ = qrel - 64 * (jn_ - 4) - 4 * hi + 256, s_ = 767 - A_, c_ = s_ & 3; \
            const LAS f32x4* t4 = (const LAS f32x4*)(tb + c_ * 768 + (s_ - c_)); \
            _Pragma("unroll") for (int g = 0; g < 4; ++g) { const f32x4 x0 = t4[2 * g], x1 = t4[2 * g + 8]; \
                _Pragma("unroll") for (int j = 0; j < 4; ++j) { P0[4 * g + j] += x0[j]; P1[4 * g + j] += x1[j]; } } } \
        float ra = __builtin_fmaxf(__builtin_fmaxf(P0[0], P0[1]), P1[0]), rb = __builtin_fmaxf(__builtin_fmaxf(P0[2], P0[3]), P1[1]); \
        ra = __builtin_fmaxf(__builtin_fmaxf(ra, P1[2]), P1[3]); \
        _Pragma("unroll") for (int r = 4; r < 16; r += 4) { ra = __builtin_fmaxf(__builtin_fmaxf(ra, P0[r]), P0[r + 1]); rb = __builtin_fmaxf(__builtin_fmaxf(rb, P0[r + 2]), P0[r + 3]); \
            ra = __builtin_fmaxf(__builtin_fmaxf(ra, P1[r]), P1[r + 1]); rb = __builtin_fmaxf(__builtin_fmaxf(rb, P1[r + 2]), P1[r + 3]); } \
        OUT = hmax(__builtin_fmaxf(ra, rb)); } while (0)
#define MOBA_STEP(PC0, PC1, PN0, PN1, JNN, KBN, VBC, HASN) do { \
        bf16x8 vf[8], kf[8]; \
        if (HASN) { _Pragma("unroll") for (int d0 = 0; d0 < 4; ++d0) { kf[2 * d0] = *(const LAS bf16x8*)(kp0 + (KBN) + d0 * 2048); kf[2 * d0 + 1] = *(const LAS bf16x8*)(kp0 + (KBN) + d0 * 2048 + 512); } } \
        __builtin_amdgcn_sched_barrier(0); \
        if (__any(rm > 8.f)) { const float dl = __builtin_fmaxf(rm, 0.f), alpha = __builtin_amdgcn_exp2f(-dl); mref += dl; l *= alpha; \
            _Pragma("unroll") for (int r = 0; r < 16; ++r) { PC0[r] -= dl; PC1[r] -= dl; o0[r] *= alpha; o1[r] *= alpha; } } \
        if (HASN) { MOBA_CVEC(); \
                    PN0 = __builtin_amdgcn_mfma_f32_32x32x16_bf16(kf[0], qr[0], cvec, 0, 0, 0); PN1 = __builtin_amdgcn_mfma_f32_32x32x16_bf16(kf[1], qr[0], cvec, 0, 0, 0); \
                    _Pragma("unroll") for (int d0 = 1; d0 < 4; ++d0) { PN0 = __builtin_amdgcn_mfma_f32_32x32x16_bf16(kf[2 * d0], qr[d0], PN0, 0, 0, 0); PN1 = __builtin_amdgcn_mfma_f32_32x32x16_bf16(kf[2 * d0 + 1], qr[d0], PN1, 0, 0, 0); } } \
        { const LAS char* vp = vp0 + (VBC); \
        _Pragma("unroll") for (int k = 0; k < 4; ++k) { \
            const s16x4 lo0 = vtr(vp + k * 1024), hi0 = vtr(vp + k * 1024 + 512), lo1 = vtr(vp + 4096 + k * 1024), hi1 = vtr(vp + 4096 + k * 1024 + 512); \
            vf[2 * k] = (bf16x8){lo0[0], lo0[1], lo0[2], lo0[3], hi0[0], hi0[1], hi0[2], hi0[3]}; vf[2 * k + 1] = (bf16x8){lo1[0], lo1[1], lo1[2], lo1[3], hi1[0], hi1[1], hi1[2], hi1[3]}; } } \
        __builtin_amdgcn_sched_barrier(0); \
        float s0 = 0.f, s1 = 0.f; u32x4 pw[4]; \
        _Pragma("unroll") for (int r = 0; r < 16; ++r) { PC0[r] = __builtin_amdgcn_exp2f(PC0[r]); PC1[r] = __builtin_amdgcn_exp2f(PC1[r]); s0 += PC0[r]; s1 += PC1[r]; } \
        l += s0 + s1; \
        _Pragma("unroll") for (int q = 0; q < 4; ++q) { pw[0][q] = cvtpk(PC0[2 * q], PC0[2 * q + 1]); pw[1][q] = cvtpk(PC0[8 + 2 * q], PC0[9 + 2 * q]); pw[2][q] = cvtpk(PC1[2 * q], PC1[2 * q + 1]); pw[3][q] = cvtpk(PC1[8 + 2 * q], PC1[9 + 2 * q]); } \
        _Pragma("unroll") for (int k = 0; k < 4; ++k) { const bf16x8 pa = __builtin_bit_cast(bf16x8, pw[k]); \
            o0 = __builtin_amdgcn_mfma_f32_32x32x16_bf16(vf[2 * k], pa, o0, 0, 0, 0); o1 = __builtin_amdgcn_mfma_f32_32x32x16_bf16(vf[2 * k + 1], pa, o1, 0, 0, 0); } \
        if (HASN) MOBA_NEARMAX(PN0, PN1, JNN, rm); \
    } while (0)
#define MOBA_BLOCK4(JN0, PRE4) \
    float mref = 0.f, l = 0.f; f32x16 o0 = f32x16{}, o1 = f32x16{}; f32x16 pa0, pa1, pb0, pb1; float rm; \
    { const int jn0_ = (JN0); \
      { MOBA_CVEC(); MOBA_QK(pa0, pa1, 0); } MOBA_NEARMAX(pa0, pa1, jn0_, rm); \
      MOBA_STEP(pa0, pa1, pb0, pb1, (jn0_ < 0 ? -1 : jn0_ + 1), 8192, 0, true); \
      MOBA_STEP(pb0, pb1, pa0, pa1, (jn0_ < 0 ? -1 : jn0_ + 2), 16384, 8192, true); \
      MOBA_STEP(pa0, pa1, pb0, pb1, (jn0_ < 0 ? -1 : jn0_ + 3), 24576, 16384, true); \
      PRE4; \
      MOBA_STEP(pb0, pb1, pa0, pa1, -1, 0, 24576, false); }
__device__ __forceinline__ void load_block(const bf16* K, const bf16* V, size_t row0, int h, int wid, int lane, LAS char* lds) {
    const bf16* ksrc = K + (row0 + lane) * 512 + h * 64 + wid * 8;
    const bf16* vsrc = V + (row0 + 16 * (wid & 3) + (lane >> 2)) * 512 + h * 64 + (wid >> 2) * 32 + (lane & 3) * 8;
    u32x4 kr[4], vr[4];
#pragma unroll
    for (int t = 0; t < 4; ++t) { kr[t] = *(const u32x4*)(ksrc + (size_t)t * 64 * 512); vr[t] = *(const u32x4*)(vsrc + (size_t)t * 64 * 512); }
    LAS char* kd = lds + L_K + wid * 1024 + lane * 16; LAS char* vd = lds + L_V + wid * 1024 + lane * 16;
#pragma unroll
    for (int t = 0; t < 4; ++t) { *(LAS u32x4*)(kd + t * 8192) = kr[t]; *(LAS u32x4*)(vd + t * 8192) = vr[t]; }
}
__device__ __forceinline__ void fill_bias_table(const float* BT, int h, int tid, LAS float* tb) {
    const float bfar = BT[h * 132 + 128];
    for (int i = tid; i < 4 * 768; i += NTHREADS) { const int c = i / 768, j = i % 768, src_ = 767 - (j + c), rel = src_ - 256; tb[i] = (src_ < 0 || rel < 0) ? -1.0e30f : (rel < 128 ? BT[h * 132 + rel] - bfar : 0.f); }
}
__device__ __forceinline__ void sel_phase(int wave_, int vcu, int G, const bf16* Q, const float* KMP, unsigned* SEL, LAS char* lds) {
    const int w0 = G > 64 ? 32 : 0, nw = G - w0; if (vcu < w0) return;
    int lane_ = lane_id(); asm volatile("" : "+v"(lane_)); asm volatile("" : "+s"(wave_));
    const int wid = wave_, lane = lane_, tid = wid * 64 + lane, r32 = lane & 31, hi = lane >> 5;
    const int ub = ((vcu - w0) * 1024) / nw, ue = ((vcu - w0 + 1) * 1024) / nw;
    LAS float* km = (LAS float*)(lds + L_KM);
    int bhc = -1;
#pragma unroll 1
    for (int u = ub; u < ue; ++u) {
        const int bh = u >> 4, qb = u & 15, b = bh >> 3, h = bh & 7;
        if (bh != bhc) { bhc = bh;
            __syncthreads();
            for (int i = tid; i < 16 * 64; i += NTHREADS) { const int j = i >> 6, d = i & 63, pm = b * 16 + j; km[i] = KMP[pm * 512 + h * 64 + d] + KMP[128 * 512 + pm * 512 + h * 64 + d]; }
            __syncthreads(); }
        asm volatile("" ::: "memory");
        const int q = qb * 256 + wid * 32 + r32;
        const bf16* qw = Q + ((size_t)b * SEQ + q) * 512 + h * 64 + hi * 8;
        bf16x8 qr[4];
#pragma unroll
        for (int d0 = 0; d0 < 4; ++d0) qr[d0] = *(const bf16x8*)(qw + d0 * 16);
        float g[16];
#pragma unroll
        for (int j = 0; j < 16; ++j) g[j] = 0.f;
#pragma unroll
        for (int d0 = 0; d0 < 4; ++d0)
#pragma unroll
            for (int j = 0; j < 16; ++j) { const f32x4 ka = *(const LAS f32x4*)(km + j * 64 + d0 * 16 + hi * 8), kb4 = *(const LAS f32x4*)(km + j * 64 + d0 * 16 + hi * 8 + 4);
#pragma unroll
                for (int e = 0; e < 4; ++e) { g[j] += bf2f((unsigned)(unsigned short)qr[d0][e]) * ka[e]; }
#pragma unroll
                for (int e = 0; e < 4; ++e) { g[j] += bf2f((unsigned)(unsigned short)qr[d0][4 + e]) * kb4[e]; } }
#pragma unroll
        for (int j = 0; j < 16; ++j) g[j] = hsum(g[j]);
        unsigned selmask = 0u;
#pragma unroll
        for (int s3 = 0; s3 < 3; ++s3) { float bv = -3.0e38f; int bi = -1;
#pragma unroll
            for (int j = 0; j < 16; ++j) { const bool ok = (j < qb) && !((selmask >> j) & 1u) && (g[j] > bv); bv = ok ? g[j] : bv; bi = ok ? j : bi; }
            if (bi >= 0) selmask |= 1u << bi; }
        if (hi == 0) SEL[(size_t)bh * SEQ + q] = selmask;
    }
}
__device__ __forceinline__ bf16* pslot(int slot, size_t t, int h, bf16* YM, bf16* P2A, bf16* P2B) {
    return slot == 0 ? YM + t * 1024 + h * 64 : slot == 1 ? YM + t * 1024 + 512 + h * 64 : (t < (size_t)(T / 2) ? P2A + t * 512 : P2B + (t - (size_t)(T / 2)) * 512) + h * 64;
}
__device__ __forceinline__ void gather_phase(int wave_, int vcu, const bf16* Q, const bf16* K, const bf16* V, bf16* YM, bf16* P2A, bf16* P2B, float* ML, const unsigned* SEL, const float* BT, LAS char* lds) {
    if (vcu >= 256) return;
    int lane_ = lane_id(); asm volatile("" : "+v"(lane_)); asm volatile("" : "+s"(wave_));
    const int wid = wave_, lane = lane_, tid = wid * 64 + lane, r32 = lane & 31, hi = lane >> 5;
    const int bh = vcu >> 2, s = vcu & 3, b = bh >> 3, h = bh & 7;
    const size_t rowbase = (size_t)b * SEQ;
    LAS float* tb = (LAS float*)(lds + L_TB); LAS int* list = (LAS int*)(lds + L_LIST); LAS int* wcnt = (LAS int*)(lds + L_WCNT);
    const float bfar = BT[h * 132 + 128];
    fill_bias_table(BT, h, tid, tb);
    const unsigned* selrow = SEL + (size_t)bh * SEQ;
    const LAS char* kp0 = lds + L_K + hi * 1024 + r32 * 16;
    const LAS char* vp0 = lds + L_V + ((lane >> 4) & 1) * 32 + (lane & 3) * 8 + (4 * hi + ((lane & 15) >> 2)) * 64;
    const unsigned code = s == 0 ? 0xFFFA70u : s == 1 ? 0xFFE961u : s == 2 ? 0xFFFB32u : 0xFDC854u;
    u32x4 kr[4], vr[4]; unsigned msel[8];
#define MOBA_GFETCH(KB) do { const size_t row0 = rowbase + (size_t)(KB) * 256; int lg_ = lane_id(); asm volatile("" : "+v"(lg_));     \
        const bf16* ksrc = K + (row0 + lg_) * 512 + h * 64 + wid * 8; \
        const bf16* vsrc = V + (row0 + 16 * (wid & 3) + (lg_ >> 2)) * 512 + h * 64 + (wid >> 2) * 32 + (lg_ & 3) * 8; \
        _Pragma("unroll") for (int t = 0; t < 4; ++t) { kr[t] = *(const u32x4*)(ksrc + (size_t)t * 64 * 512); vr[t] = *(const u32x4*)(vsrc + (size_t)t * 64 * 512); } \
        const int qs_ = ((KB) + 1) * 256, R_ = (SEQ - qs_) >> 3; \
        _Pragma("unroll") for (int i = 0; i < 8; ++i) { const int off = i * 64 + lg_; msel[i] = off < R_ ? selrow[qs_ + wid * R_ + off] : 0u; } } while (0)
    MOBA_GFETCH((int)(code & 15u));
#pragma unroll 1
    for (int ik = 0; ik < 6; ++ik) {
        const int kb = (int)((code >> (4 * ik)) & 15u); if (kb == 15) break;
        const int kbn = (int)((code >> (4 * ik + 4)) & 15u);
        __syncthreads();
        { LAS char* kd = lds + L_K + wid * 1024 + lane * 16; LAS char* vd = lds + L_V + wid * 1024 + lane * 16;
#pragma unroll
          for (int t = 0; t < 4; ++t) { *(LAS u32x4*)(kd + t * 8192) = kr[t]; *(LAS u32x4*)(vd + t * 8192) = vr[t]; } }
        const int qs = (kb + 1) * 256, R = (SEQ - qs) >> 3;
        unsigned long long bal[8]; int cnt = 0;
#pragma unroll
        for (int i = 0; i < 8; ++i) { bal[i] = __ballot((msel[i] >> kb) & 1u); cnt += __builtin_popcountll(bal[i]); }
        if (lane == 0) wcnt[wid] = cnt;
        __syncthreads();
        int base = 0, n = 0;
#pragma unroll
        for (int w = 0; w < 8; ++w) { const int c = wcnt[w]; n += c; base += (w < wid) ? c : 0; }
#pragma unroll
        for (int i = 0; i < 8; ++i) { const unsigned long long m = bal[i];
            if ((m >> lane) & 1ull) list[base + __builtin_popcountll(m & ((1ull << lane) - 1ull))] = qs + wid * R + i * 64 + lane;
            base += __builtin_popcountll(m); }
        __syncthreads();
        const int ntask = (n + 31) >> 5;
        int tk = wid, qin = 0; bool vn = false; unsigned smn = 0u; bf16x8 qn[4];
#define MOBA_QFETCH() do { const int li_ = tk * 32 + r32; vn = li_ < n; { const int lv_ = list[vn ? li_ : (n > 0 ? n - 1 : 0)]; qin = n > 0 ? lv_ : qs; } smn = selrow[qin]; \
            const bf16* qw = Q + (rowbase + qin) * 512 + h * 64 + hi * 8; \
            _Pragma("unroll") for (int d0 = 0; d0 < 4; ++d0) qn[d0] = *(const bf16x8*)(qw + d0 * 16); } while (0)
        MOBA_QFETCH();
#pragma unroll 1
        while (tk < ntask) {
            const int qi = qin; const bool valid = vn; const unsigned sm = smn;
            bf16x8 qr[4];
#pragma unroll
            for (int d0 = 0; d0 < 4; ++d0) qr[d0] = qn[d0];
            tk += 8;
            const int slot = __builtin_popcount(sm & ((1u << kb) - 1u));
            const int qd = qi - qs, qrel = qd < 255 ? qd : 255;
            const bool nearw = __any(qd < 128);
            MOBA_BLOCK4(nearw ? 0 : -1, MOBA_QFETCH())
            const float lt = hsum(l), inv = 1.f / lt; const size_t t = rowbase + qi;
            bf16* orow = pslot(slot, t, h, YM, P2A, P2B) + 8 * hi;
#pragma unroll
            for (int d0 = 0; d0 < 2; ++d0)
#pragma unroll
                for (int gp = 0; gp < 2; ++gp) { const f32x16& oo = d0 ? o1 : o0; const int ga = 8 * gp, gb = 8 * gp + 4;
                    unsigned ax = cvtpk(oo[ga] * inv, oo[ga + 1] * inv), ay = cvtpk(oo[ga + 2] * inv, oo[ga + 3] * inv), bx = cvtpk(oo[gb] * inv, oo[gb + 1] * inv), by = cvtpk(oo[gb + 2] * inv, oo[gb + 3] * inv);
                    { auto r = __builtin_amdgcn_permlane32_swap(ax, bx, false, false); ax = r[0]; bx = r[1]; }
                    { auto r = __builtin_amdgcn_permlane32_swap(ay, by, false, false); ay = r[0]; by = r[1]; }
                    if (valid) *(u32x4*)(orow + 32 * d0 + 16 * gp) = (u32x4){ax, ay, bx, by}; }
            if (valid && hi == 0) { float* ml = ML + ((t * 8 + h) * 3 + slot) * 2; ml[0] = mref; ml[1] = lt; }
        }
#undef MOBA_QFETCH
        MOBA_GFETCH(kbn);
    }
#undef MOBA_GFETCH
}
__device__ __forceinline__ void diag_unit(int wid, int lane, int b, int h, int qb, const bf16* Q, const bf16* K, const bf16* V, bf16* YM, const bf16* P2A, const bf16* P2B, const float* ML, float bfar, LAS char* lds) {
    const int r32 = lane & 31, hi = lane >> 5; const size_t rowbase = (size_t)b * SEQ;
    LAS float* tb = (LAS float*)(lds + L_TB);
    const LAS char* kp0 = lds + L_K + hi * 1024 + r32 * 16;
    const LAS char* vp0 = lds + L_V + ((lane >> 4) & 1) * 32 + (lane & 3) * 8 + (4 * hi + ((lane & 15) >> 2)) * 64;
    __syncthreads();
    load_block(K, V, rowbase + (size_t)qb * 256, h, wid, lane, lds);
    const int qrel = wid * 32 + r32; const size_t t = rowbase + qb * 256 + qrel;
    bf16x8 qr[4];
    { const bf16* qw = Q + t * 512 + h * 64 + hi * 8;
#pragma unroll
      for (int d0 = 0; d0 < 4; ++d0) qr[d0] = *(const bf16x8*)(qw + d0 * 16); }
    __syncthreads();
    MOBA_BLOCK4(4, (void)0)
    const int nsl = qb < 3 ? qb : 3;
    const float* ml = ML + (t * 8 + h) * 6;
    const bf16* pA = YM + t * 1024 + h * 64 + 8 * hi; const bf16* pB = YM + t * 1024 + 512 + h * 64 + 8 * hi;
    const bf16* pC = (t < (size_t)(T / 2) ? P2A + t * 512 : P2B + (t - (size_t)(T / 2)) * 512) + h * 64 + 8 * hi;
    float m0 = -3.0e38f, m1 = -3.0e38f, m2 = -3.0e38f, l0 = 0.f, l1 = 0.f, l2 = 0.f;
    u32x4 xA[4], xB[4], xC[4];
#pragma unroll
    for (int c = 0; c < 4; ++c) { xA[c] = (u32x4){0u, 0u, 0u, 0u}; xB[c] = xA[c]; xC[c] = xA[c]; }
    if (nsl > 0) { m0 = ml[0]; l0 = ml[1];
#pragma unroll
        for (int c = 0; c < 4; ++c) xA[c] = *(const u32x4*)(pA + 16 * c); }
    if (nsl > 1) { m1 = ml[2]; l1 = ml[3];
#pragma unroll
        for (int c = 0; c < 4; ++c) xB[c] = *(const u32x4*)(pB + 16 * c); }
    if (nsl > 2) { m2 = ml[4]; l2 = ml[5];
#pragma unroll
        for (int c = 0; c < 4; ++c) xC[c] = *(const u32x4*)(pC + 16 * c); }
    const float M = __builtin_fmaxf(__builtin_fmaxf(mref, m0), __builtin_fmaxf(m1, m2));
    const float w0 = __builtin_amdgcn_exp2f(mref - M), wa = l0 * __builtin_amdgcn_exp2f(m0 - M), wb = l1 * __builtin_amdgcn_exp2f(m1 - M), wc = l2 * __builtin_amdgcn_exp2f(m2 - M);
    const float inv = 1.f / (hsum(l) * w0 + wa + wb + wc);
    const float s0 = w0 * inv, sa = wa * inv, sb = wb * inv, sc = wc * inv;
    bf16* orow = YM + t * 1024 + 512 + h * 64 + 8 * hi;
#pragma unroll
    for (int d0 = 0; d0 < 2; ++d0)
#pragma unroll
        for (int gp = 0; gp < 2; ++gp) { const f32x16& oo = d0 ? o1 : o0; const int ga = 8 * gp, gb = 8 * gp + 4, dof = 32 * d0 + 16 * gp, cc = 2 * d0 + gp;
            float a0 = oo[ga] * s0, a1 = oo[ga + 1] * s0, a2 = oo[ga + 2] * s0, a3 = oo[ga + 3] * s0, b0 = oo[gb] * s0, b1 = oo[gb + 1] * s0, b2 = oo[gb + 2] * s0, b3 = oo[gb + 3] * s0;
#define MOBA_ACC(X, W) { unsigned fx = X[cc].x, fy = X[cc].y, sx = X[cc].z, sy = X[cc].w; \
              { auto r = __builtin_amdgcn_permlane32_swap(fx, sx, false, false); fx = r[0]; sx = r[1]; } { auto r = __builtin_amdgcn_permlane32_swap(fy, sy, false, false); fy = r[0]; sy = r[1]; } \
              a0 += (W) * bf2f(fx & 0xffffu); a1 += (W) * __builtin_bit_cast(float, fx & 0xffff0000u); a2 += (W) * bf2f(fy & 0xffffu); a3 += (W) * __builtin_bit_cast(float, fy & 0xffff0000u); \
              b0 += (W) * bf2f(sx & 0xffffu); b1 += (W) * __builtin_bit_cast(float, sx & 0xffff0000u); b2 += (W) * bf2f(sy & 0xffffu); b3 += (W) * __builtin_bit_cast(float, sy & 0xffff0000u); }
            MOBA_ACC(xA, sa) MOBA_ACC(xB, sb) MOBA_ACC(xC, sc)
#undef MOBA_ACC
            unsigned ax = cvtpk(a0, a1), ay = cvtpk(a2, a3), bx = cvtpk(b0, b1), by = cvtpk(b2, b3);
            { auto r = __builtin_amdgcn_permlane32_swap(ax, bx, false, false); ax = r[0]; bx = r[1]; }
            { auto r = __builtin_amdgcn_permlane32_swap(ay, by, false, false); ay = r[0]; by = r[1]; }
            *(u32x4*)(orow + dof) = (u32x4){ax, ay, bx, by}; }
}
__device__ __forceinline__ void diag_phase(int wave_, int ubeg, int uend, const bf16* Q, const bf16* K, const bf16* V, bf16* YM, const bf16* P2A, const bf16* P2B, const float* ML, const float* BT, LAS char* lds) {
    int lane_ = lane_id(); asm volatile("" : "+v"(lane_)); asm volatile("" : "+s"(wave_));
    int hc = -1; float bfar = 0.f;
#pragma unroll 1
    for (int u = ubeg; u < uend; ++u) {
        const int bh = u >> 4, qb = u & 15, h = bh & 7;
        if (h != hc) { hc = h; __syncthreads(); fill_bias_table(BT, h, wave_ * 64 + lane_, (LAS float*)(lds + L_TB)); bfar = BT[h * 132 + 128]; }
        diag_unit(wave_, lane_, bh >> 3, h, qb, Q, K, V, YM, P2A, P2B, ML, bfar, lds); }
}
#undef MOBA_CVEC
#undef MOBA_QK
#undef MOBA_NEARMAX
#undef MOBA_STEP
#undef MOBA_BLOCK4
}

__device__ __forceinline__ void ph_cvt_x(const Ctx& F0) {
    const Ctx F = launder(F0);
    const int gw = F.vcu * NWAVES + F.wave, NGW = F.G * NWAVES; float* rs1 = (float*)(F.ws + WS_RS1);
    for (int m = gw; m < T; m += 2 * NGW) {
        f32x4 v[2][4];
#pragma unroll
        for (int r = 0; r < 2; ++r) { const int mr = m + r * NGW < T ? m + r * NGW : T - 1; const f32x4* xr = (const f32x4*)(F.in[0] + (size_t)mr * D) + F.lane;
#pragma unroll
            for (int j = 0; j < 4; ++j) v[r][j] = xr[64 * j]; }
#pragma unroll
        for (int r = 0; r < 2; ++r) { float s = 0.f;
#pragma unroll
            for (int j = 0; j < 4; ++j) s += (v[r][j].x * v[r][j].x + v[r][j].y * v[r][j].y) + (v[r][j].z * v[r][j].z + v[r][j].w * v[r][j].w);
            const float rstd = 1.f / sqrtf(wave_sum(s) * (1.f / D) + RMS_EPS);
            if (m + r * NGW >= T) continue;
            if (F.lane == 0) rs1[m + r * NGW] = rstd;
            unsigned long long* o8 = (unsigned long long*)(P_XB(F) + (size_t)(m + r * NGW) * D) + F.lane;
#pragma unroll
            for (int j = 0; j < 4; ++j) o8[64 * j] = (unsigned long long)pk2(v[r][j].x, v[r][j].y) | ((unsigned long long)pk2(v[r][j].z, v[r][j].w) << 32); }
    }
}
__device__ __forceinline__ float row_ssq_bf16(const bf16* row, int lane) {
    const u32x4* xr = (const u32x4*)row + lane; float s = 0.f;
#pragma unroll
    for (int j = 0; j < 2; ++j) { const u32x4 x = xr[64 * j];
        const float a0 = bf2f(x.x & 0xffffu), a1 = bf2f(x.x >> 16), a2 = bf2f(x.y & 0xffffu), a3 = bf2f(x.y >> 16), a4 = bf2f(x.z & 0xffffu), a5 = bf2f(x.z >> 16), a6 = bf2f(x.w & 0xffffu), a7 = bf2f(x.w >> 16);
        s += ((a0 * a0 + a1 * a1) + (a2 * a2 + a3 * a3)) + ((a4 * a4 + a5 * a5) + (a6 * a6 + a7 * a7)); }
    return wave_sum(s);
}
__device__ __forceinline__ void ph_rstd(const Ctx& F0) {
    const Ctx F = launder(F0);
    const int gw = F.vcu * NWAVES + F.wave, NGW = F.G * NWAVES; float* rs1 = (float*)(F.ws + WS_RS1);
    for (int m = gw; m < T; m += 4 * NGW) {
        u32x4 x[4][2];
#pragma unroll
        for (int r = 0; r < 4; ++r) { const int mr = m + r * NGW < T ? m + r * NGW : T - 1; const u32x4* xr = (const u32x4*)(P_XB(F) + (size_t)mr * D) + F.lane; x[r][0] = xr[0]; x[r][1] = xr[64]; }
#pragma unroll
        for (int r = 0; r < 4; ++r) { float s = 0.f;
#pragma unroll
            for (int j = 0; j < 2; ++j) { const u32x4 q = x[r][j];
                const float a0 = bf2f(q.x & 0xffffu), a1 = bf2f(q.x >> 16), a2 = bf2f(q.y & 0xffffu), a3 = bf2f(q.y >> 16), a4 = bf2f(q.z & 0xffffu), a5 = bf2f(q.z >> 16), a6 = bf2f(q.w & 0xffffu), a7 = bf2f(q.w >> 16);
                s += ((a0 * a0 + a1 * a1) + (a2 * a2 + a3 * a3)) + ((a4 * a4 + a5 * a5) + (a6 * a6 + a7 * a7)); }
            s = wave_sum(s); if (F.lane == 0 && m + r * NGW < T) rs1[m + r * NGW] = 1.f / sqrtf(s * (1.f / D) + RMS_EPS); } }
}

__device__ __forceinline__ void ph_bias_table(const Ctx& F0) {
    const Ctx F = launder(F0);
    if (F.vcu == 0) {
        const float* rel_bias = F.in[1];
        for (int i = F.tid; i < 8 * 132; i += NTHREADS) {
            const int h = i / 132, r = i % 132;
            int bk;
            if (r < 16) bk = r;
            else { bk = 16 + (int)(logf((float)r / 16.f) / logf(8.f) * 16.f); if (bk > 31) bk = 31; }
            P_BT(F)[i] = rel_bias[bk * 8 + h] * LOG2E;
        }
    }
}

__device__ __forceinline__ void ph_pool_dl(const Ctx& F0) {
    const Ctx F = launder(F0);
    const int gt = F.vcu * NTHREADS + F.tid, NGT = F.G * NTHREADS;
    for (int it = gt; it < (T / 32) * 128; it += NGT) {
        const int cp = it & 127, chunk = it >> 7, c = cp * 2, gi = c >> 6, win = 2 << gi, m0 = chunk * 32, t0 = m0 & (SEQ - 1);
        const unsigned* __restrict__ P2 = (const unsigned*)P_PB(F) + cp; unsigned* __restrict__ D2 = (unsigned*)P_DL(F) + cp;
        float s0 = 0.f, s1 = 0.f;
        const int back = (t0 < win) ? t0 : win;
        for (int j = 1; j <= back; ++j) { const unsigned v = P2[(size_t)(m0 - j) * 128]; s0 += bf2f(v & 0xffffu); s1 += bf2f(v >> 16); }
#pragma unroll 4
        for (int i = 0; i < 32; ++i) { const int m = m0 + i, t = t0 + i;
            const unsigned v = P2[(size_t)m * 128]; const float p0 = bf2f(v & 0xffffu), p1 = bf2f(v >> 16);
            s0 += p0; s1 += p1;
            if (t >= win) { const unsigned o = P2[(size_t)(m - win) * 128]; s0 -= bf2f(o & 0xffffu); s1 -= bf2f(o >> 16); }
            const float inv = 1.f / (float)((t + 1 < win) ? t + 1 : win);
            D2[(size_t)m * 128] = pk2(s0 * inv - p0, s1 * inv - p1); }
    }
}
__device__ __forceinline__ void ph_final(const Ctx& F0) {
    const Ctx F = launder(F0);
    const int gw = F.vcu * NWAVES + F.wave, NGW = F.G * NWAVES;
    const f32x4* gf = (const f32x4*)F.in[26];
    for (int m = gw; m < T; m += 2 * NGW) {
        u32x4 x[2][2];
#pragma unroll
        for (int r = 0; r < 2; ++r) { const int mr = m + r * NGW < T ? m + r * NGW : T - 1; const u32x4* xr = (const u32x4*)(P_XB(F) + (size_t)mr * D) + F.lane; x[r][0] = xr[0]; x[r][1] = xr[64]; }
#pragma unroll
        for (int r = 0; r < 2; ++r) { float s = 0.f;
#pragma unroll
            for (int j = 0; j < 2; ++j) { const u32x4 q = x[r][j];
                const float a0 = bf2f(q.x & 0xffffu), a1 = bf2f(q.x >> 16), a2 = bf2f(q.y & 0xffffu), a3 = bf2f(q.y >> 16), a4 = bf2f(q.z & 0xffffu), a5 = bf2f(q.z >> 16), a6 = bf2f(q.w & 0xffffu), a7 = bf2f(q.w >> 16);
                s += ((a0 * a0 + a1 * a1) + (a2 * a2 + a3 * a3)) + ((a4 * a4 + a5 * a5) + (a6 * a6 + a7 * a7)); }
            const float rstd = 1.f / sqrtf(wave_sum(s) * (1.f / D) + RMS_EPS);
            if (m + r * NGW >= T) continue;
            f32x4* orow = (f32x4*)(F.R + (size_t)(m + r * NGW) * D);
#pragma unroll
            for (int j = 0; j < 2; ++j) { const u32x4 q = x[r][j]; const int c4 = 2 * (64 * j + F.lane);
                orow[c4] = (f32x4){bf2f(q.x & 0xffffu), bf2f(q.x >> 16), bf2f(q.y & 0xffffu), bf2f(q.y >> 16)} * rstd * gf[c4];
                orow[c4 + 1] = (f32x4){bf2f(q.z & 0xffffu), bf2f(q.z >> 16), bf2f(q.w & 0xffffu), bf2f(q.w >> 16)} * rstd * gf[c4 + 1]; } }
    }
}

constexpr int LDS_BYTES = 147456;
constexpr int MISC_OFF = 131072 + 320;

__global__ void __launch_bounds__(NTHREADS, 2) mk_fwd(Args args) {
    extern __shared__ __attribute__((aligned(16))) unsigned char lds[];
    Ctx F;
    F.lds = (LAS unsigned char*)lds;
    F.wave = __builtin_amdgcn_readfirstlane((int)threadIdx.x >> 6);
    F.lane = lane_id(); F.tid = F.wave * 64 + F.lane;
    F.G = gridDim.x; { const int bx = blockIdx.x; F.vcu = (F.G % 8 == 0) ? (bx % 8) * (F.G / 8) + bx / 8 : bx; }
    F.in = (KargP)__builtin_amdgcn_kernarg_segment_ptr(); F.R = args.out; F.ws = args.ws;
    unsigned char* ws = args.ws;
    volatile LAS unsigned* MISC = (volatile LAS unsigned*)(F.lds + MISC_OFF);
    if (F.tid < 64) MISC[F.tid] = 0u;
    __syncthreads();
    XcdBarrier bar = xcd_barrier_post((unsigned*)(ws + WS_CTL) + CW_BAR, MISC + 8, F.tid == 0);
#define GRID_BAR() do { bar.bar = (unsigned*)(wsl(ws) + WS_CTL) + CW_BAR; xcd_barrier(bar, F.wave); } while (0)
#define FL launder(F)

    ph_bias_table(F);
    ph_prologue(F);
#pragma unroll 1
    for (int l = 0; l < DEPTH; ++l) {
        if (l == 0) ph_cvt_x(F); else ph_rstd(F);
        GRID_BAR();
        { pg8::Gemm g{P_XB(FL), (const bf16*)(wsl(ws) + WS_WIN) + (size_t)l * NPROJ * D, D, D, D}; pg8::StaticOrder S; S.init(T, NPROJ, sl(F.G), sl((int)blockIdx.x));
          EpiProjE E{P_UG(FL), P_PB(FL), P_QB(FL), P_KB(FL), P_VB(FL), P_KMP(FL), (const float*)(wsl(ws) + WS_RS1)}; pg8::gemm_phase(F.lds, g, S, E, sl(F.wave)); }
        GRID_BAR();
        { pg8::Gemm g{P_UG(FL) + UOF, (const bf16*)(wsl(ws) + WS_BZ) + (size_t)l * SGN * 256 * 1024, UGP, 1024, 1024}; SsmOrder S{sl(F.G), sl((int)blockIdx.x), 1};
          EpiZ E{(float*)(wsl(ws) + WS_ZB)}; pg8::gemm_phase(F.lds, g, S, E, sl(F.wave)); }
        ph_pool_dl(F);
        moba::sel_phase(sl(F.wave), sl((int)blockIdx.x), sl(F.G), P_QB(FL), P_KMP(FL), (unsigned*)(wsl(ws) + WS_SEL), (LAS char*)F.lds);
        ph_tg_expand(F, l, sl((int)blockIdx.x), sl(F.G) > 64 ? 32 : 0);
        GRID_BAR();
        ph_ssm_scan(F, l);
        moba::gather_phase(sl(F.wave), sl(F.vcu), P_QB(FL), P_KB(FL), P_VB(FL), P_YMIX(FL), P_PB(FL), (bf16*)(wsl(ws) + WS_P2B), (float*)(wsl(ws) + WS_ML), (const unsigned*)(wsl(ws) + WS_SEL), P_BT(FL), (LAS char*)F.lds);
        GRID_BAR();
        { pg8::Gemm g{P_UG(FL), (const bf16*)(wsl(ws) + WS_TG) + (size_t)l * SGN * 1024 * UGP, UGP, UGP, UGP}; SsmOrder S{sl(F.G), sl((int)blockIdx.x), 2};
          EpiSsm2 E{P_UG(FL), P_YS(FL), F.in[11] + l * 256}; pg8::gemm_phase(F.lds, g, S, E, sl(F.wave)); }
        { const int bx = sl((int)blockIdx.x), G_ = sl(F.G); int ub, ue;
          if (G_ == 256) { const int q4 = bx & 3; ub = bx < 128 ? (bx >> 2) * 12 + (q4 == 0 ? 0 : q4 == 1 ? 4 : q4 == 2 ? 7 : 10) : 384 + 5 * (bx - 128); ue = ub + (bx < 128 ? (q4 == 0 ? 4 : q4 == 3 ? 2 : 3) : 5); }
          moba::diag_phase(sl(F.wave), ub, ue, P_QB(FL), P_KB(FL), P_VB(FL), P_YMIX(FL), P_PB(FL), (const bf16*)(wsl(ws) + WS_P2B), (const float*)(wsl(ws) + WS_ML), P_BT(FL), (LAS char*)F.lds); }
        GRID_BAR();
        { pg8::Gemm g{P_YS(FL), (const bf16*)(wsl(ws) + WS_GLUT) + (size_t)l * 65536, 256, 256, 256}; HalfOrder S{sl(F.vcu)};
          EpiGluE E{P_YS(FL), P_YMIX(FL), F.in[13] + l * 256}; pg8::gemm_phase(F.lds, g, S, E, sl(F.wave)); }
        { pg8::Gemm g{P_DL(FL), (const bf16*)(wsl(ws) + WS_POOLT) + (size_t)l * 65536, 256, 256, 256}; HalfOrder S{sl(F.vcu) - 128};
          EpiPoolE E{P_YMIX(FL), F.in[15] + l * 256, F.in[16] + l * 256}; pg8::gemm_phase(F.lds, g, S, E, sl(F.wave)); }
        GRID_BAR();
        { pg8::Gemm g{P_YMIX(FL), (const bf16*)(wsl(ws) + WS_WOUT) + (size_t)l * D * D, D, D, D}; pg8::StaticOrder S; S.init(T, D, sl(F.G), sl((int)blockIdx.x));
          EpiOutE E{P_XB(FL)}; pg8::gemm_phase(F.lds, g, S, E, sl(F.wave)); }
        GRID_BAR();
        ph_route(F, l);
        GRID_BAR();
        ph_place(F);
        GRID_BAR();
        { pg8::Gemm g{P_XB(FL), (const bf16*)(wsl(ws) + WS_GU) + (size_t)l * 16 * 512 * D, D, D, D}; MoeOrder S{sl(F.G), sl((int)blockIdx.x), false, 0, 0}; S.init((const int*)(wsl(ws) + WS_TILEB));
          EpiGU E{(bf16*)(wsl(ws) + WS_HACT), (const float*)(wsl(ws) + WS_ROWW), (const float*)(wsl(ws) + WS_ROWR)}; pg8::gemm_phase<true, true>(F.lds, g, S, E, sl(F.wave), (const int*)(wsl(ws) + WS_ROWTOK)); }
        GRID_BAR();
        { pg8::Gemm g{(const bf16*)(wsl(ws) + WS_HACT), (const bf16*)(wsl(ws) + WS_WD) + (size_t)l * 24 * D * 512, 512, 512, 512}; MoeOrder S{sl(F.G), sl((int)blockIdx.x), true, 0, 0}; S.init((const int*)(wsl(ws) + WS_TILEB));
          EpiDown E{P_XB(FL), (const int*)(wsl(ws) + WS_ROWTOK)}; pg8::gemm_phase(F.lds, g, S, E, sl(F.wave)); }
        GRID_BAR();
    }
    ph_final(F);
}

extern "C" void kernel_launch(void* const* d_in, const int* in_sizes, int n_in, void* d_out, int out_size, void* d_ws, size_t ws_size, hipStream_t stream) {
    static int grid = 0;
    if (grid == 0) {
        if (n_in != 27 || out_size != T * D || ws_size < WS_END) { fprintf(stderr, "kernel_launch: unexpected shapes (n_in %d out %d ws %zu)\n", n_in, out_size, ws_size); grid = -1; return; }
        int dev = 0, cus = 0, per_cu = 0;
        if (hipGetDevice(&dev) != hipSuccess || hipDeviceGetAttribute(&cus, hipDeviceAttributeMultiprocessorCount, dev) != hipSuccess) { grid = -1; return; }
        if (hipFuncSetAttribute((const void*)mk_fwd, hipFuncAttributeMaxDynamicSharedMemorySize, LDS_BYTES) != hipSuccess) { fprintf(stderr, "kernel_launch: hipFuncSetAttribute failed\n"); grid = -1; return; }
        if (hipOccupancyMaxActiveBlocksPerMultiprocessor(&per_cu, (const void*)mk_fwd, NTHREADS, LDS_BYTES) != hipSuccess || per_cu < 1) { fprintf(stderr, "kernel_launch: occupancy query says %d\n", per_cu); per_cu = 1; }
        (void)hipGetLastError();
        grid = cus;
    }
    if (grid < 0) return;
    (void)hipMemsetAsync((char*)d_ws + WS_CTL, 0, CTL_ZERO_BYTES, stream);
    Args a{};
    for (int i = 0; i < 27; ++i) a.in[i] = (const float*)d_in[i];
    a.out = (float*)d_out; a.ws = (unsigned char*)d_ws; a.pad0 = 0; a.pad1 = 0;
    hipLaunchKernelGGL(mk_fwd, dim3(grid), dim3(NTHREADS), LDS_BYTES, stream, a);
}
```

```cpp
#include <hip/hip_runtime.h>
#include <hip/hip_bf16.h>
#include <cstdio>
#include <cstdint>

#define GAS __attribute__((address_space(1)))
#define LAS __attribute__((address_space(3)))
typedef unsigned short bf16;
typedef float f32x4 __attribute__((ext_vector_type(4)));
typedef unsigned u32x4 __attribute__((ext_vector_type(4)));
typedef unsigned u32x2 __attribute__((ext_vector_type(2)));

constexpr int NB = 8, SEQ = 4096, T = NB * SEQ, D = 1024, NPROJ = 2048, DEPTH = 2;
constexpr int NHEAD = 8, HD = 64, MBLK = 256, NBLK = SEQ / MBLK;
constexpr int SG = 16, SGN = 16, SP = 64, SCH = 64, UGP = 1152, UOF = 128;
constexpr float RMS_EPS = 1e-6f;
constexpr float LOG2E = 1.4426950408889634f;
constexpr float C2 = 0.125f * LOG2E;
constexpr int NWAVES = 8, NTHREADS = 512;

constexpr size_t MiB = 1u << 20;
constexpr size_t WS_CTL = 0, CTL_ZERO_BYTES = 1 * MiB;
constexpr size_t WS_XB = 2 * MiB;
constexpr size_t WS_UG = 66 * MiB;
constexpr size_t WS_PB = 84 * MiB;
constexpr size_t WS_QB = 100 * MiB;
constexpr size_t WS_KB = 132 * MiB;
constexpr size_t WS_VB = 164 * MiB;
constexpr size_t WS_YMIX = 196 * MiB;
constexpr size_t WS_YS = 260 * MiB;
constexpr size_t WS_DL = 276 * MiB;
constexpr size_t WS_KMP = 292 * MiB;
constexpr size_t WS_BT = 293 * MiB;
constexpr size_t WS_KT = 297 * MiB;
constexpr size_t WS_SEL = 298 * MiB;
constexpr size_t WS_WIN = 300 * MiB;
constexpr size_t WS_WOUT = 308 * MiB;
constexpr size_t WS_GU = 312 * MiB;
constexpr size_t WS_WD = 344 * MiB;
constexpr size_t WS_TG = 392 * MiB;
constexpr size_t WS_BZ = 464 * MiB;
constexpr size_t WS_GLUT = 480 * MiB;
constexpr size_t WS_POOLT = WS_GLUT + 512 * 1024;
constexpr size_t WS_ZB = 482 * MiB;
constexpr size_t WS_P2B = 486 * MiB;
constexpr size_t WS_ML = 502 * MiB;
constexpr size_t WS_END = 508 * MiB;
constexpr int MOE_MAXT = 152;
constexpr size_t WS_XS = 66 * MiB;
constexpr size_t WS_HACT = 142 * MiB;
constexpr size_t WS_TOKB = 294 * MiB;
constexpr size_t WS_TOKR = WS_TOKB + 128 * 1024;
constexpr size_t WS_TOKW = WS_TOKB + 256 * 1024;
constexpr size_t WS_ROWTOK = 295 * MiB;
constexpr size_t WS_ROWW = WS_ROWTOK + 256 * 1024;
constexpr size_t WS_ROWR = WS_ROWTOK + 576 * 1024;
constexpr size_t WS_RS1 = WS_ROWTOK + 768 * 1024;
constexpr size_t WS_WGCNT = 296 * MiB;
constexpr size_t WS_TILEB = WS_WGCNT + 64 * 1024;

constexpr int CW_BAR = 4096;

__device__ __forceinline__ unsigned f2bf(float f) { unsigned u = __builtin_bit_cast(unsigned, f); return (u + 0x7fffu + ((u >> 16) & 1u)) >> 16; }
__device__ __forceinline__ float bf2f(unsigned h) { return __builtin_bit_cast(float, h << 16); }
__device__ __forceinline__ unsigned pk2(float lo, float hi) { return f2bf(lo) | (f2bf(hi) << 16); }
template <int O> __device__ __forceinline__ float xshfl(float v) {
    if constexpr (O < 32) return __builtin_bit_cast(float, __builtin_amdgcn_ds_swizzle(__builtin_bit_cast(int, v), (O << 10) | 0x1f));
    else { const unsigned u = __builtin_bit_cast(unsigned, v); auto r = __builtin_amdgcn_permlane32_swap(u, u, false, false);
           const float a = __builtin_bit_cast(float, (unsigned)r[0]), b = __builtin_bit_cast(float, (unsigned)r[1]); return (a == v && __builtin_bit_cast(unsigned, a) == u) ? b : a; }
}
__device__ __forceinline__ float wave_sum(float v) {
    v += xshfl<1>(v); v += xshfl<2>(v); v += xshfl<4>(v); v += xshfl<8>(v); v += xshfl<16>(v);
    const unsigned u = __builtin_bit_cast(unsigned, v); auto r = __builtin_amdgcn_permlane32_swap(u, u, false, false);
    return __builtin_bit_cast(float, (unsigned)r[0]) + __builtin_bit_cast(float, (unsigned)r[1]);
}
__device__ __forceinline__ float wave_max(float v) {
    v = fmaxf(v, xshfl<1>(v)); v = fmaxf(v, xshfl<2>(v)); v = fmaxf(v, xshfl<4>(v)); v = fmaxf(v, xshfl<8>(v)); v = fmaxf(v, xshfl<16>(v));
    const unsigned u = __builtin_bit_cast(unsigned, v); auto r = __builtin_amdgcn_permlane32_swap(u, u, false, false);
    return fmaxf(__builtin_bit_cast(float, (unsigned)r[0]), __builtin_bit_cast(float, (unsigned)r[1]));
}
__device__ __forceinline__ float gelu_tanh(float x) {
    const float u = 0.7978845608028654f * (x + 0.044715f * x * x * x);
    const float e = __expf(2.f * u);
    const float th = 1.f - 2.f / (e + 1.f);
    return 0.5f * x * (1.f + th);
}
__device__ __forceinline__ float sigmoidf_(float x) { return 1.f / (1.f + __expf(-x)); }

__device__ __forceinline__ int lane_id() { unsigned m; asm volatile("s_mov_b32 %0, -1" : "=s"(m)); return (int)__builtin_amdgcn_mbcnt_hi(m, __builtin_amdgcn_mbcnt_lo(m, 0u)); }

#define XB_TMO      128
#define XB_XCNT(j)  (256  + 64 * (j))
#define XB_XSUB(j)  (1280 + 64 * (j))
#define XB_XGEN(j)  (2304 + 64 * (j))
#define XB_TOP      3328
#define XB_TOPGEN   3392
#define XCD_BAR_WORDS 3456
#define XB_SPIN_CAP (1u << 22)
__device__ __forceinline__ unsigned xb_ld(unsigned* p)              { return __hip_atomic_load(p, __ATOMIC_RELAXED, __HIP_MEMORY_SCOPE_AGENT); }
__device__ __forceinline__ unsigned xb_add(unsigned* p, unsigned v) { return __hip_atomic_fetch_add(p, v, __ATOMIC_RELAXED, __HIP_MEMORY_SCOPE_AGENT); }
__device__ __forceinline__ unsigned xb_xcc_id() { return (unsigned)__builtin_amdgcn_s_getreg((3 << 11) | 20) & 0xFu; }
#define XB_SPIN(cond, bar) do { unsigned _sp = 0; while (cond) { __builtin_amdgcn_s_sleep(1); \
    if ((++_sp & 255u) == 0u) { if (xb_ld(&(bar)[XB_TMO])) break; if (_sp > XB_SPIN_CAP) { atomicAdd(&(bar)[XB_TMO], 1u); break; } } } } while (0)
struct XcdBarrier { unsigned* bar; unsigned x; volatile LAS unsigned* st; };
__device__ __forceinline__ XcdBarrier xcd_barrier_post(unsigned* bar, volatile LAS unsigned* st, bool t0) {
    XcdBarrier b; b.bar = bar; b.x = xb_xcc_id(); b.st = st;
    if (t0) (void)xb_add(&bar[XB_XCNT(b.x)], 1u);
    return b;
}
__device__ __forceinline__ void xcd_barrier_complete(unsigned* bar, unsigned x, unsigned& nloc, unsigned& nx) {
    const unsigned G = gridDim.x * gridDim.y * gridDim.z;
    unsigned sum, cnt, mine, sp = 0u;
    for (;;) {
        sum = 0u; cnt = 0u; mine = 0u;
#pragma unroll
        for (unsigned j = 0; j < 16; ++j) { const unsigned c = xb_ld(&bar[XB_XCNT(j)]); sum += c; cnt += (c > 0u) ? 1u : 0u; mine = (j == x) ? c : mine; }
        if (sum == G) break;
        __builtin_amdgcn_s_sleep(1);
        if ((++sp & 255u) == 0u) { if (xb_ld(&bar[XB_TMO])) break; if (sp > XB_SPIN_CAP) { atomicAdd(&bar[XB_TMO], 1u); break; } }
    }
    nloc = mine > 0u ? mine : 1u; nx = cnt > 0u ? cnt : 1u;
}
__device__ __forceinline__ void xcd_barrier(const XcdBarrier& b, int wave) {
    asm volatile("s_waitcnt vmcnt(0)" ::: "memory");
    __syncthreads();
    if (wave == 0 && lane_id() == 0) {
        unsigned* bar = b.bar;
        __builtin_amdgcn_s_waitcnt(0);
        unsigned nloc = b.st[0], nx = b.st[1];
        if (nloc == 0u) { xcd_barrier_complete(bar, b.x, nloc, nx); b.st[0] = nloc; b.st[1] = nx; }
        const unsigned old = xb_add(&bar[XB_XSUB(b.x)], 1u);
        const unsigned gen = old / nloc;
        if (old + 1u == (gen + 1u) * nloc) {
            __builtin_amdgcn_fence(__ATOMIC_RELEASE, "agent");
            asm volatile("s_waitcnt vmcnt(0)" ::: "memory");
            const unsigned og = xb_add(&bar[XB_TOP], 1u);
            const unsigned tg = og / nx;
            if (og + 1u == (tg + 1u) * nx) xb_add(&bar[XB_TOPGEN], 1u);
            else XB_SPIN(xb_ld(&bar[XB_TOPGEN]) == tg, bar);
            __builtin_amdgcn_fence(__ATOMIC_ACQUIRE, "agent");
            xb_add(&bar[XB_XGEN(b.x)], 1u);
            asm volatile("s_waitcnt vmcnt(0)" ::: "memory");
        } else {
            XB_SPIN(xb_ld(&bar[XB_XGEN(b.x)]) == gen, bar);
            __builtin_amdgcn_fence(__ATOMIC_ACQUIRE, "agent");
            asm volatile("s_waitcnt vmcnt(0)" ::: "memory");
        }
    }
    __syncthreads();
}

struct Args {
    const float* in[27];
    float* out;
    unsigned char* ws;
    int pad0, pad1;
};

typedef const float* fptr_t;
typedef __attribute__((address_space(4))) const fptr_t* KargP;
struct Ctx {
    LAS unsigned char* lds;
    int tid, lane, wave, vcu, G;
    KargP in;
    float* R;
    unsigned char* ws;
};
#define P_XB(F) ((bf16*)((F).ws + WS_XB))
#define P_UG(F) ((bf16*)((F).ws + WS_UG))
#define P_PB(F) ((bf16*)((F).ws + WS_PB))
#define P_QB(F) ((bf16*)((F).ws + WS_QB))
#define P_KB(F) ((bf16*)((F).ws + WS_KB))
#define P_VB(F) ((bf16*)((F).ws + WS_VB))
#define P_YMIX(F) ((bf16*)((F).ws + WS_YMIX))
#define P_YS(F) ((bf16*)((F).ws + WS_YS))
#define P_DL(F) ((bf16*)((F).ws + WS_DL))
#define P_KMP(F) ((float*)((F).ws + WS_KMP))
#define P_BT(F) ((float*)((F).ws + WS_BT))


__device__ __forceinline__ Ctx launder(const Ctx& F0) {
    Ctx F = F0;
    int ln = lane_id(); asm volatile("" : "+v"(ln));
    asm volatile("" : "+s"(F.wave), "+s"(F.vcu), "+s"(F.G));
    F.lane = ln; F.tid = F.wave * 64 + ln;
    KargP kp = (KargP)__builtin_amdgcn_kernarg_segment_ptr(); asm volatile("" : "+s"(kp));
    F.in = kp; F.R = (float*)kp[27]; F.ws = (unsigned char*)kp[28];
    return F;
}

__device__ __forceinline__ unsigned char* wsl(unsigned char* p) { asm volatile("" : "+s"(p)); return p; }
__device__ __forceinline__ int sl(int x) { asm volatile("" : "+s"(x)); return x; }

namespace pg8 {
typedef short bf16x8 __attribute__((ext_vector_type(8)));
constexpr int BM = 256, BK = 64, HALF = 128, HTB = HALF * BK * 2, STAGE_BYTES = 8 * HTB, NXCD = 8, WGM = 8;
__device__ __forceinline__ int lds_byte(int r, int c) { const int st = (r >> 4) * 2 + (c >> 5), rr = r & 15, cc = c & 31, ob = rr * 64 + cc * 2; return st * 1024 + (ob ^ (((ob >> 9) & 1) << 5)); }
__device__ __forceinline__ void stage_rc(int b, int& R, int& C) { const int st = b / 1024, sb = b % 1024, swz = sb ^ (((sb >> 9) & 1) << 5); R = (st >> 1) * 16 + swz / 64; C = (st & 1) * 32 + (swz % 64) / 2; }
__device__ __forceinline__ int perm32(int rho) { const int n = rho >> 4, i = rho & 15; return 8 * (i >> 2) + 4 * n + (i & 3); }

struct Unit { int pm, pn, aux, kt; };
struct Gemm { const bf16* A; const bf16* Bt; int lda, ldb, K; };

struct StaticOrder {
    int nM, nN, nwg, G, c;
    __device__ void init(int M, int N, int G_, int c_) { nM = M / BM; nN = N / BM; nwg = nM * nN; G = G_; c = c_; }
    __device__ bool next(int i, Unit& u) const {
        const long L = (long)i * G + c; if (L >= nwg) return false;
        int wgid = (int)L; { const int q = nwg / NXCD, r = nwg % NXCD, xcd = wgid % NXCD, off = wgid / NXCD; wgid = (xcd < r ? xcd * (q + 1) : r * (q + 1) + (xcd - r) * q) + off; }
        const int nig = WGM * nN, gid = wgid / nig, fm = gid * WGM, gsz = (nM - fm) < WGM ? (nM - fm) : WGM;
        u.pm = fm + ((wgid % nig) % gsz); u.pn = (wgid % nig) / gsz; u.aux = 0; return true;
    }
};

__device__ __forceinline__ unsigned cvt_pk_bf16(float lo, float hi) { unsigned r; asm volatile("v_cvt_pk_bf16_f32 %0, %1, %2" : "=v"(r) : "v"(lo), "v"(hi)); return r; }

template <bool ALIGN = true, bool GATHER = false, class Epi, class Sched>
__device__ __forceinline__ void gemm_phase(LAS unsigned char* lds, const Gemm g, const Sched& S, const Epi& E, int wave_, const int* gidx = nullptr) {
    int lane_ = lane_id(); asm volatile("" : "+v"(lane_)); asm volatile("" : "+s"(wave_));
    const int wid = wave_, lane = lane_, tid = wid * 64 + lane, wr = wid >> 2, wc = wid & 3, fr = lane & 15, fq = lane >> 4;
    const int K = g.K, ntd = K / BK; int nt = ntd;
    unsigned voffA[2], voffA1[2], voffB[2];
#pragma unroll
    for (int i = 0; i < 2; ++i) { int R, C; stage_rc(tid * 16 + i * 8192, R, C); const int Rb = Epi::PERM ? ((R & ~31) + perm32(R & 31)) : R;
        voffA[i] = (unsigned)(R * g.lda + C) * 2u; voffB[i] = (unsigned)(Rb * g.ldb + C) * 2u; voffA1[i] = voffA[i] + (unsigned)(HALF * g.lda * 2); }
    const size_t kstep = (size_t)(BK * 2);
    const size_t hstepA = (size_t)HALF * g.lda * 2, hstepB = (size_t)HALF * g.ldb * 2;
    const size_t tstepA = 2 * hstepA, tstepB = 2 * hstepB;
    const unsigned ldsw = (unsigned)wid * 1024u;
    const int aoff = lds_byte(wr * 64 + fr, fq * 8), boff = lds_byte(wc * 32 + fr, fq * 8);
#define PG8_SA(b, h) (((b) * 2 + (h)) * HTB)
#define PG8_SB(b, h) ((4 + (b) * 2 + (h)) * HTB)
#define PG8_STAGE(bufoff, gbase, voff) do { _Pragma("unroll") for (int _i = 0; _i < 2; ++_i) \
        __builtin_amdgcn_global_load_lds((const unsigned*)((const char*)(gbase) + (voff)[_i]), (LAS unsigned*)(lds + (bufoff) + ldsw + _i * 8192), 16, 0, 0); } while (0)
#define PG8_LDA(dst, b, h) do { _Pragma("unroll") for (int m = 0; m < 4; ++m) _Pragma("unroll") for (int k = 0; k < 2; ++k) dst[m][k] = *(const LAS bf16x8*)(lds + PG8_SA(b, h) + aoff + m * 2048 + k * 1024); } while (0)
#define PG8_LDB(dst, b, h) do { _Pragma("unroll") for (int n = 0; n < 2; ++n) _Pragma("unroll") for (int k = 0; k < 2; ++k) dst[n][k] = *(const LAS bf16x8*)(lds + PG8_SB(b, h) + boff + n * 2048 + k * 1024); } while (0)
#define PG8_MMA(ai, bj, At, Bt) do { __builtin_amdgcn_s_setprio(1); _Pragma("unroll") for (int m = 0; m < 4; ++m) _Pragma("unroll") for (int n = 0; n < 2; ++n) _Pragma("unroll") for (int k = 0; k < 2; ++k) \
        acc[ai][bj][m][n] = __builtin_amdgcn_mfma_f32_16x16x32_bf16(Bt[n][k], At[m][k], acc[ai][bj][m][n], 0, 0, 0); __builtin_amdgcn_s_setprio(0); } while (0)
#define PG8_GLOOK(PM) do { if constexpr (GATHER) { _Pragma("unroll") for (int _i = 0; _i < 2; ++_i) { int R_, C_; stage_rc(tid * 16 + _i * 8192, R_, C_); \
        int t0_ = gidx[(PM) * 256 + R_], t1_ = gidx[(PM) * 256 + HALF + R_]; t0_ = t0_ < 0 ? 0 : t0_; t1_ = t1_ < 0 ? 0 : t1_; \
        voffA[_i] = (unsigned)(t0_ * g.lda + C_) * 2u; voffA1[_i] = (unsigned)(t1_ * g.lda + C_) * 2u; } } } while (0)
#define PG8_WAIT_V(n) asm volatile("s_waitcnt vmcnt(" #n ")" ::: "memory")
#define PG8_WAIT_L(n) asm volatile("s_waitcnt lgkmcnt(" #n ")" ::: "memory")
#define PG8_BAR __builtin_amdgcn_s_barrier()
#define PG8_SCHED __builtin_amdgcn_sched_barrier(0)
    Unit cur{0, 0, 0, 0}, nxt{0, 0, 0, 0}; int ui = 0;
    if (!S.next(0, cur)) return;
    nt = cur.kt ? cur.kt : ntd;
    f32x4 acc[2][2][4][2];
#pragma unroll
    for (int a = 0; a < 2; ++a)
#pragma unroll
        for (int b = 0; b < 2; ++b)
#pragma unroll
            for (int m = 0; m < 4; ++m)
#pragma unroll
                for (int n = 0; n < 2; ++n) acc[a][b][m][n] = (f32x4){0.f, 0.f, 0.f, 0.f};
    bf16x8 At[4][2], B0[2][2], B1[2][2];
    const char* cA = (const char*)g.A + (GATHER ? (size_t)0 : (size_t)cur.pm * tstepA); const char* cB = (const char*)g.Bt + (size_t)cur.pn * tstepB;
    PG8_GLOOK(cur.pm);
    PG8_STAGE(PG8_SB(0, 0), cB, voffB); PG8_STAGE(PG8_SB(0, 1), cB + hstepB, voffB); PG8_STAGE(PG8_SA(0, 0), cA, voffA); PG8_STAGE(PG8_SA(0, 1), cA, voffA1);
    if (wr == 1) PG8_BAR;
    PG8_WAIT_V(2); PG8_BAR;
    PG8_STAGE(PG8_SB(1, 0), cB + kstep, voffB); PG8_STAGE(PG8_SA(1, 0), cA + kstep, voffA); PG8_STAGE(PG8_SB(1, 1), cB + hstepB + kstep, voffB);
    PG8_WAIT_V(6); PG8_BAR;
    for (;;) {
        const bool has_next = S.next(ui + 1, nxt);
        const char* nA = has_next ? (const char*)g.A + (GATHER ? (size_t)0 : (size_t)nxt.pm * tstepA) : cA; const char* nB = has_next ? (const char*)g.Bt + (size_t)nxt.pn * tstepB : cB;
        for (int t = 0; t < nt; t += 2) {
            const bool last = (t == nt - 2);
            const char* a1 = cA + (size_t)(t + 1) * kstep;
            const char* a2 = last ? nA : cA + (size_t)(t + 2) * kstep; const char* b2 = last ? nB : cB + (size_t)(t + 2) * kstep;
            const char* a3 = a2 + kstep; const char* b3 = b2 + kstep;
            PG8_LDB(B0, 0, 0); PG8_LDB(B1, 0, 1); PG8_SCHED; PG8_LDA(At, 0, 0); PG8_STAGE(PG8_SA(1, 1), a1, voffA1);
            PG8_WAIT_V(8); PG8_WAIT_L(0); PG8_BAR; PG8_MMA(0, 0, At, B0); PG8_MMA(0, 1, At, B1); PG8_BAR; PG8_SCHED;
            if constexpr (GATHER) { if (last && has_next) PG8_GLOOK(nxt.pm); }
            PG8_LDA(At, 0, 1); PG8_STAGE(PG8_SB(0, 0), b2, voffB); PG8_STAGE(PG8_SB(0, 1), b2 + hstepB, voffB); PG8_STAGE(PG8_SA(0, 0), a2, voffA);
            PG8_WAIT_V(8); PG8_WAIT_L(0); PG8_BAR; PG8_MMA(1, 0, At, B0); PG8_MMA(1, 1, At, B1); PG8_BAR; PG8_SCHED;
            PG8_LDB(B0, 1, 0); PG8_LDB(B1, 1, 1); PG8_SCHED; PG8_LDA(At, 1, 0); PG8_STAGE(PG8_SA(0, 1), a2, voffA1);
            PG8_WAIT_V(8); PG8_WAIT_L(0); PG8_BAR; PG8_MMA(0, 0, At, B0); PG8_MMA(0, 1, At, B1); PG8_BAR; PG8_SCHED;
            PG8_LDA(At, 1, 1); PG8_STAGE(PG8_SB(1, 0), b3, voffB); PG8_STAGE(PG8_SB(1, 1), b3 + hstepB, voffB); PG8_STAGE(PG8_SA(1, 0), a3, voffA);
            PG8_WAIT_V(8); PG8_WAIT_L(0); PG8_BAR; PG8_MMA(1, 0, At, B0); PG8_MMA(1, 1, At, B1); PG8_BAR; PG8_SCHED;
        }
        if constexpr (ALIGN) { if (wr == 0) PG8_BAR; }
        E(acc, cur, wr, wc, fr, fq);
        if (!has_next) break;
#pragma unroll
        for (int a = 0; a < 2; ++a)
#pragma unroll
            for (int b = 0; b < 2; ++b)
#pragma unroll
                for (int m = 0; m < 4; ++m)
#pragma unroll
                    for (int n = 0; n < 2; ++n) acc[a][b][m][n] = (f32x4){0.f, 0.f, 0.f, 0.f};
        cur = nxt; cA = nA; cB = nB; ++ui; nt = cur.kt ? cur.kt : ntd;
        if constexpr (ALIGN) { if (wr == 1) PG8_BAR; }
    }
    PG8_WAIT_V(0);
    if constexpr (!ALIGN) { if (wr == 0) PG8_BAR; }
    PG8_BAR;
#undef PG8_SA
#undef PG8_SB
#undef PG8_STAGE
#undef PG8_LDA
#undef PG8_LDB
#undef PG8_MMA
#undef PG8_WAIT_V
#undef PG8_WAIT_L
#undef PG8_BAR
#undef PG8_SCHED
}
}


struct EpiProjE {
    static constexpr bool PERM = true;
    bf16 *UG, *PB, *QB, *KB, *VB; float* KMP; const float* rs1;
    __device__ __forceinline__ void operator()(const f32x4 (&acc_)[2][2][4][2], const pg8::Unit& u, int wr, int wc, int fr_, int fq_) const {
        const int ln_ = lane_id(), fr = ln_ & 15, fq = ln_ >> 4; (void)fr_; (void)fq_;
        const int pn = u.pn, row0 = u.pm * 256 + wr * 64 + fr, cl = wc * 32 + 8 * fq;
        f32x4 acc[2][2][4][2];
#pragma unroll
        for (int ai = 0; ai < 2; ++ai)
#pragma unroll
            for (int m = 0; m < 4; ++m) { const float rs = rs1[row0 + ai * 128 + m * 16];
#pragma unroll
                for (int bj = 0; bj < 2; ++bj) { acc[ai][bj][m][0] = acc_[ai][bj][m][0] * rs; acc[ai][bj][m][1] = acc_[ai][bj][m][1] * rs; } }
        if (pn == 0) {
#pragma unroll
            for (int ai = 0; ai < 2; ++ai)
#pragma unroll
                for (int m = 0; m < 4; ++m) { const int r = row0 + ai * 128 + m * 16;
#pragma unroll
                    for (int bj = 0; bj < 2; ++bj) { const int ch = bj * 128 + cl, g = ch >> 4, h0 = ch & 15;
                        const f32x4 v0 = acc[ai][bj][m][0], v1 = acc[ai][bj][m][1]; u32x4 w;
                        w.x = pg8::cvt_pk_bf16(v0[0], v0[1]); w.y = pg8::cvt_pk_bf16(v0[2], v0[3]); w.z = pg8::cvt_pk_bf16(v1[0], v1[1]); w.w = pg8::cvt_pk_bf16(v1[2], v1[3]);
                        *(u32x4*)(UG + ((size_t)(g * 512 + (r >> 6))) * UGP + UOF + (r & 63) * 16 + h0) = w; } }
        } else {
            bf16* base; int ldc, colt; float sc = 1.f;
            if (pn == 1) { base = PB; ldc = 256; colt = 0; }
            else if (pn < 4) { base = QB; ldc = 512; colt = (pn - 2) * 256; sc = C2; }
            else if (pn < 6) { base = KB; ldc = 512; colt = (pn - 4) * 256; }
            else { base = VB; ldc = 512; colt = (pn - 6) * 256; }
#pragma unroll
            for (int ai = 0; ai < 2; ++ai)
#pragma unroll
                for (int m = 0; m < 4; ++m) { bf16* rowp = base + (size_t)(row0 + ai * 128 + m * 16) * ldc + colt + cl;
#pragma unroll
                    for (int bj = 0; bj < 2; ++bj) { const f32x4 v0 = acc[ai][bj][m][0] * sc, v1 = acc[ai][bj][m][1] * sc; u32x4 w;
                        w.x = pg8::cvt_pk_bf16(v0[0], v0[1]); w.y = pg8::cvt_pk_bf16(v0[2], v0[3]); w.z = pg8::cvt_pk_bf16(v1[0], v1[1]); w.w = pg8::cvt_pk_bf16(v1[2], v1[3]);
                        *(u32x4*)(rowp + bj * 128) = w; } }
            if (pn >= 4 && pn < 6) {
#pragma unroll
                for (int bj = 0; bj < 2; ++bj)
#pragma unroll
                    for (int n = 0; n < 2; ++n) { f32x4 s = (f32x4){0.f, 0.f, 0.f, 0.f};
#pragma unroll
                        for (int ai = 0; ai < 2; ++ai)
#pragma unroll
                            for (int m = 0; m < 4; ++m) s += acc[ai][bj][m][n];
#pragma unroll
                        for (int i = 0; i < 4; ++i) { float t = s[i]; t += xshfl<1>(t); t += xshfl<2>(t); t += xshfl<4>(t); t += xshfl<8>(t); s[i] = t; }
                        if (fr == 0) *(f32x4*)(KMP + (size_t)wr * 128 * 512 + (size_t)u.pm * 512 + colt + bj * 128 + cl + 4 * n) = s; }
            }
        }
    }
};
struct EpiOutE {
    static constexpr bool PERM = true;
    bf16* RB;
    __device__ __forceinline__ void operator()(const f32x4 (&acc)[2][2][4][2], const pg8::Unit& u, int wr, int wc, int fr_, int fq_) const {
        const int ln_ = lane_id(), fr = ln_ & 15, fq = ln_ >> 4; (void)fr_; (void)fq_;
        const int row0 = u.pm * 256 + wr * 64 + fr, col0 = u.pn * 256 + wc * 32 + 8 * fq;
#pragma unroll
        for (int ai = 0; ai < 2; ++ai) { u32x4 x[4][2];
#pragma unroll
            for (int m = 0; m < 4; ++m) { const bf16* rp = RB + (size_t)(row0 + ai * 128 + m * 16) * D + col0; x[m][0] = *(const u32x4*)rp; x[m][1] = *(const u32x4*)(rp + 128); }
#pragma unroll
            for (int m = 0; m < 4; ++m) { bf16* rp = RB + (size_t)(row0 + ai * 128 + m * 16) * D + col0;
#pragma unroll
                for (int bj = 0; bj < 2; ++bj) { const u32x4 xx = x[m][bj]; const f32x4 a0 = acc[ai][bj][m][0], a1 = acc[ai][bj][m][1]; u32x4 w;
                    w.x = pg8::cvt_pk_bf16(bf2f(xx.x & 0xffffu) + a0[0], bf2f(xx.x >> 16) + a0[1]); w.y = pg8::cvt_pk_bf16(bf2f(xx.y & 0xffffu) + a0[2], bf2f(xx.y >> 16) + a0[3]);
                    w.z = pg8::cvt_pk_bf16(bf2f(xx.z & 0xffffu) + a1[0], bf2f(xx.z >> 16) + a1[1]); w.w = pg8::cvt_pk_bf16(bf2f(xx.w & 0xffffu) + a1[2], bf2f(xx.w >> 16) + a1[3]);
                    *(u32x4*)(rp + bj * 128) = w; } }
            asm volatile("" ::: "memory"); }
    }
};

__device__ __forceinline__ void transpose_item(const float* W, int K, int N, const float* kscale, bf16* WT, int ldo, int koff, int rowmode, LAS float* scr, int item, int lane) {
    const int nblk = N / 32, kb = item / nblk, nb = item % nblk, k0 = 64 * kb, n0 = 32 * nb;
    { const int r8 = lane >> 3, c4 = lane & 7; f32x4 v[8];
#pragma unroll
      for (int i = 0; i < 8; ++i) v[i] = *(const f32x4*)(W + (size_t)(k0 + 8 * i + r8) * N + n0 + 4 * c4);
#pragma unroll
      for (int i = 0; i < 8; ++i) { const int kk = 8 * i + r8; const float s = kscale ? kscale[k0 + kk] : 1.f; LAS float* d = scr + kk * 33 + 4 * c4;
          d[0] = v[i][0] * s; d[1] = v[i][1] * s; d[2] = v[i][2] * s; d[3] = v[i][3] * s; } }
    asm volatile("s_waitcnt lgkmcnt(0)" ::: "memory");
    const int c = lane & 7;
#pragma unroll
    for (int j = 0; j < 4; ++j) { const int n = (lane >> 3) + 8 * j; const LAS float* s = scr + (8 * c) * 33 + n;
        u32x4 o; o.x = pk2(s[0 * 33], s[1 * 33]); o.y = pk2(s[2 * 33], s[3 * 33]); o.z = pk2(s[4 * 33], s[5 * 33]); o.w = pk2(s[6 * 33], s[7 * 33]);
        const int nn = n0 + n, row = rowmode == 0 ? nn : (8 * (nn >> 2) + (nn & 3) + (rowmode == 2 ? 4 : 0));
        *(u32x4*)(WT + (size_t)row * ldo + koff + k0 + 8 * c) = o; }
    asm volatile("s_waitcnt lgkmcnt(0)" ::: "memory");
}
__device__ __forceinline__ void pair_decode(int pi, int& ea, int& eb) { ea = pi < 3 ? 0 : (pi < 5 ? 1 : 2); eb = pi < 3 ? pi + 1 : (pi < 5 ? pi - 1 : 3); }
__device__ __forceinline__ void ph_prologue(const Ctx& F0) {
    const Ctx F = launder(F0);
    LAS float* scr = (LAS float*)(F.lds + F.wave * 16384);
    const int gw = F.vcu * NWAVES + F.wave, NGW = F.G * NWAVES;
    constexpr int I_IN = (D / 64) * (NPROJ / 32), I_OUT = (D / 64) * (D / 32), I_GU1 = (D / 64) * (256 / 32), I_GU = 16 * 2 * I_GU1, I_WD1 = (256 / 64) * (D / 32), I_WD = 24 * 2 * I_WD1;
    constexpr int I_L = I_IN + I_OUT + I_GU + I_WD;
    for (int it = gw; it < DEPTH * I_L; it += NGW) {
        const int l = it / I_L; int r = it % I_L;
        if (r < I_IN) { transpose_item(F.in[3] + (size_t)l * D * NPROJ, D, NPROJ, F.in[2] + l * D, (bf16*)(F.ws + WS_WIN) + (size_t)l * NPROJ * D, D, 0, 0, scr, r, F.lane); continue; } r -= I_IN;
        if (r < I_OUT) { transpose_item(F.in[17] + (size_t)l * D * D, D, D, nullptr, (bf16*)(F.ws + WS_WOUT) + (size_t)l * D * D, D, 0, 0, scr, r, F.lane); continue; } r -= I_OUT;
        if (r < I_GU) { const int e = r / (2 * I_GU1), up = (r / I_GU1) & 1, item = r % I_GU1;
            transpose_item(F.in[up ? 24 : 23] + ((size_t)l * 16 + e) * D * 256, D, 256, F.in[18] + l * D, (bf16*)(F.ws + WS_GU) + ((size_t)l * 16 + e) * 512 * D, D, 0, 1 + up, scr, item, F.lane); continue; } r -= I_GU;
        { const int bk = r / (2 * I_WD1), half = (r / I_WD1) & 1, item = r % I_WD1, g = bk / 6; int ea, eb; pair_decode(bk % 6, ea, eb); const int e = g * 4 + (half ? eb : ea);
            transpose_item(F.in[25] + ((size_t)l * 16 + e) * 256 * D, 256, D, nullptr, (bf16*)(F.ws + WS_WD) + ((size_t)l * 24 + bk) * D * 512, 512, half * 256, 0, scr, item, F.lane); }
    }
    for (int it = gw; it < DEPTH * 32; it += NGW) { const int l = it >> 5;
        transpose_item(F.in[12] + (size_t)l * 256 * 256, 256, 256, nullptr, (bf16*)(F.ws + WS_GLUT) + (size_t)l * 65536, 256, 0, 0, scr, it & 31, F.lane); }
    { const int gt = F.vcu * NTHREADS + F.tid, NGT = F.G * NTHREADS;
      for (int i = gt; i < DEPTH * 65536; i += NGT) { const int l = i >> 16, n = (i >> 8) & 255, k = i & 255;
          const float v = ((n >> 6) == (k >> 6)) ? F.in[14][(((size_t)l * 4 + (n >> 6)) * 64 + (k & 63)) * 64 + (n & 63)] : 0.f;
          ((bf16*)(F.ws + WS_POOLT))[i] = (bf16)f2bf(v); } }
    for (int it = gw; it < DEPTH * SGN * 65; it += NGW) {
        const int l = it / (SGN * 65), g = (it / 65) % SGN, tau = it % 65, p = F.lane;
        const float are = F.in[4][(l * SGN + g) * SP + p], aim = F.in[5][(l * SGN + g) * SP + p], dt = expf(F.in[6][l * SGN + g]);
        float sn, cs; sincosf(aim * dt, &sn, &cs); const float mg = expf(are * dt), lbr = mg * cs, lbi = mg * sn;
        const float nr = lbr - 1.f, ni = lbi, den = are * are + aim * aim, cr = (nr * are + ni * aim) / den, ci = (ni * are - nr * aim) / den;
        float sn2, cs2; sincosf(aim * dt * (float)tau, &sn2, &cs2); const float mg2 = expf(are * dt * (float)tau), lr = mg2 * cs2, li = mg2 * sn2;
        float wr[16], wi[16];
#pragma unroll
        for (int h = 0; h < 16; ++h) { const float br = F.in[7][((size_t)(l * SGN + g) * SP + p) * SG + h], bi = F.in[8][((size_t)(l * SGN + g) * SP + p) * SG + h];
            const float bbr = cr * br - ci * bi, bbi = cr * bi + ci * br; wr[h] = lr * bbr - li * bbi; wi[h] = lr * bbi + li * bbr; }
        bf16* TG = (bf16*)(F.ws + WS_TG) + ((size_t)l * SGN + g) * 1024 * UGP;
        if (tau <= 63) {
            bf16* BZ = (bf16*)(F.ws + WS_BZ) + ((size_t)l * SGN + g) * 256 * 1024; const int s = 63 - tau;
            u32x4 o0, o1, o2, o3;
            o0.x = pk2(wr[0], wr[1]); o0.y = pk2(wr[2], wr[3]); o0.z = pk2(wr[4], wr[5]); o0.w = pk2(wr[6], wr[7]); o1.x = pk2(wr[8], wr[9]); o1.y = pk2(wr[10], wr[11]); o1.z = pk2(wr[12], wr[13]); o1.w = pk2(wr[14], wr[15]);
            o2.x = pk2(wi[0], wi[1]); o2.y = pk2(wi[2], wi[3]); o2.z = pk2(wi[4], wi[5]); o2.w = pk2(wi[6], wi[7]); o3.x = pk2(wi[8], wi[9]); o3.y = pk2(wi[10], wi[11]); o3.z = pk2(wi[12], wi[13]); o3.w = pk2(wi[14], wi[15]);
            *(u32x4*)(BZ + (size_t)p * 1024 + s * 16) = o0; *(u32x4*)(BZ + (size_t)p * 1024 + s * 16 + 8) = o1;
            *(u32x4*)(BZ + (size_t)(64 + p) * 1024 + s * 16) = o2; *(u32x4*)(BZ + (size_t)(64 + p) * 1024 + s * 16 + 8) = o3;
        }
        LAS float* Wst = scr; LAS float* Kt = scr + 128 * 16;
        if (tau <= 63) {
#pragma unroll
            for (int q = 0; q < 4; ++q) { *(LAS f32x4*)(Wst + p * 16 + 4 * q) = (f32x4){wr[4 * q], wr[4 * q + 1], wr[4 * q + 2], wr[4 * q + 3]};
                                          *(LAS f32x4*)(Wst + (64 + p) * 16 + 4 * q) = (f32x4){wi[4 * q], wi[4 * q + 1], wi[4 * q + 2], wi[4 * q + 3]}; }
            const int arow = p & 15, kq = p >> 4; f32x4 kacc = (f32x4){0.f, 0.f, 0.f, 0.f};
            const float* cre = F.in[9] + ((size_t)(l * SGN + g) * SG + arow) * SP; const float* cim = F.in[10] + ((size_t)(l * SGN + g) * SG + arow) * SP;
#pragma unroll 8
            for (int s = 0; s < 32; ++s) { const int k = 4 * s + kq; const float av = (k < 64) ? cre[k] : -cim[k - 64]; const float bv = Wst[k * 16 + arow];
                kacc = __builtin_amdgcn_mfma_f32_16x16x4f32(av, bv, kacc, 0, 0, 0); }
#pragma unroll
            for (int r = 0; r < 4; ++r) Kt[(4 * kq + r) * 16 + arow] = kacc[r];
            asm volatile("s_waitcnt lgkmcnt(0)" ::: "memory");
            const f32x4 t4 = *(const LAS f32x4*)(Kt + 4 * p);
            u32x2 o; o.x = pk2(t4[0], t4[1]); o.y = pk2(t4[2], t4[3]);
            *(u32x2*)((bf16*)(F.ws + WS_KT) + ((size_t)(l * SGN + g) * 64 + tau) * 256 + 4 * p) = o;
        }
        if (tau >= 1) {
#pragma unroll 4
            for (int ho = 0; ho < 16; ++ho) {
                const float ccr = F.in[9][((size_t)(l * SGN + g) * SG + ho) * SP + p], cci = F.in[10][((size_t)(l * SGN + g) * SG + ho) * SP + p];
                const int n = (tau - 1) * 16 + ho;
                TG[(size_t)n * UGP + p] = (bf16)f2bf(ccr * lr - cci * li); TG[(size_t)n * UGP + 64 + p] = (bf16)f2bf(-(ccr * li + cci * lr)); }
        }
    }
}

__device__ __forceinline__ void route_finish(const float (&a)[20], float ssum, int m, bool act, const float* gb_, const float* rb_, int* tokb, float* tokr, float* tokw, LAS int* hist) {
        const float rstd = 1.f / sqrtf(ssum * (1.f / D) + RMS_EPS);
        float lg0 = a[0] * rstd + gb_[0], lg1 = a[1] * rstd + gb_[1], lg2 = a[2] * rstd + gb_[2], lg3 = a[3] * rstd + gb_[3];
        int gs = 0; float gm = lg0;
        if (lg1 > gm) { gm = lg1; gs = 1; } if (lg2 > gm) { gm = lg2; gs = 2; } if (lg3 > gm) { gm = lg3; gs = 3; }
        const float gwt = 1.f / (__expf(lg0 - gm) + __expf(lg1 - gm) + __expf(lg2 - gm) + __expf(lg3 - gm));
        float q0 = a[4], q1 = a[5], q2 = a[6], q3 = a[7], q4 = a[8], q5 = a[9], q6 = a[10], q7 = a[11], q8 = a[12], q9 = a[13], q10 = a[14], q11 = a[15], q12 = a[16], q13 = a[17], q14 = a[18], q15 = a[19];
        asm volatile("" : "+v"(q0), "+v"(q1), "+v"(q2), "+v"(q3), "+v"(q4), "+v"(q5), "+v"(q6), "+v"(q7));
        asm volatile("" : "+v"(q8), "+v"(q9), "+v"(q10), "+v"(q11), "+v"(q12), "+v"(q13), "+v"(q14), "+v"(q15));
        float e0 = gs == 0 ? q0 : gs == 1 ? q4 : gs == 2 ? q8 : q12;
        float e1 = gs == 0 ? q1 : gs == 1 ? q5 : gs == 2 ? q9 : q13;
        float e2 = gs == 0 ? q2 : gs == 1 ? q6 : gs == 2 ? q10 : q14;
        float e3 = gs == 0 ? q3 : gs == 1 ? q7 : gs == 2 ? q11 : q15;
        e0 = e0 * rstd + rb_[gs * 4 + 0]; e1 = e1 * rstd + rb_[gs * 4 + 1]; e2 = e2 * rstd + rb_[gs * 4 + 2]; e3 = e3 * rstd + rb_[gs * 4 + 3];
        int t1 = 0; float v1 = e0;
        if (e1 > v1) { v1 = e1; t1 = 1; } if (e2 > v1) { v1 = e2; t1 = 2; } if (e3 > v1) { v1 = e3; t1 = 3; }
        int t2 = -1; float v2 = -3.0e38f;
        if (t1 != 0 && e0 > v2) { v2 = e0; t2 = 0; } if (t1 != 1 && e1 > v2) { v2 = e1; t2 = 1; } if (t1 != 2 && e2 > v2) { v2 = e2; t2 = 2; } if (t1 != 3 && e3 > v2) { v2 = e3; t2 = 3; }
        const float p2 = __expf(v2 - v1), w1 = gwt / (1.f + p2), w2 = gwt * p2 / (1.f + p2);
        const int lo = t1 < t2 ? t1 : t2, hi = t1 < t2 ? t2 : t1; const float wlo = t1 < t2 ? w1 : w2, whi = t1 < t2 ? w2 : w1;
        const int pi = lo == 0 ? hi - 1 : (lo == 1 ? hi + 1 : 5), bk = gs * 6 + pi;
        if (act) { tokb[m] = bk; tokr[m] = rstd; tokw[2 * m] = wlo; tokw[2 * m + 1] = whi; __hip_atomic_fetch_add(hist + bk, 1, __ATOMIC_RELAXED, __HIP_MEMORY_SCOPE_WORKGROUP); }
}
__device__ __forceinline__ void ph_route(const Ctx& F0, int l) {
    const Ctx F = launder(F0);
    constexpr int WLD = 1032;
    LAS bf16* Wh = (LAS bf16*)F.lds;
    LAS bf16* Wlo = Wh + 20 * WLD;
    LAS float* LG = (LAS float*)(F.lds + 4 * 20 * WLD);
    LAS int* hist = (LAS int*)(F.lds + 4 * 20 * WLD + 8 * 320 * 4);
    const float* g2 = F.in[18] + l * D;
    const f32x4* gw4 = (const f32x4*)(F.in[19] + (size_t)l * D * 4); const f32x4* rw4 = (const f32x4*)(F.in[21] + (size_t)l * 4 * D * 4);
    const float* gb_ = F.in[20] + l * 4; const float* rb_ = F.in[22] + l * 16;
    for (int idx = F.tid; idx < D * 5; idx += NTHREADS) { const int k = idx % D, q = idx / D;
        f32x4 v = (q == 0) ? gw4[k] : rw4[(q - 1) * D + k]; v = v * g2[k];
#pragma unroll
        for (int i = 0; i < 4; ++i) { const unsigned h = f2bf(v[i]); Wh[(q * 4 + i) * WLD + k] = (bf16)h; Wlo[(q * 4 + i) * WLD + k] = (bf16)f2bf(v[i] - bf2f(h)); } }
    if (F.tid < 32) hist[F.tid] = 0;
    __syncthreads();
    int* tokb = (int*)(F.ws + WS_TOKB); float* tokr = (float*)(F.ws + WS_TOKR); float* tokw = (float*)(F.ws + WS_TOKW);
    const int i16 = F.lane & 15, kq = F.lane >> 4, m0 = F.vcu * 128 + F.wave * 16;
    const u32x4* xr = (const u32x4*)(P_XB(F) + (size_t)(m0 + i16) * D) + kq;
    const int c1 = 16 + (i16 & 3);
    const LAS bf16* bh0 = Wh + i16 * WLD + 8 * kq; const LAS bf16* bl0 = Wlo + i16 * WLD + 8 * kq;
    const LAS bf16* bh1 = Wh + c1 * WLD + 8 * kq;  const LAS bf16* bl1 = Wlo + c1 * WLD + 8 * kq;
    f32x4 acc0 = (f32x4){0.f, 0.f, 0.f, 0.f}, acc1 = acc0; float ss = 0.f;
#pragma unroll 4
    for (int c = 0; c < 32; ++c) {
        const u32x4 xa = xr[4 * c];
        const float x0 = bf2f(xa.x & 0xffffu), x1 = __builtin_bit_cast(float, xa.x & 0xffff0000u), x2 = bf2f(xa.y & 0xffffu), x3 = __builtin_bit_cast(float, xa.y & 0xffff0000u);
        const float x4 = bf2f(xa.z & 0xffffu), x5 = __builtin_bit_cast(float, xa.z & 0xffff0000u), x6 = bf2f(xa.w & 0xffffu), x7 = __builtin_bit_cast(float, xa.w & 0xffff0000u);
        ss += ((x0 * x0 + x1 * x1) + (x2 * x2 + x3 * x3)) + ((x4 * x4 + x5 * x5) + (x6 * x6 + x7 * x7));
        const pg8::bf16x8 av = __builtin_bit_cast(pg8::bf16x8, xa);
        const pg8::bf16x8 h0 = *(const LAS pg8::bf16x8*)(bh0 + 32 * c), l0 = *(const LAS pg8::bf16x8*)(bl0 + 32 * c);
        const pg8::bf16x8 h1 = *(const LAS pg8::bf16x8*)(bh1 + 32 * c), l1 = *(const LAS pg8::bf16x8*)(bl1 + 32 * c);
        acc0 = __builtin_amdgcn_mfma_f32_16x16x32_bf16(av, h0, acc0, 0, 0, 0); acc1 = __builtin_amdgcn_mfma_f32_16x16x32_bf16(av, h1, acc1, 0, 0, 0);
        acc0 = __builtin_amdgcn_mfma_f32_16x16x32_bf16(av, l0, acc0, 0, 0, 0); acc1 = __builtin_amdgcn_mfma_f32_16x16x32_bf16(av, l1, acc1, 0, 0, 0);
    }
    ss += xshfl<16>(ss);
    { const unsigned u = __builtin_bit_cast(unsigned, ss); auto r = __builtin_amdgcn_permlane32_swap(u, u, false, false);
      ss = __builtin_bit_cast(float, (unsigned)r[0]) + __builtin_bit_cast(float, (unsigned)r[1]); }
    LAS float* lg = LG + F.wave * 320;
#pragma unroll
    for (int r = 0; r < 4; ++r) { lg[(4 * kq + r) * 20 + i16] = acc0[r]; if (i16 < 4) lg[(4 * kq + r) * 20 + 16 + i16] = acc1[r]; }
    asm volatile("s_waitcnt lgkmcnt(0)" ::: "memory");
    float a[20];
#pragma unroll
    for (int j = 0; j < 5; ++j) { const f32x4 t4 = *(const LAS f32x4*)(lg + i16 * 20 + 4 * j); a[4 * j] = t4[0]; a[4 * j + 1] = t4[1]; a[4 * j + 2] = t4[2]; a[4 * j + 3] = t4[3]; }
    route_finish(a, ss, m0 + i16, kq == 0, gb_, rb_, tokb, tokr, tokw, hist);
    __syncthreads();
    if (F.tid < 24) __hip_atomic_store((int*)(F.ws + WS_WGCNT) + F.vcu * 24 + F.tid, hist[F.tid], __ATOMIC_RELAXED, __HIP_MEMORY_SCOPE_AGENT);
}
__device__ __forceinline__ void ph_place(const Ctx& F0) {
    const Ctx F = launder(F0);
    LAS int* ptot = (LAS int*)F.lds;
    LAS int* pbef = ptot + 512;
    LAS int* bstart = pbef + 512;
    LAS int* btot = bstart + 32;
    LAS int* carry = btot + 32;
    LAS int* rowidx = carry + 32;
    const int* wgcnt = (const int*)(F.ws + WS_WGCNT);
    int* rowtok = (int*)(F.ws + WS_ROWTOK); float* roww = (float*)(F.ws + WS_ROWW); int* tileb = (int*)(F.ws + WS_TILEB);
    const int* tokb = (const int*)(F.ws + WS_TOKB); const float* tokr = (const float*)(F.ws + WS_TOKR); const float* tokw = (const float*)(F.ws + WS_TOKW);
    { const int p = F.tid >> 5, b = F.tid & 31; int tot = 0, bef = 0;
      if (b < 24) for (int v = p * 16; v < p * 16 + 16; ++v) { const int c = wgcnt[v * 24 + b]; tot += c; if (v < F.vcu) bef += c; }
      ptot[p * 32 + b] = tot; pbef[p * 32 + b] = bef; }
    __syncthreads();
    if (F.tid < 32) { int tot = 0, bef = 0; for (int p = 0; p < 16; ++p) { tot += ptot[p * 32 + F.tid]; bef += pbef[p * 32 + F.tid]; } btot[F.tid] = tot; carry[F.tid] = bef; }
    __syncthreads();
    if (F.tid == 0) { int s = 0; for (int b = 0; b < 24; ++b) { bstart[b] = s; s += (btot[b] + 255) & ~255; } bstart[24] = s; }
    __syncthreads();
    if (F.tid < 24) carry[F.tid] += bstart[F.tid];
    if (F.vcu == 0) {
        if (F.tid == 0) tileb[0] = bstart[24] >> 8;
        for (int b = 0; b < 24; ++b) { const int s = bstart[b], e = bstart[b + 1];
            for (int t = (s >> 8) + F.tid; t < (e >> 8); t += NTHREADS) tileb[1 + t] = b;
            for (int r = s + btot[b] + F.tid; r < e; r += NTHREADS) __hip_atomic_store(rowtok + r, -1, __ATOMIC_RELAXED, __HIP_MEMORY_SCOPE_AGENT); }
    }
    __syncthreads();
    if (F.wave == 0) {
        for (int pass = 0; pass < 2; ++pass) { const int i = pass * 64 + F.lane, bi = tokb[F.vcu * 128 + i]; int row = 0;
#pragma unroll 1
            for (int b = 0; b < 24; ++b) { const unsigned long long mask = __ballot(bi == b); const int c = carry[b];
                if (bi == b) row = c + __builtin_popcountll(mask & ((1ull << F.lane) - 1ull));
                asm volatile("s_waitcnt lgkmcnt(0)" ::: "memory");
                if (F.lane == 0) carry[b] = c + __builtin_popcountll(mask);
                asm volatile("s_waitcnt lgkmcnt(0)" ::: "memory"); }
            rowidx[i] = row; }
    }
    __syncthreads();
    if (F.lane < 16) { const int li = F.wave * 16 + F.lane, m = F.vcu * 128 + li, row = rowidx[li];
        const float rstd = tokr[m];
        const unsigned long long w2 = (unsigned long long)__builtin_bit_cast(unsigned, tokw[2 * m]) | ((unsigned long long)__builtin_bit_cast(unsigned, tokw[2 * m + 1]) << 32);
        __hip_atomic_store(rowtok + row, m, __ATOMIC_RELAXED, __HIP_MEMORY_SCOPE_AGENT);
        __hip_atomic_store((unsigned long long*)(roww + 2 * row), w2, __ATOMIC_RELAXED, __HIP_MEMORY_SCOPE_AGENT);
        __hip_atomic_store((float*)(F.ws + WS_ROWR) + row, rstd, __ATOMIC_RELAXED, __HIP_MEMORY_SCOPE_AGENT); }
}
struct MoeOrder {
    int G, c; bool down; int NT, bks;
    __device__ __forceinline__ void init(const int* tileb) {
        const GAS int* tb_ = (const GAS int*)tileb;
        const int nt_ = tb_[0]; int r0 = c >> 2, r1 = (G + c) >> 2, r2 = (2 * G + c) >> 2, r3 = (3 * G + c) >> 2;
        r0 = r0 < MOE_MAXT ? r0 : MOE_MAXT - 1; r1 = r1 < MOE_MAXT ? r1 : MOE_MAXT - 1; r2 = r2 < MOE_MAXT ? r2 : MOE_MAXT - 1; r3 = r3 < MOE_MAXT ? r3 : MOE_MAXT - 1;
        const int b0 = tb_[1 + r0], b1 = tb_[1 + r1], b2 = tb_[1 + r2], b3 = tb_[1 + r3];
        int n_ = __builtin_amdgcn_readfirstlane(nt_), p_ = __builtin_amdgcn_readfirstlane((b0 & 255) | ((b1 & 255) << 8) | ((b2 & 255) << 16) | ((b3 & 255) << 24));
        asm volatile("" : "+s"(n_), "+s"(p_)); NT = n_; bks = p_;
    }
    __device__ __forceinline__ bool next(int i, pg8::Unit& u) const {
        const int L = i * G + c; if (i > 3 || L >= NT * 4) return false;
        const int rt = L >> 2, pn = L & 3, b = (bks >> (8 * i)) & 255;
        if (down) { u.pm = rt; u.pn = b * 4 + pn; u.aux = pn; }
        else { int ea, eb; pair_decode(b % 6, ea, eb); const int e = (b / 6) * 4 + (pn < 2 ? ea : eb); u.pm = rt; u.pn = e * 2 + (pn & 1); u.aux = pn; }
        return true;
    }
};
struct EpiGU {
    static constexpr bool PERM = true;
    bf16* H; const float* roww; const float* rowr;
    __device__ __forceinline__ void operator()(const f32x4 (&acc)[2][2][4][2], const pg8::Unit& u, int wr, int wc, int fr_, int fq_) const {
        const int ln_ = lane_id(), fr = ln_ & 15, fq = ln_ >> 4; (void)fr_; (void)fq_;
        const int row0 = u.pm * 256 + wr * 64 + fr, cl = u.aux * 128 + 16 * wc + 4 * fq, ws = u.aux >> 1;
#pragma unroll
        for (int ai = 0; ai < 2; ++ai)
#pragma unroll
            for (int m = 0; m < 4; ++m) { const int r = row0 + ai * 128 + m * 16; const float rr = rowr[r], w = roww[2 * r + ws] * rr;
#pragma unroll
                for (int bj = 0; bj < 2; ++bj) { const f32x4 g = acc[ai][bj][m][0], up = acc[ai][bj][m][1]; f32x4 a;
#pragma unroll
                    for (int i = 0; i < 4; ++i) { const float gg = g[i] * rr; a[i] = gg * sigmoidf_(gg) * up[i] * w; }
                    u32x2 o; o.x = pg8::cvt_pk_bf16(a[0], a[1]); o.y = pg8::cvt_pk_bf16(a[2], a[3]);
                    *(u32x2*)(H + (size_t)r * 512 + cl + bj * 64) = o; } }
    }
};
struct EpiDown {
    static constexpr bool PERM = true;
    bf16* RB; const int* rowtok;
    __device__ __forceinline__ void operator()(const f32x4 (&acc)[2][2][4][2], const pg8::Unit& u, int wr, int wc, int fr_, int fq_) const {
        const int ln_ = lane_id(), fr = ln_ & 15, fq = ln_ >> 4; (void)fr_; (void)fq_;
        const int row0 = u.pm * 256 + wr * 64 + fr, col0 = u.aux * 256 + wc * 32 + 8 * fq;
        int tok[8];
#pragma unroll
        for (int i = 0; i < 8; ++i) tok[i] = rowtok[row0 + (i >> 2) * 128 + (i & 3) * 16];
#pragma unroll
        for (int ai = 0; ai < 2; ++ai) { u32x4 x[4][2];
#pragma unroll
            for (int m = 0; m < 4; ++m) { const int tk = tok[ai * 4 + m]; const bf16* rp = RB + (size_t)(tk < 0 ? 0 : tk) * D + col0; x[m][0] = *(const u32x4*)rp; x[m][1] = *(const u32x4*)(rp + 128); }
#pragma unroll
            for (int m = 0; m < 4; ++m) { const int tk = tok[ai * 4 + m]; bf16* rp = RB + (size_t)(tk < 0 ? 0 : tk) * D + col0;
#pragma unroll
                for (int bj = 0; bj < 2; ++bj) { const u32x4 xx = x[m][bj]; const f32x4 a0 = acc[ai][bj][m][0], a1 = acc[ai][bj][m][1]; u32x4 w;
                    w.x = pg8::cvt_pk_bf16(bf2f(xx.x & 0xffffu) + a0[0], bf2f(xx.x >> 16) + a0[1]); w.y = pg8::cvt_pk_bf16(bf2f(xx.y & 0xffffu) + a0[2], bf2f(xx.y >> 16) + a0[3]);
                    w.z = pg8::cvt_pk_bf16(bf2f(xx.z & 0xffffu) + a1[0], bf2f(xx.z >> 16) + a1[1]); w.w = pg8::cvt_pk_bf16(bf2f(xx.w & 0xffffu) + a1[2], bf2f(xx.w >> 16) + a1[3]);
                    if (tk >= 0) *(u32x4*)(rp + bj * 128) = w; } }
            asm volatile("" ::: "memory"); }
    }
};

struct SsmOrder { int G, c, mode;
    __device__ __forceinline__ bool next(int i, pg8::Unit& u) const { const int L = i * G + c;
        if (mode == 1) { if (L >= 32) return false; u.pm = L; u.pn = L >> 1; u.aux = 0; return true; }
        if (L >= 128) return false; const int g = L >> 3; u.pm = g * 2 + ((L >> 2) & 1); u.pn = g * 4 + (L & 3); u.aux = L & 3; u.kt = 2 + 4 * ((L & 3) + 1); return true; } };
struct HalfOrder { int L;
    __device__ __forceinline__ bool next(int i, pg8::Unit& u) const { if (i > 0 || L < 0 || L >= 128) return false; u.pm = L; u.pn = 0; u.aux = 0; return true; } };
struct EpiZ { static constexpr bool PERM = false; float* ZB;
    __device__ __forceinline__ void operator()(const f32x4 (&acc)[2][2][4][2], const pg8::Unit& u, int wr, int wc, int fr_, int fq_) const {
        const int ln_ = lane_id(), fr = ln_ & 15, fq = ln_ >> 4; (void)fr_; (void)fq_;
        const int row0 = u.pm * 256 + wr * 64 + fr, col0 = wc * 32 + 4 * fq;
#pragma unroll
        for (int ai = 0; ai < 2; ++ai)
#pragma unroll
            for (int m = 0; m < 4; ++m)
#pragma unroll
                for (int n = 0; n < 2; ++n) *(f32x4*)(ZB + (size_t)(row0 + ai * 128 + m * 16) * 128 + col0 + n * 16) = acc[ai][0][m][n];
    } };
struct EpiSsm2 { static constexpr bool PERM = true; const bf16* UG; bf16* YS; const float* dvec;
    __device__ __forceinline__ void operator()(const f32x4 (&acc)[2][2][4][2], const pg8::Unit& u, int wr, int wc, int fr_, int fq_) const {
        const int ln_ = lane_id(), fr = ln_ & 15, fq = ln_ >> 4; (void)fr_; (void)fq_;
        const int g = u.pm >> 1, cr0 = (u.pm & 1) * 256 + wr * 64 + fr;
#pragma unroll
        for (int bj = 0; bj < 2; ++bj) { const int n0 = u.aux * 256 + bj * 128 + wc * 32 + 8 * fq, to = n0 >> 4, ho0 = n0 & 15;
            const f32x4 d0 = *(const f32x4*)(dvec + g * 16 + ho0), d1 = *(const f32x4*)(dvec + g * 16 + ho0 + 4);
#pragma unroll
            for (int ai = 0; ai < 2; ++ai)
#pragma unroll
                for (int m = 0; m < 4; ++m) { const int cr = cr0 + ai * 128 + m * 16;
                    const u32x4 uu = *(const u32x4*)(UG + ((size_t)(g * 512 + cr)) * UGP + UOF + n0);
                    const f32x4 a0 = acc[ai][bj][m][0], a1 = acc[ai][bj][m][1]; float y[8];
                    y[0] = gelu_tanh(a0[0] + d0[0] * bf2f(uu.x & 0xffffu)); y[1] = gelu_tanh(a0[1] + d0[1] * bf2f(uu.x >> 16));
                    y[2] = gelu_tanh(a0[2] + d0[2] * bf2f(uu.y & 0xffffu)); y[3] = gelu_tanh(a0[3] + d0[3] * bf2f(uu.y >> 16));
                    y[4] = gelu_tanh(a1[0] + d1[0] * bf2f(uu.z & 0xffffu)); y[5] = gelu_tanh(a1[1] + d1[1] * bf2f(uu.z >> 16));
                    y[6] = gelu_tanh(a1[2] + d1[2] * bf2f(uu.w & 0xffffu)); y[7] = gelu_tanh(a1[3] + d1[3] * bf2f(uu.w >> 16));
                    u32x4 w; w.x = pg8::cvt_pk_bf16(y[0], y[1]); w.y = pg8::cvt_pk_bf16(y[2], y[3]); w.z = pg8::cvt_pk_bf16(y[4], y[5]); w.w = pg8::cvt_pk_bf16(y[6], y[7]);
                    *(u32x4*)(YS + ((size_t)cr * 64 + to) * 256 + g * 16 + ho0) = w; } }
    } };
struct EpiGluE { static constexpr bool PERM = true; const bf16* YS; bf16* YMIX; const float* gb;
    __device__ __forceinline__ void operator()(const f32x4 (&acc)[2][2][4][2], const pg8::Unit& u, int wr, int wc, int fr_, int fq_) const {
        const int ln_ = lane_id(), fr = ln_ & 15, fq = ln_ >> 4; (void)fr_; (void)fq_;
        const int row0 = u.pm * 256 + wr * 64 + fr;
#pragma unroll
        for (int bj = 0; bj < 2; ++bj) { const int n0 = bj * 128 + wc * 32 + 8 * fq; const f32x4 b0 = *(const f32x4*)(gb + n0), b1 = *(const f32x4*)(gb + n0 + 4);
#pragma unroll
            for (int ai = 0; ai < 2; ++ai)
#pragma unroll
                for (int m = 0; m < 4; ++m) { const size_t r = (size_t)(row0 + ai * 128 + m * 16); const u32x4 yy = *(const u32x4*)(YS + r * 256 + n0);
                    const f32x4 a0 = acc[ai][bj][m][0] + b0, a1 = acc[ai][bj][m][1] + b1; float o[8];
                    o[0] = bf2f(yy.x & 0xffffu) * sigmoidf_(a0[0]); o[1] = bf2f(yy.x >> 16) * sigmoidf_(a0[1]); o[2] = bf2f(yy.y & 0xffffu) * sigmoidf_(a0[2]); o[3] = bf2f(yy.y >> 16) * sigmoidf_(a0[3]);
                    o[4] = bf2f(yy.z & 0xffffu) * sigmoidf_(a1[0]); o[5] = bf2f(yy.z >> 16) * sigmoidf_(a1[1]); o[6] = bf2f(yy.w & 0xffffu) * sigmoidf_(a1[2]); o[7] = bf2f(yy.w >> 16) * sigmoidf_(a1[3]);
                    u32x4 w; w.x = pg8::cvt_pk_bf16(o[0], o[1]); w.y = pg8::cvt_pk_bf16(o[2], o[3]); w.z = pg8::cvt_pk_bf16(o[4], o[5]); w.w = pg8::cvt_pk_bf16(o[6], o[7]);
                    *(u32x4*)(YMIX + r * 1024 + n0) = w; } }
    } };
struct EpiPoolE { static constexpr bool PERM = true; bf16* YMIX; const float* pb; const float* ps;
    __device__ __forceinline__ void operator()(const f32x4 (&acc)[2][2][4][2], const pg8::Unit& u, int wr, int wc, int fr_, int fq_) const {
        const int ln_ = lane_id(), fr = ln_ & 15, fq = ln_ >> 4; (void)fr_; (void)fq_;
        const int row0 = u.pm * 256 + wr * 64 + fr;
#pragma unroll
        for (int bj = 0; bj < 2; ++bj) { const int n0 = bj * 128 + wc * 32 + 8 * fq; const f32x4 b0 = *(const f32x4*)(pb + n0), b1 = *(const f32x4*)(pb + n0 + 4), s0 = *(const f32x4*)(ps + n0), s1 = *(const f32x4*)(ps + n0 + 4);
#pragma unroll
            for (int ai = 0; ai < 2; ++ai)
#pragma unroll
                for (int m = 0; m < 4; ++m) { const size_t r = (size_t)(row0 + ai * 128 + m * 16);
                    const f32x4 a0 = (acc[ai][bj][m][0] + b0) * s0, a1 = (acc[ai][bj][m][1] + b1) * s1;
                    u32x4 w; w.x = pg8::cvt_pk_bf16(a0[0], a0[1]); w.y = pg8::cvt_pk_bf16(a0[2], a0[3]); w.z = pg8::cvt_pk_bf16(a1[0], a1[1]); w.w = pg8::cvt_pk_bf16(a1[2], a1[3]);
                    *(u32x4*)(YMIX + r * 1024 + 256 + n0) = w; } }
    } };
__device__ __forceinline__ void ph_tg_expand(const Ctx& F0, int l, int bx, int w0) {
    const Ctx F = launder(F0);
    if (bx < w0) return;
    const int gw = (bx - w0) * NWAVES + F.wave, NGW = (F.G - w0) * NWAVES;
    const bf16* KT = (const bf16*)(F.ws + WS_KT) + (size_t)l * SGN * 64 * 256;
    bf16* TG0 = (bf16*)(F.ws + WS_TG) + (size_t)l * SGN * 1024 * UGP;
#pragma unroll 2
    for (int r = gw; r < SGN * 1024; r += NGW) { const int g = r >> 10, n = r & 1023, to = n >> 4, ho = n & 15;
        bf16* d = TG0 + ((size_t)g * 1024 + n) * UGP;
#pragma unroll
        for (int half = 0; half < 2; ++half) { const int ti = half * 32 + (F.lane >> 1), tau = to - ti;
            u32x4 v = (u32x4){0u, 0u, 0u, 0u};
            if (tau >= 0) v = *(const u32x4*)(KT + (((size_t)g * 64 + tau) * 16 + ho) * 16 + (F.lane & 1) * 8);
            if (half * 512 + F.lane * 8 < ((n >> 8) + 1) * 256) *(u32x4*)(d + UOF + half * 512 + F.lane * 8) = v; } }
}
__device__ __forceinline__ void ph_ssm_scan(const Ctx& F0, int l) {
    const Ctx F = launder(F0);
    if (F.wave != 0 || (F.vcu & 1) != 0 || F.vcu >= 256) return;
    for (int it = (F.vcu >> 2) * 2 + ((F.vcu >> 1) & 1); it < SGN * NB; it += SGN * NB) {
        const int g = it >> 3, b = it & 7, p = F.lane;
        const float are = F.in[4][(l * SGN + g) * SP + p], aim = F.in[5][(l * SGN + g) * SP + p], dt = expf(F.in[6][l * SGN + g]);
        float sn, cs; sincosf(aim * dt * 64.f, &sn, &cs); const float mg = expf(are * dt * 64.f), lr = mg * cs, li = mg * sn;
        const float* Z = (const float*)(F.ws + WS_ZB) + ((size_t)g * 512 + b * 64) * 128;
        bf16* U = P_UG(F) + ((size_t)g * 512 + b * 64) * UGP;
        float sr = 0.f, si = 0.f;
#pragma unroll 1
        for (int c0 = 0; c0 < 64; c0 += 32) {
            float zr[32], zi[32];
#pragma unroll
            for (int j = 0; j < 32; ++j) { zr[j] = Z[(c0 + j) * 128 + p]; zi[j] = Z[(c0 + j) * 128 + 64 + p]; }
#pragma unroll
            for (int j = 0; j < 32; ++j) {
                U[(size_t)(c0 + j) * UGP + p] = (bf16)f2bf(sr); U[(size_t)(c0 + j) * UGP + 64 + p] = (bf16)f2bf(si);
                const float nr = lr * sr - li * si + zr[j], ni = lr * si + li * sr + zi[j]; sr = nr; si = ni; }
        }
    }
}

namespace moba {
using bf16x8 = __attribute__((ext_vector_type(8))) short;
using s16x4 = __attribute__((ext_vector_type(4))) short;
using f32x16 = __attribute__((ext_vector_type(16))) float;
typedef short v4i16_t __attribute__((ext_vector_type(4)));
typedef float f32x2_t __attribute__((ext_vector_type(2))); typedef __bf16 bf16x2_t __attribute__((ext_vector_type(2)));
constexpr int L_K = 0, L_V = 49152, L_TB = 98304, L_KM = L_TB + 4 * 768 * 4, L_END = L_KM + 16 * 64 * 4;
__device__ __forceinline__ unsigned cvtpk(float lo, float hi) { f32x2_t v = {lo, hi}; bf16x2_t b = __builtin_convertvector(v, bf16x2_t); return __builtin_bit_cast(unsigned, b); }
__device__ __forceinline__ s16x4 vtr(const LAS char* p) { return __builtin_bit_cast(s16x4, __builtin_amdgcn_ds_read_tr16_b64_v4i16((LAS v4i16_t*)p)); }
__device__ __forceinline__ float hmax(float v) { const unsigned u = __builtin_bit_cast(unsigned, v); auto r = __builtin_amdgcn_permlane32_swap(u, u, false, false); return fmaxf(__builtin_bit_cast(float, (unsigned)r[0]), __builtin_bit_cast(float, (unsigned)r[1])); }
__device__ __forceinline__ float hsum(float v) { const unsigned u = __builtin_bit_cast(unsigned, v); auto r = __builtin_amdgcn_permlane32_swap(u, u, false, false); return __builtin_bit_cast(float, (unsigned)r[0]) + __builtin_bit_cast(float, (unsigned)r[1]); }

constexpr int L_LIST = L_END, L_WCNT = 32768;
#define MOBA_CVEC() f32x16 cvec; do { const float ci_ = bfar - mref; _Pragma("unroll") for (int r = 0; r < 16; ++r) cvec[r] = ci_; } while (0)
#define MOBA_QK(P0, P1, KB) do { { const bf16x8 a0 = *(const LAS bf16x8*)(kp0 + (KB)), a1 = *(const LAS bf16x8*)(kp0 + (KB) + 512); \
          P0 = __builtin_amdgcn_mfma_f32_32x32x16_bf16(a0, qr[0], cvec, 0, 0, 0); P1 = __builtin_amdgcn_mfma_f32_32x32x16_bf16(a1, qr[0], cvec, 0, 0, 0); } \
        _Pragma("unroll") for (int d0 = 1; d0 < 4; ++d0) { const bf16x8 a0 = *(const LAS bf16x8*)(kp0 + (KB) + d0 * 2048), a1 = *(const LAS bf16x8*)(kp0 + (KB) + d0 * 2048 + 512); \
            P0 = __builtin_amdgcn_mfma_f32_32x32x16_bf16(a0, qr[d0], P0, 0, 0, 0); P1 = __builtin_amdgcn_mfma_f32_32x32x16_bf16(a1, qr[d0], P1, 0, 0, 0); } } while (0)
#define MOBA_NEARMAX(P0, P1, JN, OUT) do { const int jn_ = (JN); if (jn_ >= 0) { const int A_ = qrel - 64 * (jn_ - 4) - 4 * hi + 256, s_ = 767 - A_, c_ = s_ & 3; \
            const LAS f32x4* t4 = (const LAS f32x4*)(tb + c_ * 768 + (s_ - c_)); \
            _Pragma("unroll") for (int g = 0; g < 4; ++g) { const f32x4 x0 = t4[2 * g], x1 = t4[2 * g + 8]; \
                _Pragma("unroll") for (int j = 0; j < 4; ++j) { P0[4 * g + j] += x0[j]; P1[4 * g + j] += x1[j]; } } } \
        float ra = __builtin_fmaxf(__builtin_fmaxf(P0[0], P0[1]), P1[0]), rb = __builtin_fmaxf(__builtin_fmaxf(P0[2], P0[3]), P1[1]); \
        ra = __builtin_fmaxf(__builtin_fmaxf(ra, P1[2]), P1[3]); \
        _Pragma("unroll") for (int r = 4; r < 16; r += 4) { ra = __builtin_fmaxf(__builtin_fmaxf(ra, P0[r]), P0[r + 1]); rb = __builtin_fmaxf(__builtin_fmaxf(rb, P0[r + 2]), P0[r + 3]); \
            ra = __builtin_fmaxf(__builtin_fmaxf(ra, P1[r]), P1[r + 1]); rb = __builtin_fmaxf(__builtin_fmaxf(rb, P1[r + 2]), P1[r + 3]); } \
        OUT = hmax(__builtin_fmaxf(ra, rb)); } while (0)
#define MOBA_STEP(PC0, PC1, PN0, PN1, JNN, KBN, VBC, HASN) do { \
        bf16x8 vf[8], kf[8]; \
        if (HASN) { _Pragma("unroll") for (int d0 = 0; d0 < 4; ++d0) { kf[2 * d0] = *(const LAS bf16x8*)(kp0 + (KBN) + d0 * 2048); kf[2 * d0 + 1] = *(const LAS bf16x8*)(kp0 + (KBN) + d0 * 2048 + 512); } } \
        __builtin_amdgcn_sched_barrier(0); \
        if (__any(rm > 8.f)) { const float dl = __builtin_fmaxf(rm, 0.f), alpha = __builtin_amdgcn_exp2f(-dl); mref += dl; l *= alpha; \
            _Pragma("unroll") for (int r = 0; r < 16; ++r) { PC0[r] -= dl; PC1[r] -= dl; o0[r] *= alpha; o1[r] *= alpha; } } \
        if (HASN) { MOBA_CVEC(); \
                    PN0 = __builtin_amdgcn_mfma_f32_32x32x16_bf16(kf[0], qr[0], cvec, 0, 0, 0); PN1 = __builtin_amdgcn_mfma_f32_32x32x16_bf16(kf[1], qr[0], cvec, 0, 0, 0); \
                    _Pragma("unroll") for (int d0 = 1; d0 < 4; ++d0) { PN0 = __builtin_amdgcn_mfma_f32_32x32x16_bf16(kf[2 * d0], qr[d0], PN0, 0, 0, 0); PN1 = __builtin_amdgcn_mfma_f32_32x32x16_bf16(kf[2 * d0 + 1], qr[d0], PN1, 0, 0, 0); } } \
        { const LAS char* vp = vp0 + (VBC); \
        _Pragma("unroll") for (int k = 0; k < 4; ++k) { \
            const s16x4 lo0 = vtr(vp + k * 1024), hi0 = vtr(vp + k * 1024 + 512), lo1 = vtr(vp + 4096 + k * 1024), hi1 = vtr(vp + 4096 + k * 1024 + 512); \
            vf[2 * k] = (bf16x8){lo0[0], lo0[1], lo0[2], lo0[3], hi0[0], hi0[1], hi0[2], hi0[3]}; vf[2 * k + 1] = (bf16x8){lo1[0], lo1[1], lo1[2], lo1[3], hi1[0], hi1[1], hi1[2], hi1[3]}; } } \
        __builtin_amdgcn_sched_barrier(0); \
        float s0 = 0.f, s1 = 0.f; u32x4 pw[4]; \
        _Pragma("unroll") for (int r = 0; r < 16; ++r) { PC0[r] = __builtin_amdgcn_exp2f(PC0[r]); PC1[r] = __builtin_amdgcn_exp2f(PC1[r]); s0 += PC0[r]; s1 += PC1[r]; } \
        l += s0 + s1; \
        _Pragma("unroll") for (int q = 0; q < 4; ++q) { pw[0][q] = cvtpk(PC0[2 * q], PC0[2 * q + 1]); pw[1][q] = cvtpk(PC0[8 + 2 * q], PC0[9 + 2 * q]); pw[2][q] = cvtpk(PC1[2 * q], PC1[2 * q + 1]); pw[3][q] = cvtpk(PC1[8 + 2 * q], PC1[9 + 2 * q]); } \
        _Pragma("unroll") for (int k = 0; k < 4; ++k) { const bf16x8 pa = __builtin_bit_cast(bf16x8, pw[k]); \
            o0 = __builtin_amdgcn_mfma_f32_32x32x16_bf16(vf[2 * k], pa, o0, 0, 0, 0); o1 = __builtin_amdgcn_mfma_f32_32x32x16_bf16(vf[2 * k + 1], pa, o1, 0, 0, 0); } \
        if (HASN) MOBA_NEARMAX(PN0, PN1, JNN, rm); \
    } while (0)
#define MOBA_BLOCK4(JN0, PRE4) \
    float mref = 0.f, l = 0.f; f32x16 o0 = f32x16{}, o1 = f32x16{}; f32x16 pa0, pa1, pb0, pb1; float rm; \
    { const int jn0_ = (JN0); \
      { MOBA_CVEC(); MOBA_QK(pa0, pa1, 0); } MOBA_NEARMAX(pa0, pa1, jn0_, rm); \
      MOBA_STEP(pa0, pa1, pb0, pb1, (jn0_ < 0 ? -1 : jn0_ + 1), 8192, 0, true); \
      MOBA_STEP(pb0, pb1, pa0, pa1, (jn0_ < 0 ? -1 : jn0_ + 2), 16384, 8192, true); \
      MOBA_STEP(pa0, pa1, pb0, pb1, (jn0_ < 0 ? -1 : jn0_ + 3), 24576, 16384, true); \
      PRE4; \
      MOBA_STEP(pb0, pb1, pa0, pa1, -1, 0, 24576, false); }
__device__ __forceinline__ void load_block(const bf16* K, const bf16* V, size_t row0, int h, int wid, int lane, LAS char* lds) {
    const bf16* ksrc = K + (row0 + lane) * 512 + h * 64 + wid * 8;
    const bf16* vsrc = V + (row0 + 16 * (wid & 3) + (lane >> 2)) * 512 + h * 64 + (wid >> 2) * 32 + (lane & 3) * 8;
    u32x4 kr[4], vr[4];
#pragma unroll
    for (int t = 0; t < 4; ++t) { kr[t] = *(const u32x4*)(ksrc + (size_t)t * 64 * 512); vr[t] = *(const u32x4*)(vsrc + (size_t)t * 64 * 512); }
    LAS char* kd = lds + L_K + wid * 1024 + lane * 16; LAS char* vd = lds + L_V + wid * 1024 + lane * 16;
#pragma unroll
    for (int t = 0; t < 4; ++t) { *(LAS u32x4*)(kd + t * 8192) = kr[t]; *(LAS u32x4*)(vd + t * 8192) = vr[t]; }
}
__device__ __forceinline__ void fill_bias_table(const float* BT, int h, int tid, LAS float* tb) {
    const float bfar = BT[h * 132 + 128];
    for (int i = tid; i < 4 * 768; i += NTHREADS) { const int c = i / 768, j = i % 768, src_ = 767 - (j + c), rel = src_ - 256; tb[i] = (src_ < 0 || rel < 0) ? -1.0e30f : (rel < 128 ? BT[h * 132 + rel] - bfar : 0.f); }
}
__device__ __forceinline__ void sel_phase(int wave_, int vcu, int G, const bf16* Q, const float* KMP, unsigned* SEL, LAS char* lds) {
    const int w0 = G > 64 ? 32 : 0, nw = G - w0; if (vcu < w0) return;
    int lane_ = lane_id(); asm volatile("" : "+v"(lane_)); asm volatile("" : "+s"(wave_));
    const int wid = wave_, lane = lane_, tid = wid * 64 + lane, r32 = lane & 31, hi = lane >> 5;
    const int ub = ((vcu - w0) * 1024) / nw, ue = ((vcu - w0 + 1) * 1024) / nw;
    LAS float* km = (LAS float*)(lds + L_KM);
    int bhc = -1;
#pragma unroll 1
    for (int u = ub; u < ue; ++u) {
        const int bh = u >> 4, qb = u & 15, b = bh >> 3, h = bh & 7;
        if (bh != bhc) { bhc = bh;
            __syncthreads();
            for (int i = tid; i < 16 * 64; i += NTHREADS) { const int j = i >> 6, d = i & 63, pm = b * 16 + j; km[i] = KMP[pm * 512 + h * 64 + d] + KMP[128 * 512 + pm * 512 + h * 64 + d]; }
            __syncthreads(); }
        asm volatile("" ::: "memory");
        const int q = qb * 256 + wid * 32 + r32;
        const bf16* qw = Q + ((size_t)b * SEQ + q) * 512 + h * 64 + hi * 8;
        bf16x8 qr[4];
#pragma unroll
        for (int d0 = 0; d0 < 4; ++d0) qr[d0] = *(const bf16x8*)(qw + d0 * 16);
        float g[16];
#pragma unroll
        for (int j = 0; j < 16; ++j) g[j] = 0.f;
#pragma unroll
        for (int d0 = 0; d0 < 4; ++d0)
#pragma unroll
            for (int j = 0; j < 16; ++j) { const f32x4 ka = *(const LAS f32x4*)(km + j * 64 + d0 * 16 + hi * 8), kb4 = *(const LAS f32x4*)(km + j * 64 + d0 * 16 + hi * 8 + 4);
#pragma unroll
                for (int e = 0; e < 4; ++e) { g[j] += bf2f((unsigned)(unsigned short)qr[d0][e]) * ka[e]; }
#pragma unroll
                for (int e = 0; e < 4; ++e) { g[j] += bf2f((unsigned)(unsigned short)qr[d0][4 + e]) * kb4[e]; } }
#pragma unroll
        for (int j = 0; j < 16; ++j) g[j] = hsum(g[j]);
        unsigned selmask = 0u;
#pragma unroll
        for (int s3 = 0; s3 < 3; ++s3) { float bv = -3.0e38f; int bi = -1;
#pragma unroll
            for (int j = 0; j < 16; ++j) { const bool ok = (j < qb) && !((selmask >> j) & 1u) && (g[j] > bv); bv = ok ? g[j] : bv; bi = ok ? j : bi; }
            if (bi >= 0) selmask |= 1u << bi; }
        if (hi == 0) SEL[(size_t)bh * SEQ + q] = selmask;
    }
}
__device__ __forceinline__ bf16* pslot(int slot, size_t t, int h, bf16* YM, bf16* P2A, bf16* P2B) {
    return slot == 0 ? YM + t * 1024 + h * 64 : slot == 1 ? YM + t * 1024 + 512 + h * 64 : (t < (size_t)(T / 2) ? P2A + t * 512 : P2B + (t - (size_t)(T / 2)) * 512) + h * 64;
}
__device__ __forceinline__ void gather_phase(int wave_, int vcu, const bf16* Q, const bf16* K, const bf16* V, bf16* YM, bf16* P2A, bf16* P2B, float* ML, const unsigned* SEL, const float* BT, LAS char* lds) {
    if (vcu >= 256) return;
    int lane_ = lane_id(); asm volatile("" : "+v"(lane_)); asm volatile("" : "+s"(wave_));
    const int wid = wave_, lane = lane_, tid = wid * 64 + lane, r32 = lane & 31, hi = lane >> 5;
    const int bh = vcu >> 2, s = vcu & 3, b = bh >> 3, h = bh & 7;
    const size_t rowbase = (size_t)b * SEQ;
    LAS float* tb = (LAS float*)(lds + L_TB); LAS int* list = (LAS int*)(lds + L_LIST); LAS int* wcnt = (LAS int*)(lds + L_WCNT);
    const float bfar = BT[h * 132 + 128];
    fill_bias_table(BT, h, tid, tb);
    const unsigned* selrow = SEL + (size_t)bh * SEQ;
    const LAS char* kp0 = lds + L_K + hi * 1024 + r32 * 16;
    const LAS char* vp0 = lds + L_V + ((lane >> 4) & 1) * 32 + (lane & 3) * 8 + (4 * hi + ((lane & 15) >> 2)) * 64;
    const unsigned code = s == 0 ? 0xFFFB60u : s == 1 ? 0xFFE971u : s == 2 ? 0xFFCA52u : 0xFFD843u;
    u32x4 kr[4], vr[4]; unsigned msel[8];
#define MOBA_GFETCH(KB) do { const size_t row0 = rowbase + (size_t)(KB) * 256; int lg_ = lane_id(); asm volatile("" : "+v"(lg_));     \
        const bf16* ksrc = K + (row0 + lg_) * 512 + h * 64 + wid * 8; \
        const bf16* vsrc = V + (row0 + 16 * (wid & 3) + (lg_ >> 2)) * 512 + h * 64 + (wid >> 2) * 32 + (lg_ & 3) * 8; \
        _Pragma("unroll") for (int t = 0; t < 4; ++t) { kr[t] = *(const u32x4*)(ksrc + (size_t)t * 64 * 512); vr[t] = *(const u32x4*)(vsrc + (size_t)t * 64 * 512); } \
        const int qs_ = ((KB) + 1) * 256, R_ = (SEQ - qs_) >> 3; \
        _Pragma("unroll") for (int i = 0; i < 8; ++i) { const int off = i * 64 + lg_; msel[i] = off < R_ ? selrow[qs_ + wid * R_ + off] : 0u; } } while (0)
    MOBA_GFETCH((int)(code & 15u));
#pragma unroll 1
    for (int ik = 0; ik < 6; ++ik) {
        const int kb = (int)((code >> (4 * ik)) & 15u); if (kb == 15) break;
        const int kbn = (int)((code >> (4 * ik + 4)) & 15u);
        __syncthreads();
        { LAS char* kd = lds + L_K + wid * 1024 + lane * 16; LAS char* vd = lds + L_V + wid * 1024 + lane * 16;
#pragma unroll
          for (int t = 0; t < 4; ++t) { *(LAS u32x4*)(kd + t * 8192) = kr[t]; *(LAS u32x4*)(vd + t * 8192) = vr[t]; } }
        const int qs = (kb + 1) * 256, R = (SEQ - qs) >> 3;
        unsigned long long bal[8]; int cnt = 0;
#pragma unroll
        for (int i = 0; i < 8; ++i) { bal[i] = __ballot((msel[i] >> kb) & 1u); cnt += __builtin_popcountll(bal[i]); }
        if (lane == 0) wcnt[wid] = cnt;
        __syncthreads();
        int base = 0, n = 0;
#pragma unroll
        for (int w = 0; w < 8; ++w) { const int c = wcnt[w]; n += c; base += (w < wid) ? c : 0; }
#pragma unroll
        for (int i = 0; i < 8; ++i) { const unsigned long long m = bal[i];
            if ((m >> lane) & 1ull) list[base + __builtin_popcountll(m & ((1ull << lane) - 1ull))] = qs + wid * R + i * 64 + lane;
            base += __builtin_popcountll(m); }
        __syncthreads();
        const int ntask = (n + 31) >> 5;
        int tk = wid, qin = 0; bool vn = false; unsigned smn = 0u; bf16x8 qn[4];
#define MOBA_QFETCH() do { const int li_ = tk * 32 + r32; vn = li_ < n; { const int lv_ = list[vn ? li_ : (n > 0 ? n - 1 : 0)]; qin = n > 0 ? lv_ : qs; } smn = selrow[qin]; \
            const bf16* qw = Q + (rowbase + qin) * 512 + h * 64 + hi * 8; \
            _Pragma("unroll") for (int d0 = 0; d0 < 4; ++d0) qn[d0] = *(const bf16x8*)(qw + d0 * 16); } while (0)
        MOBA_QFETCH();
#pragma unroll 1
        while (tk < ntask) {
            const int qi = qin; const bool valid = vn; const unsigned sm = smn;
            bf16x8 qr[4];
#pragma unroll
            for (int d0 = 0; d0 < 4; ++d0) qr[d0] = qn[d0];
            tk += 8;
            const int slot = __builtin_popcount(sm & ((1u << kb) - 1u));
            const int qd = qi - qs, qrel = qd < 255 ? qd : 255;
            const bool nearw = __any(qd < 128);
            MOBA_BLOCK4(nearw ? 0 : -1, MOBA_QFETCH())
            const float lt = hsum(l), inv = 1.f / lt; const size_t t = rowbase + qi;
            bf16* orow = pslot(slot, t, h, YM, P2A, P2B) + 8 * hi;
#pragma unroll
            for (int d0 = 0; d0 < 2; ++d0)
#pragma unroll
                for (int gp = 0; gp < 2; ++gp) { const f32x16& oo = d0 ? o1 : o0; const int ga = 8 * gp, gb = 8 * gp + 4;
                    unsigned ax = cvtpk(oo[ga] * inv, oo[ga + 1] * inv), ay = cvtpk(oo[ga + 2] * inv, oo[ga + 3] * inv), bx = cvtpk(oo[gb] * inv, oo[gb + 1] * inv), by = cvtpk(oo[gb + 2] * inv, oo[gb + 3] * inv);
                    { auto r = __builtin_amdgcn_permlane32_swap(ax, bx, false, false); ax = r[0]; bx = r[1]; }
                    { auto r = __builtin_amdgcn_permlane32_swap(ay, by, false, false); ay = r[0]; by = r[1]; }
                    if (valid) *(u32x4*)(orow + 32 * d0 + 16 * gp) = (u32x4){ax, ay, bx, by}; }
            if (valid && hi == 0) { float* ml = ML + ((t * 8 + h) * 3 + slot) * 2; ml[0] = mref; ml[1] = lt; }
        }
#undef MOBA_QFETCH
        MOBA_GFETCH(kbn);
    }
#undef MOBA_GFETCH
}
__device__ __forceinline__ void diag_unit(int wid, int lane, int b, int h, int qb, const bf16* Q, const bf16* K, const bf16* V, bf16* YM, const bf16* P2A, const bf16* P2B, const float* ML, float bfar, LAS char* lds) {
    const int r32 = lane & 31, hi = lane >> 5; const size_t rowbase = (size_t)b * SEQ;
    LAS float* tb = (LAS float*)(lds + L_TB);
    const LAS char* kp0 = lds + L_K + hi * 1024 + r32 * 16;
    const LAS char* vp0 = lds + L_V + ((lane >> 4) & 1) * 32 + (lane & 3) * 8 + (4 * hi + ((lane & 15) >> 2)) * 64;
    __syncthreads();
    load_block(K, V, rowbase + (size_t)qb * 256, h, wid, lane, lds);
    const int qrel = wid * 32 + r32; const size_t t = rowbase + qb * 256 + qrel;
    bf16x8 qr[4];
    { const bf16* qw = Q + t * 512 + h * 64 + hi * 8;
#pragma unroll
      for (int d0 = 0; d0 < 4; ++d0) qr[d0] = *(const bf16x8*)(qw + d0 * 16); }
    __syncthreads();
    MOBA_BLOCK4(4, (void)0)
    const int nsl = qb < 3 ? qb : 3;
    const float* ml = ML + (t * 8 + h) * 6;
    const bf16* pA = YM + t * 1024 + h * 64 + 8 * hi; const bf16* pB = YM + t * 1024 + 512 + h * 64 + 8 * hi;
    const bf16* pC = (t < (size_t)(T / 2) ? P2A + t * 512 : P2B + (t - (size_t)(T / 2)) * 512) + h * 64 + 8 * hi;
    float m0 = -3.0e38f, m1 = -3.0e38f, m2 = -3.0e38f, l0 = 0.f, l1 = 0.f, l2 = 0.f;
    u32x4 xA[4], xB[4], xC[4];
#pragma unroll
    for (int c = 0; c < 4; ++c) { xA[c] = (u32x4){0u, 0u, 0u, 0u}; xB[c] = xA[c]; xC[c] = xA[c]; }
    if (nsl > 0) { m0 = ml[0]; l0 = ml[1];
#pragma unroll
        for (int c = 0; c < 4; ++c) xA[c] = *(const u32x4*)(pA + 16 * c); }
    if (nsl > 1) { m1 = ml[2]; l1 = ml[3];
#pragma unroll
        for (int c = 0; c < 4; ++c) xB[c] = *(const u32x4*)(pB + 16 * c); }
    if (nsl > 2) { m2 = ml[4]; l2 = ml[5];
#pragma unroll
        for (int c = 0; c < 4; ++c) xC[c] = *(const u32x4*)(pC + 16 * c); }
    const float M = __builtin_fmaxf(__builtin_fmaxf(mref, m0), __builtin_fmaxf(m1, m2));
    const float w0 = __builtin_amdgcn_exp2f(mref - M), wa = l0 * __builtin_amdgcn_exp2f(m0 - M), wb = l1 * __builtin_amdgcn_exp2f(m1 - M), wc = l2 * __builtin_amdgcn_exp2f(m2 - M);
    const float inv = 1.f / (hsum(l) * w0 + wa + wb + wc);
    const float s0 = w0 * inv, sa = wa * inv, sb = wb * inv, sc = wc * inv;
    bf16* orow = YM + t * 1024 + 512 + h * 64 + 8 * hi;
#pragma unroll
    for (int d0 = 0; d0 < 2; ++d0)
#pragma unroll
        for (int gp = 0; gp < 2; ++gp) { const f32x16& oo = d0 ? o1 : o0; const int ga = 8 * gp, gb = 8 * gp + 4, dof = 32 * d0 + 16 * gp, cc = 2 * d0 + gp;
            float a0 = oo[ga] * s0, a1 = oo[ga + 1] * s0, a2 = oo[ga + 2] * s0, a3 = oo[ga + 3] * s0, b0 = oo[gb] * s0, b1 = oo[gb + 1] * s0, b2 = oo[gb + 2] * s0, b3 = oo[gb + 3] * s0;
#define MOBA_ACC(X, W) { unsigned fx = X[cc].x, fy = X[cc].y, sx = X[cc].z, sy = X[cc].w; \
              { auto r = __builtin_amdgcn_permlane32_swap(fx, sx, false, false); fx = r[0]; sx = r[1]; } { auto r = __builtin_amdgcn_permlane32_swap(fy, sy, false, false); fy = r[0]; sy = r[1]; } \
              a0 += (W) * bf2f(fx & 0xffffu); a1 += (W) * __builtin_bit_cast(float, fx & 0xffff0000u); a2 += (W) * bf2f(fy & 0xffffu); a3 += (W) * __builtin_bit_cast(float, fy & 0xffff0000u); \
              b0 += (W) * bf2f(sx & 0xffffu); b1 += (W) * __builtin_bit_cast(float, sx & 0xffff0000u); b2 += (W) * bf2f(sy & 0xffffu); b3 += (W) * __builtin_bit_cast(float, sy & 0xffff0000u); }
            MOBA_ACC(xA, sa) MOBA_ACC(xB, sb) MOBA_ACC(xC, sc)
#undef MOBA_ACC
            unsigned ax = cvtpk(a0, a1), ay = cvtpk(a2, a3), bx = cvtpk(b0, b1), by = cvtpk(b2, b3);
            { auto r = __builtin_amdgcn_permlane32_swap(ax, bx, false, false); ax = r[0]; bx = r[1]; }
            { auto r = __builtin_amdgcn_permlane32_swap(ay, by, false, false); ay = r[0]; by = r[1]; }
            *(u32x4*)(orow + dof) = (u32x4){ax, ay, bx, by}; }
}
__device__ __forceinline__ void diag_phase(int wave_, int ubeg, int uend, const bf16* Q, const bf16* K, const bf16* V, bf16* YM, const bf16* P2A, const bf16* P2B, const float* ML, const float* BT, LAS char* lds) {
    int lane_ = lane_id(); asm volatile("" : "+v"(lane_)); asm volatile("" : "+s"(wave_));
    int hc = -1; float bfar = 0.f;
#pragma unroll 1
    for (int u = ubeg; u < uend; ++u) {
        const int bh = u >> 4, qb = u & 15, h = bh & 7;
        if (h != hc) { hc = h; __syncthreads(); fill_bias_table(BT, h, wave_ * 64 + lane_, (LAS float*)(lds + L_TB)); bfar = BT[h * 132 + 128]; }
        diag_unit(wave_, lane_, bh >> 3, h, qb, Q, K, V, YM, P2A, P2B, ML, bfar, lds); }
}
#undef MOBA_CVEC
#undef MOBA_QK
#undef MOBA_NEARMAX
#undef MOBA_STEP
#undef MOBA_BLOCK4
}

__device__ __forceinline__ void ph_cvt_x(const Ctx& F0) {
    const Ctx F = launder(F0);
    const int gw = F.vcu * NWAVES + F.wave, NGW = F.G * NWAVES; float* rs1 = (float*)(F.ws + WS_RS1);
    for (int m = gw; m < T; m += 2 * NGW) {
        f32x4 v[2][4];
#pragma unroll
        for (int r = 0; r < 2; ++r) { const int mr = m + r * NGW < T ? m + r * NGW : T - 1; const f32x4* xr = (const f32x4*)(F.in[0] + (size_t)mr * D) + F.lane;
#pragma unroll
            for (int j = 0; j < 4; ++j) v[r][j] = xr[64 * j]; }
#pragma unroll
        for (int r = 0; r < 2; ++r) { float s = 0.f;
#pragma unroll
            for (int j = 0; j < 4; ++j) s += (v[r][j].x * v[r][j].x + v[r][j].y * v[r][j].y) + (v[r][j].z * v[r][j].z + v[r][j].w * v[r][j].w);
            const float rstd = 1.f / sqrtf(wave_sum(s) * (1.f / D) + RMS_EPS);
            if (m + r * NGW >= T) continue;
            if (F.lane == 0) rs1[m + r * NGW] = rstd;
            unsigned long long* o8 = (unsigned long long*)(P_XB(F) + (size_t)(m + r * NGW) * D) + F.lane;
#pragma unroll
            for (int j = 0; j < 4; ++j) o8[64 * j] = (unsigned long long)pk2(v[r][j].x, v[r][j].y) | ((unsigned long long)pk2(v[r][j].z, v[r][j].w) << 32); }
    }
}
__device__ __forceinline__ float row_ssq_bf16(const bf16* row, int lane) {
    const u32x4* xr = (const u32x4*)row + lane; float s = 0.f;
#pragma unroll
    for (int j = 0; j < 2; ++j) { const u32x4 x = xr[64 * j];
        const float a0 = bf2f(x.x & 0xffffu), a1 = bf2f(x.x >> 16), a2 = bf2f(x.y & 0xffffu), a3 = bf2f(x.y >> 16), a4 = bf2f(x.z & 0xffffu), a5 = bf2f(x.z >> 16), a6 = bf2f(x.w & 0xffffu), a7 = bf2f(x.w >> 16);
        s += ((a0 * a0 + a1 * a1) + (a2 * a2 + a3 * a3)) + ((a4 * a4 + a5 * a5) + (a6 * a6 + a7 * a7)); }
    return wave_sum(s);
}
__device__ __forceinline__ void ph_rstd(const Ctx& F0) {
    const Ctx F = launder(F0);
    const int gw = F.vcu * NWAVES + F.wave, NGW = F.G * NWAVES; float* rs1 = (float*)(F.ws + WS_RS1);
    for (int m = gw; m < T; m += 4 * NGW) {
        u32x4 x[4][2];
#pragma unroll
        for (int r = 0; r < 4; ++r) { const int mr = m + r * NGW < T ? m + r * NGW : T - 1; const u32x4* xr = (const u32x4*)(P_XB(F) + (size_t)mr * D) + F.lane; x[r][0] = xr[0]; x[r][1] = xr[64]; }
#pragma unroll
        for (int r = 0; r < 4; ++r) { float s = 0.f;
#pragma unroll
            for (int j = 0; j < 2; ++j) { const u32x4 q = x[r][j];
                const float a0 = bf2f(q.x & 0xffffu), a1 = bf2f(q.x >> 16), a2 = bf2f(q.y & 0xffffu), a3 = bf2f(q.y >> 16), a4 = bf2f(q.z & 0xffffu), a5 = bf2f(q.z >> 16), a6 = bf2f(q.w & 0xffffu), a7 = bf2f(q.w >> 16);
                s += ((a0 * a0 + a1 * a1) + (a2 * a2 + a3 * a3)) + ((a4 * a4 + a5 * a5) + (a6 * a6 + a7 * a7)); }
            s = wave_sum(s); if (F.lane == 0 && m + r * NGW < T) rs1[m + r * NGW] = 1.f / sqrtf(s * (1.f / D) + RMS_EPS); } }
}

__device__ __forceinline__ void ph_bias_table(const Ctx& F0) {
    const Ctx F = launder(F0);
    if (F.vcu == 0) {
        const float* rel_bias = F.in[1];
        for (int i = F.tid; i < 8 * 132; i += NTHREADS) {
            const int h = i / 132, r = i % 132;
            int bk;
            if (r < 16) bk = r;
            else { bk = 16 + (int)(logf((float)r / 16.f) / logf(8.f) * 16.f); if (bk > 31) bk = 31; }
            P_BT(F)[i] = rel_bias[bk * 8 + h] * LOG2E;
        }
    }
}

__device__ __forceinline__ void ph_pool_dl(const Ctx& F0) {
    const Ctx F = launder(F0);
    const int gt = F.vcu * NTHREADS + F.tid, NGT = F.G * NTHREADS;
    for (int it = gt; it < (T / 32) * 128; it += NGT) {
        const int cp = it & 127, chunk = it >> 7, c = cp * 2, gi = c >> 6, win = 2 << gi, m0 = chunk * 32, t0 = m0 & (SEQ - 1);
        const unsigned* __restrict__ P2 = (const unsigned*)P_PB(F) + cp; unsigned* __restrict__ D2 = (unsigned*)P_DL(F) + cp;
        float s0 = 0.f, s1 = 0.f;
        const int back = (t0 < win) ? t0 : win;
        for (int j = 1; j <= back; ++j) { const unsigned v = P2[(size_t)(m0 - j) * 128]; s0 += bf2f(v & 0xffffu); s1 += bf2f(v >> 16); }
#pragma unroll 4
        for (int i = 0; i < 32; ++i) { const int m = m0 + i, t = t0 + i;
            const unsigned v = P2[(size_t)m * 128]; const float p0 = bf2f(v & 0xffffu), p1 = bf2f(v >> 16);
            s0 += p0; s1 += p1;
            if (t >= win) { const unsigned o = P2[(size_t)(m - win) * 128]; s0 -= bf2f(o & 0xffffu); s1 -= bf2f(o >> 16); }
            const float inv = 1.f / (float)((t + 1 < win) ? t + 1 : win);
            D2[(size_t)m * 128] = pk2(s0 * inv - p0, s1 * inv - p1); }
    }
}
__device__ __forceinline__ void ph_final(const Ctx& F0) {
    const Ctx F = launder(F0);
    const int gw = F.vcu * NWAVES + F.wave, NGW = F.G * NWAVES;
    const f32x4* gf = (const f32x4*)F.in[26];
    for (int m = gw; m < T; m += 2 * NGW) {
        u32x4 x[2][2];
#pragma unroll
        for (int r = 0; r < 2; ++r) { const int mr = m + r * NGW < T ? m + r * NGW : T - 1; const u32x4* xr = (const u32x4*)(P_XB(F) + (size_t)mr * D) + F.lane; x[r][0] = xr[0]; x[r][1] = xr[64]; }
#pragma unroll
        for (int r = 0; r < 2; ++r) { float s = 0.f;
#pragma unroll
            for (int j = 0; j < 2; ++j) { const u32x4 q = x[r][j];
                const float a0 = bf2f(q.x & 0xffffu), a1 = bf2f(q.x >> 16), a2 = bf2f(q.y & 0xffffu), a3 = bf2f(q.y >> 16), a4 = bf2f(q.z & 0xffffu), a5 = bf2f(q.z >> 16), a6 = bf2f(q.w & 0xffffu), a7 = bf2f(q.w >> 16);
                s += ((a0 * a0 + a1 * a1) + (a2 * a2 + a3 * a3)) + ((a4 * a4 + a5 * a5) + (a6 * a6 + a7 * a7)); }
            const float rstd = 1.f / sqrtf(wave_sum(s) * (1.f / D) + RMS_EPS);
            if (m + r * NGW >= T) continue;
            f32x4* orow = (f32x4*)(F.R + (size_t)(m + r * NGW) * D);
#pragma unroll
            for (int j = 0; j < 2; ++j) { const u32x4 q = x[r][j]; const int c4 = 2 * (64 * j + F.lane);
                orow[c4] = (f32x4){bf2f(q.x & 0xffffu), bf2f(q.x >> 16), bf2f(q.y & 0xffffu), bf2f(q.y >> 16)} * rstd * gf[c4];
                orow[c4 + 1] = (f32x4){bf2f(q.z & 0xffffu), bf2f(q.z >> 16), bf2f(q.w & 0xffffu), bf2f(q.w >> 16)} * rstd * gf[c4 + 1]; } }
    }
}

constexpr int LDS_BYTES = 147456;
constexpr int MISC_OFF = 131072 + 320;

__global__ void __launch_bounds__(NTHREADS, 2) mk_fwd(Args args) {
    extern __shared__ __attribute__((aligned(16))) unsigned char lds[];
    Ctx F;
    F.lds = (LAS unsigned char*)lds;
    F.wave = __builtin_amdgcn_readfirstlane((int)threadIdx.x >> 6);
    F.lane = lane_id(); F.tid = F.wave * 64 + F.lane;
    F.G = gridDim.x; { const int bx = blockIdx.x; F.vcu = (F.G % 8 == 0) ? (bx % 8) * (F.G / 8) + bx / 8 : bx; }
    F.in = (KargP)__builtin_amdgcn_kernarg_segment_ptr(); F.R = args.out; F.ws = args.ws;
    unsigned char* ws = args.ws;
    volatile LAS unsigned* MISC = (volatile LAS unsigned*)(F.lds + MISC_OFF);
    if (F.tid < 64) MISC[F.tid] = 0u;
    __syncthreads();
    XcdBarrier bar = xcd_barrier_post((unsigned*)(ws + WS_CTL) + CW_BAR, MISC + 8, F.tid == 0);
#define GRID_BAR() do { bar.bar = (unsigned*)(wsl(ws) + WS_CTL) + CW_BAR; xcd_barrier(bar, F.wave); } while (0)
#define FL launder(F)

    ph_bias_table(F);
    ph_prologue(F);
#pragma unroll 1
    for (int l = 0; l < DEPTH; ++l) {
        if (l == 0) ph_cvt_x(F); else ph_rstd(F);
        GRID_BAR();
        { pg8::Gemm g{P_XB(FL), (const bf16*)(wsl(ws) + WS_WIN) + (size_t)l * NPROJ * D, D, D, D}; pg8::StaticOrder S; S.init(T, NPROJ, sl(F.G), sl((int)blockIdx.x));
          EpiProjE E{P_UG(FL), P_PB(FL), P_QB(FL), P_KB(FL), P_VB(FL), P_KMP(FL), (const float*)(wsl(ws) + WS_RS1)}; pg8::gemm_phase(F.lds, g, S, E, sl(F.wave)); }
        GRID_BAR();
        { pg8::Gemm g{P_UG(FL) + UOF, (const bf16*)(wsl(ws) + WS_BZ) + (size_t)l * SGN * 256 * 1024, UGP, 1024, 1024}; SsmOrder S{sl(F.G), sl((int)blockIdx.x), 1};
          EpiZ E{(float*)(wsl(ws) + WS_ZB)}; pg8::gemm_phase(F.lds, g, S, E, sl(F.wave)); }
        ph_pool_dl(F);
        moba::sel_phase(sl(F.wave), sl((int)blockIdx.x), sl(F.G), P_QB(FL), P_KMP(FL), (unsigned*)(wsl(ws) + WS_SEL), (LAS char*)F.lds);
        ph_tg_expand(F, l, sl((int)blockIdx.x), sl(F.G) > 64 ? 32 : 0);
        GRID_BAR();
        ph_ssm_scan(F, l);
        moba::gather_phase(sl(F.wave), sl(F.vcu), P_QB(FL), P_KB(FL), P_VB(FL), P_YMIX(FL), P_PB(FL), (bf16*)(wsl(ws) + WS_P2B), (float*)(wsl(ws) + WS_ML), (const unsigned*)(wsl(ws) + WS_SEL), P_BT(FL), (LAS char*)F.lds);
        GRID_BAR();
        { pg8::Gemm g{P_UG(FL), (const bf16*)(wsl(ws) + WS_TG) + (size_t)l * SGN * 1024 * UGP, UGP, UGP, UGP}; SsmOrder S{sl(F.G), sl((int)blockIdx.x), 2};
          EpiSsm2 E{P_UG(FL), P_YS(FL), F.in[11] + l * 256}; pg8::gemm_phase(F.lds, g, S, E, sl(F.wave)); }
        { const int bx = sl((int)blockIdx.x), G_ = sl(F.G); int ub, ue;
          if (G_ == 256) { const int q4 = bx & 3; ub = bx < 128 ? (bx >> 2) * 12 + (q4 == 0 ? 0 : q4 == 1 ? 4 : q4 == 2 ? 7 : 10) : 384 + 5 * (bx - 128); ue = ub + (bx < 128 ? (q4 == 0 ? 4 : q4 == 3 ? 2 : 3) : 5); }
          moba::diag_phase(sl(F.wave), ub, ue, P_QB(FL), P_KB(FL), P_VB(FL), P_YMIX(FL), P_PB(FL), (const bf16*)(wsl(ws) + WS_P2B), (const float*)(wsl(ws) + WS_ML), P_BT(FL), (LAS char*)F.lds); }
        GRID_BAR();
        { pg8::Gemm g{P_YS(FL), (const bf16*)(wsl(ws) + WS_GLUT) + (size_t)l * 65536, 256, 256, 256}; HalfOrder S{sl(F.vcu)};
          EpiGluE E{P_YS(FL), P_YMIX(FL), F.in[13] + l * 256}; pg8::gemm_phase(F.lds, g, S, E, sl(F.wave)); }
        { pg8::Gemm g{P_DL(FL), (const bf16*)(wsl(ws) + WS_POOLT) + (size_t)l * 65536, 256, 256, 256}; HalfOrder S{sl(F.vcu) - 128};
          EpiPoolE E{P_YMIX(FL), F.in[15] + l * 256, F.in[16] + l * 256}; pg8::gemm_phase(F.lds, g, S, E, sl(F.wave)); }
        GRID_BAR();
        { pg8::Gemm g{P_YMIX(FL), (const bf16*)(wsl(ws) + WS_WOUT) + (size_t)l * D * D, D, D, D}; pg8::StaticOrder S; S.init(T, D, sl(F.G), sl((int)blockIdx.x));
          EpiOutE E{P_XB(FL)}; pg8::gemm_phase(F.lds, g, S, E, sl(F.wave)); }
        GRID_BAR();
        ph_route(F, l);
        GRID_BAR();
        ph_place(F);
        GRID_BAR();
        { pg8::Gemm g{P_XB(FL), (const bf16*)(wsl(ws) + WS_GU) + (size_t)l * 16 * 512 * D, D, D, D}; MoeOrder S{sl(F.G), sl((int)blockIdx.x), false, 0, 0}; S.init((const int*)(wsl(ws) + WS_TILEB));
          EpiGU E{(bf16*)(wsl(ws) + WS_HACT), (const float*)(wsl(ws) + WS_ROWW), (const float*)(wsl(ws) + WS_ROWR)}; pg8::gemm_phase<true, true>(F.lds, g, S, E, sl(F.wave), (const int*)(wsl(ws) + WS_ROWTOK)); }
        GRID_BAR();
        { pg8::Gemm g{(const bf16*)(wsl(ws) + WS_HACT), (const bf16*)(wsl(ws) + WS_WD) + (size_t)l * 24 * D * 512, 512, 512, 512}; MoeOrder S{sl(F.G), sl((int)blockIdx.x), true, 0, 0}; S.init((const int*)(wsl(ws) + WS_TILEB));
          EpiDown E{P_XB(FL), (const int*)(wsl(ws) + WS_ROWTOK)}; pg8::gemm_phase(F.lds, g, S, E, sl(F.wave)); }
        GRID_BAR();
    }
    ph_final(F);
}

extern "C" void kernel_launch(void* const* d_in, const int* in_sizes, int n_in, void* d_out, int out_size, void* d_ws, size_t ws_size, hipStream_t stream) {
    static int grid = 0;
    if (grid == 0) {
        if (n_in != 27 || out_size != T * D || ws_size < WS_END) { fprintf(stderr, "kernel_launch: unexpected shapes (n_in %d out %d ws %zu)\n", n_in, out_size, ws_size); grid = -1; return; }
        int dev = 0, cus = 0, per_cu = 0;
        if (hipGetDevice(&dev) != hipSuccess || hipDeviceGetAttribute(&cus, hipDeviceAttributeMultiprocessorCount, dev) != hipSuccess) { grid = -1; return; }
        if (hipFuncSetAttribute((const void*)mk_fwd, hipFuncAttributeMaxDynamicSharedMemorySize, LDS_BYTES) != hipSuccess) { fprintf(stderr, "kernel_launch: hipFuncSetAttribute failed\n"); grid = -1; return; }
        if (hipOccupancyMaxActiveBlocksPerMultiprocessor(&per_cu, (const void*)mk_fwd, NTHREADS, LDS_BYTES) != hipSuccess || per_cu < 1) { fprintf(stderr, "kernel_launch: occupancy query says %d\n", per_cu); per_cu = 1; }
        (void)hipGetLastError();
        grid = cus;
    }
    if (grid < 0) return;
    (void)hipMemsetAsync((char*)d_ws + WS_CTL, 0, CTL_ZERO_BYTES, stream);
    Args a{};
    for (int i = 0; i < 27; ++i) a.in[i] = (const float*)d_in[i];
    a.out = (float*)d_out; a.ws = (unsigned char*)d_ws; a.pad0 = 0; a.pad1 = 0;
    hipLaunchKernelGGL(mk_fwd, dim3(grid), dim3(NTHREADS), LDS_BYTES, stream, a);
}
```

```cpp
#include <hip/hip_runtime.h>
#include <hip/hip_bf16.h>
#include <cstdio>
#include <cstdint>

#define GAS __attribute__((address_space(1)))
#define LAS __attribute__((address_space(3)))
typedef unsigned short bf16;
typedef float f32x4 __attribute__((ext_vector_type(4)));
typedef unsigned u32x4 __attribute__((ext_vector_type(4)));
typedef unsigned u32x2 __attribute__((ext_vector_type(2)));

constexpr int NB = 8, SEQ = 4096, T = NB * SEQ, D = 1024, NPROJ = 2048, DEPTH = 2;
constexpr int NHEAD = 8, HD = 64, MBLK = 256, NBLK = SEQ / MBLK;
constexpr int SG = 16, SGN = 16, SP = 64, SCH = 64, UGP = 1152, UOF = 128;
constexpr float RMS_EPS = 1e-6f;
constexpr float LOG2E = 1.4426950408889634f;
constexpr float C2 = 0.125f * LOG2E;
constexpr int NWAVES = 8, NTHREADS = 512;

constexpr size_t MiB = 1u << 20;
constexpr size_t WS_CTL = 0, CTL_ZERO_BYTES = 1 * MiB;
constexpr size_t WS_XB = 2 * MiB;
constexpr size_t WS_UG = 66 * MiB;
constexpr size_t WS_PB = 84 * MiB;
constexpr size_t WS_QB = 100 * MiB;
constexpr size_t WS_KB = 132 * MiB;
constexpr size_t WS_VB = 164 * MiB;
constexpr size_t WS_YMIX = 196 * MiB;
constexpr size_t WS_YS = 260 * MiB;
constexpr size_t WS_DL = 276 * MiB;
constexpr size_t WS_KMP = 292 * MiB;
constexpr size_t WS_BT = 293 * MiB;
constexpr size_t WS_KT = 297 * MiB;
constexpr size_t WS_SEL = 298 * MiB;
constexpr size_t WS_WIN = 300 * MiB;
constexpr size_t WS_WOUT = 308 * MiB;
constexpr size_t WS_GU = 312 * MiB;
constexpr size_t WS_WD = 344 * MiB;
constexpr size_t WS_TG = 392 * MiB;
constexpr size_t WS_BZ = 464 * MiB;
constexpr size_t WS_GLUT = 480 * MiB;
constexpr size_t WS_POOLT = WS_GLUT + 512 * 1024;
constexpr size_t WS_ZB = 482 * MiB;
constexpr size_t WS_P2B = 486 * MiB;
constexpr size_t WS_ML = 502 * MiB;
constexpr size_t WS_END = 510 * MiB;
constexpr int MOE_MAXT = 152;
constexpr size_t WS_XS = 66 * MiB;
constexpr size_t WS_HACT = 142 * MiB;
constexpr size_t WS_TOKB = 294 * MiB;
constexpr size_t WS_TOKR = WS_TOKB + 128 * 1024;
constexpr size_t WS_TOKW = WS_TOKB + 256 * 1024;
constexpr size_t WS_ROWTOK = 295 * MiB;
constexpr size_t WS_ROWW = WS_ROWTOK + 256 * 1024;
constexpr size_t WS_ROWR = WS_ROWTOK + 576 * 1024;
constexpr size_t WS_RS1 = WS_ROWTOK + 768 * 1024;
constexpr size_t WS_WGCNT = 296 * MiB;
constexpr size_t WS_TILEB = WS_WGCNT + 64 * 1024;

constexpr int CW_BAR = 4096;

__device__ __forceinline__ unsigned f2bf(float f) { unsigned u = __builtin_bit_cast(unsigned, f); return (u + 0x7fffu + ((u >> 16) & 1u)) >> 16; }
__device__ __forceinline__ float bf2f(unsigned h) { return __builtin_bit_cast(float, h << 16); }
__device__ __forceinline__ unsigned pk2(float lo, float hi) { return f2bf(lo) | (f2bf(hi) << 16); }
template <int O> __device__ __forceinline__ float xshfl(float v) {
    if constexpr (O < 32) return __builtin_bit_cast(float, __builtin_amdgcn_ds_swizzle(__builtin_bit_cast(int, v), (O << 10) | 0x1f));
    else { const unsigned u = __builtin_bit_cast(unsigned, v); auto r = __builtin_amdgcn_permlane32_swap(u, u, false, false);
           const float a = __builtin_bit_cast(float, (unsigned)r[0]), b = __builtin_bit_cast(float, (unsigned)r[1]); return (a == v && __builtin_bit_cast(unsigned, a) == u) ? b : a; }
}
__device__ __forceinline__ float wave_sum(float v) {
    v += xshfl<1>(v); v += xshfl<2>(v); v += xshfl<4>(v); v += xshfl<8>(v); v += xshfl<16>(v);
    const unsigned u = __builtin_bit_cast(unsigned, v); auto r = __builtin_amdgcn_permlane32_swap(u, u, false, false);
    return __builtin_bit_cast(float, (unsigned)r[0]) + __builtin_bit_cast(float, (unsigned)r[1]);
}
__device__ __forceinline__ float wave_max(float v) {
    v = fmaxf(v, xshfl<1>(v)); v = fmaxf(v, xshfl<2>(v)); v = fmaxf(v, xshfl<4>(v)); v = fmaxf(v, xshfl<8>(v)); v = fmaxf(v, xshfl<16>(v));
    const unsigned u = __builtin_bit_cast(unsigned, v); auto r = __builtin_amdgcn_permlane32_swap(u, u, false, false);
    return fmaxf(__builtin_bit_cast(float, (unsigned)r[0]), __builtin_bit_cast(float, (unsigned)r[1]));
}
__device__ __forceinline__ float gelu_tanh(float x) {
    const float u = 0.7978845608028654f * (x + 0.044715f * x * x * x);
    const float e = __expf(2.f * u);
    const float th = 1.f - 2.f / (e + 1.f);
    return 0.5f * x * (1.f + th);
}
__device__ __forceinline__ float sigmoidf_(float x) { return 1.f / (1.f + __expf(-x)); }

__device__ __forceinline__ int lane_id() { unsigned m; asm volatile("s_mov_b32 %0, -1" : "=s"(m)); return (int)__builtin_amdgcn_mbcnt_hi(m, __builtin_amdgcn_mbcnt_lo(m, 0u)); }

#define XB_TMO      128
#define XB_XCNT(j)  (256  + 64 * (j))
#define XB_XSUB(j)  (1280 + 64 * (j))
#define XB_XGEN(j)  (2304 + 64 * (j))
#define XB_TOP      3328
#define XB_TOPGEN   3392
#define XCD_BAR_WORDS 3456
#define XB_SPIN_CAP (1u << 22)
__device__ __forceinline__ unsigned xb_ld(unsigned* p)              { return __hip_atomic_load(p, __ATOMIC_RELAXED, __HIP_MEMORY_SCOPE_AGENT); }
__device__ __forceinline__ unsigned xb_add(unsigned* p, unsigned v) { return __hip_atomic_fetch_add(p, v, __ATOMIC_RELAXED, __HIP_MEMORY_SCOPE_AGENT); }
__device__ __forceinline__ unsigned xb_xcc_id() { return (unsigned)__builtin_amdgcn_s_getreg((3 << 11) | 20) & 0xFu; }
#define XB_SPIN(cond, bar) do { unsigned _sp = 0; while (cond) { __builtin_amdgcn_s_sleep(1); \
    if ((++_sp & 255u) == 0u) { if (xb_ld(&(bar)[XB_TMO])) break; if (_sp > XB_SPIN_CAP) { atomicAdd(&(bar)[XB_TMO], 1u); break; } } } } while (0)
struct XcdBarrier { unsigned* bar; unsigned x; volatile LAS unsigned* st; };
__device__ __forceinline__ XcdBarrier xcd_barrier_post(unsigned* bar, volatile LAS unsigned* st, bool t0) {
    XcdBarrier b; b.bar = bar; b.x = xb_xcc_id(); b.st = st;
    if (t0) (void)xb_add(&bar[XB_XCNT(b.x)], 1u);
    return b;
}
__device__ __forceinline__ void xcd_barrier_complete(unsigned* bar, unsigned x, unsigned& nloc, unsigned& nx) {
    const unsigned G = gridDim.x * gridDim.y * gridDim.z;
    unsigned sum, cnt, mine, sp = 0u;
    for (;;) {
        sum = 0u; cnt = 0u; mine = 0u;
#pragma unroll
        for (unsigned j = 0; j < 16; ++j) { const unsigned c = xb_ld(&bar[XB_XCNT(j)]); sum += c; cnt += (c > 0u) ? 1u : 0u; mine = (j == x) ? c : mine; }
        if (sum == G) break;
        __builtin_amdgcn_s_sleep(1);
        if ((++sp & 255u) == 0u) { if (xb_ld(&bar[XB_TMO])) break; if (sp > XB_SPIN_CAP) { atomicAdd(&bar[XB_TMO], 1u); break; } }
    }
    nloc = mine > 0u ? mine : 1u; nx = cnt > 0u ? cnt : 1u;
}
__device__ __forceinline__ void xcd_barrier(const XcdBarrier& b, int wave) {
    asm volatile("s_waitcnt vmcnt(0)" ::: "memory");
    __syncthreads();
    if (wave == 0 && lane_id() == 0) {
        unsigned* bar = b.bar;
        __builtin_amdgcn_s_waitcnt(0);
        unsigned nloc = b.st[0], nx = b.st[1];
        if (nloc == 0u) { xcd_barrier_complete(bar, b.x, nloc, nx); b.st[0] = nloc; b.st[1] = nx; }
        const unsigned old = xb_add(&bar[XB_XSUB(b.x)], 1u);
        const unsigned gen = old / nloc;
        if (old + 1u == (gen + 1u) * nloc) {
            __builtin_amdgcn_fence(__ATOMIC_RELEASE, "agent");
            asm volatile("s_waitcnt vmcnt(0)" ::: "memory");
            const unsigned og = xb_add(&bar[XB_TOP], 1u);
            const unsigned tg = og / nx;
            if (og + 1u == (tg + 1u) * nx) xb_add(&bar[XB_TOPGEN], 1u);
            else XB_SPIN(xb_ld(&bar[XB_TOPGEN]) == tg, bar);
            __builtin_amdgcn_fence(__ATOMIC_ACQUIRE, "agent");
            xb_add(&bar[XB_XGEN(b.x)], 1u);
            asm volatile("s_waitcnt vmcnt(0)" ::: "memory");
        } else {
            XB_SPIN(xb_ld(&bar[XB_XGEN(b.x)]) == gen, bar);
            __builtin_amdgcn_fence(__ATOMIC_ACQUIRE, "agent");
            asm volatile("s_waitcnt vmcnt(0)" ::: "memory");
        }
    }
    __syncthreads();
}

struct Args {
    const float* in[27];
    float* out;
    unsigned char* ws;
    int pad0, pad1;
};

typedef const float* fptr_t;
typedef __attribute__((address_space(4))) const fptr_t* KargP;
struct Ctx {
    LAS unsigned char* lds;
    int tid, lane, wave, vcu, G;
    KargP in;
    float* R;
    unsigned char* ws;
};
#define P_XB(F) ((bf16*)((F).ws + WS_XB))
#define P_UG(F) ((bf16*)((F).ws + WS_UG))
#define P_PB(F) ((bf16*)((F).ws + WS_PB))
#define P_QB(F) ((bf16*)((F).ws + WS_QB))
#define P_KB(F) ((bf16*)((F).ws + WS_KB))
#define P_VB(F) ((bf16*)((F).ws + WS_VB))
#define P_YMIX(F) ((bf16*)((F).ws + WS_YMIX))
#define P_YS(F) ((bf16*)((F).ws + WS_YS))
#define P_DL(F) ((bf16*)((F).ws + WS_DL))
#define P_KMP(F) ((float*)((F).ws + WS_KMP))
#define P_BT(F) ((float*)((F).ws + WS_BT))


__device__ __forceinline__ Ctx launder(const Ctx& F0) {
    Ctx F = F0;
    int ln = lane_id(); asm volatile("" : "+v"(ln));
    asm volatile("" : "+s"(F.wave), "+s"(F.vcu), "+s"(F.G));
    F.lane = ln; F.tid = F.wave * 64 + ln;
    KargP kp = (KargP)__builtin_amdgcn_kernarg_segment_ptr(); asm volatile("" : "+s"(kp));
    F.in = kp; F.R = (float*)kp[27]; F.ws = (unsigned char*)kp[28];
    return F;
}

__device__ __forceinline__ unsigned char* wsl(unsigned char* p) { asm volatile("" : "+s"(p)); return p; }
__device__ __forceinline__ int sl(int x) { asm volatile("" : "+s"(x)); return x; }

namespace pg8 {
typedef short bf16x8 __attribute__((ext_vector_type(8)));
constexpr int BM = 256, BK = 64, HALF = 128, HTB = HALF * BK * 2, STAGE_BYTES = 8 * HTB, NXCD = 8, WGM = 8;
__device__ __forceinline__ int lds_byte(int r, int c) { const int st = (r >> 4) * 2 + (c >> 5), rr = r & 15, cc = c & 31, ob = rr * 64 + cc * 2; return st * 1024 + (ob ^ (((ob >> 9) & 1) << 5)); }
__device__ __forceinline__ void stage_rc(int b, int& R, int& C) { const int st = b / 1024, sb = b % 1024, swz = sb ^ (((sb >> 9) & 1) << 5); R = (st >> 1) * 16 + swz / 64; C = (st & 1) * 32 + (swz % 64) / 2; }
__device__ __forceinline__ int perm32(int rho) { const int n = rho >> 4, i = rho & 15; return 8 * (i >> 2) + 4 * n + (i & 3); }

struct Unit { int pm, pn, aux, kt; };
struct Gemm { const bf16* A; const bf16* Bt; int lda, ldb, K; };

struct StaticOrder {
    int nM, nN, nwg, G, c;
    __device__ void init(int M, int N, int G_, int c_) { nM = M / BM; nN = N / BM; nwg = nM * nN; G = G_; c = c_; }
    __device__ bool next(int i, Unit& u) const {
        const long L = (long)i * G + c; if (L >= nwg) return false;
        int wgid = (int)L; { const int q = nwg / NXCD, r = nwg % NXCD, xcd = wgid % NXCD, off = wgid / NXCD; wgid = (xcd < r ? xcd * (q + 1) : r * (q + 1) + (xcd - r) * q) + off; }
        const int nig = WGM * nN, gid = wgid / nig, fm = gid * WGM, gsz = (nM - fm) < WGM ? (nM - fm) : WGM;
        u.pm = fm + ((wgid % nig) % gsz); u.pn = (wgid % nig) / gsz; u.aux = 0; return true;
    }
};

__device__ __forceinline__ unsigned cvt_pk_bf16(float lo, float hi) { unsigned r; asm volatile("v_cvt_pk_bf16_f32 %0, %1, %2" : "=v"(r) : "v"(lo), "v"(hi)); return r; }

template <bool ALIGN = true, bool GATHER = false, class Epi, class Sched>
__device__ __forceinline__ void gemm_phase(LAS unsigned char* lds, const Gemm g, const Sched& S, const Epi& E, int wave_, const int* gidx = nullptr) {
    int lane_ = lane_id(); asm volatile("" : "+v"(lane_)); asm volatile("" : "+s"(wave_));
    const int wid = wave_, lane = lane_, tid = wid * 64 + lane, wr = wid >> 2, wc = wid & 3, fr = lane & 15, fq = lane >> 4;
    const int K = g.K, ntd = K / BK; int nt = ntd;
    unsigned voffA[2], voffA1[2], voffB[2];
#pragma unroll
    for (int i = 0; i < 2; ++i) { int R, C; stage_rc(tid * 16 + i * 8192, R, C); const int Rb = Epi::PERM ? ((R & ~31) + perm32(R & 31)) : R;
        voffA[i] = (unsigned)(R * g.lda + C) * 2u; voffB[i] = (unsigned)(Rb * g.ldb + C) * 2u; voffA1[i] = voffA[i] + (unsigned)(HALF * g.lda * 2); }
    const size_t kstep = (size_t)(BK * 2);
    const size_t hstepA = (size_t)HALF * g.lda * 2, hstepB = (size_t)HALF * g.ldb * 2;
    const size_t tstepA = 2 * hstepA, tstepB = 2 * hstepB;
    const unsigned ldsw = (unsigned)wid * 1024u;
    const int aoff = lds_byte(wr * 64 + fr, fq * 8), boff = lds_byte(wc * 32 + fr, fq * 8);
#define PG8_SA(b, h) (((b) * 2 + (h)) * HTB)
#define PG8_SB(b, h) ((4 + (b) * 2 + (h)) * HTB)
#define PG8_STAGE(bufoff, gbase, voff) do { _Pragma("unroll") for (int _i = 0; _i < 2; ++_i) \
        __builtin_amdgcn_global_load_lds((const unsigned*)((const char*)(gbase) + (voff)[_i]), (LAS unsigned*)(lds + (bufoff) + ldsw + _i * 8192), 16, 0, 0); } while (0)
#define PG8_LDA(dst, b, h) do { _Pragma("unroll") for (int m = 0; m < 4; ++m) _Pragma("unroll") for (int k = 0; k < 2; ++k) dst[m][k] = *(const LAS bf16x8*)(lds + PG8_SA(b, h) + aoff + m * 2048 + k * 1024); } while (0)
#define PG8_LDB(dst, b, h) do { _Pragma("unroll") for (int n = 0; n < 2; ++n) _Pragma("unroll") for (int k = 0; k < 2; ++k) dst[n][k] = *(const LAS bf16x8*)(lds + PG8_SB(b, h) + boff + n * 2048 + k * 1024); } while (0)
#define PG8_MMA(ai, bj, At, Bt) do { __builtin_amdgcn_s_setprio(1); _Pragma("unroll") for (int m = 0; m < 4; ++m) _Pragma("unroll") for (int n = 0; n < 2; ++n) _Pragma("unroll") for (int k = 0; k < 2; ++k) \
        acc[ai][bj][m][n] = __builtin_amdgcn_mfma_f32_16x16x32_bf16(Bt[n][k], At[m][k], acc[ai][bj][m][n], 0, 0, 0); __builtin_amdgcn_s_setprio(0); } while (0)
#define PG8_GLOOK(PM) do { if constexpr (GATHER) { _Pragma("unroll") for (int _i = 0; _i < 2; ++_i) { int R_, C_; stage_rc(tid * 16 + _i * 8192, R_, C_); \
        int t0_ = gidx[(PM) * 256 + R_], t1_ = gidx[(PM) * 256 + HALF + R_]; t0_ = t0_ < 0 ? 0 : t0_; t1_ = t1_ < 0 ? 0 : t1_; \
        voffA[_i] = (unsigned)(t0_ * g.lda + C_) * 2u; voffA1[_i] = (unsigned)(t1_ * g.lda + C_) * 2u; } } } while (0)
#define PG8_WAIT_V(n) asm volatile("s_waitcnt vmcnt(" #n ")" ::: "memory")
#define PG8_WAIT_L(n) asm volatile("s_waitcnt lgkmcnt(" #n ")" ::: "memory")
#define PG8_BAR __builtin_amdgcn_s_barrier()
#define PG8_SCHED __builtin_amdgcn_sched_barrier(0)
    Unit cur{0, 0, 0, 0}, nxt{0, 0, 0, 0}; int ui = 0;
    if (!S.next(0, cur)) return;
    nt = cur.kt ? cur.kt : ntd;
    f32x4 acc[2][2][4][2];
#pragma unroll
    for (int a = 0; a < 2; ++a)
#pragma unroll
        for (int b = 0; b < 2; ++b)
#pragma unroll
            for (int m = 0; m < 4; ++m)
#pragma unroll
                for (int n = 0; n < 2; ++n) acc[a][b][m][n] = (f32x4){0.f, 0.f, 0.f, 0.f};
    bf16x8 At[4][2], B0[2][2], B1[2][2];
    const char* cA = (const char*)g.A + (GATHER ? (size_t)0 : (size_t)cur.pm * tstepA); const char* cB = (const char*)g.Bt + (size_t)cur.pn * tstepB;
    PG8_GLOOK(cur.pm);
    PG8_STAGE(PG8_SB(0, 0), cB, voffB); PG8_STAGE(PG8_SB(0, 1), cB + hstepB, voffB); PG8_STAGE(PG8_SA(0, 0), cA, voffA); PG8_STAGE(PG8_SA(0, 1), cA, voffA1);
    if (wr == 1) PG8_BAR;
    PG8_WAIT_V(2); PG8_BAR;
    PG8_STAGE(PG8_SB(1, 0), cB + kstep, voffB); PG8_STAGE(PG8_SA(1, 0), cA + kstep, voffA); PG8_STAGE(PG8_SB(1, 1), cB + hstepB + kstep, voffB);
    PG8_WAIT_V(6); PG8_BAR;
    for (;;) {
        const bool has_next = S.next(ui + 1, nxt);
        const char* nA = has_next ? (const char*)g.A + (GATHER ? (size_t)0 : (size_t)nxt.pm * tstepA) : cA; const char* nB = has_next ? (const char*)g.Bt + (size_t)nxt.pn * tstepB : cB;
        for (int t = 0; t < nt; t += 2) {
            const bool last = (t == nt - 2);
            const char* a1 = cA + (size_t)(t + 1) * kstep;
            const char* a2 = last ? nA : cA + (size_t)(t + 2) * kstep; const char* b2 = last ? nB : cB + (size_t)(t + 2) * kstep;
            const char* a3 = a2 + kstep; const char* b3 = b2 + kstep;
            PG8_LDB(B0, 0, 0); PG8_LDB(B1, 0, 1); PG8_SCHED; PG8_LDA(At, 0, 0); PG8_STAGE(PG8_SA(1, 1), a1, voffA1);
            PG8_WAIT_V(8); PG8_WAIT_L(0); PG8_BAR; PG8_MMA(0, 0, At, B0); PG8_MMA(0, 1, At, B1); PG8_BAR; PG8_SCHED;
            if constexpr (GATHER) { if (last && has_next) PG8_GLOOK(nxt.pm); }
            PG8_LDA(At, 0, 1); PG8_STAGE(PG8_SB(0, 0), b2, voffB); PG8_STAGE(PG8_SB(0, 1), b2 + hstepB, voffB); PG8_STAGE(PG8_SA(0, 0), a2, voffA);
            PG8_WAIT_V(8); PG8_WAIT_L(0); PG8_BAR; PG8_MMA(1, 0, At, B0); PG8_MMA(1, 1, At, B1); PG8_BAR; PG8_SCHED;
            PG8_LDB(B0, 1, 0); PG8_LDB(B1, 1, 1); PG8_SCHED; PG8_LDA(At, 1, 0); PG8_STAGE(PG8_SA(0, 1), a2, voffA1);
            PG8_WAIT_V(8); PG8_WAIT_L(0); PG8_BAR; PG8_MMA(0, 0, At, B0); PG8_MMA(0, 1, At, B1); PG8_BAR; PG8_SCHED;
            PG8_LDA(At, 1, 1); PG8_STAGE(PG8_SB(1, 0), b3, voffB); PG8_STAGE(PG8_SB(1, 1), b3 + hstepB, voffB); PG8_STAGE(PG8_SA(1, 0), a3, voffA);
            PG8_WAIT_V(8); PG8_WAIT_L(0); PG8_BAR; PG8_MMA(1, 0, At, B0); PG8_MMA(1, 1, At, B1); PG8_BAR; PG8_SCHED;
        }
        if constexpr (ALIGN) { if (wr == 0) PG8_BAR; }
        E(acc, cur, wr, wc, fr, fq);
        if (!has_next) break;
#pragma unroll
        for (int a = 0; a < 2; ++a)
#pragma unroll
            for (int b = 0; b < 2; ++b)
#pragma unroll
                for (int m = 0; m < 4; ++m)
#pragma unroll
                    for (int n = 0; n < 2; ++n) acc[a][b][m][n] = (f32x4){0.f, 0.f, 0.f, 0.f};
        cur = nxt; cA = nA; cB = nB; ++ui; nt = cur.kt ? cur.kt : ntd;
        if constexpr (ALIGN) { if (wr == 1) PG8_BAR; }
    }
    PG8_WAIT_V(0);
    if constexpr (!ALIGN) { if (wr == 0) PG8_BAR; }
    PG8_BAR;
#undef PG8_SA
#undef PG8_SB
#undef PG8_STAGE
#undef PG8_LDA
#undef PG8_LDB
#undef PG8_MMA
#undef PG8_WAIT_V
#undef PG8_WAIT_L
#undef PG8_BAR
#undef PG8_SCHED
}
}


struct EpiProjE {
    static constexpr bool PERM = true;
    bf16 *UG, *PB, *QB, *KB, *VB; float* KMP; const float* rs1;
    __device__ __forceinline__ void operator()(const f32x4 (&acc_)[2][2][4][2], const pg8::Unit& u, int wr, int wc, int fr_, int fq_) const {
        const int ln_ = lane_id(), fr = ln_ & 15, fq = ln_ >> 4; (void)fr_; (void)fq_;
        const int pn = u.pn, row0 = u.pm * 256 + wr * 64 + fr, cl = wc * 32 + 8 * fq;
        f32x4 acc[2][2][4][2];
#pragma unroll
        for (int ai = 0; ai < 2; ++ai)
#pragma unroll
            for (int m = 0; m < 4; ++m) { const float rs = rs1[row0 + ai * 128 + m * 16];
#pragma unroll
                for (int bj = 0; bj < 2; ++bj) { acc[ai][bj][m][0] = acc_[ai][bj][m][0] * rs; acc[ai][bj][m][1] = acc_[ai][bj][m][1] * rs; } }
        if (pn == 0) {
#pragma unroll
            for (int ai = 0; ai < 2; ++ai)
#pragma unroll
                for (int m = 0; m < 4; ++m) { const int r = row0 + ai * 128 + m * 16;
#pragma unroll
                    for (int bj = 0; bj < 2; ++bj) { const int ch = bj * 128 + cl, g = ch >> 4, h0 = ch & 15;
                        const f32x4 v0 = acc[ai][bj][m][0], v1 = acc[ai][bj][m][1]; u32x4 w;
                        w.x = pg8::cvt_pk_bf16(v0[0], v0[1]); w.y = pg8::cvt_pk_bf16(v0[2], v0[3]); w.z = pg8::cvt_pk_bf16(v1[0], v1[1]); w.w = pg8::cvt_pk_bf16(v1[2], v1[3]);
                        *(u32x4*)(UG + ((size_t)(g * 512 + (r >> 6))) * UGP + UOF + (r & 63) * 16 + h0) = w; } }
        } else {
            bf16* base; int ldc, colt; float sc = 1.f;
            if (pn == 1) { base = PB; ldc = 256; colt = 0; }
            else if (pn < 4) { base = QB; ldc = 512; colt = (pn - 2) * 256; sc = C2; }
            else if (pn < 6) { base = KB; ldc = 512; colt = (pn - 4) * 256; }
            else { base = VB; ldc = 512; colt = (pn - 6) * 256; }
#pragma unroll
            for (int ai = 0; ai < 2; ++ai)
#pragma unroll
                for (int m = 0; m < 4; ++m) { bf16* rowp = base + (size_t)(row0 + ai * 128 + m * 16) * ldc + colt + cl;
#pragma unroll
                    for (int bj = 0; bj < 2; ++bj) { const f32x4 v0 = acc[ai][bj][m][0] * sc, v1 = acc[ai][bj][m][1] * sc; u32x4 w;
                        w.x = pg8::cvt_pk_bf16(v0[0], v0[1]); w.y = pg8::cvt_pk_bf16(v0[2], v0[3]); w.z = pg8::cvt_pk_bf16(v1[0], v1[1]); w.w = pg8::cvt_pk_bf16(v1[2], v1[3]);
                        *(u32x4*)(rowp + bj * 128) = w; } }
            if (pn >= 4 && pn < 6) {
#pragma unroll
                for (int bj = 0; bj < 2; ++bj)
#pragma unroll
                    for (int n = 0; n < 2; ++n) { f32x4 s = (f32x4){0.f, 0.f, 0.f, 0.f};
#pragma unroll
                        for (int ai = 0; ai < 2; ++ai)
#pragma unroll
                            for (int m = 0; m < 4; ++m) s += acc[ai][bj][m][n];
#pragma unroll
                        for (int i = 0; i < 4; ++i) { float t = s[i]; t += xshfl<1>(t); t += xshfl<2>(t); t += xshfl<4>(t); t += xshfl<8>(t); s[i] = t; }
                        if (fr == 0) *(f32x4*)(KMP + (size_t)wr * 128 * 512 + (size_t)u.pm * 512 + colt + bj * 128 + cl + 4 * n) = s; }
            }
        }
    }
};
struct EpiOutE {
    static constexpr bool PERM = true;
    bf16* RB;
    __device__ __forceinline__ void operator()(const f32x4 (&acc)[2][2][4][2], const pg8::Unit& u, int wr, int wc, int fr_, int fq_) const {
        const int ln_ = lane_id(), fr = ln_ & 15, fq = ln_ >> 4; (void)fr_; (void)fq_;
        const int row0 = u.pm * 256 + wr * 64 + fr, col0 = u.pn * 256 + wc * 32 + 8 * fq;
#pragma unroll
        for (int ai = 0; ai < 2; ++ai) { u32x4 x[4][2];
#pragma unroll
            for (int m = 0; m < 4; ++m) { const bf16* rp = RB + (size_t)(row0 + ai * 128 + m * 16) * D + col0; x[m][0] = *(const u32x4*)rp; x[m][1] = *(const u32x4*)(rp + 128); }
#pragma unroll
            for (int m = 0; m < 4; ++m) { bf16* rp = RB + (size_t)(row0 + ai * 128 + m * 16) * D + col0;
#pragma unroll
                for (int bj = 0; bj < 2; ++bj) { const u32x4 xx = x[m][bj]; const f32x4 a0 = acc[ai][bj][m][0], a1 = acc[ai][bj][m][1]; u32x4 w;
                    w.x = pg8::cvt_pk_bf16(bf2f(xx.x & 0xffffu) + a0[0], bf2f(xx.x >> 16) + a0[1]); w.y = pg8::cvt_pk_bf16(bf2f(xx.y & 0xffffu) + a0[2], bf2f(xx.y >> 16) + a0[3]);
                    w.z = pg8::cvt_pk_bf16(bf2f(xx.z & 0xffffu) + a1[0], bf2f(xx.z >> 16) + a1[1]); w.w = pg8::cvt_pk_bf16(bf2f(xx.w & 0xffffu) + a1[2], bf2f(xx.w >> 16) + a1[3]);
                    *(u32x4*)(rp + bj * 128) = w; } }
            asm volatile("" ::: "memory"); }
    }
};

__device__ __forceinline__ void transpose_item(const float* W, int K, int N, const float* kscale, bf16* WT, int ldo, int koff, int rowmode, LAS float* scr, int item, int lane) {
    const int nblk = N / 32, kb = item / nblk, nb = item % nblk, k0 = 64 * kb, n0 = 32 * nb;
    { const int r8 = lane >> 3, c4 = lane & 7; f32x4 v[8];
#pragma unroll
      for (int i = 0; i < 8; ++i) v[i] = *(const f32x4*)(W + (size_t)(k0 + 8 * i + r8) * N + n0 + 4 * c4);
#pragma unroll
      for (int i = 0; i < 8; ++i) { const int kk = 8 * i + r8; const float s = kscale ? kscale[k0 + kk] : 1.f; LAS float* d = scr + kk * 33 + 4 * c4;
          d[0] = v[i][0] * s; d[1] = v[i][1] * s; d[2] = v[i][2] * s; d[3] = v[i][3] * s; } }
    asm volatile("s_waitcnt lgkmcnt(0)" ::: "memory");
    const int c = lane & 7;
#pragma unroll
    for (int j = 0; j < 4; ++j) { const int n = (lane >> 3) + 8 * j; const LAS float* s = scr + (8 * c) * 33 + n;
        u32x4 o; o.x = pk2(s[0 * 33], s[1 * 33]); o.y = pk2(s[2 * 33], s[3 * 33]); o.z = pk2(s[4 * 33], s[5 * 33]); o.w = pk2(s[6 * 33], s[7 * 33]);
        const int nn = n0 + n, row = rowmode == 0 ? nn : (8 * (nn >> 2) + (nn & 3) + (rowmode == 2 ? 4 : 0));
        *(u32x4*)(WT + (size_t)row * ldo + koff + k0 + 8 * c) = o; }
    asm volatile("s_waitcnt lgkmcnt(0)" ::: "memory");
}
__device__ __forceinline__ void pair_decode(int pi, int& ea, int& eb) { ea = pi < 3 ? 0 : (pi < 5 ? 1 : 2); eb = pi < 3 ? pi + 1 : (pi < 5 ? pi - 1 : 3); }
__device__ __forceinline__ void ph_prologue(const Ctx& F0) {
    const Ctx F = launder(F0);
    LAS float* scr = (LAS float*)(F.lds + F.wave * 16384);
    const int gw = F.vcu * NWAVES + F.wave, NGW = F.G * NWAVES;
    constexpr int I_IN = (D / 64) * (NPROJ / 32), I_OUT = (D / 64) * (D / 32), I_GU1 = (D / 64) * (256 / 32), I_GU = 16 * 2 * I_GU1, I_WD1 = (256 / 64) * (D / 32), I_WD = 24 * 2 * I_WD1;
    constexpr int I_L = I_IN + I_OUT + I_GU + I_WD;
    for (int it = gw; it < DEPTH * I_L; it += NGW) {
        const int l = it / I_L; int r = it % I_L;
        if (r < I_IN) { transpose_item(F.in[3] + (size_t)l * D * NPROJ, D, NPROJ, F.in[2] + l * D, (bf16*)(F.ws + WS_WIN) + (size_t)l * NPROJ * D, D, 0, 0, scr, r, F.lane); continue; } r -= I_IN;
        if (r < I_OUT) { transpose_item(F.in[17] + (size_t)l * D * D, D, D, nullptr, (bf16*)(F.ws + WS_WOUT) + (size_t)l * D * D, D, 0, 0, scr, r, F.lane); continue; } r -= I_OUT;
        if (r < I_GU) { const int e = r / (2 * I_GU1), up = (r / I_GU1) & 1, item = r % I_GU1;
            transpose_item(F.in[up ? 24 : 23] + ((size_t)l * 16 + e) * D * 256, D, 256, F.in[18] + l * D, (bf16*)(F.ws + WS_GU) + ((size_t)l * 16 + e) * 512 * D, D, 0, 1 + up, scr, item, F.lane); continue; } r -= I_GU;
        { const int bk = r / (2 * I_WD1), half = (r / I_WD1) & 1, item = r % I_WD1, g = bk / 6; int ea, eb; pair_decode(bk % 6, ea, eb); const int e = g * 4 + (half ? eb : ea);
            transpose_item(F.in[25] + ((size_t)l * 16 + e) * 256 * D, 256, D, nullptr, (bf16*)(F.ws + WS_WD) + ((size_t)l * 24 + bk) * D * 512, 512, half * 256, 0, scr, item, F.lane); }
    }
    for (int it = gw; it < DEPTH * 32; it += NGW) { const int l = it >> 5;
        transpose_item(F.in[12] + (size_t)l * 256 * 256, 256, 256, nullptr, (bf16*)(F.ws + WS_GLUT) + (size_t)l * 65536, 256, 0, 0, scr, it & 31, F.lane); }
    { const int gt = F.vcu * NTHREADS + F.tid, NGT = F.G * NTHREADS;
      for (int i = gt; i < DEPTH * 65536; i += NGT) { const int l = i >> 16, n = (i >> 8) & 255, k = i & 255;
          const float v = ((n >> 6) == (k >> 6)) ? F.in[14][(((size_t)l * 4 + (n >> 6)) * 64 + (k & 63)) * 64 + (n & 63)] : 0.f;
          ((bf16*)(F.ws + WS_POOLT))[i] = (bf16)f2bf(v); } }
    for (int it = gw; it < DEPTH * SGN * 65; it += NGW) {
        const int l = it / (SGN * 65), g = (it / 65) % SGN, tau = it % 65, p = F.lane;
        const float are = F.in[4][(l * SGN + g) * SP + p], aim = F.in[5][(l * SGN + g) * SP + p], dt = expf(F.in[6][l * SGN + g]);
        float sn, cs; sincosf(aim * dt, &sn, &cs); const float mg = expf(are * dt), lbr = mg * cs, lbi = mg * sn;
        const float nr = lbr - 1.f, ni = lbi, den = are * are + aim * aim, cr = (nr * are + ni * aim) / den, ci = (ni * are - nr * aim) / den;
        float sn2, cs2; sincosf(aim * dt * (float)tau, &sn2, &cs2); const float mg2 = expf(are * dt * (float)tau), lr = mg2 * cs2, li = mg2 * sn2;
        float wr[16], wi[16];
#pragma unroll
        for (int h = 0; h < 16; ++h) { const float br = F.in[7][((size_t)(l * SGN + g) * SP + p) * SG + h], bi = F.in[8][((size_t)(l * SGN + g) * SP + p) * SG + h];
            const float bbr = cr * br - ci * bi, bbi = cr * bi + ci * br; wr[h] = lr * bbr - li * bbi; wi[h] = lr * bbi + li * bbr; }
        bf16* SRD = (bf16*)(F.ws + WS_BZ) + (((size_t)l * SGN + g) * 256 + 128) * 1024;
        if (tau <= 63) {
            bf16* BZ = (bf16*)(F.ws + WS_BZ) + ((size_t)l * SGN + g) * 256 * 1024; const int s = 63 - tau;
            u32x4 o0, o1, o2, o3;
            o0.x = pk2(wr[0], wr[1]); o0.y = pk2(wr[2], wr[3]); o0.z = pk2(wr[4], wr[5]); o0.w = pk2(wr[6], wr[7]); o1.x = pk2(wr[8], wr[9]); o1.y = pk2(wr[10], wr[11]); o1.z = pk2(wr[12], wr[13]); o1.w = pk2(wr[14], wr[15]);
            o2.x = pk2(wi[0], wi[1]); o2.y = pk2(wi[2], wi[3]); o2.z = pk2(wi[4], wi[5]); o2.w = pk2(wi[6], wi[7]); o3.x = pk2(wi[8], wi[9]); o3.y = pk2(wi[10], wi[11]); o3.z = pk2(wi[12], wi[13]); o3.w = pk2(wi[14], wi[15]);
            *(u32x4*)(BZ + (size_t)p * 1024 + s * 16) = o0; *(u32x4*)(BZ + (size_t)p * 1024 + s * 16 + 8) = o1;
            *(u32x4*)(BZ + (size_t)(64 + p) * 1024 + s * 16) = o2; *(u32x4*)(BZ + (size_t)(64 + p) * 1024 + s * 16 + 8) = o3;
        }
        LAS float* Wst = scr; LAS float* Kt = scr + 128 * 16;
        if (tau <= 63) {
#pragma unroll
            for (int q = 0; q < 4; ++q) { *(LAS f32x4*)(Wst + p * 16 + 4 * q) = (f32x4){wr[4 * q], wr[4 * q + 1], wr[4 * q + 2], wr[4 * q + 3]};
                                          *(LAS f32x4*)(Wst + (64 + p) * 16 + 4 * q) = (f32x4){wi[4 * q], wi[4 * q + 1], wi[4 * q + 2], wi[4 * q + 3]}; }
            const int arow = p & 15, kq = p >> 4; f32x4 kacc = (f32x4){0.f, 0.f, 0.f, 0.f};
            const float* cre = F.in[9] + ((size_t)(l * SGN + g) * SG + arow) * SP; const float* cim = F.in[10] + ((size_t)(l * SGN + g) * SG + arow) * SP;
#pragma unroll 8
            for (int s = 0; s < 32; ++s) { const int k = 4 * s + kq; const float av = (k < 64) ? cre[k] : -cim[k - 64]; const float bv = Wst[k * 16 + arow];
                kacc = __builtin_amdgcn_mfma_f32_16x16x4f32(av, bv, kacc, 0, 0, 0); }
#pragma unroll
            for (int r = 0; r < 4; ++r) Kt[(4 * kq + r) * 16 + arow] = kacc[r];
            asm volatile("s_waitcnt lgkmcnt(0)" ::: "memory");
            const f32x4 t4 = *(const LAS f32x4*)(Kt + 4 * p);
            u32x2 o; o.x = pk2(t4[0], t4[1]); o.y = pk2(t4[2], t4[3]);
            *(u32x2*)((bf16*)(F.ws + WS_KT) + ((size_t)(l * SGN + g) * 64 + tau) * 256 + 4 * p) = o;
        }
        if (tau >= 1) {
#pragma unroll 4
            for (int ho = 0; ho < 16; ++ho) {
                const float ccr = F.in[9][((size_t)(l * SGN + g) * SG + ho) * SP + p], cci = F.in[10][((size_t)(l * SGN + g) * SG + ho) * SP + p];
                const int n = (tau - 1) * 16 + ho;
                SRD[(size_t)n * 128 + p] = (bf16)f2bf(ccr * lr - cci * li); SRD[(size_t)n * 128 + 64 + p] = (bf16)f2bf(-(ccr * li + cci * lr)); }
        }
    }
}

__device__ __forceinline__ void route_finish(const float (&a)[20], float ssum, int m, bool act, const float* gb_, const float* rb_, int* tokb, float* tokr, float* tokw, LAS int* hist) {
        const float rstd = 1.f / sqrtf(ssum * (1.f / D) + RMS_EPS);
        float lg0 = a[0] * rstd + gb_[0], lg1 = a[1] * rstd + gb_[1], lg2 = a[2] * rstd + gb_[2], lg3 = a[3] * rstd + gb_[3];
        int gs = 0; float gm = lg0;
        if (lg1 > gm) { gm = lg1; gs = 1; } if (lg2 > gm) { gm = lg2; gs = 2; } if (lg3 > gm) { gm = lg3; gs = 3; }
        const float gwt = 1.f / (__expf(lg0 - gm) + __expf(lg1 - gm) + __expf(lg2 - gm) + __expf(lg3 - gm));
        float q0 = a[4], q1 = a[5], q2 = a[6], q3 = a[7], q4 = a[8], q5 = a[9], q6 = a[10], q7 = a[11], q8 = a[12], q9 = a[13], q10 = a[14], q11 = a[15], q12 = a[16], q13 = a[17], q14 = a[18], q15 = a[19];
        asm volatile("" : "+v"(q0), "+v"(q1), "+v"(q2), "+v"(q3), "+v"(q4), "+v"(q5), "+v"(q6), "+v"(q7));
        asm volatile("" : "+v"(q8), "+v"(q9), "+v"(q10), "+v"(q11), "+v"(q12), "+v"(q13), "+v"(q14), "+v"(q15));
        float e0 = gs == 0 ? q0 : gs == 1 ? q4 : gs == 2 ? q8 : q12;
        float e1 = gs == 0 ? q1 : gs == 1 ? q5 : gs == 2 ? q9 : q13;
        float e2 = gs == 0 ? q2 : gs == 1 ? q6 : gs == 2 ? q10 : q14;
        float e3 = gs == 0 ? q3 : gs == 1 ? q7 : gs == 2 ? q11 : q15;
        e0 = e0 * rstd + rb_[gs * 4 + 0]; e1 = e1 * rstd + rb_[gs * 4 + 1]; e2 = e2 * rstd + rb_[gs * 4 + 2]; e3 = e3 * rstd + rb_[gs * 4 + 3];
        int t1 = 0; float v1 = e0;
        if (e1 > v1) { v1 = e1; t1 = 1; } if (e2 > v1) { v1 = e2; t1 = 2; } if (e3 > v1) { v1 = e3; t1 = 3; }
        int t2 = -1; float v2 = -3.0e38f;
        if (t1 != 0 && e0 > v2) { v2 = e0; t2 = 0; } if (t1 != 1 && e1 > v2) { v2 = e1; t2 = 1; } if (t1 != 2 && e2 > v2) { v2 = e2; t2 = 2; } if (t1 != 3 && e3 > v2) { v2 = e3; t2 = 3; }
        const float p2 = __expf(v2 - v1), w1 = gwt / (1.f + p2), w2 = gwt * p2 / (1.f + p2);
        const int lo = t1 < t2 ? t1 : t2, hi = t1 < t2 ? t2 : t1; const float wlo = t1 < t2 ? w1 : w2, whi = t1 < t2 ? w2 : w1;
        const int pi = lo == 0 ? hi - 1 : (lo == 1 ? hi + 1 : 5), bk = gs * 6 + pi;
        if (act) { tokb[m] = bk; tokr[m] = rstd; tokw[2 * m] = wlo; tokw[2 * m + 1] = whi; __hip_atomic_fetch_add(hist + bk, 1, __ATOMIC_RELAXED, __HIP_MEMORY_SCOPE_WORKGROUP); }
}
__device__ __forceinline__ void ph_route(const Ctx& F0, int l) {
    const Ctx F = launder(F0);
    constexpr int WLD = 1032;
    LAS bf16* Wh = (LAS bf16*)F.lds;
    LAS bf16* Wlo = Wh + 20 * WLD;
    LAS float* LG = (LAS float*)(F.lds + 4 * 20 * WLD);
    LAS int* hist = (LAS int*)(F.lds + 4 * 20 * WLD + 8 * 320 * 4);
    const float* g2 = F.in[18] + l * D;
    const f32x4* gw4 = (const f32x4*)(F.in[19] + (size_t)l * D * 4); const f32x4* rw4 = (const f32x4*)(F.in[21] + (size_t)l * 4 * D * 4);
    const float* gb_ = F.in[20] + l * 4; const float* rb_ = F.in[22] + l * 16;
    for (int idx = F.tid; idx < D * 5; idx += NTHREADS) { const int k = idx % D, q = idx / D;
        f32x4 v = (q == 0) ? gw4[k] : rw4[(q - 1) * D + k]; v = v * g2[k];
#pragma unroll
        for (int i = 0; i < 4; ++i) { const unsigned h = f2bf(v[i]); Wh[(q * 4 + i) * WLD + k] = (bf16)h; Wlo[(q * 4 + i) * WLD + k] = (bf16)f2bf(v[i] - bf2f(h)); } }
    if (F.tid < 32) hist[F.tid] = 0;
    __syncthreads();
    int* tokb = (int*)(F.ws + WS_TOKB); float* tokr = (float*)(F.ws + WS_TOKR); float* tokw = (float*)(F.ws + WS_TOKW);
    const int i16 = F.lane & 15, kq = F.lane >> 4, m0 = F.vcu * 128 + F.wave * 16;
    const u32x4* xr = (const u32x4*)(P_XB(F) + (size_t)(m0 + i16) * D) + kq;
    const int c1 = 16 + (i16 & 3);
    const LAS bf16* bh0 = Wh + i16 * WLD + 8 * kq; const LAS bf16* bl0 = Wlo + i16 * WLD + 8 * kq;
    const LAS bf16* bh1 = Wh + c1 * WLD + 8 * kq;  const LAS bf16* bl1 = Wlo + c1 * WLD + 8 * kq;
    f32x4 acc0 = (f32x4){0.f, 0.f, 0.f, 0.f}, acc1 = acc0; float ss = 0.f;
#pragma unroll 4
    for (int c = 0; c < 32; ++c) {
        const u32x4 xa = xr[4 * c];
        const float x0 = bf2f(xa.x & 0xffffu), x1 = __builtin_bit_cast(float, xa.x & 0xffff0000u), x2 = bf2f(xa.y & 0xffffu), x3 = __builtin_bit_cast(float, xa.y & 0xffff0000u);
        const float x4 = bf2f(xa.z & 0xffffu), x5 = __builtin_bit_cast(float, xa.z & 0xffff0000u), x6 = bf2f(xa.w & 0xffffu), x7 = __builtin_bit_cast(float, xa.w & 0xffff0000u);
        ss += ((x0 * x0 + x1 * x1) + (x2 * x2 + x3 * x3)) + ((x4 * x4 + x5 * x5) + (x6 * x6 + x7 * x7));
        const pg8::bf16x8 av = __builtin_bit_cast(pg8::bf16x8, xa);
        const pg8::bf16x8 h0 = *(const LAS pg8::bf16x8*)(bh0 + 32 * c), l0 = *(const LAS pg8::bf16x8*)(bl0 + 32 * c);
        const pg8::bf16x8 h1 = *(const LAS pg8::bf16x8*)(bh1 + 32 * c), l1 = *(const LAS pg8::bf16x8*)(bl1 + 32 * c);
        acc0 = __builtin_amdgcn_mfma_f32_16x16x32_bf16(av, h0, acc0, 0, 0, 0); acc1 = __builtin_amdgcn_mfma_f32_16x16x32_bf16(av, h1, acc1, 0, 0, 0);
        acc0 = __builtin_amdgcn_mfma_f32_16x16x32_bf16(av, l0, acc0, 0, 0, 0); acc1 = __builtin_amdgcn_mfma_f32_16x16x32_bf16(av, l1, acc1, 0, 0, 0);
    }
    ss += xshfl<16>(ss);
    { const unsigned u = __builtin_bit_cast(unsigned, ss); auto r = __builtin_amdgcn_permlane32_swap(u, u, false, false);
      ss = __builtin_bit_cast(float, (unsigned)r[0]) + __builtin_bit_cast(float, (unsigned)r[1]); }
    LAS float* lg = LG + F.wave * 320;
#pragma unroll
    for (int r = 0; r < 4; ++r) { lg[(4 * kq + r) * 20 + i16] = acc0[r]; if (i16 < 4) lg[(4 * kq + r) * 20 + 16 + i16] = acc1[r]; }
    asm volatile("s_waitcnt lgkmcnt(0)" ::: "memory");
    float a[20];
#pragma unroll
    for (int j = 0; j < 5; ++j) { const f32x4 t4 = *(const LAS f32x4*)(lg + i16 * 20 + 4 * j); a[4 * j] = t4[0]; a[4 * j + 1] = t4[1]; a[4 * j + 2] = t4[2]; a[4 * j + 3] = t4[3]; }
    route_finish(a, ss, m0 + i16, kq == 0, gb_, rb_, tokb, tokr, tokw, hist);
    __syncthreads();
    if (F.tid < 24) __hip_atomic_store((int*)(F.ws + WS_WGCNT) + F.vcu * 24 + F.tid, hist[F.tid], __ATOMIC_RELAXED, __HIP_MEMORY_SCOPE_AGENT);
}
__device__ __forceinline__ void ph_place(const Ctx& F0) {
    const Ctx F = launder(F0);
    LAS int* ptot = (LAS int*)F.lds;
    LAS int* pbef = ptot + 512;
    LAS int* bstart = pbef + 512;
    LAS int* btot = bstart + 32;
    LAS int* carry = btot + 32;
    LAS int* rowidx = carry + 32;
    const int* wgcnt = (const int*)(F.ws + WS_WGCNT);
    int* rowtok = (int*)(F.ws + WS_ROWTOK); float* roww = (float*)(F.ws + WS_ROWW); int* tileb = (int*)(F.ws + WS_TILEB);
    const int* tokb = (const int*)(F.ws + WS_TOKB); const float* tokr = (const float*)(F.ws + WS_TOKR); const float* tokw = (const float*)(F.ws + WS_TOKW);
    { const int p = F.tid >> 5, b = F.tid & 31; int tot = 0, bef = 0;
      if (b < 24) for (int v = p * 16; v < p * 16 + 16; ++v) { const int c = wgcnt[v * 24 + b]; tot += c; if (v < F.vcu) bef += c; }
      ptot[p * 32 + b] = tot; pbef[p * 32 + b] = bef; }
    __syncthreads();
    if (F.tid < 32) { int tot = 0, bef = 0; for (int p = 0; p < 16; ++p) { tot += ptot[p * 32 + F.tid]; bef += pbef[p * 32 + F.tid]; } btot[F.tid] = tot; carry[F.tid] = bef; }
    __syncthreads();
    if (F.tid == 0) { int s = 0; for (int b = 0; b < 24; ++b) { bstart[b] = s; s += (btot[b] + 255) & ~255; } bstart[24] = s; }
    __syncthreads();
    if (F.tid < 24) carry[F.tid] += bstart[F.tid];
    if (F.vcu == 0) {
        if (F.tid == 0) tileb[0] = bstart[24] >> 8;
        for (int b = 0; b < 24; ++b) { const int s = bstart[b], e = bstart[b + 1];
            for (int t = (s >> 8) + F.tid; t < (e >> 8); t += NTHREADS) tileb[1 + t] = b;
            for (int r = s + btot[b] + F.tid; r < e; r += NTHREADS) __hip_atomic_store(rowtok + r, -1, __ATOMIC_RELAXED, __HIP_MEMORY_SCOPE_AGENT); }
    }
    __syncthreads();
    if (F.wave == 0) {
        for (int pass = 0; pass < 2; ++pass) { const int i = pass * 64 + F.lane, bi = tokb[F.vcu * 128 + i]; int row = 0;
#pragma unroll 1
            for (int b = 0; b < 24; ++b) { const unsigned long long mask = __ballot(bi == b); const int c = carry[b];
                if (bi == b) row = c + __builtin_popcountll(mask & ((1ull << F.lane) - 1ull));
                asm volatile("s_waitcnt lgkmcnt(0)" ::: "memory");
                if (F.lane == 0) carry[b] = c + __builtin_popcountll(mask);
                asm volatile("s_waitcnt lgkmcnt(0)" ::: "memory"); }
            rowidx[i] = row; }
    }
    __syncthreads();
    if (F.lane < 16) { const int li = F.wave * 16 + F.lane, m = F.vcu * 128 + li, row = rowidx[li];
        const float rstd = tokr[m];
        const unsigned long long w2 = (unsigned long long)__builtin_bit_cast(unsigned, tokw[2 * m]) | ((unsigned long long)__builtin_bit_cast(unsigned, tokw[2 * m + 1]) << 32);
        __hip_atomic_store(rowtok + row, m, __ATOMIC_RELAXED, __HIP_MEMORY_SCOPE_AGENT);
        __hip_atomic_store((unsigned long long*)(roww + 2 * row), w2, __ATOMIC_RELAXED, __HIP_MEMORY_SCOPE_AGENT);
        __hip_atomic_store((float*)(F.ws + WS_ROWR) + row, rstd, __ATOMIC_RELAXED, __HIP_MEMORY_SCOPE_AGENT); }
}
struct MoeOrder {
    int G, c; bool down; int NT, bks;
    __device__ __forceinline__ void init(const int* tileb) {
        const GAS int* tb_ = (const GAS int*)tileb;
        const int nt_ = tb_[0]; int r0 = c >> 2, r1 = (G + c) >> 2, r2 = (2 * G + c) >> 2, r3 = (3 * G + c) >> 2;
        r0 = r0 < MOE_MAXT ? r0 : MOE_MAXT - 1; r1 = r1 < MOE_MAXT ? r1 : MOE_MAXT - 1; r2 = r2 < MOE_MAXT ? r2 : MOE_MAXT - 1; r3 = r3 < MOE_MAXT ? r3 : MOE_MAXT - 1;
        const int b0 = tb_[1 + r0], b1 = tb_[1 + r1], b2 = tb_[1 + r2], b3 = tb_[1 + r3];
        int n_ = __builtin_amdgcn_readfirstlane(nt_), p_ = __builtin_amdgcn_readfirstlane((b0 & 255) | ((b1 & 255) << 8) | ((b2 & 255) << 16) | ((b3 & 255) << 24));
        asm volatile("" : "+s"(n_), "+s"(p_)); NT = n_; bks = p_;
    }
    __device__ __forceinline__ bool next(int i, pg8::Unit& u) const {
        const int L = i * G + c; if (i > 3 || L >= NT * 4) return false;
        const int rt = L >> 2, pn = L & 3, b = (bks >> (8 * i)) & 255;
        if (down) { u.pm = rt; u.pn = b * 4 + pn; u.aux = pn; }
        else { int ea, eb; pair_decode(b % 6, ea, eb); const int e = (b / 6) * 4 + (pn < 2 ? ea : eb); u.pm = rt; u.pn = e * 2 + (pn & 1); u.aux = pn; }
        return true;
    }
};
struct EpiGU {
    static constexpr bool PERM = true;
    bf16* H; const float* roww; const float* rowr;
    __device__ __forceinline__ void operator()(const f32x4 (&acc)[2][2][4][2], const pg8::Unit& u, int wr, int wc, int fr_, int fq_) const {
        const int ln_ = lane_id(), fr = ln_ & 15, fq = ln_ >> 4; (void)fr_; (void)fq_;
        const int row0 = u.pm * 256 + wr * 64 + fr, cl = u.aux * 128 + 16 * wc + 4 * fq, ws = u.aux >> 1;
#pragma unroll
        for (int ai = 0; ai < 2; ++ai)
#pragma unroll
            for (int m = 0; m < 4; ++m) { const int r = row0 + ai * 128 + m * 16; const float rr = rowr[r], w = roww[2 * r + ws] * rr;
#pragma unroll
                for (int bj = 0; bj < 2; ++bj) { const f32x4 g = acc[ai][bj][m][0], up = acc[ai][bj][m][1]; f32x4 a;
#pragma unroll
                    for (int i = 0; i < 4; ++i) { const float gg = g[i] * rr; a[i] = gg * sigmoidf_(gg) * up[i] * w; }
                    u32x2 o; o.x = pg8::cvt_pk_bf16(a[0], a[1]); o.y = pg8::cvt_pk_bf16(a[2], a[3]);
                    *(u32x2*)(H + (size_t)r * 512 + cl + bj * 64) = o; } }
    }
};
struct EpiDown {
    static constexpr bool PERM = true;
    bf16* RB; const int* rowtok;
    __device__ __forceinline__ void operator()(const f32x4 (&acc)[2][2][4][2], const pg8::Unit& u, int wr, int wc, int fr_, int fq_) const {
        const int ln_ = lane_id(), fr = ln_ & 15, fq = ln_ >> 4; (void)fr_; (void)fq_;
        const int row0 = u.pm * 256 + wr * 64 + fr, col0 = u.aux * 256 + wc * 32 + 8 * fq;
        int tok[8];
#pragma unroll
        for (int i = 0; i < 8; ++i) tok[i] = rowtok[row0 + (i >> 2) * 128 + (i & 3) * 16];
#pragma unroll
        for (int ai = 0; ai < 2; ++ai) { u32x4 x[4][2];
#pragma unroll
            for (int m = 0; m < 4; ++m) { const int tk = tok[ai * 4 + m]; const bf16* rp = RB + (size_t)(tk < 0 ? 0 : tk) * D + col0; x[m][0] = *(const u32x4*)rp; x[m][1] = *(const u32x4*)(rp + 128); }
#pragma unroll
            for (int m = 0; m < 4; ++m) { const int tk = tok[ai * 4 + m]; bf16* rp = RB + (size_t)(tk < 0 ? 0 : tk) * D + col0;
#pragma unroll
                for (int bj = 0; bj < 2; ++bj) { const u32x4 xx = x[m][bj]; const f32x4 a0 = acc[ai][bj][m][0], a1 = acc[ai][bj][m][1]; u32x4 w;
                    w.x = pg8::cvt_pk_bf16(bf2f(xx.x & 0xffffu) + a0[0], bf2f(xx.x >> 16) + a0[1]); w.y = pg8::cvt_pk_bf16(bf2f(xx.y & 0xffffu) + a0[2], bf2f(xx.y >> 16) + a0[3]);
                    w.z = pg8::cvt_pk_bf16(bf2f(xx.z & 0xffffu) + a1[0], bf2f(xx.z >> 16) + a1[1]); w.w = pg8::cvt_pk_bf16(bf2f(xx.w & 0xffffu) + a1[2], bf2f(xx.w >> 16) + a1[3]);
                    if (tk >= 0) *(u32x4*)(rp + bj * 128) = w; } }
            asm volatile("" ::: "memory"); }
    }
};

struct SsmOrder { int G, c, mode;
    __device__ __forceinline__ bool next(int i, pg8::Unit& u) const { const int L = i * G + c;
        if (mode == 1) { if (L >= 32) return false; u.pm = L; u.pn = L >> 1; u.aux = 0; return true; }
        if (L >= 128) return false; const int g = L >> 3; u.pm = g * 2 + ((L >> 2) & 1); u.pn = g * 4 + (L & 3); u.aux = L & 3; u.kt = 2 + 4 * ((L & 3) + 1); return true; } };
struct HalfOrder { int L;
    __device__ __forceinline__ bool next(int i, pg8::Unit& u) const { if (i > 0 || L < 0 || L >= 128) return false; u.pm = L; u.pn = 0; u.aux = 0; return true; } };
struct EpiZ { static constexpr bool PERM = false; float* ZB;
    __device__ __forceinline__ void operator()(const f32x4 (&acc)[2][2][4][2], const pg8::Unit& u, int wr, int wc, int fr_, int fq_) const {
        const int ln_ = lane_id(), fr = ln_ & 15, fq = ln_ >> 4; (void)fr_; (void)fq_;
        const int row0 = u.pm * 256 + wr * 64 + fr, col0 = wc * 32 + 4 * fq;
#pragma unroll
        for (int ai = 0; ai < 2; ++ai)
#pragma unroll
            for (int m = 0; m < 4; ++m)
#pragma unroll
                for (int n = 0; n < 2; ++n) *(f32x4*)(ZB + (size_t)(row0 + ai * 128 + m * 16) * 128 + col0 + n * 16) = acc[ai][0][m][n];
    } };
struct EpiSsm2 { static constexpr bool PERM = true; const bf16* UG; bf16* YS; const float* dvec;
    __device__ __forceinline__ void operator()(const f32x4 (&acc)[2][2][4][2], const pg8::Unit& u, int wr, int wc, int fr_, int fq_) const {
        const int ln_ = lane_id(), fr = ln_ & 15, fq = ln_ >> 4; (void)fr_; (void)fq_;
        const int g = u.pm >> 1, cr0 = (u.pm & 1) * 256 + wr * 64 + fr;
#pragma unroll
        for (int bj = 0; bj < 2; ++bj) { const int n0 = u.aux * 256 + bj * 128 + wc * 32 + 8 * fq, to = n0 >> 4, ho0 = n0 & 15;
            const f32x4 d0 = *(const f32x4*)(dvec + g * 16 + ho0), d1 = *(const f32x4*)(dvec + g * 16 + ho0 + 4);
#pragma unroll
            for (int ai = 0; ai < 2; ++ai)
#pragma unroll
                for (int m = 0; m < 4; ++m) { const int cr = cr0 + ai * 128 + m * 16;
                    const u32x4 uu = *(const u32x4*)(UG + ((size_t)(g * 512 + cr)) * UGP + UOF + n0);
                    const f32x4 a0 = acc[ai][bj][m][0], a1 = acc[ai][bj][m][1]; float y[8];
                    y[0] = gelu_tanh(a0[0] + d0[0] * bf2f(uu.x & 0xffffu)); y[1] = gelu_tanh(a0[1] + d0[1] * bf2f(uu.x >> 16));
                    y[2] = gelu_tanh(a0[2] + d0[2] * bf2f(uu.y & 0xffffu)); y[3] = gelu_tanh(a0[3] + d0[3] * bf2f(uu.y >> 16));
                    y[4] = gelu_tanh(a1[0] + d1[0] * bf2f(uu.z & 0xffffu)); y[5] = gelu_tanh(a1[1] + d1[1] * bf2f(uu.z >> 16));
                    y[6] = gelu_tanh(a1[2] + d1[2] * bf2f(uu.w & 0xffffu)); y[7] = gelu_tanh(a1[3] + d1[3] * bf2f(uu.w >> 16));
                    u32x4 w; w.x = pg8::cvt_pk_bf16(y[0], y[1]); w.y = pg8::cvt_pk_bf16(y[2], y[3]); w.z = pg8::cvt_pk_bf16(y[4], y[5]); w.w = pg8::cvt_pk_bf16(y[6], y[7]);
                    *(u32x4*)(YS + ((size_t)cr * 64 + to) * 256 + g * 16 + ho0) = w; } }
    } };
struct EpiGluE { static constexpr bool PERM = true; const bf16* YS; bf16* YMIX; const float* gb;
    __device__ __forceinline__ void operator()(const f32x4 (&acc)[2][2][4][2], const pg8::Unit& u, int wr, int wc, int fr_, int fq_) const {
        const int ln_ = lane_id(), fr = ln_ & 15, fq = ln_ >> 4; (void)fr_; (void)fq_;
        const int row0 = u.pm * 256 + wr * 64 + fr;
#pragma unroll
        for (int bj = 0; bj < 2; ++bj) { const int n0 = bj * 128 + wc * 32 + 8 * fq; const f32x4 b0 = *(const f32x4*)(gb + n0), b1 = *(const f32x4*)(gb + n0 + 4);
#pragma unroll
            for (int ai = 0; ai < 2; ++ai)
#pragma unroll
                for (int m = 0; m < 4; ++m) { const size_t r = (size_t)(row0 + ai * 128 + m * 16); const u32x4 yy = *(const u32x4*)(YS + r * 256 + n0);
                    const f32x4 a0 = acc[ai][bj][m][0] + b0, a1 = acc[ai][bj][m][1] + b1; float o[8];
                    o[0] = bf2f(yy.x & 0xffffu) * sigmoidf_(a0[0]); o[1] = bf2f(yy.x >> 16) * sigmoidf_(a0[1]); o[2] = bf2f(yy.y & 0xffffu) * sigmoidf_(a0[2]); o[3] = bf2f(yy.y >> 16) * sigmoidf_(a0[3]);
                    o[4] = bf2f(yy.z & 0xffffu) * sigmoidf_(a1[0]); o[5] = bf2f(yy.z >> 16) * sigmoidf_(a1[1]); o[6] = bf2f(yy.w & 0xffffu) * sigmoidf_(a1[2]); o[7] = bf2f(yy.w >> 16) * sigmoidf_(a1[3]);
                    u32x4 w; w.x = pg8::cvt_pk_bf16(o[0], o[1]); w.y = pg8::cvt_pk_bf16(o[2], o[3]); w.z = pg8::cvt_pk_bf16(o[4], o[5]); w.w = pg8::cvt_pk_bf16(o[6], o[7]);
                    *(u32x4*)(YMIX + r * 1024 + n0) = w; } }
    } };
struct EpiPoolE { static constexpr bool PERM = true; bf16* YMIX; const float* pb; const float* ps;
    __device__ __forceinline__ void operator()(const f32x4 (&acc)[2][2][4][2], const pg8::Unit& u, int wr, int wc, int fr_, int fq_) const {
        const int ln_ = lane_id(), fr = ln_ & 15, fq = ln_ >> 4; (void)fr_; (void)fq_;
        const int row0 = u.pm * 256 + wr * 64 + fr;
#pragma unroll
        for (int bj = 0; bj < 2; ++bj) { const int n0 = bj * 128 + wc * 32 + 8 * fq; const f32x4 b0 = *(const f32x4*)(pb + n0), b1 = *(const f32x4*)(pb + n0 + 4), s0 = *(const f32x4*)(ps + n0), s1 = *(const f32x4*)(ps + n0 + 4);
#pragma unroll
            for (int ai = 0; ai < 2; ++ai)
#pragma unroll
                for (int m = 0; m < 4; ++m) { const size_t r = (size_t)(row0 + ai * 128 + m * 16);
                    const f32x4 a0 = (acc[ai][bj][m][0] + b0) * s0, a1 = (acc[ai][bj][m][1] + b1) * s1;
                    u32x4 w; w.x = pg8::cvt_pk_bf16(a0[0], a0[1]); w.y = pg8::cvt_pk_bf16(a0[2], a0[3]); w.z = pg8::cvt_pk_bf16(a1[0], a1[1]); w.w = pg8::cvt_pk_bf16(a1[2], a1[3]);
                    *(u32x4*)(YMIX + r * 1024 + 256 + n0) = w; } }
    } };
__device__ __forceinline__ void ph_tg_expand(const Ctx& F0, int l, int bx, int w0) {
    const Ctx F = launder(F0);
    if (bx < w0) return;
    const int gw = (bx - w0) * NWAVES + F.wave, NGW = (F.G - w0) * NWAVES;
    const bf16* KT = (const bf16*)(F.ws + WS_KT) + (size_t)l * SGN * 64 * 256;
    bf16* TG0 = (bf16*)(F.ws + WS_TG) + (size_t)l * SGN * 1024 * UGP;
#pragma unroll 2
    for (int r = gw; r < SGN * 1024; r += NGW) { const int g = r >> 10, n = r & 1023, to = n >> 4, ho = n & 15;
        bf16* d = TG0 + ((size_t)g * 1024 + n) * UGP;
        if (F.lane < 16) *(u32x4*)(d + F.lane * 8) = *(const u32x4*)((const bf16*)(F.ws + WS_BZ) + (((size_t)l * SGN + g) * 256 + 128) * 1024 + (size_t)n * 128 + F.lane * 8);
#pragma unroll
        for (int half = 0; half < 2; ++half) { const int ti = half * 32 + (F.lane >> 1), tau = to - ti;
            u32x4 v = (u32x4){0u, 0u, 0u, 0u};
            if (tau >= 0) v = *(const u32x4*)(KT + (((size_t)g * 64 + tau) * 16 + ho) * 16 + (F.lane & 1) * 8);
            if (half * 512 + F.lane * 8 < ((n >> 8) + 1) * 256) *(u32x4*)(d + UOF + half * 512 + F.lane * 8) = v; } }
}
__device__ __forceinline__ void ph_ssm_scan(const Ctx& F0, int l) {
    const Ctx F = launder(F0);
    if (F.wave != 0 || (F.vcu & 1) != 0 || F.vcu >= 256) return;
    for (int it = (F.vcu >> 2) * 2 + ((F.vcu >> 1) & 1); it < SGN * NB; it += SGN * NB) {
        const int g = it >> 3, b = it & 7, p = F.lane;
        const float are = F.in[4][(l * SGN + g) * SP + p], aim = F.in[5][(l * SGN + g) * SP + p], dt = expf(F.in[6][l * SGN + g]);
        float sn, cs; sincosf(aim * dt * 64.f, &sn, &cs); const float mg = expf(are * dt * 64.f), lr = mg * cs, li = mg * sn;
        const float* Z = (const float*)(F.ws + WS_ZB) + ((size_t)g * 512 + b * 64) * 128;
        bf16* U = P_UG(F) + ((size_t)g * 512 + b * 64) * UGP;
        float sr = 0.f, si = 0.f;
#pragma unroll 1
        for (int c0 = 0; c0 < 64; c0 += 32) {
            float zr[32], zi[32];
#pragma unroll
            for (int j = 0; j < 32; ++j) { zr[j] = Z[(c0 + j) * 128 + p]; zi[j] = Z[(c0 + j) * 128 + 64 + p]; }
#pragma unroll
            for (int j = 0; j < 32; ++j) {
                U[(size_t)(c0 + j) * UGP + p] = (bf16)f2bf(sr); U[(size_t)(c0 + j) * UGP + 64 + p] = (bf16)f2bf(si);
                const float nr = lr * sr - li * si + zr[j], ni = lr * si + li * sr + zi[j]; sr = nr; si = ni; }
        }
    }
}

namespace moba {
using bf16x8 = __attribute__((ext_vector_type(8))) short;
using s16x4 = __attribute__((ext_vector_type(4))) short;
using f32x16 = __attribute__((ext_vector_type(16))) float;
typedef short v4i16_t __attribute__((ext_vector_type(4)));
typedef float f32x2_t __attribute__((ext_vector_type(2))); typedef __bf16 bf16x2_t __attribute__((ext_vector_type(2)));
constexpr int L_K = 0, L_V = 49152, L_TB = 98304, L_KM = L_TB + 4 * 768 * 4, L_END = L_KM + 16 * 64 * 4;
__device__ __forceinline__ unsigned cvtpk(float lo, float hi) { f32x2_t v = {lo, hi}; bf16x2_t b = __builtin_convertvector(v, bf16x2_t); return __builtin_bit_cast(unsigned, b); }
__device__ __forceinline__ s16x4 vtr(const LAS char* p) { return __builtin_bit_cast(s16x4, __builtin_amdgcn_ds_read_tr16_b64_v4i16((LAS v4i16_t*)p)); }
__device__ __forceinline__ float hmax(float v) { const unsigned u = __builtin_bit_cast(unsigned, v); auto r = __builtin_amdgcn_permlane32_swap(u, u, false, false); return fmaxf(__builtin_bit_cast(float, (unsigned)r[0]), __builtin_bit_cast(float, (unsigned)r[1])); }
__device__ __forceinline__ float hsum(float v) { const unsigned u = __builtin_bit_cast(unsigned, v); auto r = __builtin_amdgcn_permlane32_swap(u, u, false, false); return __builtin_bit_cast(float, (unsigned)r[0]) + __builtin_bit_cast(float, (unsigned)r[1]); }

constexpr int L_LIST = L_END, L_WCNT = 32768;
#define MOBA_CVEC() f32x16 cvec; do { const float ci_ = bfar - mref; _Pragma("unroll") for (int r = 0; r < 16; ++r) cvec[r] = ci_; } while (0)
#define MOBA_QK(P0, P1, KB) do { { const bf16x8 a0 = *(const LAS bf16x8*)(kp0 + (KB)), a1 = *(const LAS bf16x8*)(kp0 + (KB) + 512); \
          P0 = __builtin_amdgcn_mfma_f32_32x32x16_bf16(a0, qr[0], cvec, 0, 0, 0); P1 = __builtin_amdgcn_mfma_f32_32x32x16_bf16(a1, qr[0], cvec, 0, 0, 0); } \
        _Pragma("unroll") for (int d0 = 1; d0 < 4; ++d0) { const bf16x8 a0 = *(const LAS bf16x8*)(kp0 + (KB) + d0 * 2048), a1 = *(const LAS bf16x8*)(kp0 + (KB) + d0 * 2048 + 512); \
            P0 = __builtin_amdgcn_mfma_f32_32x32x16_bf16(a0, qr[d0], P0, 0, 0, 0); P1 = __builtin_amdgcn_mfma_f32_32x32x16_bf16(a1, qr[d0], P1, 0, 0, 0); } } while (0)
#define MOBA_NEARMAX(P0, P1, JN, OUT) do { const int jn_ = (JN); if (jn_ >= 0) { const int A_ = qrel - 64 * (jn_ - 4) - 4 * hi + 256, s_ = 767 - A_, c_ = s_ & 3; \
            const LAS f32x4* t4 = (const LAS f32x4*)(tb + c_ * 768 + (s_ - c_)); \
            _Pragma("unroll") for (int g = 0; g < 4; ++g) { const f32x4 x0 = t4[2 * g], x1 = t4[2 * g + 8]; \
                _Pragma("unroll") for (int j = 0; j < 4; ++j) { P0[4 * g + j] += x0[j]; P1[4 * g + j] += x1[j]; } } } \
        float ra = __builtin_fmaxf(__builtin_fmaxf(P0[0], P0[1]), P1[0]), rb = __builtin_fmaxf(__builtin_fmaxf(P0[2], P0[3]), P1[1]); \
        ra = __builtin_fmaxf(__builtin_fmaxf(ra, P1[2]), P1[3]); \
        _Pragma("unroll") for (int r = 4; r < 16; r += 4) { ra = __builtin_fmaxf(__builtin_fmaxf(ra, P0[r]), P0[r + 1]); rb = __builtin_fmaxf(__builtin_fmaxf(rb, P0[r + 2]), P0[r + 3]); \
            ra = __builtin_fmaxf(__builtin_fmaxf(ra, P1[r]), P1[r + 1]); rb = __builtin_fmaxf(__builtin_fmaxf(rb, P1[r + 2]), P1[r + 3]); } \
        OUT = hmax(__builtin_fmaxf(ra, rb)); } while (0)
#define MOBA_STEP(PC0, PC1, PN0, PN1, JNN, KBN, VBC, HASN) do { \
        bf16x8 vf[8], kf[8]; \
        if (HASN) { _Pragma("unroll") for (int d0 = 0; d0 < 4; ++d0) { kf[2 * d0] = *(const LAS bf16x8*)(kp0 + (KBN) + d0 * 2048); kf[2 * d0 + 1] = *(const LAS bf16x8*)(kp0 + (KBN) + d0 * 2048 + 512); } } \
        __builtin_amdgcn_sched_barrier(0); \
        if (__any(rm > 8.f)) { const float dl = __builtin_fmaxf(rm, 0.f), alpha = __builtin_amdgcn_exp2f(-dl); mref += dl; l *= alpha; \
            _Pragma("unroll") for (int r = 0; r < 16; ++r) { PC0[r] -= dl; PC1[r] -= dl; o0[r] *= alpha; o1[r] *= alpha; } } \
        if (HASN) { MOBA_CVEC(); \
                    PN0 = __builtin_amdgcn_mfma_f32_32x32x16_bf16(kf[0], qr[0], cvec, 0, 0, 0); PN1 = __builtin_amdgcn_mfma_f32_32x32x16_bf16(kf[1], qr[0], cvec, 0, 0, 0); \
                    _Pragma("unroll") for (int d0 = 1; d0 < 4; ++d0) { PN0 = __builtin_amdgcn_mfma_f32_32x32x16_bf16(kf[2 * d0], qr[d0], PN0, 0, 0, 0); PN1 = __builtin_amdgcn_mfma_f32_32x32x16_bf16(kf[2 * d0 + 1], qr[d0], PN1, 0, 0, 0); } } \
        { const LAS char* vp = vp0 + (VBC); \
        _Pragma("unroll") for (int k = 0; k < 4; ++k) { \
            const s16x4 lo0 = vtr(vp + k * 1024), hi0 = vtr(vp + k * 1024 + 512), lo1 = vtr(vp + 4096 + k * 1024), hi1 = vtr(vp + 4096 + k * 1024 + 512); \
            vf[2 * k] = (bf16x8){lo0[0], lo0[1], lo0[2], lo0[3], hi0[0], hi0[1], hi0[2], hi0[3]}; vf[2 * k + 1] = (bf16x8){lo1[0], lo1[1], lo1[2], lo1[3], hi1[0], hi1[1], hi1[2], hi1[3]}; } } \
        __builtin_amdgcn_sched_barrier(0); \
        float s0 = 0.f, s1 = 0.f; u32x4 pw[4]; \
        _Pragma("unroll") for (int r = 0; r < 16; ++r) { PC0[r] = __builtin_amdgcn_exp2f(PC0[r]); PC1[r] = __builtin_amdgcn_exp2f(PC1[r]); s0 += PC0[r]; s1 += PC1[r]; } \
        l += s0 + s1; \
        _Pragma("unroll") for (int q = 0; q < 4; ++q) { pw[0][q] = cvtpk(PC0[2 * q], PC0[2 * q + 1]); pw[1][q] = cvtpk(PC0[8 + 2 * q], PC0[9 + 2 * q]); pw[2][q] = cvtpk(PC1[2 * q], PC1[2 * q + 1]); pw[3][q] = cvtpk(PC1[8 + 2 * q], PC1[9 + 2 * q]); } \
        _Pragma("unroll") for (int k = 0; k < 4; ++k) { const bf16x8 pa = __builtin_bit_cast(bf16x8, pw[k]); \
            o0 = __builtin_amdgcn_mfma_f32_32x32x16_bf16(vf[2 * k], pa, o0, 0, 0, 0); o1 = __builtin_amdgcn_mfma_f32_32x32x16_bf16(vf[2 * k + 1], pa, o1, 0, 0, 0); } \
        if (HASN) MOBA_NEARMAX(PN0, PN1, JNN, rm); \
    } while (0)
#define MOBA_BLOCK4(JN0, PRE4) \
    float mref = 0.f, l = 0.f; f32x16 o0 = f32x16{}, o1 = f32x16{}; f32x16 pa0, pa1, pb0, pb1; float rm; \
    { const int jn0_ = (JN0); \
      { MOBA_CVEC(); MOBA_QK(pa0, pa1, 0); } MOBA_NEARMAX(pa0, pa1, jn0_, rm); \
      MOBA_STEP(pa0, pa1, pb0, pb1, (jn0_ < 0 ? -1 : jn0_ + 1), 8192, 0, true); \
      MOBA_STEP(pb0, pb1, pa0, pa1, (jn0_ < 0 ? -1 : jn0_ + 2), 16384, 8192, true); \
      MOBA_STEP(pa0, pa1, pb0, pb1, (jn0_ < 0 ? -1 : jn0_ + 3), 24576, 16384, true); \
      PRE4; \
      MOBA_STEP(pb0, pb1, pa0, pa1, -1, 0, 24576, false); }
__device__ __forceinline__ void load_block(const bf16* K, const bf16* V, size_t row0, int h, int wid, int lane, LAS char* lds) {
    const bf16* ksrc = K + (row0 + lane) * 512 + h * 64 + wid * 8;
    const bf16* vsrc = V + (row0 + 16 * (wid & 3) + (lane >> 2)) * 512 + h * 64 + (wid >> 2) * 32 + (lane & 3) * 8;
    u32x4 kr[4], vr[4];
#pragma unroll
    for (int t = 0; t < 4; ++t) { kr[t] = *(const u32x4*)(ksrc + (size_t)t * 64 * 512); vr[t] = *(const u32x4*)(vsrc + (size_t)t * 64 * 512); }
    LAS char* kd = lds + L_K + wid * 1024 + lane * 16; LAS char* vd = lds + L_V + wid * 1024 + lane * 16;
#pragma unroll
    for (int t = 0; t < 4; ++t) { *(LAS u32x4*)(kd + t * 8192) = kr[t]; *(LAS u32x4*)(vd + t * 8192) = vr[t]; }
}
__device__ __forceinline__ void fill_bias_table(const float* BT, int h, int tid, LAS float* tb) {
    const float bfar = BT[h * 132 + 128];
    for (int i = tid; i < 4 * 768; i += NTHREADS) { const int c = i / 768, j = i % 768, src_ = 767 - (j + c), rel = src_ - 256; tb[i] = (src_ < 0 || rel < 0) ? -1.0e30f : (rel < 128 ? BT[h * 132 + rel] - bfar : 0.f); }
}
__device__ __forceinline__ void sel_phase(int wave_, int vcu, int G, const bf16* Q, const float* KMP, unsigned* SEL, LAS char* lds) {
    const int w0 = G > 64 ? 32 : 0, nw = G - w0; if (vcu < w0) return;
    int lane_ = lane_id(); asm volatile("" : "+v"(lane_)); asm volatile("" : "+s"(wave_));
    const int wid = wave_, lane = lane_, tid = wid * 64 + lane, r32 = lane & 31, hi = lane >> 5;
    const int ub = ((vcu - w0) * 1024) / nw, ue = ((vcu - w0 + 1) * 1024) / nw;
    LAS float* km = (LAS float*)(lds + L_KM);
    int bhc = -1;
#pragma unroll 1
    for (int u = ub; u < ue; ++u) {
        const int bh = u >> 4, qb = u & 15, b = bh >> 3, h = bh & 7;
        if (bh != bhc) { bhc = bh;
            __syncthreads();
            for (int i = tid; i < 16 * 64; i += NTHREADS) { const int j = i >> 6, d = i & 63, pm = b * 16 + j; km[i] = KMP[pm * 512 + h * 64 + d] + KMP[128 * 512 + pm * 512 + h * 64 + d]; }
            __syncthreads(); }
        asm volatile("" ::: "memory");
        const int q = qb * 256 + wid * 32 + r32;
        const bf16* qw = Q + ((size_t)b * SEQ + q) * 512 + h * 64 + hi * 8;
        bf16x8 qr[4];
#pragma unroll
        for (int d0 = 0; d0 < 4; ++d0) qr[d0] = *(const bf16x8*)(qw + d0 * 16);
        float g[16];
#pragma unroll
        for (int j = 0; j < 16; ++j) g[j] = 0.f;
#pragma unroll
        for (int d0 = 0; d0 < 4; ++d0)
#pragma unroll
            for (int j = 0; j < 16; ++j) { const f32x4 ka = *(const LAS f32x4*)(km + j * 64 + d0 * 16 + hi * 8), kb4 = *(const LAS f32x4*)(km + j * 64 + d0 * 16 + hi * 8 + 4);
#pragma unroll
                for (int e = 0; e < 4; ++e) { g[j] += bf2f((unsigned)(unsigned short)qr[d0][e]) * ka[e]; }
#pragma unroll
                for (int e = 0; e < 4; ++e) { g[j] += bf2f((unsigned)(unsigned short)qr[d0][4 + e]) * kb4[e]; } }
#pragma unroll
        for (int j = 0; j < 16; ++j) g[j] = hsum(g[j]);
        unsigned selmask = 0u;
#pragma unroll
        for (int s3 = 0; s3 < 3; ++s3) { float bv = -3.0e38f; int bi = -1;
#pragma unroll
            for (int j = 0; j < 16; ++j) { const bool ok = (j < qb) && !((selmask >> j) & 1u) && (g[j] > bv); bv = ok ? g[j] : bv; bi = ok ? j : bi; }
            if (bi >= 0) selmask |= 1u << bi; }
        if (hi == 0) SEL[(size_t)bh * SEQ + q] = selmask;
    }
}
__device__ __forceinline__ bf16* pslot(int slot, size_t t, int h, bf16* YM, bf16* P2A, bf16* P2B, bf16* P3) {
    return slot == 3 ? P3 + t * 512 + h * 64 : slot == 0 ? YM + t * 1024 + h * 64 : slot == 1 ? YM + t * 1024 + 512 + h * 64 : (t < (size_t)(T / 2) ? P2A + t * 512 : P2B + (t - (size_t)(T / 2)) * 512) + h * 64;
}
__device__ __forceinline__ void gather_phase(int wave_, int vcu, const bf16* Q, const bf16* K, const bf16* V, bf16* YM, bf16* P2A, bf16* P2B, bf16* P3, float* ML, const unsigned* SEL, const float* BT, LAS char* lds) {
    if (vcu >= 256) return;
    int lane_ = lane_id(); asm volatile("" : "+v"(lane_)); asm volatile("" : "+s"(wave_));
    const int wid = wave_, lane = lane_, tid = wid * 64 + lane, r32 = lane & 31, hi = lane >> 5;
    const int bh = vcu >> 2, s = vcu & 3, b = bh >> 3, h = bh & 7;
    const size_t rowbase = (size_t)b * SEQ;
    LAS float* tb = (LAS float*)(lds + L_TB); LAS int* list = (LAS int*)(lds + L_LIST); LAS int* wcnt = (LAS int*)(lds + L_WCNT);
    const float bfar = BT[h * 132 + 128];
    fill_bias_table(BT, h, tid, tb);
    const unsigned* selrow = SEL + (size_t)bh * SEQ;
    const LAS char* kp0 = lds + L_K + hi * 1024 + r32 * 16;
    const LAS char* vp0 = lds + L_V + ((lane >> 4) & 1) * 32 + (lane & 3) * 8 + (4 * hi + ((lane & 15) >> 2)) * 64;
    const unsigned code = s == 0 ? 0xDB80u : s == 1 ? 0xF961u : s == 2 ? 0xCA52u : 0xE743u;
    u32x4 kr[4], vr[4]; unsigned msel[8];
#define MOBA_GFETCH(KB) do { const size_t row0 = rowbase + (size_t)(KB) * 256; int lg_ = lane_id(); asm volatile("" : "+v"(lg_));     \
        const bf16* ksrc = K + (row0 + lg_) * 512 + h * 64 + wid * 8; \
        const bf16* vsrc = V + (row0 + 16 * (wid & 3) + (lg_ >> 2)) * 512 + h * 64 + (wid >> 2) * 32 + (lg_ & 3) * 8; \
        _Pragma("unroll") for (int t = 0; t < 4; ++t) { kr[t] = *(const u32x4*)(ksrc + (size_t)t * 64 * 512); vr[t] = *(const u32x4*)(vsrc + (size_t)t * 64 * 512); } \
        const int qs_ = ((KB) + 1) * 256, R_ = (SEQ - qs_) >> 3; \
        _Pragma("unroll") for (int i = 0; i < 8; ++i) { const int off = i * 64 + lg_; msel[i] = off < R_ ? selrow[qs_ + wid * R_ + off] : 0u; } } while (0)
    MOBA_GFETCH((int)(code & 15u));
#pragma unroll 1
    for (int ik = 0; ik < 4; ++ik) {
        const int kb = (int)((code >> (4 * ik)) & 15u);
        const int kbn = (int)((code >> (4 * (ik < 3 ? ik + 1 : ik))) & 15u);
        __syncthreads();
        { LAS char* kd = lds + L_K + wid * 1024 + lane * 16; LAS char* vd = lds + L_V + wid * 1024 + lane * 16;
#pragma unroll
          for (int t = 0; t < 4; ++t) { *(LAS u32x4*)(kd + t * 8192) = kr[t]; *(LAS u32x4*)(vd + t * 8192) = vr[t]; } }
        const int qs = (kb + 1) * 256, R = (SEQ - qs) >> 3;
        unsigned long long bal[8]; int cnt = 0;
#pragma unroll
        for (int i = 0; i < 8; ++i) { bal[i] = __ballot((msel[i] >> kb) & 1u); cnt += __builtin_popcountll(bal[i]); }
        if (lane == 0) wcnt[wid] = cnt;
        __syncthreads();
        int base = 0, n = 0;
#pragma unroll
        for (int w = 0; w < 8; ++w) { const int c = wcnt[w]; n += c; base += (w < wid) ? c : 0; }
#pragma unroll
        for (int i = 0; i < 8; ++i) { const unsigned long long m = bal[i];
            if ((m >> lane) & 1ull) list[base + __builtin_popcountll(m & ((1ull << lane) - 1ull))] = qs + wid * R + i * 64 + lane;
            base += __builtin_popcountll(m); }
        __syncthreads();
        const int ntask = (n + 31) >> 5;
        int tk = wid, qin = 0; bool vn = false; unsigned smn = 0u; bf16x8 qn[4];
#define MOBA_QFETCH() do { const bool dg_ = tk >= ntask; const int li_ = tk * 32 + r32; const bool in_ = !dg_ && li_ < n; vn = dg_ || in_; \
            { const int lv_ = list[in_ ? li_ : (n > 0 ? n - 1 : 0)]; qin = dg_ ? kb * 256 + wid * 32 + r32 : (n > 0 ? lv_ : qs - 1); } smn = selrow[qin]; \
            const bf16* qw = Q + (rowbase + qin) * 512 + h * 64 + hi * 8; \
            _Pragma("unroll") for (int d0 = 0; d0 < 4; ++d0) qn[d0] = *(const bf16x8*)(qw + d0 * 16); } while (0)
        MOBA_QFETCH();
        bool more = true;
#pragma unroll 1
        while (more) {
            const bool isdiag = tk >= ntask;
            const int qi = qin; const bool valid = vn; const unsigned sm = smn;
            bf16x8 qr[4];
#pragma unroll
            for (int d0 = 0; d0 < 4; ++d0) qr[d0] = qn[d0];
            more = !isdiag; tk += 8;
            const int slot = isdiag ? 3 : __builtin_popcount(sm & ((1u << kb) - 1u));
            const int qd = qi - qs, qrel = isdiag ? qi - kb * 256 : (qd < 255 ? qd : 255);
            const bool nearw = isdiag || __any(qd < 128);
            MOBA_BLOCK4(isdiag ? 4 : (nearw ? 0 : -1), MOBA_QFETCH())
            const float lt = hsum(l), inv = 1.f / lt; const size_t t = rowbase + qi;
            bf16* orow = pslot(slot, t, h, YM, P2A, P2B, P3) + 8 * hi;
#pragma unroll
            for (int d0 = 0; d0 < 2; ++d0)
#pragma unroll
                for (int gp = 0; gp < 2; ++gp) { const f32x16& oo = d0 ? o1 : o0; const int ga = 8 * gp, gb = 8 * gp + 4;
                    unsigned ax = cvtpk(oo[ga] * inv, oo[ga + 1] * inv), ay = cvtpk(oo[ga + 2] * inv, oo[ga + 3] * inv), bx = cvtpk(oo[gb] * inv, oo[gb + 1] * inv), by = cvtpk(oo[gb + 2] * inv, oo[gb + 3] * inv);
                    { auto r = __builtin_amdgcn_permlane32_swap(ax, bx, false, false); ax = r[0]; bx = r[1]; }
                    { auto r = __builtin_amdgcn_permlane32_swap(ay, by, false, false); ay = r[0]; by = r[1]; }
                    if (valid) *(u32x4*)(orow + 32 * d0 + 16 * gp) = (u32x4){ax, ay, bx, by}; }
            if (valid && hi == 0) { float* ml = ML + ((t * 8 + h) * 4 + slot) * 2; ml[0] = mref; ml[1] = lt; }
        }
#undef MOBA_QFETCH
        MOBA_GFETCH(kbn);
    }
#undef MOBA_GFETCH
}
__device__ __forceinline__ void merge_phase(int wave_, int t0, int t1, bf16* YM, const bf16* P2A, const bf16* P2B, const bf16* P3, const float* ML) {
    int lane_ = lane_id(); asm volatile("" : "+v"(lane_)); asm volatile("" : "+s"(wave_));
    const int lane = lane_, hh = lane >> 3;
#pragma unroll 2
    for (int t = t0 + wave_; t < t1; t += NWAVES) {
        const int nsl = ((t & (SEQ - 1)) >> 8) < 3 ? ((t & (SEQ - 1)) >> 8) : 3;
        const f32x4 mla = *(const f32x4*)(ML + ((size_t)t * 8 + hh) * 8), mlb = *(const f32x4*)(ML + ((size_t)t * 8 + hh) * 8 + 4);
        const bf16* y = YM + (size_t)t * 1024 + lane * 8;
        const u32x4 z = (u32x4){0u, 0u, 0u, 0u};
        const u32x4 x3 = *(const u32x4*)(P3 + (size_t)t * 512 + lane * 8);
        const u32x4 x0 = nsl > 0 ? *(const u32x4*)y : z, x1 = nsl > 1 ? *(const u32x4*)(y + 512) : z;
        const u32x4 x2 = nsl > 2 ? *(const u32x4*)(((size_t)t < (size_t)(T / 2) ? P2A + (size_t)t * 512 : P2B + ((size_t)t - (size_t)(T / 2)) * 512) + lane * 8) : z;
        const float m0 = nsl > 0 ? mla[0] : -3.0e38f, m1 = nsl > 1 ? mla[2] : -3.0e38f, m2 = nsl > 2 ? mlb[0] : -3.0e38f, m3 = mlb[2];
        const float M = __builtin_fmaxf(__builtin_fmaxf(m0, m1), __builtin_fmaxf(m2, m3));
        const float w0 = nsl > 0 ? mla[1] * __builtin_amdgcn_exp2f(m0 - M) : 0.f, w1 = nsl > 1 ? mla[3] * __builtin_amdgcn_exp2f(m1 - M) : 0.f, w2 = nsl > 2 ? mlb[1] * __builtin_amdgcn_exp2f(m2 - M) : 0.f, w3 = mlb[3] * __builtin_amdgcn_exp2f(m3 - M);
        const float inv = 1.f / ((w0 + w1) + (w2 + w3)); const float s0 = w0 * inv, s1 = w1 * inv, s2 = w2 * inv, s3 = w3 * inv;
        u32x4 o;
#define MOBA_MIX(C) { const float lo_ = (s0 * bf2f(x0.C & 0xffffu) + s1 * bf2f(x1.C & 0xffffu)) + (s2 * bf2f(x2.C & 0xffffu) + s3 * bf2f(x3.C & 0xffffu)); \
            const float hi_ = (s0 * __builtin_bit_cast(float, x0.C & 0xffff0000u) + s1 * __builtin_bit_cast(float, x1.C & 0xffff0000u)) + (s2 * __builtin_bit_cast(float, x2.C & 0xffff0000u) + s3 * __builtin_bit_cast(float, x3.C & 0xffff0000u)); o.C = cvtpk(lo_, hi_); }
        MOBA_MIX(x) MOBA_MIX(y) MOBA_MIX(z) MOBA_MIX(w)
#undef MOBA_MIX
        *(u32x4*)(YM + (size_t)t * 1024 + 512 + lane * 8) = o;
    }
}
#undef MOBA_CVEC
#undef MOBA_QK
#undef MOBA_NEARMAX
#undef MOBA_STEP
#undef MOBA_BLOCK4
}

__device__ __forceinline__ void ph_cvt_x(const Ctx& F0) {
    const Ctx F = launder(F0);
    const int gw = F.vcu * NWAVES + F.wave, NGW = F.G * NWAVES; float* rs1 = (float*)(F.ws + WS_RS1);
    for (int m = gw; m < T; m += 2 * NGW) {
        f32x4 v[2][4];
#pragma unroll
        for (int r = 0; r < 2; ++r) { const int mr = m + r * NGW < T ? m + r * NGW : T - 1; const f32x4* xr = (const f32x4*)(F.in[0] + (size_t)mr * D) + F.lane;
#pragma unroll
            for (int j = 0; j < 4; ++j) v[r][j] = xr[64 * j]; }
#pragma unroll
        for (int r = 0; r < 2; ++r) { float s = 0.f;
#pragma unroll
            for (int j = 0; j < 4; ++j) s += (v[r][j].x * v[r][j].x + v[r][j].y * v[r][j].y) + (v[r][j].z * v[r][j].z + v[r][j].w * v[r][j].w);
            const float rstd = 1.f / sqrtf(wave_sum(s) * (1.f / D) + RMS_EPS);
            if (m + r * NGW >= T) continue;
            if (F.lane == 0) rs1[m + r * NGW] = rstd;
            unsigned long long* o8 = (unsigned long long*)(P_XB(F) + (size_t)(m + r * NGW) * D) + F.lane;
#pragma unroll
            for (int j = 0; j < 4; ++j) o8[64 * j] = (unsigned long long)pk2(v[r][j].x, v[r][j].y) | ((unsigned long long)pk2(v[r][j].z, v[r][j].w) << 32); }
    }
}
__device__ __forceinline__ float row_ssq_bf16(const bf16* row, int lane) {
    const u32x4* xr = (const u32x4*)row + lane; float s = 0.f;
#pragma unroll
    for (int j = 0; j < 2; ++j) { const u32x4 x = xr[64 * j];
        const float a0 = bf2f(x.x & 0xffffu), a1 = bf2f(x.x >> 16), a2 = bf2f(x.y & 0xffffu), a3 = bf2f(x.y >> 16), a4 = bf2f(x.z & 0xffffu), a5 = bf2f(x.z >> 16), a6 = bf2f(x.w & 0xffffu), a7 = bf2f(x.w >> 16);
        s += ((a0 * a0 + a1 * a1) + (a2 * a2 + a3 * a3)) + ((a4 * a4 + a5 * a5) + (a6 * a6 + a7 * a7)); }
    return wave_sum(s);
}
__device__ __forceinline__ void ph_rstd(const Ctx& F0) {
    const Ctx F = launder(F0);
    const int gw = F.vcu * NWAVES + F.wave, NGW = F.G * NWAVES; float* rs1 = (float*)(F.ws + WS_RS1);
    for (int m = gw; m < T; m += 4 * NGW) {
        u32x4 x[4][2];
#pragma unroll
        for (int r = 0; r < 4; ++r) { const int mr = m + r * NGW < T ? m + r * NGW : T - 1; const u32x4* xr = (const u32x4*)(P_XB(F) + (size_t)mr * D) + F.lane; x[r][0] = xr[0]; x[r][1] = xr[64]; }
#pragma unroll
        for (int r = 0; r < 4; ++r) { float s = 0.f;
#pragma unroll
            for (int j = 0; j < 2; ++j) { const u32x4 q = x[r][j];
                const float a0 = bf2f(q.x & 0xffffu), a1 = bf2f(q.x >> 16), a2 = bf2f(q.y & 0xffffu), a3 = bf2f(q.y >> 16), a4 = bf2f(q.z & 0xffffu), a5 = bf2f(q.z >> 16), a6 = bf2f(q.w & 0xffffu), a7 = bf2f(q.w >> 16);
                s += ((a0 * a0 + a1 * a1) + (a2 * a2 + a3 * a3)) + ((a4 * a4 + a5 * a5) + (a6 * a6 + a7 * a7)); }
            s = wave_sum(s); if (F.lane == 0 && m + r * NGW < T) rs1[m + r * NGW] = 1.f / sqrtf(s * (1.f / D) + RMS_EPS); } }
}

__device__ __forceinline__ void ph_bias_table(const Ctx& F0) {
    const Ctx F = launder(F0);
    if (F.vcu == 0) {
        const float* rel_bias = F.in[1];
        for (int i = F.tid; i < 8 * 132; i += NTHREADS) {
            const int h = i / 132, r = i % 132;
            int bk;
            if (r < 16) bk = r;
            else { bk = 16 + (int)(logf((float)r / 16.f) / logf(8.f) * 16.f); if (bk > 31) bk = 31; }
            P_BT(F)[i] = rel_bias[bk * 8 + h] * LOG2E;
        }
    }
}

__device__ __forceinline__ void ph_pool_dl(const Ctx& F0) {
    const Ctx F = launder(F0);
    const int gt = F.vcu * NTHREADS + F.tid, NGT = F.G * NTHREADS;
    for (int it = gt; it < (T / 32) * 128; it += NGT) {
        const int cp = it & 127, chunk = it >> 7, c = cp * 2, gi = c >> 6, win = 2 << gi, m0 = chunk * 32, t0 = m0 & (SEQ - 1);
        const unsigned* __restrict__ P2 = (const unsigned*)P_PB(F) + cp; unsigned* __restrict__ D2 = (unsigned*)P_DL(F) + cp;
        float s0 = 0.f, s1 = 0.f;
        const int back = (t0 < win) ? t0 : win;
        for (int j = 1; j <= back; ++j) { const unsigned v = P2[(size_t)(m0 - j) * 128]; s0 += bf2f(v & 0xffffu); s1 += bf2f(v >> 16); }
#pragma unroll 4
        for (int i = 0; i < 32; ++i) { const int m = m0 + i, t = t0 + i;
            const unsigned v = P2[(size_t)m * 128]; const float p0 = bf2f(v & 0xffffu), p1 = bf2f(v >> 16);
            s0 += p0; s1 += p1;
            if (t >= win) { const unsigned o = P2[(size_t)(m - win) * 128]; s0 -= bf2f(o & 0xffffu); s1 -= bf2f(o >> 16); }
            const float inv = 1.f / (float)((t + 1 < win) ? t + 1 : win);
            D2[(size_t)m * 128] = pk2(s0 * inv - p0, s1 * inv - p1); }
    }
}
__device__ __forceinline__ void ph_final(const Ctx& F0) {
    const Ctx F = launder(F0);
    const int gw = F.vcu * NWAVES + F.wave, NGW = F.G * NWAVES;
    const f32x4* gf = (const f32x4*)F.in[26];
    for (int m = gw; m < T; m += 2 * NGW) {
        u32x4 x[2][2];
#pragma unroll
        for (int r = 0; r < 2; ++r) { const int mr = m + r * NGW < T ? m + r * NGW : T - 1; const u32x4* xr = (const u32x4*)(P_XB(F) + (size_t)mr * D) + F.lane; x[r][0] = xr[0]; x[r][1] = xr[64]; }
#pragma unroll
        for (int r = 0; r < 2; ++r) { float s = 0.f;
#pragma unroll
            for (int j = 0; j < 2; ++j) { const u32x4 q = x[r][j];
                const float a0 = bf2f(q.x & 0xffffu), a1 = bf2f(q.x >> 16), a2 = bf2f(q.y & 0xffffu), a3 = bf2f(q.y >> 16), a4 = bf2f(q.z & 0xffffu), a5 = bf2f(q.z >> 16), a6 = bf2f(q.w & 0xffffu), a7 = bf2f(q.w >> 16);
                s += ((a0 * a0 + a1 * a1) + (a2 * a2 + a3 * a3)) + ((a4 * a4 + a5 * a5) + (a6 * a6 + a7 * a7)); }
            const float rstd = 1.f / sqrtf(wave_sum(s) * (1.f / D) + RMS_EPS);
            if (m + r * NGW >= T) continue;
            f32x4* orow = (f32x4*)(F.R + (size_t)(m + r * NGW) * D);
#pragma unroll
            for (int j = 0; j < 2; ++j) { const u32x4 q = x[r][j]; const int c4 = 2 * (64 * j + F.lane);
                orow[c4] = (f32x4){bf2f(q.x & 0xffffu), bf2f(q.x >> 16), bf2f(q.y & 0xffffu), bf2f(q.y >> 16)} * rstd * gf[c4];
                orow[c4 + 1] = (f32x4){bf2f(q.z & 0xffffu), bf2f(q.z >> 16), bf2f(q.w & 0xffffu), bf2f(q.w >> 16)} * rstd * gf[c4 + 1]; } }
    }
}

constexpr int LDS_BYTES = 147456;
constexpr int MISC_OFF = 131072 + 320;

__global__ void __launch_bounds__(NTHREADS, 2) mk_fwd(Args args) {
    extern __shared__ __attribute__((aligned(16))) unsigned char lds[];
    Ctx F;
    F.lds = (LAS unsigned char*)lds;
    F.wave = __builtin_amdgcn_readfirstlane((int)threadIdx.x >> 6);
    F.lane = lane_id(); F.tid = F.wave * 64 + F.lane;
    F.G = gridDim.x; { const int bx = blockIdx.x; F.vcu = (F.G % 8 == 0) ? (bx % 8) * (F.G / 8) + bx / 8 : bx; }
    F.in = (KargP)__builtin_amdgcn_kernarg_segment_ptr(); F.R = args.out; F.ws = args.ws;
    unsigned char* ws = args.ws;
    volatile LAS unsigned* MISC = (volatile LAS unsigned*)(F.lds + MISC_OFF);
    if (F.tid < 64) MISC[F.tid] = 0u;
    __syncthreads();
    XcdBarrier bar = xcd_barrier_post((unsigned*)(ws + WS_CTL) + CW_BAR, MISC + 8, F.tid == 0);
#define GRID_BAR() do { bar.bar = (unsigned*)(wsl(ws) + WS_CTL) + CW_BAR; xcd_barrier(bar, F.wave); } while (0)
#define FL launder(F)

    ph_bias_table(F);
    ph_prologue(F);
#pragma unroll 1
    for (int l = 0; l < DEPTH; ++l) {
        if (l == 0) ph_cvt_x(F); else ph_rstd(F);
        GRID_BAR();
        { pg8::Gemm g{P_XB(FL), (const bf16*)(wsl(ws) + WS_WIN) + (size_t)l * NPROJ * D, D, D, D}; pg8::StaticOrder S; S.init(T, NPROJ, sl(F.G), sl((int)blockIdx.x));
          EpiProjE E{P_UG(FL), P_PB(FL), P_QB(FL), P_KB(FL), P_VB(FL), P_KMP(FL), (const float*)(wsl(ws) + WS_RS1)}; pg8::gemm_phase(F.lds, g, S, E, sl(F.wave)); }
        GRID_BAR();
        { pg8::Gemm g{P_UG(FL) + UOF, (const bf16*)(wsl(ws) + WS_BZ) + (size_t)l * SGN * 256 * 1024, UGP, 1024, 1024}; SsmOrder S{sl(F.G), sl((int)blockIdx.x), 1};
          EpiZ E{(float*)(wsl(ws) + WS_ZB)}; pg8::gemm_phase(F.lds, g, S, E, sl(F.wave)); }
        ph_pool_dl(F);
        moba::sel_phase(sl(F.wave), sl((int)blockIdx.x), sl(F.G), P_QB(FL), P_KMP(FL), (unsigned*)(wsl(ws) + WS_SEL), (LAS char*)F.lds);
        ph_tg_expand(F, l, sl((int)blockIdx.x), sl(F.G) > 64 ? 32 : 0);
        GRID_BAR();
        ph_ssm_scan(F, l);
        moba::gather_phase(sl(F.wave), sl(F.vcu), P_QB(FL), P_KB(FL), P_VB(FL), P_YMIX(FL), P_PB(FL), (bf16*)(wsl(ws) + WS_P2B), (bf16*)(wsl(ws) + WS_TG) + (size_t)(1 - l) * SGN * 1024 * UGP, (float*)(wsl(ws) + WS_ML), (const unsigned*)(wsl(ws) + WS_SEL), P_BT(FL), (LAS char*)F.lds);
        GRID_BAR();
        { pg8::Gemm g{P_UG(FL), (const bf16*)(wsl(ws) + WS_TG) + (size_t)l * SGN * 1024 * UGP, UGP, UGP, UGP}; SsmOrder S{sl(F.G), sl((int)blockIdx.x), 2};
          EpiSsm2 E{P_UG(FL), P_YS(FL), F.in[11] + l * 256}; pg8::gemm_phase(F.lds, g, S, E, sl(F.wave)); }
        { const int bx = sl((int)blockIdx.x), G_ = sl(F.G); int u0, un, ut;
          if (G_ == 256) { const int q4 = bx & 3; ut = 704; u0 = bx < 128 ? (bx >> 2) * 6 + (q4 == 0 ? 0 : q4 == 1 ? 3 : q4 == 2 ? 5 : 6) : 192 + 4 * (bx - 128); un = bx < 128 ? 3 - q4 : 4; }
          else { ut = G_; u0 = bx; un = 1; }
          const int t0 = (int)(((long)u0 * T) / ut), t1 = (int)(((long)(u0 + un) * T) / ut);
          moba::merge_phase(sl(F.wave), t0, t1, P_YMIX(FL), P_PB(FL), (const bf16*)(wsl(ws) + WS_P2B), (const bf16*)(wsl(ws) + WS_TG) + (size_t)(1 - l) * SGN * 1024 * UGP, (const float*)(wsl(ws) + WS_ML)); }
        GRID_BAR();
        { pg8::Gemm g{P_YS(FL), (const bf16*)(wsl(ws) + WS_GLUT) + (size_t)l * 65536, 256, 256, 256}; HalfOrder S{sl(F.vcu)};
          EpiGluE E{P_YS(FL), P_YMIX(FL), F.in[13] + l * 256}; pg8::gemm_phase(F.lds, g, S, E, sl(F.wave)); }
        { pg8::Gemm g{P_DL(FL), (const bf16*)(wsl(ws) + WS_POOLT) + (size_t)l * 65536, 256, 256, 256}; HalfOrder S{sl(F.vcu) - 128};
          EpiPoolE E{P_YMIX(FL), F.in[15] + l * 256, F.in[16] + l * 256}; pg8::gemm_phase(F.lds, g, S, E, sl(F.wave)); }
        GRID_BAR();
        { pg8::Gemm g{P_YMIX(FL), (const bf16*)(wsl(ws) + WS_WOUT) + (size_t)l * D * D, D, D, D}; pg8::StaticOrder S; S.init(T, D, sl(F.G), sl((int)blockIdx.x));
          EpiOutE E{P_XB(FL)}; pg8::gemm_phase(F.lds, g, S, E, sl(F.wave)); }
        GRID_BAR();
        ph_route(F, l);
        GRID_BAR();
        ph_place(F);
        GRID_BAR();
        { pg8::Gemm g{P_XB(FL), (const bf16*)(wsl(ws) + WS_GU) + (size_t)l * 16 * 512 * D, D, D, D}; MoeOrder S{sl(F.G), sl((int)blockIdx.x), false, 0, 0}; S.init((const int*)(wsl(ws) + WS_TILEB));
          EpiGU E{(bf16*)(wsl(ws) + WS_HACT), (const float*)(wsl(ws) + WS_ROWW), (const float*)(wsl(ws) + WS_ROWR)}; pg8::gemm_phase<true, true>(F.lds, g, S, E, sl(F.wave), (const int*)(wsl(ws) + WS_ROWTOK)); }
        GRID_BAR();
        { pg8::Gemm g{(const bf16*)(wsl(ws) + WS_HACT), (const bf16*)(wsl(ws) + WS_WD) + (size_t)l * 24 * D * 512, 512, 512, 512}; MoeOrder S{sl(F.G), sl((int)blockIdx.x), true, 0, 0}; S.init((const int*)(wsl(ws) + WS_TILEB));
          EpiDown E{P_XB(FL), (const int*)(wsl(ws) + WS_ROWTOK)}; pg8::gemm_phase(F.lds, g, S, E, sl(F.wave)); }
        GRID_BAR();
    }
    ph_final(F);
}

extern "C" void kernel_launch(void* const* d_in, const int* in_sizes, int n_in, void* d_out, int out_size, void* d_ws, size_t ws_size, hipStream_t stream) {
    static int grid = 0;
    if (grid == 0) {
        if (n_in != 27 || out_size != T * D || ws_size < WS_END) { fprintf(stderr, "kernel_launch: unexpected shapes (n_in %d out %d ws %zu)\n", n_in, out_size, ws_size); grid = -1; return; }
        int dev = 0, cus = 0, per_cu = 0;
        if (hipGetDevice(&dev) != hipSuccess || hipDeviceGetAttribute(&cus, hipDeviceAttributeMultiprocessorCount, dev) != hipSuccess) { grid = -1; return; }
        if (hipFuncSetAttribute((const void*)mk_fwd, hipFuncAttributeMaxDynamicSharedMemorySize, LDS_BYTES) != hipSuccess) { fprintf(stderr, "kernel_launch: hipFuncSetAttribute failed\n"); grid = -1; return; }
        if (hipOccupancyMaxActiveBlocksPerMultiprocessor(&per_cu, (const void*)mk_fwd, NTHREADS, LDS_BYTES) != hipSuccess || per_cu < 1) { fprintf(stderr, "kernel_launch: occupancy query says %d\n", per_cu); per_cu = 1; }
        (void)hipGetLastError();
        grid = cus;
    }
    if (grid < 0) return;
    (void)hipMemsetAsync((char*)d_ws + WS_CTL, 0, CTL_ZERO_BYTES, stream);
    Args a{};
    for (int i = 0; i < 27; ++i) a.in[i] = (const float*)d_in[i];
    a.out = (float*)d_out; a.ws = (unsigned char*)d_ws; a.pad0 = 0; a.pad1 = 0;
    hipLaunchKernelGGL(mk_fwd, dim3(grid), dim3(NTHREADS), LDS_BYTES, stream, a);
}
```

```cpp
#include <hip/hip_runtime.h>
#include <hip/hip_bf16.h>
#include <cstdio>
#include <cstdint>

#define GAS __attribute__((address_space(1)))
#define LAS __attribute__((address_space(3)))
typedef unsigned short bf16;
typedef float f32x4 __attribute__((ext_vector_type(4)));
typedef unsigned u32x4 __attribute__((ext_vector_type(4)));
typedef unsigned u32x2 __attribute__((ext_vector_type(2)));

constexpr int NB = 8, SEQ = 4096, T = NB * SEQ, D = 1024, NPROJ = 2048, DEPTH = 2;
constexpr int NHEAD = 8, HD = 64, MBLK = 256, NBLK = SEQ / MBLK;
constexpr int SG = 16, SGN = 16, SP = 64, SCH = 64, UGP = 1152, UOF = 128;
constexpr float RMS_EPS = 1e-6f;
constexpr float LOG2E = 1.4426950408889634f;
constexpr float C2 = 0.125f * LOG2E;
constexpr int NWAVES = 8, NTHREADS = 512;

constexpr size_t MiB = 1u << 20;
constexpr size_t WS_CTL = 0, CTL_ZERO_BYTES = 1 * MiB;
constexpr size_t WS_XB = 2 * MiB;
constexpr size_t WS_UG = 66 * MiB;
constexpr size_t WS_PB = 84 * MiB;
constexpr size_t WS_QB = 100 * MiB;
constexpr size_t WS_KB = 132 * MiB;
constexpr size_t WS_VB = 164 * MiB;
constexpr size_t WS_YMIX = 196 * MiB;
constexpr size_t WS_YS = 260 * MiB;
constexpr size_t WS_DL = 276 * MiB;
constexpr size_t WS_KMP = 292 * MiB;
constexpr size_t WS_BT = 293 * MiB;
constexpr size_t WS_KT = 297 * MiB;
constexpr size_t WS_SEL = 298 * MiB;
constexpr size_t WS_WIN = 300 * MiB;
constexpr size_t WS_WOUT = 308 * MiB;
constexpr size_t WS_GU = 312 * MiB;
constexpr size_t WS_WD = 344 * MiB;
constexpr size_t WS_TG = 392 * MiB;
constexpr size_t WS_BZ = 464 * MiB;
constexpr size_t WS_GLUT = 480 * MiB;
constexpr size_t WS_POOLT = WS_GLUT + 512 * 1024;
constexpr size_t WS_ZB = 482 * MiB;
constexpr size_t WS_P2B = 486 * MiB;
constexpr size_t WS_ML = 502 * MiB;
constexpr size_t WS_END = 508 * MiB;
constexpr int MOE_MAXT = 152;
constexpr size_t WS_XS = 66 * MiB;
constexpr size_t WS_HACT = 142 * MiB;
constexpr size_t WS_TOKB = 294 * MiB;
constexpr size_t WS_TOKR = WS_TOKB + 128 * 1024;
constexpr size_t WS_TOKW = WS_TOKB + 256 * 1024;
constexpr size_t WS_ROWTOK = 295 * MiB;
constexpr size_t WS_ROWW = WS_ROWTOK + 256 * 1024;
constexpr size_t WS_ROWR = WS_ROWTOK + 576 * 1024;
constexpr size_t WS_RS1 = WS_ROWTOK + 768 * 1024;
constexpr size_t WS_WGCNT = 296 * MiB;
constexpr size_t WS_TILEB = WS_WGCNT + 64 * 1024;

constexpr int CW_BAR = 4096;

__device__ __forceinline__ unsigned f2bf(float f) { unsigned u = __builtin_bit_cast(unsigned, f); return (u + 0x7fffu + ((u >> 16) & 1u)) >> 16; }
__device__ __forceinline__ float bf2f(unsigned h) { return __builtin_bit_cast(float, h << 16); }
__device__ __forceinline__ unsigned pk2(float lo, float hi) { return f2bf(lo) | (f2bf(hi) << 16); }
template <int O> __device__ __forceinline__ float xshfl(float v) {
    if constexpr (O < 32) return __builtin_bit_cast(float, __builtin_amdgcn_ds_swizzle(__builtin_bit_cast(int, v), (O << 10) | 0x1f));
    else { const unsigned u = __builtin_bit_cast(unsigned, v); auto r = __builtin_amdgcn_permlane32_swap(u, u, false, false);
           const float a = __builtin_bit_cast(float, (unsigned)r[0]), b = __builtin_bit_cast(float, (unsigned)r[1]); return (a == v && __builtin_bit_cast(unsigned, a) == u) ? b : a; }
}
__device__ __forceinline__ float wave_sum(float v) {
    v += xshfl<1>(v); v += xshfl<2>(v); v += xshfl<4>(v); v += xshfl<8>(v); v += xshfl<16>(v);
    const unsigned u = __builtin_bit_cast(unsigned, v); auto r = __builtin_amdgcn_permlane32_swap(u, u, false, false);
    return __builtin_bit_cast(float, (unsigned)r[0]) + __builtin_bit_cast(float, (unsigned)r[1]);
}
__device__ __forceinline__ float wave_max(float v) {
    v = fmaxf(v, xshfl<1>(v)); v = fmaxf(v, xshfl<2>(v)); v = fmaxf(v, xshfl<4>(v)); v = fmaxf(v, xshfl<8>(v)); v = fmaxf(v, xshfl<16>(v));
    const unsigned u = __builtin_bit_cast(unsigned, v); auto r = __builtin_amdgcn_permlane32_swap(u, u, false, false);
    return fmaxf(__builtin_bit_cast(float, (unsigned)r[0]), __builtin_bit_cast(float, (unsigned)r[1]));
}
__device__ __forceinline__ float gelu_tanh(float x) {
    const float u = 0.7978845608028654f * (x + 0.044715f * x * x * x);
    const float e = __expf(2.f * u);
    const float th = 1.f - 2.f / (e + 1.f);
    return 0.5f * x * (1.f + th);
}
__device__ __forceinline__ float sigmoidf_(float x) { return 1.f / (1.f + __expf(-x)); }

__device__ __forceinline__ int lane_id() { unsigned m; asm volatile("s_mov_b32 %0, -1" : "=s"(m)); return (int)__builtin_amdgcn_mbcnt_hi(m, __builtin_amdgcn_mbcnt_lo(m, 0u)); }

#define XB_TMO      128
#define XB_XCNT(j)  (256  + 64 * (j))
#define XB_XSUB(j)  (1280 + 64 * (j))
#define XB_XGEN(j)  (2304 + 64 * (j))
#define XB_TOP      3328
#define XB_TOPGEN   3392
#define XCD_BAR_WORDS 3456
#define XB_SPIN_CAP (1u << 22)
__device__ __forceinline__ unsigned xb_ld(unsigned* p)              { return __hip_atomic_load(p, __ATOMIC_RELAXED, __HIP_MEMORY_SCOPE_AGENT); }
__device__ __forceinline__ unsigned xb_add(unsigned* p, unsigned v) { return __hip_atomic_fetch_add(p, v, __ATOMIC_RELAXED, __HIP_MEMORY_SCOPE_AGENT); }
__device__ __forceinline__ unsigned xb_xcc_id() { return (unsigned)__builtin_amdgcn_s_getreg((3 << 11) | 20) & 0xFu; }
#define XB_SPIN(cond, bar) do { unsigned _sp = 0; while (cond) { __builtin_amdgcn_s_sleep(1); \
    if ((++_sp & 255u) == 0u) { if (xb_ld(&(bar)[XB_TMO])) break; if (_sp > XB_SPIN_CAP) { atomicAdd(&(bar)[XB_TMO], 1u); break; } } } } while (0)
struct XcdBarrier { unsigned* bar; unsigned x; volatile LAS unsigned* st; };
__device__ __forceinline__ XcdBarrier xcd_barrier_post(unsigned* bar, volatile LAS unsigned* st, bool t0) {
    XcdBarrier b; b.bar = bar; b.x = xb_xcc_id(); b.st = st;
    if (t0) (void)xb_add(&bar[XB_XCNT(b.x)], 1u);
    return b;
}
__device__ __forceinline__ void xcd_barrier_complete(unsigned* bar, unsigned x, unsigned& nloc, unsigned& nx) {
    const unsigned G = gridDim.x * gridDim.y * gridDim.z;
    unsigned sum, cnt, mine, sp = 0u;
    for (;;) {
        sum = 0u; cnt = 0u; mine = 0u;
#pragma unroll
        for (unsigned j = 0; j < 16; ++j) { const unsigned c = xb_ld(&bar[XB_XCNT(j)]); sum += c; cnt += (c > 0u) ? 1u : 0u; mine = (j == x) ? c : mine; }
        if (sum == G) break;
        __builtin_amdgcn_s_sleep(1);
        if ((++sp & 255u) == 0u) { if (xb_ld(&bar[XB_TMO])) break; if (sp > XB_SPIN_CAP) { atomicAdd(&bar[XB_TMO], 1u); break; } }
    }
    nloc = mine > 0u ? mine : 1u; nx = cnt > 0u ? cnt : 1u;
}
__device__ __forceinline__ void xcd_barrier(const XcdBarrier& b, int wave) {
    asm volatile("s_waitcnt vmcnt(0)" ::: "memory");
    __syncthreads();
    if (wave == 0 && lane_id() == 0) {
        unsigned* bar = b.bar;
        __builtin_amdgcn_s_waitcnt(0);
        unsigned nloc = b.st[0], nx = b.st[1];
        if (nloc == 0u) { xcd_barrier_complete(bar, b.x, nloc, nx); b.st[0] = nloc; b.st[1] = nx; }
        const unsigned old = xb_add(&bar[XB_XSUB(b.x)], 1u);
        const unsigned gen = old / nloc;
        if (old + 1u == (gen + 1u) * nloc) {
            __builtin_amdgcn_fence(__ATOMIC_RELEASE, "agent");
            asm volatile("s_waitcnt vmcnt(0)" ::: "memory");
            const unsigned og = xb_add(&bar[XB_TOP], 1u);
            const unsigned tg = og / nx;
            if (og + 1u == (tg + 1u) * nx) xb_add(&bar[XB_TOPGEN], 1u);
            else XB_SPIN(xb_ld(&bar[XB_TOPGEN]) == tg, bar);
            __builtin_amdgcn_fence(__ATOMIC_ACQUIRE, "agent");
            xb_add(&bar[XB_XGEN(b.x)], 1u);
            asm volatile("s_waitcnt vmcnt(0)" ::: "memory");
        } else {
            XB_SPIN(xb_ld(&bar[XB_XGEN(b.x)]) == gen, bar);
            __builtin_amdgcn_fence(__ATOMIC_ACQUIRE, "agent");
            asm volatile("s_waitcnt vmcnt(0)" ::: "memory");
        }
    }
    __syncthreads();
}

struct Args {
    const float* in[27];
    float* out;
    unsigned char* ws;
    int pad0, pad1;
};

typedef const float* fptr_t;
typedef __attribute__((address_space(4))) const fptr_t* KargP;
struct Ctx {
    LAS unsigned char* lds;
    int tid, lane, wave, vcu, G;
    KargP in;
    float* R;
    unsigned char* ws;
};
#define P_XB(F) ((bf16*)((F).ws + WS_XB))
#define P_UG(F) ((bf16*)((F).ws + WS_UG))
#define P_PB(F) ((bf16*)((F).ws + WS_PB))
#define P_QB(F) ((bf16*)((F).ws + WS_QB))
#define P_KB(F) ((bf16*)((F).ws + WS_KB))
#define P_VB(F) ((bf16*)((F).ws + WS_VB))
#define P_YMIX(F) ((bf16*)((F).ws + WS_YMIX))
#define P_YS(F) ((bf16*)((F).ws + WS_YS))
#define P_DL(F) ((bf16*)((F).ws + WS_DL))
#define P_KMP(F) ((float*)((F).ws + WS_KMP))
#define P_BT(F) ((float*)((F).ws + WS_BT))


__device__ __forceinline__ Ctx launder(const Ctx& F0) {
    Ctx F = F0;
    int ln = lane_id(); asm volatile("" : "+v"(ln));
    asm volatile("" : "+s"(F.wave), "+s"(F.vcu), "+s"(F.G));
    F.lane = ln; F.tid = F.wave * 64 + ln;
    KargP kp = (KargP)__builtin_amdgcn_kernarg_segment_ptr(); asm volatile("" : "+s"(kp));
    F.in = kp; F.R = (float*)kp[27]; F.ws = (unsigned char*)kp[28];
    return F;
}

__device__ __forceinline__ unsigned char* wsl(unsigned char* p) { asm volatile("" : "+s"(p)); return p; }
__device__ __forceinline__ int sl(int x) { asm volatile("" : "+s"(x)); return x; }

namespace pg8 {
typedef short bf16x8 __attribute__((ext_vector_type(8)));
constexpr int BM = 256, BK = 64, HALF = 128, HTB = HALF * BK * 2, STAGE_BYTES = 8 * HTB, NXCD = 8, WGM = 8;
__device__ __forceinline__ int lds_byte(int r, int c) { const int st = (r >> 4) * 2 + (c >> 5), rr = r & 15, cc = c & 31, ob = rr * 64 + cc * 2; return st * 1024 + (ob ^ (((ob >> 9) & 1) << 5)); }
__device__ __forceinline__ void stage_rc(int b, int& R, int& C) { const int st = b / 1024, sb = b % 1024, swz = sb ^ (((sb >> 9) & 1) << 5); R = (st >> 1) * 16 + swz / 64; C = (st & 1) * 32 + (swz % 64) / 2; }
__device__ __forceinline__ int perm32(int rho) { const int n = rho >> 4, i = rho & 15; return 8 * (i >> 2) + 4 * n + (i & 3); }

struct Unit { int pm, pn, aux, kt; };
struct Gemm { const bf16* A; const bf16* Bt; int lda, ldb, K; };

struct StaticOrder {
    int nM, nN, nwg, G, c;
    __device__ void init(int M, int N, int G_, int c_) { nM = M / BM; nN = N / BM; nwg = nM * nN; G = G_; c = c_; }
    __device__ bool next(int i, Unit& u) const {
        const long L = (long)i * G + c; if (L >= nwg) return false;
        int wgid = (int)L; { const int q = nwg / NXCD, r = nwg % NXCD, xcd = wgid % NXCD, off = wgid / NXCD; wgid = (xcd < r ? xcd * (q + 1) : r * (q + 1) + (xcd - r) * q) + off; }
        const int nig = WGM * nN, gid = wgid / nig, fm = gid * WGM, gsz = (nM - fm) < WGM ? (nM - fm) : WGM;
        u.pm = fm + ((wgid % nig) % gsz); u.pn = (wgid % nig) / gsz; u.aux = 0; return true;
    }
};

__device__ __forceinline__ unsigned cvt_pk_bf16(float lo, float hi) { unsigned r; asm volatile("v_cvt_pk_bf16_f32 %0, %1, %2" : "=v"(r) : "v"(lo), "v"(hi)); return r; }

template <bool ALIGN = true, bool GATHER = false, class Epi, class Sched>
__device__ __forceinline__ void gemm_phase(LAS unsigned char* lds, const Gemm g, const Sched& S, const Epi& E, int wave_, const int* gidx = nullptr) {
    int lane_ = lane_id(); asm volatile("" : "+v"(lane_)); asm volatile("" : "+s"(wave_));
    const int wid = wave_, lane = lane_, tid = wid * 64 + lane, wr = wid >> 2, wc = wid & 3, fr = lane & 15, fq = lane >> 4;
    const int K = g.K, ntd = K / BK; int nt = ntd;
    unsigned voffA[2], voffA1[2], voffB[2];
#pragma unroll
    for (int i = 0; i < 2; ++i) { int R, C; stage_rc(tid * 16 + i * 8192, R, C); const int Rb = Epi::PERM ? ((R & ~31) + perm32(R & 31)) : R;
        voffA[i] = (unsigned)(R * g.lda + C) * 2u; voffB[i] = (unsigned)(Rb * g.ldb + C) * 2u; voffA1[i] = voffA[i] + (unsigned)(HALF * g.lda * 2); }
    const size_t kstep = (size_t)(BK * 2);
    const size_t hstepA = (size_t)HALF * g.lda * 2, hstepB = (size_t)HALF * g.ldb * 2;
    const size_t tstepA = 2 * hstepA, tstepB = 2 * hstepB;
    const unsigned ldsw = (unsigned)wid * 1024u;
    const int aoff = lds_byte(wr * 64 + fr, fq * 8), boff = lds_byte(wc * 32 + fr, fq * 8);
#define PG8_SA(b, h) (((b) * 2 + (h)) * HTB)
#define PG8_SB(b, h) ((4 + (b) * 2 + (h)) * HTB)
#define PG8_STAGE(bufoff, gbase, voff) do { _Pragma("unroll") for (int _i = 0; _i < 2; ++_i) \
        __builtin_amdgcn_global_load_lds((const unsigned*)((const char*)(gbase) + (voff)[_i]), (LAS unsigned*)(lds + (bufoff) + ldsw + _i * 8192), 16, 0, 0); } while (0)
#define PG8_LDA(dst, b, h) do { _Pragma("unroll") for (int m = 0; m < 4; ++m) _Pragma("unroll") for (int k = 0; k < 2; ++k) dst[m][k] = *(const LAS bf16x8*)(lds + PG8_SA(b, h) + aoff + m * 2048 + k * 1024); } while (0)
#define PG8_LDB(dst, b, h) do { _Pragma("unroll") for (int n = 0; n < 2; ++n) _Pragma("unroll") for (int k = 0; k < 2; ++k) dst[n][k] = *(const LAS bf16x8*)(lds + PG8_SB(b, h) + boff + n * 2048 + k * 1024); } while (0)
#define PG8_MMA(ai, bj, At, Bt) do { __builtin_amdgcn_s_setprio(1); _Pragma("unroll") for (int m = 0; m < 4; ++m) _Pragma("unroll") for (int n = 0; n < 2; ++n) _Pragma("unroll") for (int k = 0; k < 2; ++k) \
        acc[ai][bj][m][n] = __builtin_amdgcn_mfma_f32_16x16x32_bf16(Bt[n][k], At[m][k], acc[ai][bj][m][n], 0, 0, 0); __builtin_amdgcn_s_setprio(0); } while (0)
#define PG8_GLOOK(PM) do { if constexpr (GATHER) { _Pragma("unroll") for (int _i = 0; _i < 2; ++_i) { int R_, C_; stage_rc(tid * 16 + _i * 8192, R_, C_); \
        int t0_ = gidx[(PM) * 256 + R_], t1_ = gidx[(PM) * 256 + HALF + R_]; t0_ = t0_ < 0 ? 0 : t0_; t1_ = t1_ < 0 ? 0 : t1_; \
        voffA[_i] = (unsigned)(t0_ * g.lda + C_) * 2u; voffA1[_i] = (unsigned)(t1_ * g.lda + C_) * 2u; } } } while (0)
#define PG8_WAIT_V(n) asm volatile("s_waitcnt vmcnt(" #n ")" ::: "memory")
#define PG8_WAIT_L(n) asm volatile("s_waitcnt lgkmcnt(" #n ")" ::: "memory")
#define PG8_BAR __builtin_amdgcn_s_barrier()
#define PG8_SCHED __builtin_amdgcn_sched_barrier(0)
    Unit cur{0, 0, 0, 0}, nxt{0, 0, 0, 0}; int ui = 0;
    if (!S.next(0, cur)) return;
    nt = cur.kt ? cur.kt : ntd;
    f32x4 acc[2][2][4][2];
#pragma unroll
    for (int a = 0; a < 2; ++a)
#pragma unroll
        for (int b = 0; b < 2; ++b)
#pragma unroll
            for (int m = 0; m < 4; ++m)
#pragma unroll
                for (int n = 0; n < 2; ++n) acc[a][b][m][n] = (f32x4){0.f, 0.f, 0.f, 0.f};
    bf16x8 At[4][2], B0[2][2], B1[2][2];
    const char* cA = (const char*)g.A + (GATHER ? (size_t)0 : (size_t)cur.pm * tstepA); const char* cB = (const char*)g.Bt + (size_t)cur.pn * tstepB;
    PG8_GLOOK(cur.pm);
    PG8_STAGE(PG8_SB(0, 0), cB, voffB); PG8_STAGE(PG8_SB(0, 1), cB + hstepB, voffB); PG8_STAGE(PG8_SA(0, 0), cA, voffA); PG8_STAGE(PG8_SA(0, 1), cA, voffA1);
    if (wr == 1) PG8_BAR;
    PG8_WAIT_V(2); PG8_BAR;
    PG8_STAGE(PG8_SB(1, 0), cB + kstep, voffB); PG8_STAGE(PG8_SA(1, 0), cA + kstep, voffA); PG8_STAGE(PG8_SB(1, 1), cB + hstepB + kstep, voffB);
    PG8_WAIT_V(6); PG8_BAR;
    for (;;) {
        const bool has_next = S.next(ui + 1, nxt);
        const char* nA = has_next ? (const char*)g.A + (GATHER ? (size_t)0 : (size_t)nxt.pm * tstepA) : cA; const char* nB = has_next ? (const char*)g.Bt + (size_t)nxt.pn * tstepB : cB;
        for (int t = 0; t < nt; t += 2) {
            const bool last = (t == nt - 2);
            const char* a1 = cA + (size_t)(t + 1) * kstep;
            const char* a2 = last ? nA : cA + (size_t)(t + 2) * kstep; const char* b2 = last ? nB : cB + (size_t)(t + 2) * kstep;
            const char* a3 = a2 + kstep; const char* b3 = b2 + kstep;
            PG8_LDB(B0, 0, 0); PG8_LDB(B1, 0, 1); PG8_SCHED; PG8_LDA(At, 0, 0); PG8_STAGE(PG8_SA(1, 1), a1, voffA1);
            PG8_WAIT_V(8); PG8_WAIT_L(0); PG8_BAR; PG8_MMA(0, 0, At, B0); PG8_MMA(0, 1, At, B1); PG8_BAR; PG8_SCHED;
            if constexpr (GATHER) { if (last && has_next) PG8_GLOOK(nxt.pm); }
            PG8_LDA(At, 0, 1); PG8_STAGE(PG8_SB(0, 0), b2, voffB); PG8_STAGE(PG8_SB(0, 1), b2 + hstepB, voffB); PG8_STAGE(PG8_SA(0, 0), a2, voffA);
            PG8_WAIT_V(8); PG8_WAIT_L(0); PG8_BAR; PG8_MMA(1, 0, At, B0); PG8_MMA(1, 1, At, B1); PG8_BAR; PG8_SCHED;
            PG8_LDB(B0, 1, 0); PG8_LDB(B1, 1, 1); PG8_SCHED; PG8_LDA(At, 1, 0); PG8_STAGE(PG8_SA(0, 1), a2, voffA1);
            PG8_WAIT_V(8); PG8_WAIT_L(0); PG8_BAR; PG8_MMA(0, 0, At, B0); PG8_MMA(0, 1, At, B1); PG8_BAR; PG8_SCHED;
            PG8_LDA(At, 1, 1); PG8_STAGE(PG8_SB(1, 0), b3, voffB); PG8_STAGE(PG8_SB(1, 1), b3 + hstepB, voffB); PG8_STAGE(PG8_SA(1, 0), a3, voffA);
            PG8_WAIT_V(8); PG8_WAIT_L(0); PG8_BAR; PG8_MMA(1, 0, At, B0); PG8_MMA(1, 1, At, B1); PG8_BAR; PG8_SCHED;
        }
        if constexpr (ALIGN) { if (wr == 0) PG8_BAR; }
        E(acc, cur, wr, wc, fr, fq);
        if (!has_next) break;
#pragma unroll
        for (int a = 0; a < 2; ++a)
#pragma unroll
            for (int b = 0; b < 2; ++b)
#pragma unroll
                for (int m = 0; m < 4; ++m)
#pragma unroll
                    for (int n = 0; n < 2; ++n) acc[a][b][m][n] = (f32x4){0.f, 0.f, 0.f, 0.f};
        cur = nxt; cA = nA; cB = nB; ++ui; nt = cur.kt ? cur.kt : ntd;
        if constexpr (ALIGN) { if (wr == 1) PG8_BAR; }
    }
    PG8_WAIT_V(0);
    if constexpr (!ALIGN) { if (wr == 0) PG8_BAR; }
    PG8_BAR;
#undef PG8_SA
#undef PG8_SB
#undef PG8_STAGE
#undef PG8_LDA
#undef PG8_LDB
#undef PG8_MMA
#undef PG8_WAIT_V
#undef PG8_WAIT_L
#undef PG8_BAR
#undef PG8_SCHED
}
}


struct EpiProjE {
    static constexpr bool PERM = true;
    bf16 *UG, *PB, *QB, *KB, *VB; float* KMP; const float* rs1;
    __device__ __forceinline__ void operator()(const f32x4 (&acc_)[2][2][4][2], const pg8::Unit& u, int wr, int wc, int fr_, int fq_) const {
        const int ln_ = lane_id(), fr = ln_ & 15, fq = ln_ >> 4; (void)fr_; (void)fq_;
        const int pn = u.pn, row0 = u.pm * 256 + wr * 64 + fr, cl = wc * 32 + 8 * fq;
        f32x4 acc[2][2][4][2];
#pragma unroll
        for (int ai = 0; ai < 2; ++ai)
#pragma unroll
            for (int m = 0; m < 4; ++m) { const float rs = rs1[row0 + ai * 128 + m * 16];
#pragma unroll
                for (int bj = 0; bj < 2; ++bj) { acc[ai][bj][m][0] = acc_[ai][bj][m][0] * rs; acc[ai][bj][m][1] = acc_[ai][bj][m][1] * rs; } }
        if (pn == 0) {
#pragma unroll
            for (int ai = 0; ai < 2; ++ai)
#pragma unroll
                for (int m = 0; m < 4; ++m) { const int r = row0 + ai * 128 + m * 16;
#pragma unroll
                    for (int bj = 0; bj < 2; ++bj) { const int ch = bj * 128 + cl, g = ch >> 4, h0 = ch & 15;
                        const f32x4 v0 = acc[ai][bj][m][0], v1 = acc[ai][bj][m][1]; u32x4 w;
                        w.x = pg8::cvt_pk_bf16(v0[0], v0[1]); w.y = pg8::cvt_pk_bf16(v0[2], v0[3]); w.z = pg8::cvt_pk_bf16(v1[0], v1[1]); w.w = pg8::cvt_pk_bf16(v1[2], v1[3]);
                        *(u32x4*)(UG + ((size_t)(g * 512 + (r >> 6))) * UGP + UOF + (r & 63) * 16 + h0) = w; } }
        } else {
            bf16* base; int ldc, colt; float sc = 1.f;
            if (pn == 1) { base = PB; ldc = 256; colt = 0; }
            else if (pn < 4) { base = QB; ldc = 512; colt = (pn - 2) * 256; sc = C2; }
            else if (pn < 6) { base = KB; ldc = 512; colt = (pn - 4) * 256; }
            else { base = VB; ldc = 512; colt = (pn - 6) * 256; }
#pragma unroll
            for (int ai = 0; ai < 2; ++ai)
#pragma unroll
                for (int m = 0; m < 4; ++m) { bf16* rowp = base + (size_t)(row0 + ai * 128 + m * 16) * ldc + colt + cl;
#pragma unroll
                    for (int bj = 0; bj < 2; ++bj) { const f32x4 v0 = acc[ai][bj][m][0] * sc, v1 = acc[ai][bj][m][1] * sc; u32x4 w;
                        w.x = pg8::cvt_pk_bf16(v0[0], v0[1]); w.y = pg8::cvt_pk_bf16(v0[2], v0[3]); w.z = pg8::cvt_pk_bf16(v1[0], v1[1]); w.w = pg8::cvt_pk_bf16(v1[2], v1[3]);
                        *(u32x4*)(rowp + bj * 128) = w; } }
            if (pn >= 4 && pn < 6) {
#pragma unroll
                for (int bj = 0; bj < 2; ++bj)
#pragma unroll
                    for (int n = 0; n < 2; ++n) { f32x4 s = (f32x4){0.f, 0.f, 0.f, 0.f};
#pragma unroll
                        for (int ai = 0; ai < 2; ++ai)
#pragma unroll
                            for (int m = 0; m < 4; ++m) s += acc[ai][bj][m][n];
#pragma unroll
                        for (int i = 0; i < 4; ++i) { float t = s[i]; t += xshfl<1>(t); t += xshfl<2>(t); t += xshfl<4>(t); t += xshfl<8>(t); s[i] = t; }
                        if (fr == 0) *(f32x4*)(KMP + (size_t)wr * 128 * 512 + (size_t)u.pm * 512 + colt + bj * 128 + cl + 4 * n) = s; }
            }
        }
    }
};
struct EpiOutE {
    static constexpr bool PERM = true;
    bf16* RB;
    __device__ __forceinline__ void operator()(const f32x4 (&acc)[2][2][4][2], const pg8::Unit& u, int wr, int wc, int fr_, int fq_) const {
        const int ln_ = lane_id(), fr = ln_ & 15, fq = ln_ >> 4; (void)fr_; (void)fq_;
        const int row0 = u.pm * 256 + wr * 64 + fr, col0 = u.pn * 256 + wc * 32 + 8 * fq;
#pragma unroll
        for (int ai = 0; ai < 2; ++ai) { u32x4 x[4][2];
#pragma unroll
            for (int m = 0; m < 4; ++m) { const bf16* rp = RB + (size_t)(row0 + ai * 128 + m * 16) * D + col0; x[m][0] = *(const u32x4*)rp; x[m][1] = *(const u32x4*)(rp + 128); }
#pragma unroll
            for (int m = 0; m < 4; ++m) { bf16* rp = RB + (size_t)(row0 + ai * 128 + m * 16) * D + col0;
#pragma unroll
                for (int bj = 0; bj < 2; ++bj) { const u32x4 xx = x[m][bj]; const f32x4 a0 = acc[ai][bj][m][0], a1 = acc[ai][bj][m][1]; u32x4 w;
                    w.x = pg8::cvt_pk_bf16(bf2f(xx.x & 0xffffu) + a0[0], bf2f(xx.x >> 16) + a0[1]); w.y = pg8::cvt_pk_bf16(bf2f(xx.y & 0xffffu) + a0[2], bf2f(xx.y >> 16) + a0[3]);
                    w.z = pg8::cvt_pk_bf16(bf2f(xx.z & 0xffffu) + a1[0], bf2f(xx.z >> 16) + a1[1]); w.w = pg8::cvt_pk_bf16(bf2f(xx.w & 0xffffu) + a1[2], bf2f(xx.w >> 16) + a1[3]);
                    *(u32x4*)(rp + bj * 128) = w; } }
            asm volatile("" ::: "memory"); }
    }
};

__device__ __forceinline__ void transpose_item(const float* W, int K, int N, const float* kscale, bf16* WT, int ldo, int koff, int rowmode, LAS float* scr, int item, int lane) {
    const int nblk = N / 32, kb = item / nblk, nb = item % nblk, k0 = 64 * kb, n0 = 32 * nb;
    { const int r8 = lane >> 3, c4 = lane & 7; f32x4 v[8];
#pragma unroll
      for (int i = 0; i < 8; ++i) v[i] = *(const f32x4*)(W + (size_t)(k0 + 8 * i + r8) * N + n0 + 4 * c4);
#pragma unroll
      for (int i = 0; i < 8; ++i) { const int kk = 8 * i + r8; const float s = kscale ? kscale[k0 + kk] : 1.f; LAS float* d = scr + kk * 33 + 4 * c4;
          d[0] = v[i][0] * s; d[1] = v[i][1] * s; d[2] = v[i][2] * s; d[3] = v[i][3] * s; } }
    asm volatile("s_waitcnt lgkmcnt(0)" ::: "memory");
    const int c = lane & 7;
#pragma unroll
    for (int j = 0; j < 4; ++j) { const int n = (lane >> 3) + 8 * j; const LAS float* s = scr + (8 * c) * 33 + n;
        u32x4 o; o.x = pk2(s[0 * 33], s[1 * 33]); o.y = pk2(s[2 * 33], s[3 * 33]); o.z = pk2(s[4 * 33], s[5 * 33]); o.w = pk2(s[6 * 33], s[7 * 33]);
        const int nn = n0 + n, row = rowmode == 0 ? nn : (8 * (nn >> 2) + (nn & 3) + (rowmode == 2 ? 4 : 0));
        *(u32x4*)(WT + (size_t)row * ldo + koff + k0 + 8 * c) = o; }
    asm volatile("s_waitcnt lgkmcnt(0)" ::: "memory");
}
__device__ __forceinline__ void pair_decode(int pi, int& ea, int& eb) { ea = pi < 3 ? 0 : (pi < 5 ? 1 : 2); eb = pi < 3 ? pi + 1 : (pi < 5 ? pi - 1 : 3); }
__device__ __forceinline__ void ph_prologue(const Ctx& F0) {
    const Ctx F = launder(F0);
    LAS float* scr = (LAS float*)(F.lds + F.wave * 16384);
    const int gw = F.vcu * NWAVES + F.wave, NGW = F.G * NWAVES;
    constexpr int I_IN = (D / 64) * (NPROJ / 32), I_OUT = (D / 64) * (D / 32), I_GU1 = (D / 64) * (256 / 32), I_GU = 16 * 2 * I_GU1, I_WD1 = (256 / 64) * (D / 32), I_WD = 24 * 2 * I_WD1;
    constexpr int I_L = I_IN + I_OUT + I_GU + I_WD;
    for (int it = gw; it < DEPTH * I_L; it += NGW) {
        const int l = it / I_L; int r = it % I_L;
        if (r < I_IN) { transpose_item(F.in[3] + (size_t)l * D * NPROJ, D, NPROJ, F.in[2] + l * D, (bf16*)(F.ws + WS_WIN) + (size_t)l * NPROJ * D, D, 0, 0, scr, r, F.lane); continue; } r -= I_IN;
        if (r < I_OUT) { transpose_item(F.in[17] + (size_t)l * D * D, D, D, nullptr, (bf16*)(F.ws + WS_WOUT) + (size_t)l * D * D, D, 0, 0, scr, r, F.lane); continue; } r -= I_OUT;
        if (r < I_GU) { const int e = r / (2 * I_GU1), up = (r / I_GU1) & 1, item = r % I_GU1;
            transpose_item(F.in[up ? 24 : 23] + ((size_t)l * 16 + e) * D * 256, D, 256, F.in[18] + l * D, (bf16*)(F.ws + WS_GU) + ((size_t)l * 16 + e) * 512 * D, D, 0, 1 + up, scr, item, F.lane); continue; } r -= I_GU;
        { const int bk = r / (2 * I_WD1), half = (r / I_WD1) & 1, item = r % I_WD1, g = bk / 6; int ea, eb; pair_decode(bk % 6, ea, eb); const int e = g * 4 + (half ? eb : ea);
            transpose_item(F.in[25] + ((size_t)l * 16 + e) * 256 * D, 256, D, nullptr, (bf16*)(F.ws + WS_WD) + ((size_t)l * 24 + bk) * D * 512, 512, half * 256, 0, scr, item, F.lane); }
    }
    for (int it = gw; it < DEPTH * 32; it += NGW) { const int l = it >> 5;
        transpose_item(F.in[12] + (size_t)l * 256 * 256, 256, 256, nullptr, (bf16*)(F.ws + WS_GLUT) + (size_t)l * 65536, 256, 0, 0, scr, it & 31, F.lane); }
    { const int gt = F.vcu * NTHREADS + F.tid, NGT = F.G * NTHREADS;
      for (int i = gt; i < DEPTH * 65536; i += NGT) { const int l = i >> 16, n = (i >> 8) & 255, k = i & 255;
          const float v = ((n >> 6) == (k >> 6)) ? F.in[14][(((size_t)l * 4 + (n >> 6)) * 64 + (k & 63)) * 64 + (n & 63)] : 0.f;
          ((bf16*)(F.ws + WS_POOLT))[i] = (bf16)f2bf(v); } }
    for (int it = gw; it < DEPTH * SGN * 65; it += NGW) {
        const int l = it / (SGN * 65), g = (it / 65) % SGN, tau = it % 65, p = F.lane;
        const float are = F.in[4][(l * SGN + g) * SP + p], aim = F.in[5][(l * SGN + g) * SP + p], dt = expf(F.in[6][l * SGN + g]);
        float sn, cs; sincosf(aim * dt, &sn, &cs); const float mg = expf(are * dt), lbr = mg * cs, lbi = mg * sn;
        const float nr = lbr - 1.f, ni = lbi, den = are * are + aim * aim, cr = (nr * are + ni * aim) / den, ci = (ni * are - nr * aim) / den;
        float sn2, cs2; sincosf(aim * dt * (float)tau, &sn2, &cs2); const float mg2 = expf(are * dt * (float)tau), lr = mg2 * cs2, li = mg2 * sn2;
        float wr[16], wi[16];
#pragma unroll
        for (int h = 0; h < 16; ++h) { const float br = F.in[7][((size_t)(l * SGN + g) * SP + p) * SG + h], bi = F.in[8][((size_t)(l * SGN + g) * SP + p) * SG + h];
            const float bbr = cr * br - ci * bi, bbi = cr * bi + ci * br; wr[h] = lr * bbr - li * bbi; wi[h] = lr * bbi + li * bbr; }
        bf16* TG = (bf16*)(F.ws + WS_TG) + ((size_t)l * SGN + g) * 1024 * UGP;
        if (tau <= 63) {
            bf16* BZ = (bf16*)(F.ws + WS_BZ) + ((size_t)l * SGN + g) * 256 * 1024; const int s = 63 - tau;
            u32x4 o0, o1, o2, o3;
            o0.x = pk2(wr[0], wr[1]); o0.y = pk2(wr[2], wr[3]); o0.z = pk2(wr[4], wr[5]); o0.w = pk2(wr[6], wr[7]); o1.x = pk2(wr[8], wr[9]); o1.y = pk2(wr[10], wr[11]); o1.z = pk2(wr[12], wr[13]); o1.w = pk2(wr[14], wr[15]);
            o2.x = pk2(wi[0], wi[1]); o2.y = pk2(wi[2], wi[3]); o2.z = pk2(wi[4], wi[5]); o2.w = pk2(wi[6], wi[7]); o3.x = pk2(wi[8], wi[9]); o3.y = pk2(wi[10], wi[11]); o3.z = pk2(wi[12], wi[13]); o3.w = pk2(wi[14], wi[15]);
            *(u32x4*)(BZ + (size_t)p * 1024 + s * 16) = o0; *(u32x4*)(BZ + (size_t)p * 1024 + s * 16 + 8) = o1;
            *(u32x4*)(BZ + (size_t)(64 + p) * 1024 + s * 16) = o2; *(u32x4*)(BZ + (size_t)(64 + p) * 1024 + s * 16 + 8) = o3;
        }
        LAS float* Wst = scr; LAS float* Kt = scr + 128 * 16;
        if (tau <= 63) {
#pragma unroll
            for (int q = 0; q < 4; ++q) { *(LAS f32x4*)(Wst + p * 16 + 4 * q) = (f32x4){wr[4 * q], wr[4 * q + 1], wr[4 * q + 2], wr[4 * q + 3]};
                                          *(LAS f32x4*)(Wst + (64 + p) * 16 + 4 * q) = (f32x4){wi[4 * q], wi[4 * q + 1], wi[4 * q + 2], wi[4 * q + 3]}; }
            const int arow = p & 15, kq = p >> 4; f32x4 kacc = (f32x4){0.f, 0.f, 0.f, 0.f};
            const float* cre = F.in[9] + ((size_t)(l * SGN + g) * SG + arow) * SP; const float* cim = F.in[10] + ((size_t)(l * SGN + g) * SG + arow) * SP;
#pragma unroll 8
            for (int s = 0; s < 32; ++s) { const int k = 4 * s + kq; const float av = (k < 64) ? cre[k] : -cim[k - 64]; const float bv = Wst[k * 16 + arow];
                kacc = __builtin_amdgcn_mfma_f32_16x16x4f32(av, bv, kacc, 0, 0, 0); }
#pragma unroll
            for (int r = 0; r < 4; ++r) Kt[(4 * kq + r) * 16 + arow] = kacc[r];
            asm volatile("s_waitcnt lgkmcnt(0)" ::: "memory");
            const f32x4 t4 = *(const LAS f32x4*)(Kt + 4 * p);
            u32x2 o; o.x = pk2(t4[0], t4[1]); o.y = pk2(t4[2], t4[3]);
            *(u32x2*)((bf16*)(F.ws + WS_KT) + ((size_t)(l * SGN + g) * 64 + tau) * 256 + 4 * p) = o;
        }
        if (tau >= 1) {
#pragma unroll 4
            for (int ho = 0; ho < 16; ++ho) {
                const float ccr = F.in[9][((size_t)(l * SGN + g) * SG + ho) * SP + p], cci = F.in[10][((size_t)(l * SGN + g) * SG + ho) * SP + p];
                const int n = (tau - 1) * 16 + ho;
                TG[(size_t)n * UGP + p] = (bf16)f2bf(ccr * lr - cci * li); TG[(size_t)n * UGP + 64 + p] = (bf16)f2bf(-(ccr * li + cci * lr)); }
        }
    }
}

__device__ __forceinline__ void route_finish(const float (&a)[20], float ssum, int m, bool act, const float* gb_, const float* rb_, int* tokb, float* tokr, float* tokw, LAS int* hist) {
        const float rstd = 1.f / sqrtf(ssum * (1.f / D) + RMS_EPS);
        float lg0 = a[0] * rstd + gb_[0], lg1 = a[1] * rstd + gb_[1], lg2 = a[2] * rstd + gb_[2], lg3 = a[3] * rstd + gb_[3];
        int gs = 0; float gm = lg0;
        if (lg1 > gm) { gm = lg1; gs = 1; } if (lg2 > gm) { gm = lg2; gs = 2; } if (lg3 > gm) { gm = lg3; gs = 3; }
        const float gwt = 1.f / (__expf(lg0 - gm) + __expf(lg1 - gm) + __expf(lg2 - gm) + __expf(lg3 - gm));
        float q0 = a[4], q1 = a[5], q2 = a[6], q3 = a[7], q4 = a[8], q5 = a[9], q6 = a[10], q7 = a[11], q8 = a[12], q9 = a[13], q10 = a[14], q11 = a[15], q12 = a[16], q13 = a[17], q14 = a[18], q15 = a[19];
        asm volatile("" : "+v"(q0), "+v"(q1), "+v"(q2), "+v"(q3), "+v"(q4), "+v"(q5), "+v"(q6), "+v"(q7));
        asm volatile("" : "+v"(q8), "+v"(q9), "+v"(q10), "+v"(q11), "+v"(q12), "+v"(q13), "+v"(q14), "+v"(q15));
        float e0 = gs == 0 ? q0 : gs == 1 ? q4 : gs == 2 ? q8 : q12;
        float e1 = gs == 0 ? q1 : gs == 1 ? q5 : gs == 2 ? q9 : q13;
        float e2 = gs == 0 ? q2 : gs == 1 ? q6 : gs == 2 ? q10 : q14;
        float e3 = gs == 0 ? q3 : gs == 1 ? q7 : gs == 2 ? q11 : q15;
        e0 = e0 * rstd + rb_[gs * 4 + 0]; e1 = e1 * rstd + rb_[gs * 4 + 1]; e2 = e2 * rstd + rb_[gs * 4 + 2]; e3 = e3 * rstd + rb_[gs * 4 + 3];
        int t1 = 0; float v1 = e0;
        if (e1 > v1) { v1 = e1; t1 = 1; } if (e2 > v1) { v1 = e2; t1 = 2; } if (e3 > v1) { v1 = e3; t1 = 3; }
        int t2 = -1; float v2 = -3.0e38f;
        if (t1 != 0 && e0 > v2) { v2 = e0; t2 = 0; } if (t1 != 1 && e1 > v2) { v2 = e1; t2 = 1; } if (t1 != 2 && e2 > v2) { v2 = e2; t2 = 2; } if (t1 != 3 && e3 > v2) { v2 = e3; t2 = 3; }
        const float p2 = __expf(v2 - v1), w1 = gwt / (1.f + p2), w2 = gwt * p2 / (1.f + p2);
        const int lo = t1 < t2 ? t1 : t2, hi = t1 < t2 ? t2 : t1; const float wlo = t1 < t2 ? w1 : w2, whi = t1 < t2 ? w2 : w1;
        const int pi = lo == 0 ? hi - 1 : (lo == 1 ? hi + 1 : 5), bk = gs * 6 + pi;
        if (act) { tokb[m] = bk; tokr[m] = rstd; tokw[2 * m] = wlo; tokw[2 * m + 1] = whi; __hip_atomic_fetch_add(hist + bk, 1, __ATOMIC_RELAXED, __HIP_MEMORY_SCOPE_WORKGROUP); }
}
__device__ __forceinline__ void ph_route(const Ctx& F0, int l) {
    const Ctx F = launder(F0);
    constexpr int WLD = 1032;
    LAS bf16* Wh = (LAS bf16*)F.lds;
    LAS bf16* Wlo = Wh + 20 * WLD;
    LAS float* LG = (LAS float*)(F.lds + 4 * 20 * WLD);
    LAS int* hist = (LAS int*)(F.lds + 4 * 20 * WLD + 8 * 320 * 4);
    const float* g2 = F.in[18] + l * D;
    const f32x4* gw4 = (const f32x4*)(F.in[19] + (size_t)l * D * 4); const f32x4* rw4 = (const f32x4*)(F.in[21] + (size_t)l * 4 * D * 4);
    const float* gb_ = F.in[20] + l * 4; const float* rb_ = F.in[22] + l * 16;
    for (int idx = F.tid; idx < D * 5; idx += NTHREADS) { const int k = idx % D, q = idx / D;
        f32x4 v = (q == 0) ? gw4[k] : rw4[(q - 1) * D + k]; v = v * g2[k];
#pragma unroll
        for (int i = 0; i < 4; ++i) { const unsigned h = f2bf(v[i]); Wh[(q * 4 + i) * WLD + k] = (bf16)h; Wlo[(q * 4 + i) * WLD + k] = (bf16)f2bf(v[i] - bf2f(h)); } }
    if (F.tid < 32) hist[F.tid] = 0;
    __syncthreads();
    int* tokb = (int*)(F.ws + WS_TOKB); float* tokr = (float*)(F.ws + WS_TOKR); float* tokw = (float*)(F.ws + WS_TOKW);
    const int i16 = F.lane & 15, kq = F.lane >> 4, m0 = F.vcu * 128 + F.wave * 16;
    const u32x4* xr = (const u32x4*)(P_XB(F) + (size_t)(m0 + i16) * D) + kq;
    const int c1 = 16 + (i16 & 3);
    const LAS bf16* bh0 = Wh + i16 * WLD + 8 * kq; const LAS bf16* bl0 = Wlo + i16 * WLD + 8 * kq;
    const LAS bf16* bh1 = Wh + c1 * WLD + 8 * kq;  const LAS bf16* bl1 = Wlo + c1 * WLD + 8 * kq;
    f32x4 acc0 = (f32x4){0.f, 0.f, 0.f, 0.f}, acc1 = acc0; float ss = 0.f;
#pragma unroll 4
    for (int c = 0; c < 32; ++c) {
        const u32x4 xa = xr[4 * c];
        const float x0 = bf2f(xa.x & 0xffffu), x1 = __builtin_bit_cast(float, xa.x & 0xffff0000u), x2 = bf2f(xa.y & 0xffffu), x3 = __builtin_bit_cast(float, xa.y & 0xffff0000u);
        const float x4 = bf2f(xa.z & 0xffffu), x5 = __builtin_bit_cast(float, xa.z & 0xffff0000u), x6 = bf2f(xa.w & 0xffffu), x7 = __builtin_bit_cast(float, xa.w & 0xffff0000u);
        ss += ((x0 * x0 + x1 * x1) + (x2 * x2 + x3 * x3)) + ((x4 * x4 + x5 * x5) + (x6 * x6 + x7 * x7));
        const pg8::bf16x8 av = __builtin_bit_cast(pg8::bf16x8, xa);
        const pg8::bf16x8 h0 = *(const LAS pg8::bf16x8*)(bh0 + 32 * c), l0 = *(const LAS pg8::bf16x8*)(bl0 + 32 * c);
        const pg8::bf16x8 h1 = *(const LAS pg8::bf16x8*)(bh1 + 32 * c), l1 = *(const LAS pg8::bf16x8*)(bl1 + 32 * c);
        acc0 = __builtin_amdgcn_mfma_f32_16x16x32_bf16(av, h0, acc0, 0, 0, 0); acc1 = __builtin_amdgcn_mfma_f32_16x16x32_bf16(av, h1, acc1, 0, 0, 0);
        acc0 = __builtin_amdgcn_mfma_f32_16x16x32_bf16(av, l0, acc0, 0, 0, 0); acc1 = __builtin_amdgcn_mfma_f32_16x16x32_bf16(av, l1, acc1, 0, 0, 0);
    }
    ss += xshfl<16>(ss);
    { const unsigned u = __builtin_bit_cast(unsigned, ss); auto r = __builtin_amdgcn_permlane32_swap(u, u, false, false);
      ss = __builtin_bit_cast(float, (unsigned)r[0]) + __builtin_bit_cast(float, (unsigned)r[1]); }
    LAS float* lg = LG + F.wave * 320;
#pragma unroll
    for (int r = 0; r < 4; ++r) { lg[(4 * kq + r) * 20 + i16] = acc0[r]; if (i16 < 4) lg[(4 * kq + r) * 20 + 16 + i16] = acc1[r]; }
    asm volatile("s_waitcnt lgkmcnt(0)" ::: "memory");
    float a[20];
#pragma unroll
    for (int j = 0; j < 5; ++j) { const f32x4 t4 = *(const LAS f32x4*)(lg + i16 * 20 + 4 * j); a[4 * j] = t4[0]; a[4 * j + 1] = t4[1]; a[4 * j + 2] = t4[2]; a[4 * j + 3] = t4[3]; }
    route_finish(a, ss, m0 + i16, kq == 0, gb_, rb_, tokb, tokr, tokw, hist);
    __syncthreads();
    if (F.tid < 24) __hip_atomic_store((int*)(F.ws + WS_WGCNT) + F.vcu * 24 + F.tid, hist[F.tid], __ATOMIC_RELAXED, __HIP_MEMORY_SCOPE_AGENT);
}
__device__ __forceinline__ void ph_place(const Ctx& F0) {
    const Ctx F = launder(F0);
    LAS int* ptot = (LAS int*)F.lds;
    LAS int* pbef = ptot + 512;
    LAS int* bstart = pbef + 512;
    LAS int* btot = bstart + 32;
    LAS int* carry = btot + 32;
    LAS int* rowidx = carry + 32;
    const int* wgcnt = (const int*)(F.ws + WS_WGCNT);
    int* rowtok = (int*)(F.ws + WS_ROWTOK); float* roww = (float*)(F.ws + WS_ROWW); int* tileb = (int*)(F.ws + WS_TILEB);
    const int* tokb = (const int*)(F.ws + WS_TOKB); const float* tokr = (const float*)(F.ws + WS_TOKR); const float* tokw = (const float*)(F.ws + WS_TOKW);
    { const int p = F.tid >> 5, b = F.tid & 31; int tot = 0, bef = 0;
      if (b < 24) for (int v = p * 16; v < p * 16 + 16; ++v) { const int c = wgcnt[v * 24 + b]; tot += c; if (v < F.vcu) bef += c; }
      ptot[p * 32 + b] = tot; pbef[p * 32 + b] = bef; }
    __syncthreads();
    if (F.tid < 32) { int tot = 0, bef = 0; for (int p = 0; p < 16; ++p) { tot += ptot[p * 32 + F.tid]; bef += pbef[p * 32 + F.tid]; } btot[F.tid] = tot; carry[F.tid] = bef; }
    __syncthreads();
    if (F.tid == 0) { int s = 0; for (int b = 0; b < 24; ++b) { bstart[b] = s; s += (btot[b] + 255) & ~255; } bstart[24] = s; }
    __syncthreads();
    if (F.tid < 24) carry[F.tid] += bstart[F.tid];
    if (F.vcu == 0) {
        if (F.tid == 0) tileb[0] = bstart[24] >> 8;
        for (int b = 0; b < 24; ++b) { const int s = bstart[b], e = bstart[b + 1];
            for (int t = (s >> 8) + F.tid; t < (e >> 8); t += NTHREADS) tileb[1 + t] = b;
            for (int r = s + btot[b] + F.tid; r < e; r += NTHREADS) __hip_atomic_store(rowtok + r, -1, __ATOMIC_RELAXED, __HIP_MEMORY_SCOPE_AGENT); }
    }
    __syncthreads();
    if (F.wave == 0) {
        for (int pass = 0; pass < 2; ++pass) { const int i = pass * 64 + F.lane, bi = tokb[F.vcu * 128 + i]; int row = 0;
#pragma unroll 1
            for (int b = 0; b < 24; ++b) { const unsigned long long mask = __ballot(bi == b); const int c = carry[b];
                if (bi == b) row = c + __builtin_popcountll(mask & ((1ull << F.lane) - 1ull));
                asm volatile("s_waitcnt lgkmcnt(0)" ::: "memory");
                if (F.lane == 0) carry[b] = c + __builtin_popcountll(mask);
                asm volatile("s_waitcnt lgkmcnt(0)" ::: "memory"); }
            rowidx[i] = row; }
    }
    __syncthreads();
    if (F.lane < 16) { const int li = F.wave * 16 + F.lane, m = F.vcu * 128 + li, row = rowidx[li];
        const float rstd = tokr[m];
        const unsigned long long w2 = (unsigned long long)__builtin_bit_cast(unsigned, tokw[2 * m]) | ((unsigned long long)__builtin_bit_cast(unsigned, tokw[2 * m + 1]) << 32);
        __hip_atomic_store(rowtok + row, m, __ATOMIC_RELAXED, __HIP_MEMORY_SCOPE_AGENT);
        __hip_atomic_store((unsigned long long*)(roww + 2 * row), w2, __ATOMIC_RELAXED, __HIP_MEMORY_SCOPE_AGENT);
        __hip_atomic_store((float*)(F.ws + WS_ROWR) + row, rstd, __ATOMIC_RELAXED, __HIP_MEMORY_SCOPE_AGENT); }
}
struct MoeOrder {
    int G, c; bool down; int NT, bks;
    __device__ __forceinline__ void init(const int* tileb) {
        const GAS int* tb_ = (const GAS int*)tileb;
        const int nt_ = tb_[0]; int r0 = c >> 2, r1 = (G + c) >> 2, r2 = (2 * G + c) >> 2, r3 = (3 * G + c) >> 2;
        r0 = r0 < MOE_MAXT ? r0 : MOE_MAXT - 1; r1 = r1 < MOE_MAXT ? r1 : MOE_MAXT - 1; r2 = r2 < MOE_MAXT ? r2 : MOE_MAXT - 1; r3 = r3 < MOE_MAXT ? r3 : MOE_MAXT - 1;
        const int b0 = tb_[1 + r0], b1 = tb_[1 + r1], b2 = tb_[1 + r2], b3 = tb_[1 + r3];
        int n_ = __builtin_amdgcn_readfirstlane(nt_), p_ = __builtin_amdgcn_readfirstlane((b0 & 255) | ((b1 & 255) << 8) | ((b2 & 255) << 16) | ((b3 & 255) << 24));
        asm volatile("" : "+s"(n_), "+s"(p_)); NT = n_; bks = p_;
    }
    __device__ __forceinline__ bool next(int i, pg8::Unit& u) const {
        const int L = i * G + c; if (i > 3 || L >= NT * 4) return false;
        const int rt = L >> 2, pn = L & 3, b = (bks >> (8 * i)) & 255;
        if (down) { u.pm = rt; u.pn = b * 4 + pn; u.aux = pn; }
        else { int ea, eb; pair_decode(b % 6, ea, eb); const int e = (b / 6) * 4 + (pn < 2 ? ea : eb); u.pm = rt; u.pn = e * 2 + (pn & 1); u.aux = pn; }
        return true;
    }
};
struct EpiGU {
    static constexpr bool PERM = true;
    bf16* H; const float* roww; const float* rowr;
    __device__ __forceinline__ void operator()(const f32x4 (&acc)[2][2][4][2], const pg8::Unit& u, int wr, int wc, int fr_, int fq_) const {
        const int ln_ = lane_id(), fr = ln_ & 15, fq = ln_ >> 4; (void)fr_; (void)fq_;
        const int row0 = u.pm * 256 + wr * 64 + fr, cl = u.aux * 128 + 16 * wc + 4 * fq, ws = u.aux >> 1;
#pragma unroll
        for (int ai = 0; ai < 2; ++ai)
#pragma unroll
            for (int m = 0; m < 4; ++m) { const int r = row0 + ai * 128 + m * 16; const float rr = rowr[r], w = roww[2 * r + ws] * rr;
#pragma unroll
                for (int bj = 0; bj < 2; ++bj) { const f32x4 g = acc[ai][bj][m][0], up = acc[ai][bj][m][1]; f32x4 a;
#pragma unroll
                    for (int i = 0; i < 4; ++i) { const float gg = g[i] * rr; a[i] = gg * sigmoidf_(gg) * up[i] * w; }
                    u32x2 o; o.x = pg8::cvt_pk_bf16(a[0], a[1]); o.y = pg8::cvt_pk_bf16(a[2], a[3]);
                    *(u32x2*)(H + (size_t)r * 512 + cl + bj * 64) = o; } }
    }
};
struct EpiDown {
    static constexpr bool PERM = true;
    bf16* RB; const int* rowtok;
    __device__ __forceinline__ void operator()(const f32x4 (&acc)[2][2][4][2], const pg8::Unit& u, int wr, int wc, int fr_, int fq_) const {
        const int ln_ = lane_id(), fr = ln_ & 15, fq = ln_ >> 4; (void)fr_; (void)fq_;
        const int row0 = u.pm * 256 + wr * 64 + fr, col0 = u.aux * 256 + wc * 32 + 8 * fq;
        int tok[8];
#pragma unroll
        for (int i = 0; i < 8; ++i) tok[i] = rowtok[row0 + (i >> 2) * 128 + (i & 3) * 16];
#pragma unroll
        for (int ai = 0; ai < 2; ++ai) { u32x4 x[4][2];
#pragma unroll
            for (int m = 0; m < 4; ++m) { const int tk = tok[ai * 4 + m]; const bf16* rp = RB + (size_t)(tk < 0 ? 0 : tk) * D + col0; x[m][0] = *(const u32x4*)rp; x[m][1] = *(const u32x4*)(rp + 128); }
#pragma unroll
            for (int m = 0; m < 4; ++m) { const int tk = tok[ai * 4 + m]; bf16* rp = RB + (size_t)(tk < 0 ? 0 : tk) * D + col0;
#pragma unroll
                for (int bj = 0; bj < 2; ++bj) { const u32x4 xx = x[m][bj]; const f32x4 a0 = acc[ai][bj][m][0], a1 = acc[ai][bj][m][1]; u32x4 w;
                    w.x = pg8::cvt_pk_bf16(bf2f(xx.x & 0xffffu) + a0[0], bf2f(xx.x >> 16) + a0[1]); w.y = pg8::cvt_pk_bf16(bf2f(xx.y & 0xffffu) + a0[2], bf2f(xx.y >> 16) + a0[3]);
                    w.z = pg8::cvt_pk_bf16(bf2f(xx.z & 0xffffu) + a1[0], bf2f(xx.z >> 16) + a1[1]); w.w = pg8::cvt_pk_bf16(bf2f(xx.w & 0xffffu) + a1[2], bf2f(xx.w >> 16) + a1[3]);
                    if (tk >= 0) *(u32x4*)(rp + bj * 128) = w; } }
            asm volatile("" ::: "memory"); }
    }
};

struct SsmOrder { int G, c, mode;
    __device__ __forceinline__ bool next(int i, pg8::Unit& u) const { const int L = i * G + c;
        if (mode == 1) { if (L >= 32) return false; u.pm = L; u.pn = L >> 1; u.aux = 0; return true; }
        if (L >= 128) return false; const int g = L >> 3; u.pm = g * 2 + ((L >> 2) & 1); u.pn = g * 4 + (L & 3); u.aux = L & 3; u.kt = 2 + 4 * ((L & 3) + 1); return true; } };
struct HalfOrder { int L;
    __device__ __forceinline__ bool next(int i, pg8::Unit& u) const { if (i > 0 || L < 0 || L >= 128) return false; u.pm = L; u.pn = 0; u.aux = 0; return true; } };
struct EpiZ { static constexpr bool PERM = false; float* ZB;
    __device__ __forceinline__ void operator()(const f32x4 (&acc)[2][2][4][2], const pg8::Unit& u, int wr, int wc, int fr_, int fq_) const {
        const int ln_ = lane_id(), fr = ln_ & 15, fq = ln_ >> 4; (void)fr_; (void)fq_;
        const int row0 = u.pm * 256 + wr * 64 + fr, col0 = wc * 32 + 4 * fq;
#pragma unroll
        for (int ai = 0; ai < 2; ++ai)
#pragma unroll
            for (int m = 0; m < 4; ++m)
#pragma unroll
                for (int n = 0; n < 2; ++n) *(f32x4*)(ZB + (size_t)(row0 + ai * 128 + m * 16) * 128 + col0 + n * 16) = acc[ai][0][m][n];
    } };
struct EpiSsm2 { static constexpr bool PERM = true; const bf16* UG; bf16* YS; const float* dvec;
    __device__ __forceinline__ void operator()(const f32x4 (&acc)[2][2][4][2], const pg8::Unit& u, int wr, int wc, int fr_, int fq_) const {
        const int ln_ = lane_id(), fr = ln_ & 15, fq = ln_ >> 4; (void)fr_; (void)fq_;
        const int g = u.pm >> 1, cr0 = (u.pm & 1) * 256 + wr * 64 + fr;
#pragma unroll
        for (int bj = 0; bj < 2; ++bj) { const int n0 = u.aux * 256 + bj * 128 + wc * 32 + 8 * fq, to = n0 >> 4, ho0 = n0 & 15;
            const f32x4 d0 = *(const f32x4*)(dvec + g * 16 + ho0), d1 = *(const f32x4*)(dvec + g * 16 + ho0 + 4);
#pragma unroll
            for (int ai = 0; ai < 2; ++ai)
#pragma unroll
                for (int m = 0; m < 4; ++m) { const int cr = cr0 + ai * 128 + m * 16;
                    const u32x4 uu = *(const u32x4*)(UG + ((size_t)(g * 512 + cr)) * UGP + UOF + n0);
                    const f32x4 a0 = acc[ai][bj][m][0], a1 = acc[ai][bj][m][1]; float y[8];
                    y[0] = gelu_tanh(a0[0] + d0[0] * bf2f(uu.x & 0xffffu)); y[1] = gelu_tanh(a0[1] + d0[1] * bf2f(uu.x >> 16));
                    y[2] = gelu_tanh(a0[2] + d0[2] * bf2f(uu.y & 0xffffu)); y[3] = gelu_tanh(a0[3] + d0[3] * bf2f(uu.y >> 16));
                    y[4] = gelu_tanh(a1[0] + d1[0] * bf2f(uu.z & 0xffffu)); y[5] = gelu_tanh(a1[1] + d1[1] * bf2f(uu.z >> 16));
                    y[6] = gelu_tanh(a1[2] + d1[2] * bf2f(uu.w & 0xffffu)); y[7] = gelu_tanh(a1[3] + d1[3] * bf2f(uu.w >> 16));
                    u32x4 w; w.x = pg8::cvt_pk_bf16(y[0], y[1]); w.y = pg8::cvt_pk_bf16(y[2], y[3]); w.z = pg8::cvt_pk_bf16(y[4], y[5]); w.w = pg8::cvt_pk_bf16(y[6], y[7]);
                    *(u32x4*)(YS + ((size_t)cr * 64 + to) * 256 + g * 16 + ho0) = w; } }
    } };
struct EpiGluE { static constexpr bool PERM = true; const bf16* YS; bf16* YMIX; const float* gb;
    __device__ __forceinline__ void operator()(const f32x4 (&acc)[2][2][4][2], const pg8::Unit& u, int wr, int wc, int fr_, int fq_) const {
        const int ln_ = lane_id(), fr = ln_ & 15, fq = ln_ >> 4; (void)fr_; (void)fq_;
        const int row0 = u.pm * 256 + wr * 64 + fr;
#pragma unroll
        for (int bj = 0; bj < 2; ++bj) { const int n0 = bj * 128 + wc * 32 + 8 * fq; const f32x4 b0 = *(const f32x4*)(gb + n0), b1 = *(const f32x4*)(gb + n0 + 4);
#pragma unroll
            for (int ai = 0; ai < 2; ++ai)
#pragma unroll
                for (int m = 0; m < 4; ++m) { const size_t r = (size_t)(row0 + ai * 128 + m * 16); const u32x4 yy = *(const u32x4*)(YS + r * 256 + n0);
                    const f32x4 a0 = acc[ai][bj][m][0] + b0, a1 = acc[ai][bj][m][1] + b1; float o[8];
                    o[0] = bf2f(yy.x & 0xffffu) * sigmoidf_(a0[0]); o[1] = bf2f(yy.x >> 16) * sigmoidf_(a0[1]); o[2] = bf2f(yy.y & 0xffffu) * sigmoidf_(a0[2]); o[3] = bf2f(yy.y >> 16) * sigmoidf_(a0[3]);
                    o[4] = bf2f(yy.z & 0xffffu) * sigmoidf_(a1[0]); o[5] = bf2f(yy.z >> 16) * sigmoidf_(a1[1]); o[6] = bf2f(yy.w & 0xffffu) * sigmoidf_(a1[2]); o[7] = bf2f(yy.w >> 16) * sigmoidf_(a1[3]);
                    u32x4 w; w.x = pg8::cvt_pk_bf16(o[0], o[1]); w.y = pg8::cvt_pk_bf16(o[2], o[3]); w.z = pg8::cvt_pk_bf16(o[4], o[5]); w.w = pg8::cvt_pk_bf16(o[6], o[7]);
                    *(u32x4*)(YMIX + r * 1024 + n0) = w; } }
    } };
struct EpiPoolE { static constexpr bool PERM = true; bf16* YMIX; const float* pb; const float* ps;
    __device__ __forceinline__ void operator()(const f32x4 (&acc)[2][2][4][2], const pg8::Unit& u, int wr, int wc, int fr_, int fq_) const {
        const int ln_ = lane_id(), fr = ln_ & 15, fq = ln_ >> 4; (void)fr_; (void)fq_;
        const int row0 = u.pm * 256 + wr * 64 + fr;
#pragma unroll
        for (int bj = 0; bj < 2; ++bj) { const int n0 = bj * 128 + wc * 32 + 8 * fq; const f32x4 b0 = *(const f32x4*)(pb + n0), b1 = *(const f32x4*)(pb + n0 + 4), s0 = *(const f32x4*)(ps + n0), s1 = *(const f32x4*)(ps + n0 + 4);
#pragma unroll
            for (int ai = 0; ai < 2; ++ai)
#pragma unroll
                for (int m = 0; m < 4; ++m) { const size_t r = (size_t)(row0 + ai * 128 + m * 16);
                    const f32x4 a0 = (acc[ai][bj][m][0] + b0) * s0, a1 = (acc[ai][bj][m][1] + b1) * s1;
                    u32x4 w; w.x = pg8::cvt_pk_bf16(a0[0], a0[1]); w.y = pg8::cvt_pk_bf16(a0[2], a0[3]); w.z = pg8::cvt_pk_bf16(a1[0], a1[1]); w.w = pg8::cvt_pk_bf16(a1[2], a1[3]);
                    *(u32x4*)(YMIX + r * 1024 + 256 + n0) = w; } }
    } };
__device__ __forceinline__ void ph_tg_expand(const Ctx& F0, int l, int bx, int w0) {
    const Ctx F = launder(F0);
    if (bx < w0) return;
    const int gw = (bx - w0) * NWAVES + F.wave, NGW = (F.G - w0) * NWAVES;
    const bf16* KT = (const bf16*)(F.ws + WS_KT) + (size_t)l * SGN * 64 * 256;
    bf16* TG0 = (bf16*)(F.ws + WS_TG) + (size_t)l * SGN * 1024 * UGP;
#pragma unroll 2
    for (int r = gw; r < SGN * 1024; r += NGW) { const int g = r >> 10, n = r & 1023, to = n >> 4, ho = n & 15;
        bf16* d = TG0 + ((size_t)g * 1024 + n) * UGP;
#pragma unroll
        for (int half = 0; half < 2; ++half) { const int ti = half * 32 + (F.lane >> 1), tau = to - ti;
            u32x4 v = (u32x4){0u, 0u, 0u, 0u};
            if (tau >= 0) v = *(const u32x4*)(KT + (((size_t)g * 64 + tau) * 16 + ho) * 16 + (F.lane & 1) * 8);
            if (half * 512 + F.lane * 8 < ((n >> 8) + 1) * 256) *(u32x4*)(d + UOF + half * 512 + F.lane * 8) = v; } }
}
__device__ __forceinline__ void ph_ssm_scan(const Ctx& F0, int l) {
    const Ctx F = launder(F0);
    if (F.wave != 0 || (F.vcu & 1) != 0 || F.vcu >= 256) return;
    for (int it = (F.vcu >> 2) * 2 + ((F.vcu >> 1) & 1); it < SGN * NB; it += SGN * NB) {
        const int g = it >> 3, b = it & 7, p = F.lane;
        const float are = F.in[4][(l * SGN + g) * SP + p], aim = F.in[5][(l * SGN + g) * SP + p], dt = expf(F.in[6][l * SGN + g]);
        float sn, cs; sincosf(aim * dt * 64.f, &sn, &cs); const float mg = expf(are * dt * 64.f), lr = mg * cs, li = mg * sn;
        const float* Z = (const float*)(F.ws + WS_ZB) + ((size_t)g * 512 + b * 64) * 128;
        bf16* U = P_UG(F) + ((size_t)g * 512 + b * 64) * UGP;
        float sr = 0.f, si = 0.f;
#pragma unroll 1
        for (int c0 = 0; c0 < 64; c0 += 32) {
            float zr[32], zi[32];
#pragma unroll
            for (int j = 0; j < 32; ++j) { zr[j] = Z[(c0 + j) * 128 + p]; zi[j] = Z[(c0 + j) * 128 + 64 + p]; }
#pragma unroll
            for (int j = 0; j < 32; ++j) {
                U[(size_t)(c0 + j) * UGP + p] = (bf16)f2bf(sr); U[(size_t)(c0 + j) * UGP + 64 + p] = (bf16)f2bf(si);
                const float nr = lr * sr - li * si + zr[j], ni = lr * si + li * sr + zi[j]; sr = nr; si = ni; }
        }
    }
}

namespace moba {
using bf16x8 = __attribute__((ext_vector_type(8))) short;
using s16x4 = __attribute__((ext_vector_type(4))) short;
using f32x16 = __attribute__((ext_vector_type(16))) float;
typedef short v4i16_t __attribute__((ext_vector_type(4)));
typedef float f32x2_t __attribute__((ext_vector_type(2))); typedef __bf16 bf16x2_t __attribute__((ext_vector_type(2)));
constexpr int L_K = 0, L_V = 49152, L_TB = 98304, L_KM = L_TB + 4 * 768 * 4, L_END = L_KM + 16 * 64 * 4;
__device__ __forceinline__ unsigned cvtpk(float lo, float hi) { f32x2_t v = {lo, hi}; bf16x2_t b = __builtin_convertvector(v, bf16x2_t); return __builtin_bit_cast(unsigned, b); }
__device__ __forceinline__ s16x4 vtr(const LAS char* p) { return __builtin_bit_cast(s16x4, __builtin_amdgcn_ds_read_tr16_b64_v4i16((LAS v4i16_t*)p)); }
__device__ __forceinline__ float hmax(float v) { const unsigned u = __builtin_bit_cast(unsigned, v); auto r = __builtin_amdgcn_permlane32_swap(u, u, false, false); return fmaxf(__builtin_bit_cast(float, (unsigned)r[0]), __builtin_bit_cast(float, (unsigned)r[1])); }
__device__ __forceinline__ float hsum(float v) { const unsigned u = __builtin_bit_cast(unsigned, v); auto r = __builtin_amdgcn_permlane32_swap(u, u, false, false); return __builtin_bit_cast(float, (unsigned)r[0]) + __builtin_bit_cast(float, (unsigned)r[1]); }

constexpr int L_LIST = L_END, L_WCNT = 32768;
#define MOBA_CVEC() f32x16 cvec; do { const float ci_ = bfar - mref; _Pragma("unroll") for (int r = 0; r < 16; ++r) cvec[r] = ci_; } while (0)
#define MOBA_QK(P0, P1, KB) do { { const bf16x8 a0 = *(const LAS bf16x8*)(kp0 + (KB)), a1 = *(const LAS bf16x8*)(kp0 + (KB) + 512); \
          P0 = __builtin_amdgcn_mfma_f32_32x32x16_bf16(a0, qr[0], cvec, 0, 0, 0); P1 = __builtin_amdgcn_mfma_f32_32x32x16_bf16(a1, qr[0], cvec, 0, 0, 0); } \
        _Pragma("unroll") for (int d0 = 1; d0 < 4; ++d0) { const bf16x8 a0 = *(const LAS bf16x8*)(kp0 + (KB) + d0 * 2048), a1 = *(const LAS bf16x8*)(kp0 + (KB) + d0 * 2048 + 512); \
            P0 = __builtin_amdgcn_mfma_f32_32x32x16_bf16(a0, qr[d0], P0, 0, 0, 0); P1 = __builtin_amdgcn_mfma_f32_32x32x16_bf16(a1, qr[d0], P1, 0, 0, 0); } } while (0)
#define MOBA_NEARMAX(P0, P1, JN, OUT) do { const int jn_ = (JN); if (jn_ >= 0) { const int A_ = qrel - 64 * (jn_ - 4) - 4 * hi + 256, s_ = 767 - A_, c_ = s_ & 3; \
            const LAS f32x4* t4 = (const LAS f32x4*)(tb + c_ * 768 + (s_ - c_)); \
            _Pragma("unroll") for (int g = 0; g < 4; ++g) { const f32x4 x0 = t4[2 * g], x1 = t4[2 * g + 8]; \
                _Pragma("unroll") for (int j = 0; j < 4; ++j) { P0[4 * g + j] += x0[j]; P1[4 * g + j] += x1[j]; } } } \
        float ra = __builtin_fmaxf(__builtin_fmaxf(P0[0], P0[1]), P1[0]), rb = __builtin_fmaxf(__builtin_fmaxf(P0[2], P0[3]), P1[1]); \
        ra = __builtin_fmaxf(__builtin_fmaxf(ra, P1[2]), P1[3]); \
        _Pragma("unroll") for (int r = 4; r < 16; r += 4) { ra = __builtin_fmaxf(__builtin_fmaxf(ra, P0[r]), P0[r + 1]); rb = __builtin_fmaxf(__builtin_fmaxf(rb, P0[r + 2]), P0[r + 3]); \
            ra = __builtin_fmaxf(__builtin_fmaxf(ra, P1[r]), P1[r + 1]); rb = __builtin_fmaxf(__builtin_fmaxf(rb, P1[r + 2]), P1[r + 3]); } \
        OUT = hmax(__builtin_fmaxf(ra, rb)); } while (0)
#define MOBA_STEP(PC0, PC1, PN0, PN1, JNN, KBN, VBC, HASN) do { \
        bf16x8 vf[8], kf[8]; \
        if (HASN) { _Pragma("unroll") for (int d0 = 0; d0 < 4; ++d0) { kf[2 * d0] = *(const LAS bf16x8*)(kp0 + (KBN) + d0 * 2048); kf[2 * d0 + 1] = *(const LAS bf16x8*)(kp0 + (KBN) + d0 * 2048 + 512); } } \
        __builtin_amdgcn_sched_barrier(0); \
        if (__any(rm > 8.f)) { const float dl = __builtin_fmaxf(rm, 0.f), alpha = __builtin_amdgcn_exp2f(-dl); mref += dl; l *= alpha; \
            _Pragma("unroll") for (int r = 0; r < 16; ++r) { PC0[r] -= dl; PC1[r] -= dl; o0[r] *= alpha; o1[r] *= alpha; } } \
        if (HASN) { MOBA_CVEC(); \
                    PN0 = __builtin_amdgcn_mfma_f32_32x32x16_bf16(kf[0], qr[0], cvec, 0, 0, 0); PN1 = __builtin_amdgcn_mfma_f32_32x32x16_bf16(kf[1], qr[0], cvec, 0, 0, 0); \
                    _Pragma("unroll") for (int d0 = 1; d0 < 4; ++d0) { PN0 = __builtin_amdgcn_mfma_f32_32x32x16_bf16(kf[2 * d0], qr[d0], PN0, 0, 0, 0); PN1 = __builtin_amdgcn_mfma_f32_32x32x16_bf16(kf[2 * d0 + 1], qr[d0], PN1, 0, 0, 0); } } \
        { const LAS char* vp = vp0 + (VBC); \
        _Pragma("unroll") for (int k = 0; k < 4; ++k) { \
            const s16x4 lo0 = vtr(vp + k * 1024), hi0 = vtr(vp + k * 1024 + 512), lo1 = vtr(vp + 4096 + k * 1024), hi1 = vtr(vp + 4096 + k * 1024 + 512); \
            vf[2 * k] = (bf16x8){lo0[0], lo0[1], lo0[2], lo0[3], hi0[0], hi0[1], hi0[2], hi0[3]}; vf[2 * k + 1] = (bf16x8){lo1[0], lo1[1], lo1[2], lo1[3], hi1[0], hi1[1], hi1[2], hi1[3]}; } } \
        __builtin_amdgcn_sched_barrier(0); \
        float s0 = 0.f, s1 = 0.f; u32x4 pw[4]; \
        _Pragma("unroll") for (int r = 0; r < 16; ++r) { PC0[r] = __builtin_amdgcn_exp2f(PC0[r]); PC1[r] = __builtin_amdgcn_exp2f(PC1[r]); s0 += PC0[r]; s1 += PC1[r]; } \
        l += s0 + s1; \
        _Pragma("unroll") for (int q = 0; q < 4; ++q) { pw[0][q] = cvtpk(PC0[2 * q], PC0[2 * q + 1]); pw[1][q] = cvtpk(PC0[8 + 2 * q], PC0[9 + 2 * q]); pw[2][q] = cvtpk(PC1[2 * q], PC1[2 * q + 1]); pw[3][q] = cvtpk(PC1[8 + 2 * q], PC1[9 + 2 * q]); } \
        _Pragma("unroll") for (int k = 0; k < 4; ++k) { const bf16x8 pa = __builtin_bit_cast(bf16x8, pw[k]); \
            o0 = __builtin_amdgcn_mfma_f32_32x32x16_bf16(vf[2 * k], pa, o0, 0, 0, 0); o1 = __builtin_amdgcn_mfma_f32_32x32x16_bf16(vf[2 * k + 1], pa, o1, 0, 0, 0); } \
        if (HASN) MOBA_NEARMAX(PN0, PN1, JNN, rm); \
    } while (0)
#define MOBA_BLOCK4(JN0, PRE4) \
    float mref = 0.f, l = 0.f; f32x16 o0 = f32x16{}, o1 = f32x16{}; f32x16 pa0, pa1, pb0, pb1; float rm; \
    { const int jn0_ = (JN0); \
      { MOBA_CVEC(); MOBA_QK(pa0, pa1, 0); } MOBA_NEARMAX(pa0, pa1, jn0_, rm); \
      MOBA_STEP(pa0, pa1, pb0, pb1, (jn0_ < 0 ? -1 : jn0_ + 1), 8192, 0, true); \
      MOBA_STEP(pb0, pb1, pa0, pa1, (jn0_ < 0 ? -1 : jn0_ + 2), 16384, 8192, true); \
      MOBA_STEP(pa0, pa1, pb0, pb1, (jn0_ < 0 ? -1 : jn0_ + 3), 24576, 16384, true); \
      PRE4; \
      MOBA_STEP(pb0, pb1, pa0, pa1, -1, 0, 24576, false); }
__device__ __forceinline__ void load_block(const bf16* K, const bf16* V, size_t row0, int h, int wid, int lane, LAS char* lds) {
    const bf16* ksrc = K + (row0 + lane) * 512 + h * 64 + wid * 8;
    const bf16* vsrc = V + (row0 + 16 * (wid & 3) + (lane >> 2)) * 512 + h * 64 + (wid >> 2) * 32 + (lane & 3) * 8;
    u32x4 kr[4], vr[4];
#pragma unroll
    for (int t = 0; t < 4; ++t) { kr[t] = *(const u32x4*)(ksrc + (size_t)t * 64 * 512); vr[t] = *(const u32x4*)(vsrc + (size_t)t * 64 * 512); }
    LAS char* kd = lds + L_K + wid * 1024 + lane * 16; LAS char* vd = lds + L_V + wid * 1024 + lane * 16;
#pragma unroll
    for (int t = 0; t < 4; ++t) { *(LAS u32x4*)(kd + t * 8192) = kr[t]; *(LAS u32x4*)(vd + t * 8192) = vr[t]; }
}
__device__ __forceinline__ void fill_bias_table(const float* BT, int h, int tid, LAS float* tb) {
    const float bfar = BT[h * 132 + 128];
    for (int i = tid; i < 4 * 768; i += NTHREADS) { const int c = i / 768, j = i % 768, src_ = 767 - (j + c), rel = src_ - 256; tb[i] = (src_ < 0 || rel < 0) ? -1.0e30f : (rel < 128 ? BT[h * 132 + rel] - bfar : 0.f); }
}
__device__ __forceinline__ void sel_phase(int wave_, int vcu, int G, const bf16* Q, const float* KMP, unsigned* SEL, LAS char* lds) {
    const int w0 = G > 64 ? 32 : 0, nw = G - w0; if (vcu < w0) return;
    int lane_ = lane_id(); asm volatile("" : "+v"(lane_)); asm volatile("" : "+s"(wave_));
    const int wid = wave_, lane = lane_, tid = wid * 64 + lane, r32 = lane & 31, hi = lane >> 5;
    const int ub = ((vcu - w0) * 1024) / nw, ue = ((vcu - w0 + 1) * 1024) / nw;
    LAS float* km = (LAS float*)(lds + L_KM);
    int bhc = -1;
#pragma unroll 1
    for (int u = ub; u < ue; ++u) {
        const int bh = u >> 4, qb = u & 15, b = bh >> 3, h = bh & 7;
        if (bh != bhc) { bhc = bh;
            __syncthreads();
            for (int i = tid; i < 16 * 64; i += NTHREADS) { const int j = i >> 6, d = i & 63, pm = b * 16 + j; km[i] = KMP[pm * 512 + h * 64 + d] + KMP[128 * 512 + pm * 512 + h * 64 + d]; }
            __syncthreads(); }
        asm volatile("" ::: "memory");
        const int q = qb * 256 + wid * 32 + r32;
        const bf16* qw = Q + ((size_t)b * SEQ + q) * 512 + h * 64 + hi * 8;
        bf16x8 qr[4];
#pragma unroll
        for (int d0 = 0; d0 < 4; ++d0) qr[d0] = *(const bf16x8*)(qw + d0 * 16);
        float g[16];
#pragma unroll
        for (int j = 0; j < 16; ++j) g[j] = 0.f;
#pragma unroll
        for (int d0 = 0; d0 < 4; ++d0)
#pragma unroll
            for (int j = 0; j < 16; ++j) { const f32x4 ka = *(const LAS f32x4*)(km + j * 64 + d0 * 16 + hi * 8), kb4 = *(const LAS f32x4*)(km + j * 64 + d0 * 16 + hi * 8 + 4);
#pragma unroll
                for (int e = 0; e < 4; ++e) { g[j] += bf2f((unsigned)(unsigned short)qr[d0][e]) * ka[e]; }
#pragma unroll
                for (int e = 0; e < 4; ++e) { g[j] += bf2f((unsigned)(unsigned short)qr[d0][4 + e]) * kb4[e]; } }
#pragma unroll
        for (int j = 0; j < 16; ++j) g[j] = hsum(g[j]);
        unsigned selmask = 0u;
#pragma unroll
        for (int s3 = 0; s3 < 3; ++s3) { float bv = -3.0e38f; int bi = -1;
#pragma unroll
            for (int j = 0; j < 16; ++j) { const bool ok = (j < qb) && !((selmask >> j) & 1u) && (g[j] > bv); bv = ok ? g[j] : bv; bi = ok ? j : bi; }
            if (bi >= 0) selmask |= 1u << bi; }
        if (hi == 0) SEL[(size_t)bh * SEQ + q] = selmask;
    }
}
__device__ __forceinline__ bf16* pslot(int slot, size_t t, int h, bf16* YM, bf16* P2A, bf16* P2B) {
    return slot == 0 ? YM + t * 1024 + h * 64 : slot == 1 ? YM + t * 1024 + 512 + h * 64 : (t < (size_t)(T / 2) ? P2A + t * 512 : P2B + (t - (size_t)(T / 2)) * 512) + h * 64;
}
__device__ __forceinline__ void gather_phase(int wave_, int vcu, const bf16* Q, const bf16* K, const bf16* V, bf16* YM, bf16* P2A, bf16* P2B, float* ML, const unsigned* SEL, const float* BT, LAS char* lds) {
    if (vcu >= 256) return;
    int lane_ = lane_id(); asm volatile("" : "+v"(lane_)); asm volatile("" : "+s"(wave_));
    const int wid = wave_, lane = lane_, tid = wid * 64 + lane, r32 = lane & 31, hi = lane >> 5;
    const int bh = vcu >> 2, s = vcu & 3, b = bh >> 3, h = bh & 7;
    const size_t rowbase = (size_t)b * SEQ;
    LAS float* tb = (LAS float*)(lds + L_TB); LAS int* list = (LAS int*)(lds + L_LIST); LAS int* wcnt = (LAS int*)(lds + L_WCNT);
    const float bfar = BT[h * 132 + 128];
    fill_bias_table(BT, h, tid, tb);
    const unsigned* selrow = SEL + (size_t)bh * SEQ;
    const LAS char* kp0 = lds + L_K + hi * 1024 + r32 * 16;
    const LAS char* vp0 = lds + L_V + ((lane >> 4) & 1) * 32 + (lane & 3) * 8 + (4 * hi + ((lane & 15) >> 2)) * 64;
    const unsigned code = s == 0 ? 0xFFFB60u : s == 1 ? 0xFFE971u : s == 2 ? 0xFFCA52u : 0xFFD843u;
    u32x4 kr[4], vr[4]; unsigned msel[8];
#define MOBA_GFETCH(KB) do { const size_t row0 = rowbase + (size_t)(KB) * 256; int lg_ = lane_id(); asm volatile("" : "+v"(lg_));     \
        const bf16* ksrc = K + (row0 + lg_) * 512 + h * 64 + wid * 8; \
        const bf16* vsrc = V + (row0 + 16 * (wid & 3) + (lg_ >> 2)) * 512 + h * 64 + (wid >> 2) * 32 + (lg_ & 3) * 8; \
        _Pragma("unroll") for (int t = 0; t < 4; ++t) { kr[t] = *(const u32x4*)(ksrc + (size_t)t * 64 * 512); vr[t] = *(const u32x4*)(vsrc + (size_t)t * 64 * 512); } \
        const int qs_ = ((KB) + 1) * 256, R_ = (SEQ - qs_) >> 3; \
        _Pragma("unroll") for (int i = 0; i < 8; ++i) { const int off = i * 64 + lg_; msel[i] = off < R_ ? selrow[qs_ + wid * R_ + off] : 0u; } } while (0)
    MOBA_GFETCH((int)(code & 15u));
#pragma unroll 1
    for (int ik = 0; ik < 6; ++ik) {
        const int kb = (int)((code >> (4 * ik)) & 15u); if (kb == 15) break;
        const int kbn = (int)((code >> (4 * ik + 4)) & 15u);
        __syncthreads();
        { LAS char* kd = lds + L_K + wid * 1024 + lane * 16; LAS char* vd = lds + L_V + wid * 1024 + lane * 16;
#pragma unroll
          for (int t = 0; t < 4; ++t) { *(LAS u32x4*)(kd + t * 8192) = kr[t]; *(LAS u32x4*)(vd + t * 8192) = vr[t]; } }
        const int qs = (kb + 1) * 256, R = (SEQ - qs) >> 3;
        unsigned long long bal[8]; int cnt = 0;
#pragma unroll
        for (int i = 0; i < 8; ++i) { bal[i] = __ballot((msel[i] >> kb) & 1u); cnt += __builtin_popcountll(bal[i]); }
        if (lane == 0) wcnt[wid] = cnt;
        __syncthreads();
        int base = 0, n = 0;
#pragma unroll
        for (int w = 0; w < 8; ++w) { const int c = wcnt[w]; n += c; base += (w < wid) ? c : 0; }
#pragma unroll
        for (int i = 0; i < 8; ++i) { const unsigned long long m = bal[i];
            if ((m >> lane) & 1ull) list[base + __builtin_popcountll(m & ((1ull << lane) - 1ull))] = qs + wid * R + i * 64 + lane;
            base += __builtin_popcountll(m); }
        __syncthreads();
        const int ntask = (n + 31) >> 5;
        int tk = wid, qin = 0; bool vn = false; unsigned smn = 0u; bf16x8 qn[4];
#define MOBA_QFETCH() do { const int li_ = tk * 32 + r32; vn = li_ < n; { const int lv_ = list[vn ? li_ : (n > 0 ? n - 1 : 0)]; qin = n > 0 ? lv_ : qs; } smn = selrow[qin]; \
            const bf16* qw = Q + (rowbase + qin) * 512 + h * 64 + hi * 8; \
            _Pragma("unroll") for (int d0 = 0; d0 < 4; ++d0) qn[d0] = *(const bf16x8*)(qw + d0 * 16); } while (0)
        MOBA_QFETCH();
#pragma unroll 1
        while (tk < ntask) {
            const int qi = qin; const bool valid = vn; const unsigned sm = smn;
            bf16x8 qr[4];
#pragma unroll
            for (int d0 = 0; d0 < 4; ++d0) qr[d0] = qn[d0];
            tk += 8;
            const int slot = __builtin_popcount(sm & ((1u << kb) - 1u));
            const int qd = qi - qs, qrel = qd < 255 ? qd : 255;
            const bool nearw = __any(qd < 128);
            MOBA_BLOCK4(nearw ? 0 : -1, MOBA_QFETCH())
            const float lt = hsum(l), inv = 1.f / lt; const size_t t = rowbase + qi;
            bf16* orow = pslot(slot, t, h, YM, P2A, P2B) + 8 * hi;
#pragma unroll
            for (int d0 = 0; d0 < 2; ++d0)
#pragma unroll
                for (int gp = 0; gp < 2; ++gp) { const f32x16& oo = d0 ? o1 : o0; const int ga = 8 * gp, gb = 8 * gp + 4;
                    unsigned ax = cvtpk(oo[ga] * inv, oo[ga + 1] * inv), ay = cvtpk(oo[ga + 2] * inv, oo[ga + 3] * inv), bx = cvtpk(oo[gb] * inv, oo[gb + 1] * inv), by = cvtpk(oo[gb + 2] * inv, oo[gb + 3] * inv);
                    { auto r = __builtin_amdgcn_permlane32_swap(ax, bx, false, false); ax = r[0]; bx = r[1]; }
                    { auto r = __builtin_amdgcn_permlane32_swap(ay, by, false, false); ay = r[0]; by = r[1]; }
                    if (valid) *(u32x4*)(orow + 32 * d0 + 16 * gp) = (u32x4){ax, ay, bx, by}; }
            if (valid && hi == 0) { float* ml = ML + ((t * 8 + h) * 3 + slot) * 2; ml[0] = mref; ml[1] = lt; }
        }
#undef MOBA_QFETCH
        MOBA_GFETCH(kbn);
    }
#undef MOBA_GFETCH
}
__device__ __forceinline__ void diag_unit(int wid, int lane, int b, int h, int qb, const bf16* Q, const bf16* K, const bf16* V, bf16* YM, const bf16* P2A, const bf16* P2B, const float* ML, float bfar, LAS char* lds) {
    const int r32 = lane & 31, hi = lane >> 5; const size_t rowbase = (size_t)b * SEQ;
    LAS float* tb = (LAS float*)(lds + L_TB);
    const LAS char* kp0 = lds + L_K + hi * 1024 + r32 * 16;
    const LAS char* vp0 = lds + L_V + ((lane >> 4) & 1) * 32 + (lane & 3) * 8 + (4 * hi + ((lane & 15) >> 2)) * 64;
    __syncthreads();
    load_block(K, V, rowbase + (size_t)qb * 256, h, wid, lane, lds);
    const int qrel = wid * 32 + r32; const size_t t = rowbase + qb * 256 + qrel;
    bf16x8 qr[4];
    { const bf16* qw = Q + t * 512 + h * 64 + hi * 8;
#pragma unroll
      for (int d0 = 0; d0 < 4; ++d0) qr[d0] = *(const bf16x8*)(qw + d0 * 16); }
    __syncthreads();
    MOBA_BLOCK4(4, (void)0)
    const int nsl = qb < 3 ? qb : 3;
    const float* ml = ML + (t * 8 + h) * 6;
    const bf16* pA = YM + t * 1024 + h * 64 + 8 * hi; const bf16* pB = YM + t * 1024 + 512 + h * 64 + 8 * hi;
    const bf16* pC = (t < (size_t)(T / 2) ? P2A + t * 512 : P2B + (t - (size_t)(T / 2)) * 512) + h * 64 + 8 * hi;
    float m0 = -3.0e38f, m1 = -3.0e38f, m2 = -3.0e38f, l0 = 0.f, l1 = 0.f, l2 = 0.f;
    u32x4 xA[4], xB[4], xC[4];
#pragma unroll
    for (int c = 0; c < 4; ++c) { xA[c] = (u32x4){0u, 0u, 0u, 0u}; xB[c] = xA[c]; xC[c] = xA[c]; }
    if (nsl > 0) { m0 = ml[0]; l0 = ml[1];
#pragma unroll
        for (int c = 0; c < 4; ++c) xA[c] = *(const u32x4*)(pA + 16 * c); }
    if (nsl > 1) { m1 = ml[2]; l1 = ml[3];
#pragma unroll
        for (int c = 0; c < 4; ++c) xB[c] = *(const u32x4*)(pB + 16 * c); }
    if (nsl > 2) { m2 = ml[4]; l2 = ml[5];
#pragma unroll
        for (int c = 0; c < 4; ++c) xC[c] = *(const u32x4*)(pC + 16 * c); }
    const float M = __builtin_fmaxf(__builtin_fmaxf(mref, m0), __builtin_fmaxf(m1, m2));
    const float w0 = __builtin_amdgcn_exp2f(mref - M), wa = l0 * __builtin_amdgcn_exp2f(m0 - M), wb = l1 * __builtin_amdgcn_exp2f(m1 - M), wc = l2 * __builtin_amdgcn_exp2f(m2 - M);
    const float inv = 1.f / (hsum(l) * w0 + wa + wb + wc);
    const float s0 = w0 * inv, sa = wa * inv, sb = wb * inv, sc = wc * inv;
    bf16* orow = YM + t * 1024 + 512 + h * 64 + 8 * hi;
#pragma unroll
    for (int d0 = 0; d0 < 2; ++d0)
#pragma unroll
        for (int gp = 0; gp < 2; ++gp) { const f32x16& oo = d0 ? o1 : o0; const int ga = 8 * gp, gb = 8 * gp + 4, dof = 32 * d0 + 16 * gp, cc = 2 * d0 + gp;
            float a0 = oo[ga] * s0, a1 = oo[ga + 1] * s0, a2 = oo[ga + 2] * s0, a3 = oo[ga + 3] * s0, b0 = oo[gb] * s0, b1 = oo[gb + 1] * s0, b2 = oo[gb + 2] * s0, b3 = oo[gb + 3] * s0;
#define MOBA_ACC(X, W) { unsigned fx = X[cc].x, fy = X[cc].y, sx = X[cc].z, sy = X[cc].w; \
              { auto r = __builtin_amdgcn_permlane32_swap(fx, sx, false, false); fx = r[0]; sx = r[1]; } { auto r = __builtin_amdgcn_permlane32_swap(fy, sy, false, false); fy = r[0]; sy = r[1]; } \
              a0 += (W) * bf2f(fx & 0xffffu); a1 += (W) * __builtin_bit_cast(float, fx & 0xffff0000u); a2 += (W) * bf2f(fy & 0xffffu); a3 += (W) * __builtin_bit_cast(float, fy & 0xffff0000u); \
              b0 += (W) * bf2f(sx & 0xffffu); b1 += (W) * __builtin_bit_cast(float, sx & 0xffff0000u); b2 += (W) * bf2f(sy & 0xffffu); b3 += (W) * __builtin_bit_cast(float, sy & 0xffff0000u); }
            MOBA_ACC(xA, sa) MOBA_ACC(xB, sb) MOBA_ACC(xC, sc)
#undef MOBA_ACC
            unsigned ax = cvtpk(a0, a1), ay = cvtpk(a2, a3), bx = cvtpk(b0, b1), by = cvtpk(b2, b3);
            { auto r = __builtin_amdgcn_permlane32_swap(ax, bx, false, false); ax = r[0]; bx = r[1]; }
            { auto r = __builtin_amdgcn_permlane32_swap(ay, by, false, false); ay = r[0]; by = r[1]; }
            *(u32x4*)(orow + dof) = (u32x4){ax, ay, bx, by}; }
}
__device__ __forceinline__ void diag_phase(int wave_, int ubeg, int uend, const bf16* Q, const bf16* K, const bf16* V, bf16* YM, const bf16* P2A, const bf16* P2B, const float* ML, const float* BT, LAS char* lds) {
    int lane_ = lane_id(); asm volatile("" : "+v"(lane_)); asm volatile("" : "+s"(wave_));
    int hc = -1; float bfar = 0.f;
#pragma unroll 1
    for (int u = ubeg; u < uend; ++u) {
        const int bh = u >> 4, qb = u & 15, h = bh & 7;
        if (h != hc) { hc = h; __syncthreads(); fill_bias_table(BT, h, wave_ * 64 + lane_, (LAS float*)(lds + L_TB)); bfar = BT[h * 132 + 128]; }
        diag_unit(wave_, lane_, bh >> 3, h, qb, Q, K, V, YM, P2A, P2B, ML, bfar, lds); }
}
#undef MOBA_CVEC
#undef MOBA_QK
#undef MOBA_NEARMAX
#undef MOBA_STEP
#undef MOBA_BLOCK4
}

__device__ __forceinline__ void ph_cvt_x(const Ctx& F0) {
    const Ctx F = launder(F0);
    const int gw = F.vcu * NWAVES + F.wave, NGW = F.G * NWAVES; float* rs1 = (float*)(F.ws + WS_RS1);
    for (int m = gw; m < T; m += 2 * NGW) {
        f32x4 v[2][4];
#pragma unroll
        for (int r = 0; r < 2; ++r) { const int mr = m + r * NGW < T ? m + r * NGW : T - 1; const f32x4* xr = (const f32x4*)(F.in[0] + (size_t)mr * D) + F.lane;
#pragma unroll
            for (int j = 0; j < 4; ++j) v[r][j] = xr[64 * j]; }
#pragma unroll
        for (int r = 0; r < 2; ++r) { float s = 0.f;
#pragma unroll
            for (int j = 0; j < 4; ++j) s += (v[r][j].x * v[r][j].x + v[r][j].y * v[r][j].y) + (v[r][j].z * v[r][j].z + v[r][j].w * v[r][j].w);
            const float rstd = 1.f / sqrtf(wave_sum(s) * (1.f / D) + RMS_EPS);
            if (m + r * NGW >= T) continue;
            if (F.lane == 0) rs1[m + r * NGW] = rstd;
            unsigned long long* o8 = (unsigned long long*)(P_XB(F) + (size_t)(m + r * NGW) * D) + F.lane;
#pragma unroll
            for (int j = 0; j < 4; ++j) o8[64 * j] = (unsigned long long)pk2(v[r][j].x, v[r][j].y) | ((unsigned long long)pk2(v[r][j].z, v[r][j].w) << 32); }
    }
}
__device__ __forceinline__ float row_ssq_bf16(const bf16* row, int lane) {
    const u32x4* xr = (const u32x4*)row + lane; float s = 0.f;
#pragma unroll
    for (int j = 0; j < 2; ++j) { const u32x4 x = xr[64 * j];
        const float a0 = bf2f(x.x & 0xffffu), a1 = bf2f(x.x >> 16), a2 = bf2f(x.y & 0xffffu), a3 = bf2f(x.y >> 16), a4 = bf2f(x.z & 0xffffu), a5 = bf2f(x.z >> 16), a6 = bf2f(x.w & 0xffffu), a7 = bf2f(x.w >> 16);
        s += ((a0 * a0 + a1 * a1) + (a2 * a2 + a3 * a3)) + ((a4 * a4 + a5 * a5) + (a6 * a6 + a7 * a7)); }
    return wave_sum(s);
}
__device__ __forceinline__ void ph_rstd(const Ctx& F0) {
    const Ctx F = launder(F0);
    const int gw = F.vcu * NWAVES + F.wave, NGW = F.G * NWAVES; float* rs1 = (float*)(F.ws + WS_RS1);
    for (int m = gw; m < T; m += 4 * NGW) {
        u32x4 x[4][2];
#pragma unroll
        for (int r = 0; r < 4; ++r) { const int mr = m + r * NGW < T ? m + r * NGW : T - 1; const u32x4* xr = (const u32x4*)(P_XB(F) + (size_t)mr * D) + F.lane; x[r][0] = xr[0]; x[r][1] = xr[64]; }
#pragma unroll
        for (int r = 0; r < 4; ++r) { float s = 0.f;
#pragma unroll
            for (int j = 0; j < 2; ++j) { const u32x4 q = x[r][j];
                const float a0 = bf2f(q.x & 0xffffu), a1 = bf2f(q.x >> 16), a2 = bf2f(q.y & 0xffffu), a3 = bf2f(q.y >> 16), a4 = bf2f(q.z & 0xffffu), a5 = bf2f(q.z >> 16), a6 = bf2f(q.w & 0xffffu), a7 = bf2f(q.w >> 16);
                s += ((a0 * a0 + a1 * a1) + (a2 * a2 + a3 * a3)) + ((a4 * a4 + a5 * a5) + (a6 * a6 + a7 * a7)); }
            s = wave_sum(s); if (F.lane == 0 && m + r * NGW < T) rs1[m + r * NGW] = 1.f / sqrtf(s * (1.f / D) + RMS_EPS); } }
}

__device__ __forceinline__ void ph_bias_table(const Ctx& F0) {
    const Ctx F = launder(F0);
    if (F.vcu == 0) {
        const float* rel_bias = F.in[1];
        for (int i = F.tid; i < 8 * 132; i += NTHREADS) {
            const int h = i / 132, r = i % 132;
            int bk;
            if (r < 16) bk = r;
            else { bk = 16 + (int)(logf((float)r / 16.f) / logf(8.f) * 16.f); if (bk > 31) bk = 31; }
            P_BT(F)[i] = rel_bias[bk * 8 + h] * LOG2E;
        }
    }
}

template <int WIN> __device__ __forceinline__ void pool_item(const unsigned* __restrict__ P2, unsigned* __restrict__ D2, int m0, int t0) {
    unsigned v[32], pv[WIN];
#pragma unroll
    for (int j = 0; j < WIN; ++j) pv[j] = t0 > 0 ? P2[(size_t)(m0 - WIN + j) * 128] : 0u;
#pragma unroll
    for (int i = 0; i < 32; ++i) v[i] = P2[(size_t)(m0 + i) * 128];
    float s0 = 0.f, s1 = 0.f;
    if (t0 > 0) {
#pragma unroll
        for (int j = WIN - 1; j >= 0; --j) { s0 += bf2f(pv[j] & 0xffffu); s1 += bf2f(pv[j] >> 16); } }
#pragma unroll
    for (int i = 0; i < 32; ++i) { const int t = t0 + i; const float p0 = bf2f(v[i] & 0xffffu), p1 = bf2f(v[i] >> 16);
        s0 += p0; s1 += p1;
        if (t >= WIN) { const unsigned o = i >= WIN ? v[i >= WIN ? i - WIN : 0] : pv[i < WIN ? i : 0]; s0 -= bf2f(o & 0xffffu); s1 -= bf2f(o >> 16); }
        const float inv = 1.f / (float)((t + 1 < WIN) ? t + 1 : WIN);
        D2[(size_t)(m0 + i) * 128] = pk2(s0 * inv - p0, s1 * inv - p1); }
}
__device__ __forceinline__ void ph_pool_dl(const Ctx& F0) {
    const Ctx F = launder(F0);
    const int gt = F.vcu * NTHREADS + F.tid, NGT = F.G * NTHREADS;
    for (int it = gt; it < (T / 32) * 128; it += NGT) {
        const int cp = it & 127, chunk = it >> 7, gi = cp >> 5, m0 = chunk * 32, t0 = m0 & (SEQ - 1);
        const unsigned* P2 = (const unsigned*)P_PB(F) + cp; unsigned* D2 = (unsigned*)P_DL(F) + cp;
        if (gi == 0) pool_item<2>(P2, D2, m0, t0); else if (gi == 1) pool_item<4>(P2, D2, m0, t0); else if (gi == 2) pool_item<8>(P2, D2, m0, t0); else pool_item<16>(P2, D2, m0, t0);
    }
}
__device__ __forceinline__ void ph_final(const Ctx& F0) {
    const Ctx F = launder(F0);
    const int gw = F.vcu * NWAVES + F.wave, NGW = F.G * NWAVES;
    const f32x4* gf = (const f32x4*)F.in[26];
    for (int m = gw; m < T; m += 2 * NGW) {
        u32x4 x[2][2];
#pragma unroll
        for (int r = 0; r < 2; ++r) { const int mr = m + r * NGW < T ? m + r * NGW : T - 1; const u32x4* xr = (const u32x4*)(P_XB(F) + (size_t)mr * D) + F.lane; x[r][0] = xr[0]; x[r][1] = xr[64]; }
#pragma unroll
        for (int r = 0; r < 2; ++r) { float s = 0.f;
#pragma unroll
            for (int j = 0; j < 2; ++j) { const u32x4 q = x[r][j];
                const float a0 = bf2f(q.x & 0xffffu), a1 = bf2f(q.x >> 16), a2 = bf2f(q.y & 0xffffu), a3 = bf2f(q.y >> 16), a4 = bf2f(q.z & 0xffffu), a5 = bf2f(q.z >> 16), a6 = bf2f(q.w & 0xffffu), a7 = bf2f(q.w >> 16);
                s += ((a0 * a0 + a1 * a1) + (a2 * a2 + a3 * a3)) + ((a4 * a4 + a5 * a5) + (a6 * a6 + a7 * a7)); }
            const float rstd = 1.f / sqrtf(wave_sum(s) * (1.f / D) + RMS_EPS);
            if (m + r * NGW >= T) continue;
            f32x4* orow = (f32x4*)(F.R + (size_t)(m + r * NGW) * D);
#pragma unroll
            for (int j = 0; j < 2; ++j) { const u32x4 q = x[r][j]; const int c4 = 2 * (64 * j + F.lane);
                orow[c4] = (f32x4){bf2f(q.x & 0xffffu), bf2f(q.x >> 16), bf2f(q.y & 0xffffu), bf2f(q.y >> 16)} * rstd * gf[c4];
                orow[c4 + 1] = (f32x4){bf2f(q.z & 0xffffu), bf2f(q.z >> 16), bf2f(q.w & 0xffffu), bf2f(q.w >> 16)} * rstd * gf[c4 + 1]; } }
    }
}

constexpr int LDS_BYTES = 147456;
constexpr int MISC_OFF = 131072 + 320;

__global__ void __launch_bounds__(NTHREADS, 2) mk_fwd(Args args) {
    extern __shared__ __attribute__((aligned(16))) unsigned char lds[];
    Ctx F;
    F.lds = (LAS unsigned char*)lds;
    F.wave = __builtin_amdgcn_readfirstlane((int)threadIdx.x >> 6);
    F.lane = lane_id(); F.tid = F.wave * 64 + F.lane;
    F.G = gridDim.x; { const int bx = blockIdx.x; F.vcu = (F.G % 8 == 0) ? (bx % 8) * (F.G / 8) + bx / 8 : bx; }
    F.in = (KargP)__builtin_amdgcn_kernarg_segment_ptr(); F.R = args.out; F.ws = args.ws;
    unsigned char* ws = args.ws;
    volatile LAS unsigned* MISC = (volatile LAS unsigned*)(F.lds + MISC_OFF);
    if (F.tid < 64) MISC[F.tid] = 0u;
    __syncthreads();
    XcdBarrier bar = xcd_barrier_post((unsigned*)(ws + WS_CTL) + CW_BAR, MISC + 8, F.tid == 0);
#define GRID_BAR() do { bar.bar = (unsigned*)(wsl(ws) + WS_CTL) + CW_BAR; xcd_barrier(bar, F.wave); } while (0)
#define FL launder(F)

    ph_bias_table(F);
    ph_prologue(F);
#pragma unroll 1
    for (int l = 0; l < DEPTH; ++l) {
        if (l == 0) ph_cvt_x(F); else ph_rstd(F);
        GRID_BAR();
        { pg8::Gemm g{P_XB(FL), (const bf16*)(wsl(ws) + WS_WIN) + (size_t)l * NPROJ * D, D, D, D}; pg8::StaticOrder S; S.init(T, NPROJ, sl(F.G), sl((int)blockIdx.x));
          EpiProjE E{P_UG(FL), P_PB(FL), P_QB(FL), P_KB(FL), P_VB(FL), P_KMP(FL), (const float*)(wsl(ws) + WS_RS1)}; pg8::gemm_phase(F.lds, g, S, E, sl(F.wave)); }
        GRID_BAR();
        { pg8::Gemm g{P_UG(FL) + UOF, (const bf16*)(wsl(ws) + WS_BZ) + (size_t)l * SGN * 256 * 1024, UGP, 1024, 1024}; SsmOrder S{sl(F.G), sl((int)blockIdx.x), 1};
          EpiZ E{(float*)(wsl(ws) + WS_ZB)}; pg8::gemm_phase(F.lds, g, S, E, sl(F.wave)); }
        ph_pool_dl(F);
        moba::sel_phase(sl(F.wave), sl((int)blockIdx.x), sl(F.G), P_QB(FL), P_KMP(FL), (unsigned*)(wsl(ws) + WS_SEL), (LAS char*)F.lds);
        ph_tg_expand(F, l, sl((int)blockIdx.x), sl(F.G) > 64 ? 32 : 0);
        GRID_BAR();
        ph_ssm_scan(F, l);
        moba::gather_phase(sl(F.wave), sl(F.vcu), P_QB(FL), P_KB(FL), P_VB(FL), P_YMIX(FL), P_PB(FL), (bf16*)(wsl(ws) + WS_P2B), (float*)(wsl(ws) + WS_ML), (const unsigned*)(wsl(ws) + WS_SEL), P_BT(FL), (LAS char*)F.lds);
        GRID_BAR();
        { pg8::Gemm g{P_UG(FL), (const bf16*)(wsl(ws) + WS_TG) + (size_t)l * SGN * 1024 * UGP, UGP, UGP, UGP}; SsmOrder S{sl(F.G), sl((int)blockIdx.x), 2};
          EpiSsm2 E{P_UG(FL), P_YS(FL), F.in[11] + l * 256}; pg8::gemm_phase(F.lds, g, S, E, sl(F.wave)); }
        { const int bx = sl((int)blockIdx.x), G_ = sl(F.G); int ub, ue;
          if (G_ == 256) { const int q4 = bx & 3; ub = bx < 128 ? (bx >> 2) * 12 + (q4 == 0 ? 0 : q4 == 1 ? 4 : q4 == 2 ? 7 : 10) : 384 + 5 * (bx - 128); ue = ub + (bx < 128 ? (q4 == 0 ? 4 : q4 == 3 ? 2 : 3) : 5); }
          moba::diag_phase(sl(F.wave), ub, ue, P_QB(FL), P_KB(FL), P_VB(FL), P_YMIX(FL), P_PB(FL), (const bf16*)(wsl(ws) + WS_P2B), (const float*)(wsl(ws) + WS_ML), P_BT(FL), (LAS char*)F.lds); }
        GRID_BAR();
        { pg8::Gemm g{P_YS(FL), (const bf16*)(wsl(ws) + WS_GLUT) + (size_t)l * 65536, 256, 256, 256}; HalfOrder S{sl(F.vcu)};
          EpiGluE E{P_YS(FL), P_YMIX(FL), F.in[13] + l * 256}; pg8::gemm_phase(F.lds, g, S, E, sl(F.wave)); }
        { pg8::Gemm g{P_DL(FL), (const bf16*)(wsl(ws) + WS_POOLT) + (size_t)l * 65536, 256, 256, 256}; HalfOrder S{sl(F.vcu) - 128};
          EpiPoolE E{P_YMIX(FL), F.in[15] + l * 256, F.in[16] + l * 256}; pg8::gemm_phase(F.lds, g, S, E, sl(F.wave)); }
        GRID_BAR();
        { pg8::Gemm g{P_YMIX(FL), (const bf16*)(wsl(ws) + WS_WOUT) + (size_t)l * D * D, D, D, D}; pg8::StaticOrder S; S.init(T, D, sl(F.G), sl((int)blockIdx.x));
          EpiOutE E{P_XB(FL)}; pg8::gemm_phase(F.lds, g, S, E, sl(F.wave)); }
        GRID_BAR();
        ph_route(F, l);
        GRID_BAR();
        ph_place(F);
        GRID_BAR();
        { pg8::Gemm g{P_XB(FL), (const bf16*)(wsl(ws) + WS_GU) + (size_t)l * 16 * 512 * D, D, D, D}; MoeOrder S{sl(F.G), sl((int)blockIdx.x), false, 0, 0}; S.init((const int*)(wsl(ws) + WS_TILEB));
          EpiGU E{(bf16*)(wsl(ws) + WS_HACT), (const float*)(wsl(ws) + WS_ROWW), (const float*)(wsl(ws) + WS_ROWR)}; pg8::gemm_phase<true, true>(F.lds, g, S, E, sl(F.wave), (const int*)(wsl(ws) + WS_ROWTOK)); }
        GRID_BAR();
        { pg8::Gemm g{(const bf16*)(wsl(ws) + WS_HACT), (const bf16*)(wsl(ws) + WS_WD) + (size_t)l * 24 * D * 512, 512, 512, 512}; MoeOrder S{sl(F.G), sl((int)blockIdx.x), true, 0, 0}; S.init((const int*)(wsl(ws) + WS_TILEB));
          EpiDown E{P_XB(FL), (const int*)(wsl(ws) + WS_ROWTOK)}; pg8::gemm_phase(F.lds, g, S, E, sl(F.wave)); }
        GRID_BAR();
    }
    ph_final(F);
}

extern "C" void kernel_launch(void* const* d_in, const int* in_sizes, int n_in, void* d_out, int out_size, void* d_ws, size_t ws_size, hipStream_t stream) {
    static int grid = 0;
    if (grid == 0) {
        if (n_in != 27 || out_size != T * D || ws_size < WS_END) { fprintf(stderr, "kernel_launch: unexpected shapes (n_in %d out %d ws %zu)\n", n_in, out_size, ws_size); grid = -1; return; }
        int dev = 0, cus = 0, per_cu = 0;
        if (hipGetDevice(&dev) != hipSuccess || hipDeviceGetAttribute(&cus, hipDeviceAttributeMultiprocessorCount, dev) != hipSuccess) { grid = -1; return; }
        if (hipFuncSetAttribute((const void*)mk_fwd, hipFuncAttributeMaxDynamicSharedMemorySize, LDS_BYTES) != hipSuccess) { fprintf(stderr, "kernel_launch: hipFuncSetAttribute failed\n"); grid = -1; return; }
        if (hipOccupancyMaxActiveBlocksPerMultiprocessor(&per_cu, (const void*)mk_fwd, NTHREADS, LDS_BYTES) != hipSuccess || per_cu < 1) { fprintf(stderr, "kernel_launch: occupancy query says %d\n", per_cu); per_cu = 1; }
        (void)hipGetLastError();
        grid = cus;
    }
    if (grid < 0) return;
    (void)hipMemsetAsync((char*)d_ws + WS_CTL, 0, CTL_ZERO_BYTES, stream);
    Args a{};
    for (int i = 0; i < 27; ++i) a.in[i] = (const float*)d_in[i];
    a.out = (float*)d_out; a.ws = (unsigned char*)d_ws; a.pad0 = 0; a.pad1 = 0;
    hipLaunchKernelGGL(mk_fwd, dim3(grid), dim3(NTHREADS), LDS_BYTES, stream, a);
}
```

```cpp
#include <hip/hip_runtime.h>
#include <hip/hip_bf16.h>
#include <cstdio>
#include <cstdint>

#define GAS __attribute__((address_space(1)))
#define LAS __attribute__((address_space(3)))
typedef unsigned short bf16;
typedef float f32x4 __attribute__((ext_vector_type(4)));
typedef unsigned u32x4 __attribute__((ext_vector_type(4)));
typedef unsigned u32x2 __attribute__((ext_vector_type(2)));

constexpr int NB = 8, SEQ = 4096, T = NB * SEQ, D = 1024, NPROJ = 2048, DEPTH = 2;
constexpr int NHEAD = 8, HD = 64, MBLK = 256, NBLK = SEQ / MBLK;
constexpr int SG = 16, SGN = 16, SP = 64, SCH = 64, UGP = 1152, UOF = 128;
constexpr float RMS_EPS = 1e-6f;
constexpr float LOG2E = 1.4426950408889634f;
constexpr float C2 = 0.125f * LOG2E;
constexpr int NWAVES = 8, NTHREADS = 512;

constexpr size_t MiB = 1u << 20;
constexpr size_t WS_CTL = 0, CTL_ZERO_BYTES = 1 * MiB;
constexpr size_t WS_XB = 2 * MiB;
constexpr size_t WS_UG = 66 * MiB;
constexpr size_t WS_PB = 84 * MiB;
constexpr size_t WS_QB = 100 * MiB;
constexpr size_t WS_KB = 132 * MiB;
constexpr size_t WS_VB = 164 * MiB;
constexpr size_t WS_YMIX = 196 * MiB;
constexpr size_t WS_YS = 260 * MiB;
constexpr size_t WS_DL = 276 * MiB;
constexpr size_t WS_KMP = 292 * MiB;
constexpr size_t WS_BT = 293 * MiB;
constexpr size_t WS_KT = 297 * MiB;
constexpr size_t WS_SEL = 298 * MiB;
constexpr size_t WS_WIN = 300 * MiB;
constexpr size_t WS_WOUT = 308 * MiB;
constexpr size_t WS_GU = 312 * MiB;
constexpr size_t WS_WD = 344 * MiB;
constexpr size_t WS_TG = 392 * MiB;
constexpr size_t WS_BZ = 464 * MiB;
constexpr size_t WS_GLUT = 480 * MiB;
constexpr size_t WS_POOLT = WS_GLUT + 512 * 1024;
constexpr size_t WS_ZB = 482 * MiB;
constexpr size_t WS_P2B = 486 * MiB;
constexpr size_t WS_ML = 502 * MiB;
constexpr size_t WS_END = 508 * MiB;
constexpr int MOE_MAXT = 152;
constexpr size_t WS_XS = 66 * MiB;
constexpr size_t WS_HACT = 142 * MiB;
constexpr size_t WS_TOKB = 294 * MiB;
constexpr size_t WS_TOKR = WS_TOKB + 128 * 1024;
constexpr size_t WS_TOKW = WS_TOKB + 256 * 1024;
constexpr size_t WS_ROWTOK = 295 * MiB;
constexpr size_t WS_ROWW = WS_ROWTOK + 256 * 1024;
constexpr size_t WS_ROWR = WS_ROWTOK + 576 * 1024;
constexpr size_t WS_RS1 = WS_ROWTOK + 768 * 1024;
constexpr size_t WS_WGCNT = 296 * MiB;
constexpr size_t WS_TILEB = WS_WGCNT + 64 * 1024;

constexpr int CW_BAR = 4096;

__device__ __forceinline__ unsigned pk2(float lo, float hi) { unsigned r; asm volatile("v_cvt_pk_bf16_f32 %0, %1, %2" : "=v"(r) : "v"(lo), "v"(hi)); return r; }
__device__ __forceinline__ unsigned f2bf(float f) { return pk2(f, 0.f) & 0xffffu; }
__device__ __forceinline__ float bf2f(unsigned h) { return __builtin_bit_cast(float, h << 16); }
template <int O> __device__ __forceinline__ float xshfl(float v) {
    if constexpr (O < 32) return __builtin_bit_cast(float, __builtin_amdgcn_ds_swizzle(__builtin_bit_cast(int, v), (O << 10) | 0x1f));
    else { const unsigned u = __builtin_bit_cast(unsigned, v); auto r = __builtin_amdgcn_permlane32_swap(u, u, false, false);
           const float a = __builtin_bit_cast(float, (unsigned)r[0]), b = __builtin_bit_cast(float, (unsigned)r[1]); return (a == v && __builtin_bit_cast(unsigned, a) == u) ? b : a; }
}
template <int R> __device__ __forceinline__ float row_ror(float v) { return __builtin_bit_cast(float, __builtin_amdgcn_update_dpp(0, __builtin_bit_cast(int, v), 0x120 + R, 0xf, 0xf, false)); }
__device__ __forceinline__ float row_sum16(float v) { v += row_ror<1>(v); v += row_ror<2>(v); v += row_ror<4>(v); v += row_ror<8>(v); return v; }
__device__ __forceinline__ float wave_sum(float v) {
    v = row_sum16(v); v += xshfl<16>(v);
    const unsigned u = __builtin_bit_cast(unsigned, v); auto r = __builtin_amdgcn_permlane32_swap(u, u, false, false);
    return __builtin_bit_cast(float, (unsigned)r[0]) + __builtin_bit_cast(float, (unsigned)r[1]);
}
__device__ __forceinline__ float wave_max(float v) {
    v = fmaxf(v, xshfl<1>(v)); v = fmaxf(v, xshfl<2>(v)); v = fmaxf(v, xshfl<4>(v)); v = fmaxf(v, xshfl<8>(v)); v = fmaxf(v, xshfl<16>(v));
    const unsigned u = __builtin_bit_cast(unsigned, v); auto r = __builtin_amdgcn_permlane32_swap(u, u, false, false);
    return fmaxf(__builtin_bit_cast(float, (unsigned)r[0]), __builtin_bit_cast(float, (unsigned)r[1]));
}
__device__ __forceinline__ float sigmoidf_(float x) { return __builtin_amdgcn_rcpf(1.f + __builtin_amdgcn_exp2f(-1.4426950408889634f * x)); }
__device__ __forceinline__ float gelu_tanh(float x) {
    const float u = 0.7978845608028654f * (x + 0.044715f * x * x * x);
    return x * sigmoidf_(2.f * u);
}

__device__ __forceinline__ int lane_id() { unsigned m; asm volatile("s_mov_b32 %0, -1" : "=s"(m)); return (int)__builtin_amdgcn_mbcnt_hi(m, __builtin_amdgcn_mbcnt_lo(m, 0u)); }

#define XB_TMO      128
#define XB_XCNT(j)  (256  + 64 * (j))
#define XB_XSUB(j)  (1280 + 64 * (j))
#define XB_XGEN(j)  (2304 + 64 * (j))
#define XB_TOP      3328
#define XB_TOPGEN   3392
#define XCD_BAR_WORDS 3456
#define XB_SPIN_CAP (1u << 22)
__device__ __forceinline__ unsigned xb_ld(unsigned* p)              { return __hip_atomic_load(p, __ATOMIC_RELAXED, __HIP_MEMORY_SCOPE_AGENT); }
__device__ __forceinline__ unsigned xb_add(unsigned* p, unsigned v) { return __hip_atomic_fetch_add(p, v, __ATOMIC_RELAXED, __HIP_MEMORY_SCOPE_AGENT); }
__device__ __forceinline__ unsigned xb_xcc_id() { return (unsigned)__builtin_amdgcn_s_getreg((3 << 11) | 20) & 0xFu; }
#define XB_SPIN(cond, bar) do { unsigned _sp = 0; while (cond) { __builtin_amdgcn_s_sleep(1); \
    if ((++_sp & 255u) == 0u) { if (xb_ld(&(bar)[XB_TMO])) break; if (_sp > XB_SPIN_CAP) { atomicAdd(&(bar)[XB_TMO], 1u); break; } } } } while (0)
struct XcdBarrier { unsigned* bar; unsigned x; volatile LAS unsigned* st; };
__device__ __forceinline__ XcdBarrier xcd_barrier_post(unsigned* bar, volatile LAS unsigned* st, bool t0) {
    XcdBarrier b; b.bar = bar; b.x = xb_xcc_id(); b.st = st;
    if (t0) (void)xb_add(&bar[XB_XCNT(b.x)], 1u);
    return b;
}
__device__ __forceinline__ void xcd_barrier_complete(unsigned* bar, unsigned x, unsigned& nloc, unsigned& nx) {
    const unsigned G = gridDim.x * gridDim.y * gridDim.z;
    unsigned sum, cnt, mine, sp = 0u;
    for (;;) {
        sum = 0u; cnt = 0u; mine = 0u;
#pragma unroll
        for (unsigned j = 0; j < 16; ++j) { const unsigned c = xb_ld(&bar[XB_XCNT(j)]); sum += c; cnt += (c > 0u) ? 1u : 0u; mine = (j == x) ? c : mine; }
        if (sum == G) break;
        __builtin_amdgcn_s_sleep(1);
        if ((++sp & 255u) == 0u) { if (xb_ld(&bar[XB_TMO])) break; if (sp > XB_SPIN_CAP) { atomicAdd(&bar[XB_TMO], 1u); break; } }
    }
    nloc = mine > 0u ? mine : 1u; nx = cnt > 0u ? cnt : 1u;
}
__device__ __forceinline__ void xcd_barrier(const XcdBarrier& b, int wave) {
    asm volatile("s_waitcnt vmcnt(0)" ::: "memory");
    __syncthreads();
    if (wave == 0 && lane_id() == 0) {
        unsigned* bar = b.bar;
        __builtin_amdgcn_s_waitcnt(0);
        unsigned nloc = b.st[0], nx = b.st[1];
        if (nloc == 0u) { xcd_barrier_complete(bar, b.x, nloc, nx); b.st[0] = nloc; b.st[1] = nx; }
        const unsigned old = xb_add(&bar[XB_XSUB(b.x)], 1u);
        const unsigned gen = old / nloc;
        if (old + 1u == (gen + 1u) * nloc) {
            __builtin_amdgcn_fence(__ATOMIC_RELEASE, "agent");
            asm volatile("s_waitcnt vmcnt(0)" ::: "memory");
            const unsigned og = xb_add(&bar[XB_TOP], 1u);
            const unsigned tg = og / nx;
            if (og + 1u == (tg + 1u) * nx) xb_add(&bar[XB_TOPGEN], 1u);
            else XB_SPIN(xb_ld(&bar[XB_TOPGEN]) == tg, bar);
            __builtin_amdgcn_fence(__ATOMIC_ACQUIRE, "agent");
            xb_add(&bar[XB_XGEN(b.x)], 1u);
            asm volatile("s_waitcnt vmcnt(0)" ::: "memory");
        } else {
            XB_SPIN(xb_ld(&bar[XB_XGEN(b.x)]) == gen, bar);
            __builtin_amdgcn_fence(__ATOMIC_ACQUIRE, "agent");
            asm volatile("s_waitcnt vmcnt(0)" ::: "memory");
        }
    }
    __syncthreads();
}

struct Args {
    const float* in[27];
    float* out;
    unsigned char* ws;
    int pad0, pad1;
};

typedef const float* fptr_t;
typedef __attribute__((address_space(4))) const fptr_t* KargP;
struct Ctx {
    LAS unsigned char* lds;
    int tid, lane, wave, vcu, G;
    KargP in;
    float* R;
    unsigned char* ws;
};
#define P_XB(F) ((bf16*)((F).ws + WS_XB))
#define P_UG(F) ((bf16*)((F).ws + WS_UG))
#define P_PB(F) ((bf16*)((F).ws + WS_PB))
#define P_QB(F) ((bf16*)((F).ws + WS_QB))
#define P_KB(F) ((bf16*)((F).ws + WS_KB))
#define P_VB(F) ((bf16*)((F).ws + WS_VB))
#define P_YMIX(F) ((bf16*)((F).ws + WS_YMIX))
#define P_YS(F) ((bf16*)((F).ws + WS_YS))
#define P_DL(F) ((bf16*)((F).ws + WS_DL))
#define P_KMP(F) ((float*)((F).ws + WS_KMP))
#define P_BT(F) ((float*)((F).ws + WS_BT))


__device__ __forceinline__ Ctx launder(const Ctx& F0) {
    Ctx F = F0;
    int ln = lane_id(); asm volatile("" : "+v"(ln));
    asm volatile("" : "+s"(F.wave), "+s"(F.vcu), "+s"(F.G));
    F.lane = ln; F.tid = F.wave * 64 + ln;
    KargP kp = (KargP)__builtin_amdgcn_kernarg_segment_ptr(); asm volatile("" : "+s"(kp));
    F.in = kp; F.R = (float*)kp[27]; F.ws = (unsigned char*)kp[28];
    return F;
}

__device__ __forceinline__ unsigned char* wsl(unsigned char* p) { asm volatile("" : "+s"(p)); return p; }
__device__ __forceinline__ int sl(int x) { asm volatile("" : "+s"(x)); return x; }

namespace pg8 {
typedef short bf16x8 __attribute__((ext_vector_type(8)));
constexpr int BM = 256, BK = 64, HALF = 128, HTB = HALF * BK * 2, STAGE_BYTES = 8 * HTB, NXCD = 8, WGM = 8;
__device__ __forceinline__ int lds_byte(int r, int c) { const int st = (r >> 4) * 2 + (c >> 5), rr = r & 15, cc = c & 31, ob = rr * 64 + cc * 2; return st * 1024 + (ob ^ (((ob >> 9) & 1) << 5)); }
__device__ __forceinline__ void stage_rc(int b, int& R, int& C) { const int st = b / 1024, sb = b % 1024, swz = sb ^ (((sb >> 9) & 1) << 5); R = (st >> 1) * 16 + swz / 64; C = (st & 1) * 32 + (swz % 64) / 2; }
__device__ __forceinline__ int perm32(int rho) { const int n = rho >> 4, i = rho & 15; return 8 * (i >> 2) + 4 * n + (i & 3); }

struct Unit { int pm, pn, aux, kt, pn2; };
struct Gemm { const bf16* A; const bf16* Bt; int lda, ldb, K; };

struct StaticOrder {
    int nM, nN, nwg, G, c;
    __device__ void init(int M, int N, int G_, int c_) { nM = M / BM; nN = N / BM; nwg = nM * nN; G = G_; c = c_; }
    __device__ bool next(int i, Unit& u) const {
        const long L = (long)i * G + c; if (L >= nwg) return false;
        int wgid = (int)L; { const int q = nwg / NXCD, r = nwg % NXCD, xcd = wgid % NXCD, off = wgid / NXCD; wgid = (xcd < r ? xcd * (q + 1) : r * (q + 1) + (xcd - r) * q) + off; }
        const int nig = WGM * nN, gid = wgid / nig, fm = gid * WGM, gsz = (nM - fm) < WGM ? (nM - fm) : WGM;
        u.pm = fm + ((wgid % nig) % gsz); u.pn = (wgid % nig) / gsz; u.aux = 0; return true;
    }
};

__device__ __forceinline__ unsigned cvt_pk_bf16(float lo, float hi) { unsigned r; asm volatile("v_cvt_pk_bf16_f32 %0, %1, %2" : "=v"(r) : "v"(lo), "v"(hi)); return r; }

template <bool ALIGN = true, bool GATHER = false, bool SPLITB = false, class Epi, class Sched>
__device__ __forceinline__ void gemm_phase(LAS unsigned char* lds, const Gemm g, const Sched& S, const Epi& E, int wave_, const int* gidx = nullptr) {
    int lane_ = lane_id(); asm volatile("" : "+v"(lane_)); asm volatile("" : "+s"(wave_));
    const int wid = wave_, lane = lane_, tid = wid * 64 + lane, wr = wid >> 2, wc = wid & 3, fr = lane & 15, fq = lane >> 4;
    const int K = g.K, ntd = K / BK; int nt = ntd;
    unsigned voffA[2], voffA1[2], voffB[2];
#pragma unroll
    for (int i = 0; i < 2; ++i) { int R, C; stage_rc(tid * 16 + i * 8192, R, C); const int Rb = Epi::PERM ? ((R & ~31) + perm32(R & 31)) : R;
        voffA[i] = (unsigned)(R * g.lda + C) * 2u; voffB[i] = (unsigned)(Rb * g.ldb + C) * 2u; voffA1[i] = voffA[i] + (unsigned)(HALF * g.lda * 2); }
    const size_t kstep = (size_t)(BK * 2);
    const size_t hstepA = (size_t)HALF * g.lda * 2, hstepB = (size_t)HALF * g.ldb * 2;
    const size_t tstepA = 2 * hstepA, tstepB = 2 * hstepB;
    const unsigned ldsw = (unsigned)wid * 1024u;
    const int aoff = lds_byte(wr * 64 + fr, fq * 8), boff = lds_byte(wc * 32 + fr, fq * 8);
#define PG8_SA(b, h) (((b) * 2 + (h)) * HTB)
#define PG8_SB(b, h) ((4 + (b) * 2 + (h)) * HTB)
#define PG8_STAGE(bufoff, gbase, voff) do { _Pragma("unroll") for (int _i = 0; _i < 2; ++_i) \
        __builtin_amdgcn_global_load_lds((const unsigned*)((const char*)(gbase) + (voff)[_i]), (LAS unsigned*)(lds + (bufoff) + ldsw + _i * 8192), 16, 0, 0); } while (0)
#define PG8_LDA(dst, b, h) do { _Pragma("unroll") for (int m = 0; m < 4; ++m) _Pragma("unroll") for (int k = 0; k < 2; ++k) dst[m][k] = *(const LAS bf16x8*)(lds + PG8_SA(b, h) + aoff + m * 2048 + k * 1024); } while (0)
#define PG8_LDB(dst, b, h) do { _Pragma("unroll") for (int n = 0; n < 2; ++n) _Pragma("unroll") for (int k = 0; k < 2; ++k) dst[n][k] = *(const LAS bf16x8*)(lds + PG8_SB(b, h) + boff + n * 2048 + k * 1024); } while (0)
#define PG8_MMA(ai, bj, At, Bt) do { __builtin_amdgcn_s_setprio(1); _Pragma("unroll") for (int m = 0; m < 4; ++m) _Pragma("unroll") for (int n = 0; n < 2; ++n) _Pragma("unroll") for (int k = 0; k < 2; ++k) \
        acc[ai][bj][m][n] = __builtin_amdgcn_mfma_f32_16x16x32_bf16(Bt[n][k], At[m][k], acc[ai][bj][m][n], 0, 0, 0); __builtin_amdgcn_s_setprio(0); } while (0)
#define PG8_GLOOK(PM) do { if constexpr (GATHER) { _Pragma("unroll") for (int _i = 0; _i < 2; ++_i) { int R_, C_; stage_rc(tid * 16 + _i * 8192, R_, C_); \
        int t0_ = gidx[(PM) * 256 + R_], t1_ = gidx[(PM) * 256 + HALF + R_]; t0_ = t0_ < 0 ? 0 : t0_; t1_ = t1_ < 0 ? 0 : t1_; \
        voffA[_i] = (unsigned)(t0_ * g.lda + C_) * 2u; voffA1[_i] = (unsigned)(t1_ * g.lda + C_) * 2u; } } } while (0)
#define PG8_WAIT_V(n) asm volatile("s_waitcnt vmcnt(" #n ")" ::: "memory")
#define PG8_WAIT_L(n) asm volatile("s_waitcnt lgkmcnt(" #n ")" ::: "memory")
#define PG8_BAR __builtin_amdgcn_s_barrier()
#define PG8_SCHED __builtin_amdgcn_sched_barrier(0)
    Unit cur{0, 0, 0, 0, 0}, nxt{0, 0, 0, 0, 0}; int ui = 0;
    if (!S.next(0, cur)) return;
    nt = cur.kt ? cur.kt : ntd;
    f32x4 acc[2][2][4][2];
#pragma unroll
    for (int a = 0; a < 2; ++a)
#pragma unroll
        for (int b = 0; b < 2; ++b)
#pragma unroll
            for (int m = 0; m < 4; ++m)
#pragma unroll
                for (int n = 0; n < 2; ++n) acc[a][b][m][n] = (f32x4){0.f, 0.f, 0.f, 0.f};
    bf16x8 At[4][2], B0[2][2], B1[2][2];
    const char* cA = (const char*)g.A + (GATHER ? (size_t)0 : (size_t)cur.pm * tstepA); const char* cB = (const char*)g.Bt + (size_t)cur.pn * tstepB;
    PG8_GLOOK(cur.pm);
    PG8_STAGE(PG8_SB(0, 0), cB, voffB); PG8_STAGE(PG8_SB(0, 1), cB + hstepB, voffB); PG8_STAGE(PG8_SA(0, 0), cA, voffA); PG8_STAGE(PG8_SA(0, 1), cA, voffA1);
    if (wr == 1) PG8_BAR;
    PG8_WAIT_V(2); PG8_BAR;
    PG8_STAGE(PG8_SB(1, 0), cB + kstep, voffB); PG8_STAGE(PG8_SA(1, 0), cA + kstep, voffA); PG8_STAGE(PG8_SB(1, 1), cB + hstepB + kstep, voffB);
    PG8_WAIT_V(6); PG8_BAR;
    for (;;) {
        const bool has_next = S.next(ui + 1, nxt);
        const char* nA = has_next ? (const char*)g.A + (GATHER ? (size_t)0 : (size_t)nxt.pm * tstepA) : cA; const char* nB = has_next ? (const char*)g.Bt + (size_t)nxt.pn * tstepB : cB;
        for (int t = 0; t < nt; t += 2) {
            const bool last = (t == nt - 2);
            const char* a1 = cA + (size_t)(t + 1) * kstep;
            const char* a2 = last ? nA : cA + (size_t)(t + 2) * kstep; const char* b2 = last ? nB : ((SPLITB && t + 2 >= ntd / 2) ? (const char*)g.Bt + (size_t)cur.pn2 * tstepB - (size_t)(ntd / 2) * kstep : cB) + (size_t)(t + 2) * kstep;
            const char* a3 = a2 + kstep; const char* b3 = b2 + kstep;
            PG8_LDB(B0, 0, 0); PG8_LDB(B1, 0, 1); PG8_SCHED; PG8_LDA(At, 0, 0); PG8_STAGE(PG8_SA(1, 1), a1, voffA1);
            PG8_WAIT_V(8); PG8_WAIT_L(0); PG8_BAR; PG8_MMA(0, 0, At, B0); PG8_MMA(0, 1, At, B1); PG8_BAR; PG8_SCHED;
            if constexpr (GATHER) { if (last && has_next) PG8_GLOOK(nxt.pm); }
            PG8_LDA(At, 0, 1); PG8_STAGE(PG8_SB(0, 0), b2, voffB); PG8_STAGE(PG8_SB(0, 1), b2 + hstepB, voffB); PG8_STAGE(PG8_SA(0, 0), a2, voffA);
            PG8_WAIT_V(8); PG8_WAIT_L(0); PG8_BAR; PG8_MMA(1, 0, At, B0); PG8_MMA(1, 1, At, B1); PG8_BAR; PG8_SCHED;
            PG8_LDB(B0, 1, 0); PG8_LDB(B1, 1, 1); PG8_SCHED; PG8_LDA(At, 1, 0); PG8_STAGE(PG8_SA(0, 1), a2, voffA1);
            PG8_WAIT_V(8); PG8_WAIT_L(0); PG8_BAR; PG8_MMA(0, 0, At, B0); PG8_MMA(0, 1, At, B1); PG8_BAR; PG8_SCHED;
            PG8_LDA(At, 1, 1); PG8_STAGE(PG8_SB(1, 0), b3, voffB); PG8_STAGE(PG8_SB(1, 1), b3 + hstepB, voffB); PG8_STAGE(PG8_SA(1, 0), a3, voffA);
            PG8_WAIT_V(8); PG8_WAIT_L(0); PG8_BAR; PG8_MMA(1, 0, At, B0); PG8_MMA(1, 1, At, B1); PG8_BAR; PG8_SCHED;
        }
        if constexpr (ALIGN) { if (wr == 0) PG8_BAR; }
        E(acc, cur, wr, wc, fr, fq);
        if (!has_next) break;
#pragma unroll
        for (int a = 0; a < 2; ++a)
#pragma unroll
            for (int b = 0; b < 2; ++b)
#pragma unroll
                for (int m = 0; m < 4; ++m)
#pragma unroll
                    for (int n = 0; n < 2; ++n) acc[a][b][m][n] = (f32x4){0.f, 0.f, 0.f, 0.f};
        cur = nxt; cA = nA; cB = nB; ++ui; nt = cur.kt ? cur.kt : ntd;
        if constexpr (ALIGN) { if (wr == 1) PG8_BAR; }
    }
    PG8_WAIT_V(0);
    if constexpr (!ALIGN) { if (wr == 0) PG8_BAR; }
    PG8_BAR;
#undef PG8_SA
#undef PG8_SB
#undef PG8_STAGE
#undef PG8_LDA
#undef PG8_LDB
#undef PG8_MMA
#undef PG8_WAIT_V
#undef PG8_WAIT_L
#undef PG8_BAR
#undef PG8_SCHED
}
}


struct EpiProjE {
    static constexpr bool PERM = true;
    bf16 *UG, *PB, *QB, *KB, *VB; float* KMP; const float* rs1;
    __device__ __forceinline__ void operator()(const f32x4 (&acc_)[2][2][4][2], const pg8::Unit& u, int wr, int wc, int fr_, int fq_) const {
        const int ln_ = lane_id(), fr = ln_ & 15, fq = ln_ >> 4; (void)fr_; (void)fq_;
        const int pn = u.pn, row0 = u.pm * 256 + wr * 64 + fr, cl = wc * 32 + 8 * fq;
        f32x4 acc[2][2][4][2];
#pragma unroll
        for (int ai = 0; ai < 2; ++ai)
#pragma unroll
            for (int m = 0; m < 4; ++m) { const float rs = ((const GAS float*)rs1)[row0 + ai * 128 + m * 16];
#pragma unroll
                for (int bj = 0; bj < 2; ++bj) { acc[ai][bj][m][0] = acc_[ai][bj][m][0] * rs; acc[ai][bj][m][1] = acc_[ai][bj][m][1] * rs; } }
        if (pn == 0) {
#pragma unroll
            for (int ai = 0; ai < 2; ++ai)
#pragma unroll
                for (int m = 0; m < 4; ++m) { const int r = row0 + ai * 128 + m * 16;
#pragma unroll
                    for (int bj = 0; bj < 2; ++bj) { const int ch = bj * 128 + cl, g = ch >> 4, h0 = ch & 15;
                        const f32x4 v0 = acc[ai][bj][m][0], v1 = acc[ai][bj][m][1]; u32x4 w;
                        w.x = pg8::cvt_pk_bf16(v0[0], v0[1]); w.y = pg8::cvt_pk_bf16(v0[2], v0[3]); w.z = pg8::cvt_pk_bf16(v1[0], v1[1]); w.w = pg8::cvt_pk_bf16(v1[2], v1[3]);
                        *(GAS u32x4*)(UG + ((size_t)(g * 512 + (r >> 6))) * UGP + UOF + (r & 63) * 16 + h0) = w; } }
        } else {
            bf16* base; int ldc, colt; float sc = 1.f;
            if (pn == 1) { base = PB; ldc = 256; colt = 0; }
            else if (pn < 4) { base = QB; ldc = 512; colt = (pn - 2) * 256; sc = C2; }
            else if (pn < 6) { base = KB; ldc = 512; colt = (pn - 4) * 256; }
            else { base = VB; ldc = 512; colt = (pn - 6) * 256; }
#pragma unroll
            for (int ai = 0; ai < 2; ++ai)
#pragma unroll
                for (int m = 0; m < 4; ++m) { bf16* rowp = base + (size_t)(row0 + ai * 128 + m * 16) * ldc + colt + cl;
#pragma unroll
                    for (int bj = 0; bj < 2; ++bj) { const f32x4 v0 = acc[ai][bj][m][0] * sc, v1 = acc[ai][bj][m][1] * sc; u32x4 w;
                        w.x = pg8::cvt_pk_bf16(v0[0], v0[1]); w.y = pg8::cvt_pk_bf16(v0[2], v0[3]); w.z = pg8::cvt_pk_bf16(v1[0], v1[1]); w.w = pg8::cvt_pk_bf16(v1[2], v1[3]);
                        *(GAS u32x4*)(rowp + bj * 128) = w; } }
            if (pn >= 4 && pn < 6) {
#pragma unroll
                for (int bj = 0; bj < 2; ++bj)
#pragma unroll
                    for (int n = 0; n < 2; ++n) { f32x4 s = (f32x4){0.f, 0.f, 0.f, 0.f};
#pragma unroll
                        for (int ai = 0; ai < 2; ++ai)
#pragma unroll
                            for (int m = 0; m < 4; ++m) s += acc[ai][bj][m][n];
#pragma unroll
                        for (int i = 0; i < 4; ++i) s[i] = row_sum16(s[i]);
                        if (fr == 0) *(GAS f32x4*)(KMP + (size_t)wr * 128 * 512 + (size_t)u.pm * 512 + colt + bj * 128 + cl + 4 * n) = s; }
            }
        }
    }
};
struct EpiOutE {
    static constexpr bool PERM = true;
    bf16* RB;
    __device__ __forceinline__ void operator()(const f32x4 (&acc)[2][2][4][2], const pg8::Unit& u, int wr, int wc, int fr_, int fq_) const {
        const int ln_ = lane_id(), fr = ln_ & 15, fq = ln_ >> 4; (void)fr_; (void)fq_;
        const int row0 = u.pm * 256 + wr * 64 + fr, col0 = u.pn * 256 + wc * 32 + 8 * fq;
#pragma unroll
        for (int ai = 0; ai < 2; ++ai) { u32x4 x[4][2];
#pragma unroll
            for (int m = 0; m < 4; ++m) { const bf16* rp = RB + (size_t)(row0 + ai * 128 + m * 16) * D + col0; x[m][0] = *(const u32x4*)rp; x[m][1] = *(const u32x4*)(rp + 128); }
#pragma unroll
            for (int m = 0; m < 4; ++m) { bf16* rp = RB + (size_t)(row0 + ai * 128 + m * 16) * D + col0;
#pragma unroll
                for (int bj = 0; bj < 2; ++bj) { const u32x4 xx = x[m][bj]; const f32x4 a0 = acc[ai][bj][m][0], a1 = acc[ai][bj][m][1]; u32x4 w;
                    w.x = pg8::cvt_pk_bf16(bf2f(xx.x & 0xffffu) + a0[0], bf2f(xx.x >> 16) + a0[1]); w.y = pg8::cvt_pk_bf16(bf2f(xx.y & 0xffffu) + a0[2], bf2f(xx.y >> 16) + a0[3]);
                    w.z = pg8::cvt_pk_bf16(bf2f(xx.z & 0xffffu) + a1[0], bf2f(xx.z >> 16) + a1[1]); w.w = pg8::cvt_pk_bf16(bf2f(xx.w & 0xffffu) + a1[2], bf2f(xx.w >> 16) + a1[3]);
                    *(u32x4*)(rp + bj * 128) = w; } }
            asm volatile("" ::: "memory"); }
    }
};

__device__ __forceinline__ void transpose_item(const float* W, int K, int N, const float* kscale, bf16* WT, int ldo, int koff, int rowmode, LAS float* scr, int item, int lane, bf16* WT2 = nullptr, bf16* WT3 = nullptr) {
    const int nblk = N / 32, kb = item / nblk, nb = item % nblk, k0 = 64 * kb, n0 = 32 * nb;
    { const int r8 = lane >> 3, c4 = lane & 7; f32x4 v[8];
#pragma unroll
      for (int i = 0; i < 8; ++i) v[i] = *(const f32x4*)(W + (size_t)(k0 + 8 * i + r8) * N + n0 + 4 * c4);
#pragma unroll
      for (int i = 0; i < 8; ++i) { const int kk = 8 * i + r8; const float s = kscale ? kscale[k0 + kk] : 1.f; LAS float* d = scr + kk * 33 + 4 * c4;
          d[0] = v[i][0] * s; d[1] = v[i][1] * s; d[2] = v[i][2] * s; d[3] = v[i][3] * s; } }
    asm volatile("s_waitcnt lgkmcnt(0)" ::: "memory");
    const int c = lane & 7;
#pragma unroll
    for (int j = 0; j < 4; ++j) { const int n = (lane >> 3) + 8 * j; const LAS float* s = scr + (8 * c) * 33 + n;
        u32x4 o; o.x = pk2(s[0 * 33], s[1 * 33]); o.y = pk2(s[2 * 33], s[3 * 33]); o.z = pk2(s[4 * 33], s[5 * 33]); o.w = pk2(s[6 * 33], s[7 * 33]);
        const int nn = n0 + n, row = rowmode == 0 ? nn : (8 * (nn >> 2) + (nn & 3) + (rowmode == 2 ? 4 : 0));
        *(u32x4*)(WT + (size_t)row * ldo + koff + k0 + 8 * c) = o;
        if (WT2) *(u32x4*)(WT2 + (size_t)row * ldo + k0 + 8 * c) = o;
        if (WT3) *(u32x4*)(WT3 + (size_t)row * ldo + k0 + 8 * c) = o; }
    asm volatile("s_waitcnt lgkmcnt(0)" ::: "memory");
}
__device__ __forceinline__ void pair_decode(int pi, int& ea, int& eb) { ea = pi < 3 ? 0 : (pi < 5 ? 1 : 2); eb = pi < 3 ? pi + 1 : (pi < 5 ? pi - 1 : 3); }
__device__ __forceinline__ void ph_prologue(const Ctx& F0) {
    const Ctx F = launder(F0);
    LAS float* scr = (LAS float*)(F.lds + F.wave * 16384);
    const int gw = F.vcu * NWAVES + F.wave, NGW = F.G * NWAVES;
    constexpr int I_IN = (D / 64) * (NPROJ / 32), I_OUT = (D / 64) * (D / 32), I_GU1 = (D / 64) * (256 / 32), I_GU = 16 * 2 * I_GU1, I_WD1 = (256 / 64) * (D / 32), I_WD = 16 * I_WD1;
    constexpr int I_L = I_IN + I_OUT + I_GU + I_WD;
    for (int it = gw; it < DEPTH * I_L; it += NGW) {
        const int l = it / I_L; int r = it % I_L;
        if (r < I_IN) { transpose_item(F.in[3] + (size_t)l * D * NPROJ, D, NPROJ, F.in[2] + l * D, (bf16*)(F.ws + WS_WIN) + (size_t)l * NPROJ * D, D, 0, 0, scr, r, F.lane); continue; } r -= I_IN;
        if (r < I_OUT) { transpose_item(F.in[17] + (size_t)l * D * D, D, D, nullptr, (bf16*)(F.ws + WS_WOUT) + (size_t)l * D * D, D, 0, 0, scr, r, F.lane); continue; } r -= I_OUT;
        if (r < I_GU) { const int e = r / (2 * I_GU1), up = (r / I_GU1) & 1, item = r % I_GU1;
            transpose_item(F.in[up ? 24 : 23] + ((size_t)l * 16 + e) * D * 256, D, 256, F.in[18] + l * D, (bf16*)(F.ws + WS_GU) + ((size_t)l * 16 + e) * 512 * D, D, 0, 1 + up, scr, item, F.lane); continue; } r -= I_GU;
        { const int e = r / I_WD1, item = r % I_WD1;
            transpose_item(F.in[25] + ((size_t)l * 16 + e) * 256 * D, 256, D, nullptr, (bf16*)(F.ws + WS_WD) + ((size_t)l * 16 + e) * D * 256, 256, 0, 0, scr, item, F.lane); }
    }
    for (int it = gw; it < DEPTH * 32; it += NGW) { const int l = it >> 5;
        transpose_item(F.in[12] + (size_t)l * 256 * 256, 256, 256, nullptr, (bf16*)(F.ws + WS_GLUT) + (size_t)l * 65536, 256, 0, 0, scr, it & 31, F.lane); }
    { const int gt = F.vcu * NTHREADS + F.tid, NGT = F.G * NTHREADS;
      for (int i = gt; i < DEPTH * 65536; i += NGT) { const int l = i >> 16, n = (i >> 8) & 255, k = i & 255;
          const float v = ((n >> 6) == (k >> 6)) ? F.in[14][(((size_t)l * 4 + (n >> 6)) * 64 + (k & 63)) * 64 + (n & 63)] : 0.f;
          ((bf16*)(F.ws + WS_POOLT))[i] = (bf16)f2bf(v); } }
    for (int it = gw; it < DEPTH * SGN * 65; it += NGW) {
        const int l = it / (SGN * 65), g = (it / 65) % SGN, tau = it % 65, p = F.lane;
        const float are = F.in[4][(l * SGN + g) * SP + p], aim = F.in[5][(l * SGN + g) * SP + p], dt = expf(F.in[6][l * SGN + g]);
        float sn, cs; sincosf(aim * dt, &sn, &cs); const float mg = expf(are * dt), lbr = mg * cs, lbi = mg * sn;
        const float nr = lbr - 1.f, ni = lbi, den = are * are + aim * aim, cr = (nr * are + ni * aim) / den, ci = (ni * are - nr * aim) / den;
        float sn2, cs2; sincosf(aim * dt * (float)tau, &sn2, &cs2); const float mg2 = expf(are * dt * (float)tau), lr = mg2 * cs2, li = mg2 * sn2;
        float wr[16], wi[16];
#pragma unroll
        for (int h = 0; h < 16; ++h) { const float br = F.in[7][((size_t)(l * SGN + g) * SP + p) * SG + h], bi = F.in[8][((size_t)(l * SGN + g) * SP + p) * SG + h];
            const float bbr = cr * br - ci * bi, bbi = cr * bi + ci * br; wr[h] = lr * bbr - li * bbi; wi[h] = lr * bbi + li * bbr; }
        bf16* TG = (bf16*)(F.ws + WS_TG) + ((size_t)l * SGN + g) * 1024 * UGP;
        if (tau <= 63) {
            bf16* BZ = (bf16*)(F.ws + WS_BZ) + ((size_t)l * SGN + g) * 256 * 1024; const int s = 63 - tau;
            u32x4 o0, o1, o2, o3;
            o0.x = pk2(wr[0], wr[1]); o0.y = pk2(wr[2], wr[3]); o0.z = pk2(wr[4], wr[5]); o0.w = pk2(wr[6], wr[7]); o1.x = pk2(wr[8], wr[9]); o1.y = pk2(wr[10], wr[11]); o1.z = pk2(wr[12], wr[13]); o1.w = pk2(wr[14], wr[15]);
            o2.x = pk2(wi[0], wi[1]); o2.y = pk2(wi[2], wi[3]); o2.z = pk2(wi[4], wi[5]); o2.w = pk2(wi[6], wi[7]); o3.x = pk2(wi[8], wi[9]); o3.y = pk2(wi[10], wi[11]); o3.z = pk2(wi[12], wi[13]); o3.w = pk2(wi[14], wi[15]);
            *(u32x4*)(BZ + (size_t)p * 1024 + s * 16) = o0; *(u32x4*)(BZ + (size_t)p * 1024 + s * 16 + 8) = o1;
            *(u32x4*)(BZ + (size_t)(64 + p) * 1024 + s * 16) = o2; *(u32x4*)(BZ + (size_t)(64 + p) * 1024 + s * 16 + 8) = o3;
        }
        LAS float* Wst = scr; LAS float* Kt = scr + 128 * 16;
        if (tau <= 63) {
#pragma unroll
            for (int q = 0; q < 4; ++q) { *(LAS f32x4*)(Wst + p * 16 + 4 * q) = (f32x4){wr[4 * q], wr[4 * q + 1], wr[4 * q + 2], wr[4 * q + 3]};
                                          *(LAS f32x4*)(Wst + (64 + p) * 16 + 4 * q) = (f32x4){wi[4 * q], wi[4 * q + 1], wi[4 * q + 2], wi[4 * q + 3]}; }
            const int arow = p & 15, kq = p >> 4; f32x4 kacc = (f32x4){0.f, 0.f, 0.f, 0.f};
            const float* cre = F.in[9] + ((size_t)(l * SGN + g) * SG + arow) * SP; const float* cim = F.in[10] + ((size_t)(l * SGN + g) * SG + arow) * SP;
#pragma unroll 8
            for (int s = 0; s < 32; ++s) { const int k = 4 * s + kq; const float av = (k < 64) ? cre[k] : -cim[k - 64]; const float bv = Wst[k * 16 + arow];
                kacc = __builtin_amdgcn_mfma_f32_16x16x4f32(av, bv, kacc, 0, 0, 0); }
#pragma unroll
            for (int r = 0; r < 4; ++r) Kt[(4 * kq + r) * 16 + arow] = kacc[r] + ((tau == 0 && 4 * kq + r == arow) ? F.in[11][l * 256 + g * 16 + arow] : 0.f);
            asm volatile("s_waitcnt lgkmcnt(0)" ::: "memory");
            const f32x4 t4 = *(const LAS f32x4*)(Kt + 4 * p);
            u32x2 o; o.x = pk2(t4[0], t4[1]); o.y = pk2(t4[2], t4[3]);
            *(u32x2*)((bf16*)(F.ws + WS_KT) + ((size_t)(l * SGN + g) * 64 + tau) * 256 + 4 * p) = o;
        }
        if (tau >= 1) {
#pragma unroll 4
            for (int ho = 0; ho < 16; ++ho) {
                const float ccr = F.in[9][((size_t)(l * SGN + g) * SG + ho) * SP + p], cci = F.in[10][((size_t)(l * SGN + g) * SG + ho) * SP + p];
                const int n = (tau - 1) * 16 + ho;
                TG[(size_t)n * UGP + p] = (bf16)f2bf(ccr * lr - cci * li); TG[(size_t)n * UGP + 64 + p] = (bf16)f2bf(-(ccr * li + cci * lr)); }
        }
    }
}

__device__ __forceinline__ void route_finish(const float (&a)[20], float ssum, int m, bool act, const float* gb_, const float* rb_, int* tokb, float* tokr, float* tokw, LAS int* hist) {
        const float rstd = 1.f / sqrtf(ssum * (1.f / D) + RMS_EPS);
        float lg0 = a[0] * rstd + gb_[0], lg1 = a[1] * rstd + gb_[1], lg2 = a[2] * rstd + gb_[2], lg3 = a[3] * rstd + gb_[3];
        int gs = 0; float gm = lg0;
        if (lg1 > gm) { gm = lg1; gs = 1; } if (lg2 > gm) { gm = lg2; gs = 2; } if (lg3 > gm) { gm = lg3; gs = 3; }
        const float gwt = 1.f / (__expf(lg0 - gm) + __expf(lg1 - gm) + __expf(lg2 - gm) + __expf(lg3 - gm));
        float q0 = a[4], q1 = a[5], q2 = a[6], q3 = a[7], q4 = a[8], q5 = a[9], q6 = a[10], q7 = a[11], q8 = a[12], q9 = a[13], q10 = a[14], q11 = a[15], q12 = a[16], q13 = a[17], q14 = a[18], q15 = a[19];
        asm volatile("" : "+v"(q0), "+v"(q1), "+v"(q2), "+v"(q3), "+v"(q4), "+v"(q5), "+v"(q6), "+v"(q7));
        asm volatile("" : "+v"(q8), "+v"(q9), "+v"(q10), "+v"(q11), "+v"(q12), "+v"(q13), "+v"(q14), "+v"(q15));
        float e0 = gs == 0 ? q0 : gs == 1 ? q4 : gs == 2 ? q8 : q12;
        float e1 = gs == 0 ? q1 : gs == 1 ? q5 : gs == 2 ? q9 : q13;
        float e2 = gs == 0 ? q2 : gs == 1 ? q6 : gs == 2 ? q10 : q14;
        float e3 = gs == 0 ? q3 : gs == 1 ? q7 : gs == 2 ? q11 : q15;
        e0 = e0 * rstd + rb_[gs * 4 + 0]; e1 = e1 * rstd + rb_[gs * 4 + 1]; e2 = e2 * rstd + rb_[gs * 4 + 2]; e3 = e3 * rstd + rb_[gs * 4 + 3];
        int t1 = 0; float v1 = e0;
        if (e1 > v1) { v1 = e1; t1 = 1; } if (e2 > v1) { v1 = e2; t1 = 2; } if (e3 > v1) { v1 = e3; t1 = 3; }
        int t2 = -1; float v2 = -3.0e38f;
        if (t1 != 0 && e0 > v2) { v2 = e0; t2 = 0; } if (t1 != 1 && e1 > v2) { v2 = e1; t2 = 1; } if (t1 != 2 && e2 > v2) { v2 = e2; t2 = 2; } if (t1 != 3 && e3 > v2) { v2 = e3; t2 = 3; }
        const float p2 = __expf(v2 - v1), w1 = gwt / (1.f + p2), w2 = gwt * p2 / (1.f + p2);
        const int lo = t1 < t2 ? t1 : t2, hi = t1 < t2 ? t2 : t1; const float wlo = t1 < t2 ? w1 : w2, whi = t1 < t2 ? w2 : w1;
        const int pi = lo == 0 ? hi - 1 : (lo == 1 ? hi + 1 : 5), bk = gs * 6 + pi;
        if (act) { const int rk = __hip_atomic_fetch_add(hist + bk, 1, __ATOMIC_RELAXED, __HIP_MEMORY_SCOPE_WORKGROUP);
            tokb[m] = bk | (rk << 8); tokr[m] = rstd; tokw[2 * m] = wlo; tokw[2 * m + 1] = whi; }
}
__device__ __forceinline__ void ph_route(const Ctx& F0, int l) {
    const Ctx F = launder(F0);
    constexpr int WLD = 1032;
    LAS bf16* Wh = (LAS bf16*)F.lds;
    LAS bf16* Wlo = Wh + 20 * WLD;
    LAS float* LG = (LAS float*)(F.lds + 4 * 20 * WLD);
    LAS int* hist = (LAS int*)(F.lds + 4 * 20 * WLD + 8 * 320 * 4);
    const float* g2 = F.in[18] + l * D;
    const f32x4* gw4 = (const f32x4*)(F.in[19] + (size_t)l * D * 4); const f32x4* rw4 = (const f32x4*)(F.in[21] + (size_t)l * 4 * D * 4);
    const float* gb_ = F.in[20] + l * 4; const float* rb_ = F.in[22] + l * 16;
    const int i16 = F.lane & 15, kq = F.lane >> 4, m0 = F.vcu * 128 + F.wave * 16;
    const u32x4* xr = (const u32x4*)(P_XB(F) + (size_t)(m0 + i16) * D) + kq;
    u32x4 xp[16];
#pragma unroll
    for (int c = 0; c < 16; ++c) xp[c] = xr[4 * c];
#pragma unroll
    for (int j = 0; j < D * 5 / NTHREADS; ++j) { const int idx = F.tid + j * NTHREADS, k = idx % D, q = j / (D / NTHREADS);
        f32x4 v = (q == 0) ? gw4[k] : rw4[(q - 1) * D + k]; v = v * g2[k];
#pragma unroll
        for (int i = 0; i < 4; ++i) { const unsigned h = f2bf(v[i]); Wh[(q * 4 + i) * WLD + k] = (bf16)h; Wlo[(q * 4 + i) * WLD + k] = (bf16)f2bf(v[i] - bf2f(h)); } }
    if (F.tid < 32) hist[F.tid] = 0;
    __syncthreads();
    int* tokb = (int*)(F.ws + WS_TOKB); float* tokr = (float*)(F.ws + WS_TOKR); float* tokw = (float*)(F.ws + WS_TOKW);
    const int c1 = 16 + (i16 & 3);
    const LAS bf16* bh0 = Wh + i16 * WLD + 8 * kq; const LAS bf16* bl0 = Wlo + i16 * WLD + 8 * kq;
    const LAS bf16* bh1 = Wh + c1 * WLD + 8 * kq;  const LAS bf16* bl1 = Wlo + c1 * WLD + 8 * kq;
    f32x4 acc0 = (f32x4){0.f, 0.f, 0.f, 0.f}, acc1 = acc0; float ss = 0.f;
    auto rstep = [&](const u32x4 xa, const int c) {
        const float x0 = bf2f(xa.x & 0xffffu), x1 = __builtin_bit_cast(float, xa.x & 0xffff0000u), x2 = bf2f(xa.y & 0xffffu), x3 = __builtin_bit_cast(float, xa.y & 0xffff0000u);
        const float x4 = bf2f(xa.z & 0xffffu), x5 = __builtin_bit_cast(float, xa.z & 0xffff0000u), x6 = bf2f(xa.w & 0xffffu), x7 = __builtin_bit_cast(float, xa.w & 0xffff0000u);
        ss += ((x0 * x0 + x1 * x1) + (x2 * x2 + x3 * x3)) + ((x4 * x4 + x5 * x5) + (x6 * x6 + x7 * x7));
        const pg8::bf16x8 av = __builtin_bit_cast(pg8::bf16x8, xa);
        const pg8::bf16x8 h0 = *(const LAS pg8::bf16x8*)(bh0 + 32 * c), l0 = *(const LAS pg8::bf16x8*)(bl0 + 32 * c);
        const pg8::bf16x8 h1 = *(const LAS pg8::bf16x8*)(bh1 + 32 * c), l1 = *(const LAS pg8::bf16x8*)(bl1 + 32 * c);
        acc0 = __builtin_amdgcn_mfma_f32_16x16x32_bf16(av, h0, acc0, 0, 0, 0); acc1 = __builtin_amdgcn_mfma_f32_16x16x32_bf16(av, h1, acc1, 0, 0, 0);
        acc0 = __builtin_amdgcn_mfma_f32_16x16x32_bf16(av, l0, acc0, 0, 0, 0); acc1 = __builtin_amdgcn_mfma_f32_16x16x32_bf16(av, l1, acc1, 0, 0, 0);
    };
#pragma unroll
    for (int c = 0; c < 16; ++c) rstep(xp[c], c);
#pragma unroll 16
    for (int c = 16; c < 32; ++c) rstep(xr[4 * c], c);
    ss += xshfl<16>(ss);
    { const unsigned u = __builtin_bit_cast(unsigned, ss); auto r = __builtin_amdgcn_permlane32_swap(u, u, false, false);
      ss = __builtin_bit_cast(float, (unsigned)r[0]) + __builtin_bit_cast(float, (unsigned)r[1]); }
    LAS float* lg = LG + F.wave * 320;
#pragma unroll
    for (int r = 0; r < 4; ++r) { lg[(4 * kq + r) * 20 + i16] = acc0[r]; if (i16 < 4) lg[(4 * kq + r) * 20 + 16 + i16] = acc1[r]; }
    asm volatile("s_waitcnt lgkmcnt(0)" ::: "memory");
    float a[20];
#pragma unroll
    for (int j = 0; j < 5; ++j) { const f32x4 t4 = *(const LAS f32x4*)(lg + i16 * 20 + 4 * j); a[4 * j] = t4[0]; a[4 * j + 1] = t4[1]; a[4 * j + 2] = t4[2]; a[4 * j + 3] = t4[3]; }
    route_finish(a, ss, m0 + i16, kq == 0, gb_, rb_, tokb, tokr, tokw, hist);
    __syncthreads();
    if (F.tid < 24) __hip_atomic_store((int*)(F.ws + WS_WGCNT) + F.vcu * 24 + F.tid, hist[F.tid], __ATOMIC_RELAXED, __HIP_MEMORY_SCOPE_AGENT);
}
__device__ __forceinline__ void ph_place(const Ctx& F0) {
    const Ctx F = launder(F0);
    LAS int* ptot = (LAS int*)F.lds;
    LAS int* pbef = ptot + 512;
    LAS int* bstart = pbef + 512;
    LAS int* btot = bstart + 32;
    LAS int* carry = btot + 32;
    LAS int* rowidx = carry + 32;
    const int* wgcnt = (const int*)(F.ws + WS_WGCNT);
    int* rowtok = (int*)(F.ws + WS_ROWTOK); float* roww = (float*)(F.ws + WS_ROWW); int* tileb = (int*)(F.ws + WS_TILEB);
    const int* tokb = (const int*)(F.ws + WS_TOKB); const float* tokr = (const float*)(F.ws + WS_TOKR); const float* tokw = (const float*)(F.ws + WS_TOKW);
    const int li = F.wave * 16 + (F.lane & 15), m = F.vcu * 128 + li;
    const int tb = tokb[m]; const float rstd = tokr[m]; const float wlo_ = tokw[2 * m], whi_ = tokw[2 * m + 1];
    { const int p = F.tid >> 5, b = F.tid & 31; int tot = 0, bef = 0;
      if (b < 24)
#pragma unroll
        for (int i = 0; i < 16; ++i) { const int v = p * 16 + i; const int c = wgcnt[v * 24 + b]; tot += c; if (v < F.vcu) bef += c; }
      ptot[p * 32 + b] = tot; pbef[p * 32 + b] = bef; }
    __syncthreads();
    if (F.tid < 64) { const int b = F.tid & 31; int tot = 0, bef = 0;
#pragma unroll
        for (int p = 0; p < 16; ++p) { tot += ptot[p * 32 + b]; bef += pbef[p * 32 + b]; }
        const int pad = (F.tid < 24) ? ((tot + 255) & ~255) : 0; int inc = pad;
#pragma unroll
        for (int d = 1; d < 32; d <<= 1) { const int o = __builtin_amdgcn_ds_bpermute((F.tid - d) * 4, inc); if (F.tid >= d) inc += o; }
        if (F.tid < 32) { btot[F.tid] = tot; bstart[F.tid] = inc - pad; carry[F.tid] = bef + inc - pad; } }
    __syncthreads();
    if (F.vcu == 0) {
        const int nt = bstart[24] >> 8;
        if (F.tid == 0) tileb[0] = nt;
        for (int t = F.tid; t < nt; t += NTHREADS) { int b = 0;
#pragma unroll
            for (int q = 1; q < 24; ++q) b += (bstart[q] <= t * 256) ? 1 : 0;
            tileb[1 + t] = b; }
        for (int b = F.wave; b < 24; b += 8) { const int s = bstart[b], e = bstart[b + 1];
            for (int r = s + btot[b] + F.lane; r < e; r += 64) __hip_atomic_store(rowtok + r, -1, __ATOMIC_RELAXED, __HIP_MEMORY_SCOPE_AGENT); }
    }
    __syncthreads();
    if (F.lane < 16) { const int row = carry[tb & 255] + (tb >> 8);
        const unsigned long long w2 = (unsigned long long)__builtin_bit_cast(unsigned, wlo_) | ((unsigned long long)__builtin_bit_cast(unsigned, whi_) << 32);
        __hip_atomic_store(rowtok + row, m, __ATOMIC_RELAXED, __HIP_MEMORY_SCOPE_AGENT);
        __hip_atomic_store((unsigned long long*)(roww + 2 * row), w2, __ATOMIC_RELAXED, __HIP_MEMORY_SCOPE_AGENT);
        __hip_atomic_store((float*)(F.ws + WS_ROWR) + row, rstd, __ATOMIC_RELAXED, __HIP_MEMORY_SCOPE_AGENT); }
}
struct MoeOrder {
    int G, c; bool down; int NT, bks;
    __device__ __forceinline__ void init(const int* tileb) {
        const GAS int* tb_ = (const GAS int*)tileb;
        const int nt_ = tb_[0]; int r0 = c >> 2, r1 = (G + c) >> 2, r2 = (2 * G + c) >> 2, r3 = (3 * G + c) >> 2;
        r0 = r0 < MOE_MAXT ? r0 : MOE_MAXT - 1; r1 = r1 < MOE_MAXT ? r1 : MOE_MAXT - 1; r2 = r2 < MOE_MAXT ? r2 : MOE_MAXT - 1; r3 = r3 < MOE_MAXT ? r3 : MOE_MAXT - 1;
        const int b0 = tb_[1 + r0], b1 = tb_[1 + r1], b2 = tb_[1 + r2], b3 = tb_[1 + r3];
        int n_ = __builtin_amdgcn_readfirstlane(nt_), p_ = __builtin_amdgcn_readfirstlane((b0 & 255) | ((b1 & 255) << 8) | ((b2 & 255) << 16) | ((b3 & 255) << 24));
        asm volatile("" : "+s"(n_), "+s"(p_)); NT = n_; bks = p_;
    }
    __device__ __forceinline__ bool next(int i, pg8::Unit& u) const {
        const int L = i * G + c; if (i > 3 || L >= NT * 4) return false;
        const int rt = L >> 2, pn = L & 3, b = (bks >> (8 * i)) & 255;
        if (down) { int ea, eb; pair_decode(b % 6, ea, eb); u.pm = rt; u.pn = ((b / 6) * 4 + ea) * 4 + pn; u.pn2 = ((b / 6) * 4 + eb) * 4 + pn; u.aux = pn; }
        else { int ea, eb; pair_decode(b % 6, ea, eb); const int e = (b / 6) * 4 + (pn < 2 ? ea : eb); u.pm = rt; u.pn = e * 2 + (pn & 1); u.aux = pn; }
        return true;
    }
};
struct EpiGU {
    static constexpr bool PERM = true;
    bf16* H; const float* roww; const float* rowr;
    __device__ __forceinline__ void operator()(const f32x4 (&acc)[2][2][4][2], const pg8::Unit& u, int wr, int wc, int fr_, int fq_) const {
        const int ln_ = lane_id(), fr = ln_ & 15, fq = ln_ >> 4; (void)fr_; (void)fq_;
        const int row0 = u.pm * 256 + wr * 64 + fr, cl = u.aux * 128 + 16 * wc + 4 * fq, ws = u.aux >> 1;
        float rrv[8], wv[8];
#pragma unroll
        for (int i = 0; i < 8; ++i) { const int r = row0 + (i >> 2) * 128 + (i & 3) * 16; rrv[i] = ((const GAS float*)rowr)[r]; wv[i] = ((const GAS float*)roww)[2 * r + ws]; }
#pragma unroll
        for (int ai = 0; ai < 2; ++ai)
#pragma unroll
            for (int m = 0; m < 4; ++m) { const int r = row0 + ai * 128 + m * 16; const float rr = rrv[ai * 4 + m], w = wv[ai * 4 + m] * rr;
#pragma unroll
                for (int bj = 0; bj < 2; ++bj) { const f32x4 g = acc[ai][bj][m][0], up = acc[ai][bj][m][1]; f32x4 a;
#pragma unroll
                    for (int i = 0; i < 4; ++i) { const float gg = g[i] * rr; a[i] = gg * sigmoidf_(gg) * up[i] * w; }
                    u32x2 o; o.x = pg8::cvt_pk_bf16(a[0], a[1]); o.y = pg8::cvt_pk_bf16(a[2], a[3]);
                    *(GAS u32x2*)(H + (size_t)r * 512 + cl + bj * 64) = o; } }
    }
};
struct EpiDown {
    static constexpr bool PERM = true;
    bf16* RB; const int* rowtok;
    __device__ __forceinline__ void operator()(const f32x4 (&acc)[2][2][4][2], const pg8::Unit& u, int wr, int wc, int fr_, int fq_) const {
        const int ln_ = lane_id(), fr = ln_ & 15, fq = ln_ >> 4; (void)fr_; (void)fq_;
        const int row0 = u.pm * 256 + wr * 64 + fr, col0 = u.aux * 256 + wc * 32 + 8 * fq;
        int tok[8];
#pragma unroll
        for (int i = 0; i < 8; ++i) tok[i] = rowtok[row0 + (i >> 2) * 128 + (i & 3) * 16];
#pragma unroll
        for (int ai = 0; ai < 2; ++ai) { u32x4 x[4][2];
#pragma unroll
            for (int m = 0; m < 4; ++m) { const int tk = tok[ai * 4 + m]; const bf16* rp = RB + (size_t)(tk < 0 ? 0 : tk) * D + col0; x[m][0] = *(const u32x4*)rp; x[m][1] = *(const u32x4*)(rp + 128); }
#pragma unroll
            for (int m = 0; m < 4; ++m) { const int tk = tok[ai * 4 + m]; bf16* rp = RB + (size_t)(tk < 0 ? 0 : tk) * D + col0;
#pragma unroll
                for (int bj = 0; bj < 2; ++bj) { const u32x4 xx = x[m][bj]; const f32x4 a0 = acc[ai][bj][m][0], a1 = acc[ai][bj][m][1]; u32x4 w;
                    w.x = pg8::cvt_pk_bf16(bf2f(xx.x & 0xffffu) + a0[0], bf2f(xx.x >> 16) + a0[1]); w.y = pg8::cvt_pk_bf16(bf2f(xx.y & 0xffffu) + a0[2], bf2f(xx.y >> 16) + a0[3]);
                    w.z = pg8::cvt_pk_bf16(bf2f(xx.z & 0xffffu) + a1[0], bf2f(xx.z >> 16) + a1[1]); w.w = pg8::cvt_pk_bf16(bf2f(xx.w & 0xffffu) + a1[2], bf2f(xx.w >> 16) + a1[3]);
                    if (tk >= 0) *(u32x4*)(rp + bj * 128) = w; } }
            asm volatile("" ::: "memory"); }
    }
};

struct SsmOrder { int G, c, mode;
    __device__ __forceinline__ bool next(int i, pg8::Unit& u) const { const int L = i * G + c;
        if (mode == 1) { if (L >= 32) return false; u.pm = L; u.pn = L >> 1; u.aux = 0; return true; }
        if (L >= 128) return false; const int g = L >> 3; u.pm = g * 2 + ((L >> 2) & 1); u.pn = g * 4 + (L & 3); u.aux = L & 3; u.kt = 2 + 4 * ((L & 3) + 1); return true; } };
struct HalfOrder { int L;
    __device__ __forceinline__ bool next(int i, pg8::Unit& u) const { if (i > 0 || L < 0 || L >= 128) return false; u.pm = L; u.pn = 0; u.aux = 0; return true; } };
struct EpiZ { static constexpr bool PERM = false; float* ZB;
    __device__ __forceinline__ void operator()(const f32x4 (&acc)[2][2][4][2], const pg8::Unit& u, int wr, int wc, int fr_, int fq_) const {
        const int ln_ = lane_id(), fr = ln_ & 15, fq = ln_ >> 4; (void)fr_; (void)fq_;
        const int row0 = u.pm * 256 + wr * 64 + fr, col0 = wc * 32 + 4 * fq;
#pragma unroll
        for (int ai = 0; ai < 2; ++ai)
#pragma unroll
            for (int m = 0; m < 4; ++m)
#pragma unroll
                for (int n = 0; n < 2; ++n) *(GAS f32x4*)(ZB + (size_t)(row0 + ai * 128 + m * 16) * 128 + col0 + n * 16) = acc[ai][0][m][n];
    } };
struct EpiSsm2 { static constexpr bool PERM = true; bf16* YS;
    __device__ __forceinline__ void operator()(const f32x4 (&acc)[2][2][4][2], const pg8::Unit& u, int wr, int wc, int fr_, int fq_) const {
        const int ln_ = lane_id(), fr = ln_ & 15, fq = ln_ >> 4; (void)fr_; (void)fq_;
        const int g = u.pm >> 1, cr0 = (u.pm & 1) * 256 + wr * 64 + fr;
#pragma unroll
        for (int bj = 0; bj < 2; ++bj) { const int n0 = u.aux * 256 + bj * 128 + wc * 32 + 8 * fq, to = n0 >> 4, ho0 = n0 & 15;
#pragma unroll
            for (int ai = 0; ai < 2; ++ai)
#pragma unroll
                for (int m = 0; m < 4; ++m) { const int cr = cr0 + ai * 128 + m * 16;
                    const f32x4 a0 = acc[ai][bj][m][0], a1 = acc[ai][bj][m][1]; u32x4 w;
                    w.x = pg8::cvt_pk_bf16(gelu_tanh(a0[0]), gelu_tanh(a0[1])); w.y = pg8::cvt_pk_bf16(gelu_tanh(a0[2]), gelu_tanh(a0[3]));
                    w.z = pg8::cvt_pk_bf16(gelu_tanh(a1[0]), gelu_tanh(a1[1])); w.w = pg8::cvt_pk_bf16(gelu_tanh(a1[2]), gelu_tanh(a1[3]));
                    *(u32x4*)(YS + ((size_t)cr * 64 + to) * 256 + g * 16 + ho0) = w; } }
    } };
struct EpiGluE { static constexpr bool PERM = true; const bf16* YS; bf16* YMIX; const float* gb;
    __device__ __forceinline__ void operator()(const f32x4 (&acc)[2][2][4][2], const pg8::Unit& u, int wr, int wc, int fr_, int fq_) const {
        const int ln_ = lane_id(), fr = ln_ & 15, fq = ln_ >> 4; (void)fr_; (void)fq_;
        const int row0 = u.pm * 256 + wr * 64 + fr;
#pragma unroll
        for (int bj = 0; bj < 2; ++bj) { const int n0 = bj * 128 + wc * 32 + 8 * fq; const f32x4 b0 = *(const f32x4*)(gb + n0), b1 = *(const f32x4*)(gb + n0 + 4);
#pragma unroll
            for (int ai = 0; ai < 2; ++ai)
#pragma unroll
                for (int m = 0; m < 4; ++m) { const size_t r = (size_t)(row0 + ai * 128 + m * 16); const u32x4 yy = *(const u32x4*)(YS + r * 256 + n0);
                    const f32x4 a0 = acc[ai][bj][m][0] + b0, a1 = acc[ai][bj][m][1] + b1; float o[8];
                    o[0] = bf2f(yy.x & 0xffffu) * sigmoidf_(a0[0]); o[1] = bf2f(yy.x >> 16) * sigmoidf_(a0[1]); o[2] = bf2f(yy.y & 0xffffu) * sigmoidf_(a0[2]); o[3] = bf2f(yy.y >> 16) * sigmoidf_(a0[3]);
                    o[4] = bf2f(yy.z & 0xffffu) * sigmoidf_(a1[0]); o[5] = bf2f(yy.z >> 16) * sigmoidf_(a1[1]); o[6] = bf2f(yy.w & 0xffffu) * sigmoidf_(a1[2]); o[7] = bf2f(yy.w >> 16) * sigmoidf_(a1[3]);
                    u32x4 w; w.x = pg8::cvt_pk_bf16(o[0], o[1]); w.y = pg8::cvt_pk_bf16(o[2], o[3]); w.z = pg8::cvt_pk_bf16(o[4], o[5]); w.w = pg8::cvt_pk_bf16(o[6], o[7]);
                    *(u32x4*)(YMIX + r * 1024 + n0) = w; } }
    } };
struct EpiPoolE { static constexpr bool PERM = true; bf16* YMIX; const float* pb; const float* ps;
    __device__ __forceinline__ void operator()(const f32x4 (&acc)[2][2][4][2], const pg8::Unit& u, int wr, int wc, int fr_, int fq_) const {
        const int ln_ = lane_id(), fr = ln_ & 15, fq = ln_ >> 4; (void)fr_; (void)fq_;
        const int row0 = u.pm * 256 + wr * 64 + fr;
#pragma unroll
        for (int bj = 0; bj < 2; ++bj) { const int n0 = bj * 128 + wc * 32 + 8 * fq; const f32x4 b0 = *(const f32x4*)(pb + n0), b1 = *(const f32x4*)(pb + n0 + 4), s0 = *(const f32x4*)(ps + n0), s1 = *(const f32x4*)(ps + n0 + 4);
#pragma unroll
            for (int ai = 0; ai < 2; ++ai)
#pragma unroll
                for (int m = 0; m < 4; ++m) { const size_t r = (size_t)(row0 + ai * 128 + m * 16);
                    const f32x4 a0 = (acc[ai][bj][m][0] + b0) * s0, a1 = (acc[ai][bj][m][1] + b1) * s1;
                    u32x4 w; w.x = pg8::cvt_pk_bf16(a0[0], a0[1]); w.y = pg8::cvt_pk_bf16(a0[2], a0[3]); w.z = pg8::cvt_pk_bf16(a1[0], a1[1]); w.w = pg8::cvt_pk_bf16(a1[2], a1[3]);
                    *(u32x4*)(YMIX + r * 1024 + 256 + n0) = w; } }
    } };
__device__ __forceinline__ void ph_tg_expand(const Ctx& F0, int l, int bx, int w0) {
    const Ctx F = launder(F0);
    if (bx < w0) return;
    const int gw = (bx - w0) * NWAVES + F.wave, NGW = (F.G - w0) * NWAVES;
    const bf16* KT = (const bf16*)(F.ws + WS_KT) + (size_t)l * SGN * 64 * 256;
    bf16* TG0 = (bf16*)(F.ws + WS_TG) + (size_t)l * SGN * 1024 * UGP;
#pragma unroll 2
    for (int r = gw; r < SGN * 1024; r += NGW) { const int g = r >> 10, n = r & 1023, to = n >> 4, ho = n & 15;
        bf16* d = TG0 + ((size_t)g * 1024 + n) * UGP;
#pragma unroll
        for (int half = 0; half < 2; ++half) { const int ti = half * 32 + (F.lane >> 1), tau = to - ti;
            u32x4 v = (u32x4){0u, 0u, 0u, 0u};
            if (tau >= 0) v = *(const u32x4*)(KT + (((size_t)g * 64 + tau) * 16 + ho) * 16 + (F.lane & 1) * 8);
            if (half * 512 + F.lane * 8 < ((n >> 8) + 1) * 256) *(u32x4*)(d + UOF + half * 512 + F.lane * 8) = v; } }
}
__device__ __forceinline__ void ph_ssm_scan(const Ctx& F0, int l) {
    const Ctx F = launder(F0);
    if (F.wave != 0 || (F.vcu & 1) != 0 || F.vcu >= 256) return;
    for (int it = (F.vcu >> 2) * 2 + ((F.vcu >> 1) & 1); it < SGN * NB; it += SGN * NB) {
        const int g = it >> 3, b = it & 7, p = F.lane;
        const float are = F.in[4][(l * SGN + g) * SP + p], aim = F.in[5][(l * SGN + g) * SP + p], dt = expf(F.in[6][l * SGN + g]);
        float sn, cs; sincosf(aim * dt * 64.f, &sn, &cs); const float mg = expf(are * dt * 64.f), lr = mg * cs, li = mg * sn;
        const float* Z = (const float*)(F.ws + WS_ZB) + ((size_t)g * 512 + b * 64) * 128;
        bf16* U = P_UG(F) + ((size_t)g * 512 + b * 64) * UGP;
        float sr = 0.f, si = 0.f;
#pragma unroll 1
        for (int c0 = 0; c0 < 64; c0 += 32) {
            float zr[32], zi[32];
#pragma unroll
            for (int j = 0; j < 32; ++j) { zr[j] = Z[(c0 + j) * 128 + p]; zi[j] = Z[(c0 + j) * 128 + 64 + p]; }
#pragma unroll
            for (int j = 0; j < 32; ++j) {
                U[(size_t)(c0 + j) * UGP + p] = (bf16)f2bf(sr); U[(size_t)(c0 + j) * UGP + 64 + p] = (bf16)f2bf(si);
                const float nr = lr * sr - li * si + zr[j], ni = lr * si + li * sr + zi[j]; sr = nr; si = ni; }
        }
    }
}

namespace moba {
using bf16x8 = __attribute__((ext_vector_type(8))) short;
using s16x4 = __attribute__((ext_vector_type(4))) short;
using f32x16 = __attribute__((ext_vector_type(16))) float;
typedef short v4i16_t __attribute__((ext_vector_type(4)));
typedef float f32x2_t __attribute__((ext_vector_type(2))); typedef __bf16 bf16x2_t __attribute__((ext_vector_type(2)));
constexpr int L_K = 0, L_V = 49152, L_TB = 98304, L_KM = L_TB + 4 * 772 * 4, L_END = L_KM + 16 * 64 * 4;
__device__ __forceinline__ unsigned cvtpk(float lo, float hi) { f32x2_t v = {lo, hi}; bf16x2_t b = __builtin_convertvector(v, bf16x2_t); return __builtin_bit_cast(unsigned, b); }
__device__ __forceinline__ s16x4 vtr(const LAS char* p) { return __builtin_bit_cast(s16x4, __builtin_amdgcn_ds_read_tr16_b64_v4i16((LAS v4i16_t*)p)); }
__device__ __forceinline__ float hmax(float v) { const unsigned u = __builtin_bit_cast(unsigned, v); auto r = __builtin_amdgcn_permlane32_swap(u, u, false, false); return fmaxf(__builtin_bit_cast(float, (unsigned)r[0]), __builtin_bit_cast(float, (unsigned)r[1])); }
__device__ __forceinline__ float hsum(float v) { const unsigned u = __builtin_bit_cast(unsigned, v); auto r = __builtin_amdgcn_permlane32_swap(u, u, false, false); return __builtin_bit_cast(float, (unsigned)r[0]) + __builtin_bit_cast(float, (unsigned)r[1]); }

constexpr int L_LIST = L_END, L_WCNT = 32768;
#define MOBA_CVEC() f32x16 cvec; do { const float ci_ = bfar - mref; _Pragma("unroll") for (int r = 0; r < 16; ++r) cvec[r] = ci_; } while (0)
#define MOBA_QK(P0, P1, KB) do { { const bf16x8 a0 = *(const LAS bf16x8*)(kp0 + (KB)), a1 = *(const LAS bf16x8*)(kp0 + (KB) + 512); \
          P0 = __builtin_amdgcn_mfma_f32_32x32x16_bf16(a0, qr[0], cvec, 0, 0, 0); P1 = __builtin_amdgcn_mfma_f32_32x32x16_bf16(a1, qr[0], cvec, 0, 0, 0); } \
        _Pragma("unroll") for (int d0 = 1; d0 < 4; ++d0) { const bf16x8 a0 = *(const LAS bf16x8*)(kp0 + (KB) + d0 * 2048), a1 = *(const LAS bf16x8*)(kp0 + (KB) + d0 * 2048 + 512); \
            P0 = __builtin_amdgcn_mfma_f32_32x32x16_bf16(a0, qr[d0], P0, 0, 0, 0); P1 = __builtin_amdgcn_mfma_f32_32x32x16_bf16(a1, qr[d0], P1, 0, 0, 0); } } while (0)
#define MOBA_NEARMAX(P0, P1, JN, OUT) do { const int jn_ = (JN); if (jn_ >= 0) { const int A_ = qrel - 64 * (jn_ - 4) - 4 * hi + 256, s_ = 767 - A_, c_ = s_ & 3; \
            const LAS f32x4* t4 = (const LAS f32x4*)(tb + c_ * 772 + (s_ - c_)); \
            _Pragma("unroll") for (int g = 0; g < 4; ++g) { const f32x4 x0 = t4[2 * g], x1 = t4[2 * g + 8]; \
                _Pragma("unroll") for (int j = 0; j < 4; ++j) { P0[4 * g + j] += x0[j]; P1[4 * g + j] += x1[j]; } } } \
        float ra = __builtin_fmaxf(__builtin_fmaxf(P0[0], P0[1]), P1[0]), rb = __builtin_fmaxf(__builtin_fmaxf(P0[2], P0[3]), P1[1]); \
        ra = __builtin_fmaxf(__builtin_fmaxf(ra, P1[2]), P1[3]); \
        _Pragma("unroll") for (int r = 4; r < 16; r += 4) { ra = __builtin_fmaxf(__builtin_fmaxf(ra, P0[r]), P0[r + 1]); rb = __builtin_fmaxf(__builtin_fmaxf(rb, P0[r + 2]), P0[r + 3]); \
            ra = __builtin_fmaxf(__builtin_fmaxf(ra, P1[r]), P1[r + 1]); rb = __builtin_fmaxf(__builtin_fmaxf(rb, P1[r + 2]), P1[r + 3]); } \
        OUT = hmax(__builtin_fmaxf(ra, rb)); } while (0)
#define MOBA_STEP(PC0, PC1, PN0, PN1, JNN, KBN, VBC, HASN) do { \
        bf16x8 vf[8], kf[8]; \
        if (HASN) { _Pragma("unroll") for (int d0 = 0; d0 < 4; ++d0) { kf[2 * d0] = *(const LAS bf16x8*)(kp0 + (KBN) + d0 * 2048); kf[2 * d0 + 1] = *(const LAS bf16x8*)(kp0 + (KBN) + d0 * 2048 + 512); } } \
        __builtin_amdgcn_sched_barrier(0); \
        if (__any(rm > 8.f)) { const float dl = __builtin_fmaxf(rm, 0.f), alpha = __builtin_amdgcn_exp2f(-dl); mref += dl; l *= alpha; \
            _Pragma("unroll") for (int r = 0; r < 16; ++r) { PC0[r] -= dl; PC1[r] -= dl; o0[r] *= alpha; o1[r] *= alpha; } } \
        if (HASN) { MOBA_CVEC(); \
                    PN0 = __builtin_amdgcn_mfma_f32_32x32x16_bf16(kf[0], qr[0], cvec, 0, 0, 0); PN1 = __builtin_amdgcn_mfma_f32_32x32x16_bf16(kf[1], qr[0], cvec, 0, 0, 0); \
                    _Pragma("unroll") for (int d0 = 1; d0 < 4; ++d0) { PN0 = __builtin_amdgcn_mfma_f32_32x32x16_bf16(kf[2 * d0], qr[d0], PN0, 0, 0, 0); PN1 = __builtin_amdgcn_mfma_f32_32x32x16_bf16(kf[2 * d0 + 1], qr[d0], PN1, 0, 0, 0); } } \
        { const LAS char* vp = vp0 + (VBC); \
        _Pragma("unroll") for (int k = 0; k < 4; ++k) { \
            const s16x4 lo0 = vtr(vp + k * 1024), hi0 = vtr(vp + k * 1024 + 512), lo1 = vtr(vp + 4096 + k * 1024), hi1 = vtr(vp + 4096 + k * 1024 + 512); \
            vf[2 * k] = (bf16x8){lo0[0], lo0[1], lo0[2], lo0[3], hi0[0], hi0[1], hi0[2], hi0[3]}; vf[2 * k + 1] = (bf16x8){lo1[0], lo1[1], lo1[2], lo1[3], hi1[0], hi1[1], hi1[2], hi1[3]}; } } \
        __builtin_amdgcn_sched_barrier(0); \
        float s0 = 0.f, s1 = 0.f; u32x4 pw[4]; \
        _Pragma("unroll") for (int r = 0; r < 16; ++r) { PC0[r] = __builtin_amdgcn_exp2f(PC0[r]); PC1[r] = __builtin_amdgcn_exp2f(PC1[r]); s0 += PC0[r]; s1 += PC1[r]; } \
        l += s0 + s1; \
        _Pragma("unroll") for (int q = 0; q < 4; ++q) { pw[0][q] = cvtpk(PC0[2 * q], PC0[2 * q + 1]); pw[1][q] = cvtpk(PC0[8 + 2 * q], PC0[9 + 2 * q]); pw[2][q] = cvtpk(PC1[2 * q], PC1[2 * q + 1]); pw[3][q] = cvtpk(PC1[8 + 2 * q], PC1[9 + 2 * q]); } \
        _Pragma("unroll") for (int k = 0; k < 4; ++k) { const bf16x8 pa = __builtin_bit_cast(bf16x8, pw[k]); \
            o0 = __builtin_amdgcn_mfma_f32_32x32x16_bf16(vf[2 * k], pa, o0, 0, 0, 0); o1 = __builtin_amdgcn_mfma_f32_32x32x16_bf16(vf[2 * k + 1], pa, o1, 0, 0, 0); } \
        if (HASN) MOBA_NEARMAX(PN0, PN1, JNN, rm); \
    } while (0)
#define MOBA_BLOCK4(JN0, PRE4) \
    float mref = 0.f, l = 0.f; f32x16 o0 = f32x16{}, o1 = f32x16{}; f32x16 pa0, pa1, pb0, pb1; float rm; \
    { const int jn0_ = (JN0); \
      { MOBA_CVEC(); MOBA_QK(pa0, pa1, 0); } MOBA_NEARMAX(pa0, pa1, jn0_, rm); \
      MOBA_STEP(pa0, pa1, pb0, pb1, (jn0_ < 0 ? -1 : jn0_ + 1), 8192, 0, true); \
      MOBA_STEP(pb0, pb1, pa0, pa1, (jn0_ < 0 ? -1 : jn0_ + 2), 16384, 8192, true); \
      MOBA_STEP(pa0, pa1, pb0, pb1, (jn0_ < 0 ? -1 : jn0_ + 3), 24576, 16384, true); \
      PRE4; \
      MOBA_STEP(pb0, pb1, pa0, pa1, -1, 0, 24576, false); }
#define MOBA_BLOCKC(NST) \
    float mref = 0.f, l = 0.f; f32x16 o0 = f32x16{}, o1 = f32x16{}; f32x16 pa0, pa1, pb0, pb1; float rm; \
    { const int nst_ = (NST); \
      { MOBA_CVEC(); MOBA_QK(pa0, pa1, 0); } MOBA_NEARMAX(pa0, pa1, 4, rm); \
      MOBA_STEP(pa0, pa1, pb0, pb1, 5, 8192, 0, (nst_ > 1)); \
      if (nst_ > 1) { MOBA_STEP(pb0, pb1, pa0, pa1, 6, 16384, 8192, (nst_ > 2)); } \
      if (nst_ > 2) { MOBA_STEP(pa0, pa1, pb0, pb1, 7, 24576, 16384, (nst_ > 3)); } \
      if (nst_ > 3) { MOBA_STEP(pb0, pb1, pa0, pa1, -1, 0, 24576, false); } }
__device__ __forceinline__ int kpiece_off(int kk, int c8) { return c8 * 1024 + kk * 16; }
__device__ __forceinline__ int vpiece_off(int kk, int c8) { return ((kk >> 4) + 4 * (c8 >> 2)) * 1024 + ((kk & 15) * 4 + (c8 & 3)) * 16; }
__device__ __forceinline__ void load_block(const bf16* K, const bf16* V, size_t row0, int h, int wid, int lane, LAS char* lds) {
    const int kk = wid * 8 + (lane >> 3), c8 = lane & 7;
    const bf16* ksrc = K + (row0 + kk) * 512 + h * 64 + c8 * 8;
    const bf16* vsrc = V + (row0 + kk) * 512 + h * 64 + c8 * 8;
    u32x4 kr[4], vr[4];
#pragma unroll
    for (int t = 0; t < 4; ++t) { kr[t] = *(const GAS u32x4*)(ksrc + (size_t)t * 64 * 512); vr[t] = *(const GAS u32x4*)(vsrc + (size_t)t * 64 * 512); }
    LAS char* kd = lds + L_K + kpiece_off(kk, c8); LAS char* vd = lds + L_V + vpiece_off(kk, c8);
#pragma unroll
    for (int t = 0; t < 4; ++t) { *(LAS u32x4*)(kd + t * 8192) = kr[t]; *(LAS u32x4*)(vd + t * 8192) = vr[t]; }
}
__device__ __forceinline__ void fill_bias_table(const float* BT, int h, int tid, LAS float* tb) {
    const float bfar = BT[h * 132 + 128];
    for (int i = tid; i < 4 * 768; i += NTHREADS) { const int c = i / 768, j = i % 768, src_ = 767 - (j + c), rel = src_ - 256; tb[c * 772 + j] = (src_ < 0 || rel < 0) ? -1.0e30f : (rel < 128 ? BT[h * 132 + rel] - bfar : 0.f); }
}
__device__ __forceinline__ void sel_phase(int wave_, int vcu, int G, const bf16* Q, const float* KMP, unsigned* SEL, LAS char* lds) {
    const int w0 = G > 64 ? 32 : 0, nw = G - w0; if (vcu < w0) return;
    int lane_ = lane_id(); asm volatile("" : "+v"(lane_)); asm volatile("" : "+s"(wave_));
    const int wid = wave_, lane = lane_, tid = wid * 64 + lane, r32 = lane & 31, hi = lane >> 5;
    const int ub = ((vcu - w0) * 1024) / nw, ue = ((vcu - w0 + 1) * 1024) / nw;
    LAS float* km = (LAS float*)(lds + L_KM);
    int bhc = -1;
    bf16x8 qn[4];
#define MOBA_SFETCH(U) do { const int bh_ = (U) >> 4; const bf16* qw_ = Q + ((size_t)(bh_ >> 3) * SEQ + ((U) & 15) * 256 + wid * 32 + r32) * 512 + (bh_ & 7) * 64 + hi * 8; \
        _Pragma("unroll") for (int d0 = 0; d0 < 4; ++d0) qn[d0] = *(const GAS bf16x8*)(qw_ + d0 * 16); } while (0)
    if (ub < ue) MOBA_SFETCH(ub);
#pragma unroll 1
    for (int u = ub; u < ue; ++u) {
        const int bh = u >> 4, qb = u & 15, b = bh >> 3, h = bh & 7;
        if (bh != bhc) { bhc = bh;
            __syncthreads();
            for (int i = tid; i < 16 * 64; i += NTHREADS) { const int j = i >> 6, d = i & 63, pm = b * 16 + j; km[i] = KMP[pm * 512 + h * 64 + d] + KMP[128 * 512 + pm * 512 + h * 64 + d]; }
            __syncthreads(); }
        asm volatile("" ::: "memory");
        const int q = qb * 256 + wid * 32 + r32;
        bf16x8 qr[4];
#pragma unroll
        for (int d0 = 0; d0 < 4; ++d0) qr[d0] = qn[d0];
        { const int un = u + 1 < ue ? u + 1 : u; MOBA_SFETCH(un); }
        float g[16];
#pragma unroll
        for (int j = 0; j < 16; ++j) g[j] = 0.f;
#pragma unroll
        for (int d0 = 0; d0 < 4; ++d0)
#pragma unroll
            for (int j = 0; j < 16; ++j) { const f32x4 ka = *(const LAS f32x4*)(km + j * 64 + d0 * 16 + hi * 8), kb4 = *(const LAS f32x4*)(km + j * 64 + d0 * 16 + hi * 8 + 4);
#pragma unroll
                for (int e = 0; e < 4; ++e) { g[j] += bf2f((unsigned)(unsigned short)qr[d0][e]) * ka[e]; }
#pragma unroll
                for (int e = 0; e < 4; ++e) { g[j] += bf2f((unsigned)(unsigned short)qr[d0][4 + e]) * kb4[e]; } }
#pragma unroll
        for (int j = 0; j < 16; ++j) g[j] = hsum(g[j]);
        unsigned selmask = 0u;
#pragma unroll
        for (int s3 = 0; s3 < 3; ++s3) { float bv = -3.0e38f; int bi = -1;
#pragma unroll
            for (int j = 0; j < 16; ++j) { const bool ok = (j < qb) && !((selmask >> j) & 1u) && (g[j] > bv); bv = ok ? g[j] : bv; bi = ok ? j : bi; }
            if (bi >= 0) selmask |= 1u << bi; }
        if (hi == 0) SEL[(size_t)bh * SEQ + q] = selmask;
    }
#undef MOBA_SFETCH
}
__device__ __forceinline__ bf16* pslot(int slot, size_t t, int h, bf16* YM, bf16* P2A, bf16* P2B) {
    return slot == 0 ? YM + t * 1024 + h * 64 : slot == 1 ? YM + t * 1024 + 512 + h * 64 : (t < (size_t)(T / 2) ? P2A + t * 512 : P2B + (t - (size_t)(T / 2)) * 512) + h * 64;
}
__device__ __forceinline__ void gather_phase(int wave_, int vcu, const bf16* Q, const bf16* K, const bf16* V, bf16* YM, bf16* P2A, bf16* P2B, float* ML, const unsigned* SEL, const float* BT, LAS char* lds) {
    if (vcu >= 256) return;
    int lane_ = lane_id(); asm volatile("" : "+v"(lane_)); asm volatile("" : "+s"(wave_));
    const int wid = wave_, lane = lane_, tid = wid * 64 + lane, r32 = lane & 31, hi = lane >> 5;
    const int bh = vcu >> 2, s = vcu & 3, b = bh >> 3, h = bh & 7;
    const size_t rowbase = (size_t)b * SEQ;
    LAS float* tb = (LAS float*)(lds + L_TB); LAS int* list = (LAS int*)(lds + L_LIST); LAS int* wcnt = (LAS int*)(lds + L_WCNT);
    const float bfar = BT[h * 132 + 128];
    fill_bias_table(BT, h, tid, tb);
    const unsigned* selrow = SEL + (size_t)bh * SEQ;
    const LAS char* kp0 = lds + L_K + hi * 1024 + r32 * 16;
    const LAS char* vp0 = lds + L_V + ((lane >> 4) & 1) * 32 + (lane & 3) * 8 + (4 * hi + ((lane & 15) >> 2)) * 64;
    const unsigned code = s == 0 ? 0xFFFB60u : s == 1 ? 0xFFE971u : s == 2 ? 0xFFCA52u : 0xFFD843u;
    u32x4 kr[4], vr[4]; unsigned msel[8];
#define MOBA_GFETCH(KB) do { const size_t row0 = rowbase + (size_t)(KB) * 256; int lg_ = lane_id(); asm volatile("" : "+v"(lg_));     \
        const bf16* ksrc = K + (row0 + wid * 8 + (lg_ >> 3)) * 512 + h * 64 + (lg_ & 7) * 8; \
        const bf16* vsrc = V + (row0 + wid * 8 + (lg_ >> 3)) * 512 + h * 64 + (lg_ & 7) * 8; \
        _Pragma("unroll") for (int t = 0; t < 4; ++t) { kr[t] = *(const GAS u32x4*)(ksrc + (size_t)t * 64 * 512); vr[t] = *(const GAS u32x4*)(vsrc + (size_t)t * 64 * 512); } \
        const int qs_ = ((KB) + 1) * 256, R_ = (SEQ - qs_) >> 3; \
        _Pragma("unroll") for (int i = 0; i < 8; ++i) { const int off = i * 64 + lg_; msel[i] = off < R_ ? ((const GAS unsigned*)selrow)[qs_ + wid * R_ + off] : 0u; } } while (0)
    MOBA_GFETCH((int)(code & 15u));
#pragma unroll 1
    for (int ik = 0; ik < 6; ++ik) {
        const int kb = (int)((code >> (4 * ik)) & 15u); if (kb == 15) break;
        const int kbn = (int)((code >> (4 * ik + 4)) & 15u);
        __syncthreads();
        { LAS char* kd = lds + L_K + kpiece_off(wid * 8 + (lane >> 3), lane & 7); LAS char* vd = lds + L_V + vpiece_off(wid * 8 + (lane >> 3), lane & 7);
#pragma unroll
          for (int t = 0; t < 4; ++t) { *(LAS u32x4*)(kd + t * 8192) = kr[t]; *(LAS u32x4*)(vd + t * 8192) = vr[t]; } }
        const int qs = (kb + 1) * 256, R = (SEQ - qs) >> 3;
        unsigned long long bal[8]; int cnt = 0;
#pragma unroll
        for (int i = 0; i < 8; ++i) { bal[i] = __ballot((msel[i] >> kb) & 1u); cnt += __builtin_popcountll(bal[i]); }
        if (lane == 0) wcnt[wid] = cnt;
        __syncthreads();
        int base = 0, n = 0;
#pragma unroll
        for (int w = 0; w < 8; ++w) { const int c = wcnt[w]; n += c; base += (w < wid) ? c : 0; }
#pragma unroll
        for (int i = 0; i < 8; ++i) { const unsigned long long m = bal[i];
            if ((m >> lane) & 1ull) list[base + __builtin_popcountll(m & ((1ull << lane) - 1ull))] = qs + wid * R + i * 64 + lane;
            base += __builtin_popcountll(m); }
        __syncthreads();
        const int ntask = (n + 31) >> 5;
        int tk = wid, qin = 0; bool vn = false; unsigned smn = 0u; bf16x8 qn[4];
#define MOBA_QFETCH() do { const int li_ = tk * 32 + r32; vn = li_ < n; { const int lv_ = list[vn ? li_ : (n > 0 ? n - 1 : 0)]; qin = n > 0 ? lv_ : qs; } smn = ((const GAS unsigned*)selrow)[qin]; \
            const bf16* qw = Q + (rowbase + qin) * 512 + h * 64 + hi * 8; \
            _Pragma("unroll") for (int d0 = 0; d0 < 4; ++d0) qn[d0] = *(const GAS bf16x8*)(qw + d0 * 16); } while (0)
        MOBA_QFETCH();
#pragma unroll 1
        while (tk < ntask) {
            const int qi = qin; const bool valid = vn; const unsigned sm = smn;
            bf16x8 qr[4];
#pragma unroll
            for (int d0 = 0; d0 < 4; ++d0) qr[d0] = qn[d0];
            tk += 8;
            const int slot = __builtin_popcount(sm & ((1u << kb) - 1u));
            const int qd = qi - qs, qrel = qd < 255 ? qd : 255;
            const bool nearw = __any(qd < 128);
            MOBA_BLOCK4(nearw ? 0 : -1, MOBA_QFETCH())
            const float lt = hsum(l), inv = 1.f / lt; const size_t t = rowbase + qi;
            bf16* orow = pslot(slot, t, h, YM, P2A, P2B) + 8 * hi;
#pragma unroll
            for (int d0 = 0; d0 < 2; ++d0)
#pragma unroll
                for (int gp = 0; gp < 2; ++gp) { const f32x16& oo = d0 ? o1 : o0; const int ga = 8 * gp, gb = 8 * gp + 4;
                    unsigned ax = cvtpk(oo[ga] * inv, oo[ga + 1] * inv), ay = cvtpk(oo[ga + 2] * inv, oo[ga + 3] * inv), bx = cvtpk(oo[gb] * inv, oo[gb + 1] * inv), by = cvtpk(oo[gb + 2] * inv, oo[gb + 3] * inv);
                    { auto r = __builtin_amdgcn_permlane32_swap(ax, bx, false, false); ax = r[0]; bx = r[1]; }
                    { auto r = __builtin_amdgcn_permlane32_swap(ay, by, false, false); ay = r[0]; by = r[1]; }
                    if (valid) *(GAS u32x4*)(orow + 32 * d0 + 16 * gp) = (u32x4){ax, ay, bx, by}; }
            if (valid && hi == 0) { GAS float* ml = (GAS float*)(ML + ((t * 8 + h) * 3 + slot) * 2); ml[0] = mref; ml[1] = lt; }
        }
#undef MOBA_QFETCH
        MOBA_GFETCH(kbn);
    }
#undef MOBA_GFETCH
}
__device__ __forceinline__ void diag_unit(int wid, int lane, int b, int h, int qb, const bf16* Q, const bf16* K, const bf16* V, bf16* YM, const bf16* P2A, const bf16* P2B, const float* ML, float bfar, LAS char* lds) {
    const int r32 = lane & 31, hi = lane >> 5; const size_t rowbase = (size_t)b * SEQ;
    LAS float* tb = (LAS float*)(lds + L_TB);
    const LAS char* kp0 = lds + L_K + hi * 1024 + r32 * 16;
    const LAS char* vp0 = lds + L_V + ((lane >> 4) & 1) * 32 + (lane & 3) * 8 + (4 * hi + ((lane & 15) >> 2)) * 64;
    __syncthreads();
    load_block(K, V, rowbase + (size_t)qb * 256, h, wid, lane, lds);
    const int qrel = wid * 32 + r32; const size_t t = rowbase + qb * 256 + qrel;
    bf16x8 qr[4];
    { const bf16* qw = Q + t * 512 + h * 64 + hi * 8;
#pragma unroll
      for (int d0 = 0; d0 < 4; ++d0) qr[d0] = *(const GAS bf16x8*)(qw + d0 * 16); }
    __syncthreads();
    MOBA_BLOCKC((wid >> 1) + 1)
    const int nsl = qb < 3 ? qb : 3;
    const GAS float* ml = (const GAS float*)(ML + (t * 8 + h) * 6);
    const bf16* pA = YM + t * 1024 + h * 64 + 8 * hi; const bf16* pB = YM + t * 1024 + 512 + h * 64 + 8 * hi;
    const bf16* pC = (t < (size_t)(T / 2) ? P2A + t * 512 : P2B + (t - (size_t)(T / 2)) * 512) + h * 64 + 8 * hi;
    float m0 = -3.0e38f, m1 = -3.0e38f, m2 = -3.0e38f, l0 = 0.f, l1 = 0.f, l2 = 0.f;
    u32x4 xA[4], xB[4], xC[4];
#pragma unroll
    for (int c = 0; c < 4; ++c) { xA[c] = (u32x4){0u, 0u, 0u, 0u}; xB[c] = xA[c]; xC[c] = xA[c]; }
    if (nsl > 0) { m0 = ml[0]; l0 = ml[1];
#pragma unroll
        for (int c = 0; c < 4; ++c) xA[c] = *(const GAS u32x4*)(pA + 16 * c); }
    if (nsl > 1) { m1 = ml[2]; l1 = ml[3];
#pragma unroll
        for (int c = 0; c < 4; ++c) xB[c] = *(const GAS u32x4*)(pB + 16 * c); }
    if (nsl > 2) { m2 = ml[4]; l2 = ml[5];
#pragma unroll
        for (int c = 0; c < 4; ++c) xC[c] = *(const GAS u32x4*)(pC + 16 * c); }
    const float M = __builtin_fmaxf(__builtin_fmaxf(mref, m0), __builtin_fmaxf(m1, m2));
    const float w0 = __builtin_amdgcn_exp2f(mref - M), wa = l0 * __builtin_amdgcn_exp2f(m0 - M), wb = l1 * __builtin_amdgcn_exp2f(m1 - M), wc = l2 * __builtin_amdgcn_exp2f(m2 - M);
    const float inv = 1.f / (hsum(l) * w0 + wa + wb + wc);
    const float s0 = w0 * inv, sa = wa * inv, sb = wb * inv, sc = wc * inv;
    bf16* orow = YM + t * 1024 + 512 + h * 64 + 8 * hi;
#pragma unroll
    for (int d0 = 0; d0 < 2; ++d0)
#pragma unroll
        for (int gp = 0; gp < 2; ++gp) { const f32x16& oo = d0 ? o1 : o0; const int ga = 8 * gp, gb = 8 * gp + 4, dof = 32 * d0 + 16 * gp, cc = 2 * d0 + gp;
            float a0 = oo[ga] * s0, a1 = oo[ga + 1] * s0, a2 = oo[ga + 2] * s0, a3 = oo[ga + 3] * s0, b0 = oo[gb] * s0, b1 = oo[gb + 1] * s0, b2 = oo[gb + 2] * s0, b3 = oo[gb + 3] * s0;
#define MOBA_ACC(X, W) { unsigned fx = X[cc].x, fy = X[cc].y, sx = X[cc].z, sy = X[cc].w; \
              { auto r = __builtin_amdgcn_permlane32_swap(fx, sx, false, false); fx = r[0]; sx = r[1]; } { auto r = __builtin_amdgcn_permlane32_swap(fy, sy, false, false); fy = r[0]; sy = r[1]; } \
              a0 += (W) * bf2f(fx & 0xffffu); a1 += (W) * __builtin_bit_cast(float, fx & 0xffff0000u); a2 += (W) * bf2f(fy & 0xffffu); a3 += (W) * __builtin_bit_cast(float, fy & 0xffff0000u); \
              b0 += (W) * bf2f(sx & 0xffffu); b1 += (W) * __builtin_bit_cast(float, sx & 0xffff0000u); b2 += (W) * bf2f(sy & 0xffffu); b3 += (W) * __builtin_bit_cast(float, sy & 0xffff0000u); }
            MOBA_ACC(xA, sa) MOBA_ACC(xB, sb) MOBA_ACC(xC, sc)
#undef MOBA_ACC
            unsigned ax = cvtpk(a0, a1), ay = cvtpk(a2, a3), bx = cvtpk(b0, b1), by = cvtpk(b2, b3);
            { auto r = __builtin_amdgcn_permlane32_swap(ax, bx, false, false); ax = r[0]; bx = r[1]; }
            { auto r = __builtin_amdgcn_permlane32_swap(ay, by, false, false); ay = r[0]; by = r[1]; }
            *(GAS u32x4*)(orow + dof) = (u32x4){ax, ay, bx, by}; }
}
__device__ __forceinline__ void diag_phase(int wave_, int ubeg, int uend, const bf16* Q, const bf16* K, const bf16* V, bf16* YM, const bf16* P2A, const bf16* P2B, const float* ML, const float* BT, LAS char* lds) {
    int lane_ = lane_id(); asm volatile("" : "+v"(lane_)); asm volatile("" : "+s"(wave_));
    int hc = -1; float bfar = 0.f;
#pragma unroll 1
    for (int u = ubeg; u < uend; ++u) {
        const int bh = u >> 4, qb = u & 15, h = bh & 7;
        if (h != hc) { hc = h; __syncthreads(); fill_bias_table(BT, h, wave_ * 64 + lane_, (LAS float*)(lds + L_TB)); bfar = BT[h * 132 + 128]; }
        diag_unit(wave_, lane_, bh >> 3, h, qb, Q, K, V, YM, P2A, P2B, ML, bfar, lds); }
}
#undef MOBA_CVEC
#undef MOBA_QK
#undef MOBA_NEARMAX
#undef MOBA_STEP
#undef MOBA_BLOCK4
#undef MOBA_BLOCKC
}

__device__ __forceinline__ void ph_cvt_x(const Ctx& F0) {
    const Ctx F = launder(F0);
    const int gw = F.vcu * NWAVES + F.wave, NGW = F.G * NWAVES; float* rs1 = (float*)(F.ws + WS_RS1);
    for (int m = gw; m < T; m += 2 * NGW) {
        f32x4 v[2][4];
#pragma unroll
        for (int r = 0; r < 2; ++r) { const int mr = m + r * NGW < T ? m + r * NGW : T - 1; const f32x4* xr = (const f32x4*)(F.in[0] + (size_t)mr * D) + F.lane;
#pragma unroll
            for (int j = 0; j < 4; ++j) v[r][j] = xr[64 * j]; }
#pragma unroll
        for (int r = 0; r < 2; ++r) { float s = 0.f;
#pragma unroll
            for (int j = 0; j < 4; ++j) s += (v[r][j].x * v[r][j].x + v[r][j].y * v[r][j].y) + (v[r][j].z * v[r][j].z + v[r][j].w * v[r][j].w);
            const float rstd = 1.f / sqrtf(wave_sum(s) * (1.f / D) + RMS_EPS);
            if (m + r * NGW >= T) continue;
            if (F.lane == 0) rs1[m + r * NGW] = rstd;
            unsigned long long* o8 = (unsigned long long*)(P_XB(F) + (size_t)(m + r * NGW) * D) + F.lane;
#pragma unroll
            for (int j = 0; j < 4; ++j) o8[64 * j] = (unsigned long long)pk2(v[r][j].x, v[r][j].y) | ((unsigned long long)pk2(v[r][j].z, v[r][j].w) << 32); }
    }
}
__device__ __forceinline__ float row_ssq_bf16(const bf16* row, int lane) {
    const u32x4* xr = (const u32x4*)row + lane; float s = 0.f;
#pragma unroll
    for (int j = 0; j < 2; ++j) { const u32x4 x = xr[64 * j];
        const float a0 = bf2f(x.x & 0xffffu), a1 = bf2f(x.x >> 16), a2 = bf2f(x.y & 0xffffu), a3 = bf2f(x.y >> 16), a4 = bf2f(x.z & 0xffffu), a5 = bf2f(x.z >> 16), a6 = bf2f(x.w & 0xffffu), a7 = bf2f(x.w >> 16);
        s += ((a0 * a0 + a1 * a1) + (a2 * a2 + a3 * a3)) + ((a4 * a4 + a5 * a5) + (a6 * a6 + a7 * a7)); }
    return wave_sum(s);
}
__device__ __forceinline__ void ph_rstd(const Ctx& F0) {
    const Ctx F = launder(F0);
    const int gw = F.vcu * NWAVES + F.wave, NGW = F.G * NWAVES; float* rs1 = (float*)(F.ws + WS_RS1);
    for (int m = gw; m < T; m += 4 * NGW) {
        u32x4 x[4][2];
#pragma unroll
        for (int r = 0; r < 4; ++r) { const int mr = m + r * NGW < T ? m + r * NGW : T - 1; const u32x4* xr = (const u32x4*)(P_XB(F) + (size_t)mr * D) + F.lane; x[r][0] = xr[0]; x[r][1] = xr[64]; }
#pragma unroll
        for (int r = 0; r < 4; ++r) { float s = 0.f;
#pragma unroll
            for (int j = 0; j < 2; ++j) { const u32x4 q = x[r][j];
                const float a0 = bf2f(q.x & 0xffffu), a1 = bf2f(q.x >> 16), a2 = bf2f(q.y & 0xffffu), a3 = bf2f(q.y >> 16), a4 = bf2f(q.z & 0xffffu), a5 = bf2f(q.z >> 16), a6 = bf2f(q.w & 0xffffu), a7 = bf2f(q.w >> 16);
                s += ((a0 * a0 + a1 * a1) + (a2 * a2 + a3 * a3)) + ((a4 * a4 + a5 * a5) + (a6 * a6 + a7 * a7)); }
            s = wave_sum(s); if (F.lane == 0 && m + r * NGW < T) rs1[m + r * NGW] = 1.f / sqrtf(s * (1.f / D) + RMS_EPS); } }
}

__device__ __forceinline__ void ph_bias_table(const Ctx& F0) {
    const Ctx F = launder(F0);
    if (F.vcu == 0) {
        const float* rel_bias = F.in[1];
        for (int i = F.tid; i < 8 * 132; i += NTHREADS) {
            const int h = i / 132, r = i % 132;
            int bk;
            if (r < 16) bk = r;
            else { bk = 16 + (int)(logf((float)r / 16.f) / logf(8.f) * 16.f); if (bk > 31) bk = 31; }
            P_BT(F)[i] = rel_bias[bk * 8 + h] * LOG2E;
        }
    }
}

template <int WIN> __device__ __forceinline__ void pool_item(const unsigned* __restrict__ P2, unsigned* __restrict__ D2, int m0, int t0) {
    unsigned v[32], pv[WIN];
#pragma unroll
    for (int j = 0; j < WIN; ++j) pv[j] = t0 > 0 ? P2[(size_t)(m0 - WIN + j) * 128] : 0u;
#pragma unroll
    for (int i = 0; i < 32; ++i) v[i] = P2[(size_t)(m0 + i) * 128];
    float s0 = 0.f, s1 = 0.f;
    if (t0 > 0) {
#pragma unroll
        for (int j = WIN - 1; j >= 0; --j) { s0 += bf2f(pv[j] & 0xffffu); s1 += bf2f(pv[j] >> 16); } }
#pragma unroll
    for (int i = 0; i < 32; ++i) { const int t = t0 + i; const float p0 = bf2f(v[i] & 0xffffu), p1 = bf2f(v[i] >> 16);
        s0 += p0; s1 += p1;
        if (t >= WIN) { const unsigned o = i >= WIN ? v[i >= WIN ? i - WIN : 0] : pv[i < WIN ? i : 0]; s0 -= bf2f(o & 0xffffu); s1 -= bf2f(o >> 16); }
        const float inv = (t + 1 < WIN) ? __builtin_amdgcn_rcpf((float)(t + 1)) : (1.f / (float)WIN);
        D2[(size_t)(m0 + i) * 128] = pk2(s0 * inv - p0, s1 * inv - p1); }
}
__device__ __forceinline__ void ph_pool_dl(const Ctx& F0) {
    const Ctx F = launder(F0);
    const int gt = F.vcu * NTHREADS + F.tid, NGT = F.G * NTHREADS;
    for (int it = gt; it < (T / 32) * 128; it += NGT) {
        const int cp = it & 127, chunk = it >> 7, gi = cp >> 5, m0 = chunk * 32, t0 = m0 & (SEQ - 1);
        const unsigned* P2 = (const unsigned*)P_PB(F) + cp; unsigned* D2 = (unsigned*)P_DL(F) + cp;
        if (gi == 0) pool_item<2>(P2, D2, m0, t0); else if (gi == 1) pool_item<4>(P2, D2, m0, t0); else if (gi == 2) pool_item<8>(P2, D2, m0, t0); else pool_item<16>(P2, D2, m0, t0);
    }
}
__device__ __forceinline__ void ph_final(const Ctx& F0) {
    const Ctx F = launder(F0);
    const int gw = F.vcu * NWAVES + F.wave, NGW = F.G * NWAVES;
    const f32x4* gf = (const f32x4*)F.in[26];
    for (int m = gw; m < T; m += 2 * NGW) {
        u32x4 x[2][2];
#pragma unroll
        for (int r = 0; r < 2; ++r) { const int mr = m + r * NGW < T ? m + r * NGW : T - 1; const u32x4* xr = (const u32x4*)(P_XB(F) + (size_t)mr * D) + F.lane; x[r][0] = xr[0]; x[r][1] = xr[64]; }
#pragma unroll
        for (int r = 0; r < 2; ++r) { float s = 0.f;
#pragma unroll
            for (int j = 0; j < 2; ++j) { const u32x4 q = x[r][j];
                const float a0 = bf2f(q.x & 0xffffu), a1 = bf2f(q.x >> 16), a2 = bf2f(q.y & 0xffffu), a3 = bf2f(q.y >> 16), a4 = bf2f(q.z & 0xffffu), a5 = bf2f(q.z >> 16), a6 = bf2f(q.w & 0xffffu), a7 = bf2f(q.w >> 16);
                s += ((a0 * a0 + a1 * a1) + (a2 * a2 + a3 * a3)) + ((a4 * a4 + a5 * a5) + (a6 * a6 + a7 * a7)); }
            const float rstd = 1.f / sqrtf(wave_sum(s) * (1.f / D) + RMS_EPS);
            if (m + r * NGW >= T) continue;
            f32x4* orow = (f32x4*)(F.R + (size_t)(m + r * NGW) * D);
#pragma unroll
            for (int j = 0; j < 2; ++j) { const u32x4 q = x[r][j]; const int c4 = 2 * (64 * j + F.lane);
                orow[c4] = (f32x4){bf2f(q.x & 0xffffu), bf2f(q.x >> 16), bf2f(q.y & 0xffffu), bf2f(q.y >> 16)} * rstd * gf[c4];
                orow[c4 + 1] = (f32x4){bf2f(q.z & 0xffffu), bf2f(q.z >> 16), bf2f(q.w & 0xffffu), bf2f(q.w >> 16)} * rstd * gf[c4 + 1]; } }
    }
}

constexpr int LDS_BYTES = 147456;
constexpr int MISC_OFF = 131072 + 320;

__global__ void __launch_bounds__(NTHREADS, 2) mk_fwd(Args args) {
    extern __shared__ __attribute__((aligned(16))) unsigned char lds[];
    Ctx F;
    F.lds = (LAS unsigned char*)lds;
    F.wave = __builtin_amdgcn_readfirstlane((int)threadIdx.x >> 6);
    F.lane = lane_id(); F.tid = F.wave * 64 + F.lane;
    F.G = gridDim.x; { const int bx = blockIdx.x; F.vcu = (F.G % 8 == 0) ? (bx % 8) * (F.G / 8) + bx / 8 : bx; }
    F.in = (KargP)__builtin_amdgcn_kernarg_segment_ptr(); F.R = args.out; F.ws = args.ws;
    unsigned char* ws = args.ws;
    volatile LAS unsigned* MISC = (volatile LAS unsigned*)(F.lds + MISC_OFF);
    if (F.tid < 64) MISC[F.tid] = 0u;
    __syncthreads();
    XcdBarrier bar = xcd_barrier_post((unsigned*)(ws + WS_CTL) + CW_BAR, MISC + 8, F.tid == 0);
#define GRID_BAR() do { bar.bar = (unsigned*)(wsl(ws) + WS_CTL) + CW_BAR; xcd_barrier(bar, F.wave); } while (0)
#define FL launder(F)

    ph_bias_table(F);
    ph_prologue(F);
#pragma unroll 1
    for (int l = 0; l < DEPTH; ++l) {
        if (l == 0) ph_cvt_x(F); else ph_rstd(F);
        GRID_BAR();
        { pg8::Gemm g{P_XB(FL), (const bf16*)(wsl(ws) + WS_WIN) + (size_t)l * NPROJ * D, D, D, D}; pg8::StaticOrder S; S.init(T, NPROJ, sl(F.G), sl((int)blockIdx.x));
          EpiProjE E{P_UG(FL), P_PB(FL), P_QB(FL), P_KB(FL), P_VB(FL), P_KMP(FL), (const float*)(wsl(ws) + WS_RS1)}; pg8::gemm_phase(F.lds, g, S, E, sl(F.wave)); }
        GRID_BAR();
        { pg8::Gemm g{P_UG(FL) + UOF, (const bf16*)(wsl(ws) + WS_BZ) + (size_t)l * SGN * 256 * 1024, UGP, 1024, 1024}; SsmOrder S{sl(F.G), sl((int)blockIdx.x), 1};
          EpiZ E{(float*)(wsl(ws) + WS_ZB)}; pg8::gemm_phase(F.lds, g, S, E, sl(F.wave)); }
        ph_pool_dl(F);
        moba::sel_phase(sl(F.wave), sl((int)blockIdx.x), sl(F.G), P_QB(FL), P_KMP(FL), (unsigned*)(wsl(ws) + WS_SEL), (LAS char*)F.lds);
        ph_tg_expand(F, l, sl((int)blockIdx.x), sl(F.G) > 64 ? 32 : 0);
        GRID_BAR();
        ph_ssm_scan(F, l);
        moba::gather_phase(sl(F.wave), sl(F.vcu), P_QB(FL), P_KB(FL), P_VB(FL), P_YMIX(FL), P_PB(FL), (bf16*)(wsl(ws) + WS_P2B), (float*)(wsl(ws) + WS_ML), (const unsigned*)(wsl(ws) + WS_SEL), P_BT(FL), (LAS char*)F.lds);
        GRID_BAR();
        { const int bx = sl((int)blockIdx.x), G_ = sl(F.G); const bool g256 = G_ == 256;
          const bool p2 = g256 ? (bx >> 3) < 16 : bx < 128; const int li = g256 ? (bx & 7) * 16 + ((bx >> 3) & 15) : (bx < 128 ? bx : bx - 128);
          { pg8::Gemm g{P_UG(FL), (const bf16*)(wsl(ws) + WS_TG) + (size_t)l * SGN * 1024 * UGP, UGP, UGP, UGP}; SsmOrder S{G_, p2 ? li : 4096, 2};
            EpiSsm2 E{P_YS(FL)}; pg8::gemm_phase(F.lds, g, S, E, sl(F.wave)); }
          int ub, ue;
          if (g256) { const int q4 = li & 3; ub = p2 ? (li >> 2) * 12 + (q4 == 0 ? 0 : q4 == 1 ? 4 : q4 == 2 ? 7 : 10) : 384 + 5 * li; ue = ub + (p2 ? (q4 == 0 ? 4 : q4 == 3 ? 2 : 3) : 5); }
          else { ub = (bx * 1024) / G_; ue = ((bx + 1) * 1024) / G_; }
          moba::diag_phase(sl(F.wave), ub, ue, P_QB(FL), P_KB(FL), P_VB(FL), P_YMIX(FL), P_PB(FL), (const bf16*)(wsl(ws) + WS_P2B), (const float*)(wsl(ws) + WS_ML), P_BT(FL), (LAS char*)F.lds); }
        GRID_BAR();
        { pg8::Gemm g{P_YS(FL), (const bf16*)(wsl(ws) + WS_GLUT) + (size_t)l * 65536, 256, 256, 256}; HalfOrder S{sl(F.vcu)};
          EpiGluE E{P_YS(FL), P_YMIX(FL), F.in[13] + l * 256}; pg8::gemm_phase(F.lds, g, S, E, sl(F.wave)); }
        { pg8::Gemm g{P_DL(FL), (const bf16*)(wsl(ws) + WS_POOLT) + (size_t)l * 65536, 256, 256, 256}; HalfOrder S{sl(F.vcu) - 128};
          EpiPoolE E{P_YMIX(FL), F.in[15] + l * 256, F.in[16] + l * 256}; pg8::gemm_phase(F.lds, g, S, E, sl(F.wave)); }
        GRID_BAR();
        { pg8::Gemm g{P_YMIX(FL), (const bf16*)(wsl(ws) + WS_WOUT) + (size_t)l * D * D, D, D, D}; pg8::StaticOrder S; S.init(T, D, sl(F.G), sl((int)blockIdx.x));
          EpiOutE E{P_XB(FL)}; pg8::gemm_phase(F.lds, g, S, E, sl(F.wave)); }
        GRID_BAR();
        ph_route(F, l);
        GRID_BAR();
        ph_place(F);
        GRID_BAR();
        int moeNT, moeBK;
        { pg8::Gemm g{P_XB(FL), (const bf16*)(wsl(ws) + WS_GU) + (size_t)l * 16 * 512 * D, D, D, D}; MoeOrder S{sl(F.G), sl(F.vcu), false, 0, 0}; S.init((const int*)(wsl(ws) + WS_TILEB)); moeNT = S.NT; moeBK = S.bks;
          EpiGU E{(bf16*)(wsl(ws) + WS_HACT), (const float*)(wsl(ws) + WS_ROWW), (const float*)(wsl(ws) + WS_ROWR)}; pg8::gemm_phase<true, true>(F.lds, g, S, E, sl(F.wave), (const int*)(wsl(ws) + WS_ROWTOK)); }
        GRID_BAR();
        { pg8::Gemm g{(const bf16*)(wsl(ws) + WS_HACT), (const bf16*)(wsl(ws) + WS_WD) + (size_t)l * 16 * D * 256, 512, 256, sl(512)}; MoeOrder S{sl(F.G), sl(F.vcu), true, moeNT, moeBK};
          EpiDown E{P_XB(FL), (const int*)(wsl(ws) + WS_ROWTOK)}; pg8::gemm_phase<true, false, true>(F.lds, g, S, E, sl(F.wave)); }
        GRID_BAR();
    }
    ph_final(F);
}

extern "C" void kernel_launch(void* const* d_in, const int* in_sizes, int n_in, void* d_out, int out_size, void* d_ws, size_t ws_size, hipStream_t stream) {
    static int grid = 0;
    if (grid == 0) {
        if (n_in != 27 || out_size != T * D || ws_size < WS_END) { fprintf(stderr, "kernel_launch: unexpected shapes (n_in %d out %d ws %zu)\n", n_in, out_size, ws_size); grid = -1; return; }
        int dev = 0, cus = 0, per_cu = 0;
        if (hipGetDevice(&dev) != hipSuccess || hipDeviceGetAttribute(&cus, hipDeviceAttributeMultiprocessorCount, dev) != hipSuccess) { grid = -1; return; }
        if (hipFuncSetAttribute((const void*)mk_fwd, hipFuncAttributeMaxDynamicSharedMemorySize, LDS_BYTES) != hipSuccess) { fprintf(stderr, "kernel_launch: hipFuncSetAttribute failed\n"); grid = -1; return; }
        if (hipOccupancyMaxActiveBlocksPerMultiprocessor(&per_cu, (const void*)mk_fwd, NTHREADS, LDS_BYTES) != hipSuccess || per_cu < 1) { fprintf(stderr, "kernel_launch: occupancy query says %d\n", per_cu); per_cu = 1; }
        (void)hipGetLastError();
        grid = cus;
    }
    if (grid < 0) return;
    (void)hipMemsetAsync((char*)d_ws + WS_CTL, 0, CTL_ZERO_BYTES, stream);
    Args a{};
    for (int i = 0; i < 27; ++i) a.in[i] = (const float*)d_in[i];
    a.out = (float*)d_out; a.ws = (unsigned char*)d_ws; a.pad0 = 0; a.pad1 = 0;
    hipLaunchKernelGGL(mk_fwd, dim3(grid), dim3(NTHREADS), LDS_BYTES, stream, a);
}
```
